# Optimizing an MI355X kernel written in HIP

```python
import math, functools
import jax
import jax.numpy as jnp
from jax import lax
import numpy as np

D_MODEL = 1024
BATCH = 4
SEQ = 8192
DEPTH = 4

CTX_LEN = 256
GRID_W = 64
D_MIX = D_MODEL
MIXER_W = D_MIX // 4
CHUNK = 32
NORM_EPS = 1e-6
ROPE_BASE = 10000.0
LB_FLOOR = 1e-30
LB_CEIL = 1.0 - 1e-6

RET_HEADS = 4
RET_DK = MIXER_W // RET_HEADS
RET_DV = MIXER_W // RET_HEADS

S5_GROUP = 16
S5_GROUPS = MIXER_W // S5_GROUP
S5_STATE = 64

HG_HEADS = 4
HG_DK = MIXER_W // HG_HEADS
HG_DV = MIXER_W // HG_HEADS

GLA_HEADS = 4
GLA_DK = MIXER_W // (2 * GLA_HEADS)
GLA_DV = MIXER_W // GLA_HEADS
GLA_RANK = 16
GLA_TAU = 16.0

D_FF = 2816
N_EXPERTS = 8
TOP_K = 2
D_FF_EXPERT = 2816
MOE_BLOCK = 256
N_DENSE = (DEPTH + 1) // 2
N_MOE = DEPTH // 2

COL_SPLITS = (
    ('ret_q', RET_HEADS * RET_DK), ('ret_k', RET_HEADS * RET_DK),
    ('ret_v', RET_HEADS * RET_DV), ('ret_g', RET_HEADS * RET_DV),
    ('s5_u', MIXER_W),
    ('hg_q', HG_HEADS * HG_DK), ('hg_ff', HG_HEADS * HG_DK), ('hg_fb', HG_HEADS * HG_DK),
    ('hg_i', HG_HEADS * HG_DV), ('hg_g', HG_HEADS * HG_DV),
    ('gla_q', GLA_HEADS * GLA_DK), ('gla_k', GLA_HEADS * GLA_DK),
    ('gla_v', GLA_HEADS * GLA_DV), ('gla_g', GLA_HEADS * GLA_DV),
    ('gla_af', GLA_RANK), ('gla_ab', GLA_RANK),
)
D_IN = sum(w for _, w in COL_SPLITS)

kernel_name = 'hybrid_ret_s5_hgrn2_gla_moe_dit'


def rmsnorm(x, w):
    xf = x.astype(jnp.float32)
    y = xf * lax.rsqrt(jnp.mean(xf * xf, axis=-1, keepdims=True) + NORM_EPS)
    return (y * w.astype(jnp.float32)).astype(x.dtype)


def head_norm(o, w, center):
    of = o.astype(jnp.float32)
    if center:
        of = of - jnp.mean(of, axis=-1, keepdims=True)
    of = of * lax.rsqrt(jnp.mean(of * of, axis=-1, keepdims=True) + NORM_EPS)
    return (of.reshape(o.shape[0], o.shape[1], -1) * w.astype(jnp.float32)).astype(o.dtype)


def modulate(h, shift, scale):
    return h * (1 + scale) + shift


def split_cols(p):
    names = [n for n, _ in COL_SPLITS]
    offsets = np.cumsum([w for _, w in COL_SPLITS])[:-1].tolist()
    return dict(zip(names, jnp.split(p, offsets, axis=-1)))


def to_heads(t, n_heads):
    return t.reshape(t.shape[0], t.shape[1], n_heads, t.shape[-1] // n_heads)


def rope_1d(t, pos):
    half = t.shape[-1] // 2
    freqs = ROPE_BASE ** (-jnp.arange(half, dtype=jnp.float32) / half)
    ang = pos[:, None] * freqs[None, :]
    cos = jnp.cos(ang)[None, :, None, :]
    sin = jnp.sin(ang)[None, :, None, :]
    t1 = t[..., :half].astype(jnp.float32)
    t2 = t[..., half:].astype(jnp.float32)
    return jnp.concatenate([t1 * cos - t2 * sin, t1 * sin + t2 * cos], axis=-1).astype(t.dtype)


def axial_rope(t, row, col):
    d = t.shape[-1] // 2
    return jnp.concatenate([rope_1d(t[..., :d], row), rope_1d(t[..., d:], col)], axis=-1)


def chunk_gated_scan(inputs, h0):
    q, k, v, log_g = (a.astype(jnp.float32) for a in inputs)
    bsz, seq, n_heads, dk = q.shape
    dv = v.shape[-1]
    n_chunks = seq // CHUNK

    def chunks(a):
        return jnp.moveaxis(a.reshape(bsz, n_chunks, CHUNK, *a.shape[2:]), 1, 0)

    if h0 is None:
        h0 = jnp.zeros((bsz, n_heads, dk, dv), jnp.float32)
    causal = jnp.tril(jnp.ones((CHUNK, CHUNK), dtype=bool))[None, :, :, None, None]
    scalar_decay = log_g.shape[-1] == 1

    def step(state, blk):
        qc, kc, vc, gc = blk
        b = jnp.cumsum(gc, axis=1)
        diff = b[:, :, None] - b[:, None, :]
        decay = jnp.where(causal, jnp.exp(jnp.where(causal, diff, 0.0)), 0.0)
        if scalar_decay:
            scores = jnp.einsum('bihk,bjhk->bijh', qc, kc) * decay[..., 0]
        else:
            scores = jnp.sum(qc[:, :, None] * kc[:, None, :] * decay, axis=-1)
        out = (jnp.einsum('bijh,bjhv->bihv', scores, vc)
               + jnp.einsum('bihk,bhkv->bihv', qc * jnp.exp(b), state))
        b_last = b[:, -1]
        state = (jnp.exp(b_last)[..., None] * state
                 + jnp.einsum('bjhk,bjhv->bhkv', kc * jnp.exp(b_last[:, None] - b), vc))
        return state, out

    h_final, out = lax.scan(step, h0, tuple(chunks(a) for a in (q, k, v, log_g)))
    out = jnp.moveaxis(out, 0, 1).reshape(bsz, seq, n_heads, dv)
    return h_final, out.astype(inputs[2].dtype)


def s5_scan(prm, inputs, h0):
    lam_re, lam_im, log_dt, b_re, b_im, c_re, c_im = (a.astype(jnp.float32) for a in prm)
    (u,) = inputs
    seq = u.shape[1]
    lam = lax.complex(lam_re, lam_im)
    a_bar = jnp.exp(lam * jnp.exp(log_dt)[:, None])
    b_bar = ((a_bar - 1) / lam)[..., None] * lax.complex(b_re, b_im)
    c_mat = lax.complex(c_re, c_im)
    bu = jnp.einsum('gpc,btgc->tbgp', b_bar, u.astype(jnp.float32).astype(jnp.complex64))
    if h0 is not None:
        bu = bu.at[0].add(a_bar * h0)
    a_seq = jnp.broadcast_to(a_bar, (seq, 1) + a_bar.shape)

    def combine(e1, e2):
        return e1[0] * e2[0], e2[0] * e1[1] + e2[1]

    _, h = lax.associative_scan(combine, (a_seq, bu), axis=0)
    y = jnp.einsum('gcp,tbgp->btgc', c_mat, h).real
    return h[-1], y.astype(u.dtype)


def prefixed_bidir(run_f, run_b, ctx_f, lat_f, ctx_b, lat_b, want_ctx):
    def flip(ts):
        return tuple(t[:, ::-1] for t in ts)
    h_f, yc_f = run_f(ctx_f, None)
    _, yl_f = run_f(lat_f, h_f)
    h_b, yc_b = run_b(flip(ctx_b), None)
    _, yl_b = run_b(flip(lat_b), h_b)
    y_lat = yl_f + yl_b[:, ::-1]
    y_ctx = yc_f + yc_b[:, ::-1] if want_ctx else None
    return y_ctx, y_lat


def retention_mixer(pc, pl, gn_w, row, col, want_ctx):
    def qkv(p, rotate):
        q = to_heads(p['ret_q'], RET_HEADS)
        k = to_heads(p['ret_k'], RET_HEADS) * (RET_DK ** -0.5)
        v = to_heads(p['ret_v'], RET_HEADS)
        if rotate:
            q, k = axial_rope(q, row, col), axial_rope(k, row, col)
        return q, k, v

    log_gamma_f = jnp.log1p(-(2.0 ** (-5.0 - jnp.arange(RET_HEADS, dtype=jnp.float32))))
    log_gamma_b = log_gamma_f[::-1]

    def decay(p, lg):
        return jnp.broadcast_to(lg[None, None, :, None], (p.shape[0], p.shape[1], RET_HEADS, 1))

    qc, kc, vc = qkv(pc, False)
    ql, kl, vl = qkv(pl, True)
    yc, yl = prefixed_bidir(
        chunk_gated_scan, chunk_gated_scan,
        (qc, kc, vc, decay(pc['ret_q'], log_gamma_f)), (ql, kl, vl, decay(pl['ret_q'], log_gamma_f)),
        (qc, kc, vc, decay(pc['ret_q'], log_gamma_b)), (ql, kl, vl, decay(pl['ret_q'], log_gamma_b)),
        want_ctx)

    def post(y, p):
        return head_norm(y, gn_w, True) * jax.nn.silu(p['ret_g'])
    return (post(yc, pc) if want_ctx else None), post(yl, pl)


def s5_mixer(pc, pl, lp, want_ctx):
    names = ('s5_lam_re', 's5_lam_im', 's5_log_dt', 's5_b_re', 's5_b_im', 's5_c_re', 's5_c_im')
    run_f = functools.partial(s5_scan, tuple(lp[n][0] for n in names))
    run_b = functools.partial(s5_scan, tuple(lp[n][1] for n in names))

    def groups(u):
        return u.reshape(u.shape[0], u.shape[1], S5_GROUPS, S5_GROUP)

    uc, ul = pc['s5_u'], pl['s5_u']
    yc, yl = prefixed_bidir(run_f, run_b, (groups(uc),), (groups(ul),), (groups(uc),), (groups(ul),), want_ctx)

    def post(y, u):
        y = y.reshape(u.shape) + lp['s5_d'] * u
        z = jax.nn.gelu(y)
        return z * jax.nn.sigmoid(z @ lp['s5_glu_w'] + lp['s5_glu_b'])
    return (post(yc, uc) if want_ctx else None), post(yl, ul)


def hgrn2_mixer(pc, pl, lower_bound, norm_w, want_ctx):
    lb = lower_bound.reshape(HG_HEADS, HG_DK).astype(jnp.float32)
    log_lb = jnp.log(jnp.maximum(lb, LB_FLOOR))
    log_1m_lb = jnp.log1p(-lb)

    def inputs(p, gate_name):
        z = to_heads(p[gate_name], HG_HEADS).astype(jnp.float32)
        log_f = jnp.logaddexp(log_lb, log_1m_lb + jax.nn.log_sigmoid(z))
        k = (1.0 - lb) * jax.nn.sigmoid(-z)
        return (to_heads(p['hg_q'], HG_HEADS), k, to_heads(p['hg_i'], HG_HEADS), log_f)

    yc, yl = prefixed_bidir(chunk_gated_scan, chunk_gated_scan,
                            inputs(pc, 'hg_ff'), inputs(pl, 'hg_ff'),
                            inputs(pc, 'hg_fb'), inputs(pl, 'hg_fb'), want_ctx)

    def post(y, p):
        return head_norm(y, norm_w, False) * jax.nn.silu(p['hg_g'])
    return (post(yc, pc) if want_ctx else None), post(yl, pl)


def gla_mixer(pc, pl, wa2, ba, norm_w, want_ctx):
    def inputs(p, d):
        low = p[('gla_af', 'gla_ab')[d]]
        log_a = jax.nn.log_sigmoid((low @ wa2[d] + ba[d]).astype(jnp.float32)) / GLA_TAU
        return (to_heads(p['gla_q'], GLA_HEADS),
                to_heads(p['gla_k'], GLA_HEADS) * (GLA_DK ** -0.5),
                to_heads(p['gla_v'], GLA_HEADS),
                to_heads(log_a, GLA_HEADS))

    yc, yl = prefixed_bidir(chunk_gated_scan, chunk_gated_scan,
                            inputs(pc, 0), inputs(pl, 0), inputs(pc, 1), inputs(pl, 1), want_ctx)

    def post(y, p):
        return head_norm(y, norm_w, False) * jax.nn.silu(p['gla_g'])
    return (post(yc, pc) if want_ctx else None), post(yl, pl)


def token_mix(pc, pl, lp, lower_bound, row, col, want_ctx):
    outs = [
        retention_mixer(pc, pl, lp['ret_gn_w'], row, col, want_ctx),
        s5_mixer(pc, pl, lp, want_ctx),
        hgrn2_mixer(pc, pl, lower_bound, lp['hg_norm_w'], want_ctx),
        gla_mixer(pc, pl, lp['gla_wa2'], lp['gla_ba'], lp['gla_norm_w'], want_ctx),
    ]
    y_lat = jnp.concatenate([o[1] for o in outs], axis=-1)
    y_ctx = jnp.concatenate([o[0] for o in outs], axis=-1) if want_ctx else None
    return y_ctx, y_lat


def swiglu(x, w1, w3, w2):
    return (jax.nn.silu(x @ w1) * (x @ w3)) @ w2


def moe_ffn(xf, router_w, router_b, w1, w3, w2):
    n_tok, d = xf.shape
    logits = (xf @ router_w + router_b).astype(jnp.float32)
    top_v, top_i = lax.top_k(logits, TOP_K)
    gates = jax.nn.softmax(top_v, axis=-1).astype(xf.dtype)
    n_assign = n_tok * TOP_K
    flat_e = top_i.reshape(-1)
    flat_tok = jnp.arange(n_assign, dtype=jnp.int32) // TOP_K
    flat_g = gates.reshape(-1)
    order = jnp.argsort(flat_e)
    se, stok, sg = flat_e[order], flat_tok[order], flat_g[order]
    counts = jnp.bincount(flat_e, length=N_EXPERTS)
    starts = jnp.cumsum(counts) - counts
    padded = (counts + MOE_BLOCK - 1) // MOE_BLOCK * MOE_BLOCK
    pends = jnp.cumsum(padded)
    pstarts = pends - padded
    dest = pstarts[se] + (jnp.arange(n_assign, dtype=jnp.int32) - starts[se])
    n_blocks = -(-n_assign // MOE_BLOCK) + N_EXPERTS
    cap = n_blocks * MOE_BLOCK
    xbuf = jnp.zeros((cap, d), xf.dtype).at[dest].set(xf[stok])
    block_start = jnp.arange(n_blocks, dtype=jnp.int32) * MOE_BLOCK
    block_e = jnp.minimum(jnp.searchsorted(pends, block_start, side='right'), N_EXPERTS - 1)

    def expert_block(args):
        xb, e = args
        return swiglu(xb, w1[e], w3[e], w2[e])

    ybuf = lax.map(expert_block, (xbuf.reshape(n_blocks, MOE_BLOCK, d), block_e)).reshape(cap, d)
    return jnp.zeros_like(xf).at[stok].add(ybuf[dest] * sg[:, None])


def setup_inputs(seed: int = 0) -> dict:
    key = jax.random.key(seed)
    ks = iter(jax.random.split(key, 48))
    f32 = jnp.float32

    def nrm(shape, scale):
        return scale * jax.random.normal(next(ks), shape, f32)

    G, P, Cg = S5_GROUPS, S5_STATE, S5_GROUP
    return {
        'x': nrm((BATCH, SEQ, D_MODEL), 1.0),
        'c': nrm((BATCH, D_MODEL), 1.0),
        'ctx': nrm((BATCH, CTX_LEN, D_MODEL), 1.0),
        'c_ctx': nrm((D_MODEL,), 1.0),
        'ada_w': nrm((DEPTH, D_MODEL, 6 * D_MODEL), 0.5 * D_MODEL ** -0.5),
        'ada_b': nrm((DEPTH, 6 * D_MODEL), 0.02),
        'norm1_w': 1.0 + nrm((DEPTH, D_MODEL), 0.02),
        'norm2_w': 1.0 + nrm((DEPTH, D_MODEL), 0.02),
        'w_in': nrm((DEPTH, D_MODEL, D_IN), D_MODEL ** -0.5),
        'w_out': nrm((DEPTH, D_MIX, D_MODEL), D_MIX ** -0.5),
        'ret_gn_w': 1.0 + nrm((DEPTH, RET_HEADS * RET_DV), 0.02),
        's5_lam_re': -0.5 + nrm((DEPTH, 2, G, P), 0.01),
        's5_lam_im': math.pi * jnp.arange(P, dtype=f32) + nrm((DEPTH, 2, G, P), 0.01),
        's5_log_dt': jax.random.uniform(next(ks), (DEPTH, 2, G), f32, math.log(1e-3), math.log(1e-1)),
        's5_b_re': nrm((DEPTH, 2, G, P, Cg), (2 * Cg) ** -0.5),
        's5_b_im': nrm((DEPTH, 2, G, P, Cg), (2 * Cg) ** -0.5),
        's5_c_re': nrm((DEPTH, 2, G, Cg, P), P ** -0.5),
        's5_c_im': nrm((DEPTH, 2, G, Cg, P), P ** -0.5),
        's5_d': nrm((DEPTH, MIXER_W), 1.0),
        's5_glu_w': nrm((DEPTH, MIXER_W, MIXER_W), MIXER_W ** -0.5),
        's5_glu_b': nrm((DEPTH, MIXER_W), 0.02),
        'hg_lb_logits': nrm((DEPTH, HG_HEADS * HG_DK), 0.5),
        'hg_norm_w': 1.0 + nrm((DEPTH, HG_HEADS * HG_DV), 0.02),
        'gla_wa2': nrm((DEPTH, 2, GLA_RANK, GLA_HEADS * GLA_DK), GLA_RANK ** -0.5),
        'gla_ba': nrm((DEPTH, 2, GLA_HEADS * GLA_DK), 0.5),
        'gla_norm_w': 1.0 + nrm((DEPTH, GLA_HEADS * GLA_DV), 0.02),
        'ffn_w1': nrm((N_DENSE, D_MODEL, D_FF), D_MODEL ** -0.5),
        'ffn_w3': nrm((N_DENSE, D_MODEL, D_FF), D_MODEL ** -0.5),
        'ffn_w2': nrm((N_DENSE, D_FF, D_MODEL), D_FF ** -0.5),
        'router_w': nrm((N_MOE, D_MODEL, N_EXPERTS), D_MODEL ** -0.5),
        'router_b': nrm((N_MOE, N_EXPERTS), 0.01),
        'moe_w1': nrm((N_MOE, N_EXPERTS, D_MODEL, D_FF_EXPERT), D_MODEL ** -0.5),
        'moe_w3': nrm((N_MOE, N_EXPERTS, D_MODEL, D_FF_EXPERT), D_MODEL ** -0.5),
        'moe_w2': nrm((N_MOE, N_EXPERTS, D_FF_EXPERT, D_MODEL), D_FF_EXPERT ** -0.5),
        'final_norm_w': 1.0 + nrm((D_MODEL,), 0.02),
    }


def reference(x, c, ctx, c_ctx, ada_w, ada_b, norm1_w, norm2_w, w_in, w_out, ret_gn_w,
              s5_lam_re, s5_lam_im, s5_log_dt, s5_b_re, s5_b_im, s5_c_re, s5_c_im, s5_d,
              s5_glu_w, s5_glu_b, hg_lb_logits, hg_norm_w, gla_wa2, gla_ba, gla_norm_w,
              ffn_w1, ffn_w3, ffn_w2, router_w, router_b, moe_w1, moe_w3, moe_w2, final_norm_w):
    bsz, seq, d = x.shape
    rows = seq // GRID_W
    t_idx = jnp.arange(rows * GRID_W, dtype=jnp.int32)
    row = (t_idx // GRID_W).astype(jnp.float32)
    col = (t_idx % GRID_W).astype(jnp.float32)

    lb_sm = jax.nn.softmax(hg_lb_logits.astype(jnp.float32), axis=0)
    lower_bounds = jnp.clip(jnp.cumsum(lb_sm, axis=0) - lb_sm[0], 0.0, LB_CEIL)

    cond_lat = jax.nn.silu(c)
    cond_ctx = jax.nn.silu(c_ctx)
    h = ctx
    n_lat = bsz * seq
    for l in range(DEPTH):
        keep_ctx = l < DEPTH - 1
        ml = [m[:, None, :] for m in jnp.split(cond_lat @ ada_w[l] + ada_b[l], 6, axis=-1)]
        mc = jnp.split(cond_ctx @ ada_w[l] + ada_b[l], 6, axis=-1)

        pl = split_cols(modulate(rmsnorm(x, norm1_w[l]), ml[0], ml[1]) @ w_in[l])
        pc = split_cols(modulate(rmsnorm(h, norm1_w[l]), mc[0], mc[1]) @ w_in[l])
        lp = {
            'ret_gn_w': ret_gn_w[l],
            's5_lam_re': s5_lam_re[l], 's5_lam_im': s5_lam_im[l], 's5_log_dt': s5_log_dt[l],
            's5_b_re': s5_b_re[l], 's5_b_im': s5_b_im[l], 's5_c_re': s5_c_re[l], 's5_c_im': s5_c_im[l],
            's5_d': s5_d[l], 's5_glu_w': s5_glu_w[l], 's5_glu_b': s5_glu_b[l],
            'hg_norm_w': hg_norm_w[l],
            'gla_wa2': gla_wa2[l], 'gla_ba': gla_ba[l], 'gla_norm_w': gla_norm_w[l],
        }
        y_ctx, y_lat = token_mix(pc, pl, lp, lower_bounds[l], row, col, keep_ctx)
        x = x + ml[2] * (y_lat @ w_out[l])
        if keep_ctx:
            h = h + mc[2] * (y_ctx @ w_out[l])

        tokens = modulate(rmsnorm(x, norm2_w[l]), ml[3], ml[4]).reshape(-1, d)
        if keep_ctx:
            fc = modulate(rmsnorm(h, norm2_w[l]), mc[3], mc[4]).reshape(-1, d)
            tokens = jnp.concatenate([tokens, fc], axis=0)
        j = l // 2
        if l % 2 == 0:
            f = swiglu(tokens, ffn_w1[j], ffn_w3[j], ffn_w2[j])
        else:
            f = moe_ffn(tokens, router_w[j], router_b[j], moe_w1[j], moe_w3[j], moe_w2[j])
        x = x + ml[5] * f[:n_lat].reshape(bsz, seq, d)
        if keep_ctx:
            h = h + mc[5] * f[n_lat:].reshape(h.shape)

    return rmsnorm(x, final_norm_w)
```

```cpp
#include <hip/hip_runtime.h>
#include <cstdio>
#include <cstdint>
#define LAS __attribute__((address_space(3)))
namespace pg8 {
#define PG8_LAS __attribute__((address_space(3)))
typedef unsigned short bf16_t;
typedef short bf16x8 __attribute__((ext_vector_type(8)));
typedef float f32x4 __attribute__((ext_vector_type(4)));
typedef unsigned u32x4 __attribute__((ext_vector_type(4)));
constexpr int BM = 256, BK = 64, HALF = 128, HTB = HALF * BK * 2  , STAGE_BYTES = 8 * HTB, NXCD = 8, WGM = 8;

__host__ __device__ __forceinline__ int lds_byte(int r, int c) { const int st = (r >> 4) * 2 + (c >> 5), rr = r & 15, cc = c & 31, ob = rr * 64 + cc * 2; return st * 1024 + (ob ^ (((ob >> 9) & 1) << 5)); }
__host__ __device__ __forceinline__ void stage_rc(int b, int& R, int& C) { const int st = b / 1024, sb = b % 1024, swz = sb ^ (((sb >> 9) & 1) << 5); R = (st >> 1) * 16 + swz / 64; C = (st & 1) * 32 + (swz % 64) / 2; }
__host__ __device__ __forceinline__ int perm32(int rho) { const int n = rho >> 4, i = rho & 15; return 8 * (i >> 2) + 4 * n + (i & 3); }

struct Unit { int pm, pn, pc; };
struct Gemm { const bf16_t* A; const bf16_t* Bt; int M, N, K; };

struct StaticOrder {
    int nM, nN, nwg, G, c;
    __host__ __device__ void init(int M, int N, int G_, int c_) { nM = M / BM; nN = N / BM; nwg = nM * nN; G = G_; c = c_; }
    __host__ __device__ bool next(int i, Unit& u) const {
        const long L = (long)i * G + c; if (L >= nwg) return false;
        int wgid = (int)L; { const int q = nwg / NXCD, r = nwg % NXCD, xcd = wgid % NXCD, off = wgid / NXCD; wgid = (xcd < r ? xcd * (q + 1) : r * (q + 1) + (xcd - r) * q) + off; }
        const int nig = WGM * nN, gid = wgid / nig, fm = gid * WGM, gsz = (nM - fm) < WGM ? (nM - fm) : WGM;
        u.pm = fm + ((wgid % nig) % gsz); u.pn = (wgid % nig) / gsz; u.pc = u.pn; return true;
    }
    __device__ __forceinline__ void a_ready(const Unit&) const {}
    __device__ __forceinline__ void done(const Unit&) const {}
};

__device__ __forceinline__ unsigned cvt_pk_bf16(float lo, float hi) { unsigned r; asm volatile("v_cvt_pk_bf16_f32 %0, %1, %2" : "=v"(r) : "v"(lo), "v"(hi)); return r; }
typedef float f32x2 __attribute__((ext_vector_type(2)));

template <class Epi, class Sched, bool ALIGN_EPI = false, bool SP2 = false>
__device__ __forceinline__ void gemm_phase(PG8_LAS unsigned char* lds, const Gemm g, const Sched& S, const Epi& E, const int tid) {
    const int wid = __builtin_amdgcn_readfirstlane(tid >> 6), lane = tid & 63, wr = wid >> 2, wc = wid & 3, fr = lane & 15, fq = lane >> 4;
    const int K = g.K, nt = K / BK;
    unsigned voffA[2], voffB[2];
#pragma unroll
    for (int i = 0; i < 2; ++i) { int R, C; stage_rc(tid * 16 + i * 8192, R, C); const int Rb = Epi::PERM ? ((R & ~31) + perm32(R & 31)) : R;
        voffA[i] = (unsigned)(R * K + C) * 2u; voffB[i] = (unsigned)(Rb * K + C) * 2u; }
    const size_t kstep = (size_t)(BK * 2);
    const size_t hstep = (size_t)HALF * K * 2;
    const size_t tstep = 2 * hstep;
    const unsigned ldsw = (unsigned)wid * 1024u;
    const int aoff = lds_byte(wr * 64 + fr, fq * 8), boff = lds_byte(wc * 32 + fr, fq * 8);
#define PG8_SA(b, h) (((b) * 2 + (h)) * HTB)
#define PG8_SB(b, h) ((4 + (b) * 2 + (h)) * HTB)
#define PG8_STAGE(bufoff, gbase, voff) do { _Pragma("unroll") for (int _i = 0; _i < 2; ++_i) \
        __builtin_amdgcn_global_load_lds((const unsigned*)((const char*)(gbase) + (voff)[_i]), (PG8_LAS unsigned*)(lds + (bufoff) + ldsw + _i * 8192), 16, 0, 0); } while (0)
#define PG8_LDA(dst, b, h) do { _Pragma("unroll") for (int m = 0; m < 4; ++m) _Pragma("unroll") for (int k = 0; k < 2; ++k) dst[m][k] = *(const PG8_LAS bf16x8*)(lds + PG8_SA(b, h) + aoff + m * 2048 + k * 1024); } while (0)
#define PG8_LDB(dst, b, h) do { _Pragma("unroll") for (int n = 0; n < 2; ++n) _Pragma("unroll") for (int k = 0; k < 2; ++k) dst[n][k] = *(const PG8_LAS bf16x8*)(lds + PG8_SB(b, h) + boff + n * 2048 + k * 1024); } while (0)
#define PG8_MMA(ai, bj, At, Bt) do { __builtin_amdgcn_s_setprio(1); _Pragma("unroll") for (int m = 0; m < 4; ++m) _Pragma("unroll") for (int n = 0; n < 2; ++n) _Pragma("unroll") for (int k = 0; k < 2; ++k) \
        acc[ai][bj][m][n] = __builtin_amdgcn_mfma_f32_16x16x32_bf16(Bt[n][k], At[m][k], acc[ai][bj][m][n], 0, 0, 0); __builtin_amdgcn_s_setprio(0); } while (0)
#define PG8_WAIT_V(n) asm volatile("s_waitcnt vmcnt(" #n ")" ::: "memory")
#define PG8_WAIT_L(n) asm volatile("s_waitcnt lgkmcnt(" #n ")" ::: "memory")
#define PG8_BAR __builtin_amdgcn_s_barrier()
#define PG8_SCHED __builtin_amdgcn_sched_barrier(0)
    Unit cur, nxt; int ui = 0;
    if (!S.next(0, cur)) return;
    f32x4 acc[2][2][4][2];
#pragma unroll
    for (int a = 0; a < 2; ++a)
#pragma unroll
        for (int b = 0; b < 2; ++b)
#pragma unroll
            for (int m = 0; m < 4; ++m)
#pragma unroll
                for (int n = 0; n < 2; ++n) acc[a][b][m][n] = (f32x4){0.f, 0.f, 0.f, 0.f};
    bf16x8 At[4][2], B0[2][2], B1[2][2];
    const char* cA = (const char*)g.A + (size_t)cur.pm * tstep; const char* cB = (const char*)g.Bt + (size_t)cur.pn * tstep;
    S.a_ready(cur);
    if constexpr (SP2) {
        PG8_STAGE(PG8_SB(0, 0), cB, voffB); PG8_STAGE(PG8_SB(0, 1), cB + hstep, voffB); PG8_STAGE(PG8_SA(0, 0), cA, voffA); PG8_STAGE(PG8_SA(0, 1), cA + hstep, voffA);
        if (wr == 1) PG8_BAR;
        PG8_WAIT_V(2); PG8_BAR;
        PG8_STAGE(PG8_SB(1, 0), cB + kstep, voffB); PG8_STAGE(PG8_SA(1, 0), cA + kstep, voffA); PG8_STAGE(PG8_SB(1, 1), cB + hstep + kstep, voffB);
        PG8_WAIT_V(6); PG8_BAR;
    } else {
        PG8_STAGE(PG8_SB(0, 0), cB, voffB); PG8_STAGE(PG8_SA(0, 0), cA, voffA); PG8_STAGE(PG8_SB(0, 1), cB + hstep, voffB); PG8_STAGE(PG8_SA(0, 1), cA + hstep, voffA);
        if (wr == 1) PG8_BAR;
        PG8_WAIT_V(4); PG8_BAR;
        PG8_STAGE(PG8_SB(1, 0), cB + kstep, voffB); PG8_STAGE(PG8_SA(1, 0), cA + kstep, voffA); PG8_STAGE(PG8_SB(1, 1), cB + hstep + kstep, voffB);
        PG8_WAIT_V(6); PG8_BAR;
    }
    for (;;) {
        const bool has_next = S.next(ui + 1, nxt);
        const char* nA = has_next ? (const char*)g.A + (size_t)nxt.pm * tstep : cA; const char* nB = has_next ? (const char*)g.Bt + (size_t)nxt.pn * tstep : cB;
        for (int t = 0; t < nt; t += 2) {
            const bool last = (t == nt - 2);
            const char* a1 = cA + (size_t)(t + 1) * kstep;
            const char* a2 = last ? nA : cA + (size_t)(t + 2) * kstep; const char* b2 = last ? nB : cB + (size_t)(t + 2) * kstep;
            const char* a3 = a2 + kstep; const char* b3 = b2 + kstep;
            if (last && has_next) S.a_ready(nxt);
            if constexpr (SP2) {
            PG8_LDB(B0, 0, 0); PG8_LDB(B1, 0, 1); PG8_SCHED; PG8_LDA(At, 0, 0); PG8_STAGE(PG8_SA(1, 1), a1 + hstep, voffA);
            PG8_WAIT_V(8); PG8_WAIT_L(0); PG8_BAR; PG8_MMA(0, 0, At, B0); PG8_MMA(0, 1, At, B1); PG8_BAR; PG8_SCHED;
            PG8_LDA(At, 0, 1); PG8_STAGE(PG8_SB(0, 0), b2, voffB); PG8_STAGE(PG8_SB(0, 1), b2 + hstep, voffB); PG8_STAGE(PG8_SA(0, 0), a2, voffA);
            PG8_WAIT_V(8); PG8_WAIT_L(0); PG8_BAR; PG8_MMA(1, 0, At, B0); PG8_MMA(1, 1, At, B1); PG8_BAR; PG8_SCHED;
            PG8_LDB(B0, 1, 0); PG8_LDB(B1, 1, 1); PG8_SCHED; PG8_LDA(At, 1, 0); PG8_STAGE(PG8_SA(0, 1), a2 + hstep, voffA);
            PG8_WAIT_V(8); PG8_WAIT_L(0); PG8_BAR; PG8_MMA(0, 0, At, B0); PG8_MMA(0, 1, At, B1); PG8_BAR; PG8_SCHED;
            PG8_LDA(At, 1, 1); PG8_STAGE(PG8_SB(1, 0), b3, voffB); PG8_STAGE(PG8_SB(1, 1), b3 + hstep, voffB); PG8_STAGE(PG8_SA(1, 0), a3, voffA);
            PG8_WAIT_V(8); PG8_WAIT_L(0); PG8_BAR; PG8_MMA(1, 0, At, B0); PG8_MMA(1, 1, At, B1); PG8_BAR; PG8_SCHED;
            } else {
            PG8_LDB(B0, 0, 0); PG8_SCHED; PG8_LDA(At, 0, 0); PG8_STAGE(PG8_SA(1, 1), a1 + hstep, voffA);
            PG8_WAIT_L(8); PG8_BAR; PG8_WAIT_L(0); PG8_MMA(0, 0, At, B0); PG8_BAR; PG8_SCHED;
            PG8_LDB(B1, 0, 1); PG8_STAGE(PG8_SB(0, 0), b2, voffB);
            PG8_BAR; PG8_WAIT_L(0); PG8_MMA(0, 1, At, B1); PG8_BAR;
            PG8_LDA(At, 0, 1); PG8_STAGE(PG8_SA(0, 0), a2, voffA);
            PG8_BAR; PG8_WAIT_L(0); PG8_MMA(1, 0, At, B0); PG8_BAR; PG8_SCHED;
            PG8_STAGE(PG8_SB(0, 1), b2 + hstep, voffB);
            PG8_WAIT_V(6); PG8_BAR; PG8_MMA(1, 1, At, B1); PG8_BAR;
            PG8_LDB(B0, 1, 0); PG8_SCHED; PG8_LDA(At, 1, 0); PG8_STAGE(PG8_SA(0, 1), a2 + hstep, voffA);
            PG8_WAIT_L(8); PG8_BAR; PG8_WAIT_L(0); PG8_MMA(0, 0, At, B0); PG8_BAR; PG8_SCHED;
            PG8_LDB(B1, 1, 1); PG8_STAGE(PG8_SB(1, 0), b3, voffB);
            PG8_BAR; PG8_WAIT_L(0); PG8_MMA(0, 1, At, B1); PG8_BAR;
            PG8_LDA(At, 1, 1); PG8_STAGE(PG8_SA(1, 0), a3, voffA);
            PG8_BAR; PG8_WAIT_L(0); PG8_MMA(1, 0, At, B0); PG8_BAR; PG8_SCHED;
            PG8_STAGE(PG8_SB(1, 1), b3 + hstep, voffB);
            PG8_WAIT_V(6); PG8_BAR; PG8_MMA(1, 1, At, B1); PG8_BAR;
            }
        }
        if constexpr (ALIGN_EPI) { if (wr == 0) PG8_BAR; }
        if constexpr (!Epi::AFTER_DRAIN) { E(acc, cur, wr, wc, fr, fq); S.done(cur); }
        if (!has_next) break;
#pragma unroll
        for (int a = 0; a < 2; ++a)
#pragma unroll
            for (int b = 0; b < 2; ++b)
#pragma unroll
                for (int m = 0; m < 4; ++m)
#pragma unroll
                    for (int n = 0; n < 2; ++n) acc[a][b][m][n] = (f32x4){0.f, 0.f, 0.f, 0.f};
        cur = nxt; cA = nA; cB = nB; ++ui;
        if constexpr (ALIGN_EPI) { if (wr == 1) PG8_BAR; }
    }
    PG8_WAIT_V(0);
    if constexpr (!ALIGN_EPI) { if (wr == 0) PG8_BAR; }
    PG8_BAR;
    if constexpr (Epi::AFTER_DRAIN) { E.fused(acc, cur, wr, wc, fr, fq, lds, wid, lane); S.done(cur); }
#undef PG8_SA
#undef PG8_SB
#undef PG8_STAGE
#undef PG8_LDA
#undef PG8_LDB
#undef PG8_MMA
#undef PG8_WAIT_V
#undef PG8_WAIT_L
#undef PG8_BAR
#undef PG8_SCHED
}
}

#define XB_TMO      128
#define XB_XCNT(j)  (256  + 64 * (j))
#define XB_XSUB(j)  (1280 + 64 * (j))
#define XB_XGEN(j)  (2304 + 64 * (j))
#define XB_TOP      3328
#define XB_TOPGEN   3392
#define XCD_BAR_WORDS 3456
#define XB_SPIN_CAP (1u << 18)

__device__ __forceinline__ unsigned xb_ld(unsigned* p)              { return __hip_atomic_load(p, __ATOMIC_RELAXED, __HIP_MEMORY_SCOPE_AGENT); }
__device__ __forceinline__ unsigned xb_add(unsigned* p, unsigned v) { return __hip_atomic_fetch_add(p, v, __ATOMIC_RELAXED, __HIP_MEMORY_SCOPE_AGENT); }
__device__ __forceinline__ unsigned xb_xcc_id() { return (unsigned)__builtin_amdgcn_s_getreg((3 << 11) | 20) & 0xFu; }
#define XB_SPIN(cond, bar) do { unsigned _sp = 0; while (cond) { __builtin_amdgcn_s_sleep(1); \
    if ((++_sp & 255u) == 0u) { if (xb_ld(&(bar)[XB_TMO])) break; if (_sp > XB_SPIN_CAP) { atomicAdd(&(bar)[XB_TMO], 1u); break; } } } } while (0)

struct XcdBarrier {
    unsigned* bar; unsigned x;
    volatile LAS unsigned* st;
};

__device__ __forceinline__ XcdBarrier xcd_barrier_post(unsigned* bar, volatile LAS unsigned* st, const int xb_tid) {
    XcdBarrier b; b.bar = bar; b.x = xb_xcc_id(); b.st = st;
    if (xb_tid == 0) (void)xb_add(&bar[XB_XCNT(b.x)], 1u);
    return b;
}
__device__ __forceinline__ void xcd_barrier_complete(unsigned* bar, unsigned x, unsigned& nloc, unsigned& nx) {
    const unsigned G = gridDim.x * gridDim.y * gridDim.z;
    unsigned sum, cnt, mine, sp = 0u;
    for (;;) {
        sum = 0u; cnt = 0u; mine = 0u;
#pragma unroll
        for (unsigned j = 0; j < 16; ++j) { const unsigned c = xb_ld(&bar[XB_XCNT(j)]); sum += c; cnt += (c > 0u) ? 1u : 0u; mine = (j == x) ? c : mine; }
        if (sum == G) break;
        __builtin_amdgcn_s_sleep(1);
        if ((++sp & 255u) == 0u) { if (xb_ld(&bar[XB_TMO])) break; if (sp > XB_SPIN_CAP) { atomicAdd(&bar[XB_TMO], 1u); break; } }
    }
    nloc = mine > 0u ? mine : 1u; nx = cnt > 0u ? cnt : 1u;
}

__device__ __forceinline__ void xcd_barrier(const XcdBarrier& b, const int xb_tid) {
    asm volatile("s_waitcnt vmcnt(0)" ::: "memory");
    __syncthreads();
    if (xb_tid == 0) {
        unsigned* bar = b.bar;
        __builtin_amdgcn_s_waitcnt(0);
        unsigned nloc = b.st[0], nx = b.st[1];
        if (nloc == 0u) { xcd_barrier_complete(bar, b.x, nloc, nx); b.st[0] = nloc; b.st[1] = nx; }
        const unsigned old = xb_add(&bar[XB_XSUB(b.x)], 1u);
        const unsigned gen = old / nloc;
        if (old + 1u == (gen + 1u) * nloc) {
            __builtin_amdgcn_fence(__ATOMIC_RELEASE, "agent");
            asm volatile("s_waitcnt vmcnt(0)" ::: "memory");
            const unsigned og = xb_add(&bar[XB_TOP], 1u);
            const unsigned tg = og / nx;
            if (og + 1u == (tg + 1u) * nx) xb_add(&bar[XB_TOPGEN], 1u);
            else XB_SPIN(xb_ld(&bar[XB_TOPGEN]) == tg, bar);
            __builtin_amdgcn_fence(__ATOMIC_ACQUIRE, "agent");
            xb_add(&bar[XB_XGEN(b.x)], 1u);
            asm volatile("s_waitcnt vmcnt(0)" ::: "memory");
        } else {
            XB_SPIN(xb_ld(&bar[XB_XGEN(b.x)]) == gen, bar);
            __builtin_amdgcn_fence(__ATOMIC_ACQUIRE, "agent");
            asm volatile("s_waitcnt vmcnt(0)" ::: "memory");
        }
    }
    __syncthreads();
}

#define GAS __attribute__((address_space(1)))
typedef unsigned short bf16;
typedef unsigned v4u __attribute__((ext_vector_type(4)));
typedef unsigned v2u __attribute__((ext_vector_type(2)));
typedef float f32x4 __attribute__((ext_vector_type(4)));

constexpr int NB = 4, SEQ = 8192, DM = 1024, DEPTH = 4, CTXL = 256;
constexpr int NLAT = NB * SEQ, NCTX = NB * CTXL, MT = NLAT + NCTX;
constexpr int DIN = 3360, DINP = 3584, DFF = 2816, NEXP = 8;
constexpr int C_RQ = 0, C_RK = 256, C_RV = 512, C_RG = 768, C_S5 = 1024, C_HQ = 1280, C_HFF = 1536, C_HFB = 1792, C_HI = 2048, C_HG = 2304,
              C_GQ = 2560, C_GK = 2688, C_GV = 2816, C_GG = 3072, C_GAF = 3328, C_GAB = 3344;
constexpr int NSEG = 132;
constexpr int MOE_CAP_TILES = 272;
constexpr float NEPS = 1e-6f;

constexpr size_t MiB = 1u << 20;
constexpr size_t WS_CTL = 0, CTL_ZERO_BYTES = 2 * MiB;
constexpr size_t WS_MOD = 2 * MiB;
constexpr size_t WS_LB = 3 * MiB;
constexpr size_t WS_ROPE = 3 * MiB + 65536;
constexpr size_t WS_GLUW = 3 * MiB + 131072;
constexpr size_t WS_WIN = 4 * MiB;
constexpr size_t WS_WOUT = 32 * MiB;
constexpr size_t WS_W13D = 40 * MiB;
constexpr size_t WS_W2D = 62 * MiB;
constexpr size_t WS_W13M = 73 * MiB;
constexpr size_t WS_W2M = 161 * MiB;
constexpr size_t WS_HB = 205 * MiB;
constexpr size_t WS_ACT = 209 * MiB;
constexpr size_t WS_Z = 275 * MiB;
constexpr size_t WS_PH = 292 * MiB;
constexpr size_t WS_OF = (292 + 232) * MiB;
constexpr size_t WS_X2 = 666 * MiB;
constexpr size_t WS_LIST = 843 * MiB;
constexpr size_t WS_END = 846 * MiB;
constexpr size_t ST_DS0 = 0;
constexpr size_t ST_DS1 = ST_DS0 + (size_t)2 * 16 * NSEG * 4096;
constexpr size_t ST_DS2 = ST_DS1 + (size_t)2 * 16 * NSEG * 4096;
constexpr size_t ST_G0 = ST_DS2 + (size_t)2 * 16 * NSEG * 2048;
constexpr size_t ST_G1 = ST_G0 + (size_t)2 * 16 * NSEG * 64;
constexpr size_t ST_G2 = ST_G1 + (size_t)2 * 16 * NSEG * 64;
constexpr size_t ST_HS = ST_G2 + (size_t)2 * 16 * NSEG * 64;
constexpr size_t ST_END = ST_HS + (size_t)2 * 64 * NSEG * 128;
static_assert(ST_END * 4 <= (WS_LIST - WS_X2), "state region");
static_assert(WS_PH + (size_t)MT * DINP * 2 <= WS_OF && WS_OF + (size_t)MT * 768 * 4 <= WS_X2, "OF region");
static_assert((size_t)MOE_CAP_TILES * 256 * 1024 * 2 <= (WS_LIST - WS_X2), "XB region");
static_assert((size_t)MOE_CAP_TILES * 256 * DFF * 2 <= (WS_X2 - WS_PH) && (size_t)MT * DINP * 2 <= (WS_X2 - WS_PH), "P/H region");
constexpr int CW_BAR = 4096;
constexpr int CW_CNT = 16384;

constexpr int LDS_BYTES = 147456;
constexpr int MISC_OFF = 131072 + 320;

__device__ __forceinline__ float bf2f(unsigned short h) { return __uint_as_float(((unsigned)h) << 16); }
__device__ __forceinline__ unsigned f2bf(float f) { unsigned u = __float_as_uint(f); return (u + 0x7fffu + ((u >> 16) & 1u)) >> 16; }
__device__ __forceinline__ unsigned pk2(float lo, float hi) { return f2bf(lo) | (f2bf(hi) << 16); }
__device__ __forceinline__ float wave_sum(float v) {
#pragma unroll
    for (int o = 1; o < 64; o <<= 1) v += __shfl_xor(v, o);
    return v;
}
__device__ __forceinline__ float rdl(float v, int k) { return __uint_as_float((unsigned)__builtin_amdgcn_readlane((int)__float_as_uint(v), k)); }
__device__ __forceinline__ float sigm(float x) { return 1.0f / (1.0f + __expf(-x)); }
__device__ __forceinline__ float silu_f(float x) { return x / (1.0f + __expf(-x)); }
#define LDS_WAIT() asm volatile("s_waitcnt lgkmcnt(0)" ::: "memory")

struct Args {
    const float* in[37];
    int l_lo, l_hi, ph_lo, ph_hi, do_pro, do_fin, fused, pad;
};
constexpr int I_OUT = 35, I_WS = 36;
enum { I_X = 0, I_C, I_CTX, I_CCTX, I_ADAW, I_ADAB, I_N1W, I_N2W, I_WIN, I_WOUT, I_RETGN, I_LAMRE, I_LAMIM, I_LOGDT, I_BRE, I_BIM, I_CRE, I_CIM, I_S5D,
       I_GLUW, I_GLUB, I_LBL, I_HGNW, I_WA2, I_BA, I_GLANW, I_FW1, I_FW3, I_FW2, I_RW, I_RB, I_MW1, I_MW3, I_MW2, I_FINW };

struct Frame {
    LAS unsigned char* lds;
    int tid, lane, wave, gw, NGW, G, zz;
    unsigned char* ws; float* out;
};

struct EpiStoreBf16 {
    static constexpr bool PERM = true, AFTER_DRAIN = false;
    bf16* O; int ldc;
    __device__ __forceinline__ void operator()(const pg8::f32x4 (&acc)[2][2][4][2], const pg8::Unit& u, int wr, int wc, int fr, int fq) const {
        const int row0 = u.pm * 256 + wr * 64 + fr, col0 = u.pc * 256 + wc * 32 + 8 * fq;
#pragma unroll
        for (int ai = 0; ai < 2; ++ai)
#pragma unroll
            for (int m = 0; m < 4; ++m) { bf16* rowp = O + (size_t)(row0 + ai * 128 + m * 16) * ldc + col0;
#pragma unroll
                for (int bj = 0; bj < 2; ++bj) { const pg8::f32x4 v0 = acc[ai][bj][m][0], v1 = acc[ai][bj][m][1];
                    pg8::u32x4 w; w.x = pg8::cvt_pk_bf16(v0[0], v0[1]); w.y = pg8::cvt_pk_bf16(v0[2], v0[3]); w.z = pg8::cvt_pk_bf16(v1[0], v1[1]); w.w = pg8::cvt_pk_bf16(v1[2], v1[3]);
                    *(pg8::u32x4*)(rowp + bj * 128) = w; } }
    }
};
struct EpiSwiglu {
    static constexpr bool PERM = true, AFTER_DRAIN = false;
    bf16* H;
    __device__ __forceinline__ void operator()(const pg8::f32x4 (&acc)[2][2][4][2], const pg8::Unit& u, int wr, int wc, int fr, int fq) const {
        const int row0 = u.pm * 256 + wr * 64 + fr, col0 = u.pc * 128 + wc * 32 + 8 * fq;
#pragma unroll
        for (int ai = 0; ai < 2; ++ai)
#pragma unroll
            for (int m = 0; m < 4; ++m) { bf16* rowp = H + (size_t)(row0 + ai * 128 + m * 16) * DFF + col0;
                float h[8];
#pragma unroll
                for (int n = 0; n < 2; ++n)
#pragma unroll
                    for (int j = 0; j < 4; ++j) { const float a = acc[ai][0][m][n][j], b = acc[ai][1][m][n][j];
                        h[n * 4 + j] = a * __builtin_amdgcn_rcpf(1.0f + __builtin_amdgcn_exp2f(-1.4426950408889634f * a)) * b; }
                pg8::u32x4 w; w.x = pg8::cvt_pk_bf16(h[0], h[1]); w.y = pg8::cvt_pk_bf16(h[2], h[3]); w.z = pg8::cvt_pk_bf16(h[4], h[5]); w.w = pg8::cvt_pk_bf16(h[6], h[7]);
                *(pg8::u32x4*)rowp = w; }
    }
};
struct EpiResid {
    static constexpr bool PERM = false, AFTER_DRAIN = false;
    const float* xin_lat; const float* xin_ctx; float* xout_lat; float* xout_ctx; const float* gate;
    __device__ __forceinline__ void operator()(const pg8::f32x4 (&acc)[2][2][4][2], const pg8::Unit& u, int wr, int wc, int fr, int fq) const {
        const bool isctx = u.pm >= 128; const int bidx = isctx ? 4 : (u.pm >> 5);
        const size_t rbase = (size_t)(isctx ? (u.pm - 128) : u.pm) * 256 + wr * 64 + fr;
        const float* xi = (isctx ? xin_ctx : xin_lat); float* xo = (isctx ? xout_ctx : xout_lat);
        const int col0 = u.pc * 256 + wc * 32 + 4 * fq; const float* g = gate + (size_t)bidx * 6144 + col0;
        pg8::f32x4 gv[2][2];
#pragma unroll
        for (int bj = 0; bj < 2; ++bj)
#pragma unroll
            for (int n = 0; n < 2; ++n) gv[bj][n] = *(const pg8::f32x4*)(g + bj * 128 + n * 16);
#pragma unroll
        for (int ai = 0; ai < 2; ++ai)
#pragma unroll
            for (int m = 0; m < 4; ++m) { const size_t off = (rbase + ai * 128 + m * 16) * 1024 + col0;
#pragma unroll
                for (int bj = 0; bj < 2; ++bj)
#pragma unroll
                    for (int n = 0; n < 2; ++n) { const pg8::f32x4 xv = *(const pg8::f32x4*)(xi + off + bj * 128 + n * 16);
                        *(pg8::f32x4*)(xo + off + bj * 128 + n * 16) = xv + gv[bj][n] * acc[ai][bj][m][n]; }
                asm volatile("" ::: "memory"); }
    }
};
struct EpiGlu {
    static constexpr bool PERM = true, AFTER_DRAIN = false;
    const bf16* Z; bf16* Y; const float* bias;
    __device__ __forceinline__ void operator()(const pg8::f32x4 (&acc)[2][2][4][2], const pg8::Unit& u, int wr, int wc, int fr, int fq) const {
        const int row0 = u.pm * 256 + wr * 64 + fr, col0 = wc * 32 + 8 * fq;
#pragma unroll
        for (int ai = 0; ai < 2; ++ai)
#pragma unroll
            for (int m = 0; m < 4; ++m) { const size_t row = (size_t)(row0 + ai * 128 + m * 16);
#pragma unroll
                for (int bj = 0; bj < 2; ++bj) { const int col = col0 + bj * 128;
                    const pg8::u32x4 zz = *(const pg8::u32x4*)(Z + row * 256 + col);
                    const pg8::f32x4 b0 = *(const pg8::f32x4*)(bias + col), b1 = *(const pg8::f32x4*)(bias + col + 4);
                    const pg8::f32x4 v0 = acc[ai][bj][m][0] + b0, v1 = acc[ai][bj][m][1] + b1;
                    float o[8]; const unsigned zw[4] = {zz.x, zz.y, zz.z, zz.w};
#pragma unroll
                    for (int j = 0; j < 4; ++j) { const float zl = __uint_as_float(zw[j] << 16), zh = __uint_as_float(zw[j] & 0xffff0000u);
                        const float a0 = (j < 2) ? v0[2 * j] : v1[2 * j - 4], a1 = (j < 2) ? v0[2 * j + 1] : v1[2 * j - 3];
                        o[2 * j] = zl * sigm(a0); o[2 * j + 1] = zh * sigm(a1); }
                    pg8::u32x4 w; w.x = pg8::cvt_pk_bf16(o[0], o[1]); w.y = pg8::cvt_pk_bf16(o[2], o[3]); w.z = pg8::cvt_pk_bf16(o[4], o[5]); w.w = pg8::cvt_pk_bf16(o[6], o[7]);
                    *(pg8::u32x4*)(Y + row * 1024 + 256 + col) = w; }
                asm volatile("" ::: "memory"); }
    }
};
struct MoeOrder {
    int tp[9]; int nN, G, c, total;
    __device__ __forceinline__ void init(const unsigned* cnt, int nN_, int G_, int c_) {
        tp[0] = 0;
#pragma unroll
        for (int e = 0; e < 8; ++e) tp[e + 1] = tp[e] + (int)(((unsigned)__builtin_amdgcn_readfirstlane((int)__hip_atomic_load(cnt + e * 64, __ATOMIC_RELAXED, __HIP_MEMORY_SCOPE_AGENT)) + 255u) >> 8);
        nN = nN_; G = G_; c = c_; total = tp[8] * nN;
    }
    __device__ __forceinline__ bool next(int i, pg8::Unit& u) const {
        const int L = i * G + c; if (L >= total) return false;
        const int t = L / nN, pn = L - t * nN; int e = 0;
#pragma unroll
        for (int k = 1; k < 8; ++k) e += (t >= tp[k]) ? 1 : 0;
        u.pm = t; u.pn = e * nN + pn; u.pc = pn; return true;
    }
    __device__ __forceinline__ void a_ready(const pg8::Unit&) const {}
    __device__ __forceinline__ void done(const pg8::Unit&) const {}
};

__device__ __forceinline__ void cvt_item(const float* W, int K, int N, bf16* WT, int mode, int add, LAS float* scr, int item, int lane) {
    const int nblk = N >> 5, kb = item / nblk, nb = item - kb * nblk, k0 = 64 * kb, n0 = 32 * nb;
    const int r = lane >> 3, c4 = lane & 7;
    f32x4 v[8];
#pragma unroll
    for (int i = 0; i < 8; ++i) v[i] = *(const f32x4*)(W + (size_t)(k0 + 8 * i + r) * N + n0 + 4 * c4);
#pragma unroll
    for (int i = 0; i < 8; ++i) {
#pragma unroll
        for (int j = 0; j < 4; ++j) scr[(8 * i + r) * 33 + 4 * c4 + j] = v[i][j]; }
    LDS_WAIT();
    const int c = lane & 7;
#pragma unroll
    for (int j = 0; j < 4; ++j) { const int n = (lane >> 3) + 8 * j; const LAS float* s = scr + (8 * c) * 33 + n;
        v4u o; o.x = pk2(s[0 * 33], s[1 * 33]); o.y = pk2(s[2 * 33], s[3 * 33]); o.z = pk2(s[4 * 33], s[5 * 33]); o.w = pk2(s[6 * 33], s[7 * 33]);
        const int nn = n0 + n; const int drow = (mode == 0) ? (nn + add) : (((nn >> 7) << 8) + (nn & 127) + add);
        *(v4u*)(WT + (size_t)drow * K + k0 + 8 * c) = o; }
    LDS_WAIT();
}
__device__ __forceinline__ void moe_cvt(const Frame& F, const Args& a, int j) {
    LAS float* scr = (LAS float*)(F.lds + F.wave * 16384);
    constexpr int IT = 1408;
    for (int it = F.gw; it < 8 * 3 * IT; it += F.NGW) {
        const int e = it / (3 * IT), r = it - e * 3 * IT, which = r / IT, item = r - which * IT;
        const size_t eo = ((size_t)j * 8 + e) * (size_t)(1024 * DFF);
        if (which == 0) cvt_item(a.in[F.zz + I_MW1] + eo, 1024, DFF, (bf16*)(F.ws + WS_W13M) + (size_t)e * 5632 * 1024, 1, 0, scr, item, F.lane);
        else if (which == 1) cvt_item(a.in[F.zz + I_MW3] + eo, 1024, DFF, (bf16*)(F.ws + WS_W13M) + (size_t)e * 5632 * 1024, 1, 128, scr, item, F.lane);
        else cvt_item(a.in[F.zz + I_MW2] + eo, DFF, 1024, (bf16*)(F.ws + WS_W2M) + (size_t)e * 1024 * DFF, 0, 0, scr, item, F.lane);
    }
}
__device__ __forceinline__ void prologue(const Frame& F, const Args& a) {
    {
        LAS float* sc = (LAS float*)F.lds; LAS float* red = sc + 5120;
        for (int idx = F.tid; idx < 5120; idx += 512) { const int r = idx >> 10, k = idx & 1023; const float cv = (r < 4) ? a.in[F.zz + I_C][r * 1024 + k] : a.in[F.zz + I_CCTX][k]; sc[idx] = silu_f(cv); }
        __syncthreads();
        float* MOD = (float*)(F.ws + WS_MOD);
        for (int item = blockIdx.x; item < 384; item += F.G) {
            const int l = item / 96, nb = item - l * 96, cl = F.tid & 63, ks = F.tid >> 6, n = nb * 64 + cl;
            float acc[5] = {0.f, 0.f, 0.f, 0.f, 0.f};
            const float* wp = a.in[F.zz + I_ADAW] + ((size_t)l * 1024 + ks * 128) * 6144 + n;
#pragma unroll 16
            for (int kk = 0; kk < 128; ++kk) { const float w = wp[(size_t)kk * 6144];
#pragma unroll
                for (int r = 0; r < 5; ++r) acc[r] = fmaf(sc[r * 1024 + ks * 128 + kk], w, acc[r]); }
#pragma unroll
            for (int r = 0; r < 5; ++r) red[(ks * 5 + r) * 64 + cl] = acc[r];
            __syncthreads();
            if (F.tid < 320) { const int r = F.tid >> 6; float s = 0.f;
#pragma unroll
                for (int k2 = 0; k2 < 8; ++k2) s += red[(k2 * 5 + r) * 64 + cl];
                MOD[((size_t)l * 5 + r) * 6144 + n] = s + a.in[F.zz + I_ADAB][l * 6144 + n]; }
            __syncthreads();
        }
        if (blockIdx.x == 0 && F.tid < 256) {
            const float* lg = a.in[F.zz + I_LBL]; float x[4], mx = -3.0e38f;
#pragma unroll
            for (int l = 0; l < 4; ++l) { x[l] = lg[l * 256 + F.tid]; mx = fmaxf(mx, x[l]); }
            float s = 0.f;
#pragma unroll
            for (int l = 0; l < 4; ++l) { x[l] = expf(x[l] - mx); s += x[l]; }
            float cs = 0.f; const float sm0 = x[0] / s; float* LB = (float*)(F.ws + WS_LB);
#pragma unroll
            for (int l = 0; l < 4; ++l) { cs += x[l] / s; LB[l * 256 + F.tid] = fminf(fmaxf(cs - sm0, 0.f), 1.0f - 1e-6f); }
        }
        if (blockIdx.x == (1 % F.G)) {
            float* RC = (float*)(F.ws + WS_ROPE); float* RS = RC + 2048;
            for (int idx = F.tid; idx < 2048; idx += 512) { const int pos = idx >> 4, i = idx & 15;
                const float fr = powf(10000.0f, -(float)i / 16.0f); const float ang = (float)pos * fr; RC[idx] = cosf(ang); RS[idx] = sinf(ang); }
        }
        __syncthreads();
    }
    LAS float* scr = (LAS float*)(F.lds + F.wave * 16384);
    constexpr int I_IN = 16 * 105, I_OUT = 16 * 32, I_F = 1408, I_GL = 4 * 8;
    constexpr int NIT = 4 * I_IN + 4 * I_OUT + 6 * I_F + 4 * I_GL;
    for (int it = F.gw; it < NIT; it += F.NGW) {
        int r = it;
        if (r < 4 * I_IN) { const int l = r / I_IN; cvt_item(a.in[F.zz + I_WIN] + (size_t)l * 1024 * DIN, 1024, DIN, (bf16*)(F.ws + WS_WIN) + (size_t)l * DINP * 1024, 0, 0, scr, r - l * I_IN, F.lane); continue; } r -= 4 * I_IN;
        if (r < 4 * I_OUT) { const int l = r / I_OUT; cvt_item(a.in[F.zz + I_WOUT] + (size_t)l * 1024 * 1024, 1024, 1024, (bf16*)(F.ws + WS_WOUT) + (size_t)l * 1024 * 1024, 0, 0, scr, r - l * I_OUT, F.lane); continue; } r -= 4 * I_OUT;
        if (r < 6 * I_F) { const int j = r / (3 * I_F), r2 = r - j * 3 * I_F, which = r2 / I_F, item = r2 - which * I_F; const size_t wo = (size_t)j * 1024 * DFF;
            if (which == 0) cvt_item(a.in[F.zz + I_FW1] + wo, 1024, DFF, (bf16*)(F.ws + WS_W13D) + (size_t)j * 5632 * 1024, 1, 0, scr, item, F.lane);
            else if (which == 1) cvt_item(a.in[F.zz + I_FW3] + wo, 1024, DFF, (bf16*)(F.ws + WS_W13D) + (size_t)j * 5632 * 1024, 1, 128, scr, item, F.lane);
            else cvt_item(a.in[F.zz + I_FW2] + wo, DFF, 1024, (bf16*)(F.ws + WS_W2D) + (size_t)j * 1024 * DFF, 0, 0, scr, item, F.lane);
            continue; } r -= 6 * I_F;
        { const int l = r / I_GL; cvt_item(a.in[F.zz + I_GLUW] + (size_t)l * 65536, 256, 256, (bf16*)(F.ws + WS_GLUW) + (size_t)l * 65536, 0, 0, scr, r - l * I_GL, F.lane); }
    }
    moe_cvt(F, a, 0);
    { const v4u z = {0u, 0u, 0u, 0u};
      for (int i = blockIdx.x * 512 + F.tid; i < 4 * 28672; i += F.G * 512) { const int l = i / 28672, o = i - l * 28672;
          *((v4u*)((bf16*)(F.ws + WS_WIN) + (size_t)l * DINP * 1024 + (size_t)DIN * 1024) + o) = z; } }
}

struct MoeTp { int tp[9]; };
__device__ __forceinline__ void load_tp(MoeTp& t, const unsigned* cnt) {
    t.tp[0] = 0;
#pragma unroll
    for (int e = 0; e < 8; ++e) t.tp[e + 1] = t.tp[e] + (int)(((unsigned)__builtin_amdgcn_readfirstlane((int)__hip_atomic_load(cnt + e * 64, __ATOMIC_RELAXED, __HIP_MEMORY_SCOPE_AGENT)) + 255u) >> 8);
}
template <int MODE>
__device__ __forceinline__ void norm_phase(const Frame& F, const Args& a, int l, int which  , int nrows, int comb_l  ) {
    const float* MOD = (const float*)(F.ws + WS_MOD);
    const float* nw = (MODE == 2) ? a.in[F.zz + I_FINW] : ((which ? a.in[F.zz + I_N2W] : a.in[F.zz + I_N1W]) + l * 1024);
    bf16* XN = (bf16*)(F.ws + WS_ACT);
    float* hb = (float*)(F.ws + WS_HB);
    const int* EP = (const int*)(F.ws + WS_LIST) + 8 * MT; const float* GATE = (const float*)(F.ws + WS_LIST) + 10 * MT;
    const bf16* YM = (const bf16*)(F.ws + WS_X2);
    const bool from_input = (l == 0 && which == 0 && MODE != 2);
    MoeTp ctp; if (comb_l >= 0) load_tp(ctp, (const unsigned*)F.ws + CW_CNT + (comb_l >> 1) * 8 * 64);
    const int jm = l >> 1;
    LAS float* rwl = (LAS float*)F.lds;
    if (MODE == 1) {
        const float* rw = a.in[F.zz + I_RW] + (size_t)jm * 8192;
        for (int idx = F.tid; idx < 8192; idx += 512) { const int k = idx >> 3, e = idx & 7; rwl[e * 1024 + k] = rw[idx]; }
        __syncthreads();
    }
    f32x4 wv[4];
#pragma unroll
    for (int j = 0; j < 4; ++j) wv[j] = *((const f32x4*)nw + F.lane + 64 * j);
    for (int m = F.gw; m < nrows; m += F.NGW) {
        const bool isctx = m >= NLAT; const int bidx = isctx ? 4 : (m >> 13);
        const float* xr = from_input ? (isctx ? a.in[F.zz + I_CTX] + (size_t)(m - NLAT) * 1024 : a.in[F.zz + I_X] + (size_t)m * 1024)
                                     : (isctx ? hb + (size_t)(m - NLAT) * 1024 : F.out + (size_t)m * 1024);
        f32x4 v[4];
#pragma unroll
        for (int j = 0; j < 4; ++j) v[j] = *((const f32x4*)xr + F.lane + 64 * j);
        if (comb_l >= 0) {
            const int ep0 = EP[2 * m], ep1 = EP[2 * m + 1]; const float g0 = GATE[2 * m], g1 = GATE[2 * m + 1];
            int t0 = 0, t1 = 0;
#pragma unroll
            for (int e = 0; e < 8; ++e) { t0 = ((ep0 & 7) == e) ? ctp.tp[e] : t0; t1 = ((ep1 & 7) == e) ? ctp.tp[e] : t1; }
            const size_t d0 = (size_t)t0 * 256 + (ep0 >> 3), d1 = (size_t)t1 * 256 + (ep1 >> 3);
            const float* m5 = MOD + ((size_t)comb_l * 5 + bidx) * 6144 + 5 * 1024;
            float* xw = isctx ? hb + (size_t)(m - NLAT) * 1024 : F.out + (size_t)m * 1024;
#pragma unroll
            for (int j = 0; j < 4; ++j) {
                const v2u y0 = *((const v2u*)(YM + d0 * 1024) + F.lane + 64 * j), y1 = *((const v2u*)(YM + d1 * 1024) + F.lane + 64 * j);
                const f32x4 mm = *((const f32x4*)m5 + F.lane + 64 * j);
                f32x4 f0, f1;
                f0[0] = __uint_as_float(y0.x << 16); f0[1] = __uint_as_float(y0.x & 0xffff0000u); f0[2] = __uint_as_float(y0.y << 16); f0[3] = __uint_as_float(y0.y & 0xffff0000u);
                f1[0] = __uint_as_float(y1.x << 16); f1[1] = __uint_as_float(y1.x & 0xffff0000u); f1[2] = __uint_as_float(y1.y << 16); f1[3] = __uint_as_float(y1.y & 0xffff0000u);
                v[j] = v[j] + mm * (f0 * g0 + f1 * g1);
                if (MODE != 2) *((f32x4*)xw + F.lane + 64 * j) = v[j];
            }
        }
        float ss = 0.f;
#pragma unroll
        for (int j = 0; j < 4; ++j) ss += (v[j][0] * v[j][0] + v[j][1] * v[j][1]) + (v[j][2] * v[j][2] + v[j][3] * v[j][3]);
        ss = wave_sum(ss);
        const float rstd = 1.0f / sqrtf(ss * (1.0f / 1024.0f) + NEPS);
        if (MODE == 2) {
#pragma unroll
            for (int j = 0; j < 4; ++j) *((f32x4*)(F.out + (size_t)m * 1024) + F.lane + 64 * j) = v[j] * rstd * wv[j];
        } else {
            const float* sh = MOD + ((size_t)l * 5 + bidx) * 6144 + (which ? 3 : 0) * 1024; const float* scl = sh + 1024;
            f32x4 o[4];
#pragma unroll
            for (int j = 0; j < 4; ++j) { const f32x4 s1 = *((const f32x4*)scl + F.lane + 64 * j), s0 = *((const f32x4*)sh + F.lane + 64 * j);
                o[j] = (v[j] * rstd * wv[j]) * (s1 + 1.0f) + s0;
                v2u w; w.x = pk2(o[j][0], o[j][1]); w.y = pk2(o[j][2], o[j][3]);
                *((v2u*)(XN + (size_t)m * 1024) + F.lane + 64 * j) = w; }
            if (MODE == 1) {
                float p[8];
#pragma unroll
                for (int e = 0; e < 8; ++e) { float s = 0.f;
#pragma unroll
                    for (int j = 0; j < 4; ++j) { const f32x4 w4 = *((const LAS f32x4*)(rwl + e * 1024) + F.lane + 64 * j);
                        s += (o[j][0] * w4[0] + o[j][1] * w4[1]) + (o[j][2] * w4[2] + o[j][3] * w4[3]); }
                    p[e] = wave_sum(s) + a.in[F.zz + I_RB][jm * 8 + e]; }
                int e0 = 0; float v0 = p[0];
#pragma unroll
                for (int e = 1; e < 8; ++e) if (p[e] > v0) { v0 = p[e]; e0 = e; }
                int e1 = -1; float v1 = -3.0e38f;
#pragma unroll
                for (int e = 0; e < 8; ++e) if (e != e0 && p[e] > v1) { v1 = p[e]; e1 = e; }
                const float ex = expf(v1 - v0), g0 = 1.0f / (1.0f + ex), g1 = ex / (1.0f + ex);
                if (F.lane == 0) {
                    unsigned* cnt = (unsigned*)F.ws + CW_CNT + jm * 8 * 64; int* LIST = (int*)(F.ws + WS_LIST);
                    int* EPw = (int*)(F.ws + WS_LIST) + 8 * MT; float* GW = (float*)(F.ws + WS_LIST) + 10 * MT;
                    const unsigned p0 = __hip_atomic_fetch_add(cnt + e0 * 64, 1u, __ATOMIC_RELAXED, __HIP_MEMORY_SCOPE_AGENT);
                    const unsigned p1 = __hip_atomic_fetch_add(cnt + e1 * 64, 1u, __ATOMIC_RELAXED, __HIP_MEMORY_SCOPE_AGENT);
                    LIST[e0 * MT + p0] = m; LIST[e1 * MT + p1] = m;
                    EPw[2 * m] = e0 | (int)(p0 << 3); EPw[2 * m + 1] = e1 | (int)(p1 << 3);
                    GW[2 * m] = g0; GW[2 * m + 1] = g1;
                }
            }
        }
    }
    if (MODE == 1) __syncthreads();
}
__device__ __forceinline__ void moe_gather(const Frame& F, int jm) {
    const unsigned* cnt = (const unsigned*)F.ws + CW_CNT + jm * 8 * 64;
    MoeTp t; load_tp(t, cnt);
    int cn[8];
#pragma unroll
    for (int e = 0; e < 8; ++e) cn[e] = __builtin_amdgcn_readfirstlane((int)__hip_atomic_load(cnt + e * 64, __ATOMIC_RELAXED, __HIP_MEMORY_SCOPE_AGENT));
    const int rows = t.tp[8] * 256;
    const int* LIST = (const int*)(F.ws + WS_LIST); const v4u* XN = (const v4u*)(F.ws + WS_ACT); v4u* XB = (v4u*)(F.ws + WS_X2);
    for (int r = F.gw; r < rows; r += F.NGW) {
        const int tile = r >> 8; int e = 0, tpe = 0, ce = cn[0];
#pragma unroll
        for (int k = 1; k < 8; ++k) { const bool ge = tile >= t.tp[k]; e += ge ? 1 : 0; tpe = ge ? t.tp[k] : tpe; ce = ge ? cn[k] : ce; }
        const int pos = r - tpe * 256;
        v4u x0 = {0u, 0u, 0u, 0u}, x1 = {0u, 0u, 0u, 0u};
        if (pos < ce) { const int src = LIST[e * MT + pos]; x0 = XN[(size_t)src * 128 + F.lane]; x1 = XN[(size_t)src * 128 + 64 + F.lane]; }
        XB[(size_t)r * 128 + F.lane] = x0; XB[(size_t)r * 128 + 64 + F.lane] = x1;
    }
}

struct MixP { const bf16* P; const float* lb; const float* rcos; const float* rsin; const float* wa2; const float* ba; };
__device__ __forceinline__ int seg_row0(int b, int sg) { return sg < 4 ? NLAT + b * CTXL + sg * 64 : b * SEQ + (sg - 4) * 64; }
__device__ __forceinline__ int seg_tpos0(int sg) { return sg < 4 ? -1 : (sg - 4) * 64; }

template <int MIX, int MODE>
__device__ __forceinline__ void mix_scan(const MixP& mp, int b, int h, int dir, int sg, int lane, float (&S)[(MIX == 2) ? 32 : 64], float& Gam,
                                         float* OF, LAS float* stg, bf16* Y, const float* nw) {
    constexpr int DK = (MIX == 2) ? 32 : 64, TB = (MODE == 0) ? 4 : 1;
    const int row0 = seg_row0(b, sg), tpos0 = seg_tpos0(sg);
    int cq, ck, cv, cgate, ycol, clow = 0; const int ocol = ((MIX == 0) ? 0 : (MIX == 1 ? 256 : 512)) + h * 64 + lane;
    if (MIX == 0) { cq = C_RQ + h * 64 + lane; ck = C_RK + h * 64 + lane; cv = C_RV + h * 64 + lane; cgate = C_RG + h * 64 + lane; ycol = h * 64 + lane; }
    else if (MIX == 1) { cq = C_HQ + h * 64 + lane; ck = (dir ? C_HFB : C_HFF) + h * 64 + lane; cv = C_HI + h * 64 + lane; cgate = C_HG + h * 64 + lane; ycol = 512 + h * 64 + lane; }
    else { cq = C_GQ + h * 32 + (lane & 31); ck = C_GK + h * 32 + (lane & 31); cv = C_GV + h * 64 + lane; cgate = C_GG + h * 64 + lane; ycol = 768 + h * 64 + lane; clow = (dir ? C_GAB : C_GAF); }
    float gamma = 1.f, lbv = 0.f, oml = 1.f, bav = 0.f, nwv = 0.f;
    float wreg[16];
#pragma unroll
    for (int r = 0; r < 16; ++r) wreg[r] = 0.f;
    if (MIX == 0) gamma = 1.0f - exp2f(-5.0f - (float)(dir ? 3 - h : h));
    if (MIX == 1) { lbv = mp.lb[h * 64 + lane]; oml = 1.0f - lbv; }
    if (MIX == 2) {
#pragma unroll
        for (int r = 0; r < 16; ++r) wreg[r] = mp.wa2[(dir * 16 + r) * 128 + h * 32 + (lane & 31)];
        bav = mp.ba[dir * 128 + h * 32 + (lane & 31)];
    }
    if (MODE == 2) nwv = nw[h * 64 + lane];
    for (int i0 = 0; i0 < 64; i0 += TB) {
        unsigned short r1[TB], r2[TB], r3[TB], r5[TB]; v4u lw0[TB], lw1[TB]; float ofv[TB];
#pragma unroll
        for (int u = 0; u < TB; ++u) { const int ti = dir ? 63 - (i0 + u) : (i0 + u); const bf16* pr = mp.P + (size_t)(row0 + ti) * DINP;
            r1[u] = (MODE != 0) ? pr[cq] : (unsigned short)0; r2[u] = pr[ck]; r3[u] = pr[cv]; r5[u] = (MODE == 2) ? pr[cgate] : (unsigned short)0; ofv[u] = (MODE == 2) ? OF[(size_t)(row0 + ti) * 768 + ocol] : 0.f;
            if (MIX == 2) { lw0[u] = *(const v4u*)(pr + clow); lw1[u] = *(const v4u*)(pr + clow + 8); } }
        float vv[TB];
        LAS float* const stw = stg + lane;
#pragma unroll
        for (int u = 0; u < TB; ++u) {
            const int ti = dir ? 63 - (i0 + u) : (i0 + u);
            float q = bf2f(r1[u]), k, g; vv[u] = bf2f(r3[u]);
            if (MIX == 0) {
                k = bf2f(r2[u]) * 0.125f; g = gamma;
                if (tpos0 >= 0) { const int tpos = tpos0 + ti; const int pos = (lane & 32) ? (tpos & 63) : (tpos >> 6);
                    const float c = mp.rcos[pos * 16 + (lane & 15)], s = mp.rsin[pos * 16 + (lane & 15)];
                    const float ss = (lane & 16) ? s : -s;
                    const float qp = __shfl_xor(q, 16), kp = __shfl_xor(k, 16);
                    q = fmaf(qp, ss, q * c); k = fmaf(kp, ss, k * c); }
            } else if (MIX == 1) {
                const float z = bf2f(r2[u]); const float sp = 1.0f / (1.0f + __expf(-z)), sn = 1.0f / (1.0f + __expf(z));
                g = fmaf(oml, sp, lbv); k = oml * sn;
            } else {
                k = bf2f(r2[u]) * 0.17677669529663687f; float z = bav;
                const unsigned lw[8] = {lw0[u].x, lw0[u].y, lw0[u].z, lw0[u].w, lw1[u].x, lw1[u].y, lw1[u].z, lw1[u].w};
#pragma unroll
                for (int r = 0; r < 8; ++r) { z = fmaf(__uint_as_float(lw[r] << 16), wreg[2 * r], z); z = fmaf(__uint_as_float(lw[r] & 0xffff0000u), wreg[2 * r + 1], z); }
                const float ls = fminf(z, 0.f) - log1pf(expf(-fabsf(z)));
                g = expf(ls * 0.0625f);
            }
            if (MODE == 0) Gam *= g;
            if (MODE != 0) stw[(u * 3 + 0) * 64] = q;
            stw[(u * 3 + 1) * 64] = k;
            if (MIX != 0) stw[(u * 3 + 2) * 64] = g;
        }
        unsigned sba = (unsigned)(size_t)stg;
#pragma unroll
        for (int u = 0; u < TB; ++u) {
            const int ti = dir ? 63 - (i0 + u) : (i0 + u);
            const float v = vv[u];
            float o = 0.f;
#pragma unroll
            for (int k4 = 0; k4 < DK / 4; ++k4) {
                const LAS float* sb = (const LAS float*)(size_t)sba;
                const f32x4 kx = *(const LAS f32x4*)(sb + (u * 3 + 1) * 64 + 4 * k4);
                f32x4 gx = {gamma, gamma, gamma, gamma}; if (MIX != 0) gx = *(const LAS f32x4*)(sb + (u * 3 + 2) * 64 + 4 * k4);
                f32x4 qx = {0.f, 0.f, 0.f, 0.f}; if (MODE != 0) qx = *(const LAS f32x4*)(sb + (u * 3 + 0) * 64 + 4 * k4);
#pragma unroll
                for (int jj = 0; jj < 4; ++jj) { const int kk = 4 * k4 + jj; S[kk] = fmaf(gx[jj], S[kk], kx[jj] * v); if (MODE != 0) o = fmaf(qx[jj], S[kk], o); }
                if ((k4 & 1) == 1) { const int b0 = 4 * k4 - 4;
                    asm volatile("" : "+v"(sba), "+v"(S[b0]), "+v"(S[b0 + 1]), "+v"(S[b0 + 2]), "+v"(S[b0 + 3]), "+v"(S[b0 + 4]), "+v"(S[b0 + 5]), "+v"(S[b0 + 6]), "+v"(S[b0 + 7])); }
            }
            if (MODE == 1) OF[(size_t)(row0 + ti) * 768 + ocol] = o;
            if (MODE == 2) {
                o += ofv[u];
                float y;
                if (MIX == 0) { const float mean = wave_sum(o) * (1.0f / 64.0f); const float d = o - mean; const float var = wave_sum(d * d) * (1.0f / 64.0f); y = d * (1.0f / sqrtf(var + NEPS)) * nwv; }
                else { const float ms = wave_sum(o * o) * (1.0f / 64.0f); y = o * (1.0f / sqrtf(ms + NEPS)) * nwv; }
                const float gt = bf2f(r5[u]); y *= silu_f(gt);
                Y[(size_t)(row0 + ti) * 1024 + ycol] = (bf16)f2bf(y);
            }
        }
    }
}

struct S5P { const float *lam_re, *lam_im, *log_dt, *b_re, *b_im, *c_re, *c_im, *dd; };
__device__ __forceinline__ float gelu_tanh(float y) { const float t = 0.7978845608028654f * (y + 0.044715f * y * y * y); const float th = 1.0f - 2.0f / (1.0f + __expf(2.0f * t)); return 0.5f * y * (1.0f + th); }
template <int MODE>
__device__ __forceinline__ void s5_scan(const S5P& sp, const bf16* P, int b, int g, int dir, int sg, int lane, float& hre, float& him, LAS float* yf, LAS float* stg, bf16* Z) {
    const int row0 = seg_row0(b, sg); const int dg = dir * 16 + g;
    const float lre = sp.lam_re[dg * 64 + lane], lim = sp.lam_im[dg * 64 + lane], dt = expf(sp.log_dt[dg]);
    const float er = expf(lre * dt); const float sn = sinf(lim * dt), cs = cosf(lim * dt);
    const float ar = er * cs, ai = er * sn;
    const float nr = ar - 1.0f, ni = ai, den = lre * lre + lim * lim;
    const float cr = (nr * lre + ni * lim) / den, ci = (ni * lre - nr * lim) / den;
    float bbr[16], bbi[16], Cr[16], Ci[16];
#pragma unroll
    for (int c = 0; c < 16; ++c) { const float Br = sp.b_re[((size_t)dg * 64 + lane) * 16 + c], Bi = sp.b_im[((size_t)dg * 64 + lane) * 16 + c];
        bbr[c] = cr * Br - ci * Bi; bbi[c] = cr * Bi + ci * Br;
        Cr[c] = (MODE != 0) ? sp.c_re[((size_t)dg * 16 + c) * 64 + lane] : 0.f; Ci[c] = (MODE != 0) ? sp.c_im[((size_t)dg * 16 + c) * 64 + lane] : 0.f; }
    const int ch = ((lane >> 5) & 1) * 8 + ((lane >> 4) & 1) * 4 + ((lane >> 3) & 1) * 2 + ((lane >> 2) & 1);
    const float dv = (MODE == 2) ? sp.dd[g * 16 + ch] : 0.f;
    const bool b5 = lane & 32, b4 = lane & 16, b3 = lane & 8, b2 = lane & 4;
    for (int i0 = 0; i0 < 64; i0 += 4) {
        unsigned short ru[4];
#pragma unroll
        for (int u = 0; u < 4; ++u) { const int ti = dir ? 63 - (i0 + u) : (i0 + u); ru[u] = P[(size_t)(row0 + ti) * DINP + C_S5 + g * 16 + (lane & 15)]; }
#pragma unroll
        for (int u = 0; u < 4; ++u) stg[u * 64 + lane] = bf2f(ru[u]);
#pragma unroll
        for (int u = 0; u < 4; ++u) {
            const int ti = dir ? 63 - (i0 + u) : (i0 + u);
            const float uf = bf2f(ru[u]);
            float bur = 0.f, bui = 0.f;
#pragma unroll
            for (int c4 = 0; c4 < 4; ++c4) { const f32x4 ux = *(const LAS f32x4*)(stg + u * 64 + 4 * c4);
#pragma unroll
                for (int jj = 0; jj < 4; ++jj) { bur = fmaf(bbr[4 * c4 + jj], ux[jj], bur); bui = fmaf(bbi[4 * c4 + jj], ux[jj], bui); } }
            const float nre = ar * hre - ai * him + bur, nim = ar * him + ai * hre + bui;
            hre = nre; him = nim;
            if (MODE != 0) {
                float v[16];
#pragma unroll
                for (int c = 0; c < 16; ++c) v[c] = Cr[c] * hre - Ci[c] * him;
                float w8[8], w4[4], w2[2], w1;
#pragma unroll
                for (int i = 0; i < 8; ++i) { const float mine = b5 ? v[8 + i] : v[i], oth = b5 ? v[i] : v[8 + i]; w8[i] = mine + __shfl_xor(oth, 32); }
#pragma unroll
                for (int i = 0; i < 4; ++i) { const float mine = b4 ? w8[4 + i] : w8[i], oth = b4 ? w8[i] : w8[4 + i]; w4[i] = mine + __shfl_xor(oth, 16); }
#pragma unroll
                for (int i = 0; i < 2; ++i) { const float mine = b3 ? w4[2 + i] : w4[i], oth = b3 ? w4[i] : w4[2 + i]; w2[i] = mine + __shfl_xor(oth, 8); }
                { const float mine = b2 ? w2[1] : w2[0], oth = b2 ? w2[0] : w2[1]; w1 = mine + __shfl_xor(oth, 4); }
                w1 += __shfl_xor(w1, 2); w1 += __shfl_xor(w1, 1);
                if (MODE == 1) { if ((lane & 3) == 0) yf[ti * 16 + ch] = w1; }
                if (MODE == 2) {
                    const float uch = __shfl(uf, ch);
                    if ((lane & 3) == 0) { const float y = w1 + yf[ti * 16 + ch] + dv * uch; Z[(size_t)(row0 + ti) * 256 + g * 16 + ch] = (bf16)f2bf(gelu_tanh(y)); }
                }
            }
        }
    }
}

__device__ __forceinline__ MixP make_mixp(const Frame& F, const Args& a, int l) {
    MixP mp; mp.P = (const bf16*)(F.ws + WS_PH); mp.lb = (const float*)(F.ws + WS_LB) + l * 256; mp.rcos = (const float*)(F.ws + WS_ROPE); mp.rsin = mp.rcos + 2048;
    mp.wa2 = a.in[F.zz + I_WA2] + (size_t)l * 2 * 16 * 128; mp.ba = a.in[F.zz + I_BA] + (size_t)l * 2 * 128; return mp;
}
__device__ __forceinline__ S5P make_s5p(const Frame& F, const Args& a, int l) {
    S5P sp; sp.lam_re = a.in[F.zz + I_LAMRE] + (size_t)l * 2048; sp.lam_im = a.in[F.zz + I_LAMIM] + (size_t)l * 2048; sp.log_dt = a.in[F.zz + I_LOGDT] + l * 32;
    sp.b_re = a.in[F.zz + I_BRE] + (size_t)l * 32768; sp.b_im = a.in[F.zz + I_BIM] + (size_t)l * 32768; sp.c_re = a.in[F.zz + I_CRE] + (size_t)l * 32768; sp.c_im = a.in[F.zz + I_CIM] + (size_t)l * 32768;
    sp.dd = a.in[F.zz + I_S5D] + l * 256; return sp;
}

template <int MIX>
__device__ __forceinline__ void mixA_unit(const MixP& mp, float* ST, int idx, int lane, LAS float* stg) {
    constexpr int DK = (MIX == 2) ? 32 : 64;
    const int dir = idx / 2112, rem = idx - dir * 2112, bh = rem / NSEG, sg = rem - bh * NSEG;
    float S[DK];
#pragma unroll
    for (int k = 0; k < DK; ++k) S[k] = 0.f;
    float Gam = 1.0f;
    mix_scan<MIX, 0>(mp, bh >> 2, bh & 3, dir, sg, lane, S, Gam, nullptr, stg, nullptr, nullptr);
    const size_t slot = (size_t)((dir * 16 + bh) * NSEG + sg);
    float* ds = ST + (MIX == 0 ? ST_DS0 : (MIX == 1 ? ST_DS1 : ST_DS2)) + slot * (DK * 64);
#pragma unroll
    for (int k = 0; k < DK; ++k) ds[k * 64 + lane] = S[k];
    float* gs = ST + (MIX == 0 ? ST_G0 : (MIX == 1 ? ST_G1 : ST_G2)) + slot * 64;
    gs[lane] = Gam;
}
template <int MSEL>
__device__ __forceinline__ void mix_passA(const Frame& F, const Args& a, int l) {
    const MixP mp = make_mixp(F, a, l); const S5P sp = make_s5p(F, a, l);
    float* ST = (float*)(F.ws + WS_X2);
    LAS float* stg = (LAS float*)(F.lds + F.wave * 4096);
    if (MSEL & 1) for (int u = F.gw; u < 4224; u += F.NGW) mixA_unit<0>(mp, ST, u, F.lane, stg);
    if (MSEL & 2) for (int u = F.gw; u < 4224; u += F.NGW) mixA_unit<1>(mp, ST, u, F.lane, stg);
    if (MSEL & 4) for (int u = F.gw; u < 4224; u += F.NGW) mixA_unit<2>(mp, ST, u, F.lane, stg);
    if (MSEL & 8) for (int idx = F.gw; idx < 2 * 64 * NSEG; idx += F.NGW) {
        const int dir = idx / (64 * NSEG), rem = idx - dir * 64 * NSEG, bg = rem / NSEG, sg = rem - bg * NSEG;
        float hre = 0.f, him = 0.f;
        s5_scan<0>(sp, mp.P, bg >> 4, bg & 15, dir, sg, F.lane, hre, him, nullptr, stg, nullptr);
        float* hs = ST + ST_HS + ((size_t)((dir * 64 + bg) * NSEG + sg) * 64 + F.lane) * 2;
        hs[0] = hre; hs[1] = him;
    }
}
__device__ __forceinline__ int chain_seg(int dir, int p) { return dir ? (p < 4 ? 3 - p : 135 - p) : p; }
__device__ __forceinline__ void mix_passB(const Frame& F, const Args& a, int l) {
    float* ST = (float*)(F.ws + WS_X2);
    constexpr int N0 = 131072, N1 = 131072, N2 = 65536, N3 = 8192;
    for (int e = blockIdx.x * 512 + F.tid; e < N0 + N1 + N2 + N3; e += F.G * 512) {
        if (e < N0 + N1 + N2) {
            float* base; const float* gb; int dir, esz;
            if (e < N0 + N1) { const int mix = e >= N0, e2 = e - mix * N0, c = e2 >> 12, el = e2 & 4095; dir = c >> 4; esz = 4096;
                base = ST + (mix ? ST_DS1 : ST_DS0) + (size_t)c * NSEG * 4096 + el; gb = ST + (mix ? ST_G1 : ST_G0) + (size_t)c * NSEG * 64 + (el >> 6); }
            else { const int e2 = e - N0 - N1, c = e2 >> 11, el = e2 & 2047; dir = c >> 4; esz = 2048;
                base = ST + ST_DS2 + (size_t)c * NSEG * 2048 + el; gb = ST + ST_G2 + (size_t)c * NSEG * 64 + (el >> 6); }
            float run = 0.f;
#pragma unroll 4
            for (int p = 0; p < NSEG; ++p) { const int sg = chain_seg(dir, p); const float d = base[(size_t)sg * esz], gm = gb[sg * 64]; base[(size_t)sg * esz] = run; run = fmaf(gm, run, d); }
        } else {
            const int e2 = e - N0 - N1 - N2, c = e2 >> 6, p = e2 & 63, dir = c >> 6, g = c & 15;
            const int dg = dir * 16 + g;
            const float lre = a.in[F.zz + I_LAMRE][(size_t)l * 2048 + dg * 64 + p], lim = a.in[F.zz + I_LAMIM][(size_t)l * 2048 + dg * 64 + p], dt = expf(a.in[F.zz + I_LOGDT][l * 32 + dg]);
            const float er = expf(lre * dt * 64.0f); const float sn = sinf(lim * dt * 64.0f), cs = cosf(lim * dt * 64.0f);
            const float ar = er * cs, ai = er * sn;
            float* base = ST + ST_HS + ((size_t)c * NSEG * 64 + p) * 2;
            float rr = 0.f, ri = 0.f;
#pragma unroll 4
            for (int q = 0; q < NSEG; ++q) { const int sg = chain_seg(dir, q); float* h = base + (size_t)sg * 128; const float dr = h[0], di = h[1]; h[0] = rr; h[1] = ri;
                const float nr = ar * rr - ai * ri + dr, ni = ar * ri + ai * rr + di; rr = nr; ri = ni; }
        }
    }
}
template <int MIX>
__device__ __forceinline__ void mixC_unit(const MixP& mp, const float* ST, int idx, int lane, float* OF, LAS float* stg, bf16* Y, const float* nw) {
    constexpr int DK = (MIX == 2) ? 32 : 64;
    const int bh = idx / NSEG, sg = idx - bh * NSEG;
    float S[DK]; float Gam = 1.0f;
    const float* dsb = ST + (MIX == 0 ? ST_DS0 : (MIX == 1 ? ST_DS1 : ST_DS2));
    { const float* ds = dsb + (size_t)((0 * 16 + bh) * NSEG + sg) * (DK * 64);
#pragma unroll
      for (int k = 0; k < DK; ++k) S[k] = ds[k * 64 + lane]; }
    mix_scan<MIX, 1>(mp, bh >> 2, bh & 3, 0, sg, lane, S, Gam, OF, stg, Y, nw);
    asm volatile("s_waitcnt vmcnt(0)" ::: "memory");
    { const float* ds = dsb + (size_t)((1 * 16 + bh) * NSEG + sg) * (DK * 64);
#pragma unroll
      for (int k = 0; k < DK; ++k) S[k] = ds[k * 64 + lane]; }
    mix_scan<MIX, 2>(mp, bh >> 2, bh & 3, 1, sg, lane, S, Gam, OF, stg, Y, nw);
}
template <int MSEL>
__device__ __forceinline__ void mix_passC(const Frame& F, const Args& a, int l) {
    const MixP mp = make_mixp(F, a, l); const S5P sp = make_s5p(F, a, l);
    const float* ST = (const float*)(F.ws + WS_X2);
    LAS float* of = (LAS float*)(F.lds + 32768 + F.wave * 4096);
    LAS float* stg = (LAS float*)(F.lds + F.wave * 4096);
    float* OF = (float*)(F.ws + WS_OF);
    bf16* Y = (bf16*)(F.ws + WS_ACT); bf16* Z = (bf16*)(F.ws + WS_Z);
    const bool keep = l < DEPTH - 1;
    constexpr int NM = 16 * NSEG;
    if (MSEL & 1) for (int u = F.gw; u < NM; u += F.NGW) { if (!keep && (u % NSEG) < 4) continue; mixC_unit<0>(mp, ST, u, F.lane, OF, stg, Y, a.in[F.zz + I_RETGN] + l * 256); }
    if (MSEL & 2) for (int u = F.gw; u < NM; u += F.NGW) { if (!keep && (u % NSEG) < 4) continue; mixC_unit<1>(mp, ST, u, F.lane, OF, stg, Y, a.in[F.zz + I_HGNW] + l * 256); }
    if (MSEL & 4) for (int u = F.gw; u < NM; u += F.NGW) { if (!keep && (u % NSEG) < 4) continue; mixC_unit<2>(mp, ST, u, F.lane, OF, stg, Y, a.in[F.zz + I_GLANW] + l * 256); }
    if (MSEL & 8) for (int idx = F.gw; idx < 64 * NSEG; idx += F.NGW) {
        const int bg = idx / NSEG, sg = idx - bg * NSEG;
        if (!keep && sg < 4) continue;
        const float* h0 = ST + ST_HS + ((size_t)((0 * 64 + bg) * NSEG + sg) * 64 + F.lane) * 2;
        float hre = h0[0], him = h0[1];
        s5_scan<1>(sp, mp.P, bg >> 4, bg & 15, 0, sg, F.lane, hre, him, of, stg, Z);
        const float* h1 = ST + ST_HS + ((size_t)((1 * 64 + bg) * NSEG + sg) * 64 + F.lane) * 2;
        hre = h1[0]; him = h1[1];
        s5_scan<2>(sp, mp.P, bg >> 4, bg & 15, 1, sg, F.lane, hre, him, of, stg, Z);
    }
}

constexpr int NPH = 11;
template <int PH_MASK, int MSEL>
__global__ void __launch_bounds__(512, 2) mk_fwd(Args a) {
    extern __shared__ __attribute__((aligned(16))) unsigned char lds_raw[];
    Frame F;
    F.lds = (LAS unsigned char*)lds_raw;
    const int wave0 = __builtin_amdgcn_readfirstlane((int)threadIdx.x >> 6);
    F.lane = (int)__builtin_amdgcn_mbcnt_hi(~0u, __builtin_amdgcn_mbcnt_lo(~0u, 0u)); F.tid = wave0 * 64 + F.lane; F.wave = wave0;
    F.G = gridDim.x; F.gw = blockIdx.x * 8 + F.wave; F.NGW = F.G * 8; F.zz = 0; F.ws = (unsigned char*)a.in[I_WS]; F.out = (float*)a.in[I_OUT];
    volatile LAS unsigned* MISC = (volatile LAS unsigned*)(F.lds + MISC_OFF);
    for (int u = F.tid; u < 64; u += 512) ((LAS unsigned*)(F.lds + 131072))[u + 80] = 0u;
    __syncthreads();
    XcdBarrier bar; bar.bar = (unsigned*)F.ws + CW_BAR; bar.x = 0; bar.st = nullptr;
    if (a.fused) bar = xcd_barrier_post((unsigned*)F.ws + CW_BAR, MISC + 8, F.tid);
#define SEAM() do { if (a.fused) { XcdBarrier bb = bar; asm volatile("" : "+s"(bb.bar), "+s"(bb.x)); xcd_barrier(bb, wave0 * 64 + (int)__builtin_amdgcn_mbcnt_hi(~0u, __builtin_amdgcn_mbcnt_lo(~0u, 0u))); } } while (0)
#define PHASE_BEGIN() do { int zz_ = 0; asm volatile("" : "+s"(zz_)); F.zz = zz_; F.ws = (unsigned char*)a.in[I_WS + zz_]; F.out = (float*)a.in[I_OUT + zz_]; \
        const int ln_ = (int)__builtin_amdgcn_mbcnt_hi(~0u, __builtin_amdgcn_mbcnt_lo(~0u, 0u)); const int t_ = wave0 * 64 + ln_ + zz_; F.tid = t_; F.lane = t_ & 63; F.wave = wave0 + zz_; F.G = (int)gridDim.x + zz_; F.gw = ((int)blockIdx.x + zz_) * 8 + F.wave; F.NGW = F.G * 8; \
        F.lds = (LAS unsigned char*)lds_raw + zz_; } while (0)
#define IN(k) (((PH_MASK >> (k)) & 1) && a.ph_lo <= (k) && (k) < a.ph_hi)
#define hb ((float*)(F.ws + WS_HB))
#define MOD ((const float*)(F.ws + WS_MOD))
#define ACT ((bf16*)(F.ws + WS_ACT))
#define PH ((bf16*)(F.ws + WS_PH))

    if (((PH_MASK >> 12) & 1) && a.do_pro) { PHASE_BEGIN(); prologue(F, a); SEAM(); }

#pragma unroll
    for (int l = 0; l < DEPTH; ++l) {
        if (l < a.l_lo || l >= a.l_hi) continue;
        const bool keep = l < DEPTH - 1, moe = l & 1; const int j = l >> 1;
        const int Mrows = keep ? MT : NLAT;
        if (IN(0)) { PHASE_BEGIN();
            norm_phase<0>(F, a, l, 0, MT, (l == 2) ? 1 : -1);
            if (l == 2) { __syncthreads(); moe_cvt(F, a, 1); }
            SEAM();
        }
        if (IN(1)) { PHASE_BEGIN();
            pg8::Gemm g{ACT, (const bf16*)(F.ws + WS_WIN) + (size_t)l * DINP * 1024, MT, DINP, 1024}; pg8::StaticOrder S; S.init(MT, DINP, F.G, (int)blockIdx.x);
            EpiStoreBf16 E{PH, DINP};
            pg8::gemm_phase<EpiStoreBf16, pg8::StaticOrder, true, false>(F.lds, g, S, E, F.tid);
            SEAM();
        }
        if (IN(2)) { PHASE_BEGIN(); mix_passA<MSEL>(F, a, l); SEAM(); }
        if (IN(3)) { PHASE_BEGIN(); mix_passB(F, a, l); SEAM(); }
        if (IN(4)) { PHASE_BEGIN(); mix_passC<MSEL>(F, a, l); SEAM(); }
        if (IN(5)) { PHASE_BEGIN();
            int k256 = 256; asm volatile("" : "+s"(k256)); pg8::Gemm g{(const bf16*)(F.ws + WS_Z), (const bf16*)(F.ws + WS_GLUW) + (size_t)l * 65536, Mrows, 256, k256}; pg8::StaticOrder S; S.init(Mrows, 256, F.G, (int)blockIdx.x);
            EpiGlu E{(const bf16*)(F.ws + WS_Z), ACT, a.in[F.zz + I_GLUB] + l * 256};
            pg8::gemm_phase<EpiGlu, pg8::StaticOrder, true, false>(F.lds, g, S, E, F.tid);
            SEAM();
        }
        if (IN(6)) { PHASE_BEGIN();
            pg8::Gemm g{ACT, (const bf16*)(F.ws + WS_WOUT) + (size_t)l * 1024 * 1024, Mrows, 1024, 1024}; pg8::StaticOrder S; S.init(Mrows, 1024, F.G, (int)blockIdx.x);
            EpiResid E{(l == 0) ? a.in[F.zz + I_X] : F.out, (l == 0) ? a.in[F.zz + I_CTX] : hb, F.out, hb, MOD + (size_t)l * 5 * 6144 + 2 * 1024};
            pg8::gemm_phase<EpiResid, pg8::StaticOrder, true, false>(F.lds, g, S, E, F.tid);
            SEAM();
        }
        if (IN(7)) { PHASE_BEGIN();
            if (moe) norm_phase<1>(F, a, l, 1, Mrows, -1); else norm_phase<0>(F, a, l, 1, Mrows, -1);
            SEAM();
        }
        if (!moe) {
            if (IN(8)) { PHASE_BEGIN();
                pg8::Gemm g{ACT, (const bf16*)(F.ws + WS_W13D) + (size_t)j * 5632 * 1024, Mrows, 5632, 1024}; pg8::StaticOrder S; S.init(Mrows, 5632, F.G, (int)blockIdx.x);
                EpiSwiglu E{PH};
                pg8::gemm_phase<EpiSwiglu, pg8::StaticOrder, true, false>(F.lds, g, S, E, F.tid);
                SEAM();
            }
            if (IN(9)) { PHASE_BEGIN();
                pg8::Gemm g{PH, (const bf16*)(F.ws + WS_W2D) + (size_t)j * 1024 * DFF, Mrows, 1024, DFF}; pg8::StaticOrder S; S.init(Mrows, 1024, F.G, (int)blockIdx.x);
                EpiResid E{F.out, hb, F.out, hb, MOD + (size_t)l * 5 * 6144 + 5 * 1024};
                pg8::gemm_phase<EpiResid, pg8::StaticOrder, true, false>(F.lds, g, S, E, F.tid);
                SEAM();
            }
        } else {
                        if (IN(8)) { PHASE_BEGIN(); moe_gather(F, j); SEAM(); }
            if (IN(9)) { PHASE_BEGIN();
                pg8::Gemm g{(const bf16*)(F.ws + WS_X2), (const bf16*)(F.ws + WS_W13M), 0, 5632, 1024}; MoeOrder S; S.init((const unsigned*)F.ws + CW_CNT + j * 8 * 64, 22, F.G, (int)blockIdx.x);
                EpiSwiglu E{PH};
                pg8::gemm_phase<EpiSwiglu, MoeOrder, true, false>(F.lds, g, S, E, F.tid);
                SEAM();
            }
            if (IN(10)) { PHASE_BEGIN();
                pg8::Gemm g{PH, (const bf16*)(F.ws + WS_W2M), 0, 1024, DFF}; MoeOrder S; S.init((const unsigned*)F.ws + CW_CNT + j * 8 * 64, 4, F.G, (int)blockIdx.x);
                EpiStoreBf16 E{(bf16*)(F.ws + WS_X2), 1024};
                pg8::gemm_phase<EpiStoreBf16, MoeOrder, true, false>(F.lds, g, S, E, F.tid);
                SEAM();
            }
        }
    }
    if (((PH_MASK >> 13) & 1) && a.do_fin) { PHASE_BEGIN(); norm_phase<2>(F, a, DEPTH - 1, 0, NLAT, DEPTH - 1); }
#undef SEAM
#undef IN
#undef hb
#undef MOD
#undef ACT
#undef PH
}

#ifndef MK_FUSED
#define MK_FUSED 1
#endif
template <int PM, int MS> static void launch_one(const Args& a, int grid, hipStream_t stream) {
    static bool attr_done = false;
    if (!attr_done) { (void)hipFuncSetAttribute((const void*)mk_fwd<PM, MS>, hipFuncAttributeMaxDynamicSharedMemorySize, LDS_BYTES); attr_done = true; }
    hipLaunchKernelGGL((mk_fwd<PM, MS>), dim3(grid), dim3(512), LDS_BYTES, stream, a);
}
extern "C" void kernel_launch(void* const* d_in, const int* in_sizes, int n_in, void* d_out, int out_size, void* d_ws, size_t ws_size, hipStream_t stream) {
    static int grid = 0;
    if (grid == 0) {
        if (n_in != 35 || in_sizes[0] != NLAT * DM || out_size != NLAT * DM || ws_size < WS_END) {
            fprintf(stderr, "kernel_launch: unexpected shapes / workspace (n_in %d, ws %zu, need %zu); nothing launched\n", n_in, ws_size, (size_t)WS_END); grid = -1; return; }
        int dev = 0, cus = 0;
        if (hipGetDevice(&dev) != hipSuccess || hipDeviceGetAttribute(&cus, hipDeviceAttributeMultiprocessorCount, dev) != hipSuccess) { grid = -1; return; }
        grid = cus;
    }
    if (grid < 0) return;
    (void)hipMemsetAsync((char*)d_ws + WS_CTL, 0, CTL_ZERO_BYTES, stream);
    Args a{};
    for (int i = 0; i < 35; ++i) a.in[i] = (const float*)d_in[i];
    a.in[I_OUT] = (const float*)d_out; a.in[I_WS] = (const float*)d_ws; a.pad = 0;
#if MK_FUSED
    a.l_lo = 0; a.l_hi = DEPTH; a.ph_lo = 0; a.ph_hi = NPH; a.do_pro = 1; a.do_fin = 1; a.fused = 1;
    launch_one<0xFFFF, 15>(a, grid, stream);
#else
    a.fused = 0;
    a.l_lo = 0; a.l_hi = 0; a.ph_lo = 0; a.ph_hi = 0; a.do_pro = 1; a.do_fin = 0;
    launch_one<0x1000, 15>(a, grid, stream);
    a.do_pro = 0;
    for (int l = 0; l < DEPTH; ++l) {
        a.l_lo = l; a.l_hi = l + 1; a.ph_lo = 0; a.ph_hi = NPH;
        launch_one<0x1, 15>(a, grid, stream); launch_one<0x2, 15>(a, grid, stream); launch_one<0x4, 15>(a, grid, stream); launch_one<0x8, 15>(a, grid, stream);
        launch_one<0x10, 1>(a, grid, stream); launch_one<0x10, 2>(a, grid, stream); launch_one<0x10, 4>(a, grid, stream); launch_one<0x10, 8>(a, grid, stream);
        launch_one<0x20, 15>(a, grid, stream); launch_one<0x40, 15>(a, grid, stream); launch_one<0x80, 15>(a, grid, stream);
        launch_one<0x100, 15>(a, grid, stream); launch_one<0x200, 15>(a, grid, stream);
        if (l & 1) launch_one<0x400, 15>(a, grid, stream);
    }
    a.l_lo = 0; a.l_hi = 0; a.ph_lo = 0; a.ph_hi = 0; a.do_fin = 1;
    launch_one<0x2000, 15>(a, grid, stream);
#endif
}
```

```cpp
#include <hip/hip_runtime.h>
#include <cstdio>
#include <cstdint>
#define LAS __attribute__((address_space(3)))
namespace pg8 {
#define PG8_LAS __attribute__((address_space(3)))
typedef unsigned short bf16_t;
typedef short bf16x8 __attribute__((ext_vector_type(8)));
typedef float f32x4 __attribute__((ext_vector_type(4)));
typedef unsigned u32x4 __attribute__((ext_vector_type(4)));
constexpr int BM = 256, BK = 64, HALF = 128, HTB = HALF * BK * 2  , STAGE_BYTES = 8 * HTB, NXCD = 8, WGM = 8;

__host__ __device__ __forceinline__ int lds_byte(int r, int c) { const int st = (r >> 4) * 2 + (c >> 5), rr = r & 15, cc = c & 31, ob = rr * 64 + cc * 2; return st * 1024 + (ob ^ (((ob >> 9) & 1) << 5)); }
__host__ __device__ __forceinline__ void stage_rc(int b, int& R, int& C) { const int st = b / 1024, sb = b % 1024, swz = sb ^ (((sb >> 9) & 1) << 5); R = (st >> 1) * 16 + swz / 64; C = (st & 1) * 32 + (swz % 64) / 2; }
__host__ __device__ __forceinline__ int perm32(int rho) { const int n = rho >> 4, i = rho & 15; return 8 * (i >> 2) + 4 * n + (i & 3); }

struct Unit { int pm, pn, pc; };
struct Gemm { const bf16_t* A; const bf16_t* Bt; int M, N, K; };

struct StaticOrder {
    int nM, nN, nwg, G, c;
    __host__ __device__ void init(int M, int N, int G_, int c_) { nM = M / BM; nN = N / BM; nwg = nM * nN; G = G_; c = c_; }
    __host__ __device__ bool next(int i, Unit& u) const {
        const long L = (long)i * G + c; if (L >= nwg) return false;
        int wgid = (int)L; { const int q = nwg / NXCD, r = nwg % NXCD, xcd = wgid % NXCD, off = wgid / NXCD; wgid = (xcd < r ? xcd * (q + 1) : r * (q + 1) + (xcd - r) * q) + off; }
        const int nig = WGM * nN, gid = wgid / nig, fm = gid * WGM, gsz = (nM - fm) < WGM ? (nM - fm) : WGM;
        u.pm = fm + ((wgid % nig) % gsz); u.pn = (wgid % nig) / gsz; u.pc = u.pn; return true;
    }
    __device__ __forceinline__ void a_ready(const Unit&) const {}
    __device__ __forceinline__ void done(const Unit&) const {}
};

__device__ __forceinline__ unsigned cvt_pk_bf16(float lo, float hi) { unsigned r; asm volatile("v_cvt_pk_bf16_f32 %0, %1, %2" : "=v"(r) : "v"(lo), "v"(hi)); return r; }
typedef float f32x2 __attribute__((ext_vector_type(2)));

template <class Epi, class Sched, bool ALIGN_EPI = false, bool SP2 = false>
__device__ __forceinline__ void gemm_phase(PG8_LAS unsigned char* lds, const Gemm g, const Sched& S, const Epi& E, const int tid) {
    const int wid = __builtin_amdgcn_readfirstlane(tid >> 6), lane = tid & 63, wr = wid >> 2, wc = wid & 3, fr = lane & 15, fq = lane >> 4;
    const int K = g.K, nt = K / BK;
    unsigned voffA[2], voffB[2];
#pragma unroll
    for (int i = 0; i < 2; ++i) { int R, C; stage_rc(tid * 16 + i * 8192, R, C); const int Rb = Epi::PERM ? ((R & ~31) + perm32(R & 31)) : R;
        voffA[i] = (unsigned)(R * K + C) * 2u; voffB[i] = (unsigned)(Rb * K + C) * 2u; }
    const size_t kstep = (size_t)(BK * 2);
    const size_t hstep = (size_t)HALF * K * 2;
    const size_t tstep = 2 * hstep;
    const unsigned ldsw = (unsigned)wid * 1024u;
    const int aoff = lds_byte(wr * 64 + fr, fq * 8), boff = lds_byte(wc * 32 + fr, fq * 8);
#define PG8_SA(b, h) (((b) * 2 + (h)) * HTB)
#define PG8_SB(b, h) ((4 + (b) * 2 + (h)) * HTB)
#define PG8_STAGE(bufoff, gbase, voff) do { _Pragma("unroll") for (int _i = 0; _i < 2; ++_i) \
        __builtin_amdgcn_global_load_lds((const unsigned*)((const char*)(gbase) + (voff)[_i]), (PG8_LAS unsigned*)(lds + (bufoff) + ldsw + _i * 8192), 16, 0, 0); } while (0)
#define PG8_LDA(dst, b, h) do { _Pragma("unroll") for (int m = 0; m < 4; ++m) _Pragma("unroll") for (int k = 0; k < 2; ++k) dst[m][k] = *(const PG8_LAS bf16x8*)(lds + PG8_SA(b, h) + aoff + m * 2048 + k * 1024); } while (0)
#define PG8_LDB(dst, b, h) do { _Pragma("unroll") for (int n = 0; n < 2; ++n) _Pragma("unroll") for (int k = 0; k < 2; ++k) dst[n][k] = *(const PG8_LAS bf16x8*)(lds + PG8_SB(b, h) + boff + n * 2048 + k * 1024); } while (0)
#define PG8_MMA(ai, bj, At, Bt) do { __builtin_amdgcn_s_setprio(1); _Pragma("unroll") for (int m = 0; m < 4; ++m) _Pragma("unroll") for (int n = 0; n < 2; ++n) _Pragma("unroll") for (int k = 0; k < 2; ++k) \
        acc[ai][bj][m][n] = __builtin_amdgcn_mfma_f32_16x16x32_bf16(Bt[n][k], At[m][k], acc[ai][bj][m][n], 0, 0, 0); __builtin_amdgcn_s_setprio(0); } while (0)
#define PG8_WAIT_V(n) asm volatile("s_waitcnt vmcnt(" #n ")" ::: "memory")
#define PG8_WAIT_L(n) asm volatile("s_waitcnt lgkmcnt(" #n ")" ::: "memory")
#define PG8_BAR __builtin_amdgcn_s_barrier()
#define PG8_SCHED __builtin_amdgcn_sched_barrier(0)
    Unit cur, nxt; int ui = 0;
    if (!S.next(0, cur)) return;
    f32x4 acc[2][2][4][2];
#pragma unroll
    for (int a = 0; a < 2; ++a)
#pragma unroll
        for (int b = 0; b < 2; ++b)
#pragma unroll
            for (int m = 0; m < 4; ++m)
#pragma unroll
                for (int n = 0; n < 2; ++n) acc[a][b][m][n] = (f32x4){0.f, 0.f, 0.f, 0.f};
    bf16x8 At[4][2], B0[2][2], B1[2][2];
    const char* cA = (const char*)g.A + (size_t)cur.pm * tstep; const char* cB = (const char*)g.Bt + (size_t)cur.pn * tstep;
    S.a_ready(cur);
    if constexpr (SP2) {
        PG8_STAGE(PG8_SB(0, 0), cB, voffB); PG8_STAGE(PG8_SB(0, 1), cB + hstep, voffB); PG8_STAGE(PG8_SA(0, 0), cA, voffA); PG8_STAGE(PG8_SA(0, 1), cA + hstep, voffA);
        if (wr == 1) PG8_BAR;
        PG8_WAIT_V(2); PG8_BAR;
        PG8_STAGE(PG8_SB(1, 0), cB + kstep, voffB); PG8_STAGE(PG8_SA(1, 0), cA + kstep, voffA); PG8_STAGE(PG8_SB(1, 1), cB + hstep + kstep, voffB);
        PG8_WAIT_V(6); PG8_BAR;
    } else {
        PG8_STAGE(PG8_SB(0, 0), cB, voffB); PG8_STAGE(PG8_SA(0, 0), cA, voffA); PG8_STAGE(PG8_SB(0, 1), cB + hstep, voffB); PG8_STAGE(PG8_SA(0, 1), cA + hstep, voffA);
        if (wr == 1) PG8_BAR;
        PG8_WAIT_V(4); PG8_BAR;
        PG8_STAGE(PG8_SB(1, 0), cB + kstep, voffB); PG8_STAGE(PG8_SA(1, 0), cA + kstep, voffA); PG8_STAGE(PG8_SB(1, 1), cB + hstep + kstep, voffB);
        PG8_WAIT_V(6); PG8_BAR;
    }
    for (;;) {
        const bool has_next = S.next(ui + 1, nxt);
        const char* nA = has_next ? (const char*)g.A + (size_t)nxt.pm * tstep : cA; const char* nB = has_next ? (const char*)g.Bt + (size_t)nxt.pn * tstep : cB;
        for (int t = 0; t < nt; t += 2) {
            const bool last = (t == nt - 2);
            const char* a1 = cA + (size_t)(t + 1) * kstep;
            const char* a2 = last ? nA : cA + (size_t)(t + 2) * kstep; const char* b2 = last ? nB : cB + (size_t)(t + 2) * kstep;
            const char* a3 = a2 + kstep; const char* b3 = b2 + kstep;
            if (last && has_next) S.a_ready(nxt);
            if constexpr (SP2) {
            PG8_LDB(B0, 0, 0); PG8_LDB(B1, 0, 1); PG8_SCHED; PG8_LDA(At, 0, 0); PG8_STAGE(PG8_SA(1, 1), a1 + hstep, voffA);
            PG8_WAIT_V(8); PG8_WAIT_L(0); PG8_BAR; PG8_MMA(0, 0, At, B0); PG8_MMA(0, 1, At, B1); PG8_BAR; PG8_SCHED;
            PG8_LDA(At, 0, 1); PG8_STAGE(PG8_SB(0, 0), b2, voffB); PG8_STAGE(PG8_SB(0, 1), b2 + hstep, voffB); PG8_STAGE(PG8_SA(0, 0), a2, voffA);
            PG8_WAIT_V(8); PG8_WAIT_L(0); PG8_BAR; PG8_MMA(1, 0, At, B0); PG8_MMA(1, 1, At, B1); PG8_BAR; PG8_SCHED;
            PG8_LDB(B0, 1, 0); PG8_LDB(B1, 1, 1); PG8_SCHED; PG8_LDA(At, 1, 0); PG8_STAGE(PG8_SA(0, 1), a2 + hstep, voffA);
            PG8_WAIT_V(8); PG8_WAIT_L(0); PG8_BAR; PG8_MMA(0, 0, At, B0); PG8_MMA(0, 1, At, B1); PG8_BAR; PG8_SCHED;
            PG8_LDA(At, 1, 1); PG8_STAGE(PG8_SB(1, 0), b3, voffB); PG8_STAGE(PG8_SB(1, 1), b3 + hstep, voffB); PG8_STAGE(PG8_SA(1, 0), a3, voffA);
            PG8_WAIT_V(8); PG8_WAIT_L(0); PG8_BAR; PG8_MMA(1, 0, At, B0); PG8_MMA(1, 1, At, B1); PG8_BAR; PG8_SCHED;
            } else {
            PG8_LDB(B0, 0, 0); PG8_SCHED; PG8_LDA(At, 0, 0); PG8_STAGE(PG8_SA(1, 1), a1 + hstep, voffA);
            PG8_WAIT_L(8); PG8_BAR; PG8_WAIT_L(0); PG8_MMA(0, 0, At, B0); PG8_BAR; PG8_SCHED;
            PG8_LDB(B1, 0, 1); PG8_STAGE(PG8_SB(0, 0), b2, voffB);
            PG8_BAR; PG8_WAIT_L(0); PG8_MMA(0, 1, At, B1); PG8_BAR;
            PG8_LDA(At, 0, 1); PG8_STAGE(PG8_SA(0, 0), a2, voffA);
            PG8_BAR; PG8_WAIT_L(0); PG8_MMA(1, 0, At, B0); PG8_BAR; PG8_SCHED;
            PG8_STAGE(PG8_SB(0, 1), b2 + hstep, voffB);
            PG8_WAIT_V(6); PG8_BAR; PG8_MMA(1, 1, At, B1); PG8_BAR;
            PG8_LDB(B0, 1, 0); PG8_SCHED; PG8_LDA(At, 1, 0); PG8_STAGE(PG8_SA(0, 1), a2 + hstep, voffA);
            PG8_WAIT_L(8); PG8_BAR; PG8_WAIT_L(0); PG8_MMA(0, 0, At, B0); PG8_BAR; PG8_SCHED;
            PG8_LDB(B1, 1, 1); PG8_STAGE(PG8_SB(1, 0), b3, voffB);
            PG8_BAR; PG8_WAIT_L(0); PG8_MMA(0, 1, At, B1); PG8_BAR;
            PG8_LDA(At, 1, 1); PG8_STAGE(PG8_SA(1, 0), a3, voffA);
            PG8_BAR; PG8_WAIT_L(0); PG8_MMA(1, 0, At, B0); PG8_BAR; PG8_SCHED;
            PG8_STAGE(PG8_SB(1, 1), b3 + hstep, voffB);
            PG8_WAIT_V(6); PG8_BAR; PG8_MMA(1, 1, At, B1); PG8_BAR;
            }
        }
        if constexpr (ALIGN_EPI) { if (wr == 0) PG8_BAR; }
        if constexpr (!Epi::AFTER_DRAIN) { E(acc, cur, wr, wc, fr, fq); S.done(cur); }
        if (!has_next) break;
#pragma unroll
        for (int a = 0; a < 2; ++a)
#pragma unroll
            for (int b = 0; b < 2; ++b)
#pragma unroll
                for (int m = 0; m < 4; ++m)
#pragma unroll
                    for (int n = 0; n < 2; ++n) acc[a][b][m][n] = (f32x4){0.f, 0.f, 0.f, 0.f};
        cur = nxt; cA = nA; cB = nB; ++ui;
        if constexpr (ALIGN_EPI) { if (wr == 1) PG8_BAR; }
    }
    PG8_WAIT_V(0);
    if constexpr (!ALIGN_EPI) { if (wr == 0) PG8_BAR; }
    PG8_BAR;
    if constexpr (Epi::AFTER_DRAIN) { E.fused(acc, cur, wr, wc, fr, fq, lds, wid, lane); S.done(cur); }
#undef PG8_SA
#undef PG8_SB
#undef PG8_STAGE
#undef PG8_LDA
#undef PG8_LDB
#undef PG8_MMA
#undef PG8_WAIT_V
#undef PG8_WAIT_L
#undef PG8_BAR
#undef PG8_SCHED
}
}

#define XB_TMO      128
#define XB_XCNT(j)  (256  + 64 * (j))
#define XB_XSUB(j)  (1280 + 64 * (j))
#define XB_XGEN(j)  (2304 + 64 * (j))
#define XB_TOP      3328
#define XB_TOPGEN   3392
#define XCD_BAR_WORDS 3456
#define XB_SPIN_CAP (1u << 18)

__device__ __forceinline__ unsigned xb_ld(unsigned* p)              { return __hip_atomic_load(p, __ATOMIC_RELAXED, __HIP_MEMORY_SCOPE_AGENT); }
__device__ __forceinline__ unsigned xb_add(unsigned* p, unsigned v) { return __hip_atomic_fetch_add(p, v, __ATOMIC_RELAXED, __HIP_MEMORY_SCOPE_AGENT); }
__device__ __forceinline__ unsigned xb_xcc_id() { return (unsigned)__builtin_amdgcn_s_getreg((3 << 11) | 20) & 0xFu; }
#define XB_SPIN(cond, bar) do { unsigned _sp = 0; while (cond) { __builtin_amdgcn_s_sleep(1); \
    if ((++_sp & 255u) == 0u) { if (xb_ld(&(bar)[XB_TMO])) break; if (_sp > XB_SPIN_CAP) { atomicAdd(&(bar)[XB_TMO], 1u); break; } } } } while (0)

struct XcdBarrier {
    unsigned* bar; unsigned x;
    volatile LAS unsigned* st;
};

__device__ __forceinline__ XcdBarrier xcd_barrier_post(unsigned* bar, volatile LAS unsigned* st, const int xb_tid) {
    XcdBarrier b; b.bar = bar; b.x = xb_xcc_id(); b.st = st;
    if (xb_tid == 0) (void)xb_add(&bar[XB_XCNT(b.x)], 1u);
    return b;
}
__device__ __forceinline__ void xcd_barrier_complete(unsigned* bar, unsigned x, unsigned& nloc, unsigned& nx) {
    const unsigned G = gridDim.x * gridDim.y * gridDim.z;
    unsigned sum, cnt, mine, sp = 0u;
    for (;;) {
        sum = 0u; cnt = 0u; mine = 0u;
#pragma unroll
        for (unsigned j = 0; j < 16; ++j) { const unsigned c = xb_ld(&bar[XB_XCNT(j)]); sum += c; cnt += (c > 0u) ? 1u : 0u; mine = (j == x) ? c : mine; }
        if (sum == G) break;
        __builtin_amdgcn_s_sleep(1);
        if ((++sp & 255u) == 0u) { if (xb_ld(&bar[XB_TMO])) break; if (sp > XB_SPIN_CAP) { atomicAdd(&bar[XB_TMO], 1u); break; } }
    }
    nloc = mine > 0u ? mine : 1u; nx = cnt > 0u ? cnt : 1u;
}

__device__ __forceinline__ void xcd_barrier(const XcdBarrier& b, const int xb_tid) {
    asm volatile("s_waitcnt vmcnt(0)" ::: "memory");
    __syncthreads();
    if (xb_tid == 0) {
        unsigned* bar = b.bar;
        __builtin_amdgcn_s_waitcnt(0);
        unsigned nloc = b.st[0], nx = b.st[1];
        if (nloc == 0u) { xcd_barrier_complete(bar, b.x, nloc, nx); b.st[0] = nloc; b.st[1] = nx; }
        const unsigned old = xb_add(&bar[XB_XSUB(b.x)], 1u);
        const unsigned gen = old / nloc;
        if (old + 1u == (gen + 1u) * nloc) {
            __builtin_amdgcn_fence(__ATOMIC_RELEASE, "agent");
            asm volatile("s_waitcnt vmcnt(0)" ::: "memory");
            const unsigned og = xb_add(&bar[XB_TOP], 1u);
            const unsigned tg = og / nx;
            if (og + 1u == (tg + 1u) * nx) xb_add(&bar[XB_TOPGEN], 1u);
            else XB_SPIN(xb_ld(&bar[XB_TOPGEN]) == tg, bar);
            __builtin_amdgcn_fence(__ATOMIC_ACQUIRE, "agent");
            xb_add(&bar[XB_XGEN(b.x)], 1u);
            asm volatile("s_waitcnt vmcnt(0)" ::: "memory");
        } else {
            XB_SPIN(xb_ld(&bar[XB_XGEN(b.x)]) == gen, bar);
            __builtin_amdgcn_fence(__ATOMIC_ACQUIRE, "agent");
            asm volatile("s_waitcnt vmcnt(0)" ::: "memory");
        }
    }
    __syncthreads();
}

#define GAS __attribute__((address_space(1)))
typedef unsigned short bf16;
typedef unsigned v4u __attribute__((ext_vector_type(4)));
typedef unsigned v2u __attribute__((ext_vector_type(2)));
typedef float f32x4 __attribute__((ext_vector_type(4)));

constexpr int NB = 4, SEQ = 8192, DM = 1024, DEPTH = 4, CTXL = 256;
constexpr int NLAT = NB * SEQ, NCTX = NB * CTXL, MT = NLAT + NCTX;
constexpr int DIN = 3360, DINP = 3584, DFF = 2816, NEXP = 8;
constexpr int C_RQ = 0, C_RK = 256, C_RV = 512, C_RG = 768, C_S5 = 1024, C_HQ = 1280, C_HFF = 1536, C_HFB = 1792, C_HI = 2048, C_HG = 2304,
              C_GQ = 2560, C_GK = 2688, C_GV = 2816, C_GG = 3072, C_GAF = 3328, C_GAB = 3344,
              C_GZF = 3328, C_GZB = 3456;
constexpr int NSEG = 132;
constexpr int MOE_CAP_TILES = 272;
constexpr float NEPS = 1e-6f;

constexpr size_t MiB = 1u << 20;
constexpr size_t WS_CTL = 0, CTL_ZERO_BYTES = 2 * MiB;
constexpr size_t WS_MOD = 2 * MiB;
constexpr size_t WS_LB = 3 * MiB;
constexpr size_t WS_ROPE = 3 * MiB + 65536;
constexpr size_t WS_GLUW = 3 * MiB + 131072;
constexpr size_t WS_WIN = 4 * MiB;
constexpr size_t WS_WOUT = 32 * MiB;
constexpr size_t WS_W13D = 40 * MiB;
constexpr size_t WS_W2D = 62 * MiB;
constexpr size_t WS_W13M = 73 * MiB;
constexpr size_t WS_W2M = 161 * MiB;
constexpr size_t WS_HB = 205 * MiB;
constexpr size_t WS_ACT = 209 * MiB;
constexpr size_t WS_Z = 275 * MiB;
constexpr size_t WS_PH = 292 * MiB;
constexpr size_t WS_OF = (292 + 232) * MiB;
constexpr size_t WS_X2 = 666 * MiB;
constexpr size_t WS_LIST = 843 * MiB;
constexpr size_t WS_END = 846 * MiB;
constexpr size_t ST_DS0 = 0;
constexpr size_t ST_DS1 = ST_DS0 + (size_t)2 * 16 * NSEG * 4096;
constexpr size_t ST_DS2 = ST_DS1 + (size_t)2 * 16 * NSEG * 4096;
constexpr size_t ST_G0 = ST_DS2 + (size_t)2 * 16 * NSEG * 2048;
constexpr size_t ST_G1 = ST_G0 + (size_t)2 * 16 * NSEG * 64;
constexpr size_t ST_G2 = ST_G1 + (size_t)2 * 16 * NSEG * 64;
constexpr size_t ST_HS = ST_G2 + (size_t)2 * 16 * NSEG * 64;
constexpr size_t ST_END = ST_HS + (size_t)2 * 64 * NSEG * 128;
static_assert(ST_END * 4 <= (WS_LIST - WS_X2), "state region");
static_assert(WS_PH + (size_t)MT * DINP * 2 <= WS_OF && WS_OF + (size_t)MT * 768 * 4 <= WS_X2, "OF region");
static_assert((size_t)MOE_CAP_TILES * 256 * 1024 * 2 <= (WS_LIST - WS_X2), "XB region");
static_assert((size_t)MOE_CAP_TILES * 256 * DFF * 2 <= (WS_X2 - WS_PH) && (size_t)MT * DINP * 2 <= (WS_X2 - WS_PH), "P/H region");
constexpr int CW_BAR = 4096;
constexpr int CW_CNT = 16384;

constexpr int LDS_BYTES = 163840;
constexpr int MISC_OFF = 163840 - 512;

__device__ __forceinline__ float bf2f(unsigned short h) { return __uint_as_float(((unsigned)h) << 16); }
__device__ __forceinline__ unsigned f2bf(float f) { unsigned u = __float_as_uint(f); return (u + 0x7fffu + ((u >> 16) & 1u)) >> 16; }
__device__ __forceinline__ unsigned pk2(float lo, float hi) { return f2bf(lo) | (f2bf(hi) << 16); }
__device__ __forceinline__ float wave_sum(float v) {
#pragma unroll
    for (int o = 1; o < 64; o <<= 1) v += __shfl_xor(v, o);
    return v;
}
__device__ __forceinline__ float rdl(float v, int k) { return __uint_as_float((unsigned)__builtin_amdgcn_readlane((int)__float_as_uint(v), k)); }
__device__ __forceinline__ float sigm(float x) { return 1.0f / (1.0f + __expf(-x)); }
__device__ __forceinline__ float silu_f(float x) { return x / (1.0f + __expf(-x)); }
#define LDS_WAIT() asm volatile("s_waitcnt lgkmcnt(0)" ::: "memory")

struct Args {
    const float* in[37];
    int l_lo, l_hi, ph_lo, ph_hi, do_pro, do_fin, fused, pad;
};
constexpr int I_OUT = 35, I_WS = 36;
enum { I_X = 0, I_C, I_CTX, I_CCTX, I_ADAW, I_ADAB, I_N1W, I_N2W, I_WIN, I_WOUT, I_RETGN, I_LAMRE, I_LAMIM, I_LOGDT, I_BRE, I_BIM, I_CRE, I_CIM, I_S5D,
       I_GLUW, I_GLUB, I_LBL, I_HGNW, I_WA2, I_BA, I_GLANW, I_FW1, I_FW3, I_FW2, I_RW, I_RB, I_MW1, I_MW3, I_MW2, I_FINW };

struct Frame {
    LAS unsigned char* lds;
    int tid, lane, wave, gw, NGW, G, zz;
    unsigned char* ws; float* out;
};

struct EpiStoreBf16 {
    static constexpr bool PERM = true, AFTER_DRAIN = false;
    bf16* O; int ldc;
    __device__ __forceinline__ void operator()(const pg8::f32x4 (&acc)[2][2][4][2], const pg8::Unit& u, int wr, int wc, int fr, int fq) const {
        const int row0 = u.pm * 256 + wr * 64 + fr, col0 = u.pc * 256 + wc * 32 + 8 * fq;
#pragma unroll
        for (int ai = 0; ai < 2; ++ai)
#pragma unroll
            for (int m = 0; m < 4; ++m) { bf16* rowp = O + (size_t)(row0 + ai * 128 + m * 16) * ldc + col0;
#pragma unroll
                for (int bj = 0; bj < 2; ++bj) { const pg8::f32x4 v0 = acc[ai][bj][m][0], v1 = acc[ai][bj][m][1];
                    pg8::u32x4 w; w.x = pg8::cvt_pk_bf16(v0[0], v0[1]); w.y = pg8::cvt_pk_bf16(v0[2], v0[3]); w.z = pg8::cvt_pk_bf16(v1[0], v1[1]); w.w = pg8::cvt_pk_bf16(v1[2], v1[3]);
                    *(pg8::u32x4*)(rowp + bj * 128) = w; } }
    }
};
struct EpiSwiglu {
    static constexpr bool PERM = true, AFTER_DRAIN = false;
    bf16* H;
    __device__ __forceinline__ void operator()(const pg8::f32x4 (&acc)[2][2][4][2], const pg8::Unit& u, int wr, int wc, int fr, int fq) const {
        const int row0 = u.pm * 256 + wr * 64 + fr, col0 = u.pc * 128 + wc * 32 + 8 * fq;
#pragma unroll
        for (int ai = 0; ai < 2; ++ai)
#pragma unroll
            for (int m = 0; m < 4; ++m) { bf16* rowp = H + (size_t)(row0 + ai * 128 + m * 16) * DFF + col0;
                float h[8];
#pragma unroll
                for (int n = 0; n < 2; ++n)
#pragma unroll
                    for (int j = 0; j < 4; ++j) { const float a = acc[ai][0][m][n][j], b = acc[ai][1][m][n][j];
                        h[n * 4 + j] = a * __builtin_amdgcn_rcpf(1.0f + __builtin_amdgcn_exp2f(-1.4426950408889634f * a)) * b; }
                pg8::u32x4 w; w.x = pg8::cvt_pk_bf16(h[0], h[1]); w.y = pg8::cvt_pk_bf16(h[2], h[3]); w.z = pg8::cvt_pk_bf16(h[4], h[5]); w.w = pg8::cvt_pk_bf16(h[6], h[7]);
                *(pg8::u32x4*)rowp = w; }
    }
};
struct EpiResid {
    static constexpr bool PERM = false, AFTER_DRAIN = false;
    const float* xin_lat; const float* xin_ctx; float* xout_lat; float* xout_ctx; const float* gate;
    __device__ __forceinline__ void operator()(const pg8::f32x4 (&acc)[2][2][4][2], const pg8::Unit& u, int wr, int wc, int fr, int fq) const {
        const bool isctx = u.pm >= 128; const int bidx = isctx ? 4 : (u.pm >> 5);
        const size_t rbase = (size_t)(isctx ? (u.pm - 128) : u.pm) * 256 + wr * 64 + fr;
        const float* xi = (isctx ? xin_ctx : xin_lat); float* xo = (isctx ? xout_ctx : xout_lat);
        const int col0 = u.pc * 256 + wc * 32 + 4 * fq; const float* g = gate + (size_t)bidx * 6144 + col0;
        pg8::f32x4 gv[2][2];
#pragma unroll
        for (int bj = 0; bj < 2; ++bj)
#pragma unroll
            for (int n = 0; n < 2; ++n) gv[bj][n] = *(const pg8::f32x4*)(g + bj * 128 + n * 16);
#pragma unroll
        for (int ai = 0; ai < 2; ++ai)
#pragma unroll
            for (int m = 0; m < 4; ++m) { const size_t off = (rbase + ai * 128 + m * 16) * 1024 + col0;
#pragma unroll
                for (int bj = 0; bj < 2; ++bj)
#pragma unroll
                    for (int n = 0; n < 2; ++n) { const pg8::f32x4 xv = *(const pg8::f32x4*)(xi + off + bj * 128 + n * 16);
                        *(pg8::f32x4*)(xo + off + bj * 128 + n * 16) = xv + gv[bj][n] * acc[ai][bj][m][n]; }
                asm volatile("" ::: "memory"); }
    }
};
struct EpiGlu {
    static constexpr bool PERM = true, AFTER_DRAIN = false;
    const bf16* Z; bf16* Y; const float* bias;
    __device__ __forceinline__ void operator()(const pg8::f32x4 (&acc)[2][2][4][2], const pg8::Unit& u, int wr, int wc, int fr, int fq) const {
        const int row0 = u.pm * 256 + wr * 64 + fr, col0 = wc * 32 + 8 * fq;
#pragma unroll
        for (int ai = 0; ai < 2; ++ai)
#pragma unroll
            for (int m = 0; m < 4; ++m) { const size_t row = (size_t)(row0 + ai * 128 + m * 16);
#pragma unroll
                for (int bj = 0; bj < 2; ++bj) { const int col = col0 + bj * 128;
                    const pg8::u32x4 zz = *(const pg8::u32x4*)(Z + row * 256 + col);
                    const pg8::f32x4 b0 = *(const pg8::f32x4*)(bias + col), b1 = *(const pg8::f32x4*)(bias + col + 4);
                    const pg8::f32x4 v0 = acc[ai][bj][m][0] + b0, v1 = acc[ai][bj][m][1] + b1;
                    float o[8]; const unsigned zw[4] = {zz.x, zz.y, zz.z, zz.w};
#pragma unroll
                    for (int j = 0; j < 4; ++j) { const float zl = __uint_as_float(zw[j] << 16), zh = __uint_as_float(zw[j] & 0xffff0000u);
                        const float a0 = (j < 2) ? v0[2 * j] : v1[2 * j - 4], a1 = (j < 2) ? v0[2 * j + 1] : v1[2 * j - 3];
                        o[2 * j] = zl * sigm(a0); o[2 * j + 1] = zh * sigm(a1); }
                    pg8::u32x4 w; w.x = pg8::cvt_pk_bf16(o[0], o[1]); w.y = pg8::cvt_pk_bf16(o[2], o[3]); w.z = pg8::cvt_pk_bf16(o[4], o[5]); w.w = pg8::cvt_pk_bf16(o[6], o[7]);
                    *(pg8::u32x4*)(Y + row * 1024 + 256 + col) = w; }
                asm volatile("" ::: "memory"); }
    }
};
struct MoeOrder {
    int tp[9]; int nN, G, c, total;
    __device__ __forceinline__ void init(const unsigned* cnt, int nN_, int G_, int c_) {
        tp[0] = 0;
#pragma unroll
        for (int e = 0; e < 8; ++e) tp[e + 1] = tp[e] + (int)(((unsigned)__builtin_amdgcn_readfirstlane((int)__hip_atomic_load(cnt + e * 64, __ATOMIC_RELAXED, __HIP_MEMORY_SCOPE_AGENT)) + 255u) >> 8);
        nN = nN_; G = G_; c = c_; total = tp[8] * nN;
    }
    __device__ __forceinline__ bool next(int i, pg8::Unit& u) const {
        const int L = i * G + c; if (L >= total) return false;
        const int t = L / nN, pn = L - t * nN; int e = 0;
#pragma unroll
        for (int k = 1; k < 8; ++k) e += (t >= tp[k]) ? 1 : 0;
        u.pm = t; u.pn = e * nN + pn; u.pc = pn; return true;
    }
    __device__ __forceinline__ void a_ready(const pg8::Unit&) const {}
    __device__ __forceinline__ void done(const pg8::Unit&) const {}
};

__device__ __forceinline__ void cvt_item(const float* W, int K, int N, bf16* WT, int mode, int add, LAS float* scr, int item, int lane, int nblk_override = 0) {
    const int nblk = nblk_override ? nblk_override : (N >> 5), kb = item / nblk, nb = item - kb * nblk, k0 = 64 * kb, n0 = 32 * nb;
    const int r = lane >> 3, c4 = lane & 7;
    f32x4 v[8];
#pragma unroll
    for (int i = 0; i < 8; ++i) v[i] = *(const f32x4*)(W + (size_t)(k0 + 8 * i + r) * N + n0 + 4 * c4);
#pragma unroll
    for (int i = 0; i < 8; ++i) {
#pragma unroll
        for (int j = 0; j < 4; ++j) scr[(8 * i + r) * 33 + 4 * c4 + j] = v[i][j]; }
    LDS_WAIT();
    const int c = lane & 7;
#pragma unroll
    for (int j = 0; j < 4; ++j) { const int n = (lane >> 3) + 8 * j; const LAS float* s = scr + (8 * c) * 33 + n;
        v4u o; o.x = pk2(s[0 * 33], s[1 * 33]); o.y = pk2(s[2 * 33], s[3 * 33]); o.z = pk2(s[4 * 33], s[5 * 33]); o.w = pk2(s[6 * 33], s[7 * 33]);
        const int nn = n0 + n; const int drow = (mode == 0) ? (nn + add) : (((nn >> 7) << 8) + (nn & 127) + add);
        *(v4u*)(WT + (size_t)drow * K + k0 + 8 * c) = o; }
    LDS_WAIT();
}
__device__ __forceinline__ void moe_cvt(const Frame& F, const Args& a, int j) {
    LAS float* scr = (LAS float*)(F.lds + F.wave * 16384);
    constexpr int IT = 1408;
    for (int it = F.gw; it < 8 * 3 * IT; it += F.NGW) {
        const int e = it / (3 * IT), r = it - e * 3 * IT, which = r / IT, item = r - which * IT;
        const size_t eo = ((size_t)j * 8 + e) * (size_t)(1024 * DFF);
        if (which == 0) cvt_item(a.in[F.zz + I_MW1] + eo, 1024, DFF, (bf16*)(F.ws + WS_W13M) + (size_t)e * 5632 * 1024, 1, 0, scr, item, F.lane);
        else if (which == 1) cvt_item(a.in[F.zz + I_MW3] + eo, 1024, DFF, (bf16*)(F.ws + WS_W13M) + (size_t)e * 5632 * 1024, 1, 128, scr, item, F.lane);
        else cvt_item(a.in[F.zz + I_MW2] + eo, DFF, 1024, (bf16*)(F.ws + WS_W2M) + (size_t)e * 1024 * DFF, 0, 0, scr, item, F.lane);
    }
}
__device__ __forceinline__ void prologue(const Frame& F, const Args& a) {
    {
        LAS float* sc = (LAS float*)F.lds; LAS float* red = sc + 5120;
        for (int idx = F.tid; idx < 5120; idx += 512) { const int r = idx >> 10, k = idx & 1023; const float cv = (r < 4) ? a.in[F.zz + I_C][r * 1024 + k] : a.in[F.zz + I_CCTX][k]; sc[idx] = silu_f(cv); }
        __syncthreads();
        float* MOD = (float*)(F.ws + WS_MOD);
        for (int item = blockIdx.x; item < 384; item += F.G) {
            const int l = item / 96, nb = item - l * 96, cl = F.tid & 63, ks = F.tid >> 6, n = nb * 64 + cl;
            float acc[5] = {0.f, 0.f, 0.f, 0.f, 0.f};
            const float* wp = a.in[F.zz + I_ADAW] + ((size_t)l * 1024 + ks * 128) * 6144 + n;
#pragma unroll 16
            for (int kk = 0; kk < 128; ++kk) { const float w = wp[(size_t)kk * 6144];
#pragma unroll
                for (int r = 0; r < 5; ++r) acc[r] = fmaf(sc[r * 1024 + ks * 128 + kk], w, acc[r]); }
#pragma unroll
            for (int r = 0; r < 5; ++r) red[(ks * 5 + r) * 64 + cl] = acc[r];
            __syncthreads();
            if (F.tid < 320) { const int r = F.tid >> 6; float s = 0.f;
#pragma unroll
                for (int k2 = 0; k2 < 8; ++k2) s += red[(k2 * 5 + r) * 64 + cl];
                MOD[((size_t)l * 5 + r) * 6144 + n] = s + a.in[F.zz + I_ADAB][l * 6144 + n]; }
            __syncthreads();
        }
        if (blockIdx.x == 0 && F.tid < 256) {
            const float* lg = a.in[F.zz + I_LBL]; float x[4], mx = -3.0e38f;
#pragma unroll
            for (int l = 0; l < 4; ++l) { x[l] = lg[l * 256 + F.tid]; mx = fmaxf(mx, x[l]); }
            float s = 0.f;
#pragma unroll
            for (int l = 0; l < 4; ++l) { x[l] = expf(x[l] - mx); s += x[l]; }
            float cs = 0.f; const float sm0 = x[0] / s; float* LB = (float*)(F.ws + WS_LB);
#pragma unroll
            for (int l = 0; l < 4; ++l) { cs += x[l] / s; LB[l * 256 + F.tid] = fminf(fmaxf(cs - sm0, 0.f), 1.0f - 1e-6f); }
        }
        if (blockIdx.x == (1 % F.G)) {
            float* RC = (float*)(F.ws + WS_ROPE); float* RS = RC + 2048;
            for (int idx = F.tid; idx < 2048; idx += 512) { const int pos = idx >> 4, i = idx & 15;
                const float fr = powf(10000.0f, -(float)i / 16.0f); const float ang = (float)pos * fr; RC[idx] = cosf(ang); RS[idx] = sinf(ang); }
        }
        __syncthreads();
    }
    LAS float* scr = (LAS float*)(F.lds + F.wave * 16384);
    constexpr int I_IN = 16 * 104, I_OUT = 16 * 32, I_F = 1408, I_GL = 4 * 8;
    constexpr int NIT = 4 * I_IN + 4 * I_OUT + 6 * I_F + 4 * I_GL;
    for (int it = F.gw; it < NIT; it += F.NGW) {
        int r = it;
        if (r < 4 * I_IN) { const int l = r / I_IN; cvt_item(a.in[F.zz + I_WIN] + (size_t)l * 1024 * DIN, 1024, DIN, (bf16*)(F.ws + WS_WIN) + (size_t)l * DINP * 1024, 0, 0, scr, r - l * I_IN, F.lane, 104); continue; } r -= 4 * I_IN;
        if (r < 4 * I_OUT) { const int l = r / I_OUT; cvt_item(a.in[F.zz + I_WOUT] + (size_t)l * 1024 * 1024, 1024, 1024, (bf16*)(F.ws + WS_WOUT) + (size_t)l * 1024 * 1024, 0, 0, scr, r - l * I_OUT, F.lane); continue; } r -= 4 * I_OUT;
        if (r < 6 * I_F) { const int j = r / (3 * I_F), r2 = r - j * 3 * I_F, which = r2 / I_F, item = r2 - which * I_F; const size_t wo = (size_t)j * 1024 * DFF;
            if (which == 0) cvt_item(a.in[F.zz + I_FW1] + wo, 1024, DFF, (bf16*)(F.ws + WS_W13D) + (size_t)j * 5632 * 1024, 1, 0, scr, item, F.lane);
            else if (which == 1) cvt_item(a.in[F.zz + I_FW3] + wo, 1024, DFF, (bf16*)(F.ws + WS_W13D) + (size_t)j * 5632 * 1024, 1, 128, scr, item, F.lane);
            else cvt_item(a.in[F.zz + I_FW2] + wo, DFF, 1024, (bf16*)(F.ws + WS_W2D) + (size_t)j * 1024 * DFF, 0, 0, scr, item, F.lane);
            continue; } r -= 6 * I_F;
        { const int l = r / I_GL; cvt_item(a.in[F.zz + I_GLUW] + (size_t)l * 65536, 256, 256, (bf16*)(F.ws + WS_GLUW) + (size_t)l * 65536, 0, 0, scr, r - l * I_GL, F.lane); }
    }
    moe_cvt(F, a, 0);
    for (int i = blockIdx.x * 512 + F.tid; i < 4 * 256 * 128; i += F.G * 512) {
        const int l = i >> 15, rem = i & 32767, n = rem >> 7, k0 = (rem & 127) * 8, d = n >> 7, cidx = n & 127;
        const float* wa = a.in[F.zz + I_WA2] + ((size_t)(l * 2 + d) * 16) * 128 + cidx;
        float acc[8] = {0.f, 0.f, 0.f, 0.f, 0.f, 0.f, 0.f, 0.f};
#pragma unroll
        for (int r = 0; r < 16; ++r) { const float w2 = wa[r * 128];
#pragma unroll
            for (int kk = 0; kk < 8; ++kk) acc[kk] = fmaf(a.in[F.zz + I_WIN][((size_t)l * 1024 + k0 + kk) * DIN + 3328 + 16 * d + r], w2, acc[kk]); }
        v4u o; o.x = pk2(acc[0], acc[1]); o.y = pk2(acc[2], acc[3]); o.z = pk2(acc[4], acc[5]); o.w = pk2(acc[6], acc[7]);
        *(v4u*)((bf16*)(F.ws + WS_WIN) + ((size_t)l * DINP + 3328 + n) * 1024 + k0) = o;
    }
}

struct MoeTp { int tp[9]; };
__device__ __forceinline__ void load_tp(MoeTp& t, const unsigned* cnt) {
    t.tp[0] = 0;
#pragma unroll
    for (int e = 0; e < 8; ++e) t.tp[e + 1] = t.tp[e] + (int)(((unsigned)__builtin_amdgcn_readfirstlane((int)__hip_atomic_load(cnt + e * 64, __ATOMIC_RELAXED, __HIP_MEMORY_SCOPE_AGENT)) + 255u) >> 8);
}
template <int MODE>
__device__ __forceinline__ void norm_phase(const Frame& F, const Args& a, int l, int which  , int nrows, int comb_l  ) {
    const float* MOD = (const float*)(F.ws + WS_MOD);
    const float* nw = (MODE == 2) ? a.in[F.zz + I_FINW] : ((which ? a.in[F.zz + I_N2W] : a.in[F.zz + I_N1W]) + l * 1024);
    bf16* XN = (bf16*)(F.ws + WS_ACT);
    float* hb = (float*)(F.ws + WS_HB);
    const int* EP = (const int*)(F.ws + WS_LIST) + 8 * MT; const float* GATE = (const float*)(F.ws + WS_LIST) + 10 * MT;
    const bf16* YM = (const bf16*)(F.ws + WS_X2);
    const bool from_input = (l == 0 && which == 0 && MODE != 2);
    MoeTp ctp; if (comb_l >= 0) load_tp(ctp, (const unsigned*)F.ws + CW_CNT + (comb_l >> 1) * 8 * 64);
    const int jm = l >> 1;
    LAS float* rwl = (LAS float*)F.lds;
    if (MODE == 1) {
        const float* rw = a.in[F.zz + I_RW] + (size_t)jm * 8192;
        for (int idx = F.tid; idx < 8192; idx += 512) { const int k = idx >> 3, e = idx & 7; rwl[e * 1024 + k] = rw[idx]; }
        __syncthreads();
    }
    f32x4 wv[4];
#pragma unroll
    for (int j = 0; j < 4; ++j) wv[j] = *((const f32x4*)nw + F.lane + 64 * j);
    for (int m = F.gw; m < nrows; m += F.NGW) {
        const bool isctx = m >= NLAT; const int bidx = isctx ? 4 : (m >> 13);
        const float* xr = from_input ? (isctx ? a.in[F.zz + I_CTX] + (size_t)(m - NLAT) * 1024 : a.in[F.zz + I_X] + (size_t)m * 1024)
                                     : (isctx ? hb + (size_t)(m - NLAT) * 1024 : F.out + (size_t)m * 1024);
        f32x4 v[4];
#pragma unroll
        for (int j = 0; j < 4; ++j) v[j] = *((const f32x4*)xr + F.lane + 64 * j);
        if (comb_l >= 0) {
            const int ep0 = EP[2 * m], ep1 = EP[2 * m + 1]; const float g0 = GATE[2 * m], g1 = GATE[2 * m + 1];
            int t0 = 0, t1 = 0;
#pragma unroll
            for (int e = 0; e < 8; ++e) { t0 = ((ep0 & 7) == e) ? ctp.tp[e] : t0; t1 = ((ep1 & 7) == e) ? ctp.tp[e] : t1; }
            const size_t d0 = (size_t)t0 * 256 + (ep0 >> 3), d1 = (size_t)t1 * 256 + (ep1 >> 3);
            const float* m5 = MOD + ((size_t)comb_l * 5 + bidx) * 6144 + 5 * 1024;
            float* xw = isctx ? hb + (size_t)(m - NLAT) * 1024 : F.out + (size_t)m * 1024;
#pragma unroll
            for (int j = 0; j < 4; ++j) {
                const v2u y0 = *((const v2u*)(YM + d0 * 1024) + F.lane + 64 * j), y1 = *((const v2u*)(YM + d1 * 1024) + F.lane + 64 * j);
                const f32x4 mm = *((const f32x4*)m5 + F.lane + 64 * j);
                f32x4 f0, f1;
                f0[0] = __uint_as_float(y0.x << 16); f0[1] = __uint_as_float(y0.x & 0xffff0000u); f0[2] = __uint_as_float(y0.y << 16); f0[3] = __uint_as_float(y0.y & 0xffff0000u);
                f1[0] = __uint_as_float(y1.x << 16); f1[1] = __uint_as_float(y1.x & 0xffff0000u); f1[2] = __uint_as_float(y1.y << 16); f1[3] = __uint_as_float(y1.y & 0xffff0000u);
                v[j] = v[j] + mm * (f0 * g0 + f1 * g1);
                if (MODE != 2) *((f32x4*)xw + F.lane + 64 * j) = v[j];
            }
        }
        float ss = 0.f;
#pragma unroll
        for (int j = 0; j < 4; ++j) ss += (v[j][0] * v[j][0] + v[j][1] * v[j][1]) + (v[j][2] * v[j][2] + v[j][3] * v[j][3]);
        ss = wave_sum(ss);
        const float rstd = 1.0f / sqrtf(ss * (1.0f / 1024.0f) + NEPS);
        if (MODE == 2) {
#pragma unroll
            for (int j = 0; j < 4; ++j) *((f32x4*)(F.out + (size_t)m * 1024) + F.lane + 64 * j) = v[j] * rstd * wv[j];
        } else {
            const float* sh = MOD + ((size_t)l * 5 + bidx) * 6144 + (which ? 3 : 0) * 1024; const float* scl = sh + 1024;
            f32x4 o[4];
#pragma unroll
            for (int j = 0; j < 4; ++j) { const f32x4 s1 = *((const f32x4*)scl + F.lane + 64 * j), s0 = *((const f32x4*)sh + F.lane + 64 * j);
                o[j] = (v[j] * rstd * wv[j]) * (s1 + 1.0f) + s0;
                v2u w; w.x = pk2(o[j][0], o[j][1]); w.y = pk2(o[j][2], o[j][3]);
                *((v2u*)(XN + (size_t)m * 1024) + F.lane + 64 * j) = w; }
            if (MODE == 1) {
                float p[8];
#pragma unroll
                for (int e = 0; e < 8; ++e) { float s = 0.f;
#pragma unroll
                    for (int j = 0; j < 4; ++j) { const f32x4 w4 = *((const LAS f32x4*)(rwl + e * 1024) + F.lane + 64 * j);
                        s += (o[j][0] * w4[0] + o[j][1] * w4[1]) + (o[j][2] * w4[2] + o[j][3] * w4[3]); }
                    p[e] = wave_sum(s) + a.in[F.zz + I_RB][jm * 8 + e]; }
                int e0 = 0; float v0 = p[0];
#pragma unroll
                for (int e = 1; e < 8; ++e) if (p[e] > v0) { v0 = p[e]; e0 = e; }
                int e1 = -1; float v1 = -3.0e38f;
#pragma unroll
                for (int e = 0; e < 8; ++e) if (e != e0 && p[e] > v1) { v1 = p[e]; e1 = e; }
                const float ex = expf(v1 - v0), g0 = 1.0f / (1.0f + ex), g1 = ex / (1.0f + ex);
                if (F.lane == 0) {
                    unsigned* cnt = (unsigned*)F.ws + CW_CNT + jm * 8 * 64; int* LIST = (int*)(F.ws + WS_LIST);
                    int* EPw = (int*)(F.ws + WS_LIST) + 8 * MT; float* GW = (float*)(F.ws + WS_LIST) + 10 * MT;
                    const unsigned p0 = __hip_atomic_fetch_add(cnt + e0 * 64, 1u, __ATOMIC_RELAXED, __HIP_MEMORY_SCOPE_AGENT);
                    const unsigned p1 = __hip_atomic_fetch_add(cnt + e1 * 64, 1u, __ATOMIC_RELAXED, __HIP_MEMORY_SCOPE_AGENT);
                    LIST[e0 * MT + p0] = m; LIST[e1 * MT + p1] = m;
                    EPw[2 * m] = e0 | (int)(p0 << 3); EPw[2 * m + 1] = e1 | (int)(p1 << 3);
                    GW[2 * m] = g0; GW[2 * m + 1] = g1;
                }
            }
        }
    }
    if (MODE == 1) __syncthreads();
}
__device__ __forceinline__ void moe_gather(const Frame& F, int jm) {
    const unsigned* cnt = (const unsigned*)F.ws + CW_CNT + jm * 8 * 64;
    MoeTp t; load_tp(t, cnt);
    int cn[8];
#pragma unroll
    for (int e = 0; e < 8; ++e) cn[e] = __builtin_amdgcn_readfirstlane((int)__hip_atomic_load(cnt + e * 64, __ATOMIC_RELAXED, __HIP_MEMORY_SCOPE_AGENT));
    const int rows = t.tp[8] * 256;
    const int* LIST = (const int*)(F.ws + WS_LIST); const v4u* XN = (const v4u*)(F.ws + WS_ACT); v4u* XB = (v4u*)(F.ws + WS_X2);
    for (int r = F.gw; r < rows; r += F.NGW) {
        const int tile = r >> 8; int e = 0, tpe = 0, ce = cn[0];
#pragma unroll
        for (int k = 1; k < 8; ++k) { const bool ge = tile >= t.tp[k]; e += ge ? 1 : 0; tpe = ge ? t.tp[k] : tpe; ce = ge ? cn[k] : ce; }
        const int pos = r - tpe * 256;
        v4u x0 = {0u, 0u, 0u, 0u}, x1 = {0u, 0u, 0u, 0u};
        if (pos < ce) { const int src = LIST[e * MT + pos]; x0 = XN[(size_t)src * 128 + F.lane]; x1 = XN[(size_t)src * 128 + 64 + F.lane]; }
        XB[(size_t)r * 128 + F.lane] = x0; XB[(size_t)r * 128 + 64 + F.lane] = x1;
    }
}

struct MixP { const bf16* P; const float* lb; const float* rcos; const float* rsin; const float* ba; };
__device__ __forceinline__ int seg_row0(int b, int sg) { return sg < 4 ? NLAT + b * CTXL + sg * 64 : b * SEQ + (sg - 4) * 64; }
__device__ __forceinline__ int seg_tpos0(int sg) { return sg < 4 ? -1 : (sg - 4) * 64; }

struct S5P { const float *lam_re, *lam_im, *log_dt, *b_re, *b_im, *c_re, *c_im, *dd; };
__device__ __forceinline__ float gelu_tanh(float y) { const float t = 0.7978845608028654f * (y + 0.044715f * y * y * y); const float th = 1.0f - 2.0f / (1.0f + __expf(2.0f * t)); return 0.5f * y * (1.0f + th); }
template <int MODE>
__device__ __forceinline__ void s5_scan(const S5P& sp, const bf16* P, int b, int g, int dir, int sg, int lane, float& hre, float& him, LAS float* yf, LAS float* stg, bf16* Z) {
    const int row0 = seg_row0(b, sg); const int dg = dir * 16 + g;
    const float lre = sp.lam_re[dg * 64 + lane], lim = sp.lam_im[dg * 64 + lane], dt = expf(sp.log_dt[dg]);
    const float er = expf(lre * dt); const float sn = sinf(lim * dt), cs = cosf(lim * dt);
    const float ar = er * cs, ai = er * sn;
    const float nr = ar - 1.0f, ni = ai, den = lre * lre + lim * lim;
    const float cr = (nr * lre + ni * lim) / den, ci = (ni * lre - nr * lim) / den;
    float bbr[16], bbi[16], Cr[16], Ci[16];
#pragma unroll
    for (int c = 0; c < 16; ++c) { const float Br = sp.b_re[((size_t)dg * 64 + lane) * 16 + c], Bi = sp.b_im[((size_t)dg * 64 + lane) * 16 + c];
        bbr[c] = cr * Br - ci * Bi; bbi[c] = cr * Bi + ci * Br;
        Cr[c] = (MODE != 0) ? sp.c_re[((size_t)dg * 16 + c) * 64 + lane] : 0.f; Ci[c] = (MODE != 0) ? sp.c_im[((size_t)dg * 16 + c) * 64 + lane] : 0.f; }
    const int ch = ((lane >> 5) & 1) * 8 + ((lane >> 4) & 1) * 4 + ((lane >> 3) & 1) * 2 + ((lane >> 2) & 1);
    const float dv = (MODE == 2) ? sp.dd[g * 16 + ch] : 0.f;
    const bool b5 = lane & 32, b4 = lane & 16, b3 = lane & 8, b2 = lane & 4;
    for (int i0 = 0; i0 < 64; i0 += 4) {
        unsigned short ru[4];
#pragma unroll
        for (int u = 0; u < 4; ++u) { const int ti = dir ? 63 - (i0 + u) : (i0 + u); ru[u] = P[(size_t)(row0 + ti) * DINP + C_S5 + g * 16 + (lane & 15)]; }
#pragma unroll
        for (int u = 0; u < 4; ++u) stg[u * 64 + lane] = bf2f(ru[u]);
#pragma unroll
        for (int u = 0; u < 4; ++u) {
            const int ti = dir ? 63 - (i0 + u) : (i0 + u);
            const float uf = bf2f(ru[u]);
            float bur = 0.f, bui = 0.f;
#pragma unroll
            for (int c4 = 0; c4 < 4; ++c4) { const f32x4 ux = *(const LAS f32x4*)(stg + u * 64 + 4 * c4);
#pragma unroll
                for (int jj = 0; jj < 4; ++jj) { bur = fmaf(bbr[4 * c4 + jj], ux[jj], bur); bui = fmaf(bbi[4 * c4 + jj], ux[jj], bui); } }
            const float nre = ar * hre - ai * him + bur, nim = ar * him + ai * hre + bui;
            hre = nre; him = nim;
            if (MODE != 0) {
                float v[16];
#pragma unroll
                for (int c = 0; c < 16; ++c) v[c] = Cr[c] * hre - Ci[c] * him;
                float w8[8], w4[4], w2[2], w1;
#pragma unroll
                for (int i = 0; i < 8; ++i) { const float mine = b5 ? v[8 + i] : v[i], oth = b5 ? v[i] : v[8 + i]; w8[i] = mine + __shfl_xor(oth, 32); }
#pragma unroll
                for (int i = 0; i < 4; ++i) { const float mine = b4 ? w8[4 + i] : w8[i], oth = b4 ? w8[i] : w8[4 + i]; w4[i] = mine + __shfl_xor(oth, 16); }
#pragma unroll
                for (int i = 0; i < 2; ++i) { const float mine = b3 ? w4[2 + i] : w4[i], oth = b3 ? w4[i] : w4[2 + i]; w2[i] = mine + __shfl_xor(oth, 8); }
                { const float mine = b2 ? w2[1] : w2[0], oth = b2 ? w2[0] : w2[1]; w1 = mine + __shfl_xor(oth, 4); }
                w1 += __shfl_xor(w1, 2); w1 += __shfl_xor(w1, 1);
                if (MODE == 1) { if ((lane & 3) == 0) yf[ti * 16 + ch] = w1; }
                if (MODE == 2) {
                    const float uch = __shfl(uf, ch);
                    if ((lane & 3) == 0) { const float y = w1 + yf[ti * 16 + ch] + dv * uch; Z[(size_t)(row0 + ti) * 256 + g * 16 + ch] = (bf16)f2bf(gelu_tanh(y)); }
                }
            }
        }
    }
}

__device__ __forceinline__ MixP make_mixp(const Frame& F, const Args& a, int l) {
    MixP mp; mp.P = (const bf16*)(F.ws + WS_PH); mp.lb = (const float*)(F.ws + WS_LB) + l * 256; mp.rcos = (const float*)(F.ws + WS_ROPE); mp.rsin = mp.rcos + 2048;
    mp.ba = a.in[F.zz + I_BA] + (size_t)l * 2 * 128; return mp;
}
__device__ __forceinline__ S5P make_s5p(const Frame& F, const Args& a, int l) {
    S5P sp; sp.lam_re = a.in[F.zz + I_LAMRE] + (size_t)l * 2048; sp.lam_im = a.in[F.zz + I_LAMIM] + (size_t)l * 2048; sp.log_dt = a.in[F.zz + I_LOGDT] + l * 32;
    sp.b_re = a.in[F.zz + I_BRE] + (size_t)l * 32768; sp.b_im = a.in[F.zz + I_BIM] + (size_t)l * 32768; sp.c_re = a.in[F.zz + I_CRE] + (size_t)l * 32768; sp.c_im = a.in[F.zz + I_CIM] + (size_t)l * 32768;
    sp.dd = a.in[F.zz + I_S5D] + l * 256; return sp;
}


typedef short bf16x8_t __attribute__((ext_vector_type(8)));
typedef float f32x16 __attribute__((ext_vector_type(16)));
typedef float f32x2_t __attribute__((ext_vector_type(2)));
typedef __bf16 bf16x2_n __attribute__((ext_vector_type(2)));
__device__ __forceinline__ unsigned pkbf(float lo, float hi) { const f32x2_t v = {lo, hi}; const bf16x2_n r = __builtin_convertvector(v, bf16x2_n); return __builtin_bit_cast(unsigned, r); }
constexpr int WL_QC = 0, WL_KC = 4608, WL_KT = 9216, WL_VT = 14336, WL_PL = 19456, WL_BYTES = 19712;

struct MxC { float gamma, lbv, oml, bav; unsigned cq, ck, cv, cz; };
#define GLD(T, ubase, voff) (*(const T*)((const char*)(ubase) + (unsigned)(voff)))
#define GST(T, ubase, voff) (*(T*)((char*)(ubase) + (unsigned)(voff)))
template <int MIX>
__device__ __forceinline__ void mx_consts(MxC& c, const MixP& mp, int h, int dir, int lane) {
    c.gamma = 1.f; c.lbv = 0.f; c.oml = 1.f; c.bav = 0.f; c.cz = 0;
    if (MIX == 0) { c.cq = 2u * (unsigned)(C_RQ + h * 64 + lane); c.ck = 2u * (unsigned)(C_RK + h * 64 + lane); c.cv = 2u * (unsigned)(C_RV + h * 64 + lane); c.gamma = 1.0f - exp2f(-5.0f - (float)(dir ? 3 - h : h)); }
    else if (MIX == 1) { c.cq = 2u * (unsigned)(C_HQ + h * 64 + lane); c.ck = 2u * (unsigned)((dir ? C_HFB : C_HFF) + h * 64 + lane); c.cv = 2u * (unsigned)(C_HI + h * 64 + lane); c.lbv = mp.lb[h * 64 + lane]; c.oml = 1.0f - c.lbv; }
    else { c.cq = 2u * (unsigned)(C_GQ + h * 32 + (lane & 31)); c.ck = 2u * (unsigned)(C_GK + h * 32 + (lane & 31)); c.cv = 2u * (unsigned)(C_GV + h * 64 + lane); c.cz = 2u * (unsigned)((dir ? C_GZB : C_GZF) + h * 32 + (lane & 31));
        c.bav = mp.ba[dir * 128 + h * 32 + (lane & 31)]; }
}
struct MxRaw { unsigned short q[4], k[4], v[4], z[4]; };
template <int MIX, bool NEEDQ, int DIR>
__device__ __forceinline__ void mx_load(MxRaw& w, const MixP& mp, const MxC& c, int row0, int b4) {
#pragma unroll
    for (int u = 0; u < 4; ++u) { const int cc = b4 * 4 + u, t = DIR ? 31 - cc : cc; const bf16* pr = mp.P + (size_t)(row0 + t) * DINP;
        w.q[u] = NEEDQ ? GLD(unsigned short, pr, c.cq) : (unsigned short)0; w.k[u] = GLD(unsigned short, pr, c.ck); w.v[u] = GLD(unsigned short, pr, c.cv); w.z[u] = (MIX == 2) ? GLD(unsigned short, pr, c.cz) : (unsigned short)0; }
}
template <int MIX, bool NEEDQ, int DIR>
__device__ __forceinline__ float mx_prep(const MixP& mp, const MxC& c, int row0, int tpos0, int lane, LAS unsigned char* wl) {
    constexpr int DK = (MIX == 2) ? 32 : 64;
    float P = 1.0f;
    MxRaw cur; mx_load<MIX, NEEDQ, DIR>(cur, mp, c, row0, 0);
#pragma unroll 1
    for (int b4 = 0; b4 < 8; ++b4) {
        MxRaw nxt; mx_load<MIX, NEEDQ, DIR>(nxt, mp, c, row0, b4 < 7 ? b4 + 1 : 7);
        float kt[4], vv[4];
#pragma unroll
        for (int u = 0; u < 4; ++u) {
            const int cc = b4 * 4 + u, t = DIR ? 31 - cc : cc;
            float q = bf2f(cur.q[u]), k, f; vv[DIR ? 3 - u : u] = bf2f(cur.v[u]);
            if (MIX == 0) {
                k = bf2f(cur.k[u]) * 0.125f; f = c.gamma;
                if (tpos0 >= 0) { const int tpos = tpos0 + t; const int pos = (lane & 32) ? (tpos & 63) : (tpos >> 6);
                    const unsigned ro = 4u * (unsigned)(pos * 16 + (lane & 15)); const float cs = GLD(float, mp.rcos, ro), sn = GLD(float, mp.rsin, ro);
                    const float ss = (lane & 16) ? sn : -sn;
                    const float kp = __shfl_xor(k, 16); k = fmaf(kp, ss, k * cs);
                    if (NEEDQ) { const float qp = __shfl_xor(q, 16); q = fmaf(qp, ss, q * cs); } }
            } else if (MIX == 1) {
                const float z = bf2f(cur.k[u]); const float sp = 1.0f / (1.0f + __expf(-z)), sn = 1.0f / (1.0f + __expf(z));
                f = fmaf(c.oml, sp, c.lbv); k = c.oml * sn;
            } else {
                k = bf2f(cur.k[u]) * 0.17677669529663687f; const float z = bf2f(cur.z[u]) + c.bav;
                const float ls = fminf(z, 0.f) - log1pf(expf(-fabsf(z)));
                f = expf(ls * 0.0625f);
            }
            P = fmaxf(P * f, 1e-30f);
            const float kk = k * __builtin_amdgcn_rcpf(P); kt[DIR ? 3 - u : u] = kk;
            if (lane < DK) {
                if (NEEDQ) *(LAS unsigned short*)(wl + WL_QC + t * 144 + lane * 2) = (unsigned short)f2bf(q * P);
                *(LAS unsigned short*)(wl + WL_KC + t * 144 + lane * 2) = (unsigned short)f2bf(kk);
            }
        }
        const int g4 = DIR ? 7 - b4 : b4;
        v2u kp, vp; kp.x = pkbf(kt[0], kt[1]); kp.y = pkbf(kt[2], kt[3]); vp.x = pkbf(vv[0], vv[1]); vp.y = pkbf(vv[2], vv[3]);
        if (lane < DK) *(LAS v2u*)(wl + WL_KT + lane * 80 + g4 * 8) = kp;
        *(LAS v2u*)(wl + WL_VT + lane * 80 + g4 * 8) = vp;
        cur = nxt;
    }
    return P;
}
typedef short bf16x4_t __attribute__((ext_vector_type(4)));
#define MFMA8(a, b, c) __builtin_amdgcn_mfma_f32_32x32x8bf16_1k((a), (b), (c), 0, 0, 0)
__device__ __forceinline__ bf16x4_t pack4(const f32x16& x, int s) {
    v2u p; p.x = pkbf(x[4 * s], x[4 * s + 1]); p.y = pkbf(x[4 * s + 2], x[4 * s + 3]);
    return __builtin_bit_cast(bf16x4_t, p);
}
__device__ __forceinline__ bf16x4_t ld4(const LAS unsigned char* p) { const v2u a = *(const LAS v2u*)p; return __builtin_bit_cast(bf16x4_t, a); }
template <int MIX, int DIR, bool WITH_O>
__device__ __forceinline__ void mx_chunk(LAS unsigned char* wl, int lane, float Pl, f32x16 (&ST)[(MIX == 2) ? 1 : 2][2], f32x16 (&O)[2]) {
    constexpr int DK = (MIX == 2) ? 32 : 64, NRT = DK / 32;
    const int m32 = lane & 31, hh = lane >> 5;
    asm volatile("" ::: "memory");
    if (lane < DK) *(LAS float*)(wl + WL_PL + lane * 4) = Pl;
    asm volatile("" ::: "memory");
    if (WITH_O) {
        f32x16 x;
#pragma unroll
        for (int r = 0; r < 16; ++r) x[r] = 0.f;
#pragma unroll
        for (int s = 0; s < DK / 8; ++s) {
            const bf16x4_t ka = ld4(wl + WL_KC + m32 * 144 + (8 * s + 4 * hh) * 2);
            const bf16x4_t qb = ld4(wl + WL_QC + m32 * 144 + (8 * s + 4 * hh) * 2);
            x = MFMA8(ka, qb, x);
        }
#pragma unroll
        for (int r = 0; r < 16; ++r) { const int j = (r & 3) + 8 * (r >> 2) + 4 * hh; const bool keep = DIR ? (j >= m32) : (j <= m32); x[r] = keep ? x[r] : 0.f; }
#pragma unroll
        for (int t = 0; t < 2; ++t)
#pragma unroll
            for (int r = 0; r < 16; ++r) O[t][r] = 0.f;
#pragma unroll
        for (int s = 0; s < 4; ++s) {
            const bf16x4_t xa = pack4(x, s);
#pragma unroll
            for (int t = 0; t < 2; ++t) O[t] = MFMA8(xa, ld4(wl + WL_VT + (32 * t + m32) * 80 + (8 * s + 4 * hh) * 2), O[t]);
        }
#pragma unroll
        for (int rt = 0; rt < NRT; ++rt)
#pragma unroll
            for (int s = 0; s < 4; ++s) {
                const bf16x4_t qa = ld4(wl + WL_QC + m32 * 144 + (32 * rt + 8 * s + 4 * hh) * 2);
#pragma unroll
                for (int t = 0; t < 2; ++t) O[t] = MFMA8(qa, pack4(ST[rt][t], s), O[t]);
            }
    }
#pragma unroll
    for (int rt = 0; rt < NRT; ++rt)
#pragma unroll
        for (int s = 0; s < 4; ++s) {
            const bf16x4_t ka = ld4(wl + WL_KT + (32 * rt + m32) * 80 + (8 * s + 4 * hh) * 2);
#pragma unroll
            for (int t = 0; t < 2; ++t) ST[rt][t] = MFMA8(ka, ld4(wl + WL_VT + (32 * t + m32) * 80 + (8 * s + 4 * hh) * 2), ST[rt][t]);
        }
#pragma unroll
    for (int rt = 0; rt < NRT; ++rt)
#pragma unroll
        for (int g = 0; g < 4; ++g) {
            const f32x4 pl4 = *(const LAS f32x4*)(wl + WL_PL + (32 * rt + 8 * g + 4 * hh) * 4);
#pragma unroll
            for (int e = 0; e < 4; ++e) { ST[rt][0][4 * g + e] *= pl4[e]; ST[rt][1][4 * g + e] *= pl4[e]; }
        }
}
__device__ __forceinline__ float half_sum(float v) {
#pragma unroll
    for (int o = 1; o < 32; o <<= 1) v += __shfl_xor(v, o);
    return v;
}
template <int MIX>
__device__ __forceinline__ void mixA_unit(const MixP& mp, float* STG, int idx, int lane_in, LAS unsigned char* wl) {
    int lane = lane_in;
    constexpr int DK = (MIX == 2) ? 32 : 64, NRT = DK / 32;
    const int dir = idx / 2112, rem = idx - dir * 2112, bh = rem / NSEG, sg = rem - bh * NSEG, b = bh >> 2, h = bh & 3;
    asm volatile("" : "+v"(lane));
    MxC c; mx_consts<MIX>(c, mp, h, dir, lane);
    f32x16 ST[NRT][2], O[2];
#pragma unroll
    for (int rt = 0; rt < NRT; ++rt)
#pragma unroll
        for (int t = 0; t < 2; ++t)
#pragma unroll
            for (int r = 0; r < 16; ++r) ST[rt][t][r] = 0.f;
    const int row0 = seg_row0(b, sg), tpos0 = seg_tpos0(sg);
    float Gam = 1.0f;
#pragma unroll 1
    for (int ci = 0; ci < 2; ++ci) {
        const int ch = dir ? 1 - ci : ci;
        int ln = lane; asm volatile("" : "+v"(ln));
        float Pl;
        if (dir) Pl = mx_prep<MIX, false, 1>(mp, c, row0 + 32 * ch, tpos0 < 0 ? -1 : tpos0 + 32 * ch, ln, wl);
        else Pl = mx_prep<MIX, false, 0>(mp, c, row0 + 32 * ch, tpos0 < 0 ? -1 : tpos0 + 32 * ch, ln, wl);
        Gam *= Pl;
        mx_chunk<MIX, 0, false>(wl, ln, Pl, ST, O);
    }
    const size_t slot = (size_t)((dir * 16 + bh) * NSEG + sg);
    float* ds = STG + (MIX == 0 ? ST_DS0 : (MIX == 1 ? ST_DS1 : ST_DS2)) + slot * (DK * 64);
    const int m32 = lane & 31, hh = lane >> 5;
#pragma unroll
    for (int rt = 0; rt < NRT; ++rt)
#pragma unroll
        for (int t = 0; t < 2; ++t)
#pragma unroll
            for (int r = 0; r < 16; ++r) GST(float, ds + (32 * rt + (r & 3) + 8 * (r >> 2)) * 64 + 32 * t, 4u * (unsigned)(4 * hh * 64 + m32)) = ST[rt][t][r];
    float* gs = STG + (MIX == 0 ? ST_G0 : (MIX == 1 ? ST_G1 : ST_G2)) + slot * 64;
    GST(float, gs, 4u * (unsigned)lane) = Gam;
}
template <int MIX, int MODE>
__device__ __forceinline__ void mx_epilogue(const MixP& mp, LAS unsigned char* wl, int lane, const f32x16 (&O)[2], int rowc, float* OF, bf16* Y, int ocol, int ycol, int cgate, float nwv) {
    LAS float* ost = (LAS float*)(wl + WL_QC);
    const int m32 = lane & 31, hh = lane >> 5;
    asm volatile("" ::: "memory");
#pragma unroll
    for (int t = 0; t < 2; ++t)
#pragma unroll
        for (int r = 0; r < 16; ++r) ost[((r & 3) + 8 * (r >> 2) + 4 * hh) * 68 + 32 * t + m32] = O[t][r];
    asm volatile("" ::: "memory");
    if (MODE == 1) {
#pragma unroll 8
        for (int tk = 0; tk < 32; ++tk) GST(float, OF + (size_t)(rowc + tk) * 768 + ocol, 4u * (unsigned)lane) = ost[tk * 68 + lane];
    } else {
        float ofc[8]; unsigned short gc[8];
#pragma unroll
        for (int u = 0; u < 8; ++u) { ofc[u] = GLD(float, OF + (size_t)(rowc + u) * 768 + ocol, 4u * (unsigned)lane); gc[u] = GLD(unsigned short, mp.P + (size_t)(rowc + u) * DINP + cgate, 2u * (unsigned)lane); }
#pragma unroll 1
        for (int b8 = 0; b8 < 4; ++b8) {
            float ofn[8]; unsigned short gn[8]; const int nb = b8 < 3 ? b8 + 1 : 3;
#pragma unroll
            for (int u = 0; u < 8; ++u) { ofn[u] = GLD(float, OF + (size_t)(rowc + nb * 8 + u) * 768 + ocol, 4u * (unsigned)lane); gn[u] = GLD(unsigned short, mp.P + (size_t)(rowc + nb * 8 + u) * DINP + cgate, 2u * (unsigned)lane); }
#pragma unroll
            for (int u = 0; u < 8; ++u) {
                const int tk = b8 * 8 + u;
                const float o = ost[tk * 68 + lane] + ofc[u];
                float y;
                if (MIX == 0) { const float mean = wave_sum(o) * (1.0f / 64.0f); const float d = o - mean; y = d * (1.0f / sqrtf(wave_sum(d * d) * (1.0f / 64.0f) + NEPS)) * nwv; }
                else y = o * (1.0f / sqrtf(wave_sum(o * o) * (1.0f / 64.0f) + NEPS)) * nwv;
                y *= silu_f(bf2f(gc[u]));
                GST(unsigned short, Y + (size_t)(rowc + tk) * 1024 + ycol, 2u * (unsigned)lane) = (unsigned short)f2bf(y);
            }
#pragma unroll
            for (int u = 0; u < 8; ++u) { ofc[u] = ofn[u]; gc[u] = gn[u]; }
        }
    }
}
template <int MIX>
__device__ __forceinline__ void mixC_unit(const MixP& mp, const float* STG, int idx, int lane_in, float* OF, LAS unsigned char* wl, bf16* Y, const float* nw) {
    int lane = lane_in; asm volatile("" : "+v"(lane));
    constexpr int DK = (MIX == 2) ? 32 : 64, NRT = DK / 32;
    const int bh = idx / NSEG, sg = idx - bh * NSEG, b = bh >> 2, h = bh & 3;
    const int m32 = lane & 31, hh = lane >> 5;
    const int row0 = seg_row0(b, sg), tpos0 = seg_tpos0(sg);
    const int ocol = ((MIX == 0) ? 0 : (MIX == 1 ? 256 : 512)) + h * 64, ycol = ((MIX == 0) ? 0 : (MIX == 1 ? 512 : 768)) + h * 64;
    const int cgate = ((MIX == 0) ? C_RG : (MIX == 1 ? C_HG : C_GG)) + h * 64;
    const float* dsb = STG + (MIX == 0 ? ST_DS0 : (MIX == 1 ? ST_DS1 : ST_DS2));
    const float nwv = nw[h * 64 + lane];
    f32x16 ST[NRT][2], O[2];
#pragma unroll 1
    for (int dir = 0; dir < 2; ++dir) {
        MxC c; mx_consts<MIX>(c, mp, h, dir, lane);
        { const float* ds = dsb + (size_t)((dir * 16 + bh) * NSEG + sg) * (DK * 64);
#pragma unroll
          for (int rt = 0; rt < NRT; ++rt)
#pragma unroll
              for (int t = 0; t < 2; ++t)
#pragma unroll
                  for (int r = 0; r < 16; ++r) ST[rt][t][r] = GLD(float, ds + (32 * rt + (r & 3) + 8 * (r >> 2)) * 64 + 32 * t, 4u * (unsigned)(4 * hh * 64 + m32)); }
#pragma unroll 1
        for (int ci = 0; ci < 2; ++ci) {
            const int ch = dir ? 1 - ci : ci; const int rowc = row0 + 32 * ch;
            int ln = lane; asm volatile("" : "+v"(ln));
            if (dir == 0) {
                const float Pl = mx_prep<MIX, true, 0>(mp, c, rowc, tpos0 < 0 ? -1 : tpos0 + 32 * ch, ln, wl);
                mx_chunk<MIX, 0, true>(wl, ln, Pl, ST, O);
                mx_epilogue<MIX, 1>(mp, wl, ln, O, rowc, OF, Y, ocol, ycol, cgate, nwv);
            } else {
                const float Pl = mx_prep<MIX, true, 1>(mp, c, rowc, tpos0 < 0 ? -1 : tpos0 + 32 * ch, ln, wl);
                mx_chunk<MIX, 1, true>(wl, ln, Pl, ST, O);
                mx_epilogue<MIX, 2>(mp, wl, ln, O, rowc, OF, Y, ocol, ycol, cgate, nwv);
            }
        }
        asm volatile("s_waitcnt vmcnt(0)" ::: "memory");
    }
}
template <int MSEL>
__device__ __forceinline__ void mix_passA(const Frame& F, const Args& a, int l) {
    const MixP mp = make_mixp(F, a, l); const S5P sp = make_s5p(F, a, l);
    float* ST = (float*)(F.ws + WS_X2);
    LAS unsigned char* wl = F.lds + F.wave * WL_BYTES; LAS float* stg = (LAS float*)wl;
    if (MSEL & 1) for (int u = F.gw; u < 4224; u += F.NGW) mixA_unit<0>(mp, ST, u, F.lane, wl);
    if (MSEL & 2) for (int u = F.gw; u < 4224; u += F.NGW) mixA_unit<1>(mp, ST, u, F.lane, wl);
    if (MSEL & 4) for (int u = F.gw; u < 4224; u += F.NGW) mixA_unit<2>(mp, ST, u, F.lane, wl);
    if (MSEL & 8) for (int idx = F.gw; idx < 2 * 64 * NSEG; idx += F.NGW) {
        const int dir = idx / (64 * NSEG), rem = idx - dir * 64 * NSEG, bg = rem / NSEG, sg = rem - bg * NSEG;
        float hre = 0.f, him = 0.f;
        s5_scan<0>(sp, mp.P, bg >> 4, bg & 15, dir, sg, F.lane, hre, him, nullptr, stg, nullptr);
        float* hs = ST + ST_HS + ((size_t)((dir * 64 + bg) * NSEG + sg) * 64 + F.lane) * 2;
        hs[0] = hre; hs[1] = him;
    }
}
__device__ __forceinline__ int chain_seg(int dir, int p) { return dir ? (p < 4 ? 3 - p : 135 - p) : p; }
__device__ __forceinline__ void mix_passB(const Frame& F, const Args& a, int l) {
    float* ST = (float*)(F.ws + WS_X2);
    constexpr int N0 = 131072, N1 = 131072, N2 = 65536, N3 = 8192;
    for (int e = blockIdx.x * 512 + F.tid; e < N0 + N1 + N2 + N3; e += F.G * 512) {
        if (e < N0 + N1 + N2) {
            float* base; const float* gb; int dir, esz;
            if (e < N0 + N1) { const int mix = e >= N0, e2 = e - mix * N0, c = e2 >> 12, el = e2 & 4095; dir = c >> 4; esz = 4096;
                base = ST + (mix ? ST_DS1 : ST_DS0) + (size_t)c * NSEG * 4096 + el; gb = ST + (mix ? ST_G1 : ST_G0) + (size_t)c * NSEG * 64 + (el >> 6); }
            else { const int e2 = e - N0 - N1, c = e2 >> 11, el = e2 & 2047; dir = c >> 4; esz = 2048;
                base = ST + ST_DS2 + (size_t)c * NSEG * 2048 + el; gb = ST + ST_G2 + (size_t)c * NSEG * 64 + (el >> 6); }
            float run = 0.f;
#pragma unroll 4
            for (int p = 0; p < NSEG; ++p) { const int sg = chain_seg(dir, p); const float d = base[(size_t)sg * esz], gm = gb[sg * 64]; base[(size_t)sg * esz] = run; run = fmaf(gm, run, d); }
        } else {
            const int e2 = e - N0 - N1 - N2, c = e2 >> 6, p = e2 & 63, dir = c >> 6, g = c & 15;
            const int dg = dir * 16 + g;
            const float lre = a.in[F.zz + I_LAMRE][(size_t)l * 2048 + dg * 64 + p], lim = a.in[F.zz + I_LAMIM][(size_t)l * 2048 + dg * 64 + p], dt = expf(a.in[F.zz + I_LOGDT][l * 32 + dg]);
            const float er = expf(lre * dt * 64.0f); const float sn = sinf(lim * dt * 64.0f), cs = cosf(lim * dt * 64.0f);
            const float ar = er * cs, ai = er * sn;
            float* base = ST + ST_HS + ((size_t)c * NSEG * 64 + p) * 2;
            float rr = 0.f, ri = 0.f;
#pragma unroll 4
            for (int q = 0; q < NSEG; ++q) { const int sg = chain_seg(dir, q); float* h = base + (size_t)sg * 128; const float dr = h[0], di = h[1]; h[0] = rr; h[1] = ri;
                const float nr = ar * rr - ai * ri + dr, ni = ar * ri + ai * rr + di; rr = nr; ri = ni; }
        }
    }
}
template <int MSEL>
__device__ __forceinline__ void mix_passC(const Frame& F, const Args& a, int l) {
    const MixP mp = make_mixp(F, a, l); const S5P sp = make_s5p(F, a, l);
    const float* ST = (const float*)(F.ws + WS_X2);
    LAS unsigned char* wl = F.lds + F.wave * WL_BYTES;
    LAS float* stg = (LAS float*)wl; LAS float* of = (LAS float*)(wl + 4096);
    float* OF = (float*)(F.ws + WS_OF);
    bf16* Y = (bf16*)(F.ws + WS_ACT); bf16* Z = (bf16*)(F.ws + WS_Z);
    const bool keep = l < DEPTH - 1;
    constexpr int NM = 16 * NSEG;
    if (MSEL & 1) for (int u = F.gw; u < NM; u += F.NGW) { if (!keep && (u % NSEG) < 4) continue; mixC_unit<0>(mp, ST, u, F.lane, OF, wl, Y, a.in[F.zz + I_RETGN] + l * 256); }
    if (MSEL & 2) for (int u = F.gw; u < NM; u += F.NGW) { if (!keep && (u % NSEG) < 4) continue; mixC_unit<1>(mp, ST, u, F.lane, OF, wl, Y, a.in[F.zz + I_HGNW] + l * 256); }
    if (MSEL & 4) for (int u = F.gw; u < NM; u += F.NGW) { if (!keep && (u % NSEG) < 4) continue; mixC_unit<2>(mp, ST, u, F.lane, OF, wl, Y, a.in[F.zz + I_GLANW] + l * 256); }
    if (MSEL & 8) for (int idx = F.gw; idx < 64 * NSEG; idx += F.NGW) {
        const int bg = idx / NSEG, sg = idx - bg * NSEG;
        if (!keep && sg < 4) continue;
        const float* h0 = ST + ST_HS + ((size_t)((0 * 64 + bg) * NSEG + sg) * 64 + F.lane) * 2;
        float hre = h0[0], him = h0[1];
        s5_scan<1>(sp, mp.P, bg >> 4, bg & 15, 0, sg, F.lane, hre, him, of, stg, Z);
        const float* h1 = ST + ST_HS + ((size_t)((1 * 64 + bg) * NSEG + sg) * 64 + F.lane) * 2;
        hre = h1[0]; him = h1[1];
        s5_scan<2>(sp, mp.P, bg >> 4, bg & 15, 1, sg, F.lane, hre, him, of, stg, Z);
    }
}

constexpr int NPH = 11;
template <int PH_MASK, int MSEL>
__global__ void __launch_bounds__(512, 2) mk_fwd(Args a) {
    extern __shared__ __attribute__((aligned(16))) unsigned char lds_raw[];
    Frame F;
    F.lds = (LAS unsigned char*)lds_raw;
    const int wave0 = __builtin_amdgcn_readfirstlane((int)threadIdx.x >> 6);
    F.lane = (int)__builtin_amdgcn_mbcnt_hi(~0u, __builtin_amdgcn_mbcnt_lo(~0u, 0u)); F.tid = wave0 * 64 + F.lane; F.wave = wave0;
    F.G = gridDim.x; F.gw = blockIdx.x * 8 + F.wave; F.NGW = F.G * 8; F.zz = 0; F.ws = (unsigned char*)a.in[I_WS]; F.out = (float*)a.in[I_OUT];
    volatile LAS unsigned* MISC = (volatile LAS unsigned*)(F.lds + MISC_OFF);
    for (int u = F.tid; u < 64; u += 512) ((LAS unsigned*)(F.lds + MISC_OFF))[u] = 0u;
    __syncthreads();
    XcdBarrier bar; bar.bar = (unsigned*)F.ws + CW_BAR; bar.x = 0; bar.st = nullptr;
    if (a.fused) bar = xcd_barrier_post((unsigned*)F.ws + CW_BAR, MISC + 8, F.tid);
#define SEAM() do { if (a.fused) { XcdBarrier bb = bar; asm volatile("" : "+s"(bb.bar), "+s"(bb.x)); xcd_barrier(bb, wave0 * 64 + (int)__builtin_amdgcn_mbcnt_hi(~0u, __builtin_amdgcn_mbcnt_lo(~0u, 0u))); } } while (0)
#define PHASE_BEGIN() do { int zz_ = 0; asm volatile("" : "+s"(zz_)); F.zz = zz_; F.ws = (unsigned char*)a.in[I_WS + zz_]; F.out = (float*)a.in[I_OUT + zz_]; \
        const int ln_ = (int)__builtin_amdgcn_mbcnt_hi(~0u, __builtin_amdgcn_mbcnt_lo(~0u, 0u)); const int t_ = wave0 * 64 + ln_ + zz_; F.tid = t_; F.lane = t_ & 63; F.wave = wave0 + zz_; F.G = (int)gridDim.x + zz_; F.gw = ((int)blockIdx.x + zz_) * 8 + F.wave; F.NGW = F.G * 8; \
        F.lds = (LAS unsigned char*)lds_raw + zz_; } while (0)
#define IN(k) (((PH_MASK >> (k)) & 1) && a.ph_lo <= (k) && (k) < a.ph_hi)
#define hb ((float*)(F.ws + WS_HB))
#define MOD ((const float*)(F.ws + WS_MOD))
#define ACT ((bf16*)(F.ws + WS_ACT))
#define PH ((bf16*)(F.ws + WS_PH))

    if (((PH_MASK >> 12) & 1) && a.do_pro) { PHASE_BEGIN(); prologue(F, a); SEAM(); }

#pragma unroll
    for (int l = 0; l < DEPTH; ++l) {
        if (l < a.l_lo || l >= a.l_hi) continue;
        const bool keep = l < DEPTH - 1, moe = l & 1; const int j = l >> 1;
        const int Mrows = keep ? MT : NLAT;
        if (IN(0)) { PHASE_BEGIN();
            norm_phase<0>(F, a, l, 0, MT, (l == 2) ? 1 : -1);
            if (l == 2) { __syncthreads(); moe_cvt(F, a, 1); }
            SEAM();
        }
        if (IN(1)) { PHASE_BEGIN();
            pg8::Gemm g{ACT, (const bf16*)(F.ws + WS_WIN) + (size_t)l * DINP * 1024, MT, DINP, 1024}; pg8::StaticOrder S; S.init(MT, DINP, F.G, (int)blockIdx.x);
            EpiStoreBf16 E{PH, DINP};
            pg8::gemm_phase<EpiStoreBf16, pg8::StaticOrder, true, false>(F.lds, g, S, E, F.tid);
            SEAM();
        }
        if (IN(2)) { PHASE_BEGIN(); mix_passA<MSEL>(F, a, l); SEAM(); }
#ifdef DUP_MIX
        if (IN(2)) { PHASE_BEGIN(); mix_passA<MSEL>(F, a, l); SEAM(); }
#endif
        if (IN(3)) { PHASE_BEGIN(); mix_passB(F, a, l); SEAM(); }
        if (IN(4)) { PHASE_BEGIN(); mix_passC<MSEL>(F, a, l); SEAM(); }
#ifdef DUP_MIX
        if (IN(4)) { PHASE_BEGIN(); mix_passC<MSEL>(F, a, l); SEAM(); }
#endif
        if (IN(5)) { PHASE_BEGIN();
            int k256 = 256; asm volatile("" : "+s"(k256)); pg8::Gemm g{(const bf16*)(F.ws + WS_Z), (const bf16*)(F.ws + WS_GLUW) + (size_t)l * 65536, Mrows, 256, k256}; pg8::StaticOrder S; S.init(Mrows, 256, F.G, (int)blockIdx.x);
            EpiGlu E{(const bf16*)(F.ws + WS_Z), ACT, a.in[F.zz + I_GLUB] + l * 256};
            pg8::gemm_phase<EpiGlu, pg8::StaticOrder, true, false>(F.lds, g, S, E, F.tid);
            SEAM();
        }
        if (IN(6)) { PHASE_BEGIN();
            pg8::Gemm g{ACT, (const bf16*)(F.ws + WS_WOUT) + (size_t)l * 1024 * 1024, Mrows, 1024, 1024}; pg8::StaticOrder S; S.init(Mrows, 1024, F.G, (int)blockIdx.x);
            EpiResid E{(l == 0) ? a.in[F.zz + I_X] : F.out, (l == 0) ? a.in[F.zz + I_CTX] : hb, F.out, hb, MOD + (size_t)l * 5 * 6144 + 2 * 1024};
            pg8::gemm_phase<EpiResid, pg8::StaticOrder, true, false>(F.lds, g, S, E, F.tid);
            SEAM();
        }
        if (IN(7)) { PHASE_BEGIN();
            if (moe) norm_phase<1>(F, a, l, 1, Mrows, -1); else norm_phase<0>(F, a, l, 1, Mrows, -1);
            SEAM();
        }
        if (!moe) {
            if (IN(8)) { PHASE_BEGIN();
                pg8::Gemm g{ACT, (const bf16*)(F.ws + WS_W13D) + (size_t)j * 5632 * 1024, Mrows, 5632, 1024}; pg8::StaticOrder S; S.init(Mrows, 5632, F.G, (int)blockIdx.x);
                EpiSwiglu E{PH};
                pg8::gemm_phase<EpiSwiglu, pg8::StaticOrder, true, false>(F.lds, g, S, E, F.tid);
                SEAM();
            }
            if (IN(9)) { PHASE_BEGIN();
                pg8::Gemm g{PH, (const bf16*)(F.ws + WS_W2D) + (size_t)j * 1024 * DFF, Mrows, 1024, DFF}; pg8::StaticOrder S; S.init(Mrows, 1024, F.G, (int)blockIdx.x);
                EpiResid E{F.out, hb, F.out, hb, MOD + (size_t)l * 5 * 6144 + 5 * 1024};
                pg8::gemm_phase<EpiResid, pg8::StaticOrder, true, false>(F.lds, g, S, E, F.tid);
                SEAM();
            }
        } else {
                        if (IN(8)) { PHASE_BEGIN(); moe_gather(F, j); SEAM(); }
            if (IN(9)) { PHASE_BEGIN();
                pg8::Gemm g{(const bf16*)(F.ws + WS_X2), (const bf16*)(F.ws + WS_W13M), 0, 5632, 1024}; MoeOrder S; S.init((const unsigned*)F.ws + CW_CNT + j * 8 * 64, 22, F.G, (int)blockIdx.x);
                EpiSwiglu E{PH};
                pg8::gemm_phase<EpiSwiglu, MoeOrder, true, false>(F.lds, g, S, E, F.tid);
                SEAM();
            }
            if (IN(10)) { PHASE_BEGIN();
                pg8::Gemm g{PH, (const bf16*)(F.ws + WS_W2M), 0, 1024, DFF}; MoeOrder S; S.init((const unsigned*)F.ws + CW_CNT + j * 8 * 64, 4, F.G, (int)blockIdx.x);
                EpiStoreBf16 E{(bf16*)(F.ws + WS_X2), 1024};
                pg8::gemm_phase<EpiStoreBf16, MoeOrder, true, false>(F.lds, g, S, E, F.tid);
                SEAM();
            }
        }
    }
    if (((PH_MASK >> 13) & 1) && a.do_fin) { PHASE_BEGIN(); norm_phase<2>(F, a, DEPTH - 1, 0, NLAT, DEPTH - 1); }
#undef SEAM
#undef IN
#undef hb
#undef MOD
#undef ACT
#undef PH
}

#ifndef MK_FUSED
#define MK_FUSED 1
#endif
template <int PM, int MS> static void launch_one(const Args& a, int grid, hipStream_t stream) {
    static bool attr_done = false;
    if (!attr_done) { (void)hipFuncSetAttribute((const void*)mk_fwd<PM, MS>, hipFuncAttributeMaxDynamicSharedMemorySize, LDS_BYTES); attr_done = true; }
    hipLaunchKernelGGL((mk_fwd<PM, MS>), dim3(grid), dim3(512), LDS_BYTES, stream, a);
}
extern "C" void kernel_launch(void* const* d_in, const int* in_sizes, int n_in, void* d_out, int out_size, void* d_ws, size_t ws_size, hipStream_t stream) {
    static int grid = 0;
    if (grid == 0) {
        if (n_in != 35 || in_sizes[0] != NLAT * DM || out_size != NLAT * DM || ws_size < WS_END) {
            fprintf(stderr, "kernel_launch: unexpected shapes / workspace (n_in %d, ws %zu, need %zu); nothing launched\n", n_in, ws_size, (size_t)WS_END); grid = -1; return; }
        int dev = 0, cus = 0;
        if (hipGetDevice(&dev) != hipSuccess || hipDeviceGetAttribute(&cus, hipDeviceAttributeMultiprocessorCount, dev) != hipSuccess) { grid = -1; return; }
        grid = cus;
    }
    if (grid < 0) return;
    (void)hipMemsetAsync((char*)d_ws + WS_CTL, 0, CTL_ZERO_BYTES, stream);
    Args a{};
    for (int i = 0; i < 35; ++i) a.in[i] = (const float*)d_in[i];
    a.in[I_OUT] = (const float*)d_out; a.in[I_WS] = (const float*)d_ws; a.pad = 0;
#if MK_FUSED
    a.l_lo = 0; a.l_hi = DEPTH; a.ph_lo = 0; a.ph_hi = NPH; a.do_pro = 1; a.do_fin = 1; a.fused = 1;
#ifndef TEST_PM
#define TEST_PM 0xFFFF
#endif
#ifndef TEST_MS
#define TEST_MS 15
#endif
    launch_one<TEST_PM, TEST_MS>(a, grid, stream);
#else
    a.fused = 0;
    a.l_lo = 0; a.l_hi = 0; a.ph_lo = 0; a.ph_hi = 0; a.do_pro = 1; a.do_fin = 0;
    launch_one<0x1000, 15>(a, grid, stream);
    a.do_pro = 0;
    for (int l = 0; l < DEPTH; ++l) {
        a.l_lo = l; a.l_hi = l + 1; a.ph_lo = 0; a.ph_hi = NPH;
        launch_one<0x1, 15>(a, grid, stream); launch_one<0x2, 15>(a, grid, stream); launch_one<0x4, 15>(a, grid, stream); launch_one<0x8, 15>(a, grid, stream);
        launch_one<0x10, 1>(a, grid, stream); launch_one<0x10, 2>(a, grid, stream); launch_one<0x10, 4>(a, grid, stream); launch_one<0x10, 8>(a, grid, stream);
        launch_one<0x20, 15>(a, grid, stream); launch_one<0x40, 15>(a, grid, stream); launch_one<0x80, 15>(a, grid, stream);
        launch_one<0x100, 15>(a, grid, stream); launch_one<0x200, 15>(a, grid, stream);
        if (l & 1) launch_one<0x400, 15>(a, grid, stream);
    }
    a.l_lo = 0; a.l_hi = 0; a.ph_lo = 0; a.ph_hi = 0; a.do_fin = 1;
    launch_one<0x2000, 15>(a, grid, stream);
#endif
}
```

```cpp
#include <hip/hip_runtime.h>
#include <cstdio>
#include <cstdint>
#define LAS __attribute__((address_space(3)))
namespace pg8 {
#define PG8_LAS __attribute__((address_space(3)))
typedef unsigned short bf16_t;
typedef short bf16x8 __attribute__((ext_vector_type(8)));
typedef float f32x4 __attribute__((ext_vector_type(4)));
typedef unsigned u32x4 __attribute__((ext_vector_type(4)));
constexpr int BM = 256, BK = 64, HALF = 128, HTB = HALF * BK * 2  , STAGE_BYTES = 8 * HTB, NXCD = 8, WGM = 8;

__host__ __device__ __forceinline__ int lds_byte(int r, int c) { const int st = (r >> 4) * 2 + (c >> 5), rr = r & 15, cc = c & 31, ob = rr * 64 + cc * 2; return st * 1024 + (ob ^ (((ob >> 9) & 1) << 5)); }
__host__ __device__ __forceinline__ void stage_rc(int b, int& R, int& C) { const int st = b / 1024, sb = b % 1024, swz = sb ^ (((sb >> 9) & 1) << 5); R = (st >> 1) * 16 + swz / 64; C = (st & 1) * 32 + (swz % 64) / 2; }
__host__ __device__ __forceinline__ int perm32(int rho) { const int n = rho >> 4, i = rho & 15; return 8 * (i >> 2) + 4 * n + (i & 3); }

struct Unit { int pm, pn, pc; };
struct Gemm { const bf16_t* A; const bf16_t* Bt; int M, N, K; };

struct StaticOrder {
    int nM, nN, nwg, G, c;
    __host__ __device__ void init(int M, int N, int G_, int c_) { nM = M / BM; nN = N / BM; nwg = nM * nN; G = G_; c = c_; }
    __host__ __device__ bool next(int i, Unit& u) const {
        const long L = (long)i * G + c; if (L >= nwg) return false;
        int wgid = (int)L; { const int q = nwg / NXCD, r = nwg % NXCD, xcd = wgid % NXCD, off = wgid / NXCD; wgid = (xcd < r ? xcd * (q + 1) : r * (q + 1) + (xcd - r) * q) + off; }
        const int nig = WGM * nN, gid = wgid / nig, fm = gid * WGM, gsz = (nM - fm) < WGM ? (nM - fm) : WGM;
        u.pm = fm + ((wgid % nig) % gsz); u.pn = (wgid % nig) / gsz; u.pc = u.pn; return true;
    }
    __device__ __forceinline__ void a_ready(const Unit&) const {}
    __device__ __forceinline__ void done(const Unit&) const {}
};

__device__ __forceinline__ unsigned cvt_pk_bf16(float lo, float hi) { unsigned r; asm volatile("v_cvt_pk_bf16_f32 %0, %1, %2" : "=v"(r) : "v"(lo), "v"(hi)); return r; }
typedef float f32x2 __attribute__((ext_vector_type(2)));

template <class Epi, class Sched, bool ALIGN_EPI = false, bool SP2 = false>
__device__ __forceinline__ void gemm_phase(PG8_LAS unsigned char* lds, const Gemm g, const Sched& S, const Epi& E, const int tid) {
    const int wid = __builtin_amdgcn_readfirstlane(tid >> 6), lane = tid & 63, wr = wid >> 2, wc = wid & 3, fr = lane & 15, fq = lane >> 4;
    const int K = g.K, nt = K / BK;
    unsigned voffA[2], voffB[2];
#pragma unroll
    for (int i = 0; i < 2; ++i) { int R, C; stage_rc(tid * 16 + i * 8192, R, C); const int Rb = Epi::PERM ? ((R & ~31) + perm32(R & 31)) : R;
        voffA[i] = (unsigned)(R * K + C) * 2u; voffB[i] = (unsigned)(Rb * K + C) * 2u; }
    const size_t kstep = (size_t)(BK * 2);
    const size_t hstep = (size_t)HALF * K * 2;
    const size_t tstep = 2 * hstep;
    const unsigned ldsw = (unsigned)wid * 1024u;
    const int aoff = lds_byte(wr * 64 + fr, fq * 8), boff = lds_byte(wc * 32 + fr, fq * 8);
#define PG8_SA(b, h) (((b) * 2 + (h)) * HTB)
#define PG8_SB(b, h) ((4 + (b) * 2 + (h)) * HTB)
#define PG8_STAGE(bufoff, gbase, voff) do { _Pragma("unroll") for (int _i = 0; _i < 2; ++_i) \
        __builtin_amdgcn_global_load_lds((const unsigned*)((const char*)(gbase) + (voff)[_i]), (PG8_LAS unsigned*)(lds + (bufoff) + ldsw + _i * 8192), 16, 0, 0); } while (0)
#define PG8_LDA(dst, b, h) do { _Pragma("unroll") for (int m = 0; m < 4; ++m) _Pragma("unroll") for (int k = 0; k < 2; ++k) dst[m][k] = *(const PG8_LAS bf16x8*)(lds + PG8_SA(b, h) + aoff + m * 2048 + k * 1024); } while (0)
#define PG8_LDB(dst, b, h) do { _Pragma("unroll") for (int n = 0; n < 2; ++n) _Pragma("unroll") for (int k = 0; k < 2; ++k) dst[n][k] = *(const PG8_LAS bf16x8*)(lds + PG8_SB(b, h) + boff + n * 2048 + k * 1024); } while (0)
#define PG8_MMA(ai, bj, At, Bt) do { __builtin_amdgcn_s_setprio(1); _Pragma("unroll") for (int m = 0; m < 4; ++m) _Pragma("unroll") for (int n = 0; n < 2; ++n) _Pragma("unroll") for (int k = 0; k < 2; ++k) \
        acc[ai][bj][m][n] = __builtin_amdgcn_mfma_f32_16x16x32_bf16(Bt[n][k], At[m][k], acc[ai][bj][m][n], 0, 0, 0); __builtin_amdgcn_s_setprio(0); } while (0)
#define PG8_WAIT_V(n) asm volatile("s_waitcnt vmcnt(" #n ")" ::: "memory")
#define PG8_WAIT_L(n) asm volatile("s_waitcnt lgkmcnt(" #n ")" ::: "memory")
#define PG8_BAR __builtin_amdgcn_s_barrier()
#define PG8_SCHED __builtin_amdgcn_sched_barrier(0)
    Unit cur, nxt; int ui = 0;
    if (!S.next(0, cur)) return;
    f32x4 acc[2][2][4][2];
#pragma unroll
    for (int a = 0; a < 2; ++a)
#pragma unroll
        for (int b = 0; b < 2; ++b)
#pragma unroll
            for (int m = 0; m < 4; ++m)
#pragma unroll
                for (int n = 0; n < 2; ++n) acc[a][b][m][n] = (f32x4){0.f, 0.f, 0.f, 0.f};
    bf16x8 At[4][2], B0[2][2], B1[2][2];
    const char* cA = (const char*)g.A + (size_t)cur.pm * tstep; const char* cB = (const char*)g.Bt + (size_t)cur.pn * tstep;
    S.a_ready(cur);
    if constexpr (SP2) {
        PG8_STAGE(PG8_SB(0, 0), cB, voffB); PG8_STAGE(PG8_SB(0, 1), cB + hstep, voffB); PG8_STAGE(PG8_SA(0, 0), cA, voffA); PG8_STAGE(PG8_SA(0, 1), cA + hstep, voffA);
        if (wr == 1) PG8_BAR;
        PG8_WAIT_V(2); PG8_BAR;
        PG8_STAGE(PG8_SB(1, 0), cB + kstep, voffB); PG8_STAGE(PG8_SA(1, 0), cA + kstep, voffA); PG8_STAGE(PG8_SB(1, 1), cB + hstep + kstep, voffB);
        PG8_WAIT_V(6); PG8_BAR;
    } else {
        PG8_STAGE(PG8_SB(0, 0), cB, voffB); PG8_STAGE(PG8_SA(0, 0), cA, voffA); PG8_STAGE(PG8_SB(0, 1), cB + hstep, voffB); PG8_STAGE(PG8_SA(0, 1), cA + hstep, voffA);
        if (wr == 1) PG8_BAR;
        PG8_WAIT_V(4); PG8_BAR;
        PG8_STAGE(PG8_SB(1, 0), cB + kstep, voffB); PG8_STAGE(PG8_SA(1, 0), cA + kstep, voffA); PG8_STAGE(PG8_SB(1, 1), cB + hstep + kstep, voffB);
        PG8_WAIT_V(6); PG8_BAR;
    }
    for (;;) {
        const bool has_next = S.next(ui + 1, nxt);
        const char* nA = has_next ? (const char*)g.A + (size_t)nxt.pm * tstep : cA; const char* nB = has_next ? (const char*)g.Bt + (size_t)nxt.pn * tstep : cB;
        for (int t = 0; t < nt; t += 2) {
            const bool last = (t == nt - 2);
            const char* a1 = cA + (size_t)(t + 1) * kstep;
            const char* a2 = last ? nA : cA + (size_t)(t + 2) * kstep; const char* b2 = last ? nB : cB + (size_t)(t + 2) * kstep;
            const char* a3 = a2 + kstep; const char* b3 = b2 + kstep;
            if (last && has_next) S.a_ready(nxt);
            if constexpr (SP2) {
            PG8_LDB(B0, 0, 0); PG8_LDB(B1, 0, 1); PG8_SCHED; PG8_LDA(At, 0, 0); PG8_STAGE(PG8_SA(1, 1), a1 + hstep, voffA);
            PG8_WAIT_V(8); PG8_WAIT_L(0); PG8_BAR; PG8_MMA(0, 0, At, B0); PG8_MMA(0, 1, At, B1); PG8_BAR; PG8_SCHED;
            PG8_LDA(At, 0, 1); PG8_STAGE(PG8_SB(0, 0), b2, voffB); PG8_STAGE(PG8_SB(0, 1), b2 + hstep, voffB); PG8_STAGE(PG8_SA(0, 0), a2, voffA);
            PG8_WAIT_V(8); PG8_WAIT_L(0); PG8_BAR; PG8_MMA(1, 0, At, B0); PG8_MMA(1, 1, At, B1); PG8_BAR; PG8_SCHED;
            PG8_LDB(B0, 1, 0); PG8_LDB(B1, 1, 1); PG8_SCHED; PG8_LDA(At, 1, 0); PG8_STAGE(PG8_SA(0, 1), a2 + hstep, voffA);
            PG8_WAIT_V(8); PG8_WAIT_L(0); PG8_BAR; PG8_MMA(0, 0, At, B0); PG8_MMA(0, 1, At, B1); PG8_BAR; PG8_SCHED;
            PG8_LDA(At, 1, 1); PG8_STAGE(PG8_SB(1, 0), b3, voffB); PG8_STAGE(PG8_SB(1, 1), b3 + hstep, voffB); PG8_STAGE(PG8_SA(1, 0), a3, voffA);
            PG8_WAIT_V(8); PG8_WAIT_L(0); PG8_BAR; PG8_MMA(1, 0, At, B0); PG8_MMA(1, 1, At, B1); PG8_BAR; PG8_SCHED;
            } else {
            PG8_LDB(B0, 0, 0); PG8_SCHED; PG8_LDA(At, 0, 0); PG8_STAGE(PG8_SA(1, 1), a1 + hstep, voffA);
            PG8_WAIT_L(8); PG8_BAR; PG8_WAIT_L(0); PG8_MMA(0, 0, At, B0); PG8_BAR; PG8_SCHED;
            PG8_LDB(B1, 0, 1); PG8_STAGE(PG8_SB(0, 0), b2, voffB);
            PG8_BAR; PG8_WAIT_L(0); PG8_MMA(0, 1, At, B1); PG8_BAR;
            PG8_LDA(At, 0, 1); PG8_STAGE(PG8_SA(0, 0), a2, voffA);
            PG8_BAR; PG8_WAIT_L(0); PG8_MMA(1, 0, At, B0); PG8_BAR; PG8_SCHED;
            PG8_STAGE(PG8_SB(0, 1), b2 + hstep, voffB);
            PG8_WAIT_V(6); PG8_BAR; PG8_MMA(1, 1, At, B1); PG8_BAR;
            PG8_LDB(B0, 1, 0); PG8_SCHED; PG8_LDA(At, 1, 0); PG8_STAGE(PG8_SA(0, 1), a2 + hstep, voffA);
            PG8_WAIT_L(8); PG8_BAR; PG8_WAIT_L(0); PG8_MMA(0, 0, At, B0); PG8_BAR; PG8_SCHED;
            PG8_LDB(B1, 1, 1); PG8_STAGE(PG8_SB(1, 0), b3, voffB);
            PG8_BAR; PG8_WAIT_L(0); PG8_MMA(0, 1, At, B1); PG8_BAR;
            PG8_LDA(At, 1, 1); PG8_STAGE(PG8_SA(1, 0), a3, voffA);
            PG8_BAR; PG8_WAIT_L(0); PG8_MMA(1, 0, At, B0); PG8_BAR; PG8_SCHED;
            PG8_STAGE(PG8_SB(1, 1), b3 + hstep, voffB);
            PG8_WAIT_V(6); PG8_BAR; PG8_MMA(1, 1, At, B1); PG8_BAR;
            }
        }
        if constexpr (ALIGN_EPI) { if (wr == 0) PG8_BAR; }
        if constexpr (!Epi::AFTER_DRAIN) { E(acc, cur, wr, wc, fr, fq); S.done(cur); }
        if (!has_next) break;
#pragma unroll
        for (int a = 0; a < 2; ++a)
#pragma unroll
            for (int b = 0; b < 2; ++b)
#pragma unroll
                for (int m = 0; m < 4; ++m)
#pragma unroll
                    for (int n = 0; n < 2; ++n) acc[a][b][m][n] = (f32x4){0.f, 0.f, 0.f, 0.f};
        cur = nxt; cA = nA; cB = nB; ++ui;
        if constexpr (ALIGN_EPI) { if (wr == 1) PG8_BAR; }
    }
    PG8_WAIT_V(0);
    if constexpr (!ALIGN_EPI) { if (wr == 0) PG8_BAR; }
    PG8_BAR;
    if constexpr (Epi::AFTER_DRAIN) { E.fused(acc, cur, wr, wc, fr, fq, lds, wid, lane); S.done(cur); }
#undef PG8_SA
#undef PG8_SB
#undef PG8_STAGE
#undef PG8_LDA
#undef PG8_LDB
#undef PG8_MMA
#undef PG8_WAIT_V
#undef PG8_WAIT_L
#undef PG8_BAR
#undef PG8_SCHED
}
}

#define XB_TMO      128
#define XB_XCNT(j)  (256  + 64 * (j))
#define XB_XSUB(j)  (1280 + 64 * (j))
#define XB_XGEN(j)  (2304 + 64 * (j))
#define XB_TOP      3328
#define XB_TOPGEN   3392
#define XCD_BAR_WORDS 3456
#define XB_SPIN_CAP (1u << 18)

__device__ __forceinline__ unsigned xb_ld(unsigned* p)              { return __hip_atomic_load(p, __ATOMIC_RELAXED, __HIP_MEMORY_SCOPE_AGENT); }
__device__ __forceinline__ unsigned xb_add(unsigned* p, unsigned v) { return __hip_atomic_fetch_add(p, v, __ATOMIC_RELAXED, __HIP_MEMORY_SCOPE_AGENT); }
__device__ __forceinline__ unsigned xb_xcc_id() { return (unsigned)__builtin_amdgcn_s_getreg((3 << 11) | 20) & 0xFu; }
#define XB_SPIN(cond, bar) do { unsigned _sp = 0; while (cond) { __builtin_amdgcn_s_sleep(1); \
    if ((++_sp & 255u) == 0u) { if (xb_ld(&(bar)[XB_TMO])) break; if (_sp > XB_SPIN_CAP) { atomicAdd(&(bar)[XB_TMO], 1u); break; } } } } while (0)

struct XcdBarrier {
    unsigned* bar; unsigned x;
    volatile LAS unsigned* st;
};

__device__ __forceinline__ XcdBarrier xcd_barrier_post(unsigned* bar, volatile LAS unsigned* st, const int xb_tid) {
    XcdBarrier b; b.bar = bar; b.x = xb_xcc_id(); b.st = st;
    if (xb_tid == 0) (void)xb_add(&bar[XB_XCNT(b.x)], 1u);
    return b;
}
__device__ __forceinline__ void xcd_barrier_complete(unsigned* bar, unsigned x, unsigned& nloc, unsigned& nx) {
    const unsigned G = gridDim.x * gridDim.y * gridDim.z;
    unsigned sum, cnt, mine, sp = 0u;
    for (;;) {
        sum = 0u; cnt = 0u; mine = 0u;
#pragma unroll
        for (unsigned j = 0; j < 16; ++j) { const unsigned c = xb_ld(&bar[XB_XCNT(j)]); sum += c; cnt += (c > 0u) ? 1u : 0u; mine = (j == x) ? c : mine; }
        if (sum == G) break;
        __builtin_amdgcn_s_sleep(1);
        if ((++sp & 255u) == 0u) { if (xb_ld(&bar[XB_TMO])) break; if (sp > XB_SPIN_CAP) { atomicAdd(&bar[XB_TMO], 1u); break; } }
    }
    nloc = mine > 0u ? mine : 1u; nx = cnt > 0u ? cnt : 1u;
}

__device__ __forceinline__ void xcd_barrier(const XcdBarrier& b, const int xb_tid) {
    asm volatile("s_waitcnt vmcnt(0)" ::: "memory");
    __syncthreads();
    if (xb_tid == 0) {
        unsigned* bar = b.bar;
        __builtin_amdgcn_s_waitcnt(0);
        unsigned nloc = b.st[0], nx = b.st[1];
        if (nloc == 0u) { xcd_barrier_complete(bar, b.x, nloc, nx); b.st[0] = nloc; b.st[1] = nx; }
        const unsigned old = xb_add(&bar[XB_XSUB(b.x)], 1u);
        const unsigned gen = old / nloc;
        if (old + 1u == (gen + 1u) * nloc) {
            __builtin_amdgcn_fence(__ATOMIC_RELEASE, "agent");
            asm volatile("s_waitcnt vmcnt(0)" ::: "memory");
            const unsigned og = xb_add(&bar[XB_TOP], 1u);
            const unsigned tg = og / nx;
            if (og + 1u == (tg + 1u) * nx) xb_add(&bar[XB_TOPGEN], 1u);
            else XB_SPIN(xb_ld(&bar[XB_TOPGEN]) == tg, bar);
            __builtin_amdgcn_fence(__ATOMIC_ACQUIRE, "agent");
            xb_add(&bar[XB_XGEN(b.x)], 1u);
            asm volatile("s_waitcnt vmcnt(0)" ::: "memory");
        } else {
            XB_SPIN(xb_ld(&bar[XB_XGEN(b.x)]) == gen, bar);
            __builtin_amdgcn_fence(__ATOMIC_ACQUIRE, "agent");
            asm volatile("s_waitcnt vmcnt(0)" ::: "memory");
        }
    }
    __syncthreads();
}

#define GAS __attribute__((address_space(1)))
typedef unsigned short bf16;
typedef unsigned v4u __attribute__((ext_vector_type(4)));
typedef unsigned v2u __attribute__((ext_vector_type(2)));
typedef float f32x4 __attribute__((ext_vector_type(4)));

constexpr int NB = 4, SEQ = 8192, DM = 1024, DEPTH = 4, CTXL = 256;
constexpr int NLAT = NB * SEQ, NCTX = NB * CTXL, MT = NLAT + NCTX;
constexpr int DIN = 3360, DINP = 3584, DFF = 2816, NEXP = 8;
constexpr int C_RQ = 0, C_RK = 256, C_RV = 512, C_RG = 768, C_S5 = 1024, C_HQ = 1280, C_HFF = 1536, C_HFB = 1792, C_HI = 2048, C_HG = 2304,
              C_GQ = 2560, C_GK = 2688, C_GV = 2816, C_GG = 3072, C_GAF = 3328, C_GAB = 3344,
              C_GZF = 3328, C_GZB = 3456;
constexpr int NSEG = 132;
constexpr int MOE_CAP_TILES = 272;
constexpr float NEPS = 1e-6f;

constexpr size_t MiB = 1u << 20;
constexpr size_t WS_CTL = 0, CTL_ZERO_BYTES = 2 * MiB;
constexpr size_t WS_MOD = 2 * MiB;
constexpr size_t WS_LB = 3 * MiB;
constexpr size_t WS_ROPE = 3 * MiB + 65536;
constexpr size_t WS_GLUW = 3 * MiB + 131072;
constexpr size_t WS_WIN = 4 * MiB;
constexpr size_t WS_WOUT = 32 * MiB;
constexpr size_t WS_W13D = 40 * MiB;
constexpr size_t WS_W2D = 62 * MiB;
constexpr size_t WS_W13M = 73 * MiB;
constexpr size_t WS_W2M = 161 * MiB;
constexpr size_t WS_HB = 205 * MiB;
constexpr size_t WS_ACT = 209 * MiB;
constexpr size_t WS_Z = 275 * MiB;
constexpr size_t WS_PH = 292 * MiB;
constexpr size_t WS_OF = (292 + 232) * MiB;
constexpr size_t WS_X2 = 666 * MiB;
constexpr size_t WS_LIST = 843 * MiB;
constexpr size_t WS_END = 846 * MiB;
constexpr size_t ST_DS0 = 0;
constexpr size_t ST_DS1 = ST_DS0 + (size_t)2 * 16 * NSEG * 4096;
constexpr size_t ST_DS2 = ST_DS1 + (size_t)2 * 16 * NSEG * 4096;
constexpr size_t ST_G0 = ST_DS2 + (size_t)2 * 16 * NSEG * 2048;
constexpr size_t ST_G1 = ST_G0 + (size_t)2 * 16 * NSEG * 64;
constexpr size_t ST_G2 = ST_G1 + (size_t)2 * 16 * NSEG * 64;
constexpr size_t ST_HS = ST_G2 + (size_t)2 * 16 * NSEG * 64;
constexpr size_t ST_END = ST_HS + (size_t)2 * 64 * NSEG * 128;
static_assert(ST_END * 4 <= (WS_LIST - WS_X2), "state region");
static_assert(WS_PH + (size_t)MT * DINP * 2 <= WS_OF && WS_OF + (size_t)MT * 768 * 4 <= WS_X2, "OF region");
static_assert((size_t)MOE_CAP_TILES * 256 * 1024 * 2 <= (WS_LIST - WS_X2), "XB region");
static_assert((size_t)MOE_CAP_TILES * 256 * DFF * 2 <= (WS_X2 - WS_PH) && (size_t)MT * DINP * 2 <= (WS_X2 - WS_PH), "P/H region");
constexpr int CW_BAR = 4096;
constexpr int CW_CNT = 16384;

constexpr int LDS_BYTES = 163840;
constexpr int MISC_OFF = 163840 - 512;

__device__ __forceinline__ float bf2f(unsigned short h) { return __uint_as_float(((unsigned)h) << 16); }
__device__ __forceinline__ unsigned f2bf(float f) { unsigned u = __float_as_uint(f); return (u + 0x7fffu + ((u >> 16) & 1u)) >> 16; }
__device__ __forceinline__ unsigned pk2(float lo, float hi) { return f2bf(lo) | (f2bf(hi) << 16); }
__device__ __forceinline__ float wave_sum(float v) {
#pragma unroll
    for (int o = 1; o < 64; o <<= 1) v += __shfl_xor(v, o);
    return v;
}
__device__ __forceinline__ float rdl(float v, int k) { return __uint_as_float((unsigned)__builtin_amdgcn_readlane((int)__float_as_uint(v), k)); }
__device__ __forceinline__ float sigm(float x) { return 1.0f / (1.0f + __expf(-x)); }
__device__ __forceinline__ float silu_f(float x) { return x / (1.0f + __expf(-x)); }
#define LDS_WAIT() asm volatile("s_waitcnt lgkmcnt(0)" ::: "memory")

struct Args {
    const float* in[37];
    int l_lo, l_hi, ph_lo, ph_hi, do_pro, do_fin, fused, pad;
};
constexpr int I_OUT = 35, I_WS = 36;
enum { I_X = 0, I_C, I_CTX, I_CCTX, I_ADAW, I_ADAB, I_N1W, I_N2W, I_WIN, I_WOUT, I_RETGN, I_LAMRE, I_LAMIM, I_LOGDT, I_BRE, I_BIM, I_CRE, I_CIM, I_S5D,
       I_GLUW, I_GLUB, I_LBL, I_HGNW, I_WA2, I_BA, I_GLANW, I_FW1, I_FW3, I_FW2, I_RW, I_RB, I_MW1, I_MW3, I_MW2, I_FINW };

struct Frame {
    LAS unsigned char* lds;
    int tid, lane, wave, gw, NGW, G, zz;
    unsigned char* ws; float* out;
};

struct EpiStoreBf16 {
    static constexpr bool PERM = true, AFTER_DRAIN = false;
    bf16* O; int ldc;
    __device__ __forceinline__ void operator()(const pg8::f32x4 (&acc)[2][2][4][2], const pg8::Unit& u, int wr, int wc, int fr, int fq) const {
        const int row0 = u.pm * 256 + wr * 64 + fr, col0 = u.pc * 256 + wc * 32 + 8 * fq;
#pragma unroll
        for (int ai = 0; ai < 2; ++ai)
#pragma unroll
            for (int m = 0; m < 4; ++m) { bf16* rowp = O + (size_t)(row0 + ai * 128 + m * 16) * ldc + col0;
#pragma unroll
                for (int bj = 0; bj < 2; ++bj) { const pg8::f32x4 v0 = acc[ai][bj][m][0], v1 = acc[ai][bj][m][1];
                    pg8::u32x4 w; w.x = pg8::cvt_pk_bf16(v0[0], v0[1]); w.y = pg8::cvt_pk_bf16(v0[2], v0[3]); w.z = pg8::cvt_pk_bf16(v1[0], v1[1]); w.w = pg8::cvt_pk_bf16(v1[2], v1[3]);
                    *(pg8::u32x4*)(rowp + bj * 128) = w; } }
    }
};
struct EpiSwiglu {
    static constexpr bool PERM = true, AFTER_DRAIN = false;
    bf16* H;
    __device__ __forceinline__ void operator()(const pg8::f32x4 (&acc)[2][2][4][2], const pg8::Unit& u, int wr, int wc, int fr, int fq) const {
        const int row0 = u.pm * 256 + wr * 64 + fr, col0 = u.pc * 128 + wc * 32 + 8 * fq;
#pragma unroll
        for (int ai = 0; ai < 2; ++ai)
#pragma unroll
            for (int m = 0; m < 4; ++m) { bf16* rowp = H + (size_t)(row0 + ai * 128 + m * 16) * DFF + col0;
                float h[8];
#pragma unroll
                for (int n = 0; n < 2; ++n)
#pragma unroll
                    for (int j = 0; j < 4; ++j) { const float a = acc[ai][0][m][n][j], b = acc[ai][1][m][n][j];
                        h[n * 4 + j] = a * __builtin_amdgcn_rcpf(1.0f + __builtin_amdgcn_exp2f(-1.4426950408889634f * a)) * b; }
                pg8::u32x4 w; w.x = pg8::cvt_pk_bf16(h[0], h[1]); w.y = pg8::cvt_pk_bf16(h[2], h[3]); w.z = pg8::cvt_pk_bf16(h[4], h[5]); w.w = pg8::cvt_pk_bf16(h[6], h[7]);
                *(pg8::u32x4*)rowp = w; }
    }
};
struct EpiResid {
    static constexpr bool PERM = false, AFTER_DRAIN = false;
    const float* xin_lat; const float* xin_ctx; float* xout_lat; float* xout_ctx; const float* gate;
    __device__ __forceinline__ void operator()(const pg8::f32x4 (&acc)[2][2][4][2], const pg8::Unit& u, int wr, int wc, int fr, int fq) const {
        const bool isctx = u.pm >= 128; const int bidx = isctx ? 4 : (u.pm >> 5);
        const size_t rbase = (size_t)(isctx ? (u.pm - 128) : u.pm) * 256 + wr * 64 + fr;
        const float* xi = (isctx ? xin_ctx : xin_lat); float* xo = (isctx ? xout_ctx : xout_lat);
        const int col0 = u.pc * 256 + wc * 32 + 4 * fq; const float* g = gate + (size_t)bidx * 6144 + col0;
        pg8::f32x4 gv[2][2];
#pragma unroll
        for (int bj = 0; bj < 2; ++bj)
#pragma unroll
            for (int n = 0; n < 2; ++n) gv[bj][n] = *(const pg8::f32x4*)(g + bj * 128 + n * 16);
#pragma unroll
        for (int ai = 0; ai < 2; ++ai)
#pragma unroll
            for (int m = 0; m < 4; ++m) { const size_t off = (rbase + ai * 128 + m * 16) * 1024 + col0;
#pragma unroll
                for (int bj = 0; bj < 2; ++bj)
#pragma unroll
                    for (int n = 0; n < 2; ++n) { const pg8::f32x4 xv = *(const pg8::f32x4*)(xi + off + bj * 128 + n * 16);
                        *(pg8::f32x4*)(xo + off + bj * 128 + n * 16) = xv + gv[bj][n] * acc[ai][bj][m][n]; }
                asm volatile("" ::: "memory"); }
    }
};
struct EpiGlu {
    static constexpr bool PERM = true, AFTER_DRAIN = false;
    const bf16* Z; bf16* Y; const float* bias;
    __device__ __forceinline__ void operator()(const pg8::f32x4 (&acc)[2][2][4][2], const pg8::Unit& u, int wr, int wc, int fr, int fq) const {
        const int row0 = u.pm * 256 + wr * 64 + fr, col0 = wc * 32 + 8 * fq;
#pragma unroll
        for (int ai = 0; ai < 2; ++ai)
#pragma unroll
            for (int m = 0; m < 4; ++m) { const size_t row = (size_t)(row0 + ai * 128 + m * 16);
#pragma unroll
                for (int bj = 0; bj < 2; ++bj) { const int col = col0 + bj * 128;
                    const pg8::u32x4 zz = *(const pg8::u32x4*)(Z + row * 256 + col);
                    const pg8::f32x4 b0 = *(const pg8::f32x4*)(bias + col), b1 = *(const pg8::f32x4*)(bias + col + 4);
                    const pg8::f32x4 v0 = acc[ai][bj][m][0] + b0, v1 = acc[ai][bj][m][1] + b1;
                    float o[8]; const unsigned zw[4] = {zz.x, zz.y, zz.z, zz.w};
#pragma unroll
                    for (int j = 0; j < 4; ++j) { const float zl = __uint_as_float(zw[j] << 16), zh = __uint_as_float(zw[j] & 0xffff0000u);
                        const float a0 = (j < 2) ? v0[2 * j] : v1[2 * j - 4], a1 = (j < 2) ? v0[2 * j + 1] : v1[2 * j - 3];
                        o[2 * j] = zl * sigm(a0); o[2 * j + 1] = zh * sigm(a1); }
                    pg8::u32x4 w; w.x = pg8::cvt_pk_bf16(o[0], o[1]); w.y = pg8::cvt_pk_bf16(o[2], o[3]); w.z = pg8::cvt_pk_bf16(o[4], o[5]); w.w = pg8::cvt_pk_bf16(o[6], o[7]);
                    *(pg8::u32x4*)(Y + row * 1024 + 256 + col) = w; }
                asm volatile("" ::: "memory"); }
    }
};
struct MoeOrder {
    int tp[9]; int nN, G, c, total;
    __device__ __forceinline__ void init(const unsigned* cnt, int nN_, int G_, int c_) {
        tp[0] = 0;
#pragma unroll
        for (int e = 0; e < 8; ++e) tp[e + 1] = tp[e] + (int)(((unsigned)__builtin_amdgcn_readfirstlane((int)__hip_atomic_load(cnt + e * 64, __ATOMIC_RELAXED, __HIP_MEMORY_SCOPE_AGENT)) + 255u) >> 8);
        nN = nN_; G = G_; c = c_; total = tp[8] * nN;
    }
    __device__ __forceinline__ bool next(int i, pg8::Unit& u) const {
        const int L = i * G + c; if (L >= total) return false;
        const int t = L / nN, pn = L - t * nN; int e = 0;
#pragma unroll
        for (int k = 1; k < 8; ++k) e += (t >= tp[k]) ? 1 : 0;
        u.pm = t; u.pn = e * nN + pn; u.pc = pn; return true;
    }
    __device__ __forceinline__ void a_ready(const pg8::Unit&) const {}
    __device__ __forceinline__ void done(const pg8::Unit&) const {}
};

__device__ __forceinline__ void cvt_item(const float* W, int K, int N, bf16* WT, int mode, int add, LAS float* scr, int item, int lane, int nblk_override = 0) {
    const int nblk = nblk_override ? nblk_override : (N >> 5), kb = item / nblk, nb = item - kb * nblk, k0 = 64 * kb, n0 = 32 * nb;
    const int r = lane >> 3, c4 = lane & 7;
    f32x4 v[8];
#pragma unroll
    for (int i = 0; i < 8; ++i) v[i] = *(const f32x4*)(W + (size_t)(k0 + 8 * i + r) * N + n0 + 4 * c4);
#pragma unroll
    for (int i = 0; i < 8; ++i) {
#pragma unroll
        for (int j = 0; j < 4; ++j) scr[(8 * i + r) * 33 + 4 * c4 + j] = v[i][j]; }
    LDS_WAIT();
    const int c = lane & 7;
#pragma unroll
    for (int j = 0; j < 4; ++j) { const int n = (lane >> 3) + 8 * j; const LAS float* s = scr + (8 * c) * 33 + n;
        v4u o; o.x = pk2(s[0 * 33], s[1 * 33]); o.y = pk2(s[2 * 33], s[3 * 33]); o.z = pk2(s[4 * 33], s[5 * 33]); o.w = pk2(s[6 * 33], s[7 * 33]);
        const int nn = n0 + n; const int drow = (mode == 0) ? (nn + add) : (((nn >> 7) << 8) + (nn & 127) + add);
        *(v4u*)(WT + (size_t)drow * K + k0 + 8 * c) = o; }
    LDS_WAIT();
}
__device__ __forceinline__ void moe_cvt(const Frame& F, const Args& a, int j) {
    LAS float* scr = (LAS float*)(F.lds + F.wave * 16384);
    constexpr int IT = 1408;
    for (int it = F.gw; it < 8 * 3 * IT; it += F.NGW) {
        const int e = it / (3 * IT), r = it - e * 3 * IT, which = r / IT, item = r - which * IT;
        const size_t eo = ((size_t)j * 8 + e) * (size_t)(1024 * DFF);
        if (which == 0) cvt_item(a.in[F.zz + I_MW1] + eo, 1024, DFF, (bf16*)(F.ws + WS_W13M) + (size_t)e * 5632 * 1024, 1, 0, scr, item, F.lane);
        else if (which == 1) cvt_item(a.in[F.zz + I_MW3] + eo, 1024, DFF, (bf16*)(F.ws + WS_W13M) + (size_t)e * 5632 * 1024, 1, 128, scr, item, F.lane);
        else cvt_item(a.in[F.zz + I_MW2] + eo, DFF, 1024, (bf16*)(F.ws + WS_W2M) + (size_t)e * 1024 * DFF, 0, 0, scr, item, F.lane);
    }
}
__device__ __forceinline__ void prologue(const Frame& F, const Args& a) {
    {
        LAS float* sc = (LAS float*)F.lds; LAS float* red = sc + 5120;
        for (int idx = F.tid; idx < 5120; idx += 512) { const int r = idx >> 10, k = idx & 1023; const float cv = (r < 4) ? a.in[F.zz + I_C][r * 1024 + k] : a.in[F.zz + I_CCTX][k]; sc[idx] = silu_f(cv); }
        __syncthreads();
        float* MOD = (float*)(F.ws + WS_MOD);
        for (int item = blockIdx.x; item < 384; item += F.G) {
            const int l = item / 96, nb = item - l * 96, cl = F.tid & 63, ks = F.tid >> 6, n = nb * 64 + cl;
            float acc[5] = {0.f, 0.f, 0.f, 0.f, 0.f};
            const float* wp = a.in[F.zz + I_ADAW] + ((size_t)l * 1024 + ks * 128) * 6144 + n;
#pragma unroll 16
            for (int kk = 0; kk < 128; ++kk) { const float w = wp[(size_t)kk * 6144];
#pragma unroll
                for (int r = 0; r < 5; ++r) acc[r] = fmaf(sc[r * 1024 + ks * 128 + kk], w, acc[r]); }
#pragma unroll
            for (int r = 0; r < 5; ++r) red[(ks * 5 + r) * 64 + cl] = acc[r];
            __syncthreads();
            if (F.tid < 320) { const int r = F.tid >> 6; float s = 0.f;
#pragma unroll
                for (int k2 = 0; k2 < 8; ++k2) s += red[(k2 * 5 + r) * 64 + cl];
                MOD[((size_t)l * 5 + r) * 6144 + n] = s + a.in[F.zz + I_ADAB][l * 6144 + n]; }
            __syncthreads();
        }
        if (blockIdx.x == 0 && F.tid < 256) {
            const float* lg = a.in[F.zz + I_LBL]; float x[4], mx = -3.0e38f;
#pragma unroll
            for (int l = 0; l < 4; ++l) { x[l] = lg[l * 256 + F.tid]; mx = fmaxf(mx, x[l]); }
            float s = 0.f;
#pragma unroll
            for (int l = 0; l < 4; ++l) { x[l] = expf(x[l] - mx); s += x[l]; }
            float cs = 0.f; const float sm0 = x[0] / s; float* LB = (float*)(F.ws + WS_LB);
#pragma unroll
            for (int l = 0; l < 4; ++l) { cs += x[l] / s; LB[l * 256 + F.tid] = fminf(fmaxf(cs - sm0, 0.f), 1.0f - 1e-6f); }
        }
        if (blockIdx.x == (1 % F.G)) {
            float* RC = (float*)(F.ws + WS_ROPE); float* RS = RC + 2048;
            for (int idx = F.tid; idx < 2048; idx += 512) { const int pos = idx >> 4, i = idx & 15;
                const float fr = powf(10000.0f, -(float)i / 16.0f); const float ang = (float)pos * fr; RC[idx] = cosf(ang); RS[idx] = sinf(ang); }
        }
        __syncthreads();
    }
    LAS float* scr = (LAS float*)(F.lds + F.wave * 16384);
    constexpr int I_IN = 16 * 104, I_OUT = 16 * 32, I_F = 1408, I_GL = 4 * 8;
    constexpr int NIT = 4 * I_IN + 4 * I_OUT + 6 * I_F + 4 * I_GL;
    for (int it = F.gw; it < NIT; it += F.NGW) {
        int r = it;
        if (r < 4 * I_IN) { const int l = r / I_IN; cvt_item(a.in[F.zz + I_WIN] + (size_t)l * 1024 * DIN, 1024, DIN, (bf16*)(F.ws + WS_WIN) + (size_t)l * DINP * 1024, 0, 0, scr, r - l * I_IN, F.lane, 104); continue; } r -= 4 * I_IN;
        if (r < 4 * I_OUT) { const int l = r / I_OUT; cvt_item(a.in[F.zz + I_WOUT] + (size_t)l * 1024 * 1024, 1024, 1024, (bf16*)(F.ws + WS_WOUT) + (size_t)l * 1024 * 1024, 0, 0, scr, r - l * I_OUT, F.lane); continue; } r -= 4 * I_OUT;
        if (r < 6 * I_F) { const int j = r / (3 * I_F), r2 = r - j * 3 * I_F, which = r2 / I_F, item = r2 - which * I_F; const size_t wo = (size_t)j * 1024 * DFF;
            if (which == 0) cvt_item(a.in[F.zz + I_FW1] + wo, 1024, DFF, (bf16*)(F.ws + WS_W13D) + (size_t)j * 5632 * 1024, 1, 0, scr, item, F.lane);
            else if (which == 1) cvt_item(a.in[F.zz + I_FW3] + wo, 1024, DFF, (bf16*)(F.ws + WS_W13D) + (size_t)j * 5632 * 1024, 1, 128, scr, item, F.lane);
            else cvt_item(a.in[F.zz + I_FW2] + wo, DFF, 1024, (bf16*)(F.ws + WS_W2D) + (size_t)j * 1024 * DFF, 0, 0, scr, item, F.lane);
            continue; } r -= 6 * I_F;
        { const int l = r / I_GL; cvt_item(a.in[F.zz + I_GLUW] + (size_t)l * 65536, 256, 256, (bf16*)(F.ws + WS_GLUW) + (size_t)l * 65536, 0, 0, scr, r - l * I_GL, F.lane); }
    }
    moe_cvt(F, a, 0);
    for (int i = blockIdx.x * 512 + F.tid; i < 4 * 256 * 128; i += F.G * 512) {
        const int l = i >> 15, rem = i & 32767, n = rem >> 7, k0 = (rem & 127) * 8, d = n >> 7, cidx = n & 127;
        const float* wa = a.in[F.zz + I_WA2] + ((size_t)(l * 2 + d) * 16) * 128 + cidx;
        float acc[8] = {0.f, 0.f, 0.f, 0.f, 0.f, 0.f, 0.f, 0.f};
#pragma unroll
        for (int r = 0; r < 16; ++r) { const float w2 = wa[r * 128];
#pragma unroll
            for (int kk = 0; kk < 8; ++kk) acc[kk] = fmaf(a.in[F.zz + I_WIN][((size_t)l * 1024 + k0 + kk) * DIN + 3328 + 16 * d + r], w2, acc[kk]); }
        v4u o; o.x = pk2(acc[0], acc[1]); o.y = pk2(acc[2], acc[3]); o.z = pk2(acc[4], acc[5]); o.w = pk2(acc[6], acc[7]);
        *(v4u*)((bf16*)(F.ws + WS_WIN) + ((size_t)l * DINP + 3328 + n) * 1024 + k0) = o;
    }
}

struct MoeTp { int tp[9]; };
__device__ __forceinline__ void load_tp(MoeTp& t, const unsigned* cnt) {
    t.tp[0] = 0;
#pragma unroll
    for (int e = 0; e < 8; ++e) t.tp[e + 1] = t.tp[e] + (int)(((unsigned)__builtin_amdgcn_readfirstlane((int)__hip_atomic_load(cnt + e * 64, __ATOMIC_RELAXED, __HIP_MEMORY_SCOPE_AGENT)) + 255u) >> 8);
}
template <int MODE>
__device__ __forceinline__ void norm_phase(const Frame& F, const Args& a, int l, int which  , int nrows, int comb_l  ) {
    const float* MOD = (const float*)(F.ws + WS_MOD);
    const float* nw = (MODE == 2) ? a.in[F.zz + I_FINW] : ((which ? a.in[F.zz + I_N2W] : a.in[F.zz + I_N1W]) + l * 1024);
    bf16* XN = (bf16*)(F.ws + WS_ACT);
    float* hb = (float*)(F.ws + WS_HB);
    const int* EP = (const int*)(F.ws + WS_LIST) + 8 * MT; const float* GATE = (const float*)(F.ws + WS_LIST) + 10 * MT;
    const bf16* YM = (const bf16*)(F.ws + WS_X2);
    const bool from_input = (l == 0 && which == 0 && MODE != 2);
    MoeTp ctp; if (comb_l >= 0) load_tp(ctp, (const unsigned*)F.ws + CW_CNT + (comb_l >> 1) * 8 * 64);
    const int jm = l >> 1;
    LAS float* rwl = (LAS float*)F.lds;
    if (MODE == 1) {
        const float* rw = a.in[F.zz + I_RW] + (size_t)jm * 8192;
        for (int idx = F.tid; idx < 8192; idx += 512) { const int k = idx >> 3, e = idx & 7; rwl[e * 1024 + k] = rw[idx]; }
        __syncthreads();
    }
    f32x4 wv[4];
#pragma unroll
    for (int j = 0; j < 4; ++j) wv[j] = *((const f32x4*)nw + F.lane + 64 * j);
    for (int m = F.gw; m < nrows; m += F.NGW) {
        const bool isctx = m >= NLAT; const int bidx = isctx ? 4 : (m >> 13);
        const float* xr = from_input ? (isctx ? a.in[F.zz + I_CTX] + (size_t)(m - NLAT) * 1024 : a.in[F.zz + I_X] + (size_t)m * 1024)
                                     : (isctx ? hb + (size_t)(m - NLAT) * 1024 : F.out + (size_t)m * 1024);
        f32x4 v[4];
#pragma unroll
        for (int j = 0; j < 4; ++j) v[j] = *((const f32x4*)xr + F.lane + 64 * j);
        if (comb_l >= 0) {
            const int ep0 = EP[2 * m], ep1 = EP[2 * m + 1]; const float g0 = GATE[2 * m], g1 = GATE[2 * m + 1];
            int t0 = 0, t1 = 0;
#pragma unroll
            for (int e = 0; e < 8; ++e) { t0 = ((ep0 & 7) == e) ? ctp.tp[e] : t0; t1 = ((ep1 & 7) == e) ? ctp.tp[e] : t1; }
            const size_t d0 = (size_t)t0 * 256 + (ep0 >> 3), d1 = (size_t)t1 * 256 + (ep1 >> 3);
            const float* m5 = MOD + ((size_t)comb_l * 5 + bidx) * 6144 + 5 * 1024;
            float* xw = isctx ? hb + (size_t)(m - NLAT) * 1024 : F.out + (size_t)m * 1024;
#pragma unroll
            for (int j = 0; j < 4; ++j) {
                const v2u y0 = *((const v2u*)(YM + d0 * 1024) + F.lane + 64 * j), y1 = *((const v2u*)(YM + d1 * 1024) + F.lane + 64 * j);
                const f32x4 mm = *((const f32x4*)m5 + F.lane + 64 * j);
                f32x4 f0, f1;
                f0[0] = __uint_as_float(y0.x << 16); f0[1] = __uint_as_float(y0.x & 0xffff0000u); f0[2] = __uint_as_float(y0.y << 16); f0[3] = __uint_as_float(y0.y & 0xffff0000u);
                f1[0] = __uint_as_float(y1.x << 16); f1[1] = __uint_as_float(y1.x & 0xffff0000u); f1[2] = __uint_as_float(y1.y << 16); f1[3] = __uint_as_float(y1.y & 0xffff0000u);
                v[j] = v[j] + mm * (f0 * g0 + f1 * g1);
                if (MODE != 2) *((f32x4*)xw + F.lane + 64 * j) = v[j];
            }
        }
        float ss = 0.f;
#pragma unroll
        for (int j = 0; j < 4; ++j) ss += (v[j][0] * v[j][0] + v[j][1] * v[j][1]) + (v[j][2] * v[j][2] + v[j][3] * v[j][3]);
        ss = wave_sum(ss);
        const float rstd = 1.0f / sqrtf(ss * (1.0f / 1024.0f) + NEPS);
        if (MODE == 2) {
#pragma unroll
            for (int j = 0; j < 4; ++j) *((f32x4*)(F.out + (size_t)m * 1024) + F.lane + 64 * j) = v[j] * rstd * wv[j];
        } else {
            const float* sh = MOD + ((size_t)l * 5 + bidx) * 6144 + (which ? 3 : 0) * 1024; const float* scl = sh + 1024;
            f32x4 o[4];
#pragma unroll
            for (int j = 0; j < 4; ++j) { const f32x4 s1 = *((const f32x4*)scl + F.lane + 64 * j), s0 = *((const f32x4*)sh + F.lane + 64 * j);
                o[j] = (v[j] * rstd * wv[j]) * (s1 + 1.0f) + s0;
                v2u w; w.x = pk2(o[j][0], o[j][1]); w.y = pk2(o[j][2], o[j][3]);
                *((v2u*)(XN + (size_t)m * 1024) + F.lane + 64 * j) = w; }
            if (MODE == 1) {
                float p[8];
#pragma unroll
                for (int e = 0; e < 8; ++e) { float s = 0.f;
#pragma unroll
                    for (int j = 0; j < 4; ++j) { const f32x4 w4 = *((const LAS f32x4*)(rwl + e * 1024) + F.lane + 64 * j);
                        s += (o[j][0] * w4[0] + o[j][1] * w4[1]) + (o[j][2] * w4[2] + o[j][3] * w4[3]); }
                    p[e] = wave_sum(s) + a.in[F.zz + I_RB][jm * 8 + e]; }
                int e0 = 0; float v0 = p[0];
#pragma unroll
                for (int e = 1; e < 8; ++e) if (p[e] > v0) { v0 = p[e]; e0 = e; }
                int e1 = -1; float v1 = -3.0e38f;
#pragma unroll
                for (int e = 0; e < 8; ++e) if (e != e0 && p[e] > v1) { v1 = p[e]; e1 = e; }
                const float ex = expf(v1 - v0), g0 = 1.0f / (1.0f + ex), g1 = ex / (1.0f + ex);
                if (F.lane == 0) {
                    unsigned* cnt = (unsigned*)F.ws + CW_CNT + jm * 8 * 64; int* LIST = (int*)(F.ws + WS_LIST);
                    int* EPw = (int*)(F.ws + WS_LIST) + 8 * MT; float* GW = (float*)(F.ws + WS_LIST) + 10 * MT;
                    const unsigned p0 = __hip_atomic_fetch_add(cnt + e0 * 64, 1u, __ATOMIC_RELAXED, __HIP_MEMORY_SCOPE_AGENT);
                    const unsigned p1 = __hip_atomic_fetch_add(cnt + e1 * 64, 1u, __ATOMIC_RELAXED, __HIP_MEMORY_SCOPE_AGENT);
                    LIST[e0 * MT + p0] = m; LIST[e1 * MT + p1] = m;
                    EPw[2 * m] = e0 | (int)(p0 << 3); EPw[2 * m + 1] = e1 | (int)(p1 << 3);
                    GW[2 * m] = g0; GW[2 * m + 1] = g1;
                }
            }
        }
    }
    if (MODE == 1) __syncthreads();
}
__device__ __forceinline__ void moe_gather(const Frame& F, int jm) {
    const unsigned* cnt = (const unsigned*)F.ws + CW_CNT + jm * 8 * 64;
    MoeTp t; load_tp(t, cnt);
    int cn[8];
#pragma unroll
    for (int e = 0; e < 8; ++e) cn[e] = __builtin_amdgcn_readfirstlane((int)__hip_atomic_load(cnt + e * 64, __ATOMIC_RELAXED, __HIP_MEMORY_SCOPE_AGENT));
    const int rows = t.tp[8] * 256;
    const int* LIST = (const int*)(F.ws + WS_LIST); const v4u* XN = (const v4u*)(F.ws + WS_ACT); v4u* XB = (v4u*)(F.ws + WS_X2);
    for (int r = F.gw; r < rows; r += F.NGW) {
        const int tile = r >> 8; int e = 0, tpe = 0, ce = cn[0];
#pragma unroll
        for (int k = 1; k < 8; ++k) { const bool ge = tile >= t.tp[k]; e += ge ? 1 : 0; tpe = ge ? t.tp[k] : tpe; ce = ge ? cn[k] : ce; }
        const int pos = r - tpe * 256;
        v4u x0 = {0u, 0u, 0u, 0u}, x1 = {0u, 0u, 0u, 0u};
        if (pos < ce) { const int src = LIST[e * MT + pos]; x0 = XN[(size_t)src * 128 + F.lane]; x1 = XN[(size_t)src * 128 + 64 + F.lane]; }
        XB[(size_t)r * 128 + F.lane] = x0; XB[(size_t)r * 128 + 64 + F.lane] = x1;
    }
}
#define GLD(T, ubase, voff) (*(const T*)((const char*)(ubase) + (unsigned)(voff)))
#define GST(T, ubase, voff) (*(T*)((char*)(ubase) + (unsigned)(voff)))
__device__ __forceinline__ int fresh_lane() { int l; asm volatile("v_mbcnt_lo_u32_b32 %0, -1, 0\n\tv_mbcnt_hi_u32_b32 %0, -1, %0" : "=v"(l)); return l; }

struct MixP { const bf16* P; const float* lb; const float* rcos; const float* rsin; const float* ba; };
__device__ __forceinline__ int seg_row0(int b, int sg) { return sg < 4 ? NLAT + b * CTXL + sg * 64 : b * SEQ + (sg - 4) * 64; }
__device__ __forceinline__ int seg_tpos0(int sg) { return sg < 4 ? -1 : (sg - 4) * 64; }

struct S5P { const float *lam_re, *lam_im, *log_dt, *b_re, *b_im, *c_re, *c_im, *dd; };
__device__ __forceinline__ float gelu_tanh(float y) { const float t = 0.7978845608028654f * (y + 0.044715f * y * y * y); const float th = 1.0f - 2.0f / (1.0f + __expf(2.0f * t)); return 0.5f * y * (1.0f + th); }
template <int MODE>
__device__ __forceinline__ void s5_scan(const S5P& sp, const bf16* P, int b, int g, int dir, int sg, int lane, float& hre, float& him, LAS float* yf, LAS float* stg, bf16* Z) {
    const int row0 = seg_row0(b, sg); const int dg = dir * 16 + g;
    const float lre = sp.lam_re[dg * 64 + lane], lim = sp.lam_im[dg * 64 + lane], dt = expf(sp.log_dt[dg]);
    const float er = expf(lre * dt); const float sn = sinf(lim * dt), cs = cosf(lim * dt);
    const float ar = er * cs, ai = er * sn;
    const float nr = ar - 1.0f, ni = ai, den = lre * lre + lim * lim;
    const float cr = (nr * lre + ni * lim) / den, ci = (ni * lre - nr * lim) / den;
    float bbr[16], bbi[16], Cr[16], Ci[16];
#pragma unroll
    for (int c = 0; c < 16; ++c) { const float Br = sp.b_re[((size_t)dg * 64 + lane) * 16 + c], Bi = sp.b_im[((size_t)dg * 64 + lane) * 16 + c];
        bbr[c] = cr * Br - ci * Bi; bbi[c] = cr * Bi + ci * Br;
        Cr[c] = (MODE != 0) ? sp.c_re[((size_t)dg * 16 + c) * 64 + lane] : 0.f; Ci[c] = (MODE != 0) ? sp.c_im[((size_t)dg * 16 + c) * 64 + lane] : 0.f; }
    const int ch = ((lane >> 5) & 1) * 8 + ((lane >> 4) & 1) * 4 + ((lane >> 3) & 1) * 2 + ((lane >> 2) & 1);
    const float dv = (MODE == 2) ? sp.dd[g * 16 + ch] : 0.f;
    const bool b5 = lane & 32, b4 = lane & 16, b3 = lane & 8, b2 = lane & 4;
    const unsigned ucol = 2u * (unsigned)(C_S5 + g * 16 + (lane & 15));
    unsigned short rn0[4], rn1[4], rn2[4];
#pragma unroll
    for (int u = 0; u < 4; ++u) { rn0[u] = GLD(unsigned short, P + (size_t)(row0 + (dir ? 63 - u : u)) * DINP, ucol); rn1[u] = GLD(unsigned short, P + (size_t)(row0 + (dir ? 59 - u : 4 + u)) * DINP, ucol);
        rn2[u] = GLD(unsigned short, P + (size_t)(row0 + (dir ? 55 - u : 8 + u)) * DINP, ucol); }
#pragma unroll 1
    for (int i0 = 0; i0 < 64; i0 += 4) {
        unsigned short ru[4], rn3[4];
        const int ip = (i0 + 12 < 64) ? i0 + 12 : 60;
#pragma unroll
        for (int u = 0; u < 4; ++u) { ru[u] = rn0[u]; rn3[u] = GLD(unsigned short, P + (size_t)(row0 + (dir ? 63 - (ip + u) : (ip + u))) * DINP, ucol); }
#pragma unroll
        for (int u = 0; u < 4; ++u) stg[u * 64 + lane] = bf2f(ru[u]);
#pragma unroll
        for (int u = 0; u < 4; ++u) {
            const int ti = dir ? 63 - (i0 + u) : (i0 + u);
            const float uf = bf2f(ru[u]);
            float bur = 0.f, bui = 0.f;
#pragma unroll
            for (int c4 = 0; c4 < 4; ++c4) { const f32x4 ux = *(const LAS f32x4*)(stg + u * 64 + 4 * c4);
#pragma unroll
                for (int jj = 0; jj < 4; ++jj) { bur = fmaf(bbr[4 * c4 + jj], ux[jj], bur); bui = fmaf(bbi[4 * c4 + jj], ux[jj], bui); } }
            const float nre = ar * hre - ai * him + bur, nim = ar * him + ai * hre + bui;
            hre = nre; him = nim;
            if (MODE != 0) {
                float v[16];
#pragma unroll
                for (int c = 0; c < 16; ++c) v[c] = Cr[c] * hre - Ci[c] * him;
                float w8[8], w4[4], w2[2], w1;
#pragma unroll
                for (int i = 0; i < 8; ++i) { const float mine = b5 ? v[8 + i] : v[i], oth = b5 ? v[i] : v[8 + i]; w8[i] = mine + __shfl_xor(oth, 32); }
#pragma unroll
                for (int i = 0; i < 4; ++i) { const float mine = b4 ? w8[4 + i] : w8[i], oth = b4 ? w8[i] : w8[4 + i]; w4[i] = mine + __shfl_xor(oth, 16); }
#pragma unroll
                for (int i = 0; i < 2; ++i) { const float mine = b3 ? w4[2 + i] : w4[i], oth = b3 ? w4[i] : w4[2 + i]; w2[i] = mine + __shfl_xor(oth, 8); }
                { const float mine = b2 ? w2[1] : w2[0], oth = b2 ? w2[0] : w2[1]; w1 = mine + __shfl_xor(oth, 4); }
                w1 += __shfl_xor(w1, 2); w1 += __shfl_xor(w1, 1);
                if (MODE == 1) { if ((lane & 3) == 0) yf[ti * 16 + ch] = w1; }
                if (MODE == 2) {
                    const float uch = __shfl(uf, ch);
                    if ((lane & 3) == 0) { const float y = w1 + yf[ti * 16 + ch] + dv * uch; Z[(size_t)(row0 + ti) * 256 + g * 16 + ch] = (bf16)f2bf(gelu_tanh(y)); }
                }
            }
        }
#pragma unroll
        for (int u = 0; u < 4; ++u) { rn0[u] = rn1[u]; rn1[u] = rn2[u]; rn2[u] = rn3[u]; }
    }
}

__device__ __forceinline__ MixP make_mixp(const Frame& F, const Args& a, int l) {
    MixP mp; mp.P = (const bf16*)(F.ws + WS_PH); mp.lb = (const float*)(F.ws + WS_LB) + l * 256; mp.rcos = (const float*)(F.ws + WS_ROPE); mp.rsin = mp.rcos + 2048;
    mp.ba = a.in[F.zz + I_BA] + (size_t)l * 2 * 128; return mp;
}
__device__ __forceinline__ S5P make_s5p(const Frame& F, const Args& a, int l) {
    S5P sp; sp.lam_re = a.in[F.zz + I_LAMRE] + (size_t)l * 2048; sp.lam_im = a.in[F.zz + I_LAMIM] + (size_t)l * 2048; sp.log_dt = a.in[F.zz + I_LOGDT] + l * 32;
    sp.b_re = a.in[F.zz + I_BRE] + (size_t)l * 32768; sp.b_im = a.in[F.zz + I_BIM] + (size_t)l * 32768; sp.c_re = a.in[F.zz + I_CRE] + (size_t)l * 32768; sp.c_im = a.in[F.zz + I_CIM] + (size_t)l * 32768;
    sp.dd = a.in[F.zz + I_S5D] + l * 256; return sp;
}


typedef short bf16x8_t __attribute__((ext_vector_type(8)));
typedef float f32x16 __attribute__((ext_vector_type(16)));
typedef float f32x2_t __attribute__((ext_vector_type(2)));
typedef __bf16 bf16x2_n __attribute__((ext_vector_type(2)));
__device__ __forceinline__ unsigned pkbf(float lo, float hi) { const f32x2_t v = {lo, hi}; const bf16x2_n r = __builtin_convertvector(v, bf16x2_n); return __builtin_bit_cast(unsigned, r); }
constexpr int WL_QC = 0, WL_KC = 4608, WL_KT = 9216, WL_VT = 14336, WL_PL = 19456, WL_BYTES = 19712;

struct MxC { float gamma, lbv, oml, bav; unsigned cq, ck, cv, cz; };
template <int MIX>
__device__ __forceinline__ void mx_consts(MxC& c, const MixP& mp, int h, int dir, int lane) {
    c.gamma = 1.f; c.lbv = 0.f; c.oml = 1.f; c.bav = 0.f; c.cz = 0;
    if (MIX == 0) { c.cq = 2u * (unsigned)(C_RQ + h * 64 + lane); c.ck = 2u * (unsigned)(C_RK + h * 64 + lane); c.cv = 2u * (unsigned)(C_RV + h * 64 + lane); c.gamma = 1.0f - exp2f(-5.0f - (float)(dir ? 3 - h : h)); }
    else if (MIX == 1) { c.cq = 2u * (unsigned)(C_HQ + h * 64 + lane); c.ck = 2u * (unsigned)((dir ? C_HFB : C_HFF) + h * 64 + lane); c.cv = 2u * (unsigned)(C_HI + h * 64 + lane); c.lbv = mp.lb[h * 64 + lane]; c.oml = 1.0f - c.lbv; }
    else { c.cq = 2u * (unsigned)(C_GQ + h * 32 + (lane & 31)); c.ck = 2u * (unsigned)(C_GK + h * 32 + (lane & 31)); c.cv = 2u * (unsigned)(C_GV + h * 64 + lane); c.cz = 2u * (unsigned)((dir ? C_GZB : C_GZF) + h * 32 + (lane & 31));
        c.bav = mp.ba[dir * 128 + h * 32 + (lane & 31)]; }
}
struct MxRaw { unsigned short q[4], k[4], v[4], z[4]; };
template <int MIX, bool NEEDQ, int DIR>
__device__ __forceinline__ void mx_load(MxRaw& w, const MixP& mp, const MxC& c, int rows, int b) {
#pragma unroll
    for (int u = 0; u < 4; ++u) { const int cc = b * 4 + u; const bf16* pr = mp.P + (size_t)(rows + (DIR ? 63 - cc : cc)) * DINP;
        w.q[u] = NEEDQ ? GLD(unsigned short, pr, c.cq) : (unsigned short)0; w.k[u] = GLD(unsigned short, pr, c.ck); w.v[u] = GLD(unsigned short, pr, c.cv); w.z[u] = (MIX == 2) ? GLD(unsigned short, pr, c.cz) : (unsigned short)0; }
}
template <int MIX, bool NEEDQ, int DIR>
__device__ __forceinline__ void mx_batch(const MxRaw& cur, const MixP& mp, const MxC& c, int tposs  , int lane, LAS unsigned char* wl, int b, float& P) {
    constexpr int DK = (MIX == 2) ? 32 : 64;
    float kt[4], vv[4];
#pragma unroll
    for (int u = 0; u < 4; ++u) {
        const int cc = b * 4 + u, ts = DIR ? 63 - cc : cc, t = ts & 31;
        float q = bf2f(cur.q[u]), k, f; vv[DIR ? 3 - u : u] = bf2f(cur.v[u]);
        if (MIX == 0) {
            k = bf2f(cur.k[u]) * 0.125f; f = c.gamma;
            if (tposs >= 0) { const int tpos = tposs + ts; const int pos = (lane & 32) ? (tpos & 63) : (tpos >> 6);
                const unsigned ro = 4u * (unsigned)(pos * 16 + (lane & 15)); const float cs = GLD(float, mp.rcos, ro), sn = GLD(float, mp.rsin, ro);
                const float ss = (lane & 16) ? sn : -sn;
                const float kp = __shfl_xor(k, 16); k = fmaf(kp, ss, k * cs);
                if (NEEDQ) { const float qp = __shfl_xor(q, 16); q = fmaf(qp, ss, q * cs); } }
        } else if (MIX == 1) {
            const float z = bf2f(cur.k[u]); const float e = __expf(-z); const float sp = __builtin_amdgcn_rcpf(1.0f + e), sn = e * sp;
            f = fmaf(c.oml, sp, c.lbv); k = c.oml * sn;
        } else {
            k = bf2f(cur.k[u]) * 0.17677669529663687f; const float z = bf2f(cur.z[u]) + c.bav;
            const float ls = fminf(z, 0.f) - __logf(1.0f + __expf(-fabsf(z)));
            f = __expf(ls * 0.0625f);
        }
        P = fmaxf(P * f, 1e-30f);
        const float kk = k * __builtin_amdgcn_rcpf(P); kt[DIR ? 3 - u : u] = kk;
        if (lane < DK) {
            if (NEEDQ) *(LAS unsigned short*)(wl + WL_QC + t * 144 + lane * 2) = (unsigned short)f2bf(q * P);
            *(LAS unsigned short*)(wl + WL_KC + t * 144 + lane * 2) = (unsigned short)f2bf(kk);
        }
    }
    const int g4 = ((DIR ? 63 - b * 4 : b * 4) & 31) >> 2;
    v2u kp, vp; kp.x = pkbf(kt[0], kt[1]); kp.y = pkbf(kt[2], kt[3]); vp.x = pkbf(vv[0], vv[1]); vp.y = pkbf(vv[2], vv[3]);
    if (lane < DK) *(LAS v2u*)(wl + WL_KT + lane * 80 + g4 * 8) = kp;
    *(LAS v2u*)(wl + WL_VT + lane * 80 + g4 * 8) = vp;
}
typedef short bf16x4_t __attribute__((ext_vector_type(4)));
#define MFMA8(a, b, c) __builtin_amdgcn_mfma_f32_32x32x8bf16_1k((a), (b), (c), 0, 0, 0)
__device__ __forceinline__ bf16x4_t pack4(const f32x16& x, int s) {
    v2u p; p.x = pkbf(x[4 * s], x[4 * s + 1]); p.y = pkbf(x[4 * s + 2], x[4 * s + 3]);
    return __builtin_bit_cast(bf16x4_t, p);
}
__device__ __forceinline__ bf16x4_t ld4(const LAS unsigned char* p) { const v2u a = *(const LAS v2u*)p; return __builtin_bit_cast(bf16x4_t, a); }
template <int MIX, int DIR, bool WITH_O>
__device__ __forceinline__ void mx_chunk(LAS unsigned char* wl, int lane, float Pl, f32x16 (&ST)[(MIX == 2) ? 1 : 2][2], f32x16 (&O)[2]) {
    constexpr int DK = (MIX == 2) ? 32 : 64, NRT = DK / 32;
    const int m32 = lane & 31, hh = lane >> 5;
    asm volatile("" ::: "memory");
    if (lane < DK) *(LAS float*)(wl + WL_PL + lane * 4) = Pl;
    asm volatile("" ::: "memory");
    if (WITH_O) {
        f32x16 x;
#pragma unroll
        for (int r = 0; r < 16; ++r) x[r] = 0.f;
#pragma unroll
        for (int s = 0; s < DK / 8; ++s) {
            const bf16x4_t ka = ld4(wl + WL_KC + m32 * 144 + (8 * s + 4 * hh) * 2);
            const bf16x4_t qb = ld4(wl + WL_QC + m32 * 144 + (8 * s + 4 * hh) * 2);
            x = MFMA8(ka, qb, x);
        }
#pragma unroll
        for (int r = 0; r < 16; ++r) { const int j = (r & 3) + 8 * (r >> 2) + 4 * hh; const bool keep = DIR ? (j >= m32) : (j <= m32); x[r] = keep ? x[r] : 0.f; }
#pragma unroll
        for (int t = 0; t < 2; ++t)
#pragma unroll
            for (int r = 0; r < 16; ++r) O[t][r] = 0.f;
#pragma unroll
        for (int s = 0; s < 4; ++s) {
            const bf16x4_t xa = pack4(x, s);
#pragma unroll
            for (int t = 0; t < 2; ++t) O[t] = MFMA8(xa, ld4(wl + WL_VT + (32 * t + m32) * 80 + (8 * s + 4 * hh) * 2), O[t]);
        }
#pragma unroll
        for (int rt = 0; rt < NRT; ++rt)
#pragma unroll
            for (int s = 0; s < 4; ++s) {
                const bf16x4_t qa = ld4(wl + WL_QC + m32 * 144 + (32 * rt + 8 * s + 4 * hh) * 2);
#pragma unroll
                for (int t = 0; t < 2; ++t) O[t] = MFMA8(qa, pack4(ST[rt][t], s), O[t]);
            }
    }
#pragma unroll
    for (int rt = 0; rt < NRT; ++rt)
#pragma unroll
        for (int s = 0; s < 4; ++s) {
            const bf16x4_t ka = ld4(wl + WL_KT + (32 * rt + m32) * 80 + (8 * s + 4 * hh) * 2);
#pragma unroll
            for (int t = 0; t < 2; ++t) ST[rt][t] = MFMA8(ka, ld4(wl + WL_VT + (32 * t + m32) * 80 + (8 * s + 4 * hh) * 2), ST[rt][t]);
        }
#pragma unroll
    for (int rt = 0; rt < NRT; ++rt)
#pragma unroll
        for (int g = 0; g < 4; ++g) {
            const f32x4 pl4 = *(const LAS f32x4*)(wl + WL_PL + (32 * rt + 8 * g + 4 * hh) * 4);
#pragma unroll
            for (int e = 0; e < 4; ++e) { ST[rt][0][4 * g + e] *= pl4[e]; ST[rt][1][4 * g + e] *= pl4[e]; }
        }
}
__device__ __forceinline__ float half_sum(float v) {
#pragma unroll
    for (int o = 1; o < 32; o <<= 1) v += __shfl_xor(v, o);
    return v;
}
template <int MIX, int DIR>
__device__ __forceinline__ void mixA_stream(const MixP& mp, const MxC& c, int row0, int tpos0, int lane, LAS unsigned char* wl, f32x16 (&ST)[(MIX == 2) ? 1 : 2][2], float& Gam) {
    f32x16 O[2];
    MxRaw r0, r1, r2;
    mx_load<MIX, false, DIR>(r0, mp, c, row0, 0); mx_load<MIX, false, DIR>(r1, mp, c, row0, 1); mx_load<MIX, false, DIR>(r2, mp, c, row0, 2);
    float P = 1.0f;
#pragma unroll 1
    for (int b = 0; b < 16; ++b) {
        MxRaw r3; mx_load<MIX, false, DIR>(r3, mp, c, row0, b < 13 ? b + 3 : 15);
        int ln = lane; asm volatile("" : "+v"(ln));
        mx_batch<MIX, false, DIR>(r0, mp, c, tpos0, ln, wl, b, P);
        if ((b & 7) == 7) { Gam *= P; mx_chunk<MIX, 0, false>(wl, ln, P, ST, O); P = 1.0f; }
        r0 = r1; r1 = r2; r2 = r3;
    }
}
template <int MIX>
__device__ __forceinline__ void mixA_unit(const MixP& mp, float* STG, int idx, int lane_in, LAS unsigned char* wl) {
    int lane = lane_in;
    constexpr int DK = (MIX == 2) ? 32 : 64, NRT = DK / 32;
    const int dir = idx / 2112, rem = idx - dir * 2112, bh = rem / NSEG, sg = rem - bh * NSEG, b = bh >> 2, h = bh & 3;
    asm volatile("" : "+v"(lane));
    MxC c; mx_consts<MIX>(c, mp, h, dir, lane);
    f32x16 ST[NRT][2];
#pragma unroll
    for (int rt = 0; rt < NRT; ++rt)
#pragma unroll
        for (int t = 0; t < 2; ++t)
#pragma unroll
            for (int r = 0; r < 16; ++r) ST[rt][t][r] = 0.f;
    const int row0 = seg_row0(b, sg), tpos0 = seg_tpos0(sg);
    float Gam = 1.0f;
    if (dir) mixA_stream<MIX, 1>(mp, c, row0, tpos0, lane, wl, ST, Gam); else mixA_stream<MIX, 0>(mp, c, row0, tpos0, lane, wl, ST, Gam);
    const size_t slot = (size_t)((dir * 16 + bh) * NSEG + sg);
    float* ds = STG + (MIX == 0 ? ST_DS0 : (MIX == 1 ? ST_DS1 : ST_DS2)) + slot * (DK * 64);
    const int m32 = lane & 31, hh = lane >> 5;
#pragma unroll
    for (int rt = 0; rt < NRT; ++rt)
#pragma unroll
        for (int t = 0; t < 2; ++t)
#pragma unroll
            for (int r = 0; r < 16; ++r) GST(float, ds + (32 * rt + (r & 3) + 8 * (r >> 2)) * 64 + 32 * t, 4u * (unsigned)(4 * hh * 64 + m32)) = ST[rt][t][r];
    float* gs = STG + (MIX == 0 ? ST_G0 : (MIX == 1 ? ST_G1 : ST_G2)) + slot * 64;
    GST(float, gs, 4u * (unsigned)lane) = Gam;
}
template <int MIX, int MODE>
__device__ __forceinline__ void mx_epilogue(const MixP& mp, LAS unsigned char* wl, int lane, const f32x16 (&O)[2], int rowc, float* OF, bf16* Y, int ocol, int ycol, int cgate, float nwv) {
    LAS float* ost = (LAS float*)(wl + WL_QC);
    const int m32 = lane & 31, hh = lane >> 5;
    asm volatile("" ::: "memory");
#pragma unroll
    for (int t = 0; t < 2; ++t)
#pragma unroll
        for (int r = 0; r < 16; ++r) ost[((r & 3) + 8 * (r >> 2) + 4 * hh) * 68 + 32 * t + m32] = O[t][r];
    asm volatile("" ::: "memory");
    if (MODE == 1) {
#pragma unroll 8
        for (int tk = 0; tk < 32; ++tk) GST(float, OF + (size_t)(rowc + tk) * 768 + ocol, 4u * (unsigned)lane) = ost[tk * 68 + lane];
    } else {
        float ofc[8]; unsigned short gc[8];
#pragma unroll
        for (int u = 0; u < 8; ++u) { ofc[u] = GLD(float, OF + (size_t)(rowc + u) * 768 + ocol, 4u * (unsigned)lane); gc[u] = GLD(unsigned short, mp.P + (size_t)(rowc + u) * DINP + cgate, 2u * (unsigned)lane); }
#pragma unroll 1
        for (int b8 = 0; b8 < 4; ++b8) {
            float ofn[8]; unsigned short gn[8]; const int nb = b8 < 3 ? b8 + 1 : 3;
#pragma unroll
            for (int u = 0; u < 8; ++u) { ofn[u] = GLD(float, OF + (size_t)(rowc + nb * 8 + u) * 768 + ocol, 4u * (unsigned)lane); gn[u] = GLD(unsigned short, mp.P + (size_t)(rowc + nb * 8 + u) * DINP + cgate, 2u * (unsigned)lane); }
#pragma unroll
            for (int u = 0; u < 8; ++u) {
                const int tk = b8 * 8 + u;
                const float o = ost[tk * 68 + lane] + ofc[u];
                float y;
                if (MIX == 0) { const float mean = wave_sum(o) * (1.0f / 64.0f); const float d = o - mean; y = d * (1.0f / sqrtf(wave_sum(d * d) * (1.0f / 64.0f) + NEPS)) * nwv; }
                else y = o * (1.0f / sqrtf(wave_sum(o * o) * (1.0f / 64.0f) + NEPS)) * nwv;
                y *= silu_f(bf2f(gc[u]));
                GST(unsigned short, Y + (size_t)(rowc + tk) * 1024 + ycol, 2u * (unsigned)lane) = (unsigned short)f2bf(y);
            }
#pragma unroll
            for (int u = 0; u < 8; ++u) { ofc[u] = ofn[u]; gc[u] = gn[u]; }
        }
    }
}
template <int MIX, int DIR>
__device__ __forceinline__ void mixC_stream(const MixP& mp, const MxC& c, int row0, int tpos0, int lane, LAS unsigned char* wl, f32x16 (&ST)[(MIX == 2) ? 1 : 2][2],
                                            float* OF, bf16* Y, int ocol, int ycol, int cgate, float nwv) {
    f32x16 O[2];
    MxRaw r0, r1;
    mx_load<MIX, true, DIR>(r0, mp, c, row0, 0); mx_load<MIX, true, DIR>(r1, mp, c, row0, 1);
    float P = 1.0f;
#pragma unroll 1
    for (int b = 0; b < 16; ++b) {
        MxRaw r2; mx_load<MIX, true, DIR>(r2, mp, c, row0, b < 14 ? b + 2 : 15);
        int ln = lane; asm volatile("" : "+v"(ln));
        mx_batch<MIX, true, DIR>(r0, mp, c, tpos0, ln, wl, b, P);
        if ((b & 7) == 7) {
            const int ch = DIR ? 1 - (b >> 3) : (b >> 3);
            mx_chunk<MIX, DIR, true>(wl, ln, P, ST, O); P = 1.0f;
            mx_epilogue<MIX, DIR ? 2 : 1>(mp, wl, ln, O, row0 + 32 * ch, OF, Y, ocol, ycol, cgate, nwv);
        }
        r0 = r1; r1 = r2;
    }
}
template <int MIX>
__device__ __forceinline__ void mixC_unit(const MixP& mp, const float* STG, int idx, int lane_in, float* OF, LAS unsigned char* wl, bf16* Y, const float* nw) {
    int lane = lane_in; asm volatile("" : "+v"(lane));
    constexpr int DK = (MIX == 2) ? 32 : 64, NRT = DK / 32;
    const int bh = idx / NSEG, sg = idx - bh * NSEG, b = bh >> 2, h = bh & 3;
    const int row0 = seg_row0(b, sg), tpos0 = seg_tpos0(sg);
    const int ocol = ((MIX == 0) ? 0 : (MIX == 1 ? 256 : 512)) + h * 64, ycol = ((MIX == 0) ? 0 : (MIX == 1 ? 512 : 768)) + h * 64;
    const int cgate = ((MIX == 0) ? C_RG : (MIX == 1 ? C_HG : C_GG)) + h * 64;
    const float* dsb = STG + (MIX == 0 ? ST_DS0 : (MIX == 1 ? ST_DS1 : ST_DS2));
    const float nwv = nw[h * 64 + lane];
    f32x16 ST[NRT][2];
#pragma unroll 1
    for (int dir = 0; dir < 2; ++dir) {
        asm volatile("" : "+v"(lane));
        const int m32 = lane & 31, hh = lane >> 5;
        MxC c; mx_consts<MIX>(c, mp, h, dir, lane);
        { const float* ds = dsb + (size_t)((dir * 16 + bh) * NSEG + sg) * (DK * 64);
#pragma unroll
          for (int rt = 0; rt < NRT; ++rt)
#pragma unroll
              for (int t = 0; t < 2; ++t)
#pragma unroll
                  for (int r = 0; r < 16; ++r) ST[rt][t][r] = GLD(float, ds + (32 * rt + (r & 3) + 8 * (r >> 2)) * 64 + 32 * t, 4u * (unsigned)(4 * hh * 64 + m32)); }
        if (dir == 0) mixC_stream<MIX, 0>(mp, c, row0, tpos0, lane, wl, ST, OF, Y, ocol, ycol, cgate, nwv);
        else mixC_stream<MIX, 1>(mp, c, row0, tpos0, lane, wl, ST, OF, Y, ocol, ycol, cgate, nwv);
        asm volatile("s_waitcnt vmcnt(0)" ::: "memory");
    }
}
template <int MSEL>
__device__ __forceinline__ void mix_passA(const Frame& F, const Args& a, int l) {
    const MixP mp = make_mixp(F, a, l); const S5P sp = make_s5p(F, a, l);
    float* ST = (float*)(F.ws + WS_X2);
    LAS unsigned char* wl = F.lds + F.wave * WL_BYTES; LAS float* stg = (LAS float*)wl;
    if (MSEL == 15) {
        for (int u = F.gw; u < 3 * 4224 + 2 * 64 * NSEG; u += F.NGW) {
            if (u < 4224) mixA_unit<0>(mp, ST, u, fresh_lane(), wl);
            else if (u < 2 * 4224) mixA_unit<1>(mp, ST, u - 4224, fresh_lane(), wl);
            else if (u < 3 * 4224) mixA_unit<2>(mp, ST, u - 2 * 4224, fresh_lane(), wl);
            else { const int idx = u - 3 * 4224; const int dir = idx / (64 * NSEG), rem = idx - dir * 64 * NSEG, bg = rem / NSEG, sg = rem - bg * NSEG;
                float hre = 0.f, him = 0.f;
                s5_scan<0>(sp, mp.P, bg >> 4, bg & 15, dir, sg, fresh_lane(), hre, him, nullptr, stg, nullptr);
                float* hs = ST + ST_HS + ((size_t)((dir * 64 + bg) * NSEG + sg) * 64 + fresh_lane()) * 2;
                hs[0] = hre; hs[1] = him; }
        }
        return;
    }
    if (MSEL & 1) for (int u = F.gw; u < 4224; u += F.NGW) mixA_unit<0>(mp, ST, u, fresh_lane(), wl);
    if (MSEL & 2) for (int u = F.gw; u < 4224; u += F.NGW) mixA_unit<1>(mp, ST, u, fresh_lane(), wl);
    if (MSEL & 4) for (int u = F.gw; u < 4224; u += F.NGW) mixA_unit<2>(mp, ST, u, fresh_lane(), wl);
    if (MSEL & 8) for (int idx = F.gw; idx < 2 * 64 * NSEG; idx += F.NGW) {
        const int dir = idx / (64 * NSEG), rem = idx - dir * 64 * NSEG, bg = rem / NSEG, sg = rem - bg * NSEG;
        float hre = 0.f, him = 0.f;
        s5_scan<0>(sp, mp.P, bg >> 4, bg & 15, dir, sg, fresh_lane(), hre, him, nullptr, stg, nullptr);
        float* hs = ST + ST_HS + ((size_t)((dir * 64 + bg) * NSEG + sg) * 64 + fresh_lane()) * 2;
        hs[0] = hre; hs[1] = him;
    }
}
__device__ __forceinline__ int chain_seg(int dir, int p) { return dir ? (p < 4 ? 3 - p : 135 - p) : p; }
__device__ __forceinline__ void mix_passB(const Frame& F, const Args& a, int l) {
    float* ST = (float*)(F.ws + WS_X2);
    constexpr int N0 = 131072, N1 = 131072, N2 = 65536, N3 = 8192;
    for (int e = blockIdx.x * 512 + F.tid; e < N0 + N1 + N2 + N3; e += F.G * 512) {
        if (e < N0 + N1 + N2) {
            float* base; const float* gb; int dir, esz;
            if (e < N0 + N1) { const int mix = e >= N0, e2 = e - mix * N0, c = e2 >> 12, el = e2 & 4095; dir = c >> 4; esz = 4096;
                base = ST + (mix ? ST_DS1 : ST_DS0) + (size_t)c * NSEG * 4096 + el; gb = ST + (mix ? ST_G1 : ST_G0) + (size_t)c * NSEG * 64 + (el >> 6); }
            else { const int e2 = e - N0 - N1, c = e2 >> 11, el = e2 & 2047; dir = c >> 4; esz = 2048;
                base = ST + ST_DS2 + (size_t)c * NSEG * 2048 + el; gb = ST + ST_G2 + (size_t)c * NSEG * 64 + (el >> 6); }
            float run = 0.f;
#pragma unroll 4
            for (int p = 0; p < NSEG; ++p) { const int sg = chain_seg(dir, p); const float d = base[(size_t)sg * esz], gm = gb[sg * 64]; base[(size_t)sg * esz] = run; run = fmaf(gm, run, d); }
        } else {
            const int e2 = e - N0 - N1 - N2, c = e2 >> 6, p = e2 & 63, dir = c >> 6, g = c & 15;
            const int dg = dir * 16 + g;
            const float lre = a.in[F.zz + I_LAMRE][(size_t)l * 2048 + dg * 64 + p], lim = a.in[F.zz + I_LAMIM][(size_t)l * 2048 + dg * 64 + p], dt = expf(a.in[F.zz + I_LOGDT][l * 32 + dg]);
            const float er = expf(lre * dt * 64.0f); const float sn = sinf(lim * dt * 64.0f), cs = cosf(lim * dt * 64.0f);
            const float ar = er * cs, ai = er * sn;
            float* base = ST + ST_HS + ((size_t)c * NSEG * 64 + p) * 2;
            float rr = 0.f, ri = 0.f;
#pragma unroll 4
            for (int q = 0; q < NSEG; ++q) { const int sg = chain_seg(dir, q); float* h = base + (size_t)sg * 128; const float dr = h[0], di = h[1]; h[0] = rr; h[1] = ri;
                const float nr = ar * rr - ai * ri + dr, ni = ar * ri + ai * rr + di; rr = nr; ri = ni; }
        }
    }
}
template <int MSEL>
__device__ __forceinline__ void mix_passC(const Frame& F, const Args& a, int l) {
    const MixP mp = make_mixp(F, a, l); const S5P sp = make_s5p(F, a, l);
    const float* ST = (const float*)(F.ws + WS_X2);
    LAS unsigned char* wl = F.lds + F.wave * WL_BYTES;
    LAS float* stg = (LAS float*)wl; LAS float* of = (LAS float*)(wl + 4096);
    float* OF = (float*)(F.ws + WS_OF);
    bf16* Y = (bf16*)(F.ws + WS_ACT); bf16* Z = (bf16*)(F.ws + WS_Z);
    const bool keep = l < DEPTH - 1;
    constexpr int NM = 16 * NSEG;
    if (MSEL == 15) {
        for (int u = F.gw; u < 3 * NM + 64 * NSEG; u += F.NGW) {
            const int sgu = (u < 3 * NM) ? (u % NSEG) : ((u - 3 * NM) % NSEG);
            if (!keep && sgu < 4) continue;
            if (u < NM) mixC_unit<0>(mp, ST, u, fresh_lane(), OF, wl, Y, a.in[F.zz + I_RETGN] + l * 256);
            else if (u < 2 * NM) mixC_unit<1>(mp, ST, u - NM, fresh_lane(), OF, wl, Y, a.in[F.zz + I_HGNW] + l * 256);
            else if (u < 3 * NM) mixC_unit<2>(mp, ST, u - 2 * NM, fresh_lane(), OF, wl, Y, a.in[F.zz + I_GLANW] + l * 256);
            else { const int idx = u - 3 * NM, bg = idx / NSEG, sg = idx - bg * NSEG;
                const float* h0 = ST + ST_HS + ((size_t)((0 * 64 + bg) * NSEG + sg) * 64 + fresh_lane()) * 2;
                float hre = h0[0], him = h0[1];
                s5_scan<1>(sp, mp.P, bg >> 4, bg & 15, 0, sg, fresh_lane(), hre, him, of, stg, Z);
                const float* h1 = ST + ST_HS + ((size_t)((1 * 64 + bg) * NSEG + sg) * 64 + fresh_lane()) * 2;
                hre = h1[0]; him = h1[1];
                s5_scan<2>(sp, mp.P, bg >> 4, bg & 15, 1, sg, fresh_lane(), hre, him, of, stg, Z); }
        }
        return;
    }
    if (MSEL & 1) for (int u = F.gw; u < NM; u += F.NGW) { if (!keep && (u % NSEG) < 4) continue; mixC_unit<0>(mp, ST, u, fresh_lane(), OF, wl, Y, a.in[F.zz + I_RETGN] + l * 256); }
    if (MSEL & 2) for (int u = F.gw; u < NM; u += F.NGW) { if (!keep && (u % NSEG) < 4) continue; mixC_unit<1>(mp, ST, u, fresh_lane(), OF, wl, Y, a.in[F.zz + I_HGNW] + l * 256); }
    if (MSEL & 4) for (int u = F.gw; u < NM; u += F.NGW) { if (!keep && (u % NSEG) < 4) continue; mixC_unit<2>(mp, ST, u, fresh_lane(), OF, wl, Y, a.in[F.zz + I_GLANW] + l * 256); }
    if (MSEL & 8) for (int idx = F.gw; idx < 64 * NSEG; idx += F.NGW) {
        const int bg = idx / NSEG, sg = idx - bg * NSEG;
        if (!keep && sg < 4) continue;
        const float* h0 = ST + ST_HS + ((size_t)((0 * 64 + bg) * NSEG + sg) * 64 + fresh_lane()) * 2;
        float hre = h0[0], him = h0[1];
        s5_scan<1>(sp, mp.P, bg >> 4, bg & 15, 0, sg, fresh_lane(), hre, him, of, stg, Z);
        const float* h1 = ST + ST_HS + ((size_t)((1 * 64 + bg) * NSEG + sg) * 64 + fresh_lane()) * 2;
        hre = h1[0]; him = h1[1];
        s5_scan<2>(sp, mp.P, bg >> 4, bg & 15, 1, sg, fresh_lane(), hre, him, of, stg, Z);
    }
}

constexpr int NPH = 11;
template <int PH_MASK, int MSEL>
__global__ void __launch_bounds__(512, 2) mk_fwd(Args a) {
    extern __shared__ __attribute__((aligned(16))) unsigned char lds_raw[];
    Frame F;
    F.lds = (LAS unsigned char*)lds_raw;
    const int wave0 = __builtin_amdgcn_readfirstlane((int)threadIdx.x >> 6);
    F.lane = fresh_lane(); F.tid = wave0 * 64 + F.lane; F.wave = wave0;
    F.G = gridDim.x; F.gw = blockIdx.x * 8 + F.wave; F.NGW = F.G * 8; F.zz = 0; F.ws = (unsigned char*)a.in[I_WS]; F.out = (float*)a.in[I_OUT];
    volatile LAS unsigned* MISC = (volatile LAS unsigned*)(F.lds + MISC_OFF);
    for (int u = F.tid; u < 64; u += 512) ((LAS unsigned*)(F.lds + MISC_OFF))[u] = 0u;
    __syncthreads();
    XcdBarrier bar; bar.bar = (unsigned*)F.ws + CW_BAR; bar.x = 0; bar.st = nullptr;
    if (a.fused) bar = xcd_barrier_post((unsigned*)F.ws + CW_BAR, MISC + 8, F.tid);
#define SEAM() do { if (a.fused) { XcdBarrier bb = bar; asm volatile("" : "+s"(bb.bar), "+s"(bb.x)); xcd_barrier(bb, wave0 * 64 + fresh_lane()); } } while (0)
#define PHASE_BEGIN() do { int zz_ = 0; asm volatile("" : "+s"(zz_)); F.zz = zz_; F.ws = (unsigned char*)a.in[I_WS + zz_]; F.out = (float*)a.in[I_OUT + zz_]; \
        const int ln_ = fresh_lane(); const int t_ = wave0 * 64 + ln_ + zz_; F.tid = t_; F.lane = t_ & 63; F.wave = wave0 + zz_; F.G = (int)gridDim.x + zz_; F.gw = ((int)blockIdx.x + zz_) * 8 + F.wave; F.NGW = F.G * 8; \
        F.lds = (LAS unsigned char*)lds_raw + zz_; } while (0)
#define IN(k) (((PH_MASK >> (k)) & 1) && a.ph_lo <= (k) && (k) < a.ph_hi)
#ifndef DUP_PH
#define DUP_PH 0
#endif
#define REP(k) for (int rep_ = 0; rep_ < (((DUP_PH >> (k)) & 1) ? 2 : 1); ++rep_)
#define hb ((float*)(F.ws + WS_HB))
#define MOD ((const float*)(F.ws + WS_MOD))
#define ACT ((bf16*)(F.ws + WS_ACT))
#define PH ((bf16*)(F.ws + WS_PH))

    if (((PH_MASK >> 12) & 1) && a.do_pro) { PHASE_BEGIN(); prologue(F, a); SEAM(); }

#pragma unroll
    for (int l = 0; l < DEPTH; ++l) {
        if (l < a.l_lo || l >= a.l_hi) continue;
        const bool keep = l < DEPTH - 1, moe = l & 1; const int j = l >> 1;
        const int Mrows = keep ? MT : NLAT;
        if (IN(0)) { PHASE_BEGIN();
            norm_phase<0>(F, a, l, 0, MT, (l == 2) ? 1 : -1);
            if (l == 2) { __syncthreads(); moe_cvt(F, a, 1); }
            SEAM();
        }
        if (IN(1)) REP(1) { PHASE_BEGIN();
            pg8::Gemm g{ACT, (const bf16*)(F.ws + WS_WIN) + (size_t)l * DINP * 1024, MT, DINP, 1024}; pg8::StaticOrder S; S.init(MT, DINP, F.G, (int)blockIdx.x);
            EpiStoreBf16 E{PH, DINP};
            pg8::gemm_phase<EpiStoreBf16, pg8::StaticOrder, true, true>(F.lds, g, S, E, F.tid);
            SEAM();
        }
        if (IN(2)) { PHASE_BEGIN(); mix_passA<MSEL>(F, a, l); SEAM(); }
#ifdef DUP_MIX
        if (IN(2)) { PHASE_BEGIN(); mix_passA<DUP_MIX>(F, a, l); SEAM(); }
#endif
        if (IN(3)) { PHASE_BEGIN(); mix_passB(F, a, l); SEAM(); }
        if (IN(4)) { PHASE_BEGIN(); mix_passC<MSEL>(F, a, l); SEAM(); }
#ifdef DUP_MIX
        if (IN(4)) { PHASE_BEGIN(); mix_passC<DUP_MIX>(F, a, l); SEAM(); }
#endif
        if (IN(5)) REP(5) { PHASE_BEGIN();
            int k256 = 256; asm volatile("" : "+s"(k256)); pg8::Gemm g{(const bf16*)(F.ws + WS_Z), (const bf16*)(F.ws + WS_GLUW) + (size_t)l * 65536, Mrows, 256, k256}; pg8::StaticOrder S; S.init(Mrows, 256, F.G, (int)blockIdx.x);
            EpiGlu E{(const bf16*)(F.ws + WS_Z), ACT, a.in[F.zz + I_GLUB] + l * 256};
            pg8::gemm_phase<EpiGlu, pg8::StaticOrder, true, true>(F.lds, g, S, E, F.tid);
            SEAM();
        }
        if (IN(6)) { PHASE_BEGIN();
            pg8::Gemm g{ACT, (const bf16*)(F.ws + WS_WOUT) + (size_t)l * 1024 * 1024, Mrows, 1024, 1024}; pg8::StaticOrder S; S.init(Mrows, 1024, F.G, (int)blockIdx.x);
            EpiResid E{(l == 0) ? a.in[F.zz + I_X] : F.out, (l == 0) ? a.in[F.zz + I_CTX] : hb, F.out, hb, MOD + (size_t)l * 5 * 6144 + 2 * 1024};
            pg8::gemm_phase<EpiResid, pg8::StaticOrder, true, true>(F.lds, g, S, E, F.tid);
            SEAM();
        }
        if (IN(7)) { PHASE_BEGIN();
            if (moe) norm_phase<1>(F, a, l, 1, Mrows, -1); else norm_phase<0>(F, a, l, 1, Mrows, -1);
            SEAM();
        }
        if (!moe) {
            if (IN(8)) REP(8) { PHASE_BEGIN();
                pg8::Gemm g{ACT, (const bf16*)(F.ws + WS_W13D) + (size_t)j * 5632 * 1024, Mrows, 5632, 1024}; pg8::StaticOrder S; S.init(Mrows, 5632, F.G, (int)blockIdx.x);
                EpiSwiglu E{PH};
                pg8::gemm_phase<EpiSwiglu, pg8::StaticOrder, true, true>(F.lds, g, S, E, F.tid);
                SEAM();
            }
            if (IN(9)) { PHASE_BEGIN();
                pg8::Gemm g{PH, (const bf16*)(F.ws + WS_W2D) + (size_t)j * 1024 * DFF, Mrows, 1024, DFF}; pg8::StaticOrder S; S.init(Mrows, 1024, F.G, (int)blockIdx.x);
                EpiResid E{F.out, hb, F.out, hb, MOD + (size_t)l * 5 * 6144 + 5 * 1024};
                pg8::gemm_phase<EpiResid, pg8::StaticOrder, true, true>(F.lds, g, S, E, F.tid);
                SEAM();
            }
        } else {
                        if (IN(8)) REP(8) { PHASE_BEGIN(); moe_gather(F, j); SEAM(); }
            if (IN(9)) REP(9) { PHASE_BEGIN();
                pg8::Gemm g{(const bf16*)(F.ws + WS_X2), (const bf16*)(F.ws + WS_W13M), 0, 5632, 1024}; MoeOrder S; S.init((const unsigned*)F.ws + CW_CNT + j * 8 * 64, 22, F.G, (int)blockIdx.x);
                EpiSwiglu E{PH};
                pg8::gemm_phase<EpiSwiglu, MoeOrder, true, true>(F.lds, g, S, E, F.tid);
                SEAM();
            }
            if (IN(10)) REP(10) { PHASE_BEGIN();
                pg8::Gemm g{PH, (const bf16*)(F.ws + WS_W2M), 0, 1024, DFF}; MoeOrder S; S.init((const unsigned*)F.ws + CW_CNT + j * 8 * 64, 4, F.G, (int)blockIdx.x);
                EpiStoreBf16 E{(bf16*)(F.ws + WS_X2), 1024};
                pg8::gemm_phase<EpiStoreBf16, MoeOrder, true, true>(F.lds, g, S, E, F.tid);
                SEAM();
            }
        }
    }
    if (((PH_MASK >> 13) & 1) && a.do_fin) { PHASE_BEGIN(); norm_phase<2>(F, a, DEPTH - 1, 0, NLAT, DEPTH - 1); }
#undef SEAM
#undef IN
#undef hb
#undef MOD
#undef ACT
#undef PH
}

#ifndef MK_FUSED
#define MK_FUSED 1
#endif
template <int PM, int MS> static void launch_one(const Args& a, int grid, hipStream_t stream) {
    static bool attr_done = false;
    if (!attr_done) { (void)hipFuncSetAttribute((const void*)mk_fwd<PM, MS>, hipFuncAttributeMaxDynamicSharedMemorySize, LDS_BYTES); attr_done = true; }
    hipLaunchKernelGGL((mk_fwd<PM, MS>), dim3(grid), dim3(512), LDS_BYTES, stream, a);
}
extern "C" void kernel_launch(void* const* d_in, const int* in_sizes, int n_in, void* d_out, int out_size, void* d_ws, size_t ws_size, hipStream_t stream) {
    static int grid = 0;
    if (grid == 0) {
        if (n_in != 35 || in_sizes[0] != NLAT * DM || out_size != NLAT * DM || ws_size < WS_END) {
            fprintf(stderr, "kernel_launch: unexpected shapes / workspace (n_in %d, ws %zu, need %zu); nothing launched\n", n_in, ws_size, (size_t)WS_END); grid = -1; return; }
        int dev = 0, cus = 0;
        if (hipGetDevice(&dev) != hipSuccess || hipDeviceGetAttribute(&cus, hipDeviceAttributeMultiprocessorCount, dev) != hipSuccess) { grid = -1; return; }
        grid = cus;
    }
    if (grid < 0) return;
    (void)hipMemsetAsync((char*)d_ws + WS_CTL, 0, CTL_ZERO_BYTES, stream);
    Args a{};
    for (int i = 0; i < 35; ++i) a.in[i] = (const float*)d_in[i];
    a.in[I_OUT] = (const float*)d_out; a.in[I_WS] = (const float*)d_ws; a.pad = 0;
#if MK_FUSED
    a.l_lo = 0; a.l_hi = DEPTH; a.ph_lo = 0; a.ph_hi = NPH; a.do_pro = 1; a.do_fin = 1; a.fused = 1;
#ifndef TEST_PM
#define TEST_PM 0xFFFF
#endif
#ifndef TEST_MS
#define TEST_MS 15
#endif
    launch_one<TEST_PM, TEST_MS>(a, grid, stream);
#else
    a.fused = 0;
    a.l_lo = 0; a.l_hi = 0; a.ph_lo = 0; a.ph_hi = 0; a.do_pro = 1; a.do_fin = 0;
    launch_one<0x1000, 15>(a, grid, stream);
    a.do_pro = 0;
    for (int l = 0; l < DEPTH; ++l) {
        a.l_lo = l; a.l_hi = l + 1; a.ph_lo = 0; a.ph_hi = NPH;
        launch_one<0x1, 15>(a, grid, stream); launch_one<0x2, 15>(a, grid, stream); launch_one<0x4, 15>(a, grid, stream); launch_one<0x8, 15>(a, grid, stream);
        launch_one<0x10, 1>(a, grid, stream); launch_one<0x10, 2>(a, grid, stream); launch_one<0x10, 4>(a, grid, stream); launch_one<0x10, 8>(a, grid, stream);
        launch_one<0x20, 15>(a, grid, stream); launch_one<0x40, 15>(a, grid, stream); launch_one<0x80, 15>(a, grid, stream);
        launch_one<0x100, 15>(a, grid, stream); launch_one<0x200, 15>(a, grid, stream);
        if (l & 1) launch_one<0x400, 15>(a, grid, stream);
    }
    a.l_lo = 0; a.l_hi = 0; a.ph_lo = 0; a.ph_hi = 0; a.do_fin = 1;
    launch_one<0x2000, 15>(a, grid, stream);
#endif
}
```

```cpp
#include <hip/hip_runtime.h>
#include <cstdio>
#include <cstdint>
#define LAS __attribute__((address_space(3)))
namespace pg8 {
#define PG8_LAS __attribute__((address_space(3)))
typedef unsigned short bf16_t;
typedef short bf16x8 __attribute__((ext_vector_type(8)));
typedef float f32x4 __attribute__((ext_vector_type(4)));
typedef unsigned u32x4 __attribute__((ext_vector_type(4)));
constexpr int BM = 256, BK = 64, HALF = 128, HTB = HALF * BK * 2  , STAGE_BYTES = 8 * HTB, NXCD = 8, WGM = 8;

__host__ __device__ __forceinline__ int lds_byte(int r, int c) { const int st = (r >> 4) * 2 + (c >> 5), rr = r & 15, cc = c & 31, ob = rr * 64 + cc * 2; return st * 1024 + (ob ^ (((ob >> 9) & 1) << 5)); }
__host__ __device__ __forceinline__ void stage_rc(int b, int& R, int& C) { const int st = b / 1024, sb = b % 1024, swz = sb ^ (((sb >> 9) & 1) << 5); R = (st >> 1) * 16 + swz / 64; C = (st & 1) * 32 + (swz % 64) / 2; }
__host__ __device__ __forceinline__ int perm32(int rho) { const int n = rho >> 4, i = rho & 15; return 8 * (i >> 2) + 4 * n + (i & 3); }

struct Unit { int pm, pn, pc; };
struct Gemm { const bf16_t* A; const bf16_t* Bt; int M, N, K; };

struct StaticOrder {
    int nM, nN, nwg, G, c;
    __host__ __device__ void init(int M, int N, int G_, int c_) { nM = M / BM; nN = N / BM; nwg = nM * nN; G = G_; c = c_; }
    __host__ __device__ bool next(int i, Unit& u) const {
        const long L = (long)i * G + c; if (L >= nwg) return false;
        int wgid = (int)L; { const int q = nwg / NXCD, r = nwg % NXCD, xcd = wgid % NXCD, off = wgid / NXCD; wgid = (xcd < r ? xcd * (q + 1) : r * (q + 1) + (xcd - r) * q) + off; }
        const int nig = WGM * nN, gid = wgid / nig, fm = gid * WGM, gsz = (nM - fm) < WGM ? (nM - fm) : WGM;
        u.pm = fm + ((wgid % nig) % gsz); u.pn = (wgid % nig) / gsz; u.pc = u.pn; return true;
    }
    __device__ __forceinline__ void a_ready(const Unit&) const {}
    __device__ __forceinline__ void done(const Unit&) const {}
};

__device__ __forceinline__ unsigned cvt_pk_bf16(float lo, float hi) { unsigned r; asm volatile("v_cvt_pk_bf16_f32 %0, %1, %2" : "=v"(r) : "v"(lo), "v"(hi)); return r; }
typedef float f32x2 __attribute__((ext_vector_type(2)));

template <class Epi, class Sched, bool ALIGN_EPI = false, bool SP2 = false>
__device__ __forceinline__ void gemm_phase(PG8_LAS unsigned char* lds, const Gemm g, const Sched& S, const Epi& E, const int tid) {
    const int wid = __builtin_amdgcn_readfirstlane(tid >> 6), lane = tid & 63, wr = wid >> 2, wc = wid & 3, fr = lane & 15, fq = lane >> 4;
    const int K = g.K, nt = K / BK;
    unsigned voffA[2], voffB[2];
#pragma unroll
    for (int i = 0; i < 2; ++i) { int R, C; stage_rc(tid * 16 + i * 8192, R, C); const int Rb = Epi::PERM ? ((R & ~31) + perm32(R & 31)) : R;
        voffA[i] = (unsigned)(R * K + C) * 2u; voffB[i] = (unsigned)(Rb * K + C) * 2u; }
    const size_t kstep = (size_t)(BK * 2);
    const size_t hstep = (size_t)HALF * K * 2;
    const size_t tstep = 2 * hstep;
    const unsigned ldsw = (unsigned)wid * 1024u;
    const int aoff = lds_byte(wr * 64 + fr, fq * 8), boff = lds_byte(wc * 32 + fr, fq * 8);
#define PG8_SA(b, h) (((b) * 2 + (h)) * HTB)
#define PG8_SB(b, h) ((4 + (b) * 2 + (h)) * HTB)
#define PG8_STAGE(bufoff, gbase, voff) do { _Pragma("unroll") for (int _i = 0; _i < 2; ++_i) \
        __builtin_amdgcn_global_load_lds((const unsigned*)((const char*)(gbase) + (voff)[_i]), (PG8_LAS unsigned*)(lds + (bufoff) + ldsw + _i * 8192), 16, 0, 0); } while (0)
#define PG8_LDA(dst, b, h) do { _Pragma("unroll") for (int m = 0; m < 4; ++m) _Pragma("unroll") for (int k = 0; k < 2; ++k) dst[m][k] = *(const PG8_LAS bf16x8*)(lds + PG8_SA(b, h) + aoff + m * 2048 + k * 1024); } while (0)
#define PG8_LDB(dst, b, h) do { _Pragma("unroll") for (int n = 0; n < 2; ++n) _Pragma("unroll") for (int k = 0; k < 2; ++k) dst[n][k] = *(const PG8_LAS bf16x8*)(lds + PG8_SB(b, h) + boff + n * 2048 + k * 1024); } while (0)
#define PG8_MMA(ai, bj, At, Bt) do { __builtin_amdgcn_s_setprio(1); _Pragma("unroll") for (int m = 0; m < 4; ++m) _Pragma("unroll") for (int n = 0; n < 2; ++n) _Pragma("unroll") for (int k = 0; k < 2; ++k) \
        acc[ai][bj][m][n] = __builtin_amdgcn_mfma_f32_16x16x32_bf16(Bt[n][k], At[m][k], acc[ai][bj][m][n], 0, 0, 0); __builtin_amdgcn_s_setprio(0); } while (0)
#define PG8_WAIT_V(n) asm volatile("s_waitcnt vmcnt(" #n ")" ::: "memory")
#define PG8_WAIT_L(n) asm volatile("s_waitcnt lgkmcnt(" #n ")" ::: "memory")
#define PG8_BAR __builtin_amdgcn_s_barrier()
#define PG8_SCHED __builtin_amdgcn_sched_barrier(0)
    Unit cur, nxt; int ui = 0;
    if (!S.next(0, cur)) return;
    f32x4 acc[2][2][4][2];
#pragma unroll
    for (int a = 0; a < 2; ++a)
#pragma unroll
        for (int b = 0; b < 2; ++b)
#pragma unroll
            for (int m = 0; m < 4; ++m)
#pragma unroll
                for (int n = 0; n < 2; ++n) acc[a][b][m][n] = (f32x4){0.f, 0.f, 0.f, 0.f};
    bf16x8 At[4][2], B0[2][2], B1[2][2];
    const char* cA = (const char*)g.A + (size_t)cur.pm * tstep; const char* cB = (const char*)g.Bt + (size_t)cur.pn * tstep;
    S.a_ready(cur);
    if constexpr (SP2) {
        PG8_STAGE(PG8_SB(0, 0), cB, voffB); PG8_STAGE(PG8_SB(0, 1), cB + hstep, voffB); PG8_STAGE(PG8_SA(0, 0), cA, voffA); PG8_STAGE(PG8_SA(0, 1), cA + hstep, voffA);
        if (wr == 1) PG8_BAR;
        PG8_WAIT_V(2); PG8_BAR;
        PG8_STAGE(PG8_SB(1, 0), cB + kstep, voffB); PG8_STAGE(PG8_SA(1, 0), cA + kstep, voffA); PG8_STAGE(PG8_SB(1, 1), cB + hstep + kstep, voffB);
        PG8_WAIT_V(6); PG8_BAR;
    } else {
        PG8_STAGE(PG8_SB(0, 0), cB, voffB); PG8_STAGE(PG8_SA(0, 0), cA, voffA); PG8_STAGE(PG8_SB(0, 1), cB + hstep, voffB); PG8_STAGE(PG8_SA(0, 1), cA + hstep, voffA);
        if (wr == 1) PG8_BAR;
        PG8_WAIT_V(4); PG8_BAR;
        PG8_STAGE(PG8_SB(1, 0), cB + kstep, voffB); PG8_STAGE(PG8_SA(1, 0), cA + kstep, voffA); PG8_STAGE(PG8_SB(1, 1), cB + hstep + kstep, voffB);
        PG8_WAIT_V(6); PG8_BAR;
    }
    for (;;) {
        const bool has_next = S.next(ui + 1, nxt);
        const char* nA = has_next ? (const char*)g.A + (size_t)nxt.pm * tstep : cA; const char* nB = has_next ? (const char*)g.Bt + (size_t)nxt.pn * tstep : cB;
        for (int t = 0; t < nt; t += 2) {
            const bool last = (t == nt - 2);
            const char* a1 = cA + (size_t)(t + 1) * kstep;
            const char* a2 = last ? nA : cA + (size_t)(t + 2) * kstep; const char* b2 = last ? nB : cB + (size_t)(t + 2) * kstep;
            const char* a3 = a2 + kstep; const char* b3 = b2 + kstep;
            if (last && has_next) S.a_ready(nxt);
            if constexpr (SP2) {
            PG8_LDB(B0, 0, 0); PG8_LDB(B1, 0, 1); PG8_SCHED; PG8_LDA(At, 0, 0); PG8_STAGE(PG8_SA(1, 1), a1 + hstep, voffA);
            PG8_WAIT_V(8); PG8_WAIT_L(0); PG8_BAR; PG8_MMA(0, 0, At, B0); PG8_MMA(0, 1, At, B1); PG8_BAR; PG8_SCHED;
            PG8_LDA(At, 0, 1); PG8_STAGE(PG8_SB(0, 0), b2, voffB); PG8_STAGE(PG8_SB(0, 1), b2 + hstep, voffB); PG8_STAGE(PG8_SA(0, 0), a2, voffA);
            PG8_WAIT_V(8); PG8_WAIT_L(0); PG8_BAR; PG8_MMA(1, 0, At, B0); PG8_MMA(1, 1, At, B1); PG8_BAR; PG8_SCHED;
            PG8_LDB(B0, 1, 0); PG8_LDB(B1, 1, 1); PG8_SCHED; PG8_LDA(At, 1, 0); PG8_STAGE(PG8_SA(0, 1), a2 + hstep, voffA);
            PG8_WAIT_V(8); PG8_WAIT_L(0); PG8_BAR; PG8_MMA(0, 0, At, B0); PG8_MMA(0, 1, At, B1); PG8_BAR; PG8_SCHED;
            PG8_LDA(At, 1, 1); PG8_STAGE(PG8_SB(1, 0), b3, voffB); PG8_STAGE(PG8_SB(1, 1), b3 + hstep, voffB); PG8_STAGE(PG8_SA(1, 0), a3, voffA);
            PG8_WAIT_V(8); PG8_WAIT_L(0); PG8_BAR; PG8_MMA(1, 0, At, B0); PG8_MMA(1, 1, At, B1); PG8_BAR; PG8_SCHED;
            } else {
            PG8_LDB(B0, 0, 0); PG8_SCHED; PG8_LDA(At, 0, 0); PG8_STAGE(PG8_SA(1, 1), a1 + hstep, voffA);
            PG8_WAIT_L(8); PG8_BAR; PG8_WAIT_L(0); PG8_MMA(0, 0, At, B0); PG8_BAR; PG8_SCHED;
            PG8_LDB(B1, 0, 1); PG8_STAGE(PG8_SB(0, 0), b2, voffB);
            PG8_BAR; PG8_WAIT_L(0); PG8_MMA(0, 1, At, B1); PG8_BAR;
            PG8_LDA(At, 0, 1); PG8_STAGE(PG8_SA(0, 0), a2, voffA);
            PG8_BAR; PG8_WAIT_L(0); PG8_MMA(1, 0, At, B0); PG8_BAR; PG8_SCHED;
            PG8_STAGE(PG8_SB(0, 1), b2 + hstep, voffB);
            PG8_WAIT_V(6); PG8_BAR; PG8_MMA(1, 1, At, B1); PG8_BAR;
            PG8_LDB(B0, 1, 0); PG8_SCHED; PG8_LDA(At, 1, 0); PG8_STAGE(PG8_SA(0, 1), a2 + hstep, voffA);
            PG8_WAIT_L(8); PG8_BAR; PG8_WAIT_L(0); PG8_MMA(0, 0, At, B0); PG8_BAR; PG8_SCHED;
            PG8_LDB(B1, 1, 1); PG8_STAGE(PG8_SB(1, 0), b3, voffB);
            PG8_BAR; PG8_WAIT_L(0); PG8_MMA(0, 1, At, B1); PG8_BAR;
            PG8_LDA(At, 1, 1); PG8_STAGE(PG8_SA(1, 0), a3, voffA);
            PG8_BAR; PG8_WAIT_L(0); PG8_MMA(1, 0, At, B0); PG8_BAR; PG8_SCHED;
            PG8_STAGE(PG8_SB(1, 1), b3 + hstep, voffB);
            PG8_WAIT_V(6); PG8_BAR; PG8_MMA(1, 1, At, B1); PG8_BAR;
            }
        }
        if constexpr (ALIGN_EPI) { if (wr == 0) PG8_BAR; }
        if constexpr (!Epi::AFTER_DRAIN) { E(acc, cur, wr, wc, fr, fq); S.done(cur); }
        if (!has_next) break;
#pragma unroll
        for (int a = 0; a < 2; ++a)
#pragma unroll
            for (int b = 0; b < 2; ++b)
#pragma unroll
                for (int m = 0; m < 4; ++m)
#pragma unroll
                    for (int n = 0; n < 2; ++n) acc[a][b][m][n] = (f32x4){0.f, 0.f, 0.f, 0.f};
        cur = nxt; cA = nA; cB = nB; ++ui;
        if constexpr (ALIGN_EPI) { if (wr == 1) PG8_BAR; }
    }
    PG8_WAIT_V(0);
    if constexpr (!ALIGN_EPI) { if (wr == 0) PG8_BAR; }
    PG8_BAR;
    if constexpr (Epi::AFTER_DRAIN) { E.fused(acc, cur, wr, wc, fr, fq, lds, wid, lane); S.done(cur); }
#undef PG8_SA
#undef PG8_SB
#undef PG8_STAGE
#undef PG8_LDA
#undef PG8_LDB
#undef PG8_MMA
#undef PG8_WAIT_V
#undef PG8_WAIT_L
#undef PG8_BAR
#undef PG8_SCHED
}
}

#define XB_TMO      128
#define XB_XCNT(j)  (256  + 64 * (j))
#define XB_XSUB(j)  (1280 + 64 * (j))
#define XB_XGEN(j)  (2304 + 64 * (j))
#define XB_TOP      3328
#define XB_TOPGEN   3392
#define XCD_BAR_WORDS 3456
#define XB_SPIN_CAP (1u << 18)

__device__ __forceinline__ unsigned xb_ld(unsigned* p)              { return __hip_atomic_load(p, __ATOMIC_RELAXED, __HIP_MEMORY_SCOPE_AGENT); }
__device__ __forceinline__ unsigned xb_add(unsigned* p, unsigned v) { return __hip_atomic_fetch_add(p, v, __ATOMIC_RELAXED, __HIP_MEMORY_SCOPE_AGENT); }
__device__ __forceinline__ unsigned xb_xcc_id() { return (unsigned)__builtin_amdgcn_s_getreg((3 << 11) | 20) & 0xFu; }
#define XB_SPIN(cond, bar) do { unsigned _sp = 0; while (cond) { __builtin_amdgcn_s_sleep(1); \
    if ((++_sp & 255u) == 0u) { if (xb_ld(&(bar)[XB_TMO])) break; if (_sp > XB_SPIN_CAP) { atomicAdd(&(bar)[XB_TMO], 1u); break; } } } } while (0)

struct XcdBarrier {
    unsigned* bar; unsigned x;
    volatile LAS unsigned* st;
};

__device__ __forceinline__ XcdBarrier xcd_barrier_post(unsigned* bar, volatile LAS unsigned* st, const int xb_tid) {
    XcdBarrier b; b.bar = bar; b.x = xb_xcc_id(); b.st = st;
    if (xb_tid == 0) (void)xb_add(&bar[XB_XCNT(b.x)], 1u);
    return b;
}
__device__ __forceinline__ void xcd_barrier_complete(unsigned* bar, unsigned x, unsigned& nloc, unsigned& nx) {
    const unsigned G = gridDim.x * gridDim.y * gridDim.z;
    unsigned sum, cnt, mine, sp = 0u;
    for (;;) {
        sum = 0u; cnt = 0u; mine = 0u;
#pragma unroll
        for (unsigned j = 0; j < 16; ++j) { const unsigned c = xb_ld(&bar[XB_XCNT(j)]); sum += c; cnt += (c > 0u) ? 1u : 0u; mine = (j == x) ? c : mine; }
        if (sum == G) break;
        __builtin_amdgcn_s_sleep(1);
        if ((++sp & 255u) == 0u) { if (xb_ld(&bar[XB_TMO])) break; if (sp > XB_SPIN_CAP) { atomicAdd(&bar[XB_TMO], 1u); break; } }
    }
    nloc = mine > 0u ? mine : 1u; nx = cnt > 0u ? cnt : 1u;
}

__device__ __forceinline__ void xcd_barrier(const XcdBarrier& b, const int xb_tid) {
    asm volatile("s_waitcnt vmcnt(0)" ::: "memory");
    __syncthreads();
    if (xb_tid == 0) {
        unsigned* bar = b.bar;
        __builtin_amdgcn_s_waitcnt(0);
        unsigned nloc = b.st[0], nx = b.st[1];
        if (nloc == 0u) { xcd_barrier_complete(bar, b.x, nloc, nx); b.st[0] = nloc; b.st[1] = nx; }
        const unsigned old = xb_add(&bar[XB_XSUB(b.x)], 1u);
        const unsigned gen = old / nloc;
        if (old + 1u == (gen + 1u) * nloc) {
            __builtin_amdgcn_fence(__ATOMIC_RELEASE, "agent");
            asm volatile("s_waitcnt vmcnt(0)" ::: "memory");
            const unsigned og = xb_add(&bar[XB_TOP], 1u);
            const unsigned tg = og / nx;
            if (og + 1u == (tg + 1u) * nx) xb_add(&bar[XB_TOPGEN], 1u);
            else XB_SPIN(xb_ld(&bar[XB_TOPGEN]) == tg, bar);
            __builtin_amdgcn_fence(__ATOMIC_ACQUIRE, "agent");
            xb_add(&bar[XB_XGEN(b.x)], 1u);
            asm volatile("s_waitcnt vmcnt(0)" ::: "memory");
        } else {
            XB_SPIN(xb_ld(&bar[XB_XGEN(b.x)]) == gen, bar);
            __builtin_amdgcn_fence(__ATOMIC_ACQUIRE, "agent");
            asm volatile("s_waitcnt vmcnt(0)" ::: "memory");
        }
    }
    __syncthreads();
}

#define GAS __attribute__((address_space(1)))
typedef unsigned short bf16;
typedef unsigned v4u __attribute__((ext_vector_type(4)));
typedef unsigned v2u __attribute__((ext_vector_type(2)));
typedef float f32x4 __attribute__((ext_vector_type(4)));

constexpr int NB = 4, SEQ = 8192, DM = 1024, DEPTH = 4, CTXL = 256;
constexpr int NLAT = NB * SEQ, NCTX = NB * CTXL, MT = NLAT + NCTX;
constexpr int DIN = 3360, DINP = 3584, DFF = 2816, NEXP = 8;
constexpr int C_RQ = 0, C_RK = 256, C_RV = 512, C_RG = 768, C_S5 = 1024, C_HQ = 1280, C_HFF = 1536, C_HFB = 1792, C_HI = 2048, C_HG = 2304,
              C_GQ = 2560, C_GK = 2688, C_GV = 2816, C_GG = 3072, C_GAF = 3328, C_GAB = 3344,
              C_GZF = 3328, C_GZB = 3456;
constexpr int NSEG = 132;
constexpr int MOE_CAP_TILES = 272;
constexpr float NEPS = 1e-6f;

constexpr size_t MiB = 1u << 20;
constexpr size_t WS_CTL = 0, CTL_ZERO_BYTES = 2 * MiB;
constexpr size_t WS_MOD = 2 * MiB;
constexpr size_t WS_LB = 3 * MiB;
constexpr size_t WS_ROPE = 3 * MiB + 65536;
constexpr size_t WS_GLUW = 3 * MiB + 131072;
constexpr size_t WS_WIN = 4 * MiB;
constexpr size_t WS_WOUT = 32 * MiB;
constexpr size_t WS_W13D = 40 * MiB;
constexpr size_t WS_W2D = 62 * MiB;
constexpr size_t WS_W13M = 73 * MiB;
constexpr size_t WS_W2M = 161 * MiB;
constexpr size_t WS_HB = 205 * MiB;
constexpr size_t WS_ACT = 209 * MiB;
constexpr size_t WS_Z = 275 * MiB;
constexpr size_t WS_PH = 292 * MiB;
constexpr size_t WS_OF = (292 + 232) * MiB;
constexpr size_t WS_X2 = 666 * MiB;
constexpr size_t WS_LIST = 843 * MiB;
constexpr size_t WS_END = 846 * MiB;
constexpr size_t ST_DS0 = 0;
constexpr size_t ST_DS1 = ST_DS0 + (size_t)2 * 16 * NSEG * 4096;
constexpr size_t ST_DS2 = ST_DS1 + (size_t)2 * 16 * NSEG * 4096;
constexpr size_t ST_G0 = ST_DS2 + (size_t)2 * 16 * NSEG * 2048;
constexpr size_t ST_G1 = ST_G0 + (size_t)2 * 16 * NSEG * 64;
constexpr size_t ST_G2 = ST_G1 + (size_t)2 * 16 * NSEG * 64;
constexpr size_t ST_HS = ST_G2 + (size_t)2 * 16 * NSEG * 64;
constexpr size_t ST_END = ST_HS + (size_t)2 * 64 * NSEG * 128;
static_assert(ST_END * 4 <= (WS_LIST - WS_X2), "state region");
static_assert(WS_PH + (size_t)MT * DINP * 2 <= WS_OF && WS_OF + (size_t)MT * 768 * 4 <= WS_X2, "OF region");
static_assert((size_t)MOE_CAP_TILES * 256 * 1024 * 2 <= (WS_LIST - WS_X2), "XB region");
static_assert((size_t)MOE_CAP_TILES * 256 * DFF * 2 <= (WS_X2 - WS_PH) && (size_t)MT * DINP * 2 <= (WS_X2 - WS_PH), "P/H region");
constexpr int CW_BAR = 4096;
constexpr int CW_CNT = 16384;

constexpr int LDS_BYTES = 163840;
constexpr int MISC_OFF = 163840 - 512;

__device__ __forceinline__ float bf2f(unsigned short h) { return __uint_as_float(((unsigned)h) << 16); }
__device__ __forceinline__ unsigned f2bf(float f) { unsigned u = __float_as_uint(f); return (u + 0x7fffu + ((u >> 16) & 1u)) >> 16; }
__device__ __forceinline__ unsigned pk2(float lo, float hi) { return f2bf(lo) | (f2bf(hi) << 16); }
__device__ __forceinline__ float wave_sum(float v) {
#pragma unroll
    for (int o = 1; o < 64; o <<= 1) v += __shfl_xor(v, o);
    return v;
}
__device__ __forceinline__ float rdl(float v, int k) { return __uint_as_float((unsigned)__builtin_amdgcn_readlane((int)__float_as_uint(v), k)); }
__device__ __forceinline__ float sigm(float x) { return 1.0f / (1.0f + __expf(-x)); }
__device__ __forceinline__ float silu_f(float x) { return x / (1.0f + __expf(-x)); }
#define LDS_WAIT() asm volatile("s_waitcnt lgkmcnt(0)" ::: "memory")

struct Args {
    const float* in[37];
    int l_lo, l_hi, ph_lo, ph_hi, do_pro, do_fin, fused, pad;
};
constexpr int I_OUT = 35, I_WS = 36;
enum { I_X = 0, I_C, I_CTX, I_CCTX, I_ADAW, I_ADAB, I_N1W, I_N2W, I_WIN, I_WOUT, I_RETGN, I_LAMRE, I_LAMIM, I_LOGDT, I_BRE, I_BIM, I_CRE, I_CIM, I_S5D,
       I_GLUW, I_GLUB, I_LBL, I_HGNW, I_WA2, I_BA, I_GLANW, I_FW1, I_FW3, I_FW2, I_RW, I_RB, I_MW1, I_MW3, I_MW2, I_FINW };

struct Frame {
    LAS unsigned char* lds;
    int tid, lane, wave, gw, NGW, G, zz;
    unsigned char* ws; float* out;
};

struct EpiStoreBf16 {
    static constexpr bool PERM = true, AFTER_DRAIN = false;
    bf16* O; int ldc;
    __device__ __forceinline__ void operator()(const pg8::f32x4 (&acc)[2][2][4][2], const pg8::Unit& u, int wr, int wc, int fr, int fq) const {
        const int row0 = u.pm * 256 + wr * 64 + fr, col0 = u.pc * 256 + wc * 32 + 8 * fq;
#pragma unroll
        for (int ai = 0; ai < 2; ++ai)
#pragma unroll
            for (int m = 0; m < 4; ++m) { bf16* rowp = O + (size_t)(row0 + ai * 128 + m * 16) * ldc + col0;
#pragma unroll
                for (int bj = 0; bj < 2; ++bj) { const pg8::f32x4 v0 = acc[ai][bj][m][0], v1 = acc[ai][bj][m][1];
                    pg8::u32x4 w; w.x = pg8::cvt_pk_bf16(v0[0], v0[1]); w.y = pg8::cvt_pk_bf16(v0[2], v0[3]); w.z = pg8::cvt_pk_bf16(v1[0], v1[1]); w.w = pg8::cvt_pk_bf16(v1[2], v1[3]);
                    *(pg8::u32x4*)(rowp + bj * 128) = w; } }
    }
};
struct EpiSwiglu {
    static constexpr bool PERM = true, AFTER_DRAIN = false;
    bf16* H;
    __device__ __forceinline__ void operator()(const pg8::f32x4 (&acc)[2][2][4][2], const pg8::Unit& u, int wr, int wc, int fr, int fq) const {
        const int row0 = u.pm * 256 + wr * 64 + fr, col0 = u.pc * 128 + wc * 32 + 8 * fq;
#pragma unroll
        for (int ai = 0; ai < 2; ++ai)
#pragma unroll
            for (int m = 0; m < 4; ++m) { bf16* rowp = H + (size_t)(row0 + ai * 128 + m * 16) * DFF + col0;
                float h[8];
#pragma unroll
                for (int n = 0; n < 2; ++n)
#pragma unroll
                    for (int j = 0; j < 4; ++j) { const float a = acc[ai][0][m][n][j], b = acc[ai][1][m][n][j];
                        h[n * 4 + j] = a * __builtin_amdgcn_rcpf(1.0f + __builtin_amdgcn_exp2f(-1.4426950408889634f * a)) * b; }
                pg8::u32x4 w; w.x = pg8::cvt_pk_bf16(h[0], h[1]); w.y = pg8::cvt_pk_bf16(h[2], h[3]); w.z = pg8::cvt_pk_bf16(h[4], h[5]); w.w = pg8::cvt_pk_bf16(h[6], h[7]);
                *(pg8::u32x4*)rowp = w; }
    }
};
struct EpiResid {
    static constexpr bool PERM = false, AFTER_DRAIN = false;
    const float* xin_lat; const float* xin_ctx; float* xout_lat; float* xout_ctx; const float* gate;
    __device__ __forceinline__ void operator()(const pg8::f32x4 (&acc)[2][2][4][2], const pg8::Unit& u, int wr, int wc, int fr, int fq) const {
        const bool isctx = u.pm >= 128; const int bidx = isctx ? 4 : (u.pm >> 5);
        const size_t rbase = (size_t)(isctx ? (u.pm - 128) : u.pm) * 256 + wr * 64 + fr;
        const float* xi = (isctx ? xin_ctx : xin_lat); float* xo = (isctx ? xout_ctx : xout_lat);
        const int col0 = u.pc * 256 + wc * 32 + 4 * fq; const float* g = gate + (size_t)bidx * 6144 + col0;
        pg8::f32x4 gv[2][2];
#pragma unroll
        for (int bj = 0; bj < 2; ++bj)
#pragma unroll
            for (int n = 0; n < 2; ++n) gv[bj][n] = *(const pg8::f32x4*)(g + bj * 128 + n * 16);
#pragma unroll
        for (int ai = 0; ai < 2; ++ai)
#pragma unroll
            for (int m = 0; m < 4; ++m) { const size_t off = (rbase + ai * 128 + m * 16) * 1024 + col0;
#pragma unroll
                for (int bj = 0; bj < 2; ++bj)
#pragma unroll
                    for (int n = 0; n < 2; ++n) { const pg8::f32x4 xv = *(const pg8::f32x4*)(xi + off + bj * 128 + n * 16);
                        *(pg8::f32x4*)(xo + off + bj * 128 + n * 16) = xv + gv[bj][n] * acc[ai][bj][m][n]; }
                asm volatile("" ::: "memory"); }
    }
};
struct EpiGlu {
    static constexpr bool PERM = true, AFTER_DRAIN = false;
    const bf16* Z; bf16* Y; const float* bias;
    __device__ __forceinline__ void operator()(const pg8::f32x4 (&acc)[2][2][4][2], const pg8::Unit& u, int wr, int wc, int fr, int fq) const {
        const int row0 = u.pm * 256 + wr * 64 + fr, col0 = wc * 32 + 8 * fq;
#pragma unroll
        for (int ai = 0; ai < 2; ++ai)
#pragma unroll
            for (int m = 0; m < 4; ++m) { const size_t row = (size_t)(row0 + ai * 128 + m * 16);
#pragma unroll
                for (int bj = 0; bj < 2; ++bj) { const int col = col0 + bj * 128;
                    const pg8::u32x4 zz = *(const pg8::u32x4*)(Z + row * 256 + col);
                    const pg8::f32x4 b0 = *(const pg8::f32x4*)(bias + col), b1 = *(const pg8::f32x4*)(bias + col + 4);
                    const pg8::f32x4 v0 = acc[ai][bj][m][0] + b0, v1 = acc[ai][bj][m][1] + b1;
                    float o[8]; const unsigned zw[4] = {zz.x, zz.y, zz.z, zz.w};
#pragma unroll
                    for (int j = 0; j < 4; ++j) { const float zl = __uint_as_float(zw[j] << 16), zh = __uint_as_float(zw[j] & 0xffff0000u);
                        const float a0 = (j < 2) ? v0[2 * j] : v1[2 * j - 4], a1 = (j < 2) ? v0[2 * j + 1] : v1[2 * j - 3];
                        o[2 * j] = zl * sigm(a0); o[2 * j + 1] = zh * sigm(a1); }
                    pg8::u32x4 w; w.x = pg8::cvt_pk_bf16(o[0], o[1]); w.y = pg8::cvt_pk_bf16(o[2], o[3]); w.z = pg8::cvt_pk_bf16(o[4], o[5]); w.w = pg8::cvt_pk_bf16(o[6], o[7]);
                    *(pg8::u32x4*)(Y + row * 1024 + 256 + col) = w; }
                asm volatile("" ::: "memory"); }
    }
};
struct MoeOrder {
    int tp[9]; int nN, G, c, total;
    __device__ __forceinline__ void init(const unsigned* cnt, int nN_, int G_, int c_) {
        tp[0] = 0;
#pragma unroll
        for (int e = 0; e < 8; ++e) tp[e + 1] = tp[e] + (int)(((unsigned)__builtin_amdgcn_readfirstlane((int)__hip_atomic_load(cnt + e * 64, __ATOMIC_RELAXED, __HIP_MEMORY_SCOPE_AGENT)) + 255u) >> 8);
        nN = nN_; G = G_; c = c_; total = tp[8] * nN;
    }
    __device__ __forceinline__ bool next(int i, pg8::Unit& u) const {
        const int L = i * G + c; if (L >= total) return false;
        const int t = L / nN, pn = L - t * nN; int e = 0;
#pragma unroll
        for (int k = 1; k < 8; ++k) e += (t >= tp[k]) ? 1 : 0;
        u.pm = t; u.pn = e * nN + pn; u.pc = pn; return true;
    }
    __device__ __forceinline__ void a_ready(const pg8::Unit&) const {}
    __device__ __forceinline__ void done(const pg8::Unit&) const {}
};

__device__ __forceinline__ void cvt_item(const float* W, int K, int N, bf16* WT, int mode, int add, LAS float* scr, int item, int lane, int nblk_override = 0) {
    const int nblk = nblk_override ? nblk_override : (N >> 5), kb = item / nblk, nb = item - kb * nblk, k0 = 64 * kb, n0 = 32 * nb;
    const int r = lane >> 3, c4 = lane & 7;
    f32x4 v[8];
#pragma unroll
    for (int i = 0; i < 8; ++i) v[i] = *(const f32x4*)(W + (size_t)(k0 + 8 * i + r) * N + n0 + 4 * c4);
#pragma unroll
    for (int i = 0; i < 8; ++i) {
#pragma unroll
        for (int j = 0; j < 4; ++j) scr[(8 * i + r) * 33 + 4 * c4 + j] = v[i][j]; }
    LDS_WAIT();
    const int c = lane & 7;
#pragma unroll
    for (int j = 0; j < 4; ++j) { const int n = (lane >> 3) + 8 * j; const LAS float* s = scr + (8 * c) * 33 + n;
        v4u o; o.x = pk2(s[0 * 33], s[1 * 33]); o.y = pk2(s[2 * 33], s[3 * 33]); o.z = pk2(s[4 * 33], s[5 * 33]); o.w = pk2(s[6 * 33], s[7 * 33]);
        const int nn = n0 + n; const int drow = (mode == 0) ? (nn + add) : (((nn >> 7) << 8) + (nn & 127) + add);
        *(v4u*)(WT + (size_t)drow * K + k0 + 8 * c) = o; }
    LDS_WAIT();
}
__device__ __forceinline__ void moe_cvt(const Frame& F, const Args& a, int j) {
    LAS float* scr = (LAS float*)(F.lds + F.wave * 16384);
    constexpr int IT = 1408;
    for (int it = F.gw; it < 8 * 3 * IT; it += F.NGW) {
        const int e = it / (3 * IT), r = it - e * 3 * IT, which = r / IT, item = r - which * IT;
        const size_t eo = ((size_t)j * 8 + e) * (size_t)(1024 * DFF);
        if (which == 0) cvt_item(a.in[F.zz + I_MW1] + eo, 1024, DFF, (bf16*)(F.ws + WS_W13M) + (size_t)e * 5632 * 1024, 1, 0, scr, item, F.lane);
        else if (which == 1) cvt_item(a.in[F.zz + I_MW3] + eo, 1024, DFF, (bf16*)(F.ws + WS_W13M) + (size_t)e * 5632 * 1024, 1, 128, scr, item, F.lane);
        else cvt_item(a.in[F.zz + I_MW2] + eo, DFF, 1024, (bf16*)(F.ws + WS_W2M) + (size_t)e * 1024 * DFF, 0, 0, scr, item, F.lane);
    }
}
__device__ __forceinline__ void prologue(const Frame& F, const Args& a) {
    {
        LAS float* sc = (LAS float*)F.lds; LAS float* red = sc + 5120;
        for (int idx = F.tid; idx < 5120; idx += 512) { const int r = idx >> 10, k = idx & 1023; const float cv = (r < 4) ? a.in[F.zz + I_C][r * 1024 + k] : a.in[F.zz + I_CCTX][k]; sc[idx] = silu_f(cv); }
        __syncthreads();
        float* MOD = (float*)(F.ws + WS_MOD);
        for (int item = blockIdx.x; item < 384; item += F.G) {
            const int l = item / 96, nb = item - l * 96, cl = F.tid & 63, ks = F.tid >> 6, n = nb * 64 + cl;
            float acc[5] = {0.f, 0.f, 0.f, 0.f, 0.f};
            const float* wp = a.in[F.zz + I_ADAW] + ((size_t)l * 1024 + ks * 128) * 6144 + n;
#pragma unroll 16
            for (int kk = 0; kk < 128; ++kk) { const float w = wp[(size_t)kk * 6144];
#pragma unroll
                for (int r = 0; r < 5; ++r) acc[r] = fmaf(sc[r * 1024 + ks * 128 + kk], w, acc[r]); }
#pragma unroll
            for (int r = 0; r < 5; ++r) red[(ks * 5 + r) * 64 + cl] = acc[r];
            __syncthreads();
            if (F.tid < 320) { const int r = F.tid >> 6; float s = 0.f;
#pragma unroll
                for (int k2 = 0; k2 < 8; ++k2) s += red[(k2 * 5 + r) * 64 + cl];
                MOD[((size_t)l * 5 + r) * 6144 + n] = s + a.in[F.zz + I_ADAB][l * 6144 + n]; }
            __syncthreads();
        }
        if (blockIdx.x == 0 && F.tid < 256) {
            const float* lg = a.in[F.zz + I_LBL]; float x[4], mx = -3.0e38f;
#pragma unroll
            for (int l = 0; l < 4; ++l) { x[l] = lg[l * 256 + F.tid]; mx = fmaxf(mx, x[l]); }
            float s = 0.f;
#pragma unroll
            for (int l = 0; l < 4; ++l) { x[l] = expf(x[l] - mx); s += x[l]; }
            float cs = 0.f; const float sm0 = x[0] / s; float* LB = (float*)(F.ws + WS_LB);
#pragma unroll
            for (int l = 0; l < 4; ++l) { cs += x[l] / s; LB[l * 256 + F.tid] = fminf(fmaxf(cs - sm0, 0.f), 1.0f - 1e-6f); }
        }
        if (blockIdx.x == (1 % F.G)) {
            float* RC = (float*)(F.ws + WS_ROPE); float* RS = RC + 2048;
            for (int idx = F.tid; idx < 2048; idx += 512) { const int pos = idx >> 4, i = idx & 15;
                const float fr = powf(10000.0f, -(float)i / 16.0f); const float ang = (float)pos * fr; RC[idx] = cosf(ang); RS[idx] = sinf(ang); }
        }
        __syncthreads();
    }
    LAS float* scr = (LAS float*)(F.lds + F.wave * 16384);
    constexpr int I_IN = 16 * 104, I_OUT = 16 * 32, I_F = 1408, I_GL = 4 * 8;
    constexpr int NIT = 4 * I_IN + 4 * I_OUT + 6 * I_F + 4 * I_GL;
    for (int it = F.gw; it < NIT; it += F.NGW) {
        int r = it;
        if (r < 4 * I_IN) { const int l = r / I_IN; cvt_item(a.in[F.zz + I_WIN] + (size_t)l * 1024 * DIN, 1024, DIN, (bf16*)(F.ws + WS_WIN) + (size_t)l * DINP * 1024, 0, 0, scr, r - l * I_IN, F.lane, 104); continue; } r -= 4 * I_IN;
        if (r < 4 * I_OUT) { const int l = r / I_OUT; cvt_item(a.in[F.zz + I_WOUT] + (size_t)l * 1024 * 1024, 1024, 1024, (bf16*)(F.ws + WS_WOUT) + (size_t)l * 1024 * 1024, 0, 0, scr, r - l * I_OUT, F.lane); continue; } r -= 4 * I_OUT;
        if (r < 6 * I_F) { const int j = r / (3 * I_F), r2 = r - j * 3 * I_F, which = r2 / I_F, item = r2 - which * I_F; const size_t wo = (size_t)j * 1024 * DFF;
            if (which == 0) cvt_item(a.in[F.zz + I_FW1] + wo, 1024, DFF, (bf16*)(F.ws + WS_W13D) + (size_t)j * 5632 * 1024, 1, 0, scr, item, F.lane);
            else if (which == 1) cvt_item(a.in[F.zz + I_FW3] + wo, 1024, DFF, (bf16*)(F.ws + WS_W13D) + (size_t)j * 5632 * 1024, 1, 128, scr, item, F.lane);
            else cvt_item(a.in[F.zz + I_FW2] + wo, DFF, 1024, (bf16*)(F.ws + WS_W2D) + (size_t)j * 1024 * DFF, 0, 0, scr, item, F.lane);
            continue; } r -= 6 * I_F;
        { const int l = r / I_GL; cvt_item(a.in[F.zz + I_GLUW] + (size_t)l * 65536, 256, 256, (bf16*)(F.ws + WS_GLUW) + (size_t)l * 65536, 0, 0, scr, r - l * I_GL, F.lane); }
    }
    moe_cvt(F, a, 0);
    for (int i = blockIdx.x * 512 + F.tid; i < 4 * 256 * 128; i += F.G * 512) {
        const int l = i >> 15, rem = i & 32767, n = rem >> 7, k0 = (rem & 127) * 8, d = n >> 7, cidx = n & 127;
        const float* wa = a.in[F.zz + I_WA2] + ((size_t)(l * 2 + d) * 16) * 128 + cidx;
        float acc[8] = {0.f, 0.f, 0.f, 0.f, 0.f, 0.f, 0.f, 0.f};
#pragma unroll
        for (int r = 0; r < 16; ++r) { const float w2 = wa[r * 128];
#pragma unroll
            for (int kk = 0; kk < 8; ++kk) acc[kk] = fmaf(a.in[F.zz + I_WIN][((size_t)l * 1024 + k0 + kk) * DIN + 3328 + 16 * d + r], w2, acc[kk]); }
        v4u o; o.x = pk2(acc[0], acc[1]); o.y = pk2(acc[2], acc[3]); o.z = pk2(acc[4], acc[5]); o.w = pk2(acc[6], acc[7]);
        *(v4u*)((bf16*)(F.ws + WS_WIN) + ((size_t)l * DINP + 3328 + n) * 1024 + k0) = o;
    }
}

struct MoeTp { int tp[9]; };
__device__ __forceinline__ void load_tp(MoeTp& t, const unsigned* cnt) {
    t.tp[0] = 0;
#pragma unroll
    for (int e = 0; e < 8; ++e) t.tp[e + 1] = t.tp[e] + (int)(((unsigned)__builtin_amdgcn_readfirstlane((int)__hip_atomic_load(cnt + e * 64, __ATOMIC_RELAXED, __HIP_MEMORY_SCOPE_AGENT)) + 255u) >> 8);
}
template <int MODE>
__device__ __forceinline__ void norm_phase(const Frame& F, const Args& a, int l, int which  , int nrows, int comb_l  ) {
    const float* MOD = (const float*)(F.ws + WS_MOD);
    const float* nw = (MODE == 2) ? a.in[F.zz + I_FINW] : ((which ? a.in[F.zz + I_N2W] : a.in[F.zz + I_N1W]) + l * 1024);
    bf16* XN = (bf16*)(F.ws + WS_ACT);
    float* hb = (float*)(F.ws + WS_HB);
    const int* EP = (const int*)(F.ws + WS_LIST) + 8 * MT; const float* GATE = (const float*)(F.ws + WS_LIST) + 10 * MT;
    const bf16* YM = (const bf16*)(F.ws + WS_X2);
    const bool from_input = (l == 0 && which == 0 && MODE != 2);
    MoeTp ctp; if (comb_l >= 0) load_tp(ctp, (const unsigned*)F.ws + CW_CNT + (comb_l >> 1) * 8 * 64);
    const int jm = l >> 1;
    LAS float* rwl = (LAS float*)F.lds;
    if (MODE == 1) {
        const float* rw = a.in[F.zz + I_RW] + (size_t)jm * 8192;
        for (int idx = F.tid; idx < 8192; idx += 512) { const int k = idx >> 3, e = idx & 7; rwl[e * 1024 + k] = rw[idx]; }
        __syncthreads();
    }
    f32x4 wv[4];
#pragma unroll
    for (int j = 0; j < 4; ++j) wv[j] = *((const f32x4*)nw + F.lane + 64 * j);
    for (int m = F.gw; m < nrows; m += F.NGW) {
        const bool isctx = m >= NLAT; const int bidx = isctx ? 4 : (m >> 13);
        const float* xr = from_input ? (isctx ? a.in[F.zz + I_CTX] + (size_t)(m - NLAT) * 1024 : a.in[F.zz + I_X] + (size_t)m * 1024)
                                     : (isctx ? hb + (size_t)(m - NLAT) * 1024 : F.out + (size_t)m * 1024);
        f32x4 v[4];
#pragma unroll
        for (int j = 0; j < 4; ++j) v[j] = *((const f32x4*)xr + F.lane + 64 * j);
        if (comb_l >= 0) {
            const int ep0 = EP[2 * m], ep1 = EP[2 * m + 1]; const float g0 = GATE[2 * m], g1 = GATE[2 * m + 1];
            int t0 = 0, t1 = 0;
#pragma unroll
            for (int e = 0; e < 8; ++e) { t0 = ((ep0 & 7) == e) ? ctp.tp[e] : t0; t1 = ((ep1 & 7) == e) ? ctp.tp[e] : t1; }
            const size_t d0 = (size_t)t0 * 256 + (ep0 >> 3), d1 = (size_t)t1 * 256 + (ep1 >> 3);
            const float* m5 = MOD + ((size_t)comb_l * 5 + bidx) * 6144 + 5 * 1024;
            float* xw = isctx ? hb + (size_t)(m - NLAT) * 1024 : F.out + (size_t)m * 1024;
#pragma unroll
            for (int j = 0; j < 4; ++j) {
                const v2u y0 = *((const v2u*)(YM + d0 * 1024) + F.lane + 64 * j), y1 = *((const v2u*)(YM + d1 * 1024) + F.lane + 64 * j);
                const f32x4 mm = *((const f32x4*)m5 + F.lane + 64 * j);
                f32x4 f0, f1;
                f0[0] = __uint_as_float(y0.x << 16); f0[1] = __uint_as_float(y0.x & 0xffff0000u); f0[2] = __uint_as_float(y0.y << 16); f0[3] = __uint_as_float(y0.y & 0xffff0000u);
                f1[0] = __uint_as_float(y1.x << 16); f1[1] = __uint_as_float(y1.x & 0xffff0000u); f1[2] = __uint_as_float(y1.y << 16); f1[3] = __uint_as_float(y1.y & 0xffff0000u);
                v[j] = v[j] + mm * (f0 * g0 + f1 * g1);
                if (MODE != 2) *((f32x4*)xw + F.lane + 64 * j) = v[j];
            }
        }
        float ss = 0.f;
#pragma unroll
        for (int j = 0; j < 4; ++j) ss += (v[j][0] * v[j][0] + v[j][1] * v[j][1]) + (v[j][2] * v[j][2] + v[j][3] * v[j][3]);
        ss = wave_sum(ss);
        const float rstd = 1.0f / sqrtf(ss * (1.0f / 1024.0f) + NEPS);
        if (MODE == 2) {
#pragma unroll
            for (int j = 0; j < 4; ++j) *((f32x4*)(F.out + (size_t)m * 1024) + F.lane + 64 * j) = v[j] * rstd * wv[j];
        } else {
            const float* sh = MOD + ((size_t)l * 5 + bidx) * 6144 + (which ? 3 : 0) * 1024; const float* scl = sh + 1024;
            f32x4 o[4];
#pragma unroll
            for (int j = 0; j < 4; ++j) { const f32x4 s1 = *((const f32x4*)scl + F.lane + 64 * j), s0 = *((const f32x4*)sh + F.lane + 64 * j);
                o[j] = (v[j] * rstd * wv[j]) * (s1 + 1.0f) + s0;
                v2u w; w.x = pk2(o[j][0], o[j][1]); w.y = pk2(o[j][2], o[j][3]);
                *((v2u*)(XN + (size_t)m * 1024) + F.lane + 64 * j) = w; }
            if (MODE == 1) {
                float p[8];
#pragma unroll
                for (int e = 0; e < 8; ++e) { float s = 0.f;
#pragma unroll
                    for (int j = 0; j < 4; ++j) { const f32x4 w4 = *((const LAS f32x4*)(rwl + e * 1024) + F.lane + 64 * j);
                        s += (o[j][0] * w4[0] + o[j][1] * w4[1]) + (o[j][2] * w4[2] + o[j][3] * w4[3]); }
                    p[e] = wave_sum(s) + a.in[F.zz + I_RB][jm * 8 + e]; }
                int e0 = 0; float v0 = p[0];
#pragma unroll
                for (int e = 1; e < 8; ++e) if (p[e] > v0) { v0 = p[e]; e0 = e; }
                int e1 = -1; float v1 = -3.0e38f;
#pragma unroll
                for (int e = 0; e < 8; ++e) if (e != e0 && p[e] > v1) { v1 = p[e]; e1 = e; }
                const float ex = expf(v1 - v0), g0 = 1.0f / (1.0f + ex), g1 = ex / (1.0f + ex);
                if (F.lane == 0) {
                    unsigned* cnt = (unsigned*)F.ws + CW_CNT + jm * 8 * 64; int* LIST = (int*)(F.ws + WS_LIST);
                    int* EPw = (int*)(F.ws + WS_LIST) + 8 * MT; float* GW = (float*)(F.ws + WS_LIST) + 10 * MT;
                    const unsigned p0 = __hip_atomic_fetch_add(cnt + e0 * 64, 1u, __ATOMIC_RELAXED, __HIP_MEMORY_SCOPE_AGENT);
                    const unsigned p1 = __hip_atomic_fetch_add(cnt + e1 * 64, 1u, __ATOMIC_RELAXED, __HIP_MEMORY_SCOPE_AGENT);
                    LIST[e0 * MT + p0] = m; LIST[e1 * MT + p1] = m;
                    EPw[2 * m] = e0 | (int)(p0 << 3); EPw[2 * m + 1] = e1 | (int)(p1 << 3);
                    GW[2 * m] = g0; GW[2 * m + 1] = g1;
                }
            }
        }
    }
    if (MODE == 1) __syncthreads();
}
__device__ __forceinline__ void moe_gather(const Frame& F, int jm) {
    const unsigned* cnt = (const unsigned*)F.ws + CW_CNT + jm * 8 * 64;
    MoeTp t; load_tp(t, cnt);
    int cn[8];
#pragma unroll
    for (int e = 0; e < 8; ++e) cn[e] = __builtin_amdgcn_readfirstlane((int)__hip_atomic_load(cnt + e * 64, __ATOMIC_RELAXED, __HIP_MEMORY_SCOPE_AGENT));
    const int rows = t.tp[8] * 256;
    const int* LIST = (const int*)(F.ws + WS_LIST); const v4u* XN = (const v4u*)(F.ws + WS_ACT); v4u* XB = (v4u*)(F.ws + WS_X2);
    for (int r = F.gw; r < rows; r += F.NGW) {
        const int tile = r >> 8; int e = 0, tpe = 0, ce = cn[0];
#pragma unroll
        for (int k = 1; k < 8; ++k) { const bool ge = tile >= t.tp[k]; e += ge ? 1 : 0; tpe = ge ? t.tp[k] : tpe; ce = ge ? cn[k] : ce; }
        const int pos = r - tpe * 256;
        v4u x0 = {0u, 0u, 0u, 0u}, x1 = {0u, 0u, 0u, 0u};
        if (pos < ce) { const int src = LIST[e * MT + pos]; x0 = XN[(size_t)src * 128 + F.lane]; x1 = XN[(size_t)src * 128 + 64 + F.lane]; }
        XB[(size_t)r * 128 + F.lane] = x0; XB[(size_t)r * 128 + 64 + F.lane] = x1;
    }
}
#define GLD(T, ubase, voff) (*(const T*)((const char*)(ubase) + (unsigned)(voff)))
#define GST(T, ubase, voff) (*(T*)((char*)(ubase) + (unsigned)(voff)))
__device__ __forceinline__ int fresh_lane() { int l; asm volatile("v_mbcnt_lo_u32_b32 %0, -1, 0\n\tv_mbcnt_hi_u32_b32 %0, -1, %0" : "=v"(l)); return l; }

struct MixP { const bf16* P; const float* lb; const float* rcos; const float* rsin; const float* ba; };
__device__ __forceinline__ int seg_row0(int b, int sg) { return sg < 4 ? NLAT + b * CTXL + sg * 64 : b * SEQ + (sg - 4) * 64; }
__device__ __forceinline__ int seg_tpos0(int sg) { return sg < 4 ? -1 : (sg - 4) * 64; }

struct S5P { const float *lam_re, *lam_im, *log_dt, *b_re, *b_im, *c_re, *c_im, *dd; };
__device__ __forceinline__ float gelu_tanh(float y) { const float t = 0.7978845608028654f * (y + 0.044715f * y * y * y); const float th = 1.0f - 2.0f / (1.0f + __expf(2.0f * t)); return 0.5f * y * (1.0f + th); }
template <int MODE>
__device__ __forceinline__ void s5_scan(const S5P& sp, const bf16* P, int b, int g, int dir, int sg, int lane, float& hre, float& him, LAS float* yf, LAS float* stg, bf16* Z) {
    const int row0 = seg_row0(b, sg); const int dg = dir * 16 + g;
    const float lre = sp.lam_re[dg * 64 + lane], lim = sp.lam_im[dg * 64 + lane], dt = expf(sp.log_dt[dg]);
    const float er = expf(lre * dt); const float sn = sinf(lim * dt), cs = cosf(lim * dt);
    const float ar = er * cs, ai = er * sn;
    const float nr = ar - 1.0f, ni = ai, den = lre * lre + lim * lim;
    const float cr = (nr * lre + ni * lim) / den, ci = (ni * lre - nr * lim) / den;
    float bbr[16], bbi[16], Cr[16], Ci[16];
#pragma unroll
    for (int c = 0; c < 16; ++c) { const float Br = sp.b_re[((size_t)dg * 64 + lane) * 16 + c], Bi = sp.b_im[((size_t)dg * 64 + lane) * 16 + c];
        bbr[c] = cr * Br - ci * Bi; bbi[c] = cr * Bi + ci * Br;
        Cr[c] = (MODE != 0) ? sp.c_re[((size_t)dg * 16 + c) * 64 + lane] : 0.f; Ci[c] = (MODE != 0) ? sp.c_im[((size_t)dg * 16 + c) * 64 + lane] : 0.f; }
    const int ch = ((lane >> 5) & 1) * 8 + ((lane >> 4) & 1) * 4 + ((lane >> 3) & 1) * 2 + ((lane >> 2) & 1);
    const float dv = (MODE == 2) ? sp.dd[g * 16 + ch] : 0.f;
    const bool b5 = lane & 32, b4 = lane & 16, b3 = lane & 8, b2 = lane & 4;
    const unsigned ucol = 2u * (unsigned)(C_S5 + g * 16 + (lane & 15));
    unsigned short rn0[4], rn1[4], rn2[4];
#pragma unroll
    for (int u = 0; u < 4; ++u) { rn0[u] = GLD(unsigned short, P + (size_t)(row0 + (dir ? 63 - u : u)) * DINP, ucol); rn1[u] = GLD(unsigned short, P + (size_t)(row0 + (dir ? 59 - u : 4 + u)) * DINP, ucol);
        rn2[u] = GLD(unsigned short, P + (size_t)(row0 + (dir ? 55 - u : 8 + u)) * DINP, ucol); }
#pragma unroll 1
    for (int i0 = 0; i0 < 64; i0 += 4) {
        unsigned short ru[4], rn3[4];
        const int ip = (i0 + 12 < 64) ? i0 + 12 : 60;
#pragma unroll
        for (int u = 0; u < 4; ++u) { ru[u] = rn0[u]; rn3[u] = GLD(unsigned short, P + (size_t)(row0 + (dir ? 63 - (ip + u) : (ip + u))) * DINP, ucol); }
#pragma unroll
        for (int u = 0; u < 4; ++u) stg[u * 64 + lane] = bf2f(ru[u]);
#pragma unroll
        for (int u = 0; u < 4; ++u) {
            const int ti = dir ? 63 - (i0 + u) : (i0 + u);
            const float uf = bf2f(ru[u]);
            float bur = 0.f, bui = 0.f;
#pragma unroll
            for (int c4 = 0; c4 < 4; ++c4) { const f32x4 ux = *(const LAS f32x4*)(stg + u * 64 + 4 * c4);
#pragma unroll
                for (int jj = 0; jj < 4; ++jj) { bur = fmaf(bbr[4 * c4 + jj], ux[jj], bur); bui = fmaf(bbi[4 * c4 + jj], ux[jj], bui); } }
            const float nre = ar * hre - ai * him + bur, nim = ar * him + ai * hre + bui;
            hre = nre; him = nim;
            if (MODE != 0) {
                float v[16];
#pragma unroll
                for (int c = 0; c < 16; ++c) v[c] = Cr[c] * hre - Ci[c] * him;
                float w8[8], w4[4], w2[2], w1;
#pragma unroll
                for (int i = 0; i < 8; ++i) { const float mine = b5 ? v[8 + i] : v[i], oth = b5 ? v[i] : v[8 + i]; w8[i] = mine + __shfl_xor(oth, 32); }
#pragma unroll
                for (int i = 0; i < 4; ++i) { const float mine = b4 ? w8[4 + i] : w8[i], oth = b4 ? w8[i] : w8[4 + i]; w4[i] = mine + __shfl_xor(oth, 16); }
#pragma unroll
                for (int i = 0; i < 2; ++i) { const float mine = b3 ? w4[2 + i] : w4[i], oth = b3 ? w4[i] : w4[2 + i]; w2[i] = mine + __shfl_xor(oth, 8); }
                { const float mine = b2 ? w2[1] : w2[0], oth = b2 ? w2[0] : w2[1]; w1 = mine + __shfl_xor(oth, 4); }
                w1 += __shfl_xor(w1, 2); w1 += __shfl_xor(w1, 1);
                if (MODE == 1) { if ((lane & 3) == 0) yf[ti * 16 + ch] = w1; }
                if (MODE == 2) {
                    const float uch = __shfl(uf, ch);
                    if ((lane & 3) == 0) { const float y = w1 + yf[ti * 16 + ch] + dv * uch; Z[(size_t)(row0 + ti) * 256 + g * 16 + ch] = (bf16)f2bf(gelu_tanh(y)); }
                }
            }
        }
#pragma unroll
        for (int u = 0; u < 4; ++u) { rn0[u] = rn1[u]; rn1[u] = rn2[u]; rn2[u] = rn3[u]; }
    }
}

__device__ __forceinline__ MixP make_mixp(const Frame& F, const Args& a, int l) {
    MixP mp; mp.P = (const bf16*)(F.ws + WS_PH); mp.lb = (const float*)(F.ws + WS_LB) + l * 256; mp.rcos = (const float*)(F.ws + WS_ROPE); mp.rsin = mp.rcos + 2048;
    mp.ba = a.in[F.zz + I_BA] + (size_t)l * 2 * 128; return mp;
}
__device__ __forceinline__ S5P make_s5p(const Frame& F, const Args& a, int l) {
    S5P sp; sp.lam_re = a.in[F.zz + I_LAMRE] + (size_t)l * 2048; sp.lam_im = a.in[F.zz + I_LAMIM] + (size_t)l * 2048; sp.log_dt = a.in[F.zz + I_LOGDT] + l * 32;
    sp.b_re = a.in[F.zz + I_BRE] + (size_t)l * 32768; sp.b_im = a.in[F.zz + I_BIM] + (size_t)l * 32768; sp.c_re = a.in[F.zz + I_CRE] + (size_t)l * 32768; sp.c_im = a.in[F.zz + I_CIM] + (size_t)l * 32768;
    sp.dd = a.in[F.zz + I_S5D] + l * 256; return sp;
}


typedef short bf16x8_t __attribute__((ext_vector_type(8)));
typedef float f32x16 __attribute__((ext_vector_type(16)));
typedef float f32x2_t __attribute__((ext_vector_type(2)));
typedef __bf16 bf16x2_n __attribute__((ext_vector_type(2)));
__device__ __forceinline__ unsigned pkbf(float lo, float hi) { const f32x2_t v = {lo, hi}; const bf16x2_n r = __builtin_convertvector(v, bf16x2_n); return __builtin_bit_cast(unsigned, r); }
constexpr int WL_QC = 0, WL_KC = 4608, WL_KT = 9216, WL_VT = 14336, WL_PL = 19456, WL_BYTES = 19712;

struct MxC { float gamma, lbv, oml, bav; unsigned cq, ck, cv, cz; };
template <int MIX>
__device__ __forceinline__ void mx_consts(MxC& c, const MixP& mp, int h, int dir, int lane) {
    c.gamma = 1.f; c.lbv = 0.f; c.oml = 1.f; c.bav = 0.f; c.cz = 0;
    if (MIX == 0) { c.cq = 2u * (unsigned)(C_RQ + h * 64 + lane); c.ck = 2u * (unsigned)(C_RK + h * 64 + lane); c.cv = 2u * (unsigned)(C_RV + h * 64 + lane); c.gamma = 1.0f - exp2f(-5.0f - (float)(dir ? 3 - h : h)); }
    else if (MIX == 1) { c.cq = 2u * (unsigned)(C_HQ + h * 64 + lane); c.ck = 2u * (unsigned)((dir ? C_HFB : C_HFF) + h * 64 + lane); c.cv = 2u * (unsigned)(C_HI + h * 64 + lane); c.lbv = mp.lb[h * 64 + lane]; c.oml = 1.0f - c.lbv; }
    else { c.cq = 2u * (unsigned)(C_GQ + h * 32 + (lane & 31)); c.ck = 2u * (unsigned)(C_GK + h * 32 + (lane & 31)); c.cv = 2u * (unsigned)(C_GV + h * 64 + lane); c.cz = 2u * (unsigned)((dir ? C_GZB : C_GZF) + h * 32 + (lane & 31));
        c.bav = mp.ba[dir * 128 + h * 32 + (lane & 31)]; }
}
struct MxRaw { unsigned short q[4], k[4], v[4], z[4]; };
template <int MIX, bool NEEDQ, int DIR>
__device__ __forceinline__ void mx_load(MxRaw& w, const MixP& mp, const MxC& c, int rows, int b) {
#pragma unroll
    for (int u = 0; u < 4; ++u) { const int cc = b * 4 + u; const bf16* pr = mp.P + (size_t)(rows + (DIR ? 63 - cc : cc)) * DINP;
        w.q[u] = NEEDQ ? GLD(unsigned short, pr, c.cq) : (unsigned short)0; w.k[u] = GLD(unsigned short, pr, c.ck); w.v[u] = GLD(unsigned short, pr, c.cv); w.z[u] = (MIX == 2) ? GLD(unsigned short, pr, c.cz) : (unsigned short)0; }
}
template <int MIX, bool NEEDQ, int DIR>
__device__ __forceinline__ void mx_batch(const MxRaw& cur, const MixP& mp, const MxC& c, int tposs  , int lane, LAS unsigned char* wl, int b, float& P) {
    constexpr int DK = (MIX == 2) ? 32 : 64;
    float kt[4], vv[4];
#pragma unroll
    for (int u = 0; u < 4; ++u) {
        const int cc = b * 4 + u, ts = DIR ? 63 - cc : cc, t = ts & 31;
        float q = bf2f(cur.q[u]), k, f; vv[DIR ? 3 - u : u] = bf2f(cur.v[u]);
        if (MIX == 0) {
            k = bf2f(cur.k[u]) * 0.125f; f = c.gamma;
            if (tposs >= 0) { const int tpos = tposs + ts; const int pos = (lane & 32) ? (tpos & 63) : (tpos >> 6);
                const unsigned ro = 4u * (unsigned)(pos * 16 + (lane & 15)); const float cs = GLD(float, mp.rcos, ro), sn = GLD(float, mp.rsin, ro);
                const float ss = (lane & 16) ? sn : -sn;
                const float kp = __shfl_xor(k, 16); k = fmaf(kp, ss, k * cs);
                if (NEEDQ) { const float qp = __shfl_xor(q, 16); q = fmaf(qp, ss, q * cs); } }
        } else if (MIX == 1) {
            const float z = bf2f(cur.k[u]); const float e = __expf(-z); const float sp = __builtin_amdgcn_rcpf(1.0f + e), sn = e * sp;
            f = fmaf(c.oml, sp, c.lbv); k = c.oml * sn;
        } else {
            k = bf2f(cur.k[u]) * 0.17677669529663687f; const float z = bf2f(cur.z[u]) + c.bav;
            const float ls = fminf(z, 0.f) - __logf(1.0f + __expf(-fabsf(z)));
            f = __expf(ls * 0.0625f);
        }
        P = fmaxf(P * f, 1e-30f);
        const float kk = k * __builtin_amdgcn_rcpf(P); kt[DIR ? 3 - u : u] = kk;
        if (lane < DK) {
            if (NEEDQ) *(LAS unsigned short*)(wl + WL_QC + t * 144 + lane * 2) = (unsigned short)f2bf(q * P);
            *(LAS unsigned short*)(wl + WL_KC + t * 144 + lane * 2) = (unsigned short)f2bf(kk);
        }
    }
    const int g4 = ((DIR ? 63 - b * 4 : b * 4) & 31) >> 2;
    v2u kp, vp; kp.x = pkbf(kt[0], kt[1]); kp.y = pkbf(kt[2], kt[3]); vp.x = pkbf(vv[0], vv[1]); vp.y = pkbf(vv[2], vv[3]);
    if (lane < DK) *(LAS v2u*)(wl + WL_KT + lane * 80 + g4 * 8) = kp;
    *(LAS v2u*)(wl + WL_VT + lane * 80 + g4 * 8) = vp;
}
typedef short bf16x4_t __attribute__((ext_vector_type(4)));
#define MFMA8(a, b, c) __builtin_amdgcn_mfma_f32_32x32x8bf16_1k((a), (b), (c), 0, 0, 0)
__device__ __forceinline__ bf16x4_t pack4(const f32x16& x, int s) {
    v2u p; p.x = pkbf(x[4 * s], x[4 * s + 1]); p.y = pkbf(x[4 * s + 2], x[4 * s + 3]);
    return __builtin_bit_cast(bf16x4_t, p);
}
__device__ __forceinline__ bf16x4_t ld4(const LAS unsigned char* p) { const v2u a = *(const LAS v2u*)p; return __builtin_bit_cast(bf16x4_t, a); }

template <int MODE, int DIR>
__device__ __forceinline__ void s5_mm_dir(const S5P& sp, const bf16* P, int b, int g, int sg, int lane, float& hre, float& him, LAS float* yf, LAS unsigned char* hs, bf16* Z) {
    const int m32 = lane & 31, hh = lane >> 5, dg = DIR * 16 + g, row0 = seg_row0(b, sg);
    float ar[2], ai[2], a2r[2], a2i[2], a3r[2], a3i[2], a4r[2], a4i[2];
    bf16x4_t bfr[4][2];
    const float dt = __expf(sp.log_dt[dg]);
#pragma unroll
    for (int sh = 0; sh < 2; ++sh) {
        const int p = 32 * sh + m32;
        const float lre = sp.lam_re[dg * 64 + p], lim = sp.lam_im[dg * 64 + p];
        const float er = __expf(lre * dt), sn = sinf(lim * dt), cs = cosf(lim * dt);
        ar[sh] = er * cs; ai[sh] = er * sn;
        a2r[sh] = ar[sh] * ar[sh] - ai[sh] * ai[sh]; a2i[sh] = ar[sh] * ai[sh] + ar[sh] * ai[sh];
        a3r[sh] = a2r[sh] * ar[sh] - a2i[sh] * ai[sh]; a3i[sh] = a2r[sh] * ai[sh] + a2i[sh] * ar[sh];
        a4r[sh] = a2r[sh] * a2r[sh] - a2i[sh] * a2i[sh]; a4i[sh] = a2r[sh] * a2i[sh] + a2r[sh] * a2i[sh];
        const float nr = ar[sh] - 1.0f, ni = ai[sh], den = 1.0f / (lre * lre + lim * lim);
        const float cr = (nr * lre + ni * lim) * den, ci = (ni * lre - nr * lim) * den;
#pragma unroll
        for (int s2 = 0; s2 < 2; ++s2) {
            const f32x4 Br = *(const f32x4*)(sp.b_re + ((size_t)dg * 64 + p) * 16 + 8 * s2 + 4 * hh), Bi = *(const f32x4*)(sp.b_im + ((size_t)dg * 64 + p) * 16 + 8 * s2 + 4 * hh);
            const f32x4 re = Br * cr - Bi * ci, im = Bi * cr + Br * ci;
            v2u pr, pi; pr.x = pkbf(re[0], re[1]); pr.y = pkbf(re[2], re[3]); pi.x = pkbf(im[0], im[1]); pi.y = pkbf(im[2], im[3]);
            bfr[sh][s2] = __builtin_bit_cast(bf16x4_t, pr); bfr[2 + sh][s2] = __builtin_bit_cast(bf16x4_t, pi);
        }
    }
    bf16x4_t cfr[16];
    if (MODE != 0) {
#pragma unroll
        for (int s = 0; s < 16; ++s) {
            const int p4 = (8 * s + 4 * hh) & 63; f32x4 cv = {0.f, 0.f, 0.f, 0.f};
            if (m32 < 16) cv = (s < 8) ? *(const f32x4*)(sp.c_re + ((size_t)dg * 16 + m32) * 64 + p4) : -*(const f32x4*)(sp.c_im + ((size_t)dg * 16 + m32) * 64 + p4);
            v2u pc; pc.x = pkbf(cv[0], cv[1]); pc.y = pkbf(cv[2], cv[3]); cfr[s] = __builtin_bit_cast(bf16x4_t, pc);
        }
    }
    const float ddv = (MODE == 2 && m32 < 16) ? sp.dd[g * 16 + m32] : 0.f;
    float hr[2], hi[2];
    hr[0] = __shfl(hre, m32); hi[0] = __shfl(him, m32); hr[1] = __shfl(hre, m32 + 32); hi[1] = __shfl(him, m32 + 32);
#pragma unroll 1
    for (int ci2 = 0; ci2 < 2; ++ci2) {
        const int ch = DIR ? 1 - ci2 : ci2, rowc = row0 + 32 * ch;
        const bf16* urow = P + (size_t)(rowc + m32) * DINP + C_S5 + g * 16 + 4 * hh;
        const bf16x4_t ua0 = __builtin_bit_cast(bf16x4_t, *(const v2u*)urow), ua1 = __builtin_bit_cast(bf16x4_t, *(const v2u*)(urow + 8));
        f32x16 BU[4];
#pragma unroll
        for (int nt = 0; nt < 4; ++nt) {
#pragma unroll
            for (int r = 0; r < 16; ++r) BU[nt][r] = 0.f;
            BU[nt] = MFMA8(ua0, bfr[nt][0], BU[nt]); BU[nt] = MFMA8(ua1, bfr[nt][1], BU[nt]);
        }
#pragma unroll
        for (int sh = 0; sh < 2; ++sh)
#pragma unroll
            for (int gg = 0; gg < 4; ++gg)
#pragma unroll
                for (int jj = 1; jj < 4; ++jj) {
                    const int r = DIR ? 4 * gg + 3 - jj : 4 * gg + jj, rp = DIR ? r + 1 : r - 1;
                    const float pr = BU[sh][rp], pi = BU[2 + sh][rp];
                    BU[sh][r] += ar[sh] * pr - ai[sh] * pi; BU[2 + sh][r] += ar[sh] * pi + ai[sh] * pr;
                }
        float hnr[2][4], hni[2][4];
#pragma unroll
        for (int st = 0; st < 8; ++st) {
            const int gg = DIR ? 3 - (st >> 1) : (st >> 1), turn = DIR ? 1 - (st & 1) : (st & 1), rl = DIR ? 4 * gg : 4 * gg + 3;
            const bool act = (hh == turn);
#pragma unroll
            for (int sh = 0; sh < 2; ++sh) {
                if (turn == (DIR ? 1 : 0)) { hnr[sh][gg] = hr[sh]; hni[sh][gg] = hi[sh]; }
                else { hnr[sh][gg] = act ? hr[sh] : hnr[sh][gg]; hni[sh][gg] = act ? hi[sh] : hni[sh][gg]; }
                const float outr = BU[sh][rl] + a4r[sh] * hr[sh] - a4i[sh] * hi[sh], outi = BU[2 + sh][rl] + a4r[sh] * hi[sh] + a4i[sh] * hr[sh];
                const float sr = __shfl_xor(outr, 32), si = __shfl_xor(outi, 32);
                hr[sh] = act ? outr : sr; hi[sh] = act ? outi : si;
            }
        }
        if (MODE != 0) {
#pragma unroll
            for (int sh = 0; sh < 2; ++sh)
#pragma unroll
                for (int gg = 0; gg < 4; ++gg)
#pragma unroll
                    for (int jj = 0; jj < 4; ++jj) {
                        const int pw = DIR ? 4 - jj : jj + 1;
                        const float pr = (pw == 1) ? ar[sh] : (pw == 2) ? a2r[sh] : (pw == 3) ? a3r[sh] : a4r[sh], pi = (pw == 1) ? ai[sh] : (pw == 2) ? a2i[sh] : (pw == 3) ? a3i[sh] : a4i[sh];
                        BU[sh][4 * gg + jj] += pr * hnr[sh][gg] - pi * hni[sh][gg]; BU[2 + sh][4 * gg + jj] += pr * hni[sh][gg] + pi * hnr[sh][gg];
                    }
#pragma unroll
            for (int nt = 0; nt < 4; ++nt)
#pragma unroll
                for (int r = 0; r < 16; ++r) *(LAS unsigned short*)(hs + ((r & 3) + 8 * (r >> 2) + 4 * hh) * 272 + (32 * nt + m32) * 2) = (unsigned short)f2bf(BU[nt][r]);
            f32x16 Yv;
#pragma unroll
            for (int r = 0; r < 16; ++r) Yv[r] = 0.f;
#pragma unroll
            for (int s = 0; s < 16; ++s) Yv = MFMA8(ld4(hs + m32 * 272 + (8 * s + 4 * hh) * 2), cfr[s], Yv);
            if (m32 < 16) {
#pragma unroll
                for (int r = 0; r < 16; ++r) {
                    const int tl = (r & 3) + 8 * (r >> 2) + 4 * hh;
                    if (MODE == 1) yf[(32 * ch + tl) * 16 + m32] = Yv[r];
                    else { const float u = bf2f(P[(size_t)(rowc + tl) * DINP + C_S5 + g * 16 + m32]);
                        const float y = Yv[r] + yf[(32 * ch + tl) * 16 + m32] + ddv * u;
                        Z[(size_t)(rowc + tl) * 256 + g * 16 + m32] = (bf16)f2bf(gelu_tanh(y)); }
                }
            }
        }
    }
    hre = hh ? hr[1] : hr[0]; him = hh ? hi[1] : hi[0];
}
template <int MODE>
__device__ __forceinline__ void s5_mm(const S5P& sp, const bf16* P, int b, int g, int dir, int sg, int lane, float& hre, float& him, LAS float* yf, LAS unsigned char* hs, bf16* Z) {
    if (dir) s5_mm_dir<MODE, 1>(sp, P, b, g, sg, lane, hre, him, yf, hs, Z); else s5_mm_dir<MODE, 0>(sp, P, b, g, sg, lane, hre, him, yf, hs, Z);
}
template <int MIX, int DIR, bool WITH_O>
__device__ __forceinline__ void mx_chunk(LAS unsigned char* wl, int lane, float Pl, f32x16 (&ST)[(MIX == 2) ? 1 : 2][2], f32x16 (&O)[2]) {
    constexpr int DK = (MIX == 2) ? 32 : 64, NRT = DK / 32;
    const int m32 = lane & 31, hh = lane >> 5;
    asm volatile("" ::: "memory");
    if (lane < DK) *(LAS float*)(wl + WL_PL + lane * 4) = Pl;
    asm volatile("" ::: "memory");
    if (WITH_O) {
        f32x16 x;
#pragma unroll
        for (int r = 0; r < 16; ++r) x[r] = 0.f;
#pragma unroll
        for (int s = 0; s < DK / 8; ++s) {
            const bf16x4_t ka = ld4(wl + WL_KC + m32 * 144 + (8 * s + 4 * hh) * 2);
            const bf16x4_t qb = ld4(wl + WL_QC + m32 * 144 + (8 * s + 4 * hh) * 2);
            x = MFMA8(ka, qb, x);
        }
#pragma unroll
        for (int r = 0; r < 16; ++r) { const int j = (r & 3) + 8 * (r >> 2) + 4 * hh; const bool keep = DIR ? (j >= m32) : (j <= m32); x[r] = keep ? x[r] : 0.f; }
#pragma unroll
        for (int t = 0; t < 2; ++t)
#pragma unroll
            for (int r = 0; r < 16; ++r) O[t][r] = 0.f;
#pragma unroll
        for (int s = 0; s < 4; ++s) {
            const bf16x4_t xa = pack4(x, s);
#pragma unroll
            for (int t = 0; t < 2; ++t) O[t] = MFMA8(xa, ld4(wl + WL_VT + (32 * t + m32) * 80 + (8 * s + 4 * hh) * 2), O[t]);
        }
#pragma unroll
        for (int rt = 0; rt < NRT; ++rt)
#pragma unroll
            for (int s = 0; s < 4; ++s) {
                const bf16x4_t qa = ld4(wl + WL_QC + m32 * 144 + (32 * rt + 8 * s + 4 * hh) * 2);
#pragma unroll
                for (int t = 0; t < 2; ++t) O[t] = MFMA8(qa, pack4(ST[rt][t], s), O[t]);
            }
    }
#pragma unroll
    for (int rt = 0; rt < NRT; ++rt)
#pragma unroll
        for (int s = 0; s < 4; ++s) {
            const bf16x4_t ka = ld4(wl + WL_KT + (32 * rt + m32) * 80 + (8 * s + 4 * hh) * 2);
#pragma unroll
            for (int t = 0; t < 2; ++t) ST[rt][t] = MFMA8(ka, ld4(wl + WL_VT + (32 * t + m32) * 80 + (8 * s + 4 * hh) * 2), ST[rt][t]);
        }
#pragma unroll
    for (int rt = 0; rt < NRT; ++rt)
#pragma unroll
        for (int g = 0; g < 4; ++g) {
            const f32x4 pl4 = *(const LAS f32x4*)(wl + WL_PL + (32 * rt + 8 * g + 4 * hh) * 4);
#pragma unroll
            for (int e = 0; e < 4; ++e) { ST[rt][0][4 * g + e] *= pl4[e]; ST[rt][1][4 * g + e] *= pl4[e]; }
        }
}
__device__ __forceinline__ float half_sum(float v) {
#pragma unroll
    for (int o = 1; o < 32; o <<= 1) v += __shfl_xor(v, o);
    return v;
}
template <int MIX, int DIR>
__device__ __forceinline__ void mixA_stream(const MixP& mp, const MxC& c, int row0, int tpos0, int lane, LAS unsigned char* wl, f32x16 (&ST)[(MIX == 2) ? 1 : 2][2], float& Gam) {
    f32x16 O[2];
    MxRaw r0, r1, r2;
    mx_load<MIX, false, DIR>(r0, mp, c, row0, 0); mx_load<MIX, false, DIR>(r1, mp, c, row0, 1); mx_load<MIX, false, DIR>(r2, mp, c, row0, 2);
    float P = 1.0f;
#pragma unroll 1
    for (int b = 0; b < 16; ++b) {
        MxRaw r3; mx_load<MIX, false, DIR>(r3, mp, c, row0, b < 13 ? b + 3 : 15);
        int ln = lane; asm volatile("" : "+v"(ln));
        mx_batch<MIX, false, DIR>(r0, mp, c, tpos0, ln, wl, b, P);
        if ((b & 7) == 7) { Gam *= P; mx_chunk<MIX, 0, false>(wl, ln, P, ST, O); P = 1.0f; }
        r0 = r1; r1 = r2; r2 = r3;
    }
}
template <int MIX>
__device__ __forceinline__ void mixA_unit(const MixP& mp, float* STG, int idx, int lane_in, LAS unsigned char* wl) {
    int lane = lane_in;
    constexpr int DK = (MIX == 2) ? 32 : 64, NRT = DK / 32;
    const int dir = idx / 2112, rem = idx - dir * 2112, bh = rem / NSEG, sg = rem - bh * NSEG, b = bh >> 2, h = bh & 3;
    asm volatile("" : "+v"(lane));
    MxC c; mx_consts<MIX>(c, mp, h, dir, lane);
    f32x16 ST[NRT][2];
#pragma unroll
    for (int rt = 0; rt < NRT; ++rt)
#pragma unroll
        for (int t = 0; t < 2; ++t)
#pragma unroll
            for (int r = 0; r < 16; ++r) ST[rt][t][r] = 0.f;
    const int row0 = seg_row0(b, sg), tpos0 = seg_tpos0(sg);
    float Gam = 1.0f;
    if (dir) mixA_stream<MIX, 1>(mp, c, row0, tpos0, lane, wl, ST, Gam); else mixA_stream<MIX, 0>(mp, c, row0, tpos0, lane, wl, ST, Gam);
    const size_t slot = (size_t)((dir * 16 + bh) * NSEG + sg);
    float* ds = STG + (MIX == 0 ? ST_DS0 : (MIX == 1 ? ST_DS1 : ST_DS2)) + slot * (DK * 64);
    const int m32 = lane & 31, hh = lane >> 5;
#pragma unroll
    for (int rt = 0; rt < NRT; ++rt)
#pragma unroll
        for (int t = 0; t < 2; ++t)
#pragma unroll
            for (int r = 0; r < 16; ++r) GST(float, ds + (32 * rt + (r & 3) + 8 * (r >> 2)) * 64 + 32 * t, 4u * (unsigned)(4 * hh * 64 + m32)) = ST[rt][t][r];
    float* gs = STG + (MIX == 0 ? ST_G0 : (MIX == 1 ? ST_G1 : ST_G2)) + slot * 64;
    GST(float, gs, 4u * (unsigned)lane) = Gam;
}
template <int MIX, int MODE>
__device__ __forceinline__ void mx_epilogue(const MixP& mp, LAS unsigned char* wl, int lane, const f32x16 (&O)[2], int rowc, float* OF, bf16* Y, int ocol, int ycol, int cgate, float nwv) {
    LAS float* ost = (LAS float*)(wl + WL_QC);
    const int m32 = lane & 31, hh = lane >> 5;
    asm volatile("" ::: "memory");
#pragma unroll
    for (int t = 0; t < 2; ++t)
#pragma unroll
        for (int r = 0; r < 16; ++r) ost[((r & 3) + 8 * (r >> 2) + 4 * hh) * 68 + 32 * t + m32] = O[t][r];
    asm volatile("" ::: "memory");
    if (MODE == 1) {
#pragma unroll 8
        for (int tk = 0; tk < 32; ++tk) GST(float, OF + (size_t)(rowc + tk) * 768 + ocol, 4u * (unsigned)lane) = ost[tk * 68 + lane];
    } else {
        float ofc[8]; unsigned short gc[8];
#pragma unroll
        for (int u = 0; u < 8; ++u) { ofc[u] = GLD(float, OF + (size_t)(rowc + u) * 768 + ocol, 4u * (unsigned)lane); gc[u] = GLD(unsigned short, mp.P + (size_t)(rowc + u) * DINP + cgate, 2u * (unsigned)lane); }
#pragma unroll 1
        for (int b8 = 0; b8 < 4; ++b8) {
            float ofn[8]; unsigned short gn[8]; const int nb = b8 < 3 ? b8 + 1 : 3;
#pragma unroll
            for (int u = 0; u < 8; ++u) { ofn[u] = GLD(float, OF + (size_t)(rowc + nb * 8 + u) * 768 + ocol, 4u * (unsigned)lane); gn[u] = GLD(unsigned short, mp.P + (size_t)(rowc + nb * 8 + u) * DINP + cgate, 2u * (unsigned)lane); }
#pragma unroll
            for (int u = 0; u < 8; ++u) {
                const int tk = b8 * 8 + u;
                const float o = ost[tk * 68 + lane] + ofc[u];
                float y;
                if (MIX == 0) { const float mean = wave_sum(o) * (1.0f / 64.0f); const float d = o - mean; y = d * (1.0f / sqrtf(wave_sum(d * d) * (1.0f / 64.0f) + NEPS)) * nwv; }
                else y = o * (1.0f / sqrtf(wave_sum(o * o) * (1.0f / 64.0f) + NEPS)) * nwv;
                y *= silu_f(bf2f(gc[u]));
                GST(unsigned short, Y + (size_t)(rowc + tk) * 1024 + ycol, 2u * (unsigned)lane) = (unsigned short)f2bf(y);
            }
#pragma unroll
            for (int u = 0; u < 8; ++u) { ofc[u] = ofn[u]; gc[u] = gn[u]; }
        }
    }
}
template <int MIX, int DIR>
__device__ __forceinline__ void mixC_stream(const MixP& mp, const MxC& c, int row0, int tpos0, int lane, LAS unsigned char* wl, f32x16 (&ST)[(MIX == 2) ? 1 : 2][2],
                                            float* OF, bf16* Y, int ocol, int ycol, int cgate, float nwv) {
    f32x16 O[2];
    MxRaw r0, r1;
    mx_load<MIX, true, DIR>(r0, mp, c, row0, 0); mx_load<MIX, true, DIR>(r1, mp, c, row0, 1);
    float P = 1.0f;
#pragma unroll 1
    for (int b = 0; b < 16; ++b) {
        MxRaw r2; mx_load<MIX, true, DIR>(r2, mp, c, row0, b < 14 ? b + 2 : 15);
        int ln = lane; asm volatile("" : "+v"(ln));
        mx_batch<MIX, true, DIR>(r0, mp, c, tpos0, ln, wl, b, P);
        if ((b & 7) == 7) {
            const int ch = DIR ? 1 - (b >> 3) : (b >> 3);
            mx_chunk<MIX, DIR, true>(wl, ln, P, ST, O); P = 1.0f;
            mx_epilogue<MIX, DIR ? 2 : 1>(mp, wl, ln, O, row0 + 32 * ch, OF, Y, ocol, ycol, cgate, nwv);
        }
        r0 = r1; r1 = r2;
    }
}
template <int MIX>
__device__ __forceinline__ void mixC_unit(const MixP& mp, const float* STG, int idx, int lane_in, float* OF, LAS unsigned char* wl, bf16* Y, const float* nw) {
    int lane = lane_in; asm volatile("" : "+v"(lane));
    constexpr int DK = (MIX == 2) ? 32 : 64, NRT = DK / 32;
    const int bh = idx / NSEG, sg = idx - bh * NSEG, b = bh >> 2, h = bh & 3;
    const int row0 = seg_row0(b, sg), tpos0 = seg_tpos0(sg);
    const int ocol = ((MIX == 0) ? 0 : (MIX == 1 ? 256 : 512)) + h * 64, ycol = ((MIX == 0) ? 0 : (MIX == 1 ? 512 : 768)) + h * 64;
    const int cgate = ((MIX == 0) ? C_RG : (MIX == 1 ? C_HG : C_GG)) + h * 64;
    const float* dsb = STG + (MIX == 0 ? ST_DS0 : (MIX == 1 ? ST_DS1 : ST_DS2));
    const float nwv = nw[h * 64 + lane];
    f32x16 ST[NRT][2];
#pragma unroll 1
    for (int dir = 0; dir < 2; ++dir) {
        asm volatile("" : "+v"(lane));
        const int m32 = lane & 31, hh = lane >> 5;
        MxC c; mx_consts<MIX>(c, mp, h, dir, lane);
        { const float* ds = dsb + (size_t)((dir * 16 + bh) * NSEG + sg) * (DK * 64);
#pragma unroll
          for (int rt = 0; rt < NRT; ++rt)
#pragma unroll
              for (int t = 0; t < 2; ++t)
#pragma unroll
                  for (int r = 0; r < 16; ++r) ST[rt][t][r] = GLD(float, ds + (32 * rt + (r & 3) + 8 * (r >> 2)) * 64 + 32 * t, 4u * (unsigned)(4 * hh * 64 + m32)); }
        if (dir == 0) mixC_stream<MIX, 0>(mp, c, row0, tpos0, lane, wl, ST, OF, Y, ocol, ycol, cgate, nwv);
        else mixC_stream<MIX, 1>(mp, c, row0, tpos0, lane, wl, ST, OF, Y, ocol, ycol, cgate, nwv);
        asm volatile("s_waitcnt vmcnt(0)" ::: "memory");
    }
}
template <int MSEL>
__device__ __forceinline__ void mix_passA(const Frame& F, const Args& a, int l) {
    const MixP mp = make_mixp(F, a, l); const S5P sp = make_s5p(F, a, l);
    float* ST = (float*)(F.ws + WS_X2);
    LAS unsigned char* wl = F.lds + F.wave * WL_BYTES; LAS float* stg = (LAS float*)wl;
    if (MSEL == 15) {
        for (int u = F.gw; u < 3 * 4224 + 2 * 64 * NSEG; u += F.NGW) {
            if (u < 4224) mixA_unit<0>(mp, ST, u, fresh_lane(), wl);
            else if (u < 2 * 4224) mixA_unit<1>(mp, ST, u - 4224, fresh_lane(), wl);
            else if (u < 3 * 4224) mixA_unit<2>(mp, ST, u - 2 * 4224, fresh_lane(), wl);
            else { const int idx = u - 3 * 4224; const int dir = idx / (64 * NSEG), rem = idx - dir * 64 * NSEG, bg = rem / NSEG, sg = rem - bg * NSEG;
                float hre = 0.f, him = 0.f;
                s5_mm<0>(sp, mp.P, bg >> 4, bg & 15, dir, sg, fresh_lane(), hre, him, nullptr, wl, nullptr);
                float* hs = ST + ST_HS + ((size_t)((dir * 64 + bg) * NSEG + sg) * 64 + fresh_lane()) * 2;
                hs[0] = hre; hs[1] = him; }
        }
        return;
    }
    if (MSEL & 1) for (int u = F.gw; u < 4224; u += F.NGW) mixA_unit<0>(mp, ST, u, fresh_lane(), wl);
    if (MSEL & 2) for (int u = F.gw; u < 4224; u += F.NGW) mixA_unit<1>(mp, ST, u, fresh_lane(), wl);
    if (MSEL & 4) for (int u = F.gw; u < 4224; u += F.NGW) mixA_unit<2>(mp, ST, u, fresh_lane(), wl);
    if (MSEL & 8) for (int idx = F.gw; idx < 2 * 64 * NSEG; idx += F.NGW) {
        const int dir = idx / (64 * NSEG), rem = idx - dir * 64 * NSEG, bg = rem / NSEG, sg = rem - bg * NSEG;
        float hre = 0.f, him = 0.f;
        s5_mm<0>(sp, mp.P, bg >> 4, bg & 15, dir, sg, fresh_lane(), hre, him, nullptr, wl, nullptr);
        float* hs = ST + ST_HS + ((size_t)((dir * 64 + bg) * NSEG + sg) * 64 + fresh_lane()) * 2;
        hs[0] = hre; hs[1] = him;
    }
}
__device__ __forceinline__ int chain_seg(int dir, int p) { return dir ? (p < 4 ? 3 - p : 135 - p) : p; }
__device__ __forceinline__ void mix_passB(const Frame& F, const Args& a, int l) {
    float* ST = (float*)(F.ws + WS_X2);
    constexpr int N0 = 131072, N1 = 131072, N2 = 65536, N3 = 8192;
    for (int e = blockIdx.x * 512 + F.tid; e < N0 + N1 + N2 + N3; e += F.G * 512) {
        if (e < N0 + N1 + N2) {
            float* base; const float* gb; int dir, esz;
            if (e < N0 + N1) { const int mix = e >= N0, e2 = e - mix * N0, c = e2 >> 12, el = e2 & 4095; dir = c >> 4; esz = 4096;
                base = ST + (mix ? ST_DS1 : ST_DS0) + (size_t)c * NSEG * 4096 + el; gb = ST + (mix ? ST_G1 : ST_G0) + (size_t)c * NSEG * 64 + (el >> 6); }
            else { const int e2 = e - N0 - N1, c = e2 >> 11, el = e2 & 2047; dir = c >> 4; esz = 2048;
                base = ST + ST_DS2 + (size_t)c * NSEG * 2048 + el; gb = ST + ST_G2 + (size_t)c * NSEG * 64 + (el >> 6); }
            float run = 0.f;
#pragma unroll 4
            for (int p = 0; p < NSEG; ++p) { const int sg = chain_seg(dir, p); const float d = base[(size_t)sg * esz], gm = gb[sg * 64]; base[(size_t)sg * esz] = run; run = fmaf(gm, run, d); }
        } else {
            const int e2 = e - N0 - N1 - N2, c = e2 >> 6, p = e2 & 63, dir = c >> 6, g = c & 15;
            const int dg = dir * 16 + g;
            const float lre = a.in[F.zz + I_LAMRE][(size_t)l * 2048 + dg * 64 + p], lim = a.in[F.zz + I_LAMIM][(size_t)l * 2048 + dg * 64 + p], dt = expf(a.in[F.zz + I_LOGDT][l * 32 + dg]);
            const float er = expf(lre * dt * 64.0f); const float sn = sinf(lim * dt * 64.0f), cs = cosf(lim * dt * 64.0f);
            const float ar = er * cs, ai = er * sn;
            float* base = ST + ST_HS + ((size_t)c * NSEG * 64 + p) * 2;
            float rr = 0.f, ri = 0.f;
#pragma unroll 4
            for (int q = 0; q < NSEG; ++q) { const int sg = chain_seg(dir, q); float* h = base + (size_t)sg * 128; const float dr = h[0], di = h[1]; h[0] = rr; h[1] = ri;
                const float nr = ar * rr - ai * ri + dr, ni = ar * ri + ai * rr + di; rr = nr; ri = ni; }
        }
    }
}
template <int MSEL>
__device__ __forceinline__ void mix_passC(const Frame& F, const Args& a, int l) {
    const MixP mp = make_mixp(F, a, l); const S5P sp = make_s5p(F, a, l);
    const float* ST = (const float*)(F.ws + WS_X2);
    LAS unsigned char* wl = F.lds + F.wave * WL_BYTES;
    LAS float* stg = (LAS float*)wl; LAS float* of = (LAS float*)(wl + 9216);
    float* OF = (float*)(F.ws + WS_OF);
    bf16* Y = (bf16*)(F.ws + WS_ACT); bf16* Z = (bf16*)(F.ws + WS_Z);
    const bool keep = l < DEPTH - 1;
    constexpr int NM = 16 * NSEG;
    if (MSEL == 15) {
        for (int u = F.gw; u < 3 * NM + 64 * NSEG; u += F.NGW) {
            const int sgu = (u < 3 * NM) ? (u % NSEG) : ((u - 3 * NM) % NSEG);
            if (!keep && sgu < 4) continue;
            if (u < NM) mixC_unit<0>(mp, ST, u, fresh_lane(), OF, wl, Y, a.in[F.zz + I_RETGN] + l * 256);
            else if (u < 2 * NM) mixC_unit<1>(mp, ST, u - NM, fresh_lane(), OF, wl, Y, a.in[F.zz + I_HGNW] + l * 256);
            else if (u < 3 * NM) mixC_unit<2>(mp, ST, u - 2 * NM, fresh_lane(), OF, wl, Y, a.in[F.zz + I_GLANW] + l * 256);
            else { const int idx = u - 3 * NM, bg = idx / NSEG, sg = idx - bg * NSEG;
                const float* h0 = ST + ST_HS + ((size_t)((0 * 64 + bg) * NSEG + sg) * 64 + fresh_lane()) * 2;
                float hre = h0[0], him = h0[1];
                s5_mm<1>(sp, mp.P, bg >> 4, bg & 15, 0, sg, fresh_lane(), hre, him, of, wl, Z);
                const float* h1 = ST + ST_HS + ((size_t)((1 * 64 + bg) * NSEG + sg) * 64 + fresh_lane()) * 2;
                hre = h1[0]; him = h1[1];
                s5_mm<2>(sp, mp.P, bg >> 4, bg & 15, 1, sg, fresh_lane(), hre, him, of, wl, Z); }
        }
        return;
    }
    if (MSEL & 1) for (int u = F.gw; u < NM; u += F.NGW) { if (!keep && (u % NSEG) < 4) continue; mixC_unit<0>(mp, ST, u, fresh_lane(), OF, wl, Y, a.in[F.zz + I_RETGN] + l * 256); }
    if (MSEL & 2) for (int u = F.gw; u < NM; u += F.NGW) { if (!keep && (u % NSEG) < 4) continue; mixC_unit<1>(mp, ST, u, fresh_lane(), OF, wl, Y, a.in[F.zz + I_HGNW] + l * 256); }
    if (MSEL & 4) for (int u = F.gw; u < NM; u += F.NGW) { if (!keep && (u % NSEG) < 4) continue; mixC_unit<2>(mp, ST, u, fresh_lane(), OF, wl, Y, a.in[F.zz + I_GLANW] + l * 256); }
    if (MSEL & 8) for (int idx = F.gw; idx < 64 * NSEG; idx += F.NGW) {
        const int bg = idx / NSEG, sg = idx - bg * NSEG;
        if (!keep && sg < 4) continue;
        const float* h0 = ST + ST_HS + ((size_t)((0 * 64 + bg) * NSEG + sg) * 64 + fresh_lane()) * 2;
        float hre = h0[0], him = h0[1];
        s5_mm<1>(sp, mp.P, bg >> 4, bg & 15, 0, sg, fresh_lane(), hre, him, of, wl, Z);
        const float* h1 = ST + ST_HS + ((size_t)((1 * 64 + bg) * NSEG + sg) * 64 + fresh_lane()) * 2;
        hre = h1[0]; him = h1[1];
        s5_mm<2>(sp, mp.P, bg >> 4, bg & 15, 1, sg, fresh_lane(), hre, him, of, wl, Z);
    }
}

constexpr int NPH = 11;
template <int PH_MASK, int MSEL>
__global__ void __launch_bounds__(512, 2) mk_fwd(Args a) {
    extern __shared__ __attribute__((aligned(16))) unsigned char lds_raw[];
    Frame F;
    F.lds = (LAS unsigned char*)lds_raw;
    const int wave0 = __builtin_amdgcn_readfirstlane((int)threadIdx.x >> 6);
    F.lane = fresh_lane(); F.tid = wave0 * 64 + F.lane; F.wave = wave0;
    F.G = gridDim.x; F.gw = blockIdx.x * 8 + F.wave; F.NGW = F.G * 8; F.zz = 0; F.ws = (unsigned char*)a.in[I_WS]; F.out = (float*)a.in[I_OUT];
    volatile LAS unsigned* MISC = (volatile LAS unsigned*)(F.lds + MISC_OFF);
    for (int u = F.tid; u < 64; u += 512) ((LAS unsigned*)(F.lds + MISC_OFF))[u] = 0u;
    __syncthreads();
    XcdBarrier bar; bar.bar = (unsigned*)F.ws + CW_BAR; bar.x = 0; bar.st = nullptr;
    if (a.fused) bar = xcd_barrier_post((unsigned*)F.ws + CW_BAR, MISC + 8, F.tid);
#define SEAM() do { if (a.fused) { XcdBarrier bb = bar; asm volatile("" : "+s"(bb.bar), "+s"(bb.x)); xcd_barrier(bb, wave0 * 64 + fresh_lane()); } } while (0)
#define PHASE_BEGIN() do { int zz_ = 0; asm volatile("" : "+s"(zz_)); F.zz = zz_; F.ws = (unsigned char*)a.in[I_WS + zz_]; F.out = (float*)a.in[I_OUT + zz_]; \
        const int ln_ = fresh_lane(); const int t_ = wave0 * 64 + ln_ + zz_; F.tid = t_; F.lane = t_ & 63; F.wave = wave0 + zz_; F.G = (int)gridDim.x + zz_; F.gw = ((int)blockIdx.x + zz_) * 8 + F.wave; F.NGW = F.G * 8; \
        F.lds = (LAS unsigned char*)lds_raw + zz_; } while (0)
#define IN(k) (((PH_MASK >> (k)) & 1) && a.ph_lo <= (k) && (k) < a.ph_hi)
#ifndef DUP_PH
#define DUP_PH 0
#endif
#define REP(k) for (int rep_ = 0; rep_ < (((DUP_PH >> (k)) & 1) ? 2 : 1); ++rep_)
#define hb ((float*)(F.ws + WS_HB))
#define MOD ((const float*)(F.ws + WS_MOD))
#define ACT ((bf16*)(F.ws + WS_ACT))
#define PH ((bf16*)(F.ws + WS_PH))

    if (((PH_MASK >> 12) & 1) && a.do_pro) { PHASE_BEGIN(); prologue(F, a); SEAM(); }

#pragma unroll
    for (int l = 0; l < DEPTH; ++l) {
        if (l < a.l_lo || l >= a.l_hi) continue;
        const bool keep = l < DEPTH - 1, moe = l & 1; const int j = l >> 1;
        const int Mrows = keep ? MT : NLAT;
        if (IN(0)) { PHASE_BEGIN();
            norm_phase<0>(F, a, l, 0, MT, (l == 2) ? 1 : -1);
            if (l == 2) { __syncthreads(); moe_cvt(F, a, 1); }
            SEAM();
        }
        if (IN(1)) REP(1) { PHASE_BEGIN();
            pg8::Gemm g{ACT, (const bf16*)(F.ws + WS_WIN) + (size_t)l * DINP * 1024, MT, DINP, 1024}; pg8::StaticOrder S; S.init(MT, DINP, F.G, (int)blockIdx.x);
            EpiStoreBf16 E{PH, DINP};
            pg8::gemm_phase<EpiStoreBf16, pg8::StaticOrder, true, true>(F.lds, g, S, E, F.tid);
            SEAM();
        }
        if (IN(2)) { PHASE_BEGIN(); mix_passA<MSEL>(F, a, l); SEAM(); }
#ifdef DUP_MIX
        if (IN(2)) { PHASE_BEGIN(); mix_passA<DUP_MIX>(F, a, l); SEAM(); }
#endif
        if (IN(3)) { PHASE_BEGIN(); mix_passB(F, a, l); SEAM(); }
        if (IN(4)) { PHASE_BEGIN(); mix_passC<MSEL>(F, a, l); SEAM(); }
#ifdef DUP_MIX
        if (IN(4)) { PHASE_BEGIN(); mix_passC<DUP_MIX>(F, a, l); SEAM(); }
#endif
        if (IN(5)) REP(5) { PHASE_BEGIN();
            int k256 = 256; asm volatile("" : "+s"(k256)); pg8::Gemm g{(const bf16*)(F.ws + WS_Z), (const bf16*)(F.ws + WS_GLUW) + (size_t)l * 65536, Mrows, 256, k256}; pg8::StaticOrder S; S.init(Mrows, 256, F.G, (int)blockIdx.x);
            EpiGlu E{(const bf16*)(F.ws + WS_Z), ACT, a.in[F.zz + I_GLUB] + l * 256};
            pg8::gemm_phase<EpiGlu, pg8::StaticOrder, true, true>(F.lds, g, S, E, F.tid);
            SEAM();
        }
        if (IN(6)) { PHASE_BEGIN();
            pg8::Gemm g{ACT, (const bf16*)(F.ws + WS_WOUT) + (size_t)l * 1024 * 1024, Mrows, 1024, 1024}; pg8::StaticOrder S; S.init(Mrows, 1024, F.G, (int)blockIdx.x);
            EpiResid E{(l == 0) ? a.in[F.zz + I_X] : F.out, (l == 0) ? a.in[F.zz + I_CTX] : hb, F.out, hb, MOD + (size_t)l * 5 * 6144 + 2 * 1024};
            pg8::gemm_phase<EpiResid, pg8::StaticOrder, true, true>(F.lds, g, S, E, F.tid);
            SEAM();
        }
        if (IN(7)) { PHASE_BEGIN();
            if (moe) norm_phase<1>(F, a, l, 1, Mrows, -1); else norm_phase<0>(F, a, l, 1, Mrows, -1);
            SEAM();
        }
        if (!moe) {
            if (IN(8)) REP(8) { PHASE_BEGIN();
                pg8::Gemm g{ACT, (const bf16*)(F.ws + WS_W13D) + (size_t)j * 5632 * 1024, Mrows, 5632, 1024}; pg8::StaticOrder S; S.init(Mrows, 5632, F.G, (int)blockIdx.x);
                EpiSwiglu E{PH};
                pg8::gemm_phase<EpiSwiglu, pg8::StaticOrder, true, true>(F.lds, g, S, E, F.tid);
                SEAM();
            }
            if (IN(9)) { PHASE_BEGIN();
                pg8::Gemm g{PH, (const bf16*)(F.ws + WS_W2D) + (size_t)j * 1024 * DFF, Mrows, 1024, DFF}; pg8::StaticOrder S; S.init(Mrows, 1024, F.G, (int)blockIdx.x);
                EpiResid E{F.out, hb, F.out, hb, MOD + (size_t)l * 5 * 6144 + 5 * 1024};
                pg8::gemm_phase<EpiResid, pg8::StaticOrder, true, true>(F.lds, g, S, E, F.tid);
                SEAM();
            }
        } else {
                        if (IN(8)) REP(8) { PHASE_BEGIN(); moe_gather(F, j); SEAM(); }
            if (IN(9)) REP(9) { PHASE_BEGIN();
                pg8::Gemm g{(const bf16*)(F.ws + WS_X2), (const bf16*)(F.ws + WS_W13M), 0, 5632, 1024}; MoeOrder S; S.init((const unsigned*)F.ws + CW_CNT + j * 8 * 64, 22, F.G, (int)blockIdx.x);
                EpiSwiglu E{PH};
                pg8::gemm_phase<EpiSwiglu, MoeOrder, true, true>(F.lds, g, S, E, F.tid);
                SEAM();
            }
            if (IN(10)) REP(10) { PHASE_BEGIN();
                pg8::Gemm g{PH, (const bf16*)(F.ws + WS_W2M), 0, 1024, DFF}; MoeOrder S; S.init((const unsigned*)F.ws + CW_CNT + j * 8 * 64, 4, F.G, (int)blockIdx.x);
                EpiStoreBf16 E{(bf16*)(F.ws + WS_X2), 1024};
                pg8::gemm_phase<EpiStoreBf16, MoeOrder, true, true>(F.lds, g, S, E, F.tid);
                SEAM();
            }
        }
    }
    if (((PH_MASK >> 13) & 1) && a.do_fin) { PHASE_BEGIN(); norm_phase<2>(F, a, DEPTH - 1, 0, NLAT, DEPTH - 1); }
#undef SEAM
#undef IN
#undef hb
#undef MOD
#undef ACT
#undef PH
}

#ifndef MK_FUSED
#define MK_FUSED 1
#endif
template <int PM, int MS> static void launch_one(const Args& a, int grid, hipStream_t stream) {
    static bool attr_done = false;
    if (!attr_done) { (void)hipFuncSetAttribute((const void*)mk_fwd<PM, MS>, hipFuncAttributeMaxDynamicSharedMemorySize, LDS_BYTES); attr_done = true; }
    hipLaunchKernelGGL((mk_fwd<PM, MS>), dim3(grid), dim3(512), LDS_BYTES, stream, a);
}
extern "C" void kernel_launch(void* const* d_in, const int* in_sizes, int n_in, void* d_out, int out_size, void* d_ws, size_t ws_size, hipStream_t stream) {
    static int grid = 0;
    if (grid == 0) {
        if (n_in != 35 || in_sizes[0] != NLAT * DM || out_size != NLAT * DM || ws_size < WS_END) {
            fprintf(stderr, "kernel_launch: unexpected shapes / workspace (n_in %d, ws %zu, need %zu); nothing launched\n", n_in, ws_size, (size_t)WS_END); grid = -1; return; }
        int dev = 0, cus = 0;
        if (hipGetDevice(&dev) != hipSuccess || hipDeviceGetAttribute(&cus, hipDeviceAttributeMultiprocessorCount, dev) != hipSuccess) { grid = -1; return; }
        grid = cus;
    }
    if (grid < 0) return;
    (void)hipMemsetAsync((char*)d_ws + WS_CTL, 0, CTL_ZERO_BYTES, stream);
    Args a{};
    for (int i = 0; i < 35; ++i) a.in[i] = (const float*)d_in[i];
    a.in[I_OUT] = (const float*)d_out; a.in[I_WS] = (const float*)d_ws; a.pad = 0;
#if MK_FUSED
    a.l_lo = 0; a.l_hi = DEPTH; a.ph_lo = 0; a.ph_hi = NPH; a.do_pro = 1; a.do_fin = 1; a.fused = 1;
#ifndef TEST_PM
#define TEST_PM 0xFFFF
#endif
#ifndef TEST_MS
#define TEST_MS 15
#endif
    launch_one<TEST_PM, TEST_MS>(a, grid, stream);
#else
    a.fused = 0;
    a.l_lo = 0; a.l_hi = 0; a.ph_lo = 0; a.ph_hi = 0; a.do_pro = 1; a.do_fin = 0;
    launch_one<0x1000, 15>(a, grid, stream);
    a.do_pro = 0;
    for (int l = 0; l < DEPTH; ++l) {
        a.l_lo = l; a.l_hi = l + 1; a.ph_lo = 0; a.ph_hi = NPH;
        launch_one<0x1, 15>(a, grid, stream); launch_one<0x2, 15>(a, grid, stream); launch_one<0x4, 15>(a, grid, stream); launch_one<0x8, 15>(a, grid, stream);
        launch_one<0x10, 1>(a, grid, stream); launch_one<0x10, 2>(a, grid, stream); launch_one<0x10, 4>(a, grid, stream); launch_one<0x10, 8>(a, grid, stream);
        launch_one<0x20, 15>(a, grid, stream); launch_one<0x40, 15>(a, grid, stream); launch_one<0x80, 15>(a, grid, stream);
        launch_one<0x100, 15>(a, grid, stream); launch_one<0x200, 15>(a, grid, stream);
        if (l & 1) launch_one<0x400, 15>(a, grid, stream);
    }
    a.l_lo = 0; a.l_hi = 0; a.ph_lo = 0; a.ph_hi = 0; a.do_fin = 1;
    launch_one<0x2000, 15>(a, grid, stream);
#endif
}
```

```cpp
#include <hip/hip_runtime.h>
#include <cstdio>
#include <cstdint>
#define LAS __attribute__((address_space(3)))
namespace pg8 {
#define PG8_LAS __attribute__((address_space(3)))
typedef unsigned short bf16_t;
typedef short bf16x8 __attribute__((ext_vector_type(8)));
typedef float f32x4 __attribute__((ext_vector_type(4)));
typedef unsigned u32x4 __attribute__((ext_vector_type(4)));
constexpr int BM = 256, BK = 64, HALF = 128, HTB = HALF * BK * 2  , STAGE_BYTES = 8 * HTB, NXCD = 8, WGM = 8;

__host__ __device__ __forceinline__ int lds_byte(int r, int c) { const int st = (r >> 4) * 2 + (c >> 5), rr = r & 15, cc = c & 31, ob = rr * 64 + cc * 2; return st * 1024 + (ob ^ (((ob >> 9) & 1) << 5)); }
__host__ __device__ __forceinline__ void stage_rc(int b, int& R, int& C) { const int st = b / 1024, sb = b % 1024, swz = sb ^ (((sb >> 9) & 1) << 5); R = (st >> 1) * 16 + swz / 64; C = (st & 1) * 32 + (swz % 64) / 2; }
__host__ __device__ __forceinline__ int perm32(int rho) { const int n = rho >> 4, i = rho & 15; return 8 * (i >> 2) + 4 * n + (i & 3); }

struct Unit { int pm, pn, pc; };
struct Gemm { const bf16_t* A; const bf16_t* Bt; int M, N, K; };

struct StaticOrder {
    int nM, nN, nwg, G, c;
    __host__ __device__ void init(int M, int N, int G_, int c_) { nM = M / BM; nN = N / BM; nwg = nM * nN; G = G_; c = c_; }
    __host__ __device__ bool next(int i, Unit& u) const {
        const long L = (long)i * G + c; if (L >= nwg) return false;
        int wgid = (int)L; { const int q = nwg / NXCD, r = nwg % NXCD, xcd = wgid % NXCD, off = wgid / NXCD; wgid = (xcd < r ? xcd * (q + 1) : r * (q + 1) + (xcd - r) * q) + off; }
        const int nig = WGM * nN, gid = wgid / nig, fm = gid * WGM, gsz = (nM - fm) < WGM ? (nM - fm) : WGM;
        u.pm = fm + ((wgid % nig) % gsz); u.pn = (wgid % nig) / gsz; u.pc = u.pn; return true;
    }
    __device__ __forceinline__ void a_ready(const Unit&) const {}
    __device__ __forceinline__ void done(const Unit&) const {}
};

__device__ __forceinline__ unsigned cvt_pk_bf16(float lo, float hi) { unsigned r; asm volatile("v_cvt_pk_bf16_f32 %0, %1, %2" : "=v"(r) : "v"(lo), "v"(hi)); return r; }
typedef float f32x2 __attribute__((ext_vector_type(2)));

template <class Epi, class Sched, bool ALIGN_EPI = false, bool SP2 = false>
__device__ __forceinline__ void gemm_phase(PG8_LAS unsigned char* lds, const Gemm g, const Sched& S, const Epi& E, const int tid) {
    const int wid = __builtin_amdgcn_readfirstlane(tid >> 6), lane = tid & 63, wr = wid >> 2, wc = wid & 3, fr = lane & 15, fq = lane >> 4;
    const int K = g.K, nt = K / BK;
    unsigned voffA[2], voffB[2];
#pragma unroll
    for (int i = 0; i < 2; ++i) { int R, C; stage_rc(tid * 16 + i * 8192, R, C); const int Rb = Epi::PERM ? ((R & ~31) + perm32(R & 31)) : R;
        voffA[i] = (unsigned)(R * K + C) * 2u; voffB[i] = (unsigned)(Rb * K + C) * 2u; }
    const size_t kstep = (size_t)(BK * 2);
    const size_t hstep = (size_t)HALF * K * 2;
    const size_t tstep = 2 * hstep;
    const unsigned ldsw = (unsigned)wid * 1024u;
    const int aoff = lds_byte(wr * 64 + fr, fq * 8), boff = lds_byte(wc * 32 + fr, fq * 8);
#define PG8_SA(b, h) (((b) * 2 + (h)) * HTB)
#define PG8_SB(b, h) ((4 + (b) * 2 + (h)) * HTB)
#define PG8_STAGE(bufoff, gbase, voff) do { _Pragma("unroll") for (int _i = 0; _i < 2; ++_i) \
        __builtin_amdgcn_global_load_lds((const unsigned*)((const char*)(gbase) + (voff)[_i]), (PG8_LAS unsigned*)(lds + (bufoff) + ldsw + _i * 8192), 16, 0, 0); } while (0)
#define PG8_LDA(dst, b, h) do { _Pragma("unroll") for (int m = 0; m < 4; ++m) _Pragma("unroll") for (int k = 0; k < 2; ++k) dst[m][k] = *(const PG8_LAS bf16x8*)(lds + PG8_SA(b, h) + aoff + m * 2048 + k * 1024); } while (0)
#define PG8_LDB(dst, b, h) do { _Pragma("unroll") for (int n = 0; n < 2; ++n) _Pragma("unroll") for (int k = 0; k < 2; ++k) dst[n][k] = *(const PG8_LAS bf16x8*)(lds + PG8_SB(b, h) + boff + n * 2048 + k * 1024); } while (0)
#define PG8_MMA(ai, bj, At, Bt) do { __builtin_amdgcn_s_setprio(1); _Pragma("unroll") for (int m = 0; m < 4; ++m) _Pragma("unroll") for (int n = 0; n < 2; ++n) _Pragma("unroll") for (int k = 0; k < 2; ++k) \
        acc[ai][bj][m][n] = __builtin_amdgcn_mfma_f32_16x16x32_bf16(Bt[n][k], At[m][k], acc[ai][bj][m][n], 0, 0, 0); __builtin_amdgcn_s_setprio(0); } while (0)
#define PG8_WAIT_V(n) asm volatile("s_waitcnt vmcnt(" #n ")" ::: "memory")
#define PG8_WAIT_L(n) asm volatile("s_waitcnt lgkmcnt(" #n ")" ::: "memory")
#define PG8_BAR __builtin_amdgcn_s_barrier()
#define PG8_SCHED __builtin_amdgcn_sched_barrier(0)
    Unit cur, nxt; int ui = 0;
    if (!S.next(0, cur)) return;
    f32x4 acc[2][2][4][2];
#pragma unroll
    for (int a = 0; a < 2; ++a)
#pragma unroll
        for (int b = 0; b < 2; ++b)
#pragma unroll
            for (int m = 0; m < 4; ++m)
#pragma unroll
                for (int n = 0; n < 2; ++n) acc[a][b][m][n] = (f32x4){0.f, 0.f, 0.f, 0.f};
    bf16x8 At[4][2], B0[2][2], B1[2][2];
    const char* cA = (const char*)g.A + (size_t)cur.pm * tstep; const char* cB = (const char*)g.Bt + (size_t)cur.pn * tstep;
    S.a_ready(cur);
    if constexpr (SP2) {
        PG8_STAGE(PG8_SB(0, 0), cB, voffB); PG8_STAGE(PG8_SB(0, 1), cB + hstep, voffB); PG8_STAGE(PG8_SA(0, 0), cA, voffA); PG8_STAGE(PG8_SA(0, 1), cA + hstep, voffA);
        if (wr == 1) PG8_BAR;
        PG8_WAIT_V(2); PG8_BAR;
        PG8_STAGE(PG8_SB(1, 0), cB + kstep, voffB); PG8_STAGE(PG8_SA(1, 0), cA + kstep, voffA); PG8_STAGE(PG8_SB(1, 1), cB + hstep + kstep, voffB);
        PG8_WAIT_V(6); PG8_BAR;
    } else {
        PG8_STAGE(PG8_SB(0, 0), cB, voffB); PG8_STAGE(PG8_SA(0, 0), cA, voffA); PG8_STAGE(PG8_SB(0, 1), cB + hstep, voffB); PG8_STAGE(PG8_SA(0, 1), cA + hstep, voffA);
        if (wr == 1) PG8_BAR;
        PG8_WAIT_V(4); PG8_BAR;
        PG8_STAGE(PG8_SB(1, 0), cB + kstep, voffB); PG8_STAGE(PG8_SA(1, 0), cA + kstep, voffA); PG8_STAGE(PG8_SB(1, 1), cB + hstep + kstep, voffB);
        PG8_WAIT_V(6); PG8_BAR;
    }
    for (;;) {
        const bool has_next = S.next(ui + 1, nxt);
        const char* nA = has_next ? (const char*)g.A + (size_t)nxt.pm * tstep : cA; const char* nB = has_next ? (const char*)g.Bt + (size_t)nxt.pn * tstep : cB;
        for (int t = 0; t < nt; t += 2) {
            const bool last = (t == nt - 2);
            const char* a1 = cA + (size_t)(t + 1) * kstep;
            const char* a2 = last ? nA : cA + (size_t)(t + 2) * kstep; const char* b2 = last ? nB : cB + (size_t)(t + 2) * kstep;
            const char* a3 = a2 + kstep; const char* b3 = b2 + kstep;
            if (last && has_next) S.a_ready(nxt);
            if constexpr (SP2) {
            PG8_LDB(B0, 0, 0); PG8_LDB(B1, 0, 1); PG8_SCHED; PG8_LDA(At, 0, 0); PG8_STAGE(PG8_SA(1, 1), a1 + hstep, voffA);
            PG8_WAIT_V(8); PG8_WAIT_L(0); PG8_BAR; PG8_MMA(0, 0, At, B0); PG8_MMA(0, 1, At, B1); PG8_BAR; PG8_SCHED;
            PG8_LDA(At, 0, 1); PG8_STAGE(PG8_SB(0, 0), b2, voffB); PG8_STAGE(PG8_SB(0, 1), b2 + hstep, voffB); PG8_STAGE(PG8_SA(0, 0), a2, voffA);
            PG8_WAIT_V(8); PG8_WAIT_L(0); PG8_BAR; PG8_MMA(1, 0, At, B0); PG8_MMA(1, 1, At, B1); PG8_BAR; PG8_SCHED;
            PG8_LDB(B0, 1, 0); PG8_LDB(B1, 1, 1); PG8_SCHED; PG8_LDA(At, 1, 0); PG8_STAGE(PG8_SA(0, 1), a2 + hstep, voffA);
            PG8_WAIT_V(8); PG8_WAIT_L(0); PG8_BAR; PG8_MMA(0, 0, At, B0); PG8_MMA(0, 1, At, B1); PG8_BAR; PG8_SCHED;
            PG8_LDA(At, 1, 1); PG8_STAGE(PG8_SB(1, 0), b3, voffB); PG8_STAGE(PG8_SB(1, 1), b3 + hstep, voffB); PG8_STAGE(PG8_SA(1, 0), a3, voffA);
            PG8_WAIT_V(8); PG8_WAIT_L(0); PG8_BAR; PG8_MMA(1, 0, At, B0); PG8_MMA(1, 1, At, B1); PG8_BAR; PG8_SCHED;
            } else {
            PG8_LDB(B0, 0, 0); PG8_SCHED; PG8_LDA(At, 0, 0); PG8_STAGE(PG8_SA(1, 1), a1 + hstep, voffA);
            PG8_WAIT_L(8); PG8_BAR; PG8_WAIT_L(0); PG8_MMA(0, 0, At, B0); PG8_BAR; PG8_SCHED;
            PG8_LDB(B1, 0, 1); PG8_STAGE(PG8_SB(0, 0), b2, voffB);
            PG8_BAR; PG8_WAIT_L(0); PG8_MMA(0, 1, At, B1); PG8_BAR;
            PG8_LDA(At, 0, 1); PG8_STAGE(PG8_SA(0, 0), a2, voffA);
            PG8_BAR; PG8_WAIT_L(0); PG8_MMA(1, 0, At, B0); PG8_BAR; PG8_SCHED;
            PG8_STAGE(PG8_SB(0, 1), b2 + hstep, voffB);
            PG8_WAIT_V(6); PG8_BAR; PG8_MMA(1, 1, At, B1); PG8_BAR;
            PG8_LDB(B0, 1, 0); PG8_SCHED; PG8_LDA(At, 1, 0); PG8_STAGE(PG8_SA(0, 1), a2 + hstep, voffA);
            PG8_WAIT_L(8); PG8_BAR; PG8_WAIT_L(0); PG8_MMA(0, 0, At, B0); PG8_BAR; PG8_SCHED;
            PG8_LDB(B1, 1, 1); PG8_STAGE(PG8_SB(1, 0), b3, voffB);
            PG8_BAR; PG8_WAIT_L(0); PG8_MMA(0, 1, At, B1); PG8_BAR;
            PG8_LDA(At, 1, 1); PG8_STAGE(PG8_SA(1, 0), a3, voffA);
            PG8_BAR; PG8_WAIT_L(0); PG8_MMA(1, 0, At, B0); PG8_BAR; PG8_SCHED;
            PG8_STAGE(PG8_SB(1, 1), b3 + hstep, voffB);
            PG8_WAIT_V(6); PG8_BAR; PG8_MMA(1, 1, At, B1); PG8_BAR;
            }
        }
        if constexpr (ALIGN_EPI) { if (wr == 0) PG8_BAR; }
        if constexpr (!Epi::AFTER_DRAIN) { E(acc, cur, wr, wc, fr, fq); S.done(cur); }
        if (!has_next) break;
#pragma unroll
        for (int a = 0; a < 2; ++a)
#pragma unroll
            for (int b = 0; b < 2; ++b)
#pragma unroll
                for (int m = 0; m < 4; ++m)
#pragma unroll
                    for (int n = 0; n < 2; ++n) acc[a][b][m][n] = (f32x4){0.f, 0.f, 0.f, 0.f};
        cur = nxt; cA = nA; cB = nB; ++ui;
        if constexpr (ALIGN_EPI) { if (wr == 1) PG8_BAR; }
    }
    PG8_WAIT_V(0);
    if constexpr (!ALIGN_EPI) { if (wr == 0) PG8_BAR; }
    PG8_BAR;
    if constexpr (Epi::AFTER_DRAIN) { E.fused(acc, cur, wr, wc, fr, fq, lds, wid, lane); S.done(cur); }
#undef PG8_SA
#undef PG8_SB
#undef PG8_STAGE
#undef PG8_LDA
#undef PG8_LDB
#undef PG8_MMA
#undef PG8_WAIT_V
#undef PG8_WAIT_L
#undef PG8_BAR
#undef PG8_SCHED
}
}

#define XB_TMO      128
#define XB_XCNT(j)  (256  + 64 * (j))
#define XB_XSUB(j)  (1280 + 64 * (j))
#define XB_XGEN(j)  (2304 + 64 * (j))
#define XB_TOP      3328
#define XB_TOPGEN   3392
#define XCD_BAR_WORDS 3456
#define XB_SPIN_CAP (1u << 18)

__device__ __forceinline__ unsigned xb_ld(unsigned* p)              { return __hip_atomic_load(p, __ATOMIC_RELAXED, __HIP_MEMORY_SCOPE_AGENT); }
__device__ __forceinline__ unsigned xb_add(unsigned* p, unsigned v) { return __hip_atomic_fetch_add(p, v, __ATOMIC_RELAXED, __HIP_MEMORY_SCOPE_AGENT); }
__device__ __forceinline__ unsigned xb_xcc_id() { return (unsigned)__builtin_amdgcn_s_getreg((3 << 11) | 20) & 0xFu; }
#define XB_SPIN(cond, bar) do { unsigned _sp = 0; while (cond) { __builtin_amdgcn_s_sleep(1); \
    if ((++_sp & 255u) == 0u) { if (xb_ld(&(bar)[XB_TMO])) break; if (_sp > XB_SPIN_CAP) { atomicAdd(&(bar)[XB_TMO], 1u); break; } } } } while (0)

struct XcdBarrier {
    unsigned* bar; unsigned x;
    volatile LAS unsigned* st;
};

__device__ __forceinline__ XcdBarrier xcd_barrier_post(unsigned* bar, volatile LAS unsigned* st, const int xb_tid) {
    XcdBarrier b; b.bar = bar; b.x = xb_xcc_id(); b.st = st;
    if (xb_tid == 0) (void)xb_add(&bar[XB_XCNT(b.x)], 1u);
    return b;
}
__device__ __forceinline__ void xcd_barrier_complete(unsigned* bar, unsigned x, unsigned& nloc, unsigned& nx) {
    const unsigned G = gridDim.x * gridDim.y * gridDim.z;
    unsigned sum, cnt, mine, sp = 0u;
    for (;;) {
        sum = 0u; cnt = 0u; mine = 0u;
#pragma unroll
        for (unsigned j = 0; j < 16; ++j) { const unsigned c = xb_ld(&bar[XB_XCNT(j)]); sum += c; cnt += (c > 0u) ? 1u : 0u; mine = (j == x) ? c : mine; }
        if (sum == G) break;
        __builtin_amdgcn_s_sleep(1);
        if ((++sp & 255u) == 0u) { if (xb_ld(&bar[XB_TMO])) break; if (sp > XB_SPIN_CAP) { atomicAdd(&bar[XB_TMO], 1u); break; } }
    }
    nloc = mine > 0u ? mine : 1u; nx = cnt > 0u ? cnt : 1u;
}

__device__ __forceinline__ void xcd_barrier(const XcdBarrier& b, const int xb_tid) {
    asm volatile("s_waitcnt vmcnt(0)" ::: "memory");
    __syncthreads();
    if (xb_tid == 0) {
        unsigned* bar = b.bar;
        __builtin_amdgcn_s_waitcnt(0);
        unsigned nloc = b.st[0], nx = b.st[1];
        if (nloc == 0u) { xcd_barrier_complete(bar, b.x, nloc, nx); b.st[0] = nloc; b.st[1] = nx; }
        const unsigned old = xb_add(&bar[XB_XSUB(b.x)], 1u);
        const unsigned gen = old / nloc;
        if (old + 1u == (gen + 1u) * nloc) {
            __builtin_amdgcn_fence(__ATOMIC_RELEASE, "agent");
            asm volatile("s_waitcnt vmcnt(0)" ::: "memory");
            const unsigned og = xb_add(&bar[XB_TOP], 1u);
            const unsigned tg = og / nx;
            if (og + 1u == (tg + 1u) * nx) xb_add(&bar[XB_TOPGEN], 1u);
            else XB_SPIN(xb_ld(&bar[XB_TOPGEN]) == tg, bar);
            __builtin_amdgcn_fence(__ATOMIC_ACQUIRE, "agent");
            xb_add(&bar[XB_XGEN(b.x)], 1u);
            asm volatile("s_waitcnt vmcnt(0)" ::: "memory");
        } else {
            XB_SPIN(xb_ld(&bar[XB_XGEN(b.x)]) == gen, bar);
            __builtin_amdgcn_fence(__ATOMIC_ACQUIRE, "agent");
            asm volatile("s_waitcnt vmcnt(0)" ::: "memory");
        }
    }
    __syncthreads();
}

#define GAS __attribute__((address_space(1)))
typedef unsigned short bf16;
typedef unsigned v4u __attribute__((ext_vector_type(4)));
typedef unsigned v2u __attribute__((ext_vector_type(2)));
typedef float f32x4 __attribute__((ext_vector_type(4)));

constexpr int NB = 4, SEQ = 8192, DM = 1024, DEPTH = 4, CTXL = 256;
constexpr int NLAT = NB * SEQ, NCTX = NB * CTXL, MT = NLAT + NCTX;
constexpr int DIN = 3360, DINP = 3584, DFF = 2816, NEXP = 8;
constexpr int C_RQ = 0, C_RK = 256, C_RV = 512, C_RG = 768, C_S5 = 1024, C_HQ = 1280, C_HFF = 1536, C_HFB = 1792, C_HI = 2048, C_HG = 2304,
              C_GQ = 2560, C_GK = 2688, C_GV = 2816, C_GG = 3072, C_GAF = 3328, C_GAB = 3344,
              C_GZF = 3328, C_GZB = 3456;
constexpr int NSEG = 132;
constexpr int MOE_CAP_TILES = 272;
constexpr float NEPS = 1e-6f;

constexpr size_t MiB = 1u << 20;
constexpr size_t WS_CTL = 0, CTL_ZERO_BYTES = 2 * MiB;
constexpr size_t WS_MOD = 2 * MiB;
constexpr size_t WS_LB = 3 * MiB;
constexpr size_t WS_ROPE = 3 * MiB + 65536;
constexpr size_t WS_GLUW = 3 * MiB + 131072;
constexpr size_t WS_WIN = 4 * MiB;
constexpr size_t WS_WOUT = 32 * MiB;
constexpr size_t WS_W13D = 40 * MiB;
constexpr size_t WS_W2D = 62 * MiB;
constexpr size_t WS_W13M = 73 * MiB;
constexpr size_t WS_W2M = 161 * MiB;
constexpr size_t WS_HB = 205 * MiB;
constexpr size_t WS_ACT = 209 * MiB;
constexpr size_t WS_Z = 275 * MiB;
constexpr size_t WS_PH = 292 * MiB;
constexpr size_t WS_OF = (292 + 232) * MiB;
constexpr size_t WS_X2 = 666 * MiB;
constexpr size_t WS_LIST = 843 * MiB;
constexpr size_t WS_END = 846 * MiB;
constexpr size_t ST_DS0 = 0;
constexpr size_t ST_DS1 = ST_DS0 + (size_t)2 * 16 * NSEG * 4096;
constexpr size_t ST_DS2 = ST_DS1 + (size_t)2 * 16 * NSEG * 4096;
constexpr size_t ST_G0 = ST_DS2 + (size_t)2 * 16 * NSEG * 2048;
constexpr size_t ST_G1 = ST_G0 + (size_t)2 * 16 * NSEG * 64;
constexpr size_t ST_G2 = ST_G1 + (size_t)2 * 16 * NSEG * 64;
constexpr size_t ST_HS = ST_G2 + (size_t)2 * 16 * NSEG * 64;
constexpr size_t ST_END = ST_HS + (size_t)2 * 64 * NSEG * 128;
static_assert(ST_END * 4 <= (WS_LIST - WS_X2), "state region");
static_assert(WS_PH + (size_t)MT * DINP * 2 <= WS_OF && WS_OF + (size_t)MT * 768 * 4 <= WS_X2, "OF region");
static_assert((size_t)MOE_CAP_TILES * 256 * 1024 * 2 <= (WS_LIST - WS_X2), "XB region");
static_assert((size_t)MOE_CAP_TILES * 256 * DFF * 2 <= (WS_X2 - WS_PH) && (size_t)MT * DINP * 2 <= (WS_X2 - WS_PH), "P/H region");
constexpr int CW_BAR = 4096;
constexpr int CW_CNT = 16384;

constexpr int LDS_BYTES = 163840;
constexpr int MISC_OFF = 163840 - 512;

__device__ __forceinline__ float bf2f(unsigned short h) { return __uint_as_float(((unsigned)h) << 16); }
__device__ __forceinline__ unsigned f2bf(float f) { unsigned u = __float_as_uint(f); return (u + 0x7fffu + ((u >> 16) & 1u)) >> 16; }
__device__ __forceinline__ unsigned pk2(float lo, float hi) { return f2bf(lo) | (f2bf(hi) << 16); }
__device__ __forceinline__ float wave_sum(float v) {
#pragma unroll
    for (int o = 1; o < 64; o <<= 1) v += __shfl_xor(v, o);
    return v;
}
__device__ __forceinline__ float rdl(float v, int k) { return __uint_as_float((unsigned)__builtin_amdgcn_readlane((int)__float_as_uint(v), k)); }
__device__ __forceinline__ float sigm(float x) { return 1.0f / (1.0f + __expf(-x)); }
__device__ __forceinline__ float silu_f(float x) { return x / (1.0f + __expf(-x)); }
#define LDS_WAIT() asm volatile("s_waitcnt lgkmcnt(0)" ::: "memory")

struct Args {
    const float* in[37];
    int l_lo, l_hi, ph_lo, ph_hi, do_pro, do_fin, fused, pad;
};
constexpr int I_OUT = 35, I_WS = 36;
enum { I_X = 0, I_C, I_CTX, I_CCTX, I_ADAW, I_ADAB, I_N1W, I_N2W, I_WIN, I_WOUT, I_RETGN, I_LAMRE, I_LAMIM, I_LOGDT, I_BRE, I_BIM, I_CRE, I_CIM, I_S5D,
       I_GLUW, I_GLUB, I_LBL, I_HGNW, I_WA2, I_BA, I_GLANW, I_FW1, I_FW3, I_FW2, I_RW, I_RB, I_MW1, I_MW3, I_MW2, I_FINW };

struct Frame {
    LAS unsigned char* lds;
    int tid, lane, wave, gw, NGW, G, zz;
    unsigned char* ws; float* out;
};

struct EpiStoreBf16 {
    static constexpr bool PERM = true, AFTER_DRAIN = false;
    bf16* O; int ldc;
    __device__ __forceinline__ void operator()(const pg8::f32x4 (&acc)[2][2][4][2], const pg8::Unit& u, int wr, int wc, int fr, int fq) const {
        const int row0 = u.pm * 256 + wr * 64 + fr, col0 = u.pc * 256 + wc * 32 + 8 * fq;
#pragma unroll
        for (int ai = 0; ai < 2; ++ai)
#pragma unroll
            for (int m = 0; m < 4; ++m) { bf16* rowp = O + (size_t)(row0 + ai * 128 + m * 16) * ldc + col0;
#pragma unroll
                for (int bj = 0; bj < 2; ++bj) { const pg8::f32x4 v0 = acc[ai][bj][m][0], v1 = acc[ai][bj][m][1];
                    pg8::u32x4 w; w.x = pg8::cvt_pk_bf16(v0[0], v0[1]); w.y = pg8::cvt_pk_bf16(v0[2], v0[3]); w.z = pg8::cvt_pk_bf16(v1[0], v1[1]); w.w = pg8::cvt_pk_bf16(v1[2], v1[3]);
                    *(pg8::u32x4*)(rowp + bj * 128) = w; } }
    }
};
struct EpiSwiglu {
    static constexpr bool PERM = true, AFTER_DRAIN = false;
    bf16* H;
    __device__ __forceinline__ void operator()(const pg8::f32x4 (&acc)[2][2][4][2], const pg8::Unit& u, int wr, int wc, int fr, int fq) const {
        const int row0 = u.pm * 256 + wr * 64 + fr, col0 = u.pc * 128 + wc * 32 + 8 * fq;
#pragma unroll
        for (int ai = 0; ai < 2; ++ai)
#pragma unroll
            for (int m = 0; m < 4; ++m) { bf16* rowp = H + (size_t)(row0 + ai * 128 + m * 16) * DFF + col0;
                float h[8];
#pragma unroll
                for (int n = 0; n < 2; ++n)
#pragma unroll
                    for (int j = 0; j < 4; ++j) { const float a = acc[ai][0][m][n][j], b = acc[ai][1][m][n][j];
                        h[n * 4 + j] = a * __builtin_amdgcn_rcpf(1.0f + __builtin_amdgcn_exp2f(-1.4426950408889634f * a)) * b; }
                pg8::u32x4 w; w.x = pg8::cvt_pk_bf16(h[0], h[1]); w.y = pg8::cvt_pk_bf16(h[2], h[3]); w.z = pg8::cvt_pk_bf16(h[4], h[5]); w.w = pg8::cvt_pk_bf16(h[6], h[7]);
                *(pg8::u32x4*)rowp = w; }
    }
};
struct EpiResid {
    static constexpr bool PERM = false, AFTER_DRAIN = false;
    const float* xin_lat; const float* xin_ctx; float* xout_lat; float* xout_ctx; const float* gate;
    __device__ __forceinline__ void operator()(const pg8::f32x4 (&acc)[2][2][4][2], const pg8::Unit& u, int wr, int wc, int fr, int fq) const {
        const bool isctx = u.pm >= 128; const int bidx = isctx ? 4 : (u.pm >> 5);
        const size_t rbase = (size_t)(isctx ? (u.pm - 128) : u.pm) * 256 + wr * 64 + fr;
        const float* xi = (isctx ? xin_ctx : xin_lat); float* xo = (isctx ? xout_ctx : xout_lat);
        const int col0 = u.pc * 256 + wc * 32 + 4 * fq; const float* g = gate + (size_t)bidx * 6144 + col0;
        pg8::f32x4 gv[2][2];
#pragma unroll
        for (int bj = 0; bj < 2; ++bj)
#pragma unroll
            for (int n = 0; n < 2; ++n) gv[bj][n] = *(const pg8::f32x4*)(g + bj * 128 + n * 16);
#pragma unroll
        for (int ai = 0; ai < 2; ++ai)
#pragma unroll
            for (int m = 0; m < 4; ++m) { const size_t off = (rbase + ai * 128 + m * 16) * 1024 + col0;
#pragma unroll
                for (int bj = 0; bj < 2; ++bj)
#pragma unroll
                    for (int n = 0; n < 2; ++n) { const pg8::f32x4 xv = *(const pg8::f32x4*)(xi + off + bj * 128 + n * 16);
                        *(pg8::f32x4*)(xo + off + bj * 128 + n * 16) = xv + gv[bj][n] * acc[ai][bj][m][n]; }
                asm volatile("" ::: "memory"); }
    }
};
struct EpiGlu {
    static constexpr bool PERM = true, AFTER_DRAIN = false;
    const bf16* Z; bf16* Y; const float* bias;
    __device__ __forceinline__ void operator()(const pg8::f32x4 (&acc)[2][2][4][2], const pg8::Unit& u, int wr, int wc, int fr, int fq) const {
        const int row0 = u.pm * 256 + wr * 64 + fr, col0 = wc * 32 + 8 * fq;
#pragma unroll
        for (int ai = 0; ai < 2; ++ai)
#pragma unroll
            for (int m = 0; m < 4; ++m) { const size_t row = (size_t)(row0 + ai * 128 + m * 16);
#pragma unroll
                for (int bj = 0; bj < 2; ++bj) { const int col = col0 + bj * 128;
                    const pg8::u32x4 zz = *(const pg8::u32x4*)(Z + row * 256 + col);
                    const pg8::f32x4 b0 = *(const pg8::f32x4*)(bias + col), b1 = *(const pg8::f32x4*)(bias + col + 4);
                    const pg8::f32x4 v0 = acc[ai][bj][m][0] + b0, v1 = acc[ai][bj][m][1] + b1;
                    float o[8]; const unsigned zw[4] = {zz.x, zz.y, zz.z, zz.w};
#pragma unroll
                    for (int j = 0; j < 4; ++j) { const float zl = __uint_as_float(zw[j] << 16), zh = __uint_as_float(zw[j] & 0xffff0000u);
                        const float a0 = (j < 2) ? v0[2 * j] : v1[2 * j - 4], a1 = (j < 2) ? v0[2 * j + 1] : v1[2 * j - 3];
                        o[2 * j] = zl * sigm(a0); o[2 * j + 1] = zh * sigm(a1); }
                    pg8::u32x4 w; w.x = pg8::cvt_pk_bf16(o[0], o[1]); w.y = pg8::cvt_pk_bf16(o[2], o[3]); w.z = pg8::cvt_pk_bf16(o[4], o[5]); w.w = pg8::cvt_pk_bf16(o[6], o[7]);
                    *(pg8::u32x4*)(Y + row * 1024 + 256 + col) = w; }
                asm volatile("" ::: "memory"); }
    }
};
struct MoeOrder {
    int tp[9]; int nN, G, c, total;
    __device__ __forceinline__ void init(const unsigned* cnt, int nN_, int G_, int c_) {
        tp[0] = 0;
#pragma unroll
        for (int e = 0; e < 8; ++e) tp[e + 1] = tp[e] + (int)(((unsigned)__builtin_amdgcn_readfirstlane((int)__hip_atomic_load(cnt + e * 64, __ATOMIC_RELAXED, __HIP_MEMORY_SCOPE_AGENT)) + 255u) >> 8);
        nN = nN_; G = G_; c = c_; total = tp[8] * nN;
    }
    __device__ __forceinline__ bool next(int i, pg8::Unit& u) const {
        const int L = i * G + c; if (L >= total) return false;
        const int t = L / nN, pn = L - t * nN; int e = 0;
#pragma unroll
        for (int k = 1; k < 8; ++k) e += (t >= tp[k]) ? 1 : 0;
        u.pm = t; u.pn = e * nN + pn; u.pc = pn; return true;
    }
    __device__ __forceinline__ void a_ready(const pg8::Unit&) const {}
    __device__ __forceinline__ void done(const pg8::Unit&) const {}
};

__device__ __forceinline__ void cvt_item(const float* W, int K, int N, bf16* WT, int mode, int add, LAS float* scr, int item, int lane, int nblk_override = 0) {
    const int nblk = nblk_override ? nblk_override : (N >> 5), kb = item / nblk, nb = item - kb * nblk, k0 = 64 * kb, n0 = 32 * nb;
    const int r = lane >> 3, c4 = lane & 7;
    f32x4 v[8];
#pragma unroll
    for (int i = 0; i < 8; ++i) v[i] = *(const f32x4*)(W + (size_t)(k0 + 8 * i + r) * N + n0 + 4 * c4);
#pragma unroll
    for (int i = 0; i < 8; ++i) {
#pragma unroll
        for (int j = 0; j < 4; ++j) scr[(8 * i + r) * 33 + 4 * c4 + j] = v[i][j]; }
    LDS_WAIT();
    const int c = lane & 7;
#pragma unroll
    for (int j = 0; j < 4; ++j) { const int n = (lane >> 3) + 8 * j; const LAS float* s = scr + (8 * c) * 33 + n;
        v4u o; o.x = pk2(s[0 * 33], s[1 * 33]); o.y = pk2(s[2 * 33], s[3 * 33]); o.z = pk2(s[4 * 33], s[5 * 33]); o.w = pk2(s[6 * 33], s[7 * 33]);
        const int nn = n0 + n; const int drow = (mode == 0) ? (nn + add) : (((nn >> 7) << 8) + (nn & 127) + add);
        *(v4u*)(WT + (size_t)drow * K + k0 + 8 * c) = o; }
    LDS_WAIT();
}
__device__ __forceinline__ void moe_cvt(const Frame& F, const Args& a, int j) {
    LAS float* scr = (LAS float*)(F.lds + F.wave * 16384);
    constexpr int IT = 1408;
    for (int it = F.gw; it < 8 * 3 * IT; it += F.NGW) {
        const int e = it / (3 * IT), r = it - e * 3 * IT, which = r / IT, item = r - which * IT;
        const size_t eo = ((size_t)j * 8 + e) * (size_t)(1024 * DFF);
        if (which == 0) cvt_item(a.in[F.zz + I_MW1] + eo, 1024, DFF, (bf16*)(F.ws + WS_W13M) + (size_t)e * 5632 * 1024, 1, 0, scr, item, F.lane);
        else if (which == 1) cvt_item(a.in[F.zz + I_MW3] + eo, 1024, DFF, (bf16*)(F.ws + WS_W13M) + (size_t)e * 5632 * 1024, 1, 128, scr, item, F.lane);
        else cvt_item(a.in[F.zz + I_MW2] + eo, DFF, 1024, (bf16*)(F.ws + WS_W2M) + (size_t)e * 1024 * DFF, 0, 0, scr, item, F.lane);
    }
}
__device__ __forceinline__ void prologue(const Frame& F, const Args& a) {
    {
        LAS float* sc = (LAS float*)F.lds; LAS float* red = sc + 5120;
        for (int idx = F.tid; idx < 5120; idx += 512) { const int r = idx >> 10, k = idx & 1023; const float cv = (r < 4) ? a.in[F.zz + I_C][r * 1024 + k] : a.in[F.zz + I_CCTX][k]; sc[idx] = silu_f(cv); }
        __syncthreads();
        float* MOD = (float*)(F.ws + WS_MOD);
        for (int item = blockIdx.x; item < 384; item += F.G) {
            const int l = item / 96, nb = item - l * 96, cl = F.tid & 63, ks = F.tid >> 6, n = nb * 64 + cl;
            float acc[5] = {0.f, 0.f, 0.f, 0.f, 0.f};
            const float* wp = a.in[F.zz + I_ADAW] + ((size_t)l * 1024 + ks * 128) * 6144 + n;
#pragma unroll 16
            for (int kk = 0; kk < 128; ++kk) { const float w = wp[(size_t)kk * 6144];
#pragma unroll
                for (int r = 0; r < 5; ++r) acc[r] = fmaf(sc[r * 1024 + ks * 128 + kk], w, acc[r]); }
#pragma unroll
            for (int r = 0; r < 5; ++r) red[(ks * 5 + r) * 64 + cl] = acc[r];
            __syncthreads();
            if (F.tid < 320) { const int r = F.tid >> 6; float s = 0.f;
#pragma unroll
                for (int k2 = 0; k2 < 8; ++k2) s += red[(k2 * 5 + r) * 64 + cl];
                MOD[((size_t)l * 5 + r) * 6144 + n] = s + a.in[F.zz + I_ADAB][l * 6144 + n]; }
            __syncthreads();
        }
        if (blockIdx.x == 0 && F.tid < 256) {
            const float* lg = a.in[F.zz + I_LBL]; float x[4], mx = -3.0e38f;
#pragma unroll
            for (int l = 0; l < 4; ++l) { x[l] = lg[l * 256 + F.tid]; mx = fmaxf(mx, x[l]); }
            float s = 0.f;
#pragma unroll
            for (int l = 0; l < 4; ++l) { x[l] = expf(x[l] - mx); s += x[l]; }
            float cs = 0.f; const float sm0 = x[0] / s; float* LB = (float*)(F.ws + WS_LB);
#pragma unroll
            for (int l = 0; l < 4; ++l) { cs += x[l] / s; LB[l * 256 + F.tid] = fminf(fmaxf(cs - sm0, 0.f), 1.0f - 1e-6f); }
        }
        if (blockIdx.x == (1 % F.G)) {
            float* RC = (float*)(F.ws + WS_ROPE); float* RS = RC + 2048;
            for (int idx = F.tid; idx < 2048; idx += 512) { const int pos = idx >> 4, i = idx & 15;
                const float fr = powf(10000.0f, -(float)i / 16.0f); const float ang = (float)pos * fr; RC[idx] = cosf(ang); RS[idx] = sinf(ang); }
        }
        __syncthreads();
    }
    LAS float* scr = (LAS float*)(F.lds + F.wave * 16384);
    constexpr int I_IN = 16 * 104, I_OUT = 16 * 32, I_F = 1408, I_GL = 4 * 8;
    constexpr int NIT = 4 * I_IN + 4 * I_OUT + 6 * I_F + 4 * I_GL;
    for (int it = F.gw; it < NIT; it += F.NGW) {
        int r = it;
        if (r < 4 * I_IN) { const int l = r / I_IN; cvt_item(a.in[F.zz + I_WIN] + (size_t)l * 1024 * DIN, 1024, DIN, (bf16*)(F.ws + WS_WIN) + (size_t)l * DINP * 1024, 0, 0, scr, r - l * I_IN, F.lane, 104); continue; } r -= 4 * I_IN;
        if (r < 4 * I_OUT) { const int l = r / I_OUT; cvt_item(a.in[F.zz + I_WOUT] + (size_t)l * 1024 * 1024, 1024, 1024, (bf16*)(F.ws + WS_WOUT) + (size_t)l * 1024 * 1024, 0, 0, scr, r - l * I_OUT, F.lane); continue; } r -= 4 * I_OUT;
        if (r < 6 * I_F) { const int j = r / (3 * I_F), r2 = r - j * 3 * I_F, which = r2 / I_F, item = r2 - which * I_F; const size_t wo = (size_t)j * 1024 * DFF;
            if (which == 0) cvt_item(a.in[F.zz + I_FW1] + wo, 1024, DFF, (bf16*)(F.ws + WS_W13D) + (size_t)j * 5632 * 1024, 1, 0, scr, item, F.lane);
            else if (which == 1) cvt_item(a.in[F.zz + I_FW3] + wo, 1024, DFF, (bf16*)(F.ws + WS_W13D) + (size_t)j * 5632 * 1024, 1, 128, scr, item, F.lane);
            else cvt_item(a.in[F.zz + I_FW2] + wo, DFF, 1024, (bf16*)(F.ws + WS_W2D) + (size_t)j * 1024 * DFF, 0, 0, scr, item, F.lane);
            continue; } r -= 6 * I_F;
        { const int l = r / I_GL; cvt_item(a.in[F.zz + I_GLUW] + (size_t)l * 65536, 256, 256, (bf16*)(F.ws + WS_GLUW) + (size_t)l * 65536, 0, 0, scr, r - l * I_GL, F.lane); }
    }
    moe_cvt(F, a, 0);
    for (int i = blockIdx.x * 512 + F.tid; i < 4 * 256 * 128; i += F.G * 512) {
        const int l = i >> 15, rem = i & 32767, n = rem >> 7, k0 = (rem & 127) * 8, d = n >> 7, cidx = n & 127;
        const float* wa = a.in[F.zz + I_WA2] + ((size_t)(l * 2 + d) * 16) * 128 + cidx;
        float acc[8] = {0.f, 0.f, 0.f, 0.f, 0.f, 0.f, 0.f, 0.f};
#pragma unroll
        for (int r = 0; r < 16; ++r) { const float w2 = wa[r * 128];
#pragma unroll
            for (int kk = 0; kk < 8; ++kk) acc[kk] = fmaf(a.in[F.zz + I_WIN][((size_t)l * 1024 + k0 + kk) * DIN + 3328 + 16 * d + r], w2, acc[kk]); }
        v4u o; o.x = pk2(acc[0], acc[1]); o.y = pk2(acc[2], acc[3]); o.z = pk2(acc[4], acc[5]); o.w = pk2(acc[6], acc[7]);
        *(v4u*)((bf16*)(F.ws + WS_WIN) + ((size_t)l * DINP + 3328 + n) * 1024 + k0) = o;
    }
}

struct MoeTp { int tp[9]; };
__device__ __forceinline__ void load_tp(MoeTp& t, const unsigned* cnt) {
    t.tp[0] = 0;
#pragma unroll
    for (int e = 0; e < 8; ++e) t.tp[e + 1] = t.tp[e] + (int)(((unsigned)__builtin_amdgcn_readfirstlane((int)__hip_atomic_load(cnt + e * 64, __ATOMIC_RELAXED, __HIP_MEMORY_SCOPE_AGENT)) + 255u) >> 8);
}
template <int MODE>
__device__ __forceinline__ void norm_phase(const Frame& F, const Args& a, int l, int which  , int nrows, int comb_l  ) {
    const float* MOD = (const float*)(F.ws + WS_MOD);
    const float* nw = (MODE == 2) ? a.in[F.zz + I_FINW] : ((which ? a.in[F.zz + I_N2W] : a.in[F.zz + I_N1W]) + l * 1024);
    bf16* XN = (bf16*)(F.ws + WS_ACT);
    float* hb = (float*)(F.ws + WS_HB);
    const int* EP = (const int*)(F.ws + WS_LIST) + 8 * MT; const float* GATE = (const float*)(F.ws + WS_LIST) + 10 * MT;
    const bf16* YM = (const bf16*)(F.ws + WS_X2);
    const bool from_input = (l == 0 && which == 0 && MODE != 2);
    MoeTp ctp; if (comb_l >= 0) load_tp(ctp, (const unsigned*)F.ws + CW_CNT + (comb_l >> 1) * 8 * 64);
    const int jm = l >> 1;
    LAS float* rwl = (LAS float*)F.lds;
    if (MODE == 1) {
        const float* rw = a.in[F.zz + I_RW] + (size_t)jm * 8192;
        for (int idx = F.tid; idx < 8192; idx += 512) { const int k = idx >> 3, e = idx & 7; rwl[e * 1024 + k] = rw[idx]; }
        __syncthreads();
    }
    f32x4 wv[4];
#pragma unroll
    for (int j = 0; j < 4; ++j) wv[j] = *((const f32x4*)nw + F.lane + 64 * j);
    for (int m = F.gw; m < nrows; m += F.NGW) {
        const bool isctx = m >= NLAT; const int bidx = isctx ? 4 : (m >> 13);
        const float* xr = from_input ? (isctx ? a.in[F.zz + I_CTX] + (size_t)(m - NLAT) * 1024 : a.in[F.zz + I_X] + (size_t)m * 1024)
                                     : (isctx ? hb + (size_t)(m - NLAT) * 1024 : F.out + (size_t)m * 1024);
        f32x4 v[4];
#pragma unroll
        for (int j = 0; j < 4; ++j) v[j] = *((const f32x4*)xr + F.lane + 64 * j);
        if (comb_l >= 0) {
            const int ep0 = EP[2 * m], ep1 = EP[2 * m + 1]; const float g0 = GATE[2 * m], g1 = GATE[2 * m + 1];
            int t0 = 0, t1 = 0;
#pragma unroll
            for (int e = 0; e < 8; ++e) { t0 = ((ep0 & 7) == e) ? ctp.tp[e] : t0; t1 = ((ep1 & 7) == e) ? ctp.tp[e] : t1; }
            const size_t d0 = (size_t)t0 * 256 + (ep0 >> 3), d1 = (size_t)t1 * 256 + (ep1 >> 3);
            const float* m5 = MOD + ((size_t)comb_l * 5 + bidx) * 6144 + 5 * 1024;
            float* xw = isctx ? hb + (size_t)(m - NLAT) * 1024 : F.out + (size_t)m * 1024;
#pragma unroll
            for (int j = 0; j < 4; ++j) {
                const v2u y0 = *((const v2u*)(YM + d0 * 1024) + F.lane + 64 * j), y1 = *((const v2u*)(YM + d1 * 1024) + F.lane + 64 * j);
                const f32x4 mm = *((const f32x4*)m5 + F.lane + 64 * j);
                f32x4 f0, f1;
                f0[0] = __uint_as_float(y0.x << 16); f0[1] = __uint_as_float(y0.x & 0xffff0000u); f0[2] = __uint_as_float(y0.y << 16); f0[3] = __uint_as_float(y0.y & 0xffff0000u);
                f1[0] = __uint_as_float(y1.x << 16); f1[1] = __uint_as_float(y1.x & 0xffff0000u); f1[2] = __uint_as_float(y1.y << 16); f1[3] = __uint_as_float(y1.y & 0xffff0000u);
                v[j] = v[j] + mm * (f0 * g0 + f1 * g1);
                if (MODE != 2) *((f32x4*)xw + F.lane + 64 * j) = v[j];
            }
        }
        float ss = 0.f;
#pragma unroll
        for (int j = 0; j < 4; ++j) ss += (v[j][0] * v[j][0] + v[j][1] * v[j][1]) + (v[j][2] * v[j][2] + v[j][3] * v[j][3]);
        ss = wave_sum(ss);
        const float rstd = 1.0f / sqrtf(ss * (1.0f / 1024.0f) + NEPS);
        if (MODE == 2) {
#pragma unroll
            for (int j = 0; j < 4; ++j) *((f32x4*)(F.out + (size_t)m * 1024) + F.lane + 64 * j) = v[j] * rstd * wv[j];
        } else {
            const float* sh = MOD + ((size_t)l * 5 + bidx) * 6144 + (which ? 3 : 0) * 1024; const float* scl = sh + 1024;
            f32x4 o[4];
#pragma unroll
            for (int j = 0; j < 4; ++j) { const f32x4 s1 = *((const f32x4*)scl + F.lane + 64 * j), s0 = *((const f32x4*)sh + F.lane + 64 * j);
                o[j] = (v[j] * rstd * wv[j]) * (s1 + 1.0f) + s0;
                v2u w; w.x = pk2(o[j][0], o[j][1]); w.y = pk2(o[j][2], o[j][3]);
                *((v2u*)(XN + (size_t)m * 1024) + F.lane + 64 * j) = w; }
            if (MODE == 1) {
                float p[8];
#pragma unroll
                for (int e = 0; e < 8; ++e) { float s = 0.f;
#pragma unroll
                    for (int j = 0; j < 4; ++j) { const f32x4 w4 = *((const LAS f32x4*)(rwl + e * 1024) + F.lane + 64 * j);
                        s += (o[j][0] * w4[0] + o[j][1] * w4[1]) + (o[j][2] * w4[2] + o[j][3] * w4[3]); }
                    p[e] = wave_sum(s) + a.in[F.zz + I_RB][jm * 8 + e]; }
                int e0 = 0; float v0 = p[0];
#pragma unroll
                for (int e = 1; e < 8; ++e) if (p[e] > v0) { v0 = p[e]; e0 = e; }
                int e1 = -1; float v1 = -3.0e38f;
#pragma unroll
                for (int e = 0; e < 8; ++e) if (e != e0 && p[e] > v1) { v1 = p[e]; e1 = e; }
                const float ex = expf(v1 - v0), g0 = 1.0f / (1.0f + ex), g1 = ex / (1.0f + ex);
                if (F.lane == 0) {
                    unsigned* cnt = (unsigned*)F.ws + CW_CNT + jm * 8 * 64; int* LIST = (int*)(F.ws + WS_LIST);
                    int* EPw = (int*)(F.ws + WS_LIST) + 8 * MT; float* GW = (float*)(F.ws + WS_LIST) + 10 * MT;
                    const unsigned p0 = __hip_atomic_fetch_add(cnt + e0 * 64, 1u, __ATOMIC_RELAXED, __HIP_MEMORY_SCOPE_AGENT);
                    const unsigned p1 = __hip_atomic_fetch_add(cnt + e1 * 64, 1u, __ATOMIC_RELAXED, __HIP_MEMORY_SCOPE_AGENT);
                    LIST[e0 * MT + p0] = m; LIST[e1 * MT + p1] = m;
                    EPw[2 * m] = e0 | (int)(p0 << 3); EPw[2 * m + 1] = e1 | (int)(p1 << 3);
                    GW[2 * m] = g0; GW[2 * m + 1] = g1;
                }
            }
        }
    }
    if (MODE == 1) __syncthreads();
}
__device__ __forceinline__ void moe_gather(const Frame& F, int jm) {
    const unsigned* cnt = (const unsigned*)F.ws + CW_CNT + jm * 8 * 64;
    MoeTp t; load_tp(t, cnt);
    int cn[8];
#pragma unroll
    for (int e = 0; e < 8; ++e) cn[e] = __builtin_amdgcn_readfirstlane((int)__hip_atomic_load(cnt + e * 64, __ATOMIC_RELAXED, __HIP_MEMORY_SCOPE_AGENT));
    const int rows = t.tp[8] * 256;
    const int* LIST = (const int*)(F.ws + WS_LIST); const v4u* XN = (const v4u*)(F.ws + WS_ACT); v4u* XB = (v4u*)(F.ws + WS_X2);
    for (int r = F.gw; r < rows; r += F.NGW) {
        const int tile = r >> 8; int e = 0, tpe = 0, ce = cn[0];
#pragma unroll
        for (int k = 1; k < 8; ++k) { const bool ge = tile >= t.tp[k]; e += ge ? 1 : 0; tpe = ge ? t.tp[k] : tpe; ce = ge ? cn[k] : ce; }
        const int pos = r - tpe * 256;
        v4u x0 = {0u, 0u, 0u, 0u}, x1 = {0u, 0u, 0u, 0u};
        if (pos < ce) { const int src = LIST[e * MT + pos]; x0 = XN[(size_t)src * 128 + F.lane]; x1 = XN[(size_t)src * 128 + 64 + F.lane]; }
        XB[(size_t)r * 128 + F.lane] = x0; XB[(size_t)r * 128 + 64 + F.lane] = x1;
    }
}
#define GLD(T, ubase, voff) (*(const T*)((const char*)(ubase) + (unsigned)(voff)))
#define GST(T, ubase, voff) (*(T*)((char*)(ubase) + (unsigned)(voff)))
__device__ __forceinline__ int fresh_lane() { int l; asm volatile("v_mbcnt_lo_u32_b32 %0, -1, 0\n\tv_mbcnt_hi_u32_b32 %0, -1, %0" : "=v"(l)); return l; }

struct MixP { const bf16* P; const float* lb; const float* rcos; const float* rsin; const float* ba; };
__device__ __forceinline__ int seg_row0(int b, int sg) { return sg < 4 ? NLAT + b * CTXL + sg * 64 : b * SEQ + (sg - 4) * 64; }
__device__ __forceinline__ int seg_tpos0(int sg) { return sg < 4 ? -1 : (sg - 4) * 64; }

struct S5P { const float *lam_re, *lam_im, *log_dt, *b_re, *b_im, *c_re, *c_im, *dd; };
__device__ __forceinline__ float gelu_tanh(float y) { const float t = 0.7978845608028654f * (y + 0.044715f * y * y * y); const float th = 1.0f - 2.0f / (1.0f + __expf(2.0f * t)); return 0.5f * y * (1.0f + th); }
template <int MODE>
__device__ __forceinline__ void s5_scan(const S5P& sp, const bf16* P, int b, int g, int dir, int sg, int lane, float& hre, float& him, LAS float* yf, LAS float* stg, bf16* Z) {
    const int row0 = seg_row0(b, sg); const int dg = dir * 16 + g;
    const float lre = sp.lam_re[dg * 64 + lane], lim = sp.lam_im[dg * 64 + lane], dt = expf(sp.log_dt[dg]);
    const float er = expf(lre * dt); const float sn = sinf(lim * dt), cs = cosf(lim * dt);
    const float ar = er * cs, ai = er * sn;
    const float nr = ar - 1.0f, ni = ai, den = lre * lre + lim * lim;
    const float cr = (nr * lre + ni * lim) / den, ci = (ni * lre - nr * lim) / den;
    float bbr[16], bbi[16], Cr[16], Ci[16];
#pragma unroll
    for (int c = 0; c < 16; ++c) { const float Br = sp.b_re[((size_t)dg * 64 + lane) * 16 + c], Bi = sp.b_im[((size_t)dg * 64 + lane) * 16 + c];
        bbr[c] = cr * Br - ci * Bi; bbi[c] = cr * Bi + ci * Br;
        Cr[c] = (MODE != 0) ? sp.c_re[((size_t)dg * 16 + c) * 64 + lane] : 0.f; Ci[c] = (MODE != 0) ? sp.c_im[((size_t)dg * 16 + c) * 64 + lane] : 0.f; }
    const int ch = ((lane >> 5) & 1) * 8 + ((lane >> 4) & 1) * 4 + ((lane >> 3) & 1) * 2 + ((lane >> 2) & 1);
    const float dv = (MODE == 2) ? sp.dd[g * 16 + ch] : 0.f;
    const bool b5 = lane & 32, b4 = lane & 16, b3 = lane & 8, b2 = lane & 4;
    const unsigned ucol = 2u * (unsigned)(C_S5 + g * 16 + (lane & 15));
    unsigned short rn0[4], rn1[4], rn2[4];
#pragma unroll
    for (int u = 0; u < 4; ++u) { rn0[u] = GLD(unsigned short, P + (size_t)(row0 + (dir ? 63 - u : u)) * DINP, ucol); rn1[u] = GLD(unsigned short, P + (size_t)(row0 + (dir ? 59 - u : 4 + u)) * DINP, ucol);
        rn2[u] = GLD(unsigned short, P + (size_t)(row0 + (dir ? 55 - u : 8 + u)) * DINP, ucol); }
#pragma unroll 1
    for (int i0 = 0; i0 < 64; i0 += 4) {
        unsigned short ru[4], rn3[4];
        const int ip = (i0 + 12 < 64) ? i0 + 12 : 60;
#pragma unroll
        for (int u = 0; u < 4; ++u) { ru[u] = rn0[u]; rn3[u] = GLD(unsigned short, P + (size_t)(row0 + (dir ? 63 - (ip + u) : (ip + u))) * DINP, ucol); }
#pragma unroll
        for (int u = 0; u < 4; ++u) stg[u * 64 + lane] = bf2f(ru[u]);
#pragma unroll
        for (int u = 0; u < 4; ++u) {
            const int ti = dir ? 63 - (i0 + u) : (i0 + u);
            const float uf = bf2f(ru[u]);
            float bur = 0.f, bui = 0.f;
#pragma unroll
            for (int c4 = 0; c4 < 4; ++c4) { const f32x4 ux = *(const LAS f32x4*)(stg + u * 64 + 4 * c4);
#pragma unroll
                for (int jj = 0; jj < 4; ++jj) { bur = fmaf(bbr[4 * c4 + jj], ux[jj], bur); bui = fmaf(bbi[4 * c4 + jj], ux[jj], bui); } }
            const float nre = ar * hre - ai * him + bur, nim = ar * him + ai * hre + bui;
            hre = nre; him = nim;
            if (MODE != 0) {
                float v[16];
#pragma unroll
                for (int c = 0; c < 16; ++c) v[c] = Cr[c] * hre - Ci[c] * him;
                float w8[8], w4[4], w2[2], w1;
#pragma unroll
                for (int i = 0; i < 8; ++i) { const float mine = b5 ? v[8 + i] : v[i], oth = b5 ? v[i] : v[8 + i]; w8[i] = mine + __shfl_xor(oth, 32); }
#pragma unroll
                for (int i = 0; i < 4; ++i) { const float mine = b4 ? w8[4 + i] : w8[i], oth = b4 ? w8[i] : w8[4 + i]; w4[i] = mine + __shfl_xor(oth, 16); }
#pragma unroll
                for (int i = 0; i < 2; ++i) { const float mine = b3 ? w4[2 + i] : w4[i], oth = b3 ? w4[i] : w4[2 + i]; w2[i] = mine + __shfl_xor(oth, 8); }
                { const float mine = b2 ? w2[1] : w2[0], oth = b2 ? w2[0] : w2[1]; w1 = mine + __shfl_xor(oth, 4); }
                w1 += __shfl_xor(w1, 2); w1 += __shfl_xor(w1, 1);
                if (MODE == 1) { if ((lane & 3) == 0) yf[ti * 16 + ch] = w1; }
                if (MODE == 2) {
                    const float uch = __shfl(uf, ch);
                    if ((lane & 3) == 0) { const float y = w1 + yf[ti * 16 + ch] + dv * uch; Z[(size_t)(row0 + ti) * 256 + g * 16 + ch] = (bf16)f2bf(gelu_tanh(y)); }
                }
            }
        }
#pragma unroll
        for (int u = 0; u < 4; ++u) { rn0[u] = rn1[u]; rn1[u] = rn2[u]; rn2[u] = rn3[u]; }
    }
}

__device__ __forceinline__ MixP make_mixp(const Frame& F, const Args& a, int l) {
    MixP mp; mp.P = (const bf16*)(F.ws + WS_PH); mp.lb = (const float*)(F.ws + WS_LB) + l * 256; mp.rcos = (const float*)(F.ws + WS_ROPE); mp.rsin = mp.rcos + 2048;
    mp.ba = a.in[F.zz + I_BA] + (size_t)l * 2 * 128; return mp;
}
__device__ __forceinline__ S5P make_s5p(const Frame& F, const Args& a, int l) {
    S5P sp; sp.lam_re = a.in[F.zz + I_LAMRE] + (size_t)l * 2048; sp.lam_im = a.in[F.zz + I_LAMIM] + (size_t)l * 2048; sp.log_dt = a.in[F.zz + I_LOGDT] + l * 32;
    sp.b_re = a.in[F.zz + I_BRE] + (size_t)l * 32768; sp.b_im = a.in[F.zz + I_BIM] + (size_t)l * 32768; sp.c_re = a.in[F.zz + I_CRE] + (size_t)l * 32768; sp.c_im = a.in[F.zz + I_CIM] + (size_t)l * 32768;
    sp.dd = a.in[F.zz + I_S5D] + l * 256; return sp;
}


typedef short bf16x8_t __attribute__((ext_vector_type(8)));
typedef float f32x16 __attribute__((ext_vector_type(16)));
typedef float f32x2_t __attribute__((ext_vector_type(2)));
typedef __bf16 bf16x2_n __attribute__((ext_vector_type(2)));
__device__ __forceinline__ unsigned pkbf(float lo, float hi) { const f32x2_t v = {lo, hi}; const bf16x2_n r = __builtin_convertvector(v, bf16x2_n); return __builtin_bit_cast(unsigned, r); }
constexpr int WL_QC = 0, WL_KC = 4608, WL_KT = 9216, WL_VT = 14336, WL_PL = 19456, WL_BYTES = 19712;

struct MxC { float gamma, lbv, oml, bav; unsigned cq, ck, cv, cz; };
template <int MIX>
__device__ __forceinline__ void mx_consts(MxC& c, const MixP& mp, int h, int dir, int lane) {
    c.gamma = 1.f; c.lbv = 0.f; c.oml = 1.f; c.bav = 0.f; c.cz = 0;
    if (MIX == 0) { c.cq = 2u * (unsigned)(C_RQ + h * 64 + lane); c.ck = 2u * (unsigned)(C_RK + h * 64 + lane); c.cv = 2u * (unsigned)(C_RV + h * 64 + lane); c.gamma = 1.0f - exp2f(-5.0f - (float)(dir ? 3 - h : h)); }
    else if (MIX == 1) { c.cq = 2u * (unsigned)(C_HQ + h * 64 + lane); c.ck = 2u * (unsigned)((dir ? C_HFB : C_HFF) + h * 64 + lane); c.cv = 2u * (unsigned)(C_HI + h * 64 + lane); c.lbv = mp.lb[h * 64 + lane]; c.oml = 1.0f - c.lbv; }
    else { c.cq = 2u * (unsigned)(C_GQ + h * 32 + (lane & 31)); c.ck = 2u * (unsigned)(C_GK + h * 32 + (lane & 31)); c.cv = 2u * (unsigned)(C_GV + h * 64 + lane); c.cz = 2u * (unsigned)((dir ? C_GZB : C_GZF) + h * 32 + (lane & 31));
        c.bav = mp.ba[dir * 128 + h * 32 + (lane & 31)]; }
}
struct MxRaw { unsigned short q[4], k[4], v[4], z[4]; };
template <int MIX, bool NEEDQ, int DIR>
__device__ __forceinline__ void mx_load(MxRaw& w, const MixP& mp, const MxC& c, int rows, int b) {
#pragma unroll
    for (int u = 0; u < 4; ++u) { const int cc = b * 4 + u; const bf16* pr = mp.P + (size_t)(rows + (DIR ? 63 - cc : cc)) * DINP;
        w.q[u] = NEEDQ ? GLD(unsigned short, pr, c.cq) : (unsigned short)0; w.k[u] = GLD(unsigned short, pr, c.ck); w.v[u] = GLD(unsigned short, pr, c.cv); w.z[u] = (MIX == 2) ? GLD(unsigned short, pr, c.cz) : (unsigned short)0; }
}
template <int MIX, bool NEEDQ, int DIR>
__device__ __forceinline__ void mx_batch(const MxRaw& cur, const MixP& mp, const MxC& c, int tposs  , int lane, LAS unsigned char* wl, int b, float& P) {
    constexpr int DK = (MIX == 2) ? 32 : 64;
    float kt[4], vv[4];
#pragma unroll
    for (int u = 0; u < 4; ++u) {
        const int cc = b * 4 + u, ts = DIR ? 63 - cc : cc, t = ts & 31;
        float q = bf2f(cur.q[u]), k, f; vv[DIR ? 3 - u : u] = bf2f(cur.v[u]);
        if (MIX == 0) {
            k = bf2f(cur.k[u]) * 0.125f; f = c.gamma;
            if (tposs >= 0) { const int tpos = tposs + ts; const int pos = (lane & 32) ? (tpos & 63) : (tpos >> 6);
                const unsigned ro = 4u * (unsigned)(pos * 16 + (lane & 15)); const float cs = GLD(float, mp.rcos, ro), sn = GLD(float, mp.rsin, ro);
                const float ss = (lane & 16) ? sn : -sn;
                const float kp = __shfl_xor(k, 16); k = fmaf(kp, ss, k * cs);
                if (NEEDQ) { const float qp = __shfl_xor(q, 16); q = fmaf(qp, ss, q * cs); } }
        } else if (MIX == 1) {
            const float z = bf2f(cur.k[u]); const float e = __expf(-z); const float sp = __builtin_amdgcn_rcpf(1.0f + e), sn = e * sp;
            f = fmaf(c.oml, sp, c.lbv); k = c.oml * sn;
        } else {
            k = bf2f(cur.k[u]) * 0.17677669529663687f; const float z = bf2f(cur.z[u]) + c.bav;
            const float ls = fminf(z, 0.f) - __logf(1.0f + __expf(-fabsf(z)));
            f = __expf(ls * 0.0625f);
        }
        P = fmaxf(P * f, 1e-30f);
        const float kk = k * __builtin_amdgcn_rcpf(P); kt[DIR ? 3 - u : u] = kk;
        if (lane < DK) {
            if (NEEDQ) *(LAS unsigned short*)(wl + WL_QC + t * 144 + lane * 2) = (unsigned short)f2bf(q * P);
            *(LAS unsigned short*)(wl + WL_KC + t * 144 + lane * 2) = (unsigned short)f2bf(kk);
        }
    }
    const int g4 = ((DIR ? 63 - b * 4 : b * 4) & 31) >> 2;
    v2u kp, vp; kp.x = pkbf(kt[0], kt[1]); kp.y = pkbf(kt[2], kt[3]); vp.x = pkbf(vv[0], vv[1]); vp.y = pkbf(vv[2], vv[3]);
    if (lane < DK) *(LAS v2u*)(wl + WL_KT + lane * 80 + g4 * 8) = kp;
    *(LAS v2u*)(wl + WL_VT + lane * 80 + g4 * 8) = vp;
}
typedef short bf16x4_t __attribute__((ext_vector_type(4)));
#define MFMA8(a, b, c) __builtin_amdgcn_mfma_f32_32x32x8bf16_1k((a), (b), (c), 0, 0, 0)
__device__ __forceinline__ bf16x4_t pack4(const f32x16& x, int s) {
    v2u p; p.x = pkbf(x[4 * s], x[4 * s + 1]); p.y = pkbf(x[4 * s + 2], x[4 * s + 3]);
    return __builtin_bit_cast(bf16x4_t, p);
}
__device__ __forceinline__ bf16x4_t ld4(const LAS unsigned char* p) { const v2u a = *(const LAS v2u*)p; return __builtin_bit_cast(bf16x4_t, a); }

template <int MODE, int DIR>
__device__ __forceinline__ void s5_mm_dir(const S5P& sp, const bf16* P, int b, int g, int sg, int lane, float& hre, float& him, LAS float* yf, LAS unsigned char* hs, bf16* Z) {
    const int m32 = lane & 31, hh = lane >> 5, dg = DIR * 16 + g, row0 = seg_row0(b, sg);
    float ar[2], ai[2], a2r[2], a2i[2], a3r[2], a3i[2], a4r[2], a4i[2];
    bf16x4_t bfr[4][2];
    const float dt = __expf(sp.log_dt[dg]);
#pragma unroll
    for (int sh = 0; sh < 2; ++sh) {
        const int p = 32 * sh + m32;
        const float lre = sp.lam_re[dg * 64 + p], lim = sp.lam_im[dg * 64 + p];
        const float er = __expf(lre * dt), sn = sinf(lim * dt), cs = cosf(lim * dt);
        ar[sh] = er * cs; ai[sh] = er * sn;
        a2r[sh] = ar[sh] * ar[sh] - ai[sh] * ai[sh]; a2i[sh] = ar[sh] * ai[sh] + ar[sh] * ai[sh];
        a3r[sh] = a2r[sh] * ar[sh] - a2i[sh] * ai[sh]; a3i[sh] = a2r[sh] * ai[sh] + a2i[sh] * ar[sh];
        a4r[sh] = a2r[sh] * a2r[sh] - a2i[sh] * a2i[sh]; a4i[sh] = a2r[sh] * a2i[sh] + a2r[sh] * a2i[sh];
        const float nr = ar[sh] - 1.0f, ni = ai[sh], den = 1.0f / (lre * lre + lim * lim);
        const float cr = (nr * lre + ni * lim) * den, ci = (ni * lre - nr * lim) * den;
#pragma unroll
        for (int s2 = 0; s2 < 2; ++s2) {
            const f32x4 Br = *(const f32x4*)(sp.b_re + ((size_t)dg * 64 + p) * 16 + 8 * s2 + 4 * hh), Bi = *(const f32x4*)(sp.b_im + ((size_t)dg * 64 + p) * 16 + 8 * s2 + 4 * hh);
            const f32x4 re = Br * cr - Bi * ci, im = Bi * cr + Br * ci;
            v2u pr, pi; pr.x = pkbf(re[0], re[1]); pr.y = pkbf(re[2], re[3]); pi.x = pkbf(im[0], im[1]); pi.y = pkbf(im[2], im[3]);
            bfr[sh][s2] = __builtin_bit_cast(bf16x4_t, pr); bfr[2 + sh][s2] = __builtin_bit_cast(bf16x4_t, pi);
        }
    }
    bf16x4_t cfr[16];
    if (MODE != 0) {
#pragma unroll
        for (int s = 0; s < 16; ++s) {
            const int p4 = (8 * s + 4 * hh) & 63; f32x4 cv = {0.f, 0.f, 0.f, 0.f};
            if (m32 < 16) cv = (s < 8) ? *(const f32x4*)(sp.c_re + ((size_t)dg * 16 + m32) * 64 + p4) : -*(const f32x4*)(sp.c_im + ((size_t)dg * 16 + m32) * 64 + p4);
            v2u pc; pc.x = pkbf(cv[0], cv[1]); pc.y = pkbf(cv[2], cv[3]); cfr[s] = __builtin_bit_cast(bf16x4_t, pc);
        }
    }
    const float ddv = (MODE == 2 && m32 < 16) ? sp.dd[g * 16 + m32] : 0.f;
    float hr[2], hi[2];
    hr[0] = __shfl(hre, m32); hi[0] = __shfl(him, m32); hr[1] = __shfl(hre, m32 + 32); hi[1] = __shfl(him, m32 + 32);
#pragma unroll 1
    for (int ci2 = 0; ci2 < 2; ++ci2) {
        const int ch = DIR ? 1 - ci2 : ci2, rowc = row0 + 32 * ch;
        const bf16* urow = P + (size_t)(rowc + m32) * DINP + C_S5 + g * 16 + 4 * hh;
        const bf16x4_t ua0 = __builtin_bit_cast(bf16x4_t, *(const v2u*)urow), ua1 = __builtin_bit_cast(bf16x4_t, *(const v2u*)(urow + 8));
        f32x16 BU[4];
#pragma unroll
        for (int nt = 0; nt < 4; ++nt) {
#pragma unroll
            for (int r = 0; r < 16; ++r) BU[nt][r] = 0.f;
            BU[nt] = MFMA8(ua0, bfr[nt][0], BU[nt]); BU[nt] = MFMA8(ua1, bfr[nt][1], BU[nt]);
        }
#pragma unroll
        for (int sh = 0; sh < 2; ++sh)
#pragma unroll
            for (int gg = 0; gg < 4; ++gg)
#pragma unroll
                for (int jj = 1; jj < 4; ++jj) {
                    const int r = DIR ? 4 * gg + 3 - jj : 4 * gg + jj, rp = DIR ? r + 1 : r - 1;
                    const float pr = BU[sh][rp], pi = BU[2 + sh][rp];
                    BU[sh][r] += ar[sh] * pr - ai[sh] * pi; BU[2 + sh][r] += ar[sh] * pi + ai[sh] * pr;
                }
        float hnr[2][4], hni[2][4];
#pragma unroll
        for (int st = 0; st < 8; ++st) {
            const int gg = DIR ? 3 - (st >> 1) : (st >> 1), turn = DIR ? 1 - (st & 1) : (st & 1), rl = DIR ? 4 * gg : 4 * gg + 3;
            const bool act = (hh == turn);
#pragma unroll
            for (int sh = 0; sh < 2; ++sh) {
                if (turn == (DIR ? 1 : 0)) { hnr[sh][gg] = hr[sh]; hni[sh][gg] = hi[sh]; }
                else { hnr[sh][gg] = act ? hr[sh] : hnr[sh][gg]; hni[sh][gg] = act ? hi[sh] : hni[sh][gg]; }
                const float outr = BU[sh][rl] + a4r[sh] * hr[sh] - a4i[sh] * hi[sh], outi = BU[2 + sh][rl] + a4r[sh] * hi[sh] + a4i[sh] * hr[sh];
                const float sr = __shfl_xor(outr, 32), si = __shfl_xor(outi, 32);
                hr[sh] = act ? outr : sr; hi[sh] = act ? outi : si;
            }
        }
        if (MODE != 0) {
#pragma unroll
            for (int sh = 0; sh < 2; ++sh)
#pragma unroll
                for (int gg = 0; gg < 4; ++gg)
#pragma unroll
                    for (int jj = 0; jj < 4; ++jj) {
                        const int pw = DIR ? 4 - jj : jj + 1;
                        const float pr = (pw == 1) ? ar[sh] : (pw == 2) ? a2r[sh] : (pw == 3) ? a3r[sh] : a4r[sh], pi = (pw == 1) ? ai[sh] : (pw == 2) ? a2i[sh] : (pw == 3) ? a3i[sh] : a4i[sh];
                        BU[sh][4 * gg + jj] += pr * hnr[sh][gg] - pi * hni[sh][gg]; BU[2 + sh][4 * gg + jj] += pr * hni[sh][gg] + pi * hnr[sh][gg];
                    }
#pragma unroll
            for (int nt = 0; nt < 4; ++nt)
#pragma unroll
                for (int r = 0; r < 16; ++r) *(LAS unsigned short*)(hs + ((r & 3) + 8 * (r >> 2) + 4 * hh) * 272 + (32 * nt + m32) * 2) = (unsigned short)f2bf(BU[nt][r]);
            f32x16 Yv;
#pragma unroll
            for (int r = 0; r < 16; ++r) Yv[r] = 0.f;
#pragma unroll
            for (int s = 0; s < 16; ++s) Yv = MFMA8(ld4(hs + m32 * 272 + (8 * s + 4 * hh) * 2), cfr[s], Yv);
            if (m32 < 16) {
#pragma unroll
                for (int r = 0; r < 16; ++r) {
                    const int tl = (r & 3) + 8 * (r >> 2) + 4 * hh;
                    if (MODE == 1) yf[(32 * ch + tl) * 16 + m32] = Yv[r];
                    else { const float u = bf2f(P[(size_t)(rowc + tl) * DINP + C_S5 + g * 16 + m32]);
                        const float y = Yv[r] + yf[(32 * ch + tl) * 16 + m32] + ddv * u;
                        Z[(size_t)(rowc + tl) * 256 + g * 16 + m32] = (bf16)f2bf(gelu_tanh(y)); }
                }
            }
        }
    }
    hre = hh ? hr[1] : hr[0]; him = hh ? hi[1] : hi[0];
}
template <int MODE>
__device__ __forceinline__ void s5_mm(const S5P& sp, const bf16* P, int b, int g, int dir, int sg, int lane, float& hre, float& him, LAS float* yf, LAS unsigned char* hs, bf16* Z) {
    if (dir) s5_mm_dir<MODE, 1>(sp, P, b, g, sg, lane, hre, him, yf, hs, Z); else s5_mm_dir<MODE, 0>(sp, P, b, g, sg, lane, hre, him, yf, hs, Z);
}
template <int MIX, int DIR, bool WITH_O>
__device__ __forceinline__ void mx_chunk(LAS unsigned char* wl, int lane, float Pl, f32x16 (&ST)[(MIX == 2) ? 1 : 2][2], f32x16 (&O)[2]) {
    constexpr int DK = (MIX == 2) ? 32 : 64, NRT = DK / 32;
    const int m32 = lane & 31, hh = lane >> 5;
    asm volatile("" ::: "memory");
    if (lane < DK) *(LAS float*)(wl + WL_PL + lane * 4) = Pl;
    asm volatile("" ::: "memory");
    if (WITH_O) {
        f32x16 x;
#pragma unroll
        for (int r = 0; r < 16; ++r) x[r] = 0.f;
#pragma unroll
        for (int s = 0; s < DK / 8; ++s) {
            const bf16x4_t ka = ld4(wl + WL_KC + m32 * 144 + (8 * s + 4 * hh) * 2);
            const bf16x4_t qb = ld4(wl + WL_QC + m32 * 144 + (8 * s + 4 * hh) * 2);
            x = MFMA8(ka, qb, x);
        }
#pragma unroll
        for (int r = 0; r < 16; ++r) { const int j = (r & 3) + 8 * (r >> 2) + 4 * hh; const bool keep = DIR ? (j >= m32) : (j <= m32); x[r] = keep ? x[r] : 0.f; }
#pragma unroll
        for (int t = 0; t < 2; ++t)
#pragma unroll
            for (int r = 0; r < 16; ++r) O[t][r] = 0.f;
#pragma unroll
        for (int s = 0; s < 4; ++s) {
            const bf16x4_t xa = pack4(x, s);
#pragma unroll
            for (int t = 0; t < 2; ++t) O[t] = MFMA8(xa, ld4(wl + WL_VT + (32 * t + m32) * 80 + (8 * s + 4 * hh) * 2), O[t]);
        }
#pragma unroll
        for (int rt = 0; rt < NRT; ++rt)
#pragma unroll
            for (int s = 0; s < 4; ++s) {
                const bf16x4_t qa = ld4(wl + WL_QC + m32 * 144 + (32 * rt + 8 * s + 4 * hh) * 2);
#pragma unroll
                for (int t = 0; t < 2; ++t) O[t] = MFMA8(qa, pack4(ST[rt][t], s), O[t]);
            }
    }
#pragma unroll
    for (int rt = 0; rt < NRT; ++rt)
#pragma unroll
        for (int s = 0; s < 4; ++s) {
            const bf16x4_t ka = ld4(wl + WL_KT + (32 * rt + m32) * 80 + (8 * s + 4 * hh) * 2);
#pragma unroll
            for (int t = 0; t < 2; ++t) ST[rt][t] = MFMA8(ka, ld4(wl + WL_VT + (32 * t + m32) * 80 + (8 * s + 4 * hh) * 2), ST[rt][t]);
        }
#pragma unroll
    for (int rt = 0; rt < NRT; ++rt)
#pragma unroll
        for (int g = 0; g < 4; ++g) {
            const f32x4 pl4 = *(const LAS f32x4*)(wl + WL_PL + (32 * rt + 8 * g + 4 * hh) * 4);
#pragma unroll
            for (int e = 0; e < 4; ++e) { ST[rt][0][4 * g + e] *= pl4[e]; ST[rt][1][4 * g + e] *= pl4[e]; }
        }
}
__device__ __forceinline__ float half_sum(float v) {
#pragma unroll
    for (int o = 1; o < 32; o <<= 1) v += __shfl_xor(v, o);
    return v;
}
template <int MIX, int DIR>
__device__ __forceinline__ void mixA_stream(const MixP& mp, const MxC& c, int row0, int tpos0, int lane, LAS unsigned char* wl, f32x16 (&ST)[(MIX == 2) ? 1 : 2][2], float& Gam) {
    f32x16 O[2];
    MxRaw r0, r1, r2;
    mx_load<MIX, false, DIR>(r0, mp, c, row0, 0); mx_load<MIX, false, DIR>(r1, mp, c, row0, 1); mx_load<MIX, false, DIR>(r2, mp, c, row0, 2);
    float P = 1.0f;
#pragma unroll 1
    for (int b = 0; b < 16; ++b) {
        MxRaw r3; mx_load<MIX, false, DIR>(r3, mp, c, row0, b < 13 ? b + 3 : 15);
        int ln = lane; asm volatile("" : "+v"(ln));
        mx_batch<MIX, false, DIR>(r0, mp, c, tpos0, ln, wl, b, P);
        if ((b & 7) == 7) { Gam *= P; mx_chunk<MIX, 0, false>(wl, ln, P, ST, O); P = 1.0f; }
        r0 = r1; r1 = r2; r2 = r3;
    }
}
template <int MIX>
__device__ __forceinline__ void mixA_unit(const MixP& mp, float* STG, int idx, int lane_in, LAS unsigned char* wl) {
    int lane = lane_in;
    constexpr int DK = (MIX == 2) ? 32 : 64, NRT = DK / 32;
    const int dir = idx / 2112, rem = idx - dir * 2112, bh = rem / NSEG, sg = rem - bh * NSEG, b = bh >> 2, h = bh & 3;
    asm volatile("" : "+v"(lane));
    MxC c; mx_consts<MIX>(c, mp, h, dir, lane);
    f32x16 ST[NRT][2];
#pragma unroll
    for (int rt = 0; rt < NRT; ++rt)
#pragma unroll
        for (int t = 0; t < 2; ++t)
#pragma unroll
            for (int r = 0; r < 16; ++r) ST[rt][t][r] = 0.f;
    const int row0 = seg_row0(b, sg), tpos0 = seg_tpos0(sg);
    float Gam = 1.0f;
    if (dir) mixA_stream<MIX, 1>(mp, c, row0, tpos0, lane, wl, ST, Gam); else mixA_stream<MIX, 0>(mp, c, row0, tpos0, lane, wl, ST, Gam);
    const size_t slot = (size_t)((dir * 16 + bh) * NSEG + sg);
    float* ds = STG + (MIX == 0 ? ST_DS0 : (MIX == 1 ? ST_DS1 : ST_DS2)) + slot * (DK * 64);
    const int m32 = lane & 31, hh = lane >> 5;
#pragma unroll
    for (int rt = 0; rt < NRT; ++rt)
#pragma unroll
        for (int t = 0; t < 2; ++t)
#pragma unroll
            for (int r = 0; r < 16; ++r) GST(float, ds + (32 * rt + (r & 3) + 8 * (r >> 2)) * 64 + 32 * t, 4u * (unsigned)(4 * hh * 64 + m32)) = ST[rt][t][r];
    float* gs = STG + (MIX == 0 ? ST_G0 : (MIX == 1 ? ST_G1 : ST_G2)) + slot * 64;
    GST(float, gs, 4u * (unsigned)lane) = Gam;
}
template <int MIX, int MODE>
__device__ __forceinline__ void mx_epilogue(const MixP& mp, LAS unsigned char* wl, int lane, const f32x16 (&O)[2], int rowc, float* OF, bf16* Y, int ocol, int ycol, int cgate, float nwv) {
    LAS float* ost = (LAS float*)(wl + WL_QC);
    const int m32 = lane & 31, hh = lane >> 5;
    asm volatile("" ::: "memory");
#pragma unroll
    for (int t = 0; t < 2; ++t)
#pragma unroll
        for (int r = 0; r < 16; ++r) ost[((r & 3) + 8 * (r >> 2) + 4 * hh) * 68 + 32 * t + m32] = O[t][r];
    asm volatile("" ::: "memory");
    if (MODE == 1) {
#pragma unroll 8
        for (int tk = 0; tk < 32; ++tk) GST(float, OF + (size_t)(rowc + tk) * 768 + ocol, 4u * (unsigned)lane) = ost[tk * 68 + lane];
    } else {
        float ofc[8]; unsigned short gc[8];
#pragma unroll
        for (int u = 0; u < 8; ++u) { ofc[u] = GLD(float, OF + (size_t)(rowc + u) * 768 + ocol, 4u * (unsigned)lane); gc[u] = GLD(unsigned short, mp.P + (size_t)(rowc + u) * DINP + cgate, 2u * (unsigned)lane); }
#pragma unroll 1
        for (int b8 = 0; b8 < 4; ++b8) {
            float ofn[8]; unsigned short gn[8]; const int nb = b8 < 3 ? b8 + 1 : 3;
#pragma unroll
            for (int u = 0; u < 8; ++u) { ofn[u] = GLD(float, OF + (size_t)(rowc + nb * 8 + u) * 768 + ocol, 4u * (unsigned)lane); gn[u] = GLD(unsigned short, mp.P + (size_t)(rowc + nb * 8 + u) * DINP + cgate, 2u * (unsigned)lane); }
#pragma unroll
            for (int u = 0; u < 8; ++u) {
                const int tk = b8 * 8 + u;
                const float o = ost[tk * 68 + lane] + ofc[u];
                float y;
                if (MIX == 0) { const float mean = wave_sum(o) * (1.0f / 64.0f); const float d = o - mean; y = d * (1.0f / sqrtf(wave_sum(d * d) * (1.0f / 64.0f) + NEPS)) * nwv; }
                else y = o * (1.0f / sqrtf(wave_sum(o * o) * (1.0f / 64.0f) + NEPS)) * nwv;
                y *= silu_f(bf2f(gc[u]));
                GST(unsigned short, Y + (size_t)(rowc + tk) * 1024 + ycol, 2u * (unsigned)lane) = (unsigned short)f2bf(y);
            }
#pragma unroll
            for (int u = 0; u < 8; ++u) { ofc[u] = ofn[u]; gc[u] = gn[u]; }
        }
    }
}
template <int MIX, int DIR>
__device__ __forceinline__ void mixC_stream(const MixP& mp, const MxC& c, int row0, int tpos0, int lane, LAS unsigned char* wl, f32x16 (&ST)[(MIX == 2) ? 1 : 2][2],
                                            float* OF, bf16* Y, int ocol, int ycol, int cgate, float nwv) {
    f32x16 O[2];
    MxRaw r0, r1;
    mx_load<MIX, true, DIR>(r0, mp, c, row0, 0); mx_load<MIX, true, DIR>(r1, mp, c, row0, 1);
    float P = 1.0f;
#pragma unroll 1
    for (int b = 0; b < 16; ++b) {
        MxRaw r2; mx_load<MIX, true, DIR>(r2, mp, c, row0, b < 14 ? b + 2 : 15);
        int ln = lane; asm volatile("" : "+v"(ln));
        mx_batch<MIX, true, DIR>(r0, mp, c, tpos0, ln, wl, b, P);
        if ((b & 7) == 7) {
            const int ch = DIR ? 1 - (b >> 3) : (b >> 3);
            mx_chunk<MIX, DIR, true>(wl, ln, P, ST, O); P = 1.0f;
            mx_epilogue<MIX, DIR ? 2 : 1>(mp, wl, ln, O, row0 + 32 * ch, OF, Y, ocol, ycol, cgate, nwv);
        }
        r0 = r1; r1 = r2;
    }
}
template <int MIX>
__device__ __forceinline__ void mixC_unit(const MixP& mp, const float* STG, int idx, int lane_in, float* OF, LAS unsigned char* wl, bf16* Y, const float* nw) {
    int lane = lane_in; asm volatile("" : "+v"(lane));
    constexpr int DK = (MIX == 2) ? 32 : 64, NRT = DK / 32;
    const int bh = idx / NSEG, sg = idx - bh * NSEG, b = bh >> 2, h = bh & 3;
    const int row0 = seg_row0(b, sg), tpos0 = seg_tpos0(sg);
    const int ocol = ((MIX == 0) ? 0 : (MIX == 1 ? 256 : 512)) + h * 64, ycol = ((MIX == 0) ? 0 : (MIX == 1 ? 512 : 768)) + h * 64;
    const int cgate = ((MIX == 0) ? C_RG : (MIX == 1 ? C_HG : C_GG)) + h * 64;
    const float* dsb = STG + (MIX == 0 ? ST_DS0 : (MIX == 1 ? ST_DS1 : ST_DS2));
    const float nwv = nw[h * 64 + lane];
    f32x16 ST[NRT][2];
#pragma unroll 1
    for (int dir = 0; dir < 2; ++dir) {
        asm volatile("" : "+v"(lane));
        const int m32 = lane & 31, hh = lane >> 5;
        MxC c; mx_consts<MIX>(c, mp, h, dir, lane);
        { const float* ds = dsb + (size_t)((dir * 16 + bh) * NSEG + sg) * (DK * 64);
#pragma unroll
          for (int rt = 0; rt < NRT; ++rt)
#pragma unroll
              for (int t = 0; t < 2; ++t)
#pragma unroll
                  for (int r = 0; r < 16; ++r) ST[rt][t][r] = GLD(float, ds + (32 * rt + (r & 3) + 8 * (r >> 2)) * 64 + 32 * t, 4u * (unsigned)(4 * hh * 64 + m32)); }
        if (dir == 0) mixC_stream<MIX, 0>(mp, c, row0, tpos0, lane, wl, ST, OF, Y, ocol, ycol, cgate, nwv);
        else mixC_stream<MIX, 1>(mp, c, row0, tpos0, lane, wl, ST, OF, Y, ocol, ycol, cgate, nwv);
        asm volatile("s_waitcnt vmcnt(0)" ::: "memory");
    }
}
template <int MSEL>
__device__ __forceinline__ void mix_passA(const Frame& F, const Args& a, int l) {
    const MixP mp = make_mixp(F, a, l); const S5P sp = make_s5p(F, a, l);
    float* ST = (float*)(F.ws + WS_X2);
    LAS unsigned char* wl = F.lds + F.wave * WL_BYTES; LAS float* stg = (LAS float*)wl;
    if (MSEL == 15) {
        for (int u = F.gw; u < 3 * 4224 + 2 * 64 * NSEG; u += F.NGW) {
            if (u < 4224) mixA_unit<0>(mp, ST, u, fresh_lane(), wl);
            else if (u < 2 * 4224) mixA_unit<1>(mp, ST, u - 4224, fresh_lane(), wl);
            else if (u < 3 * 4224) mixA_unit<2>(mp, ST, u - 2 * 4224, fresh_lane(), wl);
            else { const int idx = u - 3 * 4224; const int dir = idx / (64 * NSEG), rem = idx - dir * 64 * NSEG, bg = rem / NSEG, sg = rem - bg * NSEG;
                float hre = 0.f, him = 0.f;
                s5_mm<0>(sp, mp.P, bg >> 4, bg & 15, dir, sg, fresh_lane(), hre, him, nullptr, wl, nullptr);
                float* hs = ST + ST_HS + ((size_t)((dir * 64 + bg) * NSEG + sg) * 64 + fresh_lane()) * 2;
                hs[0] = hre; hs[1] = him; }
        }
        return;
    }
    if (MSEL & 1) for (int u = F.gw; u < 4224; u += F.NGW) mixA_unit<0>(mp, ST, u, fresh_lane(), wl);
    if (MSEL & 2) for (int u = F.gw; u < 4224; u += F.NGW) mixA_unit<1>(mp, ST, u, fresh_lane(), wl);
    if (MSEL & 4) for (int u = F.gw; u < 4224; u += F.NGW) mixA_unit<2>(mp, ST, u, fresh_lane(), wl);
    if (MSEL & 8) for (int idx = F.gw; idx < 2 * 64 * NSEG; idx += F.NGW) {
        const int dir = idx / (64 * NSEG), rem = idx - dir * 64 * NSEG, bg = rem / NSEG, sg = rem - bg * NSEG;
        float hre = 0.f, him = 0.f;
        s5_mm<0>(sp, mp.P, bg >> 4, bg & 15, dir, sg, fresh_lane(), hre, him, nullptr, wl, nullptr);
        float* hs = ST + ST_HS + ((size_t)((dir * 64 + bg) * NSEG + sg) * 64 + fresh_lane()) * 2;
        hs[0] = hre; hs[1] = him;
    }
}
__device__ __forceinline__ int chain_seg(int dir, int p) { return dir ? (p < 4 ? 3 - p : 135 - p) : p; }
__device__ __forceinline__ void mix_passB(const Frame& F, const Args& a, int l) {
    float* ST = (float*)(F.ws + WS_X2);
    constexpr int N0 = 131072, N1 = 131072, N2 = 65536, N3 = 8192;
    for (int e = blockIdx.x * 512 + F.tid; e < N0 + N1 + N2 + N3; e += F.G * 512) {
        if (e < N0 + N1 + N2) {
            float* base; const float* gb; int dir, esz;
            if (e < N0 + N1) { const int mix = e >= N0, e2 = e - mix * N0, c = e2 >> 12, el = e2 & 4095; dir = c >> 4; esz = 4096;
                base = ST + (mix ? ST_DS1 : ST_DS0) + (size_t)c * NSEG * 4096 + el; gb = ST + (mix ? ST_G1 : ST_G0) + (size_t)c * NSEG * 64 + (el >> 6); }
            else { const int e2 = e - N0 - N1, c = e2 >> 11, el = e2 & 2047; dir = c >> 4; esz = 2048;
                base = ST + ST_DS2 + (size_t)c * NSEG * 2048 + el; gb = ST + ST_G2 + (size_t)c * NSEG * 64 + (el >> 6); }
            float run = 0.f;
#pragma unroll 1
            for (int p0 = 0; p0 < NSEG; p0 += 12) {
                float d[12], gm[12];
#pragma unroll
                for (int q = 0; q < 12; ++q) { const int sg = chain_seg(dir, p0 + q); d[q] = base[(size_t)sg * esz]; gm[q] = gb[sg * 64]; }
#pragma unroll
                for (int q = 0; q < 12; ++q) { const int sg = chain_seg(dir, p0 + q); base[(size_t)sg * esz] = run; run = fmaf(gm[q], run, d[q]); }
            }
        } else {
            const int e2 = e - N0 - N1 - N2, c = e2 >> 6, p = e2 & 63, dir = c >> 6, g = c & 15;
            const int dg = dir * 16 + g;
            const float lre = a.in[F.zz + I_LAMRE][(size_t)l * 2048 + dg * 64 + p], lim = a.in[F.zz + I_LAMIM][(size_t)l * 2048 + dg * 64 + p], dt = expf(a.in[F.zz + I_LOGDT][l * 32 + dg]);
            const float er = expf(lre * dt * 64.0f); const float sn = sinf(lim * dt * 64.0f), cs = cosf(lim * dt * 64.0f);
            const float ar = er * cs, ai = er * sn;
            float* base = ST + ST_HS + ((size_t)c * NSEG * 64 + p) * 2;
            float rr = 0.f, ri = 0.f;
#pragma unroll 1
            for (int q0 = 0; q0 < NSEG; q0 += 12) {
                float dr[12], di[12];
#pragma unroll
                for (int q = 0; q < 12; ++q) { const int sg = chain_seg(dir, q0 + q); dr[q] = base[(size_t)sg * 128]; di[q] = base[(size_t)sg * 128 + 1]; }
#pragma unroll
                for (int q = 0; q < 12; ++q) { const int sg = chain_seg(dir, q0 + q); base[(size_t)sg * 128] = rr; base[(size_t)sg * 128 + 1] = ri;
                    const float nr = ar * rr - ai * ri + dr[q], ni = ar * ri + ai * rr + di[q]; rr = nr; ri = ni; }
            }
        }
    }
}
template <int MSEL>
__device__ __forceinline__ void mix_passC(const Frame& F, const Args& a, int l) {
    const MixP mp = make_mixp(F, a, l); const S5P sp = make_s5p(F, a, l);
    const float* ST = (const float*)(F.ws + WS_X2);
    LAS unsigned char* wl = F.lds + F.wave * WL_BYTES;
    LAS float* stg = (LAS float*)wl; LAS float* of = (LAS float*)(wl + 9216);
    float* OF = (float*)(F.ws + WS_OF);
    bf16* Y = (bf16*)(F.ws + WS_ACT); bf16* Z = (bf16*)(F.ws + WS_Z);
    const bool keep = l < DEPTH - 1;
    constexpr int NM = 16 * NSEG;
    if (MSEL == 15) {
        for (int u = F.gw; u < 3 * NM + 64 * NSEG; u += F.NGW) {
            const int sgu = (u < 3 * NM) ? (u % NSEG) : ((u - 3 * NM) % NSEG);
            if (!keep && sgu < 4) continue;
            if (u < NM) mixC_unit<0>(mp, ST, u, fresh_lane(), OF, wl, Y, a.in[F.zz + I_RETGN] + l * 256);
            else if (u < 2 * NM) mixC_unit<1>(mp, ST, u - NM, fresh_lane(), OF, wl, Y, a.in[F.zz + I_HGNW] + l * 256);
            else if (u < 3 * NM) mixC_unit<2>(mp, ST, u - 2 * NM, fresh_lane(), OF, wl, Y, a.in[F.zz + I_GLANW] + l * 256);
            else { const int idx = u - 3 * NM, bg = idx / NSEG, sg = idx - bg * NSEG;
                const float* h0 = ST + ST_HS + ((size_t)((0 * 64 + bg) * NSEG + sg) * 64 + fresh_lane()) * 2;
                float hre = h0[0], him = h0[1];
                s5_mm<1>(sp, mp.P, bg >> 4, bg & 15, 0, sg, fresh_lane(), hre, him, of, wl, Z);
                const float* h1 = ST + ST_HS + ((size_t)((1 * 64 + bg) * NSEG + sg) * 64 + fresh_lane()) * 2;
                hre = h1[0]; him = h1[1];
                s5_mm<2>(sp, mp.P, bg >> 4, bg & 15, 1, sg, fresh_lane(), hre, him, of, wl, Z); }
        }
        return;
    }
    if (MSEL & 1) for (int u = F.gw; u < NM; u += F.NGW) { if (!keep && (u % NSEG) < 4) continue; mixC_unit<0>(mp, ST, u, fresh_lane(), OF, wl, Y, a.in[F.zz + I_RETGN] + l * 256); }
    if (MSEL & 2) for (int u = F.gw; u < NM; u += F.NGW) { if (!keep && (u % NSEG) < 4) continue; mixC_unit<1>(mp, ST, u, fresh_lane(), OF, wl, Y, a.in[F.zz + I_HGNW] + l * 256); }
    if (MSEL & 4) for (int u = F.gw; u < NM; u += F.NGW) { if (!keep && (u % NSEG) < 4) continue; mixC_unit<2>(mp, ST, u, fresh_lane(), OF, wl, Y, a.in[F.zz + I_GLANW] + l * 256); }
    if (MSEL & 8) for (int idx = F.gw; idx < 64 * NSEG; idx += F.NGW) {
        const int bg = idx / NSEG, sg = idx - bg * NSEG;
        if (!keep && sg < 4) continue;
        const float* h0 = ST + ST_HS + ((size_t)((0 * 64 + bg) * NSEG + sg) * 64 + fresh_lane()) * 2;
        float hre = h0[0], him = h0[1];
        s5_mm<1>(sp, mp.P, bg >> 4, bg & 15, 0, sg, fresh_lane(), hre, him, of, wl, Z);
        const float* h1 = ST + ST_HS + ((size_t)((1 * 64 + bg) * NSEG + sg) * 64 + fresh_lane()) * 2;
        hre = h1[0]; him = h1[1];
        s5_mm<2>(sp, mp.P, bg >> 4, bg & 15, 1, sg, fresh_lane(), hre, him, of, wl, Z);
    }
}

constexpr int NPH = 11;
template <int PH_MASK, int MSEL>
__global__ void __launch_bounds__(512, 2) mk_fwd(Args a) {
    extern __shared__ __attribute__((aligned(16))) unsigned char lds_raw[];
    Frame F;
    F.lds = (LAS unsigned char*)lds_raw;
    const int wave0 = __builtin_amdgcn_readfirstlane((int)threadIdx.x >> 6);
    F.lane = fresh_lane(); F.tid = wave0 * 64 + F.lane; F.wave = wave0;
    F.G = gridDim.x; F.gw = blockIdx.x * 8 + F.wave; F.NGW = F.G * 8; F.zz = 0; F.ws = (unsigned char*)a.in[I_WS]; F.out = (float*)a.in[I_OUT];
    volatile LAS unsigned* MISC = (volatile LAS unsigned*)(F.lds + MISC_OFF);
    for (int u = F.tid; u < 64; u += 512) ((LAS unsigned*)(F.lds + MISC_OFF))[u] = 0u;
    __syncthreads();
    XcdBarrier bar; bar.bar = (unsigned*)F.ws + CW_BAR; bar.x = 0; bar.st = nullptr;
    if (a.fused) bar = xcd_barrier_post((unsigned*)F.ws + CW_BAR, MISC + 8, F.tid);
#define SEAM() do { if (a.fused) { XcdBarrier bb = bar; asm volatile("" : "+s"(bb.bar), "+s"(bb.x)); xcd_barrier(bb, wave0 * 64 + fresh_lane()); } } while (0)
#define PHASE_BEGIN() do { int zz_ = 0; asm volatile("" : "+s"(zz_)); F.zz = zz_; F.ws = (unsigned char*)a.in[I_WS + zz_]; F.out = (float*)a.in[I_OUT + zz_]; \
        const int ln_ = fresh_lane(); const int t_ = wave0 * 64 + ln_ + zz_; F.tid = t_; F.lane = t_ & 63; F.wave = wave0 + zz_; F.G = (int)gridDim.x + zz_; F.gw = ((int)blockIdx.x + zz_) * 8 + F.wave; F.NGW = F.G * 8; \
        F.lds = (LAS unsigned char*)lds_raw + zz_; } while (0)
#define IN(k) (((PH_MASK >> (k)) & 1) && a.ph_lo <= (k) && (k) < a.ph_hi)
#ifndef DUP_PH
#define DUP_PH 0
#endif
#define REP(k) for (int rep_ = 0; rep_ < (((DUP_PH >> (k)) & 1) ? 2 : 1); ++rep_)
#define hb ((float*)(F.ws + WS_HB))
#define MOD ((const float*)(F.ws + WS_MOD))
#define ACT ((bf16*)(F.ws + WS_ACT))
#define PH ((bf16*)(F.ws + WS_PH))

    if (((PH_MASK >> 12) & 1) && a.do_pro) REP(12) { PHASE_BEGIN(); prologue(F, a); SEAM(); }

#pragma unroll
    for (int l = 0; l < DEPTH; ++l) {
        if (l < a.l_lo || l >= a.l_hi) continue;
        const bool keep = l < DEPTH - 1, moe = l & 1; const int j = l >> 1;
        const int Mrows = keep ? MT : NLAT;
        if (IN(0)) for (int rep_ = 0; rep_ < ((((DUP_PH >> 0) & 1) && l != 2) ? 2 : 1); ++rep_) { PHASE_BEGIN();
            norm_phase<0>(F, a, l, 0, MT, (l == 2) ? 1 : -1);
            if (l == 2) { __syncthreads(); moe_cvt(F, a, 1); }
            SEAM();
        }
        if (IN(1)) REP(1) { PHASE_BEGIN();
            pg8::Gemm g{ACT, (const bf16*)(F.ws + WS_WIN) + (size_t)l * DINP * 1024, MT, DINP, 1024}; pg8::StaticOrder S; S.init(MT, DINP, F.G, (int)blockIdx.x);
            EpiStoreBf16 E{PH, DINP};
            pg8::gemm_phase<EpiStoreBf16, pg8::StaticOrder, true, true>(F.lds, g, S, E, F.tid);
            SEAM();
        }
        if (IN(2)) { PHASE_BEGIN(); mix_passA<MSEL>(F, a, l); SEAM(); }
#ifdef DUP_MIX
        if (IN(2)) { PHASE_BEGIN(); mix_passA<DUP_MIX>(F, a, l); SEAM(); }
#endif
        if (IN(3)) { PHASE_BEGIN(); mix_passB(F, a, l); SEAM(); }
        if (IN(4)) { PHASE_BEGIN(); mix_passC<MSEL>(F, a, l); SEAM(); }
#ifdef DUP_MIX
        if (IN(4)) { PHASE_BEGIN(); mix_passC<DUP_MIX>(F, a, l); SEAM(); }
#endif
        if (IN(5)) REP(5) { PHASE_BEGIN();
            int k256 = 256; asm volatile("" : "+s"(k256)); pg8::Gemm g{(const bf16*)(F.ws + WS_Z), (const bf16*)(F.ws + WS_GLUW) + (size_t)l * 65536, Mrows, 256, k256}; pg8::StaticOrder S; S.init(Mrows, 256, F.G, (int)blockIdx.x);
            EpiGlu E{(const bf16*)(F.ws + WS_Z), ACT, a.in[F.zz + I_GLUB] + l * 256};
            pg8::gemm_phase<EpiGlu, pg8::StaticOrder, true, true>(F.lds, g, S, E, F.tid);
            SEAM();
        }
        if (IN(6)) { PHASE_BEGIN();
            pg8::Gemm g{ACT, (const bf16*)(F.ws + WS_WOUT) + (size_t)l * 1024 * 1024, Mrows, 1024, 1024}; pg8::StaticOrder S; S.init(Mrows, 1024, F.G, (int)blockIdx.x);
            EpiResid E{(l == 0) ? a.in[F.zz + I_X] : F.out, (l == 0) ? a.in[F.zz + I_CTX] : hb, F.out, hb, MOD + (size_t)l * 5 * 6144 + 2 * 1024};
            pg8::gemm_phase<EpiResid, pg8::StaticOrder, true, true>(F.lds, g, S, E, F.tid);
            SEAM();
        }
        if (IN(7)) for (int rep_ = 0; rep_ < ((((DUP_PH >> 7) & 1) && !moe) ? 2 : 1); ++rep_) { PHASE_BEGIN();
            if (moe) norm_phase<1>(F, a, l, 1, Mrows, -1); else norm_phase<0>(F, a, l, 1, Mrows, -1);
            SEAM();
        }
        if (!moe) {
            if (IN(8)) REP(8) { PHASE_BEGIN();
                pg8::Gemm g{ACT, (const bf16*)(F.ws + WS_W13D) + (size_t)j * 5632 * 1024, Mrows, 5632, 1024}; pg8::StaticOrder S; S.init(Mrows, 5632, F.G, (int)blockIdx.x);
                EpiSwiglu E{PH};
                pg8::gemm_phase<EpiSwiglu, pg8::StaticOrder, true, true>(F.lds, g, S, E, F.tid);
                SEAM();
            }
            if (IN(9)) { PHASE_BEGIN();
                pg8::Gemm g{PH, (const bf16*)(F.ws + WS_W2D) + (size_t)j * 1024 * DFF, Mrows, 1024, DFF}; pg8::StaticOrder S; S.init(Mrows, 1024, F.G, (int)blockIdx.x);
                EpiResid E{F.out, hb, F.out, hb, MOD + (size_t)l * 5 * 6144 + 5 * 1024};
                pg8::gemm_phase<EpiResid, pg8::StaticOrder, true, true>(F.lds, g, S, E, F.tid);
                SEAM();
            }
        } else {
                        if (IN(8)) REP(8) { PHASE_BEGIN(); moe_gather(F, j); SEAM(); }
            if (IN(9)) REP(9) { PHASE_BEGIN();
                pg8::Gemm g{(const bf16*)(F.ws + WS_X2), (const bf16*)(F.ws + WS_W13M), 0, 5632, 1024}; MoeOrder S; S.init((const unsigned*)F.ws + CW_CNT + j * 8 * 64, 22, F.G, (int)blockIdx.x);
                EpiSwiglu E{PH};
                pg8::gemm_phase<EpiSwiglu, MoeOrder, true, true>(F.lds, g, S, E, F.tid);
                SEAM();
            }
            if (IN(10)) REP(10) { PHASE_BEGIN();
                pg8::Gemm g{PH, (const bf16*)(F.ws + WS_W2M), 0, 1024, DFF}; MoeOrder S; S.init((const unsigned*)F.ws + CW_CNT + j * 8 * 64, 4, F.G, (int)blockIdx.x);
                EpiStoreBf16 E{(bf16*)(F.ws + WS_X2), 1024};
                pg8::gemm_phase<EpiStoreBf16, MoeOrder, true, true>(F.lds, g, S, E, F.tid);
                SEAM();
            }
        }
    }
    if (((PH_MASK >> 13) & 1) && a.do_fin) { PHASE_BEGIN(); norm_phase<2>(F, a, DEPTH - 1, 0, NLAT, DEPTH - 1); }
#undef SEAM
#undef IN
#undef hb
#undef MOD
#undef ACT
#undef PH
}

#ifndef MK_FUSED
#define MK_FUSED 1
#endif
template <int PM, int MS> static void launch_one(const Args& a, int grid, hipStream_t stream) {
    static bool attr_done = false;
    if (!attr_done) { (void)hipFuncSetAttribute((const void*)mk_fwd<PM, MS>, hipFuncAttributeMaxDynamicSharedMemorySize, LDS_BYTES); attr_done = true; }
    hipLaunchKernelGGL((mk_fwd<PM, MS>), dim3(grid), dim3(512), LDS_BYTES, stream, a);
}
extern "C" void kernel_launch(void* const* d_in, const int* in_sizes, int n_in, void* d_out, int out_size, void* d_ws, size_t ws_size, hipStream_t stream) {
    static int grid = 0;
    if (grid == 0) {
        if (n_in != 35 || in_sizes[0] != NLAT * DM || out_size != NLAT * DM || ws_size < WS_END) {
            fprintf(stderr, "kernel_launch: unexpected shapes / workspace (n_in %d, ws %zu, need %zu); nothing launched\n", n_in, ws_size, (size_t)WS_END); grid = -1; return; }
        int dev = 0, cus = 0;
        if (hipGetDevice(&dev) != hipSuccess || hipDeviceGetAttribute(&cus, hipDeviceAttributeMultiprocessorCount, dev) != hipSuccess) { grid = -1; return; }
        grid = cus;
    }
    if (grid < 0) return;
    (void)hipMemsetAsync((char*)d_ws + WS_CTL, 0, CTL_ZERO_BYTES, stream);
    Args a{};
    for (int i = 0; i < 35; ++i) a.in[i] = (const float*)d_in[i];
    a.in[I_OUT] = (const float*)d_out; a.in[I_WS] = (const float*)d_ws; a.pad = 0;
#if MK_FUSED
    a.l_lo = 0; a.l_hi = DEPTH; a.ph_lo = 0; a.ph_hi = NPH; a.do_pro = 1; a.do_fin = 1; a.fused = 1;
#ifndef TEST_PM
#define TEST_PM 0xFFFF
#endif
#ifndef TEST_MS
#define TEST_MS 15
#endif
    launch_one<TEST_PM, TEST_MS>(a, grid, stream);
#else
    a.fused = 0;
    a.l_lo = 0; a.l_hi = 0; a.ph_lo = 0; a.ph_hi = 0; a.do_pro = 1; a.do_fin = 0;
    launch_one<0x1000, 15>(a, grid, stream);
    a.do_pro = 0;
    for (int l = 0; l < DEPTH; ++l) {
        a.l_lo = l; a.l_hi = l + 1; a.ph_lo = 0; a.ph_hi = NPH;
        launch_one<0x1, 15>(a, grid, stream); launch_one<0x2, 15>(a, grid, stream); launch_one<0x4, 15>(a, grid, stream); launch_one<0x8, 15>(a, grid, stream);
        launch_one<0x10, 1>(a, grid, stream); launch_one<0x10, 2>(a, grid, stream); launch_one<0x10, 4>(a, grid, stream); launch_one<0x10, 8>(a, grid, stream);
        launch_one<0x20, 15>(a, grid, stream); launch_one<0x40, 15>(a, grid, stream); launch_one<0x80, 15>(a, grid, stream);
        launch_one<0x100, 15>(a, grid, stream); launch_one<0x200, 15>(a, grid, stream);
        if (l & 1) launch_one<0x400, 15>(a, grid, stream);
    }
    a.l_lo = 0; a.l_hi = 0; a.ph_lo = 0; a.ph_hi = 0; a.do_fin = 1;
    launch_one<0x2000, 15>(a, grid, stream);
#endif
}
```

```cpp
#include <hip/hip_runtime.h>
#include <cstdio>
#include <cstdint>
#define LAS __attribute__((address_space(3)))
namespace pg8 {
#define PG8_LAS __attribute__((address_space(3)))
typedef unsigned short bf16_t;
typedef short bf16x8 __attribute__((ext_vector_type(8)));
typedef float f32x4 __attribute__((ext_vector_type(4)));
typedef unsigned u32x4 __attribute__((ext_vector_type(4)));
constexpr int BM = 256, BK = 64, HALF = 128, HTB = HALF * BK * 2  , STAGE_BYTES = 8 * HTB, NXCD = 8, WGM = 8;

__host__ __device__ __forceinline__ int lds_byte(int r, int c) { const int st = (r >> 4) * 2 + (c >> 5), rr = r & 15, cc = c & 31, ob = rr * 64 + cc * 2; return st * 1024 + (ob ^ (((ob >> 9) & 1) << 5)); }
__host__ __device__ __forceinline__ void stage_rc(int b, int& R, int& C) { const int st = b / 1024, sb = b % 1024, swz = sb ^ (((sb >> 9) & 1) << 5); R = (st >> 1) * 16 + swz / 64; C = (st & 1) * 32 + (swz % 64) / 2; }
__host__ __device__ __forceinline__ int perm32(int rho) { const int n = rho >> 4, i = rho & 15; return 8 * (i >> 2) + 4 * n + (i & 3); }

struct Unit { int pm, pn, pc; };
struct Gemm { const bf16_t* A; const bf16_t* Bt; int M, N, K; };

struct StaticOrder {
    int nM, nN, nwg, G, c;
    __host__ __device__ void init(int M, int N, int G_, int c_) { nM = M / BM; nN = N / BM; nwg = nM * nN; G = G_; c = c_; }
    __host__ __device__ bool next(int i, Unit& u) const {
        const long L = (long)i * G + c; if (L >= nwg) return false;
        int wgid = (int)L; { const int q = nwg / NXCD, r = nwg % NXCD, xcd = wgid % NXCD, off = wgid / NXCD; wgid = (xcd < r ? xcd * (q + 1) : r * (q + 1) + (xcd - r) * q) + off; }
        const int nig = WGM * nN, gid = wgid / nig, fm = gid * WGM, gsz = (nM - fm) < WGM ? (nM - fm) : WGM;
        u.pm = fm + ((wgid % nig) % gsz); u.pn = (wgid % nig) / gsz; u.pc = u.pn; return true;
    }
    __device__ __forceinline__ void a_ready(const Unit&) const {}
    __device__ __forceinline__ void done(const Unit&) const {}
};

__device__ __forceinline__ unsigned cvt_pk_bf16(float lo, float hi) { unsigned r; asm volatile("v_cvt_pk_bf16_f32 %0, %1, %2" : "=v"(r) : "v"(lo), "v"(hi)); return r; }
typedef float f32x2 __attribute__((ext_vector_type(2)));

template <class Epi, class Sched, bool ALIGN_EPI = false, bool SP2 = false>
__device__ __forceinline__ void gemm_phase(PG8_LAS unsigned char* lds, const Gemm g, const Sched& S, const Epi& E, const int tid) {
    const int wid = __builtin_amdgcn_readfirstlane(tid >> 6), lane = tid & 63, wr = wid >> 2, wc = wid & 3, fr = lane & 15, fq = lane >> 4;
    const int K = g.K, nt = K / BK;
    unsigned voffA[2], voffB[2];
#pragma unroll
    for (int i = 0; i < 2; ++i) { int R, C; stage_rc(tid * 16 + i * 8192, R, C); const int Rb = Epi::PERM ? ((R & ~31) + perm32(R & 31)) : R;
        voffA[i] = (unsigned)(R * K + C) * 2u; voffB[i] = (unsigned)(Rb * K + C) * 2u; }
    const size_t kstep = (size_t)(BK * 2);
    const size_t hstep = (size_t)HALF * K * 2;
    const size_t tstep = 2 * hstep;
    const unsigned ldsw = (unsigned)wid * 1024u;
    const int aoff = lds_byte(wr * 64 + fr, fq * 8), boff = lds_byte(wc * 32 + fr, fq * 8);
#define PG8_SA(b, h) (((b) * 2 + (h)) * HTB)
#define PG8_SB(b, h) ((4 + (b) * 2 + (h)) * HTB)
#define PG8_STAGE(bufoff, gbase, voff) do { _Pragma("unroll") for (int _i = 0; _i < 2; ++_i) \
        __builtin_amdgcn_global_load_lds((const unsigned*)((const char*)(gbase) + (voff)[_i]), (PG8_LAS unsigned*)(lds + (bufoff) + ldsw + _i * 8192), 16, 0, 0); } while (0)
#define PG8_LDA(dst, b, h) do { _Pragma("unroll") for (int m = 0; m < 4; ++m) _Pragma("unroll") for (int k = 0; k < 2; ++k) dst[m][k] = *(const PG8_LAS bf16x8*)(lds + PG8_SA(b, h) + aoff + m * 2048 + k * 1024); } while (0)
#define PG8_LDB(dst, b, h) do { _Pragma("unroll") for (int n = 0; n < 2; ++n) _Pragma("unroll") for (int k = 0; k < 2; ++k) dst[n][k] = *(const PG8_LAS bf16x8*)(lds + PG8_SB(b, h) + boff + n * 2048 + k * 1024); } while (0)
#define PG8_MMA(ai, bj, At, Bt) do { __builtin_amdgcn_s_setprio(1); _Pragma("unroll") for (int m = 0; m < 4; ++m) _Pragma("unroll") for (int n = 0; n < 2; ++n) _Pragma("unroll") for (int k = 0; k < 2; ++k) \
        acc[ai][bj][m][n] = __builtin_amdgcn_mfma_f32_16x16x32_bf16(Bt[n][k], At[m][k], acc[ai][bj][m][n], 0, 0, 0); __builtin_amdgcn_s_setprio(0); } while (0)
#define PG8_WAIT_V(n) asm volatile("s_waitcnt vmcnt(" #n ")" ::: "memory")
#define PG8_WAIT_L(n) asm volatile("s_waitcnt lgkmcnt(" #n ")" ::: "memory")
#define PG8_BAR __builtin_amdgcn_s_barrier()
#define PG8_SCHED __builtin_amdgcn_sched_barrier(0)
    Unit cur, nxt; int ui = 0;
    if (!S.next(0, cur)) return;
    f32x4 acc[2][2][4][2];
#pragma unroll
    for (int a = 0; a < 2; ++a)
#pragma unroll
        for (int b = 0; b < 2; ++b)
#pragma unroll
            for (int m = 0; m < 4; ++m)
#pragma unroll
                for (int n = 0; n < 2; ++n) acc[a][b][m][n] = (f32x4){0.f, 0.f, 0.f, 0.f};
    bf16x8 At[4][2], B0[2][2], B1[2][2];
    const char* cA = (const char*)g.A + (size_t)cur.pm * tstep; const char* cB = (const char*)g.Bt + (size_t)cur.pn * tstep;
    S.a_ready(cur);
    if constexpr (SP2) {
        PG8_STAGE(PG8_SB(0, 0), cB, voffB); PG8_STAGE(PG8_SB(0, 1), cB + hstep, voffB); PG8_STAGE(PG8_SA(0, 0), cA, voffA); PG8_STAGE(PG8_SA(0, 1), cA + hstep, voffA);
        if (wr == 1) PG8_BAR;
        PG8_WAIT_V(2); PG8_BAR;
        PG8_STAGE(PG8_SB(1, 0), cB + kstep, voffB); PG8_STAGE(PG8_SA(1, 0), cA + kstep, voffA); PG8_STAGE(PG8_SB(1, 1), cB + hstep + kstep, voffB);
        PG8_WAIT_V(6); PG8_BAR;
    } else {
        PG8_STAGE(PG8_SB(0, 0), cB, voffB); PG8_STAGE(PG8_SA(0, 0), cA, voffA); PG8_STAGE(PG8_SB(0, 1), cB + hstep, voffB); PG8_STAGE(PG8_SA(0, 1), cA + hstep, voffA);
        if (wr == 1) PG8_BAR;
        PG8_WAIT_V(4); PG8_BAR;
        PG8_STAGE(PG8_SB(1, 0), cB + kstep, voffB); PG8_STAGE(PG8_SA(1, 0), cA + kstep, voffA); PG8_STAGE(PG8_SB(1, 1), cB + hstep + kstep, voffB);
        PG8_WAIT_V(6); PG8_BAR;
    }
    for (;;) {
        const bool has_next = S.next(ui + 1, nxt);
        const char* nA = has_next ? (const char*)g.A + (size_t)nxt.pm * tstep : cA; const char* nB = has_next ? (const char*)g.Bt + (size_t)nxt.pn * tstep : cB;
        for (int t = 0; t < nt; t += 2) {
            const bool last = (t == nt - 2);
            const char* a1 = cA + (size_t)(t + 1) * kstep;
            const char* a2 = last ? nA : cA + (size_t)(t + 2) * kstep; const char* b2 = last ? nB : cB + (size_t)(t + 2) * kstep;
            const char* a3 = a2 + kstep; const char* b3 = b2 + kstep;
            if (last && has_next) S.a_ready(nxt);
            if constexpr (SP2) {
            PG8_LDB(B0, 0, 0); PG8_LDB(B1, 0, 1); PG8_SCHED; PG8_LDA(At, 0, 0); PG8_STAGE(PG8_SA(1, 1), a1 + hstep, voffA);
            PG8_WAIT_V(8); PG8_WAIT_L(0); PG8_BAR; PG8_MMA(0, 0, At, B0); PG8_MMA(0, 1, At, B1); PG8_BAR; PG8_SCHED;
            PG8_LDA(At, 0, 1); PG8_STAGE(PG8_SB(0, 0), b2, voffB); PG8_STAGE(PG8_SB(0, 1), b2 + hstep, voffB); PG8_STAGE(PG8_SA(0, 0), a2, voffA);
            PG8_WAIT_V(8); PG8_WAIT_L(0); PG8_BAR; PG8_MMA(1, 0, At, B0); PG8_MMA(1, 1, At, B1); PG8_BAR; PG8_SCHED;
            PG8_LDB(B0, 1, 0); PG8_LDB(B1, 1, 1); PG8_SCHED; PG8_LDA(At, 1, 0); PG8_STAGE(PG8_SA(0, 1), a2 + hstep, voffA);
            PG8_WAIT_V(8); PG8_WAIT_L(0); PG8_BAR; PG8_MMA(0, 0, At, B0); PG8_MMA(0, 1, At, B1); PG8_BAR; PG8_SCHED;
            PG8_LDA(At, 1, 1); PG8_STAGE(PG8_SB(1, 0), b3, voffB); PG8_STAGE(PG8_SB(1, 1), b3 + hstep, voffB); PG8_STAGE(PG8_SA(1, 0), a3, voffA);
            PG8_WAIT_V(8); PG8_WAIT_L(0); PG8_BAR; PG8_MMA(1, 0, At, B0); PG8_MMA(1, 1, At, B1); PG8_BAR; PG8_SCHED;
            } else {
            PG8_LDB(B0, 0, 0); PG8_SCHED; PG8_LDA(At, 0, 0); PG8_STAGE(PG8_SA(1, 1), a1 + hstep, voffA);
            PG8_WAIT_L(8); PG8_BAR; PG8_WAIT_L(0); PG8_MMA(0, 0, At, B0); PG8_BAR; PG8_SCHED;
            PG8_LDB(B1, 0, 1); PG8_STAGE(PG8_SB(0, 0), b2, voffB);
            PG8_BAR; PG8_WAIT_L(0); PG8_MMA(0, 1, At, B1); PG8_BAR;
            PG8_LDA(At, 0, 1); PG8_STAGE(PG8_SA(0, 0), a2, voffA);
            PG8_BAR; PG8_WAIT_L(0); PG8_MMA(1, 0, At, B0); PG8_BAR; PG8_SCHED;
            PG8_STAGE(PG8_SB(0, 1), b2 + hstep, voffB);
            PG8_WAIT_V(6); PG8_BAR; PG8_MMA(1, 1, At, B1); PG8_BAR;
            PG8_LDB(B0, 1, 0); PG8_SCHED; PG8_LDA(At, 1, 0); PG8_STAGE(PG8_SA(0, 1), a2 + hstep, voffA);
            PG8_WAIT_L(8); PG8_BAR; PG8_WAIT_L(0); PG8_MMA(0, 0, At, B0); PG8_BAR; PG8_SCHED;
            PG8_LDB(B1, 1, 1); PG8_STAGE(PG8_SB(1, 0), b3, voffB);
            PG8_BAR; PG8_WAIT_L(0); PG8_MMA(0, 1, At, B1); PG8_BAR;
            PG8_LDA(At, 1, 1); PG8_STAGE(PG8_SA(1, 0), a3, voffA);
            PG8_BAR; PG8_WAIT_L(0); PG8_MMA(1, 0, At, B0); PG8_BAR; PG8_SCHED;
            PG8_STAGE(PG8_SB(1, 1), b3 + hstep, voffB);
            PG8_WAIT_V(6); PG8_BAR; PG8_MMA(1, 1, At, B1); PG8_BAR;
            }
        }
        if constexpr (ALIGN_EPI) { if (wr == 0) PG8_BAR; }
        if constexpr (!Epi::AFTER_DRAIN) { E(acc, cur, wr, wc, fr, fq); S.done(cur); }
        if (!has_next) break;
#pragma unroll
        for (int a = 0; a < 2; ++a)
#pragma unroll
            for (int b = 0; b < 2; ++b)
#pragma unroll
                for (int m = 0; m < 4; ++m)
#pragma unroll
                    for (int n = 0; n < 2; ++n) acc[a][b][m][n] = (f32x4){0.f, 0.f, 0.f, 0.f};
        cur = nxt; cA = nA; cB = nB; ++ui;
        if constexpr (ALIGN_EPI) { if (wr == 1) PG8_BAR; }
    }
    PG8_WAIT_V(0);
    if constexpr (!ALIGN_EPI) { if (wr == 0) PG8_BAR; }
    PG8_BAR;
    if constexpr (Epi::AFTER_DRAIN) { E.fused(acc, cur, wr, wc, fr, fq, lds, wid, lane); S.done(cur); }
#undef PG8_SA
#undef PG8_SB
#undef PG8_STAGE
#undef PG8_LDA
#undef PG8_LDB
#undef PG8_MMA
#undef PG8_WAIT_V
#undef PG8_WAIT_L
#undef PG8_BAR
#undef PG8_SCHED
}
typedef int v8i_t __attribute__((ext_vector_type(8)));
typedef int v4i_t __attribute__((ext_vector_type(4)));
template <class Epi, class Sched, bool ALIGN_EPI = false, bool SP2 = false>
__device__ __forceinline__ void gemm_phase_f8(PG8_LAS unsigned char* lds, const Gemm g, const Sched& S, const Epi& E, const int tid) {
    const int wid = __builtin_amdgcn_readfirstlane(tid >> 6), lane = tid & 63, wr = wid >> 2, wc = wid & 3, fr = lane & 15, fq = lane >> 4;
    const int K = g.K, nt = K / BK;
    unsigned voffA[2], voffB[2];
#pragma unroll
    for (int i = 0; i < 2; ++i) { int R, C; stage_rc(tid * 16 + i * 8192, R, C); const int Rb = Epi::PERM ? ((R & ~31) + perm32(R & 31)) : R;
        voffA[i] = (unsigned)(R * K + C) * 2u; voffB[i] = (unsigned)(Rb * K + C) * 2u; }
    const size_t kstep = (size_t)(BK * 2);
    const size_t hstep = (size_t)HALF * K * 2;
    const size_t tstep = 2 * hstep;
    const unsigned ldsw = (unsigned)wid * 1024u;
    const int aoff0 = lds_byte(wr * 64 + fr, fq * 16), aoff1 = lds_byte(wr * 64 + fr, fq * 16 + 8), boff0 = lds_byte(wc * 32 + fr, fq * 16), boff1 = lds_byte(wc * 32 + fr, fq * 16 + 8);
#define PG8_SA(b, h) (((b) * 2 + (h)) * HTB)
#define PG8_SB(b, h) ((4 + (b) * 2 + (h)) * HTB)
#define PG8_STAGE(bufoff, gbase, voff) do { _Pragma("unroll") for (int _i = 0; _i < 2; ++_i) \
        __builtin_amdgcn_global_load_lds((const unsigned*)((const char*)(gbase) + (voff)[_i]), (PG8_LAS unsigned*)(lds + (bufoff) + ldsw + _i * 8192), 16, 0, 0); } while (0)
#define PG8_LDA(dst, b, h) do { _Pragma("unroll") for (int m = 0; m < 4; ++m) { const u32x4 lo_ = *(const PG8_LAS u32x4*)(lds + PG8_SA(b, h) + aoff0 + m * 2048), hi_ = *(const PG8_LAS u32x4*)(lds + PG8_SA(b, h) + aoff1 + m * 2048); \
        dst[m] = __builtin_shufflevector((v4i_t)lo_, (v4i_t)hi_, 0, 1, 2, 3, 4, 5, 6, 7); } } while (0)
#define PG8_LDB(dst, b, h) do { _Pragma("unroll") for (int n = 0; n < 2; ++n) { const u32x4 lo_ = *(const PG8_LAS u32x4*)(lds + PG8_SB(b, h) + boff0 + n * 2048), hi_ = *(const PG8_LAS u32x4*)(lds + PG8_SB(b, h) + boff1 + n * 2048); \
        dst[n] = __builtin_shufflevector((v4i_t)lo_, (v4i_t)hi_, 0, 1, 2, 3, 4, 5, 6, 7); } } while (0)
#define PG8_MMA(ai, bj, At, Bt) do { __builtin_amdgcn_s_setprio(1); _Pragma("unroll") for (int m = 0; m < 4; ++m) _Pragma("unroll") for (int n = 0; n < 2; ++n) \
        asm volatile("v_mfma_scale_f32_16x16x128_f8f6f4 %0, %1, %2, %0, %3, %3 op_sel_hi:[0,0,0]" : "+v"(acc[ai][bj][m][n]) : "v"(Bt[n]), "v"(At[m]), "v"(one_scale)); __builtin_amdgcn_s_setprio(0); } while (0)
#define PG8_WAIT_V(n) asm volatile("s_waitcnt vmcnt(" #n ")" ::: "memory")
#define PG8_WAIT_L(n) asm volatile("s_waitcnt lgkmcnt(" #n ")" ::: "memory")
#define PG8_BAR __builtin_amdgcn_s_barrier()
#define PG8_SCHED __builtin_amdgcn_sched_barrier(0)
    Unit cur, nxt; int ui = 0;
    if (!S.next(0, cur)) return;
    f32x4 acc[2][2][4][2];
#pragma unroll
    for (int a = 0; a < 2; ++a)
#pragma unroll
        for (int b = 0; b < 2; ++b)
#pragma unroll
            for (int m = 0; m < 4; ++m)
#pragma unroll
                for (int n = 0; n < 2; ++n) acc[a][b][m][n] = (f32x4){0.f, 0.f, 0.f, 0.f};
    v8i_t At[4], B0[2], B1[2]; const int one_scale = 0x7f7f7f7f;
    const char* cA = (const char*)g.A + (size_t)cur.pm * tstep; const char* cB = (const char*)g.Bt + (size_t)cur.pn * tstep;
    S.a_ready(cur);
    if constexpr (SP2) {
        PG8_STAGE(PG8_SB(0, 0), cB, voffB); PG8_STAGE(PG8_SB(0, 1), cB + hstep, voffB); PG8_STAGE(PG8_SA(0, 0), cA, voffA); PG8_STAGE(PG8_SA(0, 1), cA + hstep, voffA);
        if (wr == 1) PG8_BAR;
        PG8_WAIT_V(2); PG8_BAR;
        PG8_STAGE(PG8_SB(1, 0), cB + kstep, voffB); PG8_STAGE(PG8_SA(1, 0), cA + kstep, voffA); PG8_STAGE(PG8_SB(1, 1), cB + hstep + kstep, voffB);
        PG8_WAIT_V(6); PG8_BAR;
    } else {
        PG8_STAGE(PG8_SB(0, 0), cB, voffB); PG8_STAGE(PG8_SA(0, 0), cA, voffA); PG8_STAGE(PG8_SB(0, 1), cB + hstep, voffB); PG8_STAGE(PG8_SA(0, 1), cA + hstep, voffA);
        if (wr == 1) PG8_BAR;
        PG8_WAIT_V(4); PG8_BAR;
        PG8_STAGE(PG8_SB(1, 0), cB + kstep, voffB); PG8_STAGE(PG8_SA(1, 0), cA + kstep, voffA); PG8_STAGE(PG8_SB(1, 1), cB + hstep + kstep, voffB);
        PG8_WAIT_V(6); PG8_BAR;
    }
    for (;;) {
        const bool has_next = S.next(ui + 1, nxt);
        const char* nA = has_next ? (const char*)g.A + (size_t)nxt.pm * tstep : cA; const char* nB = has_next ? (const char*)g.Bt + (size_t)nxt.pn * tstep : cB;
        for (int t = 0; t < nt; t += 2) {
            const bool last = (t == nt - 2);
            const char* a1 = cA + (size_t)(t + 1) * kstep;
            const char* a2 = last ? nA : cA + (size_t)(t + 2) * kstep; const char* b2 = last ? nB : cB + (size_t)(t + 2) * kstep;
            const char* a3 = a2 + kstep; const char* b3 = b2 + kstep;
            if (last && has_next) S.a_ready(nxt);
            if constexpr (SP2) {
            PG8_LDB(B0, 0, 0); PG8_LDB(B1, 0, 1); PG8_SCHED; PG8_LDA(At, 0, 0); PG8_STAGE(PG8_SA(1, 1), a1 + hstep, voffA);
            PG8_WAIT_V(8); PG8_WAIT_L(0); PG8_BAR; PG8_MMA(0, 0, At, B0); PG8_MMA(0, 1, At, B1); PG8_BAR; PG8_SCHED;
            PG8_LDA(At, 0, 1); PG8_STAGE(PG8_SB(0, 0), b2, voffB); PG8_STAGE(PG8_SB(0, 1), b2 + hstep, voffB); PG8_STAGE(PG8_SA(0, 0), a2, voffA);
            PG8_WAIT_V(8); PG8_WAIT_L(0); PG8_BAR; PG8_MMA(1, 0, At, B0); PG8_MMA(1, 1, At, B1); PG8_BAR; PG8_SCHED;
            PG8_LDB(B0, 1, 0); PG8_LDB(B1, 1, 1); PG8_SCHED; PG8_LDA(At, 1, 0); PG8_STAGE(PG8_SA(0, 1), a2 + hstep, voffA);
            PG8_WAIT_V(8); PG8_WAIT_L(0); PG8_BAR; PG8_MMA(0, 0, At, B0); PG8_MMA(0, 1, At, B1); PG8_BAR; PG8_SCHED;
            PG8_LDA(At, 1, 1); PG8_STAGE(PG8_SB(1, 0), b3, voffB); PG8_STAGE(PG8_SB(1, 1), b3 + hstep, voffB); PG8_STAGE(PG8_SA(1, 0), a3, voffA);
            PG8_WAIT_V(8); PG8_WAIT_L(0); PG8_BAR; PG8_MMA(1, 0, At, B0); PG8_MMA(1, 1, At, B1); PG8_BAR; PG8_SCHED;
            } else {
            PG8_LDB(B0, 0, 0); PG8_SCHED; PG8_LDA(At, 0, 0); PG8_STAGE(PG8_SA(1, 1), a1 + hstep, voffA);
            PG8_WAIT_L(8); PG8_BAR; PG8_WAIT_L(0); PG8_MMA(0, 0, At, B0); PG8_BAR; PG8_SCHED;
            PG8_LDB(B1, 0, 1); PG8_STAGE(PG8_SB(0, 0), b2, voffB);
            PG8_BAR; PG8_WAIT_L(0); PG8_MMA(0, 1, At, B1); PG8_BAR;
            PG8_LDA(At, 0, 1); PG8_STAGE(PG8_SA(0, 0), a2, voffA);
            PG8_BAR; PG8_WAIT_L(0); PG8_MMA(1, 0, At, B0); PG8_BAR; PG8_SCHED;
            PG8_STAGE(PG8_SB(0, 1), b2 + hstep, voffB);
            PG8_WAIT_V(6); PG8_BAR; PG8_MMA(1, 1, At, B1); PG8_BAR;
            PG8_LDB(B0, 1, 0); PG8_SCHED; PG8_LDA(At, 1, 0); PG8_STAGE(PG8_SA(0, 1), a2 + hstep, voffA);
            PG8_WAIT_L(8); PG8_BAR; PG8_WAIT_L(0); PG8_MMA(0, 0, At, B0); PG8_BAR; PG8_SCHED;
            PG8_LDB(B1, 1, 1); PG8_STAGE(PG8_SB(1, 0), b3, voffB);
            PG8_BAR; PG8_WAIT_L(0); PG8_MMA(0, 1, At, B1); PG8_BAR;
            PG8_LDA(At, 1, 1); PG8_STAGE(PG8_SA(1, 0), a3, voffA);
            PG8_BAR; PG8_WAIT_L(0); PG8_MMA(1, 0, At, B0); PG8_BAR; PG8_SCHED;
            PG8_STAGE(PG8_SB(1, 1), b3 + hstep, voffB);
            PG8_WAIT_V(6); PG8_BAR; PG8_MMA(1, 1, At, B1); PG8_BAR;
            }
        }
        if constexpr (ALIGN_EPI) { if (wr == 0) PG8_BAR; }
        asm volatile("s_nop 15\n\ts_nop 15" ::: "memory");
        if constexpr (!Epi::AFTER_DRAIN) { E(acc, cur, wr, wc, fr, fq); S.done(cur); }
        if (!has_next) break;
#pragma unroll
        for (int a = 0; a < 2; ++a)
#pragma unroll
            for (int b = 0; b < 2; ++b)
#pragma unroll
                for (int m = 0; m < 4; ++m)
#pragma unroll
                    for (int n = 0; n < 2; ++n) acc[a][b][m][n] = (f32x4){0.f, 0.f, 0.f, 0.f};
        cur = nxt; cA = nA; cB = nB; ++ui;
        if constexpr (ALIGN_EPI) { if (wr == 1) PG8_BAR; }
    }
    PG8_WAIT_V(0);
    if constexpr (!ALIGN_EPI) { if (wr == 0) PG8_BAR; }
    PG8_BAR;
    if constexpr (Epi::AFTER_DRAIN) { E.fused(acc, cur, wr, wc, fr, fq, lds, wid, lane); S.done(cur); }
#undef PG8_SA
#undef PG8_SB
#undef PG8_STAGE
#undef PG8_LDA
#undef PG8_LDB
#undef PG8_MMA
#undef PG8_WAIT_V
#undef PG8_WAIT_L
#undef PG8_BAR
#undef PG8_SCHED
}
}

#define XB_TMO      128
#define XB_XCNT(j)  (256  + 64 * (j))
#define XB_XSUB(j)  (1280 + 64 * (j))
#define XB_XGEN(j)  (2304 + 64 * (j))
#define XB_TOP      3328
#define XB_TOPGEN   3392
#define XCD_BAR_WORDS 3456
#define XB_SPIN_CAP (1u << 18)

__device__ __forceinline__ unsigned xb_ld(unsigned* p)              { return __hip_atomic_load(p, __ATOMIC_RELAXED, __HIP_MEMORY_SCOPE_AGENT); }
__device__ __forceinline__ unsigned xb_add(unsigned* p, unsigned v) { return __hip_atomic_fetch_add(p, v, __ATOMIC_RELAXED, __HIP_MEMORY_SCOPE_AGENT); }
__device__ __forceinline__ unsigned xb_xcc_id() { return (unsigned)__builtin_amdgcn_s_getreg((3 << 11) | 20) & 0xFu; }
#define XB_SPIN(cond, bar) do { unsigned _sp = 0; while (cond) { __builtin_amdgcn_s_sleep(1); \
    if ((++_sp & 255u) == 0u) { if (xb_ld(&(bar)[XB_TMO])) break; if (_sp > XB_SPIN_CAP) { atomicAdd(&(bar)[XB_TMO], 1u); break; } } } } while (0)

struct XcdBarrier {
    unsigned* bar; unsigned x;
    volatile LAS unsigned* st;
};

__device__ __forceinline__ XcdBarrier xcd_barrier_post(unsigned* bar, volatile LAS unsigned* st, const int xb_tid) {
    XcdBarrier b; b.bar = bar; b.x = xb_xcc_id(); b.st = st;
    if (xb_tid == 0) (void)xb_add(&bar[XB_XCNT(b.x)], 1u);
    return b;
}
__device__ __forceinline__ void xcd_barrier_complete(unsigned* bar, unsigned x, unsigned& nloc, unsigned& nx) {
    const unsigned G = gridDim.x * gridDim.y * gridDim.z;
    unsigned sum, cnt, mine, sp = 0u;
    for (;;) {
        sum = 0u; cnt = 0u; mine = 0u;
#pragma unroll
        for (unsigned j = 0; j < 16; ++j) { const unsigned c = xb_ld(&bar[XB_XCNT(j)]); sum += c; cnt += (c > 0u) ? 1u : 0u; mine = (j == x) ? c : mine; }
        if (sum == G) break;
        __builtin_amdgcn_s_sleep(1);
        if ((++sp & 255u) == 0u) { if (xb_ld(&bar[XB_TMO])) break; if (sp > XB_SPIN_CAP) { atomicAdd(&bar[XB_TMO], 1u); break; } }
    }
    nloc = mine > 0u ? mine : 1u; nx = cnt > 0u ? cnt : 1u;
}

__device__ __forceinline__ void xcd_barrier(const XcdBarrier& b, const int xb_tid) {
    asm volatile("s_waitcnt vmcnt(0)" ::: "memory");
    __syncthreads();
    if (xb_tid == 0) {
        unsigned* bar = b.bar;
        __builtin_amdgcn_s_waitcnt(0);
        unsigned nloc = b.st[0], nx = b.st[1];
        if (nloc == 0u) { xcd_barrier_complete(bar, b.x, nloc, nx); b.st[0] = nloc; b.st[1] = nx; }
        const unsigned old = xb_add(&bar[XB_XSUB(b.x)], 1u);
        const unsigned gen = old / nloc;
        if (old + 1u == (gen + 1u) * nloc) {
            __builtin_amdgcn_fence(__ATOMIC_RELEASE, "agent");
            asm volatile("s_waitcnt vmcnt(0)" ::: "memory");
            const unsigned og = xb_add(&bar[XB_TOP], 1u);
            const unsigned tg = og / nx;
            if (og + 1u == (tg + 1u) * nx) xb_add(&bar[XB_TOPGEN], 1u);
            else XB_SPIN(xb_ld(&bar[XB_TOPGEN]) == tg, bar);
            __builtin_amdgcn_fence(__ATOMIC_ACQUIRE, "agent");
            xb_add(&bar[XB_XGEN(b.x)], 1u);
            asm volatile("s_waitcnt vmcnt(0)" ::: "memory");
        } else {
            XB_SPIN(xb_ld(&bar[XB_XGEN(b.x)]) == gen, bar);
            __builtin_amdgcn_fence(__ATOMIC_ACQUIRE, "agent");
            asm volatile("s_waitcnt vmcnt(0)" ::: "memory");
        }
    }
    __syncthreads();
}

#define GAS __attribute__((address_space(1)))
typedef unsigned short bf16;
typedef unsigned v4u __attribute__((ext_vector_type(4)));
typedef unsigned v2u __attribute__((ext_vector_type(2)));
typedef float f32x4 __attribute__((ext_vector_type(4)));

constexpr int NB = 4, SEQ = 8192, DM = 1024, DEPTH = 4, CTXL = 256;
constexpr int NLAT = NB * SEQ, NCTX = NB * CTXL, MT = NLAT + NCTX;
constexpr int DIN = 3360, DINP = 3584, DFF = 2816, NEXP = 8;
constexpr int C_RQ = 0, C_RK = 256, C_RV = 512, C_RG = 768, C_S5 = 1024, C_HQ = 1280, C_HFF = 1536, C_HFB = 1792, C_HI = 2048, C_HG = 2304,
              C_GQ = 2560, C_GK = 2688, C_GV = 2816, C_GG = 3072, C_GAF = 3328, C_GAB = 3344,
              C_GZF = 3328, C_GZB = 3456;
constexpr int NSEG = 132;
constexpr int MOE_CAP_TILES = 272;
constexpr float NEPS = 1e-6f;
constexpr float WSC8 = 64.0f;

constexpr size_t MiB = 1u << 20;
constexpr size_t WS_CTL = 0, CTL_ZERO_BYTES = 2 * MiB;
constexpr size_t WS_MOD = 2 * MiB;
constexpr size_t WS_LB = 3 * MiB;
constexpr size_t WS_ROPE = 3 * MiB + 65536;
constexpr size_t WS_GLUW = 3 * MiB + 131072;
constexpr size_t WS_WIN = 4 * MiB;
constexpr size_t WS_WOUT = 32 * MiB;
constexpr size_t WS_W13D = 40 * MiB;
constexpr size_t WS_W2D = 62 * MiB;
constexpr size_t WS_W13M = 73 * MiB;
constexpr size_t WS_W2M = 161 * MiB;
constexpr size_t WS_HB = 205 * MiB;
constexpr size_t WS_ACT = 209 * MiB;
constexpr size_t WS_Z = 275 * MiB;
constexpr size_t WS_PH = 292 * MiB;
constexpr size_t WS_OF = (292 + 232) * MiB;
constexpr size_t WS_X2 = 666 * MiB;
constexpr size_t WS_LIST = 843 * MiB;
constexpr size_t WS_END = 846 * MiB;
constexpr size_t ST_DS0 = 0;
constexpr size_t ST_DS1 = ST_DS0 + (size_t)2 * 16 * NSEG * 4096;
constexpr size_t ST_DS2 = ST_DS1 + (size_t)2 * 16 * NSEG * 4096;
constexpr size_t ST_G0 = ST_DS2 + (size_t)2 * 16 * NSEG * 2048;
constexpr size_t ST_G1 = ST_G0 + (size_t)2 * 16 * NSEG * 64;
constexpr size_t ST_G2 = ST_G1 + (size_t)2 * 16 * NSEG * 64;
constexpr size_t ST_HS = ST_G2 + (size_t)2 * 16 * NSEG * 64;
constexpr size_t ST_END = ST_HS + (size_t)2 * 64 * NSEG * 128;
static_assert(ST_END * 4 <= (WS_LIST - WS_X2), "state region");
static_assert(WS_PH + (size_t)MT * DINP * 2 <= WS_OF && WS_OF + (size_t)MT * 768 * 4 <= WS_X2, "OF region");
static_assert((size_t)MOE_CAP_TILES * 256 * 1024 * 2 <= (WS_LIST - WS_X2), "XB region");
static_assert((size_t)MOE_CAP_TILES * 256 * DFF * 2 <= (WS_X2 - WS_PH) && (size_t)MT * DINP * 2 <= (WS_X2 - WS_PH), "P/H region");
constexpr int CW_BAR = 4096;
constexpr int CW_CNT = 16384;

constexpr int LDS_BYTES = 163840;
constexpr int MISC_OFF = 163840 - 512;

__device__ __forceinline__ float bf2f(unsigned short h) { return __uint_as_float(((unsigned)h) << 16); }
__device__ __forceinline__ unsigned f2bf(float f) { unsigned u = __float_as_uint(f); return (u + 0x7fffu + ((u >> 16) & 1u)) >> 16; }
__device__ __forceinline__ unsigned pk2(float lo, float hi) { return f2bf(lo) | (f2bf(hi) << 16); }
__device__ __forceinline__ float wave_sum(float v) {
#pragma unroll
    for (int o = 1; o < 64; o <<= 1) v += __shfl_xor(v, o);
    return v;
}
__device__ __forceinline__ float rdl(float v, int k) { return __uint_as_float((unsigned)__builtin_amdgcn_readlane((int)__float_as_uint(v), k)); }
__device__ __forceinline__ float sigm(float x) { return 1.0f / (1.0f + __expf(-x)); }
__device__ __forceinline__ float silu_f(float x) { return x / (1.0f + __expf(-x)); }
#define LDS_WAIT() asm volatile("s_waitcnt lgkmcnt(0)" ::: "memory")

struct Args {
    const float* in[37];
    int l_lo, l_hi, ph_lo, ph_hi, do_pro, do_fin, fused, pad;
};
constexpr int I_OUT = 35, I_WS = 36;
enum { I_X = 0, I_C, I_CTX, I_CCTX, I_ADAW, I_ADAB, I_N1W, I_N2W, I_WIN, I_WOUT, I_RETGN, I_LAMRE, I_LAMIM, I_LOGDT, I_BRE, I_BIM, I_CRE, I_CIM, I_S5D,
       I_GLUW, I_GLUB, I_LBL, I_HGNW, I_WA2, I_BA, I_GLANW, I_FW1, I_FW3, I_FW2, I_RW, I_RB, I_MW1, I_MW3, I_MW2, I_FINW };

struct Frame {
    LAS unsigned char* lds;
    int tid, lane, wave, gw, NGW, G, zz;
    unsigned char* ws; float* out;
};

struct EpiStoreBf16 {
    static constexpr bool PERM = true, AFTER_DRAIN = false;
    bf16* O; int ldc; float sc;
    __device__ __forceinline__ void operator()(const pg8::f32x4 (&acc)[2][2][4][2], const pg8::Unit& u, int wr, int wc, int fr, int fq) const {
        const int row0 = u.pm * 256 + wr * 64 + fr, col0 = u.pc * 256 + wc * 32 + 8 * fq;
#pragma unroll
        for (int ai = 0; ai < 2; ++ai)
#pragma unroll
            for (int m = 0; m < 4; ++m) { bf16* rowp = O + (size_t)(row0 + ai * 128 + m * 16) * ldc + col0;
#pragma unroll
                for (int bj = 0; bj < 2; ++bj) { const pg8::f32x4 v0 = acc[ai][bj][m][0] * sc, v1 = acc[ai][bj][m][1] * sc;
                    pg8::u32x4 w; w.x = pg8::cvt_pk_bf16(v0[0], v0[1]); w.y = pg8::cvt_pk_bf16(v0[2], v0[3]); w.z = pg8::cvt_pk_bf16(v1[0], v1[1]); w.w = pg8::cvt_pk_bf16(v1[2], v1[3]);
                    *(pg8::u32x4*)(rowp + bj * 128) = w; } }
    }
};
struct EpiSwiglu {
    static constexpr bool PERM = true, AFTER_DRAIN = false;
    bf16* H;
    __device__ __forceinline__ void operator()(const pg8::f32x4 (&acc)[2][2][4][2], const pg8::Unit& u, int wr, int wc, int fr, int fq) const {
        const int row0 = u.pm * 256 + wr * 64 + fr, col0 = u.pc * 128 + wc * 32 + 8 * fq;
#pragma unroll
        for (int ai = 0; ai < 2; ++ai)
#pragma unroll
            for (int m = 0; m < 4; ++m) { bf16* rowp = H + (size_t)(row0 + ai * 128 + m * 16) * DFF + col0;
                float h[8];
#pragma unroll
                for (int n = 0; n < 2; ++n)
#pragma unroll
                    for (int j = 0; j < 4; ++j) { const float a = acc[ai][0][m][n][j], b = acc[ai][1][m][n][j];
                        h[n * 4 + j] = a * __builtin_amdgcn_rcpf(1.0f + __builtin_amdgcn_exp2f(-1.4426950408889634f * a)) * b; }
                pg8::u32x4 w; w.x = pg8::cvt_pk_bf16(h[0], h[1]); w.y = pg8::cvt_pk_bf16(h[2], h[3]); w.z = pg8::cvt_pk_bf16(h[4], h[5]); w.w = pg8::cvt_pk_bf16(h[6], h[7]);
                *(pg8::u32x4*)rowp = w; }
    }
};
struct EpiSwiglu8 {
    static constexpr bool PERM = true, AFTER_DRAIN = false;
    unsigned char* H; float sc;
    __device__ __forceinline__ void operator()(const pg8::f32x4 (&acc)[2][2][4][2], const pg8::Unit& u, int wr, int wc, int fr, int fq) const {
        const int row0 = u.pm * 256 + wr * 64 + fr, col0 = u.pc * 128 + wc * 32 + 8 * fq;
#pragma unroll
        for (int ai = 0; ai < 2; ++ai)
#pragma unroll
            for (int m = 0; m < 4; ++m) { unsigned char* rowp = H + (size_t)(row0 + ai * 128 + m * 16) * DFF + col0;
                float h[8];
#pragma unroll
                for (int n = 0; n < 2; ++n)
#pragma unroll
                    for (int j = 0; j < 4; ++j) { const float a = acc[ai][0][m][n][j] * sc, b = acc[ai][1][m][n][j] * sc;
                        const float hv = a * __builtin_amdgcn_rcpf(1.0f + __builtin_amdgcn_exp2f(-1.4426950408889634f * a)) * b;
                        h[n * 4 + j] = fminf(fmaxf(hv, -448.0f), 448.0f); }
                unsigned w0 = 0u, w1 = 0u;
                w0 = __builtin_amdgcn_cvt_pk_fp8_f32(h[0], h[1], w0, false); w0 = __builtin_amdgcn_cvt_pk_fp8_f32(h[2], h[3], w0, true);
                w1 = __builtin_amdgcn_cvt_pk_fp8_f32(h[4], h[5], w1, false); w1 = __builtin_amdgcn_cvt_pk_fp8_f32(h[6], h[7], w1, true);
                v2u w; w.x = w0; w.y = w1; *(v2u*)rowp = w; }
    }
};
struct EpiResid {
    static constexpr bool PERM = false, AFTER_DRAIN = false;
    const float* xin_lat; const float* xin_ctx; float* xout_lat; float* xout_ctx; const float* gate; float sc;
    __device__ __forceinline__ void operator()(const pg8::f32x4 (&acc)[2][2][4][2], const pg8::Unit& u, int wr, int wc, int fr, int fq) const {
        const bool isctx = u.pm >= 128; const int bidx = isctx ? 4 : (u.pm >> 5);
        const size_t rbase = (size_t)(isctx ? (u.pm - 128) : u.pm) * 256 + wr * 64 + fr;
        const float* xi = (isctx ? xin_ctx : xin_lat); float* xo = (isctx ? xout_ctx : xout_lat);
        const int col0 = u.pc * 256 + wc * 32 + 4 * fq; const float* g = gate + (size_t)bidx * 6144 + col0;
        pg8::f32x4 gv[2][2];
#pragma unroll
        for (int bj = 0; bj < 2; ++bj)
#pragma unroll
            for (int n = 0; n < 2; ++n) gv[bj][n] = *(const pg8::f32x4*)(g + bj * 128 + n * 16) * sc;
#pragma unroll
        for (int ai = 0; ai < 2; ++ai)
#pragma unroll
            for (int m = 0; m < 4; ++m) { const size_t off = (rbase + ai * 128 + m * 16) * 1024 + col0;
#pragma unroll
                for (int bj = 0; bj < 2; ++bj)
#pragma unroll
                    for (int n = 0; n < 2; ++n) { const pg8::f32x4 xv = *(const pg8::f32x4*)(xi + off + bj * 128 + n * 16);
                        *(pg8::f32x4*)(xo + off + bj * 128 + n * 16) = xv + gv[bj][n] * acc[ai][bj][m][n]; }
                asm volatile("" ::: "memory"); }
    }
};
struct EpiGlu {
    static constexpr bool PERM = true, AFTER_DRAIN = false;
    const bf16* Z; bf16* Y; const float* bias;
    __device__ __forceinline__ void operator()(const pg8::f32x4 (&acc)[2][2][4][2], const pg8::Unit& u, int wr, int wc, int fr, int fq) const {
        const int row0 = u.pm * 256 + wr * 64 + fr, col0 = wc * 32 + 8 * fq;
#pragma unroll
        for (int ai = 0; ai < 2; ++ai)
#pragma unroll
            for (int m = 0; m < 4; ++m) { const size_t row = (size_t)(row0 + ai * 128 + m * 16);
#pragma unroll
                for (int bj = 0; bj < 2; ++bj) { const int col = col0 + bj * 128;
                    const pg8::u32x4 zz = *(const pg8::u32x4*)(Z + row * 256 + col);
                    const pg8::f32x4 b0 = *(const pg8::f32x4*)(bias + col), b1 = *(const pg8::f32x4*)(bias + col + 4);
                    const pg8::f32x4 v0 = acc[ai][bj][m][0] + b0, v1 = acc[ai][bj][m][1] + b1;
                    float o[8]; const unsigned zw[4] = {zz.x, zz.y, zz.z, zz.w};
#pragma unroll
                    for (int j = 0; j < 4; ++j) { const float zl = __uint_as_float(zw[j] << 16), zh = __uint_as_float(zw[j] & 0xffff0000u);
                        const float a0 = (j < 2) ? v0[2 * j] : v1[2 * j - 4], a1 = (j < 2) ? v0[2 * j + 1] : v1[2 * j - 3];
                        o[2 * j] = zl * sigm(a0); o[2 * j + 1] = zh * sigm(a1); }
                    pg8::u32x4 w; w.x = pg8::cvt_pk_bf16(o[0], o[1]); w.y = pg8::cvt_pk_bf16(o[2], o[3]); w.z = pg8::cvt_pk_bf16(o[4], o[5]); w.w = pg8::cvt_pk_bf16(o[6], o[7]);
                    *(pg8::u32x4*)(Y + row * 1024 + 256 + col) = w; }
                asm volatile("" ::: "memory"); }
    }
};
struct MoeOrder {
    int tp[9]; int nN, G, c, total;
    __device__ __forceinline__ void init(const unsigned* cnt, int nN_, int G_, int c_) {
        tp[0] = 0;
#pragma unroll
        for (int e = 0; e < 8; ++e) tp[e + 1] = tp[e] + (int)(((unsigned)__builtin_amdgcn_readfirstlane((int)__hip_atomic_load(cnt + e * 64, __ATOMIC_RELAXED, __HIP_MEMORY_SCOPE_AGENT)) + 255u) >> 8);
        nN = nN_; G = G_; c = c_; total = tp[8] * nN;
    }
    __device__ __forceinline__ bool next(int i, pg8::Unit& u) const {
        const int L = i * G + c; if (L >= total) return false;
        const int t = L / nN, pn = L - t * nN; int e = 0;
#pragma unroll
        for (int k = 1; k < 8; ++k) e += (t >= tp[k]) ? 1 : 0;
        u.pm = t; u.pn = e * nN + pn; u.pc = pn; return true;
    }
    __device__ __forceinline__ void a_ready(const pg8::Unit&) const {}
    __device__ __forceinline__ void done(const pg8::Unit&) const {}
};

__device__ __forceinline__ void cvt_item(const float* W, int K, int N, bf16* WT, int mode, int add, LAS float* scr, int item, int lane, int nblk_override = 0) {
    const int nblk = nblk_override ? nblk_override : (N >> 5), kb = item / nblk, nb = item - kb * nblk, k0 = 64 * kb, n0 = 32 * nb;
    const int r = lane >> 3, c4 = lane & 7;
    f32x4 v[8];
#pragma unroll
    for (int i = 0; i < 8; ++i) v[i] = *(const f32x4*)(W + (size_t)(k0 + 8 * i + r) * N + n0 + 4 * c4);
#pragma unroll
    for (int i = 0; i < 8; ++i) {
#pragma unroll
        for (int j = 0; j < 4; ++j) scr[(8 * i + r) * 33 + 4 * c4 + j] = v[i][j]; }
    LDS_WAIT();
    const int c = lane & 7;
#pragma unroll
    for (int j = 0; j < 4; ++j) { const int n = (lane >> 3) + 8 * j; const LAS float* s = scr + (8 * c) * 33 + n;
        v4u o; o.x = pk2(s[0 * 33], s[1 * 33]); o.y = pk2(s[2 * 33], s[3 * 33]); o.z = pk2(s[4 * 33], s[5 * 33]); o.w = pk2(s[6 * 33], s[7 * 33]);
        const int nn = n0 + n; const int drow = (mode == 0) ? (nn + add) : (((nn >> 7) << 8) + (nn & 127) + add);
        *(v4u*)(WT + (size_t)drow * K + k0 + 8 * c) = o; }
    LDS_WAIT();
}
__device__ __forceinline__ void cvt_item_f8(const float* W, int K, int N, unsigned char* WT, int mode, int add, LAS float* scr, int item, int lane) {
    const int nblk = N >> 5, kb = item / nblk, nb = item - kb * nblk, k0 = 64 * kb, n0 = 32 * nb;
    const int r = lane >> 3, c4 = lane & 7;
    f32x4 v[8];
#pragma unroll
    for (int i = 0; i < 8; ++i) v[i] = *(const f32x4*)(W + (size_t)(k0 + 8 * i + r) * N + n0 + 4 * c4);
#pragma unroll
    for (int i = 0; i < 8; ++i) {
#pragma unroll
        for (int j = 0; j < 4; ++j) scr[(8 * i + r) * 33 + 4 * c4 + j] = v[i][j]; }
    LDS_WAIT();
    const int c = lane & 3;
#pragma unroll
    for (int j = 0; j < 2; ++j) { const int n = (lane >> 2) + 16 * j; const LAS float* s = scr + (16 * c) * 33 + n;
        unsigned w[4];
#pragma unroll
        for (int q = 0; q < 4; ++q) { unsigned x = 0u;
            x = __builtin_amdgcn_cvt_pk_fp8_f32(s[(4 * q) * 33] * WSC8, s[(4 * q + 1) * 33] * WSC8, x, false);
            x = __builtin_amdgcn_cvt_pk_fp8_f32(s[(4 * q + 2) * 33] * WSC8, s[(4 * q + 3) * 33] * WSC8, x, true); w[q] = x; }
        v4u o; o.x = w[0]; o.y = w[1]; o.z = w[2]; o.w = w[3];
        const int nn = n0 + n; const int drow = (mode == 0) ? (nn + add) : (((nn >> 7) << 8) + (nn & 127) + add);
        *(v4u*)(WT + (size_t)drow * K + k0 + 16 * c) = o; }
    LDS_WAIT();
}
__device__ __forceinline__ void moe_cvt(const Frame& F, const Args& a, int j) {
    LAS float* scr = (LAS float*)(F.lds + F.wave * 16384);
    constexpr int IT = 1408;
    for (int it = F.gw; it < 8 * 3 * IT; it += F.NGW) {
        const int e = it / (3 * IT), r = it - e * 3 * IT, which = r / IT, item = r - which * IT;
        const size_t eo = ((size_t)j * 8 + e) * (size_t)(1024 * DFF);
        if (which == 0) cvt_item_f8(a.in[F.zz + I_MW1] + eo, 1024, DFF, F.ws + WS_W13M + (size_t)e * 5632 * 1024, 1, 0, scr, item, F.lane);
        else if (which == 1) cvt_item_f8(a.in[F.zz + I_MW3] + eo, 1024, DFF, F.ws + WS_W13M + (size_t)e * 5632 * 1024, 1, 128, scr, item, F.lane);
        else cvt_item_f8(a.in[F.zz + I_MW2] + eo, DFF, 1024, F.ws + WS_W2M + (size_t)e * 1024 * DFF, 0, 0, scr, item, F.lane);
    }
}
__device__ __forceinline__ void prologue(const Frame& F, const Args& a) {
    {
        LAS float* sc = (LAS float*)F.lds; LAS float* red = sc + 5120;
        for (int idx = F.tid; idx < 5120; idx += 512) { const int r = idx >> 10, k = idx & 1023; const float cv = (r < 4) ? a.in[F.zz + I_C][r * 1024 + k] : a.in[F.zz + I_CCTX][k]; sc[idx] = silu_f(cv); }
        __syncthreads();
        float* MOD = (float*)(F.ws + WS_MOD);
        for (int item = blockIdx.x; item < 384; item += F.G) {
            const int l = item / 96, nb = item - l * 96, cl = F.tid & 63, ks = F.tid >> 6, n = nb * 64 + cl;
            float acc[5] = {0.f, 0.f, 0.f, 0.f, 0.f};
            const float* wp = a.in[F.zz + I_ADAW] + ((size_t)l * 1024 + ks * 128) * 6144 + n;
#pragma unroll 16
            for (int kk = 0; kk < 128; ++kk) { const float w = wp[(size_t)kk * 6144];
#pragma unroll
                for (int r = 0; r < 5; ++r) acc[r] = fmaf(sc[r * 1024 + ks * 128 + kk], w, acc[r]); }
#pragma unroll
            for (int r = 0; r < 5; ++r) red[(ks * 5 + r) * 64 + cl] = acc[r];
            __syncthreads();
            if (F.tid < 320) { const int r = F.tid >> 6; float s = 0.f;
#pragma unroll
                for (int k2 = 0; k2 < 8; ++k2) s += red[(k2 * 5 + r) * 64 + cl];
                MOD[((size_t)l * 5 + r) * 6144 + n] = s + a.in[F.zz + I_ADAB][l * 6144 + n]; }
            __syncthreads();
        }
        if (blockIdx.x == 0 && F.tid < 256) {
            const float* lg = a.in[F.zz + I_LBL]; float x[4], mx = -3.0e38f;
#pragma unroll
            for (int l = 0; l < 4; ++l) { x[l] = lg[l * 256 + F.tid]; mx = fmaxf(mx, x[l]); }
            float s = 0.f;
#pragma unroll
            for (int l = 0; l < 4; ++l) { x[l] = expf(x[l] - mx); s += x[l]; }
            float cs = 0.f; const float sm0 = x[0] / s; float* LB = (float*)(F.ws + WS_LB);
#pragma unroll
            for (int l = 0; l < 4; ++l) { cs += x[l] / s; LB[l * 256 + F.tid] = fminf(fmaxf(cs - sm0, 0.f), 1.0f - 1e-6f); }
        }
        if (blockIdx.x == (1 % F.G)) {
            float* RC = (float*)(F.ws + WS_ROPE); float* RS = RC + 2048;
            for (int idx = F.tid; idx < 2048; idx += 512) { const int pos = idx >> 4, i = idx & 15;
                const float fr = powf(10000.0f, -(float)i / 16.0f); const float ang = (float)pos * fr; RC[idx] = cosf(ang); RS[idx] = sinf(ang); }
        }
        __syncthreads();
    }
    LAS float* scr = (LAS float*)(F.lds + F.wave * 16384);
    constexpr int I_IN = 16 * 104, I_OUT = 16 * 32, I_F = 1408, I_GL = 4 * 8;
    constexpr int NIT = 4 * I_IN + 4 * I_OUT + 6 * I_F + 4 * I_GL;
    for (int it = F.gw; it < NIT; it += F.NGW) {
        int r = it;
        if (r < 4 * I_IN) { const int l = r / I_IN; cvt_item(a.in[F.zz + I_WIN] + (size_t)l * 1024 * DIN, 1024, DIN, (bf16*)(F.ws + WS_WIN) + (size_t)l * DINP * 1024, 0, 0, scr, r - l * I_IN, F.lane, 104); continue; } r -= 4 * I_IN;
        if (r < 4 * I_OUT) { const int l = r / I_OUT; cvt_item(a.in[F.zz + I_WOUT] + (size_t)l * 1024 * 1024, 1024, 1024, (bf16*)(F.ws + WS_WOUT) + (size_t)l * 1024 * 1024, 0, 0, scr, r - l * I_OUT, F.lane); continue; } r -= 4 * I_OUT;
        if (r < 6 * I_F) { const int j = r / (3 * I_F), r2 = r - j * 3 * I_F, which = r2 / I_F, item = r2 - which * I_F; const size_t wo = (size_t)j * 1024 * DFF;
            if (which == 0) cvt_item(a.in[F.zz + I_FW1] + wo, 1024, DFF, (bf16*)(F.ws + WS_W13D) + (size_t)j * 5632 * 1024, 1, 0, scr, item, F.lane);
            else if (which == 1) cvt_item(a.in[F.zz + I_FW3] + wo, 1024, DFF, (bf16*)(F.ws + WS_W13D) + (size_t)j * 5632 * 1024, 1, 128, scr, item, F.lane);
            else cvt_item(a.in[F.zz + I_FW2] + wo, DFF, 1024, (bf16*)(F.ws + WS_W2D) + (size_t)j * 1024 * DFF, 0, 0, scr, item, F.lane);
            continue; } r -= 6 * I_F;
        { const int l = r / I_GL; cvt_item(a.in[F.zz + I_GLUW] + (size_t)l * 65536, 256, 256, (bf16*)(F.ws + WS_GLUW) + (size_t)l * 65536, 0, 0, scr, r - l * I_GL, F.lane); }
    }
    moe_cvt(F, a, 0);
    for (int i = blockIdx.x * 512 + F.tid; i < 4 * 256 * 128; i += F.G * 512) {
        const int l = i >> 15, rem = i & 32767, n = rem >> 7, k0 = (rem & 127) * 8, d = n >> 7, cidx = n & 127;
        const float* wa = a.in[F.zz + I_WA2] + ((size_t)(l * 2 + d) * 16) * 128 + cidx;
        float acc[8] = {0.f, 0.f, 0.f, 0.f, 0.f, 0.f, 0.f, 0.f};
#pragma unroll
        for (int r = 0; r < 16; ++r) { const float w2 = wa[r * 128];
#pragma unroll
            for (int kk = 0; kk < 8; ++kk) acc[kk] = fmaf(a.in[F.zz + I_WIN][((size_t)l * 1024 + k0 + kk) * DIN + 3328 + 16 * d + r], w2, acc[kk]); }
        v4u o; o.x = pk2(acc[0], acc[1]); o.y = pk2(acc[2], acc[3]); o.z = pk2(acc[4], acc[5]); o.w = pk2(acc[6], acc[7]);
        *(v4u*)((bf16*)(F.ws + WS_WIN) + ((size_t)l * DINP + 3328 + n) * 1024 + k0) = o;
    }
}

struct MoeTp { int tp[9]; };
__device__ __forceinline__ void load_tp(MoeTp& t, const unsigned* cnt) {
    t.tp[0] = 0;
#pragma unroll
    for (int e = 0; e < 8; ++e) t.tp[e + 1] = t.tp[e] + (int)(((unsigned)__builtin_amdgcn_readfirstlane((int)__hip_atomic_load(cnt + e * 64, __ATOMIC_RELAXED, __HIP_MEMORY_SCOPE_AGENT)) + 255u) >> 8);
}
template <int MODE>
__device__ __forceinline__ void norm_phase(const Frame& F, const Args& a, int l, int which  , int nrows, int comb_l  ) {
    const float* MOD = (const float*)(F.ws + WS_MOD);
    const float* nw = (MODE == 2) ? a.in[F.zz + I_FINW] : ((which ? a.in[F.zz + I_N2W] : a.in[F.zz + I_N1W]) + l * 1024);
    bf16* XN = (bf16*)(F.ws + WS_ACT);
    float* hb = (float*)(F.ws + WS_HB);
    const int* EP = (const int*)(F.ws + WS_LIST) + 8 * MT; const float* GATE = (const float*)(F.ws + WS_LIST) + 10 * MT;
    const bf16* YM = (const bf16*)(F.ws + WS_X2);
    const bool from_input = (l == 0 && which == 0 && MODE != 2);
    MoeTp ctp; if (comb_l >= 0) load_tp(ctp, (const unsigned*)F.ws + CW_CNT + (comb_l >> 1) * 8 * 64);
    const int jm = l >> 1;
    LAS float* rwl = (LAS float*)F.lds;
    if (MODE == 1) {
        const float* rw = a.in[F.zz + I_RW] + (size_t)jm * 8192;
        for (int idx = F.tid; idx < 8192; idx += 512) { const int k = idx >> 3, e = idx & 7; rwl[e * 1024 + k] = rw[idx]; }
        __syncthreads();
    }
    f32x4 wv[4];
#pragma unroll
    for (int j = 0; j < 4; ++j) wv[j] = *((const f32x4*)nw + F.lane + 64 * j);
    f32x4 vn[4]; int epn0 = 0, epn1 = 0; float gn0 = 0.f, gn1 = 0.f;
    { const int m = F.gw < nrows ? F.gw : 0; const bool isctx = m >= NLAT;
      const float* xr = from_input ? (isctx ? a.in[F.zz + I_CTX] + (size_t)(m - NLAT) * 1024 : a.in[F.zz + I_X] + (size_t)m * 1024) : (isctx ? hb + (size_t)(m - NLAT) * 1024 : F.out + (size_t)m * 1024);
#pragma unroll
      for (int j = 0; j < 4; ++j) vn[j] = *((const f32x4*)xr + F.lane + 64 * j);
      if (comb_l >= 0) { epn0 = EP[2 * m]; epn1 = EP[2 * m + 1]; gn0 = GATE[2 * m]; gn1 = GATE[2 * m + 1]; } }
    for (int m = F.gw; m < nrows; m += F.NGW) {
        const bool isctx = m >= NLAT; const int bidx = isctx ? 4 : (m >> 13);
        f32x4 v[4];
#pragma unroll
        for (int j = 0; j < 4; ++j) v[j] = vn[j];
        const int ep0 = epn0, ep1 = epn1; const float g0 = gn0, g1 = gn1;
        { const int mn = (m + F.NGW < nrows) ? m + F.NGW : m; const bool cn = mn >= NLAT;
          const float* xr = from_input ? (cn ? a.in[F.zz + I_CTX] + (size_t)(mn - NLAT) * 1024 : a.in[F.zz + I_X] + (size_t)mn * 1024) : (cn ? hb + (size_t)(mn - NLAT) * 1024 : F.out + (size_t)mn * 1024);
#pragma unroll
          for (int j = 0; j < 4; ++j) vn[j] = *((const f32x4*)xr + F.lane + 64 * j);
          if (comb_l >= 0) { epn0 = EP[2 * mn]; epn1 = EP[2 * mn + 1]; gn0 = GATE[2 * mn]; gn1 = GATE[2 * mn + 1]; } }
        if (comb_l >= 0) {
            int t0 = 0, t1 = 0;
#pragma unroll
            for (int e = 0; e < 8; ++e) { t0 = ((ep0 & 7) == e) ? ctp.tp[e] : t0; t1 = ((ep1 & 7) == e) ? ctp.tp[e] : t1; }
            const size_t d0 = (size_t)t0 * 256 + (ep0 >> 3), d1 = (size_t)t1 * 256 + (ep1 >> 3);
            const float* m5 = MOD + ((size_t)comb_l * 5 + bidx) * 6144 + 5 * 1024;
            float* xw = isctx ? hb + (size_t)(m - NLAT) * 1024 : F.out + (size_t)m * 1024;
#pragma unroll
            for (int j = 0; j < 4; ++j) {
                const v2u y0 = *((const v2u*)(YM + d0 * 1024) + F.lane + 64 * j), y1 = *((const v2u*)(YM + d1 * 1024) + F.lane + 64 * j);
                const f32x4 mm = *((const f32x4*)m5 + F.lane + 64 * j);
                f32x4 f0, f1;
                f0[0] = __uint_as_float(y0.x << 16); f0[1] = __uint_as_float(y0.x & 0xffff0000u); f0[2] = __uint_as_float(y0.y << 16); f0[3] = __uint_as_float(y0.y & 0xffff0000u);
                f1[0] = __uint_as_float(y1.x << 16); f1[1] = __uint_as_float(y1.x & 0xffff0000u); f1[2] = __uint_as_float(y1.y << 16); f1[3] = __uint_as_float(y1.y & 0xffff0000u);
                v[j] = v[j] + mm * (f0 * g0 + f1 * g1);
                if (MODE != 2) *((f32x4*)xw + F.lane + 64 * j) = v[j];
            }
        }
        float ss = 0.f;
#pragma unroll
        for (int j = 0; j < 4; ++j) ss += (v[j][0] * v[j][0] + v[j][1] * v[j][1]) + (v[j][2] * v[j][2] + v[j][3] * v[j][3]);
        ss = wave_sum(ss);
        const float rstd = 1.0f / sqrtf(ss * (1.0f / 1024.0f) + NEPS);
        if (MODE == 2) {
#pragma unroll
            for (int j = 0; j < 4; ++j) *((f32x4*)(F.out + (size_t)m * 1024) + F.lane + 64 * j) = v[j] * rstd * wv[j];
        } else {
            const float* sh = MOD + ((size_t)l * 5 + bidx) * 6144 + (which ? 3 : 0) * 1024; const float* scl = sh + 1024;
            f32x4 o[4];
#pragma unroll
            for (int j = 0; j < 4; ++j) { const f32x4 s1 = *((const f32x4*)scl + F.lane + 64 * j), s0 = *((const f32x4*)sh + F.lane + 64 * j);
                o[j] = (v[j] * rstd * wv[j]) * (s1 + 1.0f) + s0;
                if (MODE == 1) {
                    unsigned w8 = 0u; w8 = __builtin_amdgcn_cvt_pk_fp8_f32(fminf(fmaxf(o[j][0], -448.f), 448.f), fminf(fmaxf(o[j][1], -448.f), 448.f), w8, false);
                    w8 = __builtin_amdgcn_cvt_pk_fp8_f32(fminf(fmaxf(o[j][2], -448.f), 448.f), fminf(fmaxf(o[j][3], -448.f), 448.f), w8, true);
                    *((unsigned*)((unsigned char*)XN + (size_t)m * 1024) + F.lane + 64 * j) = w8;
                } else { v2u w; w.x = pk2(o[j][0], o[j][1]); w.y = pk2(o[j][2], o[j][3]);
                    *((v2u*)(XN + (size_t)m * 1024) + F.lane + 64 * j) = w; } }
            if (MODE == 1) {
                float p[8];
#pragma unroll
                for (int e = 0; e < 8; ++e) { float s = 0.f;
#pragma unroll
                    for (int j = 0; j < 4; ++j) { const f32x4 w4 = *((const LAS f32x4*)(rwl + e * 1024) + F.lane + 64 * j);
                        s += (o[j][0] * w4[0] + o[j][1] * w4[1]) + (o[j][2] * w4[2] + o[j][3] * w4[3]); }
                    p[e] = wave_sum(s) + a.in[F.zz + I_RB][jm * 8 + e]; }
                int e0 = 0; float v0 = p[0];
#pragma unroll
                for (int e = 1; e < 8; ++e) if (p[e] > v0) { v0 = p[e]; e0 = e; }
                int e1 = -1; float v1 = -3.0e38f;
#pragma unroll
                for (int e = 0; e < 8; ++e) if (e != e0 && p[e] > v1) { v1 = p[e]; e1 = e; }
                const float ex = expf(v1 - v0), g0 = 1.0f / (1.0f + ex), g1 = ex / (1.0f + ex);
                if (F.lane == 0) {
                    unsigned* cnt = (unsigned*)F.ws + CW_CNT + jm * 8 * 64; int* LIST = (int*)(F.ws + WS_LIST);
                    int* EPw = (int*)(F.ws + WS_LIST) + 8 * MT; float* GW = (float*)(F.ws + WS_LIST) + 10 * MT;
                    const unsigned p0 = __hip_atomic_fetch_add(cnt + e0 * 64, 1u, __ATOMIC_RELAXED, __HIP_MEMORY_SCOPE_AGENT);
                    const unsigned p1 = __hip_atomic_fetch_add(cnt + e1 * 64, 1u, __ATOMIC_RELAXED, __HIP_MEMORY_SCOPE_AGENT);
                    LIST[e0 * MT + p0] = m; LIST[e1 * MT + p1] = m;
                    EPw[2 * m] = e0 | (int)(p0 << 3); EPw[2 * m + 1] = e1 | (int)(p1 << 3);
                    GW[2 * m] = g0; GW[2 * m + 1] = g1;
                }
            }
        }
    }
    if (MODE == 1) __syncthreads();
}
__device__ __forceinline__ void moe_gather(const Frame& F, int jm) {
    const unsigned* cnt = (const unsigned*)F.ws + CW_CNT + jm * 8 * 64;
    MoeTp t; load_tp(t, cnt);
    int cn[8];
#pragma unroll
    for (int e = 0; e < 8; ++e) cn[e] = __builtin_amdgcn_readfirstlane((int)__hip_atomic_load(cnt + e * 64, __ATOMIC_RELAXED, __HIP_MEMORY_SCOPE_AGENT));
    const int rows = t.tp[8] * 256;
    const int* LIST = (const int*)(F.ws + WS_LIST); const v4u* XN = (const v4u*)(F.ws + WS_ACT); v4u* XB = (v4u*)(F.ws + WS_X2);
    for (int r = F.gw; r < rows; r += F.NGW) {
        const int tile = r >> 8; int e = 0, tpe = 0, ce = cn[0];
#pragma unroll
        for (int k = 1; k < 8; ++k) { const bool ge = tile >= t.tp[k]; e += ge ? 1 : 0; tpe = ge ? t.tp[k] : tpe; ce = ge ? cn[k] : ce; }
        const int pos = r - tpe * 256;
        v4u x0 = {0u, 0u, 0u, 0u};
        if (pos < ce) { const int src = LIST[e * MT + pos]; x0 = XN[(size_t)src * 64 + F.lane]; }
        XB[(size_t)r * 64 + F.lane] = x0;
    }
}
#define GLD(T, ubase, voff) (*(const T*)((const char*)(ubase) + (unsigned)(voff)))
#define GST(T, ubase, voff) (*(T*)((char*)(ubase) + (unsigned)(voff)))
__device__ __forceinline__ int fresh_lane() { int l; asm volatile("v_mbcnt_lo_u32_b32 %0, -1, 0\n\tv_mbcnt_hi_u32_b32 %0, -1, %0" : "=v"(l)); return l; }

struct MixP { const bf16* P; const float* lb; const float* rcos; const float* rsin; const float* ba; };
__device__ __forceinline__ int seg_row0(int b, int sg) { return sg < 4 ? NLAT + b * CTXL + sg * 64 : b * SEQ + (sg - 4) * 64; }
__device__ __forceinline__ int seg_tpos0(int sg) { return sg < 4 ? -1 : (sg - 4) * 64; }

struct S5P { const float *lam_re, *lam_im, *log_dt, *b_re, *b_im, *c_re, *c_im, *dd; };
__device__ __forceinline__ float gelu_tanh(float y) { const float t = 0.7978845608028654f * (y + 0.044715f * y * y * y); const float th = 1.0f - 2.0f / (1.0f + __expf(2.0f * t)); return 0.5f * y * (1.0f + th); }
template <int MODE>
__device__ __forceinline__ void s5_scan(const S5P& sp, const bf16* P, int b, int g, int dir, int sg, int lane, float& hre, float& him, LAS float* yf, LAS float* stg, bf16* Z) {
    const int row0 = seg_row0(b, sg); const int dg = dir * 16 + g;
    const float lre = sp.lam_re[dg * 64 + lane], lim = sp.lam_im[dg * 64 + lane], dt = expf(sp.log_dt[dg]);
    const float er = expf(lre * dt); const float sn = sinf(lim * dt), cs = cosf(lim * dt);
    const float ar = er * cs, ai = er * sn;
    const float nr = ar - 1.0f, ni = ai, den = lre * lre + lim * lim;
    const float cr = (nr * lre + ni * lim) / den, ci = (ni * lre - nr * lim) / den;
    float bbr[16], bbi[16], Cr[16], Ci[16];
#pragma unroll
    for (int c = 0; c < 16; ++c) { const float Br = sp.b_re[((size_t)dg * 64 + lane) * 16 + c], Bi = sp.b_im[((size_t)dg * 64 + lane) * 16 + c];
        bbr[c] = cr * Br - ci * Bi; bbi[c] = cr * Bi + ci * Br;
        Cr[c] = (MODE != 0) ? sp.c_re[((size_t)dg * 16 + c) * 64 + lane] : 0.f; Ci[c] = (MODE != 0) ? sp.c_im[((size_t)dg * 16 + c) * 64 + lane] : 0.f; }
    const int ch = ((lane >> 5) & 1) * 8 + ((lane >> 4) & 1) * 4 + ((lane >> 3) & 1) * 2 + ((lane >> 2) & 1);
    const float dv = (MODE == 2) ? sp.dd[g * 16 + ch] : 0.f;
    const bool b5 = lane & 32, b4 = lane & 16, b3 = lane & 8, b2 = lane & 4;
    const unsigned ucol = 2u * (unsigned)(C_S5 + g * 16 + (lane & 15));
    unsigned short rn0[4], rn1[4], rn2[4];
#pragma unroll
    for (int u = 0; u < 4; ++u) { rn0[u] = GLD(unsigned short, P + (size_t)(row0 + (dir ? 63 - u : u)) * DINP, ucol); rn1[u] = GLD(unsigned short, P + (size_t)(row0 + (dir ? 59 - u : 4 + u)) * DINP, ucol);
        rn2[u] = GLD(unsigned short, P + (size_t)(row0 + (dir ? 55 - u : 8 + u)) * DINP, ucol); }
#pragma unroll 1
    for (int i0 = 0; i0 < 64; i0 += 4) {
        unsigned short ru[4], rn3[4];
        const int ip = (i0 + 12 < 64) ? i0 + 12 : 60;
#pragma unroll
        for (int u = 0; u < 4; ++u) { ru[u] = rn0[u]; rn3[u] = GLD(unsigned short, P + (size_t)(row0 + (dir ? 63 - (ip + u) : (ip + u))) * DINP, ucol); }
#pragma unroll
        for (int u = 0; u < 4; ++u) stg[u * 64 + lane] = bf2f(ru[u]);
#pragma unroll
        for (int u = 0; u < 4; ++u) {
            const int ti = dir ? 63 - (i0 + u) : (i0 + u);
            const float uf = bf2f(ru[u]);
            float bur = 0.f, bui = 0.f;
#pragma unroll
            for (int c4 = 0; c4 < 4; ++c4) { const f32x4 ux = *(const LAS f32x4*)(stg + u * 64 + 4 * c4);
#pragma unroll
                for (int jj = 0; jj < 4; ++jj) { bur = fmaf(bbr[4 * c4 + jj], ux[jj], bur); bui = fmaf(bbi[4 * c4 + jj], ux[jj], bui); } }
            const float nre = ar * hre - ai * him + bur, nim = ar * him + ai * hre + bui;
            hre = nre; him = nim;
            if (MODE != 0) {
                float v[16];
#pragma unroll
                for (int c = 0; c < 16; ++c) v[c] = Cr[c] * hre - Ci[c] * him;
                float w8[8], w4[4], w2[2], w1;
#pragma unroll
                for (int i = 0; i < 8; ++i) { const float mine = b5 ? v[8 + i] : v[i], oth = b5 ? v[i] : v[8 + i]; w8[i] = mine + __shfl_xor(oth, 32); }
#pragma unroll
                for (int i = 0; i < 4; ++i) { const float mine = b4 ? w8[4 + i] : w8[i], oth = b4 ? w8[i] : w8[4 + i]; w4[i] = mine + __shfl_xor(oth, 16); }
#pragma unroll
                for (int i = 0; i < 2; ++i) { const float mine = b3 ? w4[2 + i] : w4[i], oth = b3 ? w4[i] : w4[2 + i]; w2[i] = mine + __shfl_xor(oth, 8); }
                { const float mine = b2 ? w2[1] : w2[0], oth = b2 ? w2[0] : w2[1]; w1 = mine + __shfl_xor(oth, 4); }
                w1 += __shfl_xor(w1, 2); w1 += __shfl_xor(w1, 1);
                if (MODE == 1) { if ((lane & 3) == 0) yf[ti * 16 + ch] = w1; }
                if (MODE == 2) {
                    const float uch = __shfl(uf, ch);
                    if ((lane & 3) == 0) { const float y = w1 + yf[ti * 16 + ch] + dv * uch; Z[(size_t)(row0 + ti) * 256 + g * 16 + ch] = (bf16)f2bf(gelu_tanh(y)); }
                }
            }
        }
#pragma unroll
        for (int u = 0; u < 4; ++u) { rn0[u] = rn1[u]; rn1[u] = rn2[u]; rn2[u] = rn3[u]; }
    }
}

__device__ __forceinline__ MixP make_mixp(const Frame& F, const Args& a, int l) {
    MixP mp; mp.P = (const bf16*)(F.ws + WS_PH); mp.lb = (const float*)(F.ws + WS_LB) + l * 256; mp.rcos = (const float*)(F.ws + WS_ROPE); mp.rsin = mp.rcos + 2048;
    mp.ba = a.in[F.zz + I_BA] + (size_t)l * 2 * 128; return mp;
}
__device__ __forceinline__ S5P make_s5p(const Frame& F, const Args& a, int l) {
    S5P sp; sp.lam_re = a.in[F.zz + I_LAMRE] + (size_t)l * 2048; sp.lam_im = a.in[F.zz + I_LAMIM] + (size_t)l * 2048; sp.log_dt = a.in[F.zz + I_LOGDT] + l * 32;
    sp.b_re = a.in[F.zz + I_BRE] + (size_t)l * 32768; sp.b_im = a.in[F.zz + I_BIM] + (size_t)l * 32768; sp.c_re = a.in[F.zz + I_CRE] + (size_t)l * 32768; sp.c_im = a.in[F.zz + I_CIM] + (size_t)l * 32768;
    sp.dd = a.in[F.zz + I_S5D] + l * 256; return sp;
}


typedef short bf16x8_t __attribute__((ext_vector_type(8)));
typedef float f32x16 __attribute__((ext_vector_type(16)));
typedef float f32x2_t __attribute__((ext_vector_type(2)));
typedef __bf16 bf16x2_n __attribute__((ext_vector_type(2)));
__device__ __forceinline__ unsigned pkbf(float lo, float hi) { const f32x2_t v = {lo, hi}; const bf16x2_n r = __builtin_convertvector(v, bf16x2_n); return __builtin_bit_cast(unsigned, r); }
constexpr int WL_QC = 0, WL_KC = 4608, WL_KT = 9216, WL_VT = 14336, WL_PL = 19456, WL_BYTES = 19712;

struct MxC { float gamma, lbv, oml, bav; unsigned cq, ck, cv, cz; };
template <int MIX>
__device__ __forceinline__ void mx_consts(MxC& c, const MixP& mp, int h, int dir, int lane) {
    c.gamma = 1.f; c.lbv = 0.f; c.oml = 1.f; c.bav = 0.f; c.cz = 0;
    if (MIX == 0) { c.cq = 2u * (unsigned)(C_RQ + h * 64 + lane); c.ck = 2u * (unsigned)(C_RK + h * 64 + lane); c.cv = 2u * (unsigned)(C_RV + h * 64 + lane); c.gamma = 1.0f - exp2f(-5.0f - (float)(dir ? 3 - h : h)); }
    else if (MIX == 1) { c.cq = 2u * (unsigned)(C_HQ + h * 64 + lane); c.ck = 2u * (unsigned)((dir ? C_HFB : C_HFF) + h * 64 + lane); c.cv = 2u * (unsigned)(C_HI + h * 64 + lane); c.lbv = mp.lb[h * 64 + lane]; c.oml = 1.0f - c.lbv; }
    else { c.cq = 2u * (unsigned)(C_GQ + h * 32 + (lane & 31)); c.ck = 2u * (unsigned)(C_GK + h * 32 + (lane & 31)); c.cv = 2u * (unsigned)(C_GV + h * 64 + lane); c.cz = 2u * (unsigned)((dir ? C_GZB : C_GZF) + h * 32 + (lane & 31));
        c.bav = mp.ba[dir * 128 + h * 32 + (lane & 31)]; }
}
struct MxRaw { unsigned short q[4], k[4], v[4], z[4]; };
template <int MIX, bool NEEDQ, int DIR>
__device__ __forceinline__ void mx_load(MxRaw& w, const MixP& mp, const MxC& c, int rows, int b) {
#pragma unroll
    for (int u = 0; u < 4; ++u) { const int cc = b * 4 + u; const bf16* pr = mp.P + (size_t)(rows + (DIR ? 63 - cc : cc)) * DINP;
        w.q[u] = NEEDQ ? GLD(unsigned short, pr, c.cq) : (unsigned short)0; w.k[u] = GLD(unsigned short, pr, c.ck); w.v[u] = GLD(unsigned short, pr, c.cv); w.z[u] = (MIX == 2) ? GLD(unsigned short, pr, c.cz) : (unsigned short)0; }
}
template <int MIX, bool NEEDQ, int DIR>
__device__ __forceinline__ void mx_batch(const MxRaw& cur, const MixP& mp, const MxC& c, int tposs  , int lane, LAS unsigned char* wl, int b, float& P) {
    constexpr int DK = (MIX == 2) ? 32 : 64;
    float kt[4], vv[4];
#pragma unroll
    for (int u = 0; u < 4; ++u) {
        const int cc = b * 4 + u, ts = DIR ? 63 - cc : cc, t = ts & 31;
        float q = bf2f(cur.q[u]), k, f; vv[DIR ? 3 - u : u] = bf2f(cur.v[u]);
        if (MIX == 0) {
            k = bf2f(cur.k[u]) * 0.125f; f = c.gamma;
            if (tposs >= 0) { const int tpos = tposs + ts; const int pos = (lane & 32) ? (tpos & 63) : (tpos >> 6);
                const unsigned ro = 4u * (unsigned)(pos * 16 + (lane & 15)); const float cs = GLD(float, mp.rcos, ro), sn = GLD(float, mp.rsin, ro);
                const float ss = (lane & 16) ? sn : -sn;
                const float kp = __shfl_xor(k, 16); k = fmaf(kp, ss, k * cs);
                if (NEEDQ) { const float qp = __shfl_xor(q, 16); q = fmaf(qp, ss, q * cs); } }
        } else if (MIX == 1) {
            const float z = bf2f(cur.k[u]); const float e = __expf(-z); const float sp = __builtin_amdgcn_rcpf(1.0f + e), sn = e * sp;
            f = fmaf(c.oml, sp, c.lbv); k = c.oml * sn;
        } else {
            k = bf2f(cur.k[u]) * 0.17677669529663687f; const float z = bf2f(cur.z[u]) + c.bav;
            const float ls = fminf(z, 0.f) - __logf(1.0f + __expf(-fabsf(z)));
            f = __expf(ls * 0.0625f);
        }
        P = fmaxf(P * f, 1e-30f);
        const float kk = k * __builtin_amdgcn_rcpf(P); kt[DIR ? 3 - u : u] = kk;
        if (lane < DK) {
            if (NEEDQ) *(LAS unsigned short*)(wl + WL_QC + t * 144 + lane * 2) = (unsigned short)f2bf(q * P);
            *(LAS unsigned short*)(wl + WL_KC + t * 144 + lane * 2) = (unsigned short)f2bf(kk);
        }
    }
    const int g4 = ((DIR ? 63 - b * 4 : b * 4) & 31) >> 2;
    v2u kp, vp; kp.x = pkbf(kt[0], kt[1]); kp.y = pkbf(kt[2], kt[3]); vp.x = pkbf(vv[0], vv[1]); vp.y = pkbf(vv[2], vv[3]);
    if (lane < DK) *(LAS v2u*)(wl + WL_KT + lane * 80 + g4 * 8) = kp;
    *(LAS v2u*)(wl + WL_VT + lane * 80 + g4 * 8) = vp;
}
typedef short bf16x4_t __attribute__((ext_vector_type(4)));
#define MFMA8(a, b, c) __builtin_amdgcn_mfma_f32_32x32x8bf16_1k((a), (b), (c), 0, 0, 0)
__device__ __forceinline__ bf16x4_t pack4(const f32x16& x, int s) {
    v2u p; p.x = pkbf(x[4 * s], x[4 * s + 1]); p.y = pkbf(x[4 * s + 2], x[4 * s + 3]);
    return __builtin_bit_cast(bf16x4_t, p);
}
__device__ __forceinline__ bf16x4_t ld4(const LAS unsigned char* p) { const v2u a = *(const LAS v2u*)p; return __builtin_bit_cast(bf16x4_t, a); }

template <int MODE, int DIR>
__device__ __forceinline__ void s5_mm_dir(const S5P& sp, const bf16* P, int b, int g, int sg, int lane, float& hre, float& him, LAS float* yf, LAS unsigned char* hs, bf16* Z) {
    const int m32 = lane & 31, hh = lane >> 5, dg = DIR * 16 + g, row0 = seg_row0(b, sg);
    float ar[2], ai[2], a2r[2], a2i[2], a3r[2], a3i[2], a4r[2], a4i[2];
    bf16x4_t bfr[4][2];
    const float dt = __expf(sp.log_dt[dg]);
#pragma unroll
    for (int sh = 0; sh < 2; ++sh) {
        const int p = 32 * sh + m32;
        const float lre = sp.lam_re[dg * 64 + p], lim = sp.lam_im[dg * 64 + p];
        const float er = __expf(lre * dt), sn = sinf(lim * dt), cs = cosf(lim * dt);
        ar[sh] = er * cs; ai[sh] = er * sn;
        a2r[sh] = ar[sh] * ar[sh] - ai[sh] * ai[sh]; a2i[sh] = ar[sh] * ai[sh] + ar[sh] * ai[sh];
        a3r[sh] = a2r[sh] * ar[sh] - a2i[sh] * ai[sh]; a3i[sh] = a2r[sh] * ai[sh] + a2i[sh] * ar[sh];
        a4r[sh] = a2r[sh] * a2r[sh] - a2i[sh] * a2i[sh]; a4i[sh] = a2r[sh] * a2i[sh] + a2r[sh] * a2i[sh];
        const float nr = ar[sh] - 1.0f, ni = ai[sh], den = 1.0f / (lre * lre + lim * lim);
        const float cr = (nr * lre + ni * lim) * den, ci = (ni * lre - nr * lim) * den;
#pragma unroll
        for (int s2 = 0; s2 < 2; ++s2) {
            const f32x4 Br = *(const f32x4*)(sp.b_re + ((size_t)dg * 64 + p) * 16 + 8 * s2 + 4 * hh), Bi = *(const f32x4*)(sp.b_im + ((size_t)dg * 64 + p) * 16 + 8 * s2 + 4 * hh);
            const f32x4 re = Br * cr - Bi * ci, im = Bi * cr + Br * ci;
            v2u pr, pi; pr.x = pkbf(re[0], re[1]); pr.y = pkbf(re[2], re[3]); pi.x = pkbf(im[0], im[1]); pi.y = pkbf(im[2], im[3]);
            bfr[sh][s2] = __builtin_bit_cast(bf16x4_t, pr); bfr[2 + sh][s2] = __builtin_bit_cast(bf16x4_t, pi);
        }
    }
    bf16x4_t cfr[16];
    if (MODE != 0) {
#pragma unroll
        for (int s = 0; s < 16; ++s) {
            const int p4 = (8 * s + 4 * hh) & 63; f32x4 cv = {0.f, 0.f, 0.f, 0.f};
            if (m32 < 16) cv = (s < 8) ? *(const f32x4*)(sp.c_re + ((size_t)dg * 16 + m32) * 64 + p4) : -*(const f32x4*)(sp.c_im + ((size_t)dg * 16 + m32) * 64 + p4);
            v2u pc; pc.x = pkbf(cv[0], cv[1]); pc.y = pkbf(cv[2], cv[3]); cfr[s] = __builtin_bit_cast(bf16x4_t, pc);
        }
    }
    const float ddv = (MODE == 2 && m32 < 16) ? sp.dd[g * 16 + m32] : 0.f;
    float hr[2], hi[2];
    hr[0] = __shfl(hre, m32); hi[0] = __shfl(him, m32); hr[1] = __shfl(hre, m32 + 32); hi[1] = __shfl(him, m32 + 32);
#pragma unroll 1
    for (int ci2 = 0; ci2 < 2; ++ci2) {
        const int ch = DIR ? 1 - ci2 : ci2, rowc = row0 + 32 * ch;
        const bf16* urow = P + (size_t)(rowc + m32) * DINP + C_S5 + g * 16 + 4 * hh;
        const bf16x4_t ua0 = __builtin_bit_cast(bf16x4_t, *(const v2u*)urow), ua1 = __builtin_bit_cast(bf16x4_t, *(const v2u*)(urow + 8));
        f32x16 BU[4];
#pragma unroll
        for (int nt = 0; nt < 4; ++nt) {
#pragma unroll
            for (int r = 0; r < 16; ++r) BU[nt][r] = 0.f;
            BU[nt] = MFMA8(ua0, bfr[nt][0], BU[nt]); BU[nt] = MFMA8(ua1, bfr[nt][1], BU[nt]);
        }
#pragma unroll
        for (int sh = 0; sh < 2; ++sh)
#pragma unroll
            for (int gg = 0; gg < 4; ++gg)
#pragma unroll
                for (int jj = 1; jj < 4; ++jj) {
                    const int r = DIR ? 4 * gg + 3 - jj : 4 * gg + jj, rp = DIR ? r + 1 : r - 1;
                    const float pr = BU[sh][rp], pi = BU[2 + sh][rp];
                    BU[sh][r] += ar[sh] * pr - ai[sh] * pi; BU[2 + sh][r] += ar[sh] * pi + ai[sh] * pr;
                }
        float hnr[2][4], hni[2][4];
#pragma unroll
        for (int st = 0; st < 8; ++st) {
            const int gg = DIR ? 3 - (st >> 1) : (st >> 1), turn = DIR ? 1 - (st & 1) : (st & 1), rl = DIR ? 4 * gg : 4 * gg + 3;
            const bool act = (hh == turn);
#pragma unroll
            for (int sh = 0; sh < 2; ++sh) {
                if (turn == (DIR ? 1 : 0)) { hnr[sh][gg] = hr[sh]; hni[sh][gg] = hi[sh]; }
                else { hnr[sh][gg] = act ? hr[sh] : hnr[sh][gg]; hni[sh][gg] = act ? hi[sh] : hni[sh][gg]; }
                const float outr = BU[sh][rl] + a4r[sh] * hr[sh] - a4i[sh] * hi[sh], outi = BU[2 + sh][rl] + a4r[sh] * hi[sh] + a4i[sh] * hr[sh];
                const float sr = __shfl_xor(outr, 32), si = __shfl_xor(outi, 32);
                hr[sh] = act ? outr : sr; hi[sh] = act ? outi : si;
            }
        }
        if (MODE != 0) {
#pragma unroll
            for (int sh = 0; sh < 2; ++sh)
#pragma unroll
                for (int gg = 0; gg < 4; ++gg)
#pragma unroll
                    for (int jj = 0; jj < 4; ++jj) {
                        const int pw = DIR ? 4 - jj : jj + 1;
                        const float pr = (pw == 1) ? ar[sh] : (pw == 2) ? a2r[sh] : (pw == 3) ? a3r[sh] : a4r[sh], pi = (pw == 1) ? ai[sh] : (pw == 2) ? a2i[sh] : (pw == 3) ? a3i[sh] : a4i[sh];
                        BU[sh][4 * gg + jj] += pr * hnr[sh][gg] - pi * hni[sh][gg]; BU[2 + sh][4 * gg + jj] += pr * hni[sh][gg] + pi * hnr[sh][gg];
                    }
#pragma unroll
            for (int nt = 0; nt < 4; ++nt)
#pragma unroll
                for (int r = 0; r < 16; ++r) *(LAS unsigned short*)(hs + ((r & 3) + 8 * (r >> 2) + 4 * hh) * 272 + (32 * nt + m32) * 2) = (unsigned short)f2bf(BU[nt][r]);
            f32x16 Yv;
#pragma unroll
            for (int r = 0; r < 16; ++r) Yv[r] = 0.f;
#pragma unroll
            for (int s = 0; s < 16; ++s) Yv = MFMA8(ld4(hs + m32 * 272 + (8 * s + 4 * hh) * 2), cfr[s], Yv);
            if (m32 < 16) {
#pragma unroll
                for (int r = 0; r < 16; ++r) {
                    const int tl = (r & 3) + 8 * (r >> 2) + 4 * hh;
                    if (MODE == 1) yf[(32 * ch + tl) * 16 + m32] = Yv[r];
                    else { const float u = bf2f(P[(size_t)(rowc + tl) * DINP + C_S5 + g * 16 + m32]);
                        const float y = Yv[r] + yf[(32 * ch + tl) * 16 + m32] + ddv * u;
                        Z[(size_t)(rowc + tl) * 256 + g * 16 + m32] = (bf16)f2bf(gelu_tanh(y)); }
                }
            }
        }
    }
    hre = hh ? hr[1] : hr[0]; him = hh ? hi[1] : hi[0];
}
template <int MODE>
__device__ __forceinline__ void s5_mm(const S5P& sp, const bf16* P, int b, int g, int dir, int sg, int lane, float& hre, float& him, LAS float* yf, LAS unsigned char* hs, bf16* Z) {
    if (dir) s5_mm_dir<MODE, 1>(sp, P, b, g, sg, lane, hre, him, yf, hs, Z); else s5_mm_dir<MODE, 0>(sp, P, b, g, sg, lane, hre, him, yf, hs, Z);
}
template <int MIX, int DIR, bool WITH_O>
__device__ __forceinline__ void mx_chunk(LAS unsigned char* wl, int lane, float Pl, f32x16 (&ST)[(MIX == 2) ? 1 : 2][2], f32x16 (&O)[2]) {
    constexpr int DK = (MIX == 2) ? 32 : 64, NRT = DK / 32;
    const int m32 = lane & 31, hh = lane >> 5;
    asm volatile("" ::: "memory");
    if (lane < DK) *(LAS float*)(wl + WL_PL + lane * 4) = Pl;
    asm volatile("" ::: "memory");
    if (WITH_O) {
        f32x16 x;
#pragma unroll
        for (int r = 0; r < 16; ++r) x[r] = 0.f;
#pragma unroll
        for (int s = 0; s < DK / 8; ++s) {
            const bf16x4_t ka = ld4(wl + WL_KC + m32 * 144 + (8 * s + 4 * hh) * 2);
            const bf16x4_t qb = ld4(wl + WL_QC + m32 * 144 + (8 * s + 4 * hh) * 2);
            x = MFMA8(ka, qb, x);
        }
#pragma unroll
        for (int r = 0; r < 16; ++r) { const int j = (r & 3) + 8 * (r >> 2) + 4 * hh; const bool keep = DIR ? (j >= m32) : (j <= m32); x[r] = keep ? x[r] : 0.f; }
#pragma unroll
        for (int t = 0; t < 2; ++t)
#pragma unroll
            for (int r = 0; r < 16; ++r) O[t][r] = 0.f;
#pragma unroll
        for (int s = 0; s < 4; ++s) {
            const bf16x4_t xa = pack4(x, s);
#pragma unroll
            for (int t = 0; t < 2; ++t) O[t] = MFMA8(xa, ld4(wl + WL_VT + (32 * t + m32) * 80 + (8 * s + 4 * hh) * 2), O[t]);
        }
#pragma unroll
        for (int rt = 0; rt < NRT; ++rt)
#pragma unroll
            for (int s = 0; s < 4; ++s) {
                const bf16x4_t qa = ld4(wl + WL_QC + m32 * 144 + (32 * rt + 8 * s + 4 * hh) * 2);
#pragma unroll
                for (int t = 0; t < 2; ++t) O[t] = MFMA8(qa, pack4(ST[rt][t], s), O[t]);
            }
    }
#pragma unroll
    for (int rt = 0; rt < NRT; ++rt)
#pragma unroll
        for (int s = 0; s < 4; ++s) {
            const bf16x4_t ka = ld4(wl + WL_KT + (32 * rt + m32) * 80 + (8 * s + 4 * hh) * 2);
#pragma unroll
            for (int t = 0; t < 2; ++t) ST[rt][t] = MFMA8(ka, ld4(wl + WL_VT + (32 * t + m32) * 80 + (8 * s + 4 * hh) * 2), ST[rt][t]);
        }
#pragma unroll
    for (int rt = 0; rt < NRT; ++rt)
#pragma unroll
        for (int g = 0; g < 4; ++g) {
            const f32x4 pl4 = *(const LAS f32x4*)(wl + WL_PL + (32 * rt + 8 * g + 4 * hh) * 4);
#pragma unroll
            for (int e = 0; e < 4; ++e) { ST[rt][0][4 * g + e] *= pl4[e]; ST[rt][1][4 * g + e] *= pl4[e]; }
        }
}
__device__ __forceinline__ float half_sum(float v) {
#pragma unroll
    for (int o = 1; o < 32; o <<= 1) v += __shfl_xor(v, o);
    return v;
}
template <int MIX, int DIR>
__device__ __forceinline__ void mixA_stream(const MixP& mp, const MxC& c, int row0, int tpos0, int lane, LAS unsigned char* wl, f32x16 (&ST)[(MIX == 2) ? 1 : 2][2], float& Gam) {
    f32x16 O[2];
    MxRaw r0, r1, r2;
    mx_load<MIX, false, DIR>(r0, mp, c, row0, 0); mx_load<MIX, false, DIR>(r1, mp, c, row0, 1); mx_load<MIX, false, DIR>(r2, mp, c, row0, 2);
    float P = 1.0f;
#pragma unroll 1
    for (int b = 0; b < 16; ++b) {
        MxRaw r3; mx_load<MIX, false, DIR>(r3, mp, c, row0, b < 13 ? b + 3 : 15);
        int ln = lane; asm volatile("" : "+v"(ln));
        mx_batch<MIX, false, DIR>(r0, mp, c, tpos0, ln, wl, b, P);
        if ((b & 7) == 7) { Gam *= P; mx_chunk<MIX, 0, false>(wl, ln, P, ST, O); P = 1.0f; }
        r0 = r1; r1 = r2; r2 = r3;
    }
}
template <int MIX>
__device__ __forceinline__ void mixA_unit(const MixP& mp, float* STG, int idx, int lane_in, LAS unsigned char* wl) {
    int lane = lane_in;
    constexpr int DK = (MIX == 2) ? 32 : 64, NRT = DK / 32;
    const int dir = idx / 2112, rem = idx - dir * 2112, bh = rem / NSEG, sg = rem - bh * NSEG, b = bh >> 2, h = bh & 3;
    asm volatile("" : "+v"(lane));
    MxC c; mx_consts<MIX>(c, mp, h, dir, lane);
    f32x16 ST[NRT][2];
#pragma unroll
    for (int rt = 0; rt < NRT; ++rt)
#pragma unroll
        for (int t = 0; t < 2; ++t)
#pragma unroll
            for (int r = 0; r < 16; ++r) ST[rt][t][r] = 0.f;
    const int row0 = seg_row0(b, sg), tpos0 = seg_tpos0(sg);
    float Gam = 1.0f;
    if (dir) mixA_stream<MIX, 1>(mp, c, row0, tpos0, lane, wl, ST, Gam); else mixA_stream<MIX, 0>(mp, c, row0, tpos0, lane, wl, ST, Gam);
    const size_t slot = (size_t)((dir * 16 + bh) * NSEG + sg);
    float* ds = STG + (MIX == 0 ? ST_DS0 : (MIX == 1 ? ST_DS1 : ST_DS2)) + slot * (DK * 64);
    const int m32 = lane & 31, hh = lane >> 5;
#pragma unroll
    for (int rt = 0; rt < NRT; ++rt)
#pragma unroll
        for (int t = 0; t < 2; ++t)
#pragma unroll
            for (int r = 0; r < 16; ++r) GST(float, ds + (32 * rt + (r & 3) + 8 * (r >> 2)) * 64 + 32 * t, 4u * (unsigned)(4 * hh * 64 + m32)) = ST[rt][t][r];
    float* gs = STG + (MIX == 0 ? ST_G0 : (MIX == 1 ? ST_G1 : ST_G2)) + slot * 64;
    GST(float, gs, 4u * (unsigned)lane) = Gam;
}
template <int MIX, int MODE>
__device__ __forceinline__ void mx_epilogue(const MixP& mp, LAS unsigned char* wl, int lane, const f32x16 (&O)[2], int rowc, float* OF, bf16* Y, int ocol, int ycol, int cgate, float nwv) {
    LAS float* ost = (LAS float*)(wl + WL_QC);
    const int m32 = lane & 31, hh = lane >> 5;
    asm volatile("" ::: "memory");
#pragma unroll
    for (int t = 0; t < 2; ++t)
#pragma unroll
        for (int r = 0; r < 16; ++r) ost[((r & 3) + 8 * (r >> 2) + 4 * hh) * 68 + 32 * t + m32] = O[t][r];
    asm volatile("" ::: "memory");
    if (MODE == 1) {
#pragma unroll 8
        for (int tk = 0; tk < 32; ++tk) GST(float, OF + (size_t)(rowc + tk) * 768 + ocol, 4u * (unsigned)lane) = ost[tk * 68 + lane];
    } else {
        float ofc[8]; unsigned short gc[8];
#pragma unroll
        for (int u = 0; u < 8; ++u) { ofc[u] = GLD(float, OF + (size_t)(rowc + u) * 768 + ocol, 4u * (unsigned)lane); gc[u] = GLD(unsigned short, mp.P + (size_t)(rowc + u) * DINP + cgate, 2u * (unsigned)lane); }
#pragma unroll 1
        for (int b8 = 0; b8 < 4; ++b8) {
            float ofn[8]; unsigned short gn[8]; const int nb = b8 < 3 ? b8 + 1 : 3;
#pragma unroll
            for (int u = 0; u < 8; ++u) { ofn[u] = GLD(float, OF + (size_t)(rowc + nb * 8 + u) * 768 + ocol, 4u * (unsigned)lane); gn[u] = GLD(unsigned short, mp.P + (size_t)(rowc + nb * 8 + u) * DINP + cgate, 2u * (unsigned)lane); }
#pragma unroll
            for (int u = 0; u < 8; ++u) {
                const int tk = b8 * 8 + u;
                const float o = ost[tk * 68 + lane] + ofc[u];
                float y;
                if (MIX == 0) { const float mean = wave_sum(o) * (1.0f / 64.0f); const float d = o - mean; y = d * (1.0f / sqrtf(wave_sum(d * d) * (1.0f / 64.0f) + NEPS)) * nwv; }
                else y = o * (1.0f / sqrtf(wave_sum(o * o) * (1.0f / 64.0f) + NEPS)) * nwv;
                y *= silu_f(bf2f(gc[u]));
                GST(unsigned short, Y + (size_t)(rowc + tk) * 1024 + ycol, 2u * (unsigned)lane) = (unsigned short)f2bf(y);
            }
#pragma unroll
            for (int u = 0; u < 8; ++u) { ofc[u] = ofn[u]; gc[u] = gn[u]; }
        }
    }
}
template <int MIX, int DIR>
__device__ __forceinline__ void mixC_stream(const MixP& mp, const MxC& c, int row0, int tpos0, int lane, LAS unsigned char* wl, f32x16 (&ST)[(MIX == 2) ? 1 : 2][2],
                                            float* OF, bf16* Y, int ocol, int ycol, int cgate, float nwv) {
    f32x16 O[2];
    MxRaw r0, r1;
    mx_load<MIX, true, DIR>(r0, mp, c, row0, 0); mx_load<MIX, true, DIR>(r1, mp, c, row0, 1);
    float P = 1.0f;
#pragma unroll 1
    for (int b = 0; b < 16; ++b) {
        MxRaw r2; mx_load<MIX, true, DIR>(r2, mp, c, row0, b < 14 ? b + 2 : 15);
        int ln = lane; asm volatile("" : "+v"(ln));
        mx_batch<MIX, true, DIR>(r0, mp, c, tpos0, ln, wl, b, P);
        if ((b & 7) == 7) {
            const int ch = DIR ? 1 - (b >> 3) : (b >> 3);
            mx_chunk<MIX, DIR, true>(wl, ln, P, ST, O); P = 1.0f;
            mx_epilogue<MIX, DIR ? 2 : 1>(mp, wl, ln, O, row0 + 32 * ch, OF, Y, ocol, ycol, cgate, nwv);
        }
        r0 = r1; r1 = r2;
    }
}
template <int MIX>
__device__ __forceinline__ void mixC_unit(const MixP& mp, const float* STG, int idx, int lane_in, float* OF, LAS unsigned char* wl, bf16* Y, const float* nw) {
    int lane = lane_in; asm volatile("" : "+v"(lane));
    constexpr int DK = (MIX == 2) ? 32 : 64, NRT = DK / 32;
    const int bh = idx / NSEG, sg = idx - bh * NSEG, b = bh >> 2, h = bh & 3;
    const int row0 = seg_row0(b, sg), tpos0 = seg_tpos0(sg);
    const int ocol = ((MIX == 0) ? 0 : (MIX == 1 ? 256 : 512)) + h * 64, ycol = ((MIX == 0) ? 0 : (MIX == 1 ? 512 : 768)) + h * 64;
    const int cgate = ((MIX == 0) ? C_RG : (MIX == 1 ? C_HG : C_GG)) + h * 64;
    const float* dsb = STG + (MIX == 0 ? ST_DS0 : (MIX == 1 ? ST_DS1 : ST_DS2));
    const float nwv = nw[h * 64 + lane];
    f32x16 ST[NRT][2];
#pragma unroll 1
    for (int dir = 0; dir < 2; ++dir) {
        asm volatile("" : "+v"(lane));
        const int m32 = lane & 31, hh = lane >> 5;
        MxC c; mx_consts<MIX>(c, mp, h, dir, lane);
        { const float* ds = dsb + (size_t)((dir * 16 + bh) * NSEG + sg) * (DK * 64);
#pragma unroll
          for (int rt = 0; rt < NRT; ++rt)
#pragma unroll
              for (int t = 0; t < 2; ++t)
#pragma unroll
                  for (int r = 0; r < 16; ++r) ST[rt][t][r] = GLD(float, ds + (32 * rt + (r & 3) + 8 * (r >> 2)) * 64 + 32 * t, 4u * (unsigned)(4 * hh * 64 + m32)); }
        if (dir == 0) mixC_stream<MIX, 0>(mp, c, row0, tpos0, lane, wl, ST, OF, Y, ocol, ycol, cgate, nwv);
        else mixC_stream<MIX, 1>(mp, c, row0, tpos0, lane, wl, ST, OF, Y, ocol, ycol, cgate, nwv);
        asm volatile("s_waitcnt vmcnt(0)" ::: "memory");
    }
}
template <int MSEL>
__device__ __forceinline__ void mix_passA(const Frame& F, const Args& a, int l) {
    const MixP mp = make_mixp(F, a, l); const S5P sp = make_s5p(F, a, l);
    float* ST = (float*)(F.ws + WS_X2);
    LAS unsigned char* wl = F.lds + F.wave * WL_BYTES; LAS float* stg = (LAS float*)wl;
    if (MSEL == 15) {
        for (int u = F.gw; u < 3 * 4224 + 2 * 64 * NSEG; u += F.NGW) {
            if (u < 4224) mixA_unit<0>(mp, ST, u, fresh_lane(), wl);
            else if (u < 2 * 4224) mixA_unit<1>(mp, ST, u - 4224, fresh_lane(), wl);
            else if (u < 3 * 4224) mixA_unit<2>(mp, ST, u - 2 * 4224, fresh_lane(), wl);
            else { const int idx = u - 3 * 4224; const int dir = idx / (64 * NSEG), rem = idx - dir * 64 * NSEG, bg = rem / NSEG, sg = rem - bg * NSEG;
                float hre = 0.f, him = 0.f;
                s5_mm<0>(sp, mp.P, bg >> 4, bg & 15, dir, sg, fresh_lane(), hre, him, nullptr, wl, nullptr);
                float* hs = ST + ST_HS + ((size_t)((dir * 64 + bg) * NSEG + sg) * 64 + fresh_lane()) * 2;
                hs[0] = hre; hs[1] = him; }
        }
        return;
    }
    if (MSEL & 1) for (int u = F.gw; u < 4224; u += F.NGW) mixA_unit<0>(mp, ST, u, fresh_lane(), wl);
    if (MSEL & 2) for (int u = F.gw; u < 4224; u += F.NGW) mixA_unit<1>(mp, ST, u, fresh_lane(), wl);
    if (MSEL & 4) for (int u = F.gw; u < 4224; u += F.NGW) mixA_unit<2>(mp, ST, u, fresh_lane(), wl);
    if (MSEL & 8) for (int idx = F.gw; idx < 2 * 64 * NSEG; idx += F.NGW) {
        const int dir = idx / (64 * NSEG), rem = idx - dir * 64 * NSEG, bg = rem / NSEG, sg = rem - bg * NSEG;
        float hre = 0.f, him = 0.f;
        s5_mm<0>(sp, mp.P, bg >> 4, bg & 15, dir, sg, fresh_lane(), hre, him, nullptr, wl, nullptr);
        float* hs = ST + ST_HS + ((size_t)((dir * 64 + bg) * NSEG + sg) * 64 + fresh_lane()) * 2;
        hs[0] = hre; hs[1] = him;
    }
}
__device__ __forceinline__ int chain_seg(int dir, int p) { return dir ? (p < 4 ? 3 - p : 135 - p) : p; }
__device__ __forceinline__ void mix_passB(const Frame& F, const Args& a, int l) {
    float* ST = (float*)(F.ws + WS_X2);
    constexpr int N0 = 131072, N1 = 131072, N2 = 65536, N3 = 8192;
    for (int e = blockIdx.x * 512 + F.tid; e < N0 + N1 + N2 + N3; e += F.G * 512) {
        if (e < N0 + N1 + N2) {
            float* base; const float* gb; int dir, esz;
            if (e < N0 + N1) { const int mix = e >= N0, e2 = e - mix * N0, c = e2 >> 12, el = e2 & 4095; dir = c >> 4; esz = 4096;
                base = ST + (mix ? ST_DS1 : ST_DS0) + (size_t)c * NSEG * 4096 + el; gb = ST + (mix ? ST_G1 : ST_G0) + (size_t)c * NSEG * 64 + (el >> 6); }
            else { const int e2 = e - N0 - N1, c = e2 >> 11, el = e2 & 2047; dir = c >> 4; esz = 2048;
                base = ST + ST_DS2 + (size_t)c * NSEG * 2048 + el; gb = ST + ST_G2 + (size_t)c * NSEG * 64 + (el >> 6); }
            float run = 0.f;
#pragma unroll 1
            for (int p0 = 0; p0 < NSEG; p0 += 12) {
                float d[12], gm[12];
#pragma unroll
                for (int q = 0; q < 12; ++q) { const int sg = chain_seg(dir, p0 + q); d[q] = base[(size_t)sg * esz]; gm[q] = gb[sg * 64]; }
#pragma unroll
                for (int q = 0; q < 12; ++q) { const int sg = chain_seg(dir, p0 + q); base[(size_t)sg * esz] = run; run = fmaf(gm[q], run, d[q]); }
            }
        } else {
            const int e2 = e - N0 - N1 - N2, c = e2 >> 6, p = e2 & 63, dir = c >> 6, g = c & 15;
            const int dg = dir * 16 + g;
            const float lre = a.in[F.zz + I_LAMRE][(size_t)l * 2048 + dg * 64 + p], lim = a.in[F.zz + I_LAMIM][(size_t)l * 2048 + dg * 64 + p], dt = expf(a.in[F.zz + I_LOGDT][l * 32 + dg]);
            const float er = expf(lre * dt * 64.0f); const float sn = sinf(lim * dt * 64.0f), cs = cosf(lim * dt * 64.0f);
            const float ar = er * cs, ai = er * sn;
            float* base = ST + ST_HS + ((size_t)c * NSEG * 64 + p) * 2;
            float rr = 0.f, ri = 0.f;
#pragma unroll 1
            for (int q0 = 0; q0 < NSEG; q0 += 12) {
                float dr[12], di[12];
#pragma unroll
                for (int q = 0; q < 12; ++q) { const int sg = chain_seg(dir, q0 + q); dr[q] = base[(size_t)sg * 128]; di[q] = base[(size_t)sg * 128 + 1]; }
#pragma unroll
                for (int q = 0; q < 12; ++q) { const int sg = chain_seg(dir, q0 + q); base[(size_t)sg * 128] = rr; base[(size_t)sg * 128 + 1] = ri;
                    const float nr = ar * rr - ai * ri + dr[q], ni = ar * ri + ai * rr + di[q]; rr = nr; ri = ni; }
            }
        }
    }
}
template <int MSEL>
__device__ __forceinline__ void mix_passC(const Frame& F, const Args& a, int l) {
    const MixP mp = make_mixp(F, a, l); const S5P sp = make_s5p(F, a, l);
    const float* ST = (const float*)(F.ws + WS_X2);
    LAS unsigned char* wl = F.lds + F.wave * WL_BYTES;
    LAS float* stg = (LAS float*)wl; LAS float* of = (LAS float*)(wl + 9216);
    float* OF = (float*)(F.ws + WS_OF);
    bf16* Y = (bf16*)(F.ws + WS_ACT); bf16* Z = (bf16*)(F.ws + WS_Z);
    const bool keep = l < DEPTH - 1;
    constexpr int NM = 16 * NSEG;
    if (MSEL == 15) {
        for (int u = F.gw; u < 3 * NM + 64 * NSEG; u += F.NGW) {
            const int sgu = (u < 3 * NM) ? (u % NSEG) : ((u - 3 * NM) % NSEG);
            if (!keep && sgu < 4) continue;
            if (u < NM) mixC_unit<0>(mp, ST, u, fresh_lane(), OF, wl, Y, a.in[F.zz + I_RETGN] + l * 256);
            else if (u < 2 * NM) mixC_unit<1>(mp, ST, u - NM, fresh_lane(), OF, wl, Y, a.in[F.zz + I_HGNW] + l * 256);
            else if (u < 3 * NM) mixC_unit<2>(mp, ST, u - 2 * NM, fresh_lane(), OF, wl, Y, a.in[F.zz + I_GLANW] + l * 256);
            else { const int idx = u - 3 * NM, bg = idx / NSEG, sg = idx - bg * NSEG;
                const float* h0 = ST + ST_HS + ((size_t)((0 * 64 + bg) * NSEG + sg) * 64 + fresh_lane()) * 2;
                float hre = h0[0], him = h0[1];
                s5_mm<1>(sp, mp.P, bg >> 4, bg & 15, 0, sg, fresh_lane(), hre, him, of, wl, Z);
                const float* h1 = ST + ST_HS + ((size_t)((1 * 64 + bg) * NSEG + sg) * 64 + fresh_lane()) * 2;
                hre = h1[0]; him = h1[1];
                s5_mm<2>(sp, mp.P, bg >> 4, bg & 15, 1, sg, fresh_lane(), hre, him, of, wl, Z); }
        }
        return;
    }
    if (MSEL & 1) for (int u = F.gw; u < NM; u += F.NGW) { if (!keep && (u % NSEG) < 4) continue; mixC_unit<0>(mp, ST, u, fresh_lane(), OF, wl, Y, a.in[F.zz + I_RETGN] + l * 256); }
    if (MSEL & 2) for (int u = F.gw; u < NM; u += F.NGW) { if (!keep && (u % NSEG) < 4) continue; mixC_unit<1>(mp, ST, u, fresh_lane(), OF, wl, Y, a.in[F.zz + I_HGNW] + l * 256); }
    if (MSEL & 4) for (int u = F.gw; u < NM; u += F.NGW) { if (!keep && (u % NSEG) < 4) continue; mixC_unit<2>(mp, ST, u, fresh_lane(), OF, wl, Y, a.in[F.zz + I_GLANW] + l * 256); }
    if (MSEL & 8) for (int idx = F.gw; idx < 64 * NSEG; idx += F.NGW) {
        const int bg = idx / NSEG, sg = idx - bg * NSEG;
        if (!keep && sg < 4) continue;
        const float* h0 = ST + ST_HS + ((size_t)((0 * 64 + bg) * NSEG + sg) * 64 + fresh_lane()) * 2;
        float hre = h0[0], him = h0[1];
        s5_mm<1>(sp, mp.P, bg >> 4, bg & 15, 0, sg, fresh_lane(), hre, him, of, wl, Z);
        const float* h1 = ST + ST_HS + ((size_t)((1 * 64 + bg) * NSEG + sg) * 64 + fresh_lane()) * 2;
        hre = h1[0]; him = h1[1];
        s5_mm<2>(sp, mp.P, bg >> 4, bg & 15, 1, sg, fresh_lane(), hre, him, of, wl, Z);
    }
}

constexpr int NPH = 11;
template <int PH_MASK, int MSEL>
__global__ void __launch_bounds__(512, 2) mk_fwd(Args a) {
    extern __shared__ __attribute__((aligned(16))) unsigned char lds_raw[];
    Frame F;
    F.lds = (LAS unsigned char*)lds_raw;
    const int wave0 = __builtin_amdgcn_readfirstlane((int)threadIdx.x >> 6);
    F.lane = fresh_lane(); F.tid = wave0 * 64 + F.lane; F.wave = wave0;
    F.G = gridDim.x; F.gw = blockIdx.x * 8 + F.wave; F.NGW = F.G * 8; F.zz = 0; F.ws = (unsigned char*)a.in[I_WS]; F.out = (float*)a.in[I_OUT];
    volatile LAS unsigned* MISC = (volatile LAS unsigned*)(F.lds + MISC_OFF);
    for (int u = F.tid; u < 64; u += 512) ((LAS unsigned*)(F.lds + MISC_OFF))[u] = 0u;
    __syncthreads();
    XcdBarrier bar; bar.bar = (unsigned*)F.ws + CW_BAR; bar.x = 0; bar.st = nullptr;
    if (a.fused) bar = xcd_barrier_post((unsigned*)F.ws + CW_BAR, MISC + 8, F.tid);
#define SEAM() do { if (a.fused) { XcdBarrier bb = bar; asm volatile("" : "+s"(bb.bar), "+s"(bb.x)); xcd_barrier(bb, wave0 * 64 + fresh_lane()); } } while (0)
#define PHASE_BEGIN() do { int zz_ = 0; asm volatile("" : "+s"(zz_)); F.zz = zz_; F.ws = (unsigned char*)a.in[I_WS + zz_]; F.out = (float*)a.in[I_OUT + zz_]; \
        const int ln_ = fresh_lane(); const int t_ = wave0 * 64 + ln_ + zz_; F.tid = t_; F.lane = t_ & 63; F.wave = wave0 + zz_; F.G = (int)gridDim.x + zz_; F.gw = ((int)blockIdx.x + zz_) * 8 + F.wave; F.NGW = F.G * 8; \
        F.lds = (LAS unsigned char*)lds_raw + zz_; } while (0)
#define IN(k) (((PH_MASK >> (k)) & 1) && a.ph_lo <= (k) && (k) < a.ph_hi)
#ifndef DUP_PH
#define DUP_PH 0
#endif
#define REP(k) for (int rep_ = 0; rep_ < (((DUP_PH >> (k)) & 1) ? 2 : 1); ++rep_)
#define hb ((float*)(F.ws + WS_HB))
#define MOD ((const float*)(F.ws + WS_MOD))
#define ACT ((bf16*)(F.ws + WS_ACT))
#define PH ((bf16*)(F.ws + WS_PH))

    if (((PH_MASK >> 12) & 1) && a.do_pro) REP(12) { PHASE_BEGIN(); prologue(F, a); SEAM(); }

#pragma unroll
    for (int l = 0; l < DEPTH; ++l) {
        if (l < a.l_lo || l >= a.l_hi) continue;
        const bool keep = l < DEPTH - 1, moe = l & 1; const int j = l >> 1;
        const int Mrows = keep ? MT : NLAT;
        if (IN(0)) for (int rep_ = 0; rep_ < ((((DUP_PH >> 0) & 1) && l != 2) ? 2 : 1); ++rep_) { PHASE_BEGIN();
            norm_phase<0>(F, a, l, 0, MT, (l == 2) ? 1 : -1);
            if (l == 2) { __syncthreads(); moe_cvt(F, a, 1); }
            SEAM();
        }
        if (IN(1)) REP(1) { PHASE_BEGIN();
            pg8::Gemm g{ACT, (const bf16*)(F.ws + WS_WIN) + (size_t)l * DINP * 1024, MT, DINP, 1024}; pg8::StaticOrder S; S.init(MT, DINP, F.G, (int)blockIdx.x);
            EpiStoreBf16 E{PH, DINP, 1.0f};
            pg8::gemm_phase<EpiStoreBf16, pg8::StaticOrder, true, true>(F.lds, g, S, E, F.tid);
            SEAM();
        }
        if (IN(2)) { PHASE_BEGIN(); mix_passA<MSEL>(F, a, l); SEAM(); }
#ifdef DUP_MIX
        if (IN(2)) { PHASE_BEGIN(); mix_passA<DUP_MIX>(F, a, l); SEAM(); }
#endif
        if (IN(3)) { PHASE_BEGIN(); mix_passB(F, a, l); SEAM(); }
        if (IN(4)) { PHASE_BEGIN(); mix_passC<MSEL>(F, a, l); SEAM(); }
#ifdef DUP_MIX
        if (IN(4)) { PHASE_BEGIN(); mix_passC<DUP_MIX>(F, a, l); SEAM(); }
#endif
        if (IN(5)) REP(5) { PHASE_BEGIN();
            int k256 = 256; asm volatile("" : "+s"(k256)); pg8::Gemm g{(const bf16*)(F.ws + WS_Z), (const bf16*)(F.ws + WS_GLUW) + (size_t)l * 65536, Mrows, 256, k256}; pg8::StaticOrder S; S.init(Mrows, 256, F.G, (int)blockIdx.x);
            EpiGlu E{(const bf16*)(F.ws + WS_Z), ACT, a.in[F.zz + I_GLUB] + l * 256};
            pg8::gemm_phase<EpiGlu, pg8::StaticOrder, true, true>(F.lds, g, S, E, F.tid);
            SEAM();
        }
        if (IN(6)) { PHASE_BEGIN();
            pg8::Gemm g{ACT, (const bf16*)(F.ws + WS_WOUT) + (size_t)l * 1024 * 1024, Mrows, 1024, 1024}; pg8::StaticOrder S; S.init(Mrows, 1024, F.G, (int)blockIdx.x);
            EpiResid E{(l == 0) ? a.in[F.zz + I_X] : F.out, (l == 0) ? a.in[F.zz + I_CTX] : hb, F.out, hb, MOD + (size_t)l * 5 * 6144 + 2 * 1024, 1.0f};
            pg8::gemm_phase<EpiResid, pg8::StaticOrder, true, true>(F.lds, g, S, E, F.tid);
            SEAM();
        }
        if (IN(7)) for (int rep_ = 0; rep_ < ((((DUP_PH >> 7) & 1) && !moe) ? 2 : 1); ++rep_) { PHASE_BEGIN();
            if (moe) norm_phase<1>(F, a, l, 1, Mrows, -1); else norm_phase<0>(F, a, l, 1, Mrows, -1);
            SEAM();
        }
        if (!moe) {
            if (IN(8)) REP(8) { PHASE_BEGIN();
                pg8::Gemm g{ACT, (const bf16*)(F.ws + WS_W13D) + (size_t)j * 5632 * 1024, Mrows, 5632, 1024}; pg8::StaticOrder S; S.init(Mrows, 5632, F.G, (int)blockIdx.x);
                EpiSwiglu E{PH};
                pg8::gemm_phase<EpiSwiglu, pg8::StaticOrder, true, true>(F.lds, g, S, E, F.tid);
                SEAM();
            }
            if (IN(9)) { PHASE_BEGIN();
                pg8::Gemm g{PH, (const bf16*)(F.ws + WS_W2D) + (size_t)j * 1024 * DFF, Mrows, 1024, DFF}; pg8::StaticOrder S; S.init(Mrows, 1024, F.G, (int)blockIdx.x);
                EpiResid E{F.out, hb, F.out, hb, MOD + (size_t)l * 5 * 6144 + 5 * 1024, 1.0f};
                pg8::gemm_phase<EpiResid, pg8::StaticOrder, true, true>(F.lds, g, S, E, F.tid);
                SEAM();
            }
        } else {
                        if (IN(8)) REP(8) { PHASE_BEGIN(); moe_gather(F, j); SEAM(); }
            if (IN(9)) REP(9) { PHASE_BEGIN();
                int k8 = 512; asm volatile("" : "+s"(k8)); pg8::Gemm g{(const bf16*)(F.ws + WS_X2), (const bf16*)(F.ws + WS_W13M), 0, 5632, k8}; MoeOrder S; S.init((const unsigned*)F.ws + CW_CNT + j * 8 * 64, 22, F.G, (int)blockIdx.x);
                EpiSwiglu8 E{(unsigned char*)PH, 1.0f / WSC8};
                pg8::gemm_phase_f8<EpiSwiglu8, MoeOrder, true, true>(F.lds, g, S, E, F.tid);
                SEAM();
            }
            if (IN(10)) REP(10) { PHASE_BEGIN();
                int k8 = DFF / 2; asm volatile("" : "+s"(k8)); pg8::Gemm g{PH, (const bf16*)(F.ws + WS_W2M), 0, 1024, k8}; MoeOrder S; S.init((const unsigned*)F.ws + CW_CNT + j * 8 * 64, 4, F.G, (int)blockIdx.x);
                EpiStoreBf16 E{(bf16*)(F.ws + WS_X2), 1024, 1.0f / WSC8};
                pg8::gemm_phase_f8<EpiStoreBf16, MoeOrder, true, true>(F.lds, g, S, E, F.tid);
                SEAM();
            }
        }
    }
    if (((PH_MASK >> 13) & 1) && a.do_fin) { PHASE_BEGIN(); norm_phase<2>(F, a, DEPTH - 1, 0, NLAT, DEPTH - 1); }
#undef SEAM
#undef IN
#undef hb
#undef MOD
#undef ACT
#undef PH
}

#ifndef MK_FUSED
#define MK_FUSED 1
#endif
template <int PM, int MS> static void launch_one(const Args& a, int grid, hipStream_t stream) {
    static bool attr_done = false;
    if (!attr_done) { (void)hipFuncSetAttribute((const void*)mk_fwd<PM, MS>, hipFuncAttributeMaxDynamicSharedMemorySize, LDS_BYTES); attr_done = true; }
    hipLaunchKernelGGL((mk_fwd<PM, MS>), dim3(grid), dim3(512), LDS_BYTES, stream, a);
}
extern "C" void kernel_launch(void* const* d_in, const int* in_sizes, int n_in, void* d_out, int out_size, void* d_ws, size_t ws_size, hipStream_t stream) {
    static int grid = 0;
    if (grid == 0) {
        if (n_in != 35 || in_sizes[0] != NLAT * DM || out_size != NLAT * DM || ws_size < WS_END) {
            fprintf(stderr, "kernel_launch: unexpected shapes / workspace (n_in %d, ws %zu, need %zu); nothing launched\n", n_in, ws_size, (size_t)WS_END); grid = -1; return; }
        int dev = 0, cus = 0;
        if (hipGetDevice(&dev) != hipSuccess || hipDeviceGetAttribute(&cus, hipDeviceAttributeMultiprocessorCount, dev) != hipSuccess) { grid = -1; return; }
        grid = cus;
    }
    if (grid < 0) return;
    (void)hipMemsetAsync((char*)d_ws + WS_CTL, 0, CTL_ZERO_BYTES, stream);
    Args a{};
    for (int i = 0; i < 35; ++i) a.in[i] = (const float*)d_in[i];
    a.in[I_OUT] = (const float*)d_out; a.in[I_WS] = (const float*)d_ws; a.pad = 0;
#if MK_FUSED
    a.l_lo = 0; a.l_hi = DEPTH; a.ph_lo = 0; a.ph_hi = NPH; a.do_pro = 1; a.do_fin = 1; a.fused = 1;
#ifndef TEST_PM
#define TEST_PM 0xFFFF
#endif
#ifndef TEST_MS
#define TEST_MS 15
#endif
    launch_one<TEST_PM, TEST_MS>(a, grid, stream);
#else
    a.fused = 0;
    a.l_lo = 0; a.l_hi = 0; a.ph_lo = 0; a.ph_hi = 0; a.do_pro = 1; a.do_fin = 0;
    launch_one<0x1000, 15>(a, grid, stream);
    a.do_pro = 0;
    for (int l = 0; l < DEPTH; ++l) {
        a.l_lo = l; a.l_hi = l + 1; a.ph_lo = 0; a.ph_hi = NPH;
        launch_one<0x1, 15>(a, grid, stream); launch_one<0x2, 15>(a, grid, stream); launch_one<0x4, 15>(a, grid, stream); launch_one<0x8, 15>(a, grid, stream);
        launch_one<0x10, 1>(a, grid, stream); launch_one<0x10, 2>(a, grid, stream); launch_one<0x10, 4>(a, grid, stream); launch_one<0x10, 8>(a, grid, stream);
        launch_one<0x20, 15>(a, grid, stream); launch_one<0x40, 15>(a, grid, stream); launch_one<0x80, 15>(a, grid, stream);
        launch_one<0x100, 15>(a, grid, stream); launch_one<0x200, 15>(a, grid, stream);
        if (l & 1) launch_one<0x400, 15>(a, grid, stream);
    }
    a.l_lo = 0; a.l_hi = 0; a.ph_lo = 0; a.ph_hi = 0; a.do_fin = 1;
    launch_one<0x2000, 15>(a, grid, stream);
#endif
}
```

```cpp
#include <hip/hip_runtime.h>
#include <cstdio>
#include <cstdint>
#define LAS __attribute__((address_space(3)))
namespace pg8 {
#define PG8_LAS __attribute__((address_space(3)))
typedef unsigned short bf16_t;
typedef short bf16x8 __attribute__((ext_vector_type(8)));
typedef float f32x4 __attribute__((ext_vector_type(4)));
typedef unsigned u32x4 __attribute__((ext_vector_type(4)));
constexpr int BM = 256, BK = 64, HALF = 128, HTB = HALF * BK * 2  , STAGE_BYTES = 8 * HTB, NXCD = 8, WGM = 8;

__host__ __device__ __forceinline__ int lds_byte(int r, int c) { const int st = (r >> 4) * 2 + (c >> 5), rr = r & 15, cc = c & 31, ob = rr * 64 + cc * 2; return st * 1024 + (ob ^ (((ob >> 9) & 1) << 5)); }
__host__ __device__ __forceinline__ void stage_rc(int b, int& R, int& C) { const int st = b / 1024, sb = b % 1024, swz = sb ^ (((sb >> 9) & 1) << 5); R = (st >> 1) * 16 + swz / 64; C = (st & 1) * 32 + (swz % 64) / 2; }
__host__ __device__ __forceinline__ int perm32(int rho) { const int n = rho >> 4, i = rho & 15; return 8 * (i >> 2) + 4 * n + (i & 3); }

struct Unit { int pm, pn, pc; };
struct Gemm { const bf16_t* A; const bf16_t* Bt; int M, N, K; };

struct StaticOrder {
    int nM, nN, nwg, G, c;
    __host__ __device__ void init(int M, int N, int G_, int c_) { nM = M / BM; nN = N / BM; nwg = nM * nN; G = G_; c = c_; }
    __host__ __device__ bool next(int i, Unit& u) const {
        const long L = (long)i * G + c; if (L >= nwg) return false;
        int wgid = (int)L; { const int q = nwg / NXCD, r = nwg % NXCD, xcd = wgid % NXCD, off = wgid / NXCD; wgid = (xcd < r ? xcd * (q + 1) : r * (q + 1) + (xcd - r) * q) + off; }
        const int nig = WGM * nN, gid = wgid / nig, fm = gid * WGM, gsz = (nM - fm) < WGM ? (nM - fm) : WGM;
        u.pm = fm + ((wgid % nig) % gsz); u.pn = (wgid % nig) / gsz; u.pc = u.pn; return true;
    }
    __device__ __forceinline__ void a_ready(const Unit&) const {}
    __device__ __forceinline__ void done(const Unit&) const {}
};

__device__ __forceinline__ unsigned cvt_pk_bf16(float lo, float hi) { unsigned r; asm volatile("v_cvt_pk_bf16_f32 %0, %1, %2" : "=v"(r) : "v"(lo), "v"(hi)); return r; }
typedef float f32x2 __attribute__((ext_vector_type(2)));

template <class Epi, class Sched, bool ALIGN_EPI = false, bool SP2 = false>
__device__ __forceinline__ void gemm_phase(PG8_LAS unsigned char* lds, const Gemm g, const Sched& S, const Epi& E, const int tid) {
    const int wid = __builtin_amdgcn_readfirstlane(tid >> 6), lane = tid & 63, wr = wid >> 2, wc = wid & 3, fr = lane & 15, fq = lane >> 4;
    const int K = g.K, nt = K / BK;
    unsigned voffA[2], voffB[2];
#pragma unroll
    for (int i = 0; i < 2; ++i) { int R, C; stage_rc(tid * 16 + i * 8192, R, C); const int Rb = Epi::PERM ? ((R & ~31) + perm32(R & 31)) : R;
        voffA[i] = (unsigned)(R * K + C) * 2u; voffB[i] = (unsigned)(Rb * K + C) * 2u; }
    const size_t kstep = (size_t)(BK * 2);
    const size_t hstep = (size_t)HALF * K * 2;
    const size_t tstep = 2 * hstep;
    const unsigned ldsw = (unsigned)wid * 1024u;
    const int aoff = lds_byte(wr * 64 + fr, fq * 8), boff = lds_byte(wc * 32 + fr, fq * 8);
#define PG8_SA(b, h) (((b) * 2 + (h)) * HTB)
#define PG8_SB(b, h) ((4 + (b) * 2 + (h)) * HTB)
#define PG8_STAGE(bufoff, gbase, voff) do { _Pragma("unroll") for (int _i = 0; _i < 2; ++_i) \
        __builtin_amdgcn_global_load_lds((const unsigned*)((const char*)(gbase) + (voff)[_i]), (PG8_LAS unsigned*)(lds + (bufoff) + ldsw + _i * 8192), 16, 0, 0); } while (0)
#define PG8_LDA(dst, b, h) do { _Pragma("unroll") for (int m = 0; m < 4; ++m) _Pragma("unroll") for (int k = 0; k < 2; ++k) dst[m][k] = *(const PG8_LAS bf16x8*)(lds + PG8_SA(b, h) + aoff + m * 2048 + k * 1024); } while (0)
#define PG8_LDB(dst, b, h) do { _Pragma("unroll") for (int n = 0; n < 2; ++n) _Pragma("unroll") for (int k = 0; k < 2; ++k) dst[n][k] = *(const PG8_LAS bf16x8*)(lds + PG8_SB(b, h) + boff + n * 2048 + k * 1024); } while (0)
#define PG8_MMA(ai, bj, At, Bt) do { __builtin_amdgcn_s_setprio(1); _Pragma("unroll") for (int m = 0; m < 4; ++m) _Pragma("unroll") for (int n = 0; n < 2; ++n) _Pragma("unroll") for (int k = 0; k < 2; ++k) \
        acc[ai][bj][m][n] = __builtin_amdgcn_mfma_f32_16x16x32_bf16(Bt[n][k], At[m][k], acc[ai][bj][m][n], 0, 0, 0); __builtin_amdgcn_s_setprio(0); } while (0)
#define PG8_WAIT_V(n) asm volatile("s_waitcnt vmcnt(" #n ")" ::: "memory")
#define PG8_WAIT_L(n) asm volatile("s_waitcnt lgkmcnt(" #n ")" ::: "memory")
#define PG8_BAR __builtin_amdgcn_s_barrier()
#define PG8_SCHED __builtin_amdgcn_sched_barrier(0)
    Unit cur, nxt; int ui = 0;
    if (!S.next(0, cur)) return;
    f32x4 acc[2][2][4][2];
#pragma unroll
    for (int a = 0; a < 2; ++a)
#pragma unroll
        for (int b = 0; b < 2; ++b)
#pragma unroll
            for (int m = 0; m < 4; ++m)
#pragma unroll
                for (int n = 0; n < 2; ++n) acc[a][b][m][n] = (f32x4){0.f, 0.f, 0.f, 0.f};
    bf16x8 At[4][2], B0[2][2], B1[2][2];
    const char* cA = (const char*)g.A + (size_t)cur.pm * tstep; const char* cB = (const char*)g.Bt + (size_t)cur.pn * tstep;
    S.a_ready(cur);
    if constexpr (SP2) {
        PG8_STAGE(PG8_SB(0, 0), cB, voffB); PG8_STAGE(PG8_SB(0, 1), cB + hstep, voffB); PG8_STAGE(PG8_SA(0, 0), cA, voffA); PG8_STAGE(PG8_SA(0, 1), cA + hstep, voffA);
        if (wr == 1) PG8_BAR;
        PG8_WAIT_V(2); PG8_BAR;
        PG8_STAGE(PG8_SB(1, 0), cB + kstep, voffB); PG8_STAGE(PG8_SA(1, 0), cA + kstep, voffA); PG8_STAGE(PG8_SB(1, 1), cB + hstep + kstep, voffB);
        PG8_WAIT_V(6); PG8_BAR;
    } else {
        PG8_STAGE(PG8_SB(0, 0), cB, voffB); PG8_STAGE(PG8_SA(0, 0), cA, voffA); PG8_STAGE(PG8_SB(0, 1), cB + hstep, voffB); PG8_STAGE(PG8_SA(0, 1), cA + hstep, voffA);
        if (wr == 1) PG8_BAR;
        PG8_WAIT_V(4); PG8_BAR;
        PG8_STAGE(PG8_SB(1, 0), cB + kstep, voffB); PG8_STAGE(PG8_SA(1, 0), cA + kstep, voffA); PG8_STAGE(PG8_SB(1, 1), cB + hstep + kstep, voffB);
        PG8_WAIT_V(6); PG8_BAR;
    }
    for (;;) {
        const bool has_next = S.next(ui + 1, nxt);
        const char* nA = has_next ? (const char*)g.A + (size_t)nxt.pm * tstep : cA; const char* nB = has_next ? (const char*)g.Bt + (size_t)nxt.pn * tstep : cB;
        for (int t = 0; t < nt; t += 2) {
            const bool last = (t == nt - 2);
            const char* a1 = cA + (size_t)(t + 1) * kstep;
            const char* a2 = last ? nA : cA + (size_t)(t + 2) * kstep; const char* b2 = last ? nB : cB + (size_t)(t + 2) * kstep;
            const char* a3 = a2 + kstep; const char* b3 = b2 + kstep;
            if (last && has_next) S.a_ready(nxt);
            if constexpr (SP2) {
            PG8_LDB(B0, 0, 0); PG8_LDB(B1, 0, 1); PG8_SCHED; PG8_LDA(At, 0, 0); PG8_STAGE(PG8_SA(1, 1), a1 + hstep, voffA);
            PG8_WAIT_V(8); PG8_WAIT_L(0); PG8_BAR; PG8_MMA(0, 0, At, B0); PG8_MMA(0, 1, At, B1); PG8_BAR; PG8_SCHED;
            PG8_LDA(At, 0, 1); PG8_STAGE(PG8_SB(0, 0), b2, voffB); PG8_STAGE(PG8_SB(0, 1), b2 + hstep, voffB); PG8_STAGE(PG8_SA(0, 0), a2, voffA);
            PG8_WAIT_V(8); PG8_WAIT_L(0); PG8_BAR; PG8_MMA(1, 0, At, B0); PG8_MMA(1, 1, At, B1); PG8_BAR; PG8_SCHED;
            PG8_LDB(B0, 1, 0); PG8_LDB(B1, 1, 1); PG8_SCHED; PG8_LDA(At, 1, 0); PG8_STAGE(PG8_SA(0, 1), a2 + hstep, voffA);
            PG8_WAIT_V(8); PG8_WAIT_L(0); PG8_BAR; PG8_MMA(0, 0, At, B0); PG8_MMA(0, 1, At, B1); PG8_BAR; PG8_SCHED;
            PG8_LDA(At, 1, 1); PG8_STAGE(PG8_SB(1, 0), b3, voffB); PG8_STAGE(PG8_SB(1, 1), b3 + hstep, voffB); PG8_STAGE(PG8_SA(1, 0), a3, voffA);
            PG8_WAIT_V(8); PG8_WAIT_L(0); PG8_BAR; PG8_MMA(1, 0, At, B0); PG8_MMA(1, 1, At, B1); PG8_BAR; PG8_SCHED;
            } else {
            PG8_LDB(B0, 0, 0); PG8_SCHED; PG8_LDA(At, 0, 0); PG8_STAGE(PG8_SA(1, 1), a1 + hstep, voffA);
            PG8_WAIT_L(8); PG8_BAR; PG8_WAIT_L(0); PG8_MMA(0, 0, At, B0); PG8_BAR; PG8_SCHED;
            PG8_LDB(B1, 0, 1); PG8_STAGE(PG8_SB(0, 0), b2, voffB);
            PG8_BAR; PG8_WAIT_L(0); PG8_MMA(0, 1, At, B1); PG8_BAR;
            PG8_LDA(At, 0, 1); PG8_STAGE(PG8_SA(0, 0), a2, voffA);
            PG8_BAR; PG8_WAIT_L(0); PG8_MMA(1, 0, At, B0); PG8_BAR; PG8_SCHED;
            PG8_STAGE(PG8_SB(0, 1), b2 + hstep, voffB);
            PG8_WAIT_V(6); PG8_BAR; PG8_MMA(1, 1, At, B1); PG8_BAR;
            PG8_LDB(B0, 1, 0); PG8_SCHED; PG8_LDA(At, 1, 0); PG8_STAGE(PG8_SA(0, 1), a2 + hstep, voffA);
            PG8_WAIT_L(8); PG8_BAR; PG8_WAIT_L(0); PG8_MMA(0, 0, At, B0); PG8_BAR; PG8_SCHED;
            PG8_LDB(B1, 1, 1); PG8_STAGE(PG8_SB(1, 0), b3, voffB);
            PG8_BAR; PG8_WAIT_L(0); PG8_MMA(0, 1, At, B1); PG8_BAR;
            PG8_LDA(At, 1, 1); PG8_STAGE(PG8_SA(1, 0), a3, voffA);
            PG8_BAR; PG8_WAIT_L(0); PG8_MMA(1, 0, At, B0); PG8_BAR; PG8_SCHED;
            PG8_STAGE(PG8_SB(1, 1), b3 + hstep, voffB);
            PG8_WAIT_V(6); PG8_BAR; PG8_MMA(1, 1, At, B1); PG8_BAR;
            }
        }
        if constexpr (ALIGN_EPI) { if (wr == 0) PG8_BAR; }
        if constexpr (!Epi::AFTER_DRAIN) { E(acc, cur, wr, wc, fr, fq); S.done(cur); }
        if (!has_next) break;
#pragma unroll
        for (int a = 0; a < 2; ++a)
#pragma unroll
            for (int b = 0; b < 2; ++b)
#pragma unroll
                for (int m = 0; m < 4; ++m)
#pragma unroll
                    for (int n = 0; n < 2; ++n) acc[a][b][m][n] = (f32x4){0.f, 0.f, 0.f, 0.f};
        cur = nxt; cA = nA; cB = nB; ++ui;
        if constexpr (ALIGN_EPI) { if (wr == 1) PG8_BAR; }
    }
    PG8_WAIT_V(0);
    if constexpr (!ALIGN_EPI) { if (wr == 0) PG8_BAR; }
    PG8_BAR;
    if constexpr (Epi::AFTER_DRAIN) { E.fused(acc, cur, wr, wc, fr, fq, lds, wid, lane); S.done(cur); }
#undef PG8_SA
#undef PG8_SB
#undef PG8_STAGE
#undef PG8_LDA
#undef PG8_LDB
#undef PG8_MMA
#undef PG8_WAIT_V
#undef PG8_WAIT_L
#undef PG8_BAR
#undef PG8_SCHED
}
typedef int v8i_t __attribute__((ext_vector_type(8)));
typedef int v4i_t __attribute__((ext_vector_type(4)));
template <class Epi, class Sched, bool ALIGN_EPI = false, bool SP2 = false>
__device__ __forceinline__ void gemm_phase_f8(PG8_LAS unsigned char* lds, const Gemm g, const Sched& S, const Epi& E, const int tid) {
    const int wid = __builtin_amdgcn_readfirstlane(tid >> 6), lane = tid & 63, wr = wid >> 2, wc = wid & 3, fr = lane & 15, fq = lane >> 4;
    const int K = g.K, nt = K / BK;
    unsigned voffA[2], voffB[2];
#pragma unroll
    for (int i = 0; i < 2; ++i) { int R, C; stage_rc(tid * 16 + i * 8192, R, C); const int Rb = Epi::PERM ? ((R & ~31) + perm32(R & 31)) : R;
        voffA[i] = (unsigned)(R * K + C) * 2u; voffB[i] = (unsigned)(Rb * K + C) * 2u; }
    const size_t kstep = (size_t)(BK * 2);
    const size_t hstep = (size_t)HALF * K * 2;
    const size_t tstep = 2 * hstep;
    const unsigned ldsw = (unsigned)wid * 1024u;
    const int aoff0 = lds_byte(wr * 64 + fr, fq * 16), aoff1 = lds_byte(wr * 64 + fr, fq * 16 + 8), boff0 = lds_byte(wc * 32 + fr, fq * 16), boff1 = lds_byte(wc * 32 + fr, fq * 16 + 8);
#define PG8_SA(b, h) (((b) * 2 + (h)) * HTB)
#define PG8_SB(b, h) ((4 + (b) * 2 + (h)) * HTB)
#define PG8_STAGE(bufoff, gbase, voff) do { _Pragma("unroll") for (int _i = 0; _i < 2; ++_i) \
        __builtin_amdgcn_global_load_lds((const unsigned*)((const char*)(gbase) + (voff)[_i]), (PG8_LAS unsigned*)(lds + (bufoff) + ldsw + _i * 8192), 16, 0, 0); } while (0)
#define PG8_LDA(dst, b, h) do { _Pragma("unroll") for (int m = 0; m < 4; ++m) { const u32x4 lo_ = *(const PG8_LAS u32x4*)(lds + PG8_SA(b, h) + aoff0 + m * 2048), hi_ = *(const PG8_LAS u32x4*)(lds + PG8_SA(b, h) + aoff1 + m * 2048); \
        dst[m] = __builtin_shufflevector((v4i_t)lo_, (v4i_t)hi_, 0, 1, 2, 3, 4, 5, 6, 7); } } while (0)
#define PG8_LDB(dst, b, h) do { _Pragma("unroll") for (int n = 0; n < 2; ++n) { const u32x4 lo_ = *(const PG8_LAS u32x4*)(lds + PG8_SB(b, h) + boff0 + n * 2048), hi_ = *(const PG8_LAS u32x4*)(lds + PG8_SB(b, h) + boff1 + n * 2048); \
        dst[n] = __builtin_shufflevector((v4i_t)lo_, (v4i_t)hi_, 0, 1, 2, 3, 4, 5, 6, 7); } } while (0)
#define PG8_MMA(ai, bj, At, Bt) do { __builtin_amdgcn_s_setprio(1); _Pragma("unroll") for (int m = 0; m < 4; ++m) _Pragma("unroll") for (int n = 0; n < 2; ++n) \
        asm volatile("v_mfma_scale_f32_16x16x128_f8f6f4 %0, %1, %2, %0, %3, %3 op_sel_hi:[0,0,0]" : "+v"(acc[ai][bj][m][n]) : "v"(Bt[n]), "v"(At[m]), "v"(one_scale)); __builtin_amdgcn_s_setprio(0); } while (0)
#define PG8_WAIT_V(n) asm volatile("s_waitcnt vmcnt(" #n ")" ::: "memory")
#define PG8_WAIT_L(n) asm volatile("s_waitcnt lgkmcnt(" #n ")" ::: "memory")
#define PG8_BAR __builtin_amdgcn_s_barrier()
#define PG8_SCHED __builtin_amdgcn_sched_barrier(0)
    Unit cur, nxt; int ui = 0;
    if (!S.next(0, cur)) return;
    f32x4 acc[2][2][4][2];
#pragma unroll
    for (int a = 0; a < 2; ++a)
#pragma unroll
        for (int b = 0; b < 2; ++b)
#pragma unroll
            for (int m = 0; m < 4; ++m)
#pragma unroll
                for (int n = 0; n < 2; ++n) acc[a][b][m][n] = (f32x4){0.f, 0.f, 0.f, 0.f};
    v8i_t At[4], B0[2], B1[2]; const int one_scale = 0x7f7f7f7f;
    const char* cA = (const char*)g.A + (size_t)cur.pm * tstep; const char* cB = (const char*)g.Bt + (size_t)cur.pn * tstep;
    S.a_ready(cur);
    if constexpr (SP2) {
        PG8_STAGE(PG8_SB(0, 0), cB, voffB); PG8_STAGE(PG8_SB(0, 1), cB + hstep, voffB); PG8_STAGE(PG8_SA(0, 0), cA, voffA); PG8_STAGE(PG8_SA(0, 1), cA + hstep, voffA);
        if (wr == 1) PG8_BAR;
        PG8_WAIT_V(2); PG8_BAR;
        PG8_STAGE(PG8_SB(1, 0), cB + kstep, voffB); PG8_STAGE(PG8_SA(1, 0), cA + kstep, voffA); PG8_STAGE(PG8_SB(1, 1), cB + hstep + kstep, voffB);
        PG8_WAIT_V(6); PG8_BAR;
    } else {
        PG8_STAGE(PG8_SB(0, 0), cB, voffB); PG8_STAGE(PG8_SA(0, 0), cA, voffA); PG8_STAGE(PG8_SB(0, 1), cB + hstep, voffB); PG8_STAGE(PG8_SA(0, 1), cA + hstep, voffA);
        if (wr == 1) PG8_BAR;
        PG8_WAIT_V(4); PG8_BAR;
        PG8_STAGE(PG8_SB(1, 0), cB + kstep, voffB); PG8_STAGE(PG8_SA(1, 0), cA + kstep, voffA); PG8_STAGE(PG8_SB(1, 1), cB + hstep + kstep, voffB);
        PG8_WAIT_V(6); PG8_BAR;
    }
    for (;;) {
        const bool has_next = S.next(ui + 1, nxt);
        const char* nA = has_next ? (const char*)g.A + (size_t)nxt.pm * tstep : cA; const char* nB = has_next ? (const char*)g.Bt + (size_t)nxt.pn * tstep : cB;
        for (int t = 0; t < nt; t += 2) {
            const bool last = (t == nt - 2);
            const char* a1 = cA + (size_t)(t + 1) * kstep;
            const char* a2 = last ? nA : cA + (size_t)(t + 2) * kstep; const char* b2 = last ? nB : cB + (size_t)(t + 2) * kstep;
            const char* a3 = a2 + kstep; const char* b3 = b2 + kstep;
            if (last && has_next) S.a_ready(nxt);
            if constexpr (SP2) {
            PG8_LDB(B0, 0, 0); PG8_LDB(B1, 0, 1); PG8_SCHED; PG8_LDA(At, 0, 0); PG8_STAGE(PG8_SA(1, 1), a1 + hstep, voffA);
            PG8_WAIT_V(8); PG8_WAIT_L(0); PG8_BAR; PG8_MMA(0, 0, At, B0); PG8_MMA(0, 1, At, B1); PG8_BAR; PG8_SCHED;
            PG8_LDA(At, 0, 1); PG8_STAGE(PG8_SB(0, 0), b2, voffB); PG8_STAGE(PG8_SB(0, 1), b2 + hstep, voffB); PG8_STAGE(PG8_SA(0, 0), a2, voffA);
            PG8_WAIT_V(8); PG8_WAIT_L(0); PG8_BAR; PG8_MMA(1, 0, At, B0); PG8_MMA(1, 1, At, B1); PG8_BAR; PG8_SCHED;
            PG8_LDB(B0, 1, 0); PG8_LDB(B1, 1, 1); PG8_SCHED; PG8_LDA(At, 1, 0); PG8_STAGE(PG8_SA(0, 1), a2 + hstep, voffA);
            PG8_WAIT_V(8); PG8_WAIT_L(0); PG8_BAR; PG8_MMA(0, 0, At, B0); PG8_MMA(0, 1, At, B1); PG8_BAR; PG8_SCHED;
            PG8_LDA(At, 1, 1); PG8_STAGE(PG8_SB(1, 0), b3, voffB); PG8_STAGE(PG8_SB(1, 1), b3 + hstep, voffB); PG8_STAGE(PG8_SA(1, 0), a3, voffA);
            PG8_WAIT_V(8); PG8_WAIT_L(0); PG8_BAR; PG8_MMA(1, 0, At, B0); PG8_MMA(1, 1, At, B1); PG8_BAR; PG8_SCHED;
            } else {
            PG8_LDB(B0, 0, 0); PG8_SCHED; PG8_LDA(At, 0, 0); PG8_STAGE(PG8_SA(1, 1), a1 + hstep, voffA);
            PG8_WAIT_L(8); PG8_BAR; PG8_WAIT_L(0); PG8_MMA(0, 0, At, B0); PG8_BAR; PG8_SCHED;
            PG8_LDB(B1, 0, 1); PG8_STAGE(PG8_SB(0, 0), b2, voffB);
            PG8_BAR; PG8_WAIT_L(0); PG8_MMA(0, 1, At, B1); PG8_BAR;
            PG8_LDA(At, 0, 1); PG8_STAGE(PG8_SA(0, 0), a2, voffA);
            PG8_BAR; PG8_WAIT_L(0); PG8_MMA(1, 0, At, B0); PG8_BAR; PG8_SCHED;
            PG8_STAGE(PG8_SB(0, 1), b2 + hstep, voffB);
            PG8_WAIT_V(6); PG8_BAR; PG8_MMA(1, 1, At, B1); PG8_BAR;
            PG8_LDB(B0, 1, 0); PG8_SCHED; PG8_LDA(At, 1, 0); PG8_STAGE(PG8_SA(0, 1), a2 + hstep, voffA);
            PG8_WAIT_L(8); PG8_BAR; PG8_WAIT_L(0); PG8_MMA(0, 0, At, B0); PG8_BAR; PG8_SCHED;
            PG8_LDB(B1, 1, 1); PG8_STAGE(PG8_SB(1, 0), b3, voffB);
            PG8_BAR; PG8_WAIT_L(0); PG8_MMA(0, 1, At, B1); PG8_BAR;
            PG8_LDA(At, 1, 1); PG8_STAGE(PG8_SA(1, 0), a3, voffA);
            PG8_BAR; PG8_WAIT_L(0); PG8_MMA(1, 0, At, B0); PG8_BAR; PG8_SCHED;
            PG8_STAGE(PG8_SB(1, 1), b3 + hstep, voffB);
            PG8_WAIT_V(6); PG8_BAR; PG8_MMA(1, 1, At, B1); PG8_BAR;
            }
        }
        if constexpr (ALIGN_EPI) { if (wr == 0) PG8_BAR; }
        asm volatile("s_nop 15\n\ts_nop 15" ::: "memory");
        if constexpr (!Epi::AFTER_DRAIN) { E(acc, cur, wr, wc, fr, fq); S.done(cur); }
        if (!has_next) break;
#pragma unroll
        for (int a = 0; a < 2; ++a)
#pragma unroll
            for (int b = 0; b < 2; ++b)
#pragma unroll
                for (int m = 0; m < 4; ++m)
#pragma unroll
                    for (int n = 0; n < 2; ++n) acc[a][b][m][n] = (f32x4){0.f, 0.f, 0.f, 0.f};
        cur = nxt; cA = nA; cB = nB; ++ui;
        if constexpr (ALIGN_EPI) { if (wr == 1) PG8_BAR; }
    }
    PG8_WAIT_V(0);
    if constexpr (!ALIGN_EPI) { if (wr == 0) PG8_BAR; }
    PG8_BAR;
    if constexpr (Epi::AFTER_DRAIN) { E.fused(acc, cur, wr, wc, fr, fq, lds, wid, lane); S.done(cur); }
#undef PG8_SA
#undef PG8_SB
#undef PG8_STAGE
#undef PG8_LDA
#undef PG8_LDB
#undef PG8_MMA
#undef PG8_WAIT_V
#undef PG8_WAIT_L
#undef PG8_BAR
#undef PG8_SCHED
}
}

#define XB_TMO      128
#define XB_XCNT(j)  (256  + 64 * (j))
#define XB_XSUB(j)  (1280 + 64 * (j))
#define XB_XGEN(j)  (2304 + 64 * (j))
#define XB_TOP      3328
#define XB_TOPGEN   3392
#define XCD_BAR_WORDS 3456
#define XB_SPIN_CAP (1u << 18)

__device__ __forceinline__ unsigned xb_ld(unsigned* p)              { return __hip_atomic_load(p, __ATOMIC_RELAXED, __HIP_MEMORY_SCOPE_AGENT); }
__device__ __forceinline__ unsigned xb_add(unsigned* p, unsigned v) { return __hip_atomic_fetch_add(p, v, __ATOMIC_RELAXED, __HIP_MEMORY_SCOPE_AGENT); }
__device__ __forceinline__ unsigned xb_xcc_id() { return (unsigned)__builtin_amdgcn_s_getreg((3 << 11) | 20) & 0xFu; }
#define XB_SPIN(cond, bar) do { unsigned _sp = 0; while (cond) { __builtin_amdgcn_s_sleep(1); \
    if ((++_sp & 255u) == 0u) { if (xb_ld(&(bar)[XB_TMO])) break; if (_sp > XB_SPIN_CAP) { atomicAdd(&(bar)[XB_TMO], 1u); break; } } } } while (0)

struct XcdBarrier {
    unsigned* bar; unsigned x;
    volatile LAS unsigned* st;
};

__device__ __forceinline__ XcdBarrier xcd_barrier_post(unsigned* bar, volatile LAS unsigned* st, const int xb_tid) {
    XcdBarrier b; b.bar = bar; b.x = xb_xcc_id(); b.st = st;
    if (xb_tid == 0) (void)xb_add(&bar[XB_XCNT(b.x)], 1u);
    return b;
}
__device__ __forceinline__ void xcd_barrier_complete(unsigned* bar, unsigned x, unsigned& nloc, unsigned& nx) {
    const unsigned G = gridDim.x * gridDim.y * gridDim.z;
    unsigned sum, cnt, mine, sp = 0u;
    for (;;) {
        sum = 0u; cnt = 0u; mine = 0u;
#pragma unroll
        for (unsigned j = 0; j < 16; ++j) { const unsigned c = xb_ld(&bar[XB_XCNT(j)]); sum += c; cnt += (c > 0u) ? 1u : 0u; mine = (j == x) ? c : mine; }
        if (sum == G) break;
        __builtin_amdgcn_s_sleep(1);
        if ((++sp & 255u) == 0u) { if (xb_ld(&bar[XB_TMO])) break; if (sp > XB_SPIN_CAP) { atomicAdd(&bar[XB_TMO], 1u); break; } }
    }
    nloc = mine > 0u ? mine : 1u; nx = cnt > 0u ? cnt : 1u;
}

__device__ __forceinline__ void xcd_barrier(const XcdBarrier& b, const int xb_tid) {
    asm volatile("s_waitcnt vmcnt(0)" ::: "memory");
    __syncthreads();
    if (xb_tid == 0) {
        unsigned* bar = b.bar;
        __builtin_amdgcn_s_waitcnt(0);
        unsigned nloc = b.st[0], nx = b.st[1];
        if (nloc == 0u) { xcd_barrier_complete(bar, b.x, nloc, nx); b.st[0] = nloc; b.st[1] = nx; }
        const unsigned old = xb_add(&bar[XB_XSUB(b.x)], 1u);
        const unsigned gen = old / nloc;
        if (old + 1u == (gen + 1u) * nloc) {
            __builtin_amdgcn_fence(__ATOMIC_RELEASE, "agent");
            asm volatile("s_waitcnt vmcnt(0)" ::: "memory");
            const unsigned og = xb_add(&bar[XB_TOP], 1u);
            const unsigned tg = og / nx;
            if (og + 1u == (tg + 1u) * nx) xb_add(&bar[XB_TOPGEN], 1u);
            else XB_SPIN(xb_ld(&bar[XB_TOPGEN]) == tg, bar);
            __builtin_amdgcn_fence(__ATOMIC_ACQUIRE, "agent");
            xb_add(&bar[XB_XGEN(b.x)], 1u);
            asm volatile("s_waitcnt vmcnt(0)" ::: "memory");
        } else {
            XB_SPIN(xb_ld(&bar[XB_XGEN(b.x)]) == gen, bar);
            __builtin_amdgcn_fence(__ATOMIC_ACQUIRE, "agent");
            asm volatile("s_waitcnt vmcnt(0)" ::: "memory");
        }
    }
    __syncthreads();
}

#define GAS __attribute__((address_space(1)))
typedef unsigned short bf16;
typedef unsigned v4u __attribute__((ext_vector_type(4)));
typedef unsigned v2u __attribute__((ext_vector_type(2)));
typedef float f32x4 __attribute__((ext_vector_type(4)));

constexpr int NB = 4, SEQ = 8192, DM = 1024, DEPTH = 4, CTXL = 256;
constexpr int NLAT = NB * SEQ, NCTX = NB * CTXL, MT = NLAT + NCTX;
constexpr int DIN = 3360, DINP = 3584, DFF = 2816, NEXP = 8;
constexpr int C_RQ = 0, C_RK = 256, C_RV = 512, C_RG = 768, C_S5 = 1024, C_HQ = 1280, C_HFF = 1536, C_HFB = 1792, C_HI = 2048, C_HG = 2304,
              C_GQ = 2560, C_GK = 2688, C_GV = 2816, C_GG = 3072, C_GAF = 3328, C_GAB = 3344,
              C_GZF = 3328, C_GZB = 3456;
constexpr int NSEG = 132;
constexpr int MOE_CAP_TILES = 272;
constexpr float NEPS = 1e-6f;
constexpr float WSC8 = 64.0f;

constexpr size_t MiB = 1u << 20;
constexpr size_t WS_CTL = 0, CTL_ZERO_BYTES = 2 * MiB;
constexpr size_t WS_MOD = 2 * MiB;
constexpr size_t WS_LB = 3 * MiB;
constexpr size_t WS_ROPE = 3 * MiB + 65536;
constexpr size_t WS_GLUW = 3 * MiB + 131072;
constexpr size_t WS_WIN = 4 * MiB;
constexpr size_t WS_WOUT = 32 * MiB;
constexpr size_t WS_W13D = 40 * MiB;
constexpr size_t WS_W2D = 62 * MiB;
constexpr size_t WS_W13M = 73 * MiB;
constexpr size_t WS_W2M = 161 * MiB;
constexpr size_t WS_HB = 205 * MiB;
constexpr size_t WS_ACT = 209 * MiB;
constexpr size_t WS_Z = 275 * MiB;
constexpr size_t WS_PH = 292 * MiB;
constexpr size_t WS_OF = (292 + 232) * MiB;
constexpr size_t WS_X2 = 666 * MiB;
constexpr size_t WS_LIST = 843 * MiB;
constexpr size_t WS_END = 846 * MiB;
constexpr size_t ST_DS0 = 0;
constexpr size_t ST_DS1 = ST_DS0 + (size_t)2 * 16 * NSEG * 4096;
constexpr size_t ST_DS2 = ST_DS1 + (size_t)2 * 16 * NSEG * 4096;
constexpr size_t ST_G0 = ST_DS2 + (size_t)2 * 16 * NSEG * 2048;
constexpr size_t ST_G1 = ST_G0 + (size_t)2 * 16 * NSEG * 64;
constexpr size_t ST_G2 = ST_G1 + (size_t)2 * 16 * NSEG * 64;
constexpr size_t ST_HS = ST_G2 + (size_t)2 * 16 * NSEG * 64;
constexpr size_t ST_END = ST_HS + (size_t)2 * 64 * NSEG * 128;
static_assert(ST_END * 4 <= (WS_LIST - WS_X2), "state region");
static_assert(WS_PH + (size_t)MT * DINP * 2 <= WS_OF && WS_OF + (size_t)MT * 768 * 4 <= WS_X2, "OF region");
static_assert((size_t)MOE_CAP_TILES * 256 * 1024 * 2 <= (WS_LIST - WS_X2), "XB region");
static_assert((size_t)MOE_CAP_TILES * 256 * DFF * 2 <= (WS_X2 - WS_PH) && (size_t)MT * DINP * 2 <= (WS_X2 - WS_PH), "P/H region");
constexpr int CW_BAR = 4096;
constexpr int CW_CNT = 16384;

constexpr int LDS_BYTES = 163840;
constexpr int MISC_OFF = 163840 - 512;

__device__ __forceinline__ float bf2f(unsigned short h) { return __uint_as_float(((unsigned)h) << 16); }
__device__ __forceinline__ unsigned f2bf(float f) { unsigned u = __float_as_uint(f); return (u + 0x7fffu + ((u >> 16) & 1u)) >> 16; }
__device__ __forceinline__ unsigned pk2(float lo, float hi) { return f2bf(lo) | (f2bf(hi) << 16); }
__device__ __forceinline__ float wave_sum(float v) {
#pragma unroll
    for (int o = 1; o < 64; o <<= 1) v += __shfl_xor(v, o);
    return v;
}
__device__ __forceinline__ float rdl(float v, int k) { return __uint_as_float((unsigned)__builtin_amdgcn_readlane((int)__float_as_uint(v), k)); }
__device__ __forceinline__ float sigm(float x) { return 1.0f / (1.0f + __expf(-x)); }
__device__ __forceinline__ float silu_f(float x) { return x / (1.0f + __expf(-x)); }
#define LDS_WAIT() asm volatile("s_waitcnt lgkmcnt(0)" ::: "memory")

struct Args {
    const float* in[37];
    int l_lo, l_hi, ph_lo, ph_hi, do_pro, do_fin, fused, pad;
};
constexpr int I_OUT = 35, I_WS = 36;
enum { I_X = 0, I_C, I_CTX, I_CCTX, I_ADAW, I_ADAB, I_N1W, I_N2W, I_WIN, I_WOUT, I_RETGN, I_LAMRE, I_LAMIM, I_LOGDT, I_BRE, I_BIM, I_CRE, I_CIM, I_S5D,
       I_GLUW, I_GLUB, I_LBL, I_HGNW, I_WA2, I_BA, I_GLANW, I_FW1, I_FW3, I_FW2, I_RW, I_RB, I_MW1, I_MW3, I_MW2, I_FINW };

struct Frame {
    LAS unsigned char* lds;
    int tid, lane, wave, gw, NGW, G, zz;
    unsigned char* ws; float* out;
};

struct EpiStoreBf16 {
    static constexpr bool PERM = true, AFTER_DRAIN = false;
    bf16* O; int ldc; float sc;
    __device__ __forceinline__ void operator()(const pg8::f32x4 (&acc)[2][2][4][2], const pg8::Unit& u, int wr, int wc, int fr, int fq) const {
        const int row0 = u.pm * 256 + wr * 64 + fr, col0 = u.pc * 256 + wc * 32 + 8 * fq;
#pragma unroll
        for (int ai = 0; ai < 2; ++ai)
#pragma unroll
            for (int m = 0; m < 4; ++m) { bf16* rowp = O + (size_t)(row0 + ai * 128 + m * 16) * ldc + col0;
#pragma unroll
                for (int bj = 0; bj < 2; ++bj) { const pg8::f32x4 v0 = acc[ai][bj][m][0] * sc, v1 = acc[ai][bj][m][1] * sc;
                    pg8::u32x4 w; w.x = pg8::cvt_pk_bf16(v0[0], v0[1]); w.y = pg8::cvt_pk_bf16(v0[2], v0[3]); w.z = pg8::cvt_pk_bf16(v1[0], v1[1]); w.w = pg8::cvt_pk_bf16(v1[2], v1[3]);
                    *(pg8::u32x4*)(rowp + bj * 128) = w; } }
    }
};
struct EpiSwiglu {
    static constexpr bool PERM = true, AFTER_DRAIN = false;
    bf16* H;
    __device__ __forceinline__ void operator()(const pg8::f32x4 (&acc)[2][2][4][2], const pg8::Unit& u, int wr, int wc, int fr, int fq) const {
        const int row0 = u.pm * 256 + wr * 64 + fr, col0 = u.pc * 128 + wc * 32 + 8 * fq;
#pragma unroll
        for (int ai = 0; ai < 2; ++ai)
#pragma unroll
            for (int m = 0; m < 4; ++m) { bf16* rowp = H + (size_t)(row0 + ai * 128 + m * 16) * DFF + col0;
                float h[8];
#pragma unroll
                for (int n = 0; n < 2; ++n)
#pragma unroll
                    for (int j = 0; j < 4; ++j) { const float a = acc[ai][0][m][n][j], b = acc[ai][1][m][n][j];
                        h[n * 4 + j] = a * __builtin_amdgcn_rcpf(1.0f + __builtin_amdgcn_exp2f(-1.4426950408889634f * a)) * b; }
                pg8::u32x4 w; w.x = pg8::cvt_pk_bf16(h[0], h[1]); w.y = pg8::cvt_pk_bf16(h[2], h[3]); w.z = pg8::cvt_pk_bf16(h[4], h[5]); w.w = pg8::cvt_pk_bf16(h[6], h[7]);
                *(pg8::u32x4*)rowp = w; }
    }
};
struct EpiSwiglu8 {
    static constexpr bool PERM = true, AFTER_DRAIN = false;
    unsigned char* H; float sc;
    __device__ __forceinline__ void operator()(const pg8::f32x4 (&acc)[2][2][4][2], const pg8::Unit& u, int wr, int wc, int fr, int fq) const {
        const int row0 = u.pm * 256 + wr * 64 + fr, col0 = u.pc * 128 + wc * 32 + 8 * fq;
#pragma unroll
        for (int ai = 0; ai < 2; ++ai)
#pragma unroll
            for (int m = 0; m < 4; ++m) { unsigned char* rowp = H + (size_t)(row0 + ai * 128 + m * 16) * DFF + col0;
                float h[8];
#pragma unroll
                for (int n = 0; n < 2; ++n)
#pragma unroll
                    for (int j = 0; j < 4; ++j) { const float a = acc[ai][0][m][n][j] * sc, b = acc[ai][1][m][n][j] * sc;
                        const float hv = a * __builtin_amdgcn_rcpf(1.0f + __builtin_amdgcn_exp2f(-1.4426950408889634f * a)) * b;
                        h[n * 4 + j] = fminf(fmaxf(hv, -448.0f), 448.0f); }
                unsigned w0 = 0u, w1 = 0u;
                w0 = __builtin_amdgcn_cvt_pk_fp8_f32(h[0], h[1], w0, false); w0 = __builtin_amdgcn_cvt_pk_fp8_f32(h[2], h[3], w0, true);
                w1 = __builtin_amdgcn_cvt_pk_fp8_f32(h[4], h[5], w1, false); w1 = __builtin_amdgcn_cvt_pk_fp8_f32(h[6], h[7], w1, true);
                v2u w; w.x = w0; w.y = w1; *(v2u*)rowp = w; }
    }
};
struct EpiResid {
    static constexpr bool PERM = false, AFTER_DRAIN = false;
    const float* xin_lat; const float* xin_ctx; float* xout_lat; float* xout_ctx; const float* gate; float sc;
    __device__ __forceinline__ void operator()(const pg8::f32x4 (&acc)[2][2][4][2], const pg8::Unit& u, int wr, int wc, int fr, int fq) const {
        const bool isctx = u.pm >= 128; const int bidx = isctx ? 4 : (u.pm >> 5);
        const size_t rbase = (size_t)(isctx ? (u.pm - 128) : u.pm) * 256 + wr * 64 + fr;
        const float* xi = (isctx ? xin_ctx : xin_lat); float* xo = (isctx ? xout_ctx : xout_lat);
        const int col0 = u.pc * 256 + wc * 32 + 4 * fq; const float* g = gate + (size_t)bidx * 6144 + col0;
        pg8::f32x4 gv[2][2];
#pragma unroll
        for (int bj = 0; bj < 2; ++bj)
#pragma unroll
            for (int n = 0; n < 2; ++n) gv[bj][n] = *(const pg8::f32x4*)(g + bj * 128 + n * 16) * sc;
#pragma unroll
        for (int ai = 0; ai < 2; ++ai)
#pragma unroll
            for (int m = 0; m < 4; ++m) { const size_t off = (rbase + ai * 128 + m * 16) * 1024 + col0;
#pragma unroll
                for (int bj = 0; bj < 2; ++bj)
#pragma unroll
                    for (int n = 0; n < 2; ++n) { const pg8::f32x4 xv = *(const pg8::f32x4*)(xi + off + bj * 128 + n * 16);
                        *(pg8::f32x4*)(xo + off + bj * 128 + n * 16) = xv + gv[bj][n] * acc[ai][bj][m][n]; }
                asm volatile("" ::: "memory"); }
    }
};
struct EpiGlu {
    static constexpr bool PERM = true, AFTER_DRAIN = false;
    const bf16* Z; bf16* Y; const float* bias;
    __device__ __forceinline__ void operator()(const pg8::f32x4 (&acc)[2][2][4][2], const pg8::Unit& u, int wr, int wc, int fr, int fq) const {
        const int row0 = u.pm * 256 + wr * 64 + fr, col0 = wc * 32 + 8 * fq;
#pragma unroll
        for (int ai = 0; ai < 2; ++ai)
#pragma unroll
            for (int m = 0; m < 4; ++m) { const size_t row = (size_t)(row0 + ai * 128 + m * 16);
#pragma unroll
                for (int bj = 0; bj < 2; ++bj) { const int col = col0 + bj * 128;
                    const pg8::u32x4 zz = *(const pg8::u32x4*)(Z + row * 256 + col);
                    const pg8::f32x4 b0 = *(const pg8::f32x4*)(bias + col), b1 = *(const pg8::f32x4*)(bias + col + 4);
                    const pg8::f32x4 v0 = acc[ai][bj][m][0] + b0, v1 = acc[ai][bj][m][1] + b1;
                    float o[8]; const unsigned zw[4] = {zz.x, zz.y, zz.z, zz.w};
#pragma unroll
                    for (int j = 0; j < 4; ++j) { const float zl = __uint_as_float(zw[j] << 16), zh = __uint_as_float(zw[j] & 0xffff0000u);
                        const float a0 = (j < 2) ? v0[2 * j] : v1[2 * j - 4], a1 = (j < 2) ? v0[2 * j + 1] : v1[2 * j - 3];
                        o[2 * j] = zl * sigm(a0); o[2 * j + 1] = zh * sigm(a1); }
                    pg8::u32x4 w; w.x = pg8::cvt_pk_bf16(o[0], o[1]); w.y = pg8::cvt_pk_bf16(o[2], o[3]); w.z = pg8::cvt_pk_bf16(o[4], o[5]); w.w = pg8::cvt_pk_bf16(o[6], o[7]);
                    *(pg8::u32x4*)(Y + row * 1024 + 256 + col) = w; }
                asm volatile("" ::: "memory"); }
    }
};
struct MoeOrder {
    int tp[9]; int nN, G, c, total;
    __device__ __forceinline__ void init(const unsigned* cnt, int nN_, int G_, int c_) {
        tp[0] = 0;
#pragma unroll
        for (int e = 0; e < 8; ++e) tp[e + 1] = tp[e] + (int)(((unsigned)__builtin_amdgcn_readfirstlane((int)__hip_atomic_load(cnt + e * 64, __ATOMIC_RELAXED, __HIP_MEMORY_SCOPE_AGENT)) + 255u) >> 8);
        nN = nN_; G = G_; c = c_; total = tp[8] * nN;
    }
    __device__ __forceinline__ bool next(int i, pg8::Unit& u) const {
        const int L = i * G + c; if (L >= total) return false;
        const int t = L / nN, pn = L - t * nN; int e = 0;
#pragma unroll
        for (int k = 1; k < 8; ++k) e += (t >= tp[k]) ? 1 : 0;
        u.pm = t; u.pn = e * nN + pn; u.pc = pn; return true;
    }
    __device__ __forceinline__ void a_ready(const pg8::Unit&) const {}
    __device__ __forceinline__ void done(const pg8::Unit&) const {}
};

__device__ __forceinline__ void cvt_item(const float* W, int K, int N, bf16* WT, int mode, int add, LAS float* scr, int item, int lane, int nblk_override = 0) {
    const int nblk = nblk_override ? nblk_override : (N >> 5), kb = item / nblk, nb = item - kb * nblk, k0 = 64 * kb, n0 = 32 * nb;
    const int r = lane >> 3, c4 = lane & 7;
    f32x4 v[8];
#pragma unroll
    for (int i = 0; i < 8; ++i) v[i] = *(const f32x4*)(W + (size_t)(k0 + 8 * i + r) * N + n0 + 4 * c4);
#pragma unroll
    for (int i = 0; i < 8; ++i) {
#pragma unroll
        for (int j = 0; j < 4; ++j) scr[(8 * i + r) * 33 + 4 * c4 + j] = v[i][j]; }
    LDS_WAIT();
    const int c = lane & 7;
#pragma unroll
    for (int j = 0; j < 4; ++j) { const int n = (lane >> 3) + 8 * j; const LAS float* s = scr + (8 * c) * 33 + n;
        v4u o; o.x = pk2(s[0 * 33], s[1 * 33]); o.y = pk2(s[2 * 33], s[3 * 33]); o.z = pk2(s[4 * 33], s[5 * 33]); o.w = pk2(s[6 * 33], s[7 * 33]);
        const int nn = n0 + n; const int drow = (mode == 0) ? (nn + add) : (((nn >> 7) << 8) + (nn & 127) + add);
        *(v4u*)(WT + (size_t)drow * K + k0 + 8 * c) = o; }
    LDS_WAIT();
}
__device__ __forceinline__ void cvt_item_f8(const float* W, int K, int N, unsigned char* WT, int mode, int add, LAS float* scr, int item, int lane) {
    const int nblk = N >> 5, kb = item / nblk, nb = item - kb * nblk, k0 = 64 * kb, n0 = 32 * nb;
    const int r = lane >> 3, c4 = lane & 7;
    f32x4 v[8];
#pragma unroll
    for (int i = 0; i < 8; ++i) v[i] = *(const f32x4*)(W + (size_t)(k0 + 8 * i + r) * N + n0 + 4 * c4);
#pragma unroll
    for (int i = 0; i < 8; ++i) {
#pragma unroll
        for (int j = 0; j < 4; ++j) scr[(8 * i + r) * 33 + 4 * c4 + j] = v[i][j]; }
    LDS_WAIT();
    const int c = lane & 3;
#pragma unroll
    for (int j = 0; j < 2; ++j) { const int n = (lane >> 2) + 16 * j; const LAS float* s = scr + (16 * c) * 33 + n;
        unsigned w[4];
#pragma unroll
        for (int q = 0; q < 4; ++q) { unsigned x = 0u;
            x = __builtin_amdgcn_cvt_pk_fp8_f32(s[(4 * q) * 33] * WSC8, s[(4 * q + 1) * 33] * WSC8, x, false);
            x = __builtin_amdgcn_cvt_pk_fp8_f32(s[(4 * q + 2) * 33] * WSC8, s[(4 * q + 3) * 33] * WSC8, x, true); w[q] = x; }
        v4u o; o.x = w[0]; o.y = w[1]; o.z = w[2]; o.w = w[3];
        const int nn = n0 + n; const int drow = (mode == 0) ? (nn + add) : (((nn >> 7) << 8) + (nn & 127) + add);
        *(v4u*)(WT + (size_t)drow * K + k0 + 16 * c) = o; }
    LDS_WAIT();
}
__device__ __forceinline__ void moe_cvt(const Frame& F, const Args& a, int j) {
    LAS float* scr = (LAS float*)(F.lds + F.wave * 16384);
    constexpr int IT = 1408;
    for (int it = F.gw; it < 8 * 3 * IT; it += F.NGW) {
        const int e = it / (3 * IT), r = it - e * 3 * IT, which = r / IT, item = r - which * IT;
        const size_t eo = ((size_t)j * 8 + e) * (size_t)(1024 * DFF);
        if (which == 0) cvt_item_f8(a.in[F.zz + I_MW1] + eo, 1024, DFF, F.ws + WS_W13M + (size_t)e * 5632 * 1024, 1, 0, scr, item, F.lane);
        else if (which == 1) cvt_item_f8(a.in[F.zz + I_MW3] + eo, 1024, DFF, F.ws + WS_W13M + (size_t)e * 5632 * 1024, 1, 128, scr, item, F.lane);
        else cvt_item_f8(a.in[F.zz + I_MW2] + eo, DFF, 1024, F.ws + WS_W2M + (size_t)e * 1024 * DFF, 0, 0, scr, item, F.lane);
    }
}
__device__ __forceinline__ void prologue(const Frame& F, const Args& a) {
    {
        LAS float* sc = (LAS float*)F.lds; LAS float* red = sc + 5120;
        for (int idx = F.tid; idx < 5120; idx += 512) { const int r = idx >> 10, k = idx & 1023; const float cv = (r < 4) ? a.in[F.zz + I_C][r * 1024 + k] : a.in[F.zz + I_CCTX][k]; sc[idx] = silu_f(cv); }
        __syncthreads();
        float* MOD = (float*)(F.ws + WS_MOD);
        for (int item = blockIdx.x; item < 384; item += F.G) {
            const int l = item / 96, nb = item - l * 96, cl = F.tid & 63, ks = F.tid >> 6, n = nb * 64 + cl;
            float acc[5] = {0.f, 0.f, 0.f, 0.f, 0.f};
            const float* wp = a.in[F.zz + I_ADAW] + ((size_t)l * 1024 + ks * 128) * 6144 + n;
#pragma unroll 16
            for (int kk = 0; kk < 128; ++kk) { const float w = wp[(size_t)kk * 6144];
#pragma unroll
                for (int r = 0; r < 5; ++r) acc[r] = fmaf(sc[r * 1024 + ks * 128 + kk], w, acc[r]); }
#pragma unroll
            for (int r = 0; r < 5; ++r) red[(ks * 5 + r) * 64 + cl] = acc[r];
            __syncthreads();
            if (F.tid < 320) { const int r = F.tid >> 6; float s = 0.f;
#pragma unroll
                for (int k2 = 0; k2 < 8; ++k2) s += red[(k2 * 5 + r) * 64 + cl];
                MOD[((size_t)l * 5 + r) * 6144 + n] = s + a.in[F.zz + I_ADAB][l * 6144 + n]; }
            __syncthreads();
        }
        if (blockIdx.x == 0 && F.tid < 256) {
            const float* lg = a.in[F.zz + I_LBL]; float x[4], mx = -3.0e38f;
#pragma unroll
            for (int l = 0; l < 4; ++l) { x[l] = lg[l * 256 + F.tid]; mx = fmaxf(mx, x[l]); }
            float s = 0.f;
#pragma unroll
            for (int l = 0; l < 4; ++l) { x[l] = expf(x[l] - mx); s += x[l]; }
            float cs = 0.f; const float sm0 = x[0] / s; float* LB = (float*)(F.ws + WS_LB);
#pragma unroll
            for (int l = 0; l < 4; ++l) { cs += x[l] / s; LB[l * 256 + F.tid] = fminf(fmaxf(cs - sm0, 0.f), 1.0f - 1e-6f); }
        }
        if (blockIdx.x == (1 % F.G)) {
            float* RC = (float*)(F.ws + WS_ROPE); float* RS = RC + 2048;
            for (int idx = F.tid; idx < 2048; idx += 512) { const int pos = idx >> 4, i = idx & 15;
                const float fr = powf(10000.0f, -(float)i / 16.0f); const float ang = (float)pos * fr; RC[idx] = cosf(ang); RS[idx] = sinf(ang); }
        }
        __syncthreads();
    }
    LAS float* scr = (LAS float*)(F.lds + F.wave * 16384);
    constexpr int I_IN = 16 * 104, I_OUT = 16 * 32, I_F = 1408, I_GL = 4 * 8;
    constexpr int NIT = 4 * I_IN + 4 * I_OUT + 6 * I_F + 4 * I_GL;
    for (int it = F.gw; it < NIT; it += F.NGW) {
        int r = it;
        if (r < 4 * I_IN) { const int l = r / I_IN; cvt_item(a.in[F.zz + I_WIN] + (size_t)l * 1024 * DIN, 1024, DIN, (bf16*)(F.ws + WS_WIN) + (size_t)l * DINP * 1024, 0, 0, scr, r - l * I_IN, F.lane, 104); continue; } r -= 4 * I_IN;
        if (r < 4 * I_OUT) { const int l = r / I_OUT; cvt_item(a.in[F.zz + I_WOUT] + (size_t)l * 1024 * 1024, 1024, 1024, (bf16*)(F.ws + WS_WOUT) + (size_t)l * 1024 * 1024, 0, 0, scr, r - l * I_OUT, F.lane); continue; } r -= 4 * I_OUT;
        if (r < 6 * I_F) { const int j = r / (3 * I_F), r2 = r - j * 3 * I_F, which = r2 / I_F, item = r2 - which * I_F; const size_t wo = (size_t)j * 1024 * DFF;
            if (which == 0) cvt_item(a.in[F.zz + I_FW1] + wo, 1024, DFF, (bf16*)(F.ws + WS_W13D) + (size_t)j * 5632 * 1024, 1, 0, scr, item, F.lane);
            else if (which == 1) cvt_item(a.in[F.zz + I_FW3] + wo, 1024, DFF, (bf16*)(F.ws + WS_W13D) + (size_t)j * 5632 * 1024, 1, 128, scr, item, F.lane);
            else cvt_item(a.in[F.zz + I_FW2] + wo, DFF, 1024, (bf16*)(F.ws + WS_W2D) + (size_t)j * 1024 * DFF, 0, 0, scr, item, F.lane);
            continue; } r -= 6 * I_F;
        { const int l = r / I_GL; cvt_item(a.in[F.zz + I_GLUW] + (size_t)l * 65536, 256, 256, (bf16*)(F.ws + WS_GLUW) + (size_t)l * 65536, 0, 0, scr, r - l * I_GL, F.lane); }
    }
    moe_cvt(F, a, 0);
    for (int i = blockIdx.x * 512 + F.tid; i < 4 * 256 * 128; i += F.G * 512) {
        const int l = i >> 15, rem = i & 32767, n = rem >> 7, k0 = (rem & 127) * 8, d = n >> 7, cidx = n & 127;
        const float* wa = a.in[F.zz + I_WA2] + ((size_t)(l * 2 + d) * 16) * 128 + cidx;
        float acc[8] = {0.f, 0.f, 0.f, 0.f, 0.f, 0.f, 0.f, 0.f};
#pragma unroll
        for (int r = 0; r < 16; ++r) { const float w2 = wa[r * 128];
#pragma unroll
            for (int kk = 0; kk < 8; ++kk) acc[kk] = fmaf(a.in[F.zz + I_WIN][((size_t)l * 1024 + k0 + kk) * DIN + 3328 + 16 * d + r], w2, acc[kk]); }
        v4u o; o.x = pk2(acc[0], acc[1]); o.y = pk2(acc[2], acc[3]); o.z = pk2(acc[4], acc[5]); o.w = pk2(acc[6], acc[7]);
        *(v4u*)((bf16*)(F.ws + WS_WIN) + ((size_t)l * DINP + 3328 + n) * 1024 + k0) = o;
    }
}

struct MoeTp { int tp[9]; };
__device__ __forceinline__ void load_tp(MoeTp& t, const unsigned* cnt) {
    t.tp[0] = 0;
#pragma unroll
    for (int e = 0; e < 8; ++e) t.tp[e + 1] = t.tp[e] + (int)(((unsigned)__builtin_amdgcn_readfirstlane((int)__hip_atomic_load(cnt + e * 64, __ATOMIC_RELAXED, __HIP_MEMORY_SCOPE_AGENT)) + 255u) >> 8);
}
template <int MODE>
__device__ __forceinline__ void norm_phase(const Frame& F, const Args& a, int l, int which  , int nrows, int comb_l  ) {
    const float* MOD = (const float*)(F.ws + WS_MOD);
    const float* nw = (MODE == 2) ? a.in[F.zz + I_FINW] : ((which ? a.in[F.zz + I_N2W] : a.in[F.zz + I_N1W]) + l * 1024);
    bf16* XN = (bf16*)(F.ws + WS_ACT);
    float* hb = (float*)(F.ws + WS_HB);
    const int* EP = (const int*)(F.ws + WS_LIST) + 8 * MT; const float* GATE = (const float*)(F.ws + WS_LIST) + 10 * MT;
    const bf16* YM = (const bf16*)(F.ws + WS_X2);
    const bool from_input = (l == 0 && which == 0 && MODE != 2);
    MoeTp ctp; if (comb_l >= 0) load_tp(ctp, (const unsigned*)F.ws + CW_CNT + (comb_l >> 1) * 8 * 64);
    const int jm = l >> 1;
    LAS float* rwl = (LAS float*)F.lds;
    if (MODE == 1) {
        const float* rw = a.in[F.zz + I_RW] + (size_t)jm * 8192;
        for (int idx = F.tid; idx < 8192; idx += 512) { const int k = idx >> 3, e = idx & 7; rwl[e * 1024 + k] = rw[idx]; }
        __syncthreads();
    }
    f32x4 wv[4];
#pragma unroll
    for (int j = 0; j < 4; ++j) wv[j] = *((const f32x4*)nw + F.lane + 64 * j);
    f32x4 vn[4]; int epn0 = 0, epn1 = 0; float gn0 = 0.f, gn1 = 0.f;
    { const int m = F.gw < nrows ? F.gw : 0; const bool isctx = m >= NLAT;
      const float* xr = from_input ? (isctx ? a.in[F.zz + I_CTX] + (size_t)(m - NLAT) * 1024 : a.in[F.zz + I_X] + (size_t)m * 1024) : (isctx ? hb + (size_t)(m - NLAT) * 1024 : F.out + (size_t)m * 1024);
#pragma unroll
      for (int j = 0; j < 4; ++j) vn[j] = *((const f32x4*)xr + F.lane + 64 * j);
      if (comb_l >= 0) { epn0 = EP[2 * m]; epn1 = EP[2 * m + 1]; gn0 = GATE[2 * m]; gn1 = GATE[2 * m + 1]; } }
    for (int m = F.gw; m < nrows; m += F.NGW) {
        const bool isctx = m >= NLAT; const int bidx = isctx ? 4 : (m >> 13);
        f32x4 v[4];
#pragma unroll
        for (int j = 0; j < 4; ++j) v[j] = vn[j];
        const int ep0 = epn0, ep1 = epn1; const float g0 = gn0, g1 = gn1;
        { const int mn = (m + F.NGW < nrows) ? m + F.NGW : m; const bool cn = mn >= NLAT;
          const float* xr = from_input ? (cn ? a.in[F.zz + I_CTX] + (size_t)(mn - NLAT) * 1024 : a.in[F.zz + I_X] + (size_t)mn * 1024) : (cn ? hb + (size_t)(mn - NLAT) * 1024 : F.out + (size_t)mn * 1024);
#pragma unroll
          for (int j = 0; j < 4; ++j) vn[j] = *((const f32x4*)xr + F.lane + 64 * j);
          if (comb_l >= 0) { epn0 = EP[2 * mn]; epn1 = EP[2 * mn + 1]; gn0 = GATE[2 * mn]; gn1 = GATE[2 * mn + 1]; } }
        if (comb_l >= 0) {
            int t0 = 0, t1 = 0;
#pragma unroll
            for (int e = 0; e < 8; ++e) { t0 = ((ep0 & 7) == e) ? ctp.tp[e] : t0; t1 = ((ep1 & 7) == e) ? ctp.tp[e] : t1; }
            const size_t d0 = (size_t)t0 * 256 + (ep0 >> 3), d1 = (size_t)t1 * 256 + (ep1 >> 3);
            const float* m5 = MOD + ((size_t)comb_l * 5 + bidx) * 6144 + 5 * 1024;
            float* xw = isctx ? hb + (size_t)(m - NLAT) * 1024 : F.out + (size_t)m * 1024;
#pragma unroll
            for (int j = 0; j < 4; ++j) {
                const v2u y0 = *((const v2u*)(YM + d0 * 1024) + F.lane + 64 * j), y1 = *((const v2u*)(YM + d1 * 1024) + F.lane + 64 * j);
                const f32x4 mm = *((const f32x4*)m5 + F.lane + 64 * j);
                f32x4 f0, f1;
                f0[0] = __uint_as_float(y0.x << 16); f0[1] = __uint_as_float(y0.x & 0xffff0000u); f0[2] = __uint_as_float(y0.y << 16); f0[3] = __uint_as_float(y0.y & 0xffff0000u);
                f1[0] = __uint_as_float(y1.x << 16); f1[1] = __uint_as_float(y1.x & 0xffff0000u); f1[2] = __uint_as_float(y1.y << 16); f1[3] = __uint_as_float(y1.y & 0xffff0000u);
                v[j] = v[j] + mm * (f0 * g0 + f1 * g1);
                if (MODE != 2) *((f32x4*)xw + F.lane + 64 * j) = v[j];
            }
        }
        float ss = 0.f;
#pragma unroll
        for (int j = 0; j < 4; ++j) ss += (v[j][0] * v[j][0] + v[j][1] * v[j][1]) + (v[j][2] * v[j][2] + v[j][3] * v[j][3]);
        ss = wave_sum(ss);
        const float rstd = 1.0f / sqrtf(ss * (1.0f / 1024.0f) + NEPS);
        if (MODE == 2) {
#pragma unroll
            for (int j = 0; j < 4; ++j) *((f32x4*)(F.out + (size_t)m * 1024) + F.lane + 64 * j) = v[j] * rstd * wv[j];
        } else {
            const float* sh = MOD + ((size_t)l * 5 + bidx) * 6144 + (which ? 3 : 0) * 1024; const float* scl = sh + 1024;
            f32x4 o[4];
#pragma unroll
            for (int j = 0; j < 4; ++j) { const f32x4 s1 = *((const f32x4*)scl + F.lane + 64 * j), s0 = *((const f32x4*)sh + F.lane + 64 * j);
                o[j] = (v[j] * rstd * wv[j]) * (s1 + 1.0f) + s0;
                if (MODE == 1) {
                    unsigned w8 = 0u; w8 = __builtin_amdgcn_cvt_pk_fp8_f32(fminf(fmaxf(o[j][0], -448.f), 448.f), fminf(fmaxf(o[j][1], -448.f), 448.f), w8, false);
                    w8 = __builtin_amdgcn_cvt_pk_fp8_f32(fminf(fmaxf(o[j][2], -448.f), 448.f), fminf(fmaxf(o[j][3], -448.f), 448.f), w8, true);
                    *((unsigned*)((unsigned char*)XN + (size_t)m * 1024) + F.lane + 64 * j) = w8;
                } else { v2u w; w.x = pk2(o[j][0], o[j][1]); w.y = pk2(o[j][2], o[j][3]);
                    *((v2u*)(XN + (size_t)m * 1024) + F.lane + 64 * j) = w; } }
            if (MODE == 1) {
                float p[8];
#pragma unroll
                for (int e = 0; e < 8; ++e) { float s = 0.f;
#pragma unroll
                    for (int j = 0; j < 4; ++j) { const f32x4 w4 = *((const LAS f32x4*)(rwl + e * 1024) + F.lane + 64 * j);
                        s += (o[j][0] * w4[0] + o[j][1] * w4[1]) + (o[j][2] * w4[2] + o[j][3] * w4[3]); }
                    p[e] = wave_sum(s) + a.in[F.zz + I_RB][jm * 8 + e]; }
                int e0 = 0; float v0 = p[0];
#pragma unroll
                for (int e = 1; e < 8; ++e) if (p[e] > v0) { v0 = p[e]; e0 = e; }
                int e1 = -1; float v1 = -3.0e38f;
#pragma unroll
                for (int e = 0; e < 8; ++e) if (e != e0 && p[e] > v1) { v1 = p[e]; e1 = e; }
                const float ex = expf(v1 - v0), g0 = 1.0f / (1.0f + ex), g1 = ex / (1.0f + ex);
                if (F.lane == 0) {
                    unsigned* cnt = (unsigned*)F.ws + CW_CNT + jm * 8 * 64; int* LIST = (int*)(F.ws + WS_LIST);
                    int* EPw = (int*)(F.ws + WS_LIST) + 8 * MT; float* GW = (float*)(F.ws + WS_LIST) + 10 * MT;
                    const unsigned p0 = __hip_atomic_fetch_add(cnt + e0 * 64, 1u, __ATOMIC_RELAXED, __HIP_MEMORY_SCOPE_AGENT);
                    const unsigned p1 = __hip_atomic_fetch_add(cnt + e1 * 64, 1u, __ATOMIC_RELAXED, __HIP_MEMORY_SCOPE_AGENT);
                    LIST[e0 * MT + p0] = m; LIST[e1 * MT + p1] = m;
                    EPw[2 * m] = e0 | (int)(p0 << 3); EPw[2 * m + 1] = e1 | (int)(p1 << 3);
                    GW[2 * m] = g0; GW[2 * m + 1] = g1;
                }
            }
        }
    }
    if (MODE == 1) __syncthreads();
}
__device__ __forceinline__ void moe_gather(const Frame& F, int jm) {
    const unsigned* cnt = (const unsigned*)F.ws + CW_CNT + jm * 8 * 64;
    MoeTp t; load_tp(t, cnt);
    int cn[8];
#pragma unroll
    for (int e = 0; e < 8; ++e) cn[e] = __builtin_amdgcn_readfirstlane((int)__hip_atomic_load(cnt + e * 64, __ATOMIC_RELAXED, __HIP_MEMORY_SCOPE_AGENT));
    const int rows = t.tp[8] * 256;
    const int* LIST = (const int*)(F.ws + WS_LIST); const v4u* XN = (const v4u*)(F.ws + WS_ACT); v4u* XB = (v4u*)(F.ws + WS_X2);
    for (int r = F.gw; r < rows; r += F.NGW) {
        const int tile = r >> 8; int e = 0, tpe = 0, ce = cn[0];
#pragma unroll
        for (int k = 1; k < 8; ++k) { const bool ge = tile >= t.tp[k]; e += ge ? 1 : 0; tpe = ge ? t.tp[k] : tpe; ce = ge ? cn[k] : ce; }
        const int pos = r - tpe * 256;
        v4u x0 = {0u, 0u, 0u, 0u};
        if (pos < ce) { const int src = LIST[e * MT + pos]; x0 = XN[(size_t)src * 64 + F.lane]; }
        XB[(size_t)r * 64 + F.lane] = x0;
    }
}
#define GLD(T, ubase, voff) (*(const T*)((const char*)(ubase) + (unsigned)(voff)))
#define GST(T, ubase, voff) (*(T*)((char*)(ubase) + (unsigned)(voff)))
__device__ __forceinline__ int fresh_lane() { int l; asm volatile("v_mbcnt_lo_u32_b32 %0, -1, 0\n\tv_mbcnt_hi_u32_b32 %0, -1, %0" : "=v"(l)); return l; }

struct MixP { const bf16* P; const float* lb; const float* rcos; const float* rsin; const float* ba; };
__device__ __forceinline__ int seg_row0(int b, int sg) { return sg < 4 ? NLAT + b * CTXL + sg * 64 : b * SEQ + (sg - 4) * 64; }
__device__ __forceinline__ int seg_tpos0(int sg) { return sg < 4 ? -1 : (sg - 4) * 64; }

struct S5P { const float *lam_re, *lam_im, *log_dt, *b_re, *b_im, *c_re, *c_im, *dd; };
__device__ __forceinline__ float gelu_tanh(float y) { const float t = 0.7978845608028654f * (y + 0.044715f * y * y * y); const float th = 1.0f - 2.0f / (1.0f + __expf(2.0f * t)); return 0.5f * y * (1.0f + th); }
template <int MODE>
__device__ __forceinline__ void s5_scan(const S5P& sp, const bf16* P, int b, int g, int dir, int sg, int lane, float& hre, float& him, LAS float* yf, LAS float* stg, bf16* Z) {
    const int row0 = seg_row0(b, sg); const int dg = dir * 16 + g;
    const float lre = sp.lam_re[dg * 64 + lane], lim = sp.lam_im[dg * 64 + lane], dt = expf(sp.log_dt[dg]);
    const float er = expf(lre * dt); const float sn = sinf(lim * dt), cs = cosf(lim * dt);
    const float ar = er * cs, ai = er * sn;
    const float nr = ar - 1.0f, ni = ai, den = lre * lre + lim * lim;
    const float cr = (nr * lre + ni * lim) / den, ci = (ni * lre - nr * lim) / den;
    float bbr[16], bbi[16], Cr[16], Ci[16];
#pragma unroll
    for (int c = 0; c < 16; ++c) { const float Br = sp.b_re[((size_t)dg * 64 + lane) * 16 + c], Bi = sp.b_im[((size_t)dg * 64 + lane) * 16 + c];
        bbr[c] = cr * Br - ci * Bi; bbi[c] = cr * Bi + ci * Br;
        Cr[c] = (MODE != 0) ? sp.c_re[((size_t)dg * 16 + c) * 64 + lane] : 0.f; Ci[c] = (MODE != 0) ? sp.c_im[((size_t)dg * 16 + c) * 64 + lane] : 0.f; }
    const int ch = ((lane >> 5) & 1) * 8 + ((lane >> 4) & 1) * 4 + ((lane >> 3) & 1) * 2 + ((lane >> 2) & 1);
    const float dv = (MODE == 2) ? sp.dd[g * 16 + ch] : 0.f;
    const bool b5 = lane & 32, b4 = lane & 16, b3 = lane & 8, b2 = lane & 4;
    const unsigned ucol = 2u * (unsigned)(C_S5 + g * 16 + (lane & 15));
    unsigned short rn0[4], rn1[4], rn2[4];
#pragma unroll
    for (int u = 0; u < 4; ++u) { rn0[u] = GLD(unsigned short, P + (size_t)(row0 + (dir ? 63 - u : u)) * DINP, ucol); rn1[u] = GLD(unsigned short, P + (size_t)(row0 + (dir ? 59 - u : 4 + u)) * DINP, ucol);
        rn2[u] = GLD(unsigned short, P + (size_t)(row0 + (dir ? 55 - u : 8 + u)) * DINP, ucol); }
#pragma unroll 1
    for (int i0 = 0; i0 < 64; i0 += 4) {
        unsigned short ru[4], rn3[4];
        const int ip = (i0 + 12 < 64) ? i0 + 12 : 60;
#pragma unroll
        for (int u = 0; u < 4; ++u) { ru[u] = rn0[u]; rn3[u] = GLD(unsigned short, P + (size_t)(row0 + (dir ? 63 - (ip + u) : (ip + u))) * DINP, ucol); }
#pragma unroll
        for (int u = 0; u < 4; ++u) stg[u * 64 + lane] = bf2f(ru[u]);
#pragma unroll
        for (int u = 0; u < 4; ++u) {
            const int ti = dir ? 63 - (i0 + u) : (i0 + u);
            const float uf = bf2f(ru[u]);
            float bur = 0.f, bui = 0.f;
#pragma unroll
            for (int c4 = 0; c4 < 4; ++c4) { const f32x4 ux = *(const LAS f32x4*)(stg + u * 64 + 4 * c4);
#pragma unroll
                for (int jj = 0; jj < 4; ++jj) { bur = fmaf(bbr[4 * c4 + jj], ux[jj], bur); bui = fmaf(bbi[4 * c4 + jj], ux[jj], bui); } }
            const float nre = ar * hre - ai * him + bur, nim = ar * him + ai * hre + bui;
            hre = nre; him = nim;
            if (MODE != 0) {
                float v[16];
#pragma unroll
                for (int c = 0; c < 16; ++c) v[c] = Cr[c] * hre - Ci[c] * him;
                float w8[8], w4[4], w2[2], w1;
#pragma unroll
                for (int i = 0; i < 8; ++i) { const float mine = b5 ? v[8 + i] : v[i], oth = b5 ? v[i] : v[8 + i]; w8[i] = mine + __shfl_xor(oth, 32); }
#pragma unroll
                for (int i = 0; i < 4; ++i) { const float mine = b4 ? w8[4 + i] : w8[i], oth = b4 ? w8[i] : w8[4 + i]; w4[i] = mine + __shfl_xor(oth, 16); }
#pragma unroll
                for (int i = 0; i < 2; ++i) { const float mine = b3 ? w4[2 + i] : w4[i], oth = b3 ? w4[i] : w4[2 + i]; w2[i] = mine + __shfl_xor(oth, 8); }
                { const float mine = b2 ? w2[1] : w2[0], oth = b2 ? w2[0] : w2[1]; w1 = mine + __shfl_xor(oth, 4); }
                w1 += __shfl_xor(w1, 2); w1 += __shfl_xor(w1, 1);
                if (MODE == 1) { if ((lane & 3) == 0) yf[ti * 16 + ch] = w1; }
                if (MODE == 2) {
                    const float uch = __shfl(uf, ch);
                    if ((lane & 3) == 0) { const float y = w1 + yf[ti * 16 + ch] + dv * uch; Z[(size_t)(row0 + ti) * 256 + g * 16 + ch] = (bf16)f2bf(gelu_tanh(y)); }
                }
            }
        }
#pragma unroll
        for (int u = 0; u < 4; ++u) { rn0[u] = rn1[u]; rn1[u] = rn2[u]; rn2[u] = rn3[u]; }
    }
}

__device__ __forceinline__ MixP make_mixp(const Frame& F, const Args& a, int l) {
    MixP mp; mp.P = (const bf16*)(F.ws + WS_PH); mp.lb = (const float*)(F.ws + WS_LB) + l * 256; mp.rcos = (const float*)(F.ws + WS_ROPE); mp.rsin = mp.rcos + 2048;
    mp.ba = a.in[F.zz + I_BA] + (size_t)l * 2 * 128; return mp;
}
__device__ __forceinline__ S5P make_s5p(const Frame& F, const Args& a, int l) {
    S5P sp; sp.lam_re = a.in[F.zz + I_LAMRE] + (size_t)l * 2048; sp.lam_im = a.in[F.zz + I_LAMIM] + (size_t)l * 2048; sp.log_dt = a.in[F.zz + I_LOGDT] + l * 32;
    sp.b_re = a.in[F.zz + I_BRE] + (size_t)l * 32768; sp.b_im = a.in[F.zz + I_BIM] + (size_t)l * 32768; sp.c_re = a.in[F.zz + I_CRE] + (size_t)l * 32768; sp.c_im = a.in[F.zz + I_CIM] + (size_t)l * 32768;
    sp.dd = a.in[F.zz + I_S5D] + l * 256; return sp;
}


typedef short bf16x8_t __attribute__((ext_vector_type(8)));
typedef float f32x16 __attribute__((ext_vector_type(16)));
typedef float f32x2_t __attribute__((ext_vector_type(2)));
typedef __bf16 bf16x2_n __attribute__((ext_vector_type(2)));
__device__ __forceinline__ unsigned pkbf(float lo, float hi) { const f32x2_t v = {lo, hi}; const bf16x2_n r = __builtin_convertvector(v, bf16x2_n); return __builtin_bit_cast(unsigned, r); }
constexpr int WL_QC = 0, WL_KC = 4608, WL_KT = 9216, WL_VT = 14336, WL_PL = 19456, WL_BYTES = 19712;

struct MxC { float gamma, lbv, oml, bav; unsigned cq, ck, cv, cz; };
template <int MIX>
__device__ __forceinline__ void mx_consts(MxC& c, const MixP& mp, int h, int dir, int lane) {
    c.gamma = 1.f; c.lbv = 0.f; c.oml = 1.f; c.bav = 0.f; c.cz = 0;
    if (MIX == 0) { c.cq = 2u * (unsigned)(C_RQ + h * 64 + lane); c.ck = 2u * (unsigned)(C_RK + h * 64 + lane); c.cv = 2u * (unsigned)(C_RV + h * 64 + lane); c.gamma = 1.0f - exp2f(-5.0f - (float)(dir ? 3 - h : h)); }
    else if (MIX == 1) { c.cq = 2u * (unsigned)(C_HQ + h * 64 + lane); c.ck = 2u * (unsigned)((dir ? C_HFB : C_HFF) + h * 64 + lane); c.cv = 2u * (unsigned)(C_HI + h * 64 + lane); c.lbv = mp.lb[h * 64 + lane]; c.oml = 1.0f - c.lbv; }
    else { c.cq = 2u * (unsigned)(C_GQ + h * 32 + (lane & 31)); c.ck = 2u * (unsigned)(C_GK + h * 32 + (lane & 31)); c.cv = 2u * (unsigned)(C_GV + h * 64 + lane); c.cz = 2u * (unsigned)((dir ? C_GZB : C_GZF) + h * 32 + (lane & 31));
        c.bav = mp.ba[dir * 128 + h * 32 + (lane & 31)]; }
}
struct MxRaw { unsigned short q[4], k[4], v[4], z[4]; };
template <int MIX, bool NEEDQ, int DIR>
__device__ __forceinline__ void mx_load(MxRaw& w, const MixP& mp, const MxC& c, int rows, int b) {
#pragma unroll
    for (int u = 0; u < 4; ++u) { const int cc = b * 4 + u; const bf16* pr = mp.P + (size_t)(rows + (DIR ? 63 - cc : cc)) * DINP;
        w.q[u] = NEEDQ ? GLD(unsigned short, pr, c.cq) : (unsigned short)0; w.k[u] = GLD(unsigned short, pr, c.ck); w.v[u] = GLD(unsigned short, pr, c.cv); w.z[u] = (MIX == 2) ? GLD(unsigned short, pr, c.cz) : (unsigned short)0; }
}
template <int MIX, bool NEEDQ, int DIR>
__device__ __forceinline__ void mx_batch(const MxRaw& cur, const MixP& mp, const MxC& c, int tposs  , int lane, LAS unsigned char* wl, int b, float& P) {
    constexpr int DK = (MIX == 2) ? 32 : 64;
    float kt[4], vv[4];
#pragma unroll
    for (int u = 0; u < 4; ++u) {
        const int cc = b * 4 + u, ts = DIR ? 63 - cc : cc, t = ts & 31;
        float q = bf2f(cur.q[u]), k, f; vv[DIR ? 3 - u : u] = bf2f(cur.v[u]);
        if (MIX == 0) {
            k = bf2f(cur.k[u]) * 0.125f; f = c.gamma;
            if (tposs >= 0) { const int tpos = tposs + ts; const int pos = (lane & 32) ? (tpos & 63) : (tpos >> 6);
                const unsigned ro = 4u * (unsigned)(pos * 16 + (lane & 15)); const float cs = GLD(float, mp.rcos, ro), sn = GLD(float, mp.rsin, ro);
                const float ss = (lane & 16) ? sn : -sn;
                const float kp = __shfl_xor(k, 16); k = fmaf(kp, ss, k * cs);
                if (NEEDQ) { const float qp = __shfl_xor(q, 16); q = fmaf(qp, ss, q * cs); } }
        } else if (MIX == 1) {
            const float z = bf2f(cur.k[u]); const float e = __expf(-z); const float sp = __builtin_amdgcn_rcpf(1.0f + e), sn = e * sp;
            f = fmaf(c.oml, sp, c.lbv); k = c.oml * sn;
        } else {
            k = bf2f(cur.k[u]) * 0.17677669529663687f; const float z = bf2f(cur.z[u]) + c.bav;
            const float ls = fminf(z, 0.f) - __logf(1.0f + __expf(-fabsf(z)));
            f = __expf(ls * 0.0625f);
        }
        P = fmaxf(P * f, 1e-30f);
        const float kk = k * __builtin_amdgcn_rcpf(P); kt[DIR ? 3 - u : u] = kk;
        if (lane < DK) {
            if (NEEDQ) *(LAS unsigned short*)(wl + WL_QC + t * 144 + lane * 2) = (unsigned short)f2bf(q * P);
            *(LAS unsigned short*)(wl + WL_KC + t * 144 + lane * 2) = (unsigned short)f2bf(kk);
        }
    }
    const int g4 = ((DIR ? 63 - b * 4 : b * 4) & 31) >> 2;
    v2u kp, vp; kp.x = pkbf(kt[0], kt[1]); kp.y = pkbf(kt[2], kt[3]); vp.x = pkbf(vv[0], vv[1]); vp.y = pkbf(vv[2], vv[3]);
    if (lane < DK) *(LAS v2u*)(wl + WL_KT + lane * 80 + g4 * 8) = kp;
    *(LAS v2u*)(wl + WL_VT + lane * 80 + g4 * 8) = vp;
}
typedef short bf16x4_t __attribute__((ext_vector_type(4)));
#define MFMA8(a, b, c) __builtin_amdgcn_mfma_f32_32x32x8bf16_1k((a), (b), (c), 0, 0, 0)
__device__ __forceinline__ bf16x4_t pack4(const f32x16& x, int s) {
    v2u p; p.x = pkbf(x[4 * s], x[4 * s + 1]); p.y = pkbf(x[4 * s + 2], x[4 * s + 3]);
    return __builtin_bit_cast(bf16x4_t, p);
}
__device__ __forceinline__ bf16x4_t ld4(const LAS unsigned char* p) { const v2u a = *(const LAS v2u*)p; return __builtin_bit_cast(bf16x4_t, a); }

template <int MODE, int DIR>
__device__ __forceinline__ void s5_mm_dir(const S5P& sp, const bf16* P, int b, int g, int sg, int lane, float& hre, float& him, LAS float* yf, LAS unsigned char* hs, bf16* Z) {
    const int m32 = lane & 31, hh = lane >> 5, dg = DIR * 16 + g, row0 = seg_row0(b, sg);
    float ar[2], ai[2], a2r[2], a2i[2], a3r[2], a3i[2], a4r[2], a4i[2];
    bf16x4_t bfr[4][2];
    const float dt = __expf(sp.log_dt[dg]);
#pragma unroll
    for (int sh = 0; sh < 2; ++sh) {
        const int p = 32 * sh + m32;
        const float lre = sp.lam_re[dg * 64 + p], lim = sp.lam_im[dg * 64 + p];
        const float er = __expf(lre * dt), sn = sinf(lim * dt), cs = cosf(lim * dt);
        ar[sh] = er * cs; ai[sh] = er * sn;
        a2r[sh] = ar[sh] * ar[sh] - ai[sh] * ai[sh]; a2i[sh] = ar[sh] * ai[sh] + ar[sh] * ai[sh];
        a3r[sh] = a2r[sh] * ar[sh] - a2i[sh] * ai[sh]; a3i[sh] = a2r[sh] * ai[sh] + a2i[sh] * ar[sh];
        a4r[sh] = a2r[sh] * a2r[sh] - a2i[sh] * a2i[sh]; a4i[sh] = a2r[sh] * a2i[sh] + a2r[sh] * a2i[sh];
        const float nr = ar[sh] - 1.0f, ni = ai[sh], den = 1.0f / (lre * lre + lim * lim);
        const float cr = (nr * lre + ni * lim) * den, ci = (ni * lre - nr * lim) * den;
#pragma unroll
        for (int s2 = 0; s2 < 2; ++s2) {
            const f32x4 Br = *(const f32x4*)(sp.b_re + ((size_t)dg * 64 + p) * 16 + 8 * s2 + 4 * hh), Bi = *(const f32x4*)(sp.b_im + ((size_t)dg * 64 + p) * 16 + 8 * s2 + 4 * hh);
            const f32x4 re = Br * cr - Bi * ci, im = Bi * cr + Br * ci;
            v2u pr, pi; pr.x = pkbf(re[0], re[1]); pr.y = pkbf(re[2], re[3]); pi.x = pkbf(im[0], im[1]); pi.y = pkbf(im[2], im[3]);
            bfr[sh][s2] = __builtin_bit_cast(bf16x4_t, pr); bfr[2 + sh][s2] = __builtin_bit_cast(bf16x4_t, pi);
        }
    }
    bf16x4_t cfr[16];
    if (MODE != 0) {
#pragma unroll
        for (int s = 0; s < 16; ++s) {
            const int p4 = (8 * s + 4 * hh) & 63; f32x4 cv = {0.f, 0.f, 0.f, 0.f};
            if (m32 < 16) cv = (s < 8) ? *(const f32x4*)(sp.c_re + ((size_t)dg * 16 + m32) * 64 + p4) : -*(const f32x4*)(sp.c_im + ((size_t)dg * 16 + m32) * 64 + p4);
            v2u pc; pc.x = pkbf(cv[0], cv[1]); pc.y = pkbf(cv[2], cv[3]); cfr[s] = __builtin_bit_cast(bf16x4_t, pc);
        }
    }
    const float ddv = (MODE == 2 && m32 < 16) ? sp.dd[g * 16 + m32] : 0.f;
    float hr[2], hi[2];
    hr[0] = __shfl(hre, m32); hi[0] = __shfl(him, m32); hr[1] = __shfl(hre, m32 + 32); hi[1] = __shfl(him, m32 + 32);
#pragma unroll 1
    for (int ci2 = 0; ci2 < 2; ++ci2) {
        const int ch = DIR ? 1 - ci2 : ci2, rowc = row0 + 32 * ch;
        const bf16* urow = P + (size_t)(rowc + m32) * DINP + C_S5 + g * 16 + 4 * hh;
        const bf16x4_t ua0 = __builtin_bit_cast(bf16x4_t, *(const v2u*)urow), ua1 = __builtin_bit_cast(bf16x4_t, *(const v2u*)(urow + 8));
        f32x16 BU[4];
#pragma unroll
        for (int nt = 0; nt < 4; ++nt) {
#pragma unroll
            for (int r = 0; r < 16; ++r) BU[nt][r] = 0.f;
            BU[nt] = MFMA8(ua0, bfr[nt][0], BU[nt]); BU[nt] = MFMA8(ua1, bfr[nt][1], BU[nt]);
        }
#pragma unroll
        for (int sh = 0; sh < 2; ++sh)
#pragma unroll
            for (int gg = 0; gg < 4; ++gg)
#pragma unroll
                for (int jj = 1; jj < 4; ++jj) {
                    const int r = DIR ? 4 * gg + 3 - jj : 4 * gg + jj, rp = DIR ? r + 1 : r - 1;
                    const float pr = BU[sh][rp], pi = BU[2 + sh][rp];
                    BU[sh][r] += ar[sh] * pr - ai[sh] * pi; BU[2 + sh][r] += ar[sh] * pi + ai[sh] * pr;
                }
        float hnr[2][4], hni[2][4];
#pragma unroll
        for (int st = 0; st < 8; ++st) {
            const int gg = DIR ? 3 - (st >> 1) : (st >> 1), turn = DIR ? 1 - (st & 1) : (st & 1), rl = DIR ? 4 * gg : 4 * gg + 3;
            const bool act = (hh == turn);
#pragma unroll
            for (int sh = 0; sh < 2; ++sh) {
                if (turn == (DIR ? 1 : 0)) { hnr[sh][gg] = hr[sh]; hni[sh][gg] = hi[sh]; }
                else { hnr[sh][gg] = act ? hr[sh] : hnr[sh][gg]; hni[sh][gg] = act ? hi[sh] : hni[sh][gg]; }
                const float outr = BU[sh][rl] + a4r[sh] * hr[sh] - a4i[sh] * hi[sh], outi = BU[2 + sh][rl] + a4r[sh] * hi[sh] + a4i[sh] * hr[sh];
                const float sr = __shfl_xor(outr, 32), si = __shfl_xor(outi, 32);
                hr[sh] = act ? outr : sr; hi[sh] = act ? outi : si;
            }
        }
        if (MODE != 0) {
#pragma unroll
            for (int sh = 0; sh < 2; ++sh)
#pragma unroll
                for (int gg = 0; gg < 4; ++gg)
#pragma unroll
                    for (int jj = 0; jj < 4; ++jj) {
                        const int pw = DIR ? 4 - jj : jj + 1;
                        const float pr = (pw == 1) ? ar[sh] : (pw == 2) ? a2r[sh] : (pw == 3) ? a3r[sh] : a4r[sh], pi = (pw == 1) ? ai[sh] : (pw == 2) ? a2i[sh] : (pw == 3) ? a3i[sh] : a4i[sh];
                        BU[sh][4 * gg + jj] += pr * hnr[sh][gg] - pi * hni[sh][gg]; BU[2 + sh][4 * gg + jj] += pr * hni[sh][gg] + pi * hnr[sh][gg];
                    }
#pragma unroll
            for (int nt = 0; nt < 4; ++nt)
#pragma unroll
                for (int r = 0; r < 16; ++r) *(LAS unsigned short*)(hs + ((r & 3) + 8 * (r >> 2) + 4 * hh) * 272 + (32 * nt + m32) * 2) = (unsigned short)f2bf(BU[nt][r]);
            f32x16 Yv;
#pragma unroll
            for (int r = 0; r < 16; ++r) Yv[r] = 0.f;
#pragma unroll
            for (int s = 0; s < 16; ++s) Yv = MFMA8(ld4(hs + m32 * 272 + (8 * s + 4 * hh) * 2), cfr[s], Yv);
            if (m32 < 16) {
#pragma unroll
                for (int r = 0; r < 16; ++r) {
                    const int tl = (r & 3) + 8 * (r >> 2) + 4 * hh;
                    if (MODE == 1) yf[(32 * ch + tl) * 16 + m32] = Yv[r];
                    else { const float u = bf2f(P[(size_t)(rowc + tl) * DINP + C_S5 + g * 16 + m32]);
                        const float y = Yv[r] + yf[(32 * ch + tl) * 16 + m32] + ddv * u;
                        Z[(size_t)(rowc + tl) * 256 + g * 16 + m32] = (bf16)f2bf(gelu_tanh(y)); }
                }
            }
        }
    }
    hre = hh ? hr[1] : hr[0]; him = hh ? hi[1] : hi[0];
}
template <int MODE>
__device__ __forceinline__ void s5_mm(const S5P& sp, const bf16* P, int b, int g, int dir, int sg, int lane, float& hre, float& him, LAS float* yf, LAS unsigned char* hs, bf16* Z) {
    if (dir) s5_mm_dir<MODE, 1>(sp, P, b, g, sg, lane, hre, him, yf, hs, Z); else s5_mm_dir<MODE, 0>(sp, P, b, g, sg, lane, hre, him, yf, hs, Z);
}
template <int MIX, int DIR, bool WITH_O>
__device__ __forceinline__ void mx_chunk(LAS unsigned char* wl, int lane, float Pl, f32x16 (&ST)[(MIX == 2) ? 1 : 2][2], f32x16 (&O)[2]) {
    constexpr int DK = (MIX == 2) ? 32 : 64, NRT = DK / 32;
    const int m32 = lane & 31, hh = lane >> 5;
    asm volatile("" ::: "memory");
    if (lane < DK) *(LAS float*)(wl + WL_PL + lane * 4) = Pl;
    asm volatile("" ::: "memory");
    if (WITH_O) {
        f32x16 x;
#pragma unroll
        for (int r = 0; r < 16; ++r) x[r] = 0.f;
#pragma unroll
        for (int s = 0; s < DK / 8; ++s) {
            const bf16x4_t ka = ld4(wl + WL_KC + m32 * 144 + (8 * s + 4 * hh) * 2);
            const bf16x4_t qb = ld4(wl + WL_QC + m32 * 144 + (8 * s + 4 * hh) * 2);
            x = MFMA8(ka, qb, x);
        }
#pragma unroll
        for (int r = 0; r < 16; ++r) { const int j = (r & 3) + 8 * (r >> 2) + 4 * hh; const bool keep = DIR ? (j >= m32) : (j <= m32); x[r] = keep ? x[r] : 0.f; }
#pragma unroll
        for (int t = 0; t < 2; ++t)
#pragma unroll
            for (int r = 0; r < 16; ++r) O[t][r] = 0.f;
#pragma unroll
        for (int s = 0; s < 4; ++s) {
            const bf16x4_t xa = pack4(x, s);
#pragma unroll
            for (int t = 0; t < 2; ++t) O[t] = MFMA8(xa, ld4(wl + WL_VT + (32 * t + m32) * 80 + (8 * s + 4 * hh) * 2), O[t]);
        }
#pragma unroll
        for (int rt = 0; rt < NRT; ++rt)
#pragma unroll
            for (int s = 0; s < 4; ++s) {
                const bf16x4_t qa = ld4(wl + WL_QC + m32 * 144 + (32 * rt + 8 * s + 4 * hh) * 2);
#pragma unroll
                for (int t = 0; t < 2; ++t) O[t] = MFMA8(qa, pack4(ST[rt][t], s), O[t]);
            }
    }
#pragma unroll
    for (int rt = 0; rt < NRT; ++rt)
#pragma unroll
        for (int s = 0; s < 4; ++s) {
            const bf16x4_t ka = ld4(wl + WL_KT + (32 * rt + m32) * 80 + (8 * s + 4 * hh) * 2);
#pragma unroll
            for (int t = 0; t < 2; ++t) ST[rt][t] = MFMA8(ka, ld4(wl + WL_VT + (32 * t + m32) * 80 + (8 * s + 4 * hh) * 2), ST[rt][t]);
        }
#pragma unroll
    for (int rt = 0; rt < NRT; ++rt)
#pragma unroll
        for (int g = 0; g < 4; ++g) {
            const f32x4 pl4 = *(const LAS f32x4*)(wl + WL_PL + (32 * rt + 8 * g + 4 * hh) * 4);
#pragma unroll
            for (int e = 0; e < 4; ++e) { ST[rt][0][4 * g + e] *= pl4[e]; ST[rt][1][4 * g + e] *= pl4[e]; }
        }
}
__device__ __forceinline__ float half_sum(float v) {
#pragma unroll
    for (int o = 1; o < 32; o <<= 1) v += __shfl_xor(v, o);
    return v;
}
template <int MIX, int DIR>
__device__ __forceinline__ void mixA_stream(const MixP& mp, const MxC& c, int row0, int tpos0, int lane, LAS unsigned char* wl, f32x16 (&ST)[(MIX == 2) ? 1 : 2][2], float& Gam) {
    f32x16 O[2];
    MxRaw r0, r1, r2;
    mx_load<MIX, false, DIR>(r0, mp, c, row0, 0); mx_load<MIX, false, DIR>(r1, mp, c, row0, 1); mx_load<MIX, false, DIR>(r2, mp, c, row0, 2);
    float P = 1.0f;
#pragma unroll 1
    for (int b = 0; b < 16; ++b) {
        MxRaw r3; mx_load<MIX, false, DIR>(r3, mp, c, row0, b < 13 ? b + 3 : 15);
        int ln = lane; asm volatile("" : "+v"(ln));
        mx_batch<MIX, false, DIR>(r0, mp, c, tpos0, ln, wl, b, P);
        if ((b & 7) == 7) { Gam *= P; mx_chunk<MIX, 0, false>(wl, ln, P, ST, O); P = 1.0f; }
        r0 = r1; r1 = r2; r2 = r3;
    }
}
template <int MIX>
__device__ __forceinline__ void mixA_unit(const MixP& mp, float* STG, int idx, int lane_in, LAS unsigned char* wl) {
    int lane = lane_in;
    constexpr int DK = (MIX == 2) ? 32 : 64, NRT = DK / 32;
    const int dir = idx / 2112, rem = idx - dir * 2112, bh = rem / NSEG, sg = rem - bh * NSEG, b = bh >> 2, h = bh & 3;
    asm volatile("" : "+v"(lane));
    MxC c; mx_consts<MIX>(c, mp, h, dir, lane);
    f32x16 ST[NRT][2];
#pragma unroll
    for (int rt = 0; rt < NRT; ++rt)
#pragma unroll
        for (int t = 0; t < 2; ++t)
#pragma unroll
            for (int r = 0; r < 16; ++r) ST[rt][t][r] = 0.f;
    const int row0 = seg_row0(b, sg), tpos0 = seg_tpos0(sg);
    float Gam = 1.0f;
    if (dir) mixA_stream<MIX, 1>(mp, c, row0, tpos0, lane, wl, ST, Gam); else mixA_stream<MIX, 0>(mp, c, row0, tpos0, lane, wl, ST, Gam);
    const size_t slot = (size_t)((dir * 16 + bh) * NSEG + sg);
    float* ds = STG + (MIX == 0 ? ST_DS0 : (MIX == 1 ? ST_DS1 : ST_DS2)) + slot * (DK * 64);
    const int m32 = lane & 31, hh = lane >> 5;
#pragma unroll
    for (int rt = 0; rt < NRT; ++rt)
#pragma unroll
        for (int t = 0; t < 2; ++t)
#pragma unroll
            for (int r = 0; r < 16; ++r) GST(float, ds + (32 * rt + (r & 3) + 8 * (r >> 2)) * 64 + 32 * t, 4u * (unsigned)(4 * hh * 64 + m32)) = ST[rt][t][r];
    float* gs = STG + (MIX == 0 ? ST_G0 : (MIX == 1 ? ST_G1 : ST_G2)) + slot * 64;
    GST(float, gs, 4u * (unsigned)lane) = Gam;
}
template <int MIX, int MODE>
__device__ __forceinline__ void mx_epilogue(const MixP& mp, LAS unsigned char* wl, int lane, const f32x16 (&O)[2], int rowc, float* OF, bf16* Y, int ocol, int ycol, int cgate, float nwv) {
    LAS float* ost = (LAS float*)(wl + WL_QC);
    const int m32 = lane & 31, hh = lane >> 5;
    asm volatile("" ::: "memory");
#pragma unroll
    for (int t = 0; t < 2; ++t)
#pragma unroll
        for (int r = 0; r < 16; ++r) ost[((r & 3) + 8 * (r >> 2) + 4 * hh) * 68 + 32 * t + m32] = O[t][r];
    asm volatile("" ::: "memory");
    if (MODE == 1) {
#pragma unroll 8
        for (int tk = 0; tk < 32; ++tk) GST(float, OF + (size_t)(rowc + tk) * 768 + ocol, 4u * (unsigned)lane) = ost[tk * 68 + lane];
    } else {
        float ofc[8]; unsigned short gc[8];
#pragma unroll
        for (int u = 0; u < 8; ++u) { ofc[u] = GLD(float, OF + (size_t)(rowc + u) * 768 + ocol, 4u * (unsigned)lane); gc[u] = GLD(unsigned short, mp.P + (size_t)(rowc + u) * DINP + cgate, 2u * (unsigned)lane); }
#pragma unroll 1
        for (int b8 = 0; b8 < 4; ++b8) {
            float ofn[8]; unsigned short gn[8]; const int nb = b8 < 3 ? b8 + 1 : 3;
#pragma unroll
            for (int u = 0; u < 8; ++u) { ofn[u] = GLD(float, OF + (size_t)(rowc + nb * 8 + u) * 768 + ocol, 4u * (unsigned)lane); gn[u] = GLD(unsigned short, mp.P + (size_t)(rowc + nb * 8 + u) * DINP + cgate, 2u * (unsigned)lane); }
#pragma unroll
            for (int u = 0; u < 8; ++u) {
                const int tk = b8 * 8 + u;
                const float o = ost[tk * 68 + lane] + ofc[u];
                float y;
                if (MIX == 0) { const float mean = wave_sum(o) * (1.0f / 64.0f); const float d = o - mean; y = d * (1.0f / sqrtf(wave_sum(d * d) * (1.0f / 64.0f) + NEPS)) * nwv; }
                else y = o * (1.0f / sqrtf(wave_sum(o * o) * (1.0f / 64.0f) + NEPS)) * nwv;
                y *= silu_f(bf2f(gc[u]));
                GST(unsigned short, Y + (size_t)(rowc + tk) * 1024 + ycol, 2u * (unsigned)lane) = (unsigned short)f2bf(y);
            }
#pragma unroll
            for (int u = 0; u < 8; ++u) { ofc[u] = ofn[u]; gc[u] = gn[u]; }
        }
    }
}
template <int MIX, int DIR>
__device__ __forceinline__ void mixC_stream(const MixP& mp, const MxC& c, int row0, int tpos0, int lane, LAS unsigned char* wl, f32x16 (&ST)[(MIX == 2) ? 1 : 2][2],
                                            float* OF, bf16* Y, int ocol, int ycol, int cgate, float nwv) {
    f32x16 O[2];
    MxRaw r0, r1;
    mx_load<MIX, true, DIR>(r0, mp, c, row0, 0); mx_load<MIX, true, DIR>(r1, mp, c, row0, 1);
    float P = 1.0f;
#pragma unroll 1
    for (int b = 0; b < 16; ++b) {
        MxRaw r2; mx_load<MIX, true, DIR>(r2, mp, c, row0, b < 14 ? b + 2 : 15);
        int ln = lane; asm volatile("" : "+v"(ln));
        mx_batch<MIX, true, DIR>(r0, mp, c, tpos0, ln, wl, b, P);
        if ((b & 7) == 7) {
            const int ch = DIR ? 1 - (b >> 3) : (b >> 3);
            mx_chunk<MIX, DIR, true>(wl, ln, P, ST, O); P = 1.0f;
            mx_epilogue<MIX, DIR ? 2 : 1>(mp, wl, ln, O, row0 + 32 * ch, OF, Y, ocol, ycol, cgate, nwv);
        }
        r0 = r1; r1 = r2;
    }
}
template <int MIX>
__device__ __forceinline__ void mixC_unit(const MixP& mp, const float* STG, int idx, int lane_in, float* OF, LAS unsigned char* wl, bf16* Y, const float* nw) {
    int lane = lane_in; asm volatile("" : "+v"(lane));
    constexpr int DK = (MIX == 2) ? 32 : 64, NRT = DK / 32;
    const int bh = idx / NSEG, sg = idx - bh * NSEG, b = bh >> 2, h = bh & 3;
    const int row0 = seg_row0(b, sg), tpos0 = seg_tpos0(sg);
    const int ocol = ((MIX == 0) ? 0 : (MIX == 1 ? 256 : 512)) + h * 64, ycol = ((MIX == 0) ? 0 : (MIX == 1 ? 512 : 768)) + h * 64;
    const int cgate = ((MIX == 0) ? C_RG : (MIX == 1 ? C_HG : C_GG)) + h * 64;
    const float* dsb = STG + (MIX == 0 ? ST_DS0 : (MIX == 1 ? ST_DS1 : ST_DS2));
    const float nwv = nw[h * 64 + lane];
    f32x16 ST[NRT][2];
#pragma unroll 1
    for (int dir = 0; dir < 2; ++dir) {
        asm volatile("" : "+v"(lane));
        const int m32 = lane & 31, hh = lane >> 5;
        MxC c; mx_consts<MIX>(c, mp, h, dir, lane);
        { const float* ds = dsb + (size_t)((dir * 16 + bh) * NSEG + sg) * (DK * 64);
#pragma unroll
          for (int rt = 0; rt < NRT; ++rt)
#pragma unroll
              for (int t = 0; t < 2; ++t)
#pragma unroll
                  for (int r = 0; r < 16; ++r) ST[rt][t][r] = GLD(float, ds + (32 * rt + (r & 3) + 8 * (r >> 2)) * 64 + 32 * t, 4u * (unsigned)(4 * hh * 64 + m32)); }
        if (dir == 0) mixC_stream<MIX, 0>(mp, c, row0, tpos0, lane, wl, ST, OF, Y, ocol, ycol, cgate, nwv);
        else mixC_stream<MIX, 1>(mp, c, row0, tpos0, lane, wl, ST, OF, Y, ocol, ycol, cgate, nwv);
        asm volatile("s_waitcnt vmcnt(0)" ::: "memory");
    }
}
template <int MSEL>
__device__ __forceinline__ void mix_passA(const Frame& F, const Args& a, int l) {
    const MixP mp = make_mixp(F, a, l); const S5P sp = make_s5p(F, a, l);
    float* ST = (float*)(F.ws + WS_X2);
    LAS unsigned char* wl = F.lds + F.wave * WL_BYTES; LAS float* stg = (LAS float*)wl;
    if (MSEL == 15) {
        constexpr int NMX = 3 * 4224, NS5 = 2 * 64 * NSEG;
        const int heavy = NMX - (NMX / F.NGW) * F.NGW, nlight = F.NGW - heavy;
        const int n_all = (NS5 - 4 * nlight) / F.NGW;
        for (int it = 0; ; ++it) {
            int u;
            const int nmine = NMX / F.NGW + (F.gw < heavy ? 1 : 0);
            if (it < nmine) u = F.gw + it * F.NGW;
            else if (it < nmine + n_all) u = NMX + F.gw + (it - nmine) * F.NGW;
            else { const int k2 = it - nmine - n_all; if (F.gw < heavy || k2 >= 4) {
                    const int rest0 = NMX + n_all * F.NGW + 4 * nlight; const int uu = rest0 + F.gw + (k2 - (F.gw < heavy ? 0 : 4)) * F.NGW; if (uu >= NMX + NS5) break; u = uu; }
                else u = NMX + n_all * F.NGW + (F.gw - heavy) + k2 * nlight; }
            if (u >= NMX + NS5) break;
            if (u < 4224) mixA_unit<0>(mp, ST, u, fresh_lane(), wl);
            else if (u < 2 * 4224) mixA_unit<1>(mp, ST, u - 4224, fresh_lane(), wl);
            else if (u < 3 * 4224) mixA_unit<2>(mp, ST, u - 2 * 4224, fresh_lane(), wl);
            else { const int idx = u - 3 * 4224; const int dir = idx / (64 * NSEG), rem = idx - dir * 64 * NSEG, bg = rem / NSEG, sg = rem - bg * NSEG;
                float hre = 0.f, him = 0.f;
                s5_mm<0>(sp, mp.P, bg >> 4, bg & 15, dir, sg, fresh_lane(), hre, him, nullptr, wl, nullptr);
                float* hs = ST + ST_HS + ((size_t)((dir * 64 + bg) * NSEG + sg) * 64 + fresh_lane()) * 2;
                hs[0] = hre; hs[1] = him; }
        }
        return;
    }
    if (MSEL & 1) for (int u = F.gw; u < 4224; u += F.NGW) mixA_unit<0>(mp, ST, u, fresh_lane(), wl);
    if (MSEL & 2) for (int u = F.gw; u < 4224; u += F.NGW) mixA_unit<1>(mp, ST, u, fresh_lane(), wl);
    if (MSEL & 4) for (int u = F.gw; u < 4224; u += F.NGW) mixA_unit<2>(mp, ST, u, fresh_lane(), wl);
    if (MSEL & 8) for (int idx = F.gw; idx < 2 * 64 * NSEG; idx += F.NGW) {
        const int dir = idx / (64 * NSEG), rem = idx - dir * 64 * NSEG, bg = rem / NSEG, sg = rem - bg * NSEG;
        float hre = 0.f, him = 0.f;
        s5_mm<0>(sp, mp.P, bg >> 4, bg & 15, dir, sg, fresh_lane(), hre, him, nullptr, wl, nullptr);
        float* hs = ST + ST_HS + ((size_t)((dir * 64 + bg) * NSEG + sg) * 64 + fresh_lane()) * 2;
        hs[0] = hre; hs[1] = him;
    }
}
__device__ __forceinline__ int chain_seg(int dir, int p) { return dir ? (p < 4 ? 3 - p : 135 - p) : p; }
__device__ __forceinline__ void mix_passB(const Frame& F, const Args& a, int l) {
    float* ST = (float*)(F.ws + WS_X2);
    constexpr int N0 = 131072, N1 = 131072, N2 = 65536, N3 = 8192;
    for (int e = blockIdx.x * 512 + F.tid; e < N0 + N1 + N2 + N3; e += F.G * 512) {
        if (e < N0 + N1 + N2) {
            float* base; const float* gb; int dir, esz;
            if (e < N0 + N1) { const int mix = e >= N0, e2 = e - mix * N0, c = e2 >> 12, el = e2 & 4095; dir = c >> 4; esz = 4096;
                base = ST + (mix ? ST_DS1 : ST_DS0) + (size_t)c * NSEG * 4096 + el; gb = ST + (mix ? ST_G1 : ST_G0) + (size_t)c * NSEG * 64 + (el >> 6); }
            else { const int e2 = e - N0 - N1, c = e2 >> 11, el = e2 & 2047; dir = c >> 4; esz = 2048;
                base = ST + ST_DS2 + (size_t)c * NSEG * 2048 + el; gb = ST + ST_G2 + (size_t)c * NSEG * 64 + (el >> 6); }
            float run = 0.f;
#pragma unroll 1
            for (int p0 = 0; p0 < NSEG; p0 += 12) {
                float d[12], gm[12];
#pragma unroll
                for (int q = 0; q < 12; ++q) { const int sg = chain_seg(dir, p0 + q); d[q] = base[(size_t)sg * esz]; gm[q] = gb[sg * 64]; }
#pragma unroll
                for (int q = 0; q < 12; ++q) { const int sg = chain_seg(dir, p0 + q); base[(size_t)sg * esz] = run; run = fmaf(gm[q], run, d[q]); }
            }
        } else {
            const int e2 = e - N0 - N1 - N2, c = e2 >> 6, p = e2 & 63, dir = c >> 6, g = c & 15;
            const int dg = dir * 16 + g;
            const float lre = a.in[F.zz + I_LAMRE][(size_t)l * 2048 + dg * 64 + p], lim = a.in[F.zz + I_LAMIM][(size_t)l * 2048 + dg * 64 + p], dt = expf(a.in[F.zz + I_LOGDT][l * 32 + dg]);
            const float er = expf(lre * dt * 64.0f); const float sn = sinf(lim * dt * 64.0f), cs = cosf(lim * dt * 64.0f);
            const float ar = er * cs, ai = er * sn;
            float* base = ST + ST_HS + ((size_t)c * NSEG * 64 + p) * 2;
            float rr = 0.f, ri = 0.f;
#pragma unroll 1
            for (int q0 = 0; q0 < NSEG; q0 += 12) {
                float dr[12], di[12];
#pragma unroll
                for (int q = 0; q < 12; ++q) { const int sg = chain_seg(dir, q0 + q); dr[q] = base[(size_t)sg * 128]; di[q] = base[(size_t)sg * 128 + 1]; }
#pragma unroll
                for (int q = 0; q < 12; ++q) { const int sg = chain_seg(dir, q0 + q); base[(size_t)sg * 128] = rr; base[(size_t)sg * 128 + 1] = ri;
                    const float nr = ar * rr - ai * ri + dr[q], ni = ar * ri + ai * rr + di[q]; rr = nr; ri = ni; }
            }
        }
    }
}
template <int MSEL>
__device__ __forceinline__ void mix_passC(const Frame& F, const Args& a, int l) {
    const MixP mp = make_mixp(F, a, l); const S5P sp = make_s5p(F, a, l);
    const float* ST = (const float*)(F.ws + WS_X2);
    LAS unsigned char* wl = F.lds + F.wave * WL_BYTES;
    LAS float* stg = (LAS float*)wl; LAS float* of = (LAS float*)(wl + 9216);
    float* OF = (float*)(F.ws + WS_OF);
    bf16* Y = (bf16*)(F.ws + WS_ACT); bf16* Z = (bf16*)(F.ws + WS_Z);
    const bool keep = l < DEPTH - 1;
    constexpr int NM = 16 * NSEG;
    if (MSEL == 15) {
        constexpr int NMX = 3 * NM, NS5 = 64 * NSEG;
        const int heavy = NMX - (NMX / F.NGW) * F.NGW, nlight = F.NGW - heavy;
        for (int it = 0; ; ++it) {
            int u;
            const int nmine = NMX / F.NGW + (F.gw < heavy ? 1 : 0);
            if (it < nmine) u = F.gw + it * F.NGW;
            else { if (F.gw < heavy) break; u = NMX + (F.gw - heavy) + (it - nmine) * nlight; }
            if (u >= NMX + NS5) break;
            const int sgu = (u < 3 * NM) ? (u % NSEG) : ((u - 3 * NM) % NSEG);
            if (!keep && sgu < 4) continue;
            if (u < NM) mixC_unit<0>(mp, ST, u, fresh_lane(), OF, wl, Y, a.in[F.zz + I_RETGN] + l * 256);
            else if (u < 2 * NM) mixC_unit<1>(mp, ST, u - NM, fresh_lane(), OF, wl, Y, a.in[F.zz + I_HGNW] + l * 256);
            else if (u < 3 * NM) mixC_unit<2>(mp, ST, u - 2 * NM, fresh_lane(), OF, wl, Y, a.in[F.zz + I_GLANW] + l * 256);
            else { const int idx = u - 3 * NM, bg = idx / NSEG, sg = idx - bg * NSEG;
                const float* h0 = ST + ST_HS + ((size_t)((0 * 64 + bg) * NSEG + sg) * 64 + fresh_lane()) * 2;
                float hre = h0[0], him = h0[1];
                s5_mm<1>(sp, mp.P, bg >> 4, bg & 15, 0, sg, fresh_lane(), hre, him, of, wl, Z);
                const float* h1 = ST + ST_HS + ((size_t)((1 * 64 + bg) * NSEG + sg) * 64 + fresh_lane()) * 2;
                hre = h1[0]; him = h1[1];
                s5_mm<2>(sp, mp.P, bg >> 4, bg & 15, 1, sg, fresh_lane(), hre, him, of, wl, Z); }
        }
        return;
    }
    if (MSEL & 1) for (int u = F.gw; u < NM; u += F.NGW) { if (!keep && (u % NSEG) < 4) continue; mixC_unit<0>(mp, ST, u, fresh_lane(), OF, wl, Y, a.in[F.zz + I_RETGN] + l * 256); }
    if (MSEL & 2) for (int u = F.gw; u < NM; u += F.NGW) { if (!keep && (u % NSEG) < 4) continue; mixC_unit<1>(mp, ST, u, fresh_lane(), OF, wl, Y, a.in[F.zz + I_HGNW] + l * 256); }
    if (MSEL & 4) for (int u = F.gw; u < NM; u += F.NGW) { if (!keep && (u % NSEG) < 4) continue; mixC_unit<2>(mp, ST, u, fresh_lane(), OF, wl, Y, a.in[F.zz + I_GLANW] + l * 256); }
    if (MSEL & 8) for (int idx = F.gw; idx < 64 * NSEG; idx += F.NGW) {
        const int bg = idx / NSEG, sg = idx - bg * NSEG;
        if (!keep && sg < 4) continue;
        const float* h0 = ST + ST_HS + ((size_t)((0 * 64 + bg) * NSEG + sg) * 64 + fresh_lane()) * 2;
        float hre = h0[0], him = h0[1];
        s5_mm<1>(sp, mp.P, bg >> 4, bg & 15, 0, sg, fresh_lane(), hre, him, of, wl, Z);
        const float* h1 = ST + ST_HS + ((size_t)((1 * 64 + bg) * NSEG + sg) * 64 + fresh_lane()) * 2;
        hre = h1[0]; him = h1[1];
        s5_mm<2>(sp, mp.P, bg >> 4, bg & 15, 1, sg, fresh_lane(), hre, him, of, wl, Z);
    }
}

constexpr int NPH = 11;
template <int PH_MASK, int MSEL>
__global__ void __launch_bounds__(512, 2) mk_fwd(Args a) {
    extern __shared__ __attribute__((aligned(16))) unsigned char lds_raw[];
    Frame F;
    F.lds = (LAS unsigned char*)lds_raw;
    const int wave0 = __builtin_amdgcn_readfirstlane((int)threadIdx.x >> 6);
    F.lane = fresh_lane(); F.tid = wave0 * 64 + F.lane; F.wave = wave0;
    F.G = gridDim.x; F.gw = blockIdx.x * 8 + F.wave; F.NGW = F.G * 8; F.zz = 0; F.ws = (unsigned char*)a.in[I_WS]; F.out = (float*)a.in[I_OUT];
    volatile LAS unsigned* MISC = (volatile LAS unsigned*)(F.lds + MISC_OFF);
    for (int u = F.tid; u < 64; u += 512) ((LAS unsigned*)(F.lds + MISC_OFF))[u] = 0u;
    __syncthreads();
    XcdBarrier bar; bar.bar = (unsigned*)F.ws + CW_BAR; bar.x = 0; bar.st = nullptr;
    if (a.fused) bar = xcd_barrier_post((unsigned*)F.ws + CW_BAR, MISC + 8, F.tid);
#define SEAM() do { if (a.fused) { XcdBarrier bb = bar; asm volatile("" : "+s"(bb.bar), "+s"(bb.x)); xcd_barrier(bb, wave0 * 64 + fresh_lane()); } } while (0)
#define PHASE_BEGIN() do { int zz_ = 0; asm volatile("" : "+s"(zz_)); F.zz = zz_; F.ws = (unsigned char*)a.in[I_WS + zz_]; F.out = (float*)a.in[I_OUT + zz_]; \
        const int ln_ = fresh_lane(); const int t_ = wave0 * 64 + ln_ + zz_; F.tid = t_; F.lane = t_ & 63; F.wave = wave0 + zz_; F.G = (int)gridDim.x + zz_; F.gw = ((int)blockIdx.x + zz_) * 8 + F.wave; F.NGW = F.G * 8; \
        F.lds = (LAS unsigned char*)lds_raw + zz_; } while (0)
#define IN(k) (((PH_MASK >> (k)) & 1) && a.ph_lo <= (k) && (k) < a.ph_hi)
#ifndef DUP_PH
#define DUP_PH 0
#endif
#define REP(k) for (int rep_ = 0; rep_ < (((DUP_PH >> (k)) & 1) ? 2 : 1); ++rep_)
#define hb ((float*)(F.ws + WS_HB))
#define MOD ((const float*)(F.ws + WS_MOD))
#define ACT ((bf16*)(F.ws + WS_ACT))
#define PH ((bf16*)(F.ws + WS_PH))

    if (((PH_MASK >> 12) & 1) && a.do_pro) REP(12) { PHASE_BEGIN(); prologue(F, a); SEAM(); }

#pragma unroll
    for (int l = 0; l < DEPTH; ++l) {
        if (l < a.l_lo || l >= a.l_hi) continue;
        const bool keep = l < DEPTH - 1, moe = l & 1; const int j = l >> 1;
        const int Mrows = keep ? MT : NLAT;
        if (IN(0)) for (int rep_ = 0; rep_ < ((((DUP_PH >> 0) & 1) && l != 2) ? 2 : 1); ++rep_) { PHASE_BEGIN();
            norm_phase<0>(F, a, l, 0, MT, (l == 2) ? 1 : -1);
            if (l == 2) { __syncthreads(); moe_cvt(F, a, 1); }
            SEAM();
        }
        if (IN(1)) REP(1) { PHASE_BEGIN();
            pg8::Gemm g{ACT, (const bf16*)(F.ws + WS_WIN) + (size_t)l * DINP * 1024, MT, DINP, 1024}; pg8::StaticOrder S; S.init(MT, DINP, F.G, (int)blockIdx.x);
            EpiStoreBf16 E{PH, DINP, 1.0f};
            pg8::gemm_phase<EpiStoreBf16, pg8::StaticOrder, true, true>(F.lds, g, S, E, F.tid);
            SEAM();
        }
        if (IN(2)) { PHASE_BEGIN(); mix_passA<MSEL>(F, a, l); SEAM(); }
#ifdef DUP_MIX
        if (IN(2)) { PHASE_BEGIN(); mix_passA<DUP_MIX>(F, a, l); SEAM(); }
#endif
        if (IN(3)) { PHASE_BEGIN(); mix_passB(F, a, l); SEAM(); }
        if (IN(4)) { PHASE_BEGIN(); mix_passC<MSEL>(F, a, l); SEAM(); }
#ifdef DUP_MIX
        if (IN(4)) { PHASE_BEGIN(); mix_passC<DUP_MIX>(F, a, l); SEAM(); }
#endif
        if (IN(5)) REP(5) { PHASE_BEGIN();
            int k256 = 256; asm volatile("" : "+s"(k256)); pg8::Gemm g{(const bf16*)(F.ws + WS_Z), (const bf16*)(F.ws + WS_GLUW) + (size_t)l * 65536, Mrows, 256, k256}; pg8::StaticOrder S; S.init(Mrows, 256, F.G, (int)blockIdx.x);
            EpiGlu E{(const bf16*)(F.ws + WS_Z), ACT, a.in[F.zz + I_GLUB] + l * 256};
            pg8::gemm_phase<EpiGlu, pg8::StaticOrder, true, true>(F.lds, g, S, E, F.tid);
            SEAM();
        }
        if (IN(6)) { PHASE_BEGIN();
            pg8::Gemm g{ACT, (const bf16*)(F.ws + WS_WOUT) + (size_t)l * 1024 * 1024, Mrows, 1024, 1024}; pg8::StaticOrder S; S.init(Mrows, 1024, F.G, (int)blockIdx.x);
            EpiResid E{(l == 0) ? a.in[F.zz + I_X] : F.out, (l == 0) ? a.in[F.zz + I_CTX] : hb, F.out, hb, MOD + (size_t)l * 5 * 6144 + 2 * 1024, 1.0f};
            pg8::gemm_phase<EpiResid, pg8::StaticOrder, true, true>(F.lds, g, S, E, F.tid);
            SEAM();
        }
        if (IN(7)) for (int rep_ = 0; rep_ < ((((DUP_PH >> 7) & 1) && !moe) ? 2 : 1); ++rep_) { PHASE_BEGIN();
            if (moe) norm_phase<1>(F, a, l, 1, Mrows, -1); else norm_phase<0>(F, a, l, 1, Mrows, -1);
            SEAM();
        }
        if (!moe) {
            if (IN(8)) REP(8) { PHASE_BEGIN();
                pg8::Gemm g{ACT, (const bf16*)(F.ws + WS_W13D) + (size_t)j * 5632 * 1024, Mrows, 5632, 1024}; pg8::StaticOrder S; S.init(Mrows, 5632, F.G, (int)blockIdx.x);
                EpiSwiglu E{PH};
                pg8::gemm_phase<EpiSwiglu, pg8::StaticOrder, true, true>(F.lds, g, S, E, F.tid);
                SEAM();
            }
            if (IN(9)) { PHASE_BEGIN();
                pg8::Gemm g{PH, (const bf16*)(F.ws + WS_W2D) + (size_t)j * 1024 * DFF, Mrows, 1024, DFF}; pg8::StaticOrder S; S.init(Mrows, 1024, F.G, (int)blockIdx.x);
                EpiResid E{F.out, hb, F.out, hb, MOD + (size_t)l * 5 * 6144 + 5 * 1024, 1.0f};
                pg8::gemm_phase<EpiResid, pg8::StaticOrder, true, true>(F.lds, g, S, E, F.tid);
                SEAM();
            }
        } else {
                        if (IN(8)) REP(8) { PHASE_BEGIN(); moe_gather(F, j); SEAM(); }
            if (IN(9)) REP(9) { PHASE_BEGIN();
                int k8 = 512; asm volatile("" : "+s"(k8)); pg8::Gemm g{(const bf16*)(F.ws + WS_X2), (const bf16*)(F.ws + WS_W13M), 0, 5632, k8}; MoeOrder S; S.init((const unsigned*)F.ws + CW_CNT + j * 8 * 64, 22, F.G, (int)blockIdx.x);
                EpiSwiglu8 E{(unsigned char*)PH, 1.0f / WSC8};
                pg8::gemm_phase_f8<EpiSwiglu8, MoeOrder, true, true>(F.lds, g, S, E, F.tid);
                SEAM();
            }
            if (IN(10)) REP(10) { PHASE_BEGIN();
                int k8 = DFF / 2; asm volatile("" : "+s"(k8)); pg8::Gemm g{PH, (const bf16*)(F.ws + WS_W2M), 0, 1024, k8}; MoeOrder S; S.init((const unsigned*)F.ws + CW_CNT + j * 8 * 64, 4, F.G, (int)blockIdx.x);
                EpiStoreBf16 E{(bf16*)(F.ws + WS_X2), 1024, 1.0f / WSC8};
                pg8::gemm_phase_f8<EpiStoreBf16, MoeOrder, true, true>(F.lds, g, S, E, F.tid);
                SEAM();
            }
        }
    }
    if (((PH_MASK >> 13) & 1) && a.do_fin) { PHASE_BEGIN(); norm_phase<2>(F, a, DEPTH - 1, 0, NLAT, DEPTH - 1); }
#undef SEAM
#undef IN
#undef hb
#undef MOD
#undef ACT
#undef PH
}

#ifndef MK_FUSED
#define MK_FUSED 1
#endif
template <int PM, int MS> static void launch_one(const Args& a, int grid, hipStream_t stream) {
    static bool attr_done = false;
    if (!attr_done) { (void)hipFuncSetAttribute((const void*)mk_fwd<PM, MS>, hipFuncAttributeMaxDynamicSharedMemorySize, LDS_BYTES); attr_done = true; }
    hipLaunchKernelGGL((mk_fwd<PM, MS>), dim3(grid), dim3(512), LDS_BYTES, stream, a);
}
extern "C" void kernel_launch(void* const* d_in, const int* in_sizes, int n_in, void* d_out, int out_size, void* d_ws, size_t ws_size, hipStream_t stream) {
    static int grid = 0;
    if (grid == 0) {
        if (n_in != 35 || in_sizes[0] != NLAT * DM || out_size != NLAT * DM || ws_size < WS_END) {
            fprintf(stderr, "kernel_launch: unexpected shapes / workspace (n_in %d, ws %zu, need %zu); nothing launched\n", n_in, ws_size, (size_t)WS_END); grid = -1; return; }
        int dev = 0, cus = 0;
        if (hipGetDevice(&dev) != hipSuccess || hipDeviceGetAttribute(&cus, hipDeviceAttributeMultiprocessorCount, dev) != hipSuccess) { grid = -1; return; }
        grid = cus;
    }
    if (grid < 0) return;
    (void)hipMemsetAsync((char*)d_ws + WS_CTL, 0, CTL_ZERO_BYTES, stream);
    Args a{};
    for (int i = 0; i < 35; ++i) a.in[i] = (const float*)d_in[i];
    a.in[I_OUT] = (const float*)d_out; a.in[I_WS] = (const float*)d_ws; a.pad = 0;
#if MK_FUSED
    a.l_lo = 0; a.l_hi = DEPTH; a.ph_lo = 0; a.ph_hi = NPH; a.do_pro = 1; a.do_fin = 1; a.fused = 1;
#ifndef TEST_PM
#define TEST_PM 0xFFFF
#endif
#ifndef TEST_MS
#define TEST_MS 15
#endif
    launch_one<TEST_PM, TEST_MS>(a, grid, stream);
#else
    a.fused = 0;
    a.l_lo = 0; a.l_hi = 0; a.ph_lo = 0; a.ph_hi = 0; a.do_pro = 1; a.do_fin = 0;
    launch_one<0x1000, 15>(a, grid, stream);
    a.do_pro = 0;
    for (int l = 0; l < DEPTH; ++l) {
        a.l_lo = l; a.l_hi = l + 1; a.ph_lo = 0; a.ph_hi = NPH;
        launch_one<0x1, 15>(a, grid, stream); launch_one<0x2, 15>(a, grid, stream); launch_one<0x4, 15>(a, grid, stream); launch_one<0x8, 15>(a, grid, stream);
        launch_one<0x10, 1>(a, grid, stream); launch_one<0x10, 2>(a, grid, stream); launch_one<0x10, 4>(a, grid, stream); launch_one<0x10, 8>(a, grid, stream);
        launch_one<0x20, 15>(a, grid, stream); launch_one<0x40, 15>(a, grid, stream); launch_one<0x80, 15>(a, grid, stream);
        launch_one<0x100, 15>(a, grid, stream); launch_one<0x200, 15>(a, grid, stream);
        if (l & 1) launch_one<0x400, 15>(a, grid, stream);
    }
    a.l_lo = 0; a.l_hi = 0; a.ph_lo = 0; a.ph_hi = 0; a.do_fin = 1;
    launch_one<0x2000, 15>(a, grid, stream);
#endif
}
```

```cpp
#include <hip/hip_runtime.h>
#include <cstdio>
#include <cstdint>
#define LAS __attribute__((address_space(3)))
namespace pg8 {
#define PG8_LAS __attribute__((address_space(3)))
typedef unsigned short bf16_t;
typedef short bf16x8 __attribute__((ext_vector_type(8)));
typedef float f32x4 __attribute__((ext_vector_type(4)));
typedef unsigned u32x4 __attribute__((ext_vector_type(4)));
constexpr int BM = 256, BK = 64, HALF = 128, HTB = HALF * BK * 2  , STAGE_BYTES = 8 * HTB, NXCD = 8, WGM = 8;

__host__ __device__ __forceinline__ int lds_byte(int r, int c) { const int st = (r >> 4) * 2 + (c >> 5), rr = r & 15, cc = c & 31, ob = rr * 64 + cc * 2; return st * 1024 + (ob ^ (((ob >> 9) & 1) << 5)); }
__host__ __device__ __forceinline__ void stage_rc(int b, int& R, int& C) { const int st = b / 1024, sb = b % 1024, swz = sb ^ (((sb >> 9) & 1) << 5); R = (st >> 1) * 16 + swz / 64; C = (st & 1) * 32 + (swz % 64) / 2; }
__host__ __device__ __forceinline__ int perm32(int rho) { const int n = rho >> 4, i = rho & 15; return 8 * (i >> 2) + 4 * n + (i & 3); }

struct Unit { int pm, pn, pc; };
struct Gemm { const bf16_t* A; const bf16_t* Bt; int M, N, K; };

struct StaticOrder {
    int nM, nN, nwg, G, c;
    __host__ __device__ void init(int M, int N, int G_, int c_) { nM = M / BM; nN = N / BM; nwg = nM * nN; G = G_; c = c_; }
    __host__ __device__ bool next(int i, Unit& u) const {
        const long L = (long)i * G + c; if (L >= nwg) return false;
        int wgid = (int)L; { const int q = nwg / NXCD, r = nwg % NXCD, xcd = wgid % NXCD, off = wgid / NXCD; wgid = (xcd < r ? xcd * (q + 1) : r * (q + 1) + (xcd - r) * q) + off; }
        const int nig = WGM * nN, gid = wgid / nig, fm = gid * WGM, gsz = (nM - fm) < WGM ? (nM - fm) : WGM;
        u.pm = fm + ((wgid % nig) % gsz); u.pn = (wgid % nig) / gsz; u.pc = u.pn; return true;
    }
    __device__ __forceinline__ void a_ready(const Unit&) const {}
    __device__ __forceinline__ void done(const Unit&) const {}
};

__device__ __forceinline__ unsigned cvt_pk_bf16(float lo, float hi) { unsigned r; asm volatile("v_cvt_pk_bf16_f32 %0, %1, %2" : "=v"(r) : "v"(lo), "v"(hi)); return r; }
typedef float f32x2 __attribute__((ext_vector_type(2)));

template <class Epi, class Sched, bool ALIGN_EPI = false, bool SP2 = false>
__device__ __forceinline__ void gemm_phase(PG8_LAS unsigned char* lds, const Gemm g, const Sched& S, const Epi& E, const int tid) {
    const int wid = __builtin_amdgcn_readfirstlane(tid >> 6), lane = tid & 63, wr = wid >> 2, wc = wid & 3, fr = lane & 15, fq = lane >> 4;
    const int K = g.K, nt = K / BK;
    unsigned voffA[2], voffB[2];
#pragma unroll
    for (int i = 0; i < 2; ++i) { int R, C; stage_rc(tid * 16 + i * 8192, R, C); const int Rb = Epi::PERM ? ((R & ~31) + perm32(R & 31)) : R;
        voffA[i] = (unsigned)(R * K + C) * 2u; voffB[i] = (unsigned)(Rb * K + C) * 2u; }
    const size_t kstep = (size_t)(BK * 2);
    const size_t hstep = (size_t)HALF * K * 2;
    const size_t tstep = 2 * hstep;
    const unsigned ldsw = (unsigned)wid * 1024u;
    const int aoff = lds_byte(wr * 64 + fr, fq * 8), boff = lds_byte(wc * 32 + fr, fq * 8);
#define PG8_SA(b, h) (((b) * 2 + (h)) * HTB)
#define PG8_SB(b, h) ((4 + (b) * 2 + (h)) * HTB)
#define PG8_STAGE(bufoff, gbase, voff) do { _Pragma("unroll") for (int _i = 0; _i < 2; ++_i) \
        __builtin_amdgcn_global_load_lds((const unsigned*)((const char*)(gbase) + (voff)[_i]), (PG8_LAS unsigned*)(lds + (bufoff) + ldsw + _i * 8192), 16, 0, 0); } while (0)
#define PG8_LDA(dst, b, h) do { _Pragma("unroll") for (int m = 0; m < 4; ++m) _Pragma("unroll") for (int k = 0; k < 2; ++k) dst[m][k] = *(const PG8_LAS bf16x8*)(lds + PG8_SA(b, h) + aoff + m * 2048 + k * 1024); } while (0)
#define PG8_LDB(dst, b, h) do { _Pragma("unroll") for (int n = 0; n < 2; ++n) _Pragma("unroll") for (int k = 0; k < 2; ++k) dst[n][k] = *(const PG8_LAS bf16x8*)(lds + PG8_SB(b, h) + boff + n * 2048 + k * 1024); } while (0)
#define PG8_MMA(ai, bj, At, Bt) do { __builtin_amdgcn_s_setprio(1); _Pragma("unroll") for (int m = 0; m < 4; ++m) _Pragma("unroll") for (int n = 0; n < 2; ++n) _Pragma("unroll") for (int k = 0; k < 2; ++k) \
        acc[ai][bj][m][n] = __builtin_amdgcn_mfma_f32_16x16x32_bf16(Bt[n][k], At[m][k], acc[ai][bj][m][n], 0, 0, 0); __builtin_amdgcn_s_setprio(0); } while (0)
#define PG8_WAIT_V(n) asm volatile("s_waitcnt vmcnt(" #n ")" ::: "memory")
#define PG8_WAIT_L(n) asm volatile("s_waitcnt lgkmcnt(" #n ")" ::: "memory")
#define PG8_BAR __builtin_amdgcn_s_barrier()
#define PG8_SCHED __builtin_amdgcn_sched_barrier(0)
    Unit cur, nxt; int ui = 0;
    if (!S.next(0, cur)) return;
    f32x4 acc[2][2][4][2];
#pragma unroll
    for (int a = 0; a < 2; ++a)
#pragma unroll
        for (int b = 0; b < 2; ++b)
#pragma unroll
            for (int m = 0; m < 4; ++m)
#pragma unroll
                for (int n = 0; n < 2; ++n) acc[a][b][m][n] = (f32x4){0.f, 0.f, 0.f, 0.f};
    bf16x8 At[4][2], B0[2][2], B1[2][2];
    const char* cA = (const char*)g.A + (size_t)cur.pm * tstep; const char* cB = (const char*)g.Bt + (size_t)cur.pn * tstep;
    S.a_ready(cur);
    if constexpr (SP2) {
        PG8_STAGE(PG8_SB(0, 0), cB, voffB); PG8_STAGE(PG8_SB(0, 1), cB + hstep, voffB); PG8_STAGE(PG8_SA(0, 0), cA, voffA); PG8_STAGE(PG8_SA(0, 1), cA + hstep, voffA);
        if (wr == 1) PG8_BAR;
        PG8_WAIT_V(2); PG8_BAR;
        PG8_STAGE(PG8_SB(1, 0), cB + kstep, voffB); PG8_STAGE(PG8_SA(1, 0), cA + kstep, voffA); PG8_STAGE(PG8_SB(1, 1), cB + hstep + kstep, voffB);
        PG8_WAIT_V(6); PG8_BAR;
    } else {
        PG8_STAGE(PG8_SB(0, 0), cB, voffB); PG8_STAGE(PG8_SA(0, 0), cA, voffA); PG8_STAGE(PG8_SB(0, 1), cB + hstep, voffB); PG8_STAGE(PG8_SA(0, 1), cA + hstep, voffA);
        if (wr == 1) PG8_BAR;
        PG8_WAIT_V(4); PG8_BAR;
        PG8_STAGE(PG8_SB(1, 0), cB + kstep, voffB); PG8_STAGE(PG8_SA(1, 0), cA + kstep, voffA); PG8_STAGE(PG8_SB(1, 1), cB + hstep + kstep, voffB);
        PG8_WAIT_V(6); PG8_BAR;
    }
    for (;;) {
        const bool has_next = S.next(ui + 1, nxt);
        const char* nA = has_next ? (const char*)g.A + (size_t)nxt.pm * tstep : cA; const char* nB = has_next ? (const char*)g.Bt + (size_t)nxt.pn * tstep : cB;
        for (int t = 0; t < nt; t += 2) {
            const bool last = (t == nt - 2);
            const char* a1 = cA + (size_t)(t + 1) * kstep;
            const char* a2 = last ? nA : cA + (size_t)(t + 2) * kstep; const char* b2 = last ? nB : cB + (size_t)(t + 2) * kstep;
            const char* a3 = a2 + kstep; const char* b3 = b2 + kstep;
            if (last && has_next) S.a_ready(nxt);
            if constexpr (SP2) {
            PG8_LDB(B0, 0, 0); PG8_LDB(B1, 0, 1); PG8_SCHED; PG8_LDA(At, 0, 0); PG8_STAGE(PG8_SA(1, 1), a1 + hstep, voffA);
            PG8_WAIT_V(8); PG8_WAIT_L(0); PG8_BAR; PG8_MMA(0, 0, At, B0); PG8_MMA(0, 1, At, B1); PG8_BAR; PG8_SCHED;
            PG8_LDA(At, 0, 1); PG8_STAGE(PG8_SB(0, 0), b2, voffB); PG8_STAGE(PG8_SB(0, 1), b2 + hstep, voffB); PG8_STAGE(PG8_SA(0, 0), a2, voffA);
            PG8_WAIT_V(8); PG8_WAIT_L(0); PG8_BAR; PG8_MMA(1, 0, At, B0); PG8_MMA(1, 1, At, B1); PG8_BAR; PG8_SCHED;
            PG8_LDB(B0, 1, 0); PG8_LDB(B1, 1, 1); PG8_SCHED; PG8_LDA(At, 1, 0); PG8_STAGE(PG8_SA(0, 1), a2 + hstep, voffA);
            PG8_WAIT_V(8); PG8_WAIT_L(0); PG8_BAR; PG8_MMA(0, 0, At, B0); PG8_MMA(0, 1, At, B1); PG8_BAR; PG8_SCHED;
            PG8_LDA(At, 1, 1); PG8_STAGE(PG8_SB(1, 0), b3, voffB); PG8_STAGE(PG8_SB(1, 1), b3 + hstep, voffB); PG8_STAGE(PG8_SA(1, 0), a3, voffA);
            PG8_WAIT_V(8); PG8_WAIT_L(0); PG8_BAR; PG8_MMA(1, 0, At, B0); PG8_MMA(1, 1, At, B1); PG8_BAR; PG8_SCHED;
            } else {
            PG8_LDB(B0, 0, 0); PG8_SCHED; PG8_LDA(At, 0, 0); PG8_STAGE(PG8_SA(1, 1), a1 + hstep, voffA);
            PG8_WAIT_L(8); PG8_BAR; PG8_WAIT_L(0); PG8_MMA(0, 0, At, B0); PG8_BAR; PG8_SCHED;
            PG8_LDB(B1, 0, 1); PG8_STAGE(PG8_SB(0, 0), b2, voffB);
            PG8_BAR; PG8_WAIT_L(0); PG8_MMA(0, 1, At, B1); PG8_BAR;
            PG8_LDA(At, 0, 1); PG8_STAGE(PG8_SA(0, 0), a2, voffA);
            PG8_BAR; PG8_WAIT_L(0); PG8_MMA(1, 0, At, B0); PG8_BAR; PG8_SCHED;
            PG8_STAGE(PG8_SB(0, 1), b2 + hstep, voffB);
            PG8_WAIT_V(6); PG8_BAR; PG8_MMA(1, 1, At, B1); PG8_BAR;
            PG8_LDB(B0, 1, 0); PG8_SCHED; PG8_LDA(At, 1, 0); PG8_STAGE(PG8_SA(0, 1), a2 + hstep, voffA);
            PG8_WAIT_L(8); PG8_BAR; PG8_WAIT_L(0); PG8_MMA(0, 0, At, B0); PG8_BAR; PG8_SCHED;
            PG8_LDB(B1, 1, 1); PG8_STAGE(PG8_SB(1, 0), b3, voffB);
            PG8_BAR; PG8_WAIT_L(0); PG8_MMA(0, 1, At, B1); PG8_BAR;
            PG8_LDA(At, 1, 1); PG8_STAGE(PG8_SA(1, 0), a3, voffA);
            PG8_BAR; PG8_WAIT_L(0); PG8_MMA(1, 0, At, B0); PG8_BAR; PG8_SCHED;
            PG8_STAGE(PG8_SB(1, 1), b3 + hstep, voffB);
            PG8_WAIT_V(6); PG8_BAR; PG8_MMA(1, 1, At, B1); PG8_BAR;
            }
        }
        if constexpr (ALIGN_EPI) { if (wr == 0) PG8_BAR; }
        if constexpr (!Epi::AFTER_DRAIN) { E(acc, cur, wr, wc, fr, fq); S.done(cur); }
        if (!has_next) break;
#pragma unroll
        for (int a = 0; a < 2; ++a)
#pragma unroll
            for (int b = 0; b < 2; ++b)
#pragma unroll
                for (int m = 0; m < 4; ++m)
#pragma unroll
                    for (int n = 0; n < 2; ++n) acc[a][b][m][n] = (f32x4){0.f, 0.f, 0.f, 0.f};
        cur = nxt; cA = nA; cB = nB; ++ui;
        if constexpr (ALIGN_EPI) { if (wr == 1) PG8_BAR; }
    }
    PG8_WAIT_V(0);
    if constexpr (!ALIGN_EPI) { if (wr == 0) PG8_BAR; }
    PG8_BAR;
    if constexpr (Epi::AFTER_DRAIN) { E.fused(acc, cur, wr, wc, fr, fq, lds, wid, lane); S.done(cur); }
#undef PG8_SA
#undef PG8_SB
#undef PG8_STAGE
#undef PG8_LDA
#undef PG8_LDB
#undef PG8_MMA
#undef PG8_WAIT_V
#undef PG8_WAIT_L
#undef PG8_BAR
#undef PG8_SCHED
}
typedef int v8i_t __attribute__((ext_vector_type(8)));
typedef int v4i_t __attribute__((ext_vector_type(4)));
template <class Epi, class Sched, bool ALIGN_EPI = false, bool SP2 = false>
__device__ __forceinline__ void gemm_phase_f8(PG8_LAS unsigned char* lds, const Gemm g, const Sched& S, const Epi& E, const int tid) {
    const int wid = __builtin_amdgcn_readfirstlane(tid >> 6), lane = tid & 63, wr = wid >> 2, wc = wid & 3, fr = lane & 15, fq = lane >> 4;
    const int K = g.K, nt = K / BK;
    unsigned voffA[2], voffB[2];
#pragma unroll
    for (int i = 0; i < 2; ++i) { int R, C; stage_rc(tid * 16 + i * 8192, R, C); const int Rb = Epi::PERM ? ((R & ~31) + perm32(R & 31)) : R;
        voffA[i] = (unsigned)(R * K + C) * 2u; voffB[i] = (unsigned)(Rb * K + C) * 2u; }
    const size_t kstep = (size_t)(BK * 2);
    const size_t hstep = (size_t)HALF * K * 2;
    const size_t tstep = 2 * hstep;
    const unsigned ldsw = (unsigned)wid * 1024u;
    const int aoff0 = lds_byte(wr * 64 + fr, fq * 16), aoff1 = lds_byte(wr * 64 + fr, fq * 16 + 8), boff0 = lds_byte(wc * 32 + fr, fq * 16), boff1 = lds_byte(wc * 32 + fr, fq * 16 + 8);
#define PG8_SA(b, h) (((b) * 2 + (h)) * HTB)
#define PG8_SB(b, h) ((4 + (b) * 2 + (h)) * HTB)
#define PG8_STAGE(bufoff, gbase, voff) do { _Pragma("unroll") for (int _i = 0; _i < 2; ++_i) \
        __builtin_amdgcn_global_load_lds((const unsigned*)((const char*)(gbase) + (voff)[_i]), (PG8_LAS unsigned*)(lds + (bufoff) + ldsw + _i * 8192), 16, 0, 0); } while (0)
#define PG8_LDA(dst, b, h) do { _Pragma("unroll") for (int m = 0; m < 4; ++m) { const u32x4 lo_ = *(const PG8_LAS u32x4*)(lds + PG8_SA(b, h) + aoff0 + m * 2048), hi_ = *(const PG8_LAS u32x4*)(lds + PG8_SA(b, h) + aoff1 + m * 2048); \
        dst[m] = __builtin_shufflevector((v4i_t)lo_, (v4i_t)hi_, 0, 1, 2, 3, 4, 5, 6, 7); } } while (0)
#define PG8_LDB(dst, b, h) do { _Pragma("unroll") for (int n = 0; n < 2; ++n) { const u32x4 lo_ = *(const PG8_LAS u32x4*)(lds + PG8_SB(b, h) + boff0 + n * 2048), hi_ = *(const PG8_LAS u32x4*)(lds + PG8_SB(b, h) + boff1 + n * 2048); \
        dst[n] = __builtin_shufflevector((v4i_t)lo_, (v4i_t)hi_, 0, 1, 2, 3, 4, 5, 6, 7); } } while (0)
#define PG8_MMA(ai, bj, At, Bt) do { __builtin_amdgcn_s_setprio(1); _Pragma("unroll") for (int m = 0; m < 4; ++m) _Pragma("unroll") for (int n = 0; n < 2; ++n) \
        asm volatile("v_mfma_scale_f32_16x16x128_f8f6f4 %0, %1, %2, %0, %3, %3 op_sel_hi:[0,0,0]" : "+v"(acc[ai][bj][m][n]) : "v"(Bt[n]), "v"(At[m]), "v"(one_scale)); __builtin_amdgcn_s_setprio(0); } while (0)
#define PG8_WAIT_V(n) asm volatile("s_waitcnt vmcnt(" #n ")" ::: "memory")
#define PG8_WAIT_L(n) asm volatile("s_waitcnt lgkmcnt(" #n ")" ::: "memory")
#define PG8_BAR __builtin_amdgcn_s_barrier()
#define PG8_SCHED __builtin_amdgcn_sched_barrier(0)
    Unit cur, nxt; int ui = 0;
    if (!S.next(0, cur)) return;
    f32x4 acc[2][2][4][2];
#pragma unroll
    for (int a = 0; a < 2; ++a)
#pragma unroll
        for (int b = 0; b < 2; ++b)
#pragma unroll
            for (int m = 0; m < 4; ++m)
#pragma unroll
                for (int n = 0; n < 2; ++n) acc[a][b][m][n] = (f32x4){0.f, 0.f, 0.f, 0.f};
    v8i_t At[4], B0[2], B1[2]; const int one_scale = 0x7f7f7f7f;
    const char* cA = (const char*)g.A + (size_t)cur.pm * tstep; const char* cB = (const char*)g.Bt + (size_t)cur.pn * tstep;
    S.a_ready(cur);
    if constexpr (SP2) {
        PG8_STAGE(PG8_SB(0, 0), cB, voffB); PG8_STAGE(PG8_SB(0, 1), cB + hstep, voffB); PG8_STAGE(PG8_SA(0, 0), cA, voffA); PG8_STAGE(PG8_SA(0, 1), cA + hstep, voffA);
        if (wr == 1) PG8_BAR;
        PG8_WAIT_V(2); PG8_BAR;
        PG8_STAGE(PG8_SB(1, 0), cB + kstep, voffB); PG8_STAGE(PG8_SA(1, 0), cA + kstep, voffA); PG8_STAGE(PG8_SB(1, 1), cB + hstep + kstep, voffB);
        PG8_WAIT_V(6); PG8_BAR;
    } else {
        PG8_STAGE(PG8_SB(0, 0), cB, voffB); PG8_STAGE(PG8_SA(0, 0), cA, voffA); PG8_STAGE(PG8_SB(0, 1), cB + hstep, voffB); PG8_STAGE(PG8_SA(0, 1), cA + hstep, voffA);
        if (wr == 1) PG8_BAR;
        PG8_WAIT_V(4); PG8_BAR;
        PG8_STAGE(PG8_SB(1, 0), cB + kstep, voffB); PG8_STAGE(PG8_SA(1, 0), cA + kstep, voffA); PG8_STAGE(PG8_SB(1, 1), cB + hstep + kstep, voffB);
        PG8_WAIT_V(6); PG8_BAR;
    }
    for (;;) {
        const bool has_next = S.next(ui + 1, nxt);
        const char* nA = has_next ? (const char*)g.A + (size_t)nxt.pm * tstep : cA; const char* nB = has_next ? (const char*)g.Bt + (size_t)nxt.pn * tstep : cB;
        for (int t = 0; t < nt; t += 2) {
            const bool last = (t == nt - 2);
            const char* a1 = cA + (size_t)(t + 1) * kstep;
            const char* a2 = last ? nA : cA + (size_t)(t + 2) * kstep; const char* b2 = last ? nB : cB + (size_t)(t + 2) * kstep;
            const char* a3 = a2 + kstep; const char* b3 = b2 + kstep;
            if (last && has_next) S.a_ready(nxt);
            if constexpr (SP2) {
            PG8_LDB(B0, 0, 0); PG8_LDB(B1, 0, 1); PG8_SCHED; PG8_LDA(At, 0, 0); PG8_STAGE(PG8_SA(1, 1), a1 + hstep, voffA);
            PG8_WAIT_V(8); PG8_WAIT_L(0); PG8_BAR; PG8_MMA(0, 0, At, B0); PG8_MMA(0, 1, At, B1); PG8_BAR; PG8_SCHED;
            PG8_LDA(At, 0, 1); PG8_STAGE(PG8_SB(0, 0), b2, voffB); PG8_STAGE(PG8_SB(0, 1), b2 + hstep, voffB); PG8_STAGE(PG8_SA(0, 0), a2, voffA);
            PG8_WAIT_V(8); PG8_WAIT_L(0); PG8_BAR; PG8_MMA(1, 0, At, B0); PG8_MMA(1, 1, At, B1); PG8_BAR; PG8_SCHED;
            PG8_LDB(B0, 1, 0); PG8_LDB(B1, 1, 1); PG8_SCHED; PG8_LDA(At, 1, 0); PG8_STAGE(PG8_SA(0, 1), a2 + hstep, voffA);
            PG8_WAIT_V(8); PG8_WAIT_L(0); PG8_BAR; PG8_MMA(0, 0, At, B0); PG8_MMA(0, 1, At, B1); PG8_BAR; PG8_SCHED;
            PG8_LDA(At, 1, 1); PG8_STAGE(PG8_SB(1, 0), b3, voffB); PG8_STAGE(PG8_SB(1, 1), b3 + hstep, voffB); PG8_STAGE(PG8_SA(1, 0), a3, voffA);
            PG8_WAIT_V(8); PG8_WAIT_L(0); PG8_BAR; PG8_MMA(1, 0, At, B0); PG8_MMA(1, 1, At, B1); PG8_BAR; PG8_SCHED;
            } else {
            PG8_LDB(B0, 0, 0); PG8_SCHED; PG8_LDA(At, 0, 0); PG8_STAGE(PG8_SA(1, 1), a1 + hstep, voffA);
            PG8_WAIT_L(8); PG8_BAR; PG8_WAIT_L(0); PG8_MMA(0, 0, At, B0); PG8_BAR; PG8_SCHED;
            PG8_LDB(B1, 0, 1); PG8_STAGE(PG8_SB(0, 0), b2, voffB);
            PG8_BAR; PG8_WAIT_L(0); PG8_MMA(0, 1, At, B1); PG8_BAR;
            PG8_LDA(At, 0, 1); PG8_STAGE(PG8_SA(0, 0), a2, voffA);
            PG8_BAR; PG8_WAIT_L(0); PG8_MMA(1, 0, At, B0); PG8_BAR; PG8_SCHED;
            PG8_STAGE(PG8_SB(0, 1), b2 + hstep, voffB);
            PG8_WAIT_V(6); PG8_BAR; PG8_MMA(1, 1, At, B1); PG8_BAR;
            PG8_LDB(B0, 1, 0); PG8_SCHED; PG8_LDA(At, 1, 0); PG8_STAGE(PG8_SA(0, 1), a2 + hstep, voffA);
            PG8_WAIT_L(8); PG8_BAR; PG8_WAIT_L(0); PG8_MMA(0, 0, At, B0); PG8_BAR; PG8_SCHED;
            PG8_LDB(B1, 1, 1); PG8_STAGE(PG8_SB(1, 0), b3, voffB);
            PG8_BAR; PG8_WAIT_L(0); PG8_MMA(0, 1, At, B1); PG8_BAR;
            PG8_LDA(At, 1, 1); PG8_STAGE(PG8_SA(1, 0), a3, voffA);
            PG8_BAR; PG8_WAIT_L(0); PG8_MMA(1, 0, At, B0); PG8_BAR; PG8_SCHED;
            PG8_STAGE(PG8_SB(1, 1), b3 + hstep, voffB);
            PG8_WAIT_V(6); PG8_BAR; PG8_MMA(1, 1, At, B1); PG8_BAR;
            }
        }
        if constexpr (ALIGN_EPI) { if (wr == 0) PG8_BAR; }
        asm volatile("s_nop 15\n\ts_nop 15" ::: "memory");
        if constexpr (!Epi::AFTER_DRAIN) { E(acc, cur, wr, wc, fr, fq); S.done(cur); }
        if (!has_next) break;
#pragma unroll
        for (int a = 0; a < 2; ++a)
#pragma unroll
            for (int b = 0; b < 2; ++b)
#pragma unroll
                for (int m = 0; m < 4; ++m)
#pragma unroll
                    for (int n = 0; n < 2; ++n) acc[a][b][m][n] = (f32x4){0.f, 0.f, 0.f, 0.f};
        cur = nxt; cA = nA; cB = nB; ++ui;
        if constexpr (ALIGN_EPI) { if (wr == 1) PG8_BAR; }
    }
    PG8_WAIT_V(0);
    if constexpr (!ALIGN_EPI) { if (wr == 0) PG8_BAR; }
    PG8_BAR;
    if constexpr (Epi::AFTER_DRAIN) { E.fused(acc, cur, wr, wc, fr, fq, lds, wid, lane); S.done(cur); }
#undef PG8_SA
#undef PG8_SB
#undef PG8_STAGE
#undef PG8_LDA
#undef PG8_LDB
#undef PG8_MMA
#undef PG8_WAIT_V
#undef PG8_WAIT_L
#undef PG8_BAR
#undef PG8_SCHED
}
}

#define XB_TMO      128
#define XB_XCNT(j)  (256  + 64 * (j))
#define XB_XSUB(j)  (1280 + 64 * (j))
#define XB_XGEN(j)  (2304 + 64 * (j))
#define XB_TOP      3328
#define XB_TOPGEN   3392
#define XCD_BAR_WORDS 3456
#define XB_SPIN_CAP (1u << 18)

__device__ __forceinline__ unsigned xb_ld(unsigned* p)              { return __hip_atomic_load(p, __ATOMIC_RELAXED, __HIP_MEMORY_SCOPE_AGENT); }
__device__ __forceinline__ unsigned xb_add(unsigned* p, unsigned v) { return __hip_atomic_fetch_add(p, v, __ATOMIC_RELAXED, __HIP_MEMORY_SCOPE_AGENT); }
__device__ __forceinline__ unsigned xb_xcc_id() { return (unsigned)__builtin_amdgcn_s_getreg((3 << 11) | 20) & 0xFu; }
#define XB_SPIN(cond, bar) do { unsigned _sp = 0; while (cond) { __builtin_amdgcn_s_sleep(1); \
    if ((++_sp & 255u) == 0u) { if (xb_ld(&(bar)[XB_TMO])) break; if (_sp > XB_SPIN_CAP) { atomicAdd(&(bar)[XB_TMO], 1u); break; } } } } while (0)

struct XcdBarrier {
    unsigned* bar; unsigned x;
    volatile LAS unsigned* st;
};

__device__ __forceinline__ XcdBarrier xcd_barrier_post(unsigned* bar, volatile LAS unsigned* st, const int xb_tid) {
    XcdBarrier b; b.bar = bar; b.x = xb_xcc_id(); b.st = st;
    if (xb_tid == 0) (void)xb_add(&bar[XB_XCNT(b.x)], 1u);
    return b;
}
__device__ __forceinline__ void xcd_barrier_complete(unsigned* bar, unsigned x, unsigned& nloc, unsigned& nx) {
    const unsigned G = gridDim.x * gridDim.y * gridDim.z;
    unsigned sum, cnt, mine, sp = 0u;
    for (;;) {
        sum = 0u; cnt = 0u; mine = 0u;
#pragma unroll
        for (unsigned j = 0; j < 16; ++j) { const unsigned c = xb_ld(&bar[XB_XCNT(j)]); sum += c; cnt += (c > 0u) ? 1u : 0u; mine = (j == x) ? c : mine; }
        if (sum == G) break;
        __builtin_amdgcn_s_sleep(1);
        if ((++sp & 255u) == 0u) { if (xb_ld(&bar[XB_TMO])) break; if (sp > XB_SPIN_CAP) { atomicAdd(&bar[XB_TMO], 1u); break; } }
    }
    nloc = mine > 0u ? mine : 1u; nx = cnt > 0u ? cnt : 1u;
}

__device__ __forceinline__ void xcd_barrier(const XcdBarrier& b, const int xb_tid) {
    asm volatile("s_waitcnt vmcnt(0)" ::: "memory");
    __syncthreads();
    if (xb_tid == 0) {
        unsigned* bar = b.bar;
        __builtin_amdgcn_s_waitcnt(0);
        unsigned nloc = b.st[0], nx = b.st[1];
        if (nloc == 0u) { xcd_barrier_complete(bar, b.x, nloc, nx); b.st[0] = nloc; b.st[1] = nx; }
        const unsigned old = xb_add(&bar[XB_XSUB(b.x)], 1u);
        const unsigned gen = old / nloc;
        if (old + 1u == (gen + 1u) * nloc) {
            __builtin_amdgcn_fence(__ATOMIC_RELEASE, "agent");
            asm volatile("s_waitcnt vmcnt(0)" ::: "memory");
            const unsigned og = xb_add(&bar[XB_TOP], 1u);
            const unsigned tg = og / nx;
            if (og + 1u == (tg + 1u) * nx) xb_add(&bar[XB_TOPGEN], 1u);
            else XB_SPIN(xb_ld(&bar[XB_TOPGEN]) == tg, bar);
            __builtin_amdgcn_fence(__ATOMIC_ACQUIRE, "agent");
            xb_add(&bar[XB_XGEN(b.x)], 1u);
            asm volatile("s_waitcnt vmcnt(0)" ::: "memory");
        } else {
            XB_SPIN(xb_ld(&bar[XB_XGEN(b.x)]) == gen, bar);
            __builtin_amdgcn_fence(__ATOMIC_ACQUIRE, "agent");
            asm volatile("s_waitcnt vmcnt(0)" ::: "memory");
        }
    }
    __syncthreads();
}

#define GAS __attribute__((address_space(1)))
typedef unsigned short bf16;
typedef unsigned v4u __attribute__((ext_vector_type(4)));
typedef unsigned v2u __attribute__((ext_vector_type(2)));
typedef float f32x4 __attribute__((ext_vector_type(4)));

constexpr int NB = 4, SEQ = 8192, DM = 1024, DEPTH = 4, CTXL = 256;
constexpr int NLAT = NB * SEQ, NCTX = NB * CTXL, MT = NLAT + NCTX;
constexpr int DIN = 3360, DINP = 3584, DFF = 2816, NEXP = 8;
constexpr int C_RQ = 0, C_RK = 256, C_RV = 512, C_RG = 768, C_S5 = 1024, C_HQ = 1280, C_HFF = 1536, C_HFB = 1792, C_HI = 2048, C_HG = 2304,
              C_GQ = 2560, C_GK = 2688, C_GV = 2816, C_GG = 3072, C_GAF = 3328, C_GAB = 3344,
              C_GZF = 3328, C_GZB = 3456;
constexpr int NSEG = 132;
constexpr int MOE_CAP_TILES = 272;
constexpr float NEPS = 1e-6f;
constexpr float WSC8 = 64.0f;

constexpr size_t MiB = 1u << 20;
constexpr size_t WS_CTL = 0, CTL_ZERO_BYTES = 2 * MiB;
constexpr size_t WS_MOD = 2 * MiB;
constexpr size_t WS_LB = 3 * MiB;
constexpr size_t WS_ROPE = 3 * MiB + 65536;
constexpr size_t WS_GLUW = 3 * MiB + 131072;
constexpr size_t WS_WIN = 4 * MiB;
constexpr size_t WS_WOUT = 32 * MiB;
constexpr size_t WS_W13D = 40 * MiB;
constexpr size_t WS_W2D = 62 * MiB;
constexpr size_t WS_W13M = 73 * MiB;
constexpr size_t WS_W2M = 161 * MiB;
constexpr size_t WS_HB = 205 * MiB;
constexpr size_t WS_ACT = 209 * MiB;
constexpr size_t WS_Z = 275 * MiB;
constexpr size_t WS_PH = 292 * MiB;
constexpr size_t WS_OF = (292 + 232) * MiB;
constexpr size_t WS_X2 = 666 * MiB;
constexpr size_t WS_LIST = 843 * MiB;
constexpr size_t WS_END = 846 * MiB;
constexpr size_t ST_DS0 = 0;
constexpr size_t ST_DS1 = ST_DS0 + (size_t)2 * 16 * NSEG * 4096;
constexpr size_t ST_DS2 = ST_DS1 + (size_t)2 * 16 * NSEG * 4096;
constexpr size_t ST_G0 = ST_DS2 + (size_t)2 * 16 * NSEG * 2048;
constexpr size_t ST_G1 = ST_G0 + (size_t)2 * 16 * NSEG * 64;
constexpr size_t ST_G2 = ST_G1 + (size_t)2 * 16 * NSEG * 64;
constexpr size_t ST_HS = ST_G2 + (size_t)2 * 16 * NSEG * 64;
constexpr size_t ST_END = ST_HS + (size_t)2 * 64 * NSEG * 128;
static_assert(ST_END * 4 <= (WS_LIST - WS_X2), "state region");
static_assert(WS_PH + (size_t)MT * DINP * 2 <= WS_OF && WS_OF + (size_t)MT * 768 * 4 <= WS_X2, "OF region");
static_assert((size_t)MOE_CAP_TILES * 256 * 1024 * 2 <= (WS_LIST - WS_X2), "XB region");
static_assert((size_t)MOE_CAP_TILES * 256 * DFF * 2 <= (WS_X2 - WS_PH) && (size_t)MT * DINP * 2 <= (WS_X2 - WS_PH), "P/H region");
constexpr int CW_BAR = 4096;
constexpr int CW_CNT = 16384;

constexpr int LDS_BYTES = 163840;
constexpr int MISC_OFF = 163840 - 512;

__device__ __forceinline__ float bf2f(unsigned short h) { return __uint_as_float(((unsigned)h) << 16); }
__device__ __forceinline__ unsigned f2bf(float f) { unsigned u = __float_as_uint(f); return (u + 0x7fffu + ((u >> 16) & 1u)) >> 16; }
__device__ __forceinline__ unsigned pk2(float lo, float hi) { return f2bf(lo) | (f2bf(hi) << 16); }
__device__ __forceinline__ float wave_sum(float v) {
#define WS_DPP(ctrl, rmask) v += __int_as_float(__builtin_amdgcn_update_dpp(0, __float_as_int(v), (ctrl), (rmask), 0xf, false))
    WS_DPP(0x111, 0xf); WS_DPP(0x112, 0xf); WS_DPP(0x114, 0xf); WS_DPP(0x118, 0xf); WS_DPP(0x142, 0xa); WS_DPP(0x143, 0xc);
#undef WS_DPP
    return __int_as_float(__builtin_amdgcn_readlane(__float_as_int(v), 63));
}
__device__ __forceinline__ float rdl(float v, int k) { return __uint_as_float((unsigned)__builtin_amdgcn_readlane((int)__float_as_uint(v), k)); }
__device__ __forceinline__ float sigm(float x) { return 1.0f / (1.0f + __expf(-x)); }
__device__ __forceinline__ float silu_f(float x) { return x / (1.0f + __expf(-x)); }
#define LDS_WAIT() asm volatile("s_waitcnt lgkmcnt(0)" ::: "memory")

struct Args {
    const float* in[37];
    int l_lo, l_hi, ph_lo, ph_hi, do_pro, do_fin, fused, pad;
};
constexpr int I_OUT = 35, I_WS = 36;
enum { I_X = 0, I_C, I_CTX, I_CCTX, I_ADAW, I_ADAB, I_N1W, I_N2W, I_WIN, I_WOUT, I_RETGN, I_LAMRE, I_LAMIM, I_LOGDT, I_BRE, I_BIM, I_CRE, I_CIM, I_S5D,
       I_GLUW, I_GLUB, I_LBL, I_HGNW, I_WA2, I_BA, I_GLANW, I_FW1, I_FW3, I_FW2, I_RW, I_RB, I_MW1, I_MW3, I_MW2, I_FINW };

struct Frame {
    LAS unsigned char* lds;
    int tid, lane, wave, gw, NGW, G, zz;
    unsigned char* ws; float* out;
};

struct EpiStoreBf16 {
    static constexpr bool PERM = true, AFTER_DRAIN = false;
    bf16* O; int ldc; float sc;
    __device__ __forceinline__ void operator()(const pg8::f32x4 (&acc)[2][2][4][2], const pg8::Unit& u, int wr, int wc, int fr, int fq) const {
        const int row0 = u.pm * 256 + wr * 64 + fr, col0 = u.pc * 256 + wc * 32 + 8 * fq;
#pragma unroll
        for (int ai = 0; ai < 2; ++ai)
#pragma unroll
            for (int m = 0; m < 4; ++m) { bf16* rowp = O + (size_t)(row0 + ai * 128 + m * 16) * ldc + col0;
#pragma unroll
                for (int bj = 0; bj < 2; ++bj) { const pg8::f32x4 v0 = acc[ai][bj][m][0] * sc, v1 = acc[ai][bj][m][1] * sc;
                    pg8::u32x4 w; w.x = pg8::cvt_pk_bf16(v0[0], v0[1]); w.y = pg8::cvt_pk_bf16(v0[2], v0[3]); w.z = pg8::cvt_pk_bf16(v1[0], v1[1]); w.w = pg8::cvt_pk_bf16(v1[2], v1[3]);
                    *(pg8::u32x4*)(rowp + bj * 128) = w; } }
    }
};
struct EpiSwiglu {
    static constexpr bool PERM = true, AFTER_DRAIN = false;
    bf16* H;
    __device__ __forceinline__ void operator()(const pg8::f32x4 (&acc)[2][2][4][2], const pg8::Unit& u, int wr, int wc, int fr, int fq) const {
        const int row0 = u.pm * 256 + wr * 64 + fr, col0 = u.pc * 128 + wc * 32 + 8 * fq;
#pragma unroll
        for (int ai = 0; ai < 2; ++ai)
#pragma unroll
            for (int m = 0; m < 4; ++m) { bf16* rowp = H + (size_t)(row0 + ai * 128 + m * 16) * DFF + col0;
                float h[8];
#pragma unroll
                for (int n = 0; n < 2; ++n)
#pragma unroll
                    for (int j = 0; j < 4; ++j) { const float a = acc[ai][0][m][n][j], b = acc[ai][1][m][n][j];
                        h[n * 4 + j] = a * __builtin_amdgcn_rcpf(1.0f + __builtin_amdgcn_exp2f(-1.4426950408889634f * a)) * b; }
                pg8::u32x4 w; w.x = pg8::cvt_pk_bf16(h[0], h[1]); w.y = pg8::cvt_pk_bf16(h[2], h[3]); w.z = pg8::cvt_pk_bf16(h[4], h[5]); w.w = pg8::cvt_pk_bf16(h[6], h[7]);
                *(pg8::u32x4*)rowp = w; }
    }
};
struct EpiSwiglu8 {
    static constexpr bool PERM = true, AFTER_DRAIN = false;
    unsigned char* H; float sc;
    __device__ __forceinline__ void operator()(const pg8::f32x4 (&acc)[2][2][4][2], const pg8::Unit& u, int wr, int wc, int fr, int fq) const {
        const int row0 = u.pm * 256 + wr * 64 + fr, col0 = u.pc * 128 + wc * 32 + 8 * fq;
#pragma unroll
        for (int ai = 0; ai < 2; ++ai)
#pragma unroll
            for (int m = 0; m < 4; ++m) { unsigned char* rowp = H + (size_t)(row0 + ai * 128 + m * 16) * DFF + col0;
                float h[8];
#pragma unroll
                for (int n = 0; n < 2; ++n)
#pragma unroll
                    for (int j = 0; j < 4; ++j) { const float a = acc[ai][0][m][n][j] * sc, b = acc[ai][1][m][n][j] * sc;
                        const float hv = a * __builtin_amdgcn_rcpf(1.0f + __builtin_amdgcn_exp2f(-1.4426950408889634f * a)) * b;
                        h[n * 4 + j] = fminf(fmaxf(hv, -448.0f), 448.0f); }
                unsigned w0 = 0u, w1 = 0u;
                w0 = __builtin_amdgcn_cvt_pk_fp8_f32(h[0], h[1], w0, false); w0 = __builtin_amdgcn_cvt_pk_fp8_f32(h[2], h[3], w0, true);
                w1 = __builtin_amdgcn_cvt_pk_fp8_f32(h[4], h[5], w1, false); w1 = __builtin_amdgcn_cvt_pk_fp8_f32(h[6], h[7], w1, true);
                v2u w; w.x = w0; w.y = w1; *(v2u*)rowp = w; }
    }
};
struct EpiResid {
    static constexpr bool PERM = false, AFTER_DRAIN = false;
    const float* xin_lat; const float* xin_ctx; float* xout_lat; float* xout_ctx; const float* gate; float sc;
    __device__ __forceinline__ void operator()(const pg8::f32x4 (&acc)[2][2][4][2], const pg8::Unit& u, int wr, int wc, int fr, int fq) const {
        const bool isctx = u.pm >= 128; const int bidx = isctx ? 4 : (u.pm >> 5);
        const size_t rbase = (size_t)(isctx ? (u.pm - 128) : u.pm) * 256 + wr * 64 + fr;
        const float* xi = (isctx ? xin_ctx : xin_lat); float* xo = (isctx ? xout_ctx : xout_lat);
        const int col0 = u.pc * 256 + wc * 32 + 4 * fq; const float* g = gate + (size_t)bidx * 6144 + col0;
        pg8::f32x4 gv[2][2];
#pragma unroll
        for (int bj = 0; bj < 2; ++bj)
#pragma unroll
            for (int n = 0; n < 2; ++n) gv[bj][n] = *(const pg8::f32x4*)(g + bj * 128 + n * 16) * sc;
#pragma unroll
        for (int ai = 0; ai < 2; ++ai)
#pragma unroll
            for (int m = 0; m < 4; ++m) { const size_t off = (rbase + ai * 128 + m * 16) * 1024 + col0;
#pragma unroll
                for (int bj = 0; bj < 2; ++bj)
#pragma unroll
                    for (int n = 0; n < 2; ++n) { const pg8::f32x4 xv = *(const pg8::f32x4*)(xi + off + bj * 128 + n * 16);
                        *(pg8::f32x4*)(xo + off + bj * 128 + n * 16) = xv + gv[bj][n] * acc[ai][bj][m][n]; }
                asm volatile("" ::: "memory"); }
    }
};
struct EpiGlu {
    static constexpr bool PERM = true, AFTER_DRAIN = false;
    const bf16* Z; bf16* Y; const float* bias;
    __device__ __forceinline__ void operator()(const pg8::f32x4 (&acc)[2][2][4][2], const pg8::Unit& u, int wr, int wc, int fr, int fq) const {
        const int row0 = u.pm * 256 + wr * 64 + fr, col0 = wc * 32 + 8 * fq;
#pragma unroll
        for (int ai = 0; ai < 2; ++ai)
#pragma unroll
            for (int m = 0; m < 4; ++m) { const size_t row = (size_t)(row0 + ai * 128 + m * 16);
#pragma unroll
                for (int bj = 0; bj < 2; ++bj) { const int col = col0 + bj * 128;
                    const pg8::u32x4 zz = *(const pg8::u32x4*)(Z + row * 256 + col);
                    const pg8::f32x4 b0 = *(const pg8::f32x4*)(bias + col), b1 = *(const pg8::f32x4*)(bias + col + 4);
                    const pg8::f32x4 v0 = acc[ai][bj][m][0] + b0, v1 = acc[ai][bj][m][1] + b1;
                    float o[8]; const unsigned zw[4] = {zz.x, zz.y, zz.z, zz.w};
#pragma unroll
                    for (int j = 0; j < 4; ++j) { const float zl = __uint_as_float(zw[j] << 16), zh = __uint_as_float(zw[j] & 0xffff0000u);
                        const float a0 = (j < 2) ? v0[2 * j] : v1[2 * j - 4], a1 = (j < 2) ? v0[2 * j + 1] : v1[2 * j - 3];
                        o[2 * j] = zl * sigm(a0); o[2 * j + 1] = zh * sigm(a1); }
                    pg8::u32x4 w; w.x = pg8::cvt_pk_bf16(o[0], o[1]); w.y = pg8::cvt_pk_bf16(o[2], o[3]); w.z = pg8::cvt_pk_bf16(o[4], o[5]); w.w = pg8::cvt_pk_bf16(o[6], o[7]);
                    *(pg8::u32x4*)(Y + row * 1024 + 256 + col) = w; }
                asm volatile("" ::: "memory"); }
    }
};
struct MoeOrder {
    int tp[9]; int nN, G, c, total;
    __device__ __forceinline__ void init(const unsigned* cnt, int nN_, int G_, int c_) {
        tp[0] = 0;
#pragma unroll
        for (int e = 0; e < 8; ++e) tp[e + 1] = tp[e] + (int)(((unsigned)__builtin_amdgcn_readfirstlane((int)__hip_atomic_load(cnt + e * 64, __ATOMIC_RELAXED, __HIP_MEMORY_SCOPE_AGENT)) + 255u) >> 8);
        nN = nN_; G = G_; c = c_; total = tp[8] * nN;
    }
    __device__ __forceinline__ bool next(int i, pg8::Unit& u) const {
        const int L = i * G + c; if (L >= total) return false;
        const int t = L / nN, pn = L - t * nN; int e = 0;
#pragma unroll
        for (int k = 1; k < 8; ++k) e += (t >= tp[k]) ? 1 : 0;
        u.pm = t; u.pn = e * nN + pn; u.pc = pn; return true;
    }
    __device__ __forceinline__ void a_ready(const pg8::Unit&) const {}
    __device__ __forceinline__ void done(const pg8::Unit&) const {}
};

__device__ __forceinline__ void cvt_item(const float* W, int K, int N, bf16* WT, int mode, int add, LAS float* scr, int item, int lane, int nblk_override = 0) {
    const int nblk = nblk_override ? nblk_override : (N >> 5), kb = item / nblk, nb = item - kb * nblk, k0 = 64 * kb, n0 = 32 * nb;
    const int r = lane >> 3, c4 = lane & 7;
    f32x4 v[8];
#pragma unroll
    for (int i = 0; i < 8; ++i) v[i] = *(const f32x4*)(W + (size_t)(k0 + 8 * i + r) * N + n0 + 4 * c4);
#pragma unroll
    for (int i = 0; i < 8; ++i) {
#pragma unroll
        for (int j = 0; j < 4; ++j) scr[(8 * i + r) * 33 + 4 * c4 + j] = v[i][j]; }
    LDS_WAIT();
    const int c = lane & 7;
#pragma unroll
    for (int j = 0; j < 4; ++j) { const int n = (lane >> 3) + 8 * j; const LAS float* s = scr + (8 * c) * 33 + n;
        v4u o; o.x = pk2(s[0 * 33], s[1 * 33]); o.y = pk2(s[2 * 33], s[3 * 33]); o.z = pk2(s[4 * 33], s[5 * 33]); o.w = pk2(s[6 * 33], s[7 * 33]);
        const int nn = n0 + n; const int drow = (mode == 0) ? (nn + add) : (((nn >> 7) << 8) + (nn & 127) + add);
        *(v4u*)(WT + (size_t)drow * K + k0 + 8 * c) = o; }
    LDS_WAIT();
}
__device__ __forceinline__ void cvt_item_f8(const float* W, int K, int N, unsigned char* WT, int mode, int add, LAS float* scr, int item, int lane) {
    const int nblk = N >> 5, kb = item / nblk, nb = item - kb * nblk, k0 = 64 * kb, n0 = 32 * nb;
    const int r = lane >> 3, c4 = lane & 7;
    f32x4 v[8];
#pragma unroll
    for (int i = 0; i < 8; ++i) v[i] = *(const f32x4*)(W + (size_t)(k0 + 8 * i + r) * N + n0 + 4 * c4);
#pragma unroll
    for (int i = 0; i < 8; ++i) {
#pragma unroll
        for (int j = 0; j < 4; ++j) scr[(8 * i + r) * 33 + 4 * c4 + j] = v[i][j]; }
    LDS_WAIT();
    const int c = lane & 3;
#pragma unroll
    for (int j = 0; j < 2; ++j) { const int n = (lane >> 2) + 16 * j; const LAS float* s = scr + (16 * c) * 33 + n;
        unsigned w[4];
#pragma unroll
        for (int q = 0; q < 4; ++q) { unsigned x = 0u;
            x = __builtin_amdgcn_cvt_pk_fp8_f32(s[(4 * q) * 33] * WSC8, s[(4 * q + 1) * 33] * WSC8, x, false);
            x = __builtin_amdgcn_cvt_pk_fp8_f32(s[(4 * q + 2) * 33] * WSC8, s[(4 * q + 3) * 33] * WSC8, x, true); w[q] = x; }
        v4u o; o.x = w[0]; o.y = w[1]; o.z = w[2]; o.w = w[3];
        const int nn = n0 + n; const int drow = (mode == 0) ? (nn + add) : (((nn >> 7) << 8) + (nn & 127) + add);
        *(v4u*)(WT + (size_t)drow * K + k0 + 16 * c) = o; }
    LDS_WAIT();
}
__device__ __forceinline__ void moe_cvt_idle(const Frame& F, const Args& a, int j, int b_lo) {
    LAS float* scr = (LAS float*)(F.lds + F.wave * 16384);
    constexpr int IT = 1408;
    const int nw = (F.G - b_lo) * 8, w = ((int)blockIdx.x - b_lo) * 8 + F.wave;
    for (int it = w; it < 8 * 3 * IT; it += nw) {
        const int e = it / (3 * IT), r = it - e * 3 * IT, which = r / IT, item = r - which * IT;
        const size_t eo = ((size_t)j * 8 + e) * (size_t)(1024 * DFF);
        if (which == 0) cvt_item_f8(a.in[F.zz + I_MW1] + eo, 1024, DFF, F.ws + WS_W13M + (size_t)e * 5632 * 1024, 1, 0, scr, item, F.lane);
        else if (which == 1) cvt_item_f8(a.in[F.zz + I_MW3] + eo, 1024, DFF, F.ws + WS_W13M + (size_t)e * 5632 * 1024, 1, 128, scr, item, F.lane);
        else cvt_item_f8(a.in[F.zz + I_MW2] + eo, DFF, 1024, F.ws + WS_W2M + (size_t)e * 1024 * DFF, 0, 0, scr, item, F.lane);
    }
}
__device__ __forceinline__ void moe_cvt(const Frame& F, const Args& a, int j) {
    LAS float* scr = (LAS float*)(F.lds + F.wave * 16384);
    constexpr int IT = 1408;
    for (int it = F.gw; it < 8 * 3 * IT; it += F.NGW) {
        const int e = it / (3 * IT), r = it - e * 3 * IT, which = r / IT, item = r - which * IT;
        const size_t eo = ((size_t)j * 8 + e) * (size_t)(1024 * DFF);
        if (which == 0) cvt_item_f8(a.in[F.zz + I_MW1] + eo, 1024, DFF, F.ws + WS_W13M + (size_t)e * 5632 * 1024, 1, 0, scr, item, F.lane);
        else if (which == 1) cvt_item_f8(a.in[F.zz + I_MW3] + eo, 1024, DFF, F.ws + WS_W13M + (size_t)e * 5632 * 1024, 1, 128, scr, item, F.lane);
        else cvt_item_f8(a.in[F.zz + I_MW2] + eo, DFF, 1024, F.ws + WS_W2M + (size_t)e * 1024 * DFF, 0, 0, scr, item, F.lane);
    }
}
__device__ __forceinline__ void prologue(const Frame& F, const Args& a) {
    {
        LAS float* sc = (LAS float*)F.lds; LAS float* red = sc + 5120;
        for (int idx = F.tid; idx < 5120; idx += 512) { const int r = idx >> 10, k = idx & 1023; const float cv = (r < 4) ? a.in[F.zz + I_C][r * 1024 + k] : a.in[F.zz + I_CCTX][k]; sc[idx] = silu_f(cv); }
        __syncthreads();
        float* MOD = (float*)(F.ws + WS_MOD);
        for (int item = blockIdx.x; item < 384; item += F.G) {
            const int l = item / 96, nb = item - l * 96, cl = F.tid & 63, ks = F.tid >> 6, n = nb * 64 + cl;
            float acc[5] = {0.f, 0.f, 0.f, 0.f, 0.f};
            const float* wp = a.in[F.zz + I_ADAW] + ((size_t)l * 1024 + ks * 128) * 6144 + n;
#pragma unroll 16
            for (int kk = 0; kk < 128; ++kk) { const float w = wp[(size_t)kk * 6144];
#pragma unroll
                for (int r = 0; r < 5; ++r) acc[r] = fmaf(sc[r * 1024 + ks * 128 + kk], w, acc[r]); }
#pragma unroll
            for (int r = 0; r < 5; ++r) red[(ks * 5 + r) * 64 + cl] = acc[r];
            __syncthreads();
            if (F.tid < 320) { const int r = F.tid >> 6; float s = 0.f;
#pragma unroll
                for (int k2 = 0; k2 < 8; ++k2) s += red[(k2 * 5 + r) * 64 + cl];
                MOD[((size_t)l * 5 + r) * 6144 + n] = s + a.in[F.zz + I_ADAB][l * 6144 + n]; }
            __syncthreads();
        }
        if (blockIdx.x == 0 && F.tid < 256) {
            const float* lg = a.in[F.zz + I_LBL]; float x[4], mx = -3.0e38f;
#pragma unroll
            for (int l = 0; l < 4; ++l) { x[l] = lg[l * 256 + F.tid]; mx = fmaxf(mx, x[l]); }
            float s = 0.f;
#pragma unroll
            for (int l = 0; l < 4; ++l) { x[l] = expf(x[l] - mx); s += x[l]; }
            float cs = 0.f; const float sm0 = x[0] / s; float* LB = (float*)(F.ws + WS_LB);
#pragma unroll
            for (int l = 0; l < 4; ++l) { cs += x[l] / s; LB[l * 256 + F.tid] = fminf(fmaxf(cs - sm0, 0.f), 1.0f - 1e-6f); }
        }
        if (blockIdx.x == (1 % F.G)) {
            float* RC = (float*)(F.ws + WS_ROPE); float* RS = RC + 2048;
            for (int idx = F.tid; idx < 2048; idx += 512) { const int pos = idx >> 4, i = idx & 15;
                const float fr = powf(10000.0f, -(float)i / 16.0f); const float ang = (float)pos * fr; RC[idx] = cosf(ang); RS[idx] = sinf(ang); }
        }
        __syncthreads();
    }
    LAS float* scr = (LAS float*)(F.lds + F.wave * 16384);
    constexpr int I_IN = 16 * 104, I_OUT = 16 * 32, I_F = 1408, I_GL = 4 * 8;
    constexpr int NIT = 4 * I_IN + 4 * I_OUT + 6 * I_F + 4 * I_GL;
    for (int it = F.gw; it < NIT; it += F.NGW) {
        int r = it;
        if (r < 4 * I_IN) { const int l = r / I_IN; cvt_item(a.in[F.zz + I_WIN] + (size_t)l * 1024 * DIN, 1024, DIN, (bf16*)(F.ws + WS_WIN) + (size_t)l * DINP * 1024, 0, 0, scr, r - l * I_IN, F.lane, 104); continue; } r -= 4 * I_IN;
        if (r < 4 * I_OUT) { const int l = r / I_OUT; cvt_item(a.in[F.zz + I_WOUT] + (size_t)l * 1024 * 1024, 1024, 1024, (bf16*)(F.ws + WS_WOUT) + (size_t)l * 1024 * 1024, 0, 0, scr, r - l * I_OUT, F.lane); continue; } r -= 4 * I_OUT;
        if (r < 6 * I_F) { const int j = r / (3 * I_F), r2 = r - j * 3 * I_F, which = r2 / I_F, item = r2 - which * I_F; const size_t wo = (size_t)j * 1024 * DFF;
            if (which == 0) cvt_item(a.in[F.zz + I_FW1] + wo, 1024, DFF, (bf16*)(F.ws + WS_W13D) + (size_t)j * 5632 * 1024, 1, 0, scr, item, F.lane);
            else if (which == 1) cvt_item(a.in[F.zz + I_FW3] + wo, 1024, DFF, (bf16*)(F.ws + WS_W13D) + (size_t)j * 5632 * 1024, 1, 128, scr, item, F.lane);
            else cvt_item_f8(a.in[F.zz + I_FW2] + wo, DFF, 1024, F.ws + WS_W2D + (size_t)j * 1024 * DFF, 0, 0, scr, item, F.lane);
            continue; } r -= 6 * I_F;
        { const int l = r / I_GL; cvt_item(a.in[F.zz + I_GLUW] + (size_t)l * 65536, 256, 256, (bf16*)(F.ws + WS_GLUW) + (size_t)l * 65536, 0, 0, scr, r - l * I_GL, F.lane); }
    }
    for (int i = blockIdx.x * 512 + F.tid; i < 4 * 256 * 128; i += F.G * 512) {
        const int l = i >> 15, rem = i & 32767, n = rem >> 7, k0 = (rem & 127) * 8, d = n >> 7, cidx = n & 127;
        const float* wa = a.in[F.zz + I_WA2] + ((size_t)(l * 2 + d) * 16) * 128 + cidx;
        float acc[8] = {0.f, 0.f, 0.f, 0.f, 0.f, 0.f, 0.f, 0.f};
#pragma unroll
        for (int r = 0; r < 16; ++r) { const float w2 = wa[r * 128];
#pragma unroll
            for (int kk = 0; kk < 8; ++kk) acc[kk] = fmaf(a.in[F.zz + I_WIN][((size_t)l * 1024 + k0 + kk) * DIN + 3328 + 16 * d + r], w2, acc[kk]); }
        v4u o; o.x = pk2(acc[0], acc[1]); o.y = pk2(acc[2], acc[3]); o.z = pk2(acc[4], acc[5]); o.w = pk2(acc[6], acc[7]);
        *(v4u*)((bf16*)(F.ws + WS_WIN) + ((size_t)l * DINP + 3328 + n) * 1024 + k0) = o;
    }
}

struct MoeTp { int tp[9]; };
__device__ __forceinline__ void load_tp(MoeTp& t, const unsigned* cnt) {
    t.tp[0] = 0;
#pragma unroll
    for (int e = 0; e < 8; ++e) t.tp[e + 1] = t.tp[e] + (int)(((unsigned)__builtin_amdgcn_readfirstlane((int)__hip_atomic_load(cnt + e * 64, __ATOMIC_RELAXED, __HIP_MEMORY_SCOPE_AGENT)) + 255u) >> 8);
}
template <int MODE>
__device__ __forceinline__ void norm_phase(const Frame& F, const Args& a, int l, int which  , int nrows, int comb_l  ) {
    const float* MOD = (const float*)(F.ws + WS_MOD);
    const float* nw = (MODE == 2) ? a.in[F.zz + I_FINW] : ((which ? a.in[F.zz + I_N2W] : a.in[F.zz + I_N1W]) + l * 1024);
    bf16* XN = (bf16*)(F.ws + WS_ACT);
    float* hb = (float*)(F.ws + WS_HB);
    const int* EP = (const int*)(F.ws + WS_LIST) + 8 * MT; const float* GATE = (const float*)(F.ws + WS_LIST) + 10 * MT;
    const bf16* YM = (const bf16*)(F.ws + WS_X2);
    const bool from_input = (l == 0 && which == 0 && MODE != 2);
    MoeTp ctp; if (comb_l >= 0) load_tp(ctp, (const unsigned*)F.ws + CW_CNT + (comb_l >> 1) * 8 * 64);
    const int jm = l >> 1;
    LAS float* rwl = (LAS float*)F.lds;
    if (MODE == 1) {
        const float* rw = a.in[F.zz + I_RW] + (size_t)jm * 8192;
        for (int idx = F.tid; idx < 8192; idx += 512) { const int k = idx >> 3, e = idx & 7; rwl[e * 1024 + k] = rw[idx]; }
        __syncthreads();
    }
    f32x4 wv[4];
#pragma unroll
    for (int j = 0; j < 4; ++j) wv[j] = *((const f32x4*)nw + F.lane + 64 * j);
    f32x4 vn[4]; int epn0 = 0, epn1 = 0; float gn0 = 0.f, gn1 = 0.f;
    { const int m = F.gw < nrows ? F.gw : 0; const bool isctx = m >= NLAT;
      const float* xr = from_input ? (isctx ? a.in[F.zz + I_CTX] + (size_t)(m - NLAT) * 1024 : a.in[F.zz + I_X] + (size_t)m * 1024) : (isctx ? hb + (size_t)(m - NLAT) * 1024 : F.out + (size_t)m * 1024);
#pragma unroll
      for (int j = 0; j < 4; ++j) vn[j] = *((const f32x4*)xr + F.lane + 64 * j);
      if (comb_l >= 0) { epn0 = EP[2 * m]; epn1 = EP[2 * m + 1]; gn0 = GATE[2 * m]; gn1 = GATE[2 * m + 1]; } }
    for (int m = F.gw; m < nrows; m += F.NGW) {
        const bool isctx = m >= NLAT; const int bidx = isctx ? 4 : (m >> 13);
        f32x4 v[4];
#pragma unroll
        for (int j = 0; j < 4; ++j) v[j] = vn[j];
        const int ep0 = epn0, ep1 = epn1; const float g0 = gn0, g1 = gn1;
        { const int mn = (m + F.NGW < nrows) ? m + F.NGW : m; const bool cn = mn >= NLAT;
          const float* xr = from_input ? (cn ? a.in[F.zz + I_CTX] + (size_t)(mn - NLAT) * 1024 : a.in[F.zz + I_X] + (size_t)mn * 1024) : (cn ? hb + (size_t)(mn - NLAT) * 1024 : F.out + (size_t)mn * 1024);
#pragma unroll
          for (int j = 0; j < 4; ++j) vn[j] = *((const f32x4*)xr + F.lane + 64 * j);
          if (comb_l >= 0) { epn0 = EP[2 * mn]; epn1 = EP[2 * mn + 1]; gn0 = GATE[2 * mn]; gn1 = GATE[2 * mn + 1]; } }
        if (comb_l >= 0) {
            int t0 = 0, t1 = 0;
#pragma unroll
            for (int e = 0; e < 8; ++e) { t0 = ((ep0 & 7) == e) ? ctp.tp[e] : t0; t1 = ((ep1 & 7) == e) ? ctp.tp[e] : t1; }
            const size_t d0 = (size_t)t0 * 256 + (ep0 >> 3), d1 = (size_t)t1 * 256 + (ep1 >> 3);
            const float* m5 = MOD + ((size_t)comb_l * 5 + bidx) * 6144 + 5 * 1024;
            float* xw = isctx ? hb + (size_t)(m - NLAT) * 1024 : F.out + (size_t)m * 1024;
#pragma unroll
            for (int j = 0; j < 4; ++j) {
                const v2u y0 = *((const v2u*)(YM + d0 * 1024) + F.lane + 64 * j), y1 = *((const v2u*)(YM + d1 * 1024) + F.lane + 64 * j);
                const f32x4 mm = *((const f32x4*)m5 + F.lane + 64 * j);
                f32x4 f0, f1;
                f0[0] = __uint_as_float(y0.x << 16); f0[1] = __uint_as_float(y0.x & 0xffff0000u); f0[2] = __uint_as_float(y0.y << 16); f0[3] = __uint_as_float(y0.y & 0xffff0000u);
                f1[0] = __uint_as_float(y1.x << 16); f1[1] = __uint_as_float(y1.x & 0xffff0000u); f1[2] = __uint_as_float(y1.y << 16); f1[3] = __uint_as_float(y1.y & 0xffff0000u);
                v[j] = v[j] + mm * (f0 * g0 + f1 * g1);
                if (MODE != 2) *((f32x4*)xw + F.lane + 64 * j) = v[j];
            }
        }
        float ss = 0.f;
#pragma unroll
        for (int j = 0; j < 4; ++j) ss += (v[j][0] * v[j][0] + v[j][1] * v[j][1]) + (v[j][2] * v[j][2] + v[j][3] * v[j][3]);
        ss = wave_sum(ss);
        const float rstd = 1.0f / sqrtf(ss * (1.0f / 1024.0f) + NEPS);
        if (MODE == 2) {
#pragma unroll
            for (int j = 0; j < 4; ++j) *((f32x4*)(F.out + (size_t)m * 1024) + F.lane + 64 * j) = v[j] * rstd * wv[j];
        } else {
            const float* sh = MOD + ((size_t)l * 5 + bidx) * 6144 + (which ? 3 : 0) * 1024; const float* scl = sh + 1024;
            f32x4 o[4];
#pragma unroll
            for (int j = 0; j < 4; ++j) { const f32x4 s1 = *((const f32x4*)scl + F.lane + 64 * j), s0 = *((const f32x4*)sh + F.lane + 64 * j);
                o[j] = (v[j] * rstd * wv[j]) * (s1 + 1.0f) + s0;
                if (MODE == 1) {
                    unsigned w8 = 0u; w8 = __builtin_amdgcn_cvt_pk_fp8_f32(fminf(fmaxf(o[j][0], -448.f), 448.f), fminf(fmaxf(o[j][1], -448.f), 448.f), w8, false);
                    w8 = __builtin_amdgcn_cvt_pk_fp8_f32(fminf(fmaxf(o[j][2], -448.f), 448.f), fminf(fmaxf(o[j][3], -448.f), 448.f), w8, true);
                    *((unsigned*)((unsigned char*)XN + (size_t)m * 1024) + F.lane + 64 * j) = w8;
                } else { v2u w; w.x = pk2(o[j][0], o[j][1]); w.y = pk2(o[j][2], o[j][3]);
                    *((v2u*)(XN + (size_t)m * 1024) + F.lane + 64 * j) = w; } }
            if (MODE == 1) {
                float p[8];
#pragma unroll
                for (int e = 0; e < 8; ++e) { float s = 0.f;
#pragma unroll
                    for (int j = 0; j < 4; ++j) { const f32x4 w4 = *((const LAS f32x4*)(rwl + e * 1024) + F.lane + 64 * j);
                        s += (o[j][0] * w4[0] + o[j][1] * w4[1]) + (o[j][2] * w4[2] + o[j][3] * w4[3]); }
                    p[e] = wave_sum(s) + a.in[F.zz + I_RB][jm * 8 + e]; }
                int e0 = 0; float v0 = p[0];
#pragma unroll
                for (int e = 1; e < 8; ++e) if (p[e] > v0) { v0 = p[e]; e0 = e; }
                int e1 = -1; float v1 = -3.0e38f;
#pragma unroll
                for (int e = 0; e < 8; ++e) if (e != e0 && p[e] > v1) { v1 = p[e]; e1 = e; }
                const float ex = expf(v1 - v0), g0 = 1.0f / (1.0f + ex), g1 = ex / (1.0f + ex);
                if (F.lane == 0) {
                    unsigned* cnt = (unsigned*)F.ws + CW_CNT + jm * 8 * 64; int* LIST = (int*)(F.ws + WS_LIST);
                    int* EPw = (int*)(F.ws + WS_LIST) + 8 * MT; float* GW = (float*)(F.ws + WS_LIST) + 10 * MT;
                    const unsigned p0 = __hip_atomic_fetch_add(cnt + e0 * 64, 1u, __ATOMIC_RELAXED, __HIP_MEMORY_SCOPE_AGENT);
                    const unsigned p1 = __hip_atomic_fetch_add(cnt + e1 * 64, 1u, __ATOMIC_RELAXED, __HIP_MEMORY_SCOPE_AGENT);
                    LIST[e0 * MT + p0] = m; LIST[e1 * MT + p1] = m;
                    EPw[2 * m] = e0 | (int)(p0 << 3); EPw[2 * m + 1] = e1 | (int)(p1 << 3);
                    GW[2 * m] = g0; GW[2 * m + 1] = g1;
                }
            }
        }
    }
    if (MODE == 1) __syncthreads();
}
__device__ __forceinline__ void moe_gather(const Frame& F, int jm) {
    const unsigned* cnt = (const unsigned*)F.ws + CW_CNT + jm * 8 * 64;
    MoeTp t; load_tp(t, cnt);
    int cn[8];
#pragma unroll
    for (int e = 0; e < 8; ++e) cn[e] = __builtin_amdgcn_readfirstlane((int)__hip_atomic_load(cnt + e * 64, __ATOMIC_RELAXED, __HIP_MEMORY_SCOPE_AGENT));
    const int rows = t.tp[8] * 256;
    const int* LIST = (const int*)(F.ws + WS_LIST); const v4u* XN = (const v4u*)(F.ws + WS_ACT); v4u* XB = (v4u*)(F.ws + WS_X2);
    for (int r = F.gw; r < rows; r += F.NGW) {
        const int tile = r >> 8; int e = 0, tpe = 0, ce = cn[0];
#pragma unroll
        for (int k = 1; k < 8; ++k) { const bool ge = tile >= t.tp[k]; e += ge ? 1 : 0; tpe = ge ? t.tp[k] : tpe; ce = ge ? cn[k] : ce; }
        const int pos = r - tpe * 256;
        v4u x0 = {0u, 0u, 0u, 0u};
        if (pos < ce) { const int src = LIST[e * MT + pos]; x0 = XN[(size_t)src * 64 + F.lane]; }
        XB[(size_t)r * 64 + F.lane] = x0;
    }
}
#define GLD(T, ubase, voff) (*(const T*)((const char*)(ubase) + (unsigned)(voff)))
#define GST(T, ubase, voff) (*(T*)((char*)(ubase) + (unsigned)(voff)))
__device__ __forceinline__ int fresh_lane() { int l; asm volatile("v_mbcnt_lo_u32_b32 %0, -1, 0\n\tv_mbcnt_hi_u32_b32 %0, -1, %0" : "=v"(l)); return l; }

struct MixP { const bf16* P; const float* lb; const float* rcos; const float* rsin; const float* ba; };
__device__ __forceinline__ int seg_row0(int b, int sg) { return sg < 4 ? NLAT + b * CTXL + sg * 64 : b * SEQ + (sg - 4) * 64; }
__device__ __forceinline__ int seg_tpos0(int sg) { return sg < 4 ? -1 : (sg - 4) * 64; }

struct S5P { const float *lam_re, *lam_im, *log_dt, *b_re, *b_im, *c_re, *c_im, *dd; };
__device__ __forceinline__ float gelu_tanh(float y) { const float t = 0.7978845608028654f * (y + 0.044715f * y * y * y); const float th = 1.0f - 2.0f / (1.0f + __expf(2.0f * t)); return 0.5f * y * (1.0f + th); }
template <int MODE>
__device__ __forceinline__ void s5_scan(const S5P& sp, const bf16* P, int b, int g, int dir, int sg, int lane, float& hre, float& him, LAS float* yf, LAS float* stg, bf16* Z) {
    const int row0 = seg_row0(b, sg); const int dg = dir * 16 + g;
    const float lre = sp.lam_re[dg * 64 + lane], lim = sp.lam_im[dg * 64 + lane], dt = expf(sp.log_dt[dg]);
    const float er = expf(lre * dt); const float sn = sinf(lim * dt), cs = cosf(lim * dt);
    const float ar = er * cs, ai = er * sn;
    const float nr = ar - 1.0f, ni = ai, den = lre * lre + lim * lim;
    const float cr = (nr * lre + ni * lim) / den, ci = (ni * lre - nr * lim) / den;
    float bbr[16], bbi[16], Cr[16], Ci[16];
#pragma unroll
    for (int c = 0; c < 16; ++c) { const float Br = sp.b_re[((size_t)dg * 64 + lane) * 16 + c], Bi = sp.b_im[((size_t)dg * 64 + lane) * 16 + c];
        bbr[c] = cr * Br - ci * Bi; bbi[c] = cr * Bi + ci * Br;
        Cr[c] = (MODE != 0) ? sp.c_re[((size_t)dg * 16 + c) * 64 + lane] : 0.f; Ci[c] = (MODE != 0) ? sp.c_im[((size_t)dg * 16 + c) * 64 + lane] : 0.f; }
    const int ch = ((lane >> 5) & 1) * 8 + ((lane >> 4) & 1) * 4 + ((lane >> 3) & 1) * 2 + ((lane >> 2) & 1);
    const float dv = (MODE == 2) ? sp.dd[g * 16 + ch] : 0.f;
    const bool b5 = lane & 32, b4 = lane & 16, b3 = lane & 8, b2 = lane & 4;
    const unsigned ucol = 2u * (unsigned)(C_S5 + g * 16 + (lane & 15));
    unsigned short rn0[4], rn1[4], rn2[4];
#pragma unroll
    for (int u = 0; u < 4; ++u) { rn0[u] = GLD(unsigned short, P + (size_t)(row0 + (dir ? 63 - u : u)) * DINP, ucol); rn1[u] = GLD(unsigned short, P + (size_t)(row0 + (dir ? 59 - u : 4 + u)) * DINP, ucol);
        rn2[u] = GLD(unsigned short, P + (size_t)(row0 + (dir ? 55 - u : 8 + u)) * DINP, ucol); }
#pragma unroll 1
    for (int i0 = 0; i0 < 64; i0 += 4) {
        unsigned short ru[4], rn3[4];
        const int ip = (i0 + 12 < 64) ? i0 + 12 : 60;
#pragma unroll
        for (int u = 0; u < 4; ++u) { ru[u] = rn0[u]; rn3[u] = GLD(unsigned short, P + (size_t)(row0 + (dir ? 63 - (ip + u) : (ip + u))) * DINP, ucol); }
#pragma unroll
        for (int u = 0; u < 4; ++u) stg[u * 64 + lane] = bf2f(ru[u]);
#pragma unroll
        for (int u = 0; u < 4; ++u) {
            const int ti = dir ? 63 - (i0 + u) : (i0 + u);
            const float uf = bf2f(ru[u]);
            float bur = 0.f, bui = 0.f;
#pragma unroll
            for (int c4 = 0; c4 < 4; ++c4) { const f32x4 ux = *(const LAS f32x4*)(stg + u * 64 + 4 * c4);
#pragma unroll
                for (int jj = 0; jj < 4; ++jj) { bur = fmaf(bbr[4 * c4 + jj], ux[jj], bur); bui = fmaf(bbi[4 * c4 + jj], ux[jj], bui); } }
            const float nre = ar * hre - ai * him + bur, nim = ar * him + ai * hre + bui;
            hre = nre; him = nim;
            if (MODE != 0) {
                float v[16];
#pragma unroll
                for (int c = 0; c < 16; ++c) v[c] = Cr[c] * hre - Ci[c] * him;
                float w8[8], w4[4], w2[2], w1;
#pragma unroll
                for (int i = 0; i < 8; ++i) { const float mine = b5 ? v[8 + i] : v[i], oth = b5 ? v[i] : v[8 + i]; w8[i] = mine + __shfl_xor(oth, 32); }
#pragma unroll
                for (int i = 0; i < 4; ++i) { const float mine = b4 ? w8[4 + i] : w8[i], oth = b4 ? w8[i] : w8[4 + i]; w4[i] = mine + __shfl_xor(oth, 16); }
#pragma unroll
                for (int i = 0; i < 2; ++i) { const float mine = b3 ? w4[2 + i] : w4[i], oth = b3 ? w4[i] : w4[2 + i]; w2[i] = mine + __shfl_xor(oth, 8); }
                { const float mine = b2 ? w2[1] : w2[0], oth = b2 ? w2[0] : w2[1]; w1 = mine + __shfl_xor(oth, 4); }
                w1 += __shfl_xor(w1, 2); w1 += __shfl_xor(w1, 1);
                if (MODE == 1) { if ((lane & 3) == 0) yf[ti * 16 + ch] = w1; }
                if (MODE == 2) {
                    const float uch = __shfl(uf, ch);
                    if ((lane & 3) == 0) { const float y = w1 + yf[ti * 16 + ch] + dv * uch; Z[(size_t)(row0 + ti) * 256 + g * 16 + ch] = (bf16)f2bf(gelu_tanh(y)); }
                }
            }
        }
#pragma unroll
        for (int u = 0; u < 4; ++u) { rn0[u] = rn1[u]; rn1[u] = rn2[u]; rn2[u] = rn3[u]; }
    }
}

__device__ __forceinline__ MixP make_mixp(const Frame& F, const Args& a, int l) {
    MixP mp; mp.P = (const bf16*)(F.ws + WS_PH); mp.lb = (const float*)(F.ws + WS_LB) + l * 256; mp.rcos = (const float*)(F.ws + WS_ROPE); mp.rsin = mp.rcos + 2048;
    mp.ba = a.in[F.zz + I_BA] + (size_t)l * 2 * 128; return mp;
}
__device__ __forceinline__ S5P make_s5p(const Frame& F, const Args& a, int l) {
    S5P sp; sp.lam_re = a.in[F.zz + I_LAMRE] + (size_t)l * 2048; sp.lam_im = a.in[F.zz + I_LAMIM] + (size_t)l * 2048; sp.log_dt = a.in[F.zz + I_LOGDT] + l * 32;
    sp.b_re = a.in[F.zz + I_BRE] + (size_t)l * 32768; sp.b_im = a.in[F.zz + I_BIM] + (size_t)l * 32768; sp.c_re = a.in[F.zz + I_CRE] + (size_t)l * 32768; sp.c_im = a.in[F.zz + I_CIM] + (size_t)l * 32768;
    sp.dd = a.in[F.zz + I_S5D] + l * 256; return sp;
}


typedef short bf16x8_t __attribute__((ext_vector_type(8)));
typedef float f32x16 __attribute__((ext_vector_type(16)));
typedef float f32x2_t __attribute__((ext_vector_type(2)));
typedef __bf16 bf16x2_n __attribute__((ext_vector_type(2)));
__device__ __forceinline__ unsigned pkbf(float lo, float hi) { const f32x2_t v = {lo, hi}; const bf16x2_n r = __builtin_convertvector(v, bf16x2_n); return __builtin_bit_cast(unsigned, r); }
constexpr int WL_QC = 0, WL_KC = 4608, WL_KT = 9216, WL_VT = 14336, WL_PL = 19456, WL_BYTES = 19712;

struct MxC { float gamma, lbv, oml, bav; unsigned cq, ck, cv, cz; };
template <int MIX>
__device__ __forceinline__ void mx_consts(MxC& c, const MixP& mp, int h, int dir, int lane) {
    c.gamma = 1.f; c.lbv = 0.f; c.oml = 1.f; c.bav = 0.f; c.cz = 0;
    if (MIX == 0) { c.cq = 2u * (unsigned)(C_RQ + h * 64 + lane); c.ck = 2u * (unsigned)(C_RK + h * 64 + lane); c.cv = 2u * (unsigned)(C_RV + h * 64 + lane); c.gamma = 1.0f - exp2f(-5.0f - (float)(dir ? 3 - h : h)); }
    else if (MIX == 1) { c.cq = 2u * (unsigned)(C_HQ + h * 64 + lane); c.ck = 2u * (unsigned)((dir ? C_HFB : C_HFF) + h * 64 + lane); c.cv = 2u * (unsigned)(C_HI + h * 64 + lane); c.lbv = mp.lb[h * 64 + lane]; c.oml = 1.0f - c.lbv; }
    else { c.cq = 2u * (unsigned)(C_GQ + h * 32 + (lane & 31)); c.ck = 2u * (unsigned)(C_GK + h * 32 + (lane & 31)); c.cv = 2u * (unsigned)(C_GV + h * 64 + lane); c.cz = 2u * (unsigned)((dir ? C_GZB : C_GZF) + h * 32 + (lane & 31));
        c.bav = mp.ba[dir * 128 + h * 32 + (lane & 31)]; }
}
struct MxRaw { unsigned short q[4], k[4], v[4], z[4]; };
template <int MIX, bool NEEDQ, int DIR>
__device__ __forceinline__ void mx_load(MxRaw& w, const MixP& mp, const MxC& c, int rows, int b) {
#pragma unroll
    for (int u = 0; u < 4; ++u) { const int cc = b * 4 + u; const bf16* pr = mp.P + (size_t)(rows + (DIR ? 63 - cc : cc)) * DINP;
        w.q[u] = NEEDQ ? GLD(unsigned short, pr, c.cq) : (unsigned short)0; w.k[u] = GLD(unsigned short, pr, c.ck); w.v[u] = GLD(unsigned short, pr, c.cv); w.z[u] = (MIX == 2) ? GLD(unsigned short, pr, c.cz) : (unsigned short)0; }
}
template <int MIX, bool NEEDQ, int DIR>
__device__ __forceinline__ void mx_batch(const MxRaw& cur, const MixP& mp, const MxC& c, int tposs  , int lane, LAS unsigned char* wl, int b, float& P) {
    constexpr int DK = (MIX == 2) ? 32 : 64;
    float kt[4], vv[4];
#pragma unroll
    for (int u = 0; u < 4; ++u) {
        const int cc = b * 4 + u, ts = DIR ? 63 - cc : cc, t = ts & 31;
        float q = bf2f(cur.q[u]), k, f; vv[DIR ? 3 - u : u] = bf2f(cur.v[u]);
        if (MIX == 0) {
            k = bf2f(cur.k[u]) * 0.125f; f = c.gamma;
            if (tposs >= 0) { const int tpos = tposs + ts; const int pos = (lane & 32) ? (tpos & 63) : (tpos >> 6);
                const unsigned ro = 4u * (unsigned)(pos * 16 + (lane & 15)); const float cs = GLD(float, mp.rcos, ro), sn = GLD(float, mp.rsin, ro);
                const float ss = (lane & 16) ? sn : -sn;
                const float kp = __shfl_xor(k, 16); k = fmaf(kp, ss, k * cs);
                if (NEEDQ) { const float qp = __shfl_xor(q, 16); q = fmaf(qp, ss, q * cs); } }
        } else if (MIX == 1) {
            const float z = bf2f(cur.k[u]); const float e = __expf(-z); const float sp = __builtin_amdgcn_rcpf(1.0f + e), sn = e * sp;
            f = fmaf(c.oml, sp, c.lbv); k = c.oml * sn;
        } else {
            k = bf2f(cur.k[u]) * 0.17677669529663687f; const float z = bf2f(cur.z[u]) + c.bav;
            const float ls = fminf(z, 0.f) - __logf(1.0f + __expf(-fabsf(z)));
            f = __expf(ls * 0.0625f);
        }
        P = fmaxf(P * f, 1e-30f);
        const float kk = k * __builtin_amdgcn_rcpf(P); kt[DIR ? 3 - u : u] = kk;
        if (lane < DK) {
            if (NEEDQ) *(LAS unsigned short*)(wl + WL_QC + t * 144 + lane * 2) = (unsigned short)f2bf(q * P);
            *(LAS unsigned short*)(wl + WL_KC + t * 144 + lane * 2) = (unsigned short)f2bf(kk);
        }
    }
    const int g4 = ((DIR ? 63 - b * 4 : b * 4) & 31) >> 2;
    v2u kp, vp; kp.x = pkbf(kt[0], kt[1]); kp.y = pkbf(kt[2], kt[3]); vp.x = pkbf(vv[0], vv[1]); vp.y = pkbf(vv[2], vv[3]);
    if (lane < DK) *(LAS v2u*)(wl + WL_KT + lane * 80 + g4 * 8) = kp;
    *(LAS v2u*)(wl + WL_VT + lane * 80 + g4 * 8) = vp;
}
typedef short bf16x4_t __attribute__((ext_vector_type(4)));
#define MFMA8(a, b, c) __builtin_amdgcn_mfma_f32_32x32x8bf16_1k((a), (b), (c), 0, 0, 0)
__device__ __forceinline__ bf16x4_t pack4(const f32x16& x, int s) {
    v2u p; p.x = pkbf(x[4 * s], x[4 * s + 1]); p.y = pkbf(x[4 * s + 2], x[4 * s + 3]);
    return __builtin_bit_cast(bf16x4_t, p);
}
__device__ __forceinline__ bf16x4_t ld4(const LAS unsigned char* p) { const v2u a = *(const LAS v2u*)p; return __builtin_bit_cast(bf16x4_t, a); }

template <int MODE, int DIR>
__device__ __forceinline__ void s5_mm_dir(const S5P& sp, const bf16* P, int b, int g, int sg, int lane, float& hre, float& him, LAS float* yf, LAS unsigned char* hs, bf16* Z) {
    const int m32 = lane & 31, hh = lane >> 5, dg = DIR * 16 + g, row0 = seg_row0(b, sg);
    float ar[2], ai[2], a2r[2], a2i[2], a3r[2], a3i[2], a4r[2], a4i[2];
    bf16x4_t bfr[4][2];
    const float dt = __expf(sp.log_dt[dg]);
#pragma unroll
    for (int sh = 0; sh < 2; ++sh) {
        const int p = 32 * sh + m32;
        const float lre = sp.lam_re[dg * 64 + p], lim = sp.lam_im[dg * 64 + p];
        const float er = __expf(lre * dt), sn = sinf(lim * dt), cs = cosf(lim * dt);
        ar[sh] = er * cs; ai[sh] = er * sn;
        a2r[sh] = ar[sh] * ar[sh] - ai[sh] * ai[sh]; a2i[sh] = ar[sh] * ai[sh] + ar[sh] * ai[sh];
        a3r[sh] = a2r[sh] * ar[sh] - a2i[sh] * ai[sh]; a3i[sh] = a2r[sh] * ai[sh] + a2i[sh] * ar[sh];
        a4r[sh] = a2r[sh] * a2r[sh] - a2i[sh] * a2i[sh]; a4i[sh] = a2r[sh] * a2i[sh] + a2r[sh] * a2i[sh];
        const float nr = ar[sh] - 1.0f, ni = ai[sh], den = 1.0f / (lre * lre + lim * lim);
        const float cr = (nr * lre + ni * lim) * den, ci = (ni * lre - nr * lim) * den;
#pragma unroll
        for (int s2 = 0; s2 < 2; ++s2) {
            const f32x4 Br = *(const f32x4*)(sp.b_re + ((size_t)dg * 64 + p) * 16 + 8 * s2 + 4 * hh), Bi = *(const f32x4*)(sp.b_im + ((size_t)dg * 64 + p) * 16 + 8 * s2 + 4 * hh);
            const f32x4 re = Br * cr - Bi * ci, im = Bi * cr + Br * ci;
            v2u pr, pi; pr.x = pkbf(re[0], re[1]); pr.y = pkbf(re[2], re[3]); pi.x = pkbf(im[0], im[1]); pi.y = pkbf(im[2], im[3]);
            bfr[sh][s2] = __builtin_bit_cast(bf16x4_t, pr); bfr[2 + sh][s2] = __builtin_bit_cast(bf16x4_t, pi);
        }
    }
    bf16x4_t cfr[16];
    if (MODE != 0) {
#pragma unroll
        for (int s = 0; s < 16; ++s) {
            const int p4 = (8 * s + 4 * hh) & 63; f32x4 cv = {0.f, 0.f, 0.f, 0.f};
            if (m32 < 16) cv = (s < 8) ? *(const f32x4*)(sp.c_re + ((size_t)dg * 16 + m32) * 64 + p4) : -*(const f32x4*)(sp.c_im + ((size_t)dg * 16 + m32) * 64 + p4);
            v2u pc; pc.x = pkbf(cv[0], cv[1]); pc.y = pkbf(cv[2], cv[3]); cfr[s] = __builtin_bit_cast(bf16x4_t, pc);
        }
    }
    const float ddv = (MODE == 2 && m32 < 16) ? sp.dd[g * 16 + m32] : 0.f;
    float hr[2], hi[2];
    hr[0] = __shfl(hre, m32); hi[0] = __shfl(him, m32); hr[1] = __shfl(hre, m32 + 32); hi[1] = __shfl(him, m32 + 32);
#pragma unroll 1
    for (int ci2 = 0; ci2 < 2; ++ci2) {
        const int ch = DIR ? 1 - ci2 : ci2, rowc = row0 + 32 * ch;
        const bf16* urow = P + (size_t)(rowc + m32) * DINP + C_S5 + g * 16 + 4 * hh;
        const bf16x4_t ua0 = __builtin_bit_cast(bf16x4_t, *(const v2u*)urow), ua1 = __builtin_bit_cast(bf16x4_t, *(const v2u*)(urow + 8));
        f32x16 BU[4];
#pragma unroll
        for (int nt = 0; nt < 4; ++nt) {
#pragma unroll
            for (int r = 0; r < 16; ++r) BU[nt][r] = 0.f;
            BU[nt] = MFMA8(ua0, bfr[nt][0], BU[nt]); BU[nt] = MFMA8(ua1, bfr[nt][1], BU[nt]);
        }
#pragma unroll
        for (int sh = 0; sh < 2; ++sh)
#pragma unroll
            for (int gg = 0; gg < 4; ++gg)
#pragma unroll
                for (int jj = 1; jj < 4; ++jj) {
                    const int r = DIR ? 4 * gg + 3 - jj : 4 * gg + jj, rp = DIR ? r + 1 : r - 1;
                    const float pr = BU[sh][rp], pi = BU[2 + sh][rp];
                    BU[sh][r] += ar[sh] * pr - ai[sh] * pi; BU[2 + sh][r] += ar[sh] * pi + ai[sh] * pr;
                }
        float hnr[2][4], hni[2][4];
#pragma unroll
        for (int st = 0; st < 8; ++st) {
            const int gg = DIR ? 3 - (st >> 1) : (st >> 1), turn = DIR ? 1 - (st & 1) : (st & 1), rl = DIR ? 4 * gg : 4 * gg + 3;
            const bool act = (hh == turn);
#pragma unroll
            for (int sh = 0; sh < 2; ++sh) {
                if (turn == (DIR ? 1 : 0)) { hnr[sh][gg] = hr[sh]; hni[sh][gg] = hi[sh]; }
                else { hnr[sh][gg] = act ? hr[sh] : hnr[sh][gg]; hni[sh][gg] = act ? hi[sh] : hni[sh][gg]; }
                const float outr = BU[sh][rl] + a4r[sh] * hr[sh] - a4i[sh] * hi[sh], outi = BU[2 + sh][rl] + a4r[sh] * hi[sh] + a4i[sh] * hr[sh];
                const float sr = __shfl_xor(outr, 32), si = __shfl_xor(outi, 32);
                hr[sh] = act ? outr : sr; hi[sh] = act ? outi : si;
            }
        }
        if (MODE != 0) {
#pragma unroll
            for (int sh = 0; sh < 2; ++sh)
#pragma unroll
                for (int gg = 0; gg < 4; ++gg)
#pragma unroll
                    for (int jj = 0; jj < 4; ++jj) {
                        const int pw = DIR ? 4 - jj : jj + 1;
                        const float pr = (pw == 1) ? ar[sh] : (pw == 2) ? a2r[sh] : (pw == 3) ? a3r[sh] : a4r[sh], pi = (pw == 1) ? ai[sh] : (pw == 2) ? a2i[sh] : (pw == 3) ? a3i[sh] : a4i[sh];
                        BU[sh][4 * gg + jj] += pr * hnr[sh][gg] - pi * hni[sh][gg]; BU[2 + sh][4 * gg + jj] += pr * hni[sh][gg] + pi * hnr[sh][gg];
                    }
#pragma unroll
            for (int nt = 0; nt < 4; ++nt)
#pragma unroll
                for (int r = 0; r < 16; ++r) *(LAS unsigned short*)(hs + ((r & 3) + 8 * (r >> 2) + 4 * hh) * 272 + (32 * nt + m32) * 2) = (unsigned short)f2bf(BU[nt][r]);
            f32x16 Yv;
#pragma unroll
            for (int r = 0; r < 16; ++r) Yv[r] = 0.f;
#pragma unroll
            for (int s = 0; s < 16; ++s) Yv = MFMA8(ld4(hs + m32 * 272 + (8 * s + 4 * hh) * 2), cfr[s], Yv);
            if (m32 < 16) {
#pragma unroll
                for (int r = 0; r < 16; ++r) {
                    const int tl = (r & 3) + 8 * (r >> 2) + 4 * hh;
                    if (MODE == 1) yf[(32 * ch + tl) * 16 + m32] = Yv[r];
                    else { const float u = bf2f(P[(size_t)(rowc + tl) * DINP + C_S5 + g * 16 + m32]);
                        const float y = Yv[r] + yf[(32 * ch + tl) * 16 + m32] + ddv * u;
                        Z[(size_t)(rowc + tl) * 256 + g * 16 + m32] = (bf16)f2bf(gelu_tanh(y)); }
                }
            }
        }
    }
    hre = hh ? hr[1] : hr[0]; him = hh ? hi[1] : hi[0];
}
template <int MODE>
__device__ __forceinline__ void s5_mm(const S5P& sp, const bf16* P, int b, int g, int dir, int sg, int lane, float& hre, float& him, LAS float* yf, LAS unsigned char* hs, bf16* Z) {
    if (dir) s5_mm_dir<MODE, 1>(sp, P, b, g, sg, lane, hre, him, yf, hs, Z); else s5_mm_dir<MODE, 0>(sp, P, b, g, sg, lane, hre, him, yf, hs, Z);
}
template <int MIX, int DIR, bool WITH_O>
__device__ __forceinline__ void mx_chunk(LAS unsigned char* wl, int lane, float Pl, f32x16 (&ST)[(MIX == 2) ? 1 : 2][2], f32x16 (&O)[2]) {
    constexpr int DK = (MIX == 2) ? 32 : 64, NRT = DK / 32;
    const int m32 = lane & 31, hh = lane >> 5;
    asm volatile("" ::: "memory");
    if (lane < DK) *(LAS float*)(wl + WL_PL + lane * 4) = Pl;
    asm volatile("" ::: "memory");
    if (WITH_O) {
        f32x16 x;
#pragma unroll
        for (int r = 0; r < 16; ++r) x[r] = 0.f;
#pragma unroll
        for (int s = 0; s < DK / 8; ++s) {
            const bf16x4_t ka = ld4(wl + WL_KC + m32 * 144 + (8 * s + 4 * hh) * 2);
            const bf16x4_t qb = ld4(wl + WL_QC + m32 * 144 + (8 * s + 4 * hh) * 2);
            x = MFMA8(ka, qb, x);
        }
#pragma unroll
        for (int r = 0; r < 16; ++r) { const int j = (r & 3) + 8 * (r >> 2) + 4 * hh; const bool keep = DIR ? (j >= m32) : (j <= m32); x[r] = keep ? x[r] : 0.f; }
#pragma unroll
        for (int t = 0; t < 2; ++t)
#pragma unroll
            for (int r = 0; r < 16; ++r) O[t][r] = 0.f;
#pragma unroll
        for (int s = 0; s < 4; ++s) {
            const bf16x4_t xa = pack4(x, s);
#pragma unroll
            for (int t = 0; t < 2; ++t) O[t] = MFMA8(xa, ld4(wl + WL_VT + (32 * t + m32) * 80 + (8 * s + 4 * hh) * 2), O[t]);
        }
#pragma unroll
        for (int rt = 0; rt < NRT; ++rt)
#pragma unroll
            for (int s = 0; s < 4; ++s) {
                const bf16x4_t qa = ld4(wl + WL_QC + m32 * 144 + (32 * rt + 8 * s + 4 * hh) * 2);
#pragma unroll
                for (int t = 0; t < 2; ++t) O[t] = MFMA8(qa, pack4(ST[rt][t], s), O[t]);
            }
    }
#pragma unroll
    for (int rt = 0; rt < NRT; ++rt)
#pragma unroll
        for (int s = 0; s < 4; ++s) {
            const bf16x4_t ka = ld4(wl + WL_KT + (32 * rt + m32) * 80 + (8 * s + 4 * hh) * 2);
#pragma unroll
            for (int t = 0; t < 2; ++t) ST[rt][t] = MFMA8(ka, ld4(wl + WL_VT + (32 * t + m32) * 80 + (8 * s + 4 * hh) * 2), ST[rt][t]);
        }
#pragma unroll
    for (int rt = 0; rt < NRT; ++rt)
#pragma unroll
        for (int g = 0; g < 4; ++g) {
            const f32x4 pl4 = *(const LAS f32x4*)(wl + WL_PL + (32 * rt + 8 * g + 4 * hh) * 4);
#pragma unroll
            for (int e = 0; e < 4; ++e) { ST[rt][0][4 * g + e] *= pl4[e]; ST[rt][1][4 * g + e] *= pl4[e]; }
        }
}
__device__ __forceinline__ float half_sum(float v) {
#pragma unroll
    for (int o = 1; o < 32; o <<= 1) v += __shfl_xor(v, o);
    return v;
}
template <int MIX, int DIR>
__device__ __forceinline__ void mixA_stream(const MixP& mp, const MxC& c, int row0, int tpos0, int lane, LAS unsigned char* wl, f32x16 (&ST)[(MIX == 2) ? 1 : 2][2], float& Gam) {
    f32x16 O[2];
    MxRaw r0, r1, r2;
    mx_load<MIX, false, DIR>(r0, mp, c, row0, 0); mx_load<MIX, false, DIR>(r1, mp, c, row0, 1); mx_load<MIX, false, DIR>(r2, mp, c, row0, 2);
    float P = 1.0f;
#pragma unroll 1
    for (int b = 0; b < 16; ++b) {
        MxRaw r3; mx_load<MIX, false, DIR>(r3, mp, c, row0, b < 13 ? b + 3 : 15);
        int ln = lane; asm volatile("" : "+v"(ln));
        mx_batch<MIX, false, DIR>(r0, mp, c, tpos0, ln, wl, b, P);
        if ((b & 7) == 7) { Gam *= P; mx_chunk<MIX, 0, false>(wl, ln, P, ST, O); P = 1.0f; }
        r0 = r1; r1 = r2; r2 = r3;
    }
}
template <int MIX>
__device__ __forceinline__ void mixA_unit(const MixP& mp, float* STG, int idx, int lane_in, LAS unsigned char* wl) {
    int lane = lane_in;
    constexpr int DK = (MIX == 2) ? 32 : 64, NRT = DK / 32;
    const int dir = idx / 2112, rem = idx - dir * 2112, bh = rem / NSEG, sg = rem - bh * NSEG, b = bh >> 2, h = bh & 3;
    asm volatile("" : "+v"(lane));
    MxC c; mx_consts<MIX>(c, mp, h, dir, lane);
    f32x16 ST[NRT][2];
#pragma unroll
    for (int rt = 0; rt < NRT; ++rt)
#pragma unroll
        for (int t = 0; t < 2; ++t)
#pragma unroll
            for (int r = 0; r < 16; ++r) ST[rt][t][r] = 0.f;
    const int row0 = seg_row0(b, sg), tpos0 = seg_tpos0(sg);
    float Gam = 1.0f;
    if (dir) mixA_stream<MIX, 1>(mp, c, row0, tpos0, lane, wl, ST, Gam); else mixA_stream<MIX, 0>(mp, c, row0, tpos0, lane, wl, ST, Gam);
    const size_t slot = (size_t)((dir * 16 + bh) * NSEG + sg);
    float* ds = STG + (MIX == 0 ? ST_DS0 : (MIX == 1 ? ST_DS1 : ST_DS2)) + slot * (DK * 64);
    const int m32 = lane & 31, hh = lane >> 5;
#pragma unroll
    for (int rt = 0; rt < NRT; ++rt)
#pragma unroll
        for (int t = 0; t < 2; ++t)
#pragma unroll
            for (int r = 0; r < 16; ++r) GST(float, ds + (32 * rt + (r & 3) + 8 * (r >> 2)) * 64 + 32 * t, 4u * (unsigned)(4 * hh * 64 + m32)) = ST[rt][t][r];
    float* gs = STG + (MIX == 0 ? ST_G0 : (MIX == 1 ? ST_G1 : ST_G2)) + slot * 64;
    GST(float, gs, 4u * (unsigned)lane) = Gam;
}
template <int MIX, int MODE>
__device__ __forceinline__ void mx_epilogue(const MixP& mp, LAS unsigned char* wl, int lane, const f32x16 (&O)[2], int rowc, float* OF, bf16* Y, int ocol, int ycol, int cgate, float nwv) {
    LAS float* ost = (LAS float*)(wl + WL_QC);
    const int m32 = lane & 31, hh = lane >> 5;
    asm volatile("" ::: "memory");
#pragma unroll
    for (int t = 0; t < 2; ++t)
#pragma unroll
        for (int r = 0; r < 16; ++r) ost[((r & 3) + 8 * (r >> 2) + 4 * hh) * 68 + 32 * t + m32] = O[t][r];
    asm volatile("" ::: "memory");
    if (MODE == 1) {
#pragma unroll 8
        for (int tk = 0; tk < 32; ++tk) GST(float, OF + (size_t)(rowc + tk) * 768 + ocol, 4u * (unsigned)lane) = ost[tk * 68 + lane];
    } else {
        float ofc[8]; unsigned short gc[8];
#pragma unroll
        for (int u = 0; u < 8; ++u) { ofc[u] = GLD(float, OF + (size_t)(rowc + u) * 768 + ocol, 4u * (unsigned)lane); gc[u] = GLD(unsigned short, mp.P + (size_t)(rowc + u) * DINP + cgate, 2u * (unsigned)lane); }
#pragma unroll 1
        for (int b8 = 0; b8 < 4; ++b8) {
            float ofn[8]; unsigned short gn[8]; const int nb = b8 < 3 ? b8 + 1 : 3;
#pragma unroll
            for (int u = 0; u < 8; ++u) { ofn[u] = GLD(float, OF + (size_t)(rowc + nb * 8 + u) * 768 + ocol, 4u * (unsigned)lane); gn[u] = GLD(unsigned short, mp.P + (size_t)(rowc + nb * 8 + u) * DINP + cgate, 2u * (unsigned)lane); }
#pragma unroll
            for (int u = 0; u < 8; ++u) {
                const int tk = b8 * 8 + u;
                const float o = ost[tk * 68 + lane] + ofc[u];
                float y;
                if (MIX == 0) { const float mean = wave_sum(o) * (1.0f / 64.0f); const float d = o - mean; y = d * (1.0f / sqrtf(wave_sum(d * d) * (1.0f / 64.0f) + NEPS)) * nwv; }
                else y = o * (1.0f / sqrtf(wave_sum(o * o) * (1.0f / 64.0f) + NEPS)) * nwv;
                y *= silu_f(bf2f(gc[u]));
                GST(unsigned short, Y + (size_t)(rowc + tk) * 1024 + ycol, 2u * (unsigned)lane) = (unsigned short)f2bf(y);
            }
#pragma unroll
            for (int u = 0; u < 8; ++u) { ofc[u] = ofn[u]; gc[u] = gn[u]; }
        }
    }
}
template <int MIX, int DIR>
__device__ __forceinline__ void mixC_stream(const MixP& mp, const MxC& c, int row0, int tpos0, int lane, LAS unsigned char* wl, f32x16 (&ST)[(MIX == 2) ? 1 : 2][2],
                                            float* OF, bf16* Y, int ocol, int ycol, int cgate, float nwv) {
    f32x16 O[2];
    MxRaw r0, r1;
    mx_load<MIX, true, DIR>(r0, mp, c, row0, 0); mx_load<MIX, true, DIR>(r1, mp, c, row0, 1);
    float P = 1.0f;
#pragma unroll 1
    for (int b = 0; b < 16; ++b) {
        MxRaw r2; mx_load<MIX, true, DIR>(r2, mp, c, row0, b < 14 ? b + 2 : 15);
        int ln = lane; asm volatile("" : "+v"(ln));
        mx_batch<MIX, true, DIR>(r0, mp, c, tpos0, ln, wl, b, P);
        if ((b & 7) == 7) {
            const int ch = DIR ? 1 - (b >> 3) : (b >> 3);
            mx_chunk<MIX, DIR, true>(wl, ln, P, ST, O); P = 1.0f;
            mx_epilogue<MIX, DIR ? 2 : 1>(mp, wl, ln, O, row0 + 32 * ch, OF, Y, ocol, ycol, cgate, nwv);
        }
        r0 = r1; r1 = r2;
    }
}
template <int MIX>
__device__ __forceinline__ void mixC_unit(const MixP& mp, const float* STG, int idx, int lane_in, float* OF, LAS unsigned char* wl, bf16* Y, const float* nw) {
    int lane = lane_in; asm volatile("" : "+v"(lane));
    constexpr int DK = (MIX == 2) ? 32 : 64, NRT = DK / 32;
    const int bh = idx / NSEG, sg = idx - bh * NSEG, b = bh >> 2, h = bh & 3;
    const int row0 = seg_row0(b, sg), tpos0 = seg_tpos0(sg);
    const int ocol = ((MIX == 0) ? 0 : (MIX == 1 ? 256 : 512)) + h * 64, ycol = ((MIX == 0) ? 0 : (MIX == 1 ? 512 : 768)) + h * 64;
    const int cgate = ((MIX == 0) ? C_RG : (MIX == 1 ? C_HG : C_GG)) + h * 64;
    const float* dsb = STG + (MIX == 0 ? ST_DS0 : (MIX == 1 ? ST_DS1 : ST_DS2));
    const float nwv = nw[h * 64 + lane];
    f32x16 ST[NRT][2];
#pragma unroll 1
    for (int dir = 0; dir < 2; ++dir) {
        asm volatile("" : "+v"(lane));
        const int m32 = lane & 31, hh = lane >> 5;
        MxC c; mx_consts<MIX>(c, mp, h, dir, lane);
        { const float* ds = dsb + (size_t)((dir * 16 + bh) * NSEG + sg) * (DK * 64);
#pragma unroll
          for (int rt = 0; rt < NRT; ++rt)
#pragma unroll
              for (int t = 0; t < 2; ++t)
#pragma unroll
                  for (int r = 0; r < 16; ++r) ST[rt][t][r] = GLD(float, ds + (32 * rt + (r & 3) + 8 * (r >> 2)) * 64 + 32 * t, 4u * (unsigned)(4 * hh * 64 + m32)); }
        if (dir == 0) mixC_stream<MIX, 0>(mp, c, row0, tpos0, lane, wl, ST, OF, Y, ocol, ycol, cgate, nwv);
        else mixC_stream<MIX, 1>(mp, c, row0, tpos0, lane, wl, ST, OF, Y, ocol, ycol, cgate, nwv);
        asm volatile("s_waitcnt vmcnt(0)" ::: "memory");
    }
}
template <int MSEL>
__device__ __forceinline__ void mix_passA(const Frame& F, const Args& a, int l) {
    const MixP mp = make_mixp(F, a, l); const S5P sp = make_s5p(F, a, l);
    float* ST = (float*)(F.ws + WS_X2);
    LAS unsigned char* wl = F.lds + F.wave * WL_BYTES; LAS float* stg = (LAS float*)wl;
    if (MSEL == 15) {
        constexpr int NMX = 3 * 4224, NS5 = 2 * 64 * NSEG;
        const int heavy = NMX - (NMX / F.NGW) * F.NGW, nlight = F.NGW - heavy;
        const int n_all = (NS5 - 4 * nlight) / F.NGW;
        for (int it = 0; ; ++it) {
            int u;
            const int nmine = NMX / F.NGW + (F.gw < heavy ? 1 : 0);
            if (it < nmine) u = F.gw + it * F.NGW;
            else if (it < nmine + n_all) u = NMX + F.gw + (it - nmine) * F.NGW;
            else { const int k2 = it - nmine - n_all; if (F.gw < heavy || k2 >= 4) {
                    const int rest0 = NMX + n_all * F.NGW + 4 * nlight; const int uu = rest0 + F.gw + (k2 - (F.gw < heavy ? 0 : 4)) * F.NGW; if (uu >= NMX + NS5) break; u = uu; }
                else u = NMX + n_all * F.NGW + (F.gw - heavy) + k2 * nlight; }
            if (u >= NMX + NS5) break;
            if (u < 4224) mixA_unit<0>(mp, ST, u, fresh_lane(), wl);
            else if (u < 2 * 4224) mixA_unit<1>(mp, ST, u - 4224, fresh_lane(), wl);
            else if (u < 3 * 4224) mixA_unit<2>(mp, ST, u - 2 * 4224, fresh_lane(), wl);
            else { const int idx = u - 3 * 4224; const int dir = idx / (64 * NSEG), rem = idx - dir * 64 * NSEG, bg = rem / NSEG, sg = rem - bg * NSEG;
                float hre = 0.f, him = 0.f;
                s5_mm<0>(sp, mp.P, bg >> 4, bg & 15, dir, sg, fresh_lane(), hre, him, nullptr, wl, nullptr);
                float* hs = ST + ST_HS + ((size_t)((dir * 64 + bg) * NSEG + sg) * 64 + fresh_lane()) * 2;
                hs[0] = hre; hs[1] = him; }
        }
        return;
    }
    if (MSEL & 1) for (int u = F.gw; u < 4224; u += F.NGW) mixA_unit<0>(mp, ST, u, fresh_lane(), wl);
    if (MSEL & 2) for (int u = F.gw; u < 4224; u += F.NGW) mixA_unit<1>(mp, ST, u, fresh_lane(), wl);
    if (MSEL & 4) for (int u = F.gw; u < 4224; u += F.NGW) mixA_unit<2>(mp, ST, u, fresh_lane(), wl);
    if (MSEL & 8) for (int idx = F.gw; idx < 2 * 64 * NSEG; idx += F.NGW) {
        const int dir = idx / (64 * NSEG), rem = idx - dir * 64 * NSEG, bg = rem / NSEG, sg = rem - bg * NSEG;
        float hre = 0.f, him = 0.f;
        s5_mm<0>(sp, mp.P, bg >> 4, bg & 15, dir, sg, fresh_lane(), hre, him, nullptr, wl, nullptr);
        float* hs = ST + ST_HS + ((size_t)((dir * 64 + bg) * NSEG + sg) * 64 + fresh_lane()) * 2;
        hs[0] = hre; hs[1] = him;
    }
}
__device__ __forceinline__ int chain_seg(int dir, int p) { return dir ? (p < 4 ? 3 - p : 135 - p) : p; }
__device__ __forceinline__ void mix_passB(const Frame& F, const Args& a, int l) {
    float* ST = (float*)(F.ws + WS_X2);
    constexpr int N0 = 131072, N1 = 131072, N2 = 65536, N3 = 8192;
    for (int e = blockIdx.x * 512 + F.tid; e < N0 + N1 + N2 + N3; e += F.G * 512) {
        if (e < N0 + N1 + N2) {
            float* base; const float* gb; int dir, esz;
            if (e < N0 + N1) { const int mix = e >= N0, e2 = e - mix * N0, c = e2 >> 12, el = e2 & 4095; dir = c >> 4; esz = 4096;
                base = ST + (mix ? ST_DS1 : ST_DS0) + (size_t)c * NSEG * 4096 + el; gb = ST + (mix ? ST_G1 : ST_G0) + (size_t)c * NSEG * 64 + (el >> 6); }
            else { const int e2 = e - N0 - N1, c = e2 >> 11, el = e2 & 2047; dir = c >> 4; esz = 2048;
                base = ST + ST_DS2 + (size_t)c * NSEG * 2048 + el; gb = ST + ST_G2 + (size_t)c * NSEG * 64 + (el >> 6); }
            float run = 0.f;
#pragma unroll 1
            for (int p0 = 0; p0 < NSEG; p0 += 12) {
                float d[12], gm[12];
#pragma unroll
                for (int q = 0; q < 12; ++q) { const int sg = chain_seg(dir, p0 + q); d[q] = base[(size_t)sg * esz]; gm[q] = gb[sg * 64]; }
#pragma unroll
                for (int q = 0; q < 12; ++q) { const int sg = chain_seg(dir, p0 + q); base[(size_t)sg * esz] = run; run = fmaf(gm[q], run, d[q]); }
            }
        } else {
            const int e2 = e - N0 - N1 - N2, c = e2 >> 6, p = e2 & 63, dir = c >> 6, g = c & 15;
            const int dg = dir * 16 + g;
            const float lre = a.in[F.zz + I_LAMRE][(size_t)l * 2048 + dg * 64 + p], lim = a.in[F.zz + I_LAMIM][(size_t)l * 2048 + dg * 64 + p], dt = expf(a.in[F.zz + I_LOGDT][l * 32 + dg]);
            const float er = expf(lre * dt * 64.0f); const float sn = sinf(lim * dt * 64.0f), cs = cosf(lim * dt * 64.0f);
            const float ar = er * cs, ai = er * sn;
            float* base = ST + ST_HS + ((size_t)c * NSEG * 64 + p) * 2;
            float rr = 0.f, ri = 0.f;
#pragma unroll 1
            for (int q0 = 0; q0 < NSEG; q0 += 12) {
                float dr[12], di[12];
#pragma unroll
                for (int q = 0; q < 12; ++q) { const int sg = chain_seg(dir, q0 + q); dr[q] = base[(size_t)sg * 128]; di[q] = base[(size_t)sg * 128 + 1]; }
#pragma unroll
                for (int q = 0; q < 12; ++q) { const int sg = chain_seg(dir, q0 + q); base[(size_t)sg * 128] = rr; base[(size_t)sg * 128 + 1] = ri;
                    const float nr = ar * rr - ai * ri + dr[q], ni = ar * ri + ai * rr + di[q]; rr = nr; ri = ni; }
            }
        }
    }
}
template <int MSEL>
__device__ __forceinline__ void mix_passC(const Frame& F, const Args& a, int l) {
    const MixP mp = make_mixp(F, a, l); const S5P sp = make_s5p(F, a, l);
    const float* ST = (const float*)(F.ws + WS_X2);
    LAS unsigned char* wl = F.lds + F.wave * WL_BYTES;
    LAS float* stg = (LAS float*)wl; LAS float* of = (LAS float*)(wl + 9216);
    float* OF = (float*)(F.ws + WS_OF);
    bf16* Y = (bf16*)(F.ws + WS_ACT); bf16* Z = (bf16*)(F.ws + WS_Z);
    const bool keep = l < DEPTH - 1;
    constexpr int NM = 16 * NSEG;
    if (MSEL == 15) {
        constexpr int NMX = 3 * NM, NS5 = 64 * NSEG;
        const int heavy = NMX - (NMX / F.NGW) * F.NGW, nlight = F.NGW - heavy;
        for (int it = 0; ; ++it) {
            int u;
            const int nmine = NMX / F.NGW + (F.gw < heavy ? 1 : 0);
            if (it < nmine) u = F.gw + it * F.NGW;
            else { if (F.gw < heavy) break; u = NMX + (F.gw - heavy) + (it - nmine) * nlight; }
            if (u >= NMX + NS5) break;
            const int sgu = (u < 3 * NM) ? (u % NSEG) : ((u - 3 * NM) % NSEG);
            if (!keep && sgu < 4) continue;
            if (u < NM) mixC_unit<0>(mp, ST, u, fresh_lane(), OF, wl, Y, a.in[F.zz + I_RETGN] + l * 256);
            else if (u < 2 * NM) mixC_unit<1>(mp, ST, u - NM, fresh_lane(), OF, wl, Y, a.in[F.zz + I_HGNW] + l * 256);
            else if (u < 3 * NM) mixC_unit<2>(mp, ST, u - 2 * NM, fresh_lane(), OF, wl, Y, a.in[F.zz + I_GLANW] + l * 256);
            else { const int idx = u - 3 * NM, bg = idx / NSEG, sg = idx - bg * NSEG;
                const float* h0 = ST + ST_HS + ((size_t)((0 * 64 + bg) * NSEG + sg) * 64 + fresh_lane()) * 2;
                float hre = h0[0], him = h0[1];
                s5_mm<1>(sp, mp.P, bg >> 4, bg & 15, 0, sg, fresh_lane(), hre, him, of, wl, Z);
                const float* h1 = ST + ST_HS + ((size_t)((1 * 64 + bg) * NSEG + sg) * 64 + fresh_lane()) * 2;
                hre = h1[0]; him = h1[1];
                s5_mm<2>(sp, mp.P, bg >> 4, bg & 15, 1, sg, fresh_lane(), hre, him, of, wl, Z); }
        }
        return;
    }
    if (MSEL & 1) for (int u = F.gw; u < NM; u += F.NGW) { if (!keep && (u % NSEG) < 4) continue; mixC_unit<0>(mp, ST, u, fresh_lane(), OF, wl, Y, a.in[F.zz + I_RETGN] + l * 256); }
    if (MSEL & 2) for (int u = F.gw; u < NM; u += F.NGW) { if (!keep && (u % NSEG) < 4) continue; mixC_unit<1>(mp, ST, u, fresh_lane(), OF, wl, Y, a.in[F.zz + I_HGNW] + l * 256); }
    if (MSEL & 4) for (int u = F.gw; u < NM; u += F.NGW) { if (!keep && (u % NSEG) < 4) continue; mixC_unit<2>(mp, ST, u, fresh_lane(), OF, wl, Y, a.in[F.zz + I_GLANW] + l * 256); }
    if (MSEL & 8) for (int idx = F.gw; idx < 64 * NSEG; idx += F.NGW) {
        const int bg = idx / NSEG, sg = idx - bg * NSEG;
        if (!keep && sg < 4) continue;
        const float* h0 = ST + ST_HS + ((size_t)((0 * 64 + bg) * NSEG + sg) * 64 + fresh_lane()) * 2;
        float hre = h0[0], him = h0[1];
        s5_mm<1>(sp, mp.P, bg >> 4, bg & 15, 0, sg, fresh_lane(), hre, him, of, wl, Z);
        const float* h1 = ST + ST_HS + ((size_t)((1 * 64 + bg) * NSEG + sg) * 64 + fresh_lane()) * 2;
        hre = h1[0]; him = h1[1];
        s5_mm<2>(sp, mp.P, bg >> 4, bg & 15, 1, sg, fresh_lane(), hre, him, of, wl, Z);
    }
}

constexpr int NPH = 11;
template <int PH_MASK, int MSEL>
__global__ void __launch_bounds__(512, 2) mk_fwd(Args a) {
    extern __shared__ __attribute__((aligned(16))) unsigned char lds_raw[];
    Frame F;
    F.lds = (LAS unsigned char*)lds_raw;
    const int wave0 = __builtin_amdgcn_readfirstlane((int)threadIdx.x >> 6);
    F.lane = fresh_lane(); F.tid = wave0 * 64 + F.lane; F.wave = wave0;
    F.G = gridDim.x; F.gw = blockIdx.x * 8 + F.wave; F.NGW = F.G * 8; F.zz = 0; F.ws = (unsigned char*)a.in[I_WS]; F.out = (float*)a.in[I_OUT];
    volatile LAS unsigned* MISC = (volatile LAS unsigned*)(F.lds + MISC_OFF);
    for (int u = F.tid; u < 64; u += 512) ((LAS unsigned*)(F.lds + MISC_OFF))[u] = 0u;
    __syncthreads();
    XcdBarrier bar; bar.bar = (unsigned*)F.ws + CW_BAR; bar.x = 0; bar.st = nullptr;
    if (a.fused) bar = xcd_barrier_post((unsigned*)F.ws + CW_BAR, MISC + 8, F.tid);
#define SEAM() do { if (a.fused) { XcdBarrier bb = bar; asm volatile("" : "+s"(bb.bar), "+s"(bb.x)); xcd_barrier(bb, wave0 * 64 + fresh_lane()); } } while (0)
#define PHASE_BEGIN() do { int zz_ = 0; asm volatile("" : "+s"(zz_)); F.zz = zz_; F.ws = (unsigned char*)a.in[I_WS + zz_]; F.out = (float*)a.in[I_OUT + zz_]; \
        const int ln_ = fresh_lane(); const int t_ = wave0 * 64 + ln_ + zz_; F.tid = t_; F.lane = t_ & 63; F.wave = wave0 + zz_; F.G = (int)gridDim.x + zz_; F.gw = ((int)blockIdx.x + zz_) * 8 + F.wave; F.NGW = F.G * 8; \
        F.lds = (LAS unsigned char*)lds_raw + zz_; } while (0)
#define IN(k) (((PH_MASK >> (k)) & 1) && a.ph_lo <= (k) && (k) < a.ph_hi)
#ifndef DUP_PH
#define DUP_PH 0
#endif
#define REP(k) for (int rep_ = 0; rep_ < (((DUP_PH >> (k)) & 1) ? 2 : 1); ++rep_)
#define hb ((float*)(F.ws + WS_HB))
#define MOD ((const float*)(F.ws + WS_MOD))
#define ACT ((bf16*)(F.ws + WS_ACT))
#define PH ((bf16*)(F.ws + WS_PH))

    if (((PH_MASK >> 12) & 1) && a.do_pro) REP(12) { PHASE_BEGIN(); prologue(F, a); SEAM(); }

#pragma unroll
    for (int l = 0; l < DEPTH; ++l) {
        if (l < a.l_lo || l >= a.l_hi) continue;
        const bool keep = l < DEPTH - 1, moe = l & 1; const int j = l >> 1;
        const int Mrows = keep ? MT : NLAT;
        if (IN(0)) for (int rep_ = 0; rep_ < ((((DUP_PH >> 0) & 1) && l != 2) ? 2 : 1); ++rep_) { PHASE_BEGIN();
            norm_phase<0>(F, a, l, 0, MT, (l == 2) ? 1 : -1);
            SEAM();
        }
        if (IN(1)) REP(1) { PHASE_BEGIN();
            pg8::Gemm g{ACT, (const bf16*)(F.ws + WS_WIN) + (size_t)l * DINP * 1024, MT, DINP, 1024}; pg8::StaticOrder S; S.init(MT, DINP, F.G, (int)blockIdx.x);
            EpiStoreBf16 E{PH, DINP, 1.0f};
            pg8::gemm_phase<EpiStoreBf16, pg8::StaticOrder, true, true>(F.lds, g, S, E, F.tid);
            SEAM();
        }
        if (IN(2)) { PHASE_BEGIN(); mix_passA<MSEL>(F, a, l); SEAM(); }
#ifdef DUP_MIX
        if (IN(2)) { PHASE_BEGIN(); mix_passA<DUP_MIX>(F, a, l); SEAM(); }
#endif
        if (IN(3)) { PHASE_BEGIN(); mix_passB(F, a, l); SEAM(); }
        if (IN(4)) { PHASE_BEGIN(); mix_passC<MSEL>(F, a, l); SEAM(); }
#ifdef DUP_MIX
        if (IN(4)) { PHASE_BEGIN(); mix_passC<DUP_MIX>(F, a, l); SEAM(); }
#endif
        if (IN(5)) REP(5) { PHASE_BEGIN();
            int k256 = 256; asm volatile("" : "+s"(k256)); pg8::Gemm g{(const bf16*)(F.ws + WS_Z), (const bf16*)(F.ws + WS_GLUW) + (size_t)l * 65536, Mrows, 256, k256}; pg8::StaticOrder S; S.init(Mrows, 256, F.G, (int)blockIdx.x);
            EpiGlu E{(const bf16*)(F.ws + WS_Z), ACT, a.in[F.zz + I_GLUB] + l * 256};
            pg8::gemm_phase<EpiGlu, pg8::StaticOrder, true, true>(F.lds, g, S, E, F.tid);
            SEAM();
        }
        if (IN(6)) { PHASE_BEGIN();
            pg8::Gemm g{ACT, (const bf16*)(F.ws + WS_WOUT) + (size_t)l * 1024 * 1024, Mrows, 1024, 1024}; pg8::StaticOrder S; S.init(Mrows, 1024, F.G, (int)blockIdx.x);
            EpiResid E{(l == 0) ? a.in[F.zz + I_X] : F.out, (l == 0) ? a.in[F.zz + I_CTX] : hb, F.out, hb, MOD + (size_t)l * 5 * 6144 + 2 * 1024, 1.0f};
            pg8::gemm_phase<EpiResid, pg8::StaticOrder, true, true>(F.lds, g, S, E, F.tid);
            SEAM();
        }
        if (IN(7)) for (int rep_ = 0; rep_ < ((((DUP_PH >> 7) & 1) && !moe) ? 2 : 1); ++rep_) { PHASE_BEGIN();
            if (moe) norm_phase<1>(F, a, l, 1, Mrows, -1); else norm_phase<0>(F, a, l, 1, Mrows, -1);
            SEAM();
        }
        if (!moe) {
            if (IN(8)) REP(8) { PHASE_BEGIN();
                pg8::Gemm g{ACT, (const bf16*)(F.ws + WS_W13D) + (size_t)j * 5632 * 1024, Mrows, 5632, 1024}; pg8::StaticOrder S; S.init(Mrows, 5632, F.G, (int)blockIdx.x);
                EpiSwiglu8 E{(unsigned char*)PH, 1.0f};
                pg8::gemm_phase<EpiSwiglu8, pg8::StaticOrder, true, true>(F.lds, g, S, E, F.tid);
                SEAM();
            }
            if (IN(9)) { PHASE_BEGIN();
                int k8 = DFF / 2; asm volatile("" : "+s"(k8)); pg8::Gemm g{PH, (const bf16*)(F.ws + WS_W2D + (size_t)j * 1024 * DFF), Mrows, 1024, k8}; pg8::StaticOrder S; S.init(Mrows, 1024, F.G, (int)blockIdx.x);
                EpiResid E{F.out, hb, F.out, hb, MOD + (size_t)l * 5 * 6144 + 5 * 1024, 1.0f / WSC8};
                pg8::gemm_phase_f8<EpiResid, pg8::StaticOrder, true, true>(F.lds, g, S, E, F.tid);
                { const int rem = ((Mrows / 256) * 4) % F.G; if (rem > 0 && (int)blockIdx.x >= rem) moe_cvt_idle(F, a, j, rem); else if (rem == 0) moe_cvt(F, a, j); }
                SEAM();
            }
        } else {
                        if (IN(8)) REP(8) { PHASE_BEGIN(); moe_gather(F, j); SEAM(); }
            if (IN(9)) REP(9) { PHASE_BEGIN();
                int k8 = 512; asm volatile("" : "+s"(k8)); pg8::Gemm g{(const bf16*)(F.ws + WS_X2), (const bf16*)(F.ws + WS_W13M), 0, 5632, k8}; MoeOrder S; S.init((const unsigned*)F.ws + CW_CNT + j * 8 * 64, 22, F.G, (int)blockIdx.x);
                EpiSwiglu8 E{(unsigned char*)PH, 1.0f / WSC8};
                pg8::gemm_phase_f8<EpiSwiglu8, MoeOrder, true, true>(F.lds, g, S, E, F.tid);
                SEAM();
            }
            if (IN(10)) REP(10) { PHASE_BEGIN();
                int k8 = DFF / 2; asm volatile("" : "+s"(k8)); pg8::Gemm g{PH, (const bf16*)(F.ws + WS_W2M), 0, 1024, k8}; MoeOrder S; S.init((const unsigned*)F.ws + CW_CNT + j * 8 * 64, 4, F.G, (int)blockIdx.x);
                EpiStoreBf16 E{(bf16*)(F.ws + WS_X2), 1024, 1.0f / WSC8};
                pg8::gemm_phase_f8<EpiStoreBf16, MoeOrder, true, true>(F.lds, g, S, E, F.tid);
                SEAM();
            }
        }
    }
    if (((PH_MASK >> 13) & 1) && a.do_fin) { PHASE_BEGIN(); norm_phase<2>(F, a, DEPTH - 1, 0, NLAT, DEPTH - 1); }
#undef SEAM
#undef IN
#undef hb
#undef MOD
#undef ACT
#undef PH
}

#ifndef MK_FUSED
#define MK_FUSED 1
#endif
template <int PM, int MS> static void launch_one(const Args& a, int grid, hipStream_t stream) {
    static bool attr_done = false;
    if (!attr_done) { (void)hipFuncSetAttribute((const void*)mk_fwd<PM, MS>, hipFuncAttributeMaxDynamicSharedMemorySize, LDS_BYTES); attr_done = true; }
    hipLaunchKernelGGL((mk_fwd<PM, MS>), dim3(grid), dim3(512), LDS_BYTES, stream, a);
}
extern "C" void kernel_launch(void* const* d_in, const int* in_sizes, int n_in, void* d_out, int out_size, void* d_ws, size_t ws_size, hipStream_t stream) {
    static int grid = 0;
    if (grid == 0) {
        if (n_in != 35 || in_sizes[0] != NLAT * DM || out_size != NLAT * DM || ws_size < WS_END) {
            fprintf(stderr, "kernel_launch: unexpected shapes / workspace (n_in %d, ws %zu, need %zu); nothing launched\n", n_in, ws_size, (size_t)WS_END); grid = -1; return; }
        int dev = 0, cus = 0;
        if (hipGetDevice(&dev) != hipSuccess || hipDeviceGetAttribute(&cus, hipDeviceAttributeMultiprocessorCount, dev) != hipSuccess) { grid = -1; return; }
        grid = cus;
    }
    if (grid < 0) return;
    (void)hipMemsetAsync((char*)d_ws + WS_CTL, 0, CTL_ZERO_BYTES, stream);
    Args a{};
    for (int i = 0; i < 35; ++i) a.in[i] = (const float*)d_in[i];
    a.in[I_OUT] = (const float*)d_out; a.in[I_WS] = (const float*)d_ws; a.pad = 0;
#if MK_FUSED
    a.l_lo = 0; a.l_hi = DEPTH; a.ph_lo = 0; a.ph_hi = NPH; a.do_pro = 1; a.do_fin = 1; a.fused = 1;
#ifndef TEST_PM
#define TEST_PM 0xFFFF
#endif
#ifndef TEST_MS
#define TEST_MS 15
#endif
    launch_one<TEST_PM, TEST_MS>(a, grid, stream);
#else
    a.fused = 0;
    a.l_lo = 0; a.l_hi = 0; a.ph_lo = 0; a.ph_hi = 0; a.do_pro = 1; a.do_fin = 0;
    launch_one<0x1000, 15>(a, grid, stream);
    a.do_pro = 0;
    for (int l = 0; l < DEPTH; ++l) {
        a.l_lo = l; a.l_hi = l + 1; a.ph_lo = 0; a.ph_hi = NPH;
        launch_one<0x1, 15>(a, grid, stream); launch_one<0x2, 15>(a, grid, stream); launch_one<0x4, 15>(a, grid, stream); launch_one<0x8, 15>(a, grid, stream);
        launch_one<0x10, 1>(a, grid, stream); launch_one<0x10, 2>(a, grid, stream); launch_one<0x10, 4>(a, grid, stream); launch_one<0x10, 8>(a, grid, stream);
        launch_one<0x20, 15>(a, grid, stream); launch_one<0x40, 15>(a, grid, stream); launch_one<0x80, 15>(a, grid, stream);
        launch_one<0x100, 15>(a, grid, stream); launch_one<0x200, 15>(a, grid, stream);
        if (l & 1) launch_one<0x400, 15>(a, grid, stream);
    }
    a.l_lo = 0; a.l_hi = 0; a.ph_lo = 0; a.ph_hi = 0; a.do_fin = 1;
    launch_one<0x2000, 15>(a, grid, stream);
#endif
}
```

```cpp
#include <hip/hip_runtime.h>
#include <cstdio>
#include <cstdint>
#define LAS __attribute__((address_space(3)))
namespace pg8 {
#define PG8_LAS __attribute__((address_space(3)))
typedef unsigned short bf16_t;
typedef short bf16x8 __attribute__((ext_vector_type(8)));
typedef float f32x4 __attribute__((ext_vector_type(4)));
typedef unsigned u32x4 __attribute__((ext_vector_type(4)));
constexpr int BM = 256, BK = 64, HALF = 128, HTB = HALF * BK * 2  , STAGE_BYTES = 8 * HTB, NXCD = 8, WGM = 8;

__host__ __device__ __forceinline__ int lds_byte(int r, int c) { const int st = (r >> 4) * 2 + (c >> 5), rr = r & 15, cc = c & 31, ob = rr * 64 + cc * 2; return st * 1024 + (ob ^ (((ob >> 9) & 1) << 5)); }
__host__ __device__ __forceinline__ void stage_rc(int b, int& R, int& C) { const int st = b / 1024, sb = b % 1024, swz = sb ^ (((sb >> 9) & 1) << 5); R = (st >> 1) * 16 + swz / 64; C = (st & 1) * 32 + (swz % 64) / 2; }
__host__ __device__ __forceinline__ int perm32(int rho) { const int n = rho >> 4, i = rho & 15; return 8 * (i >> 2) + 4 * n + (i & 3); }

struct Unit { int pm, pn, pc; };
struct Gemm { const bf16_t* A; const bf16_t* Bt; int M, N, K; };

struct StaticOrder {
    int nM, nN, nwg, G, c;
    __host__ __device__ void init(int M, int N, int G_, int c_) { nM = M / BM; nN = N / BM; nwg = nM * nN; G = G_; c = c_; }
    __host__ __device__ bool next(int i, Unit& u) const {
        const long L = (long)i * G + c; if (L >= nwg) return false;
        int wgid = (int)L; { const int q = nwg / NXCD, r = nwg % NXCD, xcd = wgid % NXCD, off = wgid / NXCD; wgid = (xcd < r ? xcd * (q + 1) : r * (q + 1) + (xcd - r) * q) + off; }
        const int nig = WGM * nN, gid = wgid / nig, fm = gid * WGM, gsz = (nM - fm) < WGM ? (nM - fm) : WGM;
        u.pm = fm + ((wgid % nig) % gsz); u.pn = (wgid % nig) / gsz; u.pc = u.pn; return true;
    }
    __device__ __forceinline__ void a_ready(const Unit&) const {}
    __device__ __forceinline__ void done(const Unit&) const {}
};

__device__ __forceinline__ unsigned cvt_pk_bf16(float lo, float hi) { unsigned r; asm volatile("v_cvt_pk_bf16_f32 %0, %1, %2" : "=v"(r) : "v"(lo), "v"(hi)); return r; }
typedef float f32x2 __attribute__((ext_vector_type(2)));

template <class Epi, class Sched, bool ALIGN_EPI = false, bool SP2 = false>
__device__ __forceinline__ void gemm_phase(PG8_LAS unsigned char* lds, const Gemm g, const Sched& S, const Epi& E, const int tid) {
    const int wid = __builtin_amdgcn_readfirstlane(tid >> 6), lane = tid & 63, wr = wid >> 2, wc = wid & 3, fr = lane & 15, fq = lane >> 4;
    const int K = g.K, nt = K / BK;
    unsigned voffA[2], voffB[2];
#pragma unroll
    for (int i = 0; i < 2; ++i) { int R, C; stage_rc(tid * 16 + i * 8192, R, C); const int Rb = Epi::PERM ? ((R & ~31) + perm32(R & 31)) : R;
        voffA[i] = (unsigned)(R * K + C) * 2u; voffB[i] = (unsigned)(Rb * K + C) * 2u; }
    const size_t kstep = (size_t)(BK * 2);
    const size_t hstep = (size_t)HALF * K * 2;
    const size_t tstep = 2 * hstep;
    const unsigned ldsw = (unsigned)wid * 1024u;
    const int aoff = lds_byte(wr * 64 + fr, fq * 8), boff = lds_byte(wc * 32 + fr, fq * 8);
#define PG8_SA(b, h) (((b) * 2 + (h)) * HTB)
#define PG8_SB(b, h) ((4 + (b) * 2 + (h)) * HTB)
#define PG8_STAGE(bufoff, gbase, voff) do { _Pragma("unroll") for (int _i = 0; _i < 2; ++_i) \
        __builtin_amdgcn_global_load_lds((const unsigned*)((const char*)(gbase) + (voff)[_i]), (PG8_LAS unsigned*)(lds + (bufoff) + ldsw + _i * 8192), 16, 0, 0); } while (0)
#define PG8_LDA(dst, b, h) do { _Pragma("unroll") for (int m = 0; m < 4; ++m) _Pragma("unroll") for (int k = 0; k < 2; ++k) dst[m][k] = *(const PG8_LAS bf16x8*)(lds + PG8_SA(b, h) + aoff + m * 2048 + k * 1024); } while (0)
#define PG8_LDB(dst, b, h) do { _Pragma("unroll") for (int n = 0; n < 2; ++n) _Pragma("unroll") for (int k = 0; k < 2; ++k) dst[n][k] = *(const PG8_LAS bf16x8*)(lds + PG8_SB(b, h) + boff + n * 2048 + k * 1024); } while (0)
#define PG8_MMA(ai, bj, At, Bt) do { __builtin_amdgcn_s_setprio(1); _Pragma("unroll") for (int m = 0; m < 4; ++m) _Pragma("unroll") for (int n = 0; n < 2; ++n) _Pragma("unroll") for (int k = 0; k < 2; ++k) \
        acc[ai][bj][m][n] = __builtin_amdgcn_mfma_f32_16x16x32_bf16(Bt[n][k], At[m][k], acc[ai][bj][m][n], 0, 0, 0); __builtin_amdgcn_s_setprio(0); } while (0)
#define PG8_WAIT_V(n) asm volatile("s_waitcnt vmcnt(" #n ")" ::: "memory")
#define PG8_WAIT_L(n) asm volatile("s_waitcnt lgkmcnt(" #n ")" ::: "memory")
#define PG8_BAR __builtin_amdgcn_s_barrier()
#define PG8_SCHED __builtin_amdgcn_sched_barrier(0)
    Unit cur, nxt; int ui = 0;
    if (!S.next(0, cur)) return;
    f32x4 acc[2][2][4][2];
#pragma unroll
    for (int a = 0; a < 2; ++a)
#pragma unroll
        for (int b = 0; b < 2; ++b)
#pragma unroll
            for (int m = 0; m < 4; ++m)
#pragma unroll
                for (int n = 0; n < 2; ++n) acc[a][b][m][n] = (f32x4){0.f, 0.f, 0.f, 0.f};
    bf16x8 At[4][2], B0[2][2], B1[2][2];
    const char* cA = (const char*)g.A + (size_t)cur.pm * tstep; const char* cB = (const char*)g.Bt + (size_t)cur.pn * tstep;
    S.a_ready(cur);
    if constexpr (SP2) {
        PG8_STAGE(PG8_SB(0, 0), cB, voffB); PG8_STAGE(PG8_SB(0, 1), cB + hstep, voffB); PG8_STAGE(PG8_SA(0, 0), cA, voffA); PG8_STAGE(PG8_SA(0, 1), cA + hstep, voffA);
        if (wr == 1) PG8_BAR;
        PG8_WAIT_V(2); PG8_BAR;
        PG8_STAGE(PG8_SB(1, 0), cB + kstep, voffB); PG8_STAGE(PG8_SA(1, 0), cA + kstep, voffA); PG8_STAGE(PG8_SB(1, 1), cB + hstep + kstep, voffB);
        PG8_WAIT_V(6); PG8_BAR;
    } else {
        PG8_STAGE(PG8_SB(0, 0), cB, voffB); PG8_STAGE(PG8_SA(0, 0), cA, voffA); PG8_STAGE(PG8_SB(0, 1), cB + hstep, voffB); PG8_STAGE(PG8_SA(0, 1), cA + hstep, voffA);
        if (wr == 1) PG8_BAR;
        PG8_WAIT_V(4); PG8_BAR;
        PG8_STAGE(PG8_SB(1, 0), cB + kstep, voffB); PG8_STAGE(PG8_SA(1, 0), cA + kstep, voffA); PG8_STAGE(PG8_SB(1, 1), cB + hstep + kstep, voffB);
        PG8_WAIT_V(6); PG8_BAR;
    }
    for (;;) {
        const bool has_next = S.next(ui + 1, nxt);
        const char* nA = has_next ? (const char*)g.A + (size_t)nxt.pm * tstep : cA; const char* nB = has_next ? (const char*)g.Bt + (size_t)nxt.pn * tstep : cB;
        for (int t = 0; t < nt; t += 2) {
            const bool last = (t == nt - 2);
            const char* a1 = cA + (size_t)(t + 1) * kstep;
            const char* a2 = last ? nA : cA + (size_t)(t + 2) * kstep; const char* b2 = last ? nB : cB + (size_t)(t + 2) * kstep;
            const char* a3 = a2 + kstep; const char* b3 = b2 + kstep;
            if (last && has_next) S.a_ready(nxt);
            if constexpr (SP2) {
            PG8_LDB(B0, 0, 0); PG8_LDB(B1, 0, 1); PG8_SCHED; PG8_LDA(At, 0, 0); PG8_STAGE(PG8_SA(1, 1), a1 + hstep, voffA);
            PG8_WAIT_V(8); PG8_WAIT_L(0); PG8_BAR; PG8_MMA(0, 0, At, B0); PG8_MMA(0, 1, At, B1); PG8_BAR; PG8_SCHED;
            PG8_LDA(At, 0, 1); PG8_STAGE(PG8_SB(0, 0), b2, voffB); PG8_STAGE(PG8_SB(0, 1), b2 + hstep, voffB); PG8_STAGE(PG8_SA(0, 0), a2, voffA);
            PG8_WAIT_V(8); PG8_WAIT_L(0); PG8_BAR; PG8_MMA(1, 0, At, B0); PG8_MMA(1, 1, At, B1); PG8_BAR; PG8_SCHED;
            PG8_LDB(B0, 1, 0); PG8_LDB(B1, 1, 1); PG8_SCHED; PG8_LDA(At, 1, 0); PG8_STAGE(PG8_SA(0, 1), a2 + hstep, voffA);
            PG8_WAIT_V(8); PG8_WAIT_L(0); PG8_BAR; PG8_MMA(0, 0, At, B0); PG8_MMA(0, 1, At, B1); PG8_BAR; PG8_SCHED;
            PG8_LDA(At, 1, 1); PG8_STAGE(PG8_SB(1, 0), b3, voffB); PG8_STAGE(PG8_SB(1, 1), b3 + hstep, voffB); PG8_STAGE(PG8_SA(1, 0), a3, voffA);
            PG8_WAIT_V(8); PG8_WAIT_L(0); PG8_BAR; PG8_MMA(1, 0, At, B0); PG8_MMA(1, 1, At, B1); PG8_BAR; PG8_SCHED;
            } else {
            PG8_LDB(B0, 0, 0); PG8_SCHED; PG8_LDA(At, 0, 0); PG8_STAGE(PG8_SA(1, 1), a1 + hstep, voffA);
            PG8_WAIT_L(8); PG8_BAR; PG8_WAIT_L(0); PG8_MMA(0, 0, At, B0); PG8_BAR; PG8_SCHED;
            PG8_LDB(B1, 0, 1); PG8_STAGE(PG8_SB(0, 0), b2, voffB);
            PG8_BAR; PG8_WAIT_L(0); PG8_MMA(0, 1, At, B1); PG8_BAR;
            PG8_LDA(At, 0, 1); PG8_STAGE(PG8_SA(0, 0), a2, voffA);
            PG8_BAR; PG8_WAIT_L(0); PG8_MMA(1, 0, At, B0); PG8_BAR; PG8_SCHED;
            PG8_STAGE(PG8_SB(0, 1), b2 + hstep, voffB);
            PG8_WAIT_V(6); PG8_BAR; PG8_MMA(1, 1, At, B1); PG8_BAR;
            PG8_LDB(B0, 1, 0); PG8_SCHED; PG8_LDA(At, 1, 0); PG8_STAGE(PG8_SA(0, 1), a2 + hstep, voffA);
            PG8_WAIT_L(8); PG8_BAR; PG8_WAIT_L(0); PG8_MMA(0, 0, At, B0); PG8_BAR; PG8_SCHED;
            PG8_LDB(B1, 1, 1); PG8_STAGE(PG8_SB(1, 0), b3, voffB);
            PG8_BAR; PG8_WAIT_L(0); PG8_MMA(0, 1, At, B1); PG8_BAR;
            PG8_LDA(At, 1, 1); PG8_STAGE(PG8_SA(1, 0), a3, voffA);
            PG8_BAR; PG8_WAIT_L(0); PG8_MMA(1, 0, At, B0); PG8_BAR; PG8_SCHED;
            PG8_STAGE(PG8_SB(1, 1), b3 + hstep, voffB);
            PG8_WAIT_V(6); PG8_BAR; PG8_MMA(1, 1, At, B1); PG8_BAR;
            }
        }
        if constexpr (ALIGN_EPI) { if (wr == 0) PG8_BAR; }
        if constexpr (!Epi::AFTER_DRAIN) { E(acc, cur, wr, wc, fr, fq); S.done(cur); }
        if (!has_next) break;
#pragma unroll
        for (int a = 0; a < 2; ++a)
#pragma unroll
            for (int b = 0; b < 2; ++b)
#pragma unroll
                for (int m = 0; m < 4; ++m)
#pragma unroll
                    for (int n = 0; n < 2; ++n) acc[a][b][m][n] = (f32x4){0.f, 0.f, 0.f, 0.f};
        cur = nxt; cA = nA; cB = nB; ++ui;
        if constexpr (ALIGN_EPI) { if (wr == 1) PG8_BAR; }
    }
    PG8_WAIT_V(0);
    if constexpr (!ALIGN_EPI) { if (wr == 0) PG8_BAR; }
    PG8_BAR;
    if constexpr (Epi::AFTER_DRAIN) { E.fused(acc, cur, wr, wc, fr, fq, lds, wid, lane); S.done(cur); }
#undef PG8_SA
#undef PG8_SB
#undef PG8_STAGE
#undef PG8_LDA
#undef PG8_LDB
#undef PG8_MMA
#undef PG8_WAIT_V
#undef PG8_WAIT_L
#undef PG8_BAR
#undef PG8_SCHED
}
typedef int v8i_t __attribute__((ext_vector_type(8)));
typedef int v4i_t __attribute__((ext_vector_type(4)));
template <class Epi, class Sched, bool ALIGN_EPI = false, bool SP2 = false>
__device__ __forceinline__ void gemm_phase_f8(PG8_LAS unsigned char* lds, const Gemm g, const Sched& S, const Epi& E, const int tid) {
    const int wid = __builtin_amdgcn_readfirstlane(tid >> 6), lane = tid & 63, wr = wid >> 2, wc = wid & 3, fr = lane & 15, fq = lane >> 4;
    const int K = g.K, nt = K / BK;
    unsigned voffA[2], voffB[2];
#pragma unroll
    for (int i = 0; i < 2; ++i) { int R, C; stage_rc(tid * 16 + i * 8192, R, C); const int Rb = Epi::PERM ? ((R & ~31) + perm32(R & 31)) : R;
        voffA[i] = (unsigned)(R * K + C) * 2u; voffB[i] = (unsigned)(Rb * K + C) * 2u; }
    const size_t kstep = (size_t)(BK * 2);
    const size_t hstep = (size_t)HALF * K * 2;
    const size_t tstep = 2 * hstep;
    const unsigned ldsw = (unsigned)wid * 1024u;
    const int aoff0 = lds_byte(wr * 64 + fr, fq * 16), aoff1 = lds_byte(wr * 64 + fr, fq * 16 + 8), boff0 = lds_byte(wc * 32 + fr, fq * 16), boff1 = lds_byte(wc * 32 + fr, fq * 16 + 8);
#define PG8_SA(b, h) (((b) * 2 + (h)) * HTB)
#define PG8_SB(b, h) ((4 + (b) * 2 + (h)) * HTB)
#define PG8_STAGE(bufoff, gbase, voff) do { _Pragma("unroll") for (int _i = 0; _i < 2; ++_i) \
        __builtin_amdgcn_global_load_lds((const unsigned*)((const char*)(gbase) + (voff)[_i]), (PG8_LAS unsigned*)(lds + (bufoff) + ldsw + _i * 8192), 16, 0, 0); } while (0)
#define PG8_LDA(dst, b, h) do { _Pragma("unroll") for (int m = 0; m < 4; ++m) { const u32x4 lo_ = *(const PG8_LAS u32x4*)(lds + PG8_SA(b, h) + aoff0 + m * 2048), hi_ = *(const PG8_LAS u32x4*)(lds + PG8_SA(b, h) + aoff1 + m * 2048); \
        dst[m] = __builtin_shufflevector((v4i_t)lo_, (v4i_t)hi_, 0, 1, 2, 3, 4, 5, 6, 7); } } while (0)
#define PG8_LDB(dst, b, h) do { _Pragma("unroll") for (int n = 0; n < 2; ++n) { const u32x4 lo_ = *(const PG8_LAS u32x4*)(lds + PG8_SB(b, h) + boff0 + n * 2048), hi_ = *(const PG8_LAS u32x4*)(lds + PG8_SB(b, h) + boff1 + n * 2048); \
        dst[n] = __builtin_shufflevector((v4i_t)lo_, (v4i_t)hi_, 0, 1, 2, 3, 4, 5, 6, 7); } } while (0)
#define PG8_MMA(ai, bj, At, Bt) do { __builtin_amdgcn_s_setprio(1); _Pragma("unroll") for (int m = 0; m < 4; ++m) _Pragma("unroll") for (int n = 0; n < 2; ++n) \
        asm volatile("v_mfma_scale_f32_16x16x128_f8f6f4 %0, %1, %2, %0, %3, %3 op_sel_hi:[0,0,0]" : "+v"(acc[ai][bj][m][n]) : "v"(Bt[n]), "v"(At[m]), "v"(one_scale)); __builtin_amdgcn_s_setprio(0); } while (0)
#define PG8_WAIT_V(n) asm volatile("s_waitcnt vmcnt(" #n ")" ::: "memory")
#define PG8_WAIT_L(n) asm volatile("s_waitcnt lgkmcnt(" #n ")" ::: "memory")
#define PG8_BAR __builtin_amdgcn_s_barrier()
#define PG8_SCHED __builtin_amdgcn_sched_barrier(0)
    Unit cur, nxt; int ui = 0;
    if (!S.next(0, cur)) return;
    f32x4 acc[2][2][4][2];
#pragma unroll
    for (int a = 0; a < 2; ++a)
#pragma unroll
        for (int b = 0; b < 2; ++b)
#pragma unroll
            for (int m = 0; m < 4; ++m)
#pragma unroll
                for (int n = 0; n < 2; ++n) acc[a][b][m][n] = (f32x4){0.f, 0.f, 0.f, 0.f};
    v8i_t At[4], B0[2], B1[2]; const int one_scale = 0x7f7f7f7f;
    const char* cA = (const char*)g.A + (size_t)cur.pm * tstep; const char* cB = (const char*)g.Bt + (size_t)cur.pn * tstep;
    S.a_ready(cur);
    if constexpr (SP2) {
        PG8_STAGE(PG8_SB(0, 0), cB, voffB); PG8_STAGE(PG8_SB(0, 1), cB + hstep, voffB); PG8_STAGE(PG8_SA(0, 0), cA, voffA); PG8_STAGE(PG8_SA(0, 1), cA + hstep, voffA);
        if (wr == 1) PG8_BAR;
        PG8_WAIT_V(2); PG8_BAR;
        PG8_STAGE(PG8_SB(1, 0), cB + kstep, voffB); PG8_STAGE(PG8_SA(1, 0), cA + kstep, voffA); PG8_STAGE(PG8_SB(1, 1), cB + hstep + kstep, voffB);
        PG8_WAIT_V(6); PG8_BAR;
    } else {
        PG8_STAGE(PG8_SB(0, 0), cB, voffB); PG8_STAGE(PG8_SA(0, 0), cA, voffA); PG8_STAGE(PG8_SB(0, 1), cB + hstep, voffB); PG8_STAGE(PG8_SA(0, 1), cA + hstep, voffA);
        if (wr == 1) PG8_BAR;
        PG8_WAIT_V(4); PG8_BAR;
        PG8_STAGE(PG8_SB(1, 0), cB + kstep, voffB); PG8_STAGE(PG8_SA(1, 0), cA + kstep, voffA); PG8_STAGE(PG8_SB(1, 1), cB + hstep + kstep, voffB);
        PG8_WAIT_V(6); PG8_BAR;
    }
    for (;;) {
        const bool has_next = S.next(ui + 1, nxt);
        const char* nA = has_next ? (const char*)g.A + (size_t)nxt.pm * tstep : cA; const char* nB = has_next ? (const char*)g.Bt + (size_t)nxt.pn * tstep : cB;
        for (int t = 0; t < nt; t += 2) {
            const bool last = (t == nt - 2);
            const char* a1 = cA + (size_t)(t + 1) * kstep;
            const char* a2 = last ? nA : cA + (size_t)(t + 2) * kstep; const char* b2 = last ? nB : cB + (size_t)(t + 2) * kstep;
            const char* a3 = a2 + kstep; const char* b3 = b2 + kstep;
            if (last && has_next) S.a_ready(nxt);
            if constexpr (SP2) {
            PG8_LDB(B0, 0, 0); PG8_LDB(B1, 0, 1); PG8_SCHED; PG8_LDA(At, 0, 0); PG8_STAGE(PG8_SA(1, 1), a1 + hstep, voffA);
            PG8_WAIT_V(8); PG8_WAIT_L(0); PG8_BAR; PG8_MMA(0, 0, At, B0); PG8_MMA(0, 1, At, B1); PG8_BAR; PG8_SCHED;
            PG8_LDA(At, 0, 1); PG8_STAGE(PG8_SB(0, 0), b2, voffB); PG8_STAGE(PG8_SB(0, 1), b2 + hstep, voffB); PG8_STAGE(PG8_SA(0, 0), a2, voffA);
            PG8_WAIT_V(8); PG8_WAIT_L(0); PG8_BAR; PG8_MMA(1, 0, At, B0); PG8_MMA(1, 1, At, B1); PG8_BAR; PG8_SCHED;
            PG8_LDB(B0, 1, 0); PG8_LDB(B1, 1, 1); PG8_SCHED; PG8_LDA(At, 1, 0); PG8_STAGE(PG8_SA(0, 1), a2 + hstep, voffA);
            PG8_WAIT_V(8); PG8_WAIT_L(0); PG8_BAR; PG8_MMA(0, 0, At, B0); PG8_MMA(0, 1, At, B1); PG8_BAR; PG8_SCHED;
            PG8_LDA(At, 1, 1); PG8_STAGE(PG8_SB(1, 0), b3, voffB); PG8_STAGE(PG8_SB(1, 1), b3 + hstep, voffB); PG8_STAGE(PG8_SA(1, 0), a3, voffA);
            PG8_WAIT_V(8); PG8_WAIT_L(0); PG8_BAR; PG8_MMA(1, 0, At, B0); PG8_MMA(1, 1, At, B1); PG8_BAR; PG8_SCHED;
            } else {
            PG8_LDB(B0, 0, 0); PG8_SCHED; PG8_LDA(At, 0, 0); PG8_STAGE(PG8_SA(1, 1), a1 + hstep, voffA);
            PG8_WAIT_L(8); PG8_BAR; PG8_WAIT_L(0); PG8_MMA(0, 0, At, B0); PG8_BAR; PG8_SCHED;
            PG8_LDB(B1, 0, 1); PG8_STAGE(PG8_SB(0, 0), b2, voffB);
            PG8_BAR; PG8_WAIT_L(0); PG8_MMA(0, 1, At, B1); PG8_BAR;
            PG8_LDA(At, 0, 1); PG8_STAGE(PG8_SA(0, 0), a2, voffA);
            PG8_BAR; PG8_WAIT_L(0); PG8_MMA(1, 0, At, B0); PG8_BAR; PG8_SCHED;
            PG8_STAGE(PG8_SB(0, 1), b2 + hstep, voffB);
            PG8_WAIT_V(6); PG8_BAR; PG8_MMA(1, 1, At, B1); PG8_BAR;
            PG8_LDB(B0, 1, 0); PG8_SCHED; PG8_LDA(At, 1, 0); PG8_STAGE(PG8_SA(0, 1), a2 + hstep, voffA);
            PG8_WAIT_L(8); PG8_BAR; PG8_WAIT_L(0); PG8_MMA(0, 0, At, B0); PG8_BAR; PG8_SCHED;
            PG8_LDB(B1, 1, 1); PG8_STAGE(PG8_SB(1, 0), b3, voffB);
            PG8_BAR; PG8_WAIT_L(0); PG8_MMA(0, 1, At, B1); PG8_BAR;
            PG8_LDA(At, 1, 1); PG8_STAGE(PG8_SA(1, 0), a3, voffA);
            PG8_BAR; PG8_WAIT_L(0); PG8_MMA(1, 0, At, B0); PG8_BAR; PG8_SCHED;
            PG8_STAGE(PG8_SB(1, 1), b3 + hstep, voffB);
            PG8_WAIT_V(6); PG8_BAR; PG8_MMA(1, 1, At, B1); PG8_BAR;
            }
        }
        if constexpr (ALIGN_EPI) { if (wr == 0) PG8_BAR; }
        asm volatile("s_nop 15\n\ts_nop 15" ::: "memory");
        if constexpr (!Epi::AFTER_DRAIN) { E(acc, cur, wr, wc, fr, fq); S.done(cur); }
        if (!has_next) break;
#pragma unroll
        for (int a = 0; a < 2; ++a)
#pragma unroll
            for (int b = 0; b < 2; ++b)
#pragma unroll
                for (int m = 0; m < 4; ++m)
#pragma unroll
                    for (int n = 0; n < 2; ++n) acc[a][b][m][n] = (f32x4){0.f, 0.f, 0.f, 0.f};
        cur = nxt; cA = nA; cB = nB; ++ui;
        if constexpr (ALIGN_EPI) { if (wr == 1) PG8_BAR; }
    }
    PG8_WAIT_V(0);
    if constexpr (!ALIGN_EPI) { if (wr == 0) PG8_BAR; }
    PG8_BAR;
    if constexpr (Epi::AFTER_DRAIN) { E.fused(acc, cur, wr, wc, fr, fq, lds, wid, lane); S.done(cur); }
#undef PG8_SA
#undef PG8_SB
#undef PG8_STAGE
#undef PG8_LDA
#undef PG8_LDB
#undef PG8_MMA
#undef PG8_WAIT_V
#undef PG8_WAIT_L
#undef PG8_BAR
#undef PG8_SCHED
}
}

#define XB_TMO      128
#define XB_XCNT(j)  (256  + 64 * (j))
#define XB_XSUB(j)  (1280 + 64 * (j))
#define XB_XGEN(j)  (2304 + 64 * (j))
#define XB_TOP      3328
#define XB_TOPGEN   3392
#define XCD_BAR_WORDS 3456
#define XB_SPIN_CAP (1u << 18)

__device__ __forceinline__ unsigned xb_ld(unsigned* p)              { return __hip_atomic_load(p, __ATOMIC_RELAXED, __HIP_MEMORY_SCOPE_AGENT); }
__device__ __forceinline__ unsigned xb_add(unsigned* p, unsigned v) { return __hip_atomic_fetch_add(p, v, __ATOMIC_RELAXED, __HIP_MEMORY_SCOPE_AGENT); }
__device__ __forceinline__ unsigned xb_xcc_id() { return (unsigned)__builtin_amdgcn_s_getreg((3 << 11) | 20) & 0xFu; }
#define XB_SPIN(cond, bar) do { unsigned _sp = 0; while (cond) { __builtin_amdgcn_s_sleep(1); \
    if ((++_sp & 255u) == 0u) { if (xb_ld(&(bar)[XB_TMO])) break; if (_sp > XB_SPIN_CAP) { atomicAdd(&(bar)[XB_TMO], 1u); break; } } } } while (0)

struct XcdBarrier {
    unsigned* bar; unsigned x;
    volatile LAS unsigned* st;
};

__device__ __forceinline__ XcdBarrier xcd_barrier_post(unsigned* bar, volatile LAS unsigned* st, const int xb_tid) {
    XcdBarrier b; b.bar = bar; b.x = xb_xcc_id(); b.st = st;
    if (xb_tid == 0) (void)xb_add(&bar[XB_XCNT(b.x)], 1u);
    return b;
}
__device__ __forceinline__ void xcd_barrier_complete(unsigned* bar, unsigned x, unsigned& nloc, unsigned& nx) {
    const unsigned G = gridDim.x * gridDim.y * gridDim.z;
    unsigned sum, cnt, mine, sp = 0u;
    for (;;) {
        sum = 0u; cnt = 0u; mine = 0u;
#pragma unroll
        for (unsigned j = 0; j < 16; ++j) { const unsigned c = xb_ld(&bar[XB_XCNT(j)]); sum += c; cnt += (c > 0u) ? 1u : 0u; mine = (j == x) ? c : mine; }
        if (sum == G) break;
        __builtin_amdgcn_s_sleep(1);
        if ((++sp & 255u) == 0u) { if (xb_ld(&bar[XB_TMO])) break; if (sp > XB_SPIN_CAP) { atomicAdd(&bar[XB_TMO], 1u); break; } }
    }
    nloc = mine > 0u ? mine : 1u; nx = cnt > 0u ? cnt : 1u;
}

__device__ __forceinline__ void xcd_barrier(const XcdBarrier& b, const int xb_tid) {
    asm volatile("s_waitcnt vmcnt(0)" ::: "memory");
    __syncthreads();
    if (xb_tid == 0) {
        unsigned* bar = b.bar;
        __builtin_amdgcn_s_waitcnt(0);
        unsigned nloc = b.st[0], nx = b.st[1];
        if (nloc == 0u) { xcd_barrier_complete(bar, b.x, nloc, nx); b.st[0] = nloc; b.st[1] = nx; }
        const unsigned old = xb_add(&bar[XB_XSUB(b.x)], 1u);
        const unsigned gen = old / nloc;
        if (old + 1u == (gen + 1u) * nloc) {
            __builtin_amdgcn_fence(__ATOMIC_RELEASE, "agent");
            asm volatile("s_waitcnt vmcnt(0)" ::: "memory");
            const unsigned og = xb_add(&bar[XB_TOP], 1u);
            const unsigned tg = og / nx;
            if (og + 1u == (tg + 1u) * nx) xb_add(&bar[XB_TOPGEN], 1u);
            else XB_SPIN(xb_ld(&bar[XB_TOPGEN]) == tg, bar);
            __builtin_amdgcn_fence(__ATOMIC_ACQUIRE, "agent");
            xb_add(&bar[XB_XGEN(b.x)], 1u);
            asm volatile("s_waitcnt vmcnt(0)" ::: "memory");
        } else {
            XB_SPIN(xb_ld(&bar[XB_XGEN(b.x)]) == gen, bar);
            __builtin_amdgcn_fence(__ATOMIC_ACQUIRE, "agent");
            asm volatile("s_waitcnt vmcnt(0)" ::: "memory");
        }
    }
    __syncthreads();
}

#define GAS __attribute__((address_space(1)))
typedef unsigned short bf16;
typedef unsigned v4u __attribute__((ext_vector_type(4)));
typedef unsigned v2u __attribute__((ext_vector_type(2)));
typedef float f32x4 __attribute__((ext_vector_type(4)));

constexpr int NB = 4, SEQ = 8192, DM = 1024, DEPTH = 4, CTXL = 256;
constexpr int NLAT = NB * SEQ, NCTX = NB * CTXL, MT = NLAT + NCTX;
constexpr int DIN = 3360, DINP = 3584, DFF = 2816, NEXP = 8;
constexpr int C_RQ = 0, C_RK = 256, C_RV = 512, C_RG = 768, C_S5 = 1024, C_HQ = 1280, C_HFF = 1536, C_HFB = 1792, C_HI = 2048, C_HG = 2304,
              C_GQ = 2560, C_GK = 2688, C_GV = 2816, C_GG = 3072, C_GAF = 3328, C_GAB = 3344,
              C_GZF = 3328, C_GZB = 3456;
constexpr int NSEG = 132;
constexpr int MOE_CAP_TILES = 272;
constexpr float NEPS = 1e-6f;
constexpr float WSC8 = 64.0f;

constexpr size_t MiB = 1u << 20;
constexpr size_t WS_CTL = 0, CTL_ZERO_BYTES = 2 * MiB;
constexpr size_t WS_MOD = 2 * MiB;
constexpr size_t WS_LB = 3 * MiB;
constexpr size_t WS_ROPE = 3 * MiB + 65536;
constexpr size_t WS_GLUW = 3 * MiB + 131072;
constexpr size_t WS_WIN = 4 * MiB;
constexpr size_t WS_WOUT = 32 * MiB;
constexpr size_t WS_W13D = 40 * MiB;
constexpr size_t WS_W2D = 62 * MiB;
constexpr size_t WS_W13M = 73 * MiB;
constexpr size_t WS_W2M = 161 * MiB;
constexpr size_t WS_HB = 205 * MiB;
constexpr size_t WS_ACT = 209 * MiB;
constexpr size_t WS_Z = 275 * MiB;
constexpr size_t WS_PH = 292 * MiB;
constexpr size_t WS_OF = (292 + 232) * MiB;
constexpr size_t WS_X2 = 666 * MiB;
constexpr size_t WS_LIST = 843 * MiB;
constexpr size_t WS_END = 846 * MiB;
constexpr size_t ST_DS0 = 0;
constexpr size_t ST_DS1 = ST_DS0 + (size_t)2 * 16 * NSEG * 4096;
constexpr size_t ST_DS2 = ST_DS1 + (size_t)2 * 16 * NSEG * 4096;
constexpr size_t ST_G0 = ST_DS2 + (size_t)2 * 16 * NSEG * 2048;
constexpr size_t ST_G1 = ST_G0 + (size_t)2 * 16 * NSEG * 64;
constexpr size_t ST_G2 = ST_G1 + (size_t)2 * 16 * NSEG * 64;
constexpr size_t ST_HS = ST_G2 + (size_t)2 * 16 * NSEG * 64;
constexpr size_t ST_END = ST_HS + (size_t)2 * 64 * NSEG * 128;
static_assert(ST_END * 4 <= (WS_LIST - WS_X2), "state region");
static_assert(WS_PH + (size_t)MT * DINP * 2 <= WS_OF && WS_OF + (size_t)MT * 768 * 4 <= WS_X2, "OF region");
static_assert((size_t)MOE_CAP_TILES * 256 * 1024 * 2 <= (WS_LIST - WS_X2), "XB region");
static_assert((size_t)MOE_CAP_TILES * 256 * DFF * 2 <= (WS_X2 - WS_PH) && (size_t)MT * DINP * 2 <= (WS_X2 - WS_PH), "P/H region");
constexpr int CW_BAR = 4096;
constexpr int CW_CNT = 16384;

constexpr int LDS_BYTES = 163840;
constexpr int MISC_OFF = 163840 - 512;

__device__ __forceinline__ float bf2f(unsigned short h) { return __uint_as_float(((unsigned)h) << 16); }
__device__ __forceinline__ unsigned f2bf(float f) { unsigned u = __float_as_uint(f); return (u + 0x7fffu + ((u >> 16) & 1u)) >> 16; }
__device__ __forceinline__ unsigned pk2(float lo, float hi) { return f2bf(lo) | (f2bf(hi) << 16); }
__device__ __forceinline__ float wave_sum(float v) {
#define WS_DPP(ctrl, rmask) v += __int_as_float(__builtin_amdgcn_update_dpp(0, __float_as_int(v), (ctrl), (rmask), 0xf, false))
    WS_DPP(0x111, 0xf); WS_DPP(0x112, 0xf); WS_DPP(0x114, 0xf); WS_DPP(0x118, 0xf); WS_DPP(0x142, 0xa); WS_DPP(0x143, 0xc);
#undef WS_DPP
    return __int_as_float(__builtin_amdgcn_readlane(__float_as_int(v), 63));
}
__device__ __forceinline__ float rdl(float v, int k) { return __uint_as_float((unsigned)__builtin_amdgcn_readlane((int)__float_as_uint(v), k)); }
__device__ __forceinline__ float sigm(float x) { return __builtin_amdgcn_rcpf(1.0f + __expf(-x)); }
__device__ __forceinline__ float silu_f(float x) { return x * __builtin_amdgcn_rcpf(1.0f + __expf(-x)); }
#define LDS_WAIT() asm volatile("s_waitcnt lgkmcnt(0)" ::: "memory")

struct Args {
    const float* in[37];
    int l_lo, l_hi, ph_lo, ph_hi, do_pro, do_fin, fused, pad;
};
constexpr int I_OUT = 35, I_WS = 36;
enum { I_X = 0, I_C, I_CTX, I_CCTX, I_ADAW, I_ADAB, I_N1W, I_N2W, I_WIN, I_WOUT, I_RETGN, I_LAMRE, I_LAMIM, I_LOGDT, I_BRE, I_BIM, I_CRE, I_CIM, I_S5D,
       I_GLUW, I_GLUB, I_LBL, I_HGNW, I_WA2, I_BA, I_GLANW, I_FW1, I_FW3, I_FW2, I_RW, I_RB, I_MW1, I_MW3, I_MW2, I_FINW };

struct Frame {
    LAS unsigned char* lds;
    int tid, lane, wave, gw, NGW, G, zz;
    unsigned char* ws; float* out;
};

struct EpiStoreBf16 {
    static constexpr bool PERM = true, AFTER_DRAIN = false;
    bf16* O; int ldc; float sc;
    __device__ __forceinline__ void operator()(const pg8::f32x4 (&acc)[2][2][4][2], const pg8::Unit& u, int wr, int wc, int fr, int fq) const {
        const int row0 = u.pm * 256 + wr * 64 + fr, col0 = u.pc * 256 + wc * 32 + 8 * fq;
#pragma unroll
        for (int ai = 0; ai < 2; ++ai)
#pragma unroll
            for (int m = 0; m < 4; ++m) { bf16* rowp = O + (size_t)(row0 + ai * 128 + m * 16) * ldc + col0;
#pragma unroll
                for (int bj = 0; bj < 2; ++bj) { const pg8::f32x4 v0 = acc[ai][bj][m][0] * sc, v1 = acc[ai][bj][m][1] * sc;
                    pg8::u32x4 w; w.x = pg8::cvt_pk_bf16(v0[0], v0[1]); w.y = pg8::cvt_pk_bf16(v0[2], v0[3]); w.z = pg8::cvt_pk_bf16(v1[0], v1[1]); w.w = pg8::cvt_pk_bf16(v1[2], v1[3]);
                    *(pg8::u32x4*)(rowp + bj * 128) = w; } }
    }
};
struct EpiSwiglu {
    static constexpr bool PERM = true, AFTER_DRAIN = false;
    bf16* H;
    __device__ __forceinline__ void operator()(const pg8::f32x4 (&acc)[2][2][4][2], const pg8::Unit& u, int wr, int wc, int fr, int fq) const {
        const int row0 = u.pm * 256 + wr * 64 + fr, col0 = u.pc * 128 + wc * 32 + 8 * fq;
#pragma unroll
        for (int ai = 0; ai < 2; ++ai)
#pragma unroll
            for (int m = 0; m < 4; ++m) { bf16* rowp = H + (size_t)(row0 + ai * 128 + m * 16) * DFF + col0;
                float h[8];
#pragma unroll
                for (int n = 0; n < 2; ++n)
#pragma unroll
                    for (int j = 0; j < 4; ++j) { const float a = acc[ai][0][m][n][j], b = acc[ai][1][m][n][j];
                        h[n * 4 + j] = a * __builtin_amdgcn_rcpf(1.0f + __builtin_amdgcn_exp2f(-1.4426950408889634f * a)) * b; }
                pg8::u32x4 w; w.x = pg8::cvt_pk_bf16(h[0], h[1]); w.y = pg8::cvt_pk_bf16(h[2], h[3]); w.z = pg8::cvt_pk_bf16(h[4], h[5]); w.w = pg8::cvt_pk_bf16(h[6], h[7]);
                *(pg8::u32x4*)rowp = w; }
    }
};
struct EpiSwiglu8 {
    static constexpr bool PERM = true, AFTER_DRAIN = false;
    unsigned char* H; float sc;
    __device__ __forceinline__ void operator()(const pg8::f32x4 (&acc)[2][2][4][2], const pg8::Unit& u, int wr, int wc, int fr, int fq) const {
        const int row0 = u.pm * 256 + wr * 64 + fr, col0 = u.pc * 128 + wc * 32 + 8 * fq;
#pragma unroll
        for (int ai = 0; ai < 2; ++ai)
#pragma unroll
            for (int m = 0; m < 4; ++m) { unsigned char* rowp = H + (size_t)(row0 + ai * 128 + m * 16) * DFF + col0;
                float h[8];
#pragma unroll
                for (int n = 0; n < 2; ++n)
#pragma unroll
                    for (int j = 0; j < 4; ++j) { const float a = acc[ai][0][m][n][j] * sc, b = acc[ai][1][m][n][j] * sc;
                        const float hv = a * __builtin_amdgcn_rcpf(1.0f + __builtin_amdgcn_exp2f(-1.4426950408889634f * a)) * b;
                        h[n * 4 + j] = fminf(fmaxf(hv, -448.0f), 448.0f); }
                unsigned w0 = 0u, w1 = 0u;
                w0 = __builtin_amdgcn_cvt_pk_fp8_f32(h[0], h[1], w0, false); w0 = __builtin_amdgcn_cvt_pk_fp8_f32(h[2], h[3], w0, true);
                w1 = __builtin_amdgcn_cvt_pk_fp8_f32(h[4], h[5], w1, false); w1 = __builtin_amdgcn_cvt_pk_fp8_f32(h[6], h[7], w1, true);
                v2u w; w.x = w0; w.y = w1; *(v2u*)rowp = w; }
    }
};
struct EpiResid {
    static constexpr bool PERM = false, AFTER_DRAIN = false;
    const float* xin_lat; const float* xin_ctx; float* xout_lat; float* xout_ctx; const float* gate; float sc;
    __device__ __forceinline__ void operator()(const pg8::f32x4 (&acc)[2][2][4][2], const pg8::Unit& u, int wr, int wc, int fr, int fq) const {
        const bool isctx = u.pm >= 128; const int bidx = isctx ? 4 : (u.pm >> 5);
        const size_t rbase = (size_t)(isctx ? (u.pm - 128) : u.pm) * 256 + wr * 64 + fr;
        const float* xi = (isctx ? xin_ctx : xin_lat); float* xo = (isctx ? xout_ctx : xout_lat);
        const int col0 = u.pc * 256 + wc * 32 + 4 * fq; const float* g = gate + (size_t)bidx * 6144 + col0;
        pg8::f32x4 gv[2][2];
#pragma unroll
        for (int bj = 0; bj < 2; ++bj)
#pragma unroll
            for (int n = 0; n < 2; ++n) gv[bj][n] = *(const pg8::f32x4*)(g + bj * 128 + n * 16) * sc;
#pragma unroll
        for (int ai = 0; ai < 2; ++ai)
#pragma unroll
            for (int m = 0; m < 4; ++m) { const size_t off = (rbase + ai * 128 + m * 16) * 1024 + col0;
#pragma unroll
                for (int bj = 0; bj < 2; ++bj)
#pragma unroll
                    for (int n = 0; n < 2; ++n) { const pg8::f32x4 xv = *(const pg8::f32x4*)(xi + off + bj * 128 + n * 16);
                        *(pg8::f32x4*)(xo + off + bj * 128 + n * 16) = xv + gv[bj][n] * acc[ai][bj][m][n]; }
                asm volatile("" ::: "memory"); }
    }
};
struct EpiGlu {
    static constexpr bool PERM = true, AFTER_DRAIN = false;
    const bf16* Z; bf16* Y; const float* bias;
    __device__ __forceinline__ void operator()(const pg8::f32x4 (&acc)[2][2][4][2], const pg8::Unit& u, int wr, int wc, int fr, int fq) const {
        const int row0 = u.pm * 256 + wr * 64 + fr, col0 = wc * 32 + 8 * fq;
#pragma unroll
        for (int ai = 0; ai < 2; ++ai)
#pragma unroll
            for (int m = 0; m < 4; ++m) { const size_t row = (size_t)(row0 + ai * 128 + m * 16);
#pragma unroll
                for (int bj = 0; bj < 2; ++bj) { const int col = col0 + bj * 128;
                    const pg8::u32x4 zz = *(const pg8::u32x4*)(Z + row * 256 + col);
                    const pg8::f32x4 b0 = *(const pg8::f32x4*)(bias + col), b1 = *(const pg8::f32x4*)(bias + col + 4);
                    const pg8::f32x4 v0 = acc[ai][bj][m][0] + b0, v1 = acc[ai][bj][m][1] + b1;
                    float o[8]; const unsigned zw[4] = {zz.x, zz.y, zz.z, zz.w};
#pragma unroll
                    for (int j = 0; j < 4; ++j) { const float zl = __uint_as_float(zw[j] << 16), zh = __uint_as_float(zw[j] & 0xffff0000u);
                        const float a0 = (j < 2) ? v0[2 * j] : v1[2 * j - 4], a1 = (j < 2) ? v0[2 * j + 1] : v1[2 * j - 3];
                        o[2 * j] = zl * sigm(a0); o[2 * j + 1] = zh * sigm(a1); }
                    pg8::u32x4 w; w.x = pg8::cvt_pk_bf16(o[0], o[1]); w.y = pg8::cvt_pk_bf16(o[2], o[3]); w.z = pg8::cvt_pk_bf16(o[4], o[5]); w.w = pg8::cvt_pk_bf16(o[6], o[7]);
                    *(pg8::u32x4*)(Y + row * 1024 + 256 + col) = w; }
                asm volatile("" ::: "memory"); }
    }
};
struct MoeOrder {
    int tp[9]; int nN, G, c, total;
    __device__ __forceinline__ void init(const unsigned* cnt, int nN_, int G_, int c_) {
        tp[0] = 0;
#pragma unroll
        for (int e = 0; e < 8; ++e) tp[e + 1] = tp[e] + (int)(((unsigned)__builtin_amdgcn_readfirstlane((int)__hip_atomic_load(cnt + e * 64, __ATOMIC_RELAXED, __HIP_MEMORY_SCOPE_AGENT)) + 255u) >> 8);
        nN = nN_; G = G_; c = c_; total = tp[8] * nN;
    }
    __device__ __forceinline__ bool next(int i, pg8::Unit& u) const {
        const int L = i * G + c; if (L >= total) return false;
        const int t = L / nN, pn = L - t * nN; int e = 0;
#pragma unroll
        for (int k = 1; k < 8; ++k) e += (t >= tp[k]) ? 1 : 0;
        u.pm = t; u.pn = e * nN + pn; u.pc = pn; return true;
    }
    __device__ __forceinline__ void a_ready(const pg8::Unit&) const {}
    __device__ __forceinline__ void done(const pg8::Unit&) const {}
};

__device__ __forceinline__ void cvt_item(const float* W, int K, int N, bf16* WT, int mode, int add, LAS float* scr, int item, int lane, int nblk_override = 0) {
    const int nblk = nblk_override ? nblk_override : (N >> 5), kb = item / nblk, nb = item - kb * nblk, k0 = 64 * kb, n0 = 32 * nb;
    const int r = lane >> 3, c4 = lane & 7;
    f32x4 v[8];
#pragma unroll
    for (int i = 0; i < 8; ++i) v[i] = *(const f32x4*)(W + (size_t)(k0 + 8 * i + r) * N + n0 + 4 * c4);
#pragma unroll
    for (int i = 0; i < 8; ++i) {
#pragma unroll
        for (int j = 0; j < 4; ++j) scr[(8 * i + r) * 33 + 4 * c4 + j] = v[i][j]; }
    LDS_WAIT();
    const int c = lane & 7;
#pragma unroll
    for (int j = 0; j < 4; ++j) { const int n = (lane >> 3) + 8 * j; const LAS float* s = scr + (8 * c) * 33 + n;
        v4u o; o.x = pk2(s[0 * 33], s[1 * 33]); o.y = pk2(s[2 * 33], s[3 * 33]); o.z = pk2(s[4 * 33], s[5 * 33]); o.w = pk2(s[6 * 33], s[7 * 33]);
        const int nn = n0 + n; const int drow = (mode == 0) ? (nn + add) : (((nn >> 7) << 8) + (nn & 127) + add);
        *(v4u*)(WT + (size_t)drow * K + k0 + 8 * c) = o; }
    LDS_WAIT();
}
__device__ __forceinline__ void cvt_item_f8(const float* W, int K, int N, unsigned char* WT, int mode, int add, LAS float* scr, int item, int lane) {
    const int nblk = N >> 5, kb = item / nblk, nb = item - kb * nblk, k0 = 64 * kb, n0 = 32 * nb;
    const int r = lane >> 3, c4 = lane & 7;
    f32x4 v[8];
#pragma unroll
    for (int i = 0; i < 8; ++i) v[i] = *(const f32x4*)(W + (size_t)(k0 + 8 * i + r) * N + n0 + 4 * c4);
#pragma unroll
    for (int i = 0; i < 8; ++i) {
#pragma unroll
        for (int j = 0; j < 4; ++j) scr[(8 * i + r) * 33 + 4 * c4 + j] = v[i][j]; }
    LDS_WAIT();
    const int c = lane & 3;
#pragma unroll
    for (int j = 0; j < 2; ++j) { const int n = (lane >> 2) + 16 * j; const LAS float* s = scr + (16 * c) * 33 + n;
        unsigned w[4];
#pragma unroll
        for (int q = 0; q < 4; ++q) { unsigned x = 0u;
            x = __builtin_amdgcn_cvt_pk_fp8_f32(s[(4 * q) * 33] * WSC8, s[(4 * q + 1) * 33] * WSC8, x, false);
            x = __builtin_amdgcn_cvt_pk_fp8_f32(s[(4 * q + 2) * 33] * WSC8, s[(4 * q + 3) * 33] * WSC8, x, true); w[q] = x; }
        v4u o; o.x = w[0]; o.y = w[1]; o.z = w[2]; o.w = w[3];
        const int nn = n0 + n; const int drow = (mode == 0) ? (nn + add) : (((nn >> 7) << 8) + (nn & 127) + add);
        *(v4u*)(WT + (size_t)drow * K + k0 + 16 * c) = o; }
    LDS_WAIT();
}
__device__ __forceinline__ void moe_cvt_idle(const Frame& F, const Args& a, int j, int b_lo) {
    LAS float* scr = (LAS float*)(F.lds + F.wave * 16384);
    constexpr int IT = 1408;
    const int nw = (F.G - b_lo) * 8, w = ((int)blockIdx.x - b_lo) * 8 + F.wave;
    for (int it = w; it < 8 * 3 * IT; it += nw) {
        const int e = it / (3 * IT), r = it - e * 3 * IT, which = r / IT, item = r - which * IT;
        const size_t eo = ((size_t)j * 8 + e) * (size_t)(1024 * DFF);
        if (which == 0) cvt_item_f8(a.in[F.zz + I_MW1] + eo, 1024, DFF, F.ws + WS_W13M + (size_t)e * 5632 * 1024, 1, 0, scr, item, F.lane);
        else if (which == 1) cvt_item_f8(a.in[F.zz + I_MW3] + eo, 1024, DFF, F.ws + WS_W13M + (size_t)e * 5632 * 1024, 1, 128, scr, item, F.lane);
        else cvt_item_f8(a.in[F.zz + I_MW2] + eo, DFF, 1024, F.ws + WS_W2M + (size_t)e * 1024 * DFF, 0, 0, scr, item, F.lane);
    }
}
__device__ __forceinline__ void moe_cvt(const Frame& F, const Args& a, int j) {
    LAS float* scr = (LAS float*)(F.lds + F.wave * 16384);
    constexpr int IT = 1408;
    for (int it = F.gw; it < 8 * 3 * IT; it += F.NGW) {
        const int e = it / (3 * IT), r = it - e * 3 * IT, which = r / IT, item = r - which * IT;
        const size_t eo = ((size_t)j * 8 + e) * (size_t)(1024 * DFF);
        if (which == 0) cvt_item_f8(a.in[F.zz + I_MW1] + eo, 1024, DFF, F.ws + WS_W13M + (size_t)e * 5632 * 1024, 1, 0, scr, item, F.lane);
        else if (which == 1) cvt_item_f8(a.in[F.zz + I_MW3] + eo, 1024, DFF, F.ws + WS_W13M + (size_t)e * 5632 * 1024, 1, 128, scr, item, F.lane);
        else cvt_item_f8(a.in[F.zz + I_MW2] + eo, DFF, 1024, F.ws + WS_W2M + (size_t)e * 1024 * DFF, 0, 0, scr, item, F.lane);
    }
}
__device__ __forceinline__ void prologue(const Frame& F, const Args& a) {
    {
        LAS float* sc = (LAS float*)F.lds; LAS float* red = sc + 5120;
        for (int idx = F.tid; idx < 5120; idx += 512) { const int r = idx >> 10, k = idx & 1023; const float cv = (r < 4) ? a.in[F.zz + I_C][r * 1024 + k] : a.in[F.zz + I_CCTX][k]; sc[idx] = silu_f(cv); }
        __syncthreads();
        float* MOD = (float*)(F.ws + WS_MOD);
        for (int item = blockIdx.x; item < 384; item += F.G) {
            const int l = item / 96, nb = item - l * 96, cl = F.tid & 63, ks = F.tid >> 6, n = nb * 64 + cl;
            float acc[5] = {0.f, 0.f, 0.f, 0.f, 0.f};
            const float* wp = a.in[F.zz + I_ADAW] + ((size_t)l * 1024 + ks * 128) * 6144 + n;
#pragma unroll 16
            for (int kk = 0; kk < 128; ++kk) { const float w = wp[(size_t)kk * 6144];
#pragma unroll
                for (int r = 0; r < 5; ++r) acc[r] = fmaf(sc[r * 1024 + ks * 128 + kk], w, acc[r]); }
#pragma unroll
            for (int r = 0; r < 5; ++r) red[(ks * 5 + r) * 64 + cl] = acc[r];
            __syncthreads();
            if (F.tid < 320) { const int r = F.tid >> 6; float s = 0.f;
#pragma unroll
                for (int k2 = 0; k2 < 8; ++k2) s += red[(k2 * 5 + r) * 64 + cl];
                MOD[((size_t)l * 5 + r) * 6144 + n] = s + a.in[F.zz + I_ADAB][l * 6144 + n]; }
            __syncthreads();
        }
        if (blockIdx.x == 0 && F.tid < 256) {
            const float* lg = a.in[F.zz + I_LBL]; float x[4], mx = -3.0e38f;
#pragma unroll
            for (int l = 0; l < 4; ++l) { x[l] = lg[l * 256 + F.tid]; mx = fmaxf(mx, x[l]); }
            float s = 0.f;
#pragma unroll
            for (int l = 0; l < 4; ++l) { x[l] = expf(x[l] - mx); s += x[l]; }
            float cs = 0.f; const float sm0 = x[0] / s; float* LB = (float*)(F.ws + WS_LB);
#pragma unroll
            for (int l = 0; l < 4; ++l) { cs += x[l] / s; LB[l * 256 + F.tid] = fminf(fmaxf(cs - sm0, 0.f), 1.0f - 1e-6f); }
        }
        if (blockIdx.x == (1 % F.G)) {
            float* RC = (float*)(F.ws + WS_ROPE); float* RS = RC + 2048;
            for (int idx = F.tid; idx < 2048; idx += 512) { const int pos = idx >> 4, i = idx & 15;
                const float fr = powf(10000.0f, -(float)i / 16.0f); const float ang = (float)pos * fr; RC[idx] = cosf(ang); RS[idx] = sinf(ang); }
        }
        __syncthreads();
    }
    LAS float* scr = (LAS float*)(F.lds + F.wave * 16384);
    constexpr int I_IN = 16 * 104, I_OUT = 16 * 32, I_F = 1408, I_GL = 4 * 8;
    constexpr int NIT = 4 * I_IN + 4 * I_OUT + 6 * I_F + 4 * I_GL;
    for (int it = F.gw; it < NIT; it += F.NGW) {
        int r = it;
        if (r < 4 * I_IN) { const int l = r / I_IN; cvt_item(a.in[F.zz + I_WIN] + (size_t)l * 1024 * DIN, 1024, DIN, (bf16*)(F.ws + WS_WIN) + (size_t)l * DINP * 1024, 0, 0, scr, r - l * I_IN, F.lane, 104); continue; } r -= 4 * I_IN;
        if (r < 4 * I_OUT) { const int l = r / I_OUT; cvt_item(a.in[F.zz + I_WOUT] + (size_t)l * 1024 * 1024, 1024, 1024, (bf16*)(F.ws + WS_WOUT) + (size_t)l * 1024 * 1024, 0, 0, scr, r - l * I_OUT, F.lane); continue; } r -= 4 * I_OUT;
        if (r < 6 * I_F) { const int j = r / (3 * I_F), r2 = r - j * 3 * I_F, which = r2 / I_F, item = r2 - which * I_F; const size_t wo = (size_t)j * 1024 * DFF;
            if (which == 0) cvt_item(a.in[F.zz + I_FW1] + wo, 1024, DFF, (bf16*)(F.ws + WS_W13D) + (size_t)j * 5632 * 1024, 1, 0, scr, item, F.lane);
            else if (which == 1) cvt_item(a.in[F.zz + I_FW3] + wo, 1024, DFF, (bf16*)(F.ws + WS_W13D) + (size_t)j * 5632 * 1024, 1, 128, scr, item, F.lane);
            else cvt_item_f8(a.in[F.zz + I_FW2] + wo, DFF, 1024, F.ws + WS_W2D + (size_t)j * 1024 * DFF, 0, 0, scr, item, F.lane);
            continue; } r -= 6 * I_F;
        { const int l = r / I_GL; cvt_item(a.in[F.zz + I_GLUW] + (size_t)l * 65536, 256, 256, (bf16*)(F.ws + WS_GLUW) + (size_t)l * 65536, 0, 0, scr, r - l * I_GL, F.lane); }
    }
    for (int i = blockIdx.x * 512 + F.tid; i < 4 * 256 * 128; i += F.G * 512) {
        const int l = i >> 15, rem = i & 32767, n = rem >> 7, k0 = (rem & 127) * 8, d = n >> 7, cidx = n & 127;
        const float* wa = a.in[F.zz + I_WA2] + ((size_t)(l * 2 + d) * 16) * 128 + cidx;
        float acc[8] = {0.f, 0.f, 0.f, 0.f, 0.f, 0.f, 0.f, 0.f};
#pragma unroll
        for (int r = 0; r < 16; ++r) { const float w2 = wa[r * 128];
#pragma unroll
            for (int kk = 0; kk < 8; ++kk) acc[kk] = fmaf(a.in[F.zz + I_WIN][((size_t)l * 1024 + k0 + kk) * DIN + 3328 + 16 * d + r], w2, acc[kk]); }
        v4u o; o.x = pk2(acc[0], acc[1]); o.y = pk2(acc[2], acc[3]); o.z = pk2(acc[4], acc[5]); o.w = pk2(acc[6], acc[7]);
        *(v4u*)((bf16*)(F.ws + WS_WIN) + ((size_t)l * DINP + 3328 + n) * 1024 + k0) = o;
    }
}

struct MoeTp { int tp[9]; };
__device__ __forceinline__ void load_tp(MoeTp& t, const unsigned* cnt) {
    t.tp[0] = 0;
#pragma unroll
    for (int e = 0; e < 8; ++e) t.tp[e + 1] = t.tp[e] + (int)(((unsigned)__builtin_amdgcn_readfirstlane((int)__hip_atomic_load(cnt + e * 64, __ATOMIC_RELAXED, __HIP_MEMORY_SCOPE_AGENT)) + 255u) >> 8);
}
template <int MODE>
__device__ __forceinline__ void norm_phase(const Frame& F, const Args& a, int l, int which  , int nrows, int comb_l  ) {
    const float* MOD = (const float*)(F.ws + WS_MOD);
    const float* nw = (MODE == 2) ? a.in[F.zz + I_FINW] : ((which ? a.in[F.zz + I_N2W] : a.in[F.zz + I_N1W]) + l * 1024);
    bf16* XN = (bf16*)(F.ws + WS_ACT);
    float* hb = (float*)(F.ws + WS_HB);
    const int* EP = (const int*)(F.ws + WS_LIST) + 8 * MT; const float* GATE = (const float*)(F.ws + WS_LIST) + 10 * MT;
    const bf16* YM = (const bf16*)(F.ws + WS_X2);
    const bool from_input = (l == 0 && which == 0 && MODE != 2);
    MoeTp ctp; if (comb_l >= 0) load_tp(ctp, (const unsigned*)F.ws + CW_CNT + (comb_l >> 1) * 8 * 64);
    const int jm = l >> 1;
    LAS float* rwl = (LAS float*)F.lds;
    if (MODE == 1) {
        const float* rw = a.in[F.zz + I_RW] + (size_t)jm * 8192;
        for (int idx = F.tid; idx < 8192; idx += 512) { const int k = idx >> 3, e = idx & 7; rwl[e * 1024 + k] = rw[idx]; }
        __syncthreads();
    }
    f32x4 wv[4];
#pragma unroll
    for (int j = 0; j < 4; ++j) wv[j] = *((const f32x4*)nw + F.lane + 64 * j);
    f32x4 vn[4]; int epn0 = 0, epn1 = 0; float gn0 = 0.f, gn1 = 0.f;
    { const int m = F.gw < nrows ? F.gw : 0; const bool isctx = m >= NLAT;
      const float* xr = from_input ? (isctx ? a.in[F.zz + I_CTX] + (size_t)(m - NLAT) * 1024 : a.in[F.zz + I_X] + (size_t)m * 1024) : (isctx ? hb + (size_t)(m - NLAT) * 1024 : F.out + (size_t)m * 1024);
#pragma unroll
      for (int j = 0; j < 4; ++j) vn[j] = *((const f32x4*)xr + F.lane + 64 * j);
      if (comb_l >= 0) { epn0 = EP[2 * m]; epn1 = EP[2 * m + 1]; gn0 = GATE[2 * m]; gn1 = GATE[2 * m + 1]; } }
    for (int m = F.gw; m < nrows; m += F.NGW) {
        const bool isctx = m >= NLAT; const int bidx = isctx ? 4 : (m >> 13);
        f32x4 v[4];
#pragma unroll
        for (int j = 0; j < 4; ++j) v[j] = vn[j];
        const int ep0 = epn0, ep1 = epn1; const float g0 = gn0, g1 = gn1;
        { const int mn = (m + F.NGW < nrows) ? m + F.NGW : m; const bool cn = mn >= NLAT;
          const float* xr = from_input ? (cn ? a.in[F.zz + I_CTX] + (size_t)(mn - NLAT) * 1024 : a.in[F.zz + I_X] + (size_t)mn * 1024) : (cn ? hb + (size_t)(mn - NLAT) * 1024 : F.out + (size_t)mn * 1024);
#pragma unroll
          for (int j = 0; j < 4; ++j) vn[j] = *((const f32x4*)xr + F.lane + 64 * j);
          if (comb_l >= 0) { epn0 = EP[2 * mn]; epn1 = EP[2 * mn + 1]; gn0 = GATE[2 * mn]; gn1 = GATE[2 * mn + 1]; } }
        if (comb_l >= 0) {
            int t0 = 0, t1 = 0;
#pragma unroll
            for (int e = 0; e < 8; ++e) { t0 = ((ep0 & 7) == e) ? ctp.tp[e] : t0; t1 = ((ep1 & 7) == e) ? ctp.tp[e] : t1; }
            const size_t d0 = (size_t)t0 * 256 + (ep0 >> 3), d1 = (size_t)t1 * 256 + (ep1 >> 3);
            const float* m5 = MOD + ((size_t)comb_l * 5 + bidx) * 6144 + 5 * 1024;
            float* xw = isctx ? hb + (size_t)(m - NLAT) * 1024 : F.out + (size_t)m * 1024;
#pragma unroll
            for (int j = 0; j < 4; ++j) {
                const v2u y0 = *((const v2u*)(YM + d0 * 1024) + F.lane + 64 * j), y1 = *((const v2u*)(YM + d1 * 1024) + F.lane + 64 * j);
                const f32x4 mm = *((const f32x4*)m5 + F.lane + 64 * j);
                f32x4 f0, f1;
                f0[0] = __uint_as_float(y0.x << 16); f0[1] = __uint_as_float(y0.x & 0xffff0000u); f0[2] = __uint_as_float(y0.y << 16); f0[3] = __uint_as_float(y0.y & 0xffff0000u);
                f1[0] = __uint_as_float(y1.x << 16); f1[1] = __uint_as_float(y1.x & 0xffff0000u); f1[2] = __uint_as_float(y1.y << 16); f1[3] = __uint_as_float(y1.y & 0xffff0000u);
                v[j] = v[j] + mm * (f0 * g0 + f1 * g1);
                if (MODE != 2) *((f32x4*)xw + F.lane + 64 * j) = v[j];
            }
        }
        float ss = 0.f;
#pragma unroll
        for (int j = 0; j < 4; ++j) ss += (v[j][0] * v[j][0] + v[j][1] * v[j][1]) + (v[j][2] * v[j][2] + v[j][3] * v[j][3]);
        ss = wave_sum(ss);
        const float rstd = __builtin_amdgcn_rsqf(ss * (1.0f / 1024.0f) + NEPS);
        if (MODE == 2) {
#pragma unroll
            for (int j = 0; j < 4; ++j) *((f32x4*)(F.out + (size_t)m * 1024) + F.lane + 64 * j) = v[j] * rstd * wv[j];
        } else {
            const float* sh = MOD + ((size_t)l * 5 + bidx) * 6144 + (which ? 3 : 0) * 1024; const float* scl = sh + 1024;
            f32x4 o[4];
#pragma unroll
            for (int j = 0; j < 4; ++j) { const f32x4 s1 = *((const f32x4*)scl + F.lane + 64 * j), s0 = *((const f32x4*)sh + F.lane + 64 * j);
                o[j] = (v[j] * rstd * wv[j]) * (s1 + 1.0f) + s0;
                if (MODE == 1) {
                    unsigned w8 = 0u; w8 = __builtin_amdgcn_cvt_pk_fp8_f32(fminf(fmaxf(o[j][0], -448.f), 448.f), fminf(fmaxf(o[j][1], -448.f), 448.f), w8, false);
                    w8 = __builtin_amdgcn_cvt_pk_fp8_f32(fminf(fmaxf(o[j][2], -448.f), 448.f), fminf(fmaxf(o[j][3], -448.f), 448.f), w8, true);
                    *((unsigned*)((unsigned char*)XN + (size_t)m * 1024) + F.lane + 64 * j) = w8;
                } else { v2u w; w.x = pk2(o[j][0], o[j][1]); w.y = pk2(o[j][2], o[j][3]);
                    *((v2u*)(XN + (size_t)m * 1024) + F.lane + 64 * j) = w; } }
            if (MODE == 1) {
                float p[8];
#pragma unroll
                for (int e = 0; e < 8; ++e) { float s = 0.f;
#pragma unroll
                    for (int j = 0; j < 4; ++j) { const f32x4 w4 = *((const LAS f32x4*)(rwl + e * 1024) + F.lane + 64 * j);
                        s += (o[j][0] * w4[0] + o[j][1] * w4[1]) + (o[j][2] * w4[2] + o[j][3] * w4[3]); }
                    p[e] = wave_sum(s) + a.in[F.zz + I_RB][jm * 8 + e]; }
                int e0 = 0; float v0 = p[0];
#pragma unroll
                for (int e = 1; e < 8; ++e) if (p[e] > v0) { v0 = p[e]; e0 = e; }
                int e1 = -1; float v1 = -3.0e38f;
#pragma unroll
                for (int e = 0; e < 8; ++e) if (e != e0 && p[e] > v1) { v1 = p[e]; e1 = e; }
                const float ex = expf(v1 - v0), g0 = 1.0f / (1.0f + ex), g1 = ex / (1.0f + ex);
                if (F.lane == 0) {
                    unsigned* cnt = (unsigned*)F.ws + CW_CNT + jm * 8 * 64; int* LIST = (int*)(F.ws + WS_LIST);
                    int* EPw = (int*)(F.ws + WS_LIST) + 8 * MT; float* GW = (float*)(F.ws + WS_LIST) + 10 * MT;
                    const unsigned p0 = __hip_atomic_fetch_add(cnt + e0 * 64, 1u, __ATOMIC_RELAXED, __HIP_MEMORY_SCOPE_AGENT);
                    const unsigned p1 = __hip_atomic_fetch_add(cnt + e1 * 64, 1u, __ATOMIC_RELAXED, __HIP_MEMORY_SCOPE_AGENT);
                    LIST[e0 * MT + p0] = m; LIST[e1 * MT + p1] = m;
                    EPw[2 * m] = e0 | (int)(p0 << 3); EPw[2 * m + 1] = e1 | (int)(p1 << 3);
                    GW[2 * m] = g0; GW[2 * m + 1] = g1;
                }
            }
        }
    }
    if (MODE == 1) __syncthreads();
}
__device__ __forceinline__ void moe_gather(const Frame& F, int jm) {
    const unsigned* cnt = (const unsigned*)F.ws + CW_CNT + jm * 8 * 64;
    MoeTp t; load_tp(t, cnt);
    int cn[8];
#pragma unroll
    for (int e = 0; e < 8; ++e) cn[e] = __builtin_amdgcn_readfirstlane((int)__hip_atomic_load(cnt + e * 64, __ATOMIC_RELAXED, __HIP_MEMORY_SCOPE_AGENT));
    const int rows = t.tp[8] * 256;
    const int* LIST = (const int*)(F.ws + WS_LIST); const v4u* XN = (const v4u*)(F.ws + WS_ACT); v4u* XB = (v4u*)(F.ws + WS_X2);
    for (int r = F.gw; r < rows; r += F.NGW) {
        const int tile = r >> 8; int e = 0, tpe = 0, ce = cn[0];
#pragma unroll
        for (int k = 1; k < 8; ++k) { const bool ge = tile >= t.tp[k]; e += ge ? 1 : 0; tpe = ge ? t.tp[k] : tpe; ce = ge ? cn[k] : ce; }
        const int pos = r - tpe * 256;
        v4u x0 = {0u, 0u, 0u, 0u};
        if (pos < ce) { const int src = LIST[e * MT + pos]; x0 = XN[(size_t)src * 64 + F.lane]; }
        XB[(size_t)r * 64 + F.lane] = x0;
    }
}
#define GLD(T, ubase, voff) (*(const T*)((const char*)(ubase) + (unsigned)(voff)))
#define GST(T, ubase, voff) (*(T*)((char*)(ubase) + (unsigned)(voff)))
__device__ __forceinline__ int fresh_lane() { int l; asm volatile("v_mbcnt_lo_u32_b32 %0, -1, 0\n\tv_mbcnt_hi_u32_b32 %0, -1, %0" : "=v"(l)); return l; }

struct MixP { const bf16* P; const float* lb; const float* rcos; const float* rsin; const float* ba; };
__device__ __forceinline__ int seg_row0(int b, int sg) { return sg < 4 ? NLAT + b * CTXL + sg * 64 : b * SEQ + (sg - 4) * 64; }
__device__ __forceinline__ int seg_tpos0(int sg) { return sg < 4 ? -1 : (sg - 4) * 64; }

struct S5P { const float *lam_re, *lam_im, *log_dt, *b_re, *b_im, *c_re, *c_im, *dd; };
__device__ __forceinline__ float gelu_tanh(float y) { const float t = 0.7978845608028654f * (y + 0.044715f * y * y * y); const float th = 1.0f - 2.0f * __builtin_amdgcn_rcpf(1.0f + __expf(2.0f * t)); return 0.5f * y * (1.0f + th); }
template <int MODE>
__device__ __forceinline__ void s5_scan(const S5P& sp, const bf16* P, int b, int g, int dir, int sg, int lane, float& hre, float& him, LAS float* yf, LAS float* stg, bf16* Z) {
    const int row0 = seg_row0(b, sg); const int dg = dir * 16 + g;
    const float lre = sp.lam_re[dg * 64 + lane], lim = sp.lam_im[dg * 64 + lane], dt = expf(sp.log_dt[dg]);
    const float er = expf(lre * dt); const float sn = sinf(lim * dt), cs = cosf(lim * dt);
    const float ar = er * cs, ai = er * sn;
    const float nr = ar - 1.0f, ni = ai, den = lre * lre + lim * lim;
    const float cr = (nr * lre + ni * lim) / den, ci = (ni * lre - nr * lim) / den;
    float bbr[16], bbi[16], Cr[16], Ci[16];
#pragma unroll
    for (int c = 0; c < 16; ++c) { const float Br = sp.b_re[((size_t)dg * 64 + lane) * 16 + c], Bi = sp.b_im[((size_t)dg * 64 + lane) * 16 + c];
        bbr[c] = cr * Br - ci * Bi; bbi[c] = cr * Bi + ci * Br;
        Cr[c] = (MODE != 0) ? sp.c_re[((size_t)dg * 16 + c) * 64 + lane] : 0.f; Ci[c] = (MODE != 0) ? sp.c_im[((size_t)dg * 16 + c) * 64 + lane] : 0.f; }
    const int ch = ((lane >> 5) & 1) * 8 + ((lane >> 4) & 1) * 4 + ((lane >> 3) & 1) * 2 + ((lane >> 2) & 1);
    const float dv = (MODE == 2) ? sp.dd[g * 16 + ch] : 0.f;
    const bool b5 = lane & 32, b4 = lane & 16, b3 = lane & 8, b2 = lane & 4;
    const unsigned ucol = 2u * (unsigned)(C_S5 + g * 16 + (lane & 15));
    unsigned short rn0[4], rn1[4], rn2[4];
#pragma unroll
    for (int u = 0; u < 4; ++u) { rn0[u] = GLD(unsigned short, P + (size_t)(row0 + (dir ? 63 - u : u)) * DINP, ucol); rn1[u] = GLD(unsigned short, P + (size_t)(row0 + (dir ? 59 - u : 4 + u)) * DINP, ucol);
        rn2[u] = GLD(unsigned short, P + (size_t)(row0 + (dir ? 55 - u : 8 + u)) * DINP, ucol); }
#pragma unroll 1
    for (int i0 = 0; i0 < 64; i0 += 4) {
        unsigned short ru[4], rn3[4];
        const int ip = (i0 + 12 < 64) ? i0 + 12 : 60;
#pragma unroll
        for (int u = 0; u < 4; ++u) { ru[u] = rn0[u]; rn3[u] = GLD(unsigned short, P + (size_t)(row0 + (dir ? 63 - (ip + u) : (ip + u))) * DINP, ucol); }
#pragma unroll
        for (int u = 0; u < 4; ++u) stg[u * 64 + lane] = bf2f(ru[u]);
#pragma unroll
        for (int u = 0; u < 4; ++u) {
            const int ti = dir ? 63 - (i0 + u) : (i0 + u);
            const float uf = bf2f(ru[u]);
            float bur = 0.f, bui = 0.f;
#pragma unroll
            for (int c4 = 0; c4 < 4; ++c4) { const f32x4 ux = *(const LAS f32x4*)(stg + u * 64 + 4 * c4);
#pragma unroll
                for (int jj = 0; jj < 4; ++jj) { bur = fmaf(bbr[4 * c4 + jj], ux[jj], bur); bui = fmaf(bbi[4 * c4 + jj], ux[jj], bui); } }
            const float nre = ar * hre - ai * him + bur, nim = ar * him + ai * hre + bui;
            hre = nre; him = nim;
            if (MODE != 0) {
                float v[16];
#pragma unroll
                for (int c = 0; c < 16; ++c) v[c] = Cr[c] * hre - Ci[c] * him;
                float w8[8], w4[4], w2[2], w1;
#pragma unroll
                for (int i = 0; i < 8; ++i) { const float mine = b5 ? v[8 + i] : v[i], oth = b5 ? v[i] : v[8 + i]; w8[i] = mine + __shfl_xor(oth, 32); }
#pragma unroll
                for (int i = 0; i < 4; ++i) { const float mine = b4 ? w8[4 + i] : w8[i], oth = b4 ? w8[i] : w8[4 + i]; w4[i] = mine + __shfl_xor(oth, 16); }
#pragma unroll
                for (int i = 0; i < 2; ++i) { const float mine = b3 ? w4[2 + i] : w4[i], oth = b3 ? w4[i] : w4[2 + i]; w2[i] = mine + __shfl_xor(oth, 8); }
                { const float mine = b2 ? w2[1] : w2[0], oth = b2 ? w2[0] : w2[1]; w1 = mine + __shfl_xor(oth, 4); }
                w1 += __shfl_xor(w1, 2); w1 += __shfl_xor(w1, 1);
                if (MODE == 1) { if ((lane & 3) == 0) yf[ti * 16 + ch] = w1; }
                if (MODE == 2) {
                    const float uch = __shfl(uf, ch);
                    if ((lane & 3) == 0) { const float y = w1 + yf[ti * 16 + ch] + dv * uch; Z[(size_t)(row0 + ti) * 256 + g * 16 + ch] = (bf16)f2bf(gelu_tanh(y)); }
                }
            }
        }
#pragma unroll
        for (int u = 0; u < 4; ++u) { rn0[u] = rn1[u]; rn1[u] = rn2[u]; rn2[u] = rn3[u]; }
    }
}

__device__ __forceinline__ MixP make_mixp(const Frame& F, const Args& a, int l) {
    MixP mp; mp.P = (const bf16*)(F.ws + WS_PH); mp.lb = (const float*)(F.ws + WS_LB) + l * 256; mp.rcos = (const float*)(F.ws + WS_ROPE); mp.rsin = mp.rcos + 2048;
    mp.ba = a.in[F.zz + I_BA] + (size_t)l * 2 * 128; return mp;
}
__device__ __forceinline__ S5P make_s5p(const Frame& F, const Args& a, int l) {
    S5P sp; sp.lam_re = a.in[F.zz + I_LAMRE] + (size_t)l * 2048; sp.lam_im = a.in[F.zz + I_LAMIM] + (size_t)l * 2048; sp.log_dt = a.in[F.zz + I_LOGDT] + l * 32;
    sp.b_re = a.in[F.zz + I_BRE] + (size_t)l * 32768; sp.b_im = a.in[F.zz + I_BIM] + (size_t)l * 32768; sp.c_re = a.in[F.zz + I_CRE] + (size_t)l * 32768; sp.c_im = a.in[F.zz + I_CIM] + (size_t)l * 32768;
    sp.dd = a.in[F.zz + I_S5D] + l * 256; return sp;
}


typedef short bf16x8_t __attribute__((ext_vector_type(8)));
typedef float f32x16 __attribute__((ext_vector_type(16)));
typedef float f32x2_t __attribute__((ext_vector_type(2)));
typedef __bf16 bf16x2_n __attribute__((ext_vector_type(2)));
__device__ __forceinline__ unsigned pkbf(float lo, float hi) { const f32x2_t v = {lo, hi}; const bf16x2_n r = __builtin_convertvector(v, bf16x2_n); return __builtin_bit_cast(unsigned, r); }
constexpr int WL_QC = 0, WL_KC = 4608, WL_KT = 9216, WL_VT = 14336, WL_PL = 19456, WL_BYTES = 19712;

struct MxC { float gamma, lbv, oml, bav; unsigned cq, ck, cv, cz; };
template <int MIX>
__device__ __forceinline__ void mx_consts(MxC& c, const MixP& mp, int h, int dir, int lane) {
    c.gamma = 1.f; c.lbv = 0.f; c.oml = 1.f; c.bav = 0.f; c.cz = 0;
    if (MIX == 0) { c.cq = 2u * (unsigned)(C_RQ + h * 64 + lane); c.ck = 2u * (unsigned)(C_RK + h * 64 + lane); c.cv = 2u * (unsigned)(C_RV + h * 64 + lane); c.gamma = 1.0f - exp2f(-5.0f - (float)(dir ? 3 - h : h)); }
    else if (MIX == 1) { c.cq = 2u * (unsigned)(C_HQ + h * 64 + lane); c.ck = 2u * (unsigned)((dir ? C_HFB : C_HFF) + h * 64 + lane); c.cv = 2u * (unsigned)(C_HI + h * 64 + lane); c.lbv = mp.lb[h * 64 + lane]; c.oml = 1.0f - c.lbv; }
    else { c.cq = 2u * (unsigned)(C_GQ + h * 32 + (lane & 31)); c.ck = 2u * (unsigned)(C_GK + h * 32 + (lane & 31)); c.cv = 2u * (unsigned)(C_GV + h * 64 + lane); c.cz = 2u * (unsigned)((dir ? C_GZB : C_GZF) + h * 32 + (lane & 31));
        c.bav = mp.ba[dir * 128 + h * 32 + (lane & 31)]; }
}
struct MxRaw { unsigned short q[4], k[4], v[4], z[4]; };
template <int MIX, bool NEEDQ, int DIR>
__device__ __forceinline__ void mx_load(MxRaw& w, const MixP& mp, const MxC& c, int rows, int b) {
#pragma unroll
    for (int u = 0; u < 4; ++u) { const int cc = b * 4 + u; const bf16* pr = mp.P + (size_t)(rows + (DIR ? 63 - cc : cc)) * DINP;
        w.q[u] = NEEDQ ? GLD(unsigned short, pr, c.cq) : (unsigned short)0; w.k[u] = GLD(unsigned short, pr, c.ck); w.v[u] = GLD(unsigned short, pr, c.cv); w.z[u] = (MIX == 2) ? GLD(unsigned short, pr, c.cz) : (unsigned short)0; }
}
template <int MIX, bool NEEDQ, int DIR>
__device__ __forceinline__ void mx_batch(const MxRaw& cur, const MixP& mp, const MxC& c, int tposs  , int lane, LAS unsigned char* wl, int b, float& P) {
    constexpr int DK = (MIX == 2) ? 32 : 64;
    float kt[4], vv[4];
#pragma unroll
    for (int u = 0; u < 4; ++u) {
        const int cc = b * 4 + u, ts = DIR ? 63 - cc : cc, t = ts & 31;
        float q = bf2f(cur.q[u]), k, f; vv[DIR ? 3 - u : u] = bf2f(cur.v[u]);
        if (MIX == 0) {
            k = bf2f(cur.k[u]) * 0.125f; f = c.gamma;
            if (tposs >= 0) { const int tpos = tposs + ts; const int pos = (lane & 32) ? (tpos & 63) : (tpos >> 6);
                const unsigned ro = 4u * (unsigned)(pos * 16 + (lane & 15)); const float cs = GLD(float, mp.rcos, ro), sn = GLD(float, mp.rsin, ro);
                const float ss = (lane & 16) ? sn : -sn;
                const float kp = __shfl_xor(k, 16); k = fmaf(kp, ss, k * cs);
                if (NEEDQ) { const float qp = __shfl_xor(q, 16); q = fmaf(qp, ss, q * cs); } }
        } else if (MIX == 1) {
            const float z = bf2f(cur.k[u]); const float e = __expf(-z); const float sp = __builtin_amdgcn_rcpf(1.0f + e), sn = e * sp;
            f = fmaf(c.oml, sp, c.lbv); k = c.oml * sn;
        } else {
            k = bf2f(cur.k[u]) * 0.17677669529663687f; const float z = bf2f(cur.z[u]) + c.bav;
            const float ls = fminf(z, 0.f) - __logf(1.0f + __expf(-fabsf(z)));
            f = __expf(ls * 0.0625f);
        }
        P = fmaxf(P * f, 1e-30f);
        const float kk = k * __builtin_amdgcn_rcpf(P); kt[DIR ? 3 - u : u] = kk;
        if (lane < DK) {
            const unsigned qk = pkbf(q * P, kk);
            if (NEEDQ) *(LAS unsigned short*)(wl + WL_QC + t * 144 + lane * 2) = (unsigned short)qk;
            *(LAS unsigned short*)(wl + WL_KC + t * 144 + lane * 2) = (unsigned short)(qk >> 16);
        }
    }
    const int g4 = ((DIR ? 63 - b * 4 : b * 4) & 31) >> 2;
    v2u kp, vp; kp.x = pkbf(kt[0], kt[1]); kp.y = pkbf(kt[2], kt[3]); vp.x = pkbf(vv[0], vv[1]); vp.y = pkbf(vv[2], vv[3]);
    if (lane < DK) *(LAS v2u*)(wl + WL_KT + lane * 80 + g4 * 8) = kp;
    *(LAS v2u*)(wl + WL_VT + lane * 80 + g4 * 8) = vp;
}
typedef short bf16x4_t __attribute__((ext_vector_type(4)));
#define MFMA8(a, b, c) __builtin_amdgcn_mfma_f32_32x32x8bf16_1k((a), (b), (c), 0, 0, 0)
__device__ __forceinline__ bf16x4_t pack4(const f32x16& x, int s) {
    v2u p; p.x = pkbf(x[4 * s], x[4 * s + 1]); p.y = pkbf(x[4 * s + 2], x[4 * s + 3]);
    return __builtin_bit_cast(bf16x4_t, p);
}
__device__ __forceinline__ bf16x4_t ld4(const LAS unsigned char* p) { const v2u a = *(const LAS v2u*)p; return __builtin_bit_cast(bf16x4_t, a); }

template <int MODE, int DIR>
__device__ __forceinline__ void s5_mm_dir(const S5P& sp, const bf16* P, int b, int g, int sg, int lane, float& hre, float& him, LAS float* yf, LAS unsigned char* hs, bf16* Z) {
    const int m32 = lane & 31, hh = lane >> 5, dg = DIR * 16 + g, row0 = seg_row0(b, sg);
    float ar[2], ai[2], a2r[2], a2i[2], a3r[2], a3i[2], a4r[2], a4i[2];
    bf16x4_t bfr[4][2];
    const float dt = __expf(sp.log_dt[dg]);
#pragma unroll
    for (int sh = 0; sh < 2; ++sh) {
        const int p = 32 * sh + m32;
        const float lre = sp.lam_re[dg * 64 + p], lim = sp.lam_im[dg * 64 + p];
        const float er = __expf(lre * dt), sn = sinf(lim * dt), cs = cosf(lim * dt);
        ar[sh] = er * cs; ai[sh] = er * sn;
        a2r[sh] = ar[sh] * ar[sh] - ai[sh] * ai[sh]; a2i[sh] = ar[sh] * ai[sh] + ar[sh] * ai[sh];
        a3r[sh] = a2r[sh] * ar[sh] - a2i[sh] * ai[sh]; a3i[sh] = a2r[sh] * ai[sh] + a2i[sh] * ar[sh];
        a4r[sh] = a2r[sh] * a2r[sh] - a2i[sh] * a2i[sh]; a4i[sh] = a2r[sh] * a2i[sh] + a2r[sh] * a2i[sh];
        const float nr = ar[sh] - 1.0f, ni = ai[sh], den = 1.0f / (lre * lre + lim * lim);
        const float cr = (nr * lre + ni * lim) * den, ci = (ni * lre - nr * lim) * den;
#pragma unroll
        for (int s2 = 0; s2 < 2; ++s2) {
            const f32x4 Br = *(const f32x4*)(sp.b_re + ((size_t)dg * 64 + p) * 16 + 8 * s2 + 4 * hh), Bi = *(const f32x4*)(sp.b_im + ((size_t)dg * 64 + p) * 16 + 8 * s2 + 4 * hh);
            const f32x4 re = Br * cr - Bi * ci, im = Bi * cr + Br * ci;
            v2u pr, pi; pr.x = pkbf(re[0], re[1]); pr.y = pkbf(re[2], re[3]); pi.x = pkbf(im[0], im[1]); pi.y = pkbf(im[2], im[3]);
            bfr[sh][s2] = __builtin_bit_cast(bf16x4_t, pr); bfr[2 + sh][s2] = __builtin_bit_cast(bf16x4_t, pi);
        }
    }
    bf16x4_t cfr[16];
    if (MODE != 0) {
#pragma unroll
        for (int s = 0; s < 16; ++s) {
            const int p4 = (8 * s + 4 * hh) & 63; f32x4 cv = {0.f, 0.f, 0.f, 0.f};
            if (m32 < 16) cv = (s < 8) ? *(const f32x4*)(sp.c_re + ((size_t)dg * 16 + m32) * 64 + p4) : -*(const f32x4*)(sp.c_im + ((size_t)dg * 16 + m32) * 64 + p4);
            v2u pc; pc.x = pkbf(cv[0], cv[1]); pc.y = pkbf(cv[2], cv[3]); cfr[s] = __builtin_bit_cast(bf16x4_t, pc);
        }
    }
    const float ddv = (MODE == 2 && m32 < 16) ? sp.dd[g * 16 + m32] : 0.f;
    float hr[2], hi[2];
    hr[0] = __shfl(hre, m32); hi[0] = __shfl(him, m32); hr[1] = __shfl(hre, m32 + 32); hi[1] = __shfl(him, m32 + 32);
#pragma unroll 1
    for (int ci2 = 0; ci2 < 2; ++ci2) {
        const int ch = DIR ? 1 - ci2 : ci2, rowc = row0 + 32 * ch;
        const bf16* urow = P + (size_t)(rowc + m32) * DINP + C_S5 + g * 16 + 4 * hh;
        const bf16x4_t ua0 = __builtin_bit_cast(bf16x4_t, *(const v2u*)urow), ua1 = __builtin_bit_cast(bf16x4_t, *(const v2u*)(urow + 8));
        f32x16 BU[4];
#pragma unroll
        for (int nt = 0; nt < 4; ++nt) {
#pragma unroll
            for (int r = 0; r < 16; ++r) BU[nt][r] = 0.f;
            BU[nt] = MFMA8(ua0, bfr[nt][0], BU[nt]); BU[nt] = MFMA8(ua1, bfr[nt][1], BU[nt]);
        }
#pragma unroll
        for (int sh = 0; sh < 2; ++sh)
#pragma unroll
            for (int gg = 0; gg < 4; ++gg)
#pragma unroll
                for (int jj = 1; jj < 4; ++jj) {
                    const int r = DIR ? 4 * gg + 3 - jj : 4 * gg + jj, rp = DIR ? r + 1 : r - 1;
                    const float pr = BU[sh][rp], pi = BU[2 + sh][rp];
                    BU[sh][r] += ar[sh] * pr - ai[sh] * pi; BU[2 + sh][r] += ar[sh] * pi + ai[sh] * pr;
                }
        float hnr[2][4], hni[2][4];
#pragma unroll
        for (int st = 0; st < 8; ++st) {
            const int gg = DIR ? 3 - (st >> 1) : (st >> 1), turn = DIR ? 1 - (st & 1) : (st & 1), rl = DIR ? 4 * gg : 4 * gg + 3;
            const bool act = (hh == turn);
#pragma unroll
            for (int sh = 0; sh < 2; ++sh) {
                if (turn == (DIR ? 1 : 0)) { hnr[sh][gg] = hr[sh]; hni[sh][gg] = hi[sh]; }
                else { hnr[sh][gg] = act ? hr[sh] : hnr[sh][gg]; hni[sh][gg] = act ? hi[sh] : hni[sh][gg]; }
                const float outr = BU[sh][rl] + a4r[sh] * hr[sh] - a4i[sh] * hi[sh], outi = BU[2 + sh][rl] + a4r[sh] * hi[sh] + a4i[sh] * hr[sh];
                const float sr = __shfl_xor(outr, 32), si = __shfl_xor(outi, 32);
                hr[sh] = act ? outr : sr; hi[sh] = act ? outi : si;
            }
        }
        if (MODE != 0) {
#pragma unroll
            for (int sh = 0; sh < 2; ++sh)
#pragma unroll
                for (int gg = 0; gg < 4; ++gg)
#pragma unroll
                    for (int jj = 0; jj < 4; ++jj) {
                        const int pw = DIR ? 4 - jj : jj + 1;
                        const float pr = (pw == 1) ? ar[sh] : (pw == 2) ? a2r[sh] : (pw == 3) ? a3r[sh] : a4r[sh], pi = (pw == 1) ? ai[sh] : (pw == 2) ? a2i[sh] : (pw == 3) ? a3i[sh] : a4i[sh];
                        BU[sh][4 * gg + jj] += pr * hnr[sh][gg] - pi * hni[sh][gg]; BU[2 + sh][4 * gg + jj] += pr * hni[sh][gg] + pi * hnr[sh][gg];
                    }
#pragma unroll
            for (int nt = 0; nt < 4; ++nt)
#pragma unroll
                for (int r = 0; r < 16; ++r) *(LAS unsigned short*)(hs + ((r & 3) + 8 * (r >> 2) + 4 * hh) * 272 + (32 * nt + m32) * 2) = (unsigned short)pkbf(BU[nt][r], BU[nt][r]);
            f32x16 Yv;
#pragma unroll
            for (int r = 0; r < 16; ++r) Yv[r] = 0.f;
#pragma unroll
            for (int s = 0; s < 16; ++s) Yv = MFMA8(ld4(hs + m32 * 272 + (8 * s + 4 * hh) * 2), cfr[s], Yv);
            if (m32 < 16) {
#pragma unroll
                for (int r = 0; r < 16; ++r) {
                    const int tl = (r & 3) + 8 * (r >> 2) + 4 * hh;
                    if (MODE == 1) yf[(32 * ch + tl) * 16 + m32] = Yv[r];
                    else { const float u = bf2f(P[(size_t)(rowc + tl) * DINP + C_S5 + g * 16 + m32]);
                        const float y = Yv[r] + yf[(32 * ch + tl) * 16 + m32] + ddv * u;
                        const float zz = gelu_tanh(y); Z[(size_t)(rowc + tl) * 256 + g * 16 + m32] = (bf16)pkbf(zz, zz); }
                }
            }
        }
    }
    hre = hh ? hr[1] : hr[0]; him = hh ? hi[1] : hi[0];
}
template <int MODE>
__device__ __forceinline__ void s5_mm(const S5P& sp, const bf16* P, int b, int g, int dir, int sg, int lane, float& hre, float& him, LAS float* yf, LAS unsigned char* hs, bf16* Z) {
    if (dir) s5_mm_dir<MODE, 1>(sp, P, b, g, sg, lane, hre, him, yf, hs, Z); else s5_mm_dir<MODE, 0>(sp, P, b, g, sg, lane, hre, him, yf, hs, Z);
}
template <int MIX, int DIR, bool WITH_O>
__device__ __forceinline__ void mx_chunk(LAS unsigned char* wl, int lane, float Pl, f32x16 (&ST)[(MIX == 2) ? 1 : 2][2], f32x16 (&O)[2]) {
    constexpr int DK = (MIX == 2) ? 32 : 64, NRT = DK / 32;
    const int m32 = lane & 31, hh = lane >> 5;
    asm volatile("" ::: "memory");
    if (lane < DK) *(LAS float*)(wl + WL_PL + lane * 4) = Pl;
    asm volatile("" ::: "memory");
    if (WITH_O) {
        f32x16 x;
#pragma unroll
        for (int r = 0; r < 16; ++r) x[r] = 0.f;
#pragma unroll
        for (int s = 0; s < DK / 8; ++s) {
            const bf16x4_t ka = ld4(wl + WL_KC + m32 * 144 + (8 * s + 4 * hh) * 2);
            const bf16x4_t qb = ld4(wl + WL_QC + m32 * 144 + (8 * s + 4 * hh) * 2);
            x = MFMA8(ka, qb, x);
        }
#pragma unroll
        for (int r = 0; r < 16; ++r) { const int j = (r & 3) + 8 * (r >> 2) + 4 * hh; const bool keep = DIR ? (j >= m32) : (j <= m32); x[r] = keep ? x[r] : 0.f; }
#pragma unroll
        for (int t = 0; t < 2; ++t)
#pragma unroll
            for (int r = 0; r < 16; ++r) O[t][r] = 0.f;
#pragma unroll
        for (int s = 0; s < 4; ++s) {
            const bf16x4_t xa = pack4(x, s);
#pragma unroll
            for (int t = 0; t < 2; ++t) O[t] = MFMA8(xa, ld4(wl + WL_VT + (32 * t + m32) * 80 + (8 * s + 4 * hh) * 2), O[t]);
        }
#pragma unroll
        for (int rt = 0; rt < NRT; ++rt)
#pragma unroll
            for (int s = 0; s < 4; ++s) {
                const bf16x4_t qa = ld4(wl + WL_QC + m32 * 144 + (32 * rt + 8 * s + 4 * hh) * 2);
#pragma unroll
                for (int t = 0; t < 2; ++t) O[t] = MFMA8(qa, pack4(ST[rt][t], s), O[t]);
            }
    }
#pragma unroll
    for (int rt = 0; rt < NRT; ++rt)
#pragma unroll
        for (int s = 0; s < 4; ++s) {
            const bf16x4_t ka = ld4(wl + WL_KT + (32 * rt + m32) * 80 + (8 * s + 4 * hh) * 2);
#pragma unroll
            for (int t = 0; t < 2; ++t) ST[rt][t] = MFMA8(ka, ld4(wl + WL_VT + (32 * t + m32) * 80 + (8 * s + 4 * hh) * 2), ST[rt][t]);
        }
#pragma unroll
    for (int rt = 0; rt < NRT; ++rt)
#pragma unroll
        for (int g = 0; g < 4; ++g) {
            const f32x4 pl4 = *(const LAS f32x4*)(wl + WL_PL + (32 * rt + 8 * g + 4 * hh) * 4);
#pragma unroll
            for (int e = 0; e < 4; ++e) { ST[rt][0][4 * g + e] *= pl4[e]; ST[rt][1][4 * g + e] *= pl4[e]; }
        }
}
__device__ __forceinline__ float half_sum(float v) {
#pragma unroll
    for (int o = 1; o < 32; o <<= 1) v += __shfl_xor(v, o);
    return v;
}
template <int MIX, int DIR>
__device__ __forceinline__ void mixA_stream(const MixP& mp, const MxC& c, int row0, int tpos0, int lane, LAS unsigned char* wl, f32x16 (&ST)[(MIX == 2) ? 1 : 2][2], float& Gam) {
    f32x16 O[2];
    MxRaw r0, r1, r2;
    mx_load<MIX, false, DIR>(r0, mp, c, row0, 0); mx_load<MIX, false, DIR>(r1, mp, c, row0, 1); mx_load<MIX, false, DIR>(r2, mp, c, row0, 2);
    float P = 1.0f;
#pragma unroll 1
    for (int b = 0; b < 16; ++b) {
        MxRaw r3; mx_load<MIX, false, DIR>(r3, mp, c, row0, b < 13 ? b + 3 : 15);
        int ln = lane; asm volatile("" : "+v"(ln));
        mx_batch<MIX, false, DIR>(r0, mp, c, tpos0, ln, wl, b, P);
        if ((b & 7) == 7) { Gam *= P; mx_chunk<MIX, 0, false>(wl, ln, P, ST, O); P = 1.0f; }
        r0 = r1; r1 = r2; r2 = r3;
    }
}
template <int MIX>
__device__ __forceinline__ void mixA_unit(const MixP& mp, float* STG, int idx, int lane_in, LAS unsigned char* wl) {
    int lane = lane_in;
    constexpr int DK = (MIX == 2) ? 32 : 64, NRT = DK / 32;
    const int dir = idx / 2112, rem = idx - dir * 2112, bh = rem / NSEG, sg = rem - bh * NSEG, b = bh >> 2, h = bh & 3;
    asm volatile("" : "+v"(lane));
    MxC c; mx_consts<MIX>(c, mp, h, dir, lane);
    f32x16 ST[NRT][2];
#pragma unroll
    for (int rt = 0; rt < NRT; ++rt)
#pragma unroll
        for (int t = 0; t < 2; ++t)
#pragma unroll
            for (int r = 0; r < 16; ++r) ST[rt][t][r] = 0.f;
    const int row0 = seg_row0(b, sg), tpos0 = seg_tpos0(sg);
    float Gam = 1.0f;
    if (dir) mixA_stream<MIX, 1>(mp, c, row0, tpos0, lane, wl, ST, Gam); else mixA_stream<MIX, 0>(mp, c, row0, tpos0, lane, wl, ST, Gam);
    const size_t slot = (size_t)((dir * 16 + bh) * NSEG + sg);
    float* ds = STG + (MIX == 0 ? ST_DS0 : (MIX == 1 ? ST_DS1 : ST_DS2)) + slot * (DK * 64);
    const int m32 = lane & 31, hh = lane >> 5;
#pragma unroll
    for (int rt = 0; rt < NRT; ++rt)
#pragma unroll
        for (int t = 0; t < 2; ++t)
#pragma unroll
            for (int r = 0; r < 16; ++r) GST(float, ds + (32 * rt + (r & 3) + 8 * (r >> 2)) * 64 + 32 * t, 4u * (unsigned)(4 * hh * 64 + m32)) = ST[rt][t][r];
    float* gs = STG + (MIX == 0 ? ST_G0 : (MIX == 1 ? ST_G1 : ST_G2)) + slot * 64;
    GST(float, gs, 4u * (unsigned)lane) = Gam;
}
template <int MIX, int MODE>
__device__ __forceinline__ void mx_epilogue(const MixP& mp, LAS unsigned char* wl, int lane, const f32x16 (&O)[2], int rowc, float* OF, bf16* Y, int ocol, int ycol, int cgate, float nwv) {
    LAS float* ost = (LAS float*)(wl + WL_QC);
    const int m32 = lane & 31, hh = lane >> 5;
    asm volatile("" ::: "memory");
#pragma unroll
    for (int t = 0; t < 2; ++t)
#pragma unroll
        for (int r = 0; r < 16; ++r) ost[((r & 3) + 8 * (r >> 2) + 4 * hh) * 68 + 32 * t + m32] = O[t][r];
    asm volatile("" ::: "memory");
    if (MODE == 1) {
#pragma unroll 8
        for (int tk = 0; tk < 32; ++tk) GST(float, OF + (size_t)(rowc + tk) * 768 + ocol, 4u * (unsigned)lane) = ost[tk * 68 + lane];
    } else {
        float ofc[8]; unsigned short gc[8];
#pragma unroll
        for (int u = 0; u < 8; ++u) { ofc[u] = GLD(float, OF + (size_t)(rowc + u) * 768 + ocol, 4u * (unsigned)lane); gc[u] = GLD(unsigned short, mp.P + (size_t)(rowc + u) * DINP + cgate, 2u * (unsigned)lane); }
#pragma unroll 1
        for (int b8 = 0; b8 < 4; ++b8) {
            float ofn[8]; unsigned short gn[8]; const int nb = b8 < 3 ? b8 + 1 : 3;
#pragma unroll
            for (int u = 0; u < 8; ++u) { ofn[u] = GLD(float, OF + (size_t)(rowc + nb * 8 + u) * 768 + ocol, 4u * (unsigned)lane); gn[u] = GLD(unsigned short, mp.P + (size_t)(rowc + nb * 8 + u) * DINP + cgate, 2u * (unsigned)lane); }
#pragma unroll
            for (int u = 0; u < 8; ++u) {
                const int tk = b8 * 8 + u;
                const float o = ost[tk * 68 + lane] + ofc[u];
                float y;
                if (MIX == 0) { const float mean = wave_sum(o) * (1.0f / 64.0f); const float d = o - mean; y = d * __builtin_amdgcn_rsqf(wave_sum(d * d) * (1.0f / 64.0f) + NEPS) * nwv; }
                else y = o * __builtin_amdgcn_rsqf(wave_sum(o * o) * (1.0f / 64.0f) + NEPS) * nwv;
                y *= silu_f(bf2f(gc[u]));
                GST(unsigned short, Y + (size_t)(rowc + tk) * 1024 + ycol, 2u * (unsigned)lane) = (unsigned short)pkbf(y, y);
            }
#pragma unroll
            for (int u = 0; u < 8; ++u) { ofc[u] = ofn[u]; gc[u] = gn[u]; }
        }
    }
}
template <int MIX, int DIR>
__device__ __forceinline__ void mixC_stream(const MixP& mp, const MxC& c, int row0, int tpos0, int lane, LAS unsigned char* wl, f32x16 (&ST)[(MIX == 2) ? 1 : 2][2],
                                            float* OF, bf16* Y, int ocol, int ycol, int cgate, float nwv) {
    f32x16 O[2];
    MxRaw r0, r1;
    mx_load<MIX, true, DIR>(r0, mp, c, row0, 0); mx_load<MIX, true, DIR>(r1, mp, c, row0, 1);
    float P = 1.0f;
#pragma unroll 1
    for (int b = 0; b < 16; ++b) {
        MxRaw r2; mx_load<MIX, true, DIR>(r2, mp, c, row0, b < 14 ? b + 2 : 15);
        int ln = lane; asm volatile("" : "+v"(ln));
        mx_batch<MIX, true, DIR>(r0, mp, c, tpos0, ln, wl, b, P);
        if ((b & 7) == 7) {
            const int ch = DIR ? 1 - (b >> 3) : (b >> 3);
            mx_chunk<MIX, DIR, true>(wl, ln, P, ST, O); P = 1.0f;
            mx_epilogue<MIX, DIR ? 2 : 1>(mp, wl, ln, O, row0 + 32 * ch, OF, Y, ocol, ycol, cgate, nwv);
        }
        r0 = r1; r1 = r2;
    }
}
template <int MIX>
__device__ __forceinline__ void mixC_unit(const MixP& mp, const float* STG, int idx, int lane_in, float* OF, LAS unsigned char* wl, bf16* Y, const float* nw) {
    int lane = lane_in; asm volatile("" : "+v"(lane));
    constexpr int DK = (MIX == 2) ? 32 : 64, NRT = DK / 32;
    const int bh = idx / NSEG, sg = idx - bh * NSEG, b = bh >> 2, h = bh & 3;
    const int row0 = seg_row0(b, sg), tpos0 = seg_tpos0(sg);
    const int ocol = ((MIX == 0) ? 0 : (MIX == 1 ? 256 : 512)) + h * 64, ycol = ((MIX == 0) ? 0 : (MIX == 1 ? 512 : 768)) + h * 64;
    const int cgate = ((MIX == 0) ? C_RG : (MIX == 1 ? C_HG : C_GG)) + h * 64;
    const float* dsb = STG + (MIX == 0 ? ST_DS0 : (MIX == 1 ? ST_DS1 : ST_DS2));
    const float nwv = nw[h * 64 + lane];
    f32x16 ST[NRT][2];
#pragma unroll 1
    for (int dir = 0; dir < 2; ++dir) {
        asm volatile("" : "+v"(lane));
        const int m32 = lane & 31, hh = lane >> 5;
        MxC c; mx_consts<MIX>(c, mp, h, dir, lane);
        { const float* ds = dsb + (size_t)((dir * 16 + bh) * NSEG + sg) * (DK * 64);
#pragma unroll
          for (int rt = 0; rt < NRT; ++rt)
#pragma unroll
              for (int t = 0; t < 2; ++t)
#pragma unroll
                  for (int r = 0; r < 16; ++r) ST[rt][t][r] = GLD(float, ds + (32 * rt + (r & 3) + 8 * (r >> 2)) * 64 + 32 * t, 4u * (unsigned)(4 * hh * 64 + m32)); }
        if (dir == 0) mixC_stream<MIX, 0>(mp, c, row0, tpos0, lane, wl, ST, OF, Y, ocol, ycol, cgate, nwv);
        else mixC_stream<MIX, 1>(mp, c, row0, tpos0, lane, wl, ST, OF, Y, ocol, ycol, cgate, nwv);
        asm volatile("s_waitcnt vmcnt(0)" ::: "memory");
    }
}
template <int MSEL>
__device__ __forceinline__ void mix_passA(const Frame& F, const Args& a, int l) {
    const MixP mp = make_mixp(F, a, l); const S5P sp = make_s5p(F, a, l);
    float* ST = (float*)(F.ws + WS_X2);
    LAS unsigned char* wl = F.lds + F.wave * WL_BYTES; LAS float* stg = (LAS float*)wl;
    if (MSEL == 15) {
        constexpr int NMX = 3 * 4224, NS5 = 2 * 64 * NSEG;
        const int heavy = NMX - (NMX / F.NGW) * F.NGW, nlight = F.NGW - heavy;
        const int n_all = (NS5 - 4 * nlight) / F.NGW;
        for (int it = 0; ; ++it) {
            int u;
            const int nmine = NMX / F.NGW + (F.gw < heavy ? 1 : 0);
            if (it < nmine) u = F.gw + it * F.NGW;
            else if (it < nmine + n_all) u = NMX + F.gw + (it - nmine) * F.NGW;
            else { const int k2 = it - nmine - n_all; if (F.gw < heavy || k2 >= 4) {
                    const int rest0 = NMX + n_all * F.NGW + 4 * nlight; const int uu = rest0 + F.gw + (k2 - (F.gw < heavy ? 0 : 4)) * F.NGW; if (uu >= NMX + NS5) break; u = uu; }
                else u = NMX + n_all * F.NGW + (F.gw - heavy) + k2 * nlight; }
            if (u >= NMX + NS5) break;
            if (u < 4224) mixA_unit<0>(mp, ST, u, fresh_lane(), wl);
            else if (u < 2 * 4224) mixA_unit<1>(mp, ST, u - 4224, fresh_lane(), wl);
            else if (u < 3 * 4224) mixA_unit<2>(mp, ST, u - 2 * 4224, fresh_lane(), wl);
            else { const int idx = u - 3 * 4224; const int dir = idx / (64 * NSEG), rem = idx - dir * 64 * NSEG, bg = rem / NSEG, sg = rem - bg * NSEG;
                float hre = 0.f, him = 0.f;
                s5_mm<0>(sp, mp.P, bg >> 4, bg & 15, dir, sg, fresh_lane(), hre, him, nullptr, wl, nullptr);
                float* hs = ST + ST_HS + ((size_t)((dir * 64 + bg) * NSEG + sg) * 64 + fresh_lane()) * 2;
                hs[0] = hre; hs[1] = him; }
        }
        return;
    }
    if (MSEL & 1) for (int u = F.gw; u < 4224; u += F.NGW) mixA_unit<0>(mp, ST, u, fresh_lane(), wl);
    if (MSEL & 2) for (int u = F.gw; u < 4224; u += F.NGW) mixA_unit<1>(mp, ST, u, fresh_lane(), wl);
    if (MSEL & 4) for (int u = F.gw; u < 4224; u += F.NGW) mixA_unit<2>(mp, ST, u, fresh_lane(), wl);
    if (MSEL & 8) for (int idx = F.gw; idx < 2 * 64 * NSEG; idx += F.NGW) {
        const int dir = idx / (64 * NSEG), rem = idx - dir * 64 * NSEG, bg = rem / NSEG, sg = rem - bg * NSEG;
        float hre = 0.f, him = 0.f;
        s5_mm<0>(sp, mp.P, bg >> 4, bg & 15, dir, sg, fresh_lane(), hre, him, nullptr, wl, nullptr);
        float* hs = ST + ST_HS + ((size_t)((dir * 64 + bg) * NSEG + sg) * 64 + fresh_lane()) * 2;
        hs[0] = hre; hs[1] = him;
    }
}
__device__ __forceinline__ int chain_seg(int dir, int p) { return dir ? (p < 4 ? 3 - p : 135 - p) : p; }
__device__ __forceinline__ void mix_passB(const Frame& F, const Args& a, int l) {
    float* ST = (float*)(F.ws + WS_X2);
    constexpr int N0 = 131072, N1 = 131072, N2 = 65536, N3 = 8192;
    for (int e = blockIdx.x * 512 + F.tid; e < N0 + N1 + N2 + N3; e += F.G * 512) {
        if (e < N0 + N1 + N2) {
            float* base; const float* gb; int dir, esz;
            if (e < N0 + N1) { const int mix = e >= N0, e2 = e - mix * N0, c = e2 >> 12, el = e2 & 4095; dir = c >> 4; esz = 4096;
                base = ST + (mix ? ST_DS1 : ST_DS0) + (size_t)c * NSEG * 4096 + el; gb = ST + (mix ? ST_G1 : ST_G0) + (size_t)c * NSEG * 64 + (el >> 6); }
            else { const int e2 = e - N0 - N1, c = e2 >> 11, el = e2 & 2047; dir = c >> 4; esz = 2048;
                base = ST + ST_DS2 + (size_t)c * NSEG * 2048 + el; gb = ST + ST_G2 + (size_t)c * NSEG * 64 + (el >> 6); }
            float run = 0.f;
#pragma unroll 1
            for (int p0 = 0; p0 < NSEG; p0 += 12) {
                float d[12], gm[12];
#pragma unroll
                for (int q = 0; q < 12; ++q) { const int sg = chain_seg(dir, p0 + q); d[q] = base[(size_t)sg * esz]; gm[q] = gb[sg * 64]; }
#pragma unroll
                for (int q = 0; q < 12; ++q) { const int sg = chain_seg(dir, p0 + q); base[(size_t)sg * esz] = run; run = fmaf(gm[q], run, d[q]); }
            }
        } else {
            const int e2 = e - N0 - N1 - N2, c = e2 >> 6, p = e2 & 63, dir = c >> 6, g = c & 15;
            const int dg = dir * 16 + g;
            const float lre = a.in[F.zz + I_LAMRE][(size_t)l * 2048 + dg * 64 + p], lim = a.in[F.zz + I_LAMIM][(size_t)l * 2048 + dg * 64 + p], dt = expf(a.in[F.zz + I_LOGDT][l * 32 + dg]);
            const float er = expf(lre * dt * 64.0f); const float sn = sinf(lim * dt * 64.0f), cs = cosf(lim * dt * 64.0f);
            const float ar = er * cs, ai = er * sn;
            float* base = ST + ST_HS + ((size_t)c * NSEG * 64 + p) * 2;
            float rr = 0.f, ri = 0.f;
#pragma unroll 1
            for (int q0 = 0; q0 < NSEG; q0 += 12) {
                float dr[12], di[12];
#pragma unroll
                for (int q = 0; q < 12; ++q) { const int sg = chain_seg(dir, q0 + q); dr[q] = base[(size_t)sg * 128]; di[q] = base[(size_t)sg * 128 + 1]; }
#pragma unroll
                for (int q = 0; q < 12; ++q) { const int sg = chain_seg(dir, q0 + q); base[(size_t)sg * 128] = rr; base[(size_t)sg * 128 + 1] = ri;
                    const float nr = ar * rr - ai * ri + dr[q], ni = ar * ri + ai * rr + di[q]; rr = nr; ri = ni; }
            }
        }
    }
}
template <int MSEL>
__device__ __forceinline__ void mix_passC(const Frame& F, const Args& a, int l) {
    const MixP mp = make_mixp(F, a, l); const S5P sp = make_s5p(F, a, l);
    const float* ST = (const float*)(F.ws + WS_X2);
    LAS unsigned char* wl = F.lds + F.wave * WL_BYTES;
    LAS float* stg = (LAS float*)wl; LAS float* of = (LAS float*)(wl + 9216);
    float* OF = (float*)(F.ws + WS_OF);
    bf16* Y = (bf16*)(F.ws + WS_ACT); bf16* Z = (bf16*)(F.ws + WS_Z);
    const bool keep = l < DEPTH - 1;
    constexpr int NM = 16 * NSEG;
    if (MSEL == 15) {
        constexpr int NMX = 3 * NM, NS5 = 64 * NSEG;
        const int heavy = NMX - (NMX / F.NGW) * F.NGW, nlight = F.NGW - heavy;
        for (int it = 0; ; ++it) {
            int u;
            const int nmine = NMX / F.NGW + (F.gw < heavy ? 1 : 0);
            if (it < nmine) u = F.gw + it * F.NGW;
            else { if (F.gw < heavy) break; u = NMX + (F.gw - heavy) + (it - nmine) * nlight; }
            if (u >= NMX + NS5) break;
            const int sgu = (u < 3 * NM) ? (u % NSEG) : ((u - 3 * NM) % NSEG);
            if (!keep && sgu < 4) continue;
            if (u < NM) mixC_unit<0>(mp, ST, u, fresh_lane(), OF, wl, Y, a.in[F.zz + I_RETGN] + l * 256);
            else if (u < 2 * NM) mixC_unit<1>(mp, ST, u - NM, fresh_lane(), OF, wl, Y, a.in[F.zz + I_HGNW] + l * 256);
            else if (u < 3 * NM) mixC_unit<2>(mp, ST, u - 2 * NM, fresh_lane(), OF, wl, Y, a.in[F.zz + I_GLANW] + l * 256);
            else { const int idx = u - 3 * NM, bg = idx / NSEG, sg = idx - bg * NSEG;
                const float* h0 = ST + ST_HS + ((size_t)((0 * 64 + bg) * NSEG + sg) * 64 + fresh_lane()) * 2;
                float hre = h0[0], him = h0[1];
                s5_mm<1>(sp, mp.P, bg >> 4, bg & 15, 0, sg, fresh_lane(), hre, him, of, wl, Z);
                const float* h1 = ST + ST_HS + ((size_t)((1 * 64 + bg) * NSEG + sg) * 64 + fresh_lane()) * 2;
                hre = h1[0]; him = h1[1];
                s5_mm<2>(sp, mp.P, bg >> 4, bg & 15, 1, sg, fresh_lane(), hre, him, of, wl, Z); }
        }
        return;
    }
    if (MSEL & 1) for (int u = F.gw; u < NM; u += F.NGW) { if (!keep && (u % NSEG) < 4) continue; mixC_unit<0>(mp, ST, u, fresh_lane(), OF, wl, Y, a.in[F.zz + I_RETGN] + l * 256); }
    if (MSEL & 2) for (int u = F.gw; u < NM; u += F.NGW) { if (!keep && (u % NSEG) < 4) continue; mixC_unit<1>(mp, ST, u, fresh_lane(), OF, wl, Y, a.in[F.zz + I_HGNW] + l * 256); }
    if (MSEL & 4) for (int u = F.gw; u < NM; u += F.NGW) { if (!keep && (u % NSEG) < 4) continue; mixC_unit<2>(mp, ST, u, fresh_lane(), OF, wl, Y, a.in[F.zz + I_GLANW] + l * 256); }
    if (MSEL & 8) for (int idx = F.gw; idx < 64 * NSEG; idx += F.NGW) {
        const int bg = idx / NSEG, sg = idx - bg * NSEG;
        if (!keep && sg < 4) continue;
        const float* h0 = ST + ST_HS + ((size_t)((0 * 64 + bg) * NSEG + sg) * 64 + fresh_lane()) * 2;
        float hre = h0[0], him = h0[1];
        s5_mm<1>(sp, mp.P, bg >> 4, bg & 15, 0, sg, fresh_lane(), hre, him, of, wl, Z);
        const float* h1 = ST + ST_HS + ((size_t)((1 * 64 + bg) * NSEG + sg) * 64 + fresh_lane()) * 2;
        hre = h1[0]; him = h1[1];
        s5_mm<2>(sp, mp.P, bg >> 4, bg & 15, 1, sg, fresh_lane(), hre, him, of, wl, Z);
    }
}

constexpr int NPH = 11;
template <int PH_MASK, int MSEL>
__global__ void __launch_bounds__(512, 2) mk_fwd(Args a) {
    extern __shared__ __attribute__((aligned(16))) unsigned char lds_raw[];
    Frame F;
    F.lds = (LAS unsigned char*)lds_raw;
    const int wave0 = __builtin_amdgcn_readfirstlane((int)threadIdx.x >> 6);
    F.lane = fresh_lane(); F.tid = wave0 * 64 + F.lane; F.wave = wave0;
    F.G = gridDim.x; F.gw = blockIdx.x * 8 + F.wave; F.NGW = F.G * 8; F.zz = 0; F.ws = (unsigned char*)a.in[I_WS]; F.out = (float*)a.in[I_OUT];
    volatile LAS unsigned* MISC = (volatile LAS unsigned*)(F.lds + MISC_OFF);
    for (int u = F.tid; u < 64; u += 512) ((LAS unsigned*)(F.lds + MISC_OFF))[u] = 0u;
    __syncthreads();
    XcdBarrier bar; bar.bar = (unsigned*)F.ws + CW_BAR; bar.x = 0; bar.st = nullptr;
    if (a.fused) bar = xcd_barrier_post((unsigned*)F.ws + CW_BAR, MISC + 8, F.tid);
#define SEAM() do { if (a.fused) { XcdBarrier bb = bar; asm volatile("" : "+s"(bb.bar), "+s"(bb.x)); xcd_barrier(bb, wave0 * 64 + fresh_lane()); } } while (0)
#define PHASE_BEGIN() do { int zz_ = 0; asm volatile("" : "+s"(zz_)); F.zz = zz_; F.ws = (unsigned char*)a.in[I_WS + zz_]; F.out = (float*)a.in[I_OUT + zz_]; \
        const int ln_ = fresh_lane(); const int t_ = wave0 * 64 + ln_ + zz_; F.tid = t_; F.lane = t_ & 63; F.wave = wave0 + zz_; F.G = (int)gridDim.x + zz_; F.gw = ((int)blockIdx.x + zz_) * 8 + F.wave; F.NGW = F.G * 8; \
        F.lds = (LAS unsigned char*)lds_raw + zz_; } while (0)
#define IN(k) (((PH_MASK >> (k)) & 1) && a.ph_lo <= (k) && (k) < a.ph_hi)
#ifndef DUP_PH
#define DUP_PH 0
#endif
#define REP(k) for (int rep_ = 0; rep_ < (((DUP_PH >> (k)) & 1) ? 2 : 1); ++rep_)
#define hb ((float*)(F.ws + WS_HB))
#define MOD ((const float*)(F.ws + WS_MOD))
#define ACT ((bf16*)(F.ws + WS_ACT))
#define PH ((bf16*)(F.ws + WS_PH))

    if (((PH_MASK >> 12) & 1) && a.do_pro) REP(12) { PHASE_BEGIN(); prologue(F, a); SEAM(); }

#pragma unroll
    for (int l = 0; l < DEPTH; ++l) {
        if (l < a.l_lo || l >= a.l_hi) continue;
        const bool keep = l < DEPTH - 1, moe = l & 1; const int j = l >> 1;
        const int Mrows = keep ? MT : NLAT;
        if (IN(0)) for (int rep_ = 0; rep_ < ((((DUP_PH >> 0) & 1) && l != 2) ? 2 : 1); ++rep_) { PHASE_BEGIN();
            norm_phase<0>(F, a, l, 0, MT, (l == 2) ? 1 : -1);
            SEAM();
        }
        if (IN(1)) REP(1) { PHASE_BEGIN();
            pg8::Gemm g{ACT, (const bf16*)(F.ws + WS_WIN) + (size_t)l * DINP * 1024, MT, DINP, 1024}; pg8::StaticOrder S; S.init(MT, DINP, F.G, (int)blockIdx.x);
            EpiStoreBf16 E{PH, DINP, 1.0f};
            pg8::gemm_phase<EpiStoreBf16, pg8::StaticOrder, true, true>(F.lds, g, S, E, F.tid);
            SEAM();
        }
        if (IN(2)) { PHASE_BEGIN(); mix_passA<MSEL>(F, a, l); SEAM(); }
#ifdef DUP_MIX
        if (IN(2)) { PHASE_BEGIN(); mix_passA<DUP_MIX>(F, a, l); SEAM(); }
#endif
        if (IN(3)) { PHASE_BEGIN(); mix_passB(F, a, l); SEAM(); }
        if (IN(4)) { PHASE_BEGIN(); mix_passC<MSEL>(F, a, l); SEAM(); }
#ifdef DUP_MIX
        if (IN(4)) { PHASE_BEGIN(); mix_passC<DUP_MIX>(F, a, l); SEAM(); }
#endif
        if (IN(5)) REP(5) { PHASE_BEGIN();
            int k256 = 256; asm volatile("" : "+s"(k256)); pg8::Gemm g{(const bf16*)(F.ws + WS_Z), (const bf16*)(F.ws + WS_GLUW) + (size_t)l * 65536, Mrows, 256, k256}; pg8::StaticOrder S; S.init(Mrows, 256, F.G, (int)blockIdx.x);
            EpiGlu E{(const bf16*)(F.ws + WS_Z), ACT, a.in[F.zz + I_GLUB] + l * 256};
            pg8::gemm_phase<EpiGlu, pg8::StaticOrder, true, true>(F.lds, g, S, E, F.tid);
            SEAM();
        }
        if (IN(6)) { PHASE_BEGIN();
            pg8::Gemm g{ACT, (const bf16*)(F.ws + WS_WOUT) + (size_t)l * 1024 * 1024, Mrows, 1024, 1024}; pg8::StaticOrder S; S.init(Mrows, 1024, F.G, (int)blockIdx.x);
            EpiResid E{(l == 0) ? a.in[F.zz + I_X] : F.out, (l == 0) ? a.in[F.zz + I_CTX] : hb, F.out, hb, MOD + (size_t)l * 5 * 6144 + 2 * 1024, 1.0f};
            pg8::gemm_phase<EpiResid, pg8::StaticOrder, true, true>(F.lds, g, S, E, F.tid);
            SEAM();
        }
        if (IN(7)) for (int rep_ = 0; rep_ < ((((DUP_PH >> 7) & 1) && !moe) ? 2 : 1); ++rep_) { PHASE_BEGIN();
            if (moe) norm_phase<1>(F, a, l, 1, Mrows, -1); else norm_phase<0>(F, a, l, 1, Mrows, -1);
            SEAM();
        }
        if (!moe) {
            if (IN(8)) REP(8) { PHASE_BEGIN();
                pg8::Gemm g{ACT, (const bf16*)(F.ws + WS_W13D) + (size_t)j * 5632 * 1024, Mrows, 5632, 1024}; pg8::StaticOrder S; S.init(Mrows, 5632, F.G, (int)blockIdx.x);
                EpiSwiglu8 E{(unsigned char*)PH, 1.0f};
                pg8::gemm_phase<EpiSwiglu8, pg8::StaticOrder, true, true>(F.lds, g, S, E, F.tid);
                SEAM();
            }
            if (IN(9)) { PHASE_BEGIN();
                int k8 = DFF / 2; asm volatile("" : "+s"(k8)); pg8::Gemm g{PH, (const bf16*)(F.ws + WS_W2D + (size_t)j * 1024 * DFF), Mrows, 1024, k8}; pg8::StaticOrder S; S.init(Mrows, 1024, F.G, (int)blockIdx.x);
                EpiResid E{F.out, hb, F.out, hb, MOD + (size_t)l * 5 * 6144 + 5 * 1024, 1.0f / WSC8};
                pg8::gemm_phase_f8<EpiResid, pg8::StaticOrder, true, true>(F.lds, g, S, E, F.tid);
                { const int rem = ((Mrows / 256) * 4) % F.G; if (rem > 0 && (int)blockIdx.x >= rem) moe_cvt_idle(F, a, j, rem); else if (rem == 0) moe_cvt(F, a, j); }
                SEAM();
            }
        } else {
                        if (IN(8)) REP(8) { PHASE_BEGIN(); moe_gather(F, j); SEAM(); }
            if (IN(9)) REP(9) { PHASE_BEGIN();
                int k8 = 512; asm volatile("" : "+s"(k8)); pg8::Gemm g{(const bf16*)(F.ws + WS_X2), (const bf16*)(F.ws + WS_W13M), 0, 5632, k8}; MoeOrder S; S.init((const unsigned*)F.ws + CW_CNT + j * 8 * 64, 22, F.G, (int)blockIdx.x);
                EpiSwiglu8 E{(unsigned char*)PH, 1.0f / WSC8};
                pg8::gemm_phase_f8<EpiSwiglu8, MoeOrder, true, true>(F.lds, g, S, E, F.tid);
                SEAM();
            }
            if (IN(10)) REP(10) { PHASE_BEGIN();
                int k8 = DFF / 2; asm volatile("" : "+s"(k8)); pg8::Gemm g{PH, (const bf16*)(F.ws + WS_W2M), 0, 1024, k8}; MoeOrder S; S.init((const unsigned*)F.ws + CW_CNT + j * 8 * 64, 4, F.G, (int)blockIdx.x);
                EpiStoreBf16 E{(bf16*)(F.ws + WS_X2), 1024, 1.0f / WSC8};
                pg8::gemm_phase_f8<EpiStoreBf16, MoeOrder, true, true>(F.lds, g, S, E, F.tid);
                SEAM();
            }
        }
    }
    if (((PH_MASK >> 13) & 1) && a.do_fin) { PHASE_BEGIN(); norm_phase<2>(F, a, DEPTH - 1, 0, NLAT, DEPTH - 1); }
#undef SEAM
#undef IN
#undef hb
#undef MOD
#undef ACT
#undef PH
}

#ifndef MK_FUSED
#define MK_FUSED 1
#endif
template <int PM, int MS> static void launch_one(const Args& a, int grid, hipStream_t stream) {
    static bool attr_done = false;
    if (!attr_done) { (void)hipFuncSetAttribute((const void*)mk_fwd<PM, MS>, hipFuncAttributeMaxDynamicSharedMemorySize, LDS_BYTES); attr_done = true; }
    hipLaunchKernelGGL((mk_fwd<PM, MS>), dim3(grid), dim3(512), LDS_BYTES, stream, a);
}
extern "C" void kernel_launch(void* const* d_in, const int* in_sizes, int n_in, void* d_out, int out_size, void* d_ws, size_t ws_size, hipStream_t stream) {
    static int grid = 0;
    if (grid == 0) {
        if (n_in != 35 || in_sizes[0] != NLAT * DM || out_size != NLAT * DM || ws_size < WS_END) {
            fprintf(stderr, "kernel_launch: unexpected shapes / workspace (n_in %d, ws %zu, need %zu); nothing launched\n", n_in, ws_size, (size_t)WS_END); grid = -1; return; }
        int dev = 0, cus = 0;
        if (hipGetDevice(&dev) != hipSuccess || hipDeviceGetAttribute(&cus, hipDeviceAttributeMultiprocessorCount, dev) != hipSuccess) { grid = -1; return; }
        grid = cus;
    }
    if (grid < 0) return;
    (void)hipMemsetAsync((char*)d_ws + WS_CTL, 0, CTL_ZERO_BYTES, stream);
    Args a{};
    for (int i = 0; i < 35; ++i) a.in[i] = (const float*)d_in[i];
    a.in[I_OUT] = (const float*)d_out; a.in[I_WS] = (const float*)d_ws; a.pad = 0;
#if MK_FUSED
    a.l_lo = 0; a.l_hi = DEPTH; a.ph_lo = 0; a.ph_hi = NPH; a.do_pro = 1; a.do_fin = 1; a.fused = 1;
#ifndef TEST_PM
#define TEST_PM 0xFFFF
#endif
#ifndef TEST_MS
#define TEST_MS 15
#endif
    launch_one<TEST_PM, TEST_MS>(a, grid, stream);
#else
    a.fused = 0;
    a.l_lo = 0; a.l_hi = 0; a.ph_lo = 0; a.ph_hi = 0; a.do_pro = 1; a.do_fin = 0;
    launch_one<0x1000, 15>(a, grid, stream);
    a.do_pro = 0;
    for (int l = 0; l < DEPTH; ++l) {
        a.l_lo = l; a.l_hi = l + 1; a.ph_lo = 0; a.ph_hi = NPH;
        launch_one<0x1, 15>(a, grid, stream); launch_one<0x2, 15>(a, grid, stream); launch_one<0x4, 15>(a, grid, stream); launch_one<0x8, 15>(a, grid, stream);
        launch_one<0x10, 1>(a, grid, stream); launch_one<0x10, 2>(a, grid, stream); launch_one<0x10, 4>(a, grid, stream); launch_one<0x10, 8>(a, grid, stream);
        launch_one<0x20, 15>(a, grid, stream); launch_one<0x40, 15>(a, grid, stream); launch_one<0x80, 15>(a, grid, stream);
        launch_one<0x100, 15>(a, grid, stream); launch_one<0x200, 15>(a, grid, stream);
        if (l & 1) launch_one<0x400, 15>(a, grid, stream);
    }
    a.l_lo = 0; a.l_hi = 0; a.ph_lo = 0; a.ph_hi = 0; a.do_fin = 1;
    launch_one<0x2000, 15>(a, grid, stream);
#endif
}
```

```cpp
#include <hip/hip_runtime.h>
#include <cstdio>
#include <cstdint>
#define LAS __attribute__((address_space(3)))
namespace pg8 {
#define PG8_LAS __attribute__((address_space(3)))
typedef unsigned short bf16_t;
typedef short bf16x8 __attribute__((ext_vector_type(8)));
typedef float f32x4 __attribute__((ext_vector_type(4)));
typedef unsigned u32x4 __attribute__((ext_vector_type(4)));
constexpr int BM = 256, BK = 64, HALF = 128, HTB = HALF * BK * 2  , STAGE_BYTES = 8 * HTB, NXCD = 8, WGM = 8;

__host__ __device__ __forceinline__ int lds_byte(int r, int c) { const int st = (r >> 4) * 2 + (c >> 5), rr = r & 15, cc = c & 31, ob = rr * 64 + cc * 2; return st * 1024 + (ob ^ (((ob >> 9) & 1) << 5)); }
__host__ __device__ __forceinline__ void stage_rc(int b, int& R, int& C) { const int st = b / 1024, sb = b % 1024, swz = sb ^ (((sb >> 9) & 1) << 5); R = (st >> 1) * 16 + swz / 64; C = (st & 1) * 32 + (swz % 64) / 2; }
__host__ __device__ __forceinline__ int perm32(int rho) { const int n = rho >> 4, i = rho & 15; return 8 * (i >> 2) + 4 * n + (i & 3); }

__host__ __device__ __forceinline__ int perm32f(int rho) { return 2 * (rho & 15) + (rho >> 4); }
template <class E, class = void> struct epi_flip { static constexpr bool v = false; };
template <class E> struct epi_flip<E, decltype((void)E::FLIP)> { static constexpr bool v = E::FLIP; };
struct Unit { int pm, pn, pc; };
struct Gemm { const bf16_t* A; const bf16_t* Bt; int M, N, K; };

struct StaticOrder {
    int nM, nN, nwg, G, c;
    __host__ __device__ void init(int M, int N, int G_, int c_) { nM = M / BM; nN = N / BM; nwg = nM * nN; G = G_; c = c_; }
    __host__ __device__ bool next(int i, Unit& u) const {
        const long L = (long)i * G + c; if (L >= nwg) return false;
        int wgid = (int)L; { const int q = nwg / NXCD, r = nwg % NXCD, xcd = wgid % NXCD, off = wgid / NXCD; wgid = (xcd < r ? xcd * (q + 1) : r * (q + 1) + (xcd - r) * q) + off; }
        const int nig = WGM * nN, gid = wgid / nig, fm = gid * WGM, gsz = (nM - fm) < WGM ? (nM - fm) : WGM;
        u.pm = fm + ((wgid % nig) % gsz); u.pn = (wgid % nig) / gsz; u.pc = u.pn; return true;
    }
    __device__ __forceinline__ void a_ready(const Unit&) const {}
    __device__ __forceinline__ void done(const Unit&) const {}
};

__device__ __forceinline__ unsigned cvt_pk_bf16(float lo, float hi) { unsigned r; asm volatile("v_cvt_pk_bf16_f32 %0, %1, %2" : "=v"(r) : "v"(lo), "v"(hi)); return r; }
typedef float f32x2 __attribute__((ext_vector_type(2)));

template <class Epi, class Sched, bool ALIGN_EPI = false, bool SP2 = false>
__device__ __forceinline__ void gemm_phase(PG8_LAS unsigned char* lds, const Gemm g, const Sched& S, const Epi& E, const int tid) {
    const int wid = __builtin_amdgcn_readfirstlane(tid >> 6), lane = tid & 63, wr = wid >> 2, wc = wid & 3, fr = lane & 15, fq = lane >> 4;
    const int K = g.K, nt = K / BK;
    unsigned voffA[2], voffB[2];
#pragma unroll
    for (int i = 0; i < 2; ++i) { int R, C; stage_rc(tid * 16 + i * 8192, R, C); const int Rb = epi_flip<Epi>::v ? ((R & ~31) + perm32f(R & 31)) : (Epi::PERM ? ((R & ~31) + perm32(R & 31)) : R);
        voffA[i] = (unsigned)(R * K + C) * 2u; voffB[i] = (unsigned)(Rb * K + C) * 2u; }
    const size_t kstep = (size_t)(BK * 2);
    const size_t hstep = (size_t)HALF * K * 2;
    const size_t tstep = 2 * hstep;
    const unsigned ldsw = (unsigned)wid * 1024u;
    const int aoff = lds_byte(wr * 64 + fr, fq * 8), boff = lds_byte(wc * 32 + fr, fq * 8);
#define PG8_SA(b, h) (((b) * 2 + (h)) * HTB)
#define PG8_SB(b, h) ((4 + (b) * 2 + (h)) * HTB)
#define PG8_STAGE(bufoff, gbase, voff) do { _Pragma("unroll") for (int _i = 0; _i < 2; ++_i) \
        __builtin_amdgcn_global_load_lds((const unsigned*)((const char*)(gbase) + (voff)[_i]), (PG8_LAS unsigned*)(lds + (bufoff) + ldsw + _i * 8192), 16, 0, 0); } while (0)
#define PG8_LDA(dst, b, h) do { _Pragma("unroll") for (int m = 0; m < 4; ++m) _Pragma("unroll") for (int k = 0; k < 2; ++k) dst[m][k] = *(const PG8_LAS bf16x8*)(lds + PG8_SA(b, h) + aoff + m * 2048 + k * 1024); } while (0)
#define PG8_LDB(dst, b, h) do { _Pragma("unroll") for (int n = 0; n < 2; ++n) _Pragma("unroll") for (int k = 0; k < 2; ++k) dst[n][k] = *(const PG8_LAS bf16x8*)(lds + PG8_SB(b, h) + boff + n * 2048 + k * 1024); } while (0)
#define PG8_MMA(ai, bj, At, Bt) do { __builtin_amdgcn_s_setprio(1); _Pragma("unroll") for (int m = 0; m < 4; ++m) _Pragma("unroll") for (int n = 0; n < 2; ++n) _Pragma("unroll") for (int k = 0; k < 2; ++k) \
        { if constexpr (epi_flip<Epi>::v) acc[ai][bj][m][n] = __builtin_amdgcn_mfma_f32_16x16x32_bf16(At[m][k], Bt[n][k], acc[ai][bj][m][n], 0, 0, 0); \
          else acc[ai][bj][m][n] = __builtin_amdgcn_mfma_f32_16x16x32_bf16(Bt[n][k], At[m][k], acc[ai][bj][m][n], 0, 0, 0); } __builtin_amdgcn_s_setprio(0); } while (0)
#define PG8_WAIT_V(n) asm volatile("s_waitcnt vmcnt(" #n ")" ::: "memory")
#define PG8_WAIT_L(n) asm volatile("s_waitcnt lgkmcnt(" #n ")" ::: "memory")
#define PG8_BAR __builtin_amdgcn_s_barrier()
#define PG8_SCHED __builtin_amdgcn_sched_barrier(0)
    Unit cur, nxt; int ui = 0;
    if (!S.next(0, cur)) return;
    f32x4 acc[2][2][4][2];
#pragma unroll
    for (int a = 0; a < 2; ++a)
#pragma unroll
        for (int b = 0; b < 2; ++b)
#pragma unroll
            for (int m = 0; m < 4; ++m)
#pragma unroll
                for (int n = 0; n < 2; ++n) acc[a][b][m][n] = (f32x4){0.f, 0.f, 0.f, 0.f};
    bf16x8 At[4][2], B0[2][2], B1[2][2];
    const char* cA = (const char*)g.A + (size_t)cur.pm * tstep; const char* cB = (const char*)g.Bt + (size_t)cur.pn * tstep;
    S.a_ready(cur);
    if constexpr (SP2) {
        PG8_STAGE(PG8_SB(0, 0), cB, voffB); PG8_STAGE(PG8_SB(0, 1), cB + hstep, voffB); PG8_STAGE(PG8_SA(0, 0), cA, voffA); PG8_STAGE(PG8_SA(0, 1), cA + hstep, voffA);
        if (wr == 1) PG8_BAR;
        PG8_WAIT_V(2); PG8_BAR;
        PG8_STAGE(PG8_SB(1, 0), cB + kstep, voffB); PG8_STAGE(PG8_SA(1, 0), cA + kstep, voffA); PG8_STAGE(PG8_SB(1, 1), cB + hstep + kstep, voffB);
        PG8_WAIT_V(6); PG8_BAR;
    } else {
        PG8_STAGE(PG8_SB(0, 0), cB, voffB); PG8_STAGE(PG8_SA(0, 0), cA, voffA); PG8_STAGE(PG8_SB(0, 1), cB + hstep, voffB); PG8_STAGE(PG8_SA(0, 1), cA + hstep, voffA);
        if (wr == 1) PG8_BAR;
        PG8_WAIT_V(4); PG8_BAR;
        PG8_STAGE(PG8_SB(1, 0), cB + kstep, voffB); PG8_STAGE(PG8_SA(1, 0), cA + kstep, voffA); PG8_STAGE(PG8_SB(1, 1), cB + hstep + kstep, voffB);
        PG8_WAIT_V(6); PG8_BAR;
    }
    for (;;) {
        const bool has_next = S.next(ui + 1, nxt);
        const char* nA = has_next ? (const char*)g.A + (size_t)nxt.pm * tstep : cA; const char* nB = has_next ? (const char*)g.Bt + (size_t)nxt.pn * tstep : cB;
        for (int t = 0; t < nt; t += 2) {
            const bool last = (t == nt - 2);
            const char* a1 = cA + (size_t)(t + 1) * kstep;
            const char* a2 = last ? nA : cA + (size_t)(t + 2) * kstep; const char* b2 = last ? nB : cB + (size_t)(t + 2) * kstep;
            const char* a3 = a2 + kstep; const char* b3 = b2 + kstep;
            if (last && has_next) S.a_ready(nxt);
            if constexpr (SP2) {
            PG8_LDB(B0, 0, 0); PG8_LDB(B1, 0, 1); PG8_SCHED; PG8_LDA(At, 0, 0); PG8_STAGE(PG8_SA(1, 1), a1 + hstep, voffA);
            PG8_WAIT_V(8); PG8_WAIT_L(0); PG8_BAR; PG8_MMA(0, 0, At, B0); PG8_MMA(0, 1, At, B1); PG8_BAR; PG8_SCHED;
            PG8_LDA(At, 0, 1); PG8_STAGE(PG8_SB(0, 0), b2, voffB); PG8_STAGE(PG8_SB(0, 1), b2 + hstep, voffB); PG8_STAGE(PG8_SA(0, 0), a2, voffA);
            PG8_WAIT_V(8); PG8_WAIT_L(0); PG8_BAR; PG8_MMA(1, 0, At, B0); PG8_MMA(1, 1, At, B1); PG8_BAR; PG8_SCHED;
            PG8_LDB(B0, 1, 0); PG8_LDB(B1, 1, 1); PG8_SCHED; PG8_LDA(At, 1, 0); PG8_STAGE(PG8_SA(0, 1), a2 + hstep, voffA);
            PG8_WAIT_V(8); PG8_WAIT_L(0); PG8_BAR; PG8_MMA(0, 0, At, B0); PG8_MMA(0, 1, At, B1); PG8_BAR; PG8_SCHED;
            PG8_LDA(At, 1, 1); PG8_STAGE(PG8_SB(1, 0), b3, voffB); PG8_STAGE(PG8_SB(1, 1), b3 + hstep, voffB); PG8_STAGE(PG8_SA(1, 0), a3, voffA);
            PG8_WAIT_V(8); PG8_WAIT_L(0); PG8_BAR; PG8_MMA(1, 0, At, B0); PG8_MMA(1, 1, At, B1); PG8_BAR; PG8_SCHED;
            } else {
            PG8_LDB(B0, 0, 0); PG8_SCHED; PG8_LDA(At, 0, 0); PG8_STAGE(PG8_SA(1, 1), a1 + hstep, voffA);
            PG8_WAIT_L(8); PG8_BAR; PG8_WAIT_L(0); PG8_MMA(0, 0, At, B0); PG8_BAR; PG8_SCHED;
            PG8_LDB(B1, 0, 1); PG8_STAGE(PG8_SB(0, 0), b2, voffB);
            PG8_BAR; PG8_WAIT_L(0); PG8_MMA(0, 1, At, B1); PG8_BAR;
            PG8_LDA(At, 0, 1); PG8_STAGE(PG8_SA(0, 0), a2, voffA);
            PG8_BAR; PG8_WAIT_L(0); PG8_MMA(1, 0, At, B0); PG8_BAR; PG8_SCHED;
            PG8_STAGE(PG8_SB(0, 1), b2 + hstep, voffB);
            PG8_WAIT_V(6); PG8_BAR; PG8_MMA(1, 1, At, B1); PG8_BAR;
            PG8_LDB(B0, 1, 0); PG8_SCHED; PG8_LDA(At, 1, 0); PG8_STAGE(PG8_SA(0, 1), a2 + hstep, voffA);
            PG8_WAIT_L(8); PG8_BAR; PG8_WAIT_L(0); PG8_MMA(0, 0, At, B0); PG8_BAR; PG8_SCHED;
            PG8_LDB(B1, 1, 1); PG8_STAGE(PG8_SB(1, 0), b3, voffB);
            PG8_BAR; PG8_WAIT_L(0); PG8_MMA(0, 1, At, B1); PG8_BAR;
            PG8_LDA(At, 1, 1); PG8_STAGE(PG8_SA(1, 0), a3, voffA);
            PG8_BAR; PG8_WAIT_L(0); PG8_MMA(1, 0, At, B0); PG8_BAR; PG8_SCHED;
            PG8_STAGE(PG8_SB(1, 1), b3 + hstep, voffB);
            PG8_WAIT_V(6); PG8_BAR; PG8_MMA(1, 1, At, B1); PG8_BAR;
            }
        }
        if constexpr (ALIGN_EPI) { if (wr == 0) PG8_BAR; }
        if constexpr (!Epi::AFTER_DRAIN) { E(acc, cur, wr, wc, fr, fq); S.done(cur); }
        if (!has_next) break;
#pragma unroll
        for (int a = 0; a < 2; ++a)
#pragma unroll
            for (int b = 0; b < 2; ++b)
#pragma unroll
                for (int m = 0; m < 4; ++m)
#pragma unroll
                    for (int n = 0; n < 2; ++n) acc[a][b][m][n] = (f32x4){0.f, 0.f, 0.f, 0.f};
        cur = nxt; cA = nA; cB = nB; ++ui;
        if constexpr (ALIGN_EPI) { if (wr == 1) PG8_BAR; }
    }
    PG8_WAIT_V(0);
    if constexpr (!ALIGN_EPI) { if (wr == 0) PG8_BAR; }
    PG8_BAR;
    if constexpr (Epi::AFTER_DRAIN) { E.fused(acc, cur, wr, wc, fr, fq, lds, wid, lane); S.done(cur); }
#undef PG8_SA
#undef PG8_SB
#undef PG8_STAGE
#undef PG8_LDA
#undef PG8_LDB
#undef PG8_MMA
#undef PG8_WAIT_V
#undef PG8_WAIT_L
#undef PG8_BAR
#undef PG8_SCHED
}
typedef int v8i_t __attribute__((ext_vector_type(8)));
typedef int v4i_t __attribute__((ext_vector_type(4)));
template <class Epi, class Sched, bool ALIGN_EPI = false, bool SP2 = false>
__device__ __forceinline__ void gemm_phase_f8(PG8_LAS unsigned char* lds, const Gemm g, const Sched& S, const Epi& E, const int tid) {
    const int wid = __builtin_amdgcn_readfirstlane(tid >> 6), lane = tid & 63, wr = wid >> 2, wc = wid & 3, fr = lane & 15, fq = lane >> 4;
    const int K = g.K, nt = K / BK;
    unsigned voffA[2], voffB[2];
#pragma unroll
    for (int i = 0; i < 2; ++i) { int R, C; stage_rc(tid * 16 + i * 8192, R, C); const int Rb = Epi::PERM ? ((R & ~31) + perm32(R & 31)) : R;
        voffA[i] = (unsigned)(R * K + C) * 2u; voffB[i] = (unsigned)(Rb * K + C) * 2u; }
    const size_t kstep = (size_t)(BK * 2);
    const size_t hstep = (size_t)HALF * K * 2;
    const size_t tstep = 2 * hstep;
    const unsigned ldsw = (unsigned)wid * 1024u;
    const int aoff0 = lds_byte(wr * 64 + fr, fq * 16), aoff1 = lds_byte(wr * 64 + fr, fq * 16 + 8), boff0 = lds_byte(wc * 32 + fr, fq * 16), boff1 = lds_byte(wc * 32 + fr, fq * 16 + 8);
#define PG8_SA(b, h) (((b) * 2 + (h)) * HTB)
#define PG8_SB(b, h) ((4 + (b) * 2 + (h)) * HTB)
#define PG8_STAGE(bufoff, gbase, voff) do { _Pragma("unroll") for (int _i = 0; _i < 2; ++_i) \
        __builtin_amdgcn_global_load_lds((const unsigned*)((const char*)(gbase) + (voff)[_i]), (PG8_LAS unsigned*)(lds + (bufoff) + ldsw + _i * 8192), 16, 0, 0); } while (0)
#define PG8_LDA(dst, b, h) do { _Pragma("unroll") for (int m = 0; m < 4; ++m) { const u32x4 lo_ = *(const PG8_LAS u32x4*)(lds + PG8_SA(b, h) + aoff0 + m * 2048), hi_ = *(const PG8_LAS u32x4*)(lds + PG8_SA(b, h) + aoff1 + m * 2048); \
        dst[m] = __builtin_shufflevector((v4i_t)lo_, (v4i_t)hi_, 0, 1, 2, 3, 4, 5, 6, 7); } } while (0)
#define PG8_LDB(dst, b, h) do { _Pragma("unroll") for (int n = 0; n < 2; ++n) { const u32x4 lo_ = *(const PG8_LAS u32x4*)(lds + PG8_SB(b, h) + boff0 + n * 2048), hi_ = *(const PG8_LAS u32x4*)(lds + PG8_SB(b, h) + boff1 + n * 2048); \
        dst[n] = __builtin_shufflevector((v4i_t)lo_, (v4i_t)hi_, 0, 1, 2, 3, 4, 5, 6, 7); } } while (0)
#define PG8_MMA(ai, bj, At, Bt) do { __builtin_amdgcn_s_setprio(1); _Pragma("unroll") for (int m = 0; m < 4; ++m) _Pragma("unroll") for (int n = 0; n < 2; ++n) \
        asm volatile("v_mfma_scale_f32_16x16x128_f8f6f4 %0, %1, %2, %0, %3, %3 op_sel_hi:[0,0,0]" : "+v"(acc[ai][bj][m][n]) : "v"(Bt[n]), "v"(At[m]), "v"(one_scale)); __builtin_amdgcn_s_setprio(0); } while (0)
#define PG8_WAIT_V(n) asm volatile("s_waitcnt vmcnt(" #n ")" ::: "memory")
#define PG8_WAIT_L(n) asm volatile("s_waitcnt lgkmcnt(" #n ")" ::: "memory")
#define PG8_BAR __builtin_amdgcn_s_barrier()
#define PG8_SCHED __builtin_amdgcn_sched_barrier(0)
    Unit cur, nxt; int ui = 0;
    if (!S.next(0, cur)) return;
    f32x4 acc[2][2][4][2];
#pragma unroll
    for (int a = 0; a < 2; ++a)
#pragma unroll
        for (int b = 0; b < 2; ++b)
#pragma unroll
            for (int m = 0; m < 4; ++m)
#pragma unroll
                for (int n = 0; n < 2; ++n) acc[a][b][m][n] = (f32x4){0.f, 0.f, 0.f, 0.f};
    v8i_t At[4], B0[2], B1[2]; const int one_scale = 0x7f7f7f7f;
    const char* cA = (const char*)g.A + (size_t)cur.pm * tstep; const char* cB = (const char*)g.Bt + (size_t)cur.pn * tstep;
    S.a_ready(cur);
    if constexpr (SP2) {
        PG8_STAGE(PG8_SB(0, 0), cB, voffB); PG8_STAGE(PG8_SB(0, 1), cB + hstep, voffB); PG8_STAGE(PG8_SA(0, 0), cA, voffA); PG8_STAGE(PG8_SA(0, 1), cA + hstep, voffA);
        if (wr == 1) PG8_BAR;
        PG8_WAIT_V(2); PG8_BAR;
        PG8_STAGE(PG8_SB(1, 0), cB + kstep, voffB); PG8_STAGE(PG8_SA(1, 0), cA + kstep, voffA); PG8_STAGE(PG8_SB(1, 1), cB + hstep + kstep, voffB);
        PG8_WAIT_V(6); PG8_BAR;
    } else {
        PG8_STAGE(PG8_SB(0, 0), cB, voffB); PG8_STAGE(PG8_SA(0, 0), cA, voffA); PG8_STAGE(PG8_SB(0, 1), cB + hstep, voffB); PG8_STAGE(PG8_SA(0, 1), cA + hstep, voffA);
        if (wr == 1) PG8_BAR;
        PG8_WAIT_V(4); PG8_BAR;
        PG8_STAGE(PG8_SB(1, 0), cB + kstep, voffB); PG8_STAGE(PG8_SA(1, 0), cA + kstep, voffA); PG8_STAGE(PG8_SB(1, 1), cB + hstep + kstep, voffB);
        PG8_WAIT_V(6); PG8_BAR;
    }
    for (;;) {
        const bool has_next = S.next(ui + 1, nxt);
        const char* nA = has_next ? (const char*)g.A + (size_t)nxt.pm * tstep : cA; const char* nB = has_next ? (const char*)g.Bt + (size_t)nxt.pn * tstep : cB;
        for (int t = 0; t < nt; t += 2) {
            const bool last = (t == nt - 2);
            const char* a1 = cA + (size_t)(t + 1) * kstep;
            const char* a2 = last ? nA : cA + (size_t)(t + 2) * kstep; const char* b2 = last ? nB : cB + (size_t)(t + 2) * kstep;
            const char* a3 = a2 + kstep; const char* b3 = b2 + kstep;
            if (last && has_next) S.a_ready(nxt);
            if constexpr (SP2) {
            PG8_LDB(B0, 0, 0); PG8_LDB(B1, 0, 1); PG8_SCHED; PG8_LDA(At, 0, 0); PG8_STAGE(PG8_SA(1, 1), a1 + hstep, voffA);
            PG8_WAIT_V(8); PG8_WAIT_L(0); PG8_BAR; PG8_MMA(0, 0, At, B0); PG8_MMA(0, 1, At, B1); PG8_BAR; PG8_SCHED;
            PG8_LDA(At, 0, 1); PG8_STAGE(PG8_SB(0, 0), b2, voffB); PG8_STAGE(PG8_SB(0, 1), b2 + hstep, voffB); PG8_STAGE(PG8_SA(0, 0), a2, voffA);
            PG8_WAIT_V(8); PG8_WAIT_L(0); PG8_BAR; PG8_MMA(1, 0, At, B0); PG8_MMA(1, 1, At, B1); PG8_BAR; PG8_SCHED;
            PG8_LDB(B0, 1, 0); PG8_LDB(B1, 1, 1); PG8_SCHED; PG8_LDA(At, 1, 0); PG8_STAGE(PG8_SA(0, 1), a2 + hstep, voffA);
            PG8_WAIT_V(8); PG8_WAIT_L(0); PG8_BAR; PG8_MMA(0, 0, At, B0); PG8_MMA(0, 1, At, B1); PG8_BAR; PG8_SCHED;
            PG8_LDA(At, 1, 1); PG8_STAGE(PG8_SB(1, 0), b3, voffB); PG8_STAGE(PG8_SB(1, 1), b3 + hstep, voffB); PG8_STAGE(PG8_SA(1, 0), a3, voffA);
            PG8_WAIT_V(8); PG8_WAIT_L(0); PG8_BAR; PG8_MMA(1, 0, At, B0); PG8_MMA(1, 1, At, B1); PG8_BAR; PG8_SCHED;
            } else {
            PG8_LDB(B0, 0, 0); PG8_SCHED; PG8_LDA(At, 0, 0); PG8_STAGE(PG8_SA(1, 1), a1 + hstep, voffA);
            PG8_WAIT_L(8); PG8_BAR; PG8_WAIT_L(0); PG8_MMA(0, 0, At, B0); PG8_BAR; PG8_SCHED;
            PG8_LDB(B1, 0, 1); PG8_STAGE(PG8_SB(0, 0), b2, voffB);
            PG8_BAR; PG8_WAIT_L(0); PG8_MMA(0, 1, At, B1); PG8_BAR;
            PG8_LDA(At, 0, 1); PG8_STAGE(PG8_SA(0, 0), a2, voffA);
            PG8_BAR; PG8_WAIT_L(0); PG8_MMA(1, 0, At, B0); PG8_BAR; PG8_SCHED;
            PG8_STAGE(PG8_SB(0, 1), b2 + hstep, voffB);
            PG8_WAIT_V(6); PG8_BAR; PG8_MMA(1, 1, At, B1); PG8_BAR;
            PG8_LDB(B0, 1, 0); PG8_SCHED; PG8_LDA(At, 1, 0); PG8_STAGE(PG8_SA(0, 1), a2 + hstep, voffA);
            PG8_WAIT_L(8); PG8_BAR; PG8_WAIT_L(0); PG8_MMA(0, 0, At, B0); PG8_BAR; PG8_SCHED;
            PG8_LDB(B1, 1, 1); PG8_STAGE(PG8_SB(1, 0), b3, voffB);
            PG8_BAR; PG8_WAIT_L(0); PG8_MMA(0, 1, At, B1); PG8_BAR;
            PG8_LDA(At, 1, 1); PG8_STAGE(PG8_SA(1, 0), a3, voffA);
            PG8_BAR; PG8_WAIT_L(0); PG8_MMA(1, 0, At, B0); PG8_BAR; PG8_SCHED;
            PG8_STAGE(PG8_SB(1, 1), b3 + hstep, voffB);
            PG8_WAIT_V(6); PG8_BAR; PG8_MMA(1, 1, At, B1); PG8_BAR;
            }
        }
        if constexpr (ALIGN_EPI) { if (wr == 0) PG8_BAR; }
        asm volatile("s_nop 15\n\ts_nop 15" ::: "memory");
        if constexpr (!Epi::AFTER_DRAIN) { E(acc, cur, wr, wc, fr, fq); S.done(cur); }
        if (!has_next) break;
#pragma unroll
        for (int a = 0; a < 2; ++a)
#pragma unroll
            for (int b = 0; b < 2; ++b)
#pragma unroll
                for (int m = 0; m < 4; ++m)
#pragma unroll
                    for (int n = 0; n < 2; ++n) acc[a][b][m][n] = (f32x4){0.f, 0.f, 0.f, 0.f};
        cur = nxt; cA = nA; cB = nB; ++ui;
        if constexpr (ALIGN_EPI) { if (wr == 1) PG8_BAR; }
    }
    PG8_WAIT_V(0);
    if constexpr (!ALIGN_EPI) { if (wr == 0) PG8_BAR; }
    PG8_BAR;
    if constexpr (Epi::AFTER_DRAIN) { E.fused(acc, cur, wr, wc, fr, fq, lds, wid, lane); S.done(cur); }
#undef PG8_SA
#undef PG8_SB
#undef PG8_STAGE
#undef PG8_LDA
#undef PG8_LDB
#undef PG8_MMA
#undef PG8_WAIT_V
#undef PG8_WAIT_L
#undef PG8_BAR
#undef PG8_SCHED
}
}

#define XB_TMO      128
#define XB_XCNT(j)  (256  + 64 * (j))
#define XB_XSUB(j)  (1280 + 64 * (j))
#define XB_XGEN(j)  (2304 + 64 * (j))
#define XB_TOP      3328
#define XB_TOPGEN   3392
#define XCD_BAR_WORDS 3456
#define XB_SPIN_CAP (1u << 18)

__device__ __forceinline__ unsigned xb_ld(unsigned* p)              { return __hip_atomic_load(p, __ATOMIC_RELAXED, __HIP_MEMORY_SCOPE_AGENT); }
__device__ __forceinline__ unsigned xb_add(unsigned* p, unsigned v) { return __hip_atomic_fetch_add(p, v, __ATOMIC_RELAXED, __HIP_MEMORY_SCOPE_AGENT); }
__device__ __forceinline__ unsigned xb_xcc_id() { return (unsigned)__builtin_amdgcn_s_getreg((3 << 11) | 20) & 0xFu; }
#define XB_SPIN(cond, bar) do { unsigned _sp = 0; while (cond) { __builtin_amdgcn_s_sleep(1); \
    if ((++_sp & 255u) == 0u) { if (xb_ld(&(bar)[XB_TMO])) break; if (_sp > XB_SPIN_CAP) { atomicAdd(&(bar)[XB_TMO], 1u); break; } } } } while (0)

struct XcdBarrier {
    unsigned* bar; unsigned x;
    volatile LAS unsigned* st;
};

__device__ __forceinline__ XcdBarrier xcd_barrier_post(unsigned* bar, volatile LAS unsigned* st, const int xb_tid) {
    XcdBarrier b; b.bar = bar; b.x = xb_xcc_id(); b.st = st;
    if (xb_tid == 0) (void)xb_add(&bar[XB_XCNT(b.x)], 1u);
    return b;
}
__device__ __forceinline__ void xcd_barrier_complete(unsigned* bar, unsigned x, unsigned& nloc, unsigned& nx) {
    const unsigned G = gridDim.x * gridDim.y * gridDim.z;
    unsigned sum, cnt, mine, sp = 0u;
    for (;;) {
        sum = 0u; cnt = 0u; mine = 0u;
#pragma unroll
        for (unsigned j = 0; j < 16; ++j) { const unsigned c = xb_ld(&bar[XB_XCNT(j)]); sum += c; cnt += (c > 0u) ? 1u : 0u; mine = (j == x) ? c : mine; }
        if (sum == G) break;
        __builtin_amdgcn_s_sleep(1);
        if ((++sp & 255u) == 0u) { if (xb_ld(&bar[XB_TMO])) break; if (sp > XB_SPIN_CAP) { atomicAdd(&bar[XB_TMO], 1u); break; } }
    }
    nloc = mine > 0u ? mine : 1u; nx = cnt > 0u ? cnt : 1u;
}

__device__ __forceinline__ void xcd_barrier(const XcdBarrier& b, const int xb_tid) {
    asm volatile("s_waitcnt vmcnt(0)" ::: "memory");
    __syncthreads();
    if (xb_tid == 0) {
        unsigned* bar = b.bar;
        __builtin_amdgcn_s_waitcnt(0);
        unsigned nloc = b.st[0], nx = b.st[1];
        if (nloc == 0u) { xcd_barrier_complete(bar, b.x, nloc, nx); b.st[0] = nloc; b.st[1] = nx; }
        const unsigned old = xb_add(&bar[XB_XSUB(b.x)], 1u);
        const unsigned gen = old / nloc;
        if (old + 1u == (gen + 1u) * nloc) {
            __builtin_amdgcn_fence(__ATOMIC_RELEASE, "agent");
            asm volatile("s_waitcnt vmcnt(0)" ::: "memory");
            const unsigned og = xb_add(&bar[XB_TOP], 1u);
            const unsigned tg = og / nx;
            if (og + 1u == (tg + 1u) * nx) xb_add(&bar[XB_TOPGEN], 1u);
            else XB_SPIN(xb_ld(&bar[XB_TOPGEN]) == tg, bar);
            __builtin_amdgcn_fence(__ATOMIC_ACQUIRE, "agent");
            xb_add(&bar[XB_XGEN(b.x)], 1u);
            asm volatile("s_waitcnt vmcnt(0)" ::: "memory");
        } else {
            XB_SPIN(xb_ld(&bar[XB_XGEN(b.x)]) == gen, bar);
            __builtin_amdgcn_fence(__ATOMIC_ACQUIRE, "agent");
            asm volatile("s_waitcnt vmcnt(0)" ::: "memory");
        }
    }
    __syncthreads();
}

#define GAS __attribute__((address_space(1)))
typedef unsigned short bf16;
typedef unsigned v4u __attribute__((ext_vector_type(4)));
typedef unsigned v2u __attribute__((ext_vector_type(2)));
typedef float f32x4 __attribute__((ext_vector_type(4)));

constexpr int NB = 4, SEQ = 8192, DM = 1024, DEPTH = 4, CTXL = 256;
constexpr int NLAT = NB * SEQ, NCTX = NB * CTXL, MT = NLAT + NCTX;
constexpr int DIN = 3360, DINP = 3584, DFF = 2816, NEXP = 8;
constexpr int C_RQ = 0, C_RK = 256, C_RV = 512, C_RG = 768, C_S5 = 1024, C_HQ = 1280, C_HFF = 1536, C_HFB = 1792, C_HI = 2048, C_HG = 2304,
              C_GQ = 2560, C_GK = 2688, C_GV = 2816, C_GG = 3072, C_GAF = 3328, C_GAB = 3344,
              C_GZF = 3328, C_GZB = 3456;
constexpr int NSEG = 132;
constexpr int MOE_CAP_TILES = 272;
constexpr float NEPS = 1e-6f;
constexpr float WSC8 = 64.0f;

constexpr size_t MiB = 1u << 20;
constexpr size_t WS_CTL = 0, CTL_ZERO_BYTES = 2 * MiB;
constexpr size_t WS_MOD = 2 * MiB;
constexpr size_t WS_LB = 3 * MiB;
constexpr size_t WS_ROPE = 3 * MiB + 65536;
constexpr size_t WS_GLUW = 3 * MiB + 131072;
constexpr size_t WS_WIN = 4 * MiB;
constexpr size_t WS_WOUT = 32 * MiB;
constexpr size_t WS_W13D = 40 * MiB;
constexpr size_t WS_W2D = 62 * MiB;
constexpr size_t WS_W13M = 73 * MiB;
constexpr size_t WS_W2M = 161 * MiB;
constexpr size_t WS_HB = 205 * MiB;
constexpr size_t WS_ACT = 209 * MiB;
constexpr size_t WS_Z = 275 * MiB;
constexpr size_t WS_PH = 292 * MiB;
constexpr size_t WS_OF = (292 + 232) * MiB;
constexpr size_t WS_X2 = 666 * MiB;
constexpr size_t WS_LIST = 843 * MiB;
constexpr size_t WS_END = 846 * MiB;
constexpr size_t ST_DS0 = 0;
constexpr size_t ST_DS1 = ST_DS0 + (size_t)2 * 16 * NSEG * 4096;
constexpr size_t ST_DS2 = ST_DS1 + (size_t)2 * 16 * NSEG * 4096;
constexpr size_t ST_G0 = ST_DS2 + (size_t)2 * 16 * NSEG * 2048;
constexpr size_t ST_G1 = ST_G0 + (size_t)2 * 16 * NSEG * 64;
constexpr size_t ST_G2 = ST_G1 + (size_t)2 * 16 * NSEG * 64;
constexpr size_t ST_HS = ST_G2 + (size_t)2 * 16 * NSEG * 64;
constexpr size_t ST_END = ST_HS + (size_t)2 * 64 * NSEG * 128;
static_assert(ST_END * 4 <= (WS_LIST - WS_X2), "state region");
static_assert(WS_PH + (size_t)MT * DINP * 2 <= WS_OF && WS_OF + (size_t)MT * 768 * 4 <= WS_X2, "OF region");
static_assert((size_t)MOE_CAP_TILES * 256 * 1024 * 2 <= (WS_LIST - WS_X2), "XB region");
static_assert((size_t)MOE_CAP_TILES * 256 * DFF * 2 <= (WS_X2 - WS_PH) && (size_t)MT * DINP * 2 <= (WS_X2 - WS_PH), "P/H region");
constexpr int CW_BAR = 4096;
constexpr int CW_CNT = 16384;

constexpr int LDS_BYTES = 163840;
constexpr int MISC_OFF = 163840 - 512;

__device__ __forceinline__ float bf2f(unsigned short h) { return __uint_as_float(((unsigned)h) << 16); }
__device__ __forceinline__ unsigned f2bf(float f) { unsigned u = __float_as_uint(f); return (u + 0x7fffu + ((u >> 16) & 1u)) >> 16; }
__device__ __forceinline__ unsigned pk2(float lo, float hi) { return f2bf(lo) | (f2bf(hi) << 16); }
__device__ __forceinline__ float wave_sum(float v) {
#define WS_DPP(ctrl, rmask) v += __int_as_float(__builtin_amdgcn_update_dpp(0, __float_as_int(v), (ctrl), (rmask), 0xf, false))
    WS_DPP(0x111, 0xf); WS_DPP(0x112, 0xf); WS_DPP(0x114, 0xf); WS_DPP(0x118, 0xf); WS_DPP(0x142, 0xa); WS_DPP(0x143, 0xc);
#undef WS_DPP
    return __int_as_float(__builtin_amdgcn_readlane(__float_as_int(v), 63));
}
__device__ __forceinline__ float rdl(float v, int k) { return __uint_as_float((unsigned)__builtin_amdgcn_readlane((int)__float_as_uint(v), k)); }
__device__ __forceinline__ float sigm(float x) { return __builtin_amdgcn_rcpf(1.0f + __expf(-x)); }
__device__ __forceinline__ float silu_f(float x) { return x * __builtin_amdgcn_rcpf(1.0f + __expf(-x)); }
#define LDS_WAIT() asm volatile("s_waitcnt lgkmcnt(0)" ::: "memory")

struct Args {
    const float* in[37];
    int l_lo, l_hi, ph_lo, ph_hi, do_pro, do_fin, fused, pad;
};
constexpr int I_OUT = 35, I_WS = 36;
enum { I_X = 0, I_C, I_CTX, I_CCTX, I_ADAW, I_ADAB, I_N1W, I_N2W, I_WIN, I_WOUT, I_RETGN, I_LAMRE, I_LAMIM, I_LOGDT, I_BRE, I_BIM, I_CRE, I_CIM, I_S5D,
       I_GLUW, I_GLUB, I_LBL, I_HGNW, I_WA2, I_BA, I_GLANW, I_FW1, I_FW3, I_FW2, I_RW, I_RB, I_MW1, I_MW3, I_MW2, I_FINW };

struct Frame {
    LAS unsigned char* lds;
    int tid, lane, wave, gw, NGW, G, zz;
    unsigned char* ws; float* out;
};

struct EpiStoreBf16 {
    static constexpr bool PERM = true, AFTER_DRAIN = false;
    bf16* O; int ldc; float sc;
    __device__ __forceinline__ void operator()(const pg8::f32x4 (&acc)[2][2][4][2], const pg8::Unit& u, int wr, int wc, int fr, int fq) const {
        const int row0 = u.pm * 256 + wr * 64 + fr, col0 = u.pc * 256 + wc * 32 + 8 * fq;
#pragma unroll
        for (int ai = 0; ai < 2; ++ai)
#pragma unroll
            for (int m = 0; m < 4; ++m) { bf16* rowp = O + (size_t)(row0 + ai * 128 + m * 16) * ldc + col0;
#pragma unroll
                for (int bj = 0; bj < 2; ++bj) { const pg8::f32x4 v0 = acc[ai][bj][m][0] * sc, v1 = acc[ai][bj][m][1] * sc;
                    pg8::u32x4 w; w.x = pg8::cvt_pk_bf16(v0[0], v0[1]); w.y = pg8::cvt_pk_bf16(v0[2], v0[3]); w.z = pg8::cvt_pk_bf16(v1[0], v1[1]); w.w = pg8::cvt_pk_bf16(v1[2], v1[3]);
                    *(pg8::u32x4*)(rowp + bj * 128) = w; } }
    }
};
constexpr int P4G = 4 * DINP, P4S5 = 4096;
struct EpiStoreP4 {
    static constexpr bool PERM = true, FLIP = true, AFTER_DRAIN = false;
    bf16* O;
    __device__ __forceinline__ void operator()(const pg8::f32x4 (&acc)[2][2][4][2], const pg8::Unit& u, int wr, int wc, int fr, int fq) const {
        const int grp0 = u.pm * 64 + wr * 16 + fq;
        if (u.pc != 4) {
            bf16* base = O + (size_t)grp0 * P4G + (size_t)(u.pc * 256 + wc * 32 + 2 * fr) * 4;
#pragma unroll
            for (int ai = 0; ai < 2; ++ai)
#pragma unroll
                for (int m = 0; m < 4; ++m) { bf16* gp = base + (size_t)(ai * 32 + m * 4) * P4G;
#pragma unroll
                    for (int bj = 0; bj < 2; ++bj) { const pg8::f32x4 v0 = acc[ai][bj][m][0], v1 = acc[ai][bj][m][1];
                        pg8::u32x4 w; w.x = pg8::cvt_pk_bf16(v0[0], v0[1]); w.y = pg8::cvt_pk_bf16(v0[2], v0[3]); w.z = pg8::cvt_pk_bf16(v1[0], v1[1]); w.w = pg8::cvt_pk_bf16(v1[2], v1[3]);
                        *(pg8::u32x4*)(gp + bj * 512) = w; } }
        } else {
            bf16* base = O + (size_t)grp0 * P4G + P4S5 + wc * 32 + 2 * fr;
#pragma unroll
            for (int ai = 0; ai < 2; ++ai)
#pragma unroll
                for (int m = 0; m < 4; ++m) { bf16* gp = base + (size_t)(ai * 32 + m * 4) * P4G;
#pragma unroll
                    for (int bj = 0; bj < 2; ++bj)
#pragma unroll
                        for (int r = 0; r < 4; ++r) *(unsigned*)(gp + r * 256 + bj * 128) = pg8::cvt_pk_bf16(acc[ai][bj][m][0][r], acc[ai][bj][m][1][r]); }
        }
    }
};
struct EpiSwiglu {
    static constexpr bool PERM = true, AFTER_DRAIN = false;
    bf16* H;
    __device__ __forceinline__ void operator()(const pg8::f32x4 (&acc)[2][2][4][2], const pg8::Unit& u, int wr, int wc, int fr, int fq) const {
        const int row0 = u.pm * 256 + wr * 64 + fr, col0 = u.pc * 128 + wc * 32 + 8 * fq;
#pragma unroll
        for (int ai = 0; ai < 2; ++ai)
#pragma unroll
            for (int m = 0; m < 4; ++m) { bf16* rowp = H + (size_t)(row0 + ai * 128 + m * 16) * DFF + col0;
                float h[8];
#pragma unroll
                for (int n = 0; n < 2; ++n)
#pragma unroll
                    for (int j = 0; j < 4; ++j) { const float a = acc[ai][0][m][n][j], b = acc[ai][1][m][n][j];
                        h[n * 4 + j] = a * __builtin_amdgcn_rcpf(1.0f + __builtin_amdgcn_exp2f(-1.4426950408889634f * a)) * b; }
                pg8::u32x4 w; w.x = pg8::cvt_pk_bf16(h[0], h[1]); w.y = pg8::cvt_pk_bf16(h[2], h[3]); w.z = pg8::cvt_pk_bf16(h[4], h[5]); w.w = pg8::cvt_pk_bf16(h[6], h[7]);
                *(pg8::u32x4*)rowp = w; }
    }
};
struct EpiSwiglu8 {
    static constexpr bool PERM = true, AFTER_DRAIN = false;
    unsigned char* H; float sc;
    __device__ __forceinline__ void operator()(const pg8::f32x4 (&acc)[2][2][4][2], const pg8::Unit& u, int wr, int wc, int fr, int fq) const {
        const int row0 = u.pm * 256 + wr * 64 + fr, col0 = u.pc * 128 + wc * 32 + 8 * fq;
#pragma unroll
        for (int ai = 0; ai < 2; ++ai)
#pragma unroll
            for (int m = 0; m < 4; ++m) { unsigned char* rowp = H + (size_t)(row0 + ai * 128 + m * 16) * DFF + col0;
                float h[8];
#pragma unroll
                for (int n = 0; n < 2; ++n)
#pragma unroll
                    for (int j = 0; j < 4; ++j) { const float a = acc[ai][0][m][n][j] * sc, b = acc[ai][1][m][n][j] * sc;
                        const float hv = a * __builtin_amdgcn_rcpf(1.0f + __builtin_amdgcn_exp2f(-1.4426950408889634f * a)) * b;
                        h[n * 4 + j] = fminf(fmaxf(hv, -448.0f), 448.0f); }
                unsigned w0 = 0u, w1 = 0u;
                w0 = __builtin_amdgcn_cvt_pk_fp8_f32(h[0], h[1], w0, false); w0 = __builtin_amdgcn_cvt_pk_fp8_f32(h[2], h[3], w0, true);
                w1 = __builtin_amdgcn_cvt_pk_fp8_f32(h[4], h[5], w1, false); w1 = __builtin_amdgcn_cvt_pk_fp8_f32(h[6], h[7], w1, true);
                v2u w; w.x = w0; w.y = w1; *(v2u*)rowp = w; }
    }
};
struct EpiResid {
    static constexpr bool PERM = false, AFTER_DRAIN = false;
    const float* xin_lat; const float* xin_ctx; float* xout_lat; float* xout_ctx; const float* gate; float sc;
    __device__ __forceinline__ void operator()(const pg8::f32x4 (&acc)[2][2][4][2], const pg8::Unit& u, int wr, int wc, int fr, int fq) const {
        const bool isctx = u.pm >= 128; const int bidx = isctx ? 4 : (u.pm >> 5);
        const size_t rbase = (size_t)(isctx ? (u.pm - 128) : u.pm) * 256 + wr * 64 + fr;
        const float* xi = (isctx ? xin_ctx : xin_lat); float* xo = (isctx ? xout_ctx : xout_lat);
        const int col0 = u.pc * 256 + wc * 32 + 4 * fq; const float* g = gate + (size_t)bidx * 6144 + col0;
        pg8::f32x4 gv[2][2];
#pragma unroll
        for (int bj = 0; bj < 2; ++bj)
#pragma unroll
            for (int n = 0; n < 2; ++n) gv[bj][n] = *(const pg8::f32x4*)(g + bj * 128 + n * 16) * sc;
#pragma unroll
        for (int ai = 0; ai < 2; ++ai)
#pragma unroll
            for (int m = 0; m < 4; ++m) { const size_t off = (rbase + ai * 128 + m * 16) * 1024 + col0;
#pragma unroll
                for (int bj = 0; bj < 2; ++bj)
#pragma unroll
                    for (int n = 0; n < 2; ++n) { const pg8::f32x4 xv = *(const pg8::f32x4*)(xi + off + bj * 128 + n * 16);
                        *(pg8::f32x4*)(xo + off + bj * 128 + n * 16) = xv + gv[bj][n] * acc[ai][bj][m][n]; }
                asm volatile("" ::: "memory"); }
    }
};
struct EpiGlu {
    static constexpr bool PERM = true, AFTER_DRAIN = false;
    const bf16* Z; bf16* Y; const float* bias;
    __device__ __forceinline__ void operator()(const pg8::f32x4 (&acc)[2][2][4][2], const pg8::Unit& u, int wr, int wc, int fr, int fq) const {
        const int row0 = u.pm * 256 + wr * 64 + fr, col0 = wc * 32 + 8 * fq;
#pragma unroll
        for (int ai = 0; ai < 2; ++ai)
#pragma unroll
            for (int m = 0; m < 4; ++m) { const size_t row = (size_t)(row0 + ai * 128 + m * 16);
#pragma unroll
                for (int bj = 0; bj < 2; ++bj) { const int col = col0 + bj * 128;
                    const pg8::u32x4 zz = *(const pg8::u32x4*)(Z + row * 256 + col);
                    const pg8::f32x4 b0 = *(const pg8::f32x4*)(bias + col), b1 = *(const pg8::f32x4*)(bias + col + 4);
                    const pg8::f32x4 v0 = acc[ai][bj][m][0] + b0, v1 = acc[ai][bj][m][1] + b1;
                    float o[8]; const unsigned zw[4] = {zz.x, zz.y, zz.z, zz.w};
#pragma unroll
                    for (int j = 0; j < 4; ++j) { const float zl = __uint_as_float(zw[j] << 16), zh = __uint_as_float(zw[j] & 0xffff0000u);
                        const float a0 = (j < 2) ? v0[2 * j] : v1[2 * j - 4], a1 = (j < 2) ? v0[2 * j + 1] : v1[2 * j - 3];
                        o[2 * j] = zl * sigm(a0); o[2 * j + 1] = zh * sigm(a1); }
                    pg8::u32x4 w; w.x = pg8::cvt_pk_bf16(o[0], o[1]); w.y = pg8::cvt_pk_bf16(o[2], o[3]); w.z = pg8::cvt_pk_bf16(o[4], o[5]); w.w = pg8::cvt_pk_bf16(o[6], o[7]);
                    *(pg8::u32x4*)(Y + row * 1024 + 256 + col) = w; }
                asm volatile("" ::: "memory"); }
    }
};
struct MoeOrder {
    int tp[9]; int nN, G, c, total;
    __device__ __forceinline__ void init(const unsigned* cnt, int nN_, int G_, int c_) {
        tp[0] = 0;
#pragma unroll
        for (int e = 0; e < 8; ++e) tp[e + 1] = tp[e] + (int)(((unsigned)__builtin_amdgcn_readfirstlane((int)__hip_atomic_load(cnt + e * 64, __ATOMIC_RELAXED, __HIP_MEMORY_SCOPE_AGENT)) + 255u) >> 8);
        nN = nN_; G = G_; c = c_; total = tp[8] * nN;
    }
    __device__ __forceinline__ bool next(int i, pg8::Unit& u) const {
        const int L = i * G + c; if (L >= total) return false;
        const int t = L / nN, pn = L - t * nN; int e = 0;
#pragma unroll
        for (int k = 1; k < 8; ++k) e += (t >= tp[k]) ? 1 : 0;
        u.pm = t; u.pn = e * nN + pn; u.pc = pn; return true;
    }
    __device__ __forceinline__ void a_ready(const pg8::Unit&) const {}
    __device__ __forceinline__ void done(const pg8::Unit&) const {}
};

__device__ __forceinline__ void cvt_item(const float* W, int K, int N, bf16* WT, int mode, int add, LAS float* scr, int item, int lane, int nblk_override = 0) {
    const int nblk = nblk_override ? nblk_override : (N >> 5), kb = item / nblk, nb = item - kb * nblk, k0 = 64 * kb, n0 = 32 * nb;
    const int r = lane >> 3, c4 = lane & 7;
    f32x4 v[8];
#pragma unroll
    for (int i = 0; i < 8; ++i) v[i] = *(const f32x4*)(W + (size_t)(k0 + 8 * i + r) * N + n0 + 4 * c4);
#pragma unroll
    for (int i = 0; i < 8; ++i) {
#pragma unroll
        for (int j = 0; j < 4; ++j) scr[(8 * i + r) * 33 + 4 * c4 + j] = v[i][j]; }
    LDS_WAIT();
    const int c = lane & 7;
#pragma unroll
    for (int j = 0; j < 4; ++j) { const int n = (lane >> 3) + 8 * j; const LAS float* s = scr + (8 * c) * 33 + n;
        v4u o; o.x = pk2(s[0 * 33], s[1 * 33]); o.y = pk2(s[2 * 33], s[3 * 33]); o.z = pk2(s[4 * 33], s[5 * 33]); o.w = pk2(s[6 * 33], s[7 * 33]);
        const int nn = n0 + n; const int drow = (mode == 0) ? (nn + add) : (((nn >> 7) << 8) + (nn & 127) + add);
        *(v4u*)(WT + (size_t)drow * K + k0 + 8 * c) = o; }
    LDS_WAIT();
}
__device__ __forceinline__ void cvt_item_f8(const float* W, int K, int N, unsigned char* WT, int mode, int add, LAS float* scr, int item, int lane) {
    const int nblk = N >> 5, kb = item / nblk, nb = item - kb * nblk, k0 = 64 * kb, n0 = 32 * nb;
    const int r = lane >> 3, c4 = lane & 7;
    f32x4 v[8];
#pragma unroll
    for (int i = 0; i < 8; ++i) v[i] = *(const f32x4*)(W + (size_t)(k0 + 8 * i + r) * N + n0 + 4 * c4);
#pragma unroll
    for (int i = 0; i < 8; ++i) {
#pragma unroll
        for (int j = 0; j < 4; ++j) scr[(8 * i + r) * 33 + 4 * c4 + j] = v[i][j]; }
    LDS_WAIT();
    const int c = lane & 3;
#pragma unroll
    for (int j = 0; j < 2; ++j) { const int n = (lane >> 2) + 16 * j; const LAS float* s = scr + (16 * c) * 33 + n;
        unsigned w[4];
#pragma unroll
        for (int q = 0; q < 4; ++q) { unsigned x = 0u;
            x = __builtin_amdgcn_cvt_pk_fp8_f32(s[(4 * q) * 33] * WSC8, s[(4 * q + 1) * 33] * WSC8, x, false);
            x = __builtin_amdgcn_cvt_pk_fp8_f32(s[(4 * q + 2) * 33] * WSC8, s[(4 * q + 3) * 33] * WSC8, x, true); w[q] = x; }
        v4u o; o.x = w[0]; o.y = w[1]; o.z = w[2]; o.w = w[3];
        const int nn = n0 + n; const int drow = (mode == 0) ? (nn + add) : (((nn >> 7) << 8) + (nn & 127) + add);
        *(v4u*)(WT + (size_t)drow * K + k0 + 16 * c) = o; }
    LDS_WAIT();
}
__device__ __forceinline__ void moe_cvt_idle(const Frame& F, const Args& a, int j, int b_lo) {
    LAS float* scr = (LAS float*)(F.lds + F.wave * 16384);
    constexpr int IT = 1408;
    const int nw = (F.G - b_lo) * 8, w = ((int)blockIdx.x - b_lo) * 8 + F.wave;
    for (int it = w; it < 8 * 3 * IT; it += nw) {
        const int e = it / (3 * IT), r = it - e * 3 * IT, which = r / IT, item = r - which * IT;
        const size_t eo = ((size_t)j * 8 + e) * (size_t)(1024 * DFF);
        if (which == 0) cvt_item_f8(a.in[F.zz + I_MW1] + eo, 1024, DFF, F.ws + WS_W13M + (size_t)e * 5632 * 1024, 1, 0, scr, item, F.lane);
        else if (which == 1) cvt_item_f8(a.in[F.zz + I_MW3] + eo, 1024, DFF, F.ws + WS_W13M + (size_t)e * 5632 * 1024, 1, 128, scr, item, F.lane);
        else cvt_item_f8(a.in[F.zz + I_MW2] + eo, DFF, 1024, F.ws + WS_W2M + (size_t)e * 1024 * DFF, 0, 0, scr, item, F.lane);
    }
}
__device__ __forceinline__ void moe_cvt(const Frame& F, const Args& a, int j) {
    LAS float* scr = (LAS float*)(F.lds + F.wave * 16384);
    constexpr int IT = 1408;
    for (int it = F.gw; it < 8 * 3 * IT; it += F.NGW) {
        const int e = it / (3 * IT), r = it - e * 3 * IT, which = r / IT, item = r - which * IT;
        const size_t eo = ((size_t)j * 8 + e) * (size_t)(1024 * DFF);
        if (which == 0) cvt_item_f8(a.in[F.zz + I_MW1] + eo, 1024, DFF, F.ws + WS_W13M + (size_t)e * 5632 * 1024, 1, 0, scr, item, F.lane);
        else if (which == 1) cvt_item_f8(a.in[F.zz + I_MW3] + eo, 1024, DFF, F.ws + WS_W13M + (size_t)e * 5632 * 1024, 1, 128, scr, item, F.lane);
        else cvt_item_f8(a.in[F.zz + I_MW2] + eo, DFF, 1024, F.ws + WS_W2M + (size_t)e * 1024 * DFF, 0, 0, scr, item, F.lane);
    }
}
__device__ __forceinline__ void prologue(const Frame& F, const Args& a) {
    {
        LAS float* sc = (LAS float*)F.lds; LAS float* red = sc + 5120;
        for (int idx = F.tid; idx < 5120; idx += 512) { const int r = idx >> 10, k = idx & 1023; const float cv = (r < 4) ? a.in[F.zz + I_C][r * 1024 + k] : a.in[F.zz + I_CCTX][k]; sc[idx] = silu_f(cv); }
        __syncthreads();
        float* MOD = (float*)(F.ws + WS_MOD);
        for (int item = blockIdx.x; item < 384; item += F.G) {
            const int l = item / 96, nb = item - l * 96, cl = F.tid & 63, ks = F.tid >> 6, n = nb * 64 + cl;
            float acc[5] = {0.f, 0.f, 0.f, 0.f, 0.f};
            const float* wp = a.in[F.zz + I_ADAW] + ((size_t)l * 1024 + ks * 128) * 6144 + n;
#pragma unroll 16
            for (int kk = 0; kk < 128; ++kk) { const float w = wp[(size_t)kk * 6144];
#pragma unroll
                for (int r = 0; r < 5; ++r) acc[r] = fmaf(sc[r * 1024 + ks * 128 + kk], w, acc[r]); }
#pragma unroll
            for (int r = 0; r < 5; ++r) red[(ks * 5 + r) * 64 + cl] = acc[r];
            __syncthreads();
            if (F.tid < 320) { const int r = F.tid >> 6; float s = 0.f;
#pragma unroll
                for (int k2 = 0; k2 < 8; ++k2) s += red[(k2 * 5 + r) * 64 + cl];
                MOD[((size_t)l * 5 + r) * 6144 + n] = s + a.in[F.zz + I_ADAB][l * 6144 + n]; }
            __syncthreads();
        }
        if (blockIdx.x == 0 && F.tid < 256) {
            const float* lg = a.in[F.zz + I_LBL]; float x[4], mx = -3.0e38f;
#pragma unroll
            for (int l = 0; l < 4; ++l) { x[l] = lg[l * 256 + F.tid]; mx = fmaxf(mx, x[l]); }
            float s = 0.f;
#pragma unroll
            for (int l = 0; l < 4; ++l) { x[l] = expf(x[l] - mx); s += x[l]; }
            float cs = 0.f; const float sm0 = x[0] / s; float* LB = (float*)(F.ws + WS_LB);
#pragma unroll
            for (int l = 0; l < 4; ++l) { cs += x[l] / s; LB[l * 256 + F.tid] = fminf(fmaxf(cs - sm0, 0.f), 1.0f - 1e-6f); }
        }
        if (blockIdx.x == (1 % F.G)) {
            float* RC = (float*)(F.ws + WS_ROPE); float* RS = RC + 2048;
            for (int idx = F.tid; idx < 2048; idx += 512) { const int pos = idx >> 4, i = idx & 15;
                const float fr = powf(10000.0f, -(float)i / 16.0f); const float ang = (float)pos * fr; RC[idx] = cosf(ang); RS[idx] = sinf(ang); }
        }
        __syncthreads();
    }
    LAS float* scr = (LAS float*)(F.lds + F.wave * 16384);
    constexpr int I_IN = 16 * 104, I_OUT = 16 * 32, I_F = 1408, I_GL = 4 * 8;
    constexpr int NIT = 4 * I_IN + 4 * I_OUT + 6 * I_F + 4 * I_GL;
    for (int it = F.gw; it < NIT; it += F.NGW) {
        int r = it;
        if (r < 4 * I_IN) { const int l = r / I_IN; cvt_item(a.in[F.zz + I_WIN] + (size_t)l * 1024 * DIN, 1024, DIN, (bf16*)(F.ws + WS_WIN) + (size_t)l * DINP * 1024, 0, 0, scr, r - l * I_IN, F.lane, 104); continue; } r -= 4 * I_IN;
        if (r < 4 * I_OUT) { const int l = r / I_OUT; cvt_item(a.in[F.zz + I_WOUT] + (size_t)l * 1024 * 1024, 1024, 1024, (bf16*)(F.ws + WS_WOUT) + (size_t)l * 1024 * 1024, 0, 0, scr, r - l * I_OUT, F.lane); continue; } r -= 4 * I_OUT;
        if (r < 6 * I_F) { const int j = r / (3 * I_F), r2 = r - j * 3 * I_F, which = r2 / I_F, item = r2 - which * I_F; const size_t wo = (size_t)j * 1024 * DFF;
            if (which == 0) cvt_item(a.in[F.zz + I_FW1] + wo, 1024, DFF, (bf16*)(F.ws + WS_W13D) + (size_t)j * 5632 * 1024, 1, 0, scr, item, F.lane);
            else if (which == 1) cvt_item(a.in[F.zz + I_FW3] + wo, 1024, DFF, (bf16*)(F.ws + WS_W13D) + (size_t)j * 5632 * 1024, 1, 128, scr, item, F.lane);
            else cvt_item_f8(a.in[F.zz + I_FW2] + wo, DFF, 1024, F.ws + WS_W2D + (size_t)j * 1024 * DFF, 0, 0, scr, item, F.lane);
            continue; } r -= 6 * I_F;
        { const int l = r / I_GL; cvt_item(a.in[F.zz + I_GLUW] + (size_t)l * 65536, 256, 256, (bf16*)(F.ws + WS_GLUW) + (size_t)l * 65536, 0, 0, scr, r - l * I_GL, F.lane); }
    }
    for (int i = blockIdx.x * 512 + F.tid; i < 4 * 256 * 128; i += F.G * 512) {
        const int l = i >> 15, rem = i & 32767, n = rem >> 7, k0 = (rem & 127) * 8, d = n >> 7, cidx = n & 127;
        const float* wa = a.in[F.zz + I_WA2] + ((size_t)(l * 2 + d) * 16) * 128 + cidx;
        float acc[8] = {0.f, 0.f, 0.f, 0.f, 0.f, 0.f, 0.f, 0.f};
#pragma unroll
        for (int r = 0; r < 16; ++r) { const float w2 = wa[r * 128];
#pragma unroll
            for (int kk = 0; kk < 8; ++kk) acc[kk] = fmaf(a.in[F.zz + I_WIN][((size_t)l * 1024 + k0 + kk) * DIN + 3328 + 16 * d + r], w2, acc[kk]); }
        v4u o; o.x = pk2(acc[0], acc[1]); o.y = pk2(acc[2], acc[3]); o.z = pk2(acc[4], acc[5]); o.w = pk2(acc[6], acc[7]);
        *(v4u*)((bf16*)(F.ws + WS_WIN) + ((size_t)l * DINP + 3328 + n) * 1024 + k0) = o;
    }
}

struct MoeTp { int tp[9]; };
__device__ __forceinline__ void load_tp(MoeTp& t, const unsigned* cnt) {
    t.tp[0] = 0;
#pragma unroll
    for (int e = 0; e < 8; ++e) t.tp[e + 1] = t.tp[e] + (int)(((unsigned)__builtin_amdgcn_readfirstlane((int)__hip_atomic_load(cnt + e * 64, __ATOMIC_RELAXED, __HIP_MEMORY_SCOPE_AGENT)) + 255u) >> 8);
}
template <int MODE>
__device__ __forceinline__ void norm_phase(const Frame& F, const Args& a, int l, int which  , int nrows, int comb_l  ) {
    const float* MOD = (const float*)(F.ws + WS_MOD);
    const float* nw = (MODE == 2) ? a.in[F.zz + I_FINW] : ((which ? a.in[F.zz + I_N2W] : a.in[F.zz + I_N1W]) + l * 1024);
    bf16* XN = (bf16*)(F.ws + WS_ACT);
    float* hb = (float*)(F.ws + WS_HB);
    const int* EP = (const int*)(F.ws + WS_LIST) + 8 * MT; const float* GATE = (const float*)(F.ws + WS_LIST) + 10 * MT;
    const bf16* YM = (const bf16*)(F.ws + WS_X2);
    const bool from_input = (l == 0 && which == 0 && MODE != 2);
    MoeTp ctp; if (comb_l >= 0) load_tp(ctp, (const unsigned*)F.ws + CW_CNT + (comb_l >> 1) * 8 * 64);
    const int jm = l >> 1;
    LAS float* rwl = (LAS float*)F.lds;
    if (MODE == 1) {
        const float* rw = a.in[F.zz + I_RW] + (size_t)jm * 8192;
        for (int idx = F.tid; idx < 8192; idx += 512) { const int k = idx >> 3, e = idx & 7; rwl[e * 1024 + k] = rw[idx]; }
        __syncthreads();
    }
    f32x4 wv[4];
#pragma unroll
    for (int j = 0; j < 4; ++j) wv[j] = *((const f32x4*)nw + F.lane + 64 * j);
    f32x4 vn[4]; int epn0 = 0, epn1 = 0; float gn0 = 0.f, gn1 = 0.f;
    { const int m = F.gw < nrows ? F.gw : 0; const bool isctx = m >= NLAT;
      const float* xr = from_input ? (isctx ? a.in[F.zz + I_CTX] + (size_t)(m - NLAT) * 1024 : a.in[F.zz + I_X] + (size_t)m * 1024) : (isctx ? hb + (size_t)(m - NLAT) * 1024 : F.out + (size_t)m * 1024);
#pragma unroll
      for (int j = 0; j < 4; ++j) vn[j] = *((const f32x4*)xr + F.lane + 64 * j);
      if (comb_l >= 0) { epn0 = EP[2 * m]; epn1 = EP[2 * m + 1]; gn0 = GATE[2 * m]; gn1 = GATE[2 * m + 1]; } }
    for (int m = F.gw; m < nrows; m += F.NGW) {
        const bool isctx = m >= NLAT; const int bidx = isctx ? 4 : (m >> 13);
        f32x4 v[4];
#pragma unroll
        for (int j = 0; j < 4; ++j) v[j] = vn[j];
        const int ep0 = epn0, ep1 = epn1; const float g0 = gn0, g1 = gn1;
        { const int mn = (m + F.NGW < nrows) ? m + F.NGW : m; const bool cn = mn >= NLAT;
          const float* xr = from_input ? (cn ? a.in[F.zz + I_CTX] + (size_t)(mn - NLAT) * 1024 : a.in[F.zz + I_X] + (size_t)mn * 1024) : (cn ? hb + (size_t)(mn - NLAT) * 1024 : F.out + (size_t)mn * 1024);
#pragma unroll
          for (int j = 0; j < 4; ++j) vn[j] = *((const f32x4*)xr + F.lane + 64 * j);
          if (comb_l >= 0) { epn0 = EP[2 * mn]; epn1 = EP[2 * mn + 1]; gn0 = GATE[2 * mn]; gn1 = GATE[2 * mn + 1]; } }
        if (comb_l >= 0) {
            int t0 = 0, t1 = 0;
#pragma unroll
            for (int e = 0; e < 8; ++e) { t0 = ((ep0 & 7) == e) ? ctp.tp[e] : t0; t1 = ((ep1 & 7) == e) ? ctp.tp[e] : t1; }
            const size_t d0 = (size_t)t0 * 256 + (ep0 >> 3), d1 = (size_t)t1 * 256 + (ep1 >> 3);
            const float* m5 = MOD + ((size_t)comb_l * 5 + bidx) * 6144 + 5 * 1024;
            float* xw = isctx ? hb + (size_t)(m - NLAT) * 1024 : F.out + (size_t)m * 1024;
#pragma unroll
            for (int j = 0; j < 4; ++j) {
                const v2u y0 = *((const v2u*)(YM + d0 * 1024) + F.lane + 64 * j), y1 = *((const v2u*)(YM + d1 * 1024) + F.lane + 64 * j);
                const f32x4 mm = *((const f32x4*)m5 + F.lane + 64 * j);
                f32x4 f0, f1;
                f0[0] = __uint_as_float(y0.x << 16); f0[1] = __uint_as_float(y0.x & 0xffff0000u); f0[2] = __uint_as_float(y0.y << 16); f0[3] = __uint_as_float(y0.y & 0xffff0000u);
                f1[0] = __uint_as_float(y1.x << 16); f1[1] = __uint_as_float(y1.x & 0xffff0000u); f1[2] = __uint_as_float(y1.y << 16); f1[3] = __uint_as_float(y1.y & 0xffff0000u);
                v[j] = v[j] + mm * (f0 * g0 + f1 * g1);
                if (MODE != 2) *((f32x4*)xw + F.lane + 64 * j) = v[j];
            }
        }
        float ss = 0.f;
#pragma unroll
        for (int j = 0; j < 4; ++j) ss += (v[j][0] * v[j][0] + v[j][1] * v[j][1]) + (v[j][2] * v[j][2] + v[j][3] * v[j][3]);
        ss = wave_sum(ss);
        const float rstd = __builtin_amdgcn_rsqf(ss * (1.0f / 1024.0f) + NEPS);
        if (MODE == 2) {
#pragma unroll
            for (int j = 0; j < 4; ++j) *((f32x4*)(F.out + (size_t)m * 1024) + F.lane + 64 * j) = v[j] * rstd * wv[j];
        } else {
            const float* sh = MOD + ((size_t)l * 5 + bidx) * 6144 + (which ? 3 : 0) * 1024; const float* scl = sh + 1024;
            f32x4 o[4];
#pragma unroll
            for (int j = 0; j < 4; ++j) { const f32x4 s1 = *((const f32x4*)scl + F.lane + 64 * j), s0 = *((const f32x4*)sh + F.lane + 64 * j);
                o[j] = (v[j] * rstd * wv[j]) * (s1 + 1.0f) + s0;
                if (MODE == 1) {
                    unsigned w8 = 0u; w8 = __builtin_amdgcn_cvt_pk_fp8_f32(fminf(fmaxf(o[j][0], -448.f), 448.f), fminf(fmaxf(o[j][1], -448.f), 448.f), w8, false);
                    w8 = __builtin_amdgcn_cvt_pk_fp8_f32(fminf(fmaxf(o[j][2], -448.f), 448.f), fminf(fmaxf(o[j][3], -448.f), 448.f), w8, true);
                    *((unsigned*)((unsigned char*)XN + (size_t)m * 1024) + F.lane + 64 * j) = w8;
                } else { v2u w; w.x = pk2(o[j][0], o[j][1]); w.y = pk2(o[j][2], o[j][3]);
                    *((v2u*)(XN + (size_t)m * 1024) + F.lane + 64 * j) = w; } }
            if (MODE == 1) {
                float p[8];
#pragma unroll
                for (int e = 0; e < 8; ++e) { float s = 0.f;
#pragma unroll
                    for (int j = 0; j < 4; ++j) { const f32x4 w4 = *((const LAS f32x4*)(rwl + e * 1024) + F.lane + 64 * j);
                        s += (o[j][0] * w4[0] + o[j][1] * w4[1]) + (o[j][2] * w4[2] + o[j][3] * w4[3]); }
                    p[e] = wave_sum(s) + a.in[F.zz + I_RB][jm * 8 + e]; }
                int e0 = 0; float v0 = p[0];
#pragma unroll
                for (int e = 1; e < 8; ++e) if (p[e] > v0) { v0 = p[e]; e0 = e; }
                int e1 = -1; float v1 = -3.0e38f;
#pragma unroll
                for (int e = 0; e < 8; ++e) if (e != e0 && p[e] > v1) { v1 = p[e]; e1 = e; }
                const float ex = expf(v1 - v0), g0 = 1.0f / (1.0f + ex), g1 = ex / (1.0f + ex);
                if (F.lane == 0) {
                    unsigned* cnt = (unsigned*)F.ws + CW_CNT + jm * 8 * 64; int* LIST = (int*)(F.ws + WS_LIST);
                    int* EPw = (int*)(F.ws + WS_LIST) + 8 * MT; float* GW = (float*)(F.ws + WS_LIST) + 10 * MT;
                    const unsigned p0 = __hip_atomic_fetch_add(cnt + e0 * 64, 1u, __ATOMIC_RELAXED, __HIP_MEMORY_SCOPE_AGENT);
                    const unsigned p1 = __hip_atomic_fetch_add(cnt + e1 * 64, 1u, __ATOMIC_RELAXED, __HIP_MEMORY_SCOPE_AGENT);
                    LIST[e0 * MT + p0] = m; LIST[e1 * MT + p1] = m;
                    EPw[2 * m] = e0 | (int)(p0 << 3); EPw[2 * m + 1] = e1 | (int)(p1 << 3);
                    GW[2 * m] = g0; GW[2 * m + 1] = g1;
                }
            }
        }
    }
    if (MODE == 1) __syncthreads();
}
__device__ __forceinline__ void moe_gather(const Frame& F, int jm) {
    const unsigned* cnt = (const unsigned*)F.ws + CW_CNT + jm * 8 * 64;
    MoeTp t; load_tp(t, cnt);
    int cn[8];
#pragma unroll
    for (int e = 0; e < 8; ++e) cn[e] = __builtin_amdgcn_readfirstlane((int)__hip_atomic_load(cnt + e * 64, __ATOMIC_RELAXED, __HIP_MEMORY_SCOPE_AGENT));
    const int rows = t.tp[8] * 256;
    const int* LIST = (const int*)(F.ws + WS_LIST); const v4u* XN = (const v4u*)(F.ws + WS_ACT); v4u* XB = (v4u*)(F.ws + WS_X2);
    for (int r = F.gw; r < rows; r += F.NGW) {
        const int tile = r >> 8; int e = 0, tpe = 0, ce = cn[0];
#pragma unroll
        for (int k = 1; k < 8; ++k) { const bool ge = tile >= t.tp[k]; e += ge ? 1 : 0; tpe = ge ? t.tp[k] : tpe; ce = ge ? cn[k] : ce; }
        const int pos = r - tpe * 256;
        v4u x0 = {0u, 0u, 0u, 0u};
        if (pos < ce) { const int src = LIST[e * MT + pos]; x0 = XN[(size_t)src * 64 + F.lane]; }
        XB[(size_t)r * 64 + F.lane] = x0;
    }
}
#define GLD(T, ubase, voff) (*(const T*)((const char*)(ubase) + (unsigned)(voff)))
#define GST(T, ubase, voff) (*(T*)((char*)(ubase) + (unsigned)(voff)))
__device__ __forceinline__ int fresh_lane() { int l; asm volatile("v_mbcnt_lo_u32_b32 %0, -1, 0\n\tv_mbcnt_hi_u32_b32 %0, -1, %0" : "=v"(l)); return l; }

struct MixP { const bf16* P; const float* lb; const float* rcos; const float* rsin; const float* ba; };
__device__ __forceinline__ int seg_row0(int b, int sg) { return sg < 4 ? NLAT + b * CTXL + sg * 64 : b * SEQ + (sg - 4) * 64; }
__device__ __forceinline__ int seg_tpos0(int sg) { return sg < 4 ? -1 : (sg - 4) * 64; }

struct S5P { const float *lam_re, *lam_im, *log_dt, *b_re, *b_im, *c_re, *c_im, *dd; };
__device__ __forceinline__ float gelu_tanh(float y) { const float t = 0.7978845608028654f * (y + 0.044715f * y * y * y); const float th = 1.0f - 2.0f * __builtin_amdgcn_rcpf(1.0f + __expf(2.0f * t)); return 0.5f * y * (1.0f + th); }
template <int MODE>
__device__ __forceinline__ void s5_scan(const S5P& sp, const bf16* P, int b, int g, int dir, int sg, int lane, float& hre, float& him, LAS float* yf, LAS float* stg, bf16* Z) {
    const int row0 = seg_row0(b, sg); const int dg = dir * 16 + g;
    const float lre = sp.lam_re[dg * 64 + lane], lim = sp.lam_im[dg * 64 + lane], dt = expf(sp.log_dt[dg]);
    const float er = expf(lre * dt); const float sn = sinf(lim * dt), cs = cosf(lim * dt);
    const float ar = er * cs, ai = er * sn;
    const float nr = ar - 1.0f, ni = ai, den = lre * lre + lim * lim;
    const float cr = (nr * lre + ni * lim) / den, ci = (ni * lre - nr * lim) / den;
    float bbr[16], bbi[16], Cr[16], Ci[16];
#pragma unroll
    for (int c = 0; c < 16; ++c) { const float Br = sp.b_re[((size_t)dg * 64 + lane) * 16 + c], Bi = sp.b_im[((size_t)dg * 64 + lane) * 16 + c];
        bbr[c] = cr * Br - ci * Bi; bbi[c] = cr * Bi + ci * Br;
        Cr[c] = (MODE != 0) ? sp.c_re[((size_t)dg * 16 + c) * 64 + lane] : 0.f; Ci[c] = (MODE != 0) ? sp.c_im[((size_t)dg * 16 + c) * 64 + lane] : 0.f; }
    const int ch = ((lane >> 5) & 1) * 8 + ((lane >> 4) & 1) * 4 + ((lane >> 3) & 1) * 2 + ((lane >> 2) & 1);
    const float dv = (MODE == 2) ? sp.dd[g * 16 + ch] : 0.f;
    const bool b5 = lane & 32, b4 = lane & 16, b3 = lane & 8, b2 = lane & 4;
    const unsigned ucol = 2u * (unsigned)(C_S5 + g * 16 + (lane & 15));
    unsigned short rn0[4], rn1[4], rn2[4];
#pragma unroll
    for (int u = 0; u < 4; ++u) { rn0[u] = GLD(unsigned short, P + (size_t)(row0 + (dir ? 63 - u : u)) * DINP, ucol); rn1[u] = GLD(unsigned short, P + (size_t)(row0 + (dir ? 59 - u : 4 + u)) * DINP, ucol);
        rn2[u] = GLD(unsigned short, P + (size_t)(row0 + (dir ? 55 - u : 8 + u)) * DINP, ucol); }
#pragma unroll 1
    for (int i0 = 0; i0 < 64; i0 += 4) {
        unsigned short ru[4], rn3[4];
        const int ip = (i0 + 12 < 64) ? i0 + 12 : 60;
#pragma unroll
        for (int u = 0; u < 4; ++u) { ru[u] = rn0[u]; rn3[u] = GLD(unsigned short, P + (size_t)(row0 + (dir ? 63 - (ip + u) : (ip + u))) * DINP, ucol); }
#pragma unroll
        for (int u = 0; u < 4; ++u) stg[u * 64 + lane] = bf2f(ru[u]);
#pragma unroll
        for (int u = 0; u < 4; ++u) {
            const int ti = dir ? 63 - (i0 + u) : (i0 + u);
            const float uf = bf2f(ru[u]);
            float bur = 0.f, bui = 0.f;
#pragma unroll
            for (int c4 = 0; c4 < 4; ++c4) { const f32x4 ux = *(const LAS f32x4*)(stg + u * 64 + 4 * c4);
#pragma unroll
                for (int jj = 0; jj < 4; ++jj) { bur = fmaf(bbr[4 * c4 + jj], ux[jj], bur); bui = fmaf(bbi[4 * c4 + jj], ux[jj], bui); } }
            const float nre = ar * hre - ai * him + bur, nim = ar * him + ai * hre + bui;
            hre = nre; him = nim;
            if (MODE != 0) {
                float v[16];
#pragma unroll
                for (int c = 0; c < 16; ++c) v[c] = Cr[c] * hre - Ci[c] * him;
                float w8[8], w4[4], w2[2], w1;
#pragma unroll
                for (int i = 0; i < 8; ++i) { const float mine = b5 ? v[8 + i] : v[i], oth = b5 ? v[i] : v[8 + i]; w8[i] = mine + __shfl_xor(oth, 32); }
#pragma unroll
                for (int i = 0; i < 4; ++i) { const float mine = b4 ? w8[4 + i] : w8[i], oth = b4 ? w8[i] : w8[4 + i]; w4[i] = mine + __shfl_xor(oth, 16); }
#pragma unroll
                for (int i = 0; i < 2; ++i) { const float mine = b3 ? w4[2 + i] : w4[i], oth = b3 ? w4[i] : w4[2 + i]; w2[i] = mine + __shfl_xor(oth, 8); }
                { const float mine = b2 ? w2[1] : w2[0], oth = b2 ? w2[0] : w2[1]; w1 = mine + __shfl_xor(oth, 4); }
                w1 += __shfl_xor(w1, 2); w1 += __shfl_xor(w1, 1);
                if (MODE == 1) { if ((lane & 3) == 0) yf[ti * 16 + ch] = w1; }
                if (MODE == 2) {
                    const float uch = __shfl(uf, ch);
                    if ((lane & 3) == 0) { const float y = w1 + yf[ti * 16 + ch] + dv * uch; Z[(size_t)(row0 + ti) * 256 + g * 16 + ch] = (bf16)f2bf(gelu_tanh(y)); }
                }
            }
        }
#pragma unroll
        for (int u = 0; u < 4; ++u) { rn0[u] = rn1[u]; rn1[u] = rn2[u]; rn2[u] = rn3[u]; }
    }
}

__device__ __forceinline__ MixP make_mixp(const Frame& F, const Args& a, int l) {
    MixP mp; mp.P = (const bf16*)(F.ws + WS_PH); mp.lb = (const float*)(F.ws + WS_LB) + l * 256; mp.rcos = (const float*)(F.ws + WS_ROPE); mp.rsin = mp.rcos + 2048;
    mp.ba = a.in[F.zz + I_BA] + (size_t)l * 2 * 128; return mp;
}
__device__ __forceinline__ S5P make_s5p(const Frame& F, const Args& a, int l) {
    S5P sp; sp.lam_re = a.in[F.zz + I_LAMRE] + (size_t)l * 2048; sp.lam_im = a.in[F.zz + I_LAMIM] + (size_t)l * 2048; sp.log_dt = a.in[F.zz + I_LOGDT] + l * 32;
    sp.b_re = a.in[F.zz + I_BRE] + (size_t)l * 32768; sp.b_im = a.in[F.zz + I_BIM] + (size_t)l * 32768; sp.c_re = a.in[F.zz + I_CRE] + (size_t)l * 32768; sp.c_im = a.in[F.zz + I_CIM] + (size_t)l * 32768;
    sp.dd = a.in[F.zz + I_S5D] + l * 256; return sp;
}


typedef short bf16x8_t __attribute__((ext_vector_type(8)));
typedef float f32x16 __attribute__((ext_vector_type(16)));
typedef float f32x2_t __attribute__((ext_vector_type(2)));
typedef __bf16 bf16x2_n __attribute__((ext_vector_type(2)));
__device__ __forceinline__ unsigned pkbf(float lo, float hi) { const f32x2_t v = {lo, hi}; const bf16x2_n r = __builtin_convertvector(v, bf16x2_n); return __builtin_bit_cast(unsigned, r); }
constexpr int WL_QC = 0, WL_KC = 4608, WL_KT = 9216, WL_VT = 14336, WL_PL = 19456, WL_BYTES = 19712;

struct MxC { float gamma, lbv, oml, bav; unsigned cq, ck, cv, cz; };
template <int MIX>
__device__ __forceinline__ void mx_consts(MxC& c, const MixP& mp, int h, int dir, int lane) {
    c.gamma = 1.f; c.lbv = 0.f; c.oml = 1.f; c.bav = 0.f; c.cz = 0;
    if (MIX == 0) { c.cq = 8u * (unsigned)(C_RQ + h * 64 + lane); c.ck = 8u * (unsigned)(C_RK + h * 64 + lane); c.cv = 8u * (unsigned)(C_RV + h * 64 + lane); c.gamma = 1.0f - exp2f(-5.0f - (float)(dir ? 3 - h : h)); }
    else if (MIX == 1) { c.cq = 8u * (unsigned)(C_HQ + h * 64 + lane); c.ck = 8u * (unsigned)((dir ? C_HFB : C_HFF) + h * 64 + lane); c.cv = 8u * (unsigned)(C_HI + h * 64 + lane); c.lbv = mp.lb[h * 64 + lane]; c.oml = 1.0f - c.lbv; }
    else { c.cq = 8u * (unsigned)(C_GQ + h * 32 + (lane & 31)); c.ck = 8u * (unsigned)(C_GK + h * 32 + (lane & 31)); c.cv = 8u * (unsigned)(C_GV + h * 64 + lane); c.cz = 8u * (unsigned)((dir ? C_GZB : C_GZF) + h * 32 + (lane & 31));
        c.bav = mp.ba[dir * 128 + h * 32 + (lane & 31)]; }
}
struct MxRaw { v2u q, k, v, z; };
template <int MIX, bool NEEDQ, int DIR>
__device__ __forceinline__ void mx_load(MxRaw& w, const MixP& mp, const MxC& c, int rows, int b) {
    const bf16* pr = mp.P + (size_t)((rows >> 2) + (DIR ? 15 - b : b)) * P4G;
    const v2u zero = {0u, 0u};
    w.q = NEEDQ ? GLD(v2u, pr, c.cq) : zero; w.k = GLD(v2u, pr, c.ck); w.v = GLD(v2u, pr, c.cv); w.z = (MIX == 2) ? GLD(v2u, pr, c.cz) : zero;
}
__device__ __forceinline__ float bfx(const v2u& w, int i) { const unsigned d = (i >> 1) ? w.y : w.x; return __builtin_bit_cast(float, (i & 1) ? (d & 0xffff0000u) : (d << 16)); }
template <int MIX, bool NEEDQ, int DIR>
__device__ __forceinline__ void mx_batch(const MxRaw& cur, const MixP& mp, const MxC& c, int tposs  , int lane, LAS unsigned char* wl, int b, float& P) {
    constexpr int DK = (MIX == 2) ? 32 : 64;
    float kt[4];
#pragma unroll
    for (int u = 0; u < 4; ++u) {
        const int cc = b * 4 + u, ts = DIR ? 63 - cc : cc, t = ts & 31;
        const int pu = DIR ? 3 - u : u; float q = bfx(cur.q, pu), k, f;
        if (MIX == 0) {
            k = bfx(cur.k, pu) * 0.125f; f = c.gamma;
            if (tposs >= 0) { const int tpos = tposs + ts; const int pos = (lane & 32) ? (tpos & 63) : (tpos >> 6);
                const unsigned ro = 4u * (unsigned)(pos * 16 + (lane & 15)); const float cs = GLD(float, mp.rcos, ro), sn = GLD(float, mp.rsin, ro);
                const float ss = (lane & 16) ? sn : -sn;
                const float kp = __shfl_xor(k, 16); k = fmaf(kp, ss, k * cs);
                if (NEEDQ) { const float qp = __shfl_xor(q, 16); q = fmaf(qp, ss, q * cs); } }
        } else if (MIX == 1) {
            const float z = bfx(cur.k, pu); const float e = __expf(-z); const float sp = __builtin_amdgcn_rcpf(1.0f + e), sn = e * sp;
            f = fmaf(c.oml, sp, c.lbv); k = c.oml * sn;
        } else {
            k = bfx(cur.k, pu) * 0.17677669529663687f; const float z = bfx(cur.z, pu) + c.bav;
            const float ls = fminf(z, 0.f) - __logf(1.0f + __expf(-fabsf(z)));
            f = __expf(ls * 0.0625f);
        }
        P = fmaxf(P * f, 1e-30f);
        const float kk = k * __builtin_amdgcn_rcpf(P); kt[DIR ? 3 - u : u] = kk;
        if (lane < DK) {
            const unsigned qk = pkbf(q * P, kk);
            if (NEEDQ) *(LAS unsigned short*)(wl + WL_QC + t * 144 + lane * 2) = (unsigned short)qk;
            *(LAS unsigned short*)(wl + WL_KC + t * 144 + lane * 2) = (unsigned short)(qk >> 16);
        }
    }
    const int g4 = ((DIR ? 63 - b * 4 : b * 4) & 31) >> 2;
    v2u kp; kp.x = pkbf(kt[0], kt[1]); kp.y = pkbf(kt[2], kt[3]);
    if (lane < DK) *(LAS v2u*)(wl + WL_KT + lane * 80 + g4 * 8) = kp;
    *(LAS v2u*)(wl + WL_VT + lane * 80 + g4 * 8) = cur.v;
}
typedef short bf16x4_t __attribute__((ext_vector_type(4)));
#define MFMA8(a, b, c) __builtin_amdgcn_mfma_f32_32x32x8bf16_1k((a), (b), (c), 0, 0, 0)
__device__ __forceinline__ bf16x4_t pack4(const f32x16& x, int s) {
    v2u p; p.x = pkbf(x[4 * s], x[4 * s + 1]); p.y = pkbf(x[4 * s + 2], x[4 * s + 3]);
    return __builtin_bit_cast(bf16x4_t, p);
}
__device__ __forceinline__ bf16x4_t ld4(const LAS unsigned char* p) { const v2u a = *(const LAS v2u*)p; return __builtin_bit_cast(bf16x4_t, a); }

template <int MODE, int DIR>
__device__ __forceinline__ void s5_mm_dir(const S5P& sp, const bf16* P, int b, int g, int sg, int lane, float& hre, float& him, LAS float* yf, LAS unsigned char* hs, bf16* Z) {
    const int m32 = lane & 31, hh = lane >> 5, dg = DIR * 16 + g, row0 = seg_row0(b, sg);
    float ar[2], ai[2], a2r[2], a2i[2], a3r[2], a3i[2], a4r[2], a4i[2];
    bf16x4_t bfr[4][2];
    const float dt = __expf(sp.log_dt[dg]);
#pragma unroll
    for (int sh = 0; sh < 2; ++sh) {
        const int p = 32 * sh + m32;
        const float lre = sp.lam_re[dg * 64 + p], lim = sp.lam_im[dg * 64 + p];
        const float er = __expf(lre * dt), sn = sinf(lim * dt), cs = cosf(lim * dt);
        ar[sh] = er * cs; ai[sh] = er * sn;
        a2r[sh] = ar[sh] * ar[sh] - ai[sh] * ai[sh]; a2i[sh] = ar[sh] * ai[sh] + ar[sh] * ai[sh];
        a3r[sh] = a2r[sh] * ar[sh] - a2i[sh] * ai[sh]; a3i[sh] = a2r[sh] * ai[sh] + a2i[sh] * ar[sh];
        a4r[sh] = a2r[sh] * a2r[sh] - a2i[sh] * a2i[sh]; a4i[sh] = a2r[sh] * a2i[sh] + a2r[sh] * a2i[sh];
        const float nr = ar[sh] - 1.0f, ni = ai[sh], den = 1.0f / (lre * lre + lim * lim);
        const float cr = (nr * lre + ni * lim) * den, ci = (ni * lre - nr * lim) * den;
#pragma unroll
        for (int s2 = 0; s2 < 2; ++s2) {
            const f32x4 Br = *(const f32x4*)(sp.b_re + ((size_t)dg * 64 + p) * 16 + 8 * s2 + 4 * hh), Bi = *(const f32x4*)(sp.b_im + ((size_t)dg * 64 + p) * 16 + 8 * s2 + 4 * hh);
            const f32x4 re = Br * cr - Bi * ci, im = Bi * cr + Br * ci;
            v2u pr, pi; pr.x = pkbf(re[0], re[1]); pr.y = pkbf(re[2], re[3]); pi.x = pkbf(im[0], im[1]); pi.y = pkbf(im[2], im[3]);
            bfr[sh][s2] = __builtin_bit_cast(bf16x4_t, pr); bfr[2 + sh][s2] = __builtin_bit_cast(bf16x4_t, pi);
        }
    }
    bf16x4_t cfr[16];
    if (MODE != 0) {
#pragma unroll
        for (int s = 0; s < 16; ++s) {
            const int p4 = (8 * s + 4 * hh) & 63; f32x4 cv = {0.f, 0.f, 0.f, 0.f};
            if (m32 < 16) cv = (s < 8) ? *(const f32x4*)(sp.c_re + ((size_t)dg * 16 + m32) * 64 + p4) : -*(const f32x4*)(sp.c_im + ((size_t)dg * 16 + m32) * 64 + p4);
            v2u pc; pc.x = pkbf(cv[0], cv[1]); pc.y = pkbf(cv[2], cv[3]); cfr[s] = __builtin_bit_cast(bf16x4_t, pc);
        }
    }
    const float ddv = (MODE == 2 && m32 < 16) ? sp.dd[g * 16 + m32] : 0.f;
    float hr[2], hi[2];
    hr[0] = __shfl(hre, m32); hi[0] = __shfl(him, m32); hr[1] = __shfl(hre, m32 + 32); hi[1] = __shfl(him, m32 + 32);
#pragma unroll 1
    for (int ci2 = 0; ci2 < 2; ++ci2) {
        const int ch = DIR ? 1 - ci2 : ci2, rowc = row0 + 32 * ch;
        const bf16* urow = P + (size_t)((rowc + m32) >> 2) * P4G + P4S5 + (m32 & 3) * 256 + g * 16 + 4 * hh;
        const bf16x4_t ua0 = __builtin_bit_cast(bf16x4_t, *(const v2u*)urow), ua1 = __builtin_bit_cast(bf16x4_t, *(const v2u*)(urow + 8));
        f32x16 BU[4];
#pragma unroll
        for (int nt = 0; nt < 4; ++nt) {
#pragma unroll
            for (int r = 0; r < 16; ++r) BU[nt][r] = 0.f;
            BU[nt] = MFMA8(ua0, bfr[nt][0], BU[nt]); BU[nt] = MFMA8(ua1, bfr[nt][1], BU[nt]);
        }
#pragma unroll
        for (int sh = 0; sh < 2; ++sh)
#pragma unroll
            for (int gg = 0; gg < 4; ++gg)
#pragma unroll
                for (int jj = 1; jj < 4; ++jj) {
                    const int r = DIR ? 4 * gg + 3 - jj : 4 * gg + jj, rp = DIR ? r + 1 : r - 1;
                    const float pr = BU[sh][rp], pi = BU[2 + sh][rp];
                    BU[sh][r] += ar[sh] * pr - ai[sh] * pi; BU[2 + sh][r] += ar[sh] * pi + ai[sh] * pr;
                }
        float hnr[2][4], hni[2][4];
#pragma unroll
        for (int st = 0; st < 8; ++st) {
            const int gg = DIR ? 3 - (st >> 1) : (st >> 1), turn = DIR ? 1 - (st & 1) : (st & 1), rl = DIR ? 4 * gg : 4 * gg + 3;
            const bool act = (hh == turn);
#pragma unroll
            for (int sh = 0; sh < 2; ++sh) {
                if (turn == (DIR ? 1 : 0)) { hnr[sh][gg] = hr[sh]; hni[sh][gg] = hi[sh]; }
                else { hnr[sh][gg] = act ? hr[sh] : hnr[sh][gg]; hni[sh][gg] = act ? hi[sh] : hni[sh][gg]; }
                const float outr = BU[sh][rl] + a4r[sh] * hr[sh] - a4i[sh] * hi[sh], outi = BU[2 + sh][rl] + a4r[sh] * hi[sh] + a4i[sh] * hr[sh];
                const float sr = __shfl_xor(outr, 32), si = __shfl_xor(outi, 32);
                hr[sh] = act ? outr : sr; hi[sh] = act ? outi : si;
            }
        }
        if (MODE != 0) {
#pragma unroll
            for (int sh = 0; sh < 2; ++sh)
#pragma unroll
                for (int gg = 0; gg < 4; ++gg)
#pragma unroll
                    for (int jj = 0; jj < 4; ++jj) {
                        const int pw = DIR ? 4 - jj : jj + 1;
                        const float pr = (pw == 1) ? ar[sh] : (pw == 2) ? a2r[sh] : (pw == 3) ? a3r[sh] : a4r[sh], pi = (pw == 1) ? ai[sh] : (pw == 2) ? a2i[sh] : (pw == 3) ? a3i[sh] : a4i[sh];
                        BU[sh][4 * gg + jj] += pr * hnr[sh][gg] - pi * hni[sh][gg]; BU[2 + sh][4 * gg + jj] += pr * hni[sh][gg] + pi * hnr[sh][gg];
                    }
#pragma unroll
            for (int nt = 0; nt < 4; ++nt)
#pragma unroll
                for (int r = 0; r < 16; ++r) *(LAS unsigned short*)(hs + ((r & 3) + 8 * (r >> 2) + 4 * hh) * 272 + (32 * nt + m32) * 2) = (unsigned short)pkbf(BU[nt][r], BU[nt][r]);
            f32x16 Yv;
#pragma unroll
            for (int r = 0; r < 16; ++r) Yv[r] = 0.f;
#pragma unroll
            for (int s = 0; s < 16; ++s) Yv = MFMA8(ld4(hs + m32 * 272 + (8 * s + 4 * hh) * 2), cfr[s], Yv);
            if (m32 < 16) {
#pragma unroll
                for (int r = 0; r < 16; ++r) {
                    const int tl = (r & 3) + 8 * (r >> 2) + 4 * hh;
                    if (MODE == 1) yf[(32 * ch + tl) * 16 + m32] = Yv[r];
                    else { const float u = bf2f(P[(size_t)((rowc + tl) >> 2) * P4G + P4S5 + (tl & 3) * 256 + g * 16 + m32]);
                        const float y = Yv[r] + yf[(32 * ch + tl) * 16 + m32] + ddv * u;
                        const float zz = gelu_tanh(y); Z[(size_t)(rowc + tl) * 256 + g * 16 + m32] = (bf16)pkbf(zz, zz); }
                }
            }
        }
    }
    hre = hh ? hr[1] : hr[0]; him = hh ? hi[1] : hi[0];
}
template <int MODE>
__device__ __forceinline__ void s5_mm(const S5P& sp, const bf16* P, int b, int g, int dir, int sg, int lane, float& hre, float& him, LAS float* yf, LAS unsigned char* hs, bf16* Z) {
    if (dir) s5_mm_dir<MODE, 1>(sp, P, b, g, sg, lane, hre, him, yf, hs, Z); else s5_mm_dir<MODE, 0>(sp, P, b, g, sg, lane, hre, him, yf, hs, Z);
}
template <int MIX, int DIR, bool WITH_O>
__device__ __forceinline__ void mx_chunk(LAS unsigned char* wl, int lane, float Pl, f32x16 (&ST)[(MIX == 2) ? 1 : 2][2], f32x16 (&O)[2]) {
    constexpr int DK = (MIX == 2) ? 32 : 64, NRT = DK / 32;
    const int m32 = lane & 31, hh = lane >> 5;
    asm volatile("" ::: "memory");
    if (lane < DK) *(LAS float*)(wl + WL_PL + lane * 4) = Pl;
    asm volatile("" ::: "memory");
    if (WITH_O) {
        f32x16 x;
#pragma unroll
        for (int r = 0; r < 16; ++r) x[r] = 0.f;
#pragma unroll
        for (int s = 0; s < DK / 8; ++s) {
            const bf16x4_t ka = ld4(wl + WL_KC + m32 * 144 + (8 * s + 4 * hh) * 2);
            const bf16x4_t qb = ld4(wl + WL_QC + m32 * 144 + (8 * s + 4 * hh) * 2);
            x = MFMA8(ka, qb, x);
        }
#pragma unroll
        for (int r = 0; r < 16; ++r) { const int j = (r & 3) + 8 * (r >> 2) + 4 * hh; const bool keep = DIR ? (j >= m32) : (j <= m32); x[r] = keep ? x[r] : 0.f; }
#pragma unroll
        for (int t = 0; t < 2; ++t)
#pragma unroll
            for (int r = 0; r < 16; ++r) O[t][r] = 0.f;
#pragma unroll
        for (int s = 0; s < 4; ++s) {
            const bf16x4_t xa = pack4(x, s);
#pragma unroll
            for (int t = 0; t < 2; ++t) O[t] = MFMA8(xa, ld4(wl + WL_VT + (32 * t + m32) * 80 + (8 * s + 4 * hh) * 2), O[t]);
        }
#pragma unroll
        for (int rt = 0; rt < NRT; ++rt)
#pragma unroll
            for (int s = 0; s < 4; ++s) {
                const bf16x4_t qa = ld4(wl + WL_QC + m32 * 144 + (32 * rt + 8 * s + 4 * hh) * 2);
#pragma unroll
                for (int t = 0; t < 2; ++t) O[t] = MFMA8(qa, pack4(ST[rt][t], s), O[t]);
            }
    }
#pragma unroll
    for (int rt = 0; rt < NRT; ++rt)
#pragma unroll
        for (int s = 0; s < 4; ++s) {
            const bf16x4_t ka = ld4(wl + WL_KT + (32 * rt + m32) * 80 + (8 * s + 4 * hh) * 2);
#pragma unroll
            for (int t = 0; t < 2; ++t) ST[rt][t] = MFMA8(ka, ld4(wl + WL_VT + (32 * t + m32) * 80 + (8 * s + 4 * hh) * 2), ST[rt][t]);
        }
#pragma unroll
    for (int rt = 0; rt < NRT; ++rt)
#pragma unroll
        for (int g = 0; g < 4; ++g) {
            const f32x4 pl4 = *(const LAS f32x4*)(wl + WL_PL + (32 * rt + 8 * g + 4 * hh) * 4);
#pragma unroll
            for (int e = 0; e < 4; ++e) { ST[rt][0][4 * g + e] *= pl4[e]; ST[rt][1][4 * g + e] *= pl4[e]; }
        }
}
__device__ __forceinline__ float half_sum(float v) {
#pragma unroll
    for (int o = 1; o < 32; o <<= 1) v += __shfl_xor(v, o);
    return v;
}
template <int MIX, int DIR>
__device__ __forceinline__ void mixA_stream(const MixP& mp, const MxC& c, int row0, int tpos0, int lane, LAS unsigned char* wl, f32x16 (&ST)[(MIX == 2) ? 1 : 2][2], float& Gam) {
    f32x16 O[2];
    MxRaw r0, r1, r2;
    mx_load<MIX, false, DIR>(r0, mp, c, row0, 0); mx_load<MIX, false, DIR>(r1, mp, c, row0, 1); mx_load<MIX, false, DIR>(r2, mp, c, row0, 2);
    float P = 1.0f;
#pragma unroll 1
    for (int b = 0; b < 16; ++b) {
        MxRaw r3; mx_load<MIX, false, DIR>(r3, mp, c, row0, b < 13 ? b + 3 : 15);
        int ln = lane; asm volatile("" : "+v"(ln));
        mx_batch<MIX, false, DIR>(r0, mp, c, tpos0, ln, wl, b, P);
        if ((b & 7) == 7) { Gam *= P; mx_chunk<MIX, 0, false>(wl, ln, P, ST, O); P = 1.0f; }
        r0 = r1; r1 = r2; r2 = r3;
    }
}
template <int MIX>
__device__ __forceinline__ void mixA_unit(const MixP& mp, float* STG, int idx, int lane_in, LAS unsigned char* wl) {
    int lane = lane_in;
    constexpr int DK = (MIX == 2) ? 32 : 64, NRT = DK / 32;
    const int dir = idx / 2112, rem = idx - dir * 2112, bh = rem / NSEG, sg = rem - bh * NSEG, b = bh >> 2, h = bh & 3;
    asm volatile("" : "+v"(lane));
    MxC c; mx_consts<MIX>(c, mp, h, dir, lane);
    f32x16 ST[NRT][2];
#pragma unroll
    for (int rt = 0; rt < NRT; ++rt)
#pragma unroll
        for (int t = 0; t < 2; ++t)
#pragma unroll
            for (int r = 0; r < 16; ++r) ST[rt][t][r] = 0.f;
    const int row0 = seg_row0(b, sg), tpos0 = seg_tpos0(sg);
    float Gam = 1.0f;
    if (dir) mixA_stream<MIX, 1>(mp, c, row0, tpos0, lane, wl, ST, Gam); else mixA_stream<MIX, 0>(mp, c, row0, tpos0, lane, wl, ST, Gam);
    const size_t slot = (size_t)((dir * 16 + bh) * NSEG + sg);
    float* ds = STG + (MIX == 0 ? ST_DS0 : (MIX == 1 ? ST_DS1 : ST_DS2)) + slot * (DK * 64);
    const int m32 = lane & 31, hh = lane >> 5;
#pragma unroll
    for (int rt = 0; rt < NRT; ++rt)
#pragma unroll
        for (int t = 0; t < 2; ++t)
#pragma unroll
            for (int r = 0; r < 16; ++r) GST(float, ds + (32 * rt + (r & 3) + 8 * (r >> 2)) * 64 + 32 * t, 4u * (unsigned)(4 * hh * 64 + m32)) = ST[rt][t][r];
    float* gs = STG + (MIX == 0 ? ST_G0 : (MIX == 1 ? ST_G1 : ST_G2)) + slot * 64;
    GST(float, gs, 4u * (unsigned)lane) = Gam;
}
template <int MIX, int MODE>
__device__ __forceinline__ void mx_epilogue(const MixP& mp, LAS unsigned char* wl, int lane, const f32x16 (&O)[2], int rowc, float* OF, bf16* Y, int ocol, int ycol, int cgate, float nwv) {
    LAS float* ost = (LAS float*)(wl + WL_QC);
    const int m32 = lane & 31, hh = lane >> 5;
    asm volatile("" ::: "memory");
#pragma unroll
    for (int t = 0; t < 2; ++t)
#pragma unroll
        for (int r = 0; r < 16; ++r) ost[((r & 3) + 8 * (r >> 2) + 4 * hh) * 68 + 32 * t + m32] = O[t][r];
    asm volatile("" ::: "memory");
    if (MODE == 1) {
#pragma unroll 8
        for (int tk = 0; tk < 32; ++tk) GST(float, OF + (size_t)(rowc + tk) * 768 + ocol, 4u * (unsigned)lane) = ost[tk * 68 + lane];
    } else {
        float ofc[8]; v2u gc[2];
#pragma unroll
        for (int u = 0; u < 8; ++u) ofc[u] = GLD(float, OF + (size_t)(rowc + u) * 768 + ocol, 4u * (unsigned)lane);
#pragma unroll
        for (int u = 0; u < 2; ++u) gc[u] = GLD(v2u, mp.P + (size_t)((rowc >> 2) + u) * P4G, 8u * (unsigned)(cgate + lane));
#pragma unroll 1
        for (int b8 = 0; b8 < 4; ++b8) {
            float ofn[8]; v2u gn[2]; const int nb = b8 < 3 ? b8 + 1 : 3;
#pragma unroll
            for (int u = 0; u < 8; ++u) ofn[u] = GLD(float, OF + (size_t)(rowc + nb * 8 + u) * 768 + ocol, 4u * (unsigned)lane);
#pragma unroll
            for (int u = 0; u < 2; ++u) gn[u] = GLD(v2u, mp.P + (size_t)((rowc >> 2) + nb * 2 + u) * P4G, 8u * (unsigned)(cgate + lane));
#pragma unroll
            for (int u = 0; u < 8; ++u) {
                const int tk = b8 * 8 + u;
                const float o = ost[tk * 68 + lane] + ofc[u];
                float y;
                if (MIX == 0) { const float mean = wave_sum(o) * (1.0f / 64.0f); const float d = o - mean; y = d * __builtin_amdgcn_rsqf(wave_sum(d * d) * (1.0f / 64.0f) + NEPS) * nwv; }
                else y = o * __builtin_amdgcn_rsqf(wave_sum(o * o) * (1.0f / 64.0f) + NEPS) * nwv;
                y *= silu_f(bfx(gc[u >> 2], u & 3));
                GST(unsigned short, Y + (size_t)(rowc + tk) * 1024 + ycol, 2u * (unsigned)lane) = (unsigned short)pkbf(y, y);
            }
#pragma unroll
            for (int u = 0; u < 8; ++u) ofc[u] = ofn[u];
            gc[0] = gn[0]; gc[1] = gn[1];
        }
    }
}
template <int MIX, int DIR>
__device__ __forceinline__ void mixC_stream(const MixP& mp, const MxC& c, int row0, int tpos0, int lane, LAS unsigned char* wl, f32x16 (&ST)[(MIX == 2) ? 1 : 2][2],
                                            float* OF, bf16* Y, int ocol, int ycol, int cgate, float nwv) {
    f32x16 O[2];
    MxRaw r0, r1;
    mx_load<MIX, true, DIR>(r0, mp, c, row0, 0); mx_load<MIX, true, DIR>(r1, mp, c, row0, 1);
    float P = 1.0f;
#pragma unroll 1
    for (int b = 0; b < 16; ++b) {
        MxRaw r2; mx_load<MIX, true, DIR>(r2, mp, c, row0, b < 14 ? b + 2 : 15);
        int ln = lane; asm volatile("" : "+v"(ln));
        mx_batch<MIX, true, DIR>(r0, mp, c, tpos0, ln, wl, b, P);
        if ((b & 7) == 7) {
            const int ch = DIR ? 1 - (b >> 3) : (b >> 3);
            mx_chunk<MIX, DIR, true>(wl, ln, P, ST, O); P = 1.0f;
            mx_epilogue<MIX, DIR ? 2 : 1>(mp, wl, ln, O, row0 + 32 * ch, OF, Y, ocol, ycol, cgate, nwv);
        }
        r0 = r1; r1 = r2;
    }
}
template <int MIX>
__device__ __forceinline__ void mixC_unit(const MixP& mp, const float* STG, int idx, int lane_in, float* OF, LAS unsigned char* wl, bf16* Y, const float* nw) {
    int lane = lane_in; asm volatile("" : "+v"(lane));
    constexpr int DK = (MIX == 2) ? 32 : 64, NRT = DK / 32;
    const int bh = idx / NSEG, sg = idx - bh * NSEG, b = bh >> 2, h = bh & 3;
    const int row0 = seg_row0(b, sg), tpos0 = seg_tpos0(sg);
    const int ocol = ((MIX == 0) ? 0 : (MIX == 1 ? 256 : 512)) + h * 64, ycol = ((MIX == 0) ? 0 : (MIX == 1 ? 512 : 768)) + h * 64;
    const int cgate = ((MIX == 0) ? C_RG : (MIX == 1 ? C_HG : C_GG)) + h * 64;
    const float* dsb = STG + (MIX == 0 ? ST_DS0 : (MIX == 1 ? ST_DS1 : ST_DS2));
    const float nwv = nw[h * 64 + lane];
    f32x16 ST[NRT][2];
#pragma unroll 1
    for (int dir = 0; dir < 2; ++dir) {
        asm volatile("" : "+v"(lane));
        const int m32 = lane & 31, hh = lane >> 5;
        MxC c; mx_consts<MIX>(c, mp, h, dir, lane);
        { const float* ds = dsb + (size_t)((dir * 16 + bh) * NSEG + sg) * (DK * 64);
#pragma unroll
          for (int rt = 0; rt < NRT; ++rt)
#pragma unroll
              for (int t = 0; t < 2; ++t)
#pragma unroll
                  for (int r = 0; r < 16; ++r) ST[rt][t][r] = GLD(float, ds + (32 * rt + (r & 3) + 8 * (r >> 2)) * 64 + 32 * t, 4u * (unsigned)(4 * hh * 64 + m32)); }
        if (dir == 0) mixC_stream<MIX, 0>(mp, c, row0, tpos0, lane, wl, ST, OF, Y, ocol, ycol, cgate, nwv);
        else mixC_stream<MIX, 1>(mp, c, row0, tpos0, lane, wl, ST, OF, Y, ocol, ycol, cgate, nwv);
        asm volatile("s_waitcnt vmcnt(0)" ::: "memory");
    }
}
template <int MSEL>
__device__ __forceinline__ void mix_passA(const Frame& F, const Args& a, int l) {
    const MixP mp = make_mixp(F, a, l); const S5P sp = make_s5p(F, a, l);
    float* ST = (float*)(F.ws + WS_X2);
    LAS unsigned char* wl = F.lds + F.wave * WL_BYTES; LAS float* stg = (LAS float*)wl;
    if (MSEL == 15) {
        constexpr int NMX = 3 * 4224, NS5 = 2 * 64 * NSEG;
        const int heavy = NMX - (NMX / F.NGW) * F.NGW, nlight = F.NGW - heavy;
        const int n_all = (NS5 - 4 * nlight) / F.NGW;
        for (int it = 0; ; ++it) {
            int u;
            const int nmine = NMX / F.NGW + (F.gw < heavy ? 1 : 0);
            if (it < nmine) u = F.gw + it * F.NGW;
            else if (it < nmine + n_all) u = NMX + F.gw + (it - nmine) * F.NGW;
            else { const int k2 = it - nmine - n_all; if (F.gw < heavy || k2 >= 4) {
                    const int rest0 = NMX + n_all * F.NGW + 4 * nlight; const int uu = rest0 + F.gw + (k2 - (F.gw < heavy ? 0 : 4)) * F.NGW; if (uu >= NMX + NS5) break; u = uu; }
                else u = NMX + n_all * F.NGW + (F.gw - heavy) + k2 * nlight; }
            if (u >= NMX + NS5) break;
            if (u < 4224) mixA_unit<0>(mp, ST, u, fresh_lane(), wl);
            else if (u < 2 * 4224) mixA_unit<1>(mp, ST, u - 4224, fresh_lane(), wl);
            else if (u < 3 * 4224) mixA_unit<2>(mp, ST, u - 2 * 4224, fresh_lane(), wl);
            else { const int idx = u - 3 * 4224; const int dir = idx / (64 * NSEG), rem = idx - dir * 64 * NSEG, bg = rem / NSEG, sg = rem - bg * NSEG;
                float hre = 0.f, him = 0.f;
                s5_mm<0>(sp, mp.P, bg >> 4, bg & 15, dir, sg, fresh_lane(), hre, him, nullptr, wl, nullptr);
                float* hs = ST + ST_HS + ((size_t)((dir * 64 + bg) * NSEG + sg) * 64 + fresh_lane()) * 2;
                hs[0] = hre; hs[1] = him; }
        }
        return;
    }
    if (MSEL & 1) for (int u = F.gw; u < 4224; u += F.NGW) mixA_unit<0>(mp, ST, u, fresh_lane(), wl);
    if (MSEL & 2) for (int u = F.gw; u < 4224; u += F.NGW) mixA_unit<1>(mp, ST, u, fresh_lane(), wl);
    if (MSEL & 4) for (int u = F.gw; u < 4224; u += F.NGW) mixA_unit<2>(mp, ST, u, fresh_lane(), wl);
    if (MSEL & 8) for (int idx = F.gw; idx < 2 * 64 * NSEG; idx += F.NGW) {
        const int dir = idx / (64 * NSEG), rem = idx - dir * 64 * NSEG, bg = rem / NSEG, sg = rem - bg * NSEG;
        float hre = 0.f, him = 0.f;
        s5_mm<0>(sp, mp.P, bg >> 4, bg & 15, dir, sg, fresh_lane(), hre, him, nullptr, wl, nullptr);
        float* hs = ST + ST_HS + ((size_t)((dir * 64 + bg) * NSEG + sg) * 64 + fresh_lane()) * 2;
        hs[0] = hre; hs[1] = him;
    }
}
__device__ __forceinline__ int chain_seg(int dir, int p) { return dir ? (p < 4 ? 3 - p : 135 - p) : p; }
__device__ __forceinline__ void mix_passB(const Frame& F, const Args& a, int l) {
    float* ST = (float*)(F.ws + WS_X2);
    constexpr int N0 = 32768, N1 = 32768, N2 = 16384, N3 = 8192;
    for (int e = blockIdx.x * 512 + F.tid; e < N0 + N1 + N2 + N3; e += F.G * 512) {
        if (e < N0 + N1 + N2) {
            float* base; const float* gb; int dir, esz;
            if (e < N0 + N1) { const int mix = e >= N0, e2 = e - mix * N0, c = e2 >> 10, el = (e2 & 1023) * 4; dir = c >> 4; esz = 4096;
                base = ST + (mix ? ST_DS1 : ST_DS0) + (size_t)c * NSEG * 4096 + el; gb = ST + (mix ? ST_G1 : ST_G0) + (size_t)c * NSEG * 64 + (el >> 6); }
            else { const int e2 = e - N0 - N1, c = e2 >> 9, el = (e2 & 511) * 4; dir = c >> 4; esz = 2048;
                base = ST + ST_DS2 + (size_t)c * NSEG * 2048 + el; gb = ST + ST_G2 + (size_t)c * NSEG * 64 + (el >> 6); }
            f32x4 run = {0.f, 0.f, 0.f, 0.f};
#pragma unroll 1
            for (int p0 = 0; p0 < NSEG; p0 += 12) {
                f32x4 d[12]; float gm[12];
#pragma unroll
                for (int q = 0; q < 12; ++q) { const int sg = chain_seg(dir, p0 + q); d[q] = *(const f32x4*)(base + (size_t)sg * esz); gm[q] = gb[sg * 64]; }
#pragma unroll
                for (int q = 0; q < 12; ++q) { const int sg = chain_seg(dir, p0 + q); *(f32x4*)(base + (size_t)sg * esz) = run; run = run * gm[q] + d[q]; }
            }
        } else {
            const int e2 = e - N0 - N1 - N2, c = e2 >> 6, p = e2 & 63, dir = c >> 6, g = c & 15;
            const int dg = dir * 16 + g;
            const float lre = a.in[F.zz + I_LAMRE][(size_t)l * 2048 + dg * 64 + p], lim = a.in[F.zz + I_LAMIM][(size_t)l * 2048 + dg * 64 + p], dt = expf(a.in[F.zz + I_LOGDT][l * 32 + dg]);
            const float er = expf(lre * dt * 64.0f); const float sn = sinf(lim * dt * 64.0f), cs = cosf(lim * dt * 64.0f);
            const float ar = er * cs, ai = er * sn;
            float* base = ST + ST_HS + ((size_t)c * NSEG * 64 + p) * 2;
            float rr = 0.f, ri = 0.f;
#pragma unroll 1
            for (int q0 = 0; q0 < NSEG; q0 += 12) {
                float dr[12], di[12];
#pragma unroll
                for (int q = 0; q < 12; ++q) { const int sg = chain_seg(dir, q0 + q); dr[q] = base[(size_t)sg * 128]; di[q] = base[(size_t)sg * 128 + 1]; }
#pragma unroll
                for (int q = 0; q < 12; ++q) { const int sg = chain_seg(dir, q0 + q); base[(size_t)sg * 128] = rr; base[(size_t)sg * 128 + 1] = ri;
                    const float nr = ar * rr - ai * ri + dr[q], ni = ar * ri + ai * rr + di[q]; rr = nr; ri = ni; }
            }
        }
    }
}
template <int MSEL>
__device__ __forceinline__ void mix_passC(const Frame& F, const Args& a, int l) {
    const MixP mp = make_mixp(F, a, l); const S5P sp = make_s5p(F, a, l);
    const float* ST = (const float*)(F.ws + WS_X2);
    LAS unsigned char* wl = F.lds + F.wave * WL_BYTES;
    LAS float* stg = (LAS float*)wl; LAS float* of = (LAS float*)(wl + 9216);
    float* OF = (float*)(F.ws + WS_OF);
    bf16* Y = (bf16*)(F.ws + WS_ACT); bf16* Z = (bf16*)(F.ws + WS_Z);
    const bool keep = l < DEPTH - 1;
    constexpr int NM = 16 * NSEG;
    if (MSEL == 15) {
        constexpr int NMX = 3 * NM, NS5 = 64 * NSEG;
        const int heavy = NMX - (NMX / F.NGW) * F.NGW, nlight = F.NGW - heavy;
        for (int it = 0; ; ++it) {
            int u;
            const int nmine = NMX / F.NGW + (F.gw < heavy ? 1 : 0);
            if (it < nmine) u = F.gw + it * F.NGW;
            else { if (F.gw < heavy) break; u = NMX + (F.gw - heavy) + (it - nmine) * nlight; }
            if (u >= NMX + NS5) break;
            const int sgu = (u < 3 * NM) ? (u % NSEG) : ((u - 3 * NM) % NSEG);
            if (!keep && sgu < 4) continue;
            if (u < NM) mixC_unit<0>(mp, ST, u, fresh_lane(), OF, wl, Y, a.in[F.zz + I_RETGN] + l * 256);
            else if (u < 2 * NM) mixC_unit<1>(mp, ST, u - NM, fresh_lane(), OF, wl, Y, a.in[F.zz + I_HGNW] + l * 256);
            else if (u < 3 * NM) mixC_unit<2>(mp, ST, u - 2 * NM, fresh_lane(), OF, wl, Y, a.in[F.zz + I_GLANW] + l * 256);
            else { const int idx = u - 3 * NM, bg = idx / NSEG, sg = idx - bg * NSEG;
                const float* h0 = ST + ST_HS + ((size_t)((0 * 64 + bg) * NSEG + sg) * 64 + fresh_lane()) * 2;
                float hre = h0[0], him = h0[1];
                s5_mm<1>(sp, mp.P, bg >> 4, bg & 15, 0, sg, fresh_lane(), hre, him, of, wl, Z);
                const float* h1 = ST + ST_HS + ((size_t)((1 * 64 + bg) * NSEG + sg) * 64 + fresh_lane()) * 2;
                hre = h1[0]; him = h1[1];
                s5_mm<2>(sp, mp.P, bg >> 4, bg & 15, 1, sg, fresh_lane(), hre, him, of, wl, Z); }
        }
        return;
    }
    if (MSEL & 1) for (int u = F.gw; u < NM; u += F.NGW) { if (!keep && (u % NSEG) < 4) continue; mixC_unit<0>(mp, ST, u, fresh_lane(), OF, wl, Y, a.in[F.zz + I_RETGN] + l * 256); }
    if (MSEL & 2) for (int u = F.gw; u < NM; u += F.NGW) { if (!keep && (u % NSEG) < 4) continue; mixC_unit<1>(mp, ST, u, fresh_lane(), OF, wl, Y, a.in[F.zz + I_HGNW] + l * 256); }
    if (MSEL & 4) for (int u = F.gw; u < NM; u += F.NGW) { if (!keep && (u % NSEG) < 4) continue; mixC_unit<2>(mp, ST, u, fresh_lane(), OF, wl, Y, a.in[F.zz + I_GLANW] + l * 256); }
    if (MSEL & 8) for (int idx = F.gw; idx < 64 * NSEG; idx += F.NGW) {
        const int bg = idx / NSEG, sg = idx - bg * NSEG;
        if (!keep && sg < 4) continue;
        const float* h0 = ST + ST_HS + ((size_t)((0 * 64 + bg) * NSEG + sg) * 64 + fresh_lane()) * 2;
        float hre = h0[0], him = h0[1];
        s5_mm<1>(sp, mp.P, bg >> 4, bg & 15, 0, sg, fresh_lane(), hre, him, of, wl, Z);
        const float* h1 = ST + ST_HS + ((size_t)((1 * 64 + bg) * NSEG + sg) * 64 + fresh_lane()) * 2;
        hre = h1[0]; him = h1[1];
        s5_mm<2>(sp, mp.P, bg >> 4, bg & 15, 1, sg, fresh_lane(), hre, him, of, wl, Z);
    }
}

constexpr int NPH = 11;
template <int PH_MASK, int MSEL>
__global__ void __launch_bounds__(512, 2) mk_fwd(Args a) {
    extern __shared__ __attribute__((aligned(16))) unsigned char lds_raw[];
    Frame F;
    F.lds = (LAS unsigned char*)lds_raw;
    const int wave0 = __builtin_amdgcn_readfirstlane((int)threadIdx.x >> 6);
    F.lane = fresh_lane(); F.tid = wave0 * 64 + F.lane; F.wave = wave0;
    F.G = gridDim.x; F.gw = blockIdx.x * 8 + F.wave; F.NGW = F.G * 8; F.zz = 0; F.ws = (unsigned char*)a.in[I_WS]; F.out = (float*)a.in[I_OUT];
    volatile LAS unsigned* MISC = (volatile LAS unsigned*)(F.lds + MISC_OFF);
    for (int u = F.tid; u < 64; u += 512) ((LAS unsigned*)(F.lds + MISC_OFF))[u] = 0u;
    __syncthreads();
    XcdBarrier bar; bar.bar = (unsigned*)F.ws + CW_BAR; bar.x = 0; bar.st = nullptr;
    if (a.fused) bar = xcd_barrier_post((unsigned*)F.ws + CW_BAR, MISC + 8, F.tid);
#define SEAM() do { if (a.fused) { XcdBarrier bb = bar; asm volatile("" : "+s"(bb.bar), "+s"(bb.x)); xcd_barrier(bb, wave0 * 64 + fresh_lane()); } } while (0)
#define PHASE_BEGIN() do { int zz_ = 0; asm volatile("" : "+s"(zz_)); F.zz = zz_; F.ws = (unsigned char*)a.in[I_WS + zz_]; F.out = (float*)a.in[I_OUT + zz_]; \
        const int ln_ = fresh_lane(); const int t_ = wave0 * 64 + ln_ + zz_; F.tid = t_; F.lane = t_ & 63; F.wave = wave0 + zz_; F.G = (int)gridDim.x + zz_; F.gw = ((int)blockIdx.x + zz_) * 8 + F.wave; F.NGW = F.G * 8; \
        F.lds = (LAS unsigned char*)lds_raw + zz_; } while (0)
#define IN(k) (((PH_MASK >> (k)) & 1) && a.ph_lo <= (k) && (k) < a.ph_hi)
#ifndef DUP_PH
#define DUP_PH 0
#endif
#define REP(k) for (int rep_ = 0; rep_ < (((DUP_PH >> (k)) & 1) ? 2 : 1); ++rep_)
#define hb ((float*)(F.ws + WS_HB))
#define MOD ((const float*)(F.ws + WS_MOD))
#define ACT ((bf16*)(F.ws + WS_ACT))
#define PH ((bf16*)(F.ws + WS_PH))

    if (((PH_MASK >> 12) & 1) && a.do_pro) REP(12) { PHASE_BEGIN(); prologue(F, a); SEAM(); }

#pragma unroll
    for (int l = 0; l < DEPTH; ++l) {
        if (l < a.l_lo || l >= a.l_hi) continue;
        const bool keep = l < DEPTH - 1, moe = l & 1; const int j = l >> 1;
        const int Mrows = keep ? MT : NLAT;
        if (IN(0)) for (int rep_ = 0; rep_ < ((((DUP_PH >> 0) & 1) && l != 2) ? 2 : 1); ++rep_) { PHASE_BEGIN();
            norm_phase<0>(F, a, l, 0, MT, (l == 2) ? 1 : -1);
            SEAM();
        }
        if (IN(1)) REP(1) { PHASE_BEGIN();
            pg8::Gemm g{ACT, (const bf16*)(F.ws + WS_WIN) + (size_t)l * DINP * 1024, MT, DINP, 1024}; pg8::StaticOrder S; S.init(MT, DINP, F.G, (int)blockIdx.x);
            EpiStoreP4 E{PH};
            pg8::gemm_phase<EpiStoreP4, pg8::StaticOrder, true, true>(F.lds, g, S, E, F.tid);
            SEAM();
        }
        if (IN(2)) { PHASE_BEGIN(); mix_passA<MSEL>(F, a, l); SEAM(); }
#ifdef DUP_MIX
        if (IN(2)) { PHASE_BEGIN(); mix_passA<DUP_MIX>(F, a, l); SEAM(); }
#endif
        if (IN(3)) { PHASE_BEGIN(); mix_passB(F, a, l); SEAM(); }
        if (IN(4)) { PHASE_BEGIN(); mix_passC<MSEL>(F, a, l); SEAM(); }
#ifdef DUP_MIX
        if (IN(4)) { PHASE_BEGIN(); mix_passC<DUP_MIX>(F, a, l); SEAM(); }
#endif
        if (IN(5)) REP(5) { PHASE_BEGIN();
            int k256 = 256; asm volatile("" : "+s"(k256)); pg8::Gemm g{(const bf16*)(F.ws + WS_Z), (const bf16*)(F.ws + WS_GLUW) + (size_t)l * 65536, Mrows, 256, k256}; pg8::StaticOrder S; S.init(Mrows, 256, F.G, (int)blockIdx.x);
            EpiGlu E{(const bf16*)(F.ws + WS_Z), ACT, a.in[F.zz + I_GLUB] + l * 256};
            pg8::gemm_phase<EpiGlu, pg8::StaticOrder, true, true>(F.lds, g, S, E, F.tid);
            SEAM();
        }
        if (IN(6)) { PHASE_BEGIN();
            pg8::Gemm g{ACT, (const bf16*)(F.ws + WS_WOUT) + (size_t)l * 1024 * 1024, Mrows, 1024, 1024}; pg8::StaticOrder S; S.init(Mrows, 1024, F.G, (int)blockIdx.x);
            EpiResid E{(l == 0) ? a.in[F.zz + I_X] : F.out, (l == 0) ? a.in[F.zz + I_CTX] : hb, F.out, hb, MOD + (size_t)l * 5 * 6144 + 2 * 1024, 1.0f};
            pg8::gemm_phase<EpiResid, pg8::StaticOrder, true, true>(F.lds, g, S, E, F.tid);
            SEAM();
        }
        if (IN(7)) for (int rep_ = 0; rep_ < ((((DUP_PH >> 7) & 1) && !moe) ? 2 : 1); ++rep_) { PHASE_BEGIN();
            if (moe) norm_phase<1>(F, a, l, 1, Mrows, -1); else norm_phase<0>(F, a, l, 1, Mrows, -1);
            SEAM();
        }
        if (!moe) {
            if (IN(8)) REP(8) { PHASE_BEGIN();
                pg8::Gemm g{ACT, (const bf16*)(F.ws + WS_W13D) + (size_t)j * 5632 * 1024, Mrows, 5632, 1024}; pg8::StaticOrder S; S.init(Mrows, 5632, F.G, (int)blockIdx.x);
                EpiSwiglu8 E{(unsigned char*)PH, 1.0f};
                pg8::gemm_phase<EpiSwiglu8, pg8::StaticOrder, true, true>(F.lds, g, S, E, F.tid);
                SEAM();
            }
            if (IN(9)) { PHASE_BEGIN();
                int k8 = DFF / 2; asm volatile("" : "+s"(k8)); pg8::Gemm g{PH, (const bf16*)(F.ws + WS_W2D + (size_t)j * 1024 * DFF), Mrows, 1024, k8}; pg8::StaticOrder S; S.init(Mrows, 1024, F.G, (int)blockIdx.x);
                EpiResid E{F.out, hb, F.out, hb, MOD + (size_t)l * 5 * 6144 + 5 * 1024, 1.0f / WSC8};
                pg8::gemm_phase_f8<EpiResid, pg8::StaticOrder, true, true>(F.lds, g, S, E, F.tid);
                { const int rem = ((Mrows / 256) * 4) % F.G; if (rem > 0 && (int)blockIdx.x >= rem) moe_cvt_idle(F, a, j, rem); else if (rem == 0) moe_cvt(F, a, j); }
                SEAM();
            }
        } else {
                        if (IN(8)) REP(8) { PHASE_BEGIN(); moe_gather(F, j); SEAM(); }
            if (IN(9)) REP(9) { PHASE_BEGIN();
                int k8 = 512; asm volatile("" : "+s"(k8)); pg8::Gemm g{(const bf16*)(F.ws + WS_X2), (const bf16*)(F.ws + WS_W13M), 0, 5632, k8}; MoeOrder S; S.init((const unsigned*)F.ws + CW_CNT + j * 8 * 64, 22, F.G, (int)blockIdx.x);
                EpiSwiglu8 E{(unsigned char*)PH, 1.0f / WSC8};
                pg8::gemm_phase_f8<EpiSwiglu8, MoeOrder, true, true>(F.lds, g, S, E, F.tid);
                SEAM();
            }
            if (IN(10)) REP(10) { PHASE_BEGIN();
                int k8 = DFF / 2; asm volatile("" : "+s"(k8)); pg8::Gemm g{PH, (const bf16*)(F.ws + WS_W2M), 0, 1024, k8}; MoeOrder S; S.init((const unsigned*)F.ws + CW_CNT + j * 8 * 64, 4, F.G, (int)blockIdx.x);
                EpiStoreBf16 E{(bf16*)(F.ws + WS_X2), 1024, 1.0f / WSC8};
                pg8::gemm_phase_f8<EpiStoreBf16, MoeOrder, true, true>(F.lds, g, S, E, F.tid);
                SEAM();
            }
        }
    }
    if (((PH_MASK >> 13) & 1) && a.do_fin) { PHASE_BEGIN(); norm_phase<2>(F, a, DEPTH - 1, 0, NLAT, DEPTH - 1); }
#undef SEAM
#undef IN
#undef hb
#undef MOD
#undef ACT
#undef PH
}

#ifndef MK_FUSED
#define MK_FUSED 1
#endif
template <int PM, int MS> static void launch_one(const Args& a, int grid, hipStream_t stream) {
    static bool attr_done = false;
    if (!attr_done) { (void)hipFuncSetAttribute((const void*)mk_fwd<PM, MS>, hipFuncAttributeMaxDynamicSharedMemorySize, LDS_BYTES); attr_done = true; }
    hipLaunchKernelGGL((mk_fwd<PM, MS>), dim3(grid), dim3(512), LDS_BYTES, stream, a);
}
extern "C" void kernel_launch(void* const* d_in, const int* in_sizes, int n_in, void* d_out, int out_size, void* d_ws, size_t ws_size, hipStream_t stream) {
    static int grid = 0;
    if (grid == 0) {
        if (n_in != 35 || in_sizes[0] != NLAT * DM || out_size != NLAT * DM || ws_size < WS_END) {
            fprintf(stderr, "kernel_launch: unexpected shapes / workspace (n_in %d, ws %zu, need %zu); nothing launched\n", n_in, ws_size, (size_t)WS_END); grid = -1; return; }
        int dev = 0, cus = 0;
        if (hipGetDevice(&dev) != hipSuccess || hipDeviceGetAttribute(&cus, hipDeviceAttributeMultiprocessorCount, dev) != hipSuccess) { grid = -1; return; }
        grid = cus;
    }
    if (grid < 0) return;
    (void)hipMemsetAsync((char*)d_ws + WS_CTL, 0, CTL_ZERO_BYTES, stream);
    Args a{};
    for (int i = 0; i < 35; ++i) a.in[i] = (const float*)d_in[i];
    a.in[I_OUT] = (const float*)d_out; a.in[I_WS] = (const float*)d_ws; a.pad = 0;
#if MK_FUSED
    a.l_lo = 0; a.l_hi = DEPTH; a.ph_lo = 0; a.ph_hi = NPH; a.do_pro = 1; a.do_fin = 1; a.fused = 1;
#ifndef TEST_PM
#define TEST_PM 0xFFFF
#endif
#ifndef TEST_MS
#define TEST_MS 15
#endif
    launch_one<TEST_PM, TEST_MS>(a, grid, stream);
#else
    a.fused = 0;
    a.l_lo = 0; a.l_hi = 0; a.ph_lo = 0; a.ph_hi = 0; a.do_pro = 1; a.do_fin = 0;
    launch_one<0x1000, 15>(a, grid, stream);
    a.do_pro = 0;
    for (int l = 0; l < DEPTH; ++l) {
        a.l_lo = l; a.l_hi = l + 1; a.ph_lo = 0; a.ph_hi = NPH;
        launch_one<0x1, 15>(a, grid, stream); launch_one<0x2, 15>(a, grid, stream); launch_one<0x4, 15>(a, grid, stream); launch_one<0x8, 15>(a, grid, stream);
        launch_one<0x10, 1>(a, grid, stream); launch_one<0x10, 2>(a, grid, stream); launch_one<0x10, 4>(a, grid, stream); launch_one<0x10, 8>(a, grid, stream);
        launch_one<0x20, 15>(a, grid, stream); launch_one<0x40, 15>(a, grid, stream); launch_one<0x80, 15>(a, grid, stream);
        launch_one<0x100, 15>(a, grid, stream); launch_one<0x200, 15>(a, grid, stream);
        if (l & 1) launch_one<0x400, 15>(a, grid, stream);
    }
    a.l_lo = 0; a.l_hi = 0; a.ph_lo = 0; a.ph_hi = 0; a.do_fin = 1;
    launch_one<0x2000, 15>(a, grid, stream);
#endif
}
```

```cpp
#include <hip/hip_runtime.h>
#include <cstdio>
#include <cstdint>
#define LAS __attribute__((address_space(3)))
namespace pg8 {
#define PG8_LAS __attribute__((address_space(3)))
typedef unsigned short bf16_t;
typedef short bf16x8 __attribute__((ext_vector_type(8)));
typedef float f32x4 __attribute__((ext_vector_type(4)));
typedef unsigned u32x4 __attribute__((ext_vector_type(4)));
constexpr int BM = 256, BK = 64, HALF = 128, HTB = HALF * BK * 2  , STAGE_BYTES = 8 * HTB, NXCD = 8, WGM = 8;

__host__ __device__ __forceinline__ int lds_byte(int r, int c) { const int st = (r >> 4) * 2 + (c >> 5), rr = r & 15, cc = c & 31, ob = rr * 64 + cc * 2; return st * 1024 + (ob ^ (((ob >> 9) & 1) << 5)); }
__host__ __device__ __forceinline__ void stage_rc(int b, int& R, int& C) { const int st = b / 1024, sb = b % 1024, swz = sb ^ (((sb >> 9) & 1) << 5); R = (st >> 1) * 16 + swz / 64; C = (st & 1) * 32 + (swz % 64) / 2; }
__host__ __device__ __forceinline__ int perm32(int rho) { const int n = rho >> 4, i = rho & 15; return 8 * (i >> 2) + 4 * n + (i & 3); }

__host__ __device__ __forceinline__ int perm32f(int rho) { return 2 * (rho & 15) + (rho >> 4); }
template <class E, class = void> struct epi_flip { static constexpr bool v = false; };
template <class E> struct epi_flip<E, decltype((void)E::FLIP)> { static constexpr bool v = E::FLIP; };
struct Unit { int pm, pn, pc; };
struct Gemm { const bf16_t* A; const bf16_t* Bt; int M, N, K; };

struct StaticOrder {
    int nM, nN, nwg, G, c;
    __host__ __device__ void init(int M, int N, int G_, int c_) { nM = M / BM; nN = N / BM; nwg = nM * nN; G = G_; c = c_; }
    __host__ __device__ bool next(int i, Unit& u) const {
        const long L = (long)i * G + c; if (L >= nwg) return false;
        int wgid = (int)L; { const int q = nwg / NXCD, r = nwg % NXCD, xcd = wgid % NXCD, off = wgid / NXCD; wgid = (xcd < r ? xcd * (q + 1) : r * (q + 1) + (xcd - r) * q) + off; }
        const int nig = WGM * nN, gid = wgid / nig, fm = gid * WGM, gsz = (nM - fm) < WGM ? (nM - fm) : WGM;
        u.pm = fm + ((wgid % nig) % gsz); u.pn = (wgid % nig) / gsz; u.pc = u.pn; return true;
    }
    __device__ __forceinline__ void a_ready(const Unit&) const {}
    __device__ __forceinline__ void done(const Unit&) const {}
};

__device__ __forceinline__ unsigned cvt_pk_bf16(float lo, float hi) { unsigned r; asm volatile("v_cvt_pk_bf16_f32 %0, %1, %2" : "=v"(r) : "v"(lo), "v"(hi)); return r; }
typedef float f32x2 __attribute__((ext_vector_type(2)));

template <class Epi, class Sched, bool ALIGN_EPI = false, bool SP2 = false>
__device__ __forceinline__ void gemm_phase(PG8_LAS unsigned char* lds, const Gemm g, const Sched& S, const Epi& E, const int tid) {
    const int wid = __builtin_amdgcn_readfirstlane(tid >> 6), lane = tid & 63, wr = wid >> 2, wc = wid & 3, fr = lane & 15, fq = lane >> 4;
    const int K = g.K, nt = K / BK;
    unsigned voffA[2], voffB[2];
#pragma unroll
    for (int i = 0; i < 2; ++i) { int R, C; stage_rc(tid * 16 + i * 8192, R, C); const int Rb = epi_flip<Epi>::v ? ((R & ~31) + perm32f(R & 31)) : (Epi::PERM ? ((R & ~31) + perm32(R & 31)) : R);
        voffA[i] = (unsigned)(R * K + C) * 2u; voffB[i] = (unsigned)(Rb * K + C) * 2u; }
    const size_t kstep = (size_t)(BK * 2);
    const size_t hstep = (size_t)HALF * K * 2;
    const size_t tstep = 2 * hstep;
    const unsigned ldsw = (unsigned)wid * 1024u;
    const int aoff = lds_byte(wr * 64 + fr, fq * 8), boff = lds_byte(wc * 32 + fr, fq * 8);
#define PG8_SA(b, h) (((b) * 2 + (h)) * HTB)
#define PG8_SB(b, h) ((4 + (b) * 2 + (h)) * HTB)
#define PG8_STAGE(bufoff, gbase, voff) do { _Pragma("unroll") for (int _i = 0; _i < 2; ++_i) \
        __builtin_amdgcn_global_load_lds((const unsigned*)((const char*)(gbase) + (voff)[_i]), (PG8_LAS unsigned*)(lds + (bufoff) + ldsw + _i * 8192), 16, 0, 0); } while (0)
#define PG8_LDA(dst, b, h) do { _Pragma("unroll") for (int m = 0; m < 4; ++m) _Pragma("unroll") for (int k = 0; k < 2; ++k) dst[m][k] = *(const PG8_LAS bf16x8*)(lds + PG8_SA(b, h) + aoff + m * 2048 + k * 1024); } while (0)
#define PG8_LDB(dst, b, h) do { _Pragma("unroll") for (int n = 0; n < 2; ++n) _Pragma("unroll") for (int k = 0; k < 2; ++k) dst[n][k] = *(const PG8_LAS bf16x8*)(lds + PG8_SB(b, h) + boff + n * 2048 + k * 1024); } while (0)
#define PG8_MMA(ai, bj, At, Bt) do { __builtin_amdgcn_s_setprio(1); _Pragma("unroll") for (int m = 0; m < 4; ++m) _Pragma("unroll") for (int n = 0; n < 2; ++n) _Pragma("unroll") for (int k = 0; k < 2; ++k) \
        { if constexpr (epi_flip<Epi>::v) acc[ai][bj][m][n] = __builtin_amdgcn_mfma_f32_16x16x32_bf16(At[m][k], Bt[n][k], acc[ai][bj][m][n], 0, 0, 0); \
          else acc[ai][bj][m][n] = __builtin_amdgcn_mfma_f32_16x16x32_bf16(Bt[n][k], At[m][k], acc[ai][bj][m][n], 0, 0, 0); } __builtin_amdgcn_s_setprio(0); } while (0)
#define PG8_WAIT_V(n) asm volatile("s_waitcnt vmcnt(" #n ")" ::: "memory")
#define PG8_WAIT_L(n) asm volatile("s_waitcnt lgkmcnt(" #n ")" ::: "memory")
#define PG8_BAR __builtin_amdgcn_s_barrier()
#define PG8_SCHED __builtin_amdgcn_sched_barrier(0)
    Unit cur, nxt; int ui = 0;
    if (!S.next(0, cur)) return;
    f32x4 acc[2][2][4][2];
#pragma unroll
    for (int a = 0; a < 2; ++a)
#pragma unroll
        for (int b = 0; b < 2; ++b)
#pragma unroll
            for (int m = 0; m < 4; ++m)
#pragma unroll
                for (int n = 0; n < 2; ++n) acc[a][b][m][n] = (f32x4){0.f, 0.f, 0.f, 0.f};
    bf16x8 At[4][2], B0[2][2], B1[2][2];
    const char* cA = (const char*)g.A + (size_t)cur.pm * tstep; const char* cB = (const char*)g.Bt + (size_t)cur.pn * tstep;
    S.a_ready(cur);
    if constexpr (SP2) {
        PG8_STAGE(PG8_SB(0, 0), cB, voffB); PG8_STAGE(PG8_SB(0, 1), cB + hstep, voffB); PG8_STAGE(PG8_SA(0, 0), cA, voffA); PG8_STAGE(PG8_SA(0, 1), cA + hstep, voffA);
        if (wr == 1) PG8_BAR;
        PG8_WAIT_V(2); PG8_BAR;
        PG8_STAGE(PG8_SB(1, 0), cB + kstep, voffB); PG8_STAGE(PG8_SA(1, 0), cA + kstep, voffA); PG8_STAGE(PG8_SB(1, 1), cB + hstep + kstep, voffB);
        PG8_WAIT_V(6); PG8_BAR;
    } else {
        PG8_STAGE(PG8_SB(0, 0), cB, voffB); PG8_STAGE(PG8_SA(0, 0), cA, voffA); PG8_STAGE(PG8_SB(0, 1), cB + hstep, voffB); PG8_STAGE(PG8_SA(0, 1), cA + hstep, voffA);
        if (wr == 1) PG8_BAR;
        PG8_WAIT_V(4); PG8_BAR;
        PG8_STAGE(PG8_SB(1, 0), cB + kstep, voffB); PG8_STAGE(PG8_SA(1, 0), cA + kstep, voffA); PG8_STAGE(PG8_SB(1, 1), cB + hstep + kstep, voffB);
        PG8_WAIT_V(6); PG8_BAR;
    }
    for (;;) {
        const bool has_next = S.next(ui + 1, nxt);
        const char* nA = has_next ? (const char*)g.A + (size_t)nxt.pm * tstep : cA; const char* nB = has_next ? (const char*)g.Bt + (size_t)nxt.pn * tstep : cB;
        for (int t = 0; t < nt; t += 2) {
            const bool last = (t == nt - 2);
            const char* a1 = cA + (size_t)(t + 1) * kstep;
            const char* a2 = last ? nA : cA + (size_t)(t + 2) * kstep; const char* b2 = last ? nB : cB + (size_t)(t + 2) * kstep;
            const char* a3 = a2 + kstep; const char* b3 = b2 + kstep;
            if (last && has_next) S.a_ready(nxt);
            if constexpr (SP2) {
            PG8_LDB(B0, 0, 0); PG8_LDB(B1, 0, 1); PG8_SCHED; PG8_LDA(At, 0, 0); PG8_STAGE(PG8_SA(1, 1), a1 + hstep, voffA);
            PG8_WAIT_V(8); PG8_WAIT_L(0); PG8_BAR; PG8_MMA(0, 0, At, B0); PG8_MMA(0, 1, At, B1); PG8_BAR; PG8_SCHED;
            PG8_LDA(At, 0, 1); PG8_STAGE(PG8_SB(0, 0), b2, voffB); PG8_STAGE(PG8_SB(0, 1), b2 + hstep, voffB); PG8_STAGE(PG8_SA(0, 0), a2, voffA);
            PG8_WAIT_V(8); PG8_WAIT_L(0); PG8_BAR; PG8_MMA(1, 0, At, B0); PG8_MMA(1, 1, At, B1); PG8_BAR; PG8_SCHED;
            PG8_LDB(B0, 1, 0); PG8_LDB(B1, 1, 1); PG8_SCHED; PG8_LDA(At, 1, 0); PG8_STAGE(PG8_SA(0, 1), a2 + hstep, voffA);
            PG8_WAIT_V(8); PG8_WAIT_L(0); PG8_BAR; PG8_MMA(0, 0, At, B0); PG8_MMA(0, 1, At, B1); PG8_BAR; PG8_SCHED;
            PG8_LDA(At, 1, 1); PG8_STAGE(PG8_SB(1, 0), b3, voffB); PG8_STAGE(PG8_SB(1, 1), b3 + hstep, voffB); PG8_STAGE(PG8_SA(1, 0), a3, voffA);
            PG8_WAIT_V(8); PG8_WAIT_L(0); PG8_BAR; PG8_MMA(1, 0, At, B0); PG8_MMA(1, 1, At, B1); PG8_BAR; PG8_SCHED;
            } else {
            PG8_LDB(B0, 0, 0); PG8_SCHED; PG8_LDA(At, 0, 0); PG8_STAGE(PG8_SA(1, 1), a1 + hstep, voffA);
            PG8_WAIT_L(8); PG8_BAR; PG8_WAIT_L(0); PG8_MMA(0, 0, At, B0); PG8_BAR; PG8_SCHED;
            PG8_LDB(B1, 0, 1); PG8_STAGE(PG8_SB(0, 0), b2, voffB);
            PG8_BAR; PG8_WAIT_L(0); PG8_MMA(0, 1, At, B1); PG8_BAR;
            PG8_LDA(At, 0, 1); PG8_STAGE(PG8_SA(0, 0), a2, voffA);
            PG8_BAR; PG8_WAIT_L(0); PG8_MMA(1, 0, At, B0); PG8_BAR; PG8_SCHED;
            PG8_STAGE(PG8_SB(0, 1), b2 + hstep, voffB);
            PG8_WAIT_V(6); PG8_BAR; PG8_MMA(1, 1, At, B1); PG8_BAR;
            PG8_LDB(B0, 1, 0); PG8_SCHED; PG8_LDA(At, 1, 0); PG8_STAGE(PG8_SA(0, 1), a2 + hstep, voffA);
            PG8_WAIT_L(8); PG8_BAR; PG8_WAIT_L(0); PG8_MMA(0, 0, At, B0); PG8_BAR; PG8_SCHED;
            PG8_LDB(B1, 1, 1); PG8_STAGE(PG8_SB(1, 0), b3, voffB);
            PG8_BAR; PG8_WAIT_L(0); PG8_MMA(0, 1, At, B1); PG8_BAR;
            PG8_LDA(At, 1, 1); PG8_STAGE(PG8_SA(1, 0), a3, voffA);
            PG8_BAR; PG8_WAIT_L(0); PG8_MMA(1, 0, At, B0); PG8_BAR; PG8_SCHED;
            PG8_STAGE(PG8_SB(1, 1), b3 + hstep, voffB);
            PG8_WAIT_V(6); PG8_BAR; PG8_MMA(1, 1, At, B1); PG8_BAR;
            }
        }
        if constexpr (ALIGN_EPI) { if (wr == 0) PG8_BAR; }
        if constexpr (!Epi::AFTER_DRAIN) { E(acc, cur, wr, wc, fr, fq); S.done(cur); }
        if (!has_next) break;
#pragma unroll
        for (int a = 0; a < 2; ++a)
#pragma unroll
            for (int b = 0; b < 2; ++b)
#pragma unroll
                for (int m = 0; m < 4; ++m)
#pragma unroll
                    for (int n = 0; n < 2; ++n) acc[a][b][m][n] = (f32x4){0.f, 0.f, 0.f, 0.f};
        cur = nxt; cA = nA; cB = nB; ++ui;
        if constexpr (ALIGN_EPI) { if (wr == 1) PG8_BAR; }
    }
    PG8_WAIT_V(0);
    if constexpr (!ALIGN_EPI) { if (wr == 0) PG8_BAR; }
    PG8_BAR;
    if constexpr (Epi::AFTER_DRAIN) { E.fused(acc, cur, wr, wc, fr, fq, lds, wid, lane); S.done(cur); }
#undef PG8_SA
#undef PG8_SB
#undef PG8_STAGE
#undef PG8_LDA
#undef PG8_LDB
#undef PG8_MMA
#undef PG8_WAIT_V
#undef PG8_WAIT_L
#undef PG8_BAR
#undef PG8_SCHED
}
typedef int v8i_t __attribute__((ext_vector_type(8)));
typedef int v4i_t __attribute__((ext_vector_type(4)));
template <class Epi, class Sched, bool ALIGN_EPI = false, bool SP2 = false>
__device__ __forceinline__ void gemm_phase_f8(PG8_LAS unsigned char* lds, const Gemm g, const Sched& S, const Epi& E, const int tid) {
    const int wid = __builtin_amdgcn_readfirstlane(tid >> 6), lane = tid & 63, wr = wid >> 2, wc = wid & 3, fr = lane & 15, fq = lane >> 4;
    const int K = g.K, nt = K / BK;
    unsigned voffA[2], voffB[2];
#pragma unroll
    for (int i = 0; i < 2; ++i) { int R, C; stage_rc(tid * 16 + i * 8192, R, C); const int Rb = Epi::PERM ? ((R & ~31) + perm32(R & 31)) : R;
        voffA[i] = (unsigned)(R * K + C) * 2u; voffB[i] = (unsigned)(Rb * K + C) * 2u; }
    const size_t kstep = (size_t)(BK * 2);
    const size_t hstep = (size_t)HALF * K * 2;
    const size_t tstep = 2 * hstep;
    const unsigned ldsw = (unsigned)wid * 1024u;
    const int aoff0 = lds_byte(wr * 64 + fr, fq * 16), aoff1 = lds_byte(wr * 64 + fr, fq * 16 + 8), boff0 = lds_byte(wc * 32 + fr, fq * 16), boff1 = lds_byte(wc * 32 + fr, fq * 16 + 8);
#define PG8_SA(b, h) (((b) * 2 + (h)) * HTB)
#define PG8_SB(b, h) ((4 + (b) * 2 + (h)) * HTB)
#define PG8_STAGE(bufoff, gbase, voff) do { _Pragma("unroll") for (int _i = 0; _i < 2; ++_i) \
        __builtin_amdgcn_global_load_lds((const unsigned*)((const char*)(gbase) + (voff)[_i]), (PG8_LAS unsigned*)(lds + (bufoff) + ldsw + _i * 8192), 16, 0, 0); } while (0)
#define PG8_LDA(dst, b, h) do { _Pragma("unroll") for (int m = 0; m < 4; ++m) { const u32x4 lo_ = *(const PG8_LAS u32x4*)(lds + PG8_SA(b, h) + aoff0 + m * 2048), hi_ = *(const PG8_LAS u32x4*)(lds + PG8_SA(b, h) + aoff1 + m * 2048); \
        dst[m] = __builtin_shufflevector((v4i_t)lo_, (v4i_t)hi_, 0, 1, 2, 3, 4, 5, 6, 7); } } while (0)
#define PG8_LDB(dst, b, h) do { _Pragma("unroll") for (int n = 0; n < 2; ++n) { const u32x4 lo_ = *(const PG8_LAS u32x4*)(lds + PG8_SB(b, h) + boff0 + n * 2048), hi_ = *(const PG8_LAS u32x4*)(lds + PG8_SB(b, h) + boff1 + n * 2048); \
        dst[n] = __builtin_shufflevector((v4i_t)lo_, (v4i_t)hi_, 0, 1, 2, 3, 4, 5, 6, 7); } } while (0)
#define PG8_MMA(ai, bj, At, Bt) do { __builtin_amdgcn_s_setprio(1); _Pragma("unroll") for (int m = 0; m < 4; ++m) _Pragma("unroll") for (int n = 0; n < 2; ++n) \
        asm volatile("v_mfma_scale_f32_16x16x128_f8f6f4 %0, %1, %2, %0, %3, %3 op_sel_hi:[0,0,0]" : "+v"(acc[ai][bj][m][n]) : "v"(Bt[n]), "v"(At[m]), "v"(one_scale)); __builtin_amdgcn_s_setprio(0); } while (0)
#define PG8_WAIT_V(n) asm volatile("s_waitcnt vmcnt(" #n ")" ::: "memory")
#define PG8_WAIT_L(n) asm volatile("s_waitcnt lgkmcnt(" #n ")" ::: "memory")
#define PG8_BAR __builtin_amdgcn_s_barrier()
#define PG8_SCHED __builtin_amdgcn_sched_barrier(0)
    Unit cur, nxt; int ui = 0;
    if (!S.next(0, cur)) return;
    f32x4 acc[2][2][4][2];
#pragma unroll
    for (int a = 0; a < 2; ++a)
#pragma unroll
        for (int b = 0; b < 2; ++b)
#pragma unroll
            for (int m = 0; m < 4; ++m)
#pragma unroll
                for (int n = 0; n < 2; ++n) acc[a][b][m][n] = (f32x4){0.f, 0.f, 0.f, 0.f};
    v8i_t At[4], B0[2], B1[2]; const int one_scale = 0x7f7f7f7f;
    const char* cA = (const char*)g.A + (size_t)cur.pm * tstep; const char* cB = (const char*)g.Bt + (size_t)cur.pn * tstep;
    S.a_ready(cur);
    if constexpr (SP2) {
        PG8_STAGE(PG8_SB(0, 0), cB, voffB); PG8_STAGE(PG8_SB(0, 1), cB + hstep, voffB); PG8_STAGE(PG8_SA(0, 0), cA, voffA); PG8_STAGE(PG8_SA(0, 1), cA + hstep, voffA);
        if (wr == 1) PG8_BAR;
        PG8_WAIT_V(2); PG8_BAR;
        PG8_STAGE(PG8_SB(1, 0), cB + kstep, voffB); PG8_STAGE(PG8_SA(1, 0), cA + kstep, voffA); PG8_STAGE(PG8_SB(1, 1), cB + hstep + kstep, voffB);
        PG8_WAIT_V(6); PG8_BAR;
    } else {
        PG8_STAGE(PG8_SB(0, 0), cB, voffB); PG8_STAGE(PG8_SA(0, 0), cA, voffA); PG8_STAGE(PG8_SB(0, 1), cB + hstep, voffB); PG8_STAGE(PG8_SA(0, 1), cA + hstep, voffA);
        if (wr == 1) PG8_BAR;
        PG8_WAIT_V(4); PG8_BAR;
        PG8_STAGE(PG8_SB(1, 0), cB + kstep, voffB); PG8_STAGE(PG8_SA(1, 0), cA + kstep, voffA); PG8_STAGE(PG8_SB(1, 1), cB + hstep + kstep, voffB);
        PG8_WAIT_V(6); PG8_BAR;
    }
    for (;;) {
        const bool has_next = S.next(ui + 1, nxt);
        const char* nA = has_next ? (const char*)g.A + (size_t)nxt.pm * tstep : cA; const char* nB = has_next ? (const char*)g.Bt + (size_t)nxt.pn * tstep : cB;
        for (int t = 0; t < nt; t += 2) {
            const bool last = (t == nt - 2);
            const char* a1 = cA + (size_t)(t + 1) * kstep;
            const char* a2 = last ? nA : cA + (size_t)(t + 2) * kstep; const char* b2 = last ? nB : cB + (size_t)(t + 2) * kstep;
            const char* a3 = a2 + kstep; const char* b3 = b2 + kstep;
            if (last && has_next) S.a_ready(nxt);
            if constexpr (SP2) {
            PG8_LDB(B0, 0, 0); PG8_LDB(B1, 0, 1); PG8_SCHED; PG8_LDA(At, 0, 0); PG8_STAGE(PG8_SA(1, 1), a1 + hstep, voffA);
            PG8_WAIT_V(8); PG8_WAIT_L(0); PG8_BAR; PG8_MMA(0, 0, At, B0); PG8_MMA(0, 1, At, B1); PG8_BAR; PG8_SCHED;
            PG8_LDA(At, 0, 1); PG8_STAGE(PG8_SB(0, 0), b2, voffB); PG8_STAGE(PG8_SB(0, 1), b2 + hstep, voffB); PG8_STAGE(PG8_SA(0, 0), a2, voffA);
            PG8_WAIT_V(8); PG8_WAIT_L(0); PG8_BAR; PG8_MMA(1, 0, At, B0); PG8_MMA(1, 1, At, B1); PG8_BAR; PG8_SCHED;
            PG8_LDB(B0, 1, 0); PG8_LDB(B1, 1, 1); PG8_SCHED; PG8_LDA(At, 1, 0); PG8_STAGE(PG8_SA(0, 1), a2 + hstep, voffA);
            PG8_WAIT_V(8); PG8_WAIT_L(0); PG8_BAR; PG8_MMA(0, 0, At, B0); PG8_MMA(0, 1, At, B1); PG8_BAR; PG8_SCHED;
            PG8_LDA(At, 1, 1); PG8_STAGE(PG8_SB(1, 0), b3, voffB); PG8_STAGE(PG8_SB(1, 1), b3 + hstep, voffB); PG8_STAGE(PG8_SA(1, 0), a3, voffA);
            PG8_WAIT_V(8); PG8_WAIT_L(0); PG8_BAR; PG8_MMA(1, 0, At, B0); PG8_MMA(1, 1, At, B1); PG8_BAR; PG8_SCHED;
            } else {
            PG8_LDB(B0, 0, 0); PG8_SCHED; PG8_LDA(At, 0, 0); PG8_STAGE(PG8_SA(1, 1), a1 + hstep, voffA);
            PG8_WAIT_L(8); PG8_BAR; PG8_WAIT_L(0); PG8_MMA(0, 0, At, B0); PG8_BAR; PG8_SCHED;
            PG8_LDB(B1, 0, 1); PG8_STAGE(PG8_SB(0, 0), b2, voffB);
            PG8_BAR; PG8_WAIT_L(0); PG8_MMA(0, 1, At, B1); PG8_BAR;
            PG8_LDA(At, 0, 1); PG8_STAGE(PG8_SA(0, 0), a2, voffA);
            PG8_BAR; PG8_WAIT_L(0); PG8_MMA(1, 0, At, B0); PG8_BAR; PG8_SCHED;
            PG8_STAGE(PG8_SB(0, 1), b2 + hstep, voffB);
            PG8_WAIT_V(6); PG8_BAR; PG8_MMA(1, 1, At, B1); PG8_BAR;
            PG8_LDB(B0, 1, 0); PG8_SCHED; PG8_LDA(At, 1, 0); PG8_STAGE(PG8_SA(0, 1), a2 + hstep, voffA);
            PG8_WAIT_L(8); PG8_BAR; PG8_WAIT_L(0); PG8_MMA(0, 0, At, B0); PG8_BAR; PG8_SCHED;
            PG8_LDB(B1, 1, 1); PG8_STAGE(PG8_SB(1, 0), b3, voffB);
            PG8_BAR; PG8_WAIT_L(0); PG8_MMA(0, 1, At, B1); PG8_BAR;
            PG8_LDA(At, 1, 1); PG8_STAGE(PG8_SA(1, 0), a3, voffA);
            PG8_BAR; PG8_WAIT_L(0); PG8_MMA(1, 0, At, B0); PG8_BAR; PG8_SCHED;
            PG8_STAGE(PG8_SB(1, 1), b3 + hstep, voffB);
            PG8_WAIT_V(6); PG8_BAR; PG8_MMA(1, 1, At, B1); PG8_BAR;
            }
        }
        if constexpr (ALIGN_EPI) { if (wr == 0) PG8_BAR; }
        asm volatile("s_nop 15\n\ts_nop 15" ::: "memory");
        if constexpr (!Epi::AFTER_DRAIN) { E(acc, cur, wr, wc, fr, fq); S.done(cur); }
        if (!has_next) break;
#pragma unroll
        for (int a = 0; a < 2; ++a)
#pragma unroll
            for (int b = 0; b < 2; ++b)
#pragma unroll
                for (int m = 0; m < 4; ++m)
#pragma unroll
                    for (int n = 0; n < 2; ++n) acc[a][b][m][n] = (f32x4){0.f, 0.f, 0.f, 0.f};
        cur = nxt; cA = nA; cB = nB; ++ui;
        if constexpr (ALIGN_EPI) { if (wr == 1) PG8_BAR; }
    }
    PG8_WAIT_V(0);
    if constexpr (!ALIGN_EPI) { if (wr == 0) PG8_BAR; }
    PG8_BAR;
    if constexpr (Epi::AFTER_DRAIN) { E.fused(acc, cur, wr, wc, fr, fq, lds, wid, lane); S.done(cur); }
#undef PG8_SA
#undef PG8_SB
#undef PG8_STAGE
#undef PG8_LDA
#undef PG8_LDB
#undef PG8_MMA
#undef PG8_WAIT_V
#undef PG8_WAIT_L
#undef PG8_BAR
#undef PG8_SCHED
}
}

#define XB_TMO      128
#define XB_XCNT(j)  (256  + 64 * (j))
#define XB_XSUB(j)  (1280 + 64 * (j))
#define XB_XGEN(j)  (2304 + 64 * (j))
#define XB_TOP      3328
#define XB_TOPGEN   3392
#define XCD_BAR_WORDS 3456
#define XB_SPIN_CAP (1u << 18)

__device__ __forceinline__ unsigned xb_ld(unsigned* p)              { return __hip_atomic_load(p, __ATOMIC_RELAXED, __HIP_MEMORY_SCOPE_AGENT); }
__device__ __forceinline__ unsigned xb_add(unsigned* p, unsigned v) { return __hip_atomic_fetch_add(p, v, __ATOMIC_RELAXED, __HIP_MEMORY_SCOPE_AGENT); }
__device__ __forceinline__ unsigned xb_xcc_id() { return (unsigned)__builtin_amdgcn_s_getreg((3 << 11) | 20) & 0xFu; }
#define XB_SPIN(cond, bar) do { unsigned _sp = 0; while (cond) { __builtin_amdgcn_s_sleep(1); \
    if ((++_sp & 255u) == 0u) { if (xb_ld(&(bar)[XB_TMO])) break; if (_sp > XB_SPIN_CAP) { atomicAdd(&(bar)[XB_TMO], 1u); break; } } } } while (0)

struct XcdBarrier {
    unsigned* bar; unsigned x;
    volatile LAS unsigned* st;
};

__device__ __forceinline__ XcdBarrier xcd_barrier_post(unsigned* bar, volatile LAS unsigned* st, const int xb_tid) {
    XcdBarrier b; b.bar = bar; b.x = xb_xcc_id(); b.st = st;
    if (xb_tid == 0) (void)xb_add(&bar[XB_XCNT(b.x)], 1u);
    return b;
}
__device__ __forceinline__ void xcd_barrier_complete(unsigned* bar, unsigned x, unsigned& nloc, unsigned& nx) {
    const unsigned G = gridDim.x * gridDim.y * gridDim.z;
    unsigned sum, cnt, mine, sp = 0u;
    for (;;) {
        sum = 0u; cnt = 0u; mine = 0u;
#pragma unroll
        for (unsigned j = 0; j < 16; ++j) { const unsigned c = xb_ld(&bar[XB_XCNT(j)]); sum += c; cnt += (c > 0u) ? 1u : 0u; mine = (j == x) ? c : mine; }
        if (sum == G) break;
        __builtin_amdgcn_s_sleep(1);
        if ((++sp & 255u) == 0u) { if (xb_ld(&bar[XB_TMO])) break; if (sp > XB_SPIN_CAP) { atomicAdd(&bar[XB_TMO], 1u); break; } }
    }
    nloc = mine > 0u ? mine : 1u; nx = cnt > 0u ? cnt : 1u;
}

__device__ __forceinline__ void xcd_barrier(const XcdBarrier& b, const int xb_tid) {
    asm volatile("s_waitcnt vmcnt(0)" ::: "memory");
    __syncthreads();
    if (xb_tid == 0) {
        unsigned* bar = b.bar;
        __builtin_amdgcn_s_waitcnt(0);
        unsigned nloc = b.st[0], nx = b.st[1];
        if (nloc == 0u) { xcd_barrier_complete(bar, b.x, nloc, nx); b.st[0] = nloc; b.st[1] = nx; }
        const unsigned old = xb_add(&bar[XB_XSUB(b.x)], 1u);
        const unsigned gen = old / nloc;
        if (old + 1u == (gen + 1u) * nloc) {
            __builtin_amdgcn_fence(__ATOMIC_RELEASE, "agent");
            asm volatile("s_waitcnt vmcnt(0)" ::: "memory");
            const unsigned og = xb_add(&bar[XB_TOP], 1u);
            const unsigned tg = og / nx;
            if (og + 1u == (tg + 1u) * nx) xb_add(&bar[XB_TOPGEN], 1u);
            else XB_SPIN(xb_ld(&bar[XB_TOPGEN]) == tg, bar);
            __builtin_amdgcn_fence(__ATOMIC_ACQUIRE, "agent");
            xb_add(&bar[XB_XGEN(b.x)], 1u);
            asm volatile("s_waitcnt vmcnt(0)" ::: "memory");
        } else {
            XB_SPIN(xb_ld(&bar[XB_XGEN(b.x)]) == gen, bar);
            __builtin_amdgcn_fence(__ATOMIC_ACQUIRE, "agent");
            asm volatile("s_waitcnt vmcnt(0)" ::: "memory");
        }
    }
    __syncthreads();
}

#define GAS __attribute__((address_space(1)))
typedef unsigned short bf16;
typedef unsigned v4u __attribute__((ext_vector_type(4)));
typedef unsigned v2u __attribute__((ext_vector_type(2)));
typedef float f32x4 __attribute__((ext_vector_type(4)));

constexpr int NB = 4, SEQ = 8192, DM = 1024, DEPTH = 4, CTXL = 256;
constexpr int NLAT = NB * SEQ, NCTX = NB * CTXL, MT = NLAT + NCTX;
constexpr int DIN = 3360, DINP = 3584, DFF = 2816, NEXP = 8;
constexpr int C_RQ = 0, C_RK = 256, C_RV = 512, C_RG = 768, C_S5 = 1024, C_HQ = 1280, C_HFF = 1536, C_HFB = 1792, C_HI = 2048, C_HG = 2304,
              C_GQ = 2560, C_GK = 2688, C_GV = 2816, C_GG = 3072, C_GAF = 3328, C_GAB = 3344,
              C_GZF = 3328, C_GZB = 3456;
constexpr int NSEG = 132;
constexpr int MOE_CAP_TILES = 272;
constexpr float NEPS = 1e-6f;
constexpr float WSC8 = 64.0f;

constexpr size_t MiB = 1u << 20;
constexpr size_t WS_CTL = 0, CTL_ZERO_BYTES = 2 * MiB;
constexpr size_t WS_MOD = 2 * MiB;
constexpr size_t WS_LB = 3 * MiB;
constexpr size_t WS_ROPE = 3 * MiB + 65536;
constexpr size_t WS_GLUW = 3 * MiB + 131072;
constexpr size_t WS_WIN = 4 * MiB;
constexpr size_t WS_WOUT = 32 * MiB;
constexpr size_t WS_W13D = 40 * MiB;
constexpr size_t WS_W2D = 62 * MiB;
constexpr size_t WS_W13M = 73 * MiB;
constexpr size_t WS_W2M = 161 * MiB;
constexpr size_t WS_HB = 205 * MiB;
constexpr size_t WS_ACT = 209 * MiB;
constexpr size_t WS_Z = 275 * MiB;
constexpr size_t WS_PH = 292 * MiB;
constexpr size_t WS_OF = (292 + 232) * MiB;
constexpr size_t WS_X2 = 666 * MiB;
constexpr size_t WS_LIST = 843 * MiB;
constexpr size_t WS_END = 846 * MiB;
constexpr size_t ST_DS0 = 0;
constexpr size_t ST_DS1 = ST_DS0 + (size_t)2 * 16 * NSEG * 4096;
constexpr size_t ST_DS2 = ST_DS1 + (size_t)2 * 16 * NSEG * 4096;
constexpr size_t ST_G0 = ST_DS2 + (size_t)2 * 16 * NSEG * 2048;
constexpr size_t ST_G1 = ST_G0 + (size_t)2 * 16 * NSEG * 64;
constexpr size_t ST_G2 = ST_G1 + (size_t)2 * 16 * NSEG * 64;
constexpr size_t ST_HS = ST_G2 + (size_t)2 * 16 * NSEG * 64;
constexpr size_t ST_END = ST_HS + (size_t)2 * 64 * NSEG * 128;
static_assert(ST_END * 4 <= (WS_LIST - WS_X2), "state region");
static_assert(WS_PH + (size_t)MT * DINP * 2 <= WS_OF && WS_OF + (size_t)MT * 768 * 4 <= WS_X2, "OF region");
static_assert((size_t)MOE_CAP_TILES * 256 * 1024 * 2 <= (WS_LIST - WS_X2), "XB region");
static_assert((size_t)MOE_CAP_TILES * 256 * DFF * 2 <= (WS_X2 - WS_PH) && (size_t)MT * DINP * 2 <= (WS_X2 - WS_PH), "P/H region");
constexpr int CW_BAR = 4096;
constexpr int CW_CNT = 16384;

constexpr int LDS_BYTES = 163840;
constexpr int MISC_OFF = 163840 - 512;

__device__ __forceinline__ float bf2f(unsigned short h) { return __uint_as_float(((unsigned)h) << 16); }
__device__ __forceinline__ unsigned f2bf(float f) { unsigned u = __float_as_uint(f); return (u + 0x7fffu + ((u >> 16) & 1u)) >> 16; }
__device__ __forceinline__ unsigned pk2(float lo, float hi) { return f2bf(lo) | (f2bf(hi) << 16); }
__device__ __forceinline__ float wave_sum(float v) {
#define WS_DPP(ctrl, rmask) v += __int_as_float(__builtin_amdgcn_update_dpp(0, __float_as_int(v), (ctrl), (rmask), 0xf, false))
    WS_DPP(0x111, 0xf); WS_DPP(0x112, 0xf); WS_DPP(0x114, 0xf); WS_DPP(0x118, 0xf); WS_DPP(0x142, 0xa); WS_DPP(0x143, 0xc);
#undef WS_DPP
    return __int_as_float(__builtin_amdgcn_readlane(__float_as_int(v), 63));
}
__device__ __forceinline__ float rdl(float v, int k) { return __uint_as_float((unsigned)__builtin_amdgcn_readlane((int)__float_as_uint(v), k)); }
__device__ __forceinline__ float sigm(float x) { return __builtin_amdgcn_rcpf(1.0f + __expf(-x)); }
__device__ __forceinline__ float silu_f(float x) { return x * __builtin_amdgcn_rcpf(1.0f + __expf(-x)); }
#define LDS_WAIT() asm volatile("s_waitcnt lgkmcnt(0)" ::: "memory")

struct Args {
    const float* in[37];
    int l_lo, l_hi, ph_lo, ph_hi, do_pro, do_fin, fused, pad;
};
constexpr int I_OUT = 35, I_WS = 36;
enum { I_X = 0, I_C, I_CTX, I_CCTX, I_ADAW, I_ADAB, I_N1W, I_N2W, I_WIN, I_WOUT, I_RETGN, I_LAMRE, I_LAMIM, I_LOGDT, I_BRE, I_BIM, I_CRE, I_CIM, I_S5D,
       I_GLUW, I_GLUB, I_LBL, I_HGNW, I_WA2, I_BA, I_GLANW, I_FW1, I_FW3, I_FW2, I_RW, I_RB, I_MW1, I_MW3, I_MW2, I_FINW };

struct Frame {
    LAS unsigned char* lds;
    int tid, lane, wave, gw, NGW, G, zz;
    unsigned char* ws; float* out;
};

struct EpiStoreBf16 {
    static constexpr bool PERM = true, AFTER_DRAIN = false;
    bf16* O; int ldc; float sc;
    __device__ __forceinline__ void operator()(const pg8::f32x4 (&acc)[2][2][4][2], const pg8::Unit& u, int wr, int wc, int fr, int fq) const {
        const int row0 = u.pm * 256 + wr * 64 + fr, col0 = u.pc * 256 + wc * 32 + 8 * fq;
#pragma unroll
        for (int ai = 0; ai < 2; ++ai)
#pragma unroll
            for (int m = 0; m < 4; ++m) { bf16* rowp = O + (size_t)(row0 + ai * 128 + m * 16) * ldc + col0;
#pragma unroll
                for (int bj = 0; bj < 2; ++bj) { const pg8::f32x4 v0 = acc[ai][bj][m][0] * sc, v1 = acc[ai][bj][m][1] * sc;
                    pg8::u32x4 w; w.x = pg8::cvt_pk_bf16(v0[0], v0[1]); w.y = pg8::cvt_pk_bf16(v0[2], v0[3]); w.z = pg8::cvt_pk_bf16(v1[0], v1[1]); w.w = pg8::cvt_pk_bf16(v1[2], v1[3]);
                    *(pg8::u32x4*)(rowp + bj * 128) = w; } }
    }
};
constexpr int P4G = 4 * DINP, P4S5 = 4096;
struct EpiStoreP4 {
    static constexpr bool PERM = true, FLIP = true, AFTER_DRAIN = false;
    bf16* O;
    __device__ __forceinline__ void operator()(const pg8::f32x4 (&acc)[2][2][4][2], const pg8::Unit& u, int wr, int wc, int fr, int fq) const {
        const int grp0 = u.pm * 64 + wr * 16 + fq;
        if (u.pc != 4) {
            bf16* base = O + (size_t)grp0 * P4G + (size_t)(u.pc * 256 + wc * 32 + 2 * fr) * 4;
#pragma unroll
            for (int ai = 0; ai < 2; ++ai)
#pragma unroll
                for (int m = 0; m < 4; ++m) { bf16* gp = base + (size_t)(ai * 32 + m * 4) * P4G;
#pragma unroll
                    for (int bj = 0; bj < 2; ++bj) { const pg8::f32x4 v0 = acc[ai][bj][m][0], v1 = acc[ai][bj][m][1];
                        pg8::u32x4 w; w.x = pg8::cvt_pk_bf16(v0[0], v0[1]); w.y = pg8::cvt_pk_bf16(v0[2], v0[3]); w.z = pg8::cvt_pk_bf16(v1[0], v1[1]); w.w = pg8::cvt_pk_bf16(v1[2], v1[3]);
                        *(pg8::u32x4*)(gp + bj * 512) = w; } }
        } else {
            bf16* base = O + (size_t)grp0 * P4G + P4S5 + wc * 32 + 2 * fr;
#pragma unroll
            for (int ai = 0; ai < 2; ++ai)
#pragma unroll
                for (int m = 0; m < 4; ++m) { bf16* gp = base + (size_t)(ai * 32 + m * 4) * P4G;
#pragma unroll
                    for (int bj = 0; bj < 2; ++bj)
#pragma unroll
                        for (int r = 0; r < 4; ++r) *(unsigned*)(gp + r * 256 + bj * 128) = pg8::cvt_pk_bf16(acc[ai][bj][m][0][r], acc[ai][bj][m][1][r]); }
        }
    }
};
struct EpiSwiglu {
    static constexpr bool PERM = true, AFTER_DRAIN = false;
    bf16* H;
    __device__ __forceinline__ void operator()(const pg8::f32x4 (&acc)[2][2][4][2], const pg8::Unit& u, int wr, int wc, int fr, int fq) const {
        const int row0 = u.pm * 256 + wr * 64 + fr, col0 = u.pc * 128 + wc * 32 + 8 * fq;
#pragma unroll
        for (int ai = 0; ai < 2; ++ai)
#pragma unroll
            for (int m = 0; m < 4; ++m) { bf16* rowp = H + (size_t)(row0 + ai * 128 + m * 16) * DFF + col0;
                float h[8];
#pragma unroll
                for (int n = 0; n < 2; ++n)
#pragma unroll
                    for (int j = 0; j < 4; ++j) { const float a = acc[ai][0][m][n][j], b = acc[ai][1][m][n][j];
                        h[n * 4 + j] = a * __builtin_amdgcn_rcpf(1.0f + __builtin_amdgcn_exp2f(-1.4426950408889634f * a)) * b; }
                pg8::u32x4 w; w.x = pg8::cvt_pk_bf16(h[0], h[1]); w.y = pg8::cvt_pk_bf16(h[2], h[3]); w.z = pg8::cvt_pk_bf16(h[4], h[5]); w.w = pg8::cvt_pk_bf16(h[6], h[7]);
                *(pg8::u32x4*)rowp = w; }
    }
};
struct EpiSwiglu8 {
    static constexpr bool PERM = true, AFTER_DRAIN = false;
    unsigned char* H; float sc;
    __device__ __forceinline__ void operator()(const pg8::f32x4 (&acc)[2][2][4][2], const pg8::Unit& u, int wr, int wc, int fr, int fq) const {
        const int row0 = u.pm * 256 + wr * 64 + fr, col0 = u.pc * 128 + wc * 32 + 8 * fq;
#pragma unroll
        for (int ai = 0; ai < 2; ++ai)
#pragma unroll
            for (int m = 0; m < 4; ++m) { unsigned char* rowp = H + (size_t)(row0 + ai * 128 + m * 16) * DFF + col0;
                float h[8];
#pragma unroll
                for (int n = 0; n < 2; ++n)
#pragma unroll
                    for (int j = 0; j < 4; ++j) { const float a = acc[ai][0][m][n][j] * sc, b = acc[ai][1][m][n][j] * sc;
                        const float hv = a * __builtin_amdgcn_rcpf(1.0f + __builtin_amdgcn_exp2f(-1.4426950408889634f * a)) * b;
                        h[n * 4 + j] = fminf(fmaxf(hv, -448.0f), 448.0f); }
                unsigned w0 = 0u, w1 = 0u;
                w0 = __builtin_amdgcn_cvt_pk_fp8_f32(h[0], h[1], w0, false); w0 = __builtin_amdgcn_cvt_pk_fp8_f32(h[2], h[3], w0, true);
                w1 = __builtin_amdgcn_cvt_pk_fp8_f32(h[4], h[5], w1, false); w1 = __builtin_amdgcn_cvt_pk_fp8_f32(h[6], h[7], w1, true);
                v2u w; w.x = w0; w.y = w1; *(v2u*)rowp = w; }
    }
};
struct EpiResid {
    static constexpr bool PERM = false, AFTER_DRAIN = false;
    const float* xin_lat; const float* xin_ctx; float* xout_lat; float* xout_ctx; const float* gate; float sc;
    __device__ __forceinline__ void operator()(const pg8::f32x4 (&acc)[2][2][4][2], const pg8::Unit& u, int wr, int wc, int fr, int fq) const {
        const bool isctx = u.pm >= 128; const int bidx = isctx ? 4 : (u.pm >> 5);
        const size_t rbase = (size_t)(isctx ? (u.pm - 128) : u.pm) * 256 + wr * 64 + fr;
        const float* xi = (isctx ? xin_ctx : xin_lat); float* xo = (isctx ? xout_ctx : xout_lat);
        const int col0 = u.pc * 256 + wc * 32 + 4 * fq; const float* g = gate + (size_t)bidx * 6144 + col0;
        pg8::f32x4 gv[2][2];
#pragma unroll
        for (int bj = 0; bj < 2; ++bj)
#pragma unroll
            for (int n = 0; n < 2; ++n) gv[bj][n] = *(const pg8::f32x4*)(g + bj * 128 + n * 16) * sc;
#pragma unroll
        for (int ai = 0; ai < 2; ++ai)
#pragma unroll
            for (int m = 0; m < 4; ++m) { const size_t off = (rbase + ai * 128 + m * 16) * 1024 + col0;
#pragma unroll
                for (int bj = 0; bj < 2; ++bj)
#pragma unroll
                    for (int n = 0; n < 2; ++n) { const pg8::f32x4 xv = *(const pg8::f32x4*)(xi + off + bj * 128 + n * 16);
                        *(pg8::f32x4*)(xo + off + bj * 128 + n * 16) = xv + gv[bj][n] * acc[ai][bj][m][n]; }
                asm volatile("" ::: "memory"); }
    }
};
struct EpiGlu {
    static constexpr bool PERM = true, AFTER_DRAIN = false;
    const bf16* Z; bf16* Y; const float* bias;
    __device__ __forceinline__ void operator()(const pg8::f32x4 (&acc)[2][2][4][2], const pg8::Unit& u, int wr, int wc, int fr, int fq) const {
        const int row0 = u.pm * 256 + wr * 64 + fr, col0 = wc * 32 + 8 * fq;
#pragma unroll
        for (int ai = 0; ai < 2; ++ai)
#pragma unroll
            for (int m = 0; m < 4; ++m) { const size_t row = (size_t)(row0 + ai * 128 + m * 16);
#pragma unroll
                for (int bj = 0; bj < 2; ++bj) { const int col = col0 + bj * 128;
                    const pg8::u32x4 zz = *(const pg8::u32x4*)(Z + row * 256 + col);
                    const pg8::f32x4 b0 = *(const pg8::f32x4*)(bias + col), b1 = *(const pg8::f32x4*)(bias + col + 4);
                    const pg8::f32x4 v0 = acc[ai][bj][m][0] + b0, v1 = acc[ai][bj][m][1] + b1;
                    float o[8]; const unsigned zw[4] = {zz.x, zz.y, zz.z, zz.w};
#pragma unroll
                    for (int j = 0; j < 4; ++j) { const float zl = __uint_as_float(zw[j] << 16), zh = __uint_as_float(zw[j] & 0xffff0000u);
                        const float a0 = (j < 2) ? v0[2 * j] : v1[2 * j - 4], a1 = (j < 2) ? v0[2 * j + 1] : v1[2 * j - 3];
                        o[2 * j] = zl * sigm(a0); o[2 * j + 1] = zh * sigm(a1); }
                    pg8::u32x4 w; w.x = pg8::cvt_pk_bf16(o[0], o[1]); w.y = pg8::cvt_pk_bf16(o[2], o[3]); w.z = pg8::cvt_pk_bf16(o[4], o[5]); w.w = pg8::cvt_pk_bf16(o[6], o[7]);
                    *(pg8::u32x4*)(Y + row * 1024 + 256 + col) = w; }
                asm volatile("" ::: "memory"); }
    }
};
struct MoeOrder {
    int tp[9]; int nN, G, c, total;
    __device__ __forceinline__ void init(const unsigned* cnt, int nN_, int G_, int c_) {
        tp[0] = 0;
#pragma unroll
        for (int e = 0; e < 8; ++e) tp[e + 1] = tp[e] + (int)(((unsigned)__builtin_amdgcn_readfirstlane((int)__hip_atomic_load(cnt + e * 64, __ATOMIC_RELAXED, __HIP_MEMORY_SCOPE_AGENT)) + 255u) >> 8);
        nN = nN_; G = G_; c = c_; total = tp[8] * nN;
    }
    __device__ __forceinline__ bool next(int i, pg8::Unit& u) const {
        const int L = i * G + c; if (L >= total) return false;
        const int t = L / nN, pn = L - t * nN; int e = 0;
#pragma unroll
        for (int k = 1; k < 8; ++k) e += (t >= tp[k]) ? 1 : 0;
        u.pm = t; u.pn = e * nN + pn; u.pc = pn; return true;
    }
    __device__ __forceinline__ void a_ready(const pg8::Unit&) const {}
    __device__ __forceinline__ void done(const pg8::Unit&) const {}
};

__device__ __forceinline__ void cvt_item(const float* W, int K, int N, bf16* WT, int mode, int add, LAS float* scr, int item, int lane, int nblk_override = 0) {
    const int nblk = nblk_override ? nblk_override : (N >> 5), kb = item / nblk, nb = item - kb * nblk, k0 = 64 * kb, n0 = 32 * nb;
    const int r = lane >> 3, c4 = lane & 7;
    f32x4 v[8];
#pragma unroll
    for (int i = 0; i < 8; ++i) v[i] = *(const f32x4*)(W + (size_t)(k0 + 8 * i + r) * N + n0 + 4 * c4);
#pragma unroll
    for (int i = 0; i < 8; ++i) {
#pragma unroll
        for (int j = 0; j < 4; ++j) scr[(8 * i + r) * 33 + 4 * c4 + j] = v[i][j]; }
    LDS_WAIT();
    const int c = lane & 7;
#pragma unroll
    for (int j = 0; j < 4; ++j) { const int n = (lane >> 3) + 8 * j; const LAS float* s = scr + (8 * c) * 33 + n;
        v4u o; o.x = pk2(s[0 * 33], s[1 * 33]); o.y = pk2(s[2 * 33], s[3 * 33]); o.z = pk2(s[4 * 33], s[5 * 33]); o.w = pk2(s[6 * 33], s[7 * 33]);
        const int nn = n0 + n; const int drow = (mode == 0) ? (nn + add) : (((nn >> 7) << 8) + (nn & 127) + add);
        *(v4u*)(WT + (size_t)drow * K + k0 + 8 * c) = o; }
    LDS_WAIT();
}
__device__ __forceinline__ void cvt_item_f8(const float* W, int K, int N, unsigned char* WT, int mode, int add, LAS float* scr, int item, int lane) {
    const int nblk = N >> 5, kb = item / nblk, nb = item - kb * nblk, k0 = 64 * kb, n0 = 32 * nb;
    const int r = lane >> 3, c4 = lane & 7;
    f32x4 v[8];
#pragma unroll
    for (int i = 0; i < 8; ++i) v[i] = *(const f32x4*)(W + (size_t)(k0 + 8 * i + r) * N + n0 + 4 * c4);
#pragma unroll
    for (int i = 0; i < 8; ++i) {
#pragma unroll
        for (int j = 0; j < 4; ++j) scr[(8 * i + r) * 33 + 4 * c4 + j] = v[i][j]; }
    LDS_WAIT();
    const int c = lane & 3;
#pragma unroll
    for (int j = 0; j < 2; ++j) { const int n = (lane >> 2) + 16 * j; const LAS float* s = scr + (16 * c) * 33 + n;
        unsigned w[4];
#pragma unroll
        for (int q = 0; q < 4; ++q) { unsigned x = 0u;
            x = __builtin_amdgcn_cvt_pk_fp8_f32(s[(4 * q) * 33] * WSC8, s[(4 * q + 1) * 33] * WSC8, x, false);
            x = __builtin_amdgcn_cvt_pk_fp8_f32(s[(4 * q + 2) * 33] * WSC8, s[(4 * q + 3) * 33] * WSC8, x, true); w[q] = x; }
        v4u o; o.x = w[0]; o.y = w[1]; o.z = w[2]; o.w = w[3];
        const int nn = n0 + n; const int drow = (mode == 0) ? (nn + add) : (((nn >> 7) << 8) + (nn & 127) + add);
        *(v4u*)(WT + (size_t)drow * K + k0 + 16 * c) = o; }
    LDS_WAIT();
}
__device__ __forceinline__ void moe_cvt_idle(const Frame& F, const Args& a, int j, int b_lo) {
    LAS float* scr = (LAS float*)(F.lds + F.wave * 16384);
    constexpr int IT = 1408;
    const int nw = (F.G - b_lo) * 8, w = ((int)blockIdx.x - b_lo) * 8 + F.wave;
    for (int it = w; it < 8 * 3 * IT; it += nw) {
        const int e = it / (3 * IT), r = it - e * 3 * IT, which = r / IT, item = r - which * IT;
        const size_t eo = ((size_t)j * 8 + e) * (size_t)(1024 * DFF);
        if (which == 0) cvt_item_f8(a.in[F.zz + I_MW1] + eo, 1024, DFF, F.ws + WS_W13M + (size_t)e * 5632 * 1024, 1, 0, scr, item, F.lane);
        else if (which == 1) cvt_item_f8(a.in[F.zz + I_MW3] + eo, 1024, DFF, F.ws + WS_W13M + (size_t)e * 5632 * 1024, 1, 128, scr, item, F.lane);
        else cvt_item_f8(a.in[F.zz + I_MW2] + eo, DFF, 1024, F.ws + WS_W2M + (size_t)e * 1024 * DFF, 0, 0, scr, item, F.lane);
    }
}
__device__ __forceinline__ void moe_cvt(const Frame& F, const Args& a, int j) {
    LAS float* scr = (LAS float*)(F.lds + F.wave * 16384);
    constexpr int IT = 1408;
    for (int it = F.gw; it < 8 * 3 * IT; it += F.NGW) {
        const int e = it / (3 * IT), r = it - e * 3 * IT, which = r / IT, item = r - which * IT;
        const size_t eo = ((size_t)j * 8 + e) * (size_t)(1024 * DFF);
        if (which == 0) cvt_item_f8(a.in[F.zz + I_MW1] + eo, 1024, DFF, F.ws + WS_W13M + (size_t)e * 5632 * 1024, 1, 0, scr, item, F.lane);
        else if (which == 1) cvt_item_f8(a.in[F.zz + I_MW3] + eo, 1024, DFF, F.ws + WS_W13M + (size_t)e * 5632 * 1024, 1, 128, scr, item, F.lane);
        else cvt_item_f8(a.in[F.zz + I_MW2] + eo, DFF, 1024, F.ws + WS_W2M + (size_t)e * 1024 * DFF, 0, 0, scr, item, F.lane);
    }
}
__device__ __forceinline__ void prologue(const Frame& F, const Args& a) {
    {
        LAS float* sc = (LAS float*)F.lds; LAS float* red = sc + 5120;
        for (int idx = F.tid; idx < 5120; idx += 512) { const int r = idx >> 10, k = idx & 1023; const float cv = (r < 4) ? a.in[F.zz + I_C][r * 1024 + k] : a.in[F.zz + I_CCTX][k]; sc[idx] = silu_f(cv); }
        __syncthreads();
        float* MOD = (float*)(F.ws + WS_MOD);
        for (int item = blockIdx.x; item < 384; item += F.G) {
            const int l = item / 96, nb = item - l * 96, cl = F.tid & 63, ks = F.tid >> 6, n = nb * 64 + cl;
            float acc[5] = {0.f, 0.f, 0.f, 0.f, 0.f};
            const float* wp = a.in[F.zz + I_ADAW] + ((size_t)l * 1024 + ks * 128) * 6144 + n;
#pragma unroll 16
            for (int kk = 0; kk < 128; ++kk) { const float w = wp[(size_t)kk * 6144];
#pragma unroll
                for (int r = 0; r < 5; ++r) acc[r] = fmaf(sc[r * 1024 + ks * 128 + kk], w, acc[r]); }
#pragma unroll
            for (int r = 0; r < 5; ++r) red[(ks * 5 + r) * 64 + cl] = acc[r];
            __syncthreads();
            if (F.tid < 320) { const int r = F.tid >> 6; float s = 0.f;
#pragma unroll
                for (int k2 = 0; k2 < 8; ++k2) s += red[(k2 * 5 + r) * 64 + cl];
                MOD[((size_t)l * 5 + r) * 6144 + n] = s + a.in[F.zz + I_ADAB][l * 6144 + n]; }
            __syncthreads();
        }
        if (blockIdx.x == 0 && F.tid < 256) {
            const float* lg = a.in[F.zz + I_LBL]; float x[4], mx = -3.0e38f;
#pragma unroll
            for (int l = 0; l < 4; ++l) { x[l] = lg[l * 256 + F.tid]; mx = fmaxf(mx, x[l]); }
            float s = 0.f;
#pragma unroll
            for (int l = 0; l < 4; ++l) { x[l] = expf(x[l] - mx); s += x[l]; }
            float cs = 0.f; const float sm0 = x[0] / s; float* LB = (float*)(F.ws + WS_LB);
#pragma unroll
            for (int l = 0; l < 4; ++l) { cs += x[l] / s; LB[l * 256 + F.tid] = fminf(fmaxf(cs - sm0, 0.f), 1.0f - 1e-6f); }
        }
        if (blockIdx.x == (1 % F.G)) {
            float* RC = (float*)(F.ws + WS_ROPE); float* RS = RC + 2048;
            for (int idx = F.tid; idx < 2048; idx += 512) { const int pos = idx >> 4, i = idx & 15;
                const float fr = powf(10000.0f, -(float)i / 16.0f); const float ang = (float)pos * fr; RC[idx] = cosf(ang); RS[idx] = sinf(ang); }
        }
        __syncthreads();
    }
    LAS float* scr = (LAS float*)(F.lds + F.wave * 16384);
    constexpr int I_IN = 16 * 104, I_OUT = 16 * 32, I_F = 1408, I_GL = 4 * 8;
    constexpr int NIT = 4 * I_IN + 4 * I_OUT + 6 * I_F + 4 * I_GL;
    for (int it = F.gw; it < NIT; it += F.NGW) {
        int r = it;
        if (r < 4 * I_IN) { const int l = r / I_IN; cvt_item(a.in[F.zz + I_WIN] + (size_t)l * 1024 * DIN, 1024, DIN, (bf16*)(F.ws + WS_WIN) + (size_t)l * DINP * 1024, 0, 0, scr, r - l * I_IN, F.lane, 104); continue; } r -= 4 * I_IN;
        if (r < 4 * I_OUT) { const int l = r / I_OUT; cvt_item(a.in[F.zz + I_WOUT] + (size_t)l * 1024 * 1024, 1024, 1024, (bf16*)(F.ws + WS_WOUT) + (size_t)l * 1024 * 1024, 0, 0, scr, r - l * I_OUT, F.lane); continue; } r -= 4 * I_OUT;
        if (r < 6 * I_F) { const int j = r / (3 * I_F), r2 = r - j * 3 * I_F, which = r2 / I_F, item = r2 - which * I_F; const size_t wo = (size_t)j * 1024 * DFF;
            if (which == 0) cvt_item(a.in[F.zz + I_FW1] + wo, 1024, DFF, (bf16*)(F.ws + WS_W13D) + (size_t)j * 5632 * 1024, 1, 0, scr, item, F.lane);
            else if (which == 1) cvt_item(a.in[F.zz + I_FW3] + wo, 1024, DFF, (bf16*)(F.ws + WS_W13D) + (size_t)j * 5632 * 1024, 1, 128, scr, item, F.lane);
            else cvt_item_f8(a.in[F.zz + I_FW2] + wo, DFF, 1024, F.ws + WS_W2D + (size_t)j * 1024 * DFF, 0, 0, scr, item, F.lane);
            continue; } r -= 6 * I_F;
        { const int l = r / I_GL; cvt_item(a.in[F.zz + I_GLUW] + (size_t)l * 65536, 256, 256, (bf16*)(F.ws + WS_GLUW) + (size_t)l * 65536, 0, 0, scr, r - l * I_GL, F.lane); }
    }
    for (int i = blockIdx.x * 512 + F.tid; i < 4 * 256 * 128; i += F.G * 512) {
        const int l = i >> 15, rem = i & 32767, n = rem >> 7, k0 = (rem & 127) * 8, d = n >> 7, cidx = n & 127;
        const float* wa = a.in[F.zz + I_WA2] + ((size_t)(l * 2 + d) * 16) * 128 + cidx;
        float acc[8] = {0.f, 0.f, 0.f, 0.f, 0.f, 0.f, 0.f, 0.f};
#pragma unroll
        for (int r = 0; r < 16; ++r) { const float w2 = wa[r * 128];
#pragma unroll
            for (int kk = 0; kk < 8; ++kk) acc[kk] = fmaf(a.in[F.zz + I_WIN][((size_t)l * 1024 + k0 + kk) * DIN + 3328 + 16 * d + r], w2, acc[kk]); }
        v4u o; o.x = pk2(acc[0], acc[1]); o.y = pk2(acc[2], acc[3]); o.z = pk2(acc[4], acc[5]); o.w = pk2(acc[6], acc[7]);
        *(v4u*)((bf16*)(F.ws + WS_WIN) + ((size_t)l * DINP + 3328 + n) * 1024 + k0) = o;
    }
}

struct MoeTp { int tp[9]; };
__device__ __forceinline__ void load_tp(MoeTp& t, const unsigned* cnt) {
    t.tp[0] = 0;
#pragma unroll
    for (int e = 0; e < 8; ++e) t.tp[e + 1] = t.tp[e] + (int)(((unsigned)__builtin_amdgcn_readfirstlane((int)__hip_atomic_load(cnt + e * 64, __ATOMIC_RELAXED, __HIP_MEMORY_SCOPE_AGENT)) + 255u) >> 8);
}
template <int MODE>
__device__ __forceinline__ void norm_phase(const Frame& F, const Args& a, int l, int which  , int nrows, int comb_l  ) {
    const float* MOD = (const float*)(F.ws + WS_MOD);
    const float* nw = (MODE == 2) ? a.in[F.zz + I_FINW] : ((which ? a.in[F.zz + I_N2W] : a.in[F.zz + I_N1W]) + l * 1024);
    bf16* XN = (bf16*)(F.ws + WS_ACT);
    float* hb = (float*)(F.ws + WS_HB);
    const int* EP = (const int*)(F.ws + WS_LIST) + 8 * MT; const float* GATE = (const float*)(F.ws + WS_LIST) + 10 * MT;
    const bf16* YM = (const bf16*)(F.ws + WS_X2);
    const bool from_input = (l == 0 && which == 0 && MODE != 2);
    MoeTp ctp; if (comb_l >= 0) load_tp(ctp, (const unsigned*)F.ws + CW_CNT + (comb_l >> 1) * 8 * 64);
    const int jm = l >> 1;
    LAS float* rwl = (LAS float*)F.lds;
    if (MODE == 1) {
        const float* rw = a.in[F.zz + I_RW] + (size_t)jm * 8192;
        for (int idx = F.tid; idx < 8192; idx += 512) { const int k = idx >> 3, e = idx & 7; rwl[e * 1024 + k] = rw[idx]; }
        __syncthreads();
    }
    f32x4 wv[4];
#pragma unroll
    for (int j = 0; j < 4; ++j) wv[j] = *((const f32x4*)nw + F.lane + 64 * j);
    f32x4 vn[4]; int epn0 = 0, epn1 = 0; float gn0 = 0.f, gn1 = 0.f;
    { const int m = F.gw < nrows ? F.gw : 0; const bool isctx = m >= NLAT;
      const float* xr = from_input ? (isctx ? a.in[F.zz + I_CTX] + (size_t)(m - NLAT) * 1024 : a.in[F.zz + I_X] + (size_t)m * 1024) : (isctx ? hb + (size_t)(m - NLAT) * 1024 : F.out + (size_t)m * 1024);
#pragma unroll
      for (int j = 0; j < 4; ++j) vn[j] = *((const f32x4*)xr + F.lane + 64 * j);
      if (comb_l >= 0) { epn0 = EP[2 * m]; epn1 = EP[2 * m + 1]; gn0 = GATE[2 * m]; gn1 = GATE[2 * m + 1]; } }
    for (int m = F.gw; m < nrows; m += F.NGW) {
        const bool isctx = m >= NLAT; const int bidx = isctx ? 4 : (m >> 13);
        f32x4 v[4];
#pragma unroll
        for (int j = 0; j < 4; ++j) v[j] = vn[j];
        const int ep0 = epn0, ep1 = epn1; const float g0 = gn0, g1 = gn1;
        { const int mn = (m + F.NGW < nrows) ? m + F.NGW : m; const bool cn = mn >= NLAT;
          const float* xr = from_input ? (cn ? a.in[F.zz + I_CTX] + (size_t)(mn - NLAT) * 1024 : a.in[F.zz + I_X] + (size_t)mn * 1024) : (cn ? hb + (size_t)(mn - NLAT) * 1024 : F.out + (size_t)mn * 1024);
#pragma unroll
          for (int j = 0; j < 4; ++j) vn[j] = *((const f32x4*)xr + F.lane + 64 * j);
          if (comb_l >= 0) { epn0 = EP[2 * mn]; epn1 = EP[2 * mn + 1]; gn0 = GATE[2 * mn]; gn1 = GATE[2 * mn + 1]; } }
        if (comb_l >= 0) {
            int t0 = 0, t1 = 0;
#pragma unroll
            for (int e = 0; e < 8; ++e) { t0 = ((ep0 & 7) == e) ? ctp.tp[e] : t0; t1 = ((ep1 & 7) == e) ? ctp.tp[e] : t1; }
            const size_t d0 = (size_t)t0 * 256 + (ep0 >> 3), d1 = (size_t)t1 * 256 + (ep1 >> 3);
            const float* m5 = MOD + ((size_t)comb_l * 5 + bidx) * 6144 + 5 * 1024;
            float* xw = isctx ? hb + (size_t)(m - NLAT) * 1024 : F.out + (size_t)m * 1024;
#pragma unroll
            for (int j = 0; j < 4; ++j) {
                const v2u y0 = *((const v2u*)(YM + d0 * 1024) + F.lane + 64 * j), y1 = *((const v2u*)(YM + d1 * 1024) + F.lane + 64 * j);
                const f32x4 mm = *((const f32x4*)m5 + F.lane + 64 * j);
                f32x4 f0, f1;
                f0[0] = __uint_as_float(y0.x << 16); f0[1] = __uint_as_float(y0.x & 0xffff0000u); f0[2] = __uint_as_float(y0.y << 16); f0[3] = __uint_as_float(y0.y & 0xffff0000u);
                f1[0] = __uint_as_float(y1.x << 16); f1[1] = __uint_as_float(y1.x & 0xffff0000u); f1[2] = __uint_as_float(y1.y << 16); f1[3] = __uint_as_float(y1.y & 0xffff0000u);
                v[j] = v[j] + mm * (f0 * g0 + f1 * g1);
                if (MODE != 2) *((f32x4*)xw + F.lane + 64 * j) = v[j];
            }
        }
        float ss = 0.f;
#pragma unroll
        for (int j = 0; j < 4; ++j) ss += (v[j][0] * v[j][0] + v[j][1] * v[j][1]) + (v[j][2] * v[j][2] + v[j][3] * v[j][3]);
        ss = wave_sum(ss);
        const float rstd = __builtin_amdgcn_rsqf(ss * (1.0f / 1024.0f) + NEPS);
        if (MODE == 2) {
#pragma unroll
            for (int j = 0; j < 4; ++j) *((f32x4*)(F.out + (size_t)m * 1024) + F.lane + 64 * j) = v[j] * rstd * wv[j];
        } else {
            const float* sh = MOD + ((size_t)l * 5 + bidx) * 6144 + (which ? 3 : 0) * 1024; const float* scl = sh + 1024;
            f32x4 o[4];
#pragma unroll
            for (int j = 0; j < 4; ++j) { const f32x4 s1 = *((const f32x4*)scl + F.lane + 64 * j), s0 = *((const f32x4*)sh + F.lane + 64 * j);
                o[j] = (v[j] * rstd * wv[j]) * (s1 + 1.0f) + s0;
                if (MODE == 1) {
                    unsigned w8 = 0u; w8 = __builtin_amdgcn_cvt_pk_fp8_f32(fminf(fmaxf(o[j][0], -448.f), 448.f), fminf(fmaxf(o[j][1], -448.f), 448.f), w8, false);
                    w8 = __builtin_amdgcn_cvt_pk_fp8_f32(fminf(fmaxf(o[j][2], -448.f), 448.f), fminf(fmaxf(o[j][3], -448.f), 448.f), w8, true);
                    *((unsigned*)((unsigned char*)XN + (size_t)m * 1024) + F.lane + 64 * j) = w8;
                } else { v2u w; w.x = pk2(o[j][0], o[j][1]); w.y = pk2(o[j][2], o[j][3]);
                    *((v2u*)(XN + (size_t)m * 1024) + F.lane + 64 * j) = w; } }
            if (MODE == 1) {
                float p[8];
#pragma unroll
                for (int e = 0; e < 8; ++e) { float s = 0.f;
#pragma unroll
                    for (int j = 0; j < 4; ++j) { const f32x4 w4 = *((const LAS f32x4*)(rwl + e * 1024) + F.lane + 64 * j);
                        s += (o[j][0] * w4[0] + o[j][1] * w4[1]) + (o[j][2] * w4[2] + o[j][3] * w4[3]); }
                    p[e] = wave_sum(s) + a.in[F.zz + I_RB][jm * 8 + e]; }
                int e0 = 0; float v0 = p[0];
#pragma unroll
                for (int e = 1; e < 8; ++e) if (p[e] > v0) { v0 = p[e]; e0 = e; }
                int e1 = -1; float v1 = -3.0e38f;
#pragma unroll
                for (int e = 0; e < 8; ++e) if (e != e0 && p[e] > v1) { v1 = p[e]; e1 = e; }
                const float ex = expf(v1 - v0), g0 = 1.0f / (1.0f + ex), g1 = ex / (1.0f + ex);
                if (F.lane == 0) {
                    unsigned* cnt = (unsigned*)F.ws + CW_CNT + jm * 8 * 64; int* LIST = (int*)(F.ws + WS_LIST);
                    int* EPw = (int*)(F.ws + WS_LIST) + 8 * MT; float* GW = (float*)(F.ws + WS_LIST) + 10 * MT;
                    const unsigned p0 = __hip_atomic_fetch_add(cnt + e0 * 64, 1u, __ATOMIC_RELAXED, __HIP_MEMORY_SCOPE_AGENT);
                    const unsigned p1 = __hip_atomic_fetch_add(cnt + e1 * 64, 1u, __ATOMIC_RELAXED, __HIP_MEMORY_SCOPE_AGENT);
                    LIST[e0 * MT + p0] = m; LIST[e1 * MT + p1] = m;
                    EPw[2 * m] = e0 | (int)(p0 << 3); EPw[2 * m + 1] = e1 | (int)(p1 << 3);
                    GW[2 * m] = g0; GW[2 * m + 1] = g1;
                }
            }
        }
    }
    if (MODE == 1) __syncthreads();
}
__device__ __forceinline__ void moe_gather(const Frame& F, int jm) {
    const unsigned* cnt = (const unsigned*)F.ws + CW_CNT + jm * 8 * 64;
    MoeTp t; load_tp(t, cnt);
    int cn[8];
#pragma unroll
    for (int e = 0; e < 8; ++e) cn[e] = __builtin_amdgcn_readfirstlane((int)__hip_atomic_load(cnt + e * 64, __ATOMIC_RELAXED, __HIP_MEMORY_SCOPE_AGENT));
    const int rows = t.tp[8] * 256;
    const int* LIST = (const int*)(F.ws + WS_LIST); const v4u* XN = (const v4u*)(F.ws + WS_ACT); v4u* XB = (v4u*)(F.ws + WS_X2);
    for (int r = F.gw; r < rows; r += F.NGW) {
        const int tile = r >> 8; int e = 0, tpe = 0, ce = cn[0];
#pragma unroll
        for (int k = 1; k < 8; ++k) { const bool ge = tile >= t.tp[k]; e += ge ? 1 : 0; tpe = ge ? t.tp[k] : tpe; ce = ge ? cn[k] : ce; }
        const int pos = r - tpe * 256;
        v4u x0 = {0u, 0u, 0u, 0u};
        if (pos < ce) { const int src = LIST[e * MT + pos]; x0 = XN[(size_t)src * 64 + F.lane]; }
        XB[(size_t)r * 64 + F.lane] = x0;
    }
}
#define GLD(T, ubase, voff) (*(const T*)((const char*)(ubase) + (unsigned)(voff)))
#define GST(T, ubase, voff) (*(T*)((char*)(ubase) + (unsigned)(voff)))
__device__ __forceinline__ int fresh_lane() { int l; asm volatile("v_mbcnt_lo_u32_b32 %0, -1, 0\n\tv_mbcnt_hi_u32_b32 %0, -1, %0" : "=v"(l)); return l; }

struct MixP { const bf16* P; const float* lb; const float* rcos; const float* rsin; const float* ba; };
__device__ __forceinline__ int seg_row0(int b, int sg) { return sg < 4 ? NLAT + b * CTXL + sg * 64 : b * SEQ + (sg - 4) * 64; }
__device__ __forceinline__ int seg_tpos0(int sg) { return sg < 4 ? -1 : (sg - 4) * 64; }

struct S5P { const float *lam_re, *lam_im, *log_dt, *b_re, *b_im, *c_re, *c_im, *dd; };
__device__ __forceinline__ float gelu_tanh(float y) { const float t = 0.7978845608028654f * (y + 0.044715f * y * y * y); const float th = 1.0f - 2.0f * __builtin_amdgcn_rcpf(1.0f + __expf(2.0f * t)); return 0.5f * y * (1.0f + th); }
template <int MODE>
__device__ __forceinline__ void s5_scan(const S5P& sp, const bf16* P, int b, int g, int dir, int sg, int lane, float& hre, float& him, LAS float* yf, LAS float* stg, bf16* Z) {
    const int row0 = seg_row0(b, sg); const int dg = dir * 16 + g;
    const float lre = sp.lam_re[dg * 64 + lane], lim = sp.lam_im[dg * 64 + lane], dt = expf(sp.log_dt[dg]);
    const float er = expf(lre * dt); const float sn = sinf(lim * dt), cs = cosf(lim * dt);
    const float ar = er * cs, ai = er * sn;
    const float nr = ar - 1.0f, ni = ai, den = lre * lre + lim * lim;
    const float cr = (nr * lre + ni * lim) / den, ci = (ni * lre - nr * lim) / den;
    float bbr[16], bbi[16], Cr[16], Ci[16];
#pragma unroll
    for (int c = 0; c < 16; ++c) { const float Br = sp.b_re[((size_t)dg * 64 + lane) * 16 + c], Bi = sp.b_im[((size_t)dg * 64 + lane) * 16 + c];
        bbr[c] = cr * Br - ci * Bi; bbi[c] = cr * Bi + ci * Br;
        Cr[c] = (MODE != 0) ? sp.c_re[((size_t)dg * 16 + c) * 64 + lane] : 0.f; Ci[c] = (MODE != 0) ? sp.c_im[((size_t)dg * 16 + c) * 64 + lane] : 0.f; }
    const int ch = ((lane >> 5) & 1) * 8 + ((lane >> 4) & 1) * 4 + ((lane >> 3) & 1) * 2 + ((lane >> 2) & 1);
    const float dv = (MODE == 2) ? sp.dd[g * 16 + ch] : 0.f;
    const bool b5 = lane & 32, b4 = lane & 16, b3 = lane & 8, b2 = lane & 4;
    const unsigned ucol = 2u * (unsigned)(C_S5 + g * 16 + (lane & 15));
    unsigned short rn0[4], rn1[4], rn2[4];
#pragma unroll
    for (int u = 0; u < 4; ++u) { rn0[u] = GLD(unsigned short, P + (size_t)(row0 + (dir ? 63 - u : u)) * DINP, ucol); rn1[u] = GLD(unsigned short, P + (size_t)(row0 + (dir ? 59 - u : 4 + u)) * DINP, ucol);
        rn2[u] = GLD(unsigned short, P + (size_t)(row0 + (dir ? 55 - u : 8 + u)) * DINP, ucol); }
#pragma unroll 1
    for (int i0 = 0; i0 < 64; i0 += 4) {
        unsigned short ru[4], rn3[4];
        const int ip = (i0 + 12 < 64) ? i0 + 12 : 60;
#pragma unroll
        for (int u = 0; u < 4; ++u) { ru[u] = rn0[u]; rn3[u] = GLD(unsigned short, P + (size_t)(row0 + (dir ? 63 - (ip + u) : (ip + u))) * DINP, ucol); }
#pragma unroll
        for (int u = 0; u < 4; ++u) stg[u * 64 + lane] = bf2f(ru[u]);
#pragma unroll
        for (int u = 0; u < 4; ++u) {
            const int ti = dir ? 63 - (i0 + u) : (i0 + u);
            const float uf = bf2f(ru[u]);
            float bur = 0.f, bui = 0.f;
#pragma unroll
            for (int c4 = 0; c4 < 4; ++c4) { const f32x4 ux = *(const LAS f32x4*)(stg + u * 64 + 4 * c4);
#pragma unroll
                for (int jj = 0; jj < 4; ++jj) { bur = fmaf(bbr[4 * c4 + jj], ux[jj], bur); bui = fmaf(bbi[4 * c4 + jj], ux[jj], bui); } }
            const float nre = ar * hre - ai * him + bur, nim = ar * him + ai * hre + bui;
            hre = nre; him = nim;
            if (MODE != 0) {
                float v[16];
#pragma unroll
                for (int c = 0; c < 16; ++c) v[c] = Cr[c] * hre - Ci[c] * him;
                float w8[8], w4[4], w2[2], w1;
#pragma unroll
                for (int i = 0; i < 8; ++i) { const float mine = b5 ? v[8 + i] : v[i], oth = b5 ? v[i] : v[8 + i]; w8[i] = mine + __shfl_xor(oth, 32); }
#pragma unroll
                for (int i = 0; i < 4; ++i) { const float mine = b4 ? w8[4 + i] : w8[i], oth = b4 ? w8[i] : w8[4 + i]; w4[i] = mine + __shfl_xor(oth, 16); }
#pragma unroll
                for (int i = 0; i < 2; ++i) { const float mine = b3 ? w4[2 + i] : w4[i], oth = b3 ? w4[i] : w4[2 + i]; w2[i] = mine + __shfl_xor(oth, 8); }
                { const float mine = b2 ? w2[1] : w2[0], oth = b2 ? w2[0] : w2[1]; w1 = mine + __shfl_xor(oth, 4); }
                w1 += __shfl_xor(w1, 2); w1 += __shfl_xor(w1, 1);
                if (MODE == 1) { if ((lane & 3) == 0) yf[ti * 16 + ch] = w1; }
                if (MODE == 2) {
                    const float uch = __shfl(uf, ch);
                    if ((lane & 3) == 0) { const float y = w1 + yf[ti * 16 + ch] + dv * uch; Z[(size_t)(row0 + ti) * 256 + g * 16 + ch] = (bf16)f2bf(gelu_tanh(y)); }
                }
            }
        }
#pragma unroll
        for (int u = 0; u < 4; ++u) { rn0[u] = rn1[u]; rn1[u] = rn2[u]; rn2[u] = rn3[u]; }
    }
}

__device__ __forceinline__ MixP make_mixp(const Frame& F, const Args& a, int l) {
    MixP mp; mp.P = (const bf16*)(F.ws + WS_PH); mp.lb = (const float*)(F.ws + WS_LB) + l * 256; mp.rcos = (const float*)(F.ws + WS_ROPE); mp.rsin = mp.rcos + 2048;
    mp.ba = a.in[F.zz + I_BA] + (size_t)l * 2 * 128; return mp;
}
__device__ __forceinline__ S5P make_s5p(const Frame& F, const Args& a, int l) {
    S5P sp; sp.lam_re = a.in[F.zz + I_LAMRE] + (size_t)l * 2048; sp.lam_im = a.in[F.zz + I_LAMIM] + (size_t)l * 2048; sp.log_dt = a.in[F.zz + I_LOGDT] + l * 32;
    sp.b_re = a.in[F.zz + I_BRE] + (size_t)l * 32768; sp.b_im = a.in[F.zz + I_BIM] + (size_t)l * 32768; sp.c_re = a.in[F.zz + I_CRE] + (size_t)l * 32768; sp.c_im = a.in[F.zz + I_CIM] + (size_t)l * 32768;
    sp.dd = a.in[F.zz + I_S5D] + l * 256; return sp;
}


typedef short bf16x8_t __attribute__((ext_vector_type(8)));
typedef float f32x16 __attribute__((ext_vector_type(16)));
typedef float f32x2_t __attribute__((ext_vector_type(2)));
typedef __bf16 bf16x2_n __attribute__((ext_vector_type(2)));
__device__ __forceinline__ unsigned pkbf(float lo, float hi) { const f32x2_t v = {lo, hi}; const bf16x2_n r = __builtin_convertvector(v, bf16x2_n); return __builtin_bit_cast(unsigned, r); }
constexpr int WL_QC = 0, WL_KC = 4608, WL_KT = 9216, WL_VT = 14336, WL_PL = 19456, WL_BYTES = 19712;

struct MxC { float gamma, lbv, oml, bav, rc1, rs1; unsigned cq, ck, cv, cz; };
template <int MIX>
__device__ __forceinline__ void mx_consts(MxC& c, const MixP& mp, int h, int dir, int lane) {
    c.gamma = 1.f; c.lbv = 0.f; c.oml = 1.f; c.bav = 0.f; c.cz = 0; c.rc1 = 1.f; c.rs1 = 0.f;
    if (MIX == 0) { c.cq = 8u * (unsigned)(C_RQ + h * 64 + lane); c.ck = 8u * (unsigned)(C_RK + h * 64 + lane); c.cv = 8u * (unsigned)(C_RV + h * 64 + lane); c.gamma = 1.0f - exp2f(-5.0f - (float)(dir ? 3 - h : h));
        if (lane & 32) { const unsigned r1 = 4u * (unsigned)(16 + (lane & 15)); c.rc1 = GLD(float, mp.rcos, r1); const float s1 = GLD(float, mp.rsin, r1); c.rs1 = dir ? -s1 : s1; } }
    else if (MIX == 1) { c.cq = 8u * (unsigned)(C_HQ + h * 64 + lane); c.ck = 8u * (unsigned)((dir ? C_HFB : C_HFF) + h * 64 + lane); c.cv = 8u * (unsigned)(C_HI + h * 64 + lane); c.lbv = mp.lb[h * 64 + lane]; c.oml = 1.0f - c.lbv; }
    else { c.cq = 8u * (unsigned)(C_GQ + h * 32 + (lane & 31)); c.ck = 8u * (unsigned)(C_GK + h * 32 + (lane & 31)); c.cv = 8u * (unsigned)(C_GV + h * 64 + lane); c.cz = 8u * (unsigned)((dir ? C_GZB : C_GZF) + h * 32 + (lane & 31));
        c.bav = mp.ba[dir * 128 + h * 32 + (lane & 31)]; }
}
struct MxRaw { v2u q, k, v, z; };
template <int MIX, bool NEEDQ, int DIR>
__device__ __forceinline__ void mx_load(MxRaw& w, const MixP& mp, const MxC& c, int rows, int b) {
    const bf16* pr = mp.P + (size_t)((rows >> 2) + (DIR ? 15 - b : b)) * P4G;
    const v2u zero = {0u, 0u};
    w.q = NEEDQ ? GLD(v2u, pr, c.cq) : zero; w.k = GLD(v2u, pr, c.ck); w.v = GLD(v2u, pr, c.cv); w.z = (MIX == 2) ? GLD(v2u, pr, c.cz) : zero;
}
__device__ __forceinline__ float bfx(const v2u& w, int i) { const unsigned d = (i >> 1) ? w.y : w.x; return __builtin_bit_cast(float, (i & 1) ? (d & 0xffff0000u) : (d << 16)); }
template <int MIX, bool NEEDQ, int DIR>
__device__ __forceinline__ void mx_batch(const MxRaw& cur, const MixP& mp, const MxC& c, int tposs  , int lane, LAS unsigned char* wl, int b, float& P, float& rc, float& rs) {
    constexpr int DK = (MIX == 2) ? 32 : 64;
    float kt[4];
#pragma unroll
    for (int u = 0; u < 4; ++u) {
        const int cc = b * 4 + u, ts = DIR ? 63 - cc : cc, t = ts & 31;
        const int pu = DIR ? 3 - u : u; float q = bfx(cur.q, pu), k, f;
        if (MIX == 0) {
            k = bfx(cur.k, pu) * 0.125f; f = c.gamma;
            if (tposs >= 0) { const float cs = rc, sn = rs;
                rc = cs * c.rc1 - sn * c.rs1; rs = sn * c.rc1 + cs * c.rs1;
                const float ss = (lane & 16) ? sn : -sn;
                const float kp = __shfl_xor(k, 16); k = fmaf(kp, ss, k * cs);
                if (NEEDQ) { const float qp = __shfl_xor(q, 16); q = fmaf(qp, ss, q * cs); } }
        } else if (MIX == 1) {
            const float z = bfx(cur.k, pu); const float e = __expf(-z); const float sp = __builtin_amdgcn_rcpf(1.0f + e), sn = e * sp;
            f = fmaf(c.oml, sp, c.lbv); k = c.oml * sn;
        } else {
            k = bfx(cur.k, pu) * 0.17677669529663687f; const float z = bfx(cur.z, pu) + c.bav;
            const float ls = fminf(z, 0.f) - __logf(1.0f + __expf(-fabsf(z)));
            f = __expf(ls * 0.0625f);
        }
        P = fmaxf(P * f, 1e-30f);
        const float kk = k * __builtin_amdgcn_rcpf(P); kt[DIR ? 3 - u : u] = kk;
        if (lane < DK) {
            const unsigned qk = pkbf(q * P, kk);
            if (NEEDQ) *(LAS unsigned short*)(wl + WL_QC + t * 144 + lane * 2) = (unsigned short)qk;
            *(LAS unsigned short*)(wl + WL_KC + t * 144 + lane * 2) = (unsigned short)(qk >> 16);
        }
    }
    const int g4 = ((DIR ? 63 - b * 4 : b * 4) & 31) >> 2;
    v2u kp; kp.x = pkbf(kt[0], kt[1]); kp.y = pkbf(kt[2], kt[3]);
    if (lane < DK) *(LAS v2u*)(wl + WL_KT + lane * 80 + g4 * 8) = kp;
    *(LAS v2u*)(wl + WL_VT + lane * 80 + g4 * 8) = cur.v;
}
typedef short bf16x4_t __attribute__((ext_vector_type(4)));
#define MFMA8(a, b, c) __builtin_amdgcn_mfma_f32_32x32x8bf16_1k((a), (b), (c), 0, 0, 0)
__device__ __forceinline__ bf16x4_t pack4(const f32x16& x, int s) {
    v2u p; p.x = pkbf(x[4 * s], x[4 * s + 1]); p.y = pkbf(x[4 * s + 2], x[4 * s + 3]);
    return __builtin_bit_cast(bf16x4_t, p);
}
__device__ __forceinline__ bf16x4_t ld4(const LAS unsigned char* p) { const v2u a = *(const LAS v2u*)p; return __builtin_bit_cast(bf16x4_t, a); }

template <int MODE, int DIR>
__device__ __forceinline__ void s5_mm_dir(const S5P& sp, const bf16* P, int b, int g, int sg, int lane, float& hre, float& him, LAS float* yf, LAS unsigned char* hs, bf16* Z) {
    const int m32 = lane & 31, hh = lane >> 5, dg = DIR * 16 + g, row0 = seg_row0(b, sg);
    float ar[2], ai[2], a2r[2], a2i[2], a3r[2], a3i[2], a4r[2], a4i[2];
    bf16x4_t bfr[4][2];
    const float dt = __expf(sp.log_dt[dg]);
#pragma unroll
    for (int sh = 0; sh < 2; ++sh) {
        const int p = 32 * sh + m32;
        const float lre = sp.lam_re[dg * 64 + p], lim = sp.lam_im[dg * 64 + p];
        const float er = __expf(lre * dt), sn = sinf(lim * dt), cs = cosf(lim * dt);
        ar[sh] = er * cs; ai[sh] = er * sn;
        a2r[sh] = ar[sh] * ar[sh] - ai[sh] * ai[sh]; a2i[sh] = ar[sh] * ai[sh] + ar[sh] * ai[sh];
        a3r[sh] = a2r[sh] * ar[sh] - a2i[sh] * ai[sh]; a3i[sh] = a2r[sh] * ai[sh] + a2i[sh] * ar[sh];
        a4r[sh] = a2r[sh] * a2r[sh] - a2i[sh] * a2i[sh]; a4i[sh] = a2r[sh] * a2i[sh] + a2r[sh] * a2i[sh];
        const float nr = ar[sh] - 1.0f, ni = ai[sh], den = 1.0f / (lre * lre + lim * lim);
        const float cr = (nr * lre + ni * lim) * den, ci = (ni * lre - nr * lim) * den;
#pragma unroll
        for (int s2 = 0; s2 < 2; ++s2) {
            const f32x4 Br = *(const f32x4*)(sp.b_re + ((size_t)dg * 64 + p) * 16 + 8 * s2 + 4 * hh), Bi = *(const f32x4*)(sp.b_im + ((size_t)dg * 64 + p) * 16 + 8 * s2 + 4 * hh);
            const f32x4 re = Br * cr - Bi * ci, im = Bi * cr + Br * ci;
            v2u pr, pi; pr.x = pkbf(re[0], re[1]); pr.y = pkbf(re[2], re[3]); pi.x = pkbf(im[0], im[1]); pi.y = pkbf(im[2], im[3]);
            bfr[sh][s2] = __builtin_bit_cast(bf16x4_t, pr); bfr[2 + sh][s2] = __builtin_bit_cast(bf16x4_t, pi);
        }
    }
    bf16x4_t cfr[16];
    if (MODE != 0) {
#pragma unroll
        for (int s = 0; s < 16; ++s) {
            const int p4 = (8 * s + 4 * hh) & 63; f32x4 cv = {0.f, 0.f, 0.f, 0.f};
            if (m32 < 16) cv = (s < 8) ? *(const f32x4*)(sp.c_re + ((size_t)dg * 16 + m32) * 64 + p4) : -*(const f32x4*)(sp.c_im + ((size_t)dg * 16 + m32) * 64 + p4);
            v2u pc; pc.x = pkbf(cv[0], cv[1]); pc.y = pkbf(cv[2], cv[3]); cfr[s] = __builtin_bit_cast(bf16x4_t, pc);
        }
    }
    const float ddv = (MODE == 2 && m32 < 16) ? sp.dd[g * 16 + m32] : 0.f;
    float hr[2], hi[2];
    hr[0] = __shfl(hre, m32); hi[0] = __shfl(him, m32); hr[1] = __shfl(hre, m32 + 32); hi[1] = __shfl(him, m32 + 32);
#pragma unroll 1
    for (int ci2 = 0; ci2 < 2; ++ci2) {
        const int ch = DIR ? 1 - ci2 : ci2, rowc = row0 + 32 * ch;
        const bf16* urow = P + (size_t)((rowc + m32) >> 2) * P4G + P4S5 + (m32 & 3) * 256 + g * 16 + 4 * hh;
        const bf16x4_t ua0 = __builtin_bit_cast(bf16x4_t, *(const v2u*)urow), ua1 = __builtin_bit_cast(bf16x4_t, *(const v2u*)(urow + 8));
        f32x16 BU[4];
#pragma unroll
        for (int nt = 0; nt < 4; ++nt) {
#pragma unroll
            for (int r = 0; r < 16; ++r) BU[nt][r] = 0.f;
            BU[nt] = MFMA8(ua0, bfr[nt][0], BU[nt]); BU[nt] = MFMA8(ua1, bfr[nt][1], BU[nt]);
        }
#pragma unroll
        for (int sh = 0; sh < 2; ++sh)
#pragma unroll
            for (int gg = 0; gg < 4; ++gg)
#pragma unroll
                for (int jj = 1; jj < 4; ++jj) {
                    const int r = DIR ? 4 * gg + 3 - jj : 4 * gg + jj, rp = DIR ? r + 1 : r - 1;
                    const float pr = BU[sh][rp], pi = BU[2 + sh][rp];
                    BU[sh][r] += ar[sh] * pr - ai[sh] * pi; BU[2 + sh][r] += ar[sh] * pi + ai[sh] * pr;
                }
        float hnr[2][4], hni[2][4];
#pragma unroll
        for (int st = 0; st < 8; ++st) {
            const int gg = DIR ? 3 - (st >> 1) : (st >> 1), turn = DIR ? 1 - (st & 1) : (st & 1), rl = DIR ? 4 * gg : 4 * gg + 3;
            const bool act = (hh == turn);
#pragma unroll
            for (int sh = 0; sh < 2; ++sh) {
                if (turn == (DIR ? 1 : 0)) { hnr[sh][gg] = hr[sh]; hni[sh][gg] = hi[sh]; }
                else { hnr[sh][gg] = act ? hr[sh] : hnr[sh][gg]; hni[sh][gg] = act ? hi[sh] : hni[sh][gg]; }
                const float outr = BU[sh][rl] + a4r[sh] * hr[sh] - a4i[sh] * hi[sh], outi = BU[2 + sh][rl] + a4r[sh] * hi[sh] + a4i[sh] * hr[sh];
                const float sr = __shfl_xor(outr, 32), si = __shfl_xor(outi, 32);
                hr[sh] = act ? outr : sr; hi[sh] = act ? outi : si;
            }
        }
        if (MODE != 0) {
#pragma unroll
            for (int sh = 0; sh < 2; ++sh)
#pragma unroll
                for (int gg = 0; gg < 4; ++gg)
#pragma unroll
                    for (int jj = 0; jj < 4; ++jj) {
                        const int pw = DIR ? 4 - jj : jj + 1;
                        const float pr = (pw == 1) ? ar[sh] : (pw == 2) ? a2r[sh] : (pw == 3) ? a3r[sh] : a4r[sh], pi = (pw == 1) ? ai[sh] : (pw == 2) ? a2i[sh] : (pw == 3) ? a3i[sh] : a4i[sh];
                        BU[sh][4 * gg + jj] += pr * hnr[sh][gg] - pi * hni[sh][gg]; BU[2 + sh][4 * gg + jj] += pr * hni[sh][gg] + pi * hnr[sh][gg];
                    }
#pragma unroll
            for (int nt = 0; nt < 4; ++nt)
#pragma unroll
                for (int r = 0; r < 16; ++r) *(LAS unsigned short*)(hs + ((r & 3) + 8 * (r >> 2) + 4 * hh) * 272 + (32 * nt + m32) * 2) = (unsigned short)pkbf(BU[nt][r], BU[nt][r]);
            f32x16 Yv;
#pragma unroll
            for (int r = 0; r < 16; ++r) Yv[r] = 0.f;
#pragma unroll
            for (int s = 0; s < 16; ++s) Yv = MFMA8(ld4(hs + m32 * 272 + (8 * s + 4 * hh) * 2), cfr[s], Yv);
            if (m32 < 16) {
#pragma unroll
                for (int r = 0; r < 16; ++r) {
                    const int tl = (r & 3) + 8 * (r >> 2) + 4 * hh;
                    if (MODE == 1) yf[(32 * ch + tl) * 16 + m32] = Yv[r];
                    else { const float u = bf2f(P[(size_t)((rowc + tl) >> 2) * P4G + P4S5 + (tl & 3) * 256 + g * 16 + m32]);
                        const float y = Yv[r] + yf[(32 * ch + tl) * 16 + m32] + ddv * u;
                        const float zz = gelu_tanh(y); Z[(size_t)(rowc + tl) * 256 + g * 16 + m32] = (bf16)pkbf(zz, zz); }
                }
            }
        }
    }
    hre = hh ? hr[1] : hr[0]; him = hh ? hi[1] : hi[0];
}
template <int MODE>
__device__ __forceinline__ void s5_mm(const S5P& sp, const bf16* P, int b, int g, int dir, int sg, int lane, float& hre, float& him, LAS float* yf, LAS unsigned char* hs, bf16* Z) {
    if (dir) s5_mm_dir<MODE, 1>(sp, P, b, g, sg, lane, hre, him, yf, hs, Z); else s5_mm_dir<MODE, 0>(sp, P, b, g, sg, lane, hre, him, yf, hs, Z);
}
template <int MIX, int DIR, bool WITH_O>
__device__ __forceinline__ void mx_chunk(LAS unsigned char* wl, int lane, float Pl, f32x16 (&ST)[(MIX == 2) ? 1 : 2][2], f32x16 (&O)[2]) {
    constexpr int DK = (MIX == 2) ? 32 : 64, NRT = DK / 32;
    const int m32 = lane & 31, hh = lane >> 5;
    asm volatile("" ::: "memory");
    if (lane < DK) *(LAS float*)(wl + WL_PL + lane * 4) = Pl;
    asm volatile("" ::: "memory");
    if (WITH_O) {
        f32x16 x;
#pragma unroll
        for (int r = 0; r < 16; ++r) x[r] = 0.f;
#pragma unroll
        for (int s = 0; s < DK / 8; ++s) {
            const bf16x4_t ka = ld4(wl + WL_KC + m32 * 144 + (8 * s + 4 * hh) * 2);
            const bf16x4_t qb = ld4(wl + WL_QC + m32 * 144 + (8 * s + 4 * hh) * 2);
            x = MFMA8(ka, qb, x);
        }
#pragma unroll
        for (int r = 0; r < 16; ++r) { const int j = (r & 3) + 8 * (r >> 2) + 4 * hh; const bool keep = DIR ? (j >= m32) : (j <= m32); x[r] = keep ? x[r] : 0.f; }
#pragma unroll
        for (int t = 0; t < 2; ++t)
#pragma unroll
            for (int r = 0; r < 16; ++r) O[t][r] = 0.f;
#pragma unroll
        for (int s = 0; s < 4; ++s) {
            const bf16x4_t xa = pack4(x, s);
#pragma unroll
            for (int t = 0; t < 2; ++t) O[t] = MFMA8(xa, ld4(wl + WL_VT + (32 * t + m32) * 80 + (8 * s + 4 * hh) * 2), O[t]);
        }
#pragma unroll
        for (int rt = 0; rt < NRT; ++rt)
#pragma unroll
            for (int s = 0; s < 4; ++s) {
                const bf16x4_t qa = ld4(wl + WL_QC + m32 * 144 + (32 * rt + 8 * s + 4 * hh) * 2);
#pragma unroll
                for (int t = 0; t < 2; ++t) O[t] = MFMA8(qa, pack4(ST[rt][t], s), O[t]);
            }
    }
#pragma unroll
    for (int rt = 0; rt < NRT; ++rt)
#pragma unroll
        for (int s = 0; s < 4; ++s) {
            const bf16x4_t ka = ld4(wl + WL_KT + (32 * rt + m32) * 80 + (8 * s + 4 * hh) * 2);
#pragma unroll
            for (int t = 0; t < 2; ++t) ST[rt][t] = MFMA8(ka, ld4(wl + WL_VT + (32 * t + m32) * 80 + (8 * s + 4 * hh) * 2), ST[rt][t]);
        }
#pragma unroll
    for (int rt = 0; rt < NRT; ++rt)
#pragma unroll
        for (int g = 0; g < 4; ++g) {
            const f32x4 pl4 = *(const LAS f32x4*)(wl + WL_PL + (32 * rt + 8 * g + 4 * hh) * 4);
#pragma unroll
            for (int e = 0; e < 4; ++e) { ST[rt][0][4 * g + e] *= pl4[e]; ST[rt][1][4 * g + e] *= pl4[e]; }
        }
}
__device__ __forceinline__ float half_sum(float v) {
#pragma unroll
    for (int o = 1; o < 32; o <<= 1) v += __shfl_xor(v, o);
    return v;
}
template <int MIX, int DIR>
__device__ __forceinline__ void mixA_stream(const MixP& mp, const MxC& c, int row0, int tpos0, int lane, LAS unsigned char* wl, f32x16 (&ST)[(MIX == 2) ? 1 : 2][2], float& Gam) {
    f32x16 O[2];
    constexpr int PD = 6;
    MxRaw r[PD + 1];
#pragma unroll
    for (int i = 0; i < PD; ++i) mx_load<MIX, false, DIR>(r[i], mp, c, row0, i);
    float rc = 1.0f, rs = 0.0f;
    if (MIX == 0 && tpos0 >= 0) { const int tpos = tpos0 + (DIR ? 63 : 0); const int pos = (lane & 32) ? (tpos & 63) : (tpos >> 6);
        const unsigned ro = 4u * (unsigned)(pos * 16 + (lane & 15)); rc = GLD(float, mp.rcos, ro); rs = GLD(float, mp.rsin, ro); }
    float P = 1.0f;
#pragma unroll 1
    for (int b = 0; b < 16; ++b) {
        mx_load<MIX, false, DIR>(r[PD], mp, c, row0, b < 16 - PD ? b + PD : 15);
        int ln = lane; asm volatile("" : "+v"(ln));
        mx_batch<MIX, false, DIR>(r[0], mp, c, tpos0, ln, wl, b, P, rc, rs);
        if ((b & 7) == 7) { Gam *= P; mx_chunk<MIX, 0, false>(wl, ln, P, ST, O); P = 1.0f; }
#pragma unroll
        for (int i = 0; i < PD; ++i) r[i] = r[i + 1];
    }
}
template <int MIX>
__device__ __forceinline__ void mixA_unit(const MixP& mp, float* STG, int idx, int lane_in, LAS unsigned char* wl) {
    int lane = lane_in;
    constexpr int DK = (MIX == 2) ? 32 : 64, NRT = DK / 32;
    const int dir = idx / 2112, rem = idx - dir * 2112, bh = rem / NSEG, sg = rem - bh * NSEG, b = bh >> 2, h = bh & 3;
    asm volatile("" : "+v"(lane));
    MxC c; mx_consts<MIX>(c, mp, h, dir, lane);
    f32x16 ST[NRT][2];
#pragma unroll
    for (int rt = 0; rt < NRT; ++rt)
#pragma unroll
        for (int t = 0; t < 2; ++t)
#pragma unroll
            for (int r = 0; r < 16; ++r) ST[rt][t][r] = 0.f;
    const int row0 = seg_row0(b, sg), tpos0 = seg_tpos0(sg);
    float Gam = 1.0f;
    if (dir) mixA_stream<MIX, 1>(mp, c, row0, tpos0, lane, wl, ST, Gam); else mixA_stream<MIX, 0>(mp, c, row0, tpos0, lane, wl, ST, Gam);
    const size_t slot = (size_t)((dir * 16 + bh) * NSEG + sg);
    float* ds = STG + (MIX == 0 ? ST_DS0 : (MIX == 1 ? ST_DS1 : ST_DS2)) + slot * (DK * 64);
    const int m32 = lane & 31, hh = lane >> 5;
#pragma unroll
    for (int rt = 0; rt < NRT; ++rt)
#pragma unroll
        for (int t = 0; t < 2; ++t)
#pragma unroll
            for (int r4 = 0; r4 < 4; ++r4) { const f32x4 v = {ST[rt][t][4 * r4], ST[rt][t][4 * r4 + 1], ST[rt][t][4 * r4 + 2], ST[rt][t][4 * r4 + 3]};
                GST(f32x4, ds + ((rt * 2 + t) * 4 + r4) * 256, 16u * (unsigned)lane) = v; }
    float* gs = STG + (MIX == 0 ? ST_G0 : (MIX == 1 ? ST_G1 : ST_G2)) + slot * 64;
    GST(float, gs, 4u * (unsigned)lane) = Gam;
}
template <int MIX, int MODE>
__device__ __forceinline__ void mx_epilogue(const MixP& mp, LAS unsigned char* wl, int lane, const f32x16 (&O)[2], int rowc, float* OF, bf16* Y, int ocol, int ycol, int cgate, float nwv) {
    LAS float* ost = (LAS float*)(wl + WL_QC);
    const int m32 = lane & 31, hh = lane >> 5;
    asm volatile("" ::: "memory");
#pragma unroll
    for (int t = 0; t < 2; ++t)
#pragma unroll
        for (int r = 0; r < 16; ++r) ost[((r & 3) + 8 * (r >> 2) + 4 * hh) * 68 + 32 * t + m32] = O[t][r];
    asm volatile("" ::: "memory");
    if (MODE == 1) {
#pragma unroll 8
        for (int tk = 0; tk < 32; ++tk) GST(float, OF + (size_t)(rowc + tk) * 768 + ocol, 4u * (unsigned)lane) = ost[tk * 68 + lane];
    } else {
        float ofc[8]; v2u gc[2];
#pragma unroll
        for (int u = 0; u < 8; ++u) ofc[u] = GLD(float, OF + (size_t)(rowc + u) * 768 + ocol, 4u * (unsigned)lane);
#pragma unroll
        for (int u = 0; u < 2; ++u) gc[u] = GLD(v2u, mp.P + (size_t)((rowc >> 2) + u) * P4G, 8u * (unsigned)(cgate + lane));
#pragma unroll 1
        for (int b8 = 0; b8 < 4; ++b8) {
            float ofn[8]; v2u gn[2]; const int nb = b8 < 3 ? b8 + 1 : 3;
#pragma unroll
            for (int u = 0; u < 8; ++u) ofn[u] = GLD(float, OF + (size_t)(rowc + nb * 8 + u) * 768 + ocol, 4u * (unsigned)lane);
#pragma unroll
            for (int u = 0; u < 2; ++u) gn[u] = GLD(v2u, mp.P + (size_t)((rowc >> 2) + nb * 2 + u) * P4G, 8u * (unsigned)(cgate + lane));
#pragma unroll
            for (int u = 0; u < 8; ++u) {
                const int tk = b8 * 8 + u;
                const float o = ost[tk * 68 + lane] + ofc[u];
                float y;
                if (MIX == 0) { const float mean = wave_sum(o) * (1.0f / 64.0f); const float d = o - mean; y = d * __builtin_amdgcn_rsqf(wave_sum(d * d) * (1.0f / 64.0f) + NEPS) * nwv; }
                else y = o * __builtin_amdgcn_rsqf(wave_sum(o * o) * (1.0f / 64.0f) + NEPS) * nwv;
                y *= silu_f(bfx(gc[u >> 2], u & 3));
                GST(unsigned short, Y + (size_t)(rowc + tk) * 1024 + ycol, 2u * (unsigned)lane) = (unsigned short)pkbf(y, y);
            }
#pragma unroll
            for (int u = 0; u < 8; ++u) ofc[u] = ofn[u];
            gc[0] = gn[0]; gc[1] = gn[1];
        }
    }
}
template <int MIX, int DIR>
__device__ __forceinline__ void mixC_stream(const MixP& mp, const MxC& c, int row0, int tpos0, int lane, LAS unsigned char* wl, f32x16 (&ST)[(MIX == 2) ? 1 : 2][2],
                                            float* OF, bf16* Y, int ocol, int ycol, int cgate, float nwv) {
    f32x16 O[2];
    MxRaw r0, r1;
    mx_load<MIX, true, DIR>(r0, mp, c, row0, 0); mx_load<MIX, true, DIR>(r1, mp, c, row0, 1);
    float rc = 1.0f, rs = 0.0f;
    if (MIX == 0 && tpos0 >= 0) { const int tpos = tpos0 + (DIR ? 63 : 0); const int pos = (lane & 32) ? (tpos & 63) : (tpos >> 6);
        const unsigned ro = 4u * (unsigned)(pos * 16 + (lane & 15)); rc = GLD(float, mp.rcos, ro); rs = GLD(float, mp.rsin, ro); }
    float P = 1.0f;
#pragma unroll 1
    for (int b = 0; b < 16; ++b) {
        MxRaw r2; mx_load<MIX, true, DIR>(r2, mp, c, row0, b < 14 ? b + 2 : 15);
        int ln = lane; asm volatile("" : "+v"(ln));
        mx_batch<MIX, true, DIR>(r0, mp, c, tpos0, ln, wl, b, P, rc, rs);
        if ((b & 7) == 7) {
            const int ch = DIR ? 1 - (b >> 3) : (b >> 3);
            mx_chunk<MIX, DIR, true>(wl, ln, P, ST, O); P = 1.0f;
            mx_epilogue<MIX, DIR ? 2 : 1>(mp, wl, ln, O, row0 + 32 * ch, OF, Y, ocol, ycol, cgate, nwv);
        }
        r0 = r1; r1 = r2;
    }
}
template <int MIX>
__device__ __forceinline__ void mixC_unit(const MixP& mp, const float* STG, int idx, int lane_in, float* OF, LAS unsigned char* wl, bf16* Y, const float* nw) {
    int lane = lane_in; asm volatile("" : "+v"(lane));
    constexpr int DK = (MIX == 2) ? 32 : 64, NRT = DK / 32;
    const int bh = idx / NSEG, sg = idx - bh * NSEG, b = bh >> 2, h = bh & 3;
    const int row0 = seg_row0(b, sg), tpos0 = seg_tpos0(sg);
    const int ocol = ((MIX == 0) ? 0 : (MIX == 1 ? 256 : 512)) + h * 64, ycol = ((MIX == 0) ? 0 : (MIX == 1 ? 512 : 768)) + h * 64;
    const int cgate = ((MIX == 0) ? C_RG : (MIX == 1 ? C_HG : C_GG)) + h * 64;
    const float* dsb = STG + (MIX == 0 ? ST_DS0 : (MIX == 1 ? ST_DS1 : ST_DS2));
    const float nwv = nw[h * 64 + lane];
    f32x16 ST[NRT][2];
#pragma unroll 1
    for (int dir = 0; dir < 2; ++dir) {
        asm volatile("" : "+v"(lane));
        const int m32 = lane & 31, hh = lane >> 5;
        MxC c; mx_consts<MIX>(c, mp, h, dir, lane);
        { const float* ds = dsb + (size_t)((dir * 16 + bh) * NSEG + sg) * (DK * 64);
#pragma unroll
          for (int rt = 0; rt < NRT; ++rt)
#pragma unroll
              for (int t = 0; t < 2; ++t)
#pragma unroll
                  for (int r4 = 0; r4 < 4; ++r4) { const f32x4 v = GLD(f32x4, ds + ((rt * 2 + t) * 4 + r4) * 256, 16u * (unsigned)lane);
                      ST[rt][t][4 * r4] = v[0]; ST[rt][t][4 * r4 + 1] = v[1]; ST[rt][t][4 * r4 + 2] = v[2]; ST[rt][t][4 * r4 + 3] = v[3]; } }
        if (dir == 0) mixC_stream<MIX, 0>(mp, c, row0, tpos0, lane, wl, ST, OF, Y, ocol, ycol, cgate, nwv);
        else mixC_stream<MIX, 1>(mp, c, row0, tpos0, lane, wl, ST, OF, Y, ocol, ycol, cgate, nwv);
        asm volatile("s_waitcnt vmcnt(0)" ::: "memory");
    }
}
template <int MSEL>
__device__ __forceinline__ void mix_passA(const Frame& F, const Args& a, int l) {
    const MixP mp = make_mixp(F, a, l); const S5P sp = make_s5p(F, a, l);
    float* ST = (float*)(F.ws + WS_X2);
    LAS unsigned char* wl = F.lds + F.wave * WL_BYTES; LAS float* stg = (LAS float*)wl;
    if (MSEL == 15) {
        constexpr int NMX = 3 * 4224, NS5 = 2 * 64 * NSEG;
        const int heavy = NMX - (NMX / F.NGW) * F.NGW, nlight = F.NGW - heavy;
        const int n_all = (NS5 - 4 * nlight) / F.NGW;
        for (int it = 0; ; ++it) {
            int u;
            const int nmine = NMX / F.NGW + (F.gw < heavy ? 1 : 0);
            if (it < nmine) u = F.gw + it * F.NGW;
            else if (it < nmine + n_all) u = NMX + F.gw + (it - nmine) * F.NGW;
            else { const int k2 = it - nmine - n_all; if (F.gw < heavy || k2 >= 4) {
                    const int rest0 = NMX + n_all * F.NGW + 4 * nlight; const int uu = rest0 + F.gw + (k2 - (F.gw < heavy ? 0 : 4)) * F.NGW; if (uu >= NMX + NS5) break; u = uu; }
                else u = NMX + n_all * F.NGW + (F.gw - heavy) + k2 * nlight; }
            if (u >= NMX + NS5) break;
            if (u < 4224) mixA_unit<0>(mp, ST, u, fresh_lane(), wl);
            else if (u < 2 * 4224) mixA_unit<1>(mp, ST, u - 4224, fresh_lane(), wl);
            else if (u < 3 * 4224) mixA_unit<2>(mp, ST, u - 2 * 4224, fresh_lane(), wl);
            else { const int idx = u - 3 * 4224; const int dir = idx / (64 * NSEG), rem = idx - dir * 64 * NSEG, bg = rem / NSEG, sg = rem - bg * NSEG;
                float hre = 0.f, him = 0.f;
                s5_mm<0>(sp, mp.P, bg >> 4, bg & 15, dir, sg, fresh_lane(), hre, him, nullptr, wl, nullptr);
                float* hs = ST + ST_HS + ((size_t)((dir * 64 + bg) * NSEG + sg) * 64 + fresh_lane()) * 2;
                hs[0] = hre; hs[1] = him; }
        }
        return;
    }
    if (MSEL & 1) for (int u = F.gw; u < 4224; u += F.NGW) mixA_unit<0>(mp, ST, u, fresh_lane(), wl);
    if (MSEL & 2) for (int u = F.gw; u < 4224; u += F.NGW) mixA_unit<1>(mp, ST, u, fresh_lane(), wl);
    if (MSEL & 4) for (int u = F.gw; u < 4224; u += F.NGW) mixA_unit<2>(mp, ST, u, fresh_lane(), wl);
    if (MSEL & 8) for (int idx = F.gw; idx < 2 * 64 * NSEG; idx += F.NGW) {
        const int dir = idx / (64 * NSEG), rem = idx - dir * 64 * NSEG, bg = rem / NSEG, sg = rem - bg * NSEG;
        float hre = 0.f, him = 0.f;
        s5_mm<0>(sp, mp.P, bg >> 4, bg & 15, dir, sg, fresh_lane(), hre, him, nullptr, wl, nullptr);
        float* hs = ST + ST_HS + ((size_t)((dir * 64 + bg) * NSEG + sg) * 64 + fresh_lane()) * 2;
        hs[0] = hre; hs[1] = him;
    }
}
__device__ __forceinline__ int chain_seg(int dir, int p) { return dir ? (p < 4 ? 3 - p : 135 - p) : p; }
__device__ __forceinline__ void mix_passB(const Frame& F, const Args& a, int l) {
    float* ST = (float*)(F.ws + WS_X2);
    constexpr int N0 = 32768, N1 = 32768, N2 = 16384, N3 = 8192;
    for (int e = blockIdx.x * 512 + F.tid; e < N0 + N1 + N2 + N3; e += F.G * 512) {
        if (e < N0 + N1 + N2) {
            float* base; const float* gb; int dir, esz;
            if (e < N0 + N1) { const int mix = e >= N0, e2 = e - mix * N0, c = e2 >> 10, el = (e2 & 1023) * 4; dir = c >> 4; esz = 4096;
                base = ST + (mix ? ST_DS1 : ST_DS0) + (size_t)c * NSEG * 4096 + el; gb = ST + (mix ? ST_G1 : ST_G0) + (size_t)c * NSEG * 64 + 32 * (el >> 11) + 8 * ((el >> 8) & 3) + 4 * ((el >> 7) & 1); }
            else { const int e2 = e - N0 - N1, c = e2 >> 9, el = (e2 & 511) * 4; dir = c >> 4; esz = 2048;
                base = ST + ST_DS2 + (size_t)c * NSEG * 2048 + el; gb = ST + ST_G2 + (size_t)c * NSEG * 64 + 8 * ((el >> 8) & 3) + 4 * ((el >> 7) & 1); }
            f32x4 run = {0.f, 0.f, 0.f, 0.f};
#pragma unroll 1
            for (int p0 = 0; p0 < NSEG; p0 += 12) {
                f32x4 d[12], gm[12];
#pragma unroll
                for (int q = 0; q < 12; ++q) { const int sg = chain_seg(dir, p0 + q); d[q] = *(const f32x4*)(base + (size_t)sg * esz); gm[q] = *(const f32x4*)(gb + sg * 64); }
#pragma unroll
                for (int q = 0; q < 12; ++q) { const int sg = chain_seg(dir, p0 + q); *(f32x4*)(base + (size_t)sg * esz) = run; run = run * gm[q] + d[q]; }
            }
        } else {
            const int e2 = e - N0 - N1 - N2, c = e2 >> 6, p = e2 & 63, dir = c >> 6, g = c & 15;
            const int dg = dir * 16 + g;
            const float lre = a.in[F.zz + I_LAMRE][(size_t)l * 2048 + dg * 64 + p], lim = a.in[F.zz + I_LAMIM][(size_t)l * 2048 + dg * 64 + p], dt = expf(a.in[F.zz + I_LOGDT][l * 32 + dg]);
            const float er = expf(lre * dt * 64.0f); const float sn = sinf(lim * dt * 64.0f), cs = cosf(lim * dt * 64.0f);
            const float ar = er * cs, ai = er * sn;
            float* base = ST + ST_HS + ((size_t)c * NSEG * 64 + p) * 2;
            float rr = 0.f, ri = 0.f;
#pragma unroll 1
            for (int q0 = 0; q0 < NSEG; q0 += 12) {
                float dr[12], di[12];
#pragma unroll
                for (int q = 0; q < 12; ++q) { const int sg = chain_seg(dir, q0 + q); dr[q] = base[(size_t)sg * 128]; di[q] = base[(size_t)sg * 128 + 1]; }
#pragma unroll
                for (int q = 0; q < 12; ++q) { const int sg = chain_seg(dir, q0 + q); base[(size_t)sg * 128] = rr; base[(size_t)sg * 128 + 1] = ri;
                    const float nr = ar * rr - ai * ri + dr[q], ni = ar * ri + ai * rr + di[q]; rr = nr; ri = ni; }
            }
        }
    }
}
template <int MSEL>
__device__ __forceinline__ void mix_passC(const Frame& F, const Args& a, int l) {
    const MixP mp = make_mixp(F, a, l); const S5P sp = make_s5p(F, a, l);
    const float* ST = (const float*)(F.ws + WS_X2);
    LAS unsigned char* wl = F.lds + F.wave * WL_BYTES;
    LAS float* stg = (LAS float*)wl; LAS float* of = (LAS float*)(wl + 9216);
    float* OF = (float*)(F.ws + WS_OF);
    bf16* Y = (bf16*)(F.ws + WS_ACT); bf16* Z = (bf16*)(F.ws + WS_Z);
    const bool keep = l < DEPTH - 1;
    constexpr int NM = 16 * NSEG;
    if (MSEL == 15) {
        constexpr int NMX = 3 * NM, NS5 = 64 * NSEG;
        const int heavy = NMX - (NMX / F.NGW) * F.NGW, nlight = F.NGW - heavy;
        for (int it = 0; ; ++it) {
            int u;
            const int nmine = NMX / F.NGW + (F.gw < heavy ? 1 : 0);
            if (it < nmine) u = F.gw + it * F.NGW;
            else { if (F.gw < heavy) break; u = NMX + (F.gw - heavy) + (it - nmine) * nlight; }
            if (u >= NMX + NS5) break;
            const int sgu = (u < 3 * NM) ? (u % NSEG) : ((u - 3 * NM) % NSEG);
            if (!keep && sgu < 4) continue;
            if (u < NM) mixC_unit<0>(mp, ST, u, fresh_lane(), OF, wl, Y, a.in[F.zz + I_RETGN] + l * 256);
            else if (u < 2 * NM) mixC_unit<1>(mp, ST, u - NM, fresh_lane(), OF, wl, Y, a.in[F.zz + I_HGNW] + l * 256);
            else if (u < 3 * NM) mixC_unit<2>(mp, ST, u - 2 * NM, fresh_lane(), OF, wl, Y, a.in[F.zz + I_GLANW] + l * 256);
            else { const int idx = u - 3 * NM, bg = idx / NSEG, sg = idx - bg * NSEG;
                const float* h0 = ST + ST_HS + ((size_t)((0 * 64 + bg) * NSEG + sg) * 64 + fresh_lane()) * 2;
                float hre = h0[0], him = h0[1];
                s5_mm<1>(sp, mp.P, bg >> 4, bg & 15, 0, sg, fresh_lane(), hre, him, of, wl, Z);
                const float* h1 = ST + ST_HS + ((size_t)((1 * 64 + bg) * NSEG + sg) * 64 + fresh_lane()) * 2;
                hre = h1[0]; him = h1[1];
                s5_mm<2>(sp, mp.P, bg >> 4, bg & 15, 1, sg, fresh_lane(), hre, him, of, wl, Z); }
        }
        return;
    }
    if (MSEL & 1) for (int u = F.gw; u < NM; u += F.NGW) { if (!keep && (u % NSEG) < 4) continue; mixC_unit<0>(mp, ST, u, fresh_lane(), OF, wl, Y, a.in[F.zz + I_RETGN] + l * 256); }
    if (MSEL & 2) for (int u = F.gw; u < NM; u += F.NGW) { if (!keep && (u % NSEG) < 4) continue; mixC_unit<1>(mp, ST, u, fresh_lane(), OF, wl, Y, a.in[F.zz + I_HGNW] + l * 256); }
    if (MSEL & 4) for (int u = F.gw; u < NM; u += F.NGW) { if (!keep && (u % NSEG) < 4) continue; mixC_unit<2>(mp, ST, u, fresh_lane(), OF, wl, Y, a.in[F.zz + I_GLANW] + l * 256); }
    if (MSEL & 8) for (int idx = F.gw; idx < 64 * NSEG; idx += F.NGW) {
        const int bg = idx / NSEG, sg = idx - bg * NSEG;
        if (!keep && sg < 4) continue;
        const float* h0 = ST + ST_HS + ((size_t)((0 * 64 + bg) * NSEG + sg) * 64 + fresh_lane()) * 2;
        float hre = h0[0], him = h0[1];
        s5_mm<1>(sp, mp.P, bg >> 4, bg & 15, 0, sg, fresh_lane(), hre, him, of, wl, Z);
        const float* h1 = ST + ST_HS + ((size_t)((1 * 64 + bg) * NSEG + sg) * 64 + fresh_lane()) * 2;
        hre = h1[0]; him = h1[1];
        s5_mm<2>(sp, mp.P, bg >> 4, bg & 15, 1, sg, fresh_lane(), hre, him, of, wl, Z);
    }
}

constexpr int NPH = 11;
template <int PH_MASK, int MSEL>
__global__ void __launch_bounds__(512, 2) mk_fwd(Args a) {
    extern __shared__ __attribute__((aligned(16))) unsigned char lds_raw[];
    Frame F;
    F.lds = (LAS unsigned char*)lds_raw;
    const int wave0 = __builtin_amdgcn_readfirstlane((int)threadIdx.x >> 6);
    F.lane = fresh_lane(); F.tid = wave0 * 64 + F.lane; F.wave = wave0;
    F.G = gridDim.x; F.gw = blockIdx.x * 8 + F.wave; F.NGW = F.G * 8; F.zz = 0; F.ws = (unsigned char*)a.in[I_WS]; F.out = (float*)a.in[I_OUT];
    volatile LAS unsigned* MISC = (volatile LAS unsigned*)(F.lds + MISC_OFF);
    for (int u = F.tid; u < 64; u += 512) ((LAS unsigned*)(F.lds + MISC_OFF))[u] = 0u;
    __syncthreads();
    XcdBarrier bar; bar.bar = (unsigned*)F.ws + CW_BAR; bar.x = 0; bar.st = nullptr;
    if (a.fused) bar = xcd_barrier_post((unsigned*)F.ws + CW_BAR, MISC + 8, F.tid);
#define SEAM() do { if (a.fused) { XcdBarrier bb = bar; asm volatile("" : "+s"(bb.bar), "+s"(bb.x)); xcd_barrier(bb, wave0 * 64 + fresh_lane()); } } while (0)
#define PHASE_BEGIN() do { int zz_ = 0; asm volatile("" : "+s"(zz_)); F.zz = zz_; F.ws = (unsigned char*)a.in[I_WS + zz_]; F.out = (float*)a.in[I_OUT + zz_]; \
        const int ln_ = fresh_lane(); const int t_ = wave0 * 64 + ln_ + zz_; F.tid = t_; F.lane = t_ & 63; F.wave = wave0 + zz_; F.G = (int)gridDim.x + zz_; F.gw = ((int)blockIdx.x + zz_) * 8 + F.wave; F.NGW = F.G * 8; \
        F.lds = (LAS unsigned char*)lds_raw + zz_; } while (0)
#define IN(k) (((PH_MASK >> (k)) & 1) && a.ph_lo <= (k) && (k) < a.ph_hi)
#ifndef DUP_PH
#define DUP_PH 0
#endif
#define REP(k) for (int rep_ = 0; rep_ < (((DUP_PH >> (k)) & 1) ? 2 : 1); ++rep_)
#define hb ((float*)(F.ws + WS_HB))
#define MOD ((const float*)(F.ws + WS_MOD))
#define ACT ((bf16*)(F.ws + WS_ACT))
#define PH ((bf16*)(F.ws + WS_PH))

    if (((PH_MASK >> 12) & 1) && a.do_pro) REP(12) { PHASE_BEGIN(); prologue(F, a); SEAM(); }

#pragma unroll
    for (int l = 0; l < DEPTH; ++l) {
        if (l < a.l_lo || l >= a.l_hi) continue;
        const bool keep = l < DEPTH - 1, moe = l & 1; const int j = l >> 1;
        const int Mrows = keep ? MT : NLAT;
        if (IN(0)) for (int rep_ = 0; rep_ < ((((DUP_PH >> 0) & 1) && l != 2) ? 2 : 1); ++rep_) { PHASE_BEGIN();
            norm_phase<0>(F, a, l, 0, MT, (l == 2) ? 1 : -1);
            SEAM();
        }
        if (IN(1)) REP(1) { PHASE_BEGIN();
            pg8::Gemm g{ACT, (const bf16*)(F.ws + WS_WIN) + (size_t)l * DINP * 1024, MT, DINP, 1024}; pg8::StaticOrder S; S.init(MT, DINP, F.G, (int)blockIdx.x);
            EpiStoreP4 E{PH};
            pg8::gemm_phase<EpiStoreP4, pg8::StaticOrder, true, true>(F.lds, g, S, E, F.tid);
            SEAM();
        }
        if (IN(2)) { PHASE_BEGIN(); mix_passA<MSEL>(F, a, l); SEAM(); }
#ifdef DUP_MIX
        if (IN(2)) { PHASE_BEGIN(); mix_passA<DUP_MIX>(F, a, l); SEAM(); }
#endif
        if (IN(3)) { PHASE_BEGIN(); mix_passB(F, a, l); SEAM(); }
        if (IN(4)) { PHASE_BEGIN(); mix_passC<MSEL>(F, a, l); SEAM(); }
#ifdef DUP_MIX
        if (IN(4)) { PHASE_BEGIN(); mix_passC<DUP_MIX>(F, a, l); SEAM(); }
#endif
        if (IN(5)) REP(5) { PHASE_BEGIN();
            int k256 = 256; asm volatile("" : "+s"(k256)); pg8::Gemm g{(const bf16*)(F.ws + WS_Z), (const bf16*)(F.ws + WS_GLUW) + (size_t)l * 65536, Mrows, 256, k256}; pg8::StaticOrder S; S.init(Mrows, 256, F.G, (int)blockIdx.x);
            EpiGlu E{(const bf16*)(F.ws + WS_Z), ACT, a.in[F.zz + I_GLUB] + l * 256};
            pg8::gemm_phase<EpiGlu, pg8::StaticOrder, true, true>(F.lds, g, S, E, F.tid);
            SEAM();
        }
        if (IN(6)) { PHASE_BEGIN();
            pg8::Gemm g{ACT, (const bf16*)(F.ws + WS_WOUT) + (size_t)l * 1024 * 1024, Mrows, 1024, 1024}; pg8::StaticOrder S; S.init(Mrows, 1024, F.G, (int)blockIdx.x);
            EpiResid E{(l == 0) ? a.in[F.zz + I_X] : F.out, (l == 0) ? a.in[F.zz + I_CTX] : hb, F.out, hb, MOD + (size_t)l * 5 * 6144 + 2 * 1024, 1.0f};
            pg8::gemm_phase<EpiResid, pg8::StaticOrder, true, true>(F.lds, g, S, E, F.tid);
            SEAM();
        }
        if (IN(7)) for (int rep_ = 0; rep_ < ((((DUP_PH >> 7) & 1) && !moe) ? 2 : 1); ++rep_) { PHASE_BEGIN();
            if (moe) norm_phase<1>(F, a, l, 1, Mrows, -1); else norm_phase<0>(F, a, l, 1, Mrows, -1);
            SEAM();
        }
        if (!moe) {
            if (IN(8)) REP(8) { PHASE_BEGIN();
                pg8::Gemm g{ACT, (const bf16*)(F.ws + WS_W13D) + (size_t)j * 5632 * 1024, Mrows, 5632, 1024}; pg8::StaticOrder S; S.init(Mrows, 5632, F.G, (int)blockIdx.x);
                EpiSwiglu8 E{(unsigned char*)PH, 1.0f};
                pg8::gemm_phase<EpiSwiglu8, pg8::StaticOrder, true, true>(F.lds, g, S, E, F.tid);
                SEAM();
            }
            if (IN(9)) { PHASE_BEGIN();
                int k8 = DFF / 2; asm volatile("" : "+s"(k8)); pg8::Gemm g{PH, (const bf16*)(F.ws + WS_W2D + (size_t)j * 1024 * DFF), Mrows, 1024, k8}; pg8::StaticOrder S; S.init(Mrows, 1024, F.G, (int)blockIdx.x);
                EpiResid E{F.out, hb, F.out, hb, MOD + (size_t)l * 5 * 6144 + 5 * 1024, 1.0f / WSC8};
                pg8::gemm_phase_f8<EpiResid, pg8::StaticOrder, true, true>(F.lds, g, S, E, F.tid);
                { const int rem = ((Mrows / 256) * 4) % F.G; if (rem > 0 && (int)blockIdx.x >= rem) moe_cvt_idle(F, a, j, rem); else if (rem == 0) moe_cvt(F, a, j); }
                SEAM();
            }
        } else {
                        if (IN(8)) REP(8) { PHASE_BEGIN(); moe_gather(F, j); SEAM(); }
            if (IN(9)) REP(9) { PHASE_BEGIN();
                int k8 = 512; asm volatile("" : "+s"(k8)); pg8::Gemm g{(const bf16*)(F.ws + WS_X2), (const bf16*)(F.ws + WS_W13M), 0, 5632, k8}; MoeOrder S; S.init((const unsigned*)F.ws + CW_CNT + j * 8 * 64, 22, F.G, (int)blockIdx.x);
                EpiSwiglu8 E{(unsigned char*)PH, 1.0f / WSC8};
                pg8::gemm_phase_f8<EpiSwiglu8, MoeOrder, true, true>(F.lds, g, S, E, F.tid);
                SEAM();
            }
            if (IN(10)) REP(10) { PHASE_BEGIN();
                int k8 = DFF / 2; asm volatile("" : "+s"(k8)); pg8::Gemm g{PH, (const bf16*)(F.ws + WS_W2M), 0, 1024, k8}; MoeOrder S; S.init((const unsigned*)F.ws + CW_CNT + j * 8 * 64, 4, F.G, (int)blockIdx.x);
                EpiStoreBf16 E{(bf16*)(F.ws + WS_X2), 1024, 1.0f / WSC8};
                pg8::gemm_phase_f8<EpiStoreBf16, MoeOrder, true, true>(F.lds, g, S, E, F.tid);
                SEAM();
            }
        }
    }
    if (((PH_MASK >> 13) & 1) && a.do_fin) { PHASE_BEGIN(); norm_phase<2>(F, a, DEPTH - 1, 0, NLAT, DEPTH - 1); }
#undef SEAM
#undef IN
#undef hb
#undef MOD
#undef ACT
#undef PH
}

#ifndef MK_FUSED
#define MK_FUSED 1
#endif
template <int PM, int MS> static void launch_one(const Args& a, int grid, hipStream_t stream) {
    static bool attr_done = false;
    if (!attr_done) { (void)hipFuncSetAttribute((const void*)mk_fwd<PM, MS>, hipFuncAttributeMaxDynamicSharedMemorySize, LDS_BYTES); attr_done = true; }
    hipLaunchKernelGGL((mk_fwd<PM, MS>), dim3(grid), dim3(512), LDS_BYTES, stream, a);
}
extern "C" void kernel_launch(void* const* d_in, const int* in_sizes, int n_in, void* d_out, int out_size, void* d_ws, size_t ws_size, hipStream_t stream) {
    static int grid = 0;
    if (grid == 0) {
        if (n_in != 35 || in_sizes[0] != NLAT * DM || out_size != NLAT * DM || ws_size < WS_END) {
            fprintf(stderr, "kernel_launch: unexpected shapes / workspace (n_in %d, ws %zu, need %zu); nothing launched\n", n_in, ws_size, (size_t)WS_END); grid = -1; return; }
        int dev = 0, cus = 0;
        if (hipGetDevice(&dev) != hipSuccess || hipDeviceGetAttribute(&cus, hipDeviceAttributeMultiprocessorCount, dev) != hipSuccess) { grid = -1; return; }
        grid = cus;
    }
    if (grid < 0) return;
    (void)hipMemsetAsync((char*)d_ws + WS_CTL, 0, CTL_ZERO_BYTES, stream);
    Args a{};
    for (int i = 0; i < 35; ++i) a.in[i] = (const float*)d_in[i];
    a.in[I_OUT] = (const float*)d_out; a.in[I_WS] = (const float*)d_ws; a.pad = 0;
#if MK_FUSED
    a.l_lo = 0; a.l_hi = DEPTH; a.ph_lo = 0; a.ph_hi = NPH; a.do_pro = 1; a.do_fin = 1; a.fused = 1;
#ifndef TEST_PM
#define TEST_PM 0xFFFF
#endif
#ifndef TEST_MS
#define TEST_MS 15
#endif
    launch_one<TEST_PM, TEST_MS>(a, grid, stream);
#else
    a.fused = 0;
    a.l_lo = 0; a.l_hi = 0; a.ph_lo = 0; a.ph_hi = 0; a.do_pro = 1; a.do_fin = 0;
    launch_one<0x1000, 15>(a, grid, stream);
    a.do_pro = 0;
    for (int l = 0; l < DEPTH; ++l) {
        a.l_lo = l; a.l_hi = l + 1; a.ph_lo = 0; a.ph_hi = NPH;
        launch_one<0x1, 15>(a, grid, stream); launch_one<0x2, 15>(a, grid, stream); launch_one<0x4, 15>(a, grid, stream); launch_one<0x8, 15>(a, grid, stream);
        launch_one<0x10, 1>(a, grid, stream); launch_one<0x10, 2>(a, grid, stream); launch_one<0x10, 4>(a, grid, stream); launch_one<0x10, 8>(a, grid, stream);
        launch_one<0x20, 15>(a, grid, stream); launch_one<0x40, 15>(a, grid, stream); launch_one<0x80, 15>(a, grid, stream);
        launch_one<0x100, 15>(a, grid, stream); launch_one<0x200, 15>(a, grid, stream);
        if (l & 1) launch_one<0x400, 15>(a, grid, stream);
    }
    a.l_lo = 0; a.l_hi = 0; a.ph_lo = 0; a.ph_hi = 0; a.do_fin = 1;
    launch_one<0x2000, 15>(a, grid, stream);
#endif
}
```

```cpp
#include <hip/hip_runtime.h>
#include <cstdio>
#include <cstdint>
#define LAS __attribute__((address_space(3)))
namespace pg8 {
#define PG8_LAS __attribute__((address_space(3)))
typedef unsigned short bf16_t;
typedef short bf16x8 __attribute__((ext_vector_type(8)));
typedef float f32x4 __attribute__((ext_vector_type(4)));
typedef unsigned u32x4 __attribute__((ext_vector_type(4)));
constexpr int BM = 256, BK = 64, HALF = 128, HTB = HALF * BK * 2  , STAGE_BYTES = 8 * HTB, NXCD = 8, WGM = 8;

__host__ __device__ __forceinline__ int lds_byte(int r, int c) { const int st = (r >> 4) * 2 + (c >> 5), rr = r & 15, cc = c & 31, ob = rr * 64 + cc * 2; return st * 1024 + (ob ^ (((ob >> 9) & 1) << 5)); }
__host__ __device__ __forceinline__ void stage_rc(int b, int& R, int& C) { const int st = b / 1024, sb = b % 1024, swz = sb ^ (((sb >> 9) & 1) << 5); R = (st >> 1) * 16 + swz / 64; C = (st & 1) * 32 + (swz % 64) / 2; }
__host__ __device__ __forceinline__ int perm32(int rho) { const int n = rho >> 4, i = rho & 15; return 8 * (i >> 2) + 4 * n + (i & 3); }

__host__ __device__ __forceinline__ int perm32f(int rho) { return 2 * (rho & 15) + (rho >> 4); }
template <class E, class = void> struct epi_flip { static constexpr bool v = false; };
template <class E> struct epi_flip<E, decltype((void)E::FLIP)> { static constexpr bool v = E::FLIP; };
struct Unit { int pm, pn, pc; };
struct Gemm { const bf16_t* A; const bf16_t* Bt; int M, N, K; };

struct StaticOrder {
    int nM, nN, nwg, G, c;
    __host__ __device__ void init(int M, int N, int G_, int c_) { nM = M / BM; nN = N / BM; nwg = nM * nN; G = G_; c = c_; }
    __host__ __device__ bool next(int i, Unit& u) const {
        const long L = (long)i * G + c; if (L >= nwg) return false;
        int wgid = (int)L; { const int q = nwg / NXCD, r = nwg % NXCD, xcd = wgid % NXCD, off = wgid / NXCD; wgid = (xcd < r ? xcd * (q + 1) : r * (q + 1) + (xcd - r) * q) + off; }
        const int nig = WGM * nN, gid = wgid / nig, fm = gid * WGM, gsz = (nM - fm) < WGM ? (nM - fm) : WGM;
        u.pm = fm + ((wgid % nig) % gsz); u.pn = (wgid % nig) / gsz; u.pc = u.pn; return true;
    }
    __device__ __forceinline__ void a_ready(const Unit&) const {}
    __device__ __forceinline__ void done(const Unit&) const {}
};

__device__ __forceinline__ unsigned cvt_pk_bf16(float lo, float hi) { unsigned r; asm volatile("v_cvt_pk_bf16_f32 %0, %1, %2" : "=v"(r) : "v"(lo), "v"(hi)); return r; }
typedef float f32x2 __attribute__((ext_vector_type(2)));

template <class Epi, class Sched, bool ALIGN_EPI = false, bool SP2 = false>
__device__ __forceinline__ void gemm_phase(PG8_LAS unsigned char* lds, const Gemm g, const Sched& S, const Epi& E, const int tid) {
    const int wid = __builtin_amdgcn_readfirstlane(tid >> 6), lane = tid & 63, wr = wid >> 2, wc = wid & 3, fr = lane & 15, fq = lane >> 4;
    const int K = g.K, nt = K / BK;
    unsigned voffA[2], voffB[2];
#pragma unroll
    for (int i = 0; i < 2; ++i) { int R, C; stage_rc(tid * 16 + i * 8192, R, C); const int Rb = epi_flip<Epi>::v ? ((R & ~31) + perm32f(R & 31)) : (Epi::PERM ? ((R & ~31) + perm32(R & 31)) : R);
        voffA[i] = (unsigned)(R * K + C) * 2u; voffB[i] = (unsigned)(Rb * K + C) * 2u; }
    const size_t kstep = (size_t)(BK * 2);
    const size_t hstep = (size_t)HALF * K * 2;
    const size_t tstep = 2 * hstep;
    const unsigned ldsw = (unsigned)wid * 1024u;
    const int aoff = lds_byte(wr * 64 + fr, fq * 8), boff = lds_byte(wc * 32 + fr, fq * 8);
#define PG8_SA(b, h) (((b) * 2 + (h)) * HTB)
#define PG8_SB(b, h) ((4 + (b) * 2 + (h)) * HTB)
#define PG8_STAGE(bufoff, gbase, voff) do { _Pragma("unroll") for (int _i = 0; _i < 2; ++_i) \
        __builtin_amdgcn_global_load_lds((const unsigned*)((const char*)(gbase) + (voff)[_i]), (PG8_LAS unsigned*)(lds + (bufoff) + ldsw + _i * 8192), 16, 0, 0); } while (0)
#define PG8_LDA(dst, b, h) do { _Pragma("unroll") for (int m = 0; m < 4; ++m) _Pragma("unroll") for (int k = 0; k < 2; ++k) dst[m][k] = *(const PG8_LAS bf16x8*)(lds + PG8_SA(b, h) + aoff + m * 2048 + k * 1024); } while (0)
#define PG8_LDB(dst, b, h) do { _Pragma("unroll") for (int n = 0; n < 2; ++n) _Pragma("unroll") for (int k = 0; k < 2; ++k) dst[n][k] = *(const PG8_LAS bf16x8*)(lds + PG8_SB(b, h) + boff + n * 2048 + k * 1024); } while (0)
#define PG8_MMA(ai, bj, At, Bt) do { __builtin_amdgcn_s_setprio(1); _Pragma("unroll") for (int m = 0; m < 4; ++m) _Pragma("unroll") for (int n = 0; n < 2; ++n) _Pragma("unroll") for (int k = 0; k < 2; ++k) \
        { if constexpr (epi_flip<Epi>::v) acc[ai][bj][m][n] = __builtin_amdgcn_mfma_f32_16x16x32_bf16(At[m][k], Bt[n][k], acc[ai][bj][m][n], 0, 0, 0); \
          else acc[ai][bj][m][n] = __builtin_amdgcn_mfma_f32_16x16x32_bf16(Bt[n][k], At[m][k], acc[ai][bj][m][n], 0, 0, 0); } __builtin_amdgcn_s_setprio(0); } while (0)
#define PG8_WAIT_V(n) asm volatile("s_waitcnt vmcnt(" #n ")" ::: "memory")
#define PG8_WAIT_L(n) asm volatile("s_waitcnt lgkmcnt(" #n ")" ::: "memory")
#define PG8_BAR __builtin_amdgcn_s_barrier()
#define PG8_SCHED __builtin_amdgcn_sched_barrier(0)
    Unit cur, nxt; int ui = 0;
    if (!S.next(0, cur)) return;
    f32x4 acc[2][2][4][2];
#pragma unroll
    for (int a = 0; a < 2; ++a)
#pragma unroll
        for (int b = 0; b < 2; ++b)
#pragma unroll
            for (int m = 0; m < 4; ++m)
#pragma unroll
                for (int n = 0; n < 2; ++n) acc[a][b][m][n] = (f32x4){0.f, 0.f, 0.f, 0.f};
    bf16x8 At[4][2], B0[2][2], B1[2][2];
    const char* cA = (const char*)g.A + (size_t)cur.pm * tstep; const char* cB = (const char*)g.Bt + (size_t)cur.pn * tstep;
    S.a_ready(cur);
    if constexpr (SP2) {
        PG8_STAGE(PG8_SB(0, 0), cB, voffB); PG8_STAGE(PG8_SB(0, 1), cB + hstep, voffB); PG8_STAGE(PG8_SA(0, 0), cA, voffA); PG8_STAGE(PG8_SA(0, 1), cA + hstep, voffA);
        if (wr == 1) PG8_BAR;
        PG8_WAIT_V(2); PG8_BAR;
        PG8_STAGE(PG8_SB(1, 0), cB + kstep, voffB); PG8_STAGE(PG8_SA(1, 0), cA + kstep, voffA); PG8_STAGE(PG8_SB(1, 1), cB + hstep + kstep, voffB);
        PG8_WAIT_V(6); PG8_BAR;
    } else {
        PG8_STAGE(PG8_SB(0, 0), cB, voffB); PG8_STAGE(PG8_SA(0, 0), cA, voffA); PG8_STAGE(PG8_SB(0, 1), cB + hstep, voffB); PG8_STAGE(PG8_SA(0, 1), cA + hstep, voffA);
        if (wr == 1) PG8_BAR;
        PG8_WAIT_V(4); PG8_BAR;
        PG8_STAGE(PG8_SB(1, 0), cB + kstep, voffB); PG8_STAGE(PG8_SA(1, 0), cA + kstep, voffA); PG8_STAGE(PG8_SB(1, 1), cB + hstep + kstep, voffB);
        PG8_WAIT_V(6); PG8_BAR;
    }
    for (;;) {
        const bool has_next = S.next(ui + 1, nxt);
        const char* nA = has_next ? (const char*)g.A + (size_t)nxt.pm * tstep : cA; const char* nB = has_next ? (const char*)g.Bt + (size_t)nxt.pn * tstep : cB;
        for (int t = 0; t < nt; t += 2) {
            const bool last = (t == nt - 2);
            const char* a1 = cA + (size_t)(t + 1) * kstep;
            const char* a2 = last ? nA : cA + (size_t)(t + 2) * kstep; const char* b2 = last ? nB : cB + (size_t)(t + 2) * kstep;
            const char* a3 = a2 + kstep; const char* b3 = b2 + kstep;
            if (last && has_next) S.a_ready(nxt);
            if constexpr (SP2) {
            PG8_LDB(B0, 0, 0); PG8_LDB(B1, 0, 1); PG8_SCHED; PG8_LDA(At, 0, 0); PG8_STAGE(PG8_SA(1, 1), a1 + hstep, voffA);
            PG8_WAIT_V(8); PG8_WAIT_L(0); PG8_BAR; PG8_MMA(0, 0, At, B0); PG8_MMA(0, 1, At, B1); PG8_BAR; PG8_SCHED;
            PG8_LDA(At, 0, 1); PG8_STAGE(PG8_SB(0, 0), b2, voffB); PG8_STAGE(PG8_SB(0, 1), b2 + hstep, voffB); PG8_STAGE(PG8_SA(0, 0), a2, voffA);
            PG8_WAIT_V(8); PG8_WAIT_L(0); PG8_BAR; PG8_MMA(1, 0, At, B0); PG8_MMA(1, 1, At, B1); PG8_BAR; PG8_SCHED;
            PG8_LDB(B0, 1, 0); PG8_LDB(B1, 1, 1); PG8_SCHED; PG8_LDA(At, 1, 0); PG8_STAGE(PG8_SA(0, 1), a2 + hstep, voffA);
            PG8_WAIT_V(8); PG8_WAIT_L(0); PG8_BAR; PG8_MMA(0, 0, At, B0); PG8_MMA(0, 1, At, B1); PG8_BAR; PG8_SCHED;
            PG8_LDA(At, 1, 1); PG8_STAGE(PG8_SB(1, 0), b3, voffB); PG8_STAGE(PG8_SB(1, 1), b3 + hstep, voffB); PG8_STAGE(PG8_SA(1, 0), a3, voffA);
            PG8_WAIT_V(8); PG8_WAIT_L(0); PG8_BAR; PG8_MMA(1, 0, At, B0); PG8_MMA(1, 1, At, B1); PG8_BAR; PG8_SCHED;
            } else {
            PG8_LDB(B0, 0, 0); PG8_SCHED; PG8_LDA(At, 0, 0); PG8_STAGE(PG8_SA(1, 1), a1 + hstep, voffA);
            PG8_WAIT_L(8); PG8_BAR; PG8_WAIT_L(0); PG8_MMA(0, 0, At, B0); PG8_BAR; PG8_SCHED;
            PG8_LDB(B1, 0, 1); PG8_STAGE(PG8_SB(0, 0), b2, voffB);
            PG8_BAR; PG8_WAIT_L(0); PG8_MMA(0, 1, At, B1); PG8_BAR;
            PG8_LDA(At, 0, 1); PG8_STAGE(PG8_SA(0, 0), a2, voffA);
            PG8_BAR; PG8_WAIT_L(0); PG8_MMA(1, 0, At, B0); PG8_BAR; PG8_SCHED;
            PG8_STAGE(PG8_SB(0, 1), b2 + hstep, voffB);
            PG8_WAIT_V(6); PG8_BAR; PG8_MMA(1, 1, At, B1); PG8_BAR;
            PG8_LDB(B0, 1, 0); PG8_SCHED; PG8_LDA(At, 1, 0); PG8_STAGE(PG8_SA(0, 1), a2 + hstep, voffA);
            PG8_WAIT_L(8); PG8_BAR; PG8_WAIT_L(0); PG8_MMA(0, 0, At, B0); PG8_BAR; PG8_SCHED;
            PG8_LDB(B1, 1, 1); PG8_STAGE(PG8_SB(1, 0), b3, voffB);
            PG8_BAR; PG8_WAIT_L(0); PG8_MMA(0, 1, At, B1); PG8_BAR;
            PG8_LDA(At, 1, 1); PG8_STAGE(PG8_SA(1, 0), a3, voffA);
            PG8_BAR; PG8_WAIT_L(0); PG8_MMA(1, 0, At, B0); PG8_BAR; PG8_SCHED;
            PG8_STAGE(PG8_SB(1, 1), b3 + hstep, voffB);
            PG8_WAIT_V(6); PG8_BAR; PG8_MMA(1, 1, At, B1); PG8_BAR;
            }
        }
        if constexpr (ALIGN_EPI) { if (wr == 0) PG8_BAR; }
        if constexpr (!Epi::AFTER_DRAIN) { E(acc, cur, wr, wc, fr, fq); S.done(cur); }
        if (!has_next) break;
#pragma unroll
        for (int a = 0; a < 2; ++a)
#pragma unroll
            for (int b = 0; b < 2; ++b)
#pragma unroll
                for (int m = 0; m < 4; ++m)
#pragma unroll
                    for (int n = 0; n < 2; ++n) acc[a][b][m][n] = (f32x4){0.f, 0.f, 0.f, 0.f};
        cur = nxt; cA = nA; cB = nB; ++ui;
        if constexpr (ALIGN_EPI) { if (wr == 1) PG8_BAR; }
    }
    PG8_WAIT_V(0);
    if constexpr (!ALIGN_EPI) { if (wr == 0) PG8_BAR; }
    PG8_BAR;
    if constexpr (Epi::AFTER_DRAIN) { E.fused(acc, cur, wr, wc, fr, fq, lds, wid, lane); S.done(cur); }
#undef PG8_SA
#undef PG8_SB
#undef PG8_STAGE
#undef PG8_LDA
#undef PG8_LDB
#undef PG8_MMA
#undef PG8_WAIT_V
#undef PG8_WAIT_L
#undef PG8_BAR
#undef PG8_SCHED
}
typedef int v8i_t __attribute__((ext_vector_type(8)));
typedef int v4i_t __attribute__((ext_vector_type(4)));
template <class Epi, class Sched, bool ALIGN_EPI = false, bool SP2 = false>
__device__ __forceinline__ void gemm_phase_f8(PG8_LAS unsigned char* lds, const Gemm g, const Sched& S, const Epi& E, const int tid) {
    const int wid = __builtin_amdgcn_readfirstlane(tid >> 6), lane = tid & 63, wr = wid >> 2, wc = wid & 3, fr = lane & 15, fq = lane >> 4;
    const int K = g.K, nt = K / BK;
    unsigned voffA[2], voffB[2];
#pragma unroll
    for (int i = 0; i < 2; ++i) { int R, C; stage_rc(tid * 16 + i * 8192, R, C); const int Rb = Epi::PERM ? ((R & ~31) + perm32(R & 31)) : R;
        voffA[i] = (unsigned)(R * K + C) * 2u; voffB[i] = (unsigned)(Rb * K + C) * 2u; }
    const size_t kstep = (size_t)(BK * 2);
    const size_t hstep = (size_t)HALF * K * 2;
    const size_t tstep = 2 * hstep;
    const unsigned ldsw = (unsigned)wid * 1024u;
    const int aoff0 = lds_byte(wr * 64 + fr, fq * 16), aoff1 = lds_byte(wr * 64 + fr, fq * 16 + 8), boff0 = lds_byte(wc * 32 + fr, fq * 16), boff1 = lds_byte(wc * 32 + fr, fq * 16 + 8);
#define PG8_SA(b, h) (((b) * 2 + (h)) * HTB)
#define PG8_SB(b, h) ((4 + (b) * 2 + (h)) * HTB)
#define PG8_STAGE(bufoff, gbase, voff) do { _Pragma("unroll") for (int _i = 0; _i < 2; ++_i) \
        __builtin_amdgcn_global_load_lds((const unsigned*)((const char*)(gbase) + (voff)[_i]), (PG8_LAS unsigned*)(lds + (bufoff) + ldsw + _i * 8192), 16, 0, 0); } while (0)
#define PG8_LDA(dst, b, h) do { _Pragma("unroll") for (int m = 0; m < 4; ++m) { const u32x4 lo_ = *(const PG8_LAS u32x4*)(lds + PG8_SA(b, h) + aoff0 + m * 2048), hi_ = *(const PG8_LAS u32x4*)(lds + PG8_SA(b, h) + aoff1 + m * 2048); \
        dst[m] = __builtin_shufflevector((v4i_t)lo_, (v4i_t)hi_, 0, 1, 2, 3, 4, 5, 6, 7); } } while (0)
#define PG8_LDB(dst, b, h) do { _Pragma("unroll") for (int n = 0; n < 2; ++n) { const u32x4 lo_ = *(const PG8_LAS u32x4*)(lds + PG8_SB(b, h) + boff0 + n * 2048), hi_ = *(const PG8_LAS u32x4*)(lds + PG8_SB(b, h) + boff1 + n * 2048); \
        dst[n] = __builtin_shufflevector((v4i_t)lo_, (v4i_t)hi_, 0, 1, 2, 3, 4, 5, 6, 7); } } while (0)
#define PG8_MMA(ai, bj, At, Bt) do { __builtin_amdgcn_s_setprio(1); _Pragma("unroll") for (int m = 0; m < 4; ++m) _Pragma("unroll") for (int n = 0; n < 2; ++n) \
        asm volatile("v_mfma_scale_f32_16x16x128_f8f6f4 %0, %1, %2, %0, %3, %3 op_sel_hi:[0,0,0]" : "+v"(acc[ai][bj][m][n]) : "v"(Bt[n]), "v"(At[m]), "v"(one_scale)); __builtin_amdgcn_s_setprio(0); } while (0)
#define PG8_WAIT_V(n) asm volatile("s_waitcnt vmcnt(" #n ")" ::: "memory")
#define PG8_WAIT_L(n) asm volatile("s_waitcnt lgkmcnt(" #n ")" ::: "memory")
#define PG8_BAR __builtin_amdgcn_s_barrier()
#define PG8_SCHED __builtin_amdgcn_sched_barrier(0)
    Unit cur, nxt; int ui = 0;
    if (!S.next(0, cur)) return;
    f32x4 acc[2][2][4][2];
#pragma unroll
    for (int a = 0; a < 2; ++a)
#pragma unroll
        for (int b = 0; b < 2; ++b)
#pragma unroll
            for (int m = 0; m < 4; ++m)
#pragma unroll
                for (int n = 0; n < 2; ++n) acc[a][b][m][n] = (f32x4){0.f, 0.f, 0.f, 0.f};
    v8i_t At[4], B0[2], B1[2]; const int one_scale = 0x7f7f7f7f;
    const char* cA = (const char*)g.A + (size_t)cur.pm * tstep; const char* cB = (const char*)g.Bt + (size_t)cur.pn * tstep;
    S.a_ready(cur);
    if constexpr (SP2) {
        PG8_STAGE(PG8_SB(0, 0), cB, voffB); PG8_STAGE(PG8_SB(0, 1), cB + hstep, voffB); PG8_STAGE(PG8_SA(0, 0), cA, voffA); PG8_STAGE(PG8_SA(0, 1), cA + hstep, voffA);
        if (wr == 1) PG8_BAR;
        PG8_WAIT_V(2); PG8_BAR;
        PG8_STAGE(PG8_SB(1, 0), cB + kstep, voffB); PG8_STAGE(PG8_SA(1, 0), cA + kstep, voffA); PG8_STAGE(PG8_SB(1, 1), cB + hstep + kstep, voffB);
        PG8_WAIT_V(6); PG8_BAR;
    } else {
        PG8_STAGE(PG8_SB(0, 0), cB, voffB); PG8_STAGE(PG8_SA(0, 0), cA, voffA); PG8_STAGE(PG8_SB(0, 1), cB + hstep, voffB); PG8_STAGE(PG8_SA(0, 1), cA + hstep, voffA);
        if (wr == 1) PG8_BAR;
        PG8_WAIT_V(4); PG8_BAR;
        PG8_STAGE(PG8_SB(1, 0), cB + kstep, voffB); PG8_STAGE(PG8_SA(1, 0), cA + kstep, voffA); PG8_STAGE(PG8_SB(1, 1), cB + hstep + kstep, voffB);
        PG8_WAIT_V(6); PG8_BAR;
    }
    for (;;) {
        const bool has_next = S.next(ui + 1, nxt);
        const char* nA = has_next ? (const char*)g.A + (size_t)nxt.pm * tstep : cA; const char* nB = has_next ? (const char*)g.Bt + (size_t)nxt.pn * tstep : cB;
        for (int t = 0; t < nt; t += 2) {
            const bool last = (t == nt - 2);
            const char* a1 = cA + (size_t)(t + 1) * kstep;
            const char* a2 = last ? nA : cA + (size_t)(t + 2) * kstep; const char* b2 = last ? nB : cB + (size_t)(t + 2) * kstep;
            const char* a3 = a2 + kstep; const char* b3 = b2 + kstep;
            if (last && has_next) S.a_ready(nxt);
            if constexpr (SP2) {
            PG8_LDB(B0, 0, 0); PG8_LDB(B1, 0, 1); PG8_SCHED; PG8_LDA(At, 0, 0); PG8_STAGE(PG8_SA(1, 1), a1 + hstep, voffA);
            PG8_WAIT_V(8); PG8_WAIT_L(0); PG8_BAR; PG8_MMA(0, 0, At, B0); PG8_MMA(0, 1, At, B1); PG8_BAR; PG8_SCHED;
            PG8_LDA(At, 0, 1); PG8_STAGE(PG8_SB(0, 0), b2, voffB); PG8_STAGE(PG8_SB(0, 1), b2 + hstep, voffB); PG8_STAGE(PG8_SA(0, 0), a2, voffA);
            PG8_WAIT_V(8); PG8_WAIT_L(0); PG8_BAR; PG8_MMA(1, 0, At, B0); PG8_MMA(1, 1, At, B1); PG8_BAR; PG8_SCHED;
            PG8_LDB(B0, 1, 0); PG8_LDB(B1, 1, 1); PG8_SCHED; PG8_LDA(At, 1, 0); PG8_STAGE(PG8_SA(0, 1), a2 + hstep, voffA);
            PG8_WAIT_V(8); PG8_WAIT_L(0); PG8_BAR; PG8_MMA(0, 0, At, B0); PG8_MMA(0, 1, At, B1); PG8_BAR; PG8_SCHED;
            PG8_LDA(At, 1, 1); PG8_STAGE(PG8_SB(1, 0), b3, voffB); PG8_STAGE(PG8_SB(1, 1), b3 + hstep, voffB); PG8_STAGE(PG8_SA(1, 0), a3, voffA);
            PG8_WAIT_V(8); PG8_WAIT_L(0); PG8_BAR; PG8_MMA(1, 0, At, B0); PG8_MMA(1, 1, At, B1); PG8_BAR; PG8_SCHED;
            } else {
            PG8_LDB(B0, 0, 0); PG8_SCHED; PG8_LDA(At, 0, 0); PG8_STAGE(PG8_SA(1, 1), a1 + hstep, voffA);
            PG8_WAIT_L(8); PG8_BAR; PG8_WAIT_L(0); PG8_MMA(0, 0, At, B0); PG8_BAR; PG8_SCHED;
            PG8_LDB(B1, 0, 1); PG8_STAGE(PG8_SB(0, 0), b2, voffB);
            PG8_BAR; PG8_WAIT_L(0); PG8_MMA(0, 1, At, B1); PG8_BAR;
            PG8_LDA(At, 0, 1); PG8_STAGE(PG8_SA(0, 0), a2, voffA);
            PG8_BAR; PG8_WAIT_L(0); PG8_MMA(1, 0, At, B0); PG8_BAR; PG8_SCHED;
            PG8_STAGE(PG8_SB(0, 1), b2 + hstep, voffB);
            PG8_WAIT_V(6); PG8_BAR; PG8_MMA(1, 1, At, B1); PG8_BAR;
            PG8_LDB(B0, 1, 0); PG8_SCHED; PG8_LDA(At, 1, 0); PG8_STAGE(PG8_SA(0, 1), a2 + hstep, voffA);
            PG8_WAIT_L(8); PG8_BAR; PG8_WAIT_L(0); PG8_MMA(0, 0, At, B0); PG8_BAR; PG8_SCHED;
            PG8_LDB(B1, 1, 1); PG8_STAGE(PG8_SB(1, 0), b3, voffB);
            PG8_BAR; PG8_WAIT_L(0); PG8_MMA(0, 1, At, B1); PG8_BAR;
            PG8_LDA(At, 1, 1); PG8_STAGE(PG8_SA(1, 0), a3, voffA);
            PG8_BAR; PG8_WAIT_L(0); PG8_MMA(1, 0, At, B0); PG8_BAR; PG8_SCHED;
            PG8_STAGE(PG8_SB(1, 1), b3 + hstep, voffB);
            PG8_WAIT_V(6); PG8_BAR; PG8_MMA(1, 1, At, B1); PG8_BAR;
            }
        }
        if constexpr (ALIGN_EPI) { if (wr == 0) PG8_BAR; }
        asm volatile("s_nop 15\n\ts_nop 15" ::: "memory");
        if constexpr (!Epi::AFTER_DRAIN) { E(acc, cur, wr, wc, fr, fq); S.done(cur); }
        if (!has_next) break;
#pragma unroll
        for (int a = 0; a < 2; ++a)
#pragma unroll
            for (int b = 0; b < 2; ++b)
#pragma unroll
                for (int m = 0; m < 4; ++m)
#pragma unroll
                    for (int n = 0; n < 2; ++n) acc[a][b][m][n] = (f32x4){0.f, 0.f, 0.f, 0.f};
        cur = nxt; cA = nA; cB = nB; ++ui;
        if constexpr (ALIGN_EPI) { if (wr == 1) PG8_BAR; }
    }
    PG8_WAIT_V(0);
    if constexpr (!ALIGN_EPI) { if (wr == 0) PG8_BAR; }
    PG8_BAR;
    if constexpr (Epi::AFTER_DRAIN) { E.fused(acc, cur, wr, wc, fr, fq, lds, wid, lane); S.done(cur); }
#undef PG8_SA
#undef PG8_SB
#undef PG8_STAGE
#undef PG8_LDA
#undef PG8_LDB
#undef PG8_MMA
#undef PG8_WAIT_V
#undef PG8_WAIT_L
#undef PG8_BAR
#undef PG8_SCHED
}
}

#define XB_TMO      128
#define XB_XCNT(j)  (256  + 64 * (j))
#define XB_XSUB(j)  (1280 + 64 * (j))
#define XB_XGEN(j)  (2304 + 64 * (j))
#define XB_TOP      3328
#define XB_TOPGEN   3392
#define XCD_BAR_WORDS 3456
#define XB_SPIN_CAP (1u << 18)

__device__ __forceinline__ unsigned xb_ld(unsigned* p)              { return __hip_atomic_load(p, __ATOMIC_RELAXED, __HIP_MEMORY_SCOPE_AGENT); }
__device__ __forceinline__ unsigned xb_add(unsigned* p, unsigned v) { return __hip_atomic_fetch_add(p, v, __ATOMIC_RELAXED, __HIP_MEMORY_SCOPE_AGENT); }
__device__ __forceinline__ unsigned xb_xcc_id() { return (unsigned)__builtin_amdgcn_s_getreg((3 << 11) | 20) & 0xFu; }
#define XB_SPIN(cond, bar) do { unsigned _sp = 0; while (cond) { __builtin_amdgcn_s_sleep(1); \
    if ((++_sp & 255u) == 0u) { if (xb_ld(&(bar)[XB_TMO])) break; if (_sp > XB_SPIN_CAP) { atomicAdd(&(bar)[XB_TMO], 1u); break; } } } } while (0)

struct XcdBarrier {
    unsigned* bar; unsigned x;
    volatile LAS unsigned* st;
};

__device__ __forceinline__ XcdBarrier xcd_barrier_post(unsigned* bar, volatile LAS unsigned* st, const int xb_tid) {
    XcdBarrier b; b.bar = bar; b.x = xb_xcc_id(); b.st = st;
    if (xb_tid == 0) (void)xb_add(&bar[XB_XCNT(b.x)], 1u);
    return b;
}
__device__ __forceinline__ void xcd_barrier_complete(unsigned* bar, unsigned x, unsigned& nloc, unsigned& nx) {
    const unsigned G = gridDim.x * gridDim.y * gridDim.z;
    unsigned sum, cnt, mine, sp = 0u;
    for (;;) {
        sum = 0u; cnt = 0u; mine = 0u;
#pragma unroll
        for (unsigned j = 0; j < 16; ++j) { const unsigned c = xb_ld(&bar[XB_XCNT(j)]); sum += c; cnt += (c > 0u) ? 1u : 0u; mine = (j == x) ? c : mine; }
        if (sum == G) break;
        __builtin_amdgcn_s_sleep(1);
        if ((++sp & 255u) == 0u) { if (xb_ld(&bar[XB_TMO])) break; if (sp > XB_SPIN_CAP) { atomicAdd(&bar[XB_TMO], 1u); break; } }
    }
    nloc = mine > 0u ? mine : 1u; nx = cnt > 0u ? cnt : 1u;
}

__device__ __forceinline__ void xcd_barrier(const XcdBarrier& b, const int xb_tid) {
    asm volatile("s_waitcnt vmcnt(0)" ::: "memory");
    __syncthreads();
    if (xb_tid == 0) {
        unsigned* bar = b.bar;
        __builtin_amdgcn_s_waitcnt(0);
        unsigned nloc = b.st[0], nx = b.st[1];
        if (nloc == 0u) { xcd_barrier_complete(bar, b.x, nloc, nx); b.st[0] = nloc; b.st[1] = nx; }
        const unsigned old = xb_add(&bar[XB_XSUB(b.x)], 1u);
        const unsigned gen = old / nloc;
        if (old + 1u == (gen + 1u) * nloc) {
            __builtin_amdgcn_fence(__ATOMIC_RELEASE, "agent");
            asm volatile("s_waitcnt vmcnt(0)" ::: "memory");
            const unsigned og = xb_add(&bar[XB_TOP], 1u);
            const unsigned tg = og / nx;
            if (og + 1u == (tg + 1u) * nx) xb_add(&bar[XB_TOPGEN], 1u);
            else XB_SPIN(xb_ld(&bar[XB_TOPGEN]) == tg, bar);
            __builtin_amdgcn_fence(__ATOMIC_ACQUIRE, "agent");
            xb_add(&bar[XB_XGEN(b.x)], 1u);
            asm volatile("s_waitcnt vmcnt(0)" ::: "memory");
        } else {
            XB_SPIN(xb_ld(&bar[XB_XGEN(b.x)]) == gen, bar);
            __builtin_amdgcn_fence(__ATOMIC_ACQUIRE, "agent");
            asm volatile("s_waitcnt vmcnt(0)" ::: "memory");
        }
    }
    __syncthreads();
}

#define GAS __attribute__((address_space(1)))
typedef unsigned short bf16;
typedef unsigned v4u __attribute__((ext_vector_type(4)));
typedef unsigned v2u __attribute__((ext_vector_type(2)));
typedef float f32x4 __attribute__((ext_vector_type(4)));

constexpr int NB = 4, SEQ = 8192, DM = 1024, DEPTH = 4, CTXL = 256;
constexpr int NLAT = NB * SEQ, NCTX = NB * CTXL, MT = NLAT + NCTX;
constexpr int DIN = 3360, DINP = 3584, DFF = 2816, NEXP = 8;
constexpr int C_RQ = 0, C_RK = 256, C_RV = 512, C_RG = 768, C_S5 = 1024, C_HQ = 1280, C_HFF = 1536, C_HFB = 1792, C_HI = 2048, C_HG = 2304,
              C_GQ = 2560, C_GK = 2688, C_GV = 2816, C_GG = 3072, C_GAF = 3328, C_GAB = 3344,
              C_GZF = 3328, C_GZB = 3456;
constexpr int NSEG = 132;
constexpr int MOE_CAP_TILES = 272;
constexpr float NEPS = 1e-6f;
constexpr float WSC8 = 64.0f;

constexpr size_t MiB = 1u << 20;
constexpr size_t WS_CTL = 0, CTL_ZERO_BYTES = 2 * MiB;
constexpr size_t WS_MOD = 2 * MiB;
constexpr size_t WS_LB = 3 * MiB;
constexpr size_t WS_ROPE = 3 * MiB + 65536;
constexpr size_t WS_GLUW = 3 * MiB + 131072;
constexpr size_t WS_WIN = 4 * MiB;
constexpr size_t WS_WOUT = 32 * MiB;
constexpr size_t WS_W13D = 40 * MiB;
constexpr size_t WS_W2D = 62 * MiB;
constexpr size_t WS_W13M = 73 * MiB;
constexpr size_t WS_W2M = 161 * MiB;
constexpr size_t WS_HB = 205 * MiB;
constexpr size_t WS_ACT = 209 * MiB;
constexpr size_t WS_Z = 275 * MiB;
constexpr size_t WS_PH = 292 * MiB;
constexpr size_t WS_OF = (292 + 232) * MiB;
constexpr size_t WS_X2 = 666 * MiB;
constexpr size_t WS_LIST = 843 * MiB;
constexpr size_t WS_END = 846 * MiB;
constexpr size_t ST_DS0 = 0;
constexpr size_t ST_DS1 = ST_DS0 + (size_t)2 * 16 * NSEG * 4096;
constexpr size_t ST_DS2 = ST_DS1 + (size_t)2 * 16 * NSEG * 4096;
constexpr size_t ST_G0 = ST_DS2 + (size_t)2 * 16 * NSEG * 2048;
constexpr size_t ST_G1 = ST_G0 + (size_t)2 * 16 * NSEG * 64;
constexpr size_t ST_G2 = ST_G1 + (size_t)2 * 16 * NSEG * 64;
constexpr size_t ST_HS = ST_G2 + (size_t)2 * 16 * NSEG * 64;
constexpr size_t ST_END = ST_HS + (size_t)2 * 64 * NSEG * 128;
static_assert(ST_END * 4 <= (WS_LIST - WS_X2), "state region");
static_assert(WS_PH + (size_t)MT * DINP * 2 <= WS_OF && WS_OF + (size_t)MT * 768 * 4 <= WS_X2, "OF region");
static_assert((size_t)MOE_CAP_TILES * 256 * 1024 * 2 <= (WS_LIST - WS_X2), "XB region");
static_assert((size_t)MOE_CAP_TILES * 256 * DFF * 2 <= (WS_X2 - WS_PH) && (size_t)MT * DINP * 2 <= (WS_X2 - WS_PH), "P/H region");
constexpr int CW_BAR = 4096;
constexpr int CW_CNT = 16384;

constexpr int LDS_BYTES = 163840;
constexpr int MISC_OFF = 163840 - 512;

__device__ __forceinline__ float bf2f(unsigned short h) { return __uint_as_float(((unsigned)h) << 16); }
__device__ __forceinline__ unsigned f2bf(float f) { unsigned u = __float_as_uint(f); return (u + 0x7fffu + ((u >> 16) & 1u)) >> 16; }
__device__ __forceinline__ unsigned pk2(float lo, float hi) { return f2bf(lo) | (f2bf(hi) << 16); }
__device__ __forceinline__ float wave_sum(float v) {
#define WS_DPP(ctrl, rmask) v += __int_as_float(__builtin_amdgcn_update_dpp(0, __float_as_int(v), (ctrl), (rmask), 0xf, false))
    WS_DPP(0x111, 0xf); WS_DPP(0x112, 0xf); WS_DPP(0x114, 0xf); WS_DPP(0x118, 0xf); WS_DPP(0x142, 0xa); WS_DPP(0x143, 0xc);
#undef WS_DPP
    return __int_as_float(__builtin_amdgcn_readlane(__float_as_int(v), 63));
}
__device__ __forceinline__ float rdl(float v, int k) { return __uint_as_float((unsigned)__builtin_amdgcn_readlane((int)__float_as_uint(v), k)); }
__device__ __forceinline__ float sigm(float x) { return __builtin_amdgcn_rcpf(1.0f + __expf(-x)); }
__device__ __forceinline__ float silu_f(float x) { return x * __builtin_amdgcn_rcpf(1.0f + __expf(-x)); }
#define LDS_WAIT() asm volatile("s_waitcnt lgkmcnt(0)" ::: "memory")

struct Args {
    const float* in[37];
    int l_lo, l_hi, ph_lo, ph_hi, do_pro, do_fin, fused, pad;
};
constexpr int I_OUT = 35, I_WS = 36;
enum { I_X = 0, I_C, I_CTX, I_CCTX, I_ADAW, I_ADAB, I_N1W, I_N2W, I_WIN, I_WOUT, I_RETGN, I_LAMRE, I_LAMIM, I_LOGDT, I_BRE, I_BIM, I_CRE, I_CIM, I_S5D,
       I_GLUW, I_GLUB, I_LBL, I_HGNW, I_WA2, I_BA, I_GLANW, I_FW1, I_FW3, I_FW2, I_RW, I_RB, I_MW1, I_MW3, I_MW2, I_FINW };

struct Frame {
    LAS unsigned char* lds;
    int tid, lane, wave, gw, NGW, G, zz;
    unsigned char* ws; float* out;
};

struct EpiStoreBf16 {
    static constexpr bool PERM = true, AFTER_DRAIN = false;
    bf16* O; int ldc; float sc;
    __device__ __forceinline__ void operator()(const pg8::f32x4 (&acc)[2][2][4][2], const pg8::Unit& u, int wr, int wc, int fr, int fq) const {
        const int row0 = u.pm * 256 + wr * 64 + fr, col0 = u.pc * 256 + wc * 32 + 8 * fq;
#pragma unroll
        for (int ai = 0; ai < 2; ++ai)
#pragma unroll
            for (int m = 0; m < 4; ++m) { bf16* rowp = O + (size_t)(row0 + ai * 128 + m * 16) * ldc + col0;
#pragma unroll
                for (int bj = 0; bj < 2; ++bj) { const pg8::f32x4 v0 = acc[ai][bj][m][0] * sc, v1 = acc[ai][bj][m][1] * sc;
                    pg8::u32x4 w; w.x = pg8::cvt_pk_bf16(v0[0], v0[1]); w.y = pg8::cvt_pk_bf16(v0[2], v0[3]); w.z = pg8::cvt_pk_bf16(v1[0], v1[1]); w.w = pg8::cvt_pk_bf16(v1[2], v1[3]);
                    *(pg8::u32x4*)(rowp + bj * 128) = w; } }
    }
};
constexpr int P4G = 4 * DINP, P4S5 = 4096;
struct EpiStoreP4 {
    static constexpr bool PERM = true, FLIP = true, AFTER_DRAIN = false;
    bf16* O;
    __device__ __forceinline__ void operator()(const pg8::f32x4 (&acc)[2][2][4][2], const pg8::Unit& u, int wr, int wc, int fr, int fq) const {
        const int grp0 = u.pm * 64 + wr * 16 + fq;
        if (!(u.pc == 3 || u.pc == 4 || u.pc == 9 || u.pc == 12)) {
            bf16* base = O + (size_t)grp0 * P4G + (size_t)(u.pc * 256 + wc * 32 + 2 * fr) * 4;
#pragma unroll
            for (int ai = 0; ai < 2; ++ai)
#pragma unroll
                for (int m = 0; m < 4; ++m) { bf16* gp = base + (size_t)(ai * 32 + m * 4) * P4G;
#pragma unroll
                    for (int bj = 0; bj < 2; ++bj) { const pg8::f32x4 v0 = acc[ai][bj][m][0], v1 = acc[ai][bj][m][1];
                        pg8::u32x4 w; w.x = pg8::cvt_pk_bf16(v0[0], v0[1]); w.y = pg8::cvt_pk_bf16(v0[2], v0[3]); w.z = pg8::cvt_pk_bf16(v1[0], v1[1]); w.w = pg8::cvt_pk_bf16(v1[2], v1[3]);
                        *(pg8::u32x4*)(gp + bj * 512) = w; } }
        } else {
            bf16* base = O + (size_t)grp0 * P4G + u.pc * 1024 + wc * 32 + 2 * fr;
#pragma unroll
            for (int ai = 0; ai < 2; ++ai)
#pragma unroll
                for (int m = 0; m < 4; ++m) { bf16* gp = base + (size_t)(ai * 32 + m * 4) * P4G;
#pragma unroll
                    for (int bj = 0; bj < 2; ++bj)
#pragma unroll
                        for (int r = 0; r < 4; ++r) *(unsigned*)(gp + r * 256 + bj * 128) = pg8::cvt_pk_bf16(acc[ai][bj][m][0][r], acc[ai][bj][m][1][r]); }
        }
    }
};
struct EpiSwiglu {
    static constexpr bool PERM = true, AFTER_DRAIN = false;
    bf16* H;
    __device__ __forceinline__ void operator()(const pg8::f32x4 (&acc)[2][2][4][2], const pg8::Unit& u, int wr, int wc, int fr, int fq) const {
        const int row0 = u.pm * 256 + wr * 64 + fr, col0 = u.pc * 128 + wc * 32 + 8 * fq;
#pragma unroll
        for (int ai = 0; ai < 2; ++ai)
#pragma unroll
            for (int m = 0; m < 4; ++m) { bf16* rowp = H + (size_t)(row0 + ai * 128 + m * 16) * DFF + col0;
                float h[8];
#pragma unroll
                for (int n = 0; n < 2; ++n)
#pragma unroll
                    for (int j = 0; j < 4; ++j) { const float a = acc[ai][0][m][n][j], b = acc[ai][1][m][n][j];
                        h[n * 4 + j] = a * __builtin_amdgcn_rcpf(1.0f + __builtin_amdgcn_exp2f(-1.4426950408889634f * a)) * b; }
                pg8::u32x4 w; w.x = pg8::cvt_pk_bf16(h[0], h[1]); w.y = pg8::cvt_pk_bf16(h[2], h[3]); w.z = pg8::cvt_pk_bf16(h[4], h[5]); w.w = pg8::cvt_pk_bf16(h[6], h[7]);
                *(pg8::u32x4*)rowp = w; }
    }
};
struct EpiSwiglu8 {
    static constexpr bool PERM = true, AFTER_DRAIN = false;
    unsigned char* H; float sc;
    __device__ __forceinline__ void operator()(const pg8::f32x4 (&acc)[2][2][4][2], const pg8::Unit& u, int wr, int wc, int fr, int fq) const {
        const int row0 = u.pm * 256 + wr * 64 + fr, col0 = u.pc * 128 + wc * 32 + 8 * fq;
#pragma unroll
        for (int ai = 0; ai < 2; ++ai)
#pragma unroll
            for (int m = 0; m < 4; ++m) { unsigned char* rowp = H + (size_t)(row0 + ai * 128 + m * 16) * DFF + col0;
                float h[8];
#pragma unroll
                for (int n = 0; n < 2; ++n)
#pragma unroll
                    for (int j = 0; j < 4; ++j) { const float a = acc[ai][0][m][n][j] * sc, b = acc[ai][1][m][n][j] * sc;
                        const float hv = a * __builtin_amdgcn_rcpf(1.0f + __builtin_amdgcn_exp2f(-1.4426950408889634f * a)) * b;
                        h[n * 4 + j] = fminf(fmaxf(hv, -448.0f), 448.0f); }
                unsigned w0 = 0u, w1 = 0u;
                w0 = __builtin_amdgcn_cvt_pk_fp8_f32(h[0], h[1], w0, false); w0 = __builtin_amdgcn_cvt_pk_fp8_f32(h[2], h[3], w0, true);
                w1 = __builtin_amdgcn_cvt_pk_fp8_f32(h[4], h[5], w1, false); w1 = __builtin_amdgcn_cvt_pk_fp8_f32(h[6], h[7], w1, true);
                v2u w; w.x = w0; w.y = w1; *(v2u*)rowp = w; }
    }
};
struct EpiResid {
    static constexpr bool PERM = false, AFTER_DRAIN = false;
    const float* xin_lat; const float* xin_ctx; float* xout_lat; float* xout_ctx; const float* gate; float sc;
    __device__ __forceinline__ void operator()(const pg8::f32x4 (&acc)[2][2][4][2], const pg8::Unit& u, int wr, int wc, int fr, int fq) const {
        const bool isctx = u.pm >= 128; const int bidx = isctx ? 4 : (u.pm >> 5);
        const size_t rbase = (size_t)(isctx ? (u.pm - 128) : u.pm) * 256 + wr * 64 + fr;
        const float* xi = (isctx ? xin_ctx : xin_lat); float* xo = (isctx ? xout_ctx : xout_lat);
        const int col0 = u.pc * 256 + wc * 32 + 4 * fq; const float* g = gate + (size_t)bidx * 6144 + col0;
        pg8::f32x4 gv[2][2];
#pragma unroll
        for (int bj = 0; bj < 2; ++bj)
#pragma unroll
            for (int n = 0; n < 2; ++n) gv[bj][n] = *(const pg8::f32x4*)(g + bj * 128 + n * 16) * sc;
#pragma unroll
        for (int ai = 0; ai < 2; ++ai)
#pragma unroll
            for (int m = 0; m < 4; ++m) { const size_t off = (rbase + ai * 128 + m * 16) * 1024 + col0;
#pragma unroll
                for (int bj = 0; bj < 2; ++bj)
#pragma unroll
                    for (int n = 0; n < 2; ++n) { const pg8::f32x4 xv = *(const pg8::f32x4*)(xi + off + bj * 128 + n * 16);
                        *(pg8::f32x4*)(xo + off + bj * 128 + n * 16) = xv + gv[bj][n] * acc[ai][bj][m][n]; }
                asm volatile("" ::: "memory"); }
    }
};
struct EpiGlu {
    static constexpr bool PERM = true, AFTER_DRAIN = false;
    const bf16* Z; bf16* Y; const float* bias;
    __device__ __forceinline__ void operator()(const pg8::f32x4 (&acc)[2][2][4][2], const pg8::Unit& u, int wr, int wc, int fr, int fq) const {
        const int row0 = u.pm * 256 + wr * 64 + fr, col0 = wc * 32 + 8 * fq;
#pragma unroll
        for (int ai = 0; ai < 2; ++ai)
#pragma unroll
            for (int m = 0; m < 4; ++m) { const size_t row = (size_t)(row0 + ai * 128 + m * 16);
#pragma unroll
                for (int bj = 0; bj < 2; ++bj) { const int col = col0 + bj * 128;
                    const pg8::u32x4 zz = *(const pg8::u32x4*)(Z + row * 256 + col);
                    const pg8::f32x4 b0 = *(const pg8::f32x4*)(bias + col), b1 = *(const pg8::f32x4*)(bias + col + 4);
                    const pg8::f32x4 v0 = acc[ai][bj][m][0] + b0, v1 = acc[ai][bj][m][1] + b1;
                    float o[8]; const unsigned zw[4] = {zz.x, zz.y, zz.z, zz.w};
#pragma unroll
                    for (int j = 0; j < 4; ++j) { const float zl = __uint_as_float(zw[j] << 16), zh = __uint_as_float(zw[j] & 0xffff0000u);
                        const float a0 = (j < 2) ? v0[2 * j] : v1[2 * j - 4], a1 = (j < 2) ? v0[2 * j + 1] : v1[2 * j - 3];
                        o[2 * j] = zl * sigm(a0); o[2 * j + 1] = zh * sigm(a1); }
                    pg8::u32x4 w; w.x = pg8::cvt_pk_bf16(o[0], o[1]); w.y = pg8::cvt_pk_bf16(o[2], o[3]); w.z = pg8::cvt_pk_bf16(o[4], o[5]); w.w = pg8::cvt_pk_bf16(o[6], o[7]);
                    *(pg8::u32x4*)(Y + row * 1024 + 256 + col) = w; }
                asm volatile("" ::: "memory"); }
    }
};
struct MoeOrder {
    int tp[9]; int nN, G, c, total;
    __device__ __forceinline__ void init(const unsigned* cnt, int nN_, int G_, int c_) {
        tp[0] = 0;
#pragma unroll
        for (int e = 0; e < 8; ++e) tp[e + 1] = tp[e] + (int)(((unsigned)__builtin_amdgcn_readfirstlane((int)__hip_atomic_load(cnt + e * 64, __ATOMIC_RELAXED, __HIP_MEMORY_SCOPE_AGENT)) + 255u) >> 8);
        nN = nN_; G = G_; c = c_; total = tp[8] * nN;
    }
    __device__ __forceinline__ bool next(int i, pg8::Unit& u) const {
        const int L = i * G + c; if (L >= total) return false;
        const int t = L / nN, pn = L - t * nN; int e = 0;
#pragma unroll
        for (int k = 1; k < 8; ++k) e += (t >= tp[k]) ? 1 : 0;
        u.pm = t; u.pn = e * nN + pn; u.pc = pn; return true;
    }
    __device__ __forceinline__ void a_ready(const pg8::Unit&) const {}
    __device__ __forceinline__ void done(const pg8::Unit&) const {}
};

__device__ __forceinline__ void cvt_item(const float* W, int K, int N, bf16* WT, int mode, int add, LAS float* scr, int item, int lane, int nblk_override = 0, const float* ks = nullptr  ) {
    const int nblk = nblk_override ? nblk_override : (N >> 5), kb = item / nblk, nb = item - kb * nblk, k0 = 64 * kb, n0 = 32 * nb;
    const int r = lane >> 3, c4 = lane & 7;
    f32x4 v[8];
#pragma unroll
    for (int i = 0; i < 8; ++i) v[i] = *(const f32x4*)(W + (size_t)(k0 + 8 * i + r) * N + n0 + 4 * c4);
    if (ks) {
#pragma unroll
        for (int i = 0; i < 8; ++i) v[i] *= ks[8 * i + r]; }
#pragma unroll
    for (int i = 0; i < 8; ++i) {
#pragma unroll
        for (int j = 0; j < 4; ++j) scr[(8 * i + r) * 33 + 4 * c4 + j] = v[i][j]; }
    LDS_WAIT();
    const int c = lane & 7;
#pragma unroll
    for (int j = 0; j < 4; ++j) { const int n = (lane >> 3) + 8 * j; const LAS float* s = scr + (8 * c) * 33 + n;
        v4u o; o.x = pk2(s[0 * 33], s[1 * 33]); o.y = pk2(s[2 * 33], s[3 * 33]); o.z = pk2(s[4 * 33], s[5 * 33]); o.w = pk2(s[6 * 33], s[7 * 33]);
        const int nn = n0 + n; const int drow = (mode == 0) ? (nn + add) : (((nn >> 7) << 8) + (nn & 127) + add);
        *(v4u*)(WT + (size_t)drow * K + k0 + 8 * c) = o; }
    LDS_WAIT();
}
__device__ __forceinline__ void cvt_item_f8(const float* W, int K, int N, unsigned char* WT, int mode, int add, LAS float* scr, int item, int lane) {
    const int nblk = N >> 5, kb = item / nblk, nb = item - kb * nblk, k0 = 64 * kb, n0 = 32 * nb;
    const int r = lane >> 3, c4 = lane & 7;
    f32x4 v[8];
#pragma unroll
    for (int i = 0; i < 8; ++i) v[i] = *(const f32x4*)(W + (size_t)(k0 + 8 * i + r) * N + n0 + 4 * c4);
#pragma unroll
    for (int i = 0; i < 8; ++i) {
#pragma unroll
        for (int j = 0; j < 4; ++j) scr[(8 * i + r) * 33 + 4 * c4 + j] = v[i][j]; }
    LDS_WAIT();
    const int c = lane & 3;
#pragma unroll
    for (int j = 0; j < 2; ++j) { const int n = (lane >> 2) + 16 * j; const LAS float* s = scr + (16 * c) * 33 + n;
        unsigned w[4];
#pragma unroll
        for (int q = 0; q < 4; ++q) { unsigned x = 0u;
            x = __builtin_amdgcn_cvt_pk_fp8_f32(s[(4 * q) * 33] * WSC8, s[(4 * q + 1) * 33] * WSC8, x, false);
            x = __builtin_amdgcn_cvt_pk_fp8_f32(s[(4 * q + 2) * 33] * WSC8, s[(4 * q + 3) * 33] * WSC8, x, true); w[q] = x; }
        v4u o; o.x = w[0]; o.y = w[1]; o.z = w[2]; o.w = w[3];
        const int nn = n0 + n; const int drow = (mode == 0) ? (nn + add) : (((nn >> 7) << 8) + (nn & 127) + add);
        *(v4u*)(WT + (size_t)drow * K + k0 + 16 * c) = o; }
    LDS_WAIT();
}
__device__ __forceinline__ void moe_cvt_idle(const Frame& F, const Args& a, int j, int b_lo) {
    LAS float* scr = (LAS float*)(F.lds + F.wave * 16384);
    constexpr int IT = 1408;
    const int nw = (F.G - b_lo) * 8, w = ((int)blockIdx.x - b_lo) * 8 + F.wave;
    for (int it = w; it < 8 * 3 * IT; it += nw) {
        const int e = it / (3 * IT), r = it - e * 3 * IT, which = r / IT, item = r - which * IT;
        const size_t eo = ((size_t)j * 8 + e) * (size_t)(1024 * DFF);
        if (which == 0) cvt_item_f8(a.in[F.zz + I_MW1] + eo, 1024, DFF, F.ws + WS_W13M + (size_t)e * 5632 * 1024, 1, 0, scr, item, F.lane);
        else if (which == 1) cvt_item_f8(a.in[F.zz + I_MW3] + eo, 1024, DFF, F.ws + WS_W13M + (size_t)e * 5632 * 1024, 1, 128, scr, item, F.lane);
        else cvt_item_f8(a.in[F.zz + I_MW2] + eo, DFF, 1024, F.ws + WS_W2M + (size_t)e * 1024 * DFF, 0, 0, scr, item, F.lane);
    }
}
__device__ __forceinline__ void moe_cvt(const Frame& F, const Args& a, int j) {
    LAS float* scr = (LAS float*)(F.lds + F.wave * 16384);
    constexpr int IT = 1408;
    for (int it = F.gw; it < 8 * 3 * IT; it += F.NGW) {
        const int e = it / (3 * IT), r = it - e * 3 * IT, which = r / IT, item = r - which * IT;
        const size_t eo = ((size_t)j * 8 + e) * (size_t)(1024 * DFF);
        if (which == 0) cvt_item_f8(a.in[F.zz + I_MW1] + eo, 1024, DFF, F.ws + WS_W13M + (size_t)e * 5632 * 1024, 1, 0, scr, item, F.lane);
        else if (which == 1) cvt_item_f8(a.in[F.zz + I_MW3] + eo, 1024, DFF, F.ws + WS_W13M + (size_t)e * 5632 * 1024, 1, 128, scr, item, F.lane);
        else cvt_item_f8(a.in[F.zz + I_MW2] + eo, DFF, 1024, F.ws + WS_W2M + (size_t)e * 1024 * DFF, 0, 0, scr, item, F.lane);
    }
}
__device__ __forceinline__ void prologue(const Frame& F, const Args& a) {
    {
        LAS float* sc = (LAS float*)F.lds; LAS float* red = sc + 5120;
        for (int idx = F.tid; idx < 5120; idx += 512) { const int r = idx >> 10, k = idx & 1023; const float cv = (r < 4) ? a.in[F.zz + I_C][r * 1024 + k] : a.in[F.zz + I_CCTX][k]; sc[idx] = silu_f(cv); }
        __syncthreads();
        float* MOD = (float*)(F.ws + WS_MOD);
        for (int item = blockIdx.x; item < 384; item += F.G) {
            const int l = item / 96, nb = item - l * 96, cl = F.tid & 63, ks = F.tid >> 6, n = nb * 64 + cl;
            float acc[5] = {0.f, 0.f, 0.f, 0.f, 0.f};
            const float* wp = a.in[F.zz + I_ADAW] + ((size_t)l * 1024 + ks * 128) * 6144 + n;
#pragma unroll 16
            for (int kk = 0; kk < 128; ++kk) { const float w = wp[(size_t)kk * 6144];
#pragma unroll
                for (int r = 0; r < 5; ++r) acc[r] = fmaf(sc[r * 1024 + ks * 128 + kk], w, acc[r]); }
#pragma unroll
            for (int r = 0; r < 5; ++r) red[(ks * 5 + r) * 64 + cl] = acc[r];
            __syncthreads();
            if (F.tid < 320) { const int r = F.tid >> 6; float s = 0.f;
#pragma unroll
                for (int k2 = 0; k2 < 8; ++k2) s += red[(k2 * 5 + r) * 64 + cl];
                MOD[((size_t)l * 5 + r) * 6144 + n] = s + a.in[F.zz + I_ADAB][l * 6144 + n]; }
            __syncthreads();
        }
        if (blockIdx.x == 0 && F.tid < 256) {
            const float* lg = a.in[F.zz + I_LBL]; float x[4], mx = -3.0e38f;
#pragma unroll
            for (int l = 0; l < 4; ++l) { x[l] = lg[l * 256 + F.tid]; mx = fmaxf(mx, x[l]); }
            float s = 0.f;
#pragma unroll
            for (int l = 0; l < 4; ++l) { x[l] = expf(x[l] - mx); s += x[l]; }
            float cs = 0.f; const float sm0 = x[0] / s; float* LB = (float*)(F.ws + WS_LB);
#pragma unroll
            for (int l = 0; l < 4; ++l) { cs += x[l] / s; LB[l * 256 + F.tid] = fminf(fmaxf(cs - sm0, 0.f), 1.0f - 1e-6f); }
        }
        if (blockIdx.x == (1 % F.G)) {
            float* RC = (float*)(F.ws + WS_ROPE); float* RS = RC + 2048;
            for (int idx = F.tid; idx < 2048; idx += 512) { const int pos = idx >> 4, i = idx & 15;
                const float fr = powf(10000.0f, -(float)i / 16.0f); const float ang = (float)pos * fr; RC[idx] = cosf(ang); RS[idx] = sinf(ang); }
        }
        __syncthreads();
    }
    LAS float* scr = (LAS float*)(F.lds + F.wave * 16384);
    constexpr int I_IN = 16 * 104, I_OUT = 16 * 32, I_F = 1408, I_GL = 4 * 8;
    constexpr int NIT = 4 * I_IN + 4 * I_OUT + 6 * I_F + 4 * I_GL;
    for (int it = F.gw; it < NIT; it += F.NGW) {
        int r = it;
        if (r < 4 * I_IN) { const int l = r / I_IN; cvt_item(a.in[F.zz + I_WIN] + (size_t)l * 1024 * DIN, 1024, DIN, (bf16*)(F.ws + WS_WIN) + (size_t)l * DINP * 1024, 0, 0, scr, r - l * I_IN, F.lane, 104); continue; } r -= 4 * I_IN;
        if (r < 4 * I_OUT) { const int l = r / I_OUT, it = r - l * I_OUT, k0 = 64 * (it >> 5);
            const float* ks = k0 < 256 ? a.in[F.zz + I_RETGN] + l * 256 + k0 : (k0 < 512 ? nullptr : (k0 < 768 ? a.in[F.zz + I_HGNW] + l * 256 + (k0 - 512) : a.in[F.zz + I_GLANW] + l * 256 + (k0 - 768)));
            cvt_item(a.in[F.zz + I_WOUT] + (size_t)l * 1024 * 1024, 1024, 1024, (bf16*)(F.ws + WS_WOUT) + (size_t)l * 1024 * 1024, 0, 0, scr, it, F.lane, 0, ks); continue; } r -= 4 * I_OUT;
        if (r < 6 * I_F) { const int j = r / (3 * I_F), r2 = r - j * 3 * I_F, which = r2 / I_F, item = r2 - which * I_F; const size_t wo = (size_t)j * 1024 * DFF;
            if (which == 0) cvt_item(a.in[F.zz + I_FW1] + wo, 1024, DFF, (bf16*)(F.ws + WS_W13D) + (size_t)j * 5632 * 1024, 1, 0, scr, item, F.lane);
            else if (which == 1) cvt_item(a.in[F.zz + I_FW3] + wo, 1024, DFF, (bf16*)(F.ws + WS_W13D) + (size_t)j * 5632 * 1024, 1, 128, scr, item, F.lane);
            else cvt_item_f8(a.in[F.zz + I_FW2] + wo, DFF, 1024, F.ws + WS_W2D + (size_t)j * 1024 * DFF, 0, 0, scr, item, F.lane);
            continue; } r -= 6 * I_F;
        { const int l = r / I_GL; cvt_item(a.in[F.zz + I_GLUW] + (size_t)l * 65536, 256, 256, (bf16*)(F.ws + WS_GLUW) + (size_t)l * 65536, 0, 0, scr, r - l * I_GL, F.lane); }
    }
    for (int i = blockIdx.x * 512 + F.tid; i < 4 * 256 * 128; i += F.G * 512) {
        const int l = i >> 15, rem = i & 32767, n = rem >> 7, k0 = (rem & 127) * 8, d = n >> 7, cidx = n & 127;
        const float* wa = a.in[F.zz + I_WA2] + ((size_t)(l * 2 + d) * 16) * 128 + cidx;
        float acc[8] = {0.f, 0.f, 0.f, 0.f, 0.f, 0.f, 0.f, 0.f};
#pragma unroll
        for (int r = 0; r < 16; ++r) { const float w2 = wa[r * 128];
#pragma unroll
            for (int kk = 0; kk < 8; ++kk) acc[kk] = fmaf(a.in[F.zz + I_WIN][((size_t)l * 1024 + k0 + kk) * DIN + 3328 + 16 * d + r], w2, acc[kk]); }
        v4u o; o.x = pk2(acc[0], acc[1]); o.y = pk2(acc[2], acc[3]); o.z = pk2(acc[4], acc[5]); o.w = pk2(acc[6], acc[7]);
        *(v4u*)((bf16*)(F.ws + WS_WIN) + ((size_t)l * DINP + 3328 + n) * 1024 + k0) = o;
    }
}

struct MoeTp { int tp[9]; };
__device__ __forceinline__ void load_tp(MoeTp& t, const unsigned* cnt) {
    t.tp[0] = 0;
#pragma unroll
    for (int e = 0; e < 8; ++e) t.tp[e + 1] = t.tp[e] + (int)(((unsigned)__builtin_amdgcn_readfirstlane((int)__hip_atomic_load(cnt + e * 64, __ATOMIC_RELAXED, __HIP_MEMORY_SCOPE_AGENT)) + 255u) >> 8);
}
template <int MODE>
__device__ __forceinline__ void norm_phase(const Frame& F, const Args& a, int l, int which  , int nrows, int comb_l  ) {
    const float* MOD = (const float*)(F.ws + WS_MOD);
    const float* nw = (MODE == 2) ? a.in[F.zz + I_FINW] : ((which ? a.in[F.zz + I_N2W] : a.in[F.zz + I_N1W]) + l * 1024);
    bf16* XN = (bf16*)(F.ws + WS_ACT);
    float* hb = (float*)(F.ws + WS_HB);
    const int* EP = (const int*)(F.ws + WS_LIST) + 8 * MT; const float* GATE = (const float*)(F.ws + WS_LIST) + 10 * MT;
    const bf16* YM = (const bf16*)(F.ws + WS_X2);
    const bool from_input = (l == 0 && which == 0 && MODE != 2);
    MoeTp ctp; if (comb_l >= 0) load_tp(ctp, (const unsigned*)F.ws + CW_CNT + (comb_l >> 1) * 8 * 64);
    const int jm = l >> 1;
    LAS float* rwl = (LAS float*)F.lds;
    if (MODE == 1) {
        const float* rw = a.in[F.zz + I_RW] + (size_t)jm * 8192;
        for (int idx = F.tid; idx < 8192; idx += 512) { const int k = idx >> 3, e = idx & 7; rwl[e * 1024 + k] = rw[idx]; }
        __syncthreads();
    }
    f32x4 wv[4];
#pragma unroll
    for (int j = 0; j < 4; ++j) wv[j] = *((const f32x4*)nw + F.lane + 64 * j);
    f32x4 vn[4]; int epn0 = 0, epn1 = 0; float gn0 = 0.f, gn1 = 0.f;
    { const int m = F.gw < nrows ? F.gw : 0; const bool isctx = m >= NLAT;
      const float* xr = from_input ? (isctx ? a.in[F.zz + I_CTX] + (size_t)(m - NLAT) * 1024 : a.in[F.zz + I_X] + (size_t)m * 1024) : (isctx ? hb + (size_t)(m - NLAT) * 1024 : F.out + (size_t)m * 1024);
#pragma unroll
      for (int j = 0; j < 4; ++j) vn[j] = *((const f32x4*)xr + F.lane + 64 * j);
      if (comb_l >= 0) { epn0 = EP[2 * m]; epn1 = EP[2 * m + 1]; gn0 = GATE[2 * m]; gn1 = GATE[2 * m + 1]; } }
    for (int m = F.gw; m < nrows; m += F.NGW) {
        const bool isctx = m >= NLAT; const int bidx = isctx ? 4 : (m >> 13);
        f32x4 v[4];
#pragma unroll
        for (int j = 0; j < 4; ++j) v[j] = vn[j];
        const int ep0 = epn0, ep1 = epn1; const float g0 = gn0, g1 = gn1;
        { const int mn = (m + F.NGW < nrows) ? m + F.NGW : m; const bool cn = mn >= NLAT;
          const float* xr = from_input ? (cn ? a.in[F.zz + I_CTX] + (size_t)(mn - NLAT) * 1024 : a.in[F.zz + I_X] + (size_t)mn * 1024) : (cn ? hb + (size_t)(mn - NLAT) * 1024 : F.out + (size_t)mn * 1024);
#pragma unroll
          for (int j = 0; j < 4; ++j) vn[j] = *((const f32x4*)xr + F.lane + 64 * j);
          if (comb_l >= 0) { epn0 = EP[2 * mn]; epn1 = EP[2 * mn + 1]; gn0 = GATE[2 * mn]; gn1 = GATE[2 * mn + 1]; } }
        if (comb_l >= 0) {
            int t0 = 0, t1 = 0;
#pragma unroll
            for (int e = 0; e < 8; ++e) { t0 = ((ep0 & 7) == e) ? ctp.tp[e] : t0; t1 = ((ep1 & 7) == e) ? ctp.tp[e] : t1; }
            const size_t d0 = (size_t)t0 * 256 + (ep0 >> 3), d1 = (size_t)t1 * 256 + (ep1 >> 3);
            const float* m5 = MOD + ((size_t)comb_l * 5 + bidx) * 6144 + 5 * 1024;
            float* xw = isctx ? hb + (size_t)(m - NLAT) * 1024 : F.out + (size_t)m * 1024;
#pragma unroll
            for (int j = 0; j < 4; ++j) {
                const v2u y0 = *((const v2u*)(YM + d0 * 1024) + F.lane + 64 * j), y1 = *((const v2u*)(YM + d1 * 1024) + F.lane + 64 * j);
                const f32x4 mm = *((const f32x4*)m5 + F.lane + 64 * j);
                f32x4 f0, f1;
                f0[0] = __uint_as_float(y0.x << 16); f0[1] = __uint_as_float(y0.x & 0xffff0000u); f0[2] = __uint_as_float(y0.y << 16); f0[3] = __uint_as_float(y0.y & 0xffff0000u);
                f1[0] = __uint_as_float(y1.x << 16); f1[1] = __uint_as_float(y1.x & 0xffff0000u); f1[2] = __uint_as_float(y1.y << 16); f1[3] = __uint_as_float(y1.y & 0xffff0000u);
                v[j] = v[j] + mm * (f0 * g0 + f1 * g1);
                if (MODE != 2) *((f32x4*)xw + F.lane + 64 * j) = v[j];
            }
        }
        float ss = 0.f;
#pragma unroll
        for (int j = 0; j < 4; ++j) ss += (v[j][0] * v[j][0] + v[j][1] * v[j][1]) + (v[j][2] * v[j][2] + v[j][3] * v[j][3]);
        ss = wave_sum(ss);
        const float rstd = __builtin_amdgcn_rsqf(ss * (1.0f / 1024.0f) + NEPS);
        if (MODE == 2) {
#pragma unroll
            for (int j = 0; j < 4; ++j) *((f32x4*)(F.out + (size_t)m * 1024) + F.lane + 64 * j) = v[j] * rstd * wv[j];
        } else {
            const float* sh = MOD + ((size_t)l * 5 + bidx) * 6144 + (which ? 3 : 0) * 1024; const float* scl = sh + 1024;
            f32x4 o[4];
#pragma unroll
            for (int j = 0; j < 4; ++j) { const f32x4 s1 = *((const f32x4*)scl + F.lane + 64 * j), s0 = *((const f32x4*)sh + F.lane + 64 * j);
                o[j] = (v[j] * rstd * wv[j]) * (s1 + 1.0f) + s0;
                if (MODE == 1) {
                    unsigned w8 = 0u; w8 = __builtin_amdgcn_cvt_pk_fp8_f32(fminf(fmaxf(o[j][0], -448.f), 448.f), fminf(fmaxf(o[j][1], -448.f), 448.f), w8, false);
                    w8 = __builtin_amdgcn_cvt_pk_fp8_f32(fminf(fmaxf(o[j][2], -448.f), 448.f), fminf(fmaxf(o[j][3], -448.f), 448.f), w8, true);
                    *((unsigned*)((unsigned char*)XN + (size_t)m * 1024) + F.lane + 64 * j) = w8;
                } else { v2u w; w.x = pk2(o[j][0], o[j][1]); w.y = pk2(o[j][2], o[j][3]);
                    *((v2u*)(XN + (size_t)m * 1024) + F.lane + 64 * j) = w; } }
            if (MODE == 1) {
                float p[8];
#pragma unroll
                for (int e = 0; e < 8; ++e) { float s = 0.f;
#pragma unroll
                    for (int j = 0; j < 4; ++j) { const f32x4 w4 = *((const LAS f32x4*)(rwl + e * 1024) + F.lane + 64 * j);
                        s += (o[j][0] * w4[0] + o[j][1] * w4[1]) + (o[j][2] * w4[2] + o[j][3] * w4[3]); }
                    p[e] = wave_sum(s) + a.in[F.zz + I_RB][jm * 8 + e]; }
                int e0 = 0; float v0 = p[0];
#pragma unroll
                for (int e = 1; e < 8; ++e) if (p[e] > v0) { v0 = p[e]; e0 = e; }
                int e1 = -1; float v1 = -3.0e38f;
#pragma unroll
                for (int e = 0; e < 8; ++e) if (e != e0 && p[e] > v1) { v1 = p[e]; e1 = e; }
                const float ex = expf(v1 - v0), g0 = 1.0f / (1.0f + ex), g1 = ex / (1.0f + ex);
                if (F.lane == 0) {
                    unsigned* cnt = (unsigned*)F.ws + CW_CNT + jm * 8 * 64; int* LIST = (int*)(F.ws + WS_LIST);
                    int* EPw = (int*)(F.ws + WS_LIST) + 8 * MT; float* GW = (float*)(F.ws + WS_LIST) + 10 * MT;
                    const unsigned p0 = __hip_atomic_fetch_add(cnt + e0 * 64, 1u, __ATOMIC_RELAXED, __HIP_MEMORY_SCOPE_AGENT);
                    const unsigned p1 = __hip_atomic_fetch_add(cnt + e1 * 64, 1u, __ATOMIC_RELAXED, __HIP_MEMORY_SCOPE_AGENT);
                    LIST[e0 * MT + p0] = m; LIST[e1 * MT + p1] = m;
                    EPw[2 * m] = e0 | (int)(p0 << 3); EPw[2 * m + 1] = e1 | (int)(p1 << 3);
                    GW[2 * m] = g0; GW[2 * m + 1] = g1;
                }
            }
        }
    }
    if (MODE == 1) __syncthreads();
}
__device__ __forceinline__ void moe_gather(const Frame& F, int jm) {
    const unsigned* cnt = (const unsigned*)F.ws + CW_CNT + jm * 8 * 64;
    MoeTp t; load_tp(t, cnt);
    int cn[8];
#pragma unroll
    for (int e = 0; e < 8; ++e) cn[e] = __builtin_amdgcn_readfirstlane((int)__hip_atomic_load(cnt + e * 64, __ATOMIC_RELAXED, __HIP_MEMORY_SCOPE_AGENT));
    const int rows = t.tp[8] * 256;
    const int* LIST = (const int*)(F.ws + WS_LIST); const v4u* XN = (const v4u*)(F.ws + WS_ACT); v4u* XB = (v4u*)(F.ws + WS_X2);
    for (int r = F.gw; r < rows; r += F.NGW) {
        const int tile = r >> 8; int e = 0, tpe = 0, ce = cn[0];
#pragma unroll
        for (int k = 1; k < 8; ++k) { const bool ge = tile >= t.tp[k]; e += ge ? 1 : 0; tpe = ge ? t.tp[k] : tpe; ce = ge ? cn[k] : ce; }
        const int pos = r - tpe * 256;
        v4u x0 = {0u, 0u, 0u, 0u};
        if (pos < ce) { const int src = LIST[e * MT + pos]; x0 = XN[(size_t)src * 64 + F.lane]; }
        XB[(size_t)r * 64 + F.lane] = x0;
    }
}
#define GLD(T, ubase, voff) (*(const T*)((const char*)(ubase) + (unsigned)(voff)))
#define GST(T, ubase, voff) (*(T*)((char*)(ubase) + (unsigned)(voff)))
__device__ __forceinline__ int fresh_lane() { int l; asm volatile("v_mbcnt_lo_u32_b32 %0, -1, 0\n\tv_mbcnt_hi_u32_b32 %0, -1, %0" : "=v"(l)); return l; }

struct MixP { const bf16* P; const float* lb; const float* rcos; const float* rsin; const float* ba; };
__device__ __forceinline__ int seg_row0(int b, int sg) { return sg < 4 ? NLAT + b * CTXL + sg * 64 : b * SEQ + (sg - 4) * 64; }
__device__ __forceinline__ int seg_tpos0(int sg) { return sg < 4 ? -1 : (sg - 4) * 64; }

struct S5P { const float *lam_re, *lam_im, *log_dt, *b_re, *b_im, *c_re, *c_im, *dd; };
__device__ __forceinline__ float gelu_tanh(float y) { const float t = 0.7978845608028654f * (y + 0.044715f * y * y * y); const float th = 1.0f - 2.0f * __builtin_amdgcn_rcpf(1.0f + __expf(2.0f * t)); return 0.5f * y * (1.0f + th); }
template <int MODE>
__device__ __forceinline__ void s5_scan(const S5P& sp, const bf16* P, int b, int g, int dir, int sg, int lane, float& hre, float& him, LAS float* yf, LAS float* stg, bf16* Z) {
    const int row0 = seg_row0(b, sg); const int dg = dir * 16 + g;
    const float lre = sp.lam_re[dg * 64 + lane], lim = sp.lam_im[dg * 64 + lane], dt = expf(sp.log_dt[dg]);
    const float er = expf(lre * dt); const float sn = sinf(lim * dt), cs = cosf(lim * dt);
    const float ar = er * cs, ai = er * sn;
    const float nr = ar - 1.0f, ni = ai, den = lre * lre + lim * lim;
    const float cr = (nr * lre + ni * lim) / den, ci = (ni * lre - nr * lim) / den;
    float bbr[16], bbi[16], Cr[16], Ci[16];
#pragma unroll
    for (int c = 0; c < 16; ++c) { const float Br = sp.b_re[((size_t)dg * 64 + lane) * 16 + c], Bi = sp.b_im[((size_t)dg * 64 + lane) * 16 + c];
        bbr[c] = cr * Br - ci * Bi; bbi[c] = cr * Bi + ci * Br;
        Cr[c] = (MODE != 0) ? sp.c_re[((size_t)dg * 16 + c) * 64 + lane] : 0.f; Ci[c] = (MODE != 0) ? sp.c_im[((size_t)dg * 16 + c) * 64 + lane] : 0.f; }
    const int ch = ((lane >> 5) & 1) * 8 + ((lane >> 4) & 1) * 4 + ((lane >> 3) & 1) * 2 + ((lane >> 2) & 1);
    const float dv = (MODE == 2) ? sp.dd[g * 16 + ch] : 0.f;
    const bool b5 = lane & 32, b4 = lane & 16, b3 = lane & 8, b2 = lane & 4;
    const unsigned ucol = 2u * (unsigned)(C_S5 + g * 16 + (lane & 15));
    unsigned short rn0[4], rn1[4], rn2[4];
#pragma unroll
    for (int u = 0; u < 4; ++u) { rn0[u] = GLD(unsigned short, P + (size_t)(row0 + (dir ? 63 - u : u)) * DINP, ucol); rn1[u] = GLD(unsigned short, P + (size_t)(row0 + (dir ? 59 - u : 4 + u)) * DINP, ucol);
        rn2[u] = GLD(unsigned short, P + (size_t)(row0 + (dir ? 55 - u : 8 + u)) * DINP, ucol); }
#pragma unroll 1
    for (int i0 = 0; i0 < 64; i0 += 4) {
        unsigned short ru[4], rn3[4];
        const int ip = (i0 + 12 < 64) ? i0 + 12 : 60;
#pragma unroll
        for (int u = 0; u < 4; ++u) { ru[u] = rn0[u]; rn3[u] = GLD(unsigned short, P + (size_t)(row0 + (dir ? 63 - (ip + u) : (ip + u))) * DINP, ucol); }
#pragma unroll
        for (int u = 0; u < 4; ++u) stg[u * 64 + lane] = bf2f(ru[u]);
#pragma unroll
        for (int u = 0; u < 4; ++u) {
            const int ti = dir ? 63 - (i0 + u) : (i0 + u);
            const float uf = bf2f(ru[u]);
            float bur = 0.f, bui = 0.f;
#pragma unroll
            for (int c4 = 0; c4 < 4; ++c4) { const f32x4 ux = *(const LAS f32x4*)(stg + u * 64 + 4 * c4);
#pragma unroll
                for (int jj = 0; jj < 4; ++jj) { bur = fmaf(bbr[4 * c4 + jj], ux[jj], bur); bui = fmaf(bbi[4 * c4 + jj], ux[jj], bui); } }
            const float nre = ar * hre - ai * him + bur, nim = ar * him + ai * hre + bui;
            hre = nre; him = nim;
            if (MODE != 0) {
                float v[16];
#pragma unroll
                for (int c = 0; c < 16; ++c) v[c] = Cr[c] * hre - Ci[c] * him;
                float w8[8], w4[4], w2[2], w1;
#pragma unroll
                for (int i = 0; i < 8; ++i) { const float mine = b5 ? v[8 + i] : v[i], oth = b5 ? v[i] : v[8 + i]; w8[i] = mine + __shfl_xor(oth, 32); }
#pragma unroll
                for (int i = 0; i < 4; ++i) { const float mine = b4 ? w8[4 + i] : w8[i], oth = b4 ? w8[i] : w8[4 + i]; w4[i] = mine + __shfl_xor(oth, 16); }
#pragma unroll
                for (int i = 0; i < 2; ++i) { const float mine = b3 ? w4[2 + i] : w4[i], oth = b3 ? w4[i] : w4[2 + i]; w2[i] = mine + __shfl_xor(oth, 8); }
                { const float mine = b2 ? w2[1] : w2[0], oth = b2 ? w2[0] : w2[1]; w1 = mine + __shfl_xor(oth, 4); }
                w1 += __shfl_xor(w1, 2); w1 += __shfl_xor(w1, 1);
                if (MODE == 1) { if ((lane & 3) == 0) yf[ti * 16 + ch] = w1; }
                if (MODE == 2) {
                    const float uch = __shfl(uf, ch);
                    if ((lane & 3) == 0) { const float y = w1 + yf[ti * 16 + ch] + dv * uch; Z[(size_t)(row0 + ti) * 256 + g * 16 + ch] = (bf16)f2bf(gelu_tanh(y)); }
                }
            }
        }
#pragma unroll
        for (int u = 0; u < 4; ++u) { rn0[u] = rn1[u]; rn1[u] = rn2[u]; rn2[u] = rn3[u]; }
    }
}

__device__ __forceinline__ MixP make_mixp(const Frame& F, const Args& a, int l) {
    MixP mp; mp.P = (const bf16*)(F.ws + WS_PH); mp.lb = (const float*)(F.ws + WS_LB) + l * 256; mp.rcos = (const float*)(F.ws + WS_ROPE); mp.rsin = mp.rcos + 2048;
    mp.ba = a.in[F.zz + I_BA] + (size_t)l * 2 * 128; return mp;
}
__device__ __forceinline__ S5P make_s5p(const Frame& F, const Args& a, int l) {
    S5P sp; sp.lam_re = a.in[F.zz + I_LAMRE] + (size_t)l * 2048; sp.lam_im = a.in[F.zz + I_LAMIM] + (size_t)l * 2048; sp.log_dt = a.in[F.zz + I_LOGDT] + l * 32;
    sp.b_re = a.in[F.zz + I_BRE] + (size_t)l * 32768; sp.b_im = a.in[F.zz + I_BIM] + (size_t)l * 32768; sp.c_re = a.in[F.zz + I_CRE] + (size_t)l * 32768; sp.c_im = a.in[F.zz + I_CIM] + (size_t)l * 32768;
    sp.dd = a.in[F.zz + I_S5D] + l * 256; return sp;
}


typedef short bf16x8_t __attribute__((ext_vector_type(8)));
typedef float f32x16 __attribute__((ext_vector_type(16)));
typedef float f32x2_t __attribute__((ext_vector_type(2)));
typedef __bf16 bf16x2_n __attribute__((ext_vector_type(2)));
__device__ __forceinline__ unsigned pkbf(float lo, float hi) { const f32x2_t v = {lo, hi}; const bf16x2_n r = __builtin_convertvector(v, bf16x2_n); return __builtin_bit_cast(unsigned, r); }
constexpr int WL_QC = 0, WL_KC = 4608, WL_KT = 9216, WL_VT = 14336, WL_PL = 19456, WL_BYTES = 19712;

struct MxC { float gamma, lbv, oml, bav, rc1, rs1; unsigned cq, ck, cv, cz; };
template <int MIX>
__device__ __forceinline__ void mx_consts(MxC& c, const MixP& mp, int h, int dir, int lane) {
    c.gamma = 1.f; c.lbv = 0.f; c.oml = 1.f; c.bav = 0.f; c.cz = 0; c.rc1 = 1.f; c.rs1 = 0.f;
    if (MIX == 0) { c.cq = 8u * (unsigned)(C_RQ + h * 64 + lane); c.ck = 8u * (unsigned)(C_RK + h * 64 + lane); c.cv = 8u * (unsigned)(C_RV + h * 64 + lane); c.gamma = 1.0f - exp2f(-5.0f - (float)(dir ? 3 - h : h));
        if (lane & 32) { const unsigned r1 = 4u * (unsigned)(16 + (lane & 15)); c.rc1 = GLD(float, mp.rcos, r1); const float s1 = GLD(float, mp.rsin, r1); c.rs1 = dir ? -s1 : s1; } }
    else if (MIX == 1) { c.cq = 8u * (unsigned)(C_HQ + h * 64 + lane); c.ck = 8u * (unsigned)((dir ? C_HFB : C_HFF) + h * 64 + lane); c.cv = 8u * (unsigned)(C_HI + h * 64 + lane); c.lbv = mp.lb[h * 64 + lane]; c.oml = 1.0f - c.lbv; }
    else { c.cq = 8u * (unsigned)(C_GQ + h * 32 + (lane & 31)); c.ck = 8u * (unsigned)(C_GK + h * 32 + (lane & 31)); c.cv = 8u * (unsigned)(C_GV + h * 64 + lane); c.cz = 8u * (unsigned)((dir ? C_GZB : C_GZF) + h * 32 + (lane & 31));
        c.bav = mp.ba[dir * 128 + h * 32 + (lane & 31)]; }
}
struct MxRaw { v2u q, k, v, z; };
template <int MIX, bool NEEDQ, int DIR>
__device__ __forceinline__ void mx_load(MxRaw& w, const MixP& mp, const MxC& c, int rows, int b) {
    const bf16* pr = mp.P + (size_t)((rows >> 2) + (DIR ? 15 - b : b)) * P4G;
    const v2u zero = {0u, 0u};
    w.q = NEEDQ ? GLD(v2u, pr, c.cq) : zero; w.k = GLD(v2u, pr, c.ck); w.v = GLD(v2u, pr, c.cv); w.z = (MIX == 2) ? GLD(v2u, pr, c.cz) : zero;
}
__device__ __forceinline__ float bfx(const v2u& w, int i) { const unsigned d = (i >> 1) ? w.y : w.x; return __builtin_bit_cast(float, (i & 1) ? (d & 0xffff0000u) : (d << 16)); }
template <int MIX, bool NEEDQ, int DIR>
__device__ __forceinline__ void mx_batch(const MxRaw& cur, const MixP& mp, const MxC& c, int tposs  , int lane, LAS unsigned char* wl, int b, float& P, float& rc, float& rs) {
    constexpr int DK = (MIX == 2) ? 32 : 64;
    float kt[4];
#pragma unroll
    for (int u = 0; u < 4; ++u) {
        const int cc = b * 4 + u, ts = DIR ? 63 - cc : cc, t = ts & 31;
        const int pu = DIR ? 3 - u : u; float q = bfx(cur.q, pu), k, f;
        if (MIX == 0) {
            k = bfx(cur.k, pu) * 0.125f; f = c.gamma;
            if (tposs >= 0) { const float cs = rc, sn = rs;
                rc = cs * c.rc1 - sn * c.rs1; rs = sn * c.rc1 + cs * c.rs1;
                const float ss = (lane & 16) ? sn : -sn;
                const float kp = __shfl_xor(k, 16); k = fmaf(kp, ss, k * cs);
                if (NEEDQ) { const float qp = __shfl_xor(q, 16); q = fmaf(qp, ss, q * cs); } }
        } else if (MIX == 1) {
            const float z = bfx(cur.k, pu); const float e = __expf(-z); const float sp = __builtin_amdgcn_rcpf(1.0f + e), sn = e * sp;
            f = fmaf(c.oml, sp, c.lbv); k = c.oml * sn;
        } else {
            k = bfx(cur.k, pu) * 0.17677669529663687f; const float z = bfx(cur.z, pu) + c.bav;
            const float ls = fminf(z, 0.f) - __logf(1.0f + __expf(-fabsf(z)));
            f = __expf(ls * 0.0625f);
        }
        P = fmaxf(P * f, 1e-30f);
        const float kk = k * __builtin_amdgcn_rcpf(P); kt[DIR ? 3 - u : u] = kk;
        if (lane < DK) {
            const unsigned qk = pkbf(q * P, kk);
            if (NEEDQ) *(LAS unsigned short*)(wl + WL_QC + t * 144 + lane * 2) = (unsigned short)qk;
            *(LAS unsigned short*)(wl + WL_KC + t * 144 + lane * 2) = (unsigned short)(qk >> 16);
        }
    }
    const int g4 = ((DIR ? 63 - b * 4 : b * 4) & 31) >> 2;
    v2u kp; kp.x = pkbf(kt[0], kt[1]); kp.y = pkbf(kt[2], kt[3]);
    if (lane < DK) *(LAS v2u*)(wl + WL_KT + lane * 80 + g4 * 8) = kp;
    *(LAS v2u*)(wl + WL_VT + lane * 80 + g4 * 8) = cur.v;
}
typedef short bf16x4_t __attribute__((ext_vector_type(4)));
#define MFMA8(a, b, c) __builtin_amdgcn_mfma_f32_32x32x8bf16_1k((a), (b), (c), 0, 0, 0)
__device__ __forceinline__ bf16x4_t pack4(const f32x16& x, int s) {
    v2u p; p.x = pkbf(x[4 * s], x[4 * s + 1]); p.y = pkbf(x[4 * s + 2], x[4 * s + 3]);
    return __builtin_bit_cast(bf16x4_t, p);
}
__device__ __forceinline__ bf16x4_t ld4(const LAS unsigned char* p) { const v2u a = *(const LAS v2u*)p; return __builtin_bit_cast(bf16x4_t, a); }

template <int MODE, int DIR>
__device__ __forceinline__ void s5_mm_dir(const S5P& sp, const bf16* P, int b, int g, int sg, int lane, float& hre, float& him, LAS float* yf, LAS unsigned char* hs, bf16* Z) {
    const int m32 = lane & 31, hh = lane >> 5, dg = DIR * 16 + g, row0 = seg_row0(b, sg);
    float ar[2], ai[2], a2r[2], a2i[2], a3r[2], a3i[2], a4r[2], a4i[2];
    bf16x4_t bfr[4][2];
    const float dt = __expf(sp.log_dt[dg]);
#pragma unroll
    for (int sh = 0; sh < 2; ++sh) {
        const int p = 32 * sh + m32;
        const float lre = sp.lam_re[dg * 64 + p], lim = sp.lam_im[dg * 64 + p];
        const float er = __expf(lre * dt), sn = sinf(lim * dt), cs = cosf(lim * dt);
        ar[sh] = er * cs; ai[sh] = er * sn;
        a2r[sh] = ar[sh] * ar[sh] - ai[sh] * ai[sh]; a2i[sh] = ar[sh] * ai[sh] + ar[sh] * ai[sh];
        a3r[sh] = a2r[sh] * ar[sh] - a2i[sh] * ai[sh]; a3i[sh] = a2r[sh] * ai[sh] + a2i[sh] * ar[sh];
        a4r[sh] = a2r[sh] * a2r[sh] - a2i[sh] * a2i[sh]; a4i[sh] = a2r[sh] * a2i[sh] + a2r[sh] * a2i[sh];
        const float nr = ar[sh] - 1.0f, ni = ai[sh], den = 1.0f / (lre * lre + lim * lim);
        const float cr = (nr * lre + ni * lim) * den, ci = (ni * lre - nr * lim) * den;
#pragma unroll
        for (int s2 = 0; s2 < 2; ++s2) {
            const f32x4 Br = *(const f32x4*)(sp.b_re + ((size_t)dg * 64 + p) * 16 + 8 * s2 + 4 * hh), Bi = *(const f32x4*)(sp.b_im + ((size_t)dg * 64 + p) * 16 + 8 * s2 + 4 * hh);
            const f32x4 re = Br * cr - Bi * ci, im = Bi * cr + Br * ci;
            v2u pr, pi; pr.x = pkbf(re[0], re[1]); pr.y = pkbf(re[2], re[3]); pi.x = pkbf(im[0], im[1]); pi.y = pkbf(im[2], im[3]);
            bfr[sh][s2] = __builtin_bit_cast(bf16x4_t, pr); bfr[2 + sh][s2] = __builtin_bit_cast(bf16x4_t, pi);
        }
    }
    bf16x4_t cfr[16];
    if (MODE != 0) {
#pragma unroll
        for (int s = 0; s < 16; ++s) {
            const int p4 = (8 * s + 4 * hh) & 63; f32x4 cv = {0.f, 0.f, 0.f, 0.f};
            if (m32 < 16) cv = (s < 8) ? *(const f32x4*)(sp.c_re + ((size_t)dg * 16 + m32) * 64 + p4) : -*(const f32x4*)(sp.c_im + ((size_t)dg * 16 + m32) * 64 + p4);
            v2u pc; pc.x = pkbf(cv[0], cv[1]); pc.y = pkbf(cv[2], cv[3]); cfr[s] = __builtin_bit_cast(bf16x4_t, pc);
        }
    }
    const float ddv = (MODE == 2 && m32 < 16) ? sp.dd[g * 16 + m32] : 0.f;
    float hr[2], hi[2];
    hr[0] = __shfl(hre, m32); hi[0] = __shfl(him, m32); hr[1] = __shfl(hre, m32 + 32); hi[1] = __shfl(him, m32 + 32);
#pragma unroll 1
    for (int ci2 = 0; ci2 < 2; ++ci2) {
        const int ch = DIR ? 1 - ci2 : ci2, rowc = row0 + 32 * ch;
        const bf16* urow = P + (size_t)((rowc + m32) >> 2) * P4G + P4S5 + (m32 & 3) * 256 + g * 16 + 4 * hh;
        const bf16x4_t ua0 = __builtin_bit_cast(bf16x4_t, *(const v2u*)urow), ua1 = __builtin_bit_cast(bf16x4_t, *(const v2u*)(urow + 8));
        f32x16 BU[4];
#pragma unroll
        for (int nt = 0; nt < 4; ++nt) {
#pragma unroll
            for (int r = 0; r < 16; ++r) BU[nt][r] = 0.f;
            BU[nt] = MFMA8(ua0, bfr[nt][0], BU[nt]); BU[nt] = MFMA8(ua1, bfr[nt][1], BU[nt]);
        }
#pragma unroll
        for (int sh = 0; sh < 2; ++sh)
#pragma unroll
            for (int gg = 0; gg < 4; ++gg)
#pragma unroll
                for (int jj = 1; jj < 4; ++jj) {
                    const int r = DIR ? 4 * gg + 3 - jj : 4 * gg + jj, rp = DIR ? r + 1 : r - 1;
                    const float pr = BU[sh][rp], pi = BU[2 + sh][rp];
                    BU[sh][r] += ar[sh] * pr - ai[sh] * pi; BU[2 + sh][r] += ar[sh] * pi + ai[sh] * pr;
                }
        float hnr[2][4], hni[2][4];
#pragma unroll
        for (int st = 0; st < 8; ++st) {
            const int gg = DIR ? 3 - (st >> 1) : (st >> 1), turn = DIR ? 1 - (st & 1) : (st & 1), rl = DIR ? 4 * gg : 4 * gg + 3;
            const bool act = (hh == turn);
#pragma unroll
            for (int sh = 0; sh < 2; ++sh) {
                if (turn == (DIR ? 1 : 0)) { hnr[sh][gg] = hr[sh]; hni[sh][gg] = hi[sh]; }
                else { hnr[sh][gg] = act ? hr[sh] : hnr[sh][gg]; hni[sh][gg] = act ? hi[sh] : hni[sh][gg]; }
                const float outr = BU[sh][rl] + a4r[sh] * hr[sh] - a4i[sh] * hi[sh], outi = BU[2 + sh][rl] + a4r[sh] * hi[sh] + a4i[sh] * hr[sh];
                const float sr = __shfl_xor(outr, 32), si = __shfl_xor(outi, 32);
                hr[sh] = act ? outr : sr; hi[sh] = act ? outi : si;
            }
        }
        if (MODE != 0) {
#pragma unroll
            for (int sh = 0; sh < 2; ++sh)
#pragma unroll
                for (int gg = 0; gg < 4; ++gg)
#pragma unroll
                    for (int jj = 0; jj < 4; ++jj) {
                        const int pw = DIR ? 4 - jj : jj + 1;
                        const float pr = (pw == 1) ? ar[sh] : (pw == 2) ? a2r[sh] : (pw == 3) ? a3r[sh] : a4r[sh], pi = (pw == 1) ? ai[sh] : (pw == 2) ? a2i[sh] : (pw == 3) ? a3i[sh] : a4i[sh];
                        BU[sh][4 * gg + jj] += pr * hnr[sh][gg] - pi * hni[sh][gg]; BU[2 + sh][4 * gg + jj] += pr * hni[sh][gg] + pi * hnr[sh][gg];
                    }
#pragma unroll
            for (int nt = 0; nt < 4; ++nt)
#pragma unroll
                for (int r = 0; r < 16; ++r) *(LAS unsigned short*)(hs + ((r & 3) + 8 * (r >> 2) + 4 * hh) * 272 + (32 * nt + m32) * 2) = (unsigned short)pkbf(BU[nt][r], BU[nt][r]);
            f32x16 Yv;
#pragma unroll
            for (int r = 0; r < 16; ++r) Yv[r] = 0.f;
#pragma unroll
            for (int s = 0; s < 16; ++s) Yv = MFMA8(ld4(hs + m32 * 272 + (8 * s + 4 * hh) * 2), cfr[s], Yv);
            if (m32 < 16) {
#pragma unroll
                for (int r = 0; r < 16; ++r) {
                    const int tl = (r & 3) + 8 * (r >> 2) + 4 * hh;
                    if (MODE == 1) yf[(32 * ch + tl) * 16 + m32] = Yv[r];
                    else { const float u = bf2f(P[(size_t)((rowc + tl) >> 2) * P4G + P4S5 + (tl & 3) * 256 + g * 16 + m32]);
                        const float y = Yv[r] + yf[(32 * ch + tl) * 16 + m32] + ddv * u;
                        const float zz = gelu_tanh(y); Z[(size_t)(rowc + tl) * 256 + g * 16 + m32] = (bf16)pkbf(zz, zz); }
                }
            }
        }
    }
    hre = hh ? hr[1] : hr[0]; him = hh ? hi[1] : hi[0];
}
template <int MODE>
__device__ __forceinline__ void s5_mm(const S5P& sp, const bf16* P, int b, int g, int dir, int sg, int lane, float& hre, float& him, LAS float* yf, LAS unsigned char* hs, bf16* Z) {
    if (dir) s5_mm_dir<MODE, 1>(sp, P, b, g, sg, lane, hre, him, yf, hs, Z); else s5_mm_dir<MODE, 0>(sp, P, b, g, sg, lane, hre, him, yf, hs, Z);
}
template <int MIX, int DIR, bool WITH_O>
__device__ __forceinline__ void mx_chunk(LAS unsigned char* wl, int lane, float Pl, f32x16 (&ST)[(MIX == 2) ? 1 : 2][2], f32x16 (&O)[2]) {
    constexpr int DK = (MIX == 2) ? 32 : 64, NRT = DK / 32;
    const int m32 = lane & 31, hh = lane >> 5;
    asm volatile("" ::: "memory");
    if (lane < DK) *(LAS float*)(wl + WL_PL + lane * 4) = Pl;
    asm volatile("" ::: "memory");
    if (WITH_O) {
        f32x16 x;
#pragma unroll
        for (int r = 0; r < 16; ++r) x[r] = 0.f;
#pragma unroll
        for (int s = 0; s < DK / 8; ++s) {
            const bf16x4_t ka = ld4(wl + WL_KC + m32 * 144 + (8 * s + 4 * hh) * 2);
            const bf16x4_t qb = ld4(wl + WL_QC + m32 * 144 + (8 * s + 4 * hh) * 2);
            x = MFMA8(ka, qb, x);
        }
#pragma unroll
        for (int r = 0; r < 16; ++r) { const int j = (r & 3) + 8 * (r >> 2) + 4 * hh; const bool keep = DIR ? (j >= m32) : (j <= m32); x[r] = keep ? x[r] : 0.f; }
#pragma unroll
        for (int t = 0; t < 2; ++t)
#pragma unroll
            for (int r = 0; r < 16; ++r) O[t][r] = 0.f;
#pragma unroll
        for (int s = 0; s < 4; ++s) {
            const bf16x4_t xa = pack4(x, s);
#pragma unroll
            for (int t = 0; t < 2; ++t) O[t] = MFMA8(ld4(wl + WL_VT + (32 * t + m32) * 80 + (8 * s + 4 * hh) * 2), xa, O[t]);
        }
#pragma unroll
        for (int rt = 0; rt < NRT; ++rt)
#pragma unroll
            for (int s = 0; s < 4; ++s) {
                const bf16x4_t qa = ld4(wl + WL_QC + m32 * 144 + (32 * rt + 8 * s + 4 * hh) * 2);
#pragma unroll
                for (int t = 0; t < 2; ++t) O[t] = MFMA8(pack4(ST[rt][t], s), qa, O[t]);
            }
    }
#pragma unroll
    for (int rt = 0; rt < NRT; ++rt)
#pragma unroll
        for (int s = 0; s < 4; ++s) {
            const bf16x4_t ka = ld4(wl + WL_KT + (32 * rt + m32) * 80 + (8 * s + 4 * hh) * 2);
#pragma unroll
            for (int t = 0; t < 2; ++t) ST[rt][t] = MFMA8(ka, ld4(wl + WL_VT + (32 * t + m32) * 80 + (8 * s + 4 * hh) * 2), ST[rt][t]);
        }
#pragma unroll
    for (int rt = 0; rt < NRT; ++rt)
#pragma unroll
        for (int g = 0; g < 4; ++g) {
            const f32x4 pl4 = *(const LAS f32x4*)(wl + WL_PL + (32 * rt + 8 * g + 4 * hh) * 4);
#pragma unroll
            for (int e = 0; e < 4; ++e) { ST[rt][0][4 * g + e] *= pl4[e]; ST[rt][1][4 * g + e] *= pl4[e]; }
        }
}
__device__ __forceinline__ float half_sum(float v) {
#pragma unroll
    for (int o = 1; o < 32; o <<= 1) v += __shfl_xor(v, o);
    return v;
}
template <int MIX, int DIR>
__device__ __forceinline__ void mixA_stream(const MixP& mp, const MxC& c, int row0, int tpos0, int lane, LAS unsigned char* wl, f32x16 (&ST)[(MIX == 2) ? 1 : 2][2], float& Gam) {
    f32x16 O[2];
    MxRaw r[8];
#pragma unroll
    for (int i = 0; i < 8; ++i) mx_load<MIX, false, DIR>(r[i], mp, c, row0, i);
    float rc = 1.0f, rs = 0.0f;
    if (MIX == 0 && tpos0 >= 0) { const int tpos = tpos0 + (DIR ? 63 : 0); const int pos = (lane & 32) ? (tpos & 63) : (tpos >> 6);
        const unsigned ro = 4u * (unsigned)(pos * 16 + (lane & 15)); rc = GLD(float, mp.rcos, ro); rs = GLD(float, mp.rsin, ro); }
    float P = 1.0f;
#pragma unroll 1
    for (int ck = 0; ck < 2; ++ck) {
        int ln = lane; asm volatile("" : "+v"(ln));
#pragma unroll
        for (int j = 0; j < 8; ++j) {
            mx_batch<MIX, false, DIR>(r[j], mp, c, tpos0, ln, wl, j, P, rc, rs);
            if (ck == 0) mx_load<MIX, false, DIR>(r[j], mp, c, row0, 8 + j);
        }
        Gam *= P; mx_chunk<MIX, 0, false>(wl, ln, P, ST, O); P = 1.0f;
    }
}
template <int MIX>
__device__ __forceinline__ void mixA_unit(const MixP& mp, float* STG, int idx, int lane_in, LAS unsigned char* wl) {
    int lane = lane_in;
    constexpr int DK = (MIX == 2) ? 32 : 64, NRT = DK / 32;
    const int dir = idx / 2112, rem = idx - dir * 2112, bh = rem / NSEG, sg = rem - bh * NSEG, b = bh >> 2, h = bh & 3;
    asm volatile("" : "+v"(lane));
    MxC c; mx_consts<MIX>(c, mp, h, dir, lane);
    f32x16 ST[NRT][2];
#pragma unroll
    for (int rt = 0; rt < NRT; ++rt)
#pragma unroll
        for (int t = 0; t < 2; ++t)
#pragma unroll
            for (int r = 0; r < 16; ++r) ST[rt][t][r] = 0.f;
    const int row0 = seg_row0(b, sg), tpos0 = seg_tpos0(sg);
    float Gam = 1.0f;
    if (dir) mixA_stream<MIX, 1>(mp, c, row0, tpos0, lane, wl, ST, Gam); else mixA_stream<MIX, 0>(mp, c, row0, tpos0, lane, wl, ST, Gam);
    const size_t slot = (size_t)((dir * 16 + bh) * NSEG + sg);
    bf16* ds = (bf16*)(STG + (MIX == 0 ? ST_DS0 : (MIX == 1 ? ST_DS1 : ST_DS2))) + slot * (DK * 64);
    const int m32 = lane & 31, hh = lane >> 5;
#pragma unroll
    for (int rt = 0; rt < NRT; ++rt)
#pragma unroll
        for (int t = 0; t < 2; ++t)
#pragma unroll
            for (int r4 = 0; r4 < 4; ++r4) { v2u v; v.x = pkbf(ST[rt][t][4 * r4], ST[rt][t][4 * r4 + 1]); v.y = pkbf(ST[rt][t][4 * r4 + 2], ST[rt][t][4 * r4 + 3]);
                GST(v2u, ds + ((rt * 2 + t) * 4 + r4) * 256, 8u * (unsigned)lane) = v; }
    float* gs = STG + (MIX == 0 ? ST_G0 : (MIX == 1 ? ST_G1 : ST_G2)) + slot * 64;
    GST(float, gs, 4u * (unsigned)lane) = Gam;
}
__device__ __forceinline__ void mx_epi_loads(const MixP& mp, int lane, int rowc, const float* OFc, int gcol, v2u (&g)[2][4], f32x4 (&of)[2][4]) {
    const int m32 = lane & 31, hh = lane >> 5;
    const bf16* gb = mp.P + (size_t)(rowc >> 2) * P4G + gcol;
    const unsigned gvo = 2u * (unsigned)((m32 >> 2) * P4G + (m32 & 3) * 256 + 4 * hh);
#pragma unroll
    for (int t = 0; t < 2; ++t)
#pragma unroll
        for (int s = 0; s < 4; ++s) { g[t][s] = GLD(v2u, gb + 32 * t + 8 * s, gvo); of[t][s] = GLD(f32x4, OFc + (t * 4 + s) * 256, 16u * (unsigned)lane); }
}
template <int MIX, int MODE>
__device__ __forceinline__ void mx_epilogue(const MixP& mp, LAS unsigned char* wl, int lane, f32x16 (&O)[2], int rowc, float* OFc, bf16* Y, int ycol, const v2u (&g)[2][4], const f32x4 (&of)[2][4]) {
    const int m32 = lane & 31, hh = lane >> 5;
    if (MODE == 1) {
#pragma unroll
        for (int t = 0; t < 2; ++t)
#pragma unroll
            for (int s = 0; s < 4; ++s) { const f32x4 v = {O[t][4 * s], O[t][4 * s + 1], O[t][4 * s + 2], O[t][4 * s + 3]}; GST(f32x4, OFc + (t * 4 + s) * 256, 16u * (unsigned)lane) = v; }
    } else {
#pragma unroll
        for (int t = 0; t < 2; ++t)
#pragma unroll
            for (int s = 0; s < 4; ++s)
#pragma unroll
                for (int j = 0; j < 4; ++j) O[t][4 * s + j] += of[t][s][j];
        float mean = 0.f;
        if (MIX == 0) { float sm = 0.f;
#pragma unroll
            for (int t = 0; t < 2; ++t)
#pragma unroll
                for (int r = 0; r < 16; ++r) sm += O[t][r];
            sm += __shfl_xor(sm, 32); mean = sm * (1.0f / 64.0f); }
        float ss = 0.f;
#pragma unroll
        for (int t = 0; t < 2; ++t)
#pragma unroll
            for (int r = 0; r < 16; ++r) { const float d = O[t][r] - mean; ss = fmaf(d, d, ss); }
        ss += __shfl_xor(ss, 32);
        const float rs = __builtin_amdgcn_rsqf(ss * (1.0f / 64.0f) + NEPS), mo = -mean * rs;
        asm volatile("" ::: "memory");
#pragma unroll
        for (int t = 0; t < 2; ++t)
#pragma unroll
            for (int s = 0; s < 4; ++s) { float y[4];
#pragma unroll
                for (int j = 0; j < 4; ++j) y[j] = fmaf(O[t][4 * s + j], rs, mo) * silu_f(bfx(g[t][s], j));
                v2u w; w.x = pkbf(y[0], y[1]); w.y = pkbf(y[2], y[3]);
                *(LAS v2u*)(wl + WL_QC + m32 * 144 + (32 * t + 8 * s + 4 * hh) * 2) = w; }
        asm volatile("" ::: "memory");
#pragma unroll
        for (int k = 0; k < 4; ++k) { const v4u w = *(const LAS v4u*)(wl + WL_QC + ((lane >> 3) + 8 * k) * 144 + (lane & 7) * 16);
            GST(v4u, Y + (size_t)(rowc + 8 * k) * 1024 + ycol, 2u * (unsigned)((lane >> 3) * 1024 + (lane & 7) * 8)) = w; }
        asm volatile("" ::: "memory");
    }
}
template <int MIX, int DIR>
__device__ __forceinline__ void mixC_stream(const MixP& mp, const MxC& c, int row0, int tpos0, int lane, LAS unsigned char* wl, f32x16 (&ST)[(MIX == 2) ? 1 : 2][2],
                                            float* OFu, bf16* Y, int ycol, int gcol) {
    f32x16 O[2];
    MxRaw r[4];
#pragma unroll
    for (int i = 0; i < 3; ++i) mx_load<MIX, true, DIR>(r[i], mp, c, row0, i);
    float rc = 1.0f, rs = 0.0f;
    if (MIX == 0 && tpos0 >= 0) { const int tpos = tpos0 + (DIR ? 63 : 0); const int pos = (lane & 32) ? (tpos & 63) : (tpos >> 6);
        const unsigned ro = 4u * (unsigned)(pos * 16 + (lane & 15)); rc = GLD(float, mp.rcos, ro); rs = GLD(float, mp.rsin, ro); }
    float P = 1.0f;
#pragma unroll 1
    for (int b4 = 0; b4 < 16; b4 += 4) {
        int ln = lane; asm volatile("" : "+v"(ln));
#pragma unroll
        for (int j = 0; j < 4; ++j) {
            if (b4 < 12 || j == 0) mx_load<MIX, true, DIR>(r[(j + 3) & 3], mp, c, row0, b4 + j + 3);
            mx_batch<MIX, true, DIR>(r[j], mp, c, tpos0, ln, wl, (b4 & 4) + j, P, rc, rs);
        }
        if (b4 & 4) {
            const int ck = b4 >> 3, ch = DIR ? 1 - ck : ck; float* OFc = OFu + (size_t)ch * (12 * 2048);
            v2u g[2][4]; f32x4 of[2][4];
            mx_chunk<MIX, DIR, true>(wl, ln, P, ST, O); P = 1.0f;
            if (DIR) mx_epi_loads(mp, ln, row0 + 32 * ch, OFc, gcol, g, of);
            mx_epilogue<MIX, DIR ? 2 : 1>(mp, wl, ln, O, row0 + 32 * ch, OFc, Y, ycol, g, of);
        }
    }
}
template <int MIX>
__device__ __forceinline__ void mixC_unit(const MixP& mp, const float* STG, int idx, int lane_in, float* OF, LAS unsigned char* wl, bf16* Y) {
    int lane = lane_in; asm volatile("" : "+v"(lane));
    constexpr int DK = (MIX == 2) ? 32 : 64, NRT = DK / 32;
    const int bh = idx / NSEG, sg = idx - bh * NSEG, b = bh >> 2, h = bh & 3;
    const int row0 = seg_row0(b, sg), tpos0 = seg_tpos0(sg);
    const int ycol = ((MIX == 0) ? 0 : (MIX == 1 ? 512 : 768)) + h * 64;
    const int gcol = 4 * ((MIX == 0) ? C_RG : (MIX == 1 ? C_HG : C_GG)) + h * 64;
    float* OFu = OF + ((size_t)(row0 >> 5) * 12 + MIX * 4 + h) * 2048;
    const bf16* dsb = (const bf16*)(STG + (MIX == 0 ? ST_DS0 : (MIX == 1 ? ST_DS1 : ST_DS2)));
    f32x16 ST[NRT][2];
#pragma unroll 1
    for (int dir = 0; dir < 2; ++dir) {
        asm volatile("" : "+v"(lane));
        const int m32 = lane & 31, hh = lane >> 5;
        MxC c; mx_consts<MIX>(c, mp, h, dir, lane);
        { const bf16* ds = dsb + (size_t)((dir * 16 + bh) * NSEG + sg) * (DK * 64);
#pragma unroll
          for (int rt = 0; rt < NRT; ++rt)
#pragma unroll
              for (int t = 0; t < 2; ++t)
#pragma unroll
                  for (int r4 = 0; r4 < 4; ++r4) { const v2u v = GLD(v2u, ds + ((rt * 2 + t) * 4 + r4) * 256, 8u * (unsigned)lane);
                      ST[rt][t][4 * r4] = bfx(v, 0); ST[rt][t][4 * r4 + 1] = bfx(v, 1); ST[rt][t][4 * r4 + 2] = bfx(v, 2); ST[rt][t][4 * r4 + 3] = bfx(v, 3); } }
        if (dir == 0) mixC_stream<MIX, 0>(mp, c, row0, tpos0, lane, wl, ST, OFu, Y, ycol, gcol);
        else mixC_stream<MIX, 1>(mp, c, row0, tpos0, lane, wl, ST, OFu, Y, ycol, gcol);
        asm volatile("s_waitcnt vmcnt(0)" ::: "memory");
    }
}
template <int MSEL>
__device__ __forceinline__ void mix_passA(const Frame& F, const Args& a, int l) {
    const MixP mp = make_mixp(F, a, l); const S5P sp = make_s5p(F, a, l);
    float* ST = (float*)(F.ws + WS_X2);
    LAS unsigned char* wl = F.lds + F.wave * WL_BYTES; LAS float* stg = (LAS float*)wl;
    if (MSEL == 15) {
        constexpr int NMX = 3 * 4224, NS5 = 2 * 64 * NSEG;
        const int heavy = NMX - (NMX / F.NGW) * F.NGW, nlight = F.NGW - heavy;
        const int n_all = (NS5 - 4 * nlight) / F.NGW;
        for (int it = 0; ; ++it) {
            int u;
            const int nmine = NMX / F.NGW + (F.gw < heavy ? 1 : 0);
            if (it < nmine) u = F.gw + it * F.NGW;
            else if (it < nmine + n_all) u = NMX + F.gw + (it - nmine) * F.NGW;
            else { const int k2 = it - nmine - n_all; if (F.gw < heavy || k2 >= 4) {
                    const int rest0 = NMX + n_all * F.NGW + 4 * nlight; const int uu = rest0 + F.gw + (k2 - (F.gw < heavy ? 0 : 4)) * F.NGW; if (uu >= NMX + NS5) break; u = uu; }
                else u = NMX + n_all * F.NGW + (F.gw - heavy) + k2 * nlight; }
            if (u >= NMX + NS5) break;
            if (u < 4224) mixA_unit<0>(mp, ST, u, fresh_lane(), wl);
            else if (u < 2 * 4224) mixA_unit<1>(mp, ST, u - 4224, fresh_lane(), wl);
            else if (u < 3 * 4224) mixA_unit<2>(mp, ST, u - 2 * 4224, fresh_lane(), wl);
            else { const int idx = u - 3 * 4224; const int dir = idx / (64 * NSEG), rem = idx - dir * 64 * NSEG, bg = rem / NSEG, sg = rem - bg * NSEG;
                float hre = 0.f, him = 0.f;
                s5_mm<0>(sp, mp.P, bg >> 4, bg & 15, dir, sg, fresh_lane(), hre, him, nullptr, wl, nullptr);
                float* hs = ST + ST_HS + ((size_t)((dir * 64 + bg) * NSEG + sg) * 64 + fresh_lane()) * 2;
                hs[0] = hre; hs[1] = him; }
        }
        return;
    }
    if (MSEL & 1) for (int u = F.gw; u < 4224; u += F.NGW) mixA_unit<0>(mp, ST, u, fresh_lane(), wl);
    if (MSEL & 2) for (int u = F.gw; u < 4224; u += F.NGW) mixA_unit<1>(mp, ST, u, fresh_lane(), wl);
    if (MSEL & 4) for (int u = F.gw; u < 4224; u += F.NGW) mixA_unit<2>(mp, ST, u, fresh_lane(), wl);
    if (MSEL & 8) for (int idx = F.gw; idx < 2 * 64 * NSEG; idx += F.NGW) {
        const int dir = idx / (64 * NSEG), rem = idx - dir * 64 * NSEG, bg = rem / NSEG, sg = rem - bg * NSEG;
        float hre = 0.f, him = 0.f;
        s5_mm<0>(sp, mp.P, bg >> 4, bg & 15, dir, sg, fresh_lane(), hre, him, nullptr, wl, nullptr);
        float* hs = ST + ST_HS + ((size_t)((dir * 64 + bg) * NSEG + sg) * 64 + fresh_lane()) * 2;
        hs[0] = hre; hs[1] = him;
    }
}
__device__ __forceinline__ int chain_seg(int dir, int p) { return dir ? (p < 4 ? 3 - p : 135 - p) : p; }
__device__ __forceinline__ void mix_passB(const Frame& F, const Args& a, int l) {
    float* ST = (float*)(F.ws + WS_X2);
    constexpr int N0 = 32768, N1 = 32768, N2 = 16384, N3 = 8192;
    for (int e = blockIdx.x * 512 + F.tid; e < N0 + N1 + N2 + N3; e += F.G * 512) {
        if (e < N0 + N1 + N2) {
            bf16* base; const float* gb; int dir, esz;
            if (e < N0 + N1) { const int mix = e >= N0, e2 = e - mix * N0, c = e2 >> 10, el = (e2 & 1023) * 4; dir = c >> 4; esz = 4096;
                base = (bf16*)(ST + (mix ? ST_DS1 : ST_DS0)) + (size_t)c * NSEG * 4096 + el; gb = ST + (mix ? ST_G1 : ST_G0) + (size_t)c * NSEG * 64 + 32 * (el >> 11) + 8 * ((el >> 8) & 3) + 4 * ((el >> 7) & 1); }
            else { const int e2 = e - N0 - N1, c = e2 >> 9, el = (e2 & 511) * 4; dir = c >> 4; esz = 2048;
                base = (bf16*)(ST + ST_DS2) + (size_t)c * NSEG * 2048 + el; gb = ST + ST_G2 + (size_t)c * NSEG * 64 + 8 * ((el >> 8) & 3) + 4 * ((el >> 7) & 1); }
            f32x4 run = {0.f, 0.f, 0.f, 0.f};
#pragma unroll 1
            for (int p0 = 0; p0 < NSEG; p0 += 12) {
                f32x4 d[12], gm[12];
#pragma unroll
                for (int q = 0; q < 12; ++q) { const int sg = chain_seg(dir, p0 + q); const v2u w = *(const v2u*)(base + (size_t)sg * esz); d[q] = (f32x4){bfx(w, 0), bfx(w, 1), bfx(w, 2), bfx(w, 3)}; gm[q] = *(const f32x4*)(gb + sg * 64); }
#pragma unroll
                for (int q = 0; q < 12; ++q) { const int sg = chain_seg(dir, p0 + q); v2u w; w.x = pkbf(run[0], run[1]); w.y = pkbf(run[2], run[3]); *(v2u*)(base + (size_t)sg * esz) = w; run = run * gm[q] + d[q]; }
            }
        } else {
            const int e2 = e - N0 - N1 - N2, c = e2 >> 6, p = e2 & 63, dir = c >> 6, g = c & 15;
            const int dg = dir * 16 + g;
            const float lre = a.in[F.zz + I_LAMRE][(size_t)l * 2048 + dg * 64 + p], lim = a.in[F.zz + I_LAMIM][(size_t)l * 2048 + dg * 64 + p], dt = expf(a.in[F.zz + I_LOGDT][l * 32 + dg]);
            const float er = expf(lre * dt * 64.0f); const float sn = sinf(lim * dt * 64.0f), cs = cosf(lim * dt * 64.0f);
            const float ar = er * cs, ai = er * sn;
            float* base = ST + ST_HS + ((size_t)c * NSEG * 64 + p) * 2;
            float rr = 0.f, ri = 0.f;
#pragma unroll 1
            for (int q0 = 0; q0 < NSEG; q0 += 12) {
                float dr[12], di[12];
#pragma unroll
                for (int q = 0; q < 12; ++q) { const int sg = chain_seg(dir, q0 + q); dr[q] = base[(size_t)sg * 128]; di[q] = base[(size_t)sg * 128 + 1]; }
#pragma unroll
                for (int q = 0; q < 12; ++q) { const int sg = chain_seg(dir, q0 + q); base[(size_t)sg * 128] = rr; base[(size_t)sg * 128 + 1] = ri;
                    const float nr = ar * rr - ai * ri + dr[q], ni = ar * ri + ai * rr + di[q]; rr = nr; ri = ni; }
            }
        }
    }
}
template <int MSEL>
__device__ __forceinline__ void mix_passC(const Frame& F, const Args& a, int l) {
    const MixP mp = make_mixp(F, a, l); const S5P sp = make_s5p(F, a, l);
    const float* ST = (const float*)(F.ws + WS_X2);
    LAS unsigned char* wl = F.lds + F.wave * WL_BYTES;
    LAS float* stg = (LAS float*)wl; LAS float* of = (LAS float*)(wl + 9216);
    float* OF = (float*)(F.ws + WS_OF);
    bf16* Y = (bf16*)(F.ws + WS_ACT); bf16* Z = (bf16*)(F.ws + WS_Z);
    const bool keep = l < DEPTH - 1;
    constexpr int NM = 16 * NSEG;
    if (MSEL == 15) {
        constexpr int NMX = 3 * NM, NS5 = 64 * NSEG;
        const int heavy = NMX - (NMX / F.NGW) * F.NGW, nlight = F.NGW - heavy;
        for (int it = 0; ; ++it) {
            int u;
            const int nmine = NMX / F.NGW + (F.gw < heavy ? 1 : 0);
            if (it < nmine) u = F.gw + it * F.NGW;
            else { if (F.gw < heavy) break; u = NMX + (F.gw - heavy) + (it - nmine) * nlight; }
            if (u >= NMX + NS5) break;
            const int sgu = (u < 3 * NM) ? (u % NSEG) : ((u - 3 * NM) % NSEG);
            if (!keep && sgu < 4) continue;
            if (u < NM) mixC_unit<0>(mp, ST, u, fresh_lane(), OF, wl, Y);
            else if (u < 2 * NM) mixC_unit<1>(mp, ST, u - NM, fresh_lane(), OF, wl, Y);
            else if (u < 3 * NM) mixC_unit<2>(mp, ST, u - 2 * NM, fresh_lane(), OF, wl, Y);
            else { const int idx = u - 3 * NM, bg = idx / NSEG, sg = idx - bg * NSEG;
                const float* h0 = ST + ST_HS + ((size_t)((0 * 64 + bg) * NSEG + sg) * 64 + fresh_lane()) * 2;
                float hre = h0[0], him = h0[1];
                s5_mm<1>(sp, mp.P, bg >> 4, bg & 15, 0, sg, fresh_lane(), hre, him, of, wl, Z);
                const float* h1 = ST + ST_HS + ((size_t)((1 * 64 + bg) * NSEG + sg) * 64 + fresh_lane()) * 2;
                hre = h1[0]; him = h1[1];
                s5_mm<2>(sp, mp.P, bg >> 4, bg & 15, 1, sg, fresh_lane(), hre, him, of, wl, Z); }
        }
        return;
    }
    if (MSEL & 1) for (int u = F.gw; u < NM; u += F.NGW) { if (!keep && (u % NSEG) < 4) continue; mixC_unit<0>(mp, ST, u, fresh_lane(), OF, wl, Y); }
    if (MSEL & 2) for (int u = F.gw; u < NM; u += F.NGW) { if (!keep && (u % NSEG) < 4) continue; mixC_unit<1>(mp, ST, u, fresh_lane(), OF, wl, Y); }
    if (MSEL & 4) for (int u = F.gw; u < NM; u += F.NGW) { if (!keep && (u % NSEG) < 4) continue; mixC_unit<2>(mp, ST, u, fresh_lane(), OF, wl, Y); }
    if (MSEL & 8) for (int idx = F.gw; idx < 64 * NSEG; idx += F.NGW) {
        const int bg = idx / NSEG, sg = idx - bg * NSEG;
        if (!keep && sg < 4) continue;
        const float* h0 = ST + ST_HS + ((size_t)((0 * 64 + bg) * NSEG + sg) * 64 + fresh_lane()) * 2;
        float hre = h0[0], him = h0[1];
        s5_mm<1>(sp, mp.P, bg >> 4, bg & 15, 0, sg, fresh_lane(), hre, him, of, wl, Z);
        const float* h1 = ST + ST_HS + ((size_t)((1 * 64 + bg) * NSEG + sg) * 64 + fresh_lane()) * 2;
        hre = h1[0]; him = h1[1];
        s5_mm<2>(sp, mp.P, bg >> 4, bg & 15, 1, sg, fresh_lane(), hre, him, of, wl, Z);
    }
}

constexpr int NPH = 11;
template <int PH_MASK, int MSEL>
__global__ void __launch_bounds__(512, 2) mk_fwd(Args a) {
    extern __shared__ __attribute__((aligned(16))) unsigned char lds_raw[];
    Frame F;
    F.lds = (LAS unsigned char*)lds_raw;
    const int wave0 = __builtin_amdgcn_readfirstlane((int)threadIdx.x >> 6);
    F.lane = fresh_lane(); F.tid = wave0 * 64 + F.lane; F.wave = wave0;
    F.G = gridDim.x; F.gw = blockIdx.x * 8 + F.wave; F.NGW = F.G * 8; F.zz = 0; F.ws = (unsigned char*)a.in[I_WS]; F.out = (float*)a.in[I_OUT];
    volatile LAS unsigned* MISC = (volatile LAS unsigned*)(F.lds + MISC_OFF);
    for (int u = F.tid; u < 64; u += 512) ((LAS unsigned*)(F.lds + MISC_OFF))[u] = 0u;
    __syncthreads();
    XcdBarrier bar; bar.bar = (unsigned*)F.ws + CW_BAR; bar.x = 0; bar.st = nullptr;
    if (a.fused) bar = xcd_barrier_post((unsigned*)F.ws + CW_BAR, MISC + 8, F.tid);
#define SEAM() do { if (a.fused) { XcdBarrier bb = bar; asm volatile("" : "+s"(bb.bar), "+s"(bb.x)); xcd_barrier(bb, wave0 * 64 + fresh_lane()); } } while (0)
#define PHASE_BEGIN() do { int zz_ = 0; asm volatile("" : "+s"(zz_)); F.zz = zz_; F.ws = (unsigned char*)a.in[I_WS + zz_]; F.out = (float*)a.in[I_OUT + zz_]; \
        const int ln_ = fresh_lane(); const int t_ = wave0 * 64 + ln_ + zz_; F.tid = t_; F.lane = t_ & 63; F.wave = wave0 + zz_; F.G = (int)gridDim.x + zz_; F.gw = ((int)blockIdx.x + zz_) * 8 + F.wave; F.NGW = F.G * 8; \
        F.lds = (LAS unsigned char*)lds_raw + zz_; } while (0)
#define IN(k) (((PH_MASK >> (k)) & 1) && a.ph_lo <= (k) && (k) < a.ph_hi)
#ifndef DUP_PH
#define DUP_PH 0
#endif
#define REP(k) for (int rep_ = 0; rep_ < (((DUP_PH >> (k)) & 1) ? 2 : 1); ++rep_)
#define hb ((float*)(F.ws + WS_HB))
#define MOD ((const float*)(F.ws + WS_MOD))
#define ACT ((bf16*)(F.ws + WS_ACT))
#define PH ((bf16*)(F.ws + WS_PH))

    if (((PH_MASK >> 12) & 1) && a.do_pro) REP(12) { PHASE_BEGIN(); prologue(F, a); SEAM(); }

#pragma unroll
    for (int l = 0; l < DEPTH; ++l) {
        if (l < a.l_lo || l >= a.l_hi) continue;
        const bool keep = l < DEPTH - 1, moe = l & 1; const int j = l >> 1;
        const int Mrows = keep ? MT : NLAT;
        if (IN(0)) for (int rep_ = 0; rep_ < ((((DUP_PH >> 0) & 1) && l != 2) ? 2 : 1); ++rep_) { PHASE_BEGIN();
            norm_phase<0>(F, a, l, 0, MT, (l == 2) ? 1 : -1);
            SEAM();
        }
        if (IN(1)) REP(1) { PHASE_BEGIN();
            pg8::Gemm g{ACT, (const bf16*)(F.ws + WS_WIN) + (size_t)l * DINP * 1024, MT, DINP, 1024}; pg8::StaticOrder S; S.init(MT, DINP, F.G, (int)blockIdx.x);
            EpiStoreP4 E{PH};
            pg8::gemm_phase<EpiStoreP4, pg8::StaticOrder, true, true>(F.lds, g, S, E, F.tid);
            SEAM();
        }
        if (IN(2)) { PHASE_BEGIN(); mix_passA<MSEL>(F, a, l); SEAM(); }
#ifdef DUP_MIX
        if (IN(2)) { PHASE_BEGIN(); mix_passA<DUP_MIX>(F, a, l); SEAM(); }
#endif
#ifdef DUP_A
        if (IN(2)) { PHASE_BEGIN(); mix_passA<DUP_A>(F, a, l); SEAM(); }
#endif
        if (IN(3)) { PHASE_BEGIN(); mix_passB(F, a, l); SEAM(); }
        if (IN(4)) { PHASE_BEGIN(); mix_passC<MSEL>(F, a, l); SEAM(); }
#ifdef DUP_MIX
        if (IN(4)) { PHASE_BEGIN(); mix_passC<DUP_MIX>(F, a, l); SEAM(); }
#endif
#ifdef DUP_C
        if (IN(4)) { PHASE_BEGIN(); mix_passC<DUP_C>(F, a, l); SEAM(); }
#endif
        if (IN(5)) REP(5) { PHASE_BEGIN();
            int k256 = 256; asm volatile("" : "+s"(k256)); pg8::Gemm g{(const bf16*)(F.ws + WS_Z), (const bf16*)(F.ws + WS_GLUW) + (size_t)l * 65536, Mrows, 256, k256}; pg8::StaticOrder S; S.init(Mrows, 256, F.G, (int)blockIdx.x);
            EpiGlu E{(const bf16*)(F.ws + WS_Z), ACT, a.in[F.zz + I_GLUB] + l * 256};
            pg8::gemm_phase<EpiGlu, pg8::StaticOrder, true, true>(F.lds, g, S, E, F.tid);
            SEAM();
        }
        if (IN(6)) { PHASE_BEGIN();
            pg8::Gemm g{ACT, (const bf16*)(F.ws + WS_WOUT) + (size_t)l * 1024 * 1024, Mrows, 1024, 1024}; pg8::StaticOrder S; S.init(Mrows, 1024, F.G, (int)blockIdx.x);
            EpiResid E{(l == 0) ? a.in[F.zz + I_X] : F.out, (l == 0) ? a.in[F.zz + I_CTX] : hb, F.out, hb, MOD + (size_t)l * 5 * 6144 + 2 * 1024, 1.0f};
            pg8::gemm_phase<EpiResid, pg8::StaticOrder, true, true>(F.lds, g, S, E, F.tid);
            SEAM();
        }
        if (IN(7)) for (int rep_ = 0; rep_ < ((((DUP_PH >> 7) & 1) && !moe) ? 2 : 1); ++rep_) { PHASE_BEGIN();
            if (moe) norm_phase<1>(F, a, l, 1, Mrows, -1); else norm_phase<0>(F, a, l, 1, Mrows, -1);
            SEAM();
        }
        if (!moe) {
            if (IN(8)) REP(8) { PHASE_BEGIN();
                pg8::Gemm g{ACT, (const bf16*)(F.ws + WS_W13D) + (size_t)j * 5632 * 1024, Mrows, 5632, 1024}; pg8::StaticOrder S; S.init(Mrows, 5632, F.G, (int)blockIdx.x);
                EpiSwiglu8 E{(unsigned char*)PH, 1.0f};
                pg8::gemm_phase<EpiSwiglu8, pg8::StaticOrder, true, true>(F.lds, g, S, E, F.tid);
                SEAM();
            }
            if (IN(9)) { PHASE_BEGIN();
                int k8 = DFF / 2; asm volatile("" : "+s"(k8)); pg8::Gemm g{PH, (const bf16*)(F.ws + WS_W2D + (size_t)j * 1024 * DFF), Mrows, 1024, k8}; pg8::StaticOrder S; S.init(Mrows, 1024, F.G, (int)blockIdx.x);
                EpiResid E{F.out, hb, F.out, hb, MOD + (size_t)l * 5 * 6144 + 5 * 1024, 1.0f / WSC8};
                pg8::gemm_phase_f8<EpiResid, pg8::StaticOrder, true, true>(F.lds, g, S, E, F.tid);
                { const int rem = ((Mrows / 256) * 4) % F.G; if (rem > 0 && (int)blockIdx.x >= rem) moe_cvt_idle(F, a, j, rem); else if (rem == 0) moe_cvt(F, a, j); }
                SEAM();
            }
        } else {
                        if (IN(8)) REP(8) { PHASE_BEGIN(); moe_gather(F, j); SEAM(); }
            if (IN(9)) REP(9) { PHASE_BEGIN();
                int k8 = 512; asm volatile("" : "+s"(k8)); pg8::Gemm g{(const bf16*)(F.ws + WS_X2), (const bf16*)(F.ws + WS_W13M), 0, 5632, k8}; MoeOrder S; S.init((const unsigned*)F.ws + CW_CNT + j * 8 * 64, 22, F.G, (int)blockIdx.x);
                EpiSwiglu8 E{(unsigned char*)PH, 1.0f / WSC8};
                pg8::gemm_phase_f8<EpiSwiglu8, MoeOrder, true, true>(F.lds, g, S, E, F.tid);
                SEAM();
            }
            if (IN(10)) REP(10) { PHASE_BEGIN();
                int k8 = DFF / 2; asm volatile("" : "+s"(k8)); pg8::Gemm g{PH, (const bf16*)(F.ws + WS_W2M), 0, 1024, k8}; MoeOrder S; S.init((const unsigned*)F.ws + CW_CNT + j * 8 * 64, 4, F.G, (int)blockIdx.x);
                EpiStoreBf16 E{(bf16*)(F.ws + WS_X2), 1024, 1.0f / WSC8};
                pg8::gemm_phase_f8<EpiStoreBf16, MoeOrder, true, true>(F.lds, g, S, E, F.tid);
                SEAM();
            }
        }
    }
    if (((PH_MASK >> 13) & 1) && a.do_fin) { PHASE_BEGIN(); norm_phase<2>(F, a, DEPTH - 1, 0, NLAT, DEPTH - 1); }
#undef SEAM
#undef IN
#undef hb
#undef MOD
#undef ACT
#undef PH
}

#ifndef MK_FUSED
#define MK_FUSED 1
#endif
template <int PM, int MS> static void launch_one(const Args& a, int grid, hipStream_t stream) {
    static bool attr_done = false;
    if (!attr_done) { (void)hipFuncSetAttribute((const void*)mk_fwd<PM, MS>, hipFuncAttributeMaxDynamicSharedMemorySize, LDS_BYTES); attr_done = true; }
    hipLaunchKernelGGL((mk_fwd<PM, MS>), dim3(grid), dim3(512), LDS_BYTES, stream, a);
}
extern "C" void kernel_launch(void* const* d_in, const int* in_sizes, int n_in, void* d_out, int out_size, void* d_ws, size_t ws_size, hipStream_t stream) {
    static int grid = 0;
    if (grid == 0) {
        if (n_in != 35 || in_sizes[0] != NLAT * DM || out_size != NLAT * DM || ws_size < WS_END) {
            fprintf(stderr, "kernel_launch: unexpected shapes / workspace (n_in %d, ws %zu, need %zu); nothing launched\n", n_in, ws_size, (size_t)WS_END); grid = -1; return; }
        int dev = 0, cus = 0;
        if (hipGetDevice(&dev) != hipSuccess || hipDeviceGetAttribute(&cus, hipDeviceAttributeMultiprocessorCount, dev) != hipSuccess) { grid = -1; return; }
        grid = cus;
    }
    if (grid < 0) return;
    (void)hipMemsetAsync((char*)d_ws + WS_CTL, 0, CTL_ZERO_BYTES, stream);
    Args a{};
    for (int i = 0; i < 35; ++i) a.in[i] = (const float*)d_in[i];
    a.in[I_OUT] = (const float*)d_out; a.in[I_WS] = (const float*)d_ws; a.pad = 0;
#if MK_FUSED
    a.l_lo = 0; a.l_hi = DEPTH; a.ph_lo = 0; a.ph_hi = NPH; a.do_pro = 1; a.do_fin = 1; a.fused = 1;
#ifndef TEST_PM
#define TEST_PM 0xFFFF
#endif
#ifndef TEST_MS
#define TEST_MS 15
#endif
    launch_one<TEST_PM, TEST_MS>(a, grid, stream);
#else
    a.fused = 0;
    a.l_lo = 0; a.l_hi = 0; a.ph_lo = 0; a.ph_hi = 0; a.do_pro = 1; a.do_fin = 0;
    launch_one<0x1000, 15>(a, grid, stream);
    a.do_pro = 0;
    for (int l = 0; l < DEPTH; ++l) {
        a.l_lo = l; a.l_hi = l + 1; a.ph_lo = 0; a.ph_hi = NPH;
        launch_one<0x1, 15>(a, grid, stream); launch_one<0x2, 15>(a, grid, stream); launch_one<0x4, 15>(a, grid, stream); launch_one<0x8, 15>(a, grid, stream);
        launch_one<0x10, 1>(a, grid, stream); launch_one<0x10, 2>(a, grid, stream); launch_one<0x10, 4>(a, grid, stream); launch_one<0x10, 8>(a, grid, stream);
        launch_one<0x20, 15>(a, grid, stream); launch_one<0x40, 15>(a, grid, stream); launch_one<0x80, 15>(a, grid, stream);
        launch_one<0x100, 15>(a, grid, stream); launch_one<0x200, 15>(a, grid, stream);
        if (l & 1) launch_one<0x400, 15>(a, grid, stream);
    }
    a.l_lo = 0; a.l_hi = 0; a.ph_lo = 0; a.ph_hi = 0; a.do_fin = 1;
    launch_one<0x2000, 15>(a, grid, stream);
#endif
}
```

```cpp
#include <hip/hip_runtime.h>
#include <cstdio>
#include <cstdint>
#define LAS __attribute__((address_space(3)))
namespace pg8 {
#define PG8_LAS __attribute__((address_space(3)))
typedef unsigned short bf16_t;
typedef short bf16x8 __attribute__((ext_vector_type(8)));
typedef float f32x4 __attribute__((ext_vector_type(4)));
typedef unsigned u32x4 __attribute__((ext_vector_type(4)));
constexpr int BM = 256, BK = 64, HALF = 128, HTB = HALF * BK * 2  , STAGE_BYTES = 8 * HTB, NXCD = 8, WGM = 8;

__host__ __device__ __forceinline__ int lds_byte(int r, int c) { const int st = (r >> 4) * 2 + (c >> 5), rr = r & 15, cc = c & 31, ob = rr * 64 + cc * 2; return st * 1024 + (ob ^ (((ob >> 9) & 1) << 5)); }
__host__ __device__ __forceinline__ void stage_rc(int b, int& R, int& C) { const int st = b / 1024, sb = b % 1024, swz = sb ^ (((sb >> 9) & 1) << 5); R = (st >> 1) * 16 + swz / 64; C = (st & 1) * 32 + (swz % 64) / 2; }
__host__ __device__ __forceinline__ int perm32(int rho) { const int n = rho >> 4, i = rho & 15; return 8 * (i >> 2) + 4 * n + (i & 3); }

__host__ __device__ __forceinline__ int perm32f(int rho) { return 2 * (rho & 15) + (rho >> 4); }
template <class E, class = void> struct epi_flip { static constexpr bool v = false; };
template <class E> struct epi_flip<E, decltype((void)E::FLIP)> { static constexpr bool v = E::FLIP; };
struct Unit { int pm, pn, pc; };
struct Gemm { const bf16_t* A; const bf16_t* Bt; int M, N, K; };

struct StaticOrder {
    int nM, nN, nwg, G, c;
    __host__ __device__ void init(int M, int N, int G_, int c_) { nM = M / BM; nN = N / BM; nwg = nM * nN; G = G_; c = c_; }
    __host__ __device__ bool next(int i, Unit& u) const {
        const long L = (long)i * G + c; if (L >= nwg) return false;
        int wgid = (int)L; { const int q = nwg / NXCD, r = nwg % NXCD, xcd = wgid % NXCD, off = wgid / NXCD; wgid = (xcd < r ? xcd * (q + 1) : r * (q + 1) + (xcd - r) * q) + off; }
        const int nig = WGM * nN, gid = wgid / nig, fm = gid * WGM, gsz = (nM - fm) < WGM ? (nM - fm) : WGM;
        u.pm = fm + ((wgid % nig) % gsz); u.pn = (wgid % nig) / gsz; u.pc = u.pn; return true;
    }
    __device__ __forceinline__ void a_ready(const Unit&) const {}
    __device__ __forceinline__ void done(const Unit&) const {}
};

__device__ __forceinline__ unsigned cvt_pk_bf16(float lo, float hi) { unsigned r; asm volatile("v_cvt_pk_bf16_f32 %0, %1, %2" : "=v"(r) : "v"(lo), "v"(hi)); return r; }
typedef float f32x2 __attribute__((ext_vector_type(2)));

template <class Epi, class Sched, bool ALIGN_EPI = false, bool SP2 = false>
__device__ __forceinline__ void gemm_phase(PG8_LAS unsigned char* lds, const Gemm g, const Sched& S, const Epi& E, const int tid) {
    const int wid = __builtin_amdgcn_readfirstlane(tid >> 6), lane = tid & 63, wr = wid >> 2, wc = wid & 3, fr = lane & 15, fq = lane >> 4;
    const int K = g.K, nt = K / BK;
    unsigned voffA[2], voffB[2];
#pragma unroll
    for (int i = 0; i < 2; ++i) { int R, C; stage_rc(tid * 16 + i * 8192, R, C); const int Rb = epi_flip<Epi>::v ? ((R & ~31) + perm32f(R & 31)) : (Epi::PERM ? ((R & ~31) + perm32(R & 31)) : R);
        voffA[i] = (unsigned)(R * K + C) * 2u; voffB[i] = (unsigned)(Rb * K + C) * 2u; }
    const size_t kstep = (size_t)(BK * 2);
    const size_t hstep = (size_t)HALF * K * 2;
    const size_t tstep = 2 * hstep;
    const unsigned ldsw = (unsigned)wid * 1024u;
    const int aoff = lds_byte(wr * 64 + fr, fq * 8), boff = lds_byte(wc * 32 + fr, fq * 8);
#define PG8_SA(b, h) (((b) * 2 + (h)) * HTB)
#define PG8_SB(b, h) ((4 + (b) * 2 + (h)) * HTB)
#define PG8_STAGE(bufoff, gbase, voff) do { _Pragma("unroll") for (int _i = 0; _i < 2; ++_i) \
        __builtin_amdgcn_global_load_lds((const unsigned*)((const char*)(gbase) + (voff)[_i]), (PG8_LAS unsigned*)(lds + (bufoff) + ldsw + _i * 8192), 16, 0, 0); } while (0)
#define PG8_LDA(dst, b, h) do { _Pragma("unroll") for (int m = 0; m < 4; ++m) _Pragma("unroll") for (int k = 0; k < 2; ++k) dst[m][k] = *(const PG8_LAS bf16x8*)(lds + PG8_SA(b, h) + aoff + m * 2048 + k * 1024); } while (0)
#define PG8_LDB(dst, b, h) do { _Pragma("unroll") for (int n = 0; n < 2; ++n) _Pragma("unroll") for (int k = 0; k < 2; ++k) dst[n][k] = *(const PG8_LAS bf16x8*)(lds + PG8_SB(b, h) + boff + n * 2048 + k * 1024); } while (0)
#define PG8_MMA(ai, bj, At, Bt) do { __builtin_amdgcn_s_setprio(1); _Pragma("unroll") for (int m = 0; m < 4; ++m) _Pragma("unroll") for (int n = 0; n < 2; ++n) _Pragma("unroll") for (int k = 0; k < 2; ++k) \
        { if constexpr (epi_flip<Epi>::v) acc[ai][bj][m][n] = __builtin_amdgcn_mfma_f32_16x16x32_bf16(At[m][k], Bt[n][k], acc[ai][bj][m][n], 0, 0, 0); \
          else acc[ai][bj][m][n] = __builtin_amdgcn_mfma_f32_16x16x32_bf16(Bt[n][k], At[m][k], acc[ai][bj][m][n], 0, 0, 0); } __builtin_amdgcn_s_setprio(0); } while (0)
#define PG8_WAIT_V(n) asm volatile("s_waitcnt vmcnt(" #n ")" ::: "memory")
#define PG8_WAIT_L(n) asm volatile("s_waitcnt lgkmcnt(" #n ")" ::: "memory")
#define PG8_BAR __builtin_amdgcn_s_barrier()
#define PG8_SCHED __builtin_amdgcn_sched_barrier(0)
    Unit cur, nxt; int ui = 0;
    if (!S.next(0, cur)) return;
    f32x4 acc[2][2][4][2];
#pragma unroll
    for (int a = 0; a < 2; ++a)
#pragma unroll
        for (int b = 0; b < 2; ++b)
#pragma unroll
            for (int m = 0; m < 4; ++m)
#pragma unroll
                for (int n = 0; n < 2; ++n) acc[a][b][m][n] = (f32x4){0.f, 0.f, 0.f, 0.f};
    bf16x8 At[4][2], B0[2][2], B1[2][2];
    const char* cA = (const char*)g.A + (size_t)cur.pm * tstep; const char* cB = (const char*)g.Bt + (size_t)cur.pn * tstep;
    S.a_ready(cur);
    if constexpr (SP2) {
        PG8_STAGE(PG8_SB(0, 0), cB, voffB); PG8_STAGE(PG8_SB(0, 1), cB + hstep, voffB); PG8_STAGE(PG8_SA(0, 0), cA, voffA); PG8_STAGE(PG8_SA(0, 1), cA + hstep, voffA);
        if (wr == 1) PG8_BAR;
        PG8_WAIT_V(2); PG8_BAR;
        PG8_STAGE(PG8_SB(1, 0), cB + kstep, voffB); PG8_STAGE(PG8_SA(1, 0), cA + kstep, voffA); PG8_STAGE(PG8_SB(1, 1), cB + hstep + kstep, voffB);
        PG8_WAIT_V(6); PG8_BAR;
    } else {
        PG8_STAGE(PG8_SB(0, 0), cB, voffB); PG8_STAGE(PG8_SA(0, 0), cA, voffA); PG8_STAGE(PG8_SB(0, 1), cB + hstep, voffB); PG8_STAGE(PG8_SA(0, 1), cA + hstep, voffA);
        if (wr == 1) PG8_BAR;
        PG8_WAIT_V(4); PG8_BAR;
        PG8_STAGE(PG8_SB(1, 0), cB + kstep, voffB); PG8_STAGE(PG8_SA(1, 0), cA + kstep, voffA); PG8_STAGE(PG8_SB(1, 1), cB + hstep + kstep, voffB);
        PG8_WAIT_V(6); PG8_BAR;
    }
    for (;;) {
        const bool has_next = S.next(ui + 1, nxt);
        const char* nA = has_next ? (const char*)g.A + (size_t)nxt.pm * tstep : cA; const char* nB = has_next ? (const char*)g.Bt + (size_t)nxt.pn * tstep : cB;
        for (int t = 0; t < nt; t += 2) {
            const bool last = (t == nt - 2);
            const char* a1 = cA + (size_t)(t + 1) * kstep;
            const char* a2 = last ? nA : cA + (size_t)(t + 2) * kstep; const char* b2 = last ? nB : cB + (size_t)(t + 2) * kstep;
            const char* a3 = a2 + kstep; const char* b3 = b2 + kstep;
            if (last && has_next) S.a_ready(nxt);
            if constexpr (SP2) {
            PG8_LDB(B0, 0, 0); PG8_LDB(B1, 0, 1); PG8_SCHED; PG8_LDA(At, 0, 0); PG8_STAGE(PG8_SA(1, 1), a1 + hstep, voffA);
            PG8_WAIT_V(8); PG8_WAIT_L(0); PG8_BAR; PG8_MMA(0, 0, At, B0); PG8_MMA(0, 1, At, B1); PG8_BAR; PG8_SCHED;
            PG8_LDA(At, 0, 1); PG8_STAGE(PG8_SB(0, 0), b2, voffB); PG8_STAGE(PG8_SB(0, 1), b2 + hstep, voffB); PG8_STAGE(PG8_SA(0, 0), a2, voffA);
            PG8_WAIT_V(8); PG8_WAIT_L(0); PG8_BAR; PG8_MMA(1, 0, At, B0); PG8_MMA(1, 1, At, B1); PG8_BAR; PG8_SCHED;
            PG8_LDB(B0, 1, 0); PG8_LDB(B1, 1, 1); PG8_SCHED; PG8_LDA(At, 1, 0); PG8_STAGE(PG8_SA(0, 1), a2 + hstep, voffA);
            PG8_WAIT_V(8); PG8_WAIT_L(0); PG8_BAR; PG8_MMA(0, 0, At, B0); PG8_MMA(0, 1, At, B1); PG8_BAR; PG8_SCHED;
            PG8_LDA(At, 1, 1); PG8_STAGE(PG8_SB(1, 0), b3, voffB); PG8_STAGE(PG8_SB(1, 1), b3 + hstep, voffB); PG8_STAGE(PG8_SA(1, 0), a3, voffA);
            PG8_WAIT_V(8); PG8_WAIT_L(0); PG8_BAR; PG8_MMA(1, 0, At, B0); PG8_MMA(1, 1, At, B1); PG8_BAR; PG8_SCHED;
            } else {
            PG8_LDB(B0, 0, 0); PG8_SCHED; PG8_LDA(At, 0, 0); PG8_STAGE(PG8_SA(1, 1), a1 + hstep, voffA);
            PG8_WAIT_L(8); PG8_BAR; PG8_WAIT_L(0); PG8_MMA(0, 0, At, B0); PG8_BAR; PG8_SCHED;
            PG8_LDB(B1, 0, 1); PG8_STAGE(PG8_SB(0, 0), b2, voffB);
            PG8_BAR; PG8_WAIT_L(0); PG8_MMA(0, 1, At, B1); PG8_BAR;
            PG8_LDA(At, 0, 1); PG8_STAGE(PG8_SA(0, 0), a2, voffA);
            PG8_BAR; PG8_WAIT_L(0); PG8_MMA(1, 0, At, B0); PG8_BAR; PG8_SCHED;
            PG8_STAGE(PG8_SB(0, 1), b2 + hstep, voffB);
            PG8_WAIT_V(6); PG8_BAR; PG8_MMA(1, 1, At, B1); PG8_BAR;
            PG8_LDB(B0, 1, 0); PG8_SCHED; PG8_LDA(At, 1, 0); PG8_STAGE(PG8_SA(0, 1), a2 + hstep, voffA);
            PG8_WAIT_L(8); PG8_BAR; PG8_WAIT_L(0); PG8_MMA(0, 0, At, B0); PG8_BAR; PG8_SCHED;
            PG8_LDB(B1, 1, 1); PG8_STAGE(PG8_SB(1, 0), b3, voffB);
            PG8_BAR; PG8_WAIT_L(0); PG8_MMA(0, 1, At, B1); PG8_BAR;
            PG8_LDA(At, 1, 1); PG8_STAGE(PG8_SA(1, 0), a3, voffA);
            PG8_BAR; PG8_WAIT_L(0); PG8_MMA(1, 0, At, B0); PG8_BAR; PG8_SCHED;
            PG8_STAGE(PG8_SB(1, 1), b3 + hstep, voffB);
            PG8_WAIT_V(6); PG8_BAR; PG8_MMA(1, 1, At, B1); PG8_BAR;
            }
        }
        if constexpr (ALIGN_EPI) { if (wr == 0) PG8_BAR; }
        if constexpr (!Epi::AFTER_DRAIN) { E(acc, cur, wr, wc, fr, fq); S.done(cur); }
        if (!has_next) break;
#pragma unroll
        for (int a = 0; a < 2; ++a)
#pragma unroll
            for (int b = 0; b < 2; ++b)
#pragma unroll
                for (int m = 0; m < 4; ++m)
#pragma unroll
                    for (int n = 0; n < 2; ++n) acc[a][b][m][n] = (f32x4){0.f, 0.f, 0.f, 0.f};
        cur = nxt; cA = nA; cB = nB; ++ui;
        if constexpr (ALIGN_EPI) { if (wr == 1) PG8_BAR; }
    }
    PG8_WAIT_V(0);
    if constexpr (!ALIGN_EPI) { if (wr == 0) PG8_BAR; }
    PG8_BAR;
    if constexpr (Epi::AFTER_DRAIN) { E.fused(acc, cur, wr, wc, fr, fq, lds, wid, lane); S.done(cur); }
#undef PG8_SA
#undef PG8_SB
#undef PG8_STAGE
#undef PG8_LDA
#undef PG8_LDB
#undef PG8_MMA
#undef PG8_WAIT_V
#undef PG8_WAIT_L
#undef PG8_BAR
#undef PG8_SCHED
}
typedef int v8i_t __attribute__((ext_vector_type(8)));
typedef int v4i_t __attribute__((ext_vector_type(4)));
template <class Epi, class Sched, bool ALIGN_EPI = false, bool SP2 = false>
__device__ __forceinline__ void gemm_phase_f8(PG8_LAS unsigned char* lds, const Gemm g, const Sched& S, const Epi& E, const int tid) {
    const int wid = __builtin_amdgcn_readfirstlane(tid >> 6), lane = tid & 63, wr = wid >> 2, wc = wid & 3, fr = lane & 15, fq = lane >> 4;
    const int K = g.K, nt = K / BK;
    unsigned voffA[2], voffB[2];
#pragma unroll
    for (int i = 0; i < 2; ++i) { int R, C; stage_rc(tid * 16 + i * 8192, R, C); const int Rb = Epi::PERM ? ((R & ~31) + perm32(R & 31)) : R;
        voffA[i] = (unsigned)(R * K + C) * 2u; voffB[i] = (unsigned)(Rb * K + C) * 2u; }
    const size_t kstep = (size_t)(BK * 2);
    const size_t hstep = (size_t)HALF * K * 2;
    const size_t tstep = 2 * hstep;
    const unsigned ldsw = (unsigned)wid * 1024u;
    const int aoff0 = lds_byte(wr * 64 + fr, fq * 16), aoff1 = lds_byte(wr * 64 + fr, fq * 16 + 8), boff0 = lds_byte(wc * 32 + fr, fq * 16), boff1 = lds_byte(wc * 32 + fr, fq * 16 + 8);
#define PG8_SA(b, h) (((b) * 2 + (h)) * HTB)
#define PG8_SB(b, h) ((4 + (b) * 2 + (h)) * HTB)
#define PG8_STAGE(bufoff, gbase, voff) do { _Pragma("unroll") for (int _i = 0; _i < 2; ++_i) \
        __builtin_amdgcn_global_load_lds((const unsigned*)((const char*)(gbase) + (voff)[_i]), (PG8_LAS unsigned*)(lds + (bufoff) + ldsw + _i * 8192), 16, 0, 0); } while (0)
#define PG8_LDA(dst, b, h) do { _Pragma("unroll") for (int m = 0; m < 4; ++m) { const u32x4 lo_ = *(const PG8_LAS u32x4*)(lds + PG8_SA(b, h) + aoff0 + m * 2048), hi_ = *(const PG8_LAS u32x4*)(lds + PG8_SA(b, h) + aoff1 + m * 2048); \
        dst[m] = __builtin_shufflevector((v4i_t)lo_, (v4i_t)hi_, 0, 1, 2, 3, 4, 5, 6, 7); } } while (0)
#define PG8_LDB(dst, b, h) do { _Pragma("unroll") for (int n = 0; n < 2; ++n) { const u32x4 lo_ = *(const PG8_LAS u32x4*)(lds + PG8_SB(b, h) + boff0 + n * 2048), hi_ = *(const PG8_LAS u32x4*)(lds + PG8_SB(b, h) + boff1 + n * 2048); \
        dst[n] = __builtin_shufflevector((v4i_t)lo_, (v4i_t)hi_, 0, 1, 2, 3, 4, 5, 6, 7); } } while (0)
#define PG8_MMA(ai, bj, At, Bt) do { __builtin_amdgcn_s_setprio(1); _Pragma("unroll") for (int m = 0; m < 4; ++m) _Pragma("unroll") for (int n = 0; n < 2; ++n) \
        asm volatile("v_mfma_scale_f32_16x16x128_f8f6f4 %0, %1, %2, %0, %3, %3 op_sel_hi:[0,0,0]" : "+v"(acc[ai][bj][m][n]) : "v"(Bt[n]), "v"(At[m]), "v"(one_scale)); __builtin_amdgcn_s_setprio(0); } while (0)
#define PG8_WAIT_V(n) asm volatile("s_waitcnt vmcnt(" #n ")" ::: "memory")
#define PG8_WAIT_L(n) asm volatile("s_waitcnt lgkmcnt(" #n ")" ::: "memory")
#define PG8_BAR __builtin_amdgcn_s_barrier()
#define PG8_SCHED __builtin_amdgcn_sched_barrier(0)
    Unit cur, nxt; int ui = 0;
    if (!S.next(0, cur)) return;
    f32x4 acc[2][2][4][2];
#pragma unroll
    for (int a = 0; a < 2; ++a)
#pragma unroll
        for (int b = 0; b < 2; ++b)
#pragma unroll
            for (int m = 0; m < 4; ++m)
#pragma unroll
                for (int n = 0; n < 2; ++n) acc[a][b][m][n] = (f32x4){0.f, 0.f, 0.f, 0.f};
    v8i_t At[4], B0[2], B1[2]; const int one_scale = 0x7f7f7f7f;
    const char* cA = (const char*)g.A + (size_t)cur.pm * tstep; const char* cB = (const char*)g.Bt + (size_t)cur.pn * tstep;
    S.a_ready(cur);
    if constexpr (SP2) {
        PG8_STAGE(PG8_SB(0, 0), cB, voffB); PG8_STAGE(PG8_SB(0, 1), cB + hstep, voffB); PG8_STAGE(PG8_SA(0, 0), cA, voffA); PG8_STAGE(PG8_SA(0, 1), cA + hstep, voffA);
        if (wr == 1) PG8_BAR;
        PG8_WAIT_V(2); PG8_BAR;
        PG8_STAGE(PG8_SB(1, 0), cB + kstep, voffB); PG8_STAGE(PG8_SA(1, 0), cA + kstep, voffA); PG8_STAGE(PG8_SB(1, 1), cB + hstep + kstep, voffB);
        PG8_WAIT_V(6); PG8_BAR;
    } else {
        PG8_STAGE(PG8_SB(0, 0), cB, voffB); PG8_STAGE(PG8_SA(0, 0), cA, voffA); PG8_STAGE(PG8_SB(0, 1), cB + hstep, voffB); PG8_STAGE(PG8_SA(0, 1), cA + hstep, voffA);
        if (wr == 1) PG8_BAR;
        PG8_WAIT_V(4); PG8_BAR;
        PG8_STAGE(PG8_SB(1, 0), cB + kstep, voffB); PG8_STAGE(PG8_SA(1, 0), cA + kstep, voffA); PG8_STAGE(PG8_SB(1, 1), cB + hstep + kstep, voffB);
        PG8_WAIT_V(6); PG8_BAR;
    }
    for (;;) {
        const bool has_next = S.next(ui + 1, nxt);
        const char* nA = has_next ? (const char*)g.A + (size_t)nxt.pm * tstep : cA; const char* nB = has_next ? (const char*)g.Bt + (size_t)nxt.pn * tstep : cB;
        for (int t = 0; t < nt; t += 2) {
            const bool last = (t == nt - 2);
            const char* a1 = cA + (size_t)(t + 1) * kstep;
            const char* a2 = last ? nA : cA + (size_t)(t + 2) * kstep; const char* b2 = last ? nB : cB + (size_t)(t + 2) * kstep;
            const char* a3 = a2 + kstep; const char* b3 = b2 + kstep;
            if (last && has_next) S.a_ready(nxt);
            if constexpr (SP2) {
            PG8_LDB(B0, 0, 0); PG8_LDB(B1, 0, 1); PG8_SCHED; PG8_LDA(At, 0, 0); PG8_STAGE(PG8_SA(1, 1), a1 + hstep, voffA);
            PG8_WAIT_V(8); PG8_WAIT_L(0); PG8_BAR; PG8_MMA(0, 0, At, B0); PG8_MMA(0, 1, At, B1); PG8_BAR; PG8_SCHED;
            PG8_LDA(At, 0, 1); PG8_STAGE(PG8_SB(0, 0), b2, voffB); PG8_STAGE(PG8_SB(0, 1), b2 + hstep, voffB); PG8_STAGE(PG8_SA(0, 0), a2, voffA);
            PG8_WAIT_V(8); PG8_WAIT_L(0); PG8_BAR; PG8_MMA(1, 0, At, B0); PG8_MMA(1, 1, At, B1); PG8_BAR; PG8_SCHED;
            PG8_LDB(B0, 1, 0); PG8_LDB(B1, 1, 1); PG8_SCHED; PG8_LDA(At, 1, 0); PG8_STAGE(PG8_SA(0, 1), a2 + hstep, voffA);
            PG8_WAIT_V(8); PG8_WAIT_L(0); PG8_BAR; PG8_MMA(0, 0, At, B0); PG8_MMA(0, 1, At, B1); PG8_BAR; PG8_SCHED;
            PG8_LDA(At, 1, 1); PG8_STAGE(PG8_SB(1, 0), b3, voffB); PG8_STAGE(PG8_SB(1, 1), b3 + hstep, voffB); PG8_STAGE(PG8_SA(1, 0), a3, voffA);
            PG8_WAIT_V(8); PG8_WAIT_L(0); PG8_BAR; PG8_MMA(1, 0, At, B0); PG8_MMA(1, 1, At, B1); PG8_BAR; PG8_SCHED;
            } else {
            PG8_LDB(B0, 0, 0); PG8_SCHED; PG8_LDA(At, 0, 0); PG8_STAGE(PG8_SA(1, 1), a1 + hstep, voffA);
            PG8_WAIT_L(8); PG8_BAR; PG8_WAIT_L(0); PG8_MMA(0, 0, At, B0); PG8_BAR; PG8_SCHED;
            PG8_LDB(B1, 0, 1); PG8_STAGE(PG8_SB(0, 0), b2, voffB);
            PG8_BAR; PG8_WAIT_L(0); PG8_MMA(0, 1, At, B1); PG8_BAR;
            PG8_LDA(At, 0, 1); PG8_STAGE(PG8_SA(0, 0), a2, voffA);
            PG8_BAR; PG8_WAIT_L(0); PG8_MMA(1, 0, At, B0); PG8_BAR; PG8_SCHED;
            PG8_STAGE(PG8_SB(0, 1), b2 + hstep, voffB);
            PG8_WAIT_V(6); PG8_BAR; PG8_MMA(1, 1, At, B1); PG8_BAR;
            PG8_LDB(B0, 1, 0); PG8_SCHED; PG8_LDA(At, 1, 0); PG8_STAGE(PG8_SA(0, 1), a2 + hstep, voffA);
            PG8_WAIT_L(8); PG8_BAR; PG8_WAIT_L(0); PG8_MMA(0, 0, At, B0); PG8_BAR; PG8_SCHED;
            PG8_LDB(B1, 1, 1); PG8_STAGE(PG8_SB(1, 0), b3, voffB);
            PG8_BAR; PG8_WAIT_L(0); PG8_MMA(0, 1, At, B1); PG8_BAR;
            PG8_LDA(At, 1, 1); PG8_STAGE(PG8_SA(1, 0), a3, voffA);
            PG8_BAR; PG8_WAIT_L(0); PG8_MMA(1, 0, At, B0); PG8_BAR; PG8_SCHED;
            PG8_STAGE(PG8_SB(1, 1), b3 + hstep, voffB);
            PG8_WAIT_V(6); PG8_BAR; PG8_MMA(1, 1, At, B1); PG8_BAR;
            }
        }
        if constexpr (ALIGN_EPI) { if (wr == 0) PG8_BAR; }
        asm volatile("s_nop 15\n\ts_nop 15" ::: "memory");
        if constexpr (!Epi::AFTER_DRAIN) { E(acc, cur, wr, wc, fr, fq); S.done(cur); }
        if (!has_next) break;
#pragma unroll
        for (int a = 0; a < 2; ++a)
#pragma unroll
            for (int b = 0; b < 2; ++b)
#pragma unroll
                for (int m = 0; m < 4; ++m)
#pragma unroll
                    for (int n = 0; n < 2; ++n) acc[a][b][m][n] = (f32x4){0.f, 0.f, 0.f, 0.f};
        cur = nxt; cA = nA; cB = nB; ++ui;
        if constexpr (ALIGN_EPI) { if (wr == 1) PG8_BAR; }
    }
    PG8_WAIT_V(0);
    if constexpr (!ALIGN_EPI) { if (wr == 0) PG8_BAR; }
    PG8_BAR;
    if constexpr (Epi::AFTER_DRAIN) { E.fused(acc, cur, wr, wc, fr, fq, lds, wid, lane); S.done(cur); }
#undef PG8_SA
#undef PG8_SB
#undef PG8_STAGE
#undef PG8_LDA
#undef PG8_LDB
#undef PG8_MMA
#undef PG8_WAIT_V
#undef PG8_WAIT_L
#undef PG8_BAR
#undef PG8_SCHED
}
}

#define XB_TMO      128
#define XB_XCNT(j)  (256  + 64 * (j))
#define XB_XSUB(j)  (1280 + 64 * (j))
#define XB_XGEN(j)  (2304 + 64 * (j))
#define XB_TOP      3328
#define XB_TOPGEN   3392
#define XCD_BAR_WORDS 3456
#define XB_SPIN_CAP (1u << 18)

__device__ __forceinline__ unsigned xb_ld(unsigned* p)              { return __hip_atomic_load(p, __ATOMIC_RELAXED, __HIP_MEMORY_SCOPE_AGENT); }
__device__ __forceinline__ unsigned xb_add(unsigned* p, unsigned v) { return __hip_atomic_fetch_add(p, v, __ATOMIC_RELAXED, __HIP_MEMORY_SCOPE_AGENT); }
__device__ __forceinline__ unsigned xb_xcc_id() { return (unsigned)__builtin_amdgcn_s_getreg((3 << 11) | 20) & 0xFu; }
#define XB_SPIN(cond, bar) do { unsigned _sp = 0; while (cond) { __builtin_amdgcn_s_sleep(1); \
    if ((++_sp & 255u) == 0u) { if (xb_ld(&(bar)[XB_TMO])) break; if (_sp > XB_SPIN_CAP) { atomicAdd(&(bar)[XB_TMO], 1u); break; } } } } while (0)

struct XcdBarrier {
    unsigned* bar; unsigned x;
    volatile LAS unsigned* st;
};

__device__ __forceinline__ XcdBarrier xcd_barrier_post(unsigned* bar, volatile LAS unsigned* st, const int xb_tid) {
    XcdBarrier b; b.bar = bar; b.x = xb_xcc_id(); b.st = st;
    if (xb_tid == 0) (void)xb_add(&bar[XB_XCNT(b.x)], 1u);
    return b;
}
__device__ __forceinline__ void xcd_barrier_complete(unsigned* bar, unsigned x, unsigned& nloc, unsigned& nx) {
    const unsigned G = gridDim.x * gridDim.y * gridDim.z;
    unsigned sum, cnt, mine, sp = 0u;
    for (;;) {
        sum = 0u; cnt = 0u; mine = 0u;
#pragma unroll
        for (unsigned j = 0; j < 16; ++j) { const unsigned c = xb_ld(&bar[XB_XCNT(j)]); sum += c; cnt += (c > 0u) ? 1u : 0u; mine = (j == x) ? c : mine; }
        if (sum == G) break;
        __builtin_amdgcn_s_sleep(1);
        if ((++sp & 255u) == 0u) { if (xb_ld(&bar[XB_TMO])) break; if (sp > XB_SPIN_CAP) { atomicAdd(&bar[XB_TMO], 1u); break; } }
    }
    nloc = mine > 0u ? mine : 1u; nx = cnt > 0u ? cnt : 1u;
}

__device__ __forceinline__ void xcd_barrier(const XcdBarrier& b, const int xb_tid) {
    asm volatile("s_waitcnt vmcnt(0)" ::: "memory");
    __syncthreads();
    if (xb_tid == 0) {
        unsigned* bar = b.bar;
        __builtin_amdgcn_s_waitcnt(0);
        unsigned nloc = b.st[0], nx = b.st[1];
        if (nloc == 0u) { xcd_barrier_complete(bar, b.x, nloc, nx); b.st[0] = nloc; b.st[1] = nx; }
        const unsigned old = xb_add(&bar[XB_XSUB(b.x)], 1u);
        const unsigned gen = old / nloc;
        if (old + 1u == (gen + 1u) * nloc) {
            __builtin_amdgcn_fence(__ATOMIC_RELEASE, "agent");
            asm volatile("s_waitcnt vmcnt(0)" ::: "memory");
            const unsigned og = xb_add(&bar[XB_TOP], 1u);
            const unsigned tg = og / nx;
            if (og + 1u == (tg + 1u) * nx) xb_add(&bar[XB_TOPGEN], 1u);
            else XB_SPIN(xb_ld(&bar[XB_TOPGEN]) == tg, bar);
            __builtin_amdgcn_fence(__ATOMIC_ACQUIRE, "agent");
            xb_add(&bar[XB_XGEN(b.x)], 1u);
            asm volatile("s_waitcnt vmcnt(0)" ::: "memory");
        } else {
            XB_SPIN(xb_ld(&bar[XB_XGEN(b.x)]) == gen, bar);
            __builtin_amdgcn_fence(__ATOMIC_ACQUIRE, "agent");
            asm volatile("s_waitcnt vmcnt(0)" ::: "memory");
        }
    }
    __syncthreads();
}

#define GAS __attribute__((address_space(1)))
typedef unsigned short bf16;
typedef unsigned v4u __attribute__((ext_vector_type(4)));
typedef unsigned v2u __attribute__((ext_vector_type(2)));
typedef float f32x4 __attribute__((ext_vector_type(4)));

constexpr int NB = 4, SEQ = 8192, DM = 1024, DEPTH = 4, CTXL = 256;
constexpr int NLAT = NB * SEQ, NCTX = NB * CTXL, MT = NLAT + NCTX;
constexpr int DIN = 3360, DINP = 3584, DFF = 2816, NEXP = 8;
constexpr int C_RQ = 0, C_RK = 256, C_RV = 512, C_RG = 768, C_S5 = 1024, C_HQ = 1280, C_HFF = 1536, C_HFB = 1792, C_HI = 2048, C_HG = 2304,
              C_GQ = 2560, C_GK = 2688, C_GV = 2816, C_GG = 3072, C_GAF = 3328, C_GAB = 3344,
              C_GZF = 3328, C_GZB = 3456;
constexpr int NSEG = 132;
constexpr int MOE_CAP_TILES = 272;
constexpr float NEPS = 1e-6f;
constexpr float WSC8 = 64.0f;

constexpr size_t MiB = 1u << 20;
constexpr size_t WS_CTL = 0, CTL_ZERO_BYTES = 2 * MiB;
constexpr size_t WS_MOD = 2 * MiB;
constexpr size_t WS_LB = 3 * MiB;
constexpr size_t WS_ROPE = 3 * MiB + 65536;
constexpr size_t WS_GLUW = 3 * MiB + 131072;
constexpr size_t WS_WIN = 4 * MiB;
constexpr size_t WS_WOUT = 32 * MiB;
constexpr size_t WS_W13D = 40 * MiB;
constexpr size_t WS_W2D = 62 * MiB;
constexpr size_t WS_W13M = 73 * MiB;
constexpr size_t WS_W2M = 161 * MiB;
constexpr size_t WS_HB = 205 * MiB;
constexpr size_t WS_ACT = 209 * MiB;
constexpr size_t WS_Z = 275 * MiB;
constexpr size_t WS_PH = 292 * MiB;
constexpr size_t WS_OF = (292 + 232) * MiB;
constexpr size_t WS_X2 = 666 * MiB;
constexpr size_t WS_LIST = 843 * MiB;
constexpr size_t WS_S5PAR = 70 * MiB;
constexpr size_t WS_END = 846 * MiB;
constexpr size_t ST_DS0 = 0;
constexpr size_t ST_DS1 = ST_DS0 + (size_t)2 * 16 * NSEG * 4096;
constexpr size_t ST_DS2 = ST_DS1 + (size_t)2 * 16 * NSEG * 4096;
constexpr size_t ST_G0 = ST_DS2 + (size_t)2 * 16 * NSEG * 2048;
constexpr size_t ST_G1 = ST_G0 + (size_t)2 * 16 * NSEG * 64;
constexpr size_t ST_G2 = ST_G1 + (size_t)2 * 16 * NSEG * 64;
constexpr size_t ST_HS = ST_G2 + (size_t)2 * 16 * NSEG * 64;
constexpr size_t ST_END = ST_HS + (size_t)2 * 64 * NSEG * 128;
static_assert(ST_END * 4 <= (WS_LIST - WS_X2), "state region");
static_assert(WS_PH + (size_t)MT * DINP * 2 <= WS_OF && WS_OF + (size_t)MT * 768 * 4 <= WS_X2, "OF region");
static_assert((size_t)MOE_CAP_TILES * 256 * 1024 * 2 <= (WS_LIST - WS_X2), "XB region");
static_assert((size_t)MOE_CAP_TILES * 256 * DFF * 2 <= (WS_X2 - WS_PH) && (size_t)MT * DINP * 2 <= (WS_X2 - WS_PH), "P/H region");
constexpr int CW_BAR = 4096;
constexpr int CW_CNT = 16384;

constexpr int LDS_BYTES = 163840;
constexpr int MISC_OFF = 163840 - 512;

__device__ __forceinline__ float bf2f(unsigned short h) { return __uint_as_float(((unsigned)h) << 16); }
__device__ __forceinline__ unsigned f2bf(float f) { unsigned u = __float_as_uint(f); return (u + 0x7fffu + ((u >> 16) & 1u)) >> 16; }
__device__ __forceinline__ unsigned pk2(float lo, float hi) { return f2bf(lo) | (f2bf(hi) << 16); }
__device__ __forceinline__ float wave_sum(float v) {
#define WS_DPP(ctrl, rmask) v += __int_as_float(__builtin_amdgcn_update_dpp(0, __float_as_int(v), (ctrl), (rmask), 0xf, false))
    WS_DPP(0x111, 0xf); WS_DPP(0x112, 0xf); WS_DPP(0x114, 0xf); WS_DPP(0x118, 0xf); WS_DPP(0x142, 0xa); WS_DPP(0x143, 0xc);
#undef WS_DPP
    return __int_as_float(__builtin_amdgcn_readlane(__float_as_int(v), 63));
}
__device__ __forceinline__ float rdl(float v, int k) { return __uint_as_float((unsigned)__builtin_amdgcn_readlane((int)__float_as_uint(v), k)); }
__device__ __forceinline__ float sigm(float x) { return __builtin_amdgcn_rcpf(1.0f + __expf(-x)); }
__device__ __forceinline__ float silu_f(float x) { return x * __builtin_amdgcn_rcpf(1.0f + __expf(-x)); }
#define LDS_WAIT() asm volatile("s_waitcnt lgkmcnt(0)" ::: "memory")

struct Args {
    const float* in[37];
    int l_lo, l_hi, ph_lo, ph_hi, do_pro, do_fin, fused, pad;
};
constexpr int I_OUT = 35, I_WS = 36;
enum { I_X = 0, I_C, I_CTX, I_CCTX, I_ADAW, I_ADAB, I_N1W, I_N2W, I_WIN, I_WOUT, I_RETGN, I_LAMRE, I_LAMIM, I_LOGDT, I_BRE, I_BIM, I_CRE, I_CIM, I_S5D,
       I_GLUW, I_GLUB, I_LBL, I_HGNW, I_WA2, I_BA, I_GLANW, I_FW1, I_FW3, I_FW2, I_RW, I_RB, I_MW1, I_MW3, I_MW2, I_FINW };

struct Frame {
    LAS unsigned char* lds;
    int tid, lane, wave, gw, NGW, G, zz;
    unsigned char* ws; float* out;
};

struct EpiStoreBf16 {
    static constexpr bool PERM = true, AFTER_DRAIN = false;
    bf16* O; int ldc; float sc;
    __device__ __forceinline__ void operator()(const pg8::f32x4 (&acc)[2][2][4][2], const pg8::Unit& u, int wr, int wc, int fr, int fq) const {
        const int row0 = u.pm * 256 + wr * 64 + fr, col0 = u.pc * 256 + wc * 32 + 8 * fq;
#pragma unroll
        for (int ai = 0; ai < 2; ++ai)
#pragma unroll
            for (int m = 0; m < 4; ++m) { bf16* rowp = O + (size_t)(row0 + ai * 128 + m * 16) * ldc + col0;
#pragma unroll
                for (int bj = 0; bj < 2; ++bj) { const pg8::f32x4 v0 = acc[ai][bj][m][0] * sc, v1 = acc[ai][bj][m][1] * sc;
                    pg8::u32x4 w; w.x = pg8::cvt_pk_bf16(v0[0], v0[1]); w.y = pg8::cvt_pk_bf16(v0[2], v0[3]); w.z = pg8::cvt_pk_bf16(v1[0], v1[1]); w.w = pg8::cvt_pk_bf16(v1[2], v1[3]);
                    *(pg8::u32x4*)(rowp + bj * 128) = w; } }
    }
};
constexpr int P4G = 4 * DINP, P4S5 = 4096;
struct EpiStoreP4 {
    static constexpr bool PERM = true, FLIP = true, AFTER_DRAIN = false;
    bf16* O;
    __device__ __forceinline__ void operator()(const pg8::f32x4 (&acc)[2][2][4][2], const pg8::Unit& u, int wr, int wc, int fr, int fq) const {
        const int grp0 = u.pm * 64 + wr * 16 + fq;
        if (!(u.pc == 3 || u.pc == 4 || u.pc == 9 || u.pc == 12)) {
            bf16* base = O + (size_t)grp0 * P4G + (size_t)(u.pc * 256 + wc * 32 + 2 * fr) * 4;
#pragma unroll
            for (int ai = 0; ai < 2; ++ai)
#pragma unroll
                for (int m = 0; m < 4; ++m) { bf16* gp = base + (size_t)(ai * 32 + m * 4) * P4G;
#pragma unroll
                    for (int bj = 0; bj < 2; ++bj) { const pg8::f32x4 v0 = acc[ai][bj][m][0], v1 = acc[ai][bj][m][1];
                        pg8::u32x4 w; w.x = pg8::cvt_pk_bf16(v0[0], v0[1]); w.y = pg8::cvt_pk_bf16(v0[2], v0[3]); w.z = pg8::cvt_pk_bf16(v1[0], v1[1]); w.w = pg8::cvt_pk_bf16(v1[2], v1[3]);
                        *(pg8::u32x4*)(gp + bj * 512) = w; } }
        } else {
            bf16* base = O + (size_t)grp0 * P4G + u.pc * 1024 + wc * 32 + 2 * fr;
#pragma unroll
            for (int ai = 0; ai < 2; ++ai)
#pragma unroll
                for (int m = 0; m < 4; ++m) { bf16* gp = base + (size_t)(ai * 32 + m * 4) * P4G;
#pragma unroll
                    for (int bj = 0; bj < 2; ++bj)
#pragma unroll
                        for (int r = 0; r < 4; ++r) *(unsigned*)(gp + r * 256 + bj * 128) = pg8::cvt_pk_bf16(acc[ai][bj][m][0][r], acc[ai][bj][m][1][r]); }
        }
    }
};
struct EpiSwiglu {
    static constexpr bool PERM = true, AFTER_DRAIN = false;
    bf16* H;
    __device__ __forceinline__ void operator()(const pg8::f32x4 (&acc)[2][2][4][2], const pg8::Unit& u, int wr, int wc, int fr, int fq) const {
        const int row0 = u.pm * 256 + wr * 64 + fr, col0 = u.pc * 128 + wc * 32 + 8 * fq;
#pragma unroll
        for (int ai = 0; ai < 2; ++ai)
#pragma unroll
            for (int m = 0; m < 4; ++m) { bf16* rowp = H + (size_t)(row0 + ai * 128 + m * 16) * DFF + col0;
                float h[8];
#pragma unroll
                for (int n = 0; n < 2; ++n)
#pragma unroll
                    for (int j = 0; j < 4; ++j) { const float a = acc[ai][0][m][n][j], b = acc[ai][1][m][n][j];
                        h[n * 4 + j] = a * __builtin_amdgcn_rcpf(1.0f + __builtin_amdgcn_exp2f(-1.4426950408889634f * a)) * b; }
                pg8::u32x4 w; w.x = pg8::cvt_pk_bf16(h[0], h[1]); w.y = pg8::cvt_pk_bf16(h[2], h[3]); w.z = pg8::cvt_pk_bf16(h[4], h[5]); w.w = pg8::cvt_pk_bf16(h[6], h[7]);
                *(pg8::u32x4*)rowp = w; }
    }
};
struct EpiSwiglu8 {
    static constexpr bool PERM = true, AFTER_DRAIN = false;
    unsigned char* H; float sc;
    __device__ __forceinline__ void operator()(const pg8::f32x4 (&acc)[2][2][4][2], const pg8::Unit& u, int wr, int wc, int fr, int fq) const {
        const int row0 = u.pm * 256 + wr * 64 + fr, col0 = u.pc * 128 + wc * 32 + 8 * fq;
#pragma unroll
        for (int ai = 0; ai < 2; ++ai)
#pragma unroll
            for (int m = 0; m < 4; ++m) { unsigned char* rowp = H + (size_t)(row0 + ai * 128 + m * 16) * DFF + col0;
                float h[8];
#pragma unroll
                for (int n = 0; n < 2; ++n)
#pragma unroll
                    for (int j = 0; j < 4; ++j) { const float a = acc[ai][0][m][n][j] * sc, b = acc[ai][1][m][n][j] * sc;
                        const float hv = a * __builtin_amdgcn_rcpf(1.0f + __builtin_amdgcn_exp2f(-1.4426950408889634f * a)) * b;
                        h[n * 4 + j] = fminf(fmaxf(hv, -448.0f), 448.0f); }
                unsigned w0 = 0u, w1 = 0u;
                w0 = __builtin_amdgcn_cvt_pk_fp8_f32(h[0], h[1], w0, false); w0 = __builtin_amdgcn_cvt_pk_fp8_f32(h[2], h[3], w0, true);
                w1 = __builtin_amdgcn_cvt_pk_fp8_f32(h[4], h[5], w1, false); w1 = __builtin_amdgcn_cvt_pk_fp8_f32(h[6], h[7], w1, true);
                v2u w; w.x = w0; w.y = w1; *(v2u*)rowp = w; }
    }
};
struct EpiResid {
    static constexpr bool PERM = false, AFTER_DRAIN = false;
    const float* xin_lat; const float* xin_ctx; float* xout_lat; float* xout_ctx; const float* gate; float sc;
    __device__ __forceinline__ void operator()(const pg8::f32x4 (&acc)[2][2][4][2], const pg8::Unit& u, int wr, int wc, int fr, int fq) const {
        const bool isctx = u.pm >= 128; const int bidx = isctx ? 4 : (u.pm >> 5);
        const size_t rbase = (size_t)(isctx ? (u.pm - 128) : u.pm) * 256 + wr * 64 + fr;
        const float* xi = (isctx ? xin_ctx : xin_lat); float* xo = (isctx ? xout_ctx : xout_lat);
        const int col0 = u.pc * 256 + wc * 32 + 4 * fq; const float* g = gate + (size_t)bidx * 6144 + col0;
        pg8::f32x4 gv[2][2];
#pragma unroll
        for (int bj = 0; bj < 2; ++bj)
#pragma unroll
            for (int n = 0; n < 2; ++n) gv[bj][n] = *(const pg8::f32x4*)(g + bj * 128 + n * 16) * sc;
#pragma unroll
        for (int ai = 0; ai < 2; ++ai)
#pragma unroll
            for (int m = 0; m < 4; ++m) { const size_t off = (rbase + ai * 128 + m * 16) * 1024 + col0;
#pragma unroll
                for (int bj = 0; bj < 2; ++bj)
#pragma unroll
                    for (int n = 0; n < 2; ++n) { const pg8::f32x4 xv = *(const pg8::f32x4*)(xi + off + bj * 128 + n * 16);
                        *(pg8::f32x4*)(xo + off + bj * 128 + n * 16) = xv + gv[bj][n] * acc[ai][bj][m][n]; }
                asm volatile("" ::: "memory"); }
    }
};
struct EpiGlu {
    static constexpr bool PERM = true, AFTER_DRAIN = false;
    const bf16* Z; bf16* Y; const float* bias;
    __device__ __forceinline__ void operator()(const pg8::f32x4 (&acc)[2][2][4][2], const pg8::Unit& u, int wr, int wc, int fr, int fq) const {
        const int row0 = u.pm * 256 + wr * 64 + fr, col0 = wc * 32 + 8 * fq;
#pragma unroll
        for (int ai = 0; ai < 2; ++ai)
#pragma unroll
            for (int m = 0; m < 4; ++m) { const size_t row = (size_t)(row0 + ai * 128 + m * 16);
#pragma unroll
                for (int bj = 0; bj < 2; ++bj) { const int col = col0 + bj * 128;
                    const pg8::u32x4 zz = *(const pg8::u32x4*)(Z + row * 256 + col);
                    const pg8::f32x4 b0 = *(const pg8::f32x4*)(bias + col), b1 = *(const pg8::f32x4*)(bias + col + 4);
                    const pg8::f32x4 v0 = acc[ai][bj][m][0] + b0, v1 = acc[ai][bj][m][1] + b1;
                    float o[8]; const unsigned zw[4] = {zz.x, zz.y, zz.z, zz.w};
#pragma unroll
                    for (int j = 0; j < 4; ++j) { const float zl = __uint_as_float(zw[j] << 16), zh = __uint_as_float(zw[j] & 0xffff0000u);
                        const float a0 = (j < 2) ? v0[2 * j] : v1[2 * j - 4], a1 = (j < 2) ? v0[2 * j + 1] : v1[2 * j - 3];
                        o[2 * j] = zl * sigm(a0); o[2 * j + 1] = zh * sigm(a1); }
                    pg8::u32x4 w; w.x = pg8::cvt_pk_bf16(o[0], o[1]); w.y = pg8::cvt_pk_bf16(o[2], o[3]); w.z = pg8::cvt_pk_bf16(o[4], o[5]); w.w = pg8::cvt_pk_bf16(o[6], o[7]);
                    *(pg8::u32x4*)(Y + row * 1024 + 256 + col) = w; }
                asm volatile("" ::: "memory"); }
    }
};
struct MoeOrder {
    int tp[9]; int nN, G, c, total;
    __device__ __forceinline__ void init(const unsigned* cnt, int nN_, int G_, int c_) {
        tp[0] = 0;
#pragma unroll
        for (int e = 0; e < 8; ++e) tp[e + 1] = tp[e] + (int)(((unsigned)__builtin_amdgcn_readfirstlane((int)__hip_atomic_load(cnt + e * 64, __ATOMIC_RELAXED, __HIP_MEMORY_SCOPE_AGENT)) + 255u) >> 8);
        nN = nN_; G = G_; c = c_; total = tp[8] * nN;
    }
    __device__ __forceinline__ bool next(int i, pg8::Unit& u) const {
        const int L = i * G + c; if (L >= total) return false;
        const int t = L / nN, pn = L - t * nN; int e = 0;
#pragma unroll
        for (int k = 1; k < 8; ++k) e += (t >= tp[k]) ? 1 : 0;
        u.pm = t; u.pn = e * nN + pn; u.pc = pn; return true;
    }
    __device__ __forceinline__ void a_ready(const pg8::Unit&) const {}
    __device__ __forceinline__ void done(const pg8::Unit&) const {}
};

__device__ __forceinline__ void cvt_item(const float* W, int K, int N, bf16* WT, int mode, int add, LAS float* scr, int item, int lane, int nblk_override = 0, const float* ks = nullptr  ) {
    const int nblk = nblk_override ? nblk_override : (N >> 5), kb = item / nblk, nb = item - kb * nblk, k0 = 64 * kb, n0 = 32 * nb;
    const int r = lane >> 3, c4 = lane & 7;
    f32x4 v[8];
#pragma unroll
    for (int i = 0; i < 8; ++i) v[i] = *(const f32x4*)(W + (size_t)(k0 + 8 * i + r) * N + n0 + 4 * c4);
    if (ks) {
#pragma unroll
        for (int i = 0; i < 8; ++i) v[i] *= ks[8 * i + r]; }
#pragma unroll
    for (int i = 0; i < 8; ++i) {
#pragma unroll
        for (int j = 0; j < 4; ++j) scr[(8 * i + r) * 33 + 4 * c4 + j] = v[i][j]; }
    LDS_WAIT();
    const int c = lane & 7;
#pragma unroll
    for (int j = 0; j < 4; ++j) { const int n = (lane >> 3) + 8 * j; const LAS float* s = scr + (8 * c) * 33 + n;
        v4u o; o.x = pk2(s[0 * 33], s[1 * 33]); o.y = pk2(s[2 * 33], s[3 * 33]); o.z = pk2(s[4 * 33], s[5 * 33]); o.w = pk2(s[6 * 33], s[7 * 33]);
        const int nn = n0 + n; const int drow = (mode == 0) ? (nn + add) : (((nn >> 7) << 8) + (nn & 127) + add);
        *(v4u*)(WT + (size_t)drow * K + k0 + 8 * c) = o; }
    LDS_WAIT();
}
__device__ __forceinline__ void cvt_item_f8(const float* W, int K, int N, unsigned char* WT, int mode, int add, LAS float* scr, int item, int lane) {
    const int nblk = N >> 5, kb = item / nblk, nb = item - kb * nblk, k0 = 64 * kb, n0 = 32 * nb;
    const int r = lane >> 3, c4 = lane & 7;
    f32x4 v[8];
#pragma unroll
    for (int i = 0; i < 8; ++i) v[i] = *(const f32x4*)(W + (size_t)(k0 + 8 * i + r) * N + n0 + 4 * c4);
#pragma unroll
    for (int i = 0; i < 8; ++i) {
#pragma unroll
        for (int j = 0; j < 4; ++j) scr[(8 * i + r) * 33 + 4 * c4 + j] = v[i][j]; }
    LDS_WAIT();
    const int c = lane & 3;
#pragma unroll
    for (int j = 0; j < 2; ++j) { const int n = (lane >> 2) + 16 * j; const LAS float* s = scr + (16 * c) * 33 + n;
        unsigned w[4];
#pragma unroll
        for (int q = 0; q < 4; ++q) { unsigned x = 0u;
            x = __builtin_amdgcn_cvt_pk_fp8_f32(s[(4 * q) * 33] * WSC8, s[(4 * q + 1) * 33] * WSC8, x, false);
            x = __builtin_amdgcn_cvt_pk_fp8_f32(s[(4 * q + 2) * 33] * WSC8, s[(4 * q + 3) * 33] * WSC8, x, true); w[q] = x; }
        v4u o; o.x = w[0]; o.y = w[1]; o.z = w[2]; o.w = w[3];
        const int nn = n0 + n; const int drow = (mode == 0) ? (nn + add) : (((nn >> 7) << 8) + (nn & 127) + add);
        *(v4u*)(WT + (size_t)drow * K + k0 + 16 * c) = o; }
    LDS_WAIT();
}
__device__ __forceinline__ void moe_cvt_idle(const Frame& F, const Args& a, int j, int b_lo) {
    LAS float* scr = (LAS float*)(F.lds + F.wave * 16384);
    constexpr int IT = 1408;
    const int nw = (F.G - b_lo) * 8, w = ((int)blockIdx.x - b_lo) * 8 + F.wave;
    for (int it = w; it < 8 * 3 * IT; it += nw) {
        const int e = it / (3 * IT), r = it - e * 3 * IT, which = r / IT, item = r - which * IT;
        const size_t eo = ((size_t)j * 8 + e) * (size_t)(1024 * DFF);
        if (which == 0) cvt_item_f8(a.in[F.zz + I_MW1] + eo, 1024, DFF, F.ws + WS_W13M + (size_t)e * 5632 * 1024, 1, 0, scr, item, F.lane);
        else if (which == 1) cvt_item_f8(a.in[F.zz + I_MW3] + eo, 1024, DFF, F.ws + WS_W13M + (size_t)e * 5632 * 1024, 1, 128, scr, item, F.lane);
        else cvt_item_f8(a.in[F.zz + I_MW2] + eo, DFF, 1024, F.ws + WS_W2M + (size_t)e * 1024 * DFF, 0, 0, scr, item, F.lane);
    }
}
__device__ __forceinline__ void moe_cvt(const Frame& F, const Args& a, int j) {
    LAS float* scr = (LAS float*)(F.lds + F.wave * 16384);
    constexpr int IT = 1408;
    for (int it = F.gw; it < 8 * 3 * IT; it += F.NGW) {
        const int e = it / (3 * IT), r = it - e * 3 * IT, which = r / IT, item = r - which * IT;
        const size_t eo = ((size_t)j * 8 + e) * (size_t)(1024 * DFF);
        if (which == 0) cvt_item_f8(a.in[F.zz + I_MW1] + eo, 1024, DFF, F.ws + WS_W13M + (size_t)e * 5632 * 1024, 1, 0, scr, item, F.lane);
        else if (which == 1) cvt_item_f8(a.in[F.zz + I_MW3] + eo, 1024, DFF, F.ws + WS_W13M + (size_t)e * 5632 * 1024, 1, 128, scr, item, F.lane);
        else cvt_item_f8(a.in[F.zz + I_MW2] + eo, DFF, 1024, F.ws + WS_W2M + (size_t)e * 1024 * DFF, 0, 0, scr, item, F.lane);
    }
}
__device__ __forceinline__ void prologue(const Frame& F, const Args& a) {
    {
        LAS float* sc = (LAS float*)F.lds; LAS float* red = sc + 5120;
        for (int idx = F.tid; idx < 5120; idx += 512) { const int r = idx >> 10, k = idx & 1023; const float cv = (r < 4) ? a.in[F.zz + I_C][r * 1024 + k] : a.in[F.zz + I_CCTX][k]; sc[idx] = silu_f(cv); }
        __syncthreads();
        float* MOD = (float*)(F.ws + WS_MOD);
        for (int item = blockIdx.x; item < 384; item += F.G) {
            const int l = item / 96, nb = item - l * 96, cl = F.tid & 63, ks = F.tid >> 6, n = nb * 64 + cl;
            float acc[5] = {0.f, 0.f, 0.f, 0.f, 0.f};
            const float* wp = a.in[F.zz + I_ADAW] + ((size_t)l * 1024 + ks * 128) * 6144 + n;
#pragma unroll 16
            for (int kk = 0; kk < 128; ++kk) { const float w = wp[(size_t)kk * 6144];
#pragma unroll
                for (int r = 0; r < 5; ++r) acc[r] = fmaf(sc[r * 1024 + ks * 128 + kk], w, acc[r]); }
#pragma unroll
            for (int r = 0; r < 5; ++r) red[(ks * 5 + r) * 64 + cl] = acc[r];
            __syncthreads();
            if (F.tid < 320) { const int r = F.tid >> 6; float s = 0.f;
#pragma unroll
                for (int k2 = 0; k2 < 8; ++k2) s += red[(k2 * 5 + r) * 64 + cl];
                MOD[((size_t)l * 5 + r) * 6144 + n] = s + a.in[F.zz + I_ADAB][l * 6144 + n]; }
            __syncthreads();
        }
        if (blockIdx.x == 0 && F.tid < 256) {
            const float* lg = a.in[F.zz + I_LBL]; float x[4], mx = -3.0e38f;
#pragma unroll
            for (int l = 0; l < 4; ++l) { x[l] = lg[l * 256 + F.tid]; mx = fmaxf(mx, x[l]); }
            float s = 0.f;
#pragma unroll
            for (int l = 0; l < 4; ++l) { x[l] = expf(x[l] - mx); s += x[l]; }
            float cs = 0.f; const float sm0 = x[0] / s; float* LB = (float*)(F.ws + WS_LB);
#pragma unroll
            for (int l = 0; l < 4; ++l) { cs += x[l] / s; LB[l * 256 + F.tid] = fminf(fmaxf(cs - sm0, 0.f), 1.0f - 1e-6f); }
        }
        if (blockIdx.x == (1 % F.G)) {
            float* RC = (float*)(F.ws + WS_ROPE); float* RS = RC + 2048;
            for (int idx = F.tid; idx < 2048; idx += 512) { const int pos = idx >> 4, i = idx & 15;
                const float fr = powf(10000.0f, -(float)i / 16.0f); const float ang = (float)pos * fr; RC[idx] = cosf(ang); RS[idx] = sinf(ang); }
        }
        __syncthreads();
    }
    LAS float* scr = (LAS float*)(F.lds + F.wave * 16384);
    constexpr int I_IN = 16 * 104, I_OUT = 16 * 32, I_F = 1408, I_GL = 4 * 8;
    constexpr int NIT = 4 * I_IN + 4 * I_OUT + 6 * I_F + 4 * I_GL;
    for (int it = F.gw; it < NIT; it += F.NGW) {
        int r = it;
        if (r < 4 * I_IN) { const int l = r / I_IN; cvt_item(a.in[F.zz + I_WIN] + (size_t)l * 1024 * DIN, 1024, DIN, (bf16*)(F.ws + WS_WIN) + (size_t)l * DINP * 1024, 0, 0, scr, r - l * I_IN, F.lane, 104); continue; } r -= 4 * I_IN;
        if (r < 4 * I_OUT) { const int l = r / I_OUT, it = r - l * I_OUT, k0 = 64 * (it >> 5);
            const float* ks = k0 < 256 ? a.in[F.zz + I_RETGN] + l * 256 + k0 : (k0 < 512 ? nullptr : (k0 < 768 ? a.in[F.zz + I_HGNW] + l * 256 + (k0 - 512) : a.in[F.zz + I_GLANW] + l * 256 + (k0 - 768)));
            cvt_item(a.in[F.zz + I_WOUT] + (size_t)l * 1024 * 1024, 1024, 1024, (bf16*)(F.ws + WS_WOUT) + (size_t)l * 1024 * 1024, 0, 0, scr, it, F.lane, 0, ks); continue; } r -= 4 * I_OUT;
        if (r < 6 * I_F) { const int j = r / (3 * I_F), r2 = r - j * 3 * I_F, which = r2 / I_F, item = r2 - which * I_F; const size_t wo = (size_t)j * 1024 * DFF;
            if (which == 0) cvt_item(a.in[F.zz + I_FW1] + wo, 1024, DFF, (bf16*)(F.ws + WS_W13D) + (size_t)j * 5632 * 1024, 1, 0, scr, item, F.lane);
            else if (which == 1) cvt_item(a.in[F.zz + I_FW3] + wo, 1024, DFF, (bf16*)(F.ws + WS_W13D) + (size_t)j * 5632 * 1024, 1, 128, scr, item, F.lane);
            else cvt_item_f8(a.in[F.zz + I_FW2] + wo, DFF, 1024, F.ws + WS_W2D + (size_t)j * 1024 * DFF, 0, 0, scr, item, F.lane);
            continue; } r -= 6 * I_F;
        { const int l = r / I_GL; cvt_item(a.in[F.zz + I_GLUW] + (size_t)l * 65536, 256, 256, (bf16*)(F.ws + WS_GLUW) + (size_t)l * 65536, 0, 0, scr, r - l * I_GL, F.lane); }
    }
    for (int i = blockIdx.x * 512 + F.tid; i < 4 * 256 * 128; i += F.G * 512) {
        const int l = i >> 15, rem = i & 32767, n = rem >> 7, k0 = (rem & 127) * 8, d = n >> 7, cidx = n & 127;
        const float* wa = a.in[F.zz + I_WA2] + ((size_t)(l * 2 + d) * 16) * 128 + cidx;
        float acc[8] = {0.f, 0.f, 0.f, 0.f, 0.f, 0.f, 0.f, 0.f};
#pragma unroll
        for (int r = 0; r < 16; ++r) { const float w2 = wa[r * 128];
#pragma unroll
            for (int kk = 0; kk < 8; ++kk) acc[kk] = fmaf(a.in[F.zz + I_WIN][((size_t)l * 1024 + k0 + kk) * DIN + 3328 + 16 * d + r], w2, acc[kk]); }
        v4u o; o.x = pk2(acc[0], acc[1]); o.y = pk2(acc[2], acc[3]); o.z = pk2(acc[4], acc[5]); o.w = pk2(acc[6], acc[7]);
        *(v4u*)((bf16*)(F.ws + WS_WIN) + ((size_t)l * DINP + 3328 + n) * 1024 + k0) = o;
    }
}

struct MoeTp { int tp[9]; };
__device__ __forceinline__ void load_tp(MoeTp& t, const unsigned* cnt) {
    t.tp[0] = 0;
#pragma unroll
    for (int e = 0; e < 8; ++e) t.tp[e + 1] = t.tp[e] + (int)(((unsigned)__builtin_amdgcn_readfirstlane((int)__hip_atomic_load(cnt + e * 64, __ATOMIC_RELAXED, __HIP_MEMORY_SCOPE_AGENT)) + 255u) >> 8);
}
template <int MODE>
__device__ __forceinline__ void norm_phase(const Frame& F, const Args& a, int l, int which  , int nrows, int comb_l  ) {
    const float* MOD = (const float*)(F.ws + WS_MOD);
    const float* nw = (MODE == 2) ? a.in[F.zz + I_FINW] : ((which ? a.in[F.zz + I_N2W] : a.in[F.zz + I_N1W]) + l * 1024);
    bf16* XN = (bf16*)(F.ws + WS_ACT);
    float* hb = (float*)(F.ws + WS_HB);
    const int* EP = (const int*)(F.ws + WS_LIST) + 8 * MT; const float* GATE = (const float*)(F.ws + WS_LIST) + 10 * MT;
    const bf16* YM = (const bf16*)(F.ws + WS_X2);
    const bool from_input = (l == 0 && which == 0 && MODE != 2);
    MoeTp ctp; if (comb_l >= 0) load_tp(ctp, (const unsigned*)F.ws + CW_CNT + (comb_l >> 1) * 8 * 64);
    const int jm = l >> 1;
    LAS float* rwl = (LAS float*)F.lds;
    if (MODE == 1) {
        const float* rw = a.in[F.zz + I_RW] + (size_t)jm * 8192;
        for (int idx = F.tid; idx < 8192; idx += 512) { const int k = idx >> 3, e = idx & 7; rwl[e * 1024 + k] = rw[idx]; }
        __syncthreads();
    }
    f32x4 wv[4];
#pragma unroll
    for (int j = 0; j < 4; ++j) wv[j] = *((const f32x4*)nw + F.lane + 64 * j);
    f32x4 vn[4]; int epn0 = 0, epn1 = 0; float gn0 = 0.f, gn1 = 0.f;
    { const int m = F.gw < nrows ? F.gw : 0; const bool isctx = m >= NLAT;
      const float* xr = from_input ? (isctx ? a.in[F.zz + I_CTX] + (size_t)(m - NLAT) * 1024 : a.in[F.zz + I_X] + (size_t)m * 1024) : (isctx ? hb + (size_t)(m - NLAT) * 1024 : F.out + (size_t)m * 1024);
#pragma unroll
      for (int j = 0; j < 4; ++j) vn[j] = *((const f32x4*)xr + F.lane + 64 * j);
      if (comb_l >= 0) { epn0 = EP[2 * m]; epn1 = EP[2 * m + 1]; gn0 = GATE[2 * m]; gn1 = GATE[2 * m + 1]; } }
    for (int m = F.gw; m < nrows; m += F.NGW) {
        const bool isctx = m >= NLAT; const int bidx = isctx ? 4 : (m >> 13);
        f32x4 v[4];
#pragma unroll
        for (int j = 0; j < 4; ++j) v[j] = vn[j];
        const int ep0 = epn0, ep1 = epn1; const float g0 = gn0, g1 = gn1;
        { const int mn = (m + F.NGW < nrows) ? m + F.NGW : m; const bool cn = mn >= NLAT;
          const float* xr = from_input ? (cn ? a.in[F.zz + I_CTX] + (size_t)(mn - NLAT) * 1024 : a.in[F.zz + I_X] + (size_t)mn * 1024) : (cn ? hb + (size_t)(mn - NLAT) * 1024 : F.out + (size_t)mn * 1024);
#pragma unroll
          for (int j = 0; j < 4; ++j) vn[j] = *((const f32x4*)xr + F.lane + 64 * j);
          if (comb_l >= 0) { epn0 = EP[2 * mn]; epn1 = EP[2 * mn + 1]; gn0 = GATE[2 * mn]; gn1 = GATE[2 * mn + 1]; } }
        if (comb_l >= 0) {
            int t0 = 0, t1 = 0;
#pragma unroll
            for (int e = 0; e < 8; ++e) { t0 = ((ep0 & 7) == e) ? ctp.tp[e] : t0; t1 = ((ep1 & 7) == e) ? ctp.tp[e] : t1; }
            const size_t d0 = (size_t)t0 * 256 + (ep0 >> 3), d1 = (size_t)t1 * 256 + (ep1 >> 3);
            const float* m5 = MOD + ((size_t)comb_l * 5 + bidx) * 6144 + 5 * 1024;
            float* xw = isctx ? hb + (size_t)(m - NLAT) * 1024 : F.out + (size_t)m * 1024;
#pragma unroll
            for (int j = 0; j < 4; ++j) {
                const v2u y0 = *((const v2u*)(YM + d0 * 1024) + F.lane + 64 * j), y1 = *((const v2u*)(YM + d1 * 1024) + F.lane + 64 * j);
                const f32x4 mm = *((const f32x4*)m5 + F.lane + 64 * j);
                f32x4 f0, f1;
                f0[0] = __uint_as_float(y0.x << 16); f0[1] = __uint_as_float(y0.x & 0xffff0000u); f0[2] = __uint_as_float(y0.y << 16); f0[3] = __uint_as_float(y0.y & 0xffff0000u);
                f1[0] = __uint_as_float(y1.x << 16); f1[1] = __uint_as_float(y1.x & 0xffff0000u); f1[2] = __uint_as_float(y1.y << 16); f1[3] = __uint_as_float(y1.y & 0xffff0000u);
                v[j] = v[j] + mm * (f0 * g0 + f1 * g1);
                if (MODE != 2) *((f32x4*)xw + F.lane + 64 * j) = v[j];
            }
        }
        float ss = 0.f;
#pragma unroll
        for (int j = 0; j < 4; ++j) ss += (v[j][0] * v[j][0] + v[j][1] * v[j][1]) + (v[j][2] * v[j][2] + v[j][3] * v[j][3]);
        ss = wave_sum(ss);
        const float rstd = __builtin_amdgcn_rsqf(ss * (1.0f / 1024.0f) + NEPS);
        if (MODE == 2) {
#pragma unroll
            for (int j = 0; j < 4; ++j) *((f32x4*)(F.out + (size_t)m * 1024) + F.lane + 64 * j) = v[j] * rstd * wv[j];
        } else {
            const float* sh = MOD + ((size_t)l * 5 + bidx) * 6144 + (which ? 3 : 0) * 1024; const float* scl = sh + 1024;
            f32x4 o[4];
#pragma unroll
            for (int j = 0; j < 4; ++j) { const f32x4 s1 = *((const f32x4*)scl + F.lane + 64 * j), s0 = *((const f32x4*)sh + F.lane + 64 * j);
                o[j] = (v[j] * rstd * wv[j]) * (s1 + 1.0f) + s0;
                if (MODE == 1) {
                    unsigned w8 = 0u; w8 = __builtin_amdgcn_cvt_pk_fp8_f32(fminf(fmaxf(o[j][0], -448.f), 448.f), fminf(fmaxf(o[j][1], -448.f), 448.f), w8, false);
                    w8 = __builtin_amdgcn_cvt_pk_fp8_f32(fminf(fmaxf(o[j][2], -448.f), 448.f), fminf(fmaxf(o[j][3], -448.f), 448.f), w8, true);
                    *((unsigned*)((unsigned char*)XN + (size_t)m * 1024) + F.lane + 64 * j) = w8;
                } else { v2u w; w.x = pk2(o[j][0], o[j][1]); w.y = pk2(o[j][2], o[j][3]);
                    *((v2u*)(XN + (size_t)m * 1024) + F.lane + 64 * j) = w; } }
            if (MODE == 1) {
                float p[8];
#pragma unroll
                for (int e = 0; e < 8; ++e) { float s = 0.f;
#pragma unroll
                    for (int j = 0; j < 4; ++j) { const f32x4 w4 = *((const LAS f32x4*)(rwl + e * 1024) + F.lane + 64 * j);
                        s += (o[j][0] * w4[0] + o[j][1] * w4[1]) + (o[j][2] * w4[2] + o[j][3] * w4[3]); }
                    p[e] = wave_sum(s) + a.in[F.zz + I_RB][jm * 8 + e]; }
                int e0 = 0; float v0 = p[0];
#pragma unroll
                for (int e = 1; e < 8; ++e) if (p[e] > v0) { v0 = p[e]; e0 = e; }
                int e1 = -1; float v1 = -3.0e38f;
#pragma unroll
                for (int e = 0; e < 8; ++e) if (e != e0 && p[e] > v1) { v1 = p[e]; e1 = e; }
                const float ex = expf(v1 - v0), g0 = 1.0f / (1.0f + ex), g1 = ex / (1.0f + ex);
                if (F.lane == 0) {
                    unsigned* cnt = (unsigned*)F.ws + CW_CNT + jm * 8 * 64; int* LIST = (int*)(F.ws + WS_LIST);
                    int* EPw = (int*)(F.ws + WS_LIST) + 8 * MT; float* GW = (float*)(F.ws + WS_LIST) + 10 * MT;
                    const unsigned p0 = __hip_atomic_fetch_add(cnt + e0 * 64, 1u, __ATOMIC_RELAXED, __HIP_MEMORY_SCOPE_AGENT);
                    const unsigned p1 = __hip_atomic_fetch_add(cnt + e1 * 64, 1u, __ATOMIC_RELAXED, __HIP_MEMORY_SCOPE_AGENT);
                    LIST[e0 * MT + p0] = m; LIST[e1 * MT + p1] = m;
                    EPw[2 * m] = e0 | (int)(p0 << 3); EPw[2 * m + 1] = e1 | (int)(p1 << 3);
                    GW[2 * m] = g0; GW[2 * m + 1] = g1;
                }
            }
        }
    }
    if (MODE == 1) __syncthreads();
}
__device__ __forceinline__ void moe_gather(const Frame& F, int jm) {
    const unsigned* cnt = (const unsigned*)F.ws + CW_CNT + jm * 8 * 64;
    MoeTp t; load_tp(t, cnt);
    int cn[8];
#pragma unroll
    for (int e = 0; e < 8; ++e) cn[e] = __builtin_amdgcn_readfirstlane((int)__hip_atomic_load(cnt + e * 64, __ATOMIC_RELAXED, __HIP_MEMORY_SCOPE_AGENT));
    const int rows = t.tp[8] * 256;
    const int* LIST = (const int*)(F.ws + WS_LIST); const v4u* XN = (const v4u*)(F.ws + WS_ACT); v4u* XB = (v4u*)(F.ws + WS_X2);
    for (int r = F.gw; r < rows; r += F.NGW) {
        const int tile = r >> 8; int e = 0, tpe = 0, ce = cn[0];
#pragma unroll
        for (int k = 1; k < 8; ++k) { const bool ge = tile >= t.tp[k]; e += ge ? 1 : 0; tpe = ge ? t.tp[k] : tpe; ce = ge ? cn[k] : ce; }
        const int pos = r - tpe * 256;
        v4u x0 = {0u, 0u, 0u, 0u};
        if (pos < ce) { const int src = LIST[e * MT + pos]; x0 = XN[(size_t)src * 64 + F.lane]; }
        XB[(size_t)r * 64 + F.lane] = x0;
    }
}
#define GLD(T, ubase, voff) (*(const T*)((const char*)(ubase) + (unsigned)(voff)))
#define GST(T, ubase, voff) (*(T*)((char*)(ubase) + (unsigned)(voff)))
__device__ __forceinline__ int fresh_lane() { int l; asm volatile("v_mbcnt_lo_u32_b32 %0, -1, 0\n\tv_mbcnt_hi_u32_b32 %0, -1, %0" : "=v"(l)); return l; }

struct MixP { const bf16* P; const float* lb; const float* rcos; const float* rsin; const float* ba; };
__device__ __forceinline__ int seg_row0(int b, int sg) { return sg < 4 ? NLAT + b * CTXL + sg * 64 : b * SEQ + (sg - 4) * 64; }
__device__ __forceinline__ int seg_tpos0(int sg) { return sg < 4 ? -1 : (sg - 4) * 64; }

struct S5P { const float *lam_re, *lam_im, *log_dt, *b_re, *b_im, *c_re, *c_im, *dd; const unsigned* par; };
__device__ __forceinline__ float gelu_tanh(float y) { const float t = 0.7978845608028654f * (y + 0.044715f * y * y * y); const float th = 1.0f - 2.0f * __builtin_amdgcn_rcpf(1.0f + __expf(2.0f * t)); return 0.5f * y * (1.0f + th); }
template <int MODE>
__device__ __forceinline__ void s5_scan(const S5P& sp, const bf16* P, int b, int g, int dir, int sg, int lane, float& hre, float& him, LAS float* yf, LAS float* stg, bf16* Z) {
    const int row0 = seg_row0(b, sg); const int dg = dir * 16 + g;
    const float lre = sp.lam_re[dg * 64 + lane], lim = sp.lam_im[dg * 64 + lane], dt = expf(sp.log_dt[dg]);
    const float er = expf(lre * dt); const float sn = sinf(lim * dt), cs = cosf(lim * dt);
    const float ar = er * cs, ai = er * sn;
    const float nr = ar - 1.0f, ni = ai, den = lre * lre + lim * lim;
    const float cr = (nr * lre + ni * lim) / den, ci = (ni * lre - nr * lim) / den;
    float bbr[16], bbi[16], Cr[16], Ci[16];
#pragma unroll
    for (int c = 0; c < 16; ++c) { const float Br = sp.b_re[((size_t)dg * 64 + lane) * 16 + c], Bi = sp.b_im[((size_t)dg * 64 + lane) * 16 + c];
        bbr[c] = cr * Br - ci * Bi; bbi[c] = cr * Bi + ci * Br;
        Cr[c] = (MODE != 0) ? sp.c_re[((size_t)dg * 16 + c) * 64 + lane] : 0.f; Ci[c] = (MODE != 0) ? sp.c_im[((size_t)dg * 16 + c) * 64 + lane] : 0.f; }
    const int ch = ((lane >> 5) & 1) * 8 + ((lane >> 4) & 1) * 4 + ((lane >> 3) & 1) * 2 + ((lane >> 2) & 1);
    const float dv = (MODE == 2) ? sp.dd[g * 16 + ch] : 0.f;
    const bool b5 = lane & 32, b4 = lane & 16, b3 = lane & 8, b2 = lane & 4;
    const unsigned ucol = 2u * (unsigned)(C_S5 + g * 16 + (lane & 15));
    unsigned short rn0[4], rn1[4], rn2[4];
#pragma unroll
    for (int u = 0; u < 4; ++u) { rn0[u] = GLD(unsigned short, P + (size_t)(row0 + (dir ? 63 - u : u)) * DINP, ucol); rn1[u] = GLD(unsigned short, P + (size_t)(row0 + (dir ? 59 - u : 4 + u)) * DINP, ucol);
        rn2[u] = GLD(unsigned short, P + (size_t)(row0 + (dir ? 55 - u : 8 + u)) * DINP, ucol); }
#pragma unroll 1
    for (int i0 = 0; i0 < 64; i0 += 4) {
        unsigned short ru[4], rn3[4];
        const int ip = (i0 + 12 < 64) ? i0 + 12 : 60;
#pragma unroll
        for (int u = 0; u < 4; ++u) { ru[u] = rn0[u]; rn3[u] = GLD(unsigned short, P + (size_t)(row0 + (dir ? 63 - (ip + u) : (ip + u))) * DINP, ucol); }
#pragma unroll
        for (int u = 0; u < 4; ++u) stg[u * 64 + lane] = bf2f(ru[u]);
#pragma unroll
        for (int u = 0; u < 4; ++u) {
            const int ti = dir ? 63 - (i0 + u) : (i0 + u);
            const float uf = bf2f(ru[u]);
            float bur = 0.f, bui = 0.f;
#pragma unroll
            for (int c4 = 0; c4 < 4; ++c4) { const f32x4 ux = *(const LAS f32x4*)(stg + u * 64 + 4 * c4);
#pragma unroll
                for (int jj = 0; jj < 4; ++jj) { bur = fmaf(bbr[4 * c4 + jj], ux[jj], bur); bui = fmaf(bbi[4 * c4 + jj], ux[jj], bui); } }
            const float nre = ar * hre - ai * him + bur, nim = ar * him + ai * hre + bui;
            hre = nre; him = nim;
            if (MODE != 0) {
                float v[16];
#pragma unroll
                for (int c = 0; c < 16; ++c) v[c] = Cr[c] * hre - Ci[c] * him;
                float w8[8], w4[4], w2[2], w1;
#pragma unroll
                for (int i = 0; i < 8; ++i) { const float mine = b5 ? v[8 + i] : v[i], oth = b5 ? v[i] : v[8 + i]; w8[i] = mine + __shfl_xor(oth, 32); }
#pragma unroll
                for (int i = 0; i < 4; ++i) { const float mine = b4 ? w8[4 + i] : w8[i], oth = b4 ? w8[i] : w8[4 + i]; w4[i] = mine + __shfl_xor(oth, 16); }
#pragma unroll
                for (int i = 0; i < 2; ++i) { const float mine = b3 ? w4[2 + i] : w4[i], oth = b3 ? w4[i] : w4[2 + i]; w2[i] = mine + __shfl_xor(oth, 8); }
                { const float mine = b2 ? w2[1] : w2[0], oth = b2 ? w2[0] : w2[1]; w1 = mine + __shfl_xor(oth, 4); }
                w1 += __shfl_xor(w1, 2); w1 += __shfl_xor(w1, 1);
                if (MODE == 1) { if ((lane & 3) == 0) yf[ti * 16 + ch] = w1; }
                if (MODE == 2) {
                    const float uch = __shfl(uf, ch);
                    if ((lane & 3) == 0) { const float y = w1 + yf[ti * 16 + ch] + dv * uch; Z[(size_t)(row0 + ti) * 256 + g * 16 + ch] = (bf16)f2bf(gelu_tanh(y)); }
                }
            }
        }
#pragma unroll
        for (int u = 0; u < 4; ++u) { rn0[u] = rn1[u]; rn1[u] = rn2[u]; rn2[u] = rn3[u]; }
    }
}

__device__ __forceinline__ MixP make_mixp(const Frame& F, const Args& a, int l) {
    MixP mp; mp.P = (const bf16*)(F.ws + WS_PH); mp.lb = (const float*)(F.ws + WS_LB) + l * 256; mp.rcos = (const float*)(F.ws + WS_ROPE); mp.rsin = mp.rcos + 2048;
    mp.ba = a.in[F.zz + I_BA] + (size_t)l * 2 * 128; return mp;
}
__device__ __forceinline__ S5P make_s5p(const Frame& F, const Args& a, int l) {
    S5P sp; sp.lam_re = a.in[F.zz + I_LAMRE] + (size_t)l * 2048; sp.lam_im = a.in[F.zz + I_LAMIM] + (size_t)l * 2048; sp.log_dt = a.in[F.zz + I_LOGDT] + l * 32;
    sp.b_re = a.in[F.zz + I_BRE] + (size_t)l * 32768; sp.b_im = a.in[F.zz + I_BIM] + (size_t)l * 32768; sp.c_re = a.in[F.zz + I_CRE] + (size_t)l * 32768; sp.c_im = a.in[F.zz + I_CIM] + (size_t)l * 32768;
    sp.dd = a.in[F.zz + I_S5D] + l * 256; sp.par = (const unsigned*)(F.ws + WS_S5PAR) + (size_t)l * 32 * 4096; return sp;
}


typedef short bf16x8_t __attribute__((ext_vector_type(8)));
typedef float f32x16 __attribute__((ext_vector_type(16)));
typedef float f32x2_t __attribute__((ext_vector_type(2)));
typedef __bf16 bf16x2_n __attribute__((ext_vector_type(2)));
__device__ __forceinline__ unsigned pkbf(float lo, float hi) { const f32x2_t v = {lo, hi}; const bf16x2_n r = __builtin_convertvector(v, bf16x2_n); return __builtin_bit_cast(unsigned, r); }
constexpr int WL_QC = 0, WL_KC = 4608, WL_KT = 9216, WL_VT = 14336, WL_PL = 19456, WL_BYTES = 19712;

struct MxC { float gamma, lbv, oml, bav, rc1, rs1; unsigned cq, ck, cv, cz; };
template <int MIX>
__device__ __forceinline__ void mx_consts(MxC& c, const MixP& mp, int h, int dir, int lane) {
    c.gamma = 1.f; c.lbv = 0.f; c.oml = 1.f; c.bav = 0.f; c.cz = 0; c.rc1 = 1.f; c.rs1 = 0.f;
    if (MIX == 0) { c.cq = 8u * (unsigned)(C_RQ + h * 64 + lane); c.ck = 8u * (unsigned)(C_RK + h * 64 + lane); c.cv = 8u * (unsigned)(C_RV + h * 64 + lane); c.gamma = 1.0f - exp2f(-5.0f - (float)(dir ? 3 - h : h));
        if (lane & 32) { const unsigned r1 = 4u * (unsigned)(16 + (lane & 15)); c.rc1 = GLD(float, mp.rcos, r1); const float s1 = GLD(float, mp.rsin, r1); c.rs1 = dir ? -s1 : s1; } }
    else if (MIX == 1) { c.cq = 8u * (unsigned)(C_HQ + h * 64 + lane); c.ck = 8u * (unsigned)((dir ? C_HFB : C_HFF) + h * 64 + lane); c.cv = 8u * (unsigned)(C_HI + h * 64 + lane); c.lbv = mp.lb[h * 64 + lane]; c.oml = 1.0f - c.lbv; }
    else { c.cq = 8u * (unsigned)(C_GQ + h * 32 + (lane & 31)); c.ck = 8u * (unsigned)(C_GK + h * 32 + (lane & 31)); c.cv = 8u * (unsigned)(C_GV + h * 64 + lane); c.cz = 8u * (unsigned)((dir ? C_GZB : C_GZF) + h * 32 + (lane & 31));
        c.bav = mp.ba[dir * 128 + h * 32 + (lane & 31)]; }
}
struct MxRaw { v2u q, k, v, z; };
template <int MIX, bool NEEDQ, int DIR>
__device__ __forceinline__ void mx_load(MxRaw& w, const MixP& mp, const MxC& c, int rows, int b) {
    const bf16* pr = mp.P + (size_t)((rows >> 2) + (DIR ? 15 - b : b)) * P4G;
    const v2u zero = {0u, 0u};
    w.q = NEEDQ ? GLD(v2u, pr, c.cq) : zero; w.k = GLD(v2u, pr, c.ck); w.v = GLD(v2u, pr, c.cv); w.z = (MIX == 2) ? GLD(v2u, pr, c.cz) : zero;
}
__device__ __forceinline__ float bfx(const v2u& w, int i) { const unsigned d = (i >> 1) ? w.y : w.x; return __builtin_bit_cast(float, (i & 1) ? (d & 0xffff0000u) : (d << 16)); }
template <int MIX, bool NEEDQ, int DIR>
__device__ __forceinline__ void mx_batch(const MxRaw& cur, const MixP& mp, const MxC& c, int tposs  , int lane, LAS unsigned char* wl, int b, float& P, float& rc, float& rs) {
    constexpr int DK = (MIX == 2) ? 32 : 64;
    float kt[4];
#pragma unroll
    for (int u = 0; u < 4; ++u) {
        const int cc = b * 4 + u, ts = DIR ? 63 - cc : cc, t = ts & 31;
        const int pu = DIR ? 3 - u : u; float q = bfx(cur.q, pu), k, f;
        if (MIX == 0) {
            k = bfx(cur.k, pu) * 0.125f; f = c.gamma;
            if (tposs >= 0) { const float cs = rc, sn = rs;
                rc = cs * c.rc1 - sn * c.rs1; rs = sn * c.rc1 + cs * c.rs1;
                const float ss = (lane & 16) ? sn : -sn;
                const float kp = __shfl_xor(k, 16); k = fmaf(kp, ss, k * cs);
                if (NEEDQ) { const float qp = __shfl_xor(q, 16); q = fmaf(qp, ss, q * cs); } }
        } else if (MIX == 1) {
            const float z = bfx(cur.k, pu); const float e = __expf(-z); const float sp = __builtin_amdgcn_rcpf(1.0f + e), sn = e * sp;
            f = fmaf(c.oml, sp, c.lbv); k = c.oml * sn;
        } else {
            k = bfx(cur.k, pu) * 0.17677669529663687f; const float z = bfx(cur.z, pu) + c.bav;
            const float ls = fminf(z, 0.f) - __logf(1.0f + __expf(-fabsf(z)));
            f = __expf(ls * 0.0625f);
        }
        P = fmaxf(P * f, 1e-30f);
        const float kk = k * __builtin_amdgcn_rcpf(P); kt[DIR ? 3 - u : u] = kk;
        if (lane < DK) {
            const unsigned qk = pkbf(q * P, kk);
            if (NEEDQ) *(LAS unsigned short*)(wl + WL_QC + t * 144 + lane * 2) = (unsigned short)qk;
            *(LAS unsigned short*)(wl + WL_KC + t * 144 + lane * 2) = (unsigned short)(qk >> 16);
        }
    }
    const int g4 = ((DIR ? 63 - b * 4 : b * 4) & 31) >> 2;
    v2u kp; kp.x = pkbf(kt[0], kt[1]); kp.y = pkbf(kt[2], kt[3]);
    if (lane < DK) *(LAS v2u*)(wl + WL_KT + lane * 80 + g4 * 8) = kp;
    *(LAS v2u*)(wl + WL_VT + lane * 80 + g4 * 8) = cur.v;
}
typedef short bf16x4_t __attribute__((ext_vector_type(4)));
#define MFMA8(a, b, c) __builtin_amdgcn_mfma_f32_32x32x8bf16_1k((a), (b), (c), 0, 0, 0)
__device__ __forceinline__ bf16x4_t pack4(const f32x16& x, int s) {
    v2u p; p.x = pkbf(x[4 * s], x[4 * s + 1]); p.y = pkbf(x[4 * s + 2], x[4 * s + 3]);
    return __builtin_bit_cast(bf16x4_t, p);
}
__device__ __forceinline__ bf16x4_t ld4(const LAS unsigned char* p) { const v2u a = *(const LAS v2u*)p; return __builtin_bit_cast(bf16x4_t, a); }

__device__ __forceinline__ float u2f_(unsigned u) { return __builtin_bit_cast(float, u); }
__device__ __forceinline__ void s5_build(const Frame& F, const Args& a) {
    for (int it = F.gw; it < 128; it += F.NGW) {
        const int l = it >> 5, dg = it & 31, lane = F.lane, m32 = lane & 31, hh = lane >> 5;
        const S5P sp = make_s5p(F, a, l);
        unsigned* par = (unsigned*)(F.ws + WS_S5PAR) + (size_t)it * 4096;
    float ar[2], ai[2], a2r[2], a2i[2], a3r[2], a3i[2], a4r[2], a4i[2];
    bf16x4_t bfr[4][2];
    const float dt = __expf(sp.log_dt[dg]);
#pragma unroll
    for (int sh = 0; sh < 2; ++sh) {
        const int p = 32 * sh + m32;
        const float lre = sp.lam_re[dg * 64 + p], lim = sp.lam_im[dg * 64 + p];
        const float er = __expf(lre * dt), sn = sinf(lim * dt), cs = cosf(lim * dt);
        ar[sh] = er * cs; ai[sh] = er * sn;
        a2r[sh] = ar[sh] * ar[sh] - ai[sh] * ai[sh]; a2i[sh] = ar[sh] * ai[sh] + ar[sh] * ai[sh];
        a3r[sh] = a2r[sh] * ar[sh] - a2i[sh] * ai[sh]; a3i[sh] = a2r[sh] * ai[sh] + a2i[sh] * ar[sh];
        a4r[sh] = a2r[sh] * a2r[sh] - a2i[sh] * a2i[sh]; a4i[sh] = a2r[sh] * a2i[sh] + a2r[sh] * a2i[sh];
        const float nr = ar[sh] - 1.0f, ni = ai[sh], den = 1.0f / (lre * lre + lim * lim);
        const float cr = (nr * lre + ni * lim) * den, ci = (ni * lre - nr * lim) * den;
#pragma unroll
        for (int s2 = 0; s2 < 2; ++s2) {
            const f32x4 Br = *(const f32x4*)(sp.b_re + ((size_t)dg * 64 + p) * 16 + 8 * s2 + 4 * hh), Bi = *(const f32x4*)(sp.b_im + ((size_t)dg * 64 + p) * 16 + 8 * s2 + 4 * hh);
            const f32x4 re = Br * cr - Bi * ci, im = Bi * cr + Br * ci;
            v2u pr, pi; pr.x = pkbf(re[0], re[1]); pr.y = pkbf(re[2], re[3]); pi.x = pkbf(im[0], im[1]); pi.y = pkbf(im[2], im[3]);
            bfr[sh][s2] = __builtin_bit_cast(bf16x4_t, pr); bfr[2 + sh][s2] = __builtin_bit_cast(bf16x4_t, pi);
        }
    }
    bf16x4_t cfr[16];
    {
#pragma unroll
        for (int s = 0; s < 16; ++s) {
            const int p4 = (8 * s + 4 * hh) & 63; f32x4 cv = {0.f, 0.f, 0.f, 0.f};
            if (m32 < 16) cv = (s < 8) ? *(const f32x4*)(sp.c_re + ((size_t)dg * 16 + m32) * 64 + p4) : -*(const f32x4*)(sp.c_im + ((size_t)dg * 16 + m32) * 64 + p4);
            v2u pc; pc.x = pkbf(cv[0], cv[1]); pc.y = pkbf(cv[2], cv[3]); cfr[s] = __builtin_bit_cast(bf16x4_t, pc);
        }
    }
#define S5U(x) __builtin_bit_cast(unsigned, (x))
        v4u q;
        q.x = S5U(ar[0]); q.y = S5U(ar[1]); q.z = S5U(ai[0]); q.w = S5U(ai[1]); *(v4u*)(par + (0 * 64 + lane) * 4) = q;
        q.x = S5U(a2r[0]); q.y = S5U(a2r[1]); q.z = S5U(a2i[0]); q.w = S5U(a2i[1]); *(v4u*)(par + (1 * 64 + lane) * 4) = q;
        q.x = S5U(a3r[0]); q.y = S5U(a3r[1]); q.z = S5U(a3i[0]); q.w = S5U(a3i[1]); *(v4u*)(par + (2 * 64 + lane) * 4) = q;
        q.x = S5U(a4r[0]); q.y = S5U(a4r[1]); q.z = S5U(a4i[0]); q.w = S5U(a4i[1]); *(v4u*)(par + (3 * 64 + lane) * 4) = q;
#undef S5U
#pragma unroll
        for (int i = 0; i < 4; ++i) { const v2u lo = __builtin_bit_cast(v2u, bfr[i][0]), hi = __builtin_bit_cast(v2u, bfr[i][1]); q.x = lo.x; q.y = lo.y; q.z = hi.x; q.w = hi.y; *(v4u*)(par + ((4 + i) * 64 + lane) * 4) = q; }
#pragma unroll
        for (int k = 0; k < 8; ++k) { const v2u lo = __builtin_bit_cast(v2u, cfr[2 * k]), hi = __builtin_bit_cast(v2u, cfr[2 * k + 1]); q.x = lo.x; q.y = lo.y; q.z = hi.x; q.w = hi.y; *(v4u*)(par + ((8 + k) * 64 + lane) * 4) = q; }
    }
}
template <int MODE, int DIR>
__device__ __forceinline__ void s5_mm_dir(const S5P& sp, const bf16* P, int b, int g, int sg, int lane, float& hre, float& him, LAS float* yf, LAS unsigned char* hs, bf16* Z) {
    const int m32 = lane & 31, hh = lane >> 5, dg = DIR * 16 + g, row0 = seg_row0(b, sg);
    float ar[2], ai[2], a2r[2], a2i[2], a3r[2], a3i[2], a4r[2], a4i[2];
    bf16x4_t bfr[4][2];
    bf16x4_t cfr[16];
    {
        const unsigned* par = sp.par + (size_t)dg * 4096;
        v4u pq[16];
#pragma unroll
        for (int q = 0; q < ((MODE != 0) ? 16 : 8); ++q) pq[q] = GLD(v4u, par + q * 256, 16u * (unsigned)lane);
#define S5F(x) u2f_(x)
        ar[0] = S5F(pq[0].x); ar[1] = S5F(pq[0].y); ai[0] = S5F(pq[0].z); ai[1] = S5F(pq[0].w);
        a2r[0] = S5F(pq[1].x); a2r[1] = S5F(pq[1].y); a2i[0] = S5F(pq[1].z); a2i[1] = S5F(pq[1].w);
        a3r[0] = S5F(pq[2].x); a3r[1] = S5F(pq[2].y); a3i[0] = S5F(pq[2].z); a3i[1] = S5F(pq[2].w);
        a4r[0] = S5F(pq[3].x); a4r[1] = S5F(pq[3].y); a4i[0] = S5F(pq[3].z); a4i[1] = S5F(pq[3].w);
#undef S5F
#pragma unroll
        for (int i = 0; i < 4; ++i) { v2u lo, hi; lo.x = pq[4 + i].x; lo.y = pq[4 + i].y; hi.x = pq[4 + i].z; hi.y = pq[4 + i].w; bfr[i][0] = __builtin_bit_cast(bf16x4_t, lo); bfr[i][1] = __builtin_bit_cast(bf16x4_t, hi); }
        if (MODE != 0) {
#pragma unroll
            for (int k = 0; k < 8; ++k) { v2u lo, hi; lo.x = pq[8 + k].x; lo.y = pq[8 + k].y; hi.x = pq[8 + k].z; hi.y = pq[8 + k].w; cfr[2 * k] = __builtin_bit_cast(bf16x4_t, lo); cfr[2 * k + 1] = __builtin_bit_cast(bf16x4_t, hi); }
        }
    }
    const float ddv = (MODE == 2 && m32 < 16) ? sp.dd[g * 16 + m32] : 0.f;
    float hr[2], hi[2];
    hr[0] = __shfl(hre, m32); hi[0] = __shfl(him, m32); hr[1] = __shfl(hre, m32 + 32); hi[1] = __shfl(him, m32 + 32);
#pragma unroll 1
    for (int ci2 = 0; ci2 < 2; ++ci2) {
        const int ch = DIR ? 1 - ci2 : ci2, rowc = row0 + 32 * ch;
        const bf16* urow = P + (size_t)((rowc + m32) >> 2) * P4G + P4S5 + (m32 & 3) * 256 + g * 16 + 4 * hh;
        const bf16x4_t ua0 = __builtin_bit_cast(bf16x4_t, *(const v2u*)urow), ua1 = __builtin_bit_cast(bf16x4_t, *(const v2u*)(urow + 8));
        f32x16 BU[4];
#pragma unroll
        for (int nt = 0; nt < 4; ++nt) {
#pragma unroll
            for (int r = 0; r < 16; ++r) BU[nt][r] = 0.f;
            BU[nt] = MFMA8(ua0, bfr[nt][0], BU[nt]); BU[nt] = MFMA8(ua1, bfr[nt][1], BU[nt]);
        }
#pragma unroll
        for (int sh = 0; sh < 2; ++sh)
#pragma unroll
            for (int gg = 0; gg < 4; ++gg)
#pragma unroll
                for (int jj = 1; jj < 4; ++jj) {
                    const int r = DIR ? 4 * gg + 3 - jj : 4 * gg + jj, rp = DIR ? r + 1 : r - 1;
                    const float pr = BU[sh][rp], pi = BU[2 + sh][rp];
                    BU[sh][r] += ar[sh] * pr - ai[sh] * pi; BU[2 + sh][r] += ar[sh] * pi + ai[sh] * pr;
                }
        float hnr[2][4], hni[2][4];
#pragma unroll
        for (int st = 0; st < 8; ++st) {
            const int gg = DIR ? 3 - (st >> 1) : (st >> 1), turn = DIR ? 1 - (st & 1) : (st & 1), rl = DIR ? 4 * gg : 4 * gg + 3;
            const bool act = (hh == turn);
#pragma unroll
            for (int sh = 0; sh < 2; ++sh) {
                if (turn == (DIR ? 1 : 0)) { hnr[sh][gg] = hr[sh]; hni[sh][gg] = hi[sh]; }
                else { hnr[sh][gg] = act ? hr[sh] : hnr[sh][gg]; hni[sh][gg] = act ? hi[sh] : hni[sh][gg]; }
                const float outr = BU[sh][rl] + a4r[sh] * hr[sh] - a4i[sh] * hi[sh], outi = BU[2 + sh][rl] + a4r[sh] * hi[sh] + a4i[sh] * hr[sh];
                const float sr = __shfl_xor(outr, 32), si = __shfl_xor(outi, 32);
                hr[sh] = act ? outr : sr; hi[sh] = act ? outi : si;
            }
        }
        if (MODE != 0) {
#pragma unroll
            for (int sh = 0; sh < 2; ++sh)
#pragma unroll
                for (int gg = 0; gg < 4; ++gg)
#pragma unroll
                    for (int jj = 0; jj < 4; ++jj) {
                        const int pw = DIR ? 4 - jj : jj + 1;
                        const float pr = (pw == 1) ? ar[sh] : (pw == 2) ? a2r[sh] : (pw == 3) ? a3r[sh] : a4r[sh], pi = (pw == 1) ? ai[sh] : (pw == 2) ? a2i[sh] : (pw == 3) ? a3i[sh] : a4i[sh];
                        BU[sh][4 * gg + jj] += pr * hnr[sh][gg] - pi * hni[sh][gg]; BU[2 + sh][4 * gg + jj] += pr * hni[sh][gg] + pi * hnr[sh][gg];
                    }
#pragma unroll
            for (int nt = 0; nt < 4; ++nt)
#pragma unroll
                for (int r = 0; r < 16; ++r) *(LAS unsigned short*)(hs + ((r & 3) + 8 * (r >> 2) + 4 * hh) * 272 + (32 * nt + m32) * 2) = (unsigned short)pkbf(BU[nt][r], BU[nt][r]);
            f32x16 Yv;
#pragma unroll
            for (int r = 0; r < 16; ++r) Yv[r] = 0.f;
#pragma unroll
            for (int s = 0; s < 16; ++s) Yv = MFMA8(ld4(hs + m32 * 272 + (8 * s + 4 * hh) * 2), cfr[s], Yv);
            if (m32 < 16) {
#pragma unroll
                for (int r = 0; r < 16; ++r) {
                    const int tl = (r & 3) + 8 * (r >> 2) + 4 * hh;
                    if (MODE == 1) yf[(32 * ch + tl) * 16 + m32] = Yv[r];
                    else { const float u = bf2f(P[(size_t)((rowc + tl) >> 2) * P4G + P4S5 + (tl & 3) * 256 + g * 16 + m32]);
                        const float y = Yv[r] + yf[(32 * ch + tl) * 16 + m32] + ddv * u;
                        const float zz = gelu_tanh(y); Z[(size_t)(rowc + tl) * 256 + g * 16 + m32] = (bf16)pkbf(zz, zz); }
                }
            }
        }
    }
    hre = hh ? hr[1] : hr[0]; him = hh ? hi[1] : hi[0];
}
template <int MODE>
__device__ __forceinline__ void s5_mm(const S5P& sp, const bf16* P, int b, int g, int dir, int sg, int lane, float& hre, float& him, LAS float* yf, LAS unsigned char* hs, bf16* Z) {
    if (dir) s5_mm_dir<MODE, 1>(sp, P, b, g, sg, lane, hre, him, yf, hs, Z); else s5_mm_dir<MODE, 0>(sp, P, b, g, sg, lane, hre, him, yf, hs, Z);
}
template <int MIX, int DIR, bool WITH_O>
__device__ __forceinline__ void mx_chunk(LAS unsigned char* wl, int lane, float Pl, f32x16 (&ST)[(MIX == 2) ? 1 : 2][2], f32x16 (&O)[2]) {
    constexpr int DK = (MIX == 2) ? 32 : 64, NRT = DK / 32;
    const int m32 = lane & 31, hh = lane >> 5;
    asm volatile("" ::: "memory");
    if (lane < DK) *(LAS float*)(wl + WL_PL + lane * 4) = Pl;
    asm volatile("" ::: "memory");
    if (WITH_O) {
        f32x16 x;
#pragma unroll
        for (int r = 0; r < 16; ++r) x[r] = 0.f;
#pragma unroll
        for (int s = 0; s < DK / 8; ++s) {
            const bf16x4_t ka = ld4(wl + WL_KC + m32 * 144 + (8 * s + 4 * hh) * 2);
            const bf16x4_t qb = ld4(wl + WL_QC + m32 * 144 + (8 * s + 4 * hh) * 2);
            x = MFMA8(ka, qb, x);
        }
#pragma unroll
        for (int r = 0; r < 16; ++r) { const int j = (r & 3) + 8 * (r >> 2) + 4 * hh; const bool keep = DIR ? (j >= m32) : (j <= m32); x[r] = keep ? x[r] : 0.f; }
#pragma unroll
        for (int t = 0; t < 2; ++t)
#pragma unroll
            for (int r = 0; r < 16; ++r) O[t][r] = 0.f;
#pragma unroll
        for (int s = 0; s < 4; ++s) {
            const bf16x4_t xa = pack4(x, s);
#pragma unroll
            for (int t = 0; t < 2; ++t) O[t] = MFMA8(ld4(wl + WL_VT + (32 * t + m32) * 80 + (8 * s + 4 * hh) * 2), xa, O[t]);
        }
#pragma unroll
        for (int rt = 0; rt < NRT; ++rt)
#pragma unroll
            for (int s = 0; s < 4; ++s) {
                const bf16x4_t qa = ld4(wl + WL_QC + m32 * 144 + (32 * rt + 8 * s + 4 * hh) * 2);
#pragma unroll
                for (int t = 0; t < 2; ++t) O[t] = MFMA8(pack4(ST[rt][t], s), qa, O[t]);
            }
    }
#pragma unroll
    for (int rt = 0; rt < NRT; ++rt)
#pragma unroll
        for (int s = 0; s < 4; ++s) {
            const bf16x4_t ka = ld4(wl + WL_KT + (32 * rt + m32) * 80 + (8 * s + 4 * hh) * 2);
#pragma unroll
            for (int t = 0; t < 2; ++t) ST[rt][t] = MFMA8(ka, ld4(wl + WL_VT + (32 * t + m32) * 80 + (8 * s + 4 * hh) * 2), ST[rt][t]);
        }
#pragma unroll
    for (int rt = 0; rt < NRT; ++rt)
#pragma unroll
        for (int g = 0; g < 4; ++g) {
            const f32x4 pl4 = *(const LAS f32x4*)(wl + WL_PL + (32 * rt + 8 * g + 4 * hh) * 4);
#pragma unroll
            for (int e = 0; e < 4; ++e) { ST[rt][0][4 * g + e] *= pl4[e]; ST[rt][1][4 * g + e] *= pl4[e]; }
        }
}
__device__ __forceinline__ float half_sum(float v) {
#pragma unroll
    for (int o = 1; o < 32; o <<= 1) v += __shfl_xor(v, o);
    return v;
}
template <int MIX, int DIR>
__device__ __forceinline__ void mixA_stream(const MixP& mp, const MxC& c, int row0, int tpos0, int lane, LAS unsigned char* wl, f32x16 (&ST)[(MIX == 2) ? 1 : 2][2], float& Gam) {
    f32x16 O[2];
    MxRaw r[8];
#pragma unroll
    for (int i = 0; i < 8; ++i) mx_load<MIX, false, DIR>(r[i], mp, c, row0, i);
    float rc = 1.0f, rs = 0.0f;
    if (MIX == 0 && tpos0 >= 0) { const int tpos = tpos0 + (DIR ? 63 : 0); const int pos = (lane & 32) ? (tpos & 63) : (tpos >> 6);
        const unsigned ro = 4u * (unsigned)(pos * 16 + (lane & 15)); rc = GLD(float, mp.rcos, ro); rs = GLD(float, mp.rsin, ro); }
    float P = 1.0f;
#pragma unroll 1
    for (int ck = 0; ck < 2; ++ck) {
        int ln = lane; asm volatile("" : "+v"(ln));
#pragma unroll
        for (int j = 0; j < 8; ++j) {
            mx_batch<MIX, false, DIR>(r[j], mp, c, tpos0, ln, wl, j, P, rc, rs);
            if (ck == 0) mx_load<MIX, false, DIR>(r[j], mp, c, row0, 8 + j);
        }
        Gam *= P; mx_chunk<MIX, 0, false>(wl, ln, P, ST, O); P = 1.0f;
    }
}
template <int MIX>
__device__ __forceinline__ void mixA_unit(const MixP& mp, float* STG, int idx, int lane_in, LAS unsigned char* wl) {
    int lane = lane_in;
    constexpr int DK = (MIX == 2) ? 32 : 64, NRT = DK / 32;
    const int dir = idx / 2112, rem = idx - dir * 2112, bh = rem / NSEG, sg = rem - bh * NSEG, b = bh >> 2, h = bh & 3;
    asm volatile("" : "+v"(lane));
    MxC c; mx_consts<MIX>(c, mp, h, dir, lane);
    f32x16 ST[NRT][2];
#pragma unroll
    for (int rt = 0; rt < NRT; ++rt)
#pragma unroll
        for (int t = 0; t < 2; ++t)
#pragma unroll
            for (int r = 0; r < 16; ++r) ST[rt][t][r] = 0.f;
    const int row0 = seg_row0(b, sg), tpos0 = seg_tpos0(sg);
    float Gam = 1.0f;
    if (dir) mixA_stream<MIX, 1>(mp, c, row0, tpos0, lane, wl, ST, Gam); else mixA_stream<MIX, 0>(mp, c, row0, tpos0, lane, wl, ST, Gam);
    const size_t slot = (size_t)((dir * 16 + bh) * NSEG + sg);
    bf16* ds = (bf16*)(STG + (MIX == 0 ? ST_DS0 : (MIX == 1 ? ST_DS1 : ST_DS2))) + slot * (DK * 64);
    const int m32 = lane & 31, hh = lane >> 5;
#pragma unroll
    for (int rt = 0; rt < NRT; ++rt)
#pragma unroll
        for (int t = 0; t < 2; ++t)
#pragma unroll
            for (int r4 = 0; r4 < 4; ++r4) { v2u v; v.x = pkbf(ST[rt][t][4 * r4], ST[rt][t][4 * r4 + 1]); v.y = pkbf(ST[rt][t][4 * r4 + 2], ST[rt][t][4 * r4 + 3]);
                GST(v2u, ds + ((rt * 2 + t) * 4 + r4) * 256, 8u * (unsigned)lane) = v; }
    float* gs = STG + (MIX == 0 ? ST_G0 : (MIX == 1 ? ST_G1 : ST_G2)) + slot * 64;
    GST(float, gs, 4u * (unsigned)lane) = Gam;
}
__device__ __forceinline__ void mx_epi_loads(const MixP& mp, int lane, int rowc, const float* OFc, int gcol, v2u (&g)[2][4], f32x4 (&of)[2][4]) {
    const int m32 = lane & 31, hh = lane >> 5;
    const bf16* gb = mp.P + (size_t)(rowc >> 2) * P4G + gcol;
    const unsigned gvo = 2u * (unsigned)((m32 >> 2) * P4G + (m32 & 3) * 256 + 4 * hh);
#pragma unroll
    for (int t = 0; t < 2; ++t)
#pragma unroll
        for (int s = 0; s < 4; ++s) { g[t][s] = GLD(v2u, gb + 32 * t + 8 * s, gvo); of[t][s] = GLD(f32x4, OFc + (t * 4 + s) * 256, 16u * (unsigned)lane); }
}
template <int MIX, int MODE>
__device__ __forceinline__ void mx_epilogue(const MixP& mp, LAS unsigned char* wl, int lane, f32x16 (&O)[2], int rowc, float* OFc, bf16* Y, int ycol, const v2u (&g)[2][4], const f32x4 (&of)[2][4]) {
    const int m32 = lane & 31, hh = lane >> 5;
    if (MODE == 1) {
#pragma unroll
        for (int t = 0; t < 2; ++t)
#pragma unroll
            for (int s = 0; s < 4; ++s) { const f32x4 v = {O[t][4 * s], O[t][4 * s + 1], O[t][4 * s + 2], O[t][4 * s + 3]}; GST(f32x4, OFc + (t * 4 + s) * 256, 16u * (unsigned)lane) = v; }
    } else {
#pragma unroll
        for (int t = 0; t < 2; ++t)
#pragma unroll
            for (int s = 0; s < 4; ++s)
#pragma unroll
                for (int j = 0; j < 4; ++j) O[t][4 * s + j] += of[t][s][j];
        float mean = 0.f;
        if (MIX == 0) { float sm = 0.f;
#pragma unroll
            for (int t = 0; t < 2; ++t)
#pragma unroll
                for (int r = 0; r < 16; ++r) sm += O[t][r];
            sm += __shfl_xor(sm, 32); mean = sm * (1.0f / 64.0f); }
        float ss = 0.f;
#pragma unroll
        for (int t = 0; t < 2; ++t)
#pragma unroll
            for (int r = 0; r < 16; ++r) { const float d = O[t][r] - mean; ss = fmaf(d, d, ss); }
        ss += __shfl_xor(ss, 32);
        const float rs = __builtin_amdgcn_rsqf(ss * (1.0f / 64.0f) + NEPS), mo = -mean * rs;
        asm volatile("" ::: "memory");
#pragma unroll
        for (int t = 0; t < 2; ++t)
#pragma unroll
            for (int s = 0; s < 4; ++s) { float y[4];
#pragma unroll
                for (int j = 0; j < 4; ++j) y[j] = fmaf(O[t][4 * s + j], rs, mo) * silu_f(bfx(g[t][s], j));
                v2u w; w.x = pkbf(y[0], y[1]); w.y = pkbf(y[2], y[3]);
                *(LAS v2u*)(wl + WL_QC + m32 * 144 + (32 * t + 8 * s + 4 * hh) * 2) = w; }
        asm volatile("" ::: "memory");
#pragma unroll
        for (int k = 0; k < 4; ++k) { const v4u w = *(const LAS v4u*)(wl + WL_QC + ((lane >> 3) + 8 * k) * 144 + (lane & 7) * 16);
            GST(v4u, Y + (size_t)(rowc + 8 * k) * 1024 + ycol, 2u * (unsigned)((lane >> 3) * 1024 + (lane & 7) * 8)) = w; }
        asm volatile("" ::: "memory");
    }
}
template <int MIX, int DIR>
__device__ __forceinline__ void mixC_stream(const MixP& mp, const MxC& c, int row0, int tpos0, int lane, LAS unsigned char* wl, f32x16 (&ST)[(MIX == 2) ? 1 : 2][2],
                                            float* OFu, bf16* Y, int ycol, int gcol) {
    f32x16 O[2];
    MxRaw r[4];
#pragma unroll
    for (int i = 0; i < 3; ++i) mx_load<MIX, true, DIR>(r[i], mp, c, row0, i);
    float rc = 1.0f, rs = 0.0f;
    if (MIX == 0 && tpos0 >= 0) { const int tpos = tpos0 + (DIR ? 63 : 0); const int pos = (lane & 32) ? (tpos & 63) : (tpos >> 6);
        const unsigned ro = 4u * (unsigned)(pos * 16 + (lane & 15)); rc = GLD(float, mp.rcos, ro); rs = GLD(float, mp.rsin, ro); }
    float P = 1.0f;
#pragma unroll 1
    for (int b4 = 0; b4 < 16; b4 += 4) {
        int ln = lane; asm volatile("" : "+v"(ln));
#pragma unroll
        for (int j = 0; j < 4; ++j) {
            if (b4 < 12 || j == 0) mx_load<MIX, true, DIR>(r[(j + 3) & 3], mp, c, row0, b4 + j + 3);
            mx_batch<MIX, true, DIR>(r[j], mp, c, tpos0, ln, wl, (b4 & 4) + j, P, rc, rs);
        }
        if (b4 & 4) {
            const int ck = b4 >> 3, ch = DIR ? 1 - ck : ck; float* OFc = OFu + (size_t)ch * (12 * 2048);
            v2u g[2][4]; f32x4 of[2][4];
            mx_chunk<MIX, DIR, true>(wl, ln, P, ST, O); P = 1.0f;
            if (DIR) mx_epi_loads(mp, ln, row0 + 32 * ch, OFc, gcol, g, of);
            mx_epilogue<MIX, DIR ? 2 : 1>(mp, wl, ln, O, row0 + 32 * ch, OFc, Y, ycol, g, of);
        }
    }
}
template <int MIX>
__device__ __forceinline__ void mixC_unit(const MixP& mp, const float* STG, int idx, int lane_in, float* OF, LAS unsigned char* wl, bf16* Y) {
    int lane = lane_in; asm volatile("" : "+v"(lane));
    constexpr int DK = (MIX == 2) ? 32 : 64, NRT = DK / 32;
    const int bh = idx / NSEG, sg = idx - bh * NSEG, b = bh >> 2, h = bh & 3;
    const int row0 = seg_row0(b, sg), tpos0 = seg_tpos0(sg);
    const int ycol = ((MIX == 0) ? 0 : (MIX == 1 ? 512 : 768)) + h * 64;
    const int gcol = 4 * ((MIX == 0) ? C_RG : (MIX == 1 ? C_HG : C_GG)) + h * 64;
    float* OFu = OF + ((size_t)(row0 >> 5) * 12 + MIX * 4 + h) * 2048;
    const bf16* dsb = (const bf16*)(STG + (MIX == 0 ? ST_DS0 : (MIX == 1 ? ST_DS1 : ST_DS2)));
    f32x16 ST[NRT][2];
#pragma unroll 1
    for (int dir = 0; dir < 2; ++dir) {
        asm volatile("" : "+v"(lane));
        const int m32 = lane & 31, hh = lane >> 5;
        MxC c; mx_consts<MIX>(c, mp, h, dir, lane);
        { const bf16* ds = dsb + (size_t)((dir * 16 + bh) * NSEG + sg) * (DK * 64);
#pragma unroll
          for (int rt = 0; rt < NRT; ++rt)
#pragma unroll
              for (int t = 0; t < 2; ++t)
#pragma unroll
                  for (int r4 = 0; r4 < 4; ++r4) { const v2u v = GLD(v2u, ds + ((rt * 2 + t) * 4 + r4) * 256, 8u * (unsigned)lane);
                      ST[rt][t][4 * r4] = bfx(v, 0); ST[rt][t][4 * r4 + 1] = bfx(v, 1); ST[rt][t][4 * r4 + 2] = bfx(v, 2); ST[rt][t][4 * r4 + 3] = bfx(v, 3); } }
        if (dir == 0) mixC_stream<MIX, 0>(mp, c, row0, tpos0, lane, wl, ST, OFu, Y, ycol, gcol);
        else mixC_stream<MIX, 1>(mp, c, row0, tpos0, lane, wl, ST, OFu, Y, ycol, gcol);
        asm volatile("s_waitcnt vmcnt(0)" ::: "memory");
    }
}
template <int MSEL>
__device__ __forceinline__ void mix_passA(const Frame& F, const Args& a, int l) {
    const MixP mp = make_mixp(F, a, l); const S5P sp = make_s5p(F, a, l);
    float* ST = (float*)(F.ws + WS_X2);
    LAS unsigned char* wl = F.lds + F.wave * WL_BYTES; LAS float* stg = (LAS float*)wl;
    if (MSEL == 15) {
        constexpr int NMX = 3 * 4224, NS5 = 2 * 64 * NSEG;
        const int heavy = NMX - (NMX / F.NGW) * F.NGW, nlight = F.NGW - heavy;
        const int n_all = (NS5 - 4 * nlight) / F.NGW;
        for (int it = 0; ; ++it) {
            int u;
            const int nmine = NMX / F.NGW + (F.gw < heavy ? 1 : 0);
            if (it < nmine) u = F.gw + it * F.NGW;
            else if (it < nmine + n_all) u = NMX + F.gw + (it - nmine) * F.NGW;
            else { const int k2 = it - nmine - n_all; if (F.gw < heavy || k2 >= 4) {
                    const int rest0 = NMX + n_all * F.NGW + 4 * nlight; const int uu = rest0 + F.gw + (k2 - (F.gw < heavy ? 0 : 4)) * F.NGW; if (uu >= NMX + NS5) break; u = uu; }
                else u = NMX + n_all * F.NGW + (F.gw - heavy) + k2 * nlight; }
            if (u >= NMX + NS5) break;
            if (u < 4224) mixA_unit<0>(mp, ST, u, fresh_lane(), wl);
            else if (u < 2 * 4224) mixA_unit<1>(mp, ST, u - 4224, fresh_lane(), wl);
            else if (u < 3 * 4224) mixA_unit<2>(mp, ST, u - 2 * 4224, fresh_lane(), wl);
            else { const int idx = u - 3 * 4224; const int dir = idx / (64 * NSEG), rem = idx - dir * 64 * NSEG, bg = rem / NSEG, sg = rem - bg * NSEG;
                float hre = 0.f, him = 0.f;
                s5_mm<0>(sp, mp.P, bg >> 4, bg & 15, dir, sg, fresh_lane(), hre, him, nullptr, wl, nullptr);
                float* hs = ST + ST_HS + ((size_t)((dir * 64 + bg) * NSEG + sg) * 64 + fresh_lane()) * 2;
                hs[0] = hre; hs[1] = him; }
        }
        return;
    }
    if (MSEL & 1) for (int u = F.gw; u < 4224; u += F.NGW) mixA_unit<0>(mp, ST, u, fresh_lane(), wl);
    if (MSEL & 2) for (int u = F.gw; u < 4224; u += F.NGW) mixA_unit<1>(mp, ST, u, fresh_lane(), wl);
    if (MSEL & 4) for (int u = F.gw; u < 4224; u += F.NGW) mixA_unit<2>(mp, ST, u, fresh_lane(), wl);
    if (MSEL & 8) for (int idx = F.gw; idx < 2 * 64 * NSEG; idx += F.NGW) {
        const int dir = idx / (64 * NSEG), rem = idx - dir * 64 * NSEG, bg = rem / NSEG, sg = rem - bg * NSEG;
        float hre = 0.f, him = 0.f;
        s5_mm<0>(sp, mp.P, bg >> 4, bg & 15, dir, sg, fresh_lane(), hre, him, nullptr, wl, nullptr);
        float* hs = ST + ST_HS + ((size_t)((dir * 64 + bg) * NSEG + sg) * 64 + fresh_lane()) * 2;
        hs[0] = hre; hs[1] = him;
    }
}
__device__ __forceinline__ int chain_seg(int dir, int p) { return dir ? (p < 4 ? 3 - p : 135 - p) : p; }
__device__ __forceinline__ void mix_passB(const Frame& F, const Args& a, int l) {
    float* ST = (float*)(F.ws + WS_X2);
    constexpr int N0 = 32768, N1 = 32768, N2 = 16384, N3 = 8192;
    for (int e = blockIdx.x * 512 + F.tid; e < N0 + N1 + N2 + N3; e += F.G * 512) {
        if (e < N0 + N1 + N2) {
            bf16* base; const float* gb; int dir, esz;
            if (e < N0 + N1) { const int mix = e >= N0, e2 = e - mix * N0, c = e2 >> 10, el = (e2 & 1023) * 4; dir = c >> 4; esz = 4096;
                base = (bf16*)(ST + (mix ? ST_DS1 : ST_DS0)) + (size_t)c * NSEG * 4096 + el; gb = ST + (mix ? ST_G1 : ST_G0) + (size_t)c * NSEG * 64 + 32 * (el >> 11) + 8 * ((el >> 8) & 3) + 4 * ((el >> 7) & 1); }
            else { const int e2 = e - N0 - N1, c = e2 >> 9, el = (e2 & 511) * 4; dir = c >> 4; esz = 2048;
                base = (bf16*)(ST + ST_DS2) + (size_t)c * NSEG * 2048 + el; gb = ST + ST_G2 + (size_t)c * NSEG * 64 + 8 * ((el >> 8) & 3) + 4 * ((el >> 7) & 1); }
            f32x4 run = {0.f, 0.f, 0.f, 0.f};
#pragma unroll 1
            for (int p0 = 0; p0 < NSEG; p0 += 12) {
                f32x4 d[12], gm[12];
#pragma unroll
                for (int q = 0; q < 12; ++q) { const int sg = chain_seg(dir, p0 + q); const v2u w = *(const v2u*)(base + (size_t)sg * esz); d[q] = (f32x4){bfx(w, 0), bfx(w, 1), bfx(w, 2), bfx(w, 3)}; gm[q] = *(const f32x4*)(gb + sg * 64); }
#pragma unroll
                for (int q = 0; q < 12; ++q) { const int sg = chain_seg(dir, p0 + q); v2u w; w.x = pkbf(run[0], run[1]); w.y = pkbf(run[2], run[3]); *(v2u*)(base + (size_t)sg * esz) = w; run = run * gm[q] + d[q]; }
            }
        } else {
            const int e2 = e - N0 - N1 - N2, c = e2 >> 6, p = e2 & 63, dir = c >> 6, g = c & 15;
            const int dg = dir * 16 + g;
            const float lre = a.in[F.zz + I_LAMRE][(size_t)l * 2048 + dg * 64 + p], lim = a.in[F.zz + I_LAMIM][(size_t)l * 2048 + dg * 64 + p], dt = expf(a.in[F.zz + I_LOGDT][l * 32 + dg]);
            const float er = expf(lre * dt * 64.0f); const float sn = sinf(lim * dt * 64.0f), cs = cosf(lim * dt * 64.0f);
            const float ar = er * cs, ai = er * sn;
            float* base = ST + ST_HS + ((size_t)c * NSEG * 64 + p) * 2;
            float rr = 0.f, ri = 0.f;
#pragma unroll 1
            for (int q0 = 0; q0 < NSEG; q0 += 12) {
                float dr[12], di[12];
#pragma unroll
                for (int q = 0; q < 12; ++q) { const int sg = chain_seg(dir, q0 + q); dr[q] = base[(size_t)sg * 128]; di[q] = base[(size_t)sg * 128 + 1]; }
#pragma unroll
                for (int q = 0; q < 12; ++q) { const int sg = chain_seg(dir, q0 + q); base[(size_t)sg * 128] = rr; base[(size_t)sg * 128 + 1] = ri;
                    const float nr = ar * rr - ai * ri + dr[q], ni = ar * ri + ai * rr + di[q]; rr = nr; ri = ni; }
            }
        }
    }
}
template <int MSEL>
__device__ __forceinline__ void mix_passC(const Frame& F, const Args& a, int l) {
    const MixP mp = make_mixp(F, a, l); const S5P sp = make_s5p(F, a, l);
    const float* ST = (const float*)(F.ws + WS_X2);
    LAS unsigned char* wl = F.lds + F.wave * WL_BYTES;
    LAS float* stg = (LAS float*)wl; LAS float* of = (LAS float*)(wl + 9216);
    float* OF = (float*)(F.ws + WS_OF);
    bf16* Y = (bf16*)(F.ws + WS_ACT); bf16* Z = (bf16*)(F.ws + WS_Z);
    const bool keep = l < DEPTH - 1;
    constexpr int NM = 16 * NSEG;
    if (MSEL == 15) {
        constexpr int NMX = 3 * NM, NS5 = 64 * NSEG;
        const int heavy = NMX - (NMX / F.NGW) * F.NGW, nlight = F.NGW - heavy;
        for (int it = 0; ; ++it) {
            int u;
            const int nmine = NMX / F.NGW + (F.gw < heavy ? 1 : 0);
            if (it < nmine) u = F.gw + it * F.NGW;
            else { if (F.gw < heavy) break; u = NMX + (F.gw - heavy) + (it - nmine) * nlight; }
            if (u >= NMX + NS5) break;
            const int sgu = (u < 3 * NM) ? (u % NSEG) : ((u - 3 * NM) % NSEG);
            if (!keep && sgu < 4) continue;
            if (u < NM) mixC_unit<0>(mp, ST, u, fresh_lane(), OF, wl, Y);
            else if (u < 2 * NM) mixC_unit<1>(mp, ST, u - NM, fresh_lane(), OF, wl, Y);
            else if (u < 3 * NM) mixC_unit<2>(mp, ST, u - 2 * NM, fresh_lane(), OF, wl, Y);
            else { const int idx = u - 3 * NM, bg = idx / NSEG, sg = idx - bg * NSEG;
                const float* h0 = ST + ST_HS + ((size_t)((0 * 64 + bg) * NSEG + sg) * 64 + fresh_lane()) * 2;
                float hre = h0[0], him = h0[1];
                s5_mm<1>(sp, mp.P, bg >> 4, bg & 15, 0, sg, fresh_lane(), hre, him, of, wl, Z);
                const float* h1 = ST + ST_HS + ((size_t)((1 * 64 + bg) * NSEG + sg) * 64 + fresh_lane()) * 2;
                hre = h1[0]; him = h1[1];
                s5_mm<2>(sp, mp.P, bg >> 4, bg & 15, 1, sg, fresh_lane(), hre, him, of, wl, Z); }
        }
        return;
    }
    if (MSEL & 1) for (int u = F.gw; u < NM; u += F.NGW) { if (!keep && (u % NSEG) < 4) continue; mixC_unit<0>(mp, ST, u, fresh_lane(), OF, wl, Y); }
    if (MSEL & 2) for (int u = F.gw; u < NM; u += F.NGW) { if (!keep && (u % NSEG) < 4) continue; mixC_unit<1>(mp, ST, u, fresh_lane(), OF, wl, Y); }
    if (MSEL & 4) for (int u = F.gw; u < NM; u += F.NGW) { if (!keep && (u % NSEG) < 4) continue; mixC_unit<2>(mp, ST, u, fresh_lane(), OF, wl, Y); }
    if (MSEL & 8) for (int idx = F.gw; idx < 64 * NSEG; idx += F.NGW) {
        const int bg = idx / NSEG, sg = idx - bg * NSEG;
        if (!keep && sg < 4) continue;
        const float* h0 = ST + ST_HS + ((size_t)((0 * 64 + bg) * NSEG + sg) * 64 + fresh_lane()) * 2;
        float hre = h0[0], him = h0[1];
        s5_mm<1>(sp, mp.P, bg >> 4, bg & 15, 0, sg, fresh_lane(), hre, him, of, wl, Z);
        const float* h1 = ST + ST_HS + ((size_t)((1 * 64 + bg) * NSEG + sg) * 64 + fresh_lane()) * 2;
        hre = h1[0]; him = h1[1];
        s5_mm<2>(sp, mp.P, bg >> 4, bg & 15, 1, sg, fresh_lane(), hre, him, of, wl, Z);
    }
}

constexpr int NPH = 11;
template <int PH_MASK, int MSEL>
__global__ void __launch_bounds__(512, 2) mk_fwd(Args a) {
    extern __shared__ __attribute__((aligned(16))) unsigned char lds_raw[];
    Frame F;
    F.lds = (LAS unsigned char*)lds_raw;
    const int wave0 = __builtin_amdgcn_readfirstlane((int)threadIdx.x >> 6);
    F.lane = fresh_lane(); F.tid = wave0 * 64 + F.lane; F.wave = wave0;
    F.G = gridDim.x; F.gw = blockIdx.x * 8 + F.wave; F.NGW = F.G * 8; F.zz = 0; F.ws = (unsigned char*)a.in[I_WS]; F.out = (float*)a.in[I_OUT];
    volatile LAS unsigned* MISC = (volatile LAS unsigned*)(F.lds + MISC_OFF);
    for (int u = F.tid; u < 64; u += 512) ((LAS unsigned*)(F.lds + MISC_OFF))[u] = 0u;
    __syncthreads();
    XcdBarrier bar; bar.bar = (unsigned*)F.ws + CW_BAR; bar.x = 0; bar.st = nullptr;
    if (a.fused) bar = xcd_barrier_post((unsigned*)F.ws + CW_BAR, MISC + 8, F.tid);
#define SEAM() do { if (a.fused) { XcdBarrier bb = bar; asm volatile("" : "+s"(bb.bar), "+s"(bb.x)); xcd_barrier(bb, wave0 * 64 + fresh_lane()); } } while (0)
#define PHASE_BEGIN() do { int zz_ = 0; asm volatile("" : "+s"(zz_)); F.zz = zz_; F.ws = (unsigned char*)a.in[I_WS + zz_]; F.out = (float*)a.in[I_OUT + zz_]; \
        const int ln_ = fresh_lane(); const int t_ = wave0 * 64 + ln_ + zz_; F.tid = t_; F.lane = t_ & 63; F.wave = wave0 + zz_; F.G = (int)gridDim.x + zz_; F.gw = ((int)blockIdx.x + zz_) * 8 + F.wave; F.NGW = F.G * 8; \
        F.lds = (LAS unsigned char*)lds_raw + zz_; } while (0)
#define IN(k) (((PH_MASK >> (k)) & 1) && a.ph_lo <= (k) && (k) < a.ph_hi)
#ifndef DUP_PH
#define DUP_PH 0
#endif
#define REP(k) for (int rep_ = 0; rep_ < (((DUP_PH >> (k)) & 1) ? 2 : 1); ++rep_)
#define hb ((float*)(F.ws + WS_HB))
#define MOD ((const float*)(F.ws + WS_MOD))
#define ACT ((bf16*)(F.ws + WS_ACT))
#define PH ((bf16*)(F.ws + WS_PH))

    if (((PH_MASK >> 12) & 1) && a.do_pro) REP(12) { PHASE_BEGIN(); s5_build(F, a); prologue(F, a); SEAM(); }

#pragma unroll
    for (int l = 0; l < DEPTH; ++l) {
        if (l < a.l_lo || l >= a.l_hi) continue;
        const bool keep = l < DEPTH - 1, moe = l & 1; const int j = l >> 1;
        const int Mrows = keep ? MT : NLAT;
        if (IN(0)) for (int rep_ = 0; rep_ < ((((DUP_PH >> 0) & 1) && l != 2) ? 2 : 1); ++rep_) { PHASE_BEGIN();
            norm_phase<0>(F, a, l, 0, MT, (l == 2) ? 1 : -1);
            SEAM();
        }
        if (IN(1)) REP(1) { PHASE_BEGIN();
            pg8::Gemm g{ACT, (const bf16*)(F.ws + WS_WIN) + (size_t)l * DINP * 1024, MT, DINP, 1024}; pg8::StaticOrder S; S.init(MT, DINP, F.G, (int)blockIdx.x);
            EpiStoreP4 E{PH};
            pg8::gemm_phase<EpiStoreP4, pg8::StaticOrder, true, true>(F.lds, g, S, E, F.tid);
            SEAM();
        }
        if (IN(2)) { PHASE_BEGIN(); mix_passA<MSEL>(F, a, l); SEAM(); }
#ifdef DUP_MIX
        if (IN(2)) { PHASE_BEGIN(); mix_passA<DUP_MIX>(F, a, l); SEAM(); }
#endif
#ifdef DUP_A
        if (IN(2)) { PHASE_BEGIN(); mix_passA<DUP_A>(F, a, l); SEAM(); }
#endif
        if (IN(3)) { PHASE_BEGIN(); mix_passB(F, a, l); SEAM(); }
        if (IN(4)) { PHASE_BEGIN(); mix_passC<MSEL>(F, a, l); SEAM(); }
#ifdef DUP_MIX
        if (IN(4)) { PHASE_BEGIN(); mix_passC<DUP_MIX>(F, a, l); SEAM(); }
#endif
#ifdef DUP_C
        if (IN(4)) { PHASE_BEGIN(); mix_passC<DUP_C>(F, a, l); SEAM(); }
#endif
        if (IN(5)) REP(5) { PHASE_BEGIN();
            int k256 = 256; asm volatile("" : "+s"(k256)); pg8::Gemm g{(const bf16*)(F.ws + WS_Z), (const bf16*)(F.ws + WS_GLUW) + (size_t)l * 65536, Mrows, 256, k256}; pg8::StaticOrder S; S.init(Mrows, 256, F.G, (int)blockIdx.x);
            EpiGlu E{(const bf16*)(F.ws + WS_Z), ACT, a.in[F.zz + I_GLUB] + l * 256};
            pg8::gemm_phase<EpiGlu, pg8::StaticOrder, true, true>(F.lds, g, S, E, F.tid);
            SEAM();
        }
        if (IN(6)) { PHASE_BEGIN();
            pg8::Gemm g{ACT, (const bf16*)(F.ws + WS_WOUT) + (size_t)l * 1024 * 1024, Mrows, 1024, 1024}; pg8::StaticOrder S; S.init(Mrows, 1024, F.G, (int)blockIdx.x);
            EpiResid E{(l == 0) ? a.in[F.zz + I_X] : F.out, (l == 0) ? a.in[F.zz + I_CTX] : hb, F.out, hb, MOD + (size_t)l * 5 * 6144 + 2 * 1024, 1.0f};
            pg8::gemm_phase<EpiResid, pg8::StaticOrder, true, true>(F.lds, g, S, E, F.tid);
            SEAM();
        }
        if (IN(7)) for (int rep_ = 0; rep_ < ((((DUP_PH >> 7) & 1) && !moe) ? 2 : 1); ++rep_) { PHASE_BEGIN();
            if (moe) norm_phase<1>(F, a, l, 1, Mrows, -1); else norm_phase<0>(F, a, l, 1, Mrows, -1);
            SEAM();
        }
        if (!moe) {
            if (IN(8)) REP(8) { PHASE_BEGIN();
                pg8::Gemm g{ACT, (const bf16*)(F.ws + WS_W13D) + (size_t)j * 5632 * 1024, Mrows, 5632, 1024}; pg8::StaticOrder S; S.init(Mrows, 5632, F.G, (int)blockIdx.x);
                EpiSwiglu8 E{(unsigned char*)PH, 1.0f};
                pg8::gemm_phase<EpiSwiglu8, pg8::StaticOrder, true, true>(F.lds, g, S, E, F.tid);
                SEAM();
            }
            if (IN(9)) { PHASE_BEGIN();
                int k8 = DFF / 2; asm volatile("" : "+s"(k8)); pg8::Gemm g{PH, (const bf16*)(F.ws + WS_W2D + (size_t)j * 1024 * DFF), Mrows, 1024, k8}; pg8::StaticOrder S; S.init(Mrows, 1024, F.G, (int)blockIdx.x);
                EpiResid E{F.out, hb, F.out, hb, MOD + (size_t)l * 5 * 6144 + 5 * 1024, 1.0f / WSC8};
                pg8::gemm_phase_f8<EpiResid, pg8::StaticOrder, true, true>(F.lds, g, S, E, F.tid);
                { const int rem = ((Mrows / 256) * 4) % F.G; if (rem > 0 && (int)blockIdx.x >= rem) moe_cvt_idle(F, a, j, rem); else if (rem == 0) moe_cvt(F, a, j); }
                SEAM();
            }
        } else {
                        if (IN(8)) REP(8) { PHASE_BEGIN(); moe_gather(F, j); SEAM(); }
            if (IN(9)) REP(9) { PHASE_BEGIN();
                int k8 = 512; asm volatile("" : "+s"(k8)); pg8::Gemm g{(const bf16*)(F.ws + WS_X2), (const bf16*)(F.ws + WS_W13M), 0, 5632, k8}; MoeOrder S; S.init((const unsigned*)F.ws + CW_CNT + j * 8 * 64, 22, F.G, (int)blockIdx.x);
                EpiSwiglu8 E{(unsigned char*)PH, 1.0f / WSC8};
                pg8::gemm_phase_f8<EpiSwiglu8, MoeOrder, true, true>(F.lds, g, S, E, F.tid);
                SEAM();
            }
            if (IN(10)) REP(10) { PHASE_BEGIN();
                int k8 = DFF / 2; asm volatile("" : "+s"(k8)); pg8::Gemm g{PH, (const bf16*)(F.ws + WS_W2M), 0, 1024, k8}; MoeOrder S; S.init((const unsigned*)F.ws + CW_CNT + j * 8 * 64, 4, F.G, (int)blockIdx.x);
                EpiStoreBf16 E{(bf16*)(F.ws + WS_X2), 1024, 1.0f / WSC8};
                pg8::gemm_phase_f8<EpiStoreBf16, MoeOrder, true, true>(F.lds, g, S, E, F.tid);
                SEAM();
            }
        }
    }
    if (((PH_MASK >> 13) & 1) && a.do_fin) { PHASE_BEGIN(); norm_phase<2>(F, a, DEPTH - 1, 0, NLAT, DEPTH - 1); }
#undef SEAM
#undef IN
#undef hb
#undef MOD
#undef ACT
#undef PH
}

#ifndef MK_FUSED
#define MK_FUSED 1
#endif
template <int PM, int MS> static void launch_one(const Args& a, int grid, hipStream_t stream) {
    static bool attr_done = false;
    if (!attr_done) { (void)hipFuncSetAttribute((const void*)mk_fwd<PM, MS>, hipFuncAttributeMaxDynamicSharedMemorySize, LDS_BYTES); attr_done = true; }
    hipLaunchKernelGGL((mk_fwd<PM, MS>), dim3(grid), dim3(512), LDS_BYTES, stream, a);
}
extern "C" void kernel_launch(void* const* d_in, const int* in_sizes, int n_in, void* d_out, int out_size, void* d_ws, size_t ws_size, hipStream_t stream) {
    static int grid = 0;
    if (grid == 0) {
        if (n_in != 35 || in_sizes[0] != NLAT * DM || out_size != NLAT * DM || ws_size < WS_END) {
            fprintf(stderr, "kernel_launch: unexpected shapes / workspace (n_in %d, ws %zu, need %zu); nothing launched\n", n_in, ws_size, (size_t)WS_END); grid = -1; return; }
        int dev = 0, cus = 0;
        if (hipGetDevice(&dev) != hipSuccess || hipDeviceGetAttribute(&cus, hipDeviceAttributeMultiprocessorCount, dev) != hipSuccess) { grid = -1; return; }
        grid = cus;
    }
    if (grid < 0) return;
    (void)hipMemsetAsync((char*)d_ws + WS_CTL, 0, CTL_ZERO_BYTES, stream);
    Args a{};
    for (int i = 0; i < 35; ++i) a.in[i] = (const float*)d_in[i];
    a.in[I_OUT] = (const float*)d_out; a.in[I_WS] = (const float*)d_ws; a.pad = 0;
#if MK_FUSED
    a.l_lo = 0; a.l_hi = DEPTH; a.ph_lo = 0; a.ph_hi = NPH; a.do_pro = 1; a.do_fin = 1; a.fused = 1;
#ifndef TEST_PM
#define TEST_PM 0xFFFF
#endif
#ifndef TEST_MS
#define TEST_MS 15
#endif
    launch_one<TEST_PM, TEST_MS>(a, grid, stream);
#else
    a.fused = 0;
    a.l_lo = 0; a.l_hi = 0; a.ph_lo = 0; a.ph_hi = 0; a.do_pro = 1; a.do_fin = 0;
    launch_one<0x1000, 15>(a, grid, stream);
    a.do_pro = 0;
    for (int l = 0; l < DEPTH; ++l) {
        a.l_lo = l; a.l_hi = l + 1; a.ph_lo = 0; a.ph_hi = NPH;
        launch_one<0x1, 15>(a, grid, stream); launch_one<0x2, 15>(a, grid, stream); launch_one<0x4, 15>(a, grid, stream); launch_one<0x8, 15>(a, grid, stream);
        launch_one<0x10, 1>(a, grid, stream); launch_one<0x10, 2>(a, grid, stream); launch_one<0x10, 4>(a, grid, stream); launch_one<0x10, 8>(a, grid, stream);
        launch_one<0x20, 15>(a, grid, stream); launch_one<0x40, 15>(a, grid, stream); launch_one<0x80, 15>(a, grid, stream);
        launch_one<0x100, 15>(a, grid, stream); launch_one<0x200, 15>(a, grid, stream);
        if (l & 1) launch_one<0x400, 15>(a, grid, stream);
    }
    a.l_lo = 0; a.l_hi = 0; a.ph_lo = 0; a.ph_hi = 0; a.do_fin = 1;
    launch_one<0x2000, 15>(a, grid, stream);
#endif
}
```

```cpp
#include <hip/hip_runtime.h>
#include <cstdio>
#include <cstdint>
#define LAS __attribute__((address_space(3)))
namespace pg8 {
#define PG8_LAS __attribute__((address_space(3)))
typedef unsigned short bf16_t;
typedef short bf16x8 __attribute__((ext_vector_type(8)));
typedef float f32x4 __attribute__((ext_vector_type(4)));
typedef unsigned u32x4 __attribute__((ext_vector_type(4)));
constexpr int BM = 256, BK = 64, HALF = 128, HTB = HALF * BK * 2  , STAGE_BYTES = 8 * HTB, NXCD = 8, WGM = 8;

__host__ __device__ __forceinline__ int lds_byte(int r, int c) { const int st = (r >> 4) * 2 + (c >> 5), rr = r & 15, cc = c & 31, ob = rr * 64 + cc * 2; return st * 1024 + (ob ^ (((ob >> 9) & 1) << 5)); }
__host__ __device__ __forceinline__ void stage_rc(int b, int& R, int& C) { const int st = b / 1024, sb = b % 1024, swz = sb ^ (((sb >> 9) & 1) << 5); R = (st >> 1) * 16 + swz / 64; C = (st & 1) * 32 + (swz % 64) / 2; }
__host__ __device__ __forceinline__ int perm32(int rho) { const int n = rho >> 4, i = rho & 15; return 8 * (i >> 2) + 4 * n + (i & 3); }

__host__ __device__ __forceinline__ int perm32f(int rho) { return 2 * (rho & 15) + (rho >> 4); }
template <class E, class = void> struct epi_flip { static constexpr bool v = false; };
template <class E> struct epi_flip<E, decltype((void)E::FLIP)> { static constexpr bool v = E::FLIP; };
struct Unit { int pm, pn, pc; };
struct Gemm { const bf16_t* A; const bf16_t* Bt; int M, N, K; };

struct StaticOrder {
    int nM, nN, nwg, G, c;
    __host__ __device__ void init(int M, int N, int G_, int c_) { nM = M / BM; nN = N / BM; nwg = nM * nN; G = G_; c = c_; }
    __host__ __device__ bool next(int i, Unit& u) const {
        const long L = (long)i * G + c; if (L >= nwg) return false;
        int wgid = (int)L; { const int q = nwg / NXCD, r = nwg % NXCD, xcd = wgid % NXCD, off = wgid / NXCD; wgid = (xcd < r ? xcd * (q + 1) : r * (q + 1) + (xcd - r) * q) + off; }
        const int nig = WGM * nN, gid = wgid / nig, fm = gid * WGM, gsz = (nM - fm) < WGM ? (nM - fm) : WGM;
        u.pm = fm + ((wgid % nig) % gsz); u.pn = (wgid % nig) / gsz; u.pc = u.pn; return true;
    }
    __device__ __forceinline__ void a_ready(const Unit&) const {}
    __device__ __forceinline__ void done(const Unit&) const {}
};

__device__ __forceinline__ unsigned cvt_pk_bf16(float lo, float hi) { unsigned r; asm volatile("v_cvt_pk_bf16_f32 %0, %1, %2" : "=v"(r) : "v"(lo), "v"(hi)); return r; }
typedef float f32x2 __attribute__((ext_vector_type(2)));

template <class Epi, class Sched, bool ALIGN_EPI = false, bool SP2 = false>
__device__ __forceinline__ void gemm_phase(PG8_LAS unsigned char* lds, const Gemm g, const Sched& S, const Epi& E, const int tid) {
    const int wid = __builtin_amdgcn_readfirstlane(tid >> 6), lane = tid & 63, wr = wid >> 2, wc = wid & 3, fr = lane & 15, fq = lane >> 4;
    const int K = g.K, nt = K / BK;
    unsigned voffA[2], voffB[2];
#pragma unroll
    for (int i = 0; i < 2; ++i) { int R, C; stage_rc(tid * 16 + i * 8192, R, C); const int Rb = epi_flip<Epi>::v ? ((R & ~31) + perm32f(R & 31)) : (Epi::PERM ? ((R & ~31) + perm32(R & 31)) : R);
        voffA[i] = (unsigned)(R * K + C) * 2u; voffB[i] = (unsigned)(Rb * K + C) * 2u; }
    const size_t kstep = (size_t)(BK * 2);
    const size_t hstep = (size_t)HALF * K * 2;
    const size_t tstep = 2 * hstep;
    const unsigned ldsw = (unsigned)wid * 1024u;
    const int aoff = lds_byte(wr * 64 + fr, fq * 8), boff = lds_byte(wc * 32 + fr, fq * 8);
#define PG8_SA(b, h) (((b) * 2 + (h)) * HTB)
#define PG8_SB(b, h) ((4 + (b) * 2 + (h)) * HTB)
#define PG8_STAGE(bufoff, gbase, voff) do { _Pragma("unroll") for (int _i = 0; _i < 2; ++_i) \
        __builtin_amdgcn_global_load_lds((const unsigned*)((const char*)(gbase) + (voff)[_i]), (PG8_LAS unsigned*)(lds + (bufoff) + ldsw + _i * 8192), 16, 0, 0); } while (0)
#define PG8_LDA(dst, b, h) do { _Pragma("unroll") for (int m = 0; m < 4; ++m) _Pragma("unroll") for (int k = 0; k < 2; ++k) dst[m][k] = *(const PG8_LAS bf16x8*)(lds + PG8_SA(b, h) + aoff + m * 2048 + k * 1024); } while (0)
#define PG8_LDB(dst, b, h) do { _Pragma("unroll") for (int n = 0; n < 2; ++n) _Pragma("unroll") for (int k = 0; k < 2; ++k) dst[n][k] = *(const PG8_LAS bf16x8*)(lds + PG8_SB(b, h) + boff + n * 2048 + k * 1024); } while (0)
#define PG8_MMA(ai, bj, At, Bt) do { __builtin_amdgcn_s_setprio(1); _Pragma("unroll") for (int m = 0; m < 4; ++m) _Pragma("unroll") for (int n = 0; n < 2; ++n) _Pragma("unroll") for (int k = 0; k < 2; ++k) \
        { if constexpr (epi_flip<Epi>::v) acc[ai][bj][m][n] = __builtin_amdgcn_mfma_f32_16x16x32_bf16(At[m][k], Bt[n][k], acc[ai][bj][m][n], 0, 0, 0); \
          else acc[ai][bj][m][n] = __builtin_amdgcn_mfma_f32_16x16x32_bf16(Bt[n][k], At[m][k], acc[ai][bj][m][n], 0, 0, 0); } __builtin_amdgcn_s_setprio(0); } while (0)
#define PG8_WAIT_V(n) asm volatile("s_waitcnt vmcnt(" #n ")" ::: "memory")
#define PG8_WAIT_L(n) asm volatile("s_waitcnt lgkmcnt(" #n ")" ::: "memory")
#define PG8_BAR __builtin_amdgcn_s_barrier()
#define PG8_SCHED __builtin_amdgcn_sched_barrier(0)
    Unit cur, nxt; int ui = 0;
    if (!S.next(0, cur)) return;
    f32x4 acc[2][2][4][2];
#pragma unroll
    for (int a = 0; a < 2; ++a)
#pragma unroll
        for (int b = 0; b < 2; ++b)
#pragma unroll
            for (int m = 0; m < 4; ++m)
#pragma unroll
                for (int n = 0; n < 2; ++n) acc[a][b][m][n] = (f32x4){0.f, 0.f, 0.f, 0.f};
    bf16x8 At[4][2], B0[2][2], B1[2][2];
    const char* cA = (const char*)g.A + (size_t)cur.pm * tstep; const char* cB = (const char*)g.Bt + (size_t)cur.pn * tstep;
    S.a_ready(cur);
    if constexpr (SP2) {
        PG8_STAGE(PG8_SB(0, 0), cB, voffB); PG8_STAGE(PG8_SB(0, 1), cB + hstep, voffB); PG8_STAGE(PG8_SA(0, 0), cA, voffA); PG8_STAGE(PG8_SA(0, 1), cA + hstep, voffA);
        if (wr == 1) PG8_BAR;
        PG8_WAIT_V(2); PG8_BAR;
        PG8_STAGE(PG8_SB(1, 0), cB + kstep, voffB); PG8_STAGE(PG8_SA(1, 0), cA + kstep, voffA); PG8_STAGE(PG8_SB(1, 1), cB + hstep + kstep, voffB);
        PG8_WAIT_V(6); PG8_BAR;
    } else {
        PG8_STAGE(PG8_SB(0, 0), cB, voffB); PG8_STAGE(PG8_SA(0, 0), cA, voffA); PG8_STAGE(PG8_SB(0, 1), cB + hstep, voffB); PG8_STAGE(PG8_SA(0, 1), cA + hstep, voffA);
        if (wr == 1) PG8_BAR;
        PG8_WAIT_V(4); PG8_BAR;
        PG8_STAGE(PG8_SB(1, 0), cB + kstep, voffB); PG8_STAGE(PG8_SA(1, 0), cA + kstep, voffA); PG8_STAGE(PG8_SB(1, 1), cB + hstep + kstep, voffB);
        PG8_WAIT_V(6); PG8_BAR;
    }
    for (;;) {
        const bool has_next = S.next(ui + 1, nxt);
        const char* nA = has_next ? (const char*)g.A + (size_t)nxt.pm * tstep : cA; const char* nB = has_next ? (const char*)g.Bt + (size_t)nxt.pn * tstep : cB;
        for (int t = 0; t < nt; t += 2) {
            const bool last = (t == nt - 2);
            const char* a1 = cA + (size_t)(t + 1) * kstep;
            const char* a2 = last ? nA : cA + (size_t)(t + 2) * kstep; const char* b2 = last ? nB : cB + (size_t)(t + 2) * kstep;
            const char* a3 = a2 + kstep; const char* b3 = b2 + kstep;
            if (last && has_next) S.a_ready(nxt);
            if constexpr (SP2) {
            PG8_LDB(B0, 0, 0); PG8_LDB(B1, 0, 1); PG8_SCHED; PG8_LDA(At, 0, 0); PG8_STAGE(PG8_SA(1, 1), a1 + hstep, voffA);
            PG8_WAIT_V(8); PG8_WAIT_L(0); PG8_BAR; PG8_MMA(0, 0, At, B0); PG8_MMA(0, 1, At, B1); PG8_BAR; PG8_SCHED;
            PG8_LDA(At, 0, 1); PG8_STAGE(PG8_SB(0, 0), b2, voffB); PG8_STAGE(PG8_SB(0, 1), b2 + hstep, voffB); PG8_STAGE(PG8_SA(0, 0), a2, voffA);
            PG8_WAIT_V(8); PG8_WAIT_L(0); PG8_BAR; PG8_MMA(1, 0, At, B0); PG8_MMA(1, 1, At, B1); PG8_BAR; PG8_SCHED;
            PG8_LDB(B0, 1, 0); PG8_LDB(B1, 1, 1); PG8_SCHED; PG8_LDA(At, 1, 0); PG8_STAGE(PG8_SA(0, 1), a2 + hstep, voffA);
            PG8_WAIT_V(8); PG8_WAIT_L(0); PG8_BAR; PG8_MMA(0, 0, At, B0); PG8_MMA(0, 1, At, B1); PG8_BAR; PG8_SCHED;
            PG8_LDA(At, 1, 1); PG8_STAGE(PG8_SB(1, 0), b3, voffB); PG8_STAGE(PG8_SB(1, 1), b3 + hstep, voffB); PG8_STAGE(PG8_SA(1, 0), a3, voffA);
            PG8_WAIT_V(8); PG8_WAIT_L(0); PG8_BAR; PG8_MMA(1, 0, At, B0); PG8_MMA(1, 1, At, B1); PG8_BAR; PG8_SCHED;
            } else {
            PG8_LDB(B0, 0, 0); PG8_SCHED; PG8_LDA(At, 0, 0); PG8_STAGE(PG8_SA(1, 1), a1 + hstep, voffA);
            PG8_WAIT_L(8); PG8_BAR; PG8_WAIT_L(0); PG8_MMA(0, 0, At, B0); PG8_BAR; PG8_SCHED;
            PG8_LDB(B1, 0, 1); PG8_STAGE(PG8_SB(0, 0), b2, voffB);
            PG8_BAR; PG8_WAIT_L(0); PG8_MMA(0, 1, At, B1); PG8_BAR;
            PG8_LDA(At, 0, 1); PG8_STAGE(PG8_SA(0, 0), a2, voffA);
            PG8_BAR; PG8_WAIT_L(0); PG8_MMA(1, 0, At, B0); PG8_BAR; PG8_SCHED;
            PG8_STAGE(PG8_SB(0, 1), b2 + hstep, voffB);
            PG8_WAIT_V(6); PG8_BAR; PG8_MMA(1, 1, At, B1); PG8_BAR;
            PG8_LDB(B0, 1, 0); PG8_SCHED; PG8_LDA(At, 1, 0); PG8_STAGE(PG8_SA(0, 1), a2 + hstep, voffA);
            PG8_WAIT_L(8); PG8_BAR; PG8_WAIT_L(0); PG8_MMA(0, 0, At, B0); PG8_BAR; PG8_SCHED;
            PG8_LDB(B1, 1, 1); PG8_STAGE(PG8_SB(1, 0), b3, voffB);
            PG8_BAR; PG8_WAIT_L(0); PG8_MMA(0, 1, At, B1); PG8_BAR;
            PG8_LDA(At, 1, 1); PG8_STAGE(PG8_SA(1, 0), a3, voffA);
            PG8_BAR; PG8_WAIT_L(0); PG8_MMA(1, 0, At, B0); PG8_BAR; PG8_SCHED;
            PG8_STAGE(PG8_SB(1, 1), b3 + hstep, voffB);
            PG8_WAIT_V(6); PG8_BAR; PG8_MMA(1, 1, At, B1); PG8_BAR;
            }
        }
        if constexpr (ALIGN_EPI) { if (wr == 0) PG8_BAR; }
        if constexpr (!Epi::AFTER_DRAIN) { E(acc, cur, wr, wc, fr, fq); S.done(cur); }
        if (!has_next) break;
#pragma unroll
        for (int a = 0; a < 2; ++a)
#pragma unroll
            for (int b = 0; b < 2; ++b)
#pragma unroll
                for (int m = 0; m < 4; ++m)
#pragma unroll
                    for (int n = 0; n < 2; ++n) acc[a][b][m][n] = (f32x4){0.f, 0.f, 0.f, 0.f};
        cur = nxt; cA = nA; cB = nB; ++ui;
        if constexpr (ALIGN_EPI) { if (wr == 1) PG8_BAR; }
    }
    PG8_WAIT_V(0);
    if constexpr (!ALIGN_EPI) { if (wr == 0) PG8_BAR; }
    PG8_BAR;
    if constexpr (Epi::AFTER_DRAIN) { E.fused(acc, cur, wr, wc, fr, fq, lds, wid, lane); S.done(cur); }
#undef PG8_SA
#undef PG8_SB
#undef PG8_STAGE
#undef PG8_LDA
#undef PG8_LDB
#undef PG8_MMA
#undef PG8_WAIT_V
#undef PG8_WAIT_L
#undef PG8_BAR
#undef PG8_SCHED
}
typedef int v8i_t __attribute__((ext_vector_type(8)));
typedef int v4i_t __attribute__((ext_vector_type(4)));
template <class Epi, class Sched, bool ALIGN_EPI = false, bool SP2 = false>
__device__ __forceinline__ void gemm_phase_f8(PG8_LAS unsigned char* lds, const Gemm g, const Sched& S, const Epi& E, const int tid) {
    const int wid = __builtin_amdgcn_readfirstlane(tid >> 6), lane = tid & 63, wr = wid >> 2, wc = wid & 3, fr = lane & 15, fq = lane >> 4;
    const int K = g.K, nt = K / BK;
    unsigned voffA[2], voffB[2];
#pragma unroll
    for (int i = 0; i < 2; ++i) { int R, C; stage_rc(tid * 16 + i * 8192, R, C); const int Rb = Epi::PERM ? ((R & ~31) + perm32(R & 31)) : R;
        voffA[i] = (unsigned)(R * K + C) * 2u; voffB[i] = (unsigned)(Rb * K + C) * 2u; }
    const size_t kstep = (size_t)(BK * 2);
    const size_t hstep = (size_t)HALF * K * 2;
    const size_t tstep = 2 * hstep;
    const unsigned ldsw = (unsigned)wid * 1024u;
    const int aoff0 = lds_byte(wr * 64 + fr, fq * 16), aoff1 = lds_byte(wr * 64 + fr, fq * 16 + 8), boff0 = lds_byte(wc * 32 + fr, fq * 16), boff1 = lds_byte(wc * 32 + fr, fq * 16 + 8);
#define PG8_SA(b, h) (((b) * 2 + (h)) * HTB)
#define PG8_SB(b, h) ((4 + (b) * 2 + (h)) * HTB)
#define PG8_STAGE(bufoff, gbase, voff) do { _Pragma("unroll") for (int _i = 0; _i < 2; ++_i) \
        __builtin_amdgcn_global_load_lds((const unsigned*)((const char*)(gbase) + (voff)[_i]), (PG8_LAS unsigned*)(lds + (bufoff) + ldsw + _i * 8192), 16, 0, 0); } while (0)
#define PG8_LDA(dst, b, h) do { _Pragma("unroll") for (int m = 0; m < 4; ++m) { const u32x4 lo_ = *(const PG8_LAS u32x4*)(lds + PG8_SA(b, h) + aoff0 + m * 2048), hi_ = *(const PG8_LAS u32x4*)(lds + PG8_SA(b, h) + aoff1 + m * 2048); \
        dst[m] = __builtin_shufflevector((v4i_t)lo_, (v4i_t)hi_, 0, 1, 2, 3, 4, 5, 6, 7); } } while (0)
#define PG8_LDB(dst, b, h) do { _Pragma("unroll") for (int n = 0; n < 2; ++n) { const u32x4 lo_ = *(const PG8_LAS u32x4*)(lds + PG8_SB(b, h) + boff0 + n * 2048), hi_ = *(const PG8_LAS u32x4*)(lds + PG8_SB(b, h) + boff1 + n * 2048); \
        dst[n] = __builtin_shufflevector((v4i_t)lo_, (v4i_t)hi_, 0, 1, 2, 3, 4, 5, 6, 7); } } while (0)
#define PG8_MMA(ai, bj, At, Bt) do { __builtin_amdgcn_s_setprio(1); _Pragma("unroll") for (int m = 0; m < 4; ++m) _Pragma("unroll") for (int n = 0; n < 2; ++n) \
        asm volatile("v_mfma_scale_f32_16x16x128_f8f6f4 %0, %1, %2, %0, %3, %3 op_sel_hi:[0,0,0]" : "+v"(acc[ai][bj][m][n]) : "v"(Bt[n]), "v"(At[m]), "v"(one_scale)); __builtin_amdgcn_s_setprio(0); } while (0)
#define PG8_WAIT_V(n) asm volatile("s_waitcnt vmcnt(" #n ")" ::: "memory")
#define PG8_WAIT_L(n) asm volatile("s_waitcnt lgkmcnt(" #n ")" ::: "memory")
#define PG8_BAR __builtin_amdgcn_s_barrier()
#define PG8_SCHED __builtin_amdgcn_sched_barrier(0)
    Unit cur, nxt; int ui = 0;
    if (!S.next(0, cur)) return;
    f32x4 acc[2][2][4][2];
#pragma unroll
    for (int a = 0; a < 2; ++a)
#pragma unroll
        for (int b = 0; b < 2; ++b)
#pragma unroll
            for (int m = 0; m < 4; ++m)
#pragma unroll
                for (int n = 0; n < 2; ++n) acc[a][b][m][n] = (f32x4){0.f, 0.f, 0.f, 0.f};
    v8i_t At[4], B0[2], B1[2]; const int one_scale = 0x7f7f7f7f;
    const char* cA = (const char*)g.A + (size_t)cur.pm * tstep; const char* cB = (const char*)g.Bt + (size_t)cur.pn * tstep;
    S.a_ready(cur);
    if constexpr (SP2) {
        PG8_STAGE(PG8_SB(0, 0), cB, voffB); PG8_STAGE(PG8_SB(0, 1), cB + hstep, voffB); PG8_STAGE(PG8_SA(0, 0), cA, voffA); PG8_STAGE(PG8_SA(0, 1), cA + hstep, voffA);
        if (wr == 1) PG8_BAR;
        PG8_WAIT_V(2); PG8_BAR;
        PG8_STAGE(PG8_SB(1, 0), cB + kstep, voffB); PG8_STAGE(PG8_SA(1, 0), cA + kstep, voffA); PG8_STAGE(PG8_SB(1, 1), cB + hstep + kstep, voffB);
        PG8_WAIT_V(6); PG8_BAR;
    } else {
        PG8_STAGE(PG8_SB(0, 0), cB, voffB); PG8_STAGE(PG8_SA(0, 0), cA, voffA); PG8_STAGE(PG8_SB(0, 1), cB + hstep, voffB); PG8_STAGE(PG8_SA(0, 1), cA + hstep, voffA);
        if (wr == 1) PG8_BAR;
        PG8_WAIT_V(4); PG8_BAR;
        PG8_STAGE(PG8_SB(1, 0), cB + kstep, voffB); PG8_STAGE(PG8_SA(1, 0), cA + kstep, voffA); PG8_STAGE(PG8_SB(1, 1), cB + hstep + kstep, voffB);
        PG8_WAIT_V(6); PG8_BAR;
    }
    for (;;) {
        const bool has_next = S.next(ui + 1, nxt);
        const char* nA = has_next ? (const char*)g.A + (size_t)nxt.pm * tstep : cA; const char* nB = has_next ? (const char*)g.Bt + (size_t)nxt.pn * tstep : cB;
        for (int t = 0; t < nt; t += 2) {
            const bool last = (t == nt - 2);
            const char* a1 = cA + (size_t)(t + 1) * kstep;
            const char* a2 = last ? nA : cA + (size_t)(t + 2) * kstep; const char* b2 = last ? nB : cB + (size_t)(t + 2) * kstep;
            const char* a3 = a2 + kstep; const char* b3 = b2 + kstep;
            if (last && has_next) S.a_ready(nxt);
            if constexpr (SP2) {
            PG8_LDB(B0, 0, 0); PG8_LDB(B1, 0, 1); PG8_SCHED; PG8_LDA(At, 0, 0); PG8_STAGE(PG8_SA(1, 1), a1 + hstep, voffA);
            PG8_WAIT_V(8); PG8_WAIT_L(0); PG8_BAR; PG8_MMA(0, 0, At, B0); PG8_MMA(0, 1, At, B1); PG8_BAR; PG8_SCHED;
            PG8_LDA(At, 0, 1); PG8_STAGE(PG8_SB(0, 0), b2, voffB); PG8_STAGE(PG8_SB(0, 1), b2 + hstep, voffB); PG8_STAGE(PG8_SA(0, 0), a2, voffA);
            PG8_WAIT_V(8); PG8_WAIT_L(0); PG8_BAR; PG8_MMA(1, 0, At, B0); PG8_MMA(1, 1, At, B1); PG8_BAR; PG8_SCHED;
            PG8_LDB(B0, 1, 0); PG8_LDB(B1, 1, 1); PG8_SCHED; PG8_LDA(At, 1, 0); PG8_STAGE(PG8_SA(0, 1), a2 + hstep, voffA);
            PG8_WAIT_V(8); PG8_WAIT_L(0); PG8_BAR; PG8_MMA(0, 0, At, B0); PG8_MMA(0, 1, At, B1); PG8_BAR; PG8_SCHED;
            PG8_LDA(At, 1, 1); PG8_STAGE(PG8_SB(1, 0), b3, voffB); PG8_STAGE(PG8_SB(1, 1), b3 + hstep, voffB); PG8_STAGE(PG8_SA(1, 0), a3, voffA);
            PG8_WAIT_V(8); PG8_WAIT_L(0); PG8_BAR; PG8_MMA(1, 0, At, B0); PG8_MMA(1, 1, At, B1); PG8_BAR; PG8_SCHED;
            } else {
            PG8_LDB(B0, 0, 0); PG8_SCHED; PG8_LDA(At, 0, 0); PG8_STAGE(PG8_SA(1, 1), a1 + hstep, voffA);
            PG8_WAIT_L(8); PG8_BAR; PG8_WAIT_L(0); PG8_MMA(0, 0, At, B0); PG8_BAR; PG8_SCHED;
            PG8_LDB(B1, 0, 1); PG8_STAGE(PG8_SB(0, 0), b2, voffB);
            PG8_BAR; PG8_WAIT_L(0); PG8_MMA(0, 1, At, B1); PG8_BAR;
            PG8_LDA(At, 0, 1); PG8_STAGE(PG8_SA(0, 0), a2, voffA);
            PG8_BAR; PG8_WAIT_L(0); PG8_MMA(1, 0, At, B0); PG8_BAR; PG8_SCHED;
            PG8_STAGE(PG8_SB(0, 1), b2 + hstep, voffB);
            PG8_WAIT_V(6); PG8_BAR; PG8_MMA(1, 1, At, B1); PG8_BAR;
            PG8_LDB(B0, 1, 0); PG8_SCHED; PG8_LDA(At, 1, 0); PG8_STAGE(PG8_SA(0, 1), a2 + hstep, voffA);
            PG8_WAIT_L(8); PG8_BAR; PG8_WAIT_L(0); PG8_MMA(0, 0, At, B0); PG8_BAR; PG8_SCHED;
            PG8_LDB(B1, 1, 1); PG8_STAGE(PG8_SB(1, 0), b3, voffB);
            PG8_BAR; PG8_WAIT_L(0); PG8_MMA(0, 1, At, B1); PG8_BAR;
            PG8_LDA(At, 1, 1); PG8_STAGE(PG8_SA(1, 0), a3, voffA);
            PG8_BAR; PG8_WAIT_L(0); PG8_MMA(1, 0, At, B0); PG8_BAR; PG8_SCHED;
            PG8_STAGE(PG8_SB(1, 1), b3 + hstep, voffB);
            PG8_WAIT_V(6); PG8_BAR; PG8_MMA(1, 1, At, B1); PG8_BAR;
            }
        }
        if constexpr (ALIGN_EPI) { if (wr == 0) PG8_BAR; }
        asm volatile("s_nop 15\n\ts_nop 15" ::: "memory");
        if constexpr (!Epi::AFTER_DRAIN) { E(acc, cur, wr, wc, fr, fq); S.done(cur); }
        if (!has_next) break;
#pragma unroll
        for (int a = 0; a < 2; ++a)
#pragma unroll
            for (int b = 0; b < 2; ++b)
#pragma unroll
                for (int m = 0; m < 4; ++m)
#pragma unroll
                    for (int n = 0; n < 2; ++n) acc[a][b][m][n] = (f32x4){0.f, 0.f, 0.f, 0.f};
        cur = nxt; cA = nA; cB = nB; ++ui;
        if constexpr (ALIGN_EPI) { if (wr == 1) PG8_BAR; }
    }
    PG8_WAIT_V(0);
    if constexpr (!ALIGN_EPI) { if (wr == 0) PG8_BAR; }
    PG8_BAR;
    if constexpr (Epi::AFTER_DRAIN) { E.fused(acc, cur, wr, wc, fr, fq, lds, wid, lane); S.done(cur); }
#undef PG8_SA
#undef PG8_SB
#undef PG8_STAGE
#undef PG8_LDA
#undef PG8_LDB
#undef PG8_MMA
#undef PG8_WAIT_V
#undef PG8_WAIT_L
#undef PG8_BAR
#undef PG8_SCHED
}
}

#define XB_TMO      128
#define XB_XCNT(j)  (256  + 64 * (j))
#define XB_XSUB(j)  (1280 + 64 * (j))
#define XB_XGEN(j)  (2304 + 64 * (j))
#define XB_TOP      3328
#define XB_TOPGEN   3392
#define XCD_BAR_WORDS 3456
#define XB_SPIN_CAP (1u << 18)

__device__ __forceinline__ unsigned xb_ld(unsigned* p)              { return __hip_atomic_load(p, __ATOMIC_RELAXED, __HIP_MEMORY_SCOPE_AGENT); }
__device__ __forceinline__ unsigned xb_add(unsigned* p, unsigned v) { return __hip_atomic_fetch_add(p, v, __ATOMIC_RELAXED, __HIP_MEMORY_SCOPE_AGENT); }
__device__ __forceinline__ unsigned xb_xcc_id() { return (unsigned)__builtin_amdgcn_s_getreg((3 << 11) | 20) & 0xFu; }
#define XB_SPIN(cond, bar) do { unsigned _sp = 0; while (cond) { __builtin_amdgcn_s_sleep(1); \
    if ((++_sp & 255u) == 0u) { if (xb_ld(&(bar)[XB_TMO])) break; if (_sp > XB_SPIN_CAP) { atomicAdd(&(bar)[XB_TMO], 1u); break; } } } } while (0)

struct XcdBarrier {
    unsigned* bar; unsigned x;
    volatile LAS unsigned* st;
};

__device__ __forceinline__ XcdBarrier xcd_barrier_post(unsigned* bar, volatile LAS unsigned* st, const int xb_tid) {
    XcdBarrier b; b.bar = bar; b.x = xb_xcc_id(); b.st = st;
    if (xb_tid == 0) (void)xb_add(&bar[XB_XCNT(b.x)], 1u);
    return b;
}
__device__ __forceinline__ void xcd_barrier_complete(unsigned* bar, unsigned x, unsigned& nloc, unsigned& nx) {
    const unsigned G = gridDim.x * gridDim.y * gridDim.z;
    unsigned sum, cnt, mine, sp = 0u;
    for (;;) {
        sum = 0u; cnt = 0u; mine = 0u;
#pragma unroll
        for (unsigned j = 0; j < 16; ++j) { const unsigned c = xb_ld(&bar[XB_XCNT(j)]); sum += c; cnt += (c > 0u) ? 1u : 0u; mine = (j == x) ? c : mine; }
        if (sum == G) break;
        __builtin_amdgcn_s_sleep(1);
        if ((++sp & 255u) == 0u) { if (xb_ld(&bar[XB_TMO])) break; if (sp > XB_SPIN_CAP) { atomicAdd(&bar[XB_TMO], 1u); break; } }
    }
    nloc = mine > 0u ? mine : 1u; nx = cnt > 0u ? cnt : 1u;
}

__device__ __forceinline__ void xcd_barrier(const XcdBarrier& b, const int xb_tid) {
    asm volatile("s_waitcnt vmcnt(0)" ::: "memory");
    __syncthreads();
    if (xb_tid == 0) {
        unsigned* bar = b.bar;
        __builtin_amdgcn_s_waitcnt(0);
        unsigned nloc = b.st[0], nx = b.st[1];
        if (nloc == 0u) { xcd_barrier_complete(bar, b.x, nloc, nx); b.st[0] = nloc; b.st[1] = nx; }
        const unsigned old = xb_add(&bar[XB_XSUB(b.x)], 1u);
        const unsigned gen = old / nloc;
        if (old + 1u == (gen + 1u) * nloc) {
            __builtin_amdgcn_fence(__ATOMIC_RELEASE, "agent");
            asm volatile("s_waitcnt vmcnt(0)" ::: "memory");
            const unsigned og = xb_add(&bar[XB_TOP], 1u);
            const unsigned tg = og / nx;
            if (og + 1u == (tg + 1u) * nx) xb_add(&bar[XB_TOPGEN], 1u);
            else XB_SPIN(xb_ld(&bar[XB_TOPGEN]) == tg, bar);
            __builtin_amdgcn_fence(__ATOMIC_ACQUIRE, "agent");
            xb_add(&bar[XB_XGEN(b.x)], 1u);
            asm volatile("s_waitcnt vmcnt(0)" ::: "memory");
        } else {
            XB_SPIN(xb_ld(&bar[XB_XGEN(b.x)]) == gen, bar);
            __builtin_amdgcn_fence(__ATOMIC_ACQUIRE, "agent");
            asm volatile("s_waitcnt vmcnt(0)" ::: "memory");
        }
    }
    __syncthreads();
}

__device__ __forceinline__ void group_arrive(unsigned* cnt, const int xb_tid) {
    asm volatile("s_waitcnt vmcnt(0)" ::: "memory");
    __syncthreads();
    if (xb_tid == 0) {
        __builtin_amdgcn_s_waitcnt(0);
        __builtin_amdgcn_fence(__ATOMIC_RELEASE, "agent");
        asm volatile("s_waitcnt vmcnt(0)" ::: "memory");
        (void)xb_add(cnt, 1u);
    }
}
__device__ __forceinline__ void group_wait(unsigned* bar, unsigned* cnt, unsigned n, const int xb_tid) {
    __syncthreads();
    if (xb_tid == 0) {
        XB_SPIN(xb_ld(cnt) < n, bar);
        __builtin_amdgcn_fence(__ATOMIC_ACQUIRE, "agent");
        asm volatile("s_waitcnt vmcnt(0)" ::: "memory");
    }
    __syncthreads();
}

#define GAS __attribute__((address_space(1)))
typedef unsigned short bf16;
typedef unsigned v4u __attribute__((ext_vector_type(4)));
typedef unsigned v2u __attribute__((ext_vector_type(2)));
typedef float f32x4 __attribute__((ext_vector_type(4)));

constexpr int NB = 4, SEQ = 8192, DM = 1024, DEPTH = 4, CTXL = 256;
constexpr int NLAT = NB * SEQ, NCTX = NB * CTXL, MT = NLAT + NCTX;
constexpr int DIN = 3360, DINP = 3584, DFF = 2816, NEXP = 8;
constexpr int C_RQ = 0, C_RK = 256, C_RV = 512, C_RG = 768, C_S5 = 1024, C_HQ = 1280, C_HFF = 1536, C_HFB = 1792, C_HI = 2048, C_HG = 2304,
              C_GQ = 2560, C_GK = 2688, C_GV = 2816, C_GG = 3072, C_GAF = 3328, C_GAB = 3344,
              C_GZF = 3328, C_GZB = 3456;
constexpr int NSEG = 132;
constexpr int MOE_CAP_TILES = 272;
constexpr float NEPS = 1e-6f;
constexpr float WSC8 = 64.0f;

constexpr size_t MiB = 1u << 20;
constexpr size_t WS_CTL = 0, CTL_ZERO_BYTES = 2 * MiB;
constexpr size_t WS_MOD = 2 * MiB;
constexpr size_t WS_LB = 3 * MiB;
constexpr size_t WS_ROPE = 3 * MiB + 65536;
constexpr size_t WS_GLUW = 3 * MiB + 131072;
constexpr size_t WS_WIN = 4 * MiB;
constexpr size_t WS_WOUT = 32 * MiB;
constexpr size_t WS_W13D = 40 * MiB;
constexpr size_t WS_W2D = 62 * MiB;
constexpr size_t WS_W13M = 73 * MiB;
constexpr size_t WS_W2M = 161 * MiB;
constexpr size_t WS_HB = 205 * MiB;
constexpr size_t WS_ACT = 209 * MiB;
constexpr size_t WS_Z = 275 * MiB;
constexpr size_t WS_PH = 292 * MiB;
constexpr size_t WS_OF = (292 + 232) * MiB;
constexpr size_t WS_X2 = 666 * MiB;
constexpr size_t WS_LIST = 843 * MiB;
constexpr size_t WS_S5PAR = 70 * MiB;
constexpr size_t WS_END = 846 * MiB;
constexpr size_t ST_DS0 = 0;
constexpr size_t ST_DS1 = ST_DS0 + (size_t)2 * 16 * NSEG * 4096;
constexpr size_t ST_DS2 = ST_DS1 + (size_t)2 * 16 * NSEG * 4096;
constexpr size_t ST_G0 = ST_DS2 + (size_t)2 * 16 * NSEG * 2048;
constexpr size_t ST_G1 = ST_G0 + (size_t)2 * 16 * NSEG * 64;
constexpr size_t ST_G2 = ST_G1 + (size_t)2 * 16 * NSEG * 64;
constexpr size_t ST_HS = ST_G2 + (size_t)2 * 16 * NSEG * 64;
constexpr size_t ST_END = ST_HS + (size_t)2 * 64 * NSEG * 128;
static_assert(ST_END * 4 <= (WS_LIST - WS_X2), "state region");
static_assert(WS_PH + (size_t)MT * DINP * 2 <= WS_OF && WS_OF + (size_t)MT * 768 * 4 <= WS_X2, "OF region");
static_assert((size_t)MOE_CAP_TILES * 256 * 1024 * 2 <= (WS_LIST - WS_X2), "XB region");
static_assert((size_t)MOE_CAP_TILES * 256 * DFF * 2 <= (WS_X2 - WS_PH) && (size_t)MT * DINP * 2 <= (WS_X2 - WS_PH), "P/H region");
constexpr int CW_BAR = 4096;
constexpr int CW_TAIL = 32768;
constexpr int CW_CNT = 16384;

constexpr int LDS_BYTES = 163840;
constexpr int MISC_OFF = 163840 - 512;

__device__ __forceinline__ float bf2f(unsigned short h) { return __uint_as_float(((unsigned)h) << 16); }
__device__ __forceinline__ unsigned f2bf(float f) { unsigned u = __float_as_uint(f); return (u + 0x7fffu + ((u >> 16) & 1u)) >> 16; }
__device__ __forceinline__ unsigned pk2(float lo, float hi) { return f2bf(lo) | (f2bf(hi) << 16); }
__device__ __forceinline__ float wave_sum(float v) {
#define WS_DPP(ctrl, rmask) v += __int_as_float(__builtin_amdgcn_update_dpp(0, __float_as_int(v), (ctrl), (rmask), 0xf, false))
    WS_DPP(0x111, 0xf); WS_DPP(0x112, 0xf); WS_DPP(0x114, 0xf); WS_DPP(0x118, 0xf); WS_DPP(0x142, 0xa); WS_DPP(0x143, 0xc);
#undef WS_DPP
    return __int_as_float(__builtin_amdgcn_readlane(__float_as_int(v), 63));
}
__device__ __forceinline__ float rdl(float v, int k) { return __uint_as_float((unsigned)__builtin_amdgcn_readlane((int)__float_as_uint(v), k)); }
__device__ __forceinline__ float sigm(float x) { return __builtin_amdgcn_rcpf(1.0f + __expf(-x)); }
__device__ __forceinline__ float silu_f(float x) { return x * __builtin_amdgcn_rcpf(1.0f + __expf(-x)); }
#define LDS_WAIT() asm volatile("s_waitcnt lgkmcnt(0)" ::: "memory")

struct Args {
    const float* in[37];
    int l_lo, l_hi, ph_lo, ph_hi, do_pro, do_fin, fused, pad;
};
constexpr int I_OUT = 35, I_WS = 36;
enum { I_X = 0, I_C, I_CTX, I_CCTX, I_ADAW, I_ADAB, I_N1W, I_N2W, I_WIN, I_WOUT, I_RETGN, I_LAMRE, I_LAMIM, I_LOGDT, I_BRE, I_BIM, I_CRE, I_CIM, I_S5D,
       I_GLUW, I_GLUB, I_LBL, I_HGNW, I_WA2, I_BA, I_GLANW, I_FW1, I_FW3, I_FW2, I_RW, I_RB, I_MW1, I_MW3, I_MW2, I_FINW };

struct Frame {
    LAS unsigned char* lds;
    int tid, lane, wave, gw, NGW, G, zz;
    unsigned char* ws; float* out;
};

struct EpiStoreBf16 {
    static constexpr bool PERM = true, AFTER_DRAIN = false;
    bf16* O; int ldc; float sc;
    __device__ __forceinline__ void operator()(const pg8::f32x4 (&acc)[2][2][4][2], const pg8::Unit& u, int wr, int wc, int fr, int fq) const {
        const int row0 = u.pm * 256 + wr * 64 + fr, col0 = u.pc * 256 + wc * 32 + 8 * fq;
#pragma unroll
        for (int ai = 0; ai < 2; ++ai)
#pragma unroll
            for (int m = 0; m < 4; ++m) { bf16* rowp = O + (size_t)(row0 + ai * 128 + m * 16) * ldc + col0;
#pragma unroll
                for (int bj = 0; bj < 2; ++bj) { const pg8::f32x4 v0 = acc[ai][bj][m][0] * sc, v1 = acc[ai][bj][m][1] * sc;
                    pg8::u32x4 w; w.x = pg8::cvt_pk_bf16(v0[0], v0[1]); w.y = pg8::cvt_pk_bf16(v0[2], v0[3]); w.z = pg8::cvt_pk_bf16(v1[0], v1[1]); w.w = pg8::cvt_pk_bf16(v1[2], v1[3]);
                    *(pg8::u32x4*)(rowp + bj * 128) = w; } }
    }
};
constexpr int P4G = 4 * DINP, P4S5 = 4096;
struct EpiStoreP4 {
    static constexpr bool PERM = true, FLIP = true, AFTER_DRAIN = false;
    bf16* O;
    __device__ __forceinline__ void operator()(const pg8::f32x4 (&acc)[2][2][4][2], const pg8::Unit& u, int wr, int wc, int fr, int fq) const {
        const int grp0 = u.pm * 64 + wr * 16 + fq;
        if (!(u.pc == 3 || u.pc == 4 || u.pc == 9 || u.pc == 12)) {
            bf16* base = O + (size_t)grp0 * P4G + (size_t)(u.pc * 256 + wc * 32 + 2 * fr) * 4;
#pragma unroll
            for (int ai = 0; ai < 2; ++ai)
#pragma unroll
                for (int m = 0; m < 4; ++m) { bf16* gp = base + (size_t)(ai * 32 + m * 4) * P4G;
#pragma unroll
                    for (int bj = 0; bj < 2; ++bj) { const pg8::f32x4 v0 = acc[ai][bj][m][0], v1 = acc[ai][bj][m][1];
                        pg8::u32x4 w; w.x = pg8::cvt_pk_bf16(v0[0], v0[1]); w.y = pg8::cvt_pk_bf16(v0[2], v0[3]); w.z = pg8::cvt_pk_bf16(v1[0], v1[1]); w.w = pg8::cvt_pk_bf16(v1[2], v1[3]);
                        *(pg8::u32x4*)(gp + bj * 512) = w; } }
        } else {
            bf16* base = O + (size_t)grp0 * P4G + u.pc * 1024 + wc * 32 + 2 * fr;
#pragma unroll
            for (int ai = 0; ai < 2; ++ai)
#pragma unroll
                for (int m = 0; m < 4; ++m) { bf16* gp = base + (size_t)(ai * 32 + m * 4) * P4G;
#pragma unroll
                    for (int bj = 0; bj < 2; ++bj)
#pragma unroll
                        for (int r = 0; r < 4; ++r) *(unsigned*)(gp + r * 256 + bj * 128) = pg8::cvt_pk_bf16(acc[ai][bj][m][0][r], acc[ai][bj][m][1][r]); }
        }
    }
};
struct EpiSwiglu {
    static constexpr bool PERM = true, AFTER_DRAIN = false;
    bf16* H;
    __device__ __forceinline__ void operator()(const pg8::f32x4 (&acc)[2][2][4][2], const pg8::Unit& u, int wr, int wc, int fr, int fq) const {
        const int row0 = u.pm * 256 + wr * 64 + fr, col0 = u.pc * 128 + wc * 32 + 8 * fq;
#pragma unroll
        for (int ai = 0; ai < 2; ++ai)
#pragma unroll
            for (int m = 0; m < 4; ++m) { bf16* rowp = H + (size_t)(row0 + ai * 128 + m * 16) * DFF + col0;
                float h[8];
#pragma unroll
                for (int n = 0; n < 2; ++n)
#pragma unroll
                    for (int j = 0; j < 4; ++j) { const float a = acc[ai][0][m][n][j], b = acc[ai][1][m][n][j];
                        h[n * 4 + j] = a * __builtin_amdgcn_rcpf(1.0f + __builtin_amdgcn_exp2f(-1.4426950408889634f * a)) * b; }
                pg8::u32x4 w; w.x = pg8::cvt_pk_bf16(h[0], h[1]); w.y = pg8::cvt_pk_bf16(h[2], h[3]); w.z = pg8::cvt_pk_bf16(h[4], h[5]); w.w = pg8::cvt_pk_bf16(h[6], h[7]);
                *(pg8::u32x4*)rowp = w; }
    }
};
struct EpiSwiglu8 {
    static constexpr bool PERM = true, AFTER_DRAIN = false;
    unsigned char* H; float sc;
    __device__ __forceinline__ void operator()(const pg8::f32x4 (&acc)[2][2][4][2], const pg8::Unit& u, int wr, int wc, int fr, int fq) const {
        const int row0 = u.pm * 256 + wr * 64 + fr, col0 = u.pc * 128 + wc * 32 + 8 * fq;
#pragma unroll
        for (int ai = 0; ai < 2; ++ai)
#pragma unroll
            for (int m = 0; m < 4; ++m) { unsigned char* rowp = H + (size_t)(row0 + ai * 128 + m * 16) * DFF + col0;
                float h[8];
#pragma unroll
                for (int n = 0; n < 2; ++n)
#pragma unroll
                    for (int j = 0; j < 4; ++j) { const float a = acc[ai][0][m][n][j] * sc, b = acc[ai][1][m][n][j] * sc;
                        const float hv = a * __builtin_amdgcn_rcpf(1.0f + __builtin_amdgcn_exp2f(-1.4426950408889634f * a)) * b;
                        h[n * 4 + j] = fminf(fmaxf(hv, -448.0f), 448.0f); }
                unsigned w0 = 0u, w1 = 0u;
                w0 = __builtin_amdgcn_cvt_pk_fp8_f32(h[0], h[1], w0, false); w0 = __builtin_amdgcn_cvt_pk_fp8_f32(h[2], h[3], w0, true);
                w1 = __builtin_amdgcn_cvt_pk_fp8_f32(h[4], h[5], w1, false); w1 = __builtin_amdgcn_cvt_pk_fp8_f32(h[6], h[7], w1, true);
                v2u w; w.x = w0; w.y = w1; *(v2u*)rowp = w; }
    }
};
struct EpiResid {
    static constexpr bool PERM = false, AFTER_DRAIN = false;
    const float* xin_lat; const float* xin_ctx; float* xout_lat; float* xout_ctx; const float* gate; float sc; int pm_off;
    __device__ __forceinline__ void operator()(const pg8::f32x4 (&acc)[2][2][4][2], const pg8::Unit& u, int wr, int wc, int fr, int fq) const {
        const int pmg = u.pm + pm_off; const bool isctx = pmg >= 128; const int bidx = isctx ? 4 : (pmg >> 5);
        const size_t rbase = (size_t)(isctx ? (pmg - 128) : pmg) * 256 + wr * 64 + fr;
        const float* xi = (isctx ? xin_ctx : xin_lat); float* xo = (isctx ? xout_ctx : xout_lat);
        const int col0 = u.pc * 256 + wc * 32 + 4 * fq; const float* g = gate + (size_t)bidx * 6144 + col0;
        pg8::f32x4 gv[2][2];
#pragma unroll
        for (int bj = 0; bj < 2; ++bj)
#pragma unroll
            for (int n = 0; n < 2; ++n) gv[bj][n] = *(const pg8::f32x4*)(g + bj * 128 + n * 16) * sc;
#pragma unroll
        for (int ai = 0; ai < 2; ++ai)
#pragma unroll
            for (int m = 0; m < 4; ++m) { const size_t off = (rbase + ai * 128 + m * 16) * 1024 + col0;
#pragma unroll
                for (int bj = 0; bj < 2; ++bj)
#pragma unroll
                    for (int n = 0; n < 2; ++n) { const pg8::f32x4 xv = *(const pg8::f32x4*)(xi + off + bj * 128 + n * 16);
                        *(pg8::f32x4*)(xo + off + bj * 128 + n * 16) = xv + gv[bj][n] * acc[ai][bj][m][n]; }
                asm volatile("" ::: "memory"); }
    }
};
struct EpiGlu {
    static constexpr bool PERM = true, AFTER_DRAIN = false;
    const bf16* Z; bf16* Y; const float* bias;
    __device__ __forceinline__ void operator()(const pg8::f32x4 (&acc)[2][2][4][2], const pg8::Unit& u, int wr, int wc, int fr, int fq) const {
        const int row0 = u.pm * 256 + wr * 64 + fr, col0 = wc * 32 + 8 * fq;
#pragma unroll
        for (int ai = 0; ai < 2; ++ai)
#pragma unroll
            for (int m = 0; m < 4; ++m) { const size_t row = (size_t)(row0 + ai * 128 + m * 16);
#pragma unroll
                for (int bj = 0; bj < 2; ++bj) { const int col = col0 + bj * 128;
                    const pg8::u32x4 zz = *(const pg8::u32x4*)(Z + row * 256 + col);
                    const pg8::f32x4 b0 = *(const pg8::f32x4*)(bias + col), b1 = *(const pg8::f32x4*)(bias + col + 4);
                    const pg8::f32x4 v0 = acc[ai][bj][m][0] + b0, v1 = acc[ai][bj][m][1] + b1;
                    float o[8]; const unsigned zw[4] = {zz.x, zz.y, zz.z, zz.w};
#pragma unroll
                    for (int j = 0; j < 4; ++j) { const float zl = __uint_as_float(zw[j] << 16), zh = __uint_as_float(zw[j] & 0xffff0000u);
                        const float a0 = (j < 2) ? v0[2 * j] : v1[2 * j - 4], a1 = (j < 2) ? v0[2 * j + 1] : v1[2 * j - 3];
                        o[2 * j] = zl * sigm(a0); o[2 * j + 1] = zh * sigm(a1); }
                    pg8::u32x4 w; w.x = pg8::cvt_pk_bf16(o[0], o[1]); w.y = pg8::cvt_pk_bf16(o[2], o[3]); w.z = pg8::cvt_pk_bf16(o[4], o[5]); w.w = pg8::cvt_pk_bf16(o[6], o[7]);
                    *(pg8::u32x4*)(Y + row * 1024 + 256 + col) = w; }
                asm volatile("" ::: "memory"); }
    }
};
struct MoeOrder {
    int tp[9]; int nN, G, c, total;
    __device__ __forceinline__ void init(const unsigned* cnt, int nN_, int G_, int c_) {
        tp[0] = 0;
#pragma unroll
        for (int e = 0; e < 8; ++e) tp[e + 1] = tp[e] + (int)(((unsigned)__builtin_amdgcn_readfirstlane((int)__hip_atomic_load(cnt + e * 64, __ATOMIC_RELAXED, __HIP_MEMORY_SCOPE_AGENT)) + 255u) >> 8);
        nN = nN_; G = G_; c = c_; total = tp[8] * nN;
    }
    __device__ __forceinline__ bool next(int i, pg8::Unit& u) const {
        const int L = i * G + c; if (L >= total) return false;
        const int t = L / nN, pn = L - t * nN; int e = 0;
#pragma unroll
        for (int k = 1; k < 8; ++k) e += (t >= tp[k]) ? 1 : 0;
        u.pm = t; u.pn = e * nN + pn; u.pc = pn; return true;
    }
    __device__ __forceinline__ void a_ready(const pg8::Unit&) const {}
    __device__ __forceinline__ void done(const pg8::Unit&) const {}
};

__device__ __forceinline__ void cvt_item(const float* W, int K, int N, bf16* WT, int mode, int add, LAS float* scr, int item, int lane, int nblk_override = 0, const float* ks = nullptr  ) {
    const int nblk = nblk_override ? nblk_override : (N >> 5), kb = item / nblk, nb = item - kb * nblk, k0 = 64 * kb, n0 = 32 * nb;
    const int r = lane >> 3, c4 = lane & 7;
    f32x4 v[8];
#pragma unroll
    for (int i = 0; i < 8; ++i) v[i] = *(const f32x4*)(W + (size_t)(k0 + 8 * i + r) * N + n0 + 4 * c4);
    if (ks) {
#pragma unroll
        for (int i = 0; i < 8; ++i) v[i] *= ks[8 * i + r]; }
#pragma unroll
    for (int i = 0; i < 8; ++i) {
#pragma unroll
        for (int j = 0; j < 4; ++j) scr[(8 * i + r) * 33 + 4 * c4 + j] = v[i][j]; }
    LDS_WAIT();
    const int c = lane & 7;
#pragma unroll
    for (int j = 0; j < 4; ++j) { const int n = (lane >> 3) + 8 * j; const LAS float* s = scr + (8 * c) * 33 + n;
        v4u o; o.x = pk2(s[0 * 33], s[1 * 33]); o.y = pk2(s[2 * 33], s[3 * 33]); o.z = pk2(s[4 * 33], s[5 * 33]); o.w = pk2(s[6 * 33], s[7 * 33]);
        const int nn = n0 + n; const int drow = (mode == 0) ? (nn + add) : (((nn >> 7) << 8) + (nn & 127) + add);
        *(v4u*)(WT + (size_t)drow * K + k0 + 8 * c) = o; }
    LDS_WAIT();
}
__device__ __forceinline__ void cvt_item_f8(const float* W, int K, int N, unsigned char* WT, int mode, int add, LAS float* scr, int item, int lane) {
    const int nblk = N >> 5, kb = item / nblk, nb = item - kb * nblk, k0 = 64 * kb, n0 = 32 * nb;
    const int r = lane >> 3, c4 = lane & 7;
    f32x4 v[8];
#pragma unroll
    for (int i = 0; i < 8; ++i) v[i] = *(const f32x4*)(W + (size_t)(k0 + 8 * i + r) * N + n0 + 4 * c4);
#pragma unroll
    for (int i = 0; i < 8; ++i) {
#pragma unroll
        for (int j = 0; j < 4; ++j) scr[(8 * i + r) * 33 + 4 * c4 + j] = v[i][j]; }
    LDS_WAIT();
    const int c = lane & 3;
#pragma unroll
    for (int j = 0; j < 2; ++j) { const int n = (lane >> 2) + 16 * j; const LAS float* s = scr + (16 * c) * 33 + n;
        unsigned w[4];
#pragma unroll
        for (int q = 0; q < 4; ++q) { unsigned x = 0u;
            x = __builtin_amdgcn_cvt_pk_fp8_f32(s[(4 * q) * 33] * WSC8, s[(4 * q + 1) * 33] * WSC8, x, false);
            x = __builtin_amdgcn_cvt_pk_fp8_f32(s[(4 * q + 2) * 33] * WSC8, s[(4 * q + 3) * 33] * WSC8, x, true); w[q] = x; }
        v4u o; o.x = w[0]; o.y = w[1]; o.z = w[2]; o.w = w[3];
        const int nn = n0 + n; const int drow = (mode == 0) ? (nn + add) : (((nn >> 7) << 8) + (nn & 127) + add);
        *(v4u*)(WT + (size_t)drow * K + k0 + 16 * c) = o; }
    LDS_WAIT();
}
__device__ __forceinline__ void moe_cvt_idle(const Frame& F, const Args& a, int j, int b_lo) {
    LAS float* scr = (LAS float*)(F.lds + F.wave * 16384);
    constexpr int IT = 1408;
    const int nw = (F.G - b_lo) * 8, w = ((int)blockIdx.x - b_lo) * 8 + F.wave;
    for (int it = w; it < 8 * 3 * IT; it += nw) {
        const int e = it / (3 * IT), r = it - e * 3 * IT, which = r / IT, item = r - which * IT;
        const size_t eo = ((size_t)j * 8 + e) * (size_t)(1024 * DFF);
        if (which == 0) cvt_item_f8(a.in[F.zz + I_MW1] + eo, 1024, DFF, F.ws + WS_W13M + (size_t)e * 5632 * 1024, 1, 0, scr, item, F.lane);
        else if (which == 1) cvt_item_f8(a.in[F.zz + I_MW3] + eo, 1024, DFF, F.ws + WS_W13M + (size_t)e * 5632 * 1024, 1, 128, scr, item, F.lane);
        else cvt_item_f8(a.in[F.zz + I_MW2] + eo, DFF, 1024, F.ws + WS_W2M + (size_t)e * 1024 * DFF, 0, 0, scr, item, F.lane);
    }
}
__device__ __forceinline__ void moe_cvt(const Frame& F, const Args& a, int j) {
    LAS float* scr = (LAS float*)(F.lds + F.wave * 16384);
    constexpr int IT = 1408;
    for (int it = F.gw; it < 8 * 3 * IT; it += F.NGW) {
        const int e = it / (3 * IT), r = it - e * 3 * IT, which = r / IT, item = r - which * IT;
        const size_t eo = ((size_t)j * 8 + e) * (size_t)(1024 * DFF);
        if (which == 0) cvt_item_f8(a.in[F.zz + I_MW1] + eo, 1024, DFF, F.ws + WS_W13M + (size_t)e * 5632 * 1024, 1, 0, scr, item, F.lane);
        else if (which == 1) cvt_item_f8(a.in[F.zz + I_MW3] + eo, 1024, DFF, F.ws + WS_W13M + (size_t)e * 5632 * 1024, 1, 128, scr, item, F.lane);
        else cvt_item_f8(a.in[F.zz + I_MW2] + eo, DFF, 1024, F.ws + WS_W2M + (size_t)e * 1024 * DFF, 0, 0, scr, item, F.lane);
    }
}
__device__ __forceinline__ void prologue(const Frame& F, const Args& a) {
    {
        LAS float* sc = (LAS float*)F.lds; LAS float* red = sc + 5120;
        for (int idx = F.tid; idx < 5120; idx += 512) { const int r = idx >> 10, k = idx & 1023; const float cv = (r < 4) ? a.in[F.zz + I_C][r * 1024 + k] : a.in[F.zz + I_CCTX][k]; sc[idx] = silu_f(cv); }
        __syncthreads();
        float* MOD = (float*)(F.ws + WS_MOD);
        for (int item = blockIdx.x; item < 384; item += F.G) {
            const int l = item / 96, nb = item - l * 96, cl = F.tid & 63, ks = F.tid >> 6, n = nb * 64 + cl;
            float acc[5] = {0.f, 0.f, 0.f, 0.f, 0.f};
            const float* wp = a.in[F.zz + I_ADAW] + ((size_t)l * 1024 + ks * 128) * 6144 + n;
#pragma unroll 16
            for (int kk = 0; kk < 128; ++kk) { const float w = wp[(size_t)kk * 6144];
#pragma unroll
                for (int r = 0; r < 5; ++r) acc[r] = fmaf(sc[r * 1024 + ks * 128 + kk], w, acc[r]); }
#pragma unroll
            for (int r = 0; r < 5; ++r) red[(ks * 5 + r) * 64 + cl] = acc[r];
            __syncthreads();
            if (F.tid < 320) { const int r = F.tid >> 6; float s = 0.f;
#pragma unroll
                for (int k2 = 0; k2 < 8; ++k2) s += red[(k2 * 5 + r) * 64 + cl];
                MOD[((size_t)l * 5 + r) * 6144 + n] = s + a.in[F.zz + I_ADAB][l * 6144 + n]; }
            __syncthreads();
        }
        if (blockIdx.x == 0 && F.tid < 256) {
            const float* lg = a.in[F.zz + I_LBL]; float x[4], mx = -3.0e38f;
#pragma unroll
            for (int l = 0; l < 4; ++l) { x[l] = lg[l * 256 + F.tid]; mx = fmaxf(mx, x[l]); }
            float s = 0.f;
#pragma unroll
            for (int l = 0; l < 4; ++l) { x[l] = expf(x[l] - mx); s += x[l]; }
            float cs = 0.f; const float sm0 = x[0] / s; float* LB = (float*)(F.ws + WS_LB);
#pragma unroll
            for (int l = 0; l < 4; ++l) { cs += x[l] / s; LB[l * 256 + F.tid] = fminf(fmaxf(cs - sm0, 0.f), 1.0f - 1e-6f); }
        }
        if (blockIdx.x == (1 % F.G)) {
            float* RC = (float*)(F.ws + WS_ROPE); float* RS = RC + 2048;
            for (int idx = F.tid; idx < 2048; idx += 512) { const int pos = idx >> 4, i = idx & 15;
                const float fr = powf(10000.0f, -(float)i / 16.0f); const float ang = (float)pos * fr; RC[idx] = cosf(ang); RS[idx] = sinf(ang); }
        }
        __syncthreads();
    }
    LAS float* scr = (LAS float*)(F.lds + F.wave * 16384);
    constexpr int I_IN = 16 * 104, I_OUT = 16 * 32, I_F = 1408, I_GL = 4 * 8;
    constexpr int NIT = 4 * I_IN + 4 * I_OUT + 6 * I_F + 4 * I_GL;
    for (int it = F.gw; it < NIT; it += F.NGW) {
        int r = it;
        if (r < 4 * I_IN) { const int l = r / I_IN; cvt_item(a.in[F.zz + I_WIN] + (size_t)l * 1024 * DIN, 1024, DIN, (bf16*)(F.ws + WS_WIN) + (size_t)l * DINP * 1024, 0, 0, scr, r - l * I_IN, F.lane, 104); continue; } r -= 4 * I_IN;
        if (r < 4 * I_OUT) { const int l = r / I_OUT, it = r - l * I_OUT, k0 = 64 * (it >> 5);
            const float* ks = k0 < 256 ? a.in[F.zz + I_RETGN] + l * 256 + k0 : (k0 < 512 ? nullptr : (k0 < 768 ? a.in[F.zz + I_HGNW] + l * 256 + (k0 - 512) : a.in[F.zz + I_GLANW] + l * 256 + (k0 - 768)));
            cvt_item(a.in[F.zz + I_WOUT] + (size_t)l * 1024 * 1024, 1024, 1024, (bf16*)(F.ws + WS_WOUT) + (size_t)l * 1024 * 1024, 0, 0, scr, it, F.lane, 0, ks); continue; } r -= 4 * I_OUT;
        if (r < 6 * I_F) { const int j = r / (3 * I_F), r2 = r - j * 3 * I_F, which = r2 / I_F, item = r2 - which * I_F; const size_t wo = (size_t)j * 1024 * DFF;
            if (which == 0) cvt_item(a.in[F.zz + I_FW1] + wo, 1024, DFF, (bf16*)(F.ws + WS_W13D) + (size_t)j * 5632 * 1024, 1, 0, scr, item, F.lane);
            else if (which == 1) cvt_item(a.in[F.zz + I_FW3] + wo, 1024, DFF, (bf16*)(F.ws + WS_W13D) + (size_t)j * 5632 * 1024, 1, 128, scr, item, F.lane);
            else cvt_item_f8(a.in[F.zz + I_FW2] + wo, DFF, 1024, F.ws + WS_W2D + (size_t)j * 1024 * DFF, 0, 0, scr, item, F.lane);
            continue; } r -= 6 * I_F;
        { const int l = r / I_GL; cvt_item(a.in[F.zz + I_GLUW] + (size_t)l * 65536, 256, 256, (bf16*)(F.ws + WS_GLUW) + (size_t)l * 65536, 0, 0, scr, r - l * I_GL, F.lane); }
    }
    for (int i = blockIdx.x * 512 + F.tid; i < 4 * 256 * 128; i += F.G * 512) {
        const int l = i >> 15, rem = i & 32767, n = rem >> 7, k0 = (rem & 127) * 8, d = n >> 7, cidx = n & 127;
        const float* wa = a.in[F.zz + I_WA2] + ((size_t)(l * 2 + d) * 16) * 128 + cidx;
        float acc[8] = {0.f, 0.f, 0.f, 0.f, 0.f, 0.f, 0.f, 0.f};
#pragma unroll
        for (int r = 0; r < 16; ++r) { const float w2 = wa[r * 128];
#pragma unroll
            for (int kk = 0; kk < 8; ++kk) acc[kk] = fmaf(a.in[F.zz + I_WIN][((size_t)l * 1024 + k0 + kk) * DIN + 3328 + 16 * d + r], w2, acc[kk]); }
        v4u o; o.x = pk2(acc[0], acc[1]); o.y = pk2(acc[2], acc[3]); o.z = pk2(acc[4], acc[5]); o.w = pk2(acc[6], acc[7]);
        *(v4u*)((bf16*)(F.ws + WS_WIN) + ((size_t)l * DINP + 3328 + n) * 1024 + k0) = o;
    }
}

struct MoeTp { int tp[9]; };
__device__ __forceinline__ void load_tp(MoeTp& t, const unsigned* cnt) {
    t.tp[0] = 0;
#pragma unroll
    for (int e = 0; e < 8; ++e) t.tp[e + 1] = t.tp[e] + (int)(((unsigned)__builtin_amdgcn_readfirstlane((int)__hip_atomic_load(cnt + e * 64, __ATOMIC_RELAXED, __HIP_MEMORY_SCOPE_AGENT)) + 255u) >> 8);
}
template <int MODE>
__device__ __forceinline__ void norm_phase(const Frame& F, const Args& a, int l, int which  , int nrows, int comb_l  ,
                                           int row_lo = 0, int w0 = -1  , int nwav = 0) {
    const int wv_ = (w0 < 0) ? F.gw : w0, nwv_ = (w0 < 0) ? F.NGW : nwav;
    const float* MOD = (const float*)(F.ws + WS_MOD);
    const float* nw = (MODE == 2) ? a.in[F.zz + I_FINW] : ((which ? a.in[F.zz + I_N2W] : a.in[F.zz + I_N1W]) + l * 1024);
    bf16* XN = (bf16*)(F.ws + WS_ACT);
    float* hb = (float*)(F.ws + WS_HB);
    const int* EP = (const int*)(F.ws + WS_LIST) + 8 * MT; const float* GATE = (const float*)(F.ws + WS_LIST) + 10 * MT;
    const bf16* YM = (const bf16*)(F.ws + WS_X2);
    const bool from_input = (l == 0 && which == 0 && MODE != 2);
    MoeTp ctp; if (comb_l >= 0) load_tp(ctp, (const unsigned*)F.ws + CW_CNT + (comb_l >> 1) * 8 * 64);
    const int jm = l >> 1;
    LAS float* rwl = (LAS float*)F.lds;
    if (MODE == 1) {
        const float* rw = a.in[F.zz + I_RW] + (size_t)jm * 8192;
        for (int idx = F.tid; idx < 8192; idx += 512) { const int k = idx >> 3, e = idx & 7; rwl[e * 1024 + k] = rw[idx]; }
        __syncthreads();
    }
    f32x4 wv[4];
#pragma unroll
    for (int j = 0; j < 4; ++j) wv[j] = *((const f32x4*)nw + F.lane + 64 * j);
    f32x4 vn[4]; int epn0 = 0, epn1 = 0; float gn0 = 0.f, gn1 = 0.f;
    { const int m = (row_lo + wv_ < nrows) ? row_lo + wv_ : row_lo; const bool isctx = m >= NLAT;
      const float* xr = from_input ? (isctx ? a.in[F.zz + I_CTX] + (size_t)(m - NLAT) * 1024 : a.in[F.zz + I_X] + (size_t)m * 1024) : (isctx ? hb + (size_t)(m - NLAT) * 1024 : F.out + (size_t)m * 1024);
#pragma unroll
      for (int j = 0; j < 4; ++j) vn[j] = *((const f32x4*)xr + F.lane + 64 * j);
      if (comb_l >= 0) { epn0 = EP[2 * m]; epn1 = EP[2 * m + 1]; gn0 = GATE[2 * m]; gn1 = GATE[2 * m + 1]; } }
    for (int m = row_lo + wv_; m < nrows; m += nwv_) {
        const bool isctx = m >= NLAT; const int bidx = isctx ? 4 : (m >> 13);
        f32x4 v[4];
#pragma unroll
        for (int j = 0; j < 4; ++j) v[j] = vn[j];
        const int ep0 = epn0, ep1 = epn1; const float g0 = gn0, g1 = gn1;
        { const int mn = (m + nwv_ < nrows) ? m + nwv_ : m; const bool cn = mn >= NLAT;
          const float* xr = from_input ? (cn ? a.in[F.zz + I_CTX] + (size_t)(mn - NLAT) * 1024 : a.in[F.zz + I_X] + (size_t)mn * 1024) : (cn ? hb + (size_t)(mn - NLAT) * 1024 : F.out + (size_t)mn * 1024);
#pragma unroll
          for (int j = 0; j < 4; ++j) vn[j] = *((const f32x4*)xr + F.lane + 64 * j);
          if (comb_l >= 0) { epn0 = EP[2 * mn]; epn1 = EP[2 * mn + 1]; gn0 = GATE[2 * mn]; gn1 = GATE[2 * mn + 1]; } }
        if (comb_l >= 0) {
            int t0 = 0, t1 = 0;
#pragma unroll
            for (int e = 0; e < 8; ++e) { t0 = ((ep0 & 7) == e) ? ctp.tp[e] : t0; t1 = ((ep1 & 7) == e) ? ctp.tp[e] : t1; }
            const size_t d0 = (size_t)t0 * 256 + (ep0 >> 3), d1 = (size_t)t1 * 256 + (ep1 >> 3);
            const float* m5 = MOD + ((size_t)comb_l * 5 + bidx) * 6144 + 5 * 1024;
            float* xw = isctx ? hb + (size_t)(m - NLAT) * 1024 : F.out + (size_t)m * 1024;
#pragma unroll
            for (int j = 0; j < 4; ++j) {
                const v2u y0 = *((const v2u*)(YM + d0 * 1024) + F.lane + 64 * j), y1 = *((const v2u*)(YM + d1 * 1024) + F.lane + 64 * j);
                const f32x4 mm = *((const f32x4*)m5 + F.lane + 64 * j);
                f32x4 f0, f1;
                f0[0] = __uint_as_float(y0.x << 16); f0[1] = __uint_as_float(y0.x & 0xffff0000u); f0[2] = __uint_as_float(y0.y << 16); f0[3] = __uint_as_float(y0.y & 0xffff0000u);
                f1[0] = __uint_as_float(y1.x << 16); f1[1] = __uint_as_float(y1.x & 0xffff0000u); f1[2] = __uint_as_float(y1.y << 16); f1[3] = __uint_as_float(y1.y & 0xffff0000u);
                v[j] = v[j] + mm * (f0 * g0 + f1 * g1);
                if (MODE != 2) *((f32x4*)xw + F.lane + 64 * j) = v[j];
            }
        }
        float ss = 0.f;
#pragma unroll
        for (int j = 0; j < 4; ++j) ss += (v[j][0] * v[j][0] + v[j][1] * v[j][1]) + (v[j][2] * v[j][2] + v[j][3] * v[j][3]);
        ss = wave_sum(ss);
        const float rstd = __builtin_amdgcn_rsqf(ss * (1.0f / 1024.0f) + NEPS);
        if (MODE == 2) {
#pragma unroll
            for (int j = 0; j < 4; ++j) *((f32x4*)(F.out + (size_t)m * 1024) + F.lane + 64 * j) = v[j] * rstd * wv[j];
        } else {
            const float* sh = MOD + ((size_t)l * 5 + bidx) * 6144 + (which ? 3 : 0) * 1024; const float* scl = sh + 1024;
            f32x4 o[4];
#pragma unroll
            for (int j = 0; j < 4; ++j) { const f32x4 s1 = *((const f32x4*)scl + F.lane + 64 * j), s0 = *((const f32x4*)sh + F.lane + 64 * j);
                o[j] = (v[j] * rstd * wv[j]) * (s1 + 1.0f) + s0;
                if (MODE == 1) {
                    unsigned w8 = 0u; w8 = __builtin_amdgcn_cvt_pk_fp8_f32(fminf(fmaxf(o[j][0], -448.f), 448.f), fminf(fmaxf(o[j][1], -448.f), 448.f), w8, false);
                    w8 = __builtin_amdgcn_cvt_pk_fp8_f32(fminf(fmaxf(o[j][2], -448.f), 448.f), fminf(fmaxf(o[j][3], -448.f), 448.f), w8, true);
                    *((unsigned*)((unsigned char*)XN + (size_t)m * 1024) + F.lane + 64 * j) = w8;
                } else { v2u w; w.x = pk2(o[j][0], o[j][1]); w.y = pk2(o[j][2], o[j][3]);
                    *((v2u*)(XN + (size_t)m * 1024) + F.lane + 64 * j) = w; } }
            if (MODE == 1) {
                float p[8];
#pragma unroll
                for (int e = 0; e < 8; ++e) { float s = 0.f;
#pragma unroll
                    for (int j = 0; j < 4; ++j) { const f32x4 w4 = *((const LAS f32x4*)(rwl + e * 1024) + F.lane + 64 * j);
                        s += (o[j][0] * w4[0] + o[j][1] * w4[1]) + (o[j][2] * w4[2] + o[j][3] * w4[3]); }
                    p[e] = wave_sum(s) + a.in[F.zz + I_RB][jm * 8 + e]; }
                int e0 = 0; float v0 = p[0];
#pragma unroll
                for (int e = 1; e < 8; ++e) if (p[e] > v0) { v0 = p[e]; e0 = e; }
                int e1 = -1; float v1 = -3.0e38f;
#pragma unroll
                for (int e = 0; e < 8; ++e) if (e != e0 && p[e] > v1) { v1 = p[e]; e1 = e; }
                const float ex = expf(v1 - v0), g0 = 1.0f / (1.0f + ex), g1 = ex / (1.0f + ex);
                if (F.lane == 0) {
                    unsigned* cnt = (unsigned*)F.ws + CW_CNT + jm * 8 * 64; int* LIST = (int*)(F.ws + WS_LIST);
                    int* EPw = (int*)(F.ws + WS_LIST) + 8 * MT; float* GW = (float*)(F.ws + WS_LIST) + 10 * MT;
                    const unsigned p0 = __hip_atomic_fetch_add(cnt + e0 * 64, 1u, __ATOMIC_RELAXED, __HIP_MEMORY_SCOPE_AGENT);
                    const unsigned p1 = __hip_atomic_fetch_add(cnt + e1 * 64, 1u, __ATOMIC_RELAXED, __HIP_MEMORY_SCOPE_AGENT);
                    LIST[e0 * MT + p0] = m; LIST[e1 * MT + p1] = m;
                    EPw[2 * m] = e0 | (int)(p0 << 3); EPw[2 * m + 1] = e1 | (int)(p1 << 3);
                    GW[2 * m] = g0; GW[2 * m + 1] = g1;
                }
            }
        }
    }
    if (MODE == 1) __syncthreads();
}
__device__ __forceinline__ void moe_gather(const Frame& F, int jm) {
    const unsigned* cnt = (const unsigned*)F.ws + CW_CNT + jm * 8 * 64;
    MoeTp t; load_tp(t, cnt);
    int cn[8];
#pragma unroll
    for (int e = 0; e < 8; ++e) cn[e] = __builtin_amdgcn_readfirstlane((int)__hip_atomic_load(cnt + e * 64, __ATOMIC_RELAXED, __HIP_MEMORY_SCOPE_AGENT));
    const int rows = t.tp[8] * 256;
    const int* LIST = (const int*)(F.ws + WS_LIST); const v4u* XN = (const v4u*)(F.ws + WS_ACT); v4u* XB = (v4u*)(F.ws + WS_X2);
    for (int r = F.gw; r < rows; r += F.NGW) {
        const int tile = r >> 8; int e = 0, tpe = 0, ce = cn[0];
#pragma unroll
        for (int k = 1; k < 8; ++k) { const bool ge = tile >= t.tp[k]; e += ge ? 1 : 0; tpe = ge ? t.tp[k] : tpe; ce = ge ? cn[k] : ce; }
        const int pos = r - tpe * 256;
        v4u x0 = {0u, 0u, 0u, 0u};
        if (pos < ce) { const int src = LIST[e * MT + pos]; x0 = XN[(size_t)src * 64 + F.lane]; }
        XB[(size_t)r * 64 + F.lane] = x0;
    }
}
#define GLD(T, ubase, voff) (*(const T*)((const char*)(ubase) + (unsigned)(voff)))
#define GST(T, ubase, voff) (*(T*)((char*)(ubase) + (unsigned)(voff)))
__device__ __forceinline__ int fresh_lane() { int l; asm volatile("v_mbcnt_lo_u32_b32 %0, -1, 0\n\tv_mbcnt_hi_u32_b32 %0, -1, %0" : "=v"(l)); return l; }

struct MixP { const bf16* P; const float* lb; const float* rcos; const float* rsin; const float* ba; };
__device__ __forceinline__ int seg_row0(int b, int sg) { return sg < 4 ? NLAT + b * CTXL + sg * 64 : b * SEQ + (sg - 4) * 64; }
__device__ __forceinline__ int seg_tpos0(int sg) { return sg < 4 ? -1 : (sg - 4) * 64; }

struct S5P { const float *lam_re, *lam_im, *log_dt, *b_re, *b_im, *c_re, *c_im, *dd; const unsigned* par; };
__device__ __forceinline__ float gelu_tanh(float y) { const float t = 0.7978845608028654f * (y + 0.044715f * y * y * y); const float th = 1.0f - 2.0f * __builtin_amdgcn_rcpf(1.0f + __expf(2.0f * t)); return 0.5f * y * (1.0f + th); }
template <int MODE>
__device__ __forceinline__ void s5_scan(const S5P& sp, const bf16* P, int b, int g, int dir, int sg, int lane, float& hre, float& him, LAS float* yf, LAS float* stg, bf16* Z) {
    const int row0 = seg_row0(b, sg); const int dg = dir * 16 + g;
    const float lre = sp.lam_re[dg * 64 + lane], lim = sp.lam_im[dg * 64 + lane], dt = expf(sp.log_dt[dg]);
    const float er = expf(lre * dt); const float sn = sinf(lim * dt), cs = cosf(lim * dt);
    const float ar = er * cs, ai = er * sn;
    const float nr = ar - 1.0f, ni = ai, den = lre * lre + lim * lim;
    const float cr = (nr * lre + ni * lim) / den, ci = (ni * lre - nr * lim) / den;
    float bbr[16], bbi[16], Cr[16], Ci[16];
#pragma unroll
    for (int c = 0; c < 16; ++c) { const float Br = sp.b_re[((size_t)dg * 64 + lane) * 16 + c], Bi = sp.b_im[((size_t)dg * 64 + lane) * 16 + c];
        bbr[c] = cr * Br - ci * Bi; bbi[c] = cr * Bi + ci * Br;
        Cr[c] = (MODE != 0) ? sp.c_re[((size_t)dg * 16 + c) * 64 + lane] : 0.f; Ci[c] = (MODE != 0) ? sp.c_im[((size_t)dg * 16 + c) * 64 + lane] : 0.f; }
    const int ch = ((lane >> 5) & 1) * 8 + ((lane >> 4) & 1) * 4 + ((lane >> 3) & 1) * 2 + ((lane >> 2) & 1);
    const float dv = (MODE == 2) ? sp.dd[g * 16 + ch] : 0.f;
    const bool b5 = lane & 32, b4 = lane & 16, b3 = lane & 8, b2 = lane & 4;
    const unsigned ucol = 2u * (unsigned)(C_S5 + g * 16 + (lane & 15));
    unsigned short rn0[4], rn1[4], rn2[4];
#pragma unroll
    for (int u = 0; u < 4; ++u) { rn0[u] = GLD(unsigned short, P + (size_t)(row0 + (dir ? 63 - u : u)) * DINP, ucol); rn1[u] = GLD(unsigned short, P + (size_t)(row0 + (dir ? 59 - u : 4 + u)) * DINP, ucol);
        rn2[u] = GLD(unsigned short, P + (size_t)(row0 + (dir ? 55 - u : 8 + u)) * DINP, ucol); }
#pragma unroll 1
    for (int i0 = 0; i0 < 64; i0 += 4) {
        unsigned short ru[4], rn3[4];
        const int ip = (i0 + 12 < 64) ? i0 + 12 : 60;
#pragma unroll
        for (int u = 0; u < 4; ++u) { ru[u] = rn0[u]; rn3[u] = GLD(unsigned short, P + (size_t)(row0 + (dir ? 63 - (ip + u) : (ip + u))) * DINP, ucol); }
#pragma unroll
        for (int u = 0; u < 4; ++u) stg[u * 64 + lane] = bf2f(ru[u]);
#pragma unroll
        for (int u = 0; u < 4; ++u) {
            const int ti = dir ? 63 - (i0 + u) : (i0 + u);
            const float uf = bf2f(ru[u]);
            float bur = 0.f, bui = 0.f;
#pragma unroll
            for (int c4 = 0; c4 < 4; ++c4) { const f32x4 ux = *(const LAS f32x4*)(stg + u * 64 + 4 * c4);
#pragma unroll
                for (int jj = 0; jj < 4; ++jj) { bur = fmaf(bbr[4 * c4 + jj], ux[jj], bur); bui = fmaf(bbi[4 * c4 + jj], ux[jj], bui); } }
            const float nre = ar * hre - ai * him + bur, nim = ar * him + ai * hre + bui;
            hre = nre; him = nim;
            if (MODE != 0) {
                float v[16];
#pragma unroll
                for (int c = 0; c < 16; ++c) v[c] = Cr[c] * hre - Ci[c] * him;
                float w8[8], w4[4], w2[2], w1;
#pragma unroll
                for (int i = 0; i < 8; ++i) { const float mine = b5 ? v[8 + i] : v[i], oth = b5 ? v[i] : v[8 + i]; w8[i] = mine + __shfl_xor(oth, 32); }
#pragma unroll
                for (int i = 0; i < 4; ++i) { const float mine = b4 ? w8[4 + i] : w8[i], oth = b4 ? w8[i] : w8[4 + i]; w4[i] = mine + __shfl_xor(oth, 16); }
#pragma unroll
                for (int i = 0; i < 2; ++i) { const float mine = b3 ? w4[2 + i] : w4[i], oth = b3 ? w4[i] : w4[2 + i]; w2[i] = mine + __shfl_xor(oth, 8); }
                { const float mine = b2 ? w2[1] : w2[0], oth = b2 ? w2[0] : w2[1]; w1 = mine + __shfl_xor(oth, 4); }
                w1 += __shfl_xor(w1, 2); w1 += __shfl_xor(w1, 1);
                if (MODE == 1) { if ((lane & 3) == 0) yf[ti * 16 + ch] = w1; }
                if (MODE == 2) {
                    const float uch = __shfl(uf, ch);
                    if ((lane & 3) == 0) { const float y = w1 + yf[ti * 16 + ch] + dv * uch; Z[(size_t)(row0 + ti) * 256 + g * 16 + ch] = (bf16)f2bf(gelu_tanh(y)); }
                }
            }
        }
#pragma unroll
        for (int u = 0; u < 4; ++u) { rn0[u] = rn1[u]; rn1[u] = rn2[u]; rn2[u] = rn3[u]; }
    }
}

__device__ __forceinline__ MixP make_mixp(const Frame& F, const Args& a, int l) {
    MixP mp; mp.P = (const bf16*)(F.ws + WS_PH); mp.lb = (const float*)(F.ws + WS_LB) + l * 256; mp.rcos = (const float*)(F.ws + WS_ROPE); mp.rsin = mp.rcos + 2048;
    mp.ba = a.in[F.zz + I_BA] + (size_t)l * 2 * 128; return mp;
}
__device__ __forceinline__ S5P make_s5p(const Frame& F, const Args& a, int l) {
    S5P sp; sp.lam_re = a.in[F.zz + I_LAMRE] + (size_t)l * 2048; sp.lam_im = a.in[F.zz + I_LAMIM] + (size_t)l * 2048; sp.log_dt = a.in[F.zz + I_LOGDT] + l * 32;
    sp.b_re = a.in[F.zz + I_BRE] + (size_t)l * 32768; sp.b_im = a.in[F.zz + I_BIM] + (size_t)l * 32768; sp.c_re = a.in[F.zz + I_CRE] + (size_t)l * 32768; sp.c_im = a.in[F.zz + I_CIM] + (size_t)l * 32768;
    sp.dd = a.in[F.zz + I_S5D] + l * 256; sp.par = (const unsigned*)(F.ws + WS_S5PAR) + (size_t)l * 32 * 4096; return sp;
}


typedef short bf16x8_t __attribute__((ext_vector_type(8)));
typedef float f32x16 __attribute__((ext_vector_type(16)));
typedef float f32x2_t __attribute__((ext_vector_type(2)));
typedef __bf16 bf16x2_n __attribute__((ext_vector_type(2)));
__device__ __forceinline__ unsigned pkbf(float lo, float hi) { const f32x2_t v = {lo, hi}; const bf16x2_n r = __builtin_convertvector(v, bf16x2_n); return __builtin_bit_cast(unsigned, r); }
constexpr int WL_QC = 0, WL_KC = 4608, WL_KT = 9216, WL_VT = 14336, WL_PL = 19456, WL_BYTES = 19712;

struct MxC { float gamma, lbv, oml, bav, rc1, rs1; unsigned cq, ck, cv, cz; };
template <int MIX>
__device__ __forceinline__ void mx_consts(MxC& c, const MixP& mp, int h, int dir, int lane) {
    c.gamma = 1.f; c.lbv = 0.f; c.oml = 1.f; c.bav = 0.f; c.cz = 0; c.rc1 = 1.f; c.rs1 = 0.f;
    if (MIX == 0) { c.cq = 8u * (unsigned)(C_RQ + h * 64 + lane); c.ck = 8u * (unsigned)(C_RK + h * 64 + lane); c.cv = 8u * (unsigned)(C_RV + h * 64 + lane); c.gamma = 1.0f - exp2f(-5.0f - (float)(dir ? 3 - h : h));
        if (lane & 32) { const unsigned r1 = 4u * (unsigned)(16 + (lane & 15)); c.rc1 = GLD(float, mp.rcos, r1); const float s1 = GLD(float, mp.rsin, r1); c.rs1 = dir ? -s1 : s1; } }
    else if (MIX == 1) { c.cq = 8u * (unsigned)(C_HQ + h * 64 + lane); c.ck = 8u * (unsigned)((dir ? C_HFB : C_HFF) + h * 64 + lane); c.cv = 8u * (unsigned)(C_HI + h * 64 + lane); c.lbv = mp.lb[h * 64 + lane]; c.oml = 1.0f - c.lbv; }
    else { c.cq = 8u * (unsigned)(C_GQ + h * 32 + (lane & 31)); c.ck = 8u * (unsigned)(C_GK + h * 32 + (lane & 31)); c.cv = 8u * (unsigned)(C_GV + h * 64 + lane); c.cz = 8u * (unsigned)((dir ? C_GZB : C_GZF) + h * 32 + (lane & 31));
        c.bav = mp.ba[dir * 128 + h * 32 + (lane & 31)]; }
}
struct MxRaw { v2u q, k, v, z; };
template <int MIX, bool NEEDQ, int DIR>
__device__ __forceinline__ void mx_load(MxRaw& w, const MixP& mp, const MxC& c, int rows, int b) {
    const bf16* pr = mp.P + (size_t)((rows >> 2) + (DIR ? 15 - b : b)) * P4G;
    const v2u zero = {0u, 0u};
    w.q = NEEDQ ? GLD(v2u, pr, c.cq) : zero; w.k = GLD(v2u, pr, c.ck); w.v = GLD(v2u, pr, c.cv); w.z = (MIX == 2) ? GLD(v2u, pr, c.cz) : zero;
}
__device__ __forceinline__ float bfx(const v2u& w, int i) { const unsigned d = (i >> 1) ? w.y : w.x; return __builtin_bit_cast(float, (i & 1) ? (d & 0xffff0000u) : (d << 16)); }
template <int MIX, bool NEEDQ, int DIR>
__device__ __forceinline__ void mx_batch(const MxRaw& cur, const MixP& mp, const MxC& c, int tposs  , int lane, LAS unsigned char* wl, int b, float& P, float& rc, float& rs) {
    constexpr int DK = (MIX == 2) ? 32 : 64;
    float kt[4];
#pragma unroll
    for (int u = 0; u < 4; ++u) {
        const int cc = b * 4 + u, ts = DIR ? 63 - cc : cc, t = ts & 31;
        const int pu = DIR ? 3 - u : u; float q = bfx(cur.q, pu), k, f;
        if (MIX == 0) {
            k = bfx(cur.k, pu) * 0.125f; f = c.gamma;
            if (tposs >= 0) { const float cs = rc, sn = rs;
                rc = cs * c.rc1 - sn * c.rs1; rs = sn * c.rc1 + cs * c.rs1;
                const float ss = (lane & 16) ? sn : -sn;
                const float kp = __shfl_xor(k, 16); k = fmaf(kp, ss, k * cs);
                if (NEEDQ) { const float qp = __shfl_xor(q, 16); q = fmaf(qp, ss, q * cs); } }
        } else if (MIX == 1) {
            const float z = bfx(cur.k, pu); const float e = __expf(-z); const float sp = __builtin_amdgcn_rcpf(1.0f + e), sn = e * sp;
            f = fmaf(c.oml, sp, c.lbv); k = c.oml * sn;
        } else {
            k = bfx(cur.k, pu) * 0.17677669529663687f; const float z = bfx(cur.z, pu) + c.bav;
            const float ls = fminf(z, 0.f) - __logf(1.0f + __expf(-fabsf(z)));
            f = __expf(ls * 0.0625f);
        }
        P = fmaxf(P * f, 1e-30f);
        const float kk = k * __builtin_amdgcn_rcpf(P); kt[DIR ? 3 - u : u] = kk;
        if (lane < DK) {
            const unsigned qk = pkbf(q * P, kk);
            if (NEEDQ) *(LAS unsigned short*)(wl + WL_QC + t * 144 + lane * 2) = (unsigned short)qk;
            *(LAS unsigned short*)(wl + WL_KC + t * 144 + lane * 2) = (unsigned short)(qk >> 16);
        }
    }
    const int g4 = ((DIR ? 63 - b * 4 : b * 4) & 31) >> 2;
    v2u kp; kp.x = pkbf(kt[0], kt[1]); kp.y = pkbf(kt[2], kt[3]);
    if (lane < DK) *(LAS v2u*)(wl + WL_KT + lane * 80 + g4 * 8) = kp;
    *(LAS v2u*)(wl + WL_VT + lane * 80 + g4 * 8) = cur.v;
}
typedef short bf16x4_t __attribute__((ext_vector_type(4)));
#define MFMA8(a, b, c) __builtin_amdgcn_mfma_f32_32x32x8bf16_1k((a), (b), (c), 0, 0, 0)
__device__ __forceinline__ bf16x4_t pack4(const f32x16& x, int s) {
    v2u p; p.x = pkbf(x[4 * s], x[4 * s + 1]); p.y = pkbf(x[4 * s + 2], x[4 * s + 3]);
    return __builtin_bit_cast(bf16x4_t, p);
}
__device__ __forceinline__ bf16x4_t ld4(const LAS unsigned char* p) { const v2u a = *(const LAS v2u*)p; return __builtin_bit_cast(bf16x4_t, a); }

__device__ __forceinline__ float u2f_(unsigned u) { return __builtin_bit_cast(float, u); }
__device__ __forceinline__ unsigned f2u_(float f) { return __builtin_bit_cast(unsigned, f); }
__device__ __forceinline__ void s5_build(const Frame& F, const Args& a) {
    for (int it = F.gw; it < 128; it += F.NGW) {
        const int l = it >> 5, dg = it & 31, lane = F.lane, m32 = lane & 31, hh = lane >> 5;
        const S5P sp = make_s5p(F, a, l);
        unsigned* par = (unsigned*)(F.ws + WS_S5PAR) + (size_t)it * 4096;
    float ar[2], ai[2], a2r[2], a2i[2], a3r[2], a3i[2], a4r[2], a4i[2];
    bf16x4_t bfr[4][2];
    const float dt = __expf(sp.log_dt[dg]);
#pragma unroll
    for (int sh = 0; sh < 2; ++sh) {
        const int p = 32 * sh + m32;
        const float lre = sp.lam_re[dg * 64 + p], lim = sp.lam_im[dg * 64 + p];
        const float er = __expf(lre * dt), sn = sinf(lim * dt), cs = cosf(lim * dt);
        ar[sh] = er * cs; ai[sh] = er * sn;
        a2r[sh] = ar[sh] * ar[sh] - ai[sh] * ai[sh]; a2i[sh] = ar[sh] * ai[sh] + ar[sh] * ai[sh];
        a3r[sh] = a2r[sh] * ar[sh] - a2i[sh] * ai[sh]; a3i[sh] = a2r[sh] * ai[sh] + a2i[sh] * ar[sh];
        a4r[sh] = a2r[sh] * a2r[sh] - a2i[sh] * a2i[sh]; a4i[sh] = a2r[sh] * a2i[sh] + a2r[sh] * a2i[sh];
        const float nr = ar[sh] - 1.0f, ni = ai[sh], den = 1.0f / (lre * lre + lim * lim);
        const float cr = (nr * lre + ni * lim) * den, ci = (ni * lre - nr * lim) * den;
#pragma unroll
        for (int s2 = 0; s2 < 2; ++s2) {
            const f32x4 Br = *(const f32x4*)(sp.b_re + ((size_t)dg * 64 + p) * 16 + 8 * s2 + 4 * hh), Bi = *(const f32x4*)(sp.b_im + ((size_t)dg * 64 + p) * 16 + 8 * s2 + 4 * hh);
            const f32x4 re = Br * cr - Bi * ci, im = Bi * cr + Br * ci;
            v2u pr, pi; pr.x = pkbf(re[0], re[1]); pr.y = pkbf(re[2], re[3]); pi.x = pkbf(im[0], im[1]); pi.y = pkbf(im[2], im[3]);
            bfr[sh][s2] = __builtin_bit_cast(bf16x4_t, pr); bfr[2 + sh][s2] = __builtin_bit_cast(bf16x4_t, pi);
        }
    }
    bf16x4_t cfr[16];
    {
#pragma unroll
        for (int s = 0; s < 16; ++s) {
            const int mp_ = 2 * s + hh; f32x4 cv = {0.f, 0.f, 0.f, 0.f};
            if (m32 < 16) { const float* cre = sp.c_re + ((size_t)dg * 16 + m32) * 64 + mp_; const float* cim = sp.c_im + ((size_t)dg * 16 + m32) * 64 + mp_;
                cv[0] = cre[0]; cv[1] = cre[32]; cv[2] = -cim[0]; cv[3] = -cim[32]; }
            v2u pc; pc.x = pkbf(cv[0], cv[1]); pc.y = pkbf(cv[2], cv[3]); cfr[s] = __builtin_bit_cast(bf16x4_t, pc);
        }
    }
#define S5U(x) __builtin_bit_cast(unsigned, (x))
        v4u q;
        q.x = S5U(ar[0]); q.y = S5U(ar[1]); q.z = S5U(ai[0]); q.w = S5U(ai[1]); *(v4u*)(par + (0 * 64 + lane) * 4) = q;
        q.x = S5U(a2r[0]); q.y = S5U(a2r[1]); q.z = S5U(a2i[0]); q.w = S5U(a2i[1]); *(v4u*)(par + (1 * 64 + lane) * 4) = q;
        q.x = S5U(a3r[0]); q.y = S5U(a3r[1]); q.z = S5U(a3i[0]); q.w = S5U(a3i[1]); *(v4u*)(par + (2 * 64 + lane) * 4) = q;
        q.x = S5U(a4r[0]); q.y = S5U(a4r[1]); q.z = S5U(a4i[0]); q.w = S5U(a4i[1]); *(v4u*)(par + (3 * 64 + lane) * 4) = q;
#undef S5U
#pragma unroll
        for (int i = 0; i < 4; ++i) { const v2u lo = __builtin_bit_cast(v2u, bfr[i][0]), hi = __builtin_bit_cast(v2u, bfr[i][1]); q.x = lo.x; q.y = lo.y; q.z = hi.x; q.w = hi.y; *(v4u*)(par + ((4 + i) * 64 + lane) * 4) = q; }
#pragma unroll
        for (int k = 0; k < 8; ++k) { const v2u lo = __builtin_bit_cast(v2u, cfr[2 * k]), hi = __builtin_bit_cast(v2u, cfr[2 * k + 1]); q.x = lo.x; q.y = lo.y; q.z = hi.x; q.w = hi.y; *(v4u*)(par + ((8 + k) * 64 + lane) * 4) = q; }
    }
}
struct S5U { v2u u[2][2]; };
__device__ __forceinline__ void s5_load_u(S5U& U, const bf16* P, int b, int g, int sg, int lane) {
    const int m32 = lane & 31, hh = lane >> 5, row0 = seg_row0(b, sg);
#pragma unroll
    for (int ch = 0; ch < 2; ++ch) { const bf16* urow = P + (size_t)((row0 + 32 * ch + m32) >> 2) * P4G + P4S5 + (m32 & 3) * 256 + g * 16 + 4 * hh;
        U.u[ch][0] = *(const v2u*)urow; U.u[ch][1] = *(const v2u*)(urow + 8); }
}
template <int MODE, int DIR>
__device__ __forceinline__ void s5_mm_dir(const S5P& sp, const S5U& U, int b, int g, int sg, int lane, float& hre, float& him, LAS float* yf, LAS unsigned char* hs, bf16* Z) {
    const int m32 = lane & 31, hh = lane >> 5, dg = DIR * 16 + g, row0 = seg_row0(b, sg);
    float ar[2], ai[2], a2r[2], a2i[2], a3r[2], a3i[2], a4r[2], a4i[2];
    bf16x4_t bfr[4][2];
    bf16x4_t cfr[16];
    {
        const unsigned* par = sp.par + (size_t)dg * 4096;
        v4u pq[16];
#pragma unroll
        for (int q = 0; q < ((MODE != 0) ? 16 : 8); ++q) pq[q] = GLD(v4u, par + q * 256, 16u * (unsigned)lane);
#define S5F(x) u2f_(x)
        ar[0] = S5F(pq[0].x); ar[1] = S5F(pq[0].y); ai[0] = S5F(pq[0].z); ai[1] = S5F(pq[0].w);
        a2r[0] = S5F(pq[1].x); a2r[1] = S5F(pq[1].y); a2i[0] = S5F(pq[1].z); a2i[1] = S5F(pq[1].w);
        a3r[0] = S5F(pq[2].x); a3r[1] = S5F(pq[2].y); a3i[0] = S5F(pq[2].z); a3i[1] = S5F(pq[2].w);
        a4r[0] = S5F(pq[3].x); a4r[1] = S5F(pq[3].y); a4i[0] = S5F(pq[3].z); a4i[1] = S5F(pq[3].w);
#undef S5F
#pragma unroll
        for (int i = 0; i < 4; ++i) { v2u lo, hi; lo.x = pq[4 + i].x; lo.y = pq[4 + i].y; hi.x = pq[4 + i].z; hi.y = pq[4 + i].w; bfr[i][0] = __builtin_bit_cast(bf16x4_t, lo); bfr[i][1] = __builtin_bit_cast(bf16x4_t, hi); }
        if (MODE != 0) {
#pragma unroll
            for (int k = 0; k < 8; ++k) { v2u lo, hi; lo.x = pq[8 + k].x; lo.y = pq[8 + k].y; hi.x = pq[8 + k].z; hi.y = pq[8 + k].w; cfr[2 * k] = __builtin_bit_cast(bf16x4_t, lo); cfr[2 * k + 1] = __builtin_bit_cast(bf16x4_t, hi); }
        }
    }
    const float ddv = (MODE == 2 && m32 < 16) ? sp.dd[g * 16 + m32] : 0.f;
    float hr[2], hi[2];
    hr[0] = __shfl(hre, m32); hi[0] = __shfl(him, m32); hr[1] = __shfl(hre, m32 + 32); hi[1] = __shfl(him, m32 + 32);
#pragma unroll 1
    for (int ci2 = 0; ci2 < 2; ++ci2) {
        const int ch = DIR ? 1 - ci2 : ci2, rowc = row0 + 32 * ch;
        const v2u x0 = ch ? U.u[1][0] : U.u[0][0], x1 = ch ? U.u[1][1] : U.u[0][1];
        const bf16x4_t ua0 = __builtin_bit_cast(bf16x4_t, x0), ua1 = __builtin_bit_cast(bf16x4_t, x1);
        if (MODE == 2) { *(LAS v2u*)(hs + 13312 + m32 * 32 + 8 * hh) = x0; *(LAS v2u*)(hs + 13312 + m32 * 32 + 16 + 8 * hh) = x1; }
        f32x16 BU[4];
#pragma unroll
        for (int nt = 0; nt < 4; ++nt) {
#pragma unroll
            for (int r = 0; r < 16; ++r) BU[nt][r] = 0.f;
            BU[nt] = MFMA8(ua0, bfr[nt][0], BU[nt]); BU[nt] = MFMA8(ua1, bfr[nt][1], BU[nt]);
        }
#pragma unroll
        for (int sh = 0; sh < 2; ++sh)
#pragma unroll
            for (int gg = 0; gg < 4; ++gg)
#pragma unroll
                for (int jj = 1; jj < 4; ++jj) {
                    const int r = DIR ? 4 * gg + 3 - jj : 4 * gg + jj, rp = DIR ? r + 1 : r - 1;
                    const float pr = BU[sh][rp], pi = BU[2 + sh][rp];
                    BU[sh][r] += ar[sh] * pr - ai[sh] * pi; BU[2 + sh][r] += ar[sh] * pi + ai[sh] * pr;
                }
        float hnr[2][4], hni[2][4];
        {
            float elr[2][4], eli[2][4], ehr[2][4], ehi[2][4];
#pragma unroll
            for (int sh = 0; sh < 2; ++sh)
#pragma unroll
                for (int gg = 0; gg < 4; ++gg) { const int rl = DIR ? 4 * gg : 4 * gg + 3;
                    const unsigned vr = f2u_(BU[sh][rl]), vi = f2u_(BU[2 + sh][rl]);
                    const auto sr = __builtin_amdgcn_permlane32_swap(vr, vr, false, false), si = __builtin_amdgcn_permlane32_swap(vi, vi, false, false);
                    elr[sh][gg] = u2f_((unsigned)sr[0]); ehr[sh][gg] = u2f_((unsigned)sr[1]); eli[sh][gg] = u2f_((unsigned)si[0]); ehi[sh][gg] = u2f_((unsigned)si[1]); }
            float tr[2], ti[2];
#pragma unroll
            for (int st = 0; st < 8; ++st) {
                const int grp = DIR ? 7 - st : st, gg = grp >> 1, half = grp & 1;
#pragma unroll
                for (int sh = 0; sh < 2; ++sh) {
                    if (half == (DIR ? 1 : 0)) { tr[sh] = hr[sh]; ti[sh] = hi[sh]; }
                    else { hnr[sh][gg] = (hh == half) ? hr[sh] : tr[sh]; hni[sh][gg] = (hh == half) ? hi[sh] : ti[sh]; }
                    const float er = half ? ehr[sh][gg] : elr[sh][gg], ei = half ? ehi[sh][gg] : eli[sh][gg];
                    const float nr = er + a4r[sh] * hr[sh] - a4i[sh] * hi[sh], ni = ei + a4r[sh] * hi[sh] + a4i[sh] * hr[sh];
                    hr[sh] = nr; hi[sh] = ni;
                }
            }
        }
        if (MODE != 0) {
#pragma unroll
            for (int sh = 0; sh < 2; ++sh)
#pragma unroll
                for (int gg = 0; gg < 4; ++gg)
#pragma unroll
                    for (int jj = 0; jj < 4; ++jj) {
                        const int pw = DIR ? 4 - jj : jj + 1;
                        const float pr = (pw == 1) ? ar[sh] : (pw == 2) ? a2r[sh] : (pw == 3) ? a3r[sh] : a4r[sh], pi = (pw == 1) ? ai[sh] : (pw == 2) ? a2i[sh] : (pw == 3) ? a3i[sh] : a4i[sh];
                        BU[sh][4 * gg + jj] += pr * hnr[sh][gg] - pi * hni[sh][gg]; BU[2 + sh][4 * gg + jj] += pr * hni[sh][gg] + pi * hnr[sh][gg];
                    }
#pragma unroll
            for (int r = 0; r < 16; ++r) { v2u w; w.x = pkbf(BU[0][r], BU[1][r]); w.y = pkbf(BU[2][r], BU[3][r]);
                *(LAS v2u*)(hs + ((r & 3) + 8 * (r >> 2) + 4 * hh) * 272 + m32 * 8) = w; }
            f32x16 Yv, Yw;
#pragma unroll
            for (int r = 0; r < 16; ++r) { Yv[r] = 0.f; Yw[r] = 0.f; }
#pragma unroll
            for (int s = 0; s < 16; s += 2) { Yv = MFMA8(ld4(hs + m32 * 272 + (8 * s + 4 * hh) * 2), cfr[s], Yv); Yw = MFMA8(ld4(hs + m32 * 272 + (8 * s + 8 + 4 * hh) * 2), cfr[s + 1], Yw); }
#pragma unroll
            for (int r = 0; r < 16; ++r) Yv[r] += Yw[r];
            if (m32 < 16) {
#pragma unroll
                for (int r = 0; r < 16; ++r) {
                    const int tl = (r & 3) + 8 * (r >> 2) + 4 * hh;
                    if (MODE == 1) yf[(32 * ch + tl) * 16 + m32] = Yv[r];
                    else { const float u = bf2f(*(const LAS unsigned short*)(hs + 13312 + tl * 32 + m32 * 2));
                        const float y = Yv[r] + yf[(32 * ch + tl) * 16 + m32] + ddv * u;
                        const float zz = gelu_tanh(y); Z[(size_t)(rowc + tl) * 256 + g * 16 + m32] = (bf16)pkbf(zz, zz); }
                }
            }
        }
    }
    hre = hh ? hr[1] : hr[0]; him = hh ? hi[1] : hi[0];
}
template <int MODE>
__device__ __forceinline__ void s5_mm(const S5P& sp, const S5U& U, int b, int g, int dir, int sg, int lane, float& hre, float& him, LAS float* yf, LAS unsigned char* hs, bf16* Z) {
    if (dir) s5_mm_dir<MODE, 1>(sp, U, b, g, sg, lane, hre, him, yf, hs, Z); else s5_mm_dir<MODE, 0>(sp, U, b, g, sg, lane, hre, him, yf, hs, Z);
}
template <int MIX, int DIR, bool WITH_O>
__device__ __forceinline__ void mx_chunk(LAS unsigned char* wl, int lane, float Pl, f32x16 (&ST)[(MIX == 2) ? 1 : 2][2], f32x16 (&O)[2]) {
    constexpr int DK = (MIX == 2) ? 32 : 64, NRT = DK / 32;
    const int m32 = lane & 31, hh = lane >> 5;
    asm volatile("" ::: "memory");
    if (lane < DK) *(LAS float*)(wl + WL_PL + lane * 4) = Pl;
    asm volatile("" ::: "memory");
    if (WITH_O) {
        f32x16 x;
#pragma unroll
        for (int r = 0; r < 16; ++r) x[r] = 0.f;
#pragma unroll
        for (int s = 0; s < DK / 8; ++s) {
            const bf16x4_t ka = ld4(wl + WL_KC + m32 * 144 + (8 * s + 4 * hh) * 2);
            const bf16x4_t qb = ld4(wl + WL_QC + m32 * 144 + (8 * s + 4 * hh) * 2);
            x = MFMA8(ka, qb, x);
        }
#pragma unroll
        for (int r = 0; r < 16; ++r) { const int j = (r & 3) + 8 * (r >> 2) + 4 * hh; const bool keep = DIR ? (j >= m32) : (j <= m32); x[r] = keep ? x[r] : 0.f; }
#pragma unroll
        for (int t = 0; t < 2; ++t)
#pragma unroll
            for (int r = 0; r < 16; ++r) O[t][r] = 0.f;
#pragma unroll
        for (int s = 0; s < 4; ++s) {
            const bf16x4_t xa = pack4(x, s);
#pragma unroll
            for (int t = 0; t < 2; ++t) O[t] = MFMA8(ld4(wl + WL_VT + (32 * t + m32) * 80 + (8 * s + 4 * hh) * 2), xa, O[t]);
        }
#pragma unroll
        for (int rt = 0; rt < NRT; ++rt)
#pragma unroll
            for (int s = 0; s < 4; ++s) {
                const bf16x4_t qa = ld4(wl + WL_QC + m32 * 144 + (32 * rt + 8 * s + 4 * hh) * 2);
#pragma unroll
                for (int t = 0; t < 2; ++t) O[t] = MFMA8(pack4(ST[rt][t], s), qa, O[t]);
            }
    }
#pragma unroll
    for (int rt = 0; rt < NRT; ++rt)
#pragma unroll
        for (int s = 0; s < 4; ++s) {
            const bf16x4_t ka = ld4(wl + WL_KT + (32 * rt + m32) * 80 + (8 * s + 4 * hh) * 2);
#pragma unroll
            for (int t = 0; t < 2; ++t) ST[rt][t] = MFMA8(ka, ld4(wl + WL_VT + (32 * t + m32) * 80 + (8 * s + 4 * hh) * 2), ST[rt][t]);
        }
#pragma unroll
    for (int rt = 0; rt < NRT; ++rt)
#pragma unroll
        for (int g = 0; g < 4; ++g) {
            const f32x4 pl4 = *(const LAS f32x4*)(wl + WL_PL + (32 * rt + 8 * g + 4 * hh) * 4);
#pragma unroll
            for (int e = 0; e < 4; ++e) { ST[rt][0][4 * g + e] *= pl4[e]; ST[rt][1][4 * g + e] *= pl4[e]; }
        }
}
__device__ __forceinline__ float half_sum(float v) {
#pragma unroll
    for (int o = 1; o < 32; o <<= 1) v += __shfl_xor(v, o);
    return v;
}
template <int MIX, int DIR>
__device__ __forceinline__ void mixA_stream(const MixP& mp, const MxC& c, int row0, int tpos0, int lane, LAS unsigned char* wl, f32x16 (&ST)[(MIX == 2) ? 1 : 2][2], float& Gam) {
    f32x16 O[2];
    MxRaw r[8];
#pragma unroll
    for (int i = 0; i < 8; ++i) mx_load<MIX, false, DIR>(r[i], mp, c, row0, i);
    float rc = 1.0f, rs = 0.0f;
    if (MIX == 0 && tpos0 >= 0) { const int tpos = tpos0 + (DIR ? 63 : 0); const int pos = (lane & 32) ? (tpos & 63) : (tpos >> 6);
        const unsigned ro = 4u * (unsigned)(pos * 16 + (lane & 15)); rc = GLD(float, mp.rcos, ro); rs = GLD(float, mp.rsin, ro); }
    float P = 1.0f;
#pragma unroll 1
    for (int ck = 0; ck < 2; ++ck) {
        int ln = lane; asm volatile("" : "+v"(ln));
#pragma unroll
        for (int j = 0; j < 8; ++j) {
            mx_batch<MIX, false, DIR>(r[j], mp, c, tpos0, ln, wl, j, P, rc, rs);
            if (ck == 0) mx_load<MIX, false, DIR>(r[j], mp, c, row0, 8 + j);
        }
        Gam *= P; mx_chunk<MIX, 0, false>(wl, ln, P, ST, O); P = 1.0f;
    }
}
template <int MIX>
__device__ __forceinline__ void mixA_unit(const MixP& mp, float* STG, int idx, int lane_in, LAS unsigned char* wl) {
    int lane = lane_in;
    constexpr int DK = (MIX == 2) ? 32 : 64, NRT = DK / 32;
    const int dir = idx / 2112, rem = idx - dir * 2112, bh = rem / NSEG, sg = rem - bh * NSEG, b = bh >> 2, h = bh & 3;
    asm volatile("" : "+v"(lane));
    MxC c; mx_consts<MIX>(c, mp, h, dir, lane);
    f32x16 ST[NRT][2];
#pragma unroll
    for (int rt = 0; rt < NRT; ++rt)
#pragma unroll
        for (int t = 0; t < 2; ++t)
#pragma unroll
            for (int r = 0; r < 16; ++r) ST[rt][t][r] = 0.f;
    const int row0 = seg_row0(b, sg), tpos0 = seg_tpos0(sg);
    float Gam = 1.0f;
    if (dir) mixA_stream<MIX, 1>(mp, c, row0, tpos0, lane, wl, ST, Gam); else mixA_stream<MIX, 0>(mp, c, row0, tpos0, lane, wl, ST, Gam);
    const size_t slot = (size_t)((dir * 16 + bh) * NSEG + sg);
    bf16* ds = (bf16*)(STG + (MIX == 0 ? ST_DS0 : (MIX == 1 ? ST_DS1 : ST_DS2))) + slot * (DK * 64);
    const int m32 = lane & 31, hh = lane >> 5;
#pragma unroll
    for (int rt = 0; rt < NRT; ++rt)
#pragma unroll
        for (int t = 0; t < 2; ++t)
#pragma unroll
            for (int r4 = 0; r4 < 4; ++r4) { v2u v; v.x = pkbf(ST[rt][t][4 * r4], ST[rt][t][4 * r4 + 1]); v.y = pkbf(ST[rt][t][4 * r4 + 2], ST[rt][t][4 * r4 + 3]);
                GST(v2u, ds + ((rt * 2 + t) * 4 + r4) * 256, 8u * (unsigned)lane) = v; }
    float* gs = STG + (MIX == 0 ? ST_G0 : (MIX == 1 ? ST_G1 : ST_G2)) + slot * 64;
    GST(float, gs, 4u * (unsigned)lane) = Gam;
}
__device__ __forceinline__ void mx_epi_gates(const MixP& mp, int lane, int rowc, int gcol, v2u (&g)[2][4]) {
    const int m32 = lane & 31, hh = lane >> 5;
    const bf16* gb = mp.P + (size_t)(rowc >> 2) * P4G + gcol;
    const unsigned gvo = 2u * (unsigned)((m32 >> 2) * P4G + (m32 & 3) * 256 + 4 * hh);
#pragma unroll
    for (int t = 0; t < 2; ++t)
#pragma unroll
        for (int s = 0; s < 4; ++s) g[t][s] = GLD(v2u, gb + 32 * t + 8 * s, gvo);
}
__device__ __forceinline__ void mx_epi_of(int lane, const float* OFc, v2u (&of)[2][4]) {
#pragma unroll
    for (int t = 0; t < 2; ++t)
#pragma unroll
        for (int s = 0; s < 4; ++s) of[t][s] = GLD(v2u, (const bf16*)OFc + (t * 4 + s) * 256, 8u * (unsigned)lane);
}
template <int MIX, int MODE>
__device__ __forceinline__ void mx_epilogue(const MixP& mp, LAS unsigned char* wl, int lane, f32x16 (&O)[2], int rowc, float* OFc, bf16* Y, int ycol, const v2u (&g)[2][4], const v2u (&of)[2][4]) {
    const int m32 = lane & 31, hh = lane >> 5;
    if (MODE == 1) {
#pragma unroll
        for (int t = 0; t < 2; ++t)
#pragma unroll
            for (int s = 0; s < 4; ++s) { v2u v; v.x = pkbf(O[t][4 * s], O[t][4 * s + 1]); v.y = pkbf(O[t][4 * s + 2], O[t][4 * s + 3]); GST(v2u, (bf16*)OFc + (t * 4 + s) * 256, 8u * (unsigned)lane) = v; }
    } else {
#pragma unroll
        for (int t = 0; t < 2; ++t)
#pragma unroll
            for (int s = 0; s < 4; ++s)
#pragma unroll
                for (int j = 0; j < 4; ++j) O[t][4 * s + j] += bfx(of[t][s], j);
        float mean = 0.f;
        if (MIX == 0) { float sm = 0.f;
#pragma unroll
            for (int t = 0; t < 2; ++t)
#pragma unroll
                for (int r = 0; r < 16; ++r) sm += O[t][r];
            sm += __shfl_xor(sm, 32); mean = sm * (1.0f / 64.0f); }
        float ss = 0.f;
#pragma unroll
        for (int t = 0; t < 2; ++t)
#pragma unroll
            for (int r = 0; r < 16; ++r) { const float d = O[t][r] - mean; ss = fmaf(d, d, ss); }
        ss += __shfl_xor(ss, 32);
        const float rs = __builtin_amdgcn_rsqf(ss * (1.0f / 64.0f) + NEPS), mo = -mean * rs;
        asm volatile("" ::: "memory");
#pragma unroll
        for (int t = 0; t < 2; ++t)
#pragma unroll
            for (int s = 0; s < 4; ++s) { float y[4];
#pragma unroll
                for (int j = 0; j < 4; ++j) y[j] = fmaf(O[t][4 * s + j], rs, mo) * silu_f(bfx(g[t][s], j));
                v2u w; w.x = pkbf(y[0], y[1]); w.y = pkbf(y[2], y[3]);
                *(LAS v2u*)(wl + WL_QC + m32 * 144 + (32 * t + 8 * s + 4 * hh) * 2) = w; }
        asm volatile("" ::: "memory");
#pragma unroll
        for (int k = 0; k < 4; ++k) { const v4u w = *(const LAS v4u*)(wl + WL_QC + ((lane >> 3) + 8 * k) * 144 + (lane & 7) * 16);
            GST(v4u, Y + (size_t)(rowc + 8 * k) * 1024 + ycol, 2u * (unsigned)((lane >> 3) * 1024 + (lane & 7) * 8)) = w; }
        asm volatile("" ::: "memory");
    }
}
template <int MIX, int DIR>
__device__ __forceinline__ void mixC_stream(const MixP& mp, const MxC& c, int row0, int tpos0, int lane, LAS unsigned char* wl, f32x16 (&ST)[(MIX == 2) ? 1 : 2][2],
                                            float* OFu, bf16* Y, int ycol, int gcol) {
    f32x16 O[2];
    MxRaw r[4];
#pragma unroll
    for (int i = 0; i < 3; ++i) mx_load<MIX, true, DIR>(r[i], mp, c, row0, i);
    float rc = 1.0f, rs = 0.0f;
    if (MIX == 0 && tpos0 >= 0) { const int tpos = tpos0 + (DIR ? 63 : 0); const int pos = (lane & 32) ? (tpos & 63) : (tpos >> 6);
        const unsigned ro = 4u * (unsigned)(pos * 16 + (lane & 15)); rc = GLD(float, mp.rcos, ro); rs = GLD(float, mp.rsin, ro); }
    float P = 1.0f;
#pragma unroll 1
    for (int b4 = 0; b4 < 16; b4 += 4) {
        int ln = lane; asm volatile("" : "+v"(ln));
#pragma unroll
        for (int j = 0; j < 4; ++j) {
            if (b4 < 12 || j == 0) mx_load<MIX, true, DIR>(r[(j + 3) & 3], mp, c, row0, b4 + j + 3);
            mx_batch<MIX, true, DIR>(r[j], mp, c, tpos0, ln, wl, (b4 & 4) + j, P, rc, rs);
        }
        if (b4 & 4) {
            const int ck = b4 >> 3, ch = DIR ? 1 - ck : ck; float* OFc = OFu + (size_t)ch * (12 * 2048);
            v2u g[2][4], of[2][4];
            mx_chunk<MIX, DIR, true>(wl, ln, P, ST, O); P = 1.0f;
            if (DIR) { mx_epi_gates(mp, ln, row0 + 32 * ch, gcol, g); mx_epi_of(ln, OFc, of); }
            mx_epilogue<MIX, DIR ? 2 : 1>(mp, wl, ln, O, row0 + 32 * ch, OFc, Y, ycol, g, of);
        }
    }
}
template <int MIX>
__device__ __forceinline__ void mixC_unit(const MixP& mp, const float* STG, int idx, int lane_in, float* OF, LAS unsigned char* wl, bf16* Y) {
    int lane = lane_in; asm volatile("" : "+v"(lane));
    constexpr int DK = (MIX == 2) ? 32 : 64, NRT = DK / 32;
    const int bh = idx / NSEG, sg = idx - bh * NSEG, b = bh >> 2, h = bh & 3;
    const int row0 = seg_row0(b, sg), tpos0 = seg_tpos0(sg);
    const int ycol = ((MIX == 0) ? 0 : (MIX == 1 ? 512 : 768)) + h * 64;
    const int gcol = 4 * ((MIX == 0) ? C_RG : (MIX == 1 ? C_HG : C_GG)) + h * 64;
    float* OFu = OF + ((size_t)(row0 >> 5) * 12 + MIX * 4 + h) * 2048;
    const bf16* dsb = (const bf16*)(STG + (MIX == 0 ? ST_DS0 : (MIX == 1 ? ST_DS1 : ST_DS2)));
    f32x16 ST[NRT][2];
#pragma unroll 1
    for (int dir = 0; dir < 2; ++dir) {
        asm volatile("" : "+v"(lane));
        const int m32 = lane & 31, hh = lane >> 5;
        MxC c; mx_consts<MIX>(c, mp, h, dir, lane);
        { const bf16* ds = dsb + (size_t)((dir * 16 + bh) * NSEG + sg) * (DK * 64);
#pragma unroll
          for (int rt = 0; rt < NRT; ++rt)
#pragma unroll
              for (int t = 0; t < 2; ++t)
#pragma unroll
                  for (int r4 = 0; r4 < 4; ++r4) { const v2u v = GLD(v2u, ds + ((rt * 2 + t) * 4 + r4) * 256, 8u * (unsigned)lane);
                      ST[rt][t][4 * r4] = bfx(v, 0); ST[rt][t][4 * r4 + 1] = bfx(v, 1); ST[rt][t][4 * r4 + 2] = bfx(v, 2); ST[rt][t][4 * r4 + 3] = bfx(v, 3); } }
        if (dir == 0) mixC_stream<MIX, 0>(mp, c, row0, tpos0, lane, wl, ST, OFu, Y, ycol, gcol);
        else mixC_stream<MIX, 1>(mp, c, row0, tpos0, lane, wl, ST, OFu, Y, ycol, gcol);
        asm volatile("s_waitcnt vmcnt(0)" ::: "memory");
    }
}
template <int MSEL>
__device__ __forceinline__ void mix_passA(const Frame& F, const Args& a, int l) {
    const MixP mp = make_mixp(F, a, l); const S5P sp = make_s5p(F, a, l);
    float* ST = (float*)(F.ws + WS_X2);
    LAS unsigned char* wl = F.lds + F.wave * WL_BYTES; LAS float* stg = (LAS float*)wl;
    if (MSEL == 15) {
        constexpr int NMX = 3 * 4224, NS5 = 2 * 64 * NSEG;
        const int heavy = NMX - (NMX / F.NGW) * F.NGW, nlight = F.NGW - heavy;
        const int n_all = (NS5 - 4 * nlight) / F.NGW;
        for (int it = 0; ; ++it) {
            int u;
            const int nmine = NMX / F.NGW + (F.gw < heavy ? 1 : 0);
            if (it < nmine) u = F.gw + it * F.NGW;
            else if (it < nmine + n_all) u = NMX + F.gw + (it - nmine) * F.NGW;
            else { const int k2 = it - nmine - n_all; if (F.gw < heavy || k2 >= 4) {
                    const int rest0 = NMX + n_all * F.NGW + 4 * nlight; const int uu = rest0 + F.gw + (k2 - (F.gw < heavy ? 0 : 4)) * F.NGW; if (uu >= NMX + NS5) break; u = uu; }
                else u = NMX + n_all * F.NGW + (F.gw - heavy) + k2 * nlight; }
            if (u >= NMX + NS5) break;
            if (u < 4224) mixA_unit<0>(mp, ST, u, fresh_lane(), wl);
            else if (u < 2 * 4224) mixA_unit<1>(mp, ST, u - 4224, fresh_lane(), wl);
            else if (u < 3 * 4224) mixA_unit<2>(mp, ST, u - 2 * 4224, fresh_lane(), wl);
            else { const int idx = u - 3 * 4224; const int dir = idx / (64 * NSEG), rem = idx - dir * 64 * NSEG, bg = rem / NSEG, sg = rem - bg * NSEG;
                float hre = 0.f, him = 0.f;
                S5U U; s5_load_u(U, mp.P, bg >> 4, bg & 15, sg, fresh_lane()); s5_mm<0>(sp, U, bg >> 4, bg & 15, dir, sg, fresh_lane(), hre, him, nullptr, wl, nullptr);
                float* hs = ST + ST_HS + ((size_t)((dir * 64 + bg) * NSEG + sg) * 64 + fresh_lane()) * 2;
                hs[0] = hre; hs[1] = him; }
        }
        return;
    }
    if (MSEL & 1) for (int u = F.gw; u < 4224; u += F.NGW) mixA_unit<0>(mp, ST, u, fresh_lane(), wl);
    if (MSEL & 2) for (int u = F.gw; u < 4224; u += F.NGW) mixA_unit<1>(mp, ST, u, fresh_lane(), wl);
    if (MSEL & 4) for (int u = F.gw; u < 4224; u += F.NGW) mixA_unit<2>(mp, ST, u, fresh_lane(), wl);
    if (MSEL & 8) for (int idx = F.gw; idx < 2 * 64 * NSEG; idx += F.NGW) {
        const int dir = idx / (64 * NSEG), rem = idx - dir * 64 * NSEG, bg = rem / NSEG, sg = rem - bg * NSEG;
        float hre = 0.f, him = 0.f;
        S5U U; s5_load_u(U, mp.P, bg >> 4, bg & 15, sg, fresh_lane()); s5_mm<0>(sp, U, bg >> 4, bg & 15, dir, sg, fresh_lane(), hre, him, nullptr, wl, nullptr);
        float* hs = ST + ST_HS + ((size_t)((dir * 64 + bg) * NSEG + sg) * 64 + fresh_lane()) * 2;
        hs[0] = hre; hs[1] = him;
    }
}
__device__ __forceinline__ int chain_seg(int dir, int p) { return dir ? (p < 4 ? 3 - p : 135 - p) : p; }
__device__ __forceinline__ void mix_passB(const Frame& F, const Args& a, int l) {
    float* ST = (float*)(F.ws + WS_X2);
    constexpr int N0 = 32768, N1 = 32768, N2 = 16384, N3 = 8192;
    for (int e = blockIdx.x * 512 + F.tid; e < N0 + N1 + N2 + N3; e += F.G * 512) {
        if (e < N0 + N1 + N2) {
            bf16* base; const float* gb; int dir, esz;
            if (e < N0 + N1) { const int mix = e >= N0, e2 = e - mix * N0, c = e2 >> 10, el = (e2 & 1023) * 4; dir = c >> 4; esz = 4096;
                base = (bf16*)(ST + (mix ? ST_DS1 : ST_DS0)) + (size_t)c * NSEG * 4096 + el; gb = ST + (mix ? ST_G1 : ST_G0) + (size_t)c * NSEG * 64 + 32 * (el >> 11) + 8 * ((el >> 8) & 3) + 4 * ((el >> 7) & 1); }
            else { const int e2 = e - N0 - N1, c = e2 >> 9, el = (e2 & 511) * 4; dir = c >> 4; esz = 2048;
                base = (bf16*)(ST + ST_DS2) + (size_t)c * NSEG * 2048 + el; gb = ST + ST_G2 + (size_t)c * NSEG * 64 + 8 * ((el >> 8) & 3) + 4 * ((el >> 7) & 1); }
            f32x4 run = {0.f, 0.f, 0.f, 0.f};
#pragma unroll 1
            for (int p0 = 0; p0 < NSEG; p0 += 12) {
                f32x4 d[12], gm[12];
#pragma unroll
                for (int q = 0; q < 12; ++q) { const int sg = chain_seg(dir, p0 + q); const v2u w = *(const v2u*)(base + (size_t)sg * esz); d[q] = (f32x4){bfx(w, 0), bfx(w, 1), bfx(w, 2), bfx(w, 3)}; gm[q] = *(const f32x4*)(gb + sg * 64); }
#pragma unroll
                for (int q = 0; q < 12; ++q) { const int sg = chain_seg(dir, p0 + q); v2u w; w.x = pkbf(run[0], run[1]); w.y = pkbf(run[2], run[3]); *(v2u*)(base + (size_t)sg * esz) = w; run = run * gm[q] + d[q]; }
            }
        } else {
            const int e2 = e - N0 - N1 - N2, c = e2 >> 6, p = e2 & 63, dir = c >> 6, g = c & 15;
            const int dg = dir * 16 + g;
            const float lre = a.in[F.zz + I_LAMRE][(size_t)l * 2048 + dg * 64 + p], lim = a.in[F.zz + I_LAMIM][(size_t)l * 2048 + dg * 64 + p], dt = expf(a.in[F.zz + I_LOGDT][l * 32 + dg]);
            const float er = expf(lre * dt * 64.0f); const float sn = sinf(lim * dt * 64.0f), cs = cosf(lim * dt * 64.0f);
            const float ar = er * cs, ai = er * sn;
            float* base = ST + ST_HS + ((size_t)c * NSEG * 64 + p) * 2;
            float rr = 0.f, ri = 0.f;
#pragma unroll 1
            for (int q0 = 0; q0 < NSEG; q0 += 12) {
                float dr[12], di[12];
#pragma unroll
                for (int q = 0; q < 12; ++q) { const int sg = chain_seg(dir, q0 + q); dr[q] = base[(size_t)sg * 128]; di[q] = base[(size_t)sg * 128 + 1]; }
#pragma unroll
                for (int q = 0; q < 12; ++q) { const int sg = chain_seg(dir, q0 + q); base[(size_t)sg * 128] = rr; base[(size_t)sg * 128 + 1] = ri;
                    const float nr = ar * rr - ai * ri + dr[q], ni = ar * ri + ai * rr + di[q]; rr = nr; ri = ni; }
            }
        }
    }
}
template <int MSEL>
__device__ __forceinline__ void mix_passC(const Frame& F, const Args& a, int l) {
    const MixP mp = make_mixp(F, a, l); const S5P sp = make_s5p(F, a, l);
    const float* ST = (const float*)(F.ws + WS_X2);
    LAS unsigned char* wl = F.lds + F.wave * WL_BYTES;
    LAS float* stg = (LAS float*)wl; LAS float* of = (LAS float*)(wl + 9216);
    float* OF = (float*)(F.ws + WS_OF);
    bf16* Y = (bf16*)(F.ws + WS_ACT); bf16* Z = (bf16*)(F.ws + WS_Z);
    const bool keep = l < DEPTH - 1;
    constexpr int NM = 16 * NSEG;
    if (MSEL == 15) {
        constexpr int NMX = 3 * NM, NS5 = 64 * NSEG;
        const int heavy = NMX - (NMX / F.NGW) * F.NGW, nlight = F.NGW - heavy;
        for (int it = 0; ; ++it) {
            int u;
            const int nmine = NMX / F.NGW + (F.gw < heavy ? 1 : 0);
            if (it < nmine) u = F.gw + it * F.NGW;
            else { if (F.gw < heavy) break; u = NMX + (F.gw - heavy) + (it - nmine) * nlight; }
            if (u >= NMX + NS5) break;
            const int sgu = (u < 3 * NM) ? (u % NSEG) : ((u - 3 * NM) % NSEG);
            if (!keep && sgu < 4) continue;
            if (u < NM) mixC_unit<0>(mp, ST, u, fresh_lane(), OF, wl, Y);
            else if (u < 2 * NM) mixC_unit<1>(mp, ST, u - NM, fresh_lane(), OF, wl, Y);
            else if (u < 3 * NM) mixC_unit<2>(mp, ST, u - 2 * NM, fresh_lane(), OF, wl, Y);
            else { const int idx = u - 3 * NM, bg = idx / NSEG, sg = idx - bg * NSEG;
                S5U U; s5_load_u(U, mp.P, bg >> 4, bg & 15, sg, fresh_lane());
                const float* h0 = ST + ST_HS + ((size_t)((0 * 64 + bg) * NSEG + sg) * 64 + fresh_lane()) * 2;
                float hre = h0[0], him = h0[1];
                s5_mm<1>(sp, U, bg >> 4, bg & 15, 0, sg, fresh_lane(), hre, him, of, wl, Z);
                const float* h1 = ST + ST_HS + ((size_t)((1 * 64 + bg) * NSEG + sg) * 64 + fresh_lane()) * 2;
                hre = h1[0]; him = h1[1];
                s5_mm<2>(sp, U, bg >> 4, bg & 15, 1, sg, fresh_lane(), hre, him, of, wl, Z); }
        }
        return;
    }
    if (MSEL & 1) for (int u = F.gw; u < NM; u += F.NGW) { if (!keep && (u % NSEG) < 4) continue; mixC_unit<0>(mp, ST, u, fresh_lane(), OF, wl, Y); }
    if (MSEL & 2) for (int u = F.gw; u < NM; u += F.NGW) { if (!keep && (u % NSEG) < 4) continue; mixC_unit<1>(mp, ST, u, fresh_lane(), OF, wl, Y); }
    if (MSEL & 4) for (int u = F.gw; u < NM; u += F.NGW) { if (!keep && (u % NSEG) < 4) continue; mixC_unit<2>(mp, ST, u, fresh_lane(), OF, wl, Y); }
    if (MSEL & 8) for (int idx = F.gw; idx < 64 * NSEG; idx += F.NGW) {
        const int bg = idx / NSEG, sg = idx - bg * NSEG;
        if (!keep && sg < 4) continue;
        S5U U; s5_load_u(U, mp.P, bg >> 4, bg & 15, sg, fresh_lane());
        const float* h0 = ST + ST_HS + ((size_t)((0 * 64 + bg) * NSEG + sg) * 64 + fresh_lane()) * 2;
        float hre = h0[0], him = h0[1];
        s5_mm<1>(sp, U, bg >> 4, bg & 15, 0, sg, fresh_lane(), hre, him, of, wl, Z);
        const float* h1 = ST + ST_HS + ((size_t)((1 * 64 + bg) * NSEG + sg) * 64 + fresh_lane()) * 2;
        hre = h1[0]; him = h1[1];
        s5_mm<2>(sp, U, bg >> 4, bg & 15, 1, sg, fresh_lane(), hre, him, of, wl, Z);
    }
}

constexpr int NPH = 11;
template <int PH_MASK, int MSEL>
__global__ void __launch_bounds__(512, 2) mk_fwd(Args a) {
    extern __shared__ __attribute__((aligned(16))) unsigned char lds_raw[];
    Frame F;
    F.lds = (LAS unsigned char*)lds_raw;
    const int wave0 = __builtin_amdgcn_readfirstlane((int)threadIdx.x >> 6);
    F.lane = fresh_lane(); F.tid = wave0 * 64 + F.lane; F.wave = wave0;
    F.G = gridDim.x; F.gw = blockIdx.x * 8 + F.wave; F.NGW = F.G * 8; F.zz = 0; F.ws = (unsigned char*)a.in[I_WS]; F.out = (float*)a.in[I_OUT];
    volatile LAS unsigned* MISC = (volatile LAS unsigned*)(F.lds + MISC_OFF);
    for (int u = F.tid; u < 64; u += 512) ((LAS unsigned*)(F.lds + MISC_OFF))[u] = 0u;
    __syncthreads();
    XcdBarrier bar; bar.bar = (unsigned*)F.ws + CW_BAR; bar.x = 0; bar.st = nullptr;
    if (a.fused) bar = xcd_barrier_post((unsigned*)F.ws + CW_BAR, MISC + 8, F.tid);
#define SEAM() do { if (a.fused) { XcdBarrier bb = bar; asm volatile("" : "+s"(bb.bar), "+s"(bb.x)); xcd_barrier(bb, wave0 * 64 + fresh_lane()); } } while (0)
#define PHASE_BEGIN() do { int zz_ = 0; asm volatile("" : "+s"(zz_)); F.zz = zz_; F.ws = (unsigned char*)a.in[I_WS + zz_]; F.out = (float*)a.in[I_OUT + zz_]; \
        const int ln_ = fresh_lane(); const int t_ = wave0 * 64 + ln_ + zz_; F.tid = t_; F.lane = t_ & 63; F.wave = wave0 + zz_; F.G = (int)gridDim.x + zz_; F.gw = ((int)blockIdx.x + zz_) * 8 + F.wave; F.NGW = F.G * 8; \
        F.lds = (LAS unsigned char*)lds_raw + zz_; } while (0)
#define IN(k) (((PH_MASK >> (k)) & 1) && a.ph_lo <= (k) && (k) < a.ph_hi)
#ifndef DUP_PH
#define DUP_PH 0
#endif
constexpr int TAILB = 16;
#define REP(k) for (int rep_ = 0; rep_ < (((DUP_PH >> (k)) & 1) ? 2 : 1); ++rep_)
#define hb ((float*)(F.ws + WS_HB))
#define MOD ((const float*)(F.ws + WS_MOD))
#define ACT ((bf16*)(F.ws + WS_ACT))
#define PH ((bf16*)(F.ws + WS_PH))

    if (((PH_MASK >> 12) & 1) && a.do_pro) REP(12) { PHASE_BEGIN(); s5_build(F, a); prologue(F, a); SEAM(); }

#pragma unroll
    for (int l = 0; l < DEPTH; ++l) {
        if (l < a.l_lo || l >= a.l_hi) continue;
        const bool keep = l < DEPTH - 1, moe = l & 1; const int j = l >> 1;
        const int Mrows = keep ? MT : NLAT;
        if (IN(0)) { PHASE_BEGIN();
            if ((l & 1) && F.G > TAILB) {
                if ((int)blockIdx.x < TAILB) {
                    const int lp = l - 1, jp = lp >> 1;
                    int k8 = DFF / 2; asm volatile("" : "+s"(k8)); pg8::Gemm g{(const bf16*)((const unsigned char*)PH + (size_t)NLAT * DFF), (const bf16*)(F.ws + WS_W2D + (size_t)jp * 1024 * DFF), MT - NLAT, 1024, k8}; pg8::StaticOrder S; S.init(MT - NLAT, 1024, TAILB, (int)blockIdx.x);
                    EpiResid E{F.out, hb, F.out, hb, MOD + (size_t)lp * 5 * 6144 + 5 * 1024, 1.0f / WSC8, NLAT / 256};
                    pg8::gemm_phase_f8<EpiResid, pg8::StaticOrder, true, true>(F.lds, g, S, E, F.tid);
                    group_arrive((unsigned*)F.ws + CW_TAIL + (2 * l + 1) * 64, F.tid);
                } else {
                    moe_cvt_idle(F, a, j, TAILB);
                    norm_phase<0>(F, a, l, 0, NLAT, -1, 0, ((int)blockIdx.x - TAILB) * 8 + F.wave, (F.G - TAILB) * 8);
                }
                group_wait((unsigned*)F.ws + CW_BAR, (unsigned*)F.ws + CW_TAIL + (2 * l + 1) * 64, TAILB, F.tid);
                norm_phase<0>(F, a, l, 0, MT, -1, NLAT, F.gw, F.NGW);
            } else {
                if (l & 1) moe_cvt(F, a, j);
                norm_phase<0>(F, a, l, 0, MT, (l == 2) ? 1 : -1);
            }
            SEAM();
        }
        if (IN(1)) REP(1) { PHASE_BEGIN();
            pg8::Gemm g{ACT, (const bf16*)(F.ws + WS_WIN) + (size_t)l * DINP * 1024, MT, DINP, 1024}; pg8::StaticOrder S; S.init(MT, DINP, F.G, (int)blockIdx.x);
            EpiStoreP4 E{PH};
            pg8::gemm_phase<EpiStoreP4, pg8::StaticOrder, true, true>(F.lds, g, S, E, F.tid);
            SEAM();
        }
        if (IN(2)) { PHASE_BEGIN(); mix_passA<MSEL>(F, a, l); SEAM(); }
#ifdef DUP_MIX
        if (IN(2)) { PHASE_BEGIN(); mix_passA<DUP_MIX>(F, a, l); SEAM(); }
#endif
#ifdef DUP_A
        if (IN(2)) { PHASE_BEGIN(); mix_passA<DUP_A>(F, a, l); SEAM(); }
#endif
        if (IN(3)) { PHASE_BEGIN(); mix_passB(F, a, l); SEAM(); }
        if (IN(4)) { PHASE_BEGIN(); mix_passC<MSEL>(F, a, l); SEAM(); }
#ifdef DUP_MIX
        if (IN(4)) { PHASE_BEGIN(); mix_passC<DUP_MIX>(F, a, l); SEAM(); }
#endif
#ifdef DUP_C
        if (IN(4)) { PHASE_BEGIN(); mix_passC<DUP_C>(F, a, l); SEAM(); }
#endif
        if (IN(5)) REP(5) { PHASE_BEGIN();
            int k256 = 256; asm volatile("" : "+s"(k256)); pg8::Gemm g{(const bf16*)(F.ws + WS_Z), (const bf16*)(F.ws + WS_GLUW) + (size_t)l * 65536, Mrows, 256, k256}; pg8::StaticOrder S; S.init(Mrows, 256, F.G, (int)blockIdx.x);
            EpiGlu E{(const bf16*)(F.ws + WS_Z), ACT, a.in[F.zz + I_GLUB] + l * 256};
            pg8::gemm_phase<EpiGlu, pg8::StaticOrder, true, true>(F.lds, g, S, E, F.tid);
            SEAM();
        }
        const bool tail = keep && F.G > TAILB;
        if (IN(6)) { PHASE_BEGIN();
            const int Mg = tail ? NLAT : Mrows;
            pg8::Gemm g{ACT, (const bf16*)(F.ws + WS_WOUT) + (size_t)l * 1024 * 1024, Mg, 1024, 1024}; pg8::StaticOrder S; S.init(Mg, 1024, F.G, (int)blockIdx.x);
            EpiResid E{(l == 0) ? a.in[F.zz + I_X] : F.out, (l == 0) ? a.in[F.zz + I_CTX] : hb, F.out, hb, MOD + (size_t)l * 5 * 6144 + 2 * 1024, 1.0f};
            pg8::gemm_phase<EpiResid, pg8::StaticOrder, true, true>(F.lds, g, S, E, F.tid);
            SEAM();
        }
        if (IN(7)) { PHASE_BEGIN();
            if (tail) {
                if ((int)blockIdx.x < TAILB) {
                    pg8::Gemm g{ACT + (size_t)NLAT * 1024, (const bf16*)(F.ws + WS_WOUT) + (size_t)l * 1024 * 1024, MT - NLAT, 1024, 1024}; pg8::StaticOrder S; S.init(MT - NLAT, 1024, TAILB, (int)blockIdx.x);
                    EpiResid E{(l == 0) ? a.in[F.zz + I_X] : F.out, (l == 0) ? a.in[F.zz + I_CTX] : hb, F.out, hb, MOD + (size_t)l * 5 * 6144 + 2 * 1024, 1.0f, NLAT / 256};
                    pg8::gemm_phase<EpiResid, pg8::StaticOrder, true, true>(F.lds, g, S, E, F.tid);
                    group_arrive((unsigned*)F.ws + CW_TAIL + (2 * l) * 64, F.tid);
                } else {
                    if (moe) norm_phase<1>(F, a, l, 1, NLAT, -1, 0, ((int)blockIdx.x - TAILB) * 8 + F.wave, (F.G - TAILB) * 8); else norm_phase<0>(F, a, l, 1, NLAT, -1, 0, ((int)blockIdx.x - TAILB) * 8 + F.wave, (F.G - TAILB) * 8);
                }
                group_wait((unsigned*)F.ws + CW_BAR, (unsigned*)F.ws + CW_TAIL + (2 * l) * 64, TAILB, F.tid);
                if (moe) norm_phase<1>(F, a, l, 1, MT, -1, NLAT, F.gw, F.NGW); else norm_phase<0>(F, a, l, 1, MT, -1, NLAT, F.gw, F.NGW);
            } else { if (moe) norm_phase<1>(F, a, l, 1, Mrows, -1); else norm_phase<0>(F, a, l, 1, Mrows, -1); }
            SEAM();
        }
        if (!moe) {
            if (IN(8)) REP(8) { PHASE_BEGIN();
                pg8::Gemm g{ACT, (const bf16*)(F.ws + WS_W13D) + (size_t)j * 5632 * 1024, Mrows, 5632, 1024}; pg8::StaticOrder S; S.init(Mrows, 5632, F.G, (int)blockIdx.x);
                EpiSwiglu8 E{(unsigned char*)PH, 1.0f};
                pg8::gemm_phase<EpiSwiglu8, pg8::StaticOrder, true, true>(F.lds, g, S, E, F.tid);
                SEAM();
            }
            if (IN(9)) { PHASE_BEGIN();
                const int Mg = tail ? NLAT : Mrows;
                int k8 = DFF / 2; asm volatile("" : "+s"(k8)); pg8::Gemm g{PH, (const bf16*)(F.ws + WS_W2D + (size_t)j * 1024 * DFF), Mg, 1024, k8}; pg8::StaticOrder S; S.init(Mg, 1024, F.G, (int)blockIdx.x);
                EpiResid E{F.out, hb, F.out, hb, MOD + (size_t)l * 5 * 6144 + 5 * 1024, 1.0f / WSC8};
                pg8::gemm_phase_f8<EpiResid, pg8::StaticOrder, true, true>(F.lds, g, S, E, F.tid);
                if (!tail) { const int rem = ((Mrows / 256) * 4) % F.G; if (rem > 0 && (int)blockIdx.x >= rem) moe_cvt_idle(F, a, j, rem); else if (rem == 0) moe_cvt(F, a, j); }
                SEAM();
            }
        } else {
                        if (IN(8)) REP(8) { PHASE_BEGIN(); moe_gather(F, j); SEAM(); }
            if (IN(9)) REP(9) { PHASE_BEGIN();
                int k8 = 512; asm volatile("" : "+s"(k8)); pg8::Gemm g{(const bf16*)(F.ws + WS_X2), (const bf16*)(F.ws + WS_W13M), 0, 5632, k8}; MoeOrder S; S.init((const unsigned*)F.ws + CW_CNT + j * 8 * 64, 22, F.G, (int)blockIdx.x);
                EpiSwiglu8 E{(unsigned char*)PH, 1.0f / WSC8};
                pg8::gemm_phase_f8<EpiSwiglu8, MoeOrder, true, true>(F.lds, g, S, E, F.tid);
                SEAM();
            }
            if (IN(10)) REP(10) { PHASE_BEGIN();
                int k8 = DFF / 2; asm volatile("" : "+s"(k8)); pg8::Gemm g{PH, (const bf16*)(F.ws + WS_W2M), 0, 1024, k8}; MoeOrder S; S.init((const unsigned*)F.ws + CW_CNT + j * 8 * 64, 4, F.G, (int)blockIdx.x);
                EpiStoreBf16 E{(bf16*)(F.ws + WS_X2), 1024, 1.0f / WSC8};
                pg8::gemm_phase_f8<EpiStoreBf16, MoeOrder, true, true>(F.lds, g, S, E, F.tid);
                SEAM();
            }
        }
    }
    if (((PH_MASK >> 13) & 1) && a.do_fin) { PHASE_BEGIN(); norm_phase<2>(F, a, DEPTH - 1, 0, NLAT, DEPTH - 1); }
#undef SEAM
#undef IN
#undef hb
#undef MOD
#undef ACT
#undef PH
}

#ifndef MK_FUSED
#define MK_FUSED 1
#endif
template <int PM, int MS> static void launch_one(const Args& a, int grid, hipStream_t stream) {
    static bool attr_done = false;
    if (!attr_done) { (void)hipFuncSetAttribute((const void*)mk_fwd<PM, MS>, hipFuncAttributeMaxDynamicSharedMemorySize, LDS_BYTES); attr_done = true; }
    hipLaunchKernelGGL((mk_fwd<PM, MS>), dim3(grid), dim3(512), LDS_BYTES, stream, a);
}
extern "C" void kernel_launch(void* const* d_in, const int* in_sizes, int n_in, void* d_out, int out_size, void* d_ws, size_t ws_size, hipStream_t stream) {
    static int grid = 0;
    if (grid == 0) {
        if (n_in != 35 || in_sizes[0] != NLAT * DM || out_size != NLAT * DM || ws_size < WS_END) {
            fprintf(stderr, "kernel_launch: unexpected shapes / workspace (n_in %d, ws %zu, need %zu); nothing launched\n", n_in, ws_size, (size_t)WS_END); grid = -1; return; }
        int dev = 0, cus = 0;
        if (hipGetDevice(&dev) != hipSuccess || hipDeviceGetAttribute(&cus, hipDeviceAttributeMultiprocessorCount, dev) != hipSuccess) { grid = -1; return; }
        grid = cus;
    }
    if (grid < 0) return;
    (void)hipMemsetAsync((char*)d_ws + WS_CTL, 0, CTL_ZERO_BYTES, stream);
    Args a{};
    for (int i = 0; i < 35; ++i) a.in[i] = (const float*)d_in[i];
    a.in[I_OUT] = (const float*)d_out; a.in[I_WS] = (const float*)d_ws; a.pad = 0;
#if MK_FUSED
    a.l_lo = 0; a.l_hi = DEPTH; a.ph_lo = 0; a.ph_hi = NPH; a.do_pro = 1; a.do_fin = 1; a.fused = 1;
#ifndef TEST_PM
#define TEST_PM 0xFFFF
#endif
#ifndef TEST_MS
#define TEST_MS 15
#endif
    launch_one<TEST_PM, TEST_MS>(a, grid, stream);
#else
    a.fused = 0;
    a.l_lo = 0; a.l_hi = 0; a.ph_lo = 0; a.ph_hi = 0; a.do_pro = 1; a.do_fin = 0;
    launch_one<0x1000, 15>(a, grid, stream);
    a.do_pro = 0;
    for (int l = 0; l < DEPTH; ++l) {
        a.l_lo = l; a.l_hi = l + 1; a.ph_lo = 0; a.ph_hi = NPH;
        launch_one<0x1, 15>(a, grid, stream); launch_one<0x2, 15>(a, grid, stream); launch_one<0x4, 15>(a, grid, stream); launch_one<0x8, 15>(a, grid, stream);
        launch_one<0x10, 1>(a, grid, stream); launch_one<0x10, 2>(a, grid, stream); launch_one<0x10, 4>(a, grid, stream); launch_one<0x10, 8>(a, grid, stream);
        launch_one<0x20, 15>(a, grid, stream); launch_one<0x40, 15>(a, grid, stream); launch_one<0x80, 15>(a, grid, stream);
        launch_one<0x100, 15>(a, grid, stream); launch_one<0x200, 15>(a, grid, stream);
        if (l & 1) launch_one<0x400, 15>(a, grid, stream);
    }
    a.l_lo = 0; a.l_hi = 0; a.ph_lo = 0; a.ph_hi = 0; a.do_fin = 1;
    launch_one<0x2000, 15>(a, grid, stream);
#endif
}
```

```cpp
#include <hip/hip_runtime.h>
#include <cstdio>
#include <cstdint>
#define LAS __attribute__((address_space(3)))
namespace pg8 {
#define PG8_LAS __attribute__((address_space(3)))
typedef unsigned short bf16_t;
typedef short bf16x8 __attribute__((ext_vector_type(8)));
typedef float f32x4 __attribute__((ext_vector_type(4)));
typedef unsigned u32x4 __attribute__((ext_vector_type(4)));
constexpr int BM = 256, BK = 64, HALF = 128, HTB = HALF * BK * 2  , STAGE_BYTES = 8 * HTB, NXCD = 8, WGM = 8;

__host__ __device__ __forceinline__ int lds_byte(int r, int c) { const int st = (r >> 4) * 2 + (c >> 5), rr = r & 15, cc = c & 31, ob = rr * 64 + cc * 2; return st * 1024 + (ob ^ (((ob >> 9) & 1) << 5)); }
__host__ __device__ __forceinline__ void stage_rc(int b, int& R, int& C) { const int st = b / 1024, sb = b % 1024, swz = sb ^ (((sb >> 9) & 1) << 5); R = (st >> 1) * 16 + swz / 64; C = (st & 1) * 32 + (swz % 64) / 2; }
__host__ __device__ __forceinline__ int perm32(int rho) { const int n = rho >> 4, i = rho & 15; return 8 * (i >> 2) + 4 * n + (i & 3); }

__host__ __device__ __forceinline__ int perm32f(int rho) { return 2 * (rho & 15) + (rho >> 4); }
template <class E, class = void> struct epi_flip { static constexpr bool v = false; };
template <class E> struct epi_flip<E, decltype((void)E::FLIP)> { static constexpr bool v = E::FLIP; };
struct Unit { int pm, pn, pc; };
struct Gemm { const bf16_t* A; const bf16_t* Bt; int M, N, K; };

struct StaticOrder {
    int nM, nN, nwg, G, c;
    __host__ __device__ void init(int M, int N, int G_, int c_) { nM = M / BM; nN = N / BM; nwg = nM * nN; G = G_; c = c_; }
    __host__ __device__ bool next(int i, Unit& u) const {
        const long L = (long)i * G + c; if (L >= nwg) return false;
        int wgid = (int)L; { const int q = nwg / NXCD, r = nwg % NXCD, xcd = wgid % NXCD, off = wgid / NXCD; wgid = (xcd < r ? xcd * (q + 1) : r * (q + 1) + (xcd - r) * q) + off; }
        const int nig = WGM * nN, gid = wgid / nig, fm = gid * WGM, gsz = (nM - fm) < WGM ? (nM - fm) : WGM;
        u.pm = fm + ((wgid % nig) % gsz); u.pn = (wgid % nig) / gsz; u.pc = u.pn; return true;
    }
    __device__ __forceinline__ void a_ready(const Unit&) const {}
    __device__ __forceinline__ void done(const Unit&) const {}
};

__device__ __forceinline__ unsigned cvt_pk_bf16(float lo, float hi) { unsigned r; asm volatile("v_cvt_pk_bf16_f32 %0, %1, %2" : "=v"(r) : "v"(lo), "v"(hi)); return r; }
typedef float f32x2 __attribute__((ext_vector_type(2)));

template <class Epi, class Sched, bool ALIGN_EPI = false, bool SP2 = false>
__device__ __forceinline__ void gemm_phase(PG8_LAS unsigned char* lds, const Gemm g, const Sched& S, const Epi& E, const int tid) {
    const int wid = __builtin_amdgcn_readfirstlane(tid >> 6), lane = tid & 63, wr = wid >> 2, wc = wid & 3, fr = lane & 15, fq = lane >> 4;
    const int K = g.K, nt = K / BK;
    unsigned voffA[2], voffB[2];
#pragma unroll
    for (int i = 0; i < 2; ++i) { int R, C; stage_rc(tid * 16 + i * 8192, R, C); const int Rb = epi_flip<Epi>::v ? ((R & ~31) + perm32f(R & 31)) : (Epi::PERM ? ((R & ~31) + perm32(R & 31)) : R);
        voffA[i] = (unsigned)(R * K + C) * 2u; voffB[i] = (unsigned)(Rb * K + C) * 2u; }
    const size_t kstep = (size_t)(BK * 2);
    const size_t hstep = (size_t)HALF * K * 2;
    const size_t tstep = 2 * hstep;
    const unsigned ldsw = (unsigned)wid * 1024u;
    const int aoff = lds_byte(wr * 64 + fr, fq * 8), boff = lds_byte(wc * 32 + fr, fq * 8);
#define PG8_SA(b, h) (((b) * 2 + (h)) * HTB)
#define PG8_SB(b, h) ((4 + (b) * 2 + (h)) * HTB)
#define PG8_STAGE(bufoff, gbase, voff) do { _Pragma("unroll") for (int _i = 0; _i < 2; ++_i) \
        __builtin_amdgcn_global_load_lds((const unsigned*)((const char*)(gbase) + (voff)[_i]), (PG8_LAS unsigned*)(lds + (bufoff) + ldsw + _i * 8192), 16, 0, 0); } while (0)
#define PG8_LDA(dst, b, h) do { _Pragma("unroll") for (int m = 0; m < 4; ++m) _Pragma("unroll") for (int k = 0; k < 2; ++k) dst[m][k] = *(const PG8_LAS bf16x8*)(lds + PG8_SA(b, h) + aoff + m * 2048 + k * 1024); } while (0)
#define PG8_LDB(dst, b, h) do { _Pragma("unroll") for (int n = 0; n < 2; ++n) _Pragma("unroll") for (int k = 0; k < 2; ++k) dst[n][k] = *(const PG8_LAS bf16x8*)(lds + PG8_SB(b, h) + boff + n * 2048 + k * 1024); } while (0)
#define PG8_MMA(ai, bj, At, Bt) do { __builtin_amdgcn_s_setprio(1); _Pragma("unroll") for (int m = 0; m < 4; ++m) _Pragma("unroll") for (int n = 0; n < 2; ++n) _Pragma("unroll") for (int k = 0; k < 2; ++k) \
        { if constexpr (epi_flip<Epi>::v) acc[ai][bj][m][n] = __builtin_amdgcn_mfma_f32_16x16x32_bf16(At[m][k], Bt[n][k], acc[ai][bj][m][n], 0, 0, 0); \
          else acc[ai][bj][m][n] = __builtin_amdgcn_mfma_f32_16x16x32_bf16(Bt[n][k], At[m][k], acc[ai][bj][m][n], 0, 0, 0); } __builtin_amdgcn_s_setprio(0); } while (0)
#define PG8_WAIT_V(n) asm volatile("s_waitcnt vmcnt(" #n ")" ::: "memory")
#define PG8_WAIT_L(n) asm volatile("s_waitcnt lgkmcnt(" #n ")" ::: "memory")
#define PG8_BAR __builtin_amdgcn_s_barrier()
#define PG8_SCHED __builtin_amdgcn_sched_barrier(0)
    Unit cur, nxt; int ui = 0;
    if (!S.next(0, cur)) return;
    f32x4 acc[2][2][4][2];
#pragma unroll
    for (int a = 0; a < 2; ++a)
#pragma unroll
        for (int b = 0; b < 2; ++b)
#pragma unroll
            for (int m = 0; m < 4; ++m)
#pragma unroll
                for (int n = 0; n < 2; ++n) acc[a][b][m][n] = (f32x4){0.f, 0.f, 0.f, 0.f};
    bf16x8 At[4][2], B0[2][2], B1[2][2];
    const char* cA = (const char*)g.A + (size_t)cur.pm * tstep; const char* cB = (const char*)g.Bt + (size_t)cur.pn * tstep;
    S.a_ready(cur);
    if constexpr (SP2) {
        PG8_STAGE(PG8_SB(0, 0), cB, voffB); PG8_STAGE(PG8_SB(0, 1), cB + hstep, voffB); PG8_STAGE(PG8_SA(0, 0), cA, voffA); PG8_STAGE(PG8_SA(0, 1), cA + hstep, voffA);
        if (wr == 1) PG8_BAR;
        PG8_WAIT_V(2); PG8_BAR;
        PG8_STAGE(PG8_SB(1, 0), cB + kstep, voffB); PG8_STAGE(PG8_SA(1, 0), cA + kstep, voffA); PG8_STAGE(PG8_SB(1, 1), cB + hstep + kstep, voffB);
        PG8_WAIT_V(6); PG8_BAR;
    } else {
        PG8_STAGE(PG8_SB(0, 0), cB, voffB); PG8_STAGE(PG8_SA(0, 0), cA, voffA); PG8_STAGE(PG8_SB(0, 1), cB + hstep, voffB); PG8_STAGE(PG8_SA(0, 1), cA + hstep, voffA);
        if (wr == 1) PG8_BAR;
        PG8_WAIT_V(4); PG8_BAR;
        PG8_STAGE(PG8_SB(1, 0), cB + kstep, voffB); PG8_STAGE(PG8_SA(1, 0), cA + kstep, voffA); PG8_STAGE(PG8_SB(1, 1), cB + hstep + kstep, voffB);
        PG8_WAIT_V(6); PG8_BAR;
    }
    for (;;) {
        const bool has_next = S.next(ui + 1, nxt);
        const char* nA = has_next ? (const char*)g.A + (size_t)nxt.pm * tstep : cA; const char* nB = has_next ? (const char*)g.Bt + (size_t)nxt.pn * tstep : cB;
        for (int t = 0; t < nt; t += 2) {
            const bool last = (t == nt - 2);
            const char* a1 = cA + (size_t)(t + 1) * kstep;
            const char* a2 = last ? nA : cA + (size_t)(t + 2) * kstep; const char* b2 = last ? nB : cB + (size_t)(t + 2) * kstep;
            const char* a3 = a2 + kstep; const char* b3 = b2 + kstep;
            if (last && has_next) S.a_ready(nxt);
            if constexpr (SP2) {
            PG8_LDB(B0, 0, 0); PG8_LDB(B1, 0, 1); PG8_SCHED; PG8_LDA(At, 0, 0); PG8_STAGE(PG8_SA(1, 1), a1 + hstep, voffA);
            PG8_WAIT_V(8); PG8_WAIT_L(0); PG8_BAR; PG8_MMA(0, 0, At, B0); PG8_MMA(0, 1, At, B1); PG8_BAR; PG8_SCHED;
            PG8_LDA(At, 0, 1); PG8_STAGE(PG8_SB(0, 0), b2, voffB); PG8_STAGE(PG8_SB(0, 1), b2 + hstep, voffB); PG8_STAGE(PG8_SA(0, 0), a2, voffA);
            PG8_WAIT_V(8); PG8_WAIT_L(0); PG8_BAR; PG8_MMA(1, 0, At, B0); PG8_MMA(1, 1, At, B1); PG8_BAR; PG8_SCHED;
            PG8_LDB(B0, 1, 0); PG8_LDB(B1, 1, 1); PG8_SCHED; PG8_LDA(At, 1, 0); PG8_STAGE(PG8_SA(0, 1), a2 + hstep, voffA);
            PG8_WAIT_V(8); PG8_WAIT_L(0); PG8_BAR; PG8_MMA(0, 0, At, B0); PG8_MMA(0, 1, At, B1); PG8_BAR; PG8_SCHED;
            PG8_LDA(At, 1, 1); PG8_STAGE(PG8_SB(1, 0), b3, voffB); PG8_STAGE(PG8_SB(1, 1), b3 + hstep, voffB); PG8_STAGE(PG8_SA(1, 0), a3, voffA);
            PG8_WAIT_V(8); PG8_WAIT_L(0); PG8_BAR; PG8_MMA(1, 0, At, B0); PG8_MMA(1, 1, At, B1); PG8_BAR; PG8_SCHED;
            } else {
            PG8_LDB(B0, 0, 0); PG8_SCHED; PG8_LDA(At, 0, 0); PG8_STAGE(PG8_SA(1, 1), a1 + hstep, voffA);
            PG8_WAIT_L(8); PG8_BAR; PG8_WAIT_L(0); PG8_MMA(0, 0, At, B0); PG8_BAR; PG8_SCHED;
            PG8_LDB(B1, 0, 1); PG8_STAGE(PG8_SB(0, 0), b2, voffB);
            PG8_BAR; PG8_WAIT_L(0); PG8_MMA(0, 1, At, B1); PG8_BAR;
            PG8_LDA(At, 0, 1); PG8_STAGE(PG8_SA(0, 0), a2, voffA);
            PG8_BAR; PG8_WAIT_L(0); PG8_MMA(1, 0, At, B0); PG8_BAR; PG8_SCHED;
            PG8_STAGE(PG8_SB(0, 1), b2 + hstep, voffB);
            PG8_WAIT_V(6); PG8_BAR; PG8_MMA(1, 1, At, B1); PG8_BAR;
            PG8_LDB(B0, 1, 0); PG8_SCHED; PG8_LDA(At, 1, 0); PG8_STAGE(PG8_SA(0, 1), a2 + hstep, voffA);
            PG8_WAIT_L(8); PG8_BAR; PG8_WAIT_L(0); PG8_MMA(0, 0, At, B0); PG8_BAR; PG8_SCHED;
            PG8_LDB(B1, 1, 1); PG8_STAGE(PG8_SB(1, 0), b3, voffB);
            PG8_BAR; PG8_WAIT_L(0); PG8_MMA(0, 1, At, B1); PG8_BAR;
            PG8_LDA(At, 1, 1); PG8_STAGE(PG8_SA(1, 0), a3, voffA);
            PG8_BAR; PG8_WAIT_L(0); PG8_MMA(1, 0, At, B0); PG8_BAR; PG8_SCHED;
            PG8_STAGE(PG8_SB(1, 1), b3 + hstep, voffB);
            PG8_WAIT_V(6); PG8_BAR; PG8_MMA(1, 1, At, B1); PG8_BAR;
            }
        }
        if constexpr (ALIGN_EPI) { if (wr == 0) PG8_BAR; }
        if constexpr (!Epi::AFTER_DRAIN) { E(acc, cur, wr, wc, fr, fq); S.done(cur); }
        if (!has_next) break;
#pragma unroll
        for (int a = 0; a < 2; ++a)
#pragma unroll
            for (int b = 0; b < 2; ++b)
#pragma unroll
                for (int m = 0; m < 4; ++m)
#pragma unroll
                    for (int n = 0; n < 2; ++n) acc[a][b][m][n] = (f32x4){0.f, 0.f, 0.f, 0.f};
        cur = nxt; cA = nA; cB = nB; ++ui;
        if constexpr (ALIGN_EPI) { if (wr == 1) PG8_BAR; }
    }
    PG8_WAIT_V(0);
    if constexpr (!ALIGN_EPI) { if (wr == 0) PG8_BAR; }
    PG8_BAR;
    if constexpr (Epi::AFTER_DRAIN) { E.fused(acc, cur, wr, wc, fr, fq, lds, wid, lane); S.done(cur); }
#undef PG8_SA
#undef PG8_SB
#undef PG8_STAGE
#undef PG8_LDA
#undef PG8_LDB
#undef PG8_MMA
#undef PG8_WAIT_V
#undef PG8_WAIT_L
#undef PG8_BAR
#undef PG8_SCHED
}
typedef int v8i_t __attribute__((ext_vector_type(8)));
typedef int v4i_t __attribute__((ext_vector_type(4)));
template <class Epi, class Sched, bool ALIGN_EPI = false, bool SP2 = false>
__device__ __forceinline__ void gemm_phase_f8(PG8_LAS unsigned char* lds, const Gemm g, const Sched& S, const Epi& E, const int tid) {
    const int wid = __builtin_amdgcn_readfirstlane(tid >> 6), lane = tid & 63, wr = wid >> 2, wc = wid & 3, fr = lane & 15, fq = lane >> 4;
    const int K = g.K, nt = K / BK;
    unsigned voffA[2], voffB[2];
#pragma unroll
    for (int i = 0; i < 2; ++i) { int R, C; stage_rc(tid * 16 + i * 8192, R, C); const int Rb = Epi::PERM ? ((R & ~31) + perm32(R & 31)) : R;
        voffA[i] = (unsigned)(R * K + C) * 2u; voffB[i] = (unsigned)(Rb * K + C) * 2u; }
    const size_t kstep = (size_t)(BK * 2);
    const size_t hstep = (size_t)HALF * K * 2;
    const size_t tstep = 2 * hstep;
    const unsigned ldsw = (unsigned)wid * 1024u;
    const int aoff0 = lds_byte(wr * 64 + fr, fq * 16), aoff1 = lds_byte(wr * 64 + fr, fq * 16 + 8), boff0 = lds_byte(wc * 32 + fr, fq * 16), boff1 = lds_byte(wc * 32 + fr, fq * 16 + 8);
#define PG8_SA(b, h) (((b) * 2 + (h)) * HTB)
#define PG8_SB(b, h) ((4 + (b) * 2 + (h)) * HTB)
#define PG8_STAGE(bufoff, gbase, voff) do { _Pragma("unroll") for (int _i = 0; _i < 2; ++_i) \
        __builtin_amdgcn_global_load_lds((const unsigned*)((const char*)(gbase) + (voff)[_i]), (PG8_LAS unsigned*)(lds + (bufoff) + ldsw + _i * 8192), 16, 0, 0); } while (0)
#define PG8_LDA(dst, b, h) do { _Pragma("unroll") for (int m = 0; m < 4; ++m) { const u32x4 lo_ = *(const PG8_LAS u32x4*)(lds + PG8_SA(b, h) + aoff0 + m * 2048), hi_ = *(const PG8_LAS u32x4*)(lds + PG8_SA(b, h) + aoff1 + m * 2048); \
        dst[m] = __builtin_shufflevector((v4i_t)lo_, (v4i_t)hi_, 0, 1, 2, 3, 4, 5, 6, 7); } } while (0)
#define PG8_LDB(dst, b, h) do { _Pragma("unroll") for (int n = 0; n < 2; ++n) { const u32x4 lo_ = *(const PG8_LAS u32x4*)(lds + PG8_SB(b, h) + boff0 + n * 2048), hi_ = *(const PG8_LAS u32x4*)(lds + PG8_SB(b, h) + boff1 + n * 2048); \
        dst[n] = __builtin_shufflevector((v4i_t)lo_, (v4i_t)hi_, 0, 1, 2, 3, 4, 5, 6, 7); } } while (0)
#define PG8_MMA(ai, bj, At, Bt) do { __builtin_amdgcn_s_setprio(1); _Pragma("unroll") for (int m = 0; m < 4; ++m) _Pragma("unroll") for (int n = 0; n < 2; ++n) \
        asm volatile("v_mfma_scale_f32_16x16x128_f8f6f4 %0, %1, %2, %0, %3, %3 op_sel_hi:[0,0,0]" : "+v"(acc[ai][bj][m][n]) : "v"(Bt[n]), "v"(At[m]), "v"(one_scale)); __builtin_amdgcn_s_setprio(0); } while (0)
#define PG8_WAIT_V(n) asm volatile("s_waitcnt vmcnt(" #n ")" ::: "memory")
#define PG8_WAIT_L(n) asm volatile("s_waitcnt lgkmcnt(" #n ")" ::: "memory")
#define PG8_BAR __builtin_amdgcn_s_barrier()
#define PG8_SCHED __builtin_amdgcn_sched_barrier(0)
    Unit cur, nxt; int ui = 0;
    if (!S.next(0, cur)) return;
    f32x4 acc[2][2][4][2];
#pragma unroll
    for (int a = 0; a < 2; ++a)
#pragma unroll
        for (int b = 0; b < 2; ++b)
#pragma unroll
            for (int m = 0; m < 4; ++m)
#pragma unroll
                for (int n = 0; n < 2; ++n) acc[a][b][m][n] = (f32x4){0.f, 0.f, 0.f, 0.f};
    v8i_t At[4], B0[2], B1[2]; const int one_scale = 0x7f7f7f7f;
    const char* cA = (const char*)g.A + (size_t)cur.pm * tstep; const char* cB = (const char*)g.Bt + (size_t)cur.pn * tstep;
    S.a_ready(cur);
    if constexpr (SP2) {
        PG8_STAGE(PG8_SB(0, 0), cB, voffB); PG8_STAGE(PG8_SB(0, 1), cB + hstep, voffB); PG8_STAGE(PG8_SA(0, 0), cA, voffA); PG8_STAGE(PG8_SA(0, 1), cA + hstep, voffA);
        if (wr == 1) PG8_BAR;
        PG8_WAIT_V(2); PG8_BAR;
        PG8_STAGE(PG8_SB(1, 0), cB + kstep, voffB); PG8_STAGE(PG8_SA(1, 0), cA + kstep, voffA); PG8_STAGE(PG8_SB(1, 1), cB + hstep + kstep, voffB);
        PG8_WAIT_V(6); PG8_BAR;
    } else {
        PG8_STAGE(PG8_SB(0, 0), cB, voffB); PG8_STAGE(PG8_SA(0, 0), cA, voffA); PG8_STAGE(PG8_SB(0, 1), cB + hstep, voffB); PG8_STAGE(PG8_SA(0, 1), cA + hstep, voffA);
        if (wr == 1) PG8_BAR;
        PG8_WAIT_V(4); PG8_BAR;
        PG8_STAGE(PG8_SB(1, 0), cB + kstep, voffB); PG8_STAGE(PG8_SA(1, 0), cA + kstep, voffA); PG8_STAGE(PG8_SB(1, 1), cB + hstep + kstep, voffB);
        PG8_WAIT_V(6); PG8_BAR;
    }
    for (;;) {
        const bool has_next = S.next(ui + 1, nxt);
        const char* nA = has_next ? (const char*)g.A + (size_t)nxt.pm * tstep : cA; const char* nB = has_next ? (const char*)g.Bt + (size_t)nxt.pn * tstep : cB;
        for (int t = 0; t < nt; t += 2) {
            const bool last = (t == nt - 2);
            const char* a1 = cA + (size_t)(t + 1) * kstep;
            const char* a2 = last ? nA : cA + (size_t)(t + 2) * kstep; const char* b2 = last ? nB : cB + (size_t)(t + 2) * kstep;
            const char* a3 = a2 + kstep; const char* b3 = b2 + kstep;
            if (last && has_next) S.a_ready(nxt);
            if constexpr (SP2) {
            PG8_LDB(B0, 0, 0); PG8_LDB(B1, 0, 1); PG8_SCHED; PG8_LDA(At, 0, 0); PG8_STAGE(PG8_SA(1, 1), a1 + hstep, voffA);
            PG8_WAIT_V(8); PG8_WAIT_L(0); PG8_BAR; PG8_MMA(0, 0, At, B0); PG8_MMA(0, 1, At, B1); PG8_BAR; PG8_SCHED;
            PG8_LDA(At, 0, 1); PG8_STAGE(PG8_SB(0, 0), b2, voffB); PG8_STAGE(PG8_SB(0, 1), b2 + hstep, voffB); PG8_STAGE(PG8_SA(0, 0), a2, voffA);
            PG8_WAIT_V(8); PG8_WAIT_L(0); PG8_BAR; PG8_MMA(1, 0, At, B0); PG8_MMA(1, 1, At, B1); PG8_BAR; PG8_SCHED;
            PG8_LDB(B0, 1, 0); PG8_LDB(B1, 1, 1); PG8_SCHED; PG8_LDA(At, 1, 0); PG8_STAGE(PG8_SA(0, 1), a2 + hstep, voffA);
            PG8_WAIT_V(8); PG8_WAIT_L(0); PG8_BAR; PG8_MMA(0, 0, At, B0); PG8_MMA(0, 1, At, B1); PG8_BAR; PG8_SCHED;
            PG8_LDA(At, 1, 1); PG8_STAGE(PG8_SB(1, 0), b3, voffB); PG8_STAGE(PG8_SB(1, 1), b3 + hstep, voffB); PG8_STAGE(PG8_SA(1, 0), a3, voffA);
            PG8_WAIT_V(8); PG8_WAIT_L(0); PG8_BAR; PG8_MMA(1, 0, At, B0); PG8_MMA(1, 1, At, B1); PG8_BAR; PG8_SCHED;
            } else {
            PG8_LDB(B0, 0, 0); PG8_SCHED; PG8_LDA(At, 0, 0); PG8_STAGE(PG8_SA(1, 1), a1 + hstep, voffA);
            PG8_WAIT_L(8); PG8_BAR; PG8_WAIT_L(0); PG8_MMA(0, 0, At, B0); PG8_BAR; PG8_SCHED;
            PG8_LDB(B1, 0, 1); PG8_STAGE(PG8_SB(0, 0), b2, voffB);
            PG8_BAR; PG8_WAIT_L(0); PG8_MMA(0, 1, At, B1); PG8_BAR;
            PG8_LDA(At, 0, 1); PG8_STAGE(PG8_SA(0, 0), a2, voffA);
            PG8_BAR; PG8_WAIT_L(0); PG8_MMA(1, 0, At, B0); PG8_BAR; PG8_SCHED;
            PG8_STAGE(PG8_SB(0, 1), b2 + hstep, voffB);
            PG8_WAIT_V(6); PG8_BAR; PG8_MMA(1, 1, At, B1); PG8_BAR;
            PG8_LDB(B0, 1, 0); PG8_SCHED; PG8_LDA(At, 1, 0); PG8_STAGE(PG8_SA(0, 1), a2 + hstep, voffA);
            PG8_WAIT_L(8); PG8_BAR; PG8_WAIT_L(0); PG8_MMA(0, 0, At, B0); PG8_BAR; PG8_SCHED;
            PG8_LDB(B1, 1, 1); PG8_STAGE(PG8_SB(1, 0), b3, voffB);
            PG8_BAR; PG8_WAIT_L(0); PG8_MMA(0, 1, At, B1); PG8_BAR;
            PG8_LDA(At, 1, 1); PG8_STAGE(PG8_SA(1, 0), a3, voffA);
            PG8_BAR; PG8_WAIT_L(0); PG8_MMA(1, 0, At, B0); PG8_BAR; PG8_SCHED;
            PG8_STAGE(PG8_SB(1, 1), b3 + hstep, voffB);
            PG8_WAIT_V(6); PG8_BAR; PG8_MMA(1, 1, At, B1); PG8_BAR;
            }
        }
        if constexpr (ALIGN_EPI) { if (wr == 0) PG8_BAR; }
        asm volatile("s_nop 15\n\ts_nop 15" ::: "memory");
        if constexpr (!Epi::AFTER_DRAIN) { E(acc, cur, wr, wc, fr, fq); S.done(cur); }
        if (!has_next) break;
#pragma unroll
        for (int a = 0; a < 2; ++a)
#pragma unroll
            for (int b = 0; b < 2; ++b)
#pragma unroll
                for (int m = 0; m < 4; ++m)
#pragma unroll
                    for (int n = 0; n < 2; ++n) acc[a][b][m][n] = (f32x4){0.f, 0.f, 0.f, 0.f};
        cur = nxt; cA = nA; cB = nB; ++ui;
        if constexpr (ALIGN_EPI) { if (wr == 1) PG8_BAR; }
    }
    PG8_WAIT_V(0);
    if constexpr (!ALIGN_EPI) { if (wr == 0) PG8_BAR; }
    PG8_BAR;
    if constexpr (Epi::AFTER_DRAIN) { E.fused(acc, cur, wr, wc, fr, fq, lds, wid, lane); S.done(cur); }
#undef PG8_SA
#undef PG8_SB
#undef PG8_STAGE
#undef PG8_LDA
#undef PG8_LDB
#undef PG8_MMA
#undef PG8_WAIT_V
#undef PG8_WAIT_L
#undef PG8_BAR
#undef PG8_SCHED
}
}

#define XB_TMO      128
#define XB_XCNT(j)  (256  + 64 * (j))
#define XB_XSUB(j)  (1280 + 64 * (j))
#define XB_XGEN(j)  (2304 + 64 * (j))
#define XB_TOP      3328
#define XB_TOPGEN   3392
#define XCD_BAR_WORDS 3456
#define XB_SPIN_CAP (1u << 18)

__device__ __forceinline__ unsigned xb_ld(unsigned* p)              { return __hip_atomic_load(p, __ATOMIC_RELAXED, __HIP_MEMORY_SCOPE_AGENT); }
__device__ __forceinline__ unsigned xb_add(unsigned* p, unsigned v) { return __hip_atomic_fetch_add(p, v, __ATOMIC_RELAXED, __HIP_MEMORY_SCOPE_AGENT); }
__device__ __forceinline__ unsigned xb_xcc_id() { return (unsigned)__builtin_amdgcn_s_getreg((3 << 11) | 20) & 0xFu; }
#define XB_SPIN(cond, bar) do { unsigned _sp = 0; while (cond) { __builtin_amdgcn_s_sleep(1); \
    if ((++_sp & 255u) == 0u) { if (xb_ld(&(bar)[XB_TMO])) break; if (_sp > XB_SPIN_CAP) { atomicAdd(&(bar)[XB_TMO], 1u); break; } } } } while (0)

struct XcdBarrier {
    unsigned* bar; unsigned x;
    volatile LAS unsigned* st;
};

__device__ __forceinline__ XcdBarrier xcd_barrier_post(unsigned* bar, volatile LAS unsigned* st, const int xb_tid) {
    XcdBarrier b; b.bar = bar; b.x = xb_xcc_id(); b.st = st;
    if (xb_tid == 0) (void)xb_add(&bar[XB_XCNT(b.x)], 1u);
    return b;
}
__device__ __forceinline__ void xcd_barrier_complete(unsigned* bar, unsigned x, unsigned& nloc, unsigned& nx) {
    const unsigned G = gridDim.x * gridDim.y * gridDim.z;
    unsigned sum, cnt, mine, sp = 0u;
    for (;;) {
        sum = 0u; cnt = 0u; mine = 0u;
#pragma unroll
        for (unsigned j = 0; j < 16; ++j) { const unsigned c = xb_ld(&bar[XB_XCNT(j)]); sum += c; cnt += (c > 0u) ? 1u : 0u; mine = (j == x) ? c : mine; }
        if (sum == G) break;
        __builtin_amdgcn_s_sleep(1);
        if ((++sp & 255u) == 0u) { if (xb_ld(&bar[XB_TMO])) break; if (sp > XB_SPIN_CAP) { atomicAdd(&bar[XB_TMO], 1u); break; } }
    }
    nloc = mine > 0u ? mine : 1u; nx = cnt > 0u ? cnt : 1u;
}

__device__ __forceinline__ void xcd_barrier(const XcdBarrier& b, const int xb_tid) {
    asm volatile("s_waitcnt vmcnt(0)" ::: "memory");
    __syncthreads();
    if (xb_tid == 0) {
        unsigned* bar = b.bar;
        __builtin_amdgcn_s_waitcnt(0);
        unsigned nloc = b.st[0], nx = b.st[1];
        if (nloc == 0u) { xcd_barrier_complete(bar, b.x, nloc, nx); b.st[0] = nloc; b.st[1] = nx; }
        const unsigned old = xb_add(&bar[XB_XSUB(b.x)], 1u);
        const unsigned gen = old / nloc;
        if (old + 1u == (gen + 1u) * nloc) {
            __builtin_amdgcn_fence(__ATOMIC_RELEASE, "agent");
            asm volatile("s_waitcnt vmcnt(0)" ::: "memory");
            const unsigned og = xb_add(&bar[XB_TOP], 1u);
            const unsigned tg = og / nx;
            if (og + 1u == (tg + 1u) * nx) xb_add(&bar[XB_TOPGEN], 1u);
            else XB_SPIN(xb_ld(&bar[XB_TOPGEN]) == tg, bar);
            __builtin_amdgcn_fence(__ATOMIC_ACQUIRE, "agent");
            xb_add(&bar[XB_XGEN(b.x)], 1u);
            asm volatile("s_waitcnt vmcnt(0)" ::: "memory");
        } else {
            XB_SPIN(xb_ld(&bar[XB_XGEN(b.x)]) == gen, bar);
            __builtin_amdgcn_fence(__ATOMIC_ACQUIRE, "agent");
            asm volatile("s_waitcnt vmcnt(0)" ::: "memory");
        }
    }
    __syncthreads();
}

__device__ __forceinline__ void group_arrive(unsigned* cnt, const int xb_tid) {
    asm volatile("s_waitcnt vmcnt(0)" ::: "memory");
    __syncthreads();
    if (xb_tid == 0) {
        __builtin_amdgcn_s_waitcnt(0);
        __builtin_amdgcn_fence(__ATOMIC_RELEASE, "agent");
        asm volatile("s_waitcnt vmcnt(0)" ::: "memory");
        (void)xb_add(cnt, 1u);
    }
}
__device__ __forceinline__ void group_wait(unsigned* bar, unsigned* cnt, unsigned n, const int xb_tid) {
    __syncthreads();
    if (xb_tid == 0) {
        XB_SPIN(xb_ld(cnt) < n, bar);
        __builtin_amdgcn_fence(__ATOMIC_ACQUIRE, "agent");
        asm volatile("s_waitcnt vmcnt(0)" ::: "memory");
    }
    __syncthreads();
}

#define GAS __attribute__((address_space(1)))
typedef unsigned short bf16;
typedef unsigned v4u __attribute__((ext_vector_type(4)));
typedef unsigned v2u __attribute__((ext_vector_type(2)));
typedef float f32x4 __attribute__((ext_vector_type(4)));

constexpr int NB = 4, SEQ = 8192, DM = 1024, DEPTH = 4, CTXL = 256;
constexpr int NLAT = NB * SEQ, NCTX = NB * CTXL, MT = NLAT + NCTX;
constexpr int DIN = 3360, DINP = 3584, DFF = 2816, NEXP = 8;
constexpr int C_RQ = 0, C_RK = 256, C_RV = 512, C_RG = 768, C_S5 = 1024, C_HQ = 1280, C_HFF = 1536, C_HFB = 1792, C_HI = 2048, C_HG = 2304,
              C_GQ = 2560, C_GK = 2688, C_GV = 2816, C_GG = 3072, C_GAF = 3328, C_GAB = 3344,
              C_GZF = 3328, C_GZB = 3456;
constexpr int NSEG = 132;
constexpr int MOE_CAP_TILES = 272;
constexpr float NEPS = 1e-6f;
constexpr float WSC8 = 64.0f;

constexpr size_t MiB = 1u << 20;
constexpr size_t WS_CTL = 0, CTL_ZERO_BYTES = 2 * MiB;
constexpr size_t WS_MOD = 2 * MiB;
constexpr size_t WS_LB = 3 * MiB;
constexpr size_t WS_ROPE = 3 * MiB + 65536;
constexpr size_t WS_GLUW = 3 * MiB + 131072;
constexpr size_t WS_WIN = 4 * MiB;
constexpr size_t WS_WOUT = 32 * MiB;
constexpr size_t WS_W13D = 40 * MiB;
constexpr size_t WS_W2D = 62 * MiB;
constexpr size_t WS_W13M = 73 * MiB;
constexpr size_t WS_W2M = 161 * MiB;
constexpr size_t WS_HB = 205 * MiB;
constexpr size_t WS_ACT = 209 * MiB;
constexpr size_t WS_Z = 275 * MiB;
constexpr size_t WS_PH = 292 * MiB;
constexpr size_t WS_OF = (292 + 232) * MiB;
constexpr size_t WS_X2 = 666 * MiB;
constexpr size_t WS_LIST = 843 * MiB;
constexpr size_t WS_S5PAR = 70 * MiB;
constexpr size_t WS_END = 846 * MiB;
constexpr size_t ST_DS0 = 0;
constexpr size_t ST_DS1 = ST_DS0 + (size_t)2 * 16 * NSEG * 4096;
constexpr size_t ST_DS2 = ST_DS1 + (size_t)2 * 16 * NSEG * 4096;
constexpr size_t ST_G0 = ST_DS2 + (size_t)2 * 16 * NSEG * 2048;
constexpr size_t ST_G1 = ST_G0 + (size_t)2 * 16 * NSEG * 64;
constexpr size_t ST_G2 = ST_G1 + (size_t)2 * 16 * NSEG * 64;
constexpr size_t ST_HS = ST_G2 + (size_t)2 * 16 * NSEG * 64;
constexpr size_t ST_END = ST_HS + (size_t)2 * 64 * NSEG * 128;
static_assert(ST_END * 4 <= (WS_LIST - WS_X2), "state region");
static_assert(WS_PH + (size_t)MT * DINP * 2 <= WS_OF && WS_OF + (size_t)MT * 768 * 4 <= WS_X2, "OF region");
static_assert((size_t)MOE_CAP_TILES * 256 * 1024 * 2 <= (WS_LIST - WS_X2), "XB region");
static_assert((size_t)MOE_CAP_TILES * 256 * DFF * 2 <= (WS_X2 - WS_PH) && (size_t)MT * DINP * 2 <= (WS_X2 - WS_PH), "P/H region");
constexpr int CW_BAR = 4096;
constexpr int CW_TAIL = 32768;
constexpr int CW_CNT = 16384;

constexpr int LDS_BYTES = 163840;
constexpr int MISC_OFF = 163840 - 512;

__device__ __forceinline__ float bf2f(unsigned short h) { return __uint_as_float(((unsigned)h) << 16); }
__device__ __forceinline__ unsigned f2bf(float f) { unsigned u = __float_as_uint(f); return (u + 0x7fffu + ((u >> 16) & 1u)) >> 16; }
__device__ __forceinline__ unsigned pk2(float lo, float hi) { return f2bf(lo) | (f2bf(hi) << 16); }
__device__ __forceinline__ float wave_sum(float v) {
#define WS_DPP(ctrl, rmask) v += __int_as_float(__builtin_amdgcn_update_dpp(0, __float_as_int(v), (ctrl), (rmask), 0xf, false))
    WS_DPP(0x111, 0xf); WS_DPP(0x112, 0xf); WS_DPP(0x114, 0xf); WS_DPP(0x118, 0xf); WS_DPP(0x142, 0xa); WS_DPP(0x143, 0xc);
#undef WS_DPP
    return __int_as_float(__builtin_amdgcn_readlane(__float_as_int(v), 63));
}
__device__ __forceinline__ float rdl(float v, int k) { return __uint_as_float((unsigned)__builtin_amdgcn_readlane((int)__float_as_uint(v), k)); }
__device__ __forceinline__ float sigm(float x) { return __builtin_amdgcn_rcpf(1.0f + __expf(-x)); }
__device__ __forceinline__ float silu_f(float x) { return x * __builtin_amdgcn_rcpf(1.0f + __expf(-x)); }
#define LDS_WAIT() asm volatile("s_waitcnt lgkmcnt(0)" ::: "memory")

struct Args {
    const float* in[37];
    int l_lo, l_hi, ph_lo, ph_hi, do_pro, do_fin, fused, pad;
};
constexpr int I_OUT = 35, I_WS = 36;
enum { I_X = 0, I_C, I_CTX, I_CCTX, I_ADAW, I_ADAB, I_N1W, I_N2W, I_WIN, I_WOUT, I_RETGN, I_LAMRE, I_LAMIM, I_LOGDT, I_BRE, I_BIM, I_CRE, I_CIM, I_S5D,
       I_GLUW, I_GLUB, I_LBL, I_HGNW, I_WA2, I_BA, I_GLANW, I_FW1, I_FW3, I_FW2, I_RW, I_RB, I_MW1, I_MW3, I_MW2, I_FINW };

struct Frame {
    LAS unsigned char* lds;
    int tid, lane, wave, gw, NGW, G, zz;
    unsigned char* ws; float* out;
};

struct EpiStoreBf16 {
    static constexpr bool PERM = true, AFTER_DRAIN = false;
    bf16* O; int ldc; float sc;
    __device__ __forceinline__ void operator()(const pg8::f32x4 (&acc)[2][2][4][2], const pg8::Unit& u, int wr, int wc, int fr, int fq) const {
        const int row0 = u.pm * 256 + wr * 64 + fr, col0 = u.pc * 256 + wc * 32 + 8 * fq;
#pragma unroll
        for (int ai = 0; ai < 2; ++ai)
#pragma unroll
            for (int m = 0; m < 4; ++m) { bf16* rowp = O + (size_t)(row0 + ai * 128 + m * 16) * ldc + col0;
#pragma unroll
                for (int bj = 0; bj < 2; ++bj) { const pg8::f32x4 v0 = acc[ai][bj][m][0] * sc, v1 = acc[ai][bj][m][1] * sc;
                    pg8::u32x4 w; w.x = pg8::cvt_pk_bf16(v0[0], v0[1]); w.y = pg8::cvt_pk_bf16(v0[2], v0[3]); w.z = pg8::cvt_pk_bf16(v1[0], v1[1]); w.w = pg8::cvt_pk_bf16(v1[2], v1[3]);
                    *(pg8::u32x4*)(rowp + bj * 128) = w; } }
    }
};
constexpr int P4G = 4 * DINP, P4S5 = 4096;
struct EpiStoreP4 {
    static constexpr bool PERM = true, FLIP = true, AFTER_DRAIN = false;
    bf16* O;
    __device__ __forceinline__ void operator()(const pg8::f32x4 (&acc)[2][2][4][2], const pg8::Unit& u, int wr, int wc, int fr, int fq) const {
        const int grp0 = u.pm * 64 + wr * 16 + fq;
        if (!(u.pc == 3 || u.pc == 4 || u.pc == 9 || u.pc == 12)) {
            bf16* base = O + (size_t)grp0 * P4G + (size_t)(u.pc * 256 + wc * 32 + 2 * fr) * 4;
#pragma unroll
            for (int ai = 0; ai < 2; ++ai)
#pragma unroll
                for (int m = 0; m < 4; ++m) { bf16* gp = base + (size_t)(ai * 32 + m * 4) * P4G;
#pragma unroll
                    for (int bj = 0; bj < 2; ++bj) { const pg8::f32x4 v0 = acc[ai][bj][m][0], v1 = acc[ai][bj][m][1];
                        pg8::u32x4 w; w.x = pg8::cvt_pk_bf16(v0[0], v0[1]); w.y = pg8::cvt_pk_bf16(v0[2], v0[3]); w.z = pg8::cvt_pk_bf16(v1[0], v1[1]); w.w = pg8::cvt_pk_bf16(v1[2], v1[3]);
                        *(pg8::u32x4*)(gp + bj * 512) = w; } }
        } else {
            bf16* base = O + (size_t)grp0 * P4G + u.pc * 1024 + wc * 32 + 2 * fr;
#pragma unroll
            for (int ai = 0; ai < 2; ++ai)
#pragma unroll
                for (int m = 0; m < 4; ++m) { bf16* gp = base + (size_t)(ai * 32 + m * 4) * P4G;
#pragma unroll
                    for (int bj = 0; bj < 2; ++bj)
#pragma unroll
                        for (int r = 0; r < 4; ++r) *(unsigned*)(gp + r * 256 + bj * 128) = pg8::cvt_pk_bf16(acc[ai][bj][m][0][r], acc[ai][bj][m][1][r]); }
        }
    }
};
struct EpiSwiglu {
    static constexpr bool PERM = true, AFTER_DRAIN = false;
    bf16* H;
    __device__ __forceinline__ void operator()(const pg8::f32x4 (&acc)[2][2][4][2], const pg8::Unit& u, int wr, int wc, int fr, int fq) const {
        const int row0 = u.pm * 256 + wr * 64 + fr, col0 = u.pc * 128 + wc * 32 + 8 * fq;
#pragma unroll
        for (int ai = 0; ai < 2; ++ai)
#pragma unroll
            for (int m = 0; m < 4; ++m) { bf16* rowp = H + (size_t)(row0 + ai * 128 + m * 16) * DFF + col0;
                float h[8];
#pragma unroll
                for (int n = 0; n < 2; ++n)
#pragma unroll
                    for (int j = 0; j < 4; ++j) { const float a = acc[ai][0][m][n][j], b = acc[ai][1][m][n][j];
                        h[n * 4 + j] = a * __builtin_amdgcn_rcpf(1.0f + __builtin_amdgcn_exp2f(-1.4426950408889634f * a)) * b; }
                pg8::u32x4 w; w.x = pg8::cvt_pk_bf16(h[0], h[1]); w.y = pg8::cvt_pk_bf16(h[2], h[3]); w.z = pg8::cvt_pk_bf16(h[4], h[5]); w.w = pg8::cvt_pk_bf16(h[6], h[7]);
                *(pg8::u32x4*)rowp = w; }
    }
};
struct EpiSwiglu8 {
    static constexpr bool PERM = true, AFTER_DRAIN = false;
    unsigned char* H; float sc;
    __device__ __forceinline__ void operator()(const pg8::f32x4 (&acc)[2][2][4][2], const pg8::Unit& u, int wr, int wc, int fr, int fq) const {
        const int row0 = u.pm * 256 + wr * 64 + fr, col0 = u.pc * 128 + wc * 32 + 8 * fq;
#pragma unroll
        for (int ai = 0; ai < 2; ++ai)
#pragma unroll
            for (int m = 0; m < 4; ++m) { unsigned char* rowp = H + (size_t)(row0 + ai * 128 + m * 16) * DFF + col0;
                float h[8];
#pragma unroll
                for (int n = 0; n < 2; ++n)
#pragma unroll
                    for (int j = 0; j < 4; ++j) { const float a = acc[ai][0][m][n][j] * sc, b = acc[ai][1][m][n][j] * sc;
                        const float hv = a * __builtin_amdgcn_rcpf(1.0f + __builtin_amdgcn_exp2f(-1.4426950408889634f * a)) * b;
                        h[n * 4 + j] = fminf(fmaxf(hv, -448.0f), 448.0f); }
                unsigned w0 = 0u, w1 = 0u;
                w0 = __builtin_amdgcn_cvt_pk_fp8_f32(h[0], h[1], w0, false); w0 = __builtin_amdgcn_cvt_pk_fp8_f32(h[2], h[3], w0, true);
                w1 = __builtin_amdgcn_cvt_pk_fp8_f32(h[4], h[5], w1, false); w1 = __builtin_amdgcn_cvt_pk_fp8_f32(h[6], h[7], w1, true);
                v2u w; w.x = w0; w.y = w1; *(v2u*)rowp = w; }
    }
};
struct EpiResid {
    static constexpr bool PERM = false, AFTER_DRAIN = false;
    const float* xin_lat; const float* xin_ctx; float* xout_lat; float* xout_ctx; const float* gate; float sc; int pm_off;
    __device__ __forceinline__ void operator()(const pg8::f32x4 (&acc)[2][2][4][2], const pg8::Unit& u, int wr, int wc, int fr, int fq) const {
        const int pmg = u.pm + pm_off; const bool isctx = pmg >= 128; const int bidx = isctx ? 4 : (pmg >> 5);
        const size_t rbase = (size_t)(isctx ? (pmg - 128) : pmg) * 256 + wr * 64 + fr;
        const float* xi = (isctx ? xin_ctx : xin_lat); float* xo = (isctx ? xout_ctx : xout_lat);
        const int col0 = u.pc * 256 + wc * 32 + 4 * fq; const float* g = gate + (size_t)bidx * 6144 + col0;
        pg8::f32x4 gv[2][2];
#pragma unroll
        for (int bj = 0; bj < 2; ++bj)
#pragma unroll
            for (int n = 0; n < 2; ++n) gv[bj][n] = *(const pg8::f32x4*)(g + bj * 128 + n * 16) * sc;
#pragma unroll
        for (int ai = 0; ai < 2; ++ai)
#pragma unroll
            for (int m = 0; m < 4; ++m) { const size_t off = (rbase + ai * 128 + m * 16) * 1024 + col0;
#pragma unroll
                for (int bj = 0; bj < 2; ++bj)
#pragma unroll
                    for (int n = 0; n < 2; ++n) { const pg8::f32x4 xv = *(const pg8::f32x4*)(xi + off + bj * 128 + n * 16);
                        *(pg8::f32x4*)(xo + off + bj * 128 + n * 16) = xv + gv[bj][n] * acc[ai][bj][m][n]; }
                asm volatile("" ::: "memory"); }
    }
};
struct EpiGlu {
    static constexpr bool PERM = true, AFTER_DRAIN = false;
    const bf16* Z; bf16* Y; const float* bias;
    __device__ __forceinline__ void operator()(const pg8::f32x4 (&acc)[2][2][4][2], const pg8::Unit& u, int wr, int wc, int fr, int fq) const {
        const int row0 = u.pm * 256 + wr * 64 + fr, col0 = wc * 32 + 8 * fq;
#pragma unroll
        for (int ai = 0; ai < 2; ++ai)
#pragma unroll
            for (int m = 0; m < 4; ++m) { const size_t row = (size_t)(row0 + ai * 128 + m * 16);
#pragma unroll
                for (int bj = 0; bj < 2; ++bj) { const int col = col0 + bj * 128;
                    const pg8::u32x4 zz = *(const pg8::u32x4*)(Z + row * 256 + col);
                    const pg8::f32x4 b0 = *(const pg8::f32x4*)(bias + col), b1 = *(const pg8::f32x4*)(bias + col + 4);
                    const pg8::f32x4 v0 = acc[ai][bj][m][0] + b0, v1 = acc[ai][bj][m][1] + b1;
                    float o[8]; const unsigned zw[4] = {zz.x, zz.y, zz.z, zz.w};
#pragma unroll
                    for (int j = 0; j < 4; ++j) { const float zl = __uint_as_float(zw[j] << 16), zh = __uint_as_float(zw[j] & 0xffff0000u);
                        const float a0 = (j < 2) ? v0[2 * j] : v1[2 * j - 4], a1 = (j < 2) ? v0[2 * j + 1] : v1[2 * j - 3];
                        o[2 * j] = zl * sigm(a0); o[2 * j + 1] = zh * sigm(a1); }
                    pg8::u32x4 w; w.x = pg8::cvt_pk_bf16(o[0], o[1]); w.y = pg8::cvt_pk_bf16(o[2], o[3]); w.z = pg8::cvt_pk_bf16(o[4], o[5]); w.w = pg8::cvt_pk_bf16(o[6], o[7]);
                    *(pg8::u32x4*)(Y + row * 1024 + 256 + col) = w; }
                asm volatile("" ::: "memory"); }
    }
};
struct MoeOrder {
    int tp[9]; int nN, G, c, total;
    __device__ __forceinline__ void init(const unsigned* cnt, int nN_, int G_, int c_) {
        tp[0] = 0;
#pragma unroll
        for (int e = 0; e < 8; ++e) tp[e + 1] = tp[e] + (int)(((unsigned)__builtin_amdgcn_readfirstlane((int)__hip_atomic_load(cnt + e * 64, __ATOMIC_RELAXED, __HIP_MEMORY_SCOPE_AGENT)) + 255u) >> 8);
        nN = nN_; G = G_; c = c_; total = tp[8] * nN;
    }
    __device__ __forceinline__ bool next(int i, pg8::Unit& u) const {
        const int L = i * G + c; if (L >= total) return false;
        const int t = L / nN, pn = L - t * nN; int e = 0;
#pragma unroll
        for (int k = 1; k < 8; ++k) e += (t >= tp[k]) ? 1 : 0;
        u.pm = t; u.pn = e * nN + pn; u.pc = pn; return true;
    }
    __device__ __forceinline__ void a_ready(const pg8::Unit&) const {}
    __device__ __forceinline__ void done(const pg8::Unit&) const {}
};

__device__ __forceinline__ void cvt_item(const float* W, int K, int N, bf16* WT, int mode, int add, LAS float* scr, int item, int lane, int nblk_override = 0, const float* ks = nullptr  ) {
    const int nblk = nblk_override ? nblk_override : (N >> 5), kb = item / nblk, nb = item - kb * nblk, k0 = 64 * kb, n0 = 32 * nb;
    const int r = lane >> 3, c4 = lane & 7;
    f32x4 v[8];
#pragma unroll
    for (int i = 0; i < 8; ++i) v[i] = *(const f32x4*)(W + (size_t)(k0 + 8 * i + r) * N + n0 + 4 * c4);
    if (ks) {
#pragma unroll
        for (int i = 0; i < 8; ++i) v[i] *= ks[8 * i + r]; }
#pragma unroll
    for (int i = 0; i < 8; ++i) {
#pragma unroll
        for (int j = 0; j < 4; ++j) scr[(8 * i + r) * 33 + 4 * c4 + j] = v[i][j]; }
    LDS_WAIT();
    const int c = lane & 7;
#pragma unroll
    for (int j = 0; j < 4; ++j) { const int n = (lane >> 3) + 8 * j; const LAS float* s = scr + (8 * c) * 33 + n;
        v4u o; o.x = pk2(s[0 * 33], s[1 * 33]); o.y = pk2(s[2 * 33], s[3 * 33]); o.z = pk2(s[4 * 33], s[5 * 33]); o.w = pk2(s[6 * 33], s[7 * 33]);
        const int nn = n0 + n; const int drow = (mode == 0) ? (nn + add) : (((nn >> 7) << 8) + (nn & 127) + add);
        *(v4u*)(WT + (size_t)drow * K + k0 + 8 * c) = o; }
    LDS_WAIT();
}
__device__ __forceinline__ void cvt_item_f8(const float* W, int K, int N, unsigned char* WT, int mode, int add, LAS float* scr, int item, int lane) {
    const int nblk = N >> 5, kb = item / nblk, nb = item - kb * nblk, k0 = 64 * kb, n0 = 32 * nb;
    const int r = lane >> 3, c4 = lane & 7;
    f32x4 v[8];
#pragma unroll
    for (int i = 0; i < 8; ++i) v[i] = *(const f32x4*)(W + (size_t)(k0 + 8 * i + r) * N + n0 + 4 * c4);
#pragma unroll
    for (int i = 0; i < 8; ++i) {
#pragma unroll
        for (int j = 0; j < 4; ++j) scr[(8 * i + r) * 33 + 4 * c4 + j] = v[i][j]; }
    LDS_WAIT();
    const int c = lane & 3;
#pragma unroll
    for (int j = 0; j < 2; ++j) { const int n = (lane >> 2) + 16 * j; const LAS float* s = scr + (16 * c) * 33 + n;
        unsigned w[4];
#pragma unroll
        for (int q = 0; q < 4; ++q) { unsigned x = 0u;
            x = __builtin_amdgcn_cvt_pk_fp8_f32(s[(4 * q) * 33] * WSC8, s[(4 * q + 1) * 33] * WSC8, x, false);
            x = __builtin_amdgcn_cvt_pk_fp8_f32(s[(4 * q + 2) * 33] * WSC8, s[(4 * q + 3) * 33] * WSC8, x, true); w[q] = x; }
        v4u o; o.x = w[0]; o.y = w[1]; o.z = w[2]; o.w = w[3];
        const int nn = n0 + n; const int drow = (mode == 0) ? (nn + add) : (((nn >> 7) << 8) + (nn & 127) + add);
        *(v4u*)(WT + (size_t)drow * K + k0 + 16 * c) = o; }
    LDS_WAIT();
}
__device__ __forceinline__ void moe_cvt_idle(const Frame& F, const Args& a, int j, int b_lo) {
    LAS float* scr = (LAS float*)(F.lds + F.wave * 16384);
    constexpr int IT = 1408;
    const int nw = (F.G - b_lo) * 8, w = ((int)blockIdx.x - b_lo) * 8 + F.wave;
    for (int it = w; it < 8 * 3 * IT; it += nw) {
        const int e = it / (3 * IT), r = it - e * 3 * IT, which = r / IT, item = r - which * IT;
        const size_t eo = ((size_t)j * 8 + e) * (size_t)(1024 * DFF);
        if (which == 0) cvt_item_f8(a.in[F.zz + I_MW1] + eo, 1024, DFF, F.ws + WS_W13M + (size_t)e * 5632 * 1024, 1, 0, scr, item, F.lane);
        else if (which == 1) cvt_item_f8(a.in[F.zz + I_MW3] + eo, 1024, DFF, F.ws + WS_W13M + (size_t)e * 5632 * 1024, 1, 128, scr, item, F.lane);
        else cvt_item_f8(a.in[F.zz + I_MW2] + eo, DFF, 1024, F.ws + WS_W2M + (size_t)e * 1024 * DFF, 0, 0, scr, item, F.lane);
    }
}
__device__ __forceinline__ void moe_cvt(const Frame& F, const Args& a, int j) {
    LAS float* scr = (LAS float*)(F.lds + F.wave * 16384);
    constexpr int IT = 1408;
    for (int it = F.gw; it < 8 * 3 * IT; it += F.NGW) {
        const int e = it / (3 * IT), r = it - e * 3 * IT, which = r / IT, item = r - which * IT;
        const size_t eo = ((size_t)j * 8 + e) * (size_t)(1024 * DFF);
        if (which == 0) cvt_item_f8(a.in[F.zz + I_MW1] + eo, 1024, DFF, F.ws + WS_W13M + (size_t)e * 5632 * 1024, 1, 0, scr, item, F.lane);
        else if (which == 1) cvt_item_f8(a.in[F.zz + I_MW3] + eo, 1024, DFF, F.ws + WS_W13M + (size_t)e * 5632 * 1024, 1, 128, scr, item, F.lane);
        else cvt_item_f8(a.in[F.zz + I_MW2] + eo, DFF, 1024, F.ws + WS_W2M + (size_t)e * 1024 * DFF, 0, 0, scr, item, F.lane);
    }
}
__device__ __forceinline__ void prologue(const Frame& F, const Args& a) {
    {
        LAS float* sc = (LAS float*)F.lds; LAS float* red = sc + 5120;
        for (int idx = F.tid; idx < 5120; idx += 512) { const int r = idx >> 10, k = idx & 1023; const float cv = (r < 4) ? a.in[F.zz + I_C][r * 1024 + k] : a.in[F.zz + I_CCTX][k]; sc[idx] = silu_f(cv); }
        __syncthreads();
        float* MOD = (float*)(F.ws + WS_MOD);
        for (int item = blockIdx.x; item < 384; item += F.G) {
            const int l = item / 96, nb = item - l * 96, cl = F.tid & 63, ks = F.tid >> 6, n = nb * 64 + cl;
            float acc[5] = {0.f, 0.f, 0.f, 0.f, 0.f};
            const float* wp = a.in[F.zz + I_ADAW] + ((size_t)l * 1024 + ks * 128) * 6144 + n;
#pragma unroll 16
            for (int kk = 0; kk < 128; ++kk) { const float w = wp[(size_t)kk * 6144];
#pragma unroll
                for (int r = 0; r < 5; ++r) acc[r] = fmaf(sc[r * 1024 + ks * 128 + kk], w, acc[r]); }
#pragma unroll
            for (int r = 0; r < 5; ++r) red[(ks * 5 + r) * 64 + cl] = acc[r];
            __syncthreads();
            if (F.tid < 320) { const int r = F.tid >> 6; float s = 0.f;
#pragma unroll
                for (int k2 = 0; k2 < 8; ++k2) s += red[(k2 * 5 + r) * 64 + cl];
                MOD[((size_t)l * 5 + r) * 6144 + n] = s + a.in[F.zz + I_ADAB][l * 6144 + n]; }
            __syncthreads();
        }
        if (blockIdx.x == 0 && F.tid < 256) {
            const float* lg = a.in[F.zz + I_LBL]; float x[4], mx = -3.0e38f;
#pragma unroll
            for (int l = 0; l < 4; ++l) { x[l] = lg[l * 256 + F.tid]; mx = fmaxf(mx, x[l]); }
            float s = 0.f;
#pragma unroll
            for (int l = 0; l < 4; ++l) { x[l] = expf(x[l] - mx); s += x[l]; }
            float cs = 0.f; const float sm0 = x[0] / s; float* LB = (float*)(F.ws + WS_LB);
#pragma unroll
            for (int l = 0; l < 4; ++l) { cs += x[l] / s; LB[l * 256 + F.tid] = fminf(fmaxf(cs - sm0, 0.f), 1.0f - 1e-6f); }
        }
        if (blockIdx.x == (1 % F.G)) {
            float* RC = (float*)(F.ws + WS_ROPE); float* RS = RC + 2048;
            for (int idx = F.tid; idx < 2048; idx += 512) { const int pos = idx >> 4, i = idx & 15;
                const float fr = powf(10000.0f, -(float)i / 16.0f); const float ang = (float)pos * fr; RC[idx] = cosf(ang); RS[idx] = sinf(ang); }
        }
        __syncthreads();
    }
    LAS float* scr = (LAS float*)(F.lds + F.wave * 16384);
    constexpr int I_IN = 16 * 104, I_OUT = 16 * 32, I_F = 1408, I_GL = 4 * 8;
    constexpr int NIT = 4 * I_IN + 4 * I_OUT + 6 * I_F + 4 * I_GL;
    for (int it = F.gw; it < NIT; it += F.NGW) {
        int r = it;
        if (r < 4 * I_IN) { const int l = r / I_IN; cvt_item(a.in[F.zz + I_WIN] + (size_t)l * 1024 * DIN, 1024, DIN, (bf16*)(F.ws + WS_WIN) + (size_t)l * DINP * 1024, 0, 0, scr, r - l * I_IN, F.lane, 104); continue; } r -= 4 * I_IN;
        if (r < 4 * I_OUT) { const int l = r / I_OUT, it = r - l * I_OUT, k0 = 64 * (it >> 5);
            const float* ks = k0 < 256 ? a.in[F.zz + I_RETGN] + l * 256 + k0 : (k0 < 512 ? nullptr : (k0 < 768 ? a.in[F.zz + I_HGNW] + l * 256 + (k0 - 512) : a.in[F.zz + I_GLANW] + l * 256 + (k0 - 768)));
            cvt_item(a.in[F.zz + I_WOUT] + (size_t)l * 1024 * 1024, 1024, 1024, (bf16*)(F.ws + WS_WOUT) + (size_t)l * 1024 * 1024, 0, 0, scr, it, F.lane, 0, ks); continue; } r -= 4 * I_OUT;
        if (r < 6 * I_F) { const int j = r / (3 * I_F), r2 = r - j * 3 * I_F, which = r2 / I_F, item = r2 - which * I_F; const size_t wo = (size_t)j * 1024 * DFF;
            if (which == 0) cvt_item(a.in[F.zz + I_FW1] + wo, 1024, DFF, (bf16*)(F.ws + WS_W13D) + (size_t)j * 5632 * 1024, 1, 0, scr, item, F.lane);
            else if (which == 1) cvt_item(a.in[F.zz + I_FW3] + wo, 1024, DFF, (bf16*)(F.ws + WS_W13D) + (size_t)j * 5632 * 1024, 1, 128, scr, item, F.lane);
            else cvt_item_f8(a.in[F.zz + I_FW2] + wo, DFF, 1024, F.ws + WS_W2D + (size_t)j * 1024 * DFF, 0, 0, scr, item, F.lane);
            continue; } r -= 6 * I_F;
        { const int l = r / I_GL; cvt_item(a.in[F.zz + I_GLUW] + (size_t)l * 65536, 256, 256, (bf16*)(F.ws + WS_GLUW) + (size_t)l * 65536, 0, 0, scr, r - l * I_GL, F.lane); }
    }
    for (int i = blockIdx.x * 512 + F.tid; i < 4 * 256 * 128; i += F.G * 512) {
        const int l = i >> 15, rem = i & 32767, n = rem >> 7, k0 = (rem & 127) * 8, d = n >> 7, cidx = n & 127;
        const float* wa = a.in[F.zz + I_WA2] + ((size_t)(l * 2 + d) * 16) * 128 + cidx;
        float acc[8] = {0.f, 0.f, 0.f, 0.f, 0.f, 0.f, 0.f, 0.f};
#pragma unroll
        for (int r = 0; r < 16; ++r) { const float w2 = wa[r * 128];
#pragma unroll
            for (int kk = 0; kk < 8; ++kk) acc[kk] = fmaf(a.in[F.zz + I_WIN][((size_t)l * 1024 + k0 + kk) * DIN + 3328 + 16 * d + r], w2, acc[kk]); }
        v4u o; o.x = pk2(acc[0], acc[1]); o.y = pk2(acc[2], acc[3]); o.z = pk2(acc[4], acc[5]); o.w = pk2(acc[6], acc[7]);
        *(v4u*)((bf16*)(F.ws + WS_WIN) + ((size_t)l * DINP + 3328 + n) * 1024 + k0) = o;
    }
}

struct MoeTp { int tp[9]; };
__device__ __forceinline__ void load_tp(MoeTp& t, const unsigned* cnt) {
    t.tp[0] = 0;
#pragma unroll
    for (int e = 0; e < 8; ++e) t.tp[e + 1] = t.tp[e] + (int)(((unsigned)__builtin_amdgcn_readfirstlane((int)__hip_atomic_load(cnt + e * 64, __ATOMIC_RELAXED, __HIP_MEMORY_SCOPE_AGENT)) + 255u) >> 8);
}
template <int MODE>
__device__ __forceinline__ void norm_phase(const Frame& F, const Args& a, int l, int which  , int nrows, int comb_l  ,
                                           int row_lo = 0, int w0 = -1  , int nwav = 0) {
    const int wv_ = (w0 < 0) ? F.gw : w0, nwv_ = (w0 < 0) ? F.NGW : nwav;
    const float* MOD = (const float*)(F.ws + WS_MOD);
    const float* nw = (MODE == 2) ? a.in[F.zz + I_FINW] : ((which ? a.in[F.zz + I_N2W] : a.in[F.zz + I_N1W]) + l * 1024);
    bf16* XN = (bf16*)(F.ws + WS_ACT);
    float* hb = (float*)(F.ws + WS_HB);
    const int* EP = (const int*)(F.ws + WS_LIST) + 8 * MT; const float* GATE = (const float*)(F.ws + WS_LIST) + 10 * MT;
    const bf16* YM = (const bf16*)(F.ws + WS_X2);
    const bool from_input = (l == 0 && which == 0 && MODE != 2);
    MoeTp ctp; if (comb_l >= 0) load_tp(ctp, (const unsigned*)F.ws + CW_CNT + (comb_l >> 1) * 8 * 64);
    const int jm = l >> 1;
    LAS float* rwl = (LAS float*)F.lds;
    if (MODE == 1) {
        const float* rw = a.in[F.zz + I_RW] + (size_t)jm * 8192;
        for (int idx = F.tid; idx < 8192; idx += 512) { const int k = idx >> 3, e = idx & 7; rwl[e * 1024 + k] = rw[idx]; }
        __syncthreads();
    }
    f32x4 wv[4];
#pragma unroll
    for (int j = 0; j < 4; ++j) wv[j] = *((const f32x4*)nw + F.lane + 64 * j);
    f32x4 vn[4]; int epn0 = 0, epn1 = 0; float gn0 = 0.f, gn1 = 0.f;
    { const int m = (row_lo + wv_ < nrows) ? row_lo + wv_ : row_lo; const bool isctx = m >= NLAT;
      const float* xr = from_input ? (isctx ? a.in[F.zz + I_CTX] + (size_t)(m - NLAT) * 1024 : a.in[F.zz + I_X] + (size_t)m * 1024) : (isctx ? hb + (size_t)(m - NLAT) * 1024 : F.out + (size_t)m * 1024);
#pragma unroll
      for (int j = 0; j < 4; ++j) vn[j] = *((const f32x4*)xr + F.lane + 64 * j);
      if (comb_l >= 0) { epn0 = EP[2 * m]; epn1 = EP[2 * m + 1]; gn0 = GATE[2 * m]; gn1 = GATE[2 * m + 1]; } }
    for (int m = row_lo + wv_; m < nrows; m += nwv_) {
        const bool isctx = m >= NLAT; const int bidx = isctx ? 4 : (m >> 13);
        f32x4 v[4];
#pragma unroll
        for (int j = 0; j < 4; ++j) v[j] = vn[j];
        const int ep0 = epn0, ep1 = epn1; const float g0 = gn0, g1 = gn1;
        { const int mn = (m + nwv_ < nrows) ? m + nwv_ : m; const bool cn = mn >= NLAT;
          const float* xr = from_input ? (cn ? a.in[F.zz + I_CTX] + (size_t)(mn - NLAT) * 1024 : a.in[F.zz + I_X] + (size_t)mn * 1024) : (cn ? hb + (size_t)(mn - NLAT) * 1024 : F.out + (size_t)mn * 1024);
#pragma unroll
          for (int j = 0; j < 4; ++j) vn[j] = *((const f32x4*)xr + F.lane + 64 * j);
          if (comb_l >= 0) { epn0 = EP[2 * mn]; epn1 = EP[2 * mn + 1]; gn0 = GATE[2 * mn]; gn1 = GATE[2 * mn + 1]; } }
        if (comb_l >= 0) {
            int t0 = 0, t1 = 0;
#pragma unroll
            for (int e = 0; e < 8; ++e) { t0 = ((ep0 & 7) == e) ? ctp.tp[e] : t0; t1 = ((ep1 & 7) == e) ? ctp.tp[e] : t1; }
            const size_t d0 = (size_t)t0 * 256 + (ep0 >> 3), d1 = (size_t)t1 * 256 + (ep1 >> 3);
            const float* m5 = MOD + ((size_t)comb_l * 5 + bidx) * 6144 + 5 * 1024;
            float* xw = isctx ? hb + (size_t)(m - NLAT) * 1024 : F.out + (size_t)m * 1024;
#pragma unroll
            for (int j = 0; j < 4; ++j) {
                const v2u y0 = *((const v2u*)(YM + d0 * 1024) + F.lane + 64 * j), y1 = *((const v2u*)(YM + d1 * 1024) + F.lane + 64 * j);
                const f32x4 mm = *((const f32x4*)m5 + F.lane + 64 * j);
                f32x4 f0, f1;
                f0[0] = __uint_as_float(y0.x << 16); f0[1] = __uint_as_float(y0.x & 0xffff0000u); f0[2] = __uint_as_float(y0.y << 16); f0[3] = __uint_as_float(y0.y & 0xffff0000u);
                f1[0] = __uint_as_float(y1.x << 16); f1[1] = __uint_as_float(y1.x & 0xffff0000u); f1[2] = __uint_as_float(y1.y << 16); f1[3] = __uint_as_float(y1.y & 0xffff0000u);
                v[j] = v[j] + mm * (f0 * g0 + f1 * g1);
                if (MODE != 2) *((f32x4*)xw + F.lane + 64 * j) = v[j];
            }
        }
        float ss = 0.f;
#pragma unroll
        for (int j = 0; j < 4; ++j) ss += (v[j][0] * v[j][0] + v[j][1] * v[j][1]) + (v[j][2] * v[j][2] + v[j][3] * v[j][3]);
        ss = wave_sum(ss);
        const float rstd = __builtin_amdgcn_rsqf(ss * (1.0f / 1024.0f) + NEPS);
        if (MODE == 2) {
#pragma unroll
            for (int j = 0; j < 4; ++j) *((f32x4*)(F.out + (size_t)m * 1024) + F.lane + 64 * j) = v[j] * rstd * wv[j];
        } else {
            const float* sh = MOD + ((size_t)l * 5 + bidx) * 6144 + (which ? 3 : 0) * 1024; const float* scl = sh + 1024;
            f32x4 o[4];
#pragma unroll
            for (int j = 0; j < 4; ++j) { const f32x4 s1 = *((const f32x4*)scl + F.lane + 64 * j), s0 = *((const f32x4*)sh + F.lane + 64 * j);
                o[j] = (v[j] * rstd * wv[j]) * (s1 + 1.0f) + s0;
                if (MODE == 1) {
                    unsigned w8 = 0u; w8 = __builtin_amdgcn_cvt_pk_fp8_f32(fminf(fmaxf(o[j][0], -448.f), 448.f), fminf(fmaxf(o[j][1], -448.f), 448.f), w8, false);
                    w8 = __builtin_amdgcn_cvt_pk_fp8_f32(fminf(fmaxf(o[j][2], -448.f), 448.f), fminf(fmaxf(o[j][3], -448.f), 448.f), w8, true);
                    *((unsigned*)((unsigned char*)XN + (size_t)m * 1024) + F.lane + 64 * j) = w8;
                } else { v2u w; w.x = pk2(o[j][0], o[j][1]); w.y = pk2(o[j][2], o[j][3]);
                    *((v2u*)(XN + (size_t)m * 1024) + F.lane + 64 * j) = w; } }
            if (MODE == 1) {
                float p[8];
#pragma unroll
                for (int e = 0; e < 8; ++e) { float s = 0.f;
#pragma unroll
                    for (int j = 0; j < 4; ++j) { const f32x4 w4 = *((const LAS f32x4*)(rwl + e * 1024) + F.lane + 64 * j);
                        s += (o[j][0] * w4[0] + o[j][1] * w4[1]) + (o[j][2] * w4[2] + o[j][3] * w4[3]); }
                    p[e] = wave_sum(s) + a.in[F.zz + I_RB][jm * 8 + e]; }
                int e0 = 0; float v0 = p[0];
#pragma unroll
                for (int e = 1; e < 8; ++e) if (p[e] > v0) { v0 = p[e]; e0 = e; }
                int e1 = -1; float v1 = -3.0e38f;
#pragma unroll
                for (int e = 0; e < 8; ++e) if (e != e0 && p[e] > v1) { v1 = p[e]; e1 = e; }
                const float ex = expf(v1 - v0), g0 = 1.0f / (1.0f + ex), g1 = ex / (1.0f + ex);
                if (F.lane == 0) {
                    unsigned* cnt = (unsigned*)F.ws + CW_CNT + jm * 8 * 64; int* LIST = (int*)(F.ws + WS_LIST);
                    int* EPw = (int*)(F.ws + WS_LIST) + 8 * MT; float* GW = (float*)(F.ws + WS_LIST) + 10 * MT;
                    const unsigned p0 = __hip_atomic_fetch_add(cnt + e0 * 64, 1u, __ATOMIC_RELAXED, __HIP_MEMORY_SCOPE_AGENT);
                    const unsigned p1 = __hip_atomic_fetch_add(cnt + e1 * 64, 1u, __ATOMIC_RELAXED, __HIP_MEMORY_SCOPE_AGENT);
                    LIST[e0 * MT + p0] = m; LIST[e1 * MT + p1] = m;
                    EPw[2 * m] = e0 | (int)(p0 << 3); EPw[2 * m + 1] = e1 | (int)(p1 << 3);
                    GW[2 * m] = g0; GW[2 * m + 1] = g1;
                }
            }
        }
    }
    if (MODE == 1) __syncthreads();
}
__device__ __forceinline__ void moe_gather(const Frame& F, int jm) {
    const unsigned* cnt = (const unsigned*)F.ws + CW_CNT + jm * 8 * 64;
    MoeTp t; load_tp(t, cnt);
    int cn[8];
#pragma unroll
    for (int e = 0; e < 8; ++e) cn[e] = __builtin_amdgcn_readfirstlane((int)__hip_atomic_load(cnt + e * 64, __ATOMIC_RELAXED, __HIP_MEMORY_SCOPE_AGENT));
    const int rows = t.tp[8] * 256;
    const int* LIST = (const int*)(F.ws + WS_LIST); const v4u* XN = (const v4u*)(F.ws + WS_ACT); v4u* XB = (v4u*)(F.ws + WS_X2);
    for (int r = F.gw; r < rows; r += F.NGW) {
        const int tile = r >> 8; int e = 0, tpe = 0, ce = cn[0];
#pragma unroll
        for (int k = 1; k < 8; ++k) { const bool ge = tile >= t.tp[k]; e += ge ? 1 : 0; tpe = ge ? t.tp[k] : tpe; ce = ge ? cn[k] : ce; }
        const int pos = r - tpe * 256;
        v4u x0 = {0u, 0u, 0u, 0u};
        if (pos < ce) { const int src = LIST[e * MT + pos]; x0 = XN[(size_t)src * 64 + F.lane]; }
        XB[(size_t)r * 64 + F.lane] = x0;
    }
}
#define GLD(T, ubase, voff) (*(const T*)((const char*)(ubase) + (unsigned)(voff)))
#define GST(T, ubase, voff) (*(T*)((char*)(ubase) + (unsigned)(voff)))
__device__ __forceinline__ int fresh_lane() { int l; asm volatile("v_mbcnt_lo_u32_b32 %0, -1, 0\n\tv_mbcnt_hi_u32_b32 %0, -1, %0" : "=v"(l)); return l; }

struct MixP { const bf16* P; const float* lb; const float* rcos; const float* rsin; const float* ba; };
__device__ __forceinline__ int seg_row0(int b, int sg) { return sg < 4 ? NLAT + b * CTXL + sg * 64 : b * SEQ + (sg - 4) * 64; }
__device__ __forceinline__ int seg_tpos0(int sg) { return sg < 4 ? -1 : (sg - 4) * 64; }

struct S5P { const float *lam_re, *lam_im, *log_dt, *b_re, *b_im, *c_re, *c_im, *dd; const unsigned* par; };
__device__ __forceinline__ float gelu_tanh(float y) { const float t = 0.7978845608028654f * (y + 0.044715f * y * y * y); const float th = 1.0f - 2.0f * __builtin_amdgcn_rcpf(1.0f + __expf(2.0f * t)); return 0.5f * y * (1.0f + th); }
template <int MODE>
__device__ __forceinline__ void s5_scan(const S5P& sp, const bf16* P, int b, int g, int dir, int sg, int lane, float& hre, float& him, LAS float* yf, LAS float* stg, bf16* Z) {
    const int row0 = seg_row0(b, sg); const int dg = dir * 16 + g;
    const float lre = sp.lam_re[dg * 64 + lane], lim = sp.lam_im[dg * 64 + lane], dt = expf(sp.log_dt[dg]);
    const float er = expf(lre * dt); const float sn = sinf(lim * dt), cs = cosf(lim * dt);
    const float ar = er * cs, ai = er * sn;
    const float nr = ar - 1.0f, ni = ai, den = lre * lre + lim * lim;
    const float cr = (nr * lre + ni * lim) / den, ci = (ni * lre - nr * lim) / den;
    float bbr[16], bbi[16], Cr[16], Ci[16];
#pragma unroll
    for (int c = 0; c < 16; ++c) { const float Br = sp.b_re[((size_t)dg * 64 + lane) * 16 + c], Bi = sp.b_im[((size_t)dg * 64 + lane) * 16 + c];
        bbr[c] = cr * Br - ci * Bi; bbi[c] = cr * Bi + ci * Br;
        Cr[c] = (MODE != 0) ? sp.c_re[((size_t)dg * 16 + c) * 64 + lane] : 0.f; Ci[c] = (MODE != 0) ? sp.c_im[((size_t)dg * 16 + c) * 64 + lane] : 0.f; }
    const int ch = ((lane >> 5) & 1) * 8 + ((lane >> 4) & 1) * 4 + ((lane >> 3) & 1) * 2 + ((lane >> 2) & 1);
    const float dv = (MODE == 2) ? sp.dd[g * 16 + ch] : 0.f;
    const bool b5 = lane & 32, b4 = lane & 16, b3 = lane & 8, b2 = lane & 4;
    const unsigned ucol = 2u * (unsigned)(C_S5 + g * 16 + (lane & 15));
    unsigned short rn0[4], rn1[4], rn2[4];
#pragma unroll
    for (int u = 0; u < 4; ++u) { rn0[u] = GLD(unsigned short, P + (size_t)(row0 + (dir ? 63 - u : u)) * DINP, ucol); rn1[u] = GLD(unsigned short, P + (size_t)(row0 + (dir ? 59 - u : 4 + u)) * DINP, ucol);
        rn2[u] = GLD(unsigned short, P + (size_t)(row0 + (dir ? 55 - u : 8 + u)) * DINP, ucol); }
#pragma unroll 1
    for (int i0 = 0; i0 < 64; i0 += 4) {
        unsigned short ru[4], rn3[4];
        const int ip = (i0 + 12 < 64) ? i0 + 12 : 60;
#pragma unroll
        for (int u = 0; u < 4; ++u) { ru[u] = rn0[u]; rn3[u] = GLD(unsigned short, P + (size_t)(row0 + (dir ? 63 - (ip + u) : (ip + u))) * DINP, ucol); }
#pragma unroll
        for (int u = 0; u < 4; ++u) stg[u * 64 + lane] = bf2f(ru[u]);
#pragma unroll
        for (int u = 0; u < 4; ++u) {
            const int ti = dir ? 63 - (i0 + u) : (i0 + u);
            const float uf = bf2f(ru[u]);
            float bur = 0.f, bui = 0.f;
#pragma unroll
            for (int c4 = 0; c4 < 4; ++c4) { const f32x4 ux = *(const LAS f32x4*)(stg + u * 64 + 4 * c4);
#pragma unroll
                for (int jj = 0; jj < 4; ++jj) { bur = fmaf(bbr[4 * c4 + jj], ux[jj], bur); bui = fmaf(bbi[4 * c4 + jj], ux[jj], bui); } }
            const float nre = ar * hre - ai * him + bur, nim = ar * him + ai * hre + bui;
            hre = nre; him = nim;
            if (MODE != 0) {
                float v[16];
#pragma unroll
                for (int c = 0; c < 16; ++c) v[c] = Cr[c] * hre - Ci[c] * him;
                float w8[8], w4[4], w2[2], w1;
#pragma unroll
                for (int i = 0; i < 8; ++i) { const float mine = b5 ? v[8 + i] : v[i], oth = b5 ? v[i] : v[8 + i]; w8[i] = mine + __shfl_xor(oth, 32); }
#pragma unroll
                for (int i = 0; i < 4; ++i) { const float mine = b4 ? w8[4 + i] : w8[i], oth = b4 ? w8[i] : w8[4 + i]; w4[i] = mine + __shfl_xor(oth, 16); }
#pragma unroll
                for (int i = 0; i < 2; ++i) { const float mine = b3 ? w4[2 + i] : w4[i], oth = b3 ? w4[i] : w4[2 + i]; w2[i] = mine + __shfl_xor(oth, 8); }
                { const float mine = b2 ? w2[1] : w2[0], oth = b2 ? w2[0] : w2[1]; w1 = mine + __shfl_xor(oth, 4); }
                w1 += __shfl_xor(w1, 2); w1 += __shfl_xor(w1, 1);
                if (MODE == 1) { if ((lane & 3) == 0) yf[ti * 16 + ch] = w1; }
                if (MODE == 2) {
                    const float uch = __shfl(uf, ch);
                    if ((lane & 3) == 0) { const float y = w1 + yf[ti * 16 + ch] + dv * uch; Z[(size_t)(row0 + ti) * 256 + g * 16 + ch] = (bf16)f2bf(gelu_tanh(y)); }
                }
            }
        }
#pragma unroll
        for (int u = 0; u < 4; ++u) { rn0[u] = rn1[u]; rn1[u] = rn2[u]; rn2[u] = rn3[u]; }
    }
}

__device__ __forceinline__ MixP make_mixp(const Frame& F, const Args& a, int l) {
    MixP mp; mp.P = (const bf16*)(F.ws + WS_PH); mp.lb = (const float*)(F.ws + WS_LB) + l * 256; mp.rcos = (const float*)(F.ws + WS_ROPE); mp.rsin = mp.rcos + 2048;
    mp.ba = a.in[F.zz + I_BA] + (size_t)l * 2 * 128; return mp;
}
__device__ __forceinline__ S5P make_s5p(const Frame& F, const Args& a, int l) {
    S5P sp; sp.lam_re = a.in[F.zz + I_LAMRE] + (size_t)l * 2048; sp.lam_im = a.in[F.zz + I_LAMIM] + (size_t)l * 2048; sp.log_dt = a.in[F.zz + I_LOGDT] + l * 32;
    sp.b_re = a.in[F.zz + I_BRE] + (size_t)l * 32768; sp.b_im = a.in[F.zz + I_BIM] + (size_t)l * 32768; sp.c_re = a.in[F.zz + I_CRE] + (size_t)l * 32768; sp.c_im = a.in[F.zz + I_CIM] + (size_t)l * 32768;
    sp.dd = a.in[F.zz + I_S5D] + l * 256; sp.par = (const unsigned*)(F.ws + WS_S5PAR) + (size_t)l * 32 * 4096; return sp;
}


typedef short bf16x8_t __attribute__((ext_vector_type(8)));
typedef float f32x16 __attribute__((ext_vector_type(16)));
typedef float f32x2_t __attribute__((ext_vector_type(2)));
typedef __bf16 bf16x2_n __attribute__((ext_vector_type(2)));
__device__ __forceinline__ unsigned pkbf(float lo, float hi) { const f32x2_t v = {lo, hi}; const bf16x2_n r = __builtin_convertvector(v, bf16x2_n); return __builtin_bit_cast(unsigned, r); }
constexpr int WL_QC = 0, WL_KC = 4608, WL_KT = 9216, WL_VT = 14336, WL_PL = 19456, WL_BYTES = 19712;

struct MxC { float gamma, lbv, oml, bav, rc1, rs1; unsigned cq, ck, cv, cz; };
template <int MIX>
__device__ __forceinline__ void mx_consts(MxC& c, const MixP& mp, int h, int dir, int lane) {
    c.gamma = 1.f; c.lbv = 0.f; c.oml = 1.f; c.bav = 0.f; c.cz = 0; c.rc1 = 1.f; c.rs1 = 0.f;
    if (MIX == 0) { c.cq = 8u * (unsigned)(C_RQ + h * 64 + lane); c.ck = 8u * (unsigned)(C_RK + h * 64 + lane); c.cv = 8u * (unsigned)(C_RV + h * 64 + lane); c.gamma = 1.0f - exp2f(-5.0f - (float)(dir ? 3 - h : h));
        if (lane & 32) { const unsigned r1 = 4u * (unsigned)(16 + (lane & 15)); c.rc1 = GLD(float, mp.rcos, r1); const float s1 = GLD(float, mp.rsin, r1); c.rs1 = dir ? -s1 : s1; } }
    else if (MIX == 1) { c.cq = 8u * (unsigned)(C_HQ + h * 64 + lane); c.ck = 8u * (unsigned)((dir ? C_HFB : C_HFF) + h * 64 + lane); c.cv = 8u * (unsigned)(C_HI + h * 64 + lane); c.lbv = mp.lb[h * 64 + lane]; c.oml = 1.0f - c.lbv; }
    else { c.cq = 8u * (unsigned)(C_GQ + h * 32 + (lane & 31)); c.ck = 8u * (unsigned)(C_GK + h * 32 + (lane & 31)); c.cv = 8u * (unsigned)(C_GV + h * 64 + lane); c.cz = 8u * (unsigned)((dir ? C_GZB : C_GZF) + h * 32 + (lane & 31));
        c.bav = mp.ba[dir * 128 + h * 32 + (lane & 31)]; }
}
struct MxRaw { v2u q, k, v, z; };
template <int MIX, bool NEEDQ, int DIR>
__device__ __forceinline__ void mx_load(MxRaw& w, const MixP& mp, const MxC& c, int rows, int b) {
    const bf16* pr = mp.P + (size_t)((rows >> 2) + (DIR ? 15 - b : b)) * P4G;
    const v2u zero = {0u, 0u};
    w.q = NEEDQ ? GLD(v2u, pr, c.cq) : zero; w.k = GLD(v2u, pr, c.ck); w.v = GLD(v2u, pr, c.cv); w.z = (MIX == 2) ? GLD(v2u, pr, c.cz) : zero;
}
__device__ __forceinline__ float bfx(const v2u& w, int i) { const unsigned d = (i >> 1) ? w.y : w.x; return __builtin_bit_cast(float, (i & 1) ? (d & 0xffff0000u) : (d << 16)); }
template <int MIX, bool NEEDQ, int DIR>
__device__ __forceinline__ void mx_batch(const MxRaw& cur, const MixP& mp, const MxC& c, int tposs  , int lane, LAS unsigned char* wl, int b, float& P, float& rc, float& rs) {
    constexpr int DK = (MIX == 2) ? 32 : 64;
    float kt[4];
#pragma unroll
    for (int u = 0; u < 4; ++u) {
        const int cc = b * 4 + u, ts = DIR ? 63 - cc : cc, t = ts & 31;
        const int pu = DIR ? 3 - u : u; float q = bfx(cur.q, pu), k, f;
        if (MIX == 0) {
            k = bfx(cur.k, pu) * 0.125f; f = c.gamma;
            if (tposs >= 0) { const float cs = rc, sn = rs;
                rc = cs * c.rc1 - sn * c.rs1; rs = sn * c.rc1 + cs * c.rs1;
                const float ss = (lane & 16) ? sn : -sn;
                const float kp = __shfl_xor(k, 16); k = fmaf(kp, ss, k * cs);
                if (NEEDQ) { const float qp = __shfl_xor(q, 16); q = fmaf(qp, ss, q * cs); } }
        } else if (MIX == 1) {
            const float z = bfx(cur.k, pu); const float e = __expf(-z); const float sp = __builtin_amdgcn_rcpf(1.0f + e), sn = e * sp;
            f = fmaf(c.oml, sp, c.lbv); k = c.oml * sn;
        } else {
            k = bfx(cur.k, pu) * 0.17677669529663687f; const float z = bfx(cur.z, pu) + c.bav;
            const float ls = fminf(z, 0.f) - __logf(1.0f + __expf(-fabsf(z)));
            f = __expf(ls * 0.0625f);
        }
        P = fmaxf(P * f, 1e-30f);
        const float kk = k * __builtin_amdgcn_rcpf(P); kt[DIR ? 3 - u : u] = kk;
        if (lane < DK) {
            const unsigned qk = pkbf(q * P, kk);
            if (NEEDQ) *(LAS unsigned short*)(wl + WL_QC + t * 144 + lane * 2) = (unsigned short)qk;
            *(LAS unsigned short*)(wl + WL_KC + t * 144 + lane * 2) = (unsigned short)(qk >> 16);
        }
    }
    const int g4 = ((DIR ? 63 - b * 4 : b * 4) & 31) >> 2;
    v2u kp; kp.x = pkbf(kt[0], kt[1]); kp.y = pkbf(kt[2], kt[3]);
    if (lane < DK) *(LAS v2u*)(wl + WL_KT + lane * 80 + g4 * 8) = kp;
    *(LAS v2u*)(wl + WL_VT + lane * 80 + g4 * 8) = cur.v;
}
typedef short bf16x4_t __attribute__((ext_vector_type(4)));
#define MFMA8(a, b, c) __builtin_amdgcn_mfma_f32_32x32x8bf16_1k((a), (b), (c), 0, 0, 0)
__device__ __forceinline__ bf16x4_t pack4(const f32x16& x, int s) {
    v2u p; p.x = pkbf(x[4 * s], x[4 * s + 1]); p.y = pkbf(x[4 * s + 2], x[4 * s + 3]);
    return __builtin_bit_cast(bf16x4_t, p);
}
__device__ __forceinline__ bf16x4_t ld4(const LAS unsigned char* p) { const v2u a = *(const LAS v2u*)p; return __builtin_bit_cast(bf16x4_t, a); }

__device__ __forceinline__ float u2f_(unsigned u) { return __builtin_bit_cast(float, u); }
__device__ __forceinline__ unsigned f2u_(float f) { return __builtin_bit_cast(unsigned, f); }
__device__ __forceinline__ void s5_build(const Frame& F, const Args& a) {
    for (int it = F.gw; it < 128; it += F.NGW) {
        const int l = it >> 5, dg = it & 31, lane = F.lane, m32 = lane & 31, hh = lane >> 5;
        const S5P sp = make_s5p(F, a, l);
        unsigned* par = (unsigned*)(F.ws + WS_S5PAR) + (size_t)it * 4096;
    float ar[2], ai[2], a2r[2], a2i[2], a3r[2], a3i[2], a4r[2], a4i[2];
    bf16x4_t bfr[4][2];
    const float dt = __expf(sp.log_dt[dg]);
#pragma unroll
    for (int sh = 0; sh < 2; ++sh) {
        const int p = 32 * sh + m32;
        const float lre = sp.lam_re[dg * 64 + p], lim = sp.lam_im[dg * 64 + p];
        const float er = __expf(lre * dt), sn = sinf(lim * dt), cs = cosf(lim * dt);
        ar[sh] = er * cs; ai[sh] = er * sn;
        a2r[sh] = ar[sh] * ar[sh] - ai[sh] * ai[sh]; a2i[sh] = ar[sh] * ai[sh] + ar[sh] * ai[sh];
        a3r[sh] = a2r[sh] * ar[sh] - a2i[sh] * ai[sh]; a3i[sh] = a2r[sh] * ai[sh] + a2i[sh] * ar[sh];
        a4r[sh] = a2r[sh] * a2r[sh] - a2i[sh] * a2i[sh]; a4i[sh] = a2r[sh] * a2i[sh] + a2r[sh] * a2i[sh];
        const float nr = ar[sh] - 1.0f, ni = ai[sh], den = 1.0f / (lre * lre + lim * lim);
        const float cr = (nr * lre + ni * lim) * den, ci = (ni * lre - nr * lim) * den;
#pragma unroll
        for (int s2 = 0; s2 < 2; ++s2) {
            const f32x4 Br = *(const f32x4*)(sp.b_re + ((size_t)dg * 64 + p) * 16 + 8 * s2 + 4 * hh), Bi = *(const f32x4*)(sp.b_im + ((size_t)dg * 64 + p) * 16 + 8 * s2 + 4 * hh);
            const f32x4 re = Br * cr - Bi * ci, im = Bi * cr + Br * ci;
            v2u pr, pi; pr.x = pkbf(re[0], re[1]); pr.y = pkbf(re[2], re[3]); pi.x = pkbf(im[0], im[1]); pi.y = pkbf(im[2], im[3]);
            bfr[sh][s2] = __builtin_bit_cast(bf16x4_t, pr); bfr[2 + sh][s2] = __builtin_bit_cast(bf16x4_t, pi);
        }
    }
    bf16x4_t cfr[16];
    {
#pragma unroll
        for (int s = 0; s < 16; ++s) {
            const int mp_ = 2 * s + hh; f32x4 cv = {0.f, 0.f, 0.f, 0.f};
            if (m32 < 16) { const float* cre = sp.c_re + ((size_t)dg * 16 + m32) * 64 + mp_; const float* cim = sp.c_im + ((size_t)dg * 16 + m32) * 64 + mp_;
                cv[0] = cre[0]; cv[1] = cre[32]; cv[2] = -cim[0]; cv[3] = -cim[32]; }
            v2u pc; pc.x = pkbf(cv[0], cv[1]); pc.y = pkbf(cv[2], cv[3]); cfr[s] = __builtin_bit_cast(bf16x4_t, pc);
        }
    }
#define S5U(x) __builtin_bit_cast(unsigned, (x))
        v4u q;
        q.x = S5U(ar[0]); q.y = S5U(ar[1]); q.z = S5U(ai[0]); q.w = S5U(ai[1]); *(v4u*)(par + (0 * 64 + lane) * 4) = q;
        q.x = S5U(a2r[0]); q.y = S5U(a2r[1]); q.z = S5U(a2i[0]); q.w = S5U(a2i[1]); *(v4u*)(par + (1 * 64 + lane) * 4) = q;
        q.x = S5U(a3r[0]); q.y = S5U(a3r[1]); q.z = S5U(a3i[0]); q.w = S5U(a3i[1]); *(v4u*)(par + (2 * 64 + lane) * 4) = q;
        q.x = S5U(a4r[0]); q.y = S5U(a4r[1]); q.z = S5U(a4i[0]); q.w = S5U(a4i[1]); *(v4u*)(par + (3 * 64 + lane) * 4) = q;
#undef S5U
#pragma unroll
        for (int i = 0; i < 4; ++i) { const v2u lo = __builtin_bit_cast(v2u, bfr[i][0]), hi = __builtin_bit_cast(v2u, bfr[i][1]); q.x = lo.x; q.y = lo.y; q.z = hi.x; q.w = hi.y; *(v4u*)(par + ((4 + i) * 64 + lane) * 4) = q; }
#pragma unroll
        for (int k = 0; k < 8; ++k) { const v2u lo = __builtin_bit_cast(v2u, cfr[2 * k]), hi = __builtin_bit_cast(v2u, cfr[2 * k + 1]); q.x = lo.x; q.y = lo.y; q.z = hi.x; q.w = hi.y; *(v4u*)(par + ((8 + k) * 64 + lane) * 4) = q; }
    }
}
struct S5U { v2u u[2][2]; };
__device__ __forceinline__ void s5_load_u(S5U& U, const bf16* P, int b, int g, int sg, int lane) {
    const int m32 = lane & 31, hh = lane >> 5, row0 = seg_row0(b, sg);
#pragma unroll
    for (int ch = 0; ch < 2; ++ch) { const bf16* urow = P + (size_t)((row0 + 32 * ch + m32) >> 2) * P4G + P4S5 + (m32 & 3) * 256 + g * 16 + 4 * hh;
        U.u[ch][0] = *(const v2u*)urow; U.u[ch][1] = *(const v2u*)(urow + 8); }
}
template <int MODE, int DIR>
__device__ __forceinline__ void s5_mm_dir(const S5P& sp, const S5U& U, int b, int g, int sg, int lane, float& hre, float& him, LAS float* yf, LAS unsigned char* hs, bf16* Z) {
    const int m32 = lane & 31, hh = lane >> 5, dg = DIR * 16 + g, row0 = seg_row0(b, sg);
    float ar[2], ai[2], a2r[2], a2i[2], a3r[2], a3i[2], a4r[2], a4i[2];
    bf16x4_t bfr[4][2];
    bf16x4_t cfr[16];
    {
        const unsigned* par = sp.par + (size_t)dg * 4096;
        v4u pq[16];
#pragma unroll
        for (int q = 0; q < ((MODE != 0) ? 16 : 8); ++q) pq[q] = GLD(v4u, par + q * 256, 16u * (unsigned)lane);
#define S5F(x) u2f_(x)
        ar[0] = S5F(pq[0].x); ar[1] = S5F(pq[0].y); ai[0] = S5F(pq[0].z); ai[1] = S5F(pq[0].w);
        a2r[0] = S5F(pq[1].x); a2r[1] = S5F(pq[1].y); a2i[0] = S5F(pq[1].z); a2i[1] = S5F(pq[1].w);
        a3r[0] = S5F(pq[2].x); a3r[1] = S5F(pq[2].y); a3i[0] = S5F(pq[2].z); a3i[1] = S5F(pq[2].w);
        a4r[0] = S5F(pq[3].x); a4r[1] = S5F(pq[3].y); a4i[0] = S5F(pq[3].z); a4i[1] = S5F(pq[3].w);
#undef S5F
#pragma unroll
        for (int i = 0; i < 4; ++i) { v2u lo, hi; lo.x = pq[4 + i].x; lo.y = pq[4 + i].y; hi.x = pq[4 + i].z; hi.y = pq[4 + i].w; bfr[i][0] = __builtin_bit_cast(bf16x4_t, lo); bfr[i][1] = __builtin_bit_cast(bf16x4_t, hi); }
        if (MODE != 0) {
#pragma unroll
            for (int k = 0; k < 8; ++k) { v2u lo, hi; lo.x = pq[8 + k].x; lo.y = pq[8 + k].y; hi.x = pq[8 + k].z; hi.y = pq[8 + k].w; cfr[2 * k] = __builtin_bit_cast(bf16x4_t, lo); cfr[2 * k + 1] = __builtin_bit_cast(bf16x4_t, hi); }
        }
    }
    const float ddv = (MODE == 2 && m32 < 16) ? sp.dd[g * 16 + m32] : 0.f;
    float hr[2], hi[2];
    hr[0] = __shfl(hre, m32); hi[0] = __shfl(him, m32); hr[1] = __shfl(hre, m32 + 32); hi[1] = __shfl(him, m32 + 32);
#pragma unroll 1
    for (int ci2 = 0; ci2 < 2; ++ci2) {
        const int ch = DIR ? 1 - ci2 : ci2, rowc = row0 + 32 * ch;
        const v2u x0 = ch ? U.u[1][0] : U.u[0][0], x1 = ch ? U.u[1][1] : U.u[0][1];
        const bf16x4_t ua0 = __builtin_bit_cast(bf16x4_t, x0), ua1 = __builtin_bit_cast(bf16x4_t, x1);
        if (MODE == 2) { *(LAS v2u*)(hs + 13312 + m32 * 32 + 8 * hh) = x0; *(LAS v2u*)(hs + 13312 + m32 * 32 + 16 + 8 * hh) = x1; }
        f32x16 BU[4];
#pragma unroll
        for (int nt = 0; nt < 4; ++nt) {
#pragma unroll
            for (int r = 0; r < 16; ++r) BU[nt][r] = 0.f;
            BU[nt] = MFMA8(ua0, bfr[nt][0], BU[nt]); BU[nt] = MFMA8(ua1, bfr[nt][1], BU[nt]);
        }
#pragma unroll
        for (int sh = 0; sh < 2; ++sh)
#pragma unroll
            for (int gg = 0; gg < 4; ++gg)
#pragma unroll
                for (int jj = 1; jj < 4; ++jj) {
                    const int r = DIR ? 4 * gg + 3 - jj : 4 * gg + jj, rp = DIR ? r + 1 : r - 1;
                    const float pr = BU[sh][rp], pi = BU[2 + sh][rp];
                    BU[sh][r] += ar[sh] * pr - ai[sh] * pi; BU[2 + sh][r] += ar[sh] * pi + ai[sh] * pr;
                }
        float hnr[2][4], hni[2][4];
        {
            float elr[2][4], eli[2][4], ehr[2][4], ehi[2][4];
#pragma unroll
            for (int sh = 0; sh < 2; ++sh)
#pragma unroll
                for (int gg = 0; gg < 4; ++gg) { const int rl = DIR ? 4 * gg : 4 * gg + 3;
                    const unsigned vr = f2u_(BU[sh][rl]), vi = f2u_(BU[2 + sh][rl]);
                    const auto sr = __builtin_amdgcn_permlane32_swap(vr, vr, false, false), si = __builtin_amdgcn_permlane32_swap(vi, vi, false, false);
                    elr[sh][gg] = u2f_((unsigned)sr[0]); ehr[sh][gg] = u2f_((unsigned)sr[1]); eli[sh][gg] = u2f_((unsigned)si[0]); ehi[sh][gg] = u2f_((unsigned)si[1]); }
            float tr[2], ti[2];
#pragma unroll
            for (int st = 0; st < 8; ++st) {
                const int grp = DIR ? 7 - st : st, gg = grp >> 1, half = grp & 1;
#pragma unroll
                for (int sh = 0; sh < 2; ++sh) {
                    if (half == (DIR ? 1 : 0)) { tr[sh] = hr[sh]; ti[sh] = hi[sh]; }
                    else { hnr[sh][gg] = (hh == half) ? hr[sh] : tr[sh]; hni[sh][gg] = (hh == half) ? hi[sh] : ti[sh]; }
                    const float er = half ? ehr[sh][gg] : elr[sh][gg], ei = half ? ehi[sh][gg] : eli[sh][gg];
                    const float nr = er + a4r[sh] * hr[sh] - a4i[sh] * hi[sh], ni = ei + a4r[sh] * hi[sh] + a4i[sh] * hr[sh];
                    hr[sh] = nr; hi[sh] = ni;
                }
            }
        }
        if (MODE != 0) {
#pragma unroll
            for (int sh = 0; sh < 2; ++sh)
#pragma unroll
                for (int gg = 0; gg < 4; ++gg)
#pragma unroll
                    for (int jj = 0; jj < 4; ++jj) {
                        const int pw = DIR ? 4 - jj : jj + 1;
                        const float pr = (pw == 1) ? ar[sh] : (pw == 2) ? a2r[sh] : (pw == 3) ? a3r[sh] : a4r[sh], pi = (pw == 1) ? ai[sh] : (pw == 2) ? a2i[sh] : (pw == 3) ? a3i[sh] : a4i[sh];
                        BU[sh][4 * gg + jj] += pr * hnr[sh][gg] - pi * hni[sh][gg]; BU[2 + sh][4 * gg + jj] += pr * hni[sh][gg] + pi * hnr[sh][gg];
                    }
#pragma unroll
            for (int r = 0; r < 16; ++r) { v2u w; w.x = pkbf(BU[0][r], BU[1][r]); w.y = pkbf(BU[2][r], BU[3][r]);
                *(LAS v2u*)(hs + ((r & 3) + 8 * (r >> 2) + 4 * hh) * 272 + m32 * 8) = w; }
            f32x16 Yv, Yw;
#pragma unroll
            for (int r = 0; r < 16; ++r) { Yv[r] = 0.f; Yw[r] = 0.f; }
#pragma unroll
            for (int s = 0; s < 16; s += 2) { Yv = MFMA8(ld4(hs + m32 * 272 + (8 * s + 4 * hh) * 2), cfr[s], Yv); Yw = MFMA8(ld4(hs + m32 * 272 + (8 * s + 8 + 4 * hh) * 2), cfr[s + 1], Yw); }
#pragma unroll
            for (int r = 0; r < 16; ++r) Yv[r] += Yw[r];
            if (m32 < 16) {
#pragma unroll
                for (int r = 0; r < 16; ++r) {
                    const int tl = (r & 3) + 8 * (r >> 2) + 4 * hh;
                    if (MODE == 1) yf[(32 * ch + tl) * 16 + m32] = Yv[r];
                    else { const float u = bf2f(*(const LAS unsigned short*)(hs + 13312 + tl * 32 + m32 * 2));
                        const float y = Yv[r] + yf[(32 * ch + tl) * 16 + m32] + ddv * u;
                        const float zz = gelu_tanh(y); Z[(size_t)(rowc + tl) * 256 + g * 16 + m32] = (bf16)pkbf(zz, zz); }
                }
            }
        }
    }
    hre = hh ? hr[1] : hr[0]; him = hh ? hi[1] : hi[0];
}
template <int MODE>
__device__ __forceinline__ void s5_mm(const S5P& sp, const S5U& U, int b, int g, int dir, int sg, int lane, float& hre, float& him, LAS float* yf, LAS unsigned char* hs, bf16* Z) {
    if (dir) s5_mm_dir<MODE, 1>(sp, U, b, g, sg, lane, hre, him, yf, hs, Z); else s5_mm_dir<MODE, 0>(sp, U, b, g, sg, lane, hre, him, yf, hs, Z);
}
template <int MIX, int DIR, bool WITH_O>
__device__ __forceinline__ void mx_chunk(LAS unsigned char* wl, int lane, float Pl, f32x16 (&ST)[(MIX == 2) ? 1 : 2][2], f32x16 (&O)[2]) {
    constexpr int DK = (MIX == 2) ? 32 : 64, NRT = DK / 32;
    const int m32 = lane & 31, hh = lane >> 5;
    asm volatile("" ::: "memory");
    if (lane < DK) *(LAS float*)(wl + WL_PL + lane * 4) = Pl;
    asm volatile("" ::: "memory");
    if (WITH_O) {
        f32x16 x;
#pragma unroll
        for (int r = 0; r < 16; ++r) x[r] = 0.f;
#pragma unroll
        for (int s = 0; s < DK / 8; ++s) {
            const bf16x4_t ka = ld4(wl + WL_KC + m32 * 144 + (8 * s + 4 * hh) * 2);
            const bf16x4_t qb = ld4(wl + WL_QC + m32 * 144 + (8 * s + 4 * hh) * 2);
            x = MFMA8(ka, qb, x);
        }
#pragma unroll
        for (int r = 0; r < 16; ++r) { const int j = (r & 3) + 8 * (r >> 2) + 4 * hh; const bool keep = DIR ? (j >= m32) : (j <= m32); x[r] = keep ? x[r] : 0.f; }
#pragma unroll
        for (int t = 0; t < 2; ++t)
#pragma unroll
            for (int r = 0; r < 16; ++r) O[t][r] = 0.f;
#pragma unroll
        for (int s = 0; s < 4; ++s) {
            const bf16x4_t xa = pack4(x, s);
#pragma unroll
            for (int t = 0; t < 2; ++t) O[t] = MFMA8(ld4(wl + WL_VT + (32 * t + m32) * 80 + (8 * s + 4 * hh) * 2), xa, O[t]);
        }
#pragma unroll
        for (int rt = 0; rt < NRT; ++rt)
#pragma unroll
            for (int s = 0; s < 4; ++s) {
                const bf16x4_t qa = ld4(wl + WL_QC + m32 * 144 + (32 * rt + 8 * s + 4 * hh) * 2);
#pragma unroll
                for (int t = 0; t < 2; ++t) O[t] = MFMA8(pack4(ST[rt][t], s), qa, O[t]);
            }
    }
    {
        v4u kk4[NRT][2], vv4[2][2];
#pragma unroll
        for (int p2 = 0; p2 < 2; ++p2) {
#pragma unroll
            for (int rt = 0; rt < NRT; ++rt) kk4[rt][p2] = *(const LAS v4u*)(wl + WL_KT + (32 * rt + m32) * 80 + (16 * p2 + 8 * hh) * 2);
#pragma unroll
            for (int t = 0; t < 2; ++t) vv4[t][p2] = *(const LAS v4u*)(wl + WL_VT + (32 * t + m32) * 80 + (16 * p2 + 8 * hh) * 2);
        }
#pragma unroll
        for (int p2 = 0; p2 < 2; ++p2)
#pragma unroll
            for (int e = 0; e < 2; ++e)
#pragma unroll
                for (int rt = 0; rt < NRT; ++rt) { v2u ku; ku.x = e ? kk4[rt][p2].z : kk4[rt][p2].x; ku.y = e ? kk4[rt][p2].w : kk4[rt][p2].y; const bf16x4_t ka = __builtin_bit_cast(bf16x4_t, ku);
#pragma unroll
                    for (int t = 0; t < 2; ++t) { v2u vu; vu.x = e ? vv4[t][p2].z : vv4[t][p2].x; vu.y = e ? vv4[t][p2].w : vv4[t][p2].y; ST[rt][t] = MFMA8(ka, __builtin_bit_cast(bf16x4_t, vu), ST[rt][t]); } }
    }
#pragma unroll
    for (int rt = 0; rt < NRT; ++rt)
#pragma unroll
        for (int g = 0; g < 4; ++g) {
            const f32x4 pl4 = *(const LAS f32x4*)(wl + WL_PL + (32 * rt + 8 * g + 4 * hh) * 4);
#pragma unroll
            for (int e = 0; e < 4; ++e) { ST[rt][0][4 * g + e] *= pl4[e]; ST[rt][1][4 * g + e] *= pl4[e]; }
        }
}
__device__ __forceinline__ float half_sum(float v) {
#pragma unroll
    for (int o = 1; o < 32; o <<= 1) v += __shfl_xor(v, o);
    return v;
}
template <int MIX, int DIR>
__device__ __forceinline__ void mixA_stream(const MixP& mp, const MxC& c, int row0, int tpos0, int lane, LAS unsigned char* wl, f32x16 (&ST)[(MIX == 2) ? 1 : 2][2], float& Gam) {
    f32x16 O[2];
    MxRaw r[8];
#pragma unroll
    for (int i = 0; i < 8; ++i) mx_load<MIX, false, DIR>(r[i], mp, c, row0, i);
    float rc = 1.0f, rs = 0.0f;
    if (MIX == 0 && tpos0 >= 0) { const int tpos = tpos0 + (DIR ? 63 : 0); const int pos = (lane & 32) ? (tpos & 63) : (tpos >> 6);
        const unsigned ro = 4u * (unsigned)(pos * 16 + (lane & 15)); rc = GLD(float, mp.rcos, ro); rs = GLD(float, mp.rsin, ro); }
    float P = 1.0f;
#pragma unroll 1
    for (int cki = 0; cki < 2; ++cki) {
        int ck = cki; asm volatile("" : "+s"(ck));
        int ln = lane; asm volatile("" : "+v"(ln));
#pragma unroll
        for (int j = 0; j < 8; ++j) {
            mx_batch<MIX, false, DIR>(r[j], mp, c, tpos0, ln, wl, j, P, rc, rs);
            if (ck == 0) mx_load<MIX, false, DIR>(r[j], mp, c, row0, 8 + j);
        }
        Gam *= P; mx_chunk<MIX, 0, false>(wl, ln, P, ST, O); P = 1.0f;
    }
}
template <int MIX>
__device__ __forceinline__ void mixA_unit(const MixP& mp, float* STG, int idx, int lane_in, LAS unsigned char* wl) {
    int lane = lane_in;
    constexpr int DK = (MIX == 2) ? 32 : 64, NRT = DK / 32;
    const int dir = idx / 2112, rem = idx - dir * 2112, bh = rem / NSEG, sg = rem - bh * NSEG, b = bh >> 2, h = bh & 3;
    asm volatile("" : "+v"(lane));
    MxC c; mx_consts<MIX>(c, mp, h, dir, lane);
    f32x16 ST[NRT][2];
#pragma unroll
    for (int rt = 0; rt < NRT; ++rt)
#pragma unroll
        for (int t = 0; t < 2; ++t)
#pragma unroll
            for (int r = 0; r < 16; ++r) ST[rt][t][r] = 0.f;
    const int row0 = seg_row0(b, sg), tpos0 = seg_tpos0(sg);
    float Gam = 1.0f;
    if (dir) mixA_stream<MIX, 1>(mp, c, row0, tpos0, lane, wl, ST, Gam); else mixA_stream<MIX, 0>(mp, c, row0, tpos0, lane, wl, ST, Gam);
    const size_t slot = (size_t)((dir * 16 + bh) * NSEG + sg);
    bf16* ds = (bf16*)(STG + (MIX == 0 ? ST_DS0 : (MIX == 1 ? ST_DS1 : ST_DS2))) + slot * (DK * 64);
    const int m32 = lane & 31, hh = lane >> 5;
#pragma unroll
    for (int rt = 0; rt < NRT; ++rt)
#pragma unroll
        for (int t = 0; t < 2; ++t)
#pragma unroll
            for (int r4 = 0; r4 < 4; ++r4) { v2u v; v.x = pkbf(ST[rt][t][4 * r4], ST[rt][t][4 * r4 + 1]); v.y = pkbf(ST[rt][t][4 * r4 + 2], ST[rt][t][4 * r4 + 3]);
                GST(v2u, ds + ((rt * 2 + t) * 4 + r4) * 256, 8u * (unsigned)lane) = v; }
    float* gs = STG + (MIX == 0 ? ST_G0 : (MIX == 1 ? ST_G1 : ST_G2)) + slot * 64;
    GST(float, gs, 4u * (unsigned)lane) = Gam;
}
__device__ __forceinline__ void mx_epi_gates(const MixP& mp, int lane, int rowc, int gcol, v2u (&g)[2][4]) {
    const int m32 = lane & 31, hh = lane >> 5;
    const bf16* gb = mp.P + (size_t)(rowc >> 2) * P4G + gcol;
    const unsigned gvo = 2u * (unsigned)((m32 >> 2) * P4G + (m32 & 3) * 256 + 4 * hh);
#pragma unroll
    for (int t = 0; t < 2; ++t)
#pragma unroll
        for (int s = 0; s < 4; ++s) g[t][s] = GLD(v2u, gb + 32 * t + 8 * s, gvo);
}
__device__ __forceinline__ void mx_epi_of(int lane, const float* OFc, v2u (&of)[2][4]) {
#pragma unroll
    for (int t = 0; t < 2; ++t)
#pragma unroll
        for (int s = 0; s < 4; ++s) of[t][s] = GLD(v2u, (const bf16*)OFc + (t * 4 + s) * 256, 8u * (unsigned)lane);
}
template <int MIX, int MODE>
__device__ __forceinline__ void mx_epilogue(const MixP& mp, LAS unsigned char* wl, int lane, f32x16 (&O)[2], int rowc, float* OFc, bf16* Y, int ycol, const v2u (&g)[2][4], const v2u (&of)[2][4]) {
    const int m32 = lane & 31, hh = lane >> 5;
    if (MODE == 1) {
#pragma unroll
        for (int t = 0; t < 2; ++t)
#pragma unroll
            for (int s = 0; s < 4; ++s) { v2u v; v.x = pkbf(O[t][4 * s], O[t][4 * s + 1]); v.y = pkbf(O[t][4 * s + 2], O[t][4 * s + 3]); GST(v2u, (bf16*)OFc + (t * 4 + s) * 256, 8u * (unsigned)lane) = v; }
    } else {
#pragma unroll
        for (int t = 0; t < 2; ++t)
#pragma unroll
            for (int s = 0; s < 4; ++s)
#pragma unroll
                for (int j = 0; j < 4; ++j) O[t][4 * s + j] += bfx(of[t][s], j);
        float mean = 0.f;
        if (MIX == 0) { float sm = 0.f;
#pragma unroll
            for (int t = 0; t < 2; ++t)
#pragma unroll
                for (int r = 0; r < 16; ++r) sm += O[t][r];
            sm += __shfl_xor(sm, 32); mean = sm * (1.0f / 64.0f); }
        float ss = 0.f;
#pragma unroll
        for (int t = 0; t < 2; ++t)
#pragma unroll
            for (int r = 0; r < 16; ++r) { const float d = O[t][r] - mean; ss = fmaf(d, d, ss); }
        ss += __shfl_xor(ss, 32);
        const float rs = __builtin_amdgcn_rsqf(ss * (1.0f / 64.0f) + NEPS), mo = -mean * rs;
        asm volatile("" ::: "memory");
#pragma unroll
        for (int t = 0; t < 2; ++t)
#pragma unroll
            for (int s = 0; s < 4; ++s) { float y[4];
#pragma unroll
                for (int j = 0; j < 4; ++j) y[j] = fmaf(O[t][4 * s + j], rs, mo) * silu_f(bfx(g[t][s], j));
                v2u w; w.x = pkbf(y[0], y[1]); w.y = pkbf(y[2], y[3]);
                *(LAS v2u*)(wl + WL_QC + m32 * 144 + (32 * t + 8 * s + 4 * hh) * 2) = w; }
        asm volatile("" ::: "memory");
#pragma unroll
        for (int k = 0; k < 4; ++k) { const v4u w = *(const LAS v4u*)(wl + WL_QC + ((lane >> 3) + 8 * k) * 144 + (lane & 7) * 16);
            GST(v4u, Y + (size_t)(rowc + 8 * k) * 1024 + ycol, 2u * (unsigned)((lane >> 3) * 1024 + (lane & 7) * 8)) = w; }
        asm volatile("" ::: "memory");
    }
}
template <int MIX, int DIR>
__device__ __forceinline__ void mixC_stream(const MixP& mp, const MxC& c, int row0, int tpos0, int lane, LAS unsigned char* wl, f32x16 (&ST)[(MIX == 2) ? 1 : 2][2],
                                            const bf16* ds, float* OFu, bf16* Y, int ycol, int gcol) {
    f32x16 O[2];
    MxRaw r[4];
#pragma unroll
    for (int i = 0; i < 3; ++i) mx_load<MIX, true, DIR>(r[i], mp, c, row0, i);
    {
#pragma unroll
        for (int rt = 0; rt < ((MIX == 2) ? 1 : 2); ++rt)
#pragma unroll
            for (int t = 0; t < 2; ++t)
#pragma unroll
                for (int r4 = 0; r4 < 4; ++r4) { const v2u v = GLD(v2u, ds + ((rt * 2 + t) * 4 + r4) * 256, 8u * (unsigned)lane);
                    ST[rt][t][4 * r4] = bfx(v, 0); ST[rt][t][4 * r4 + 1] = bfx(v, 1); ST[rt][t][4 * r4 + 2] = bfx(v, 2); ST[rt][t][4 * r4 + 3] = bfx(v, 3); }
    }
    float rc = 1.0f, rs = 0.0f;
    if (MIX == 0 && tpos0 >= 0) { const int tpos = tpos0 + (DIR ? 63 : 0); const int pos = (lane & 32) ? (tpos & 63) : (tpos >> 6);
        const unsigned ro = 4u * (unsigned)(pos * 16 + (lane & 15)); rc = GLD(float, mp.rcos, ro); rs = GLD(float, mp.rsin, ro); }
    float P = 1.0f;
#pragma unroll 1
    for (int b4i = 0; b4i < 16; b4i += 4) {
        int b4 = b4i; asm volatile("" : "+s"(b4));
        int ln = lane; asm volatile("" : "+v"(ln));
#pragma unroll
        for (int j = 0; j < 4; ++j) {
            if (b4 < 12 || j == 0) mx_load<MIX, true, DIR>(r[(j + 3) & 3], mp, c, row0, b4 + j + 3);
            mx_batch<MIX, true, DIR>(r[j], mp, c, tpos0, ln, wl, (b4 & 4) + j, P, rc, rs);
        }
        if (b4 & 4) {
            const int ck = b4 >> 3, ch = DIR ? 1 - ck : ck; float* OFc = OFu + (size_t)ch * (12 * 2048);
            v2u g[2][4], of[2][4];
            mx_chunk<MIX, DIR, true>(wl, ln, P, ST, O); P = 1.0f;
            if (DIR) { mx_epi_gates(mp, ln, row0 + 32 * ch, gcol, g); mx_epi_of(ln, OFc, of); }
            mx_epilogue<MIX, DIR ? 2 : 1>(mp, wl, ln, O, row0 + 32 * ch, OFc, Y, ycol, g, of);
        }
    }
}
template <int MIX>
__device__ __forceinline__ void mixC_unit(const MixP& mp, const float* STG, int idx, int lane_in, float* OF, LAS unsigned char* wl, bf16* Y) {
    int lane = lane_in; asm volatile("" : "+v"(lane));
    constexpr int DK = (MIX == 2) ? 32 : 64, NRT = DK / 32;
    const int bh = idx / NSEG, sg = idx - bh * NSEG, b = bh >> 2, h = bh & 3;
    const int row0 = seg_row0(b, sg), tpos0 = seg_tpos0(sg);
    const int ycol = ((MIX == 0) ? 0 : (MIX == 1 ? 512 : 768)) + h * 64;
    const int gcol = 4 * ((MIX == 0) ? C_RG : (MIX == 1 ? C_HG : C_GG)) + h * 64;
    float* OFu = OF + ((size_t)(row0 >> 5) * 12 + MIX * 4 + h) * 2048;
    const bf16* dsb = (const bf16*)(STG + (MIX == 0 ? ST_DS0 : (MIX == 1 ? ST_DS1 : ST_DS2)));
    f32x16 ST[NRT][2];
#pragma unroll 1
    for (int dir = 0; dir < 2; ++dir) {
        asm volatile("" : "+v"(lane));
        const int m32 = lane & 31, hh = lane >> 5;
        MxC c; mx_consts<MIX>(c, mp, h, dir, lane);
        const bf16* ds = dsb + (size_t)((dir * 16 + bh) * NSEG + sg) * (DK * 64);
        if (dir == 0) mixC_stream<MIX, 0>(mp, c, row0, tpos0, lane, wl, ST, ds, OFu, Y, ycol, gcol);
        else mixC_stream<MIX, 1>(mp, c, row0, tpos0, lane, wl, ST, ds, OFu, Y, ycol, gcol);
        asm volatile("s_waitcnt vmcnt(0)" ::: "memory");
    }
}
template <int MSEL>
__device__ __forceinline__ void mix_passA(const Frame& F, const Args& a, int l) {
    const MixP mp = make_mixp(F, a, l); const S5P sp = make_s5p(F, a, l);
    float* ST = (float*)(F.ws + WS_X2);
    LAS unsigned char* wl = F.lds + F.wave * WL_BYTES; LAS float* stg = (LAS float*)wl;
    if (MSEL == 15) {
        constexpr int NMX = 3 * 4224, NS5 = 2 * 64 * NSEG;
        const int heavy = NMX - (NMX / F.NGW) * F.NGW, nlight = F.NGW - heavy;
        const int n_all = (NS5 - 4 * nlight) / F.NGW;
        for (int it = 0; ; ++it) {
            int u;
            const int nmine = NMX / F.NGW + (F.gw < heavy ? 1 : 0);
            if (it < nmine) u = F.gw + it * F.NGW;
            else if (it < nmine + n_all) u = NMX + F.gw + (it - nmine) * F.NGW;
            else { const int k2 = it - nmine - n_all; if (F.gw < heavy || k2 >= 4) {
                    const int rest0 = NMX + n_all * F.NGW + 4 * nlight; const int uu = rest0 + F.gw + (k2 - (F.gw < heavy ? 0 : 4)) * F.NGW; if (uu >= NMX + NS5) break; u = uu; }
                else u = NMX + n_all * F.NGW + (F.gw - heavy) + k2 * nlight; }
            if (u >= NMX + NS5) break;
            if (u < 4224) mixA_unit<0>(mp, ST, u, fresh_lane(), wl);
            else if (u < 2 * 4224) mixA_unit<1>(mp, ST, u - 4224, fresh_lane(), wl);
            else if (u < 3 * 4224) mixA_unit<2>(mp, ST, u - 2 * 4224, fresh_lane(), wl);
            else { const int idx = u - 3 * 4224; const int dir = idx / (64 * NSEG), rem = idx - dir * 64 * NSEG, bg = rem / NSEG, sg = rem - bg * NSEG;
                float hre = 0.f, him = 0.f;
                S5U U; s5_load_u(U, mp.P, bg >> 4, bg & 15, sg, fresh_lane()); s5_mm<0>(sp, U, bg >> 4, bg & 15, dir, sg, fresh_lane(), hre, him, nullptr, wl, nullptr);
                float* hs = ST + ST_HS + ((size_t)((dir * 64 + bg) * NSEG + sg) * 64 + fresh_lane()) * 2;
                hs[0] = hre; hs[1] = him; }
        }
        return;
    }
    if (MSEL & 1) for (int u = F.gw; u < 4224; u += F.NGW) mixA_unit<0>(mp, ST, u, fresh_lane(), wl);
    if (MSEL & 2) for (int u = F.gw; u < 4224; u += F.NGW) mixA_unit<1>(mp, ST, u, fresh_lane(), wl);
    if (MSEL & 4) for (int u = F.gw; u < 4224; u += F.NGW) mixA_unit<2>(mp, ST, u, fresh_lane(), wl);
    if (MSEL & 8) for (int idx = F.gw; idx < 2 * 64 * NSEG; idx += F.NGW) {
        const int dir = idx / (64 * NSEG), rem = idx - dir * 64 * NSEG, bg = rem / NSEG, sg = rem - bg * NSEG;
        float hre = 0.f, him = 0.f;
        S5U U; s5_load_u(U, mp.P, bg >> 4, bg & 15, sg, fresh_lane()); s5_mm<0>(sp, U, bg >> 4, bg & 15, dir, sg, fresh_lane(), hre, him, nullptr, wl, nullptr);
        float* hs = ST + ST_HS + ((size_t)((dir * 64 + bg) * NSEG + sg) * 64 + fresh_lane()) * 2;
        hs[0] = hre; hs[1] = him;
    }
}
__device__ __forceinline__ int chain_seg(int dir, int p) { return dir ? (p < 4 ? 3 - p : 135 - p) : p; }
__device__ __forceinline__ void mix_passB(const Frame& F, const Args& a, int l) {
    float* ST = (float*)(F.ws + WS_X2);
    constexpr int N0 = 32768, N1 = 32768, N2 = 16384, N3 = 8192;
    for (int e = blockIdx.x * 512 + F.tid; e < N0 + N1 + N2 + N3; e += F.G * 512) {
        if (e < N0 + N1 + N2) {
            bf16* base; const float* gb; int dir, esz;
            if (e < N0 + N1) { const int mix = e >= N0, e2 = e - mix * N0, c = e2 >> 10, el = (e2 & 1023) * 4; dir = c >> 4; esz = 4096;
                base = (bf16*)(ST + (mix ? ST_DS1 : ST_DS0)) + (size_t)c * NSEG * 4096 + el; gb = ST + (mix ? ST_G1 : ST_G0) + (size_t)c * NSEG * 64 + 32 * (el >> 11) + 8 * ((el >> 8) & 3) + 4 * ((el >> 7) & 1); }
            else { const int e2 = e - N0 - N1, c = e2 >> 9, el = (e2 & 511) * 4; dir = c >> 4; esz = 2048;
                base = (bf16*)(ST + ST_DS2) + (size_t)c * NSEG * 2048 + el; gb = ST + ST_G2 + (size_t)c * NSEG * 64 + 8 * ((el >> 8) & 3) + 4 * ((el >> 7) & 1); }
            f32x4 run = {0.f, 0.f, 0.f, 0.f};
#pragma unroll 1
            for (int p0 = 0; p0 < NSEG; p0 += 12) {
                f32x4 d[12], gm[12];
#pragma unroll
                for (int q = 0; q < 12; ++q) { const int sg = chain_seg(dir, p0 + q); const v2u w = *(const v2u*)(base + (size_t)sg * esz); d[q] = (f32x4){bfx(w, 0), bfx(w, 1), bfx(w, 2), bfx(w, 3)}; gm[q] = *(const f32x4*)(gb + sg * 64); }
#pragma unroll
                for (int q = 0; q < 12; ++q) { const int sg = chain_seg(dir, p0 + q); v2u w; w.x = pkbf(run[0], run[1]); w.y = pkbf(run[2], run[3]); *(v2u*)(base + (size_t)sg * esz) = w; run = run * gm[q] + d[q]; }
            }
        } else {
            const int e2 = e - N0 - N1 - N2, c = e2 >> 6, p = e2 & 63, dir = c >> 6, g = c & 15;
            const int dg = dir * 16 + g;
            const float lre = a.in[F.zz + I_LAMRE][(size_t)l * 2048 + dg * 64 + p], lim = a.in[F.zz + I_LAMIM][(size_t)l * 2048 + dg * 64 + p], dt = expf(a.in[F.zz + I_LOGDT][l * 32 + dg]);
            const float er = expf(lre * dt * 64.0f); const float sn = sinf(lim * dt * 64.0f), cs = cosf(lim * dt * 64.0f);
            const float ar = er * cs, ai = er * sn;
            float* base = ST + ST_HS + ((size_t)c * NSEG * 64 + p) * 2;
            float rr = 0.f, ri = 0.f;
#pragma unroll 1
            for (int q0 = 0; q0 < NSEG; q0 += 12) {
                float dr[12], di[12];
#pragma unroll
                for (int q = 0; q < 12; ++q) { const int sg = chain_seg(dir, q0 + q); dr[q] = base[(size_t)sg * 128]; di[q] = base[(size_t)sg * 128 + 1]; }
#pragma unroll
                for (int q = 0; q < 12; ++q) { const int sg = chain_seg(dir, q0 + q); base[(size_t)sg * 128] = rr; base[(size_t)sg * 128 + 1] = ri;
                    const float nr = ar * rr - ai * ri + dr[q], ni = ar * ri + ai * rr + di[q]; rr = nr; ri = ni; }
            }
        }
    }
}
template <int MSEL>
__device__ __forceinline__ void mix_passC(const Frame& F, const Args& a, int l) {
    const MixP mp = make_mixp(F, a, l); const S5P sp = make_s5p(F, a, l);
    const float* ST = (const float*)(F.ws + WS_X2);
    LAS unsigned char* wl = F.lds + F.wave * WL_BYTES;
    LAS float* stg = (LAS float*)wl; LAS float* of = (LAS float*)(wl + 9216);
    float* OF = (float*)(F.ws + WS_OF);
    bf16* Y = (bf16*)(F.ws + WS_ACT); bf16* Z = (bf16*)(F.ws + WS_Z);
    const bool keep = l < DEPTH - 1;
    constexpr int NM = 16 * NSEG;
    if (MSEL == 15) {
        constexpr int NMX = 3 * NM, NS5 = 64 * NSEG;
        const int heavy = NMX - (NMX / F.NGW) * F.NGW, nlight = F.NGW - heavy;
        for (int it = 0; ; ++it) {
            int u;
            const int nmine = NMX / F.NGW + (F.gw < heavy ? 1 : 0);
            if (it < nmine) u = F.gw + it * F.NGW;
            else { if (F.gw < heavy) break; u = NMX + (F.gw - heavy) + (it - nmine) * nlight; }
            if (u >= NMX + NS5) break;
            const int sgu = (u < 3 * NM) ? (u % NSEG) : ((u - 3 * NM) % NSEG);
            if (!keep && sgu < 4) continue;
            if (u < NM) mixC_unit<0>(mp, ST, u, fresh_lane(), OF, wl, Y);
            else if (u < 2 * NM) mixC_unit<1>(mp, ST, u - NM, fresh_lane(), OF, wl, Y);
            else if (u < 3 * NM) mixC_unit<2>(mp, ST, u - 2 * NM, fresh_lane(), OF, wl, Y);
            else { const int idx = u - 3 * NM, bg = idx / NSEG, sg = idx - bg * NSEG;
                S5U U; s5_load_u(U, mp.P, bg >> 4, bg & 15, sg, fresh_lane());
                const float* h0 = ST + ST_HS + ((size_t)((0 * 64 + bg) * NSEG + sg) * 64 + fresh_lane()) * 2;
                float hre = h0[0], him = h0[1];
                s5_mm<1>(sp, U, bg >> 4, bg & 15, 0, sg, fresh_lane(), hre, him, of, wl, Z);
                const float* h1 = ST + ST_HS + ((size_t)((1 * 64 + bg) * NSEG + sg) * 64 + fresh_lane()) * 2;
                hre = h1[0]; him = h1[1];
                s5_mm<2>(sp, U, bg >> 4, bg & 15, 1, sg, fresh_lane(), hre, him, of, wl, Z); }
        }
        return;
    }
    if (MSEL & 1) for (int u = F.gw; u < NM; u += F.NGW) { if (!keep && (u % NSEG) < 4) continue; mixC_unit<0>(mp, ST, u, fresh_lane(), OF, wl, Y); }
    if (MSEL & 2) for (int u = F.gw; u < NM; u += F.NGW) { if (!keep && (u % NSEG) < 4) continue; mixC_unit<1>(mp, ST, u, fresh_lane(), OF, wl, Y); }
    if (MSEL & 4) for (int u = F.gw; u < NM; u += F.NGW) { if (!keep && (u % NSEG) < 4) continue; mixC_unit<2>(mp, ST, u, fresh_lane(), OF, wl, Y); }
    if (MSEL & 8) for (int idx = F.gw; idx < 64 * NSEG; idx += F.NGW) {
        const int bg = idx / NSEG, sg = idx - bg * NSEG;
        if (!keep && sg < 4) continue;
        S5U U; s5_load_u(U, mp.P, bg >> 4, bg & 15, sg, fresh_lane());
        const float* h0 = ST + ST_HS + ((size_t)((0 * 64 + bg) * NSEG + sg) * 64 + fresh_lane()) * 2;
        float hre = h0[0], him = h0[1];
        s5_mm<1>(sp, U, bg >> 4, bg & 15, 0, sg, fresh_lane(), hre, him, of, wl, Z);
        const float* h1 = ST + ST_HS + ((size_t)((1 * 64 + bg) * NSEG + sg) * 64 + fresh_lane()) * 2;
        hre = h1[0]; him = h1[1];
        s5_mm<2>(sp, U, bg >> 4, bg & 15, 1, sg, fresh_lane(), hre, him, of, wl, Z);
    }
}

constexpr int NPH = 11;
template <int PH_MASK, int MSEL>
__global__ void __launch_bounds__(512, 2) mk_fwd(Args a) {
    extern __shared__ __attribute__((aligned(16))) unsigned char lds_raw[];
    Frame F;
    F.lds = (LAS unsigned char*)lds_raw;
    const int wave0 = __builtin_amdgcn_readfirstlane((int)threadIdx.x >> 6);
    F.lane = fresh_lane(); F.tid = wave0 * 64 + F.lane; F.wave = wave0;
    F.G = gridDim.x; F.gw = blockIdx.x * 8 + F.wave; F.NGW = F.G * 8; F.zz = 0; F.ws = (unsigned char*)a.in[I_WS]; F.out = (float*)a.in[I_OUT];
    volatile LAS unsigned* MISC = (volatile LAS unsigned*)(F.lds + MISC_OFF);
    for (int u = F.tid; u < 64; u += 512) ((LAS unsigned*)(F.lds + MISC_OFF))[u] = 0u;
    __syncthreads();
    XcdBarrier bar; bar.bar = (unsigned*)F.ws + CW_BAR; bar.x = 0; bar.st = nullptr;
    if (a.fused) bar = xcd_barrier_post((unsigned*)F.ws + CW_BAR, MISC + 8, F.tid);
#define SEAM() do { if (a.fused) { XcdBarrier bb = bar; asm volatile("" : "+s"(bb.bar), "+s"(bb.x)); xcd_barrier(bb, wave0 * 64 + fresh_lane()); } } while (0)
#define PHASE_BEGIN() do { int zz_ = 0; asm volatile("" : "+s"(zz_)); F.zz = zz_; F.ws = (unsigned char*)a.in[I_WS + zz_]; F.out = (float*)a.in[I_OUT + zz_]; \
        const int ln_ = fresh_lane(); const int t_ = wave0 * 64 + ln_ + zz_; F.tid = t_; F.lane = t_ & 63; F.wave = wave0 + zz_; F.G = (int)gridDim.x + zz_; F.gw = ((int)blockIdx.x + zz_) * 8 + F.wave; F.NGW = F.G * 8; \
        F.lds = (LAS unsigned char*)lds_raw + zz_; } while (0)
#define IN(k) (((PH_MASK >> (k)) & 1) && a.ph_lo <= (k) && (k) < a.ph_hi)
#ifndef DUP_PH
#define DUP_PH 0
#endif
constexpr int TAILB = 16;
#define REP(k) for (int rep_ = 0; rep_ < (((DUP_PH >> (k)) & 1) ? 2 : 1); ++rep_)
#define hb ((float*)(F.ws + WS_HB))
#define MOD ((const float*)(F.ws + WS_MOD))
#define ACT ((bf16*)(F.ws + WS_ACT))
#define PH ((bf16*)(F.ws + WS_PH))

    if (((PH_MASK >> 12) & 1) && a.do_pro) REP(12) { PHASE_BEGIN(); s5_build(F, a); prologue(F, a); SEAM(); }

#pragma unroll
    for (int l = 0; l < DEPTH; ++l) {
        if (l < a.l_lo || l >= a.l_hi) continue;
        const bool keep = l < DEPTH - 1, moe = l & 1; const int j = l >> 1;
        const int Mrows = keep ? MT : NLAT;
        if (IN(0)) { PHASE_BEGIN();
            if ((l & 1) && F.G > TAILB) {
                if ((int)blockIdx.x < TAILB) {
                    const int lp = l - 1, jp = lp >> 1;
                    int k8 = DFF / 2; asm volatile("" : "+s"(k8)); pg8::Gemm g{(const bf16*)((const unsigned char*)PH + (size_t)NLAT * DFF), (const bf16*)(F.ws + WS_W2D + (size_t)jp * 1024 * DFF), MT - NLAT, 1024, k8}; pg8::StaticOrder S; S.init(MT - NLAT, 1024, TAILB, (int)blockIdx.x);
                    EpiResid E{F.out, hb, F.out, hb, MOD + (size_t)lp * 5 * 6144 + 5 * 1024, 1.0f / WSC8, NLAT / 256};
                    pg8::gemm_phase_f8<EpiResid, pg8::StaticOrder, true, true>(F.lds, g, S, E, F.tid);
                    group_arrive((unsigned*)F.ws + CW_TAIL + (2 * l + 1) * 64, F.tid);
                } else {
                    moe_cvt_idle(F, a, j, TAILB);
                    norm_phase<0>(F, a, l, 0, NLAT, -1, 0, ((int)blockIdx.x - TAILB) * 8 + F.wave, (F.G - TAILB) * 8);
                }
                group_wait((unsigned*)F.ws + CW_BAR, (unsigned*)F.ws + CW_TAIL + (2 * l + 1) * 64, TAILB, F.tid);
                norm_phase<0>(F, a, l, 0, MT, -1, NLAT, F.gw, F.NGW);
            } else {
                if (l & 1) moe_cvt(F, a, j);
                norm_phase<0>(F, a, l, 0, MT, (l == 2) ? 1 : -1);
            }
            SEAM();
        }
        if (IN(1)) REP(1) { PHASE_BEGIN();
            pg8::Gemm g{ACT, (const bf16*)(F.ws + WS_WIN) + (size_t)l * DINP * 1024, MT, DINP, 1024}; pg8::StaticOrder S; S.init(MT, DINP, F.G, (int)blockIdx.x);
            EpiStoreP4 E{PH};
            pg8::gemm_phase<EpiStoreP4, pg8::StaticOrder, true, true>(F.lds, g, S, E, F.tid);
            SEAM();
        }
        if (IN(2)) { PHASE_BEGIN(); mix_passA<MSEL>(F, a, l); SEAM(); }
#ifdef DUP_MIX
        if (IN(2)) { PHASE_BEGIN(); mix_passA<DUP_MIX>(F, a, l); SEAM(); }
#endif
#ifdef DUP_A
        if (IN(2)) { PHASE_BEGIN(); mix_passA<DUP_A>(F, a, l); SEAM(); }
#endif
        if (IN(3)) { PHASE_BEGIN(); mix_passB(F, a, l); SEAM(); }
        if (IN(4)) { PHASE_BEGIN(); mix_passC<MSEL>(F, a, l); SEAM(); }
#ifdef DUP_MIX
        if (IN(4)) { PHASE_BEGIN(); mix_passC<DUP_MIX>(F, a, l); SEAM(); }
#endif
#ifdef DUP_C
        if (IN(4)) { PHASE_BEGIN(); mix_passC<DUP_C>(F, a, l); SEAM(); }
#endif
        if (IN(5)) REP(5) { PHASE_BEGIN();
            int k256 = 256; asm volatile("" : "+s"(k256)); pg8::Gemm g{(const bf16*)(F.ws + WS_Z), (const bf16*)(F.ws + WS_GLUW) + (size_t)l * 65536, Mrows, 256, k256}; pg8::StaticOrder S; S.init(Mrows, 256, F.G, (int)blockIdx.x);
            EpiGlu E{(const bf16*)(F.ws + WS_Z), ACT, a.in[F.zz + I_GLUB] + l * 256};
            pg8::gemm_phase<EpiGlu, pg8::StaticOrder, true, true>(F.lds, g, S, E, F.tid);
            SEAM();
        }
        const bool tail = keep && F.G > TAILB;
        if (IN(6)) { PHASE_BEGIN();
            const int Mg = tail ? NLAT : Mrows;
            pg8::Gemm g{ACT, (const bf16*)(F.ws + WS_WOUT) + (size_t)l * 1024 * 1024, Mg, 1024, 1024}; pg8::StaticOrder S; S.init(Mg, 1024, F.G, (int)blockIdx.x);
            EpiResid E{(l == 0) ? a.in[F.zz + I_X] : F.out, (l == 0) ? a.in[F.zz + I_CTX] : hb, F.out, hb, MOD + (size_t)l * 5 * 6144 + 2 * 1024, 1.0f};
            pg8::gemm_phase<EpiResid, pg8::StaticOrder, true, true>(F.lds, g, S, E, F.tid);
            SEAM();
        }
        if (IN(7)) { PHASE_BEGIN();
            if (tail) {
                if ((int)blockIdx.x < TAILB) {
                    pg8::Gemm g{ACT + (size_t)NLAT * 1024, (const bf16*)(F.ws + WS_WOUT) + (size_t)l * 1024 * 1024, MT - NLAT, 1024, 1024}; pg8::StaticOrder S; S.init(MT - NLAT, 1024, TAILB, (int)blockIdx.x);
                    EpiResid E{(l == 0) ? a.in[F.zz + I_X] : F.out, (l == 0) ? a.in[F.zz + I_CTX] : hb, F.out, hb, MOD + (size_t)l * 5 * 6144 + 2 * 1024, 1.0f, NLAT / 256};
                    pg8::gemm_phase<EpiResid, pg8::StaticOrder, true, true>(F.lds, g, S, E, F.tid);
                    group_arrive((unsigned*)F.ws + CW_TAIL + (2 * l) * 64, F.tid);
                } else {
                    if (moe) norm_phase<1>(F, a, l, 1, NLAT, -1, 0, ((int)blockIdx.x - TAILB) * 8 + F.wave, (F.G - TAILB) * 8); else norm_phase<0>(F, a, l, 1, NLAT, -1, 0, ((int)blockIdx.x - TAILB) * 8 + F.wave, (F.G - TAILB) * 8);
                }
                group_wait((unsigned*)F.ws + CW_BAR, (unsigned*)F.ws + CW_TAIL + (2 * l) * 64, TAILB, F.tid);
                if (moe) norm_phase<1>(F, a, l, 1, MT, -1, NLAT, F.gw, F.NGW); else norm_phase<0>(F, a, l, 1, MT, -1, NLAT, F.gw, F.NGW);
            } else { if (moe) norm_phase<1>(F, a, l, 1, Mrows, -1); else norm_phase<0>(F, a, l, 1, Mrows, -1); }
            SEAM();
        }
        if (!moe) {
            if (IN(8)) REP(8) { PHASE_BEGIN();
                pg8::Gemm g{ACT, (const bf16*)(F.ws + WS_W13D) + (size_t)j * 5632 * 1024, Mrows, 5632, 1024}; pg8::StaticOrder S; S.init(Mrows, 5632, F.G, (int)blockIdx.x);
                EpiSwiglu8 E{(unsigned char*)PH, 1.0f};
                pg8::gemm_phase<EpiSwiglu8, pg8::StaticOrder, true, true>(F.lds, g, S, E, F.tid);
                SEAM();
            }
            if (IN(9)) { PHASE_BEGIN();
                const int Mg = tail ? NLAT : Mrows;
                int k8 = DFF / 2; asm volatile("" : "+s"(k8)); pg8::Gemm g{PH, (const bf16*)(F.ws + WS_W2D + (size_t)j * 1024 * DFF), Mg, 1024, k8}; pg8::StaticOrder S; S.init(Mg, 1024, F.G, (int)blockIdx.x);
                EpiResid E{F.out, hb, F.out, hb, MOD + (size_t)l * 5 * 6144 + 5 * 1024, 1.0f / WSC8};
                pg8::gemm_phase_f8<EpiResid, pg8::StaticOrder, true, true>(F.lds, g, S, E, F.tid);
                if (!tail) { const int rem = ((Mrows / 256) * 4) % F.G; if (rem > 0 && (int)blockIdx.x >= rem) moe_cvt_idle(F, a, j, rem); else if (rem == 0) moe_cvt(F, a, j); }
                SEAM();
            }
        } else {
                        if (IN(8)) REP(8) { PHASE_BEGIN(); moe_gather(F, j); SEAM(); }
            if (IN(9)) REP(9) { PHASE_BEGIN();
                int k8 = 512; asm volatile("" : "+s"(k8)); pg8::Gemm g{(const bf16*)(F.ws + WS_X2), (const bf16*)(F.ws + WS_W13M), 0, 5632, k8}; MoeOrder S; S.init((const unsigned*)F.ws + CW_CNT + j * 8 * 64, 22, F.G, (int)blockIdx.x);
                EpiSwiglu8 E{(unsigned char*)PH, 1.0f / WSC8};
                pg8::gemm_phase_f8<EpiSwiglu8, MoeOrder, true, true>(F.lds, g, S, E, F.tid);
                SEAM();
            }
            if (IN(10)) REP(10) { PHASE_BEGIN();
                int k8 = DFF / 2; asm volatile("" : "+s"(k8)); pg8::Gemm g{PH, (const bf16*)(F.ws + WS_W2M), 0, 1024, k8}; MoeOrder S; S.init((const unsigned*)F.ws + CW_CNT + j * 8 * 64, 4, F.G, (int)blockIdx.x);
                EpiStoreBf16 E{(bf16*)(F.ws + WS_X2), 1024, 1.0f / WSC8};
                pg8::gemm_phase_f8<EpiStoreBf16, MoeOrder, true, true>(F.lds, g, S, E, F.tid);
                SEAM();
            }
        }
    }
    if (((PH_MASK >> 13) & 1) && a.do_fin) { PHASE_BEGIN(); norm_phase<2>(F, a, DEPTH - 1, 0, NLAT, DEPTH - 1); }
#undef SEAM
#undef IN
#undef hb
#undef MOD
#undef ACT
#undef PH
}

#ifndef MK_FUSED
#define MK_FUSED 1
#endif
template <int PM, int MS> static void launch_one(const Args& a, int grid, hipStream_t stream) {
    static bool attr_done = false;
    if (!attr_done) { (void)hipFuncSetAttribute((const void*)mk_fwd<PM, MS>, hipFuncAttributeMaxDynamicSharedMemorySize, LDS_BYTES); attr_done = true; }
    hipLaunchKernelGGL((mk_fwd<PM, MS>), dim3(grid), dim3(512), LDS_BYTES, stream, a);
}
extern "C" void kernel_launch(void* const* d_in, const int* in_sizes, int n_in, void* d_out, int out_size, void* d_ws, size_t ws_size, hipStream_t stream) {
    static int grid = 0;
    if (grid == 0) {
        if (n_in != 35 || in_sizes[0] != NLAT * DM || out_size != NLAT * DM || ws_size < WS_END) {
            fprintf(stderr, "kernel_launch: unexpected shapes / workspace (n_in %d, ws %zu, need %zu); nothing launched\n", n_in, ws_size, (size_t)WS_END); grid = -1; return; }
        int dev = 0, cus = 0;
        if (hipGetDevice(&dev) != hipSuccess || hipDeviceGetAttribute(&cus, hipDeviceAttributeMultiprocessorCount, dev) != hipSuccess) { grid = -1; return; }
        grid = cus;
    }
    if (grid < 0) return;
    (void)hipMemsetAsync((char*)d_ws + WS_CTL, 0, CTL_ZERO_BYTES, stream);
    Args a{};
    for (int i = 0; i < 35; ++i) a.in[i] = (const float*)d_in[i];
    a.in[I_OUT] = (const float*)d_out; a.in[I_WS] = (const float*)d_ws; a.pad = 0;
#if MK_FUSED
    a.l_lo = 0; a.l_hi = DEPTH; a.ph_lo = 0; a.ph_hi = NPH; a.do_pro = 1; a.do_fin = 1; a.fused = 1;
#ifndef TEST_PM
#define TEST_PM 0xFFFF
#endif
#ifndef TEST_MS
#define TEST_MS 15
#endif
    launch_one<TEST_PM, TEST_MS>(a, grid, stream);
#else
    a.fused = 0;
    a.l_lo = 0; a.l_hi = 0; a.ph_lo = 0; a.ph_hi = 0; a.do_pro = 1; a.do_fin = 0;
    launch_one<0x1000, 15>(a, grid, stream);
    a.do_pro = 0;
    for (int l = 0; l < DEPTH; ++l) {
        a.l_lo = l; a.l_hi = l + 1; a.ph_lo = 0; a.ph_hi = NPH;
        launch_one<0x1, 15>(a, grid, stream); launch_one<0x2, 15>(a, grid, stream); launch_one<0x4, 15>(a, grid, stream); launch_one<0x8, 15>(a, grid, stream);
        launch_one<0x10, 1>(a, grid, stream); launch_one<0x10, 2>(a, grid, stream); launch_one<0x10, 4>(a, grid, stream); launch_one<0x10, 8>(a, grid, stream);
        launch_one<0x20, 15>(a, grid, stream); launch_one<0x40, 15>(a, grid, stream); launch_one<0x80, 15>(a, grid, stream);
        launch_one<0x100, 15>(a, grid, stream); launch_one<0x200, 15>(a, grid, stream);
        if (l & 1) launch_one<0x400, 15>(a, grid, stream);
    }
    a.l_lo = 0; a.l_hi = 0; a.ph_lo = 0; a.ph_hi = 0; a.do_fin = 1;
    launch_one<0x2000, 15>(a, grid, stream);
#endif
}
```

```cpp
#include <hip/hip_runtime.h>
#include <cstdio>
#include <cstdint>
#define LAS __attribute__((address_space(3)))
namespace pg8 {
#define PG8_LAS __attribute__((address_space(3)))
typedef unsigned short bf16_t;
typedef short bf16x8 __attribute__((ext_vector_type(8)));
typedef float f32x4 __attribute__((ext_vector_type(4)));
typedef unsigned u32x4 __attribute__((ext_vector_type(4)));
constexpr int BM = 256, BK = 64, HALF = 128, HTB = HALF * BK * 2  , STAGE_BYTES = 8 * HTB, NXCD = 8, WGM = 8;

__host__ __device__ __forceinline__ int lds_byte(int r, int c) { const int st = (r >> 4) * 2 + (c >> 5), rr = r & 15, cc = c & 31, ob = rr * 64 + cc * 2; return st * 1024 + (ob ^ (((ob >> 9) & 1) << 5)); }
__host__ __device__ __forceinline__ void stage_rc(int b, int& R, int& C) { const int st = b / 1024, sb = b % 1024, swz = sb ^ (((sb >> 9) & 1) << 5); R = (st >> 1) * 16 + swz / 64; C = (st & 1) * 32 + (swz % 64) / 2; }
__host__ __device__ __forceinline__ int perm32(int rho) { const int n = rho >> 4, i = rho & 15; return 8 * (i >> 2) + 4 * n + (i & 3); }

__host__ __device__ __forceinline__ int perm32f(int rho) { return 2 * (rho & 15) + (rho >> 4); }
template <class E, class = void> struct epi_flip { static constexpr bool v = false; };
template <class E> struct epi_flip<E, decltype((void)E::FLIP)> { static constexpr bool v = E::FLIP; };
struct Unit { int pm, pn, pc; };
struct Gemm { const bf16_t* A; const bf16_t* Bt; int M, N, K; };

struct StaticOrder {
    int nM, nN, nwg, G, c;
    __host__ __device__ void init(int M, int N, int G_, int c_) { nM = M / BM; nN = N / BM; nwg = nM * nN; G = G_; c = c_; }
    __host__ __device__ bool next(int i, Unit& u) const {
        const long L = (long)i * G + c; if (L >= nwg) return false;
        int wgid = (int)L; { const int q = nwg / NXCD, r = nwg % NXCD, xcd = wgid % NXCD, off = wgid / NXCD; wgid = (xcd < r ? xcd * (q + 1) : r * (q + 1) + (xcd - r) * q) + off; }
        const int nig = WGM * nN, gid = wgid / nig, fm = gid * WGM, gsz = (nM - fm) < WGM ? (nM - fm) : WGM;
        u.pm = fm + ((wgid % nig) % gsz); u.pn = (wgid % nig) / gsz; u.pc = u.pn; return true;
    }
    __device__ __forceinline__ void a_ready(const Unit&) const {}
    __device__ __forceinline__ void done(const Unit&) const {}
};

__device__ __forceinline__ unsigned cvt_pk_bf16(float lo, float hi) { unsigned r; asm volatile("v_cvt_pk_bf16_f32 %0, %1, %2" : "=v"(r) : "v"(lo), "v"(hi)); return r; }
typedef float f32x2 __attribute__((ext_vector_type(2)));

template <class Epi, class Sched, bool ALIGN_EPI = false, bool SP2 = false>
__device__ __forceinline__ void gemm_phase(PG8_LAS unsigned char* lds, const Gemm g, const Sched& S, const Epi& E, const int tid) {
    const int wid = __builtin_amdgcn_readfirstlane(tid >> 6), lane = tid & 63, wr = wid >> 2, wc = wid & 3, fr = lane & 15, fq = lane >> 4;
    const int K = g.K, nt = K / BK;
    unsigned voffA[2], voffB[2];
#pragma unroll
    for (int i = 0; i < 2; ++i) { int R, C; stage_rc(tid * 16 + i * 8192, R, C); const int Rb = epi_flip<Epi>::v ? ((R & ~31) + perm32f(R & 31)) : (Epi::PERM ? ((R & ~31) + perm32(R & 31)) : R);
        voffA[i] = (unsigned)(R * K + C) * 2u; voffB[i] = (unsigned)(Rb * K + C) * 2u; }
    const size_t kstep = (size_t)(BK * 2);
    const size_t hstep = (size_t)HALF * K * 2;
    const size_t tstep = 2 * hstep;
    const unsigned ldsw = (unsigned)wid * 1024u;
    const int aoff = lds_byte(wr * 64 + fr, fq * 8), boff = lds_byte(wc * 32 + fr, fq * 8);
#define PG8_SA(b, h) (((b) * 2 + (h)) * HTB)
#define PG8_SB(b, h) ((4 + (b) * 2 + (h)) * HTB)
#define PG8_STAGE(bufoff, gbase, voff) do { _Pragma("unroll") for (int _i = 0; _i < 2; ++_i) \
        __builtin_amdgcn_global_load_lds((const unsigned*)((const char*)(gbase) + (voff)[_i]), (PG8_LAS unsigned*)(lds + (bufoff) + ldsw + _i * 8192), 16, 0, 0); } while (0)
#define PG8_LDA(dst, b, h) do { _Pragma("unroll") for (int m = 0; m < 4; ++m) _Pragma("unroll") for (int k = 0; k < 2; ++k) dst[m][k] = *(const PG8_LAS bf16x8*)(lds + PG8_SA(b, h) + aoff + m * 2048 + k * 1024); } while (0)
#define PG8_LDB(dst, b, h) do { _Pragma("unroll") for (int n = 0; n < 2; ++n) _Pragma("unroll") for (int k = 0; k < 2; ++k) dst[n][k] = *(const PG8_LAS bf16x8*)(lds + PG8_SB(b, h) + boff + n * 2048 + k * 1024); } while (0)
#define PG8_MMA(ai, bj, At, Bt) do { __builtin_amdgcn_s_setprio(1); _Pragma("unroll") for (int m = 0; m < 4; ++m) _Pragma("unroll") for (int n = 0; n < 2; ++n) _Pragma("unroll") for (int k = 0; k < 2; ++k) \
        { if constexpr (epi_flip<Epi>::v) acc[ai][bj][m][n] = __builtin_amdgcn_mfma_f32_16x16x32_bf16(At[m][k], Bt[n][k], acc[ai][bj][m][n], 0, 0, 0); \
          else acc[ai][bj][m][n] = __builtin_amdgcn_mfma_f32_16x16x32_bf16(Bt[n][k], At[m][k], acc[ai][bj][m][n], 0, 0, 0); } __builtin_amdgcn_s_setprio(0); } while (0)
#define PG8_WAIT_V(n) asm volatile("s_waitcnt vmcnt(" #n ")" ::: "memory")
#define PG8_WAIT_L(n) asm volatile("s_waitcnt lgkmcnt(" #n ")" ::: "memory")
#define PG8_BAR __builtin_amdgcn_s_barrier()
#define PG8_SCHED __builtin_amdgcn_sched_barrier(0)
    Unit cur, nxt; int ui = 0;
    if (!S.next(0, cur)) return;
    f32x4 acc[2][2][4][2];
#pragma unroll
    for (int a = 0; a < 2; ++a)
#pragma unroll
        for (int b = 0; b < 2; ++b)
#pragma unroll
            for (int m = 0; m < 4; ++m)
#pragma unroll
                for (int n = 0; n < 2; ++n) acc[a][b][m][n] = (f32x4){0.f, 0.f, 0.f, 0.f};
    bf16x8 At[4][2], B0[2][2], B1[2][2];
    const char* cA = (const char*)g.A + (size_t)cur.pm * tstep; const char* cB = (const char*)g.Bt + (size_t)cur.pn * tstep;
    S.a_ready(cur);
    if constexpr (SP2) {
        PG8_STAGE(PG8_SB(0, 0), cB, voffB); PG8_STAGE(PG8_SB(0, 1), cB + hstep, voffB); PG8_STAGE(PG8_SA(0, 0), cA, voffA); PG8_STAGE(PG8_SA(0, 1), cA + hstep, voffA);
        if (wr == 1) PG8_BAR;
        PG8_WAIT_V(2); PG8_BAR;
        PG8_STAGE(PG8_SB(1, 0), cB + kstep, voffB); PG8_STAGE(PG8_SA(1, 0), cA + kstep, voffA); PG8_STAGE(PG8_SB(1, 1), cB + hstep + kstep, voffB);
        PG8_WAIT_V(6); PG8_BAR;
    } else {
        PG8_STAGE(PG8_SB(0, 0), cB, voffB); PG8_STAGE(PG8_SA(0, 0), cA, voffA); PG8_STAGE(PG8_SB(0, 1), cB + hstep, voffB); PG8_STAGE(PG8_SA(0, 1), cA + hstep, voffA);
        if (wr == 1) PG8_BAR;
        PG8_WAIT_V(4); PG8_BAR;
        PG8_STAGE(PG8_SB(1, 0), cB + kstep, voffB); PG8_STAGE(PG8_SA(1, 0), cA + kstep, voffA); PG8_STAGE(PG8_SB(1, 1), cB + hstep + kstep, voffB);
        PG8_WAIT_V(6); PG8_BAR;
    }
    for (;;) {
        const bool has_next = S.next(ui + 1, nxt);
        const char* nA = has_next ? (const char*)g.A + (size_t)nxt.pm * tstep : cA; const char* nB = has_next ? (const char*)g.Bt + (size_t)nxt.pn * tstep : cB;
        for (int t = 0; t < nt; t += 2) {
            const bool last = (t == nt - 2);
            const char* a1 = cA + (size_t)(t + 1) * kstep;
            const char* a2 = last ? nA : cA + (size_t)(t + 2) * kstep; const char* b2 = last ? nB : cB + (size_t)(t + 2) * kstep;
            const char* a3 = a2 + kstep; const char* b3 = b2 + kstep;
            if (last && has_next) S.a_ready(nxt);
            if constexpr (SP2) {
            PG8_LDB(B0, 0, 0); PG8_LDB(B1, 0, 1); PG8_SCHED; PG8_LDA(At, 0, 0); PG8_STAGE(PG8_SA(1, 1), a1 + hstep, voffA);
            PG8_WAIT_V(8); PG8_WAIT_L(0); PG8_BAR; PG8_MMA(0, 0, At, B0); PG8_MMA(0, 1, At, B1); PG8_BAR; PG8_SCHED;
            PG8_LDA(At, 0, 1); PG8_STAGE(PG8_SB(0, 0), b2, voffB); PG8_STAGE(PG8_SB(0, 1), b2 + hstep, voffB); PG8_STAGE(PG8_SA(0, 0), a2, voffA);
            PG8_WAIT_V(8); PG8_WAIT_L(0); PG8_BAR; PG8_MMA(1, 0, At, B0); PG8_MMA(1, 1, At, B1); PG8_BAR; PG8_SCHED;
            PG8_LDB(B0, 1, 0); PG8_LDB(B1, 1, 1); PG8_SCHED; PG8_LDA(At, 1, 0); PG8_STAGE(PG8_SA(0, 1), a2 + hstep, voffA);
            PG8_WAIT_V(8); PG8_WAIT_L(0); PG8_BAR; PG8_MMA(0, 0, At, B0); PG8_MMA(0, 1, At, B1); PG8_BAR; PG8_SCHED;
            PG8_LDA(At, 1, 1); PG8_STAGE(PG8_SB(1, 0), b3, voffB); PG8_STAGE(PG8_SB(1, 1), b3 + hstep, voffB); PG8_STAGE(PG8_SA(1, 0), a3, voffA);
            PG8_WAIT_V(8); PG8_WAIT_L(0); PG8_BAR; PG8_MMA(1, 0, At, B0); PG8_MMA(1, 1, At, B1); PG8_BAR; PG8_SCHED;
            } else {
            PG8_LDB(B0, 0, 0); PG8_SCHED; PG8_LDA(At, 0, 0); PG8_STAGE(PG8_SA(1, 1), a1 + hstep, voffA);
            PG8_WAIT_L(8); PG8_BAR; PG8_WAIT_L(0); PG8_MMA(0, 0, At, B0); PG8_BAR; PG8_SCHED;
            PG8_LDB(B1, 0, 1); PG8_STAGE(PG8_SB(0, 0), b2, voffB);
            PG8_BAR; PG8_WAIT_L(0); PG8_MMA(0, 1, At, B1); PG8_BAR;
            PG8_LDA(At, 0, 1); PG8_STAGE(PG8_SA(0, 0), a2, voffA);
            PG8_BAR; PG8_WAIT_L(0); PG8_MMA(1, 0, At, B0); PG8_BAR; PG8_SCHED;
            PG8_STAGE(PG8_SB(0, 1), b2 + hstep, voffB);
            PG8_WAIT_V(6); PG8_BAR; PG8_MMA(1, 1, At, B1); PG8_BAR;
            PG8_LDB(B0, 1, 0); PG8_SCHED; PG8_LDA(At, 1, 0); PG8_STAGE(PG8_SA(0, 1), a2 + hstep, voffA);
            PG8_WAIT_L(8); PG8_BAR; PG8_WAIT_L(0); PG8_MMA(0, 0, At, B0); PG8_BAR; PG8_SCHED;
            PG8_LDB(B1, 1, 1); PG8_STAGE(PG8_SB(1, 0), b3, voffB);
            PG8_BAR; PG8_WAIT_L(0); PG8_MMA(0, 1, At, B1); PG8_BAR;
            PG8_LDA(At, 1, 1); PG8_STAGE(PG8_SA(1, 0), a3, voffA);
            PG8_BAR; PG8_WAIT_L(0); PG8_MMA(1, 0, At, B0); PG8_BAR; PG8_SCHED;
            PG8_STAGE(PG8_SB(1, 1), b3 + hstep, voffB);
            PG8_WAIT_V(6); PG8_BAR; PG8_MMA(1, 1, At, B1); PG8_BAR;
            }
        }
        if constexpr (ALIGN_EPI) { if (wr == 0) PG8_BAR; }
        if constexpr (!Epi::AFTER_DRAIN) { E(acc, cur, wr, wc, fr, fq); S.done(cur); }
        if (!has_next) break;
#pragma unroll
        for (int a = 0; a < 2; ++a)
#pragma unroll
            for (int b = 0; b < 2; ++b)
#pragma unroll
                for (int m = 0; m < 4; ++m)
#pragma unroll
                    for (int n = 0; n < 2; ++n) acc[a][b][m][n] = (f32x4){0.f, 0.f, 0.f, 0.f};
        cur = nxt; cA = nA; cB = nB; ++ui;
        if constexpr (ALIGN_EPI) { if (wr == 1) PG8_BAR; }
    }
    PG8_WAIT_V(0);
    if constexpr (!ALIGN_EPI) { if (wr == 0) PG8_BAR; }
    PG8_BAR;
    if constexpr (Epi::AFTER_DRAIN) { E.fused(acc, cur, wr, wc, fr, fq, lds, wid, lane); S.done(cur); }
#undef PG8_SA
#undef PG8_SB
#undef PG8_STAGE
#undef PG8_LDA
#undef PG8_LDB
#undef PG8_MMA
#undef PG8_WAIT_V
#undef PG8_WAIT_L
#undef PG8_BAR
#undef PG8_SCHED
}
typedef int v8i_t __attribute__((ext_vector_type(8)));
typedef int v4i_t __attribute__((ext_vector_type(4)));
template <class Epi, class Sched, bool ALIGN_EPI = false, bool SP2 = false>
__device__ __forceinline__ void gemm_phase_f8(PG8_LAS unsigned char* lds, const Gemm g, const Sched& S, const Epi& E, const int tid) {
    const int wid = __builtin_amdgcn_readfirstlane(tid >> 6), lane = tid & 63, wr = wid >> 2, wc = wid & 3, fr = lane & 15, fq = lane >> 4;
    const int K = g.K, nt = K / BK;
    unsigned voffA[2], voffB[2];
#pragma unroll
    for (int i = 0; i < 2; ++i) { int R, C; stage_rc(tid * 16 + i * 8192, R, C); const int Rb = Epi::PERM ? ((R & ~31) + perm32(R & 31)) : R;
        voffA[i] = (unsigned)(R * K + C) * 2u; voffB[i] = (unsigned)(Rb * K + C) * 2u; }
    const size_t kstep = (size_t)(BK * 2);
    const size_t hstep = (size_t)HALF * K * 2;
    const size_t tstep = 2 * hstep;
    const unsigned ldsw = (unsigned)wid * 1024u;
    const int aoff0 = lds_byte(wr * 64 + fr, fq * 16), aoff1 = lds_byte(wr * 64 + fr, fq * 16 + 8), boff0 = lds_byte(wc * 32 + fr, fq * 16), boff1 = lds_byte(wc * 32 + fr, fq * 16 + 8);
#define PG8_SA(b, h) (((b) * 2 + (h)) * HTB)
#define PG8_SB(b, h) ((4 + (b) * 2 + (h)) * HTB)
#define PG8_STAGE(bufoff, gbase, voff) do { _Pragma("unroll") for (int _i = 0; _i < 2; ++_i) \
        __builtin_amdgcn_global_load_lds((const unsigned*)((const char*)(gbase) + (voff)[_i]), (PG8_LAS unsigned*)(lds + (bufoff) + ldsw + _i * 8192), 16, 0, 0); } while (0)
#define PG8_LDA(dst, b, h) do { _Pragma("unroll") for (int m = 0; m < 4; ++m) { const u32x4 lo_ = *(const PG8_LAS u32x4*)(lds + PG8_SA(b, h) + aoff0 + m * 2048), hi_ = *(const PG8_LAS u32x4*)(lds + PG8_SA(b, h) + aoff1 + m * 2048); \
        dst[m] = __builtin_shufflevector((v4i_t)lo_, (v4i_t)hi_, 0, 1, 2, 3, 4, 5, 6, 7); } } while (0)
#define PG8_LDB(dst, b, h) do { _Pragma("unroll") for (int n = 0; n < 2; ++n) { const u32x4 lo_ = *(const PG8_LAS u32x4*)(lds + PG8_SB(b, h) + boff0 + n * 2048), hi_ = *(const PG8_LAS u32x4*)(lds + PG8_SB(b, h) + boff1 + n * 2048); \
        dst[n] = __builtin_shufflevector((v4i_t)lo_, (v4i_t)hi_, 0, 1, 2, 3, 4, 5, 6, 7); } } while (0)
#define PG8_MMA(ai, bj, At, Bt) do { __builtin_amdgcn_s_setprio(1); _Pragma("unroll") for (int m = 0; m < 4; ++m) _Pragma("unroll") for (int n = 0; n < 2; ++n) \
        asm volatile("v_mfma_scale_f32_16x16x128_f8f6f4 %0, %1, %2, %0, %3, %3 op_sel_hi:[0,0,0]" : "+v"(acc[ai][bj][m][n]) : "v"(Bt[n]), "v"(At[m]), "v"(one_scale)); __builtin_amdgcn_s_setprio(0); } while (0)
#define PG8_WAIT_V(n) asm volatile("s_waitcnt vmcnt(" #n ")" ::: "memory")
#define PG8_WAIT_L(n) asm volatile("s_waitcnt lgkmcnt(" #n ")" ::: "memory")
#define PG8_BAR __builtin_amdgcn_s_barrier()
#define PG8_SCHED __builtin_amdgcn_sched_barrier(0)
    Unit cur, nxt; int ui = 0;
    if (!S.next(0, cur)) return;
    f32x4 acc[2][2][4][2];
#pragma unroll
    for (int a = 0; a < 2; ++a)
#pragma unroll
        for (int b = 0; b < 2; ++b)
#pragma unroll
            for (int m = 0; m < 4; ++m)
#pragma unroll
                for (int n = 0; n < 2; ++n) acc[a][b][m][n] = (f32x4){0.f, 0.f, 0.f, 0.f};
    v8i_t At[4], B0[2], B1[2]; const int one_scale = 0x7f7f7f7f;
    const char* cA = (const char*)g.A + (size_t)cur.pm * tstep; const char* cB = (const char*)g.Bt + (size_t)cur.pn * tstep;
    S.a_ready(cur);
    if constexpr (SP2) {
        PG8_STAGE(PG8_SB(0, 0), cB, voffB); PG8_STAGE(PG8_SB(0, 1), cB + hstep, voffB); PG8_STAGE(PG8_SA(0, 0), cA, voffA); PG8_STAGE(PG8_SA(0, 1), cA + hstep, voffA);
        if (wr == 1) PG8_BAR;
        PG8_WAIT_V(2); PG8_BAR;
        PG8_STAGE(PG8_SB(1, 0), cB + kstep, voffB); PG8_STAGE(PG8_SA(1, 0), cA + kstep, voffA); PG8_STAGE(PG8_SB(1, 1), cB + hstep + kstep, voffB);
        PG8_WAIT_V(6); PG8_BAR;
    } else {
        PG8_STAGE(PG8_SB(0, 0), cB, voffB); PG8_STAGE(PG8_SA(0, 0), cA, voffA); PG8_STAGE(PG8_SB(0, 1), cB + hstep, voffB); PG8_STAGE(PG8_SA(0, 1), cA + hstep, voffA);
        if (wr == 1) PG8_BAR;
        PG8_WAIT_V(4); PG8_BAR;
        PG8_STAGE(PG8_SB(1, 0), cB + kstep, voffB); PG8_STAGE(PG8_SA(1, 0), cA + kstep, voffA); PG8_STAGE(PG8_SB(1, 1), cB + hstep + kstep, voffB);
        PG8_WAIT_V(6); PG8_BAR;
    }
    for (;;) {
        const bool has_next = S.next(ui + 1, nxt);
        const char* nA = has_next ? (const char*)g.A + (size_t)nxt.pm * tstep : cA; const char* nB = has_next ? (const char*)g.Bt + (size_t)nxt.pn * tstep : cB;
        for (int t = 0; t < nt; t += 2) {
            const bool last = (t == nt - 2);
            const char* a1 = cA + (size_t)(t + 1) * kstep;
            const char* a2 = last ? nA : cA + (size_t)(t + 2) * kstep; const char* b2 = last ? nB : cB + (size_t)(t + 2) * kstep;
            const char* a3 = a2 + kstep; const char* b3 = b2 + kstep;
            if (last && has_next) S.a_ready(nxt);
            if constexpr (SP2) {
            PG8_LDB(B0, 0, 0); PG8_LDB(B1, 0, 1); PG8_SCHED; PG8_LDA(At, 0, 0); PG8_STAGE(PG8_SA(1, 1), a1 + hstep, voffA);
            PG8_WAIT_V(8); PG8_WAIT_L(0); PG8_BAR; PG8_MMA(0, 0, At, B0); PG8_MMA(0, 1, At, B1); PG8_BAR; PG8_SCHED;
            PG8_LDA(At, 0, 1); PG8_STAGE(PG8_SB(0, 0), b2, voffB); PG8_STAGE(PG8_SB(0, 1), b2 + hstep, voffB); PG8_STAGE(PG8_SA(0, 0), a2, voffA);
            PG8_WAIT_V(8); PG8_WAIT_L(0); PG8_BAR; PG8_MMA(1, 0, At, B0); PG8_MMA(1, 1, At, B1); PG8_BAR; PG8_SCHED;
            PG8_LDB(B0, 1, 0); PG8_LDB(B1, 1, 1); PG8_SCHED; PG8_LDA(At, 1, 0); PG8_STAGE(PG8_SA(0, 1), a2 + hstep, voffA);
            PG8_WAIT_V(8); PG8_WAIT_L(0); PG8_BAR; PG8_MMA(0, 0, At, B0); PG8_MMA(0, 1, At, B1); PG8_BAR; PG8_SCHED;
            PG8_LDA(At, 1, 1); PG8_STAGE(PG8_SB(1, 0), b3, voffB); PG8_STAGE(PG8_SB(1, 1), b3 + hstep, voffB); PG8_STAGE(PG8_SA(1, 0), a3, voffA);
            PG8_WAIT_V(8); PG8_WAIT_L(0); PG8_BAR; PG8_MMA(1, 0, At, B0); PG8_MMA(1, 1, At, B1); PG8_BAR; PG8_SCHED;
            } else {
            PG8_LDB(B0, 0, 0); PG8_SCHED; PG8_LDA(At, 0, 0); PG8_STAGE(PG8_SA(1, 1), a1 + hstep, voffA);
            PG8_WAIT_L(8); PG8_BAR; PG8_WAIT_L(0); PG8_MMA(0, 0, At, B0); PG8_BAR; PG8_SCHED;
            PG8_LDB(B1, 0, 1); PG8_STAGE(PG8_SB(0, 0), b2, voffB);
            PG8_BAR; PG8_WAIT_L(0); PG8_MMA(0, 1, At, B1); PG8_BAR;
            PG8_LDA(At, 0, 1); PG8_STAGE(PG8_SA(0, 0), a2, voffA);
            PG8_BAR; PG8_WAIT_L(0); PG8_MMA(1, 0, At, B0); PG8_BAR; PG8_SCHED;
            PG8_STAGE(PG8_SB(0, 1), b2 + hstep, voffB);
            PG8_WAIT_V(6); PG8_BAR; PG8_MMA(1, 1, At, B1); PG8_BAR;
            PG8_LDB(B0, 1, 0); PG8_SCHED; PG8_LDA(At, 1, 0); PG8_STAGE(PG8_SA(0, 1), a2 + hstep, voffA);
            PG8_WAIT_L(8); PG8_BAR; PG8_WAIT_L(0); PG8_MMA(0, 0, At, B0); PG8_BAR; PG8_SCHED;
            PG8_LDB(B1, 1, 1); PG8_STAGE(PG8_SB(1, 0), b3, voffB);
            PG8_BAR; PG8_WAIT_L(0); PG8_MMA(0, 1, At, B1); PG8_BAR;
            PG8_LDA(At, 1, 1); PG8_STAGE(PG8_SA(1, 0), a3, voffA);
            PG8_BAR; PG8_WAIT_L(0); PG8_MMA(1, 0, At, B0); PG8_BAR; PG8_SCHED;
            PG8_STAGE(PG8_SB(1, 1), b3 + hstep, voffB);
            PG8_WAIT_V(6); PG8_BAR; PG8_MMA(1, 1, At, B1); PG8_BAR;
            }
        }
        if constexpr (ALIGN_EPI) { if (wr == 0) PG8_BAR; }
        asm volatile("s_nop 15\n\ts_nop 15" ::: "memory");
        if constexpr (!Epi::AFTER_DRAIN) { E(acc, cur, wr, wc, fr, fq); S.done(cur); }
        if (!has_next) break;
#pragma unroll
        for (int a = 0; a < 2; ++a)
#pragma unroll
            for (int b = 0; b < 2; ++b)
#pragma unroll
                for (int m = 0; m < 4; ++m)
#pragma unroll
                    for (int n = 0; n < 2; ++n) acc[a][b][m][n] = (f32x4){0.f, 0.f, 0.f, 0.f};
        cur = nxt; cA = nA; cB = nB; ++ui;
        if constexpr (ALIGN_EPI) { if (wr == 1) PG8_BAR; }
    }
    PG8_WAIT_V(0);
    if constexpr (!ALIGN_EPI) { if (wr == 0) PG8_BAR; }
    PG8_BAR;
    if constexpr (Epi::AFTER_DRAIN) { E.fused(acc, cur, wr, wc, fr, fq, lds, wid, lane); S.done(cur); }
#undef PG8_SA
#undef PG8_SB
#undef PG8_STAGE
#undef PG8_LDA
#undef PG8_LDB
#undef PG8_MMA
#undef PG8_WAIT_V
#undef PG8_WAIT_L
#undef PG8_BAR
#undef PG8_SCHED
}
}

#define XB_TMO      128
#define XB_XCNT(j)  (256  + 64 * (j))
#define XB_XSUB(j)  (1280 + 64 * (j))
#define XB_XGEN(j)  (2304 + 64 * (j))
#define XB_TOP      3328
#define XB_TOPGEN   3392
#define XCD_BAR_WORDS 3456
#define XB_SPIN_CAP (1u << 18)

__device__ __forceinline__ unsigned xb_ld(unsigned* p)              { return __hip_atomic_load(p, __ATOMIC_RELAXED, __HIP_MEMORY_SCOPE_AGENT); }
__device__ __forceinline__ unsigned xb_add(unsigned* p, unsigned v) { return __hip_atomic_fetch_add(p, v, __ATOMIC_RELAXED, __HIP_MEMORY_SCOPE_AGENT); }
__device__ __forceinline__ unsigned xb_xcc_id() { return (unsigned)__builtin_amdgcn_s_getreg((3 << 11) | 20) & 0xFu; }
#define XB_SPIN(cond, bar) do { unsigned _sp = 0; while (cond) { __builtin_amdgcn_s_sleep(1); \
    if ((++_sp & 255u) == 0u) { if (xb_ld(&(bar)[XB_TMO])) break; if (_sp > XB_SPIN_CAP) { atomicAdd(&(bar)[XB_TMO], 1u); break; } } } } while (0)

struct XcdBarrier {
    unsigned* bar; unsigned x;
    volatile LAS unsigned* st;
};

__device__ __forceinline__ XcdBarrier xcd_barrier_post(unsigned* bar, volatile LAS unsigned* st, const int xb_tid) {
    XcdBarrier b; b.bar = bar; b.x = xb_xcc_id(); b.st = st;
    if (xb_tid == 0) (void)xb_add(&bar[XB_XCNT(b.x)], 1u);
    return b;
}
__device__ __forceinline__ void xcd_barrier_complete(unsigned* bar, unsigned x, unsigned& nloc, unsigned& nx) {
    const unsigned G = gridDim.x * gridDim.y * gridDim.z;
    unsigned sum, cnt, mine, sp = 0u;
    for (;;) {
        sum = 0u; cnt = 0u; mine = 0u;
#pragma unroll
        for (unsigned j = 0; j < 16; ++j) { const unsigned c = xb_ld(&bar[XB_XCNT(j)]); sum += c; cnt += (c > 0u) ? 1u : 0u; mine = (j == x) ? c : mine; }
        if (sum == G) break;
        __builtin_amdgcn_s_sleep(1);
        if ((++sp & 255u) == 0u) { if (xb_ld(&bar[XB_TMO])) break; if (sp > XB_SPIN_CAP) { atomicAdd(&bar[XB_TMO], 1u); break; } }
    }
    nloc = mine > 0u ? mine : 1u; nx = cnt > 0u ? cnt : 1u;
}

__device__ __forceinline__ void xcd_barrier(const XcdBarrier& b, const int xb_tid) {
    asm volatile("s_waitcnt vmcnt(0)" ::: "memory");
    __syncthreads();
    if (xb_tid == 0) {
        unsigned* bar = b.bar;
        __builtin_amdgcn_s_waitcnt(0);
        unsigned nloc = b.st[0], nx = b.st[1];
        if (nloc == 0u) { xcd_barrier_complete(bar, b.x, nloc, nx); b.st[0] = nloc; b.st[1] = nx; }
        const unsigned old = xb_add(&bar[XB_XSUB(b.x)], 1u);
        const unsigned gen = old / nloc;
        if (old + 1u == (gen + 1u) * nloc) {
            __builtin_amdgcn_fence(__ATOMIC_RELEASE, "agent");
            asm volatile("s_waitcnt vmcnt(0)" ::: "memory");
            const unsigned og = xb_add(&bar[XB_TOP], 1u);
            const unsigned tg = og / nx;
            if (og + 1u == (tg + 1u) * nx) xb_add(&bar[XB_TOPGEN], 1u);
            else XB_SPIN(xb_ld(&bar[XB_TOPGEN]) == tg, bar);
            __builtin_amdgcn_fence(__ATOMIC_ACQUIRE, "agent");
            xb_add(&bar[XB_XGEN(b.x)], 1u);
            asm volatile("s_waitcnt vmcnt(0)" ::: "memory");
        } else {
            XB_SPIN(xb_ld(&bar[XB_XGEN(b.x)]) == gen, bar);
            __builtin_amdgcn_fence(__ATOMIC_ACQUIRE, "agent");
            asm volatile("s_waitcnt vmcnt(0)" ::: "memory");
        }
    }
    __syncthreads();
}

__device__ __forceinline__ void group_arrive(unsigned* cnt, const int xb_tid) {
    asm volatile("s_waitcnt vmcnt(0)" ::: "memory");
    __syncthreads();
    if (xb_tid == 0) {
        __builtin_amdgcn_s_waitcnt(0);
        __builtin_amdgcn_fence(__ATOMIC_RELEASE, "agent");
        asm volatile("s_waitcnt vmcnt(0)" ::: "memory");
        (void)xb_add(cnt, 1u);
    }
}
__device__ __forceinline__ void group_wait(unsigned* bar, unsigned* cnt, unsigned n, const int xb_tid) {
    __syncthreads();
    if (xb_tid == 0) {
        XB_SPIN(xb_ld(cnt) < n, bar);
        __builtin_amdgcn_fence(__ATOMIC_ACQUIRE, "agent");
        asm volatile("s_waitcnt vmcnt(0)" ::: "memory");
    }
    __syncthreads();
}

#define GAS __attribute__((address_space(1)))
typedef unsigned short bf16;
typedef unsigned v4u __attribute__((ext_vector_type(4)));
typedef unsigned v2u __attribute__((ext_vector_type(2)));
typedef float f32x4 __attribute__((ext_vector_type(4)));

constexpr int NB = 4, SEQ = 8192, DM = 1024, DEPTH = 4, CTXL = 256;
constexpr int NLAT = NB * SEQ, NCTX = NB * CTXL, MT = NLAT + NCTX;
constexpr int DIN = 3360, DINP = 3584, DFF = 2816, NEXP = 8;
constexpr int C_RQ = 0, C_RK = 256, C_RV = 512, C_RG = 768, C_S5 = 1024, C_HQ = 1280, C_HFF = 1536, C_HFB = 1792, C_HI = 2048, C_HG = 2304,
              C_GQ = 2560, C_GK = 2688, C_GV = 2816, C_GG = 3072, C_GAF = 3328, C_GAB = 3344,
              C_GZF = 3328, C_GZB = 3456;
constexpr int NSEG = 132;
constexpr int MOE_CAP_TILES = 272;
constexpr float NEPS = 1e-6f;
constexpr float WSC8 = 64.0f;

constexpr size_t MiB = 1u << 20;
constexpr size_t WS_CTL = 0, CTL_ZERO_BYTES = 2 * MiB;
constexpr size_t WS_MOD = 2 * MiB;
constexpr size_t WS_LB = 3 * MiB;
constexpr size_t WS_ROPE = 3 * MiB + 65536;
constexpr size_t WS_GLUW = 3 * MiB + 131072;
constexpr size_t WS_WIN = 4 * MiB;
constexpr size_t WS_WOUT = 32 * MiB;
constexpr size_t WS_W13D = 40 * MiB;
constexpr size_t WS_W2D = 62 * MiB;
constexpr size_t WS_W13M = 73 * MiB;
constexpr size_t WS_W2M = 161 * MiB;
constexpr size_t WS_HB = 205 * MiB;
constexpr size_t WS_ACT = 209 * MiB;
constexpr size_t WS_Z = 275 * MiB;
constexpr size_t WS_PH = 292 * MiB;
constexpr size_t WS_OF = (292 + 232) * MiB;
constexpr size_t WS_X2 = 666 * MiB;
constexpr size_t WS_LIST = 843 * MiB;
constexpr size_t WS_S5PAR = 70 * MiB;
constexpr size_t WS_END = 846 * MiB;
constexpr size_t ST_DS0 = 0;
constexpr size_t ST_DS1 = ST_DS0 + (size_t)2 * 16 * NSEG * 4096;
constexpr size_t ST_DS2 = ST_DS1 + (size_t)2 * 16 * NSEG * 4096;
constexpr size_t ST_G0 = ST_DS2 + (size_t)2 * 16 * NSEG * 2048;
constexpr size_t ST_G1 = ST_G0 + (size_t)2 * 16 * NSEG * 64;
constexpr size_t ST_G2 = ST_G1 + (size_t)2 * 16 * NSEG * 64;
constexpr size_t ST_HS = ST_G2 + (size_t)2 * 16 * NSEG * 64;
constexpr size_t ST_END = ST_HS + (size_t)2 * 64 * NSEG * 128;
static_assert(ST_END * 4 <= (WS_LIST - WS_X2), "state region");
static_assert(WS_PH + (size_t)MT * DINP * 2 <= WS_OF && WS_OF + (size_t)MT * 768 * 4 <= WS_X2, "OF region");
static_assert((size_t)MOE_CAP_TILES * 256 * 1024 * 2 <= (WS_LIST - WS_X2), "XB region");
static_assert((size_t)MOE_CAP_TILES * 256 * DFF * 2 <= (WS_X2 - WS_PH) && (size_t)MT * DINP * 2 <= (WS_X2 - WS_PH), "P/H region");
constexpr int CW_BAR = 4096;
constexpr int FP8_F1_J = 1;
constexpr int CW_TAIL = 32768;
constexpr int CW_CNT = 16384;

constexpr int LDS_BYTES = 163840;
constexpr int MISC_OFF = 163840 - 512;

__device__ __forceinline__ float bf2f(unsigned short h) { return __uint_as_float(((unsigned)h) << 16); }
__device__ __forceinline__ unsigned f2bf(float f) { unsigned u = __float_as_uint(f); return (u + 0x7fffu + ((u >> 16) & 1u)) >> 16; }
__device__ __forceinline__ unsigned pk2(float lo, float hi) { return f2bf(lo) | (f2bf(hi) << 16); }
__device__ __forceinline__ float wave_sum(float v) {
#define WS_DPP(ctrl, rmask) v += __int_as_float(__builtin_amdgcn_update_dpp(0, __float_as_int(v), (ctrl), (rmask), 0xf, false))
    WS_DPP(0x111, 0xf); WS_DPP(0x112, 0xf); WS_DPP(0x114, 0xf); WS_DPP(0x118, 0xf); WS_DPP(0x142, 0xa); WS_DPP(0x143, 0xc);
#undef WS_DPP
    return __int_as_float(__builtin_amdgcn_readlane(__float_as_int(v), 63));
}
__device__ __forceinline__ float rdl(float v, int k) { return __uint_as_float((unsigned)__builtin_amdgcn_readlane((int)__float_as_uint(v), k)); }
__device__ __forceinline__ float sigm(float x) { return __builtin_amdgcn_rcpf(1.0f + __expf(-x)); }
__device__ __forceinline__ float silu_f(float x) { return x * __builtin_amdgcn_rcpf(1.0f + __expf(-x)); }
#define LDS_WAIT() asm volatile("s_waitcnt lgkmcnt(0)" ::: "memory")

struct Args {
    const float* in[37];
    int l_lo, l_hi, ph_lo, ph_hi, do_pro, do_fin, fused, pad;
};
constexpr int I_OUT = 35, I_WS = 36;
enum { I_X = 0, I_C, I_CTX, I_CCTX, I_ADAW, I_ADAB, I_N1W, I_N2W, I_WIN, I_WOUT, I_RETGN, I_LAMRE, I_LAMIM, I_LOGDT, I_BRE, I_BIM, I_CRE, I_CIM, I_S5D,
       I_GLUW, I_GLUB, I_LBL, I_HGNW, I_WA2, I_BA, I_GLANW, I_FW1, I_FW3, I_FW2, I_RW, I_RB, I_MW1, I_MW3, I_MW2, I_FINW };

struct Frame {
    LAS unsigned char* lds;
    int tid, lane, wave, gw, NGW, G, zz;
    unsigned char* ws; float* out;
};

struct EpiStoreBf16 {
    static constexpr bool PERM = true, AFTER_DRAIN = false;
    bf16* O; int ldc; float sc;
    __device__ __forceinline__ void operator()(const pg8::f32x4 (&acc)[2][2][4][2], const pg8::Unit& u, int wr, int wc, int fr, int fq) const {
        const int row0 = u.pm * 256 + wr * 64 + fr, col0 = u.pc * 256 + wc * 32 + 8 * fq;
#pragma unroll
        for (int ai = 0; ai < 2; ++ai)
#pragma unroll
            for (int m = 0; m < 4; ++m) { bf16* rowp = O + (size_t)(row0 + ai * 128 + m * 16) * ldc + col0;
#pragma unroll
                for (int bj = 0; bj < 2; ++bj) { const pg8::f32x4 v0 = acc[ai][bj][m][0] * sc, v1 = acc[ai][bj][m][1] * sc;
                    pg8::u32x4 w; w.x = pg8::cvt_pk_bf16(v0[0], v0[1]); w.y = pg8::cvt_pk_bf16(v0[2], v0[3]); w.z = pg8::cvt_pk_bf16(v1[0], v1[1]); w.w = pg8::cvt_pk_bf16(v1[2], v1[3]);
                    *(pg8::u32x4*)(rowp + bj * 128) = w; } }
    }
};
constexpr int P4G = 4 * DINP, P4S5 = 4096;
struct EpiStoreP4 {
    static constexpr bool PERM = true, FLIP = true, AFTER_DRAIN = false;
    bf16* O;
    __device__ __forceinline__ void operator()(const pg8::f32x4 (&acc)[2][2][4][2], const pg8::Unit& u, int wr, int wc, int fr, int fq) const {
        const int grp0 = u.pm * 64 + wr * 16 + fq;
        if (!(u.pc == 3 || u.pc == 4 || u.pc == 9 || u.pc == 12)) {
            bf16* base = O + (size_t)grp0 * P4G + (size_t)(u.pc * 256 + wc * 32 + 2 * fr) * 4;
#pragma unroll
            for (int ai = 0; ai < 2; ++ai)
#pragma unroll
                for (int m = 0; m < 4; ++m) { bf16* gp = base + (size_t)(ai * 32 + m * 4) * P4G;
#pragma unroll
                    for (int bj = 0; bj < 2; ++bj) { const pg8::f32x4 v0 = acc[ai][bj][m][0], v1 = acc[ai][bj][m][1];
                        pg8::u32x4 w; w.x = pg8::cvt_pk_bf16(v0[0], v0[1]); w.y = pg8::cvt_pk_bf16(v0[2], v0[3]); w.z = pg8::cvt_pk_bf16(v1[0], v1[1]); w.w = pg8::cvt_pk_bf16(v1[2], v1[3]);
                        *(pg8::u32x4*)(gp + bj * 512) = w; } }
        } else {
            bf16* base = O + (size_t)grp0 * P4G + u.pc * 1024 + wc * 32 + 2 * fr;
#pragma unroll
            for (int ai = 0; ai < 2; ++ai)
#pragma unroll
                for (int m = 0; m < 4; ++m) { bf16* gp = base + (size_t)(ai * 32 + m * 4) * P4G;
#pragma unroll
                    for (int bj = 0; bj < 2; ++bj)
#pragma unroll
                        for (int r = 0; r < 4; ++r) *(unsigned*)(gp + r * 256 + bj * 128) = pg8::cvt_pk_bf16(acc[ai][bj][m][0][r], acc[ai][bj][m][1][r]); }
        }
    }
};
struct EpiSwiglu {
    static constexpr bool PERM = true, AFTER_DRAIN = false;
    bf16* H;
    __device__ __forceinline__ void operator()(const pg8::f32x4 (&acc)[2][2][4][2], const pg8::Unit& u, int wr, int wc, int fr, int fq) const {
        const int row0 = u.pm * 256 + wr * 64 + fr, col0 = u.pc * 128 + wc * 32 + 8 * fq;
#pragma unroll
        for (int ai = 0; ai < 2; ++ai)
#pragma unroll
            for (int m = 0; m < 4; ++m) { bf16* rowp = H + (size_t)(row0 + ai * 128 + m * 16) * DFF + col0;
                float h[8];
#pragma unroll
                for (int n = 0; n < 2; ++n)
#pragma unroll
                    for (int j = 0; j < 4; ++j) { const float a = acc[ai][0][m][n][j], b = acc[ai][1][m][n][j];
                        h[n * 4 + j] = a * __builtin_amdgcn_rcpf(1.0f + __builtin_amdgcn_exp2f(-1.4426950408889634f * a)) * b; }
                pg8::u32x4 w; w.x = pg8::cvt_pk_bf16(h[0], h[1]); w.y = pg8::cvt_pk_bf16(h[2], h[3]); w.z = pg8::cvt_pk_bf16(h[4], h[5]); w.w = pg8::cvt_pk_bf16(h[6], h[7]);
                *(pg8::u32x4*)rowp = w; }
    }
};
struct EpiSwiglu8 {
    static constexpr bool PERM = true, AFTER_DRAIN = false;
    unsigned char* H; float sc;
    __device__ __forceinline__ void operator()(const pg8::f32x4 (&acc)[2][2][4][2], const pg8::Unit& u, int wr, int wc, int fr, int fq) const {
        const int row0 = u.pm * 256 + wr * 64 + fr, col0 = u.pc * 128 + wc * 32 + 8 * fq;
#pragma unroll
        for (int ai = 0; ai < 2; ++ai)
#pragma unroll
            for (int m = 0; m < 4; ++m) { unsigned char* rowp = H + (size_t)(row0 + ai * 128 + m * 16) * DFF + col0;
                float h[8];
#pragma unroll
                for (int n = 0; n < 2; ++n)
#pragma unroll
                    for (int j = 0; j < 4; ++j) { const float a = acc[ai][0][m][n][j] * sc, b = acc[ai][1][m][n][j] * sc;
                        const float hv = a * __builtin_amdgcn_rcpf(1.0f + __builtin_amdgcn_exp2f(-1.4426950408889634f * a)) * b;
                        h[n * 4 + j] = fminf(fmaxf(hv, -448.0f), 448.0f); }
                unsigned w0 = 0u, w1 = 0u;
                w0 = __builtin_amdgcn_cvt_pk_fp8_f32(h[0], h[1], w0, false); w0 = __builtin_amdgcn_cvt_pk_fp8_f32(h[2], h[3], w0, true);
                w1 = __builtin_amdgcn_cvt_pk_fp8_f32(h[4], h[5], w1, false); w1 = __builtin_amdgcn_cvt_pk_fp8_f32(h[6], h[7], w1, true);
                v2u w; w.x = w0; w.y = w1; *(v2u*)rowp = w; }
    }
};
struct EpiResid {
    static constexpr bool PERM = false, AFTER_DRAIN = false;
    const float* xin_lat; const float* xin_ctx; float* xout_lat; float* xout_ctx; const float* gate; float sc; int pm_off;
    __device__ __forceinline__ void operator()(const pg8::f32x4 (&acc)[2][2][4][2], const pg8::Unit& u, int wr, int wc, int fr, int fq) const {
        const int pmg = u.pm + pm_off; const bool isctx = pmg >= 128; const int bidx = isctx ? 4 : (pmg >> 5);
        const size_t rbase = (size_t)(isctx ? (pmg - 128) : pmg) * 256 + wr * 64 + fr;
        const float* xi = (isctx ? xin_ctx : xin_lat); float* xo = (isctx ? xout_ctx : xout_lat);
        const int col0 = u.pc * 256 + wc * 32 + 4 * fq; const float* g = gate + (size_t)bidx * 6144 + col0;
        pg8::f32x4 gv[2][2];
#pragma unroll
        for (int bj = 0; bj < 2; ++bj)
#pragma unroll
            for (int n = 0; n < 2; ++n) gv[bj][n] = *(const pg8::f32x4*)(g + bj * 128 + n * 16) * sc;
#pragma unroll
        for (int ai = 0; ai < 2; ++ai)
#pragma unroll
            for (int m = 0; m < 4; ++m) { const size_t off = (rbase + ai * 128 + m * 16) * 1024 + col0;
#pragma unroll
                for (int bj = 0; bj < 2; ++bj)
#pragma unroll
                    for (int n = 0; n < 2; ++n) { const pg8::f32x4 xv = *(const pg8::f32x4*)(xi + off + bj * 128 + n * 16);
                        *(pg8::f32x4*)(xo + off + bj * 128 + n * 16) = xv + gv[bj][n] * acc[ai][bj][m][n]; }
                asm volatile("" ::: "memory"); }
    }
};
struct EpiGlu {
    static constexpr bool PERM = true, AFTER_DRAIN = false;
    const bf16* Z; bf16* Y; const float* bias;
    __device__ __forceinline__ void operator()(const pg8::f32x4 (&acc)[2][2][4][2], const pg8::Unit& u, int wr, int wc, int fr, int fq) const {
        const int row0 = u.pm * 256 + wr * 64 + fr, col0 = wc * 32 + 8 * fq;
#pragma unroll
        for (int ai = 0; ai < 2; ++ai)
#pragma unroll
            for (int m = 0; m < 4; ++m) { const size_t row = (size_t)(row0 + ai * 128 + m * 16);
#pragma unroll
                for (int bj = 0; bj < 2; ++bj) { const int col = col0 + bj * 128;
                    const pg8::u32x4 zz = *(const pg8::u32x4*)(Z + row * 256 + col);
                    const pg8::f32x4 b0 = *(const pg8::f32x4*)(bias + col), b1 = *(const pg8::f32x4*)(bias + col + 4);
                    const pg8::f32x4 v0 = acc[ai][bj][m][0] + b0, v1 = acc[ai][bj][m][1] + b1;
                    float o[8]; const unsigned zw[4] = {zz.x, zz.y, zz.z, zz.w};
#pragma unroll
                    for (int j = 0; j < 4; ++j) { const float zl = __uint_as_float(zw[j] << 16), zh = __uint_as_float(zw[j] & 0xffff0000u);
                        const float a0 = (j < 2) ? v0[2 * j] : v1[2 * j - 4], a1 = (j < 2) ? v0[2 * j + 1] : v1[2 * j - 3];
                        o[2 * j] = zl * sigm(a0); o[2 * j + 1] = zh * sigm(a1); }
                    pg8::u32x4 w; w.x = pg8::cvt_pk_bf16(o[0], o[1]); w.y = pg8::cvt_pk_bf16(o[2], o[3]); w.z = pg8::cvt_pk_bf16(o[4], o[5]); w.w = pg8::cvt_pk_bf16(o[6], o[7]);
                    *(pg8::u32x4*)(Y + row * 1024 + 256 + col) = w; }
                asm volatile("" ::: "memory"); }
    }
};
struct MoeOrder {
    int tp[9]; int nN, G, c, total;
    __device__ __forceinline__ void init(const unsigned* cnt, int nN_, int G_, int c_) {
        tp[0] = 0;
#pragma unroll
        for (int e = 0; e < 8; ++e) tp[e + 1] = tp[e] + (int)(((unsigned)__builtin_amdgcn_readfirstlane((int)__hip_atomic_load(cnt + e * 64, __ATOMIC_RELAXED, __HIP_MEMORY_SCOPE_AGENT)) + 255u) >> 8);
        nN = nN_; G = G_; c = c_; total = tp[8] * nN;
    }
    __device__ __forceinline__ bool next(int i, pg8::Unit& u) const {
        const int L = i * G + c; if (L >= total) return false;
        int wgid = L; { const int q = total / pg8::NXCD, r = total % pg8::NXCD, xcd = wgid % pg8::NXCD, off = wgid / pg8::NXCD; wgid = (xcd < r ? xcd * (q + 1) : r * (q + 1) + (xcd - r) * q) + off; }
        const int nM = tp[8], nig = pg8::WGM * nN, gid = wgid / nig, fm = gid * pg8::WGM, gsz = (nM - fm) < pg8::WGM ? (nM - fm) : pg8::WGM;
        const int rem = wgid - gid * nig, t = fm + rem % gsz, pn = rem / gsz; int e = 0;
#pragma unroll
        for (int k = 1; k < 8; ++k) e += (t >= tp[k]) ? 1 : 0;
        u.pm = t; u.pn = e * nN + pn; u.pc = pn; return true;
    }
    __device__ __forceinline__ void a_ready(const pg8::Unit&) const {}
    __device__ __forceinline__ void done(const pg8::Unit&) const {}
};

__device__ __forceinline__ void cvt_item(const float* W, int K, int N, bf16* WT, int mode, int add, LAS float* scr, int item, int lane, int nblk_override = 0, const float* ks = nullptr  ) {
    const int nblk = nblk_override ? nblk_override : (N >> 5), kb = item / nblk, nb = item - kb * nblk, k0 = 64 * kb, n0 = 32 * nb;
    const int r = lane >> 3, c4 = lane & 7;
    f32x4 v[8];
#pragma unroll
    for (int i = 0; i < 8; ++i) v[i] = *(const f32x4*)(W + (size_t)(k0 + 8 * i + r) * N + n0 + 4 * c4);
    if (ks) {
#pragma unroll
        for (int i = 0; i < 8; ++i) v[i] *= ks[8 * i + r]; }
#pragma unroll
    for (int i = 0; i < 8; ++i) {
#pragma unroll
        for (int j = 0; j < 4; ++j) scr[(8 * i + r) * 33 + 4 * c4 + j] = v[i][j]; }
    LDS_WAIT();
    const int c = lane & 7;
#pragma unroll
    for (int j = 0; j < 4; ++j) { const int n = (lane >> 3) + 8 * j; const LAS float* s = scr + (8 * c) * 33 + n;
        v4u o; o.x = pk2(s[0 * 33], s[1 * 33]); o.y = pk2(s[2 * 33], s[3 * 33]); o.z = pk2(s[4 * 33], s[5 * 33]); o.w = pk2(s[6 * 33], s[7 * 33]);
        const int nn = n0 + n; const int drow = (mode == 0) ? (nn + add) : (((nn >> 7) << 8) + (nn & 127) + add);
        *(v4u*)(WT + (size_t)drow * K + k0 + 8 * c) = o; }
    LDS_WAIT();
}
__device__ __forceinline__ void cvt_item_f8(const float* W, int K, int N, unsigned char* WT, int mode, int add, LAS float* scr, int item, int lane) {
    const int nblk = N >> 5, kb = item / nblk, nb = item - kb * nblk, k0 = 64 * kb, n0 = 32 * nb;
    const int r = lane >> 3, c4 = lane & 7;
    f32x4 v[8];
#pragma unroll
    for (int i = 0; i < 8; ++i) v[i] = *(const f32x4*)(W + (size_t)(k0 + 8 * i + r) * N + n0 + 4 * c4);
#pragma unroll
    for (int i = 0; i < 8; ++i) {
#pragma unroll
        for (int j = 0; j < 4; ++j) scr[(8 * i + r) * 33 + 4 * c4 + j] = v[i][j]; }
    LDS_WAIT();
    const int c = lane & 3;
#pragma unroll
    for (int j = 0; j < 2; ++j) { const int n = (lane >> 2) + 16 * j; const LAS float* s = scr + (16 * c) * 33 + n;
        unsigned w[4];
#pragma unroll
        for (int q = 0; q < 4; ++q) { unsigned x = 0u;
            x = __builtin_amdgcn_cvt_pk_fp8_f32(s[(4 * q) * 33] * WSC8, s[(4 * q + 1) * 33] * WSC8, x, false);
            x = __builtin_amdgcn_cvt_pk_fp8_f32(s[(4 * q + 2) * 33] * WSC8, s[(4 * q + 3) * 33] * WSC8, x, true); w[q] = x; }
        v4u o; o.x = w[0]; o.y = w[1]; o.z = w[2]; o.w = w[3];
        const int nn = n0 + n; const int drow = (mode == 0) ? (nn + add) : (((nn >> 7) << 8) + (nn & 127) + add);
        *(v4u*)(WT + (size_t)drow * K + k0 + 16 * c) = o; }
    LDS_WAIT();
}
__device__ __forceinline__ void moe_cvt_idle(const Frame& F, const Args& a, int j, int b_lo) {
    LAS float* scr = (LAS float*)(F.lds + F.wave * 16384);
    constexpr int IT = 1408;
    const int nw = (F.G - b_lo) * 8, w = ((int)blockIdx.x - b_lo) * 8 + F.wave;
    for (int it = w; it < 8 * 3 * IT; it += nw) {
        const int e = it / (3 * IT), r = it - e * 3 * IT, which = r / IT, item = r - which * IT;
        const size_t eo = ((size_t)j * 8 + e) * (size_t)(1024 * DFF);
        if (which == 0) cvt_item_f8(a.in[F.zz + I_MW1] + eo, 1024, DFF, F.ws + WS_W13M + (size_t)e * 5632 * 1024, 1, 0, scr, item, F.lane);
        else if (which == 1) cvt_item_f8(a.in[F.zz + I_MW3] + eo, 1024, DFF, F.ws + WS_W13M + (size_t)e * 5632 * 1024, 1, 128, scr, item, F.lane);
        else cvt_item_f8(a.in[F.zz + I_MW2] + eo, DFF, 1024, F.ws + WS_W2M + (size_t)e * 1024 * DFF, 0, 0, scr, item, F.lane);
    }
}
struct CvtIt { const float* W; unsigned char* WT; int K, N, mode, add, item; };
__device__ __forceinline__ CvtIt moe_cvt_decode(const Frame& F, const Args& a, int j, int it) {
    constexpr int IT = 1408;
    const int e = it / (3 * IT), r = it - e * 3 * IT, which = r / IT, item = r - which * IT;
    const size_t eo = ((size_t)j * 8 + e) * (size_t)(1024 * DFF);
    CvtIt c;
    if (which == 0) { c.W = a.in[F.zz + I_MW1] + eo; c.WT = F.ws + WS_W13M + (size_t)e * 5632 * 1024; c.K = 1024; c.N = DFF; c.mode = 1; c.add = 0; }
    else if (which == 1) { c.W = a.in[F.zz + I_MW3] + eo; c.WT = F.ws + WS_W13M + (size_t)e * 5632 * 1024; c.K = 1024; c.N = DFF; c.mode = 1; c.add = 128; }
    else { c.W = a.in[F.zz + I_MW2] + eo; c.WT = F.ws + WS_W2M + (size_t)e * 1024 * DFF; c.K = DFF; c.N = 1024; c.mode = 0; c.add = 0; }
    c.item = item; return c;
}
__device__ __forceinline__ void cvt_f8_load(f32x4 (&v)[8], const CvtIt& c, int lane) {
    const int nblk = c.N >> 5, kb = c.item / nblk, nb = c.item - kb * nblk, k0 = 64 * kb, n0 = 32 * nb, r = lane >> 3, c4 = lane & 7;
#pragma unroll
    for (int i = 0; i < 8; ++i) v[i] = *(const f32x4*)(c.W + (size_t)(k0 + 8 * i + r) * c.N + n0 + 4 * c4);
}
__device__ __forceinline__ void cvt_f8_finish(const f32x4 (&v)[8], const CvtIt& c, LAS float* scr, int lane) {
    const int nblk = c.N >> 5, kb = c.item / nblk, nb = c.item - kb * nblk, k0 = 64 * kb, n0 = 32 * nb, r = lane >> 3, c4 = lane & 7;
#pragma unroll
    for (int i = 0; i < 8; ++i) {
#pragma unroll
        for (int jj = 0; jj < 4; ++jj) scr[(8 * i + r) * 33 + 4 * c4 + jj] = v[i][jj]; }
    LDS_WAIT();
    const int cc = lane & 3;
#pragma unroll
    for (int jj = 0; jj < 2; ++jj) { const int n = (lane >> 2) + 16 * jj; const LAS float* sp_ = scr + (16 * cc) * 33 + n;
        unsigned w[4];
#pragma unroll
        for (int q = 0; q < 4; ++q) { unsigned x = 0u;
            x = __builtin_amdgcn_cvt_pk_fp8_f32(sp_[(4 * q) * 33] * WSC8, sp_[(4 * q + 1) * 33] * WSC8, x, false);
            x = __builtin_amdgcn_cvt_pk_fp8_f32(sp_[(4 * q + 2) * 33] * WSC8, sp_[(4 * q + 3) * 33] * WSC8, x, true); w[q] = x; }
        v4u o; o.x = w[0]; o.y = w[1]; o.z = w[2]; o.w = w[3];
        const int nn = n0 + n; const int drow = (c.mode == 0) ? (nn + c.add) : (((nn >> 7) << 8) + (nn & 127) + c.add);
        *(v4u*)(c.WT + (size_t)drow * c.K + k0 + 16 * cc) = o; }
    LDS_WAIT();
}
__device__ __forceinline__ void moe_cvt_range(const Frame& F, const Args& a, int j, int b_lo, int i0, int i1) {
    LAS float* scr = (LAS float*)(F.lds + F.wave * 16384);
    const int nw = (F.G - b_lo) * 8, w = ((int)blockIdx.x - b_lo) * 8 + F.wave;
    int it = i0 + w; if (it >= i1) return;
    f32x4 va[8], vb[8]; CvtIt ca = moe_cvt_decode(F, a, j, it), cb = ca;
    cvt_f8_load(va, ca, F.lane);
#pragma unroll 1
    for (; it < i1; it += 2 * nw) {
        const bool hb = it + nw < i1; if (hb) { cb = moe_cvt_decode(F, a, j, it + nw); cvt_f8_load(vb, cb, F.lane); }
        cvt_f8_finish(va, ca, scr, F.lane);
        if (it + 2 * nw < i1) { ca = moe_cvt_decode(F, a, j, it + 2 * nw); cvt_f8_load(va, ca, F.lane); }
        if (hb) cvt_f8_finish(vb, cb, scr, F.lane);
    }
}
__device__ __forceinline__ void moe_cvt(const Frame& F, const Args& a, int j) {
    LAS float* scr = (LAS float*)(F.lds + F.wave * 16384);
    constexpr int IT = 1408;
    for (int it = F.gw; it < 8 * 3 * IT; it += F.NGW) {
        const int e = it / (3 * IT), r = it - e * 3 * IT, which = r / IT, item = r - which * IT;
        const size_t eo = ((size_t)j * 8 + e) * (size_t)(1024 * DFF);
        if (which == 0) cvt_item_f8(a.in[F.zz + I_MW1] + eo, 1024, DFF, F.ws + WS_W13M + (size_t)e * 5632 * 1024, 1, 0, scr, item, F.lane);
        else if (which == 1) cvt_item_f8(a.in[F.zz + I_MW3] + eo, 1024, DFF, F.ws + WS_W13M + (size_t)e * 5632 * 1024, 1, 128, scr, item, F.lane);
        else cvt_item_f8(a.in[F.zz + I_MW2] + eo, DFF, 1024, F.ws + WS_W2M + (size_t)e * 1024 * DFF, 0, 0, scr, item, F.lane);
    }
}
__device__ __forceinline__ void prologue(const Frame& F, const Args& a) {
    {
        LAS float* sc = (LAS float*)F.lds; LAS float* red = sc + 5120;
        for (int idx = F.tid; idx < 5120; idx += 512) { const int r = idx >> 10, k = idx & 1023; const float cv = (r < 4) ? a.in[F.zz + I_C][r * 1024 + k] : a.in[F.zz + I_CCTX][k]; sc[idx] = silu_f(cv); }
        __syncthreads();
        float* MOD = (float*)(F.ws + WS_MOD);
        for (int item = blockIdx.x; item < 384; item += F.G) {
            const int l = item / 96, nb = item - l * 96, cl = F.tid & 63, ks = F.tid >> 6, n = nb * 64 + cl;
            float acc[5] = {0.f, 0.f, 0.f, 0.f, 0.f};
            const float* wp = a.in[F.zz + I_ADAW] + ((size_t)l * 1024 + ks * 128) * 6144 + n;
#pragma unroll 16
            for (int kk = 0; kk < 128; ++kk) { const float w = wp[(size_t)kk * 6144];
#pragma unroll
                for (int r = 0; r < 5; ++r) acc[r] = fmaf(sc[r * 1024 + ks * 128 + kk], w, acc[r]); }
#pragma unroll
            for (int r = 0; r < 5; ++r) red[(ks * 5 + r) * 64 + cl] = acc[r];
            __syncthreads();
            if (F.tid < 320) { const int r = F.tid >> 6; float s = 0.f;
#pragma unroll
                for (int k2 = 0; k2 < 8; ++k2) s += red[(k2 * 5 + r) * 64 + cl];
                MOD[((size_t)l * 5 + r) * 6144 + n] = s + a.in[F.zz + I_ADAB][l * 6144 + n]; }
            __syncthreads();
        }
        if (blockIdx.x == 0 && F.tid < 256) {
            const float* lg = a.in[F.zz + I_LBL]; float x[4], mx = -3.0e38f;
#pragma unroll
            for (int l = 0; l < 4; ++l) { x[l] = lg[l * 256 + F.tid]; mx = fmaxf(mx, x[l]); }
            float s = 0.f;
#pragma unroll
            for (int l = 0; l < 4; ++l) { x[l] = expf(x[l] - mx); s += x[l]; }
            float cs = 0.f; const float sm0 = x[0] / s; float* LB = (float*)(F.ws + WS_LB);
#pragma unroll
            for (int l = 0; l < 4; ++l) { cs += x[l] / s; LB[l * 256 + F.tid] = fminf(fmaxf(cs - sm0, 0.f), 1.0f - 1e-6f); }
        }
        if (blockIdx.x == (1 % F.G)) {
            float* RC = (float*)(F.ws + WS_ROPE); float* RS = RC + 2048;
            for (int idx = F.tid; idx < 2048; idx += 512) { const int pos = idx >> 4, i = idx & 15;
                const float fr = powf(10000.0f, -(float)i / 16.0f); const float ang = (float)pos * fr; RC[idx] = cosf(ang); RS[idx] = sinf(ang); }
        }
        __syncthreads();
    }
    LAS float* scr = (LAS float*)(F.lds + F.wave * 16384);
    constexpr int I_IN = 16 * 104, I_OUT = 16 * 32, I_F = 1408, I_GL = 4 * 8;
    constexpr int NIT = 4 * I_IN + 4 * I_OUT + 6 * I_F + 4 * I_GL;
    for (int it = F.gw; it < NIT; it += F.NGW) {
        int r = it;
        if (r < 4 * I_IN) { const int l = r / I_IN; cvt_item(a.in[F.zz + I_WIN] + (size_t)l * 1024 * DIN, 1024, DIN, (bf16*)(F.ws + WS_WIN) + (size_t)l * DINP * 1024, 0, 0, scr, r - l * I_IN, F.lane, 104); continue; } r -= 4 * I_IN;
        if (r < 4 * I_OUT) { const int l = r / I_OUT, it = r - l * I_OUT, k0 = 64 * (it >> 5);
            const float* ks = k0 < 256 ? a.in[F.zz + I_RETGN] + l * 256 + k0 : (k0 < 512 ? nullptr : (k0 < 768 ? a.in[F.zz + I_HGNW] + l * 256 + (k0 - 512) : a.in[F.zz + I_GLANW] + l * 256 + (k0 - 768)));
            cvt_item(a.in[F.zz + I_WOUT] + (size_t)l * 1024 * 1024, 1024, 1024, (bf16*)(F.ws + WS_WOUT) + (size_t)l * 1024 * 1024, 0, 0, scr, it, F.lane, 0, ks); continue; } r -= 4 * I_OUT;
        if (r < 6 * I_F) { const int j = r / (3 * I_F), r2 = r - j * 3 * I_F, which = r2 / I_F, item = r2 - which * I_F; const size_t wo = (size_t)j * 1024 * DFF;
            if (j == FP8_F1_J && which < 2) {
                if (which == 0) cvt_item_f8(a.in[F.zz + I_FW1] + wo, 1024, DFF, F.ws + WS_W13D + (size_t)j * 5632 * 1024 * 2, 1, 0, scr, item, F.lane);
                else if (which == 1) cvt_item_f8(a.in[F.zz + I_FW3] + wo, 1024, DFF, F.ws + WS_W13D + (size_t)j * 5632 * 1024 * 2, 1, 128, scr, item, F.lane);
            } else
            if (which == 0) cvt_item(a.in[F.zz + I_FW1] + wo, 1024, DFF, (bf16*)(F.ws + WS_W13D) + (size_t)j * 5632 * 1024, 1, 0, scr, item, F.lane);
            else if (which == 1) cvt_item(a.in[F.zz + I_FW3] + wo, 1024, DFF, (bf16*)(F.ws + WS_W13D) + (size_t)j * 5632 * 1024, 1, 128, scr, item, F.lane);
            else cvt_item_f8(a.in[F.zz + I_FW2] + wo, DFF, 1024, F.ws + WS_W2D + (size_t)j * 1024 * DFF, 0, 0, scr, item, F.lane);
            continue; } r -= 6 * I_F;
        { const int l = r / I_GL; cvt_item(a.in[F.zz + I_GLUW] + (size_t)l * 65536, 256, 256, (bf16*)(F.ws + WS_GLUW) + (size_t)l * 65536, 0, 0, scr, r - l * I_GL, F.lane); }
    }
    for (int i = blockIdx.x * 512 + F.tid; i < 4 * 256 * 128; i += F.G * 512) {
        const int l = i >> 15, rem = i & 32767, n = rem >> 7, k0 = (rem & 127) * 8, d = n >> 7, cidx = n & 127;
        const float* wa = a.in[F.zz + I_WA2] + ((size_t)(l * 2 + d) * 16) * 128 + cidx;
        float acc[8] = {0.f, 0.f, 0.f, 0.f, 0.f, 0.f, 0.f, 0.f};
#pragma unroll
        for (int r = 0; r < 16; ++r) { const float w2 = wa[r * 128];
#pragma unroll
            for (int kk = 0; kk < 8; ++kk) acc[kk] = fmaf(a.in[F.zz + I_WIN][((size_t)l * 1024 + k0 + kk) * DIN + 3328 + 16 * d + r], w2, acc[kk]); }
        v4u o; o.x = pk2(acc[0], acc[1]); o.y = pk2(acc[2], acc[3]); o.z = pk2(acc[4], acc[5]); o.w = pk2(acc[6], acc[7]);
        *(v4u*)((bf16*)(F.ws + WS_WIN) + ((size_t)l * DINP + 3328 + n) * 1024 + k0) = o;
    }
}

struct MoeTp { int tp[9]; };
__device__ __forceinline__ void load_tp(MoeTp& t, const unsigned* cnt) {
    t.tp[0] = 0;
#pragma unroll
    for (int e = 0; e < 8; ++e) t.tp[e + 1] = t.tp[e] + (int)(((unsigned)__builtin_amdgcn_readfirstlane((int)__hip_atomic_load(cnt + e * 64, __ATOMIC_RELAXED, __HIP_MEMORY_SCOPE_AGENT)) + 255u) >> 8);
}
__device__ __forceinline__ void moe_route_flush(const Frame& F, int jm, int nk, int rt_e, int rt_m, float g0, float g1) {
    unsigned* cnt = (unsigned*)F.ws + CW_CNT + jm * 8 * 64; int* LIST = (int*)(F.ws + WS_LIST);
    int* EPw = (int*)(F.ws + WS_LIST) + 8 * MT; float* GW = (float*)(F.ws + WS_LIST) + 10 * MT;
    const bool has = F.lane < nk; const int e0 = rt_e & 15, e1 = rt_e >> 4;
    unsigned p0 = 0u, p1 = 0u;
#pragma unroll
    for (int e = 0; e < 8; ++e) {
        const unsigned long long b0 = __ballot(has && e0 == e), b1 = __ballot(has && e1 == e);
        const unsigned c0 = (unsigned)__popcll(b0), c = c0 + (unsigned)__popcll(b1);
        if (c == 0u) continue;
        unsigned base = 0u;
        if (F.lane == 0) base = __hip_atomic_fetch_add(cnt + e * 64, c, __ATOMIC_RELAXED, __HIP_MEMORY_SCOPE_AGENT);
        base = (unsigned)__builtin_amdgcn_readfirstlane((int)base);
        const unsigned long long below = (1ull << F.lane) - 1ull;
        if (has && e0 == e) p0 = base + (unsigned)__popcll(b0 & below);
        if (has && e1 == e) p1 = base + c0 + (unsigned)__popcll(b1 & below);
    }
    if (has) {
        LIST[e0 * MT + p0] = rt_m; LIST[e1 * MT + p1] = rt_m;
        EPw[2 * rt_m] = e0 | (int)(p0 << 3); EPw[2 * rt_m + 1] = e1 | (int)(p1 << 3);
        GW[2 * rt_m] = g0; GW[2 * rt_m + 1] = g1;
    }
}
template <int MODE>
__device__ __forceinline__ void norm_phase(const Frame& F, const Args& a, int l, int which  , int nrows, int comb_l  ,
                                           int row_lo = 0, int w0 = -1  , int nwav = 0) {
    const int wv_ = (w0 < 0) ? F.gw : w0, nwv_ = (w0 < 0) ? F.NGW : nwav;
    const float* MOD = (const float*)(F.ws + WS_MOD);
    const float* nw = (MODE == 2) ? a.in[F.zz + I_FINW] : ((which ? a.in[F.zz + I_N2W] : a.in[F.zz + I_N1W]) + l * 1024);
    bf16* XN = (bf16*)(F.ws + WS_ACT);
    float* hb = (float*)(F.ws + WS_HB);
    const int* EP = (const int*)(F.ws + WS_LIST) + 8 * MT; const float* GATE = (const float*)(F.ws + WS_LIST) + 10 * MT;
    const bf16* YM = (const bf16*)(F.ws + WS_X2);
    const bool from_input = (l == 0 && which == 0 && MODE != 2);
    MoeTp ctp; if (comb_l >= 0) load_tp(ctp, (const unsigned*)F.ws + CW_CNT + (comb_l >> 1) * 8 * 64);
    const int jm = l >> 1;
    LAS float* rwl = (LAS float*)F.lds;
    if (MODE == 1) {
        const float* rw = a.in[F.zz + I_RW] + (size_t)jm * 8192;
        for (int idx = F.tid; idx < 8192; idx += 512) { const int k = idx >> 3, e = idx & 7; rwl[e * 1024 + k] = rw[idx]; }
        __syncthreads();
    }
    f32x4 wv[4];
#pragma unroll
    for (int j = 0; j < 4; ++j) wv[j] = *((const f32x4*)nw + F.lane + 64 * j);
    f32x4 vn[4]; int epn0 = 0, epn1 = 0; float gn0 = 0.f, gn1 = 0.f, gq0 = 0.f, gq1 = 0.f; v2u ymn0[4], ymn1[4];
#pragma unroll
    for (int j = 0; j < 4; ++j) { ymn0[j] = (v2u){0u, 0u}; ymn1[j] = (v2u){0u, 0u}; }
    { const int m = (row_lo + wv_ < nrows) ? row_lo + wv_ : row_lo; const bool isctx = m >= NLAT;
      const float* xr = from_input ? (isctx ? a.in[F.zz + I_CTX] + (size_t)(m - NLAT) * 1024 : a.in[F.zz + I_X] + (size_t)m * 1024) : (isctx ? hb + (size_t)(m - NLAT) * 1024 : F.out + (size_t)m * 1024);
#pragma unroll
      for (int j = 0; j < 4; ++j) vn[j] = *((const f32x4*)xr + F.lane + 64 * j);
      if (comb_l >= 0) { const int e0 = EP[2 * m], e1 = EP[2 * m + 1]; gn0 = GATE[2 * m]; gn1 = GATE[2 * m + 1];
          int t0 = 0, t1 = 0;
#pragma unroll
          for (int e = 0; e < 8; ++e) { t0 = ((e0 & 7) == e) ? ctp.tp[e] : t0; t1 = ((e1 & 7) == e) ? ctp.tp[e] : t1; }
          const size_t d0 = (size_t)t0 * 256 + (e0 >> 3), d1 = (size_t)t1 * 256 + (e1 >> 3);
#pragma unroll
          for (int j = 0; j < 4; ++j) { ymn0[j] = *((const v2u*)(YM + d0 * 1024) + F.lane + 64 * j); ymn1[j] = *((const v2u*)(YM + d1 * 1024) + F.lane + 64 * j); }
          const int m1 = (m + nwv_ < nrows) ? m + nwv_ : m;
          epn0 = EP[2 * m1]; epn1 = EP[2 * m1 + 1]; gq0 = GATE[2 * m1]; gq1 = GATE[2 * m1 + 1]; } }
    int mod_b = -1; f32x4 ms0[4], ms1[4];
#pragma unroll
    for (int j = 0; j < 4; ++j) { ms0[j] = (f32x4){0.f, 0.f, 0.f, 0.f}; ms1[j] = ms0[j]; }
    int rt_k = 0, rt_e = 0, rt_m = 0; float rt_g0 = 0.f, rt_g1 = 0.f;
    for (int m = row_lo + wv_; m < nrows; m += nwv_) {
        const bool isctx = m >= NLAT; const int bidx = isctx ? 4 : (m >> 13);
        f32x4 v[4];
#pragma unroll
        for (int j = 0; j < 4; ++j) v[j] = vn[j];
        const float g0 = gn0, g1 = gn1; v2u ym0[4], ym1[4];
#pragma unroll
        for (int j = 0; j < 4; ++j) { ym0[j] = ymn0[j]; ym1[j] = ymn1[j]; }
        { const int mn = (m + nwv_ < nrows) ? m + nwv_ : m; const bool cn = mn >= NLAT;
          const float* xr = from_input ? (cn ? a.in[F.zz + I_CTX] + (size_t)(mn - NLAT) * 1024 : a.in[F.zz + I_X] + (size_t)mn * 1024) : (cn ? hb + (size_t)(mn - NLAT) * 1024 : F.out + (size_t)mn * 1024);
#pragma unroll
          for (int j = 0; j < 4; ++j) vn[j] = *((const f32x4*)xr + F.lane + 64 * j);
          if (comb_l >= 0) {
              int t0 = 0, t1 = 0;
#pragma unroll
              for (int e = 0; e < 8; ++e) { t0 = ((epn0 & 7) == e) ? ctp.tp[e] : t0; t1 = ((epn1 & 7) == e) ? ctp.tp[e] : t1; }
              const size_t d0 = (size_t)t0 * 256 + (epn0 >> 3), d1 = (size_t)t1 * 256 + (epn1 >> 3);
#pragma unroll
              for (int j = 0; j < 4; ++j) { ymn0[j] = *((const v2u*)(YM + d0 * 1024) + F.lane + 64 * j); ymn1[j] = *((const v2u*)(YM + d1 * 1024) + F.lane + 64 * j); }
              gn0 = gq0; gn1 = gq1;
              const int mn2 = (mn + nwv_ < nrows) ? mn + nwv_ : mn;
              epn0 = EP[2 * mn2]; epn1 = EP[2 * mn2 + 1]; gq0 = GATE[2 * mn2]; gq1 = GATE[2 * mn2 + 1]; } }
        if (comb_l >= 0) {
            const float* m5 = MOD + ((size_t)comb_l * 5 + bidx) * 6144 + 5 * 1024;
            float* xw = isctx ? hb + (size_t)(m - NLAT) * 1024 : F.out + (size_t)m * 1024;
#pragma unroll
            for (int j = 0; j < 4; ++j) {
                const v2u y0 = ym0[j], y1 = ym1[j];
                const f32x4 mm = *((const f32x4*)m5 + F.lane + 64 * j);
                f32x4 f0, f1;
                f0[0] = __uint_as_float(y0.x << 16); f0[1] = __uint_as_float(y0.x & 0xffff0000u); f0[2] = __uint_as_float(y0.y << 16); f0[3] = __uint_as_float(y0.y & 0xffff0000u);
                f1[0] = __uint_as_float(y1.x << 16); f1[1] = __uint_as_float(y1.x & 0xffff0000u); f1[2] = __uint_as_float(y1.y << 16); f1[3] = __uint_as_float(y1.y & 0xffff0000u);
                v[j] = v[j] + mm * (f0 * g0 + f1 * g1);
                if (MODE != 2) *((f32x4*)xw + F.lane + 64 * j) = v[j];
            }
        }
        float ss = 0.f;
#pragma unroll
        for (int j = 0; j < 4; ++j) ss += (v[j][0] * v[j][0] + v[j][1] * v[j][1]) + (v[j][2] * v[j][2] + v[j][3] * v[j][3]);
        ss = wave_sum(ss);
        const float rstd = __builtin_amdgcn_rsqf(ss * (1.0f / 1024.0f) + NEPS);
        if (MODE == 2) {
#pragma unroll
            for (int j = 0; j < 4; ++j) *((f32x4*)(F.out + (size_t)m * 1024) + F.lane + 64 * j) = v[j] * rstd * wv[j];
        } else {
            if (bidx != mod_b) {
                const float* sh = MOD + ((size_t)l * 5 + bidx) * 6144 + (which ? 3 : 0) * 1024; const float* scl = sh + 1024;
#pragma unroll
                for (int j = 0; j < 4; ++j) { ms1[j] = *((const f32x4*)scl + F.lane + 64 * j) + 1.0f; ms0[j] = *((const f32x4*)sh + F.lane + 64 * j); }
                mod_b = bidx;
            }
            f32x4 o[4];
#pragma unroll
            for (int j = 0; j < 4; ++j) {
                o[j] = (v[j] * rstd * wv[j]) * ms1[j] + ms0[j];
                if (MODE == 1 || MODE == 3) {
                    unsigned w8 = 0u; w8 = __builtin_amdgcn_cvt_pk_fp8_f32(fminf(fmaxf(o[j][0], -448.f), 448.f), fminf(fmaxf(o[j][1], -448.f), 448.f), w8, false);
                    w8 = __builtin_amdgcn_cvt_pk_fp8_f32(fminf(fmaxf(o[j][2], -448.f), 448.f), fminf(fmaxf(o[j][3], -448.f), 448.f), w8, true);
                    *((unsigned*)((unsigned char*)XN + (size_t)m * 1024) + F.lane + 64 * j) = w8;
                } else { v2u w; w.x = pk2(o[j][0], o[j][1]); w.y = pk2(o[j][2], o[j][3]);
                    *((v2u*)(XN + (size_t)m * 1024) + F.lane + 64 * j) = w; } }
            if (MODE == 1) {
                float p[8];
#pragma unroll
                for (int e = 0; e < 8; ++e) { float s = 0.f;
#pragma unroll
                    for (int j = 0; j < 4; ++j) { const f32x4 w4 = *((const LAS f32x4*)(rwl + e * 1024) + F.lane + 64 * j);
                        s += (o[j][0] * w4[0] + o[j][1] * w4[1]) + (o[j][2] * w4[2] + o[j][3] * w4[3]); }
                    p[e] = wave_sum(s) + a.in[F.zz + I_RB][jm * 8 + e]; }
                int e0 = 0; float v0 = p[0];
#pragma unroll
                for (int e = 1; e < 8; ++e) if (p[e] > v0) { v0 = p[e]; e0 = e; }
                int e1 = -1; float v1 = -3.0e38f;
#pragma unroll
                for (int e = 0; e < 8; ++e) if (e != e0 && p[e] > v1) { v1 = p[e]; e1 = e; }
                const float ex = expf(v1 - v0), g0 = 1.0f / (1.0f + ex), g1 = ex / (1.0f + ex);
                if (F.lane == rt_k) { rt_e = e0 | (e1 << 4); rt_m = m; rt_g0 = g0; rt_g1 = g1; }
                ++rt_k;
                if (rt_k == 64) { moe_route_flush(F, jm, rt_k, rt_e, rt_m, rt_g0, rt_g1); rt_k = 0; }
            }
        }
    }
    if (MODE == 1) { if (rt_k > 0) moe_route_flush(F, jm, rt_k, rt_e, rt_m, rt_g0, rt_g1); __syncthreads(); }
}
__device__ __forceinline__ void moe_gather(const Frame& F, int jm) {
    const unsigned* cnt = (const unsigned*)F.ws + CW_CNT + jm * 8 * 64;
    MoeTp t; load_tp(t, cnt);
    int cn[8];
#pragma unroll
    for (int e = 0; e < 8; ++e) cn[e] = __builtin_amdgcn_readfirstlane((int)__hip_atomic_load(cnt + e * 64, __ATOMIC_RELAXED, __HIP_MEMORY_SCOPE_AGENT));
    const int rows = t.tp[8] * 256;
    const int* LIST = (const int*)(F.ws + WS_LIST); const v4u* XN = (const v4u*)(F.ws + WS_ACT); v4u* XB = (v4u*)(F.ws + WS_X2);
    for (int r0 = F.gw; r0 < rows; r0 += 8 * F.NGW) {
        int src[8];
#pragma unroll
        for (int q = 0; q < 8; ++q) { const int r = r0 + q * F.NGW; src[q] = -1;
            if (r < rows) { const int tile = r >> 8; int e = 0, tpe = 0, ce = cn[0];
#pragma unroll
                for (int k = 1; k < 8; ++k) { const bool ge = tile >= t.tp[k]; e += ge ? 1 : 0; tpe = ge ? t.tp[k] : tpe; ce = ge ? cn[k] : ce; }
                const int pos = r - tpe * 256;
                if (pos < ce) src[q] = LIST[e * MT + pos]; } }
        v4u x[8];
#pragma unroll
        for (int q = 0; q < 8; ++q) { x[q] = (v4u){0u, 0u, 0u, 0u}; if (src[q] >= 0) x[q] = XN[(size_t)src[q] * 64 + F.lane]; }
#pragma unroll
        for (int q = 0; q < 8; ++q) { const int r = r0 + q * F.NGW; if (r < rows) XB[(size_t)r * 64 + F.lane] = x[q]; }
    }
}
#define GLD(T, ubase, voff) (*(const T*)((const char*)(ubase) + (unsigned)(voff)))
#define GST(T, ubase, voff) (*(T*)((char*)(ubase) + (unsigned)(voff)))
__device__ __forceinline__ int fresh_lane() { int l; asm volatile("v_mbcnt_lo_u32_b32 %0, -1, 0\n\tv_mbcnt_hi_u32_b32 %0, -1, %0" : "=v"(l)); return l; }

struct MixP { const bf16* P; const float* lb; const float* rcos; const float* rsin; const float* ba; };
__device__ __forceinline__ int seg_row0(int b, int sg) { return sg < 4 ? NLAT + b * CTXL + sg * 64 : b * SEQ + (sg - 4) * 64; }
__device__ __forceinline__ int seg_tpos0(int sg) { return sg < 4 ? -1 : (sg - 4) * 64; }

struct S5P { const float *lam_re, *lam_im, *log_dt, *b_re, *b_im, *c_re, *c_im, *dd; const unsigned* par; };
__device__ __forceinline__ float gelu_tanh(float y) { const float t = 0.7978845608028654f * (y + 0.044715f * y * y * y); const float th = 1.0f - 2.0f * __builtin_amdgcn_rcpf(1.0f + __expf(2.0f * t)); return 0.5f * y * (1.0f + th); }
template <int MODE>
__device__ __forceinline__ void s5_scan(const S5P& sp, const bf16* P, int b, int g, int dir, int sg, int lane, float& hre, float& him, LAS float* yf, LAS float* stg, bf16* Z) {
    const int row0 = seg_row0(b, sg); const int dg = dir * 16 + g;
    const float lre = sp.lam_re[dg * 64 + lane], lim = sp.lam_im[dg * 64 + lane], dt = expf(sp.log_dt[dg]);
    const float er = expf(lre * dt); const float sn = sinf(lim * dt), cs = cosf(lim * dt);
    const float ar = er * cs, ai = er * sn;
    const float nr = ar - 1.0f, ni = ai, den = lre * lre + lim * lim;
    const float cr = (nr * lre + ni * lim) / den, ci = (ni * lre - nr * lim) / den;
    float bbr[16], bbi[16], Cr[16], Ci[16];
#pragma unroll
    for (int c = 0; c < 16; ++c) { const float Br = sp.b_re[((size_t)dg * 64 + lane) * 16 + c], Bi = sp.b_im[((size_t)dg * 64 + lane) * 16 + c];
        bbr[c] = cr * Br - ci * Bi; bbi[c] = cr * Bi + ci * Br;
        Cr[c] = (MODE != 0) ? sp.c_re[((size_t)dg * 16 + c) * 64 + lane] : 0.f; Ci[c] = (MODE != 0) ? sp.c_im[((size_t)dg * 16 + c) * 64 + lane] : 0.f; }
    const int ch = ((lane >> 5) & 1) * 8 + ((lane >> 4) & 1) * 4 + ((lane >> 3) & 1) * 2 + ((lane >> 2) & 1);
    const float dv = (MODE == 2) ? sp.dd[g * 16 + ch] : 0.f;
    const bool b5 = lane & 32, b4 = lane & 16, b3 = lane & 8, b2 = lane & 4;
    const unsigned ucol = 2u * (unsigned)(C_S5 + g * 16 + (lane & 15));
    unsigned short rn0[4], rn1[4], rn2[4];
#pragma unroll
    for (int u = 0; u < 4; ++u) { rn0[u] = GLD(unsigned short, P + (size_t)(row0 + (dir ? 63 - u : u)) * DINP, ucol); rn1[u] = GLD(unsigned short, P + (size_t)(row0 + (dir ? 59 - u : 4 + u)) * DINP, ucol);
        rn2[u] = GLD(unsigned short, P + (size_t)(row0 + (dir ? 55 - u : 8 + u)) * DINP, ucol); }
#pragma unroll 1
    for (int i0 = 0; i0 < 64; i0 += 4) {
        unsigned short ru[4], rn3[4];
        const int ip = (i0 + 12 < 64) ? i0 + 12 : 60;
#pragma unroll
        for (int u = 0; u < 4; ++u) { ru[u] = rn0[u]; rn3[u] = GLD(unsigned short, P + (size_t)(row0 + (dir ? 63 - (ip + u) : (ip + u))) * DINP, ucol); }
#pragma unroll
        for (int u = 0; u < 4; ++u) stg[u * 64 + lane] = bf2f(ru[u]);
#pragma unroll
        for (int u = 0; u < 4; ++u) {
            const int ti = dir ? 63 - (i0 + u) : (i0 + u);
            const float uf = bf2f(ru[u]);
            float bur = 0.f, bui = 0.f;
#pragma unroll
            for (int c4 = 0; c4 < 4; ++c4) { const f32x4 ux = *(const LAS f32x4*)(stg + u * 64 + 4 * c4);
#pragma unroll
                for (int jj = 0; jj < 4; ++jj) { bur = fmaf(bbr[4 * c4 + jj], ux[jj], bur); bui = fmaf(bbi[4 * c4 + jj], ux[jj], bui); } }
            const float nre = ar * hre - ai * him + bur, nim = ar * him + ai * hre + bui;
            hre = nre; him = nim;
            if (MODE != 0) {
                float v[16];
#pragma unroll
                for (int c = 0; c < 16; ++c) v[c] = Cr[c] * hre - Ci[c] * him;
                float w8[8], w4[4], w2[2], w1;
#pragma unroll
                for (int i = 0; i < 8; ++i) { const float mine = b5 ? v[8 + i] : v[i], oth = b5 ? v[i] : v[8 + i]; w8[i] = mine + __shfl_xor(oth, 32); }
#pragma unroll
                for (int i = 0; i < 4; ++i) { const float mine = b4 ? w8[4 + i] : w8[i], oth = b4 ? w8[i] : w8[4 + i]; w4[i] = mine + __shfl_xor(oth, 16); }
#pragma unroll
                for (int i = 0; i < 2; ++i) { const float mine = b3 ? w4[2 + i] : w4[i], oth = b3 ? w4[i] : w4[2 + i]; w2[i] = mine + __shfl_xor(oth, 8); }
                { const float mine = b2 ? w2[1] : w2[0], oth = b2 ? w2[0] : w2[1]; w1 = mine + __shfl_xor(oth, 4); }
                w1 += __shfl_xor(w1, 2); w1 += __shfl_xor(w1, 1);
                if (MODE == 1) { if ((lane & 3) == 0) yf[ti * 16 + ch] = w1; }
                if (MODE == 2) {
                    const float uch = __shfl(uf, ch);
                    if ((lane & 3) == 0) { const float y = w1 + yf[ti * 16 + ch] + dv * uch; Z[(size_t)(row0 + ti) * 256 + g * 16 + ch] = (bf16)f2bf(gelu_tanh(y)); }
                }
            }
        }
#pragma unroll
        for (int u = 0; u < 4; ++u) { rn0[u] = rn1[u]; rn1[u] = rn2[u]; rn2[u] = rn3[u]; }
    }
}

__device__ __forceinline__ MixP make_mixp(const Frame& F, const Args& a, int l) {
    MixP mp; mp.P = (const bf16*)(F.ws + WS_PH); mp.lb = (const float*)(F.ws + WS_LB) + l * 256; mp.rcos = (const float*)(F.ws + WS_ROPE); mp.rsin = mp.rcos + 2048;
    mp.ba = a.in[F.zz + I_BA] + (size_t)l * 2 * 128; return mp;
}
__device__ __forceinline__ S5P make_s5p(const Frame& F, const Args& a, int l) {
    S5P sp; sp.lam_re = a.in[F.zz + I_LAMRE] + (size_t)l * 2048; sp.lam_im = a.in[F.zz + I_LAMIM] + (size_t)l * 2048; sp.log_dt = a.in[F.zz + I_LOGDT] + l * 32;
    sp.b_re = a.in[F.zz + I_BRE] + (size_t)l * 32768; sp.b_im = a.in[F.zz + I_BIM] + (size_t)l * 32768; sp.c_re = a.in[F.zz + I_CRE] + (size_t)l * 32768; sp.c_im = a.in[F.zz + I_CIM] + (size_t)l * 32768;
    sp.dd = a.in[F.zz + I_S5D] + l * 256; sp.par = (const unsigned*)(F.ws + WS_S5PAR) + (size_t)l * 32 * 4096; return sp;
}


typedef short bf16x8_t __attribute__((ext_vector_type(8)));
typedef float f32x16 __attribute__((ext_vector_type(16)));
typedef float f32x2_t __attribute__((ext_vector_type(2)));
typedef __bf16 bf16x2_n __attribute__((ext_vector_type(2)));
__device__ __forceinline__ unsigned pkbf(float lo, float hi) { const f32x2_t v = {lo, hi}; const bf16x2_n r = __builtin_convertvector(v, bf16x2_n); return __builtin_bit_cast(unsigned, r); }
constexpr int WL_QC = 0, WL_KC = 4608, WL_KT = 9216, WL_VT = 14336, WL_PL = 19456, WL_BYTES = 19712;

struct MxC { float gamma, lbv, oml, bav, rc1, rs1; unsigned cq, ck, cv, cz; };
template <int MIX>
__device__ __forceinline__ void mx_consts(MxC& c, const MixP& mp, int h, int dir, int lane) {
    c.gamma = 1.f; c.lbv = 0.f; c.oml = 1.f; c.bav = 0.f; c.cz = 0; c.rc1 = 1.f; c.rs1 = 0.f;
    if (MIX == 0) { c.cq = 8u * (unsigned)(C_RQ + h * 64 + lane); c.ck = 8u * (unsigned)(C_RK + h * 64 + lane); c.cv = 8u * (unsigned)(C_RV + h * 64 + lane); c.gamma = 1.0f - exp2f(-5.0f - (float)(dir ? 3 - h : h));
        if (lane & 32) { const unsigned r1 = 4u * (unsigned)(16 + (lane & 15)); c.rc1 = GLD(float, mp.rcos, r1); const float s1 = GLD(float, mp.rsin, r1); c.rs1 = dir ? -s1 : s1; } }
    else if (MIX == 1) { c.cq = 8u * (unsigned)(C_HQ + h * 64 + lane); c.ck = 8u * (unsigned)((dir ? C_HFB : C_HFF) + h * 64 + lane); c.cv = 8u * (unsigned)(C_HI + h * 64 + lane); c.lbv = mp.lb[h * 64 + lane]; c.oml = 1.0f - c.lbv; }
    else { c.cq = 8u * (unsigned)(C_GQ + h * 32 + (lane & 31)); c.ck = 8u * (unsigned)(C_GK + h * 32 + (lane & 31)); c.cv = 8u * (unsigned)(C_GV + h * 64 + lane); c.cz = 8u * (unsigned)((dir ? C_GZB : C_GZF) + h * 32 + (lane & 31));
        c.bav = mp.ba[dir * 128 + h * 32 + (lane & 31)]; }
}
struct MxRaw { v2u q, k, v, z; };
template <int MIX, bool NEEDQ, int DIR>
__device__ __forceinline__ void mx_load(MxRaw& w, const MixP& mp, const MxC& c, int rows, int b) {
    const bf16* pr = mp.P + (size_t)((rows >> 2) + (DIR ? 15 - b : b)) * P4G;
    const v2u zero = {0u, 0u};
    w.q = NEEDQ ? GLD(v2u, pr, c.cq) : zero; w.k = GLD(v2u, pr, c.ck); w.v = GLD(v2u, pr, c.cv); w.z = (MIX == 2) ? GLD(v2u, pr, c.cz) : zero;
}
__device__ __forceinline__ float bfx(const v2u& w, int i) { const unsigned d = (i >> 1) ? w.y : w.x; return __builtin_bit_cast(float, (i & 1) ? (d & 0xffff0000u) : (d << 16)); }
template <int MIX, bool NEEDQ, int DIR>
__device__ __forceinline__ void mx_batch(const MxRaw& cur, const MixP& mp, const MxC& c, int tposs  , int lane, LAS unsigned char* wl, int b, float& P, float& rc, float& rs) {
    constexpr int DK = (MIX == 2) ? 32 : 64;
    float kt[4];
#pragma unroll
    for (int u = 0; u < 4; ++u) {
        const int cc = b * 4 + u, ts = DIR ? 63 - cc : cc, t = ts & 31;
        const int pu = DIR ? 3 - u : u; float q = bfx(cur.q, pu), k, f;
        if (MIX == 0) {
            k = bfx(cur.k, pu) * 0.125f; f = c.gamma;
            if (tposs >= 0) { const float cs = rc, sn = rs;
                rc = cs * c.rc1 - sn * c.rs1; rs = sn * c.rc1 + cs * c.rs1;
                const float ss = (lane & 16) ? sn : -sn;
                const float kp = __shfl_xor(k, 16); k = fmaf(kp, ss, k * cs);
                if (NEEDQ) { const float qp = __shfl_xor(q, 16); q = fmaf(qp, ss, q * cs); } }
        } else if (MIX == 1) {
            const float z = bfx(cur.k, pu); const float e = __expf(-z); const float sp = __builtin_amdgcn_rcpf(1.0f + e), sn = e * sp;
            f = fmaf(c.oml, sp, c.lbv); k = c.oml * sn;
        } else {
            k = bfx(cur.k, pu) * 0.17677669529663687f; const float z = bfx(cur.z, pu) + c.bav;
            const float ls = fminf(z, 0.f) - __logf(1.0f + __expf(-fabsf(z)));
            f = __expf(ls * 0.0625f);
        }
        P = fmaxf(P * f, 1e-30f);
        const float kk = k * __builtin_amdgcn_rcpf(P); kt[DIR ? 3 - u : u] = kk;
        if (lane < DK) {
            const unsigned qk = pkbf(q * P, kk);
            if (NEEDQ) *(LAS unsigned short*)(wl + WL_QC + t * 144 + lane * 2) = (unsigned short)qk;
            *(LAS unsigned short*)(wl + WL_KC + t * 144 + lane * 2) = (unsigned short)(qk >> 16);
        }
    }
    const int g4 = ((DIR ? 63 - b * 4 : b * 4) & 31) >> 2;
    v2u kp; kp.x = pkbf(kt[0], kt[1]); kp.y = pkbf(kt[2], kt[3]);
    if (lane < DK) *(LAS v2u*)(wl + WL_KT + lane * 80 + g4 * 8) = kp;
    *(LAS v2u*)(wl + WL_VT + lane * 80 + g4 * 8) = cur.v;
}
typedef short bf16x4_t __attribute__((ext_vector_type(4)));
#define MFMA8(a, b, c) __builtin_amdgcn_mfma_f32_32x32x8bf16_1k((a), (b), (c), 0, 0, 0)
__device__ __forceinline__ bf16x4_t pack4(const f32x16& x, int s) {
    v2u p; p.x = pkbf(x[4 * s], x[4 * s + 1]); p.y = pkbf(x[4 * s + 2], x[4 * s + 3]);
    return __builtin_bit_cast(bf16x4_t, p);
}
__device__ __forceinline__ bf16x4_t ld4(const LAS unsigned char* p) { const v2u a = *(const LAS v2u*)p; return __builtin_bit_cast(bf16x4_t, a); }

__device__ __forceinline__ float u2f_(unsigned u) { return __builtin_bit_cast(float, u); }
__device__ __forceinline__ unsigned f2u_(float f) { return __builtin_bit_cast(unsigned, f); }
__device__ __forceinline__ void s5_build(const Frame& F, const Args& a) {
    for (int it = F.gw; it < 128; it += F.NGW) {
        const int l = it >> 5, dg = it & 31, lane = F.lane, m32 = lane & 31, hh = lane >> 5;
        const S5P sp = make_s5p(F, a, l);
        unsigned* par = (unsigned*)(F.ws + WS_S5PAR) + (size_t)it * 4096;
    float ar[2], ai[2], a2r[2], a2i[2], a3r[2], a3i[2], a4r[2], a4i[2];
    bf16x4_t bfr[4][2];
    const float dt = __expf(sp.log_dt[dg]);
#pragma unroll
    for (int sh = 0; sh < 2; ++sh) {
        const int p = 32 * sh + m32;
        const float lre = sp.lam_re[dg * 64 + p], lim = sp.lam_im[dg * 64 + p];
        const float er = __expf(lre * dt), sn = sinf(lim * dt), cs = cosf(lim * dt);
        ar[sh] = er * cs; ai[sh] = er * sn;
        a2r[sh] = ar[sh] * ar[sh] - ai[sh] * ai[sh]; a2i[sh] = ar[sh] * ai[sh] + ar[sh] * ai[sh];
        a3r[sh] = a2r[sh] * ar[sh] - a2i[sh] * ai[sh]; a3i[sh] = a2r[sh] * ai[sh] + a2i[sh] * ar[sh];
        a4r[sh] = a2r[sh] * a2r[sh] - a2i[sh] * a2i[sh]; a4i[sh] = a2r[sh] * a2i[sh] + a2r[sh] * a2i[sh];
        const float nr = ar[sh] - 1.0f, ni = ai[sh], den = 1.0f / (lre * lre + lim * lim);
        const float cr = (nr * lre + ni * lim) * den, ci = (ni * lre - nr * lim) * den;
#pragma unroll
        for (int s2 = 0; s2 < 2; ++s2) {
            const f32x4 Br = *(const f32x4*)(sp.b_re + ((size_t)dg * 64 + p) * 16 + 8 * s2 + 4 * hh), Bi = *(const f32x4*)(sp.b_im + ((size_t)dg * 64 + p) * 16 + 8 * s2 + 4 * hh);
            const f32x4 re = Br * cr - Bi * ci, im = Bi * cr + Br * ci;
            v2u pr, pi; pr.x = pkbf(re[0], re[1]); pr.y = pkbf(re[2], re[3]); pi.x = pkbf(im[0], im[1]); pi.y = pkbf(im[2], im[3]);
            bfr[sh][s2] = __builtin_bit_cast(bf16x4_t, pr); bfr[2 + sh][s2] = __builtin_bit_cast(bf16x4_t, pi);
        }
    }
    bf16x4_t cfr[16];
    {
#pragma unroll
        for (int s = 0; s < 16; ++s) {
            const int mp_ = 2 * s + hh; f32x4 cv = {0.f, 0.f, 0.f, 0.f};
            if (m32 < 16) { const float* cre = sp.c_re + ((size_t)dg * 16 + m32) * 64 + mp_; const float* cim = sp.c_im + ((size_t)dg * 16 + m32) * 64 + mp_;
                cv[0] = cre[0]; cv[1] = cre[32]; cv[2] = -cim[0]; cv[3] = -cim[32]; }
            v2u pc; pc.x = pkbf(cv[0], cv[1]); pc.y = pkbf(cv[2], cv[3]); cfr[s] = __builtin_bit_cast(bf16x4_t, pc);
        }
    }
#define S5U(x) __builtin_bit_cast(unsigned, (x))
        v4u q;
        q.x = S5U(ar[0]); q.y = S5U(ar[1]); q.z = S5U(ai[0]); q.w = S5U(ai[1]); *(v4u*)(par + (0 * 64 + lane) * 4) = q;
        q.x = S5U(a2r[0]); q.y = S5U(a2r[1]); q.z = S5U(a2i[0]); q.w = S5U(a2i[1]); *(v4u*)(par + (1 * 64 + lane) * 4) = q;
        q.x = S5U(a3r[0]); q.y = S5U(a3r[1]); q.z = S5U(a3i[0]); q.w = S5U(a3i[1]); *(v4u*)(par + (2 * 64 + lane) * 4) = q;
        q.x = S5U(a4r[0]); q.y = S5U(a4r[1]); q.z = S5U(a4i[0]); q.w = S5U(a4i[1]); *(v4u*)(par + (3 * 64 + lane) * 4) = q;
#undef S5U
#pragma unroll
        for (int i = 0; i < 4; ++i) { const v2u lo = __builtin_bit_cast(v2u, bfr[i][0]), hi = __builtin_bit_cast(v2u, bfr[i][1]); q.x = lo.x; q.y = lo.y; q.z = hi.x; q.w = hi.y; *(v4u*)(par + ((4 + i) * 64 + lane) * 4) = q; }
#pragma unroll
        for (int k = 0; k < 8; ++k) { const v2u lo = __builtin_bit_cast(v2u, cfr[2 * k]), hi = __builtin_bit_cast(v2u, cfr[2 * k + 1]); q.x = lo.x; q.y = lo.y; q.z = hi.x; q.w = hi.y; *(v4u*)(par + ((8 + k) * 64 + lane) * 4) = q; }
    }
}
struct S5U { v2u u[2][2]; };
__device__ __forceinline__ void s5_load_u(S5U& U, const bf16* P, int b, int g, int sg, int lane) {
    const int m32 = lane & 31, hh = lane >> 5, row0 = seg_row0(b, sg);
#pragma unroll
    for (int ch = 0; ch < 2; ++ch) { const bf16* urow = P + (size_t)((row0 + 32 * ch + m32) >> 2) * P4G + P4S5 + (m32 & 3) * 256 + g * 16 + 4 * hh;
        U.u[ch][0] = *(const v2u*)urow; U.u[ch][1] = *(const v2u*)(urow + 8); }
}
template <int MODE, int DIR>
__device__ __forceinline__ void s5_mm_dir(const S5P& sp, const S5U& U, int b, int g, int sg, int lane, float& hre, float& him, LAS float* yf, LAS unsigned char* hs, bf16* Z) {
    const int m32 = lane & 31, hh = lane >> 5, dg = DIR * 16 + g, row0 = seg_row0(b, sg);
    float ar[2], ai[2], a2r[2], a2i[2], a3r[2], a3i[2], a4r[2], a4i[2];
    bf16x4_t bfr[4][2];
    bf16x4_t cfr[16];
    {
        const unsigned* par = sp.par + (size_t)dg * 4096;
        v4u pq[16];
#pragma unroll
        for (int q = 0; q < ((MODE != 0) ? 16 : 8); ++q) pq[q] = GLD(v4u, par + q * 256, 16u * (unsigned)lane);
#define S5F(x) u2f_(x)
        ar[0] = S5F(pq[0].x); ar[1] = S5F(pq[0].y); ai[0] = S5F(pq[0].z); ai[1] = S5F(pq[0].w);
        a2r[0] = S5F(pq[1].x); a2r[1] = S5F(pq[1].y); a2i[0] = S5F(pq[1].z); a2i[1] = S5F(pq[1].w);
        a3r[0] = S5F(pq[2].x); a3r[1] = S5F(pq[2].y); a3i[0] = S5F(pq[2].z); a3i[1] = S5F(pq[2].w);
        a4r[0] = S5F(pq[3].x); a4r[1] = S5F(pq[3].y); a4i[0] = S5F(pq[3].z); a4i[1] = S5F(pq[3].w);
#undef S5F
#pragma unroll
        for (int i = 0; i < 4; ++i) { v2u lo, hi; lo.x = pq[4 + i].x; lo.y = pq[4 + i].y; hi.x = pq[4 + i].z; hi.y = pq[4 + i].w; bfr[i][0] = __builtin_bit_cast(bf16x4_t, lo); bfr[i][1] = __builtin_bit_cast(bf16x4_t, hi); }
        if (MODE != 0) {
#pragma unroll
            for (int k = 0; k < 8; ++k) { v2u lo, hi; lo.x = pq[8 + k].x; lo.y = pq[8 + k].y; hi.x = pq[8 + k].z; hi.y = pq[8 + k].w; cfr[2 * k] = __builtin_bit_cast(bf16x4_t, lo); cfr[2 * k + 1] = __builtin_bit_cast(bf16x4_t, hi); }
        }
    }
    const float ddv = (MODE == 2 && m32 < 16) ? sp.dd[g * 16 + m32] : 0.f;
    float hr[2], hi[2];
    hr[0] = __shfl(hre, m32); hi[0] = __shfl(him, m32); hr[1] = __shfl(hre, m32 + 32); hi[1] = __shfl(him, m32 + 32);
#pragma unroll 1
    for (int ci2 = 0; ci2 < 2; ++ci2) {
        const int ch = DIR ? 1 - ci2 : ci2, rowc = row0 + 32 * ch;
        const v2u x0 = ch ? U.u[1][0] : U.u[0][0], x1 = ch ? U.u[1][1] : U.u[0][1];
        const bf16x4_t ua0 = __builtin_bit_cast(bf16x4_t, x0), ua1 = __builtin_bit_cast(bf16x4_t, x1);
        if (MODE == 2) { *(LAS v2u*)(hs + 13312 + m32 * 32 + 8 * hh) = x0; *(LAS v2u*)(hs + 13312 + m32 * 32 + 16 + 8 * hh) = x1; }
        f32x16 BU[4];
#pragma unroll
        for (int nt = 0; nt < 4; ++nt) {
#pragma unroll
            for (int r = 0; r < 16; ++r) BU[nt][r] = 0.f;
            BU[nt] = MFMA8(ua0, bfr[nt][0], BU[nt]); BU[nt] = MFMA8(ua1, bfr[nt][1], BU[nt]);
        }
#pragma unroll
        for (int sh = 0; sh < 2; ++sh)
#pragma unroll
            for (int gg = 0; gg < 4; ++gg)
#pragma unroll
                for (int jj = 1; jj < 4; ++jj) {
                    const int r = DIR ? 4 * gg + 3 - jj : 4 * gg + jj, rp = DIR ? r + 1 : r - 1;
                    const float pr = BU[sh][rp], pi = BU[2 + sh][rp];
                    BU[sh][r] += ar[sh] * pr - ai[sh] * pi; BU[2 + sh][r] += ar[sh] * pi + ai[sh] * pr;
                }
        float hnr[2][4], hni[2][4];
        {
            float elr[2][4], eli[2][4], ehr[2][4], ehi[2][4];
#pragma unroll
            for (int sh = 0; sh < 2; ++sh)
#pragma unroll
                for (int gg = 0; gg < 4; ++gg) { const int rl = DIR ? 4 * gg : 4 * gg + 3;
                    const unsigned vr = f2u_(BU[sh][rl]), vi = f2u_(BU[2 + sh][rl]);
                    const auto sr = __builtin_amdgcn_permlane32_swap(vr, vr, false, false), si = __builtin_amdgcn_permlane32_swap(vi, vi, false, false);
                    elr[sh][gg] = u2f_((unsigned)sr[0]); ehr[sh][gg] = u2f_((unsigned)sr[1]); eli[sh][gg] = u2f_((unsigned)si[0]); ehi[sh][gg] = u2f_((unsigned)si[1]); }
            float tr[2], ti[2];
#pragma unroll
            for (int st = 0; st < 8; ++st) {
                const int grp = DIR ? 7 - st : st, gg = grp >> 1, half = grp & 1;
#pragma unroll
                for (int sh = 0; sh < 2; ++sh) {
                    if (half == (DIR ? 1 : 0)) { tr[sh] = hr[sh]; ti[sh] = hi[sh]; }
                    else { hnr[sh][gg] = (hh == half) ? hr[sh] : tr[sh]; hni[sh][gg] = (hh == half) ? hi[sh] : ti[sh]; }
                    const float er = half ? ehr[sh][gg] : elr[sh][gg], ei = half ? ehi[sh][gg] : eli[sh][gg];
                    const float nr = er + a4r[sh] * hr[sh] - a4i[sh] * hi[sh], ni = ei + a4r[sh] * hi[sh] + a4i[sh] * hr[sh];
                    hr[sh] = nr; hi[sh] = ni;
                }
            }
        }
        if (MODE != 0) {
#pragma unroll
            for (int sh = 0; sh < 2; ++sh)
#pragma unroll
                for (int gg = 0; gg < 4; ++gg)
#pragma unroll
                    for (int jj = 0; jj < 4; ++jj) {
                        const int pw = DIR ? 4 - jj : jj + 1;
                        const float pr = (pw == 1) ? ar[sh] : (pw == 2) ? a2r[sh] : (pw == 3) ? a3r[sh] : a4r[sh], pi = (pw == 1) ? ai[sh] : (pw == 2) ? a2i[sh] : (pw == 3) ? a3i[sh] : a4i[sh];
                        BU[sh][4 * gg + jj] += pr * hnr[sh][gg] - pi * hni[sh][gg]; BU[2 + sh][4 * gg + jj] += pr * hni[sh][gg] + pi * hnr[sh][gg];
                    }
#pragma unroll
            for (int r = 0; r < 16; ++r) { v2u w; w.x = pkbf(BU[0][r], BU[1][r]); w.y = pkbf(BU[2][r], BU[3][r]);
                *(LAS v2u*)(hs + ((r & 3) + 8 * (r >> 2) + 4 * hh) * 272 + m32 * 8) = w; }
            f32x16 Yv, Yw;
#pragma unroll
            for (int r = 0; r < 16; ++r) { Yv[r] = 0.f; Yw[r] = 0.f; }
#pragma unroll
            for (int s = 0; s < 16; s += 2) { Yv = MFMA8(ld4(hs + m32 * 272 + (8 * s + 4 * hh) * 2), cfr[s], Yv); Yw = MFMA8(ld4(hs + m32 * 272 + (8 * s + 8 + 4 * hh) * 2), cfr[s + 1], Yw); }
#pragma unroll
            for (int r = 0; r < 16; ++r) Yv[r] += Yw[r];
            if (m32 < 16) {
#pragma unroll
                for (int r = 0; r < 16; ++r) {
                    const int tl = (r & 3) + 8 * (r >> 2) + 4 * hh;
                    if (MODE == 1) yf[(32 * ch + tl) * 16 + m32] = Yv[r];
                    else { const float u = bf2f(*(const LAS unsigned short*)(hs + 13312 + tl * 32 + m32 * 2));
                        const float y = Yv[r] + yf[(32 * ch + tl) * 16 + m32] + ddv * u;
                        const float zz = gelu_tanh(y); Z[(size_t)(rowc + tl) * 256 + g * 16 + m32] = (bf16)pkbf(zz, zz); }
                }
            }
        }
    }
    hre = hh ? hr[1] : hr[0]; him = hh ? hi[1] : hi[0];
}
template <int MODE>
__device__ __forceinline__ void s5_mm(const S5P& sp, const S5U& U, int b, int g, int dir, int sg, int lane, float& hre, float& him, LAS float* yf, LAS unsigned char* hs, bf16* Z) {
    if (dir) s5_mm_dir<MODE, 1>(sp, U, b, g, sg, lane, hre, him, yf, hs, Z); else s5_mm_dir<MODE, 0>(sp, U, b, g, sg, lane, hre, him, yf, hs, Z);
}
template <int MIX, int DIR, bool WITH_O>
__device__ __forceinline__ void mx_chunk(LAS unsigned char* wl, int lane, float Pl, f32x16 (&ST)[(MIX == 2) ? 1 : 2][2], f32x16 (&O)[2]) {
    constexpr int DK = (MIX == 2) ? 32 : 64, NRT = DK / 32;
    const int m32 = lane & 31, hh = lane >> 5;
    asm volatile("" ::: "memory");
    if (lane < DK) *(LAS float*)(wl + WL_PL + lane * 4) = Pl;
    asm volatile("" ::: "memory");
    if (WITH_O) {
        f32x16 x;
#pragma unroll
        for (int r = 0; r < 16; ++r) x[r] = 0.f;
#pragma unroll
        for (int s = 0; s < DK / 8; ++s) {
            const bf16x4_t ka = ld4(wl + WL_KC + m32 * 144 + (8 * s + 4 * hh) * 2);
            const bf16x4_t qb = ld4(wl + WL_QC + m32 * 144 + (8 * s + 4 * hh) * 2);
            x = MFMA8(ka, qb, x);
        }
#pragma unroll
        for (int r = 0; r < 16; ++r) { const int j = (r & 3) + 8 * (r >> 2) + 4 * hh; const bool keep = DIR ? (j >= m32) : (j <= m32); x[r] = keep ? x[r] : 0.f; }
#pragma unroll
        for (int t = 0; t < 2; ++t)
#pragma unroll
            for (int r = 0; r < 16; ++r) O[t][r] = 0.f;
#pragma unroll
        for (int s = 0; s < 4; ++s) {
            const bf16x4_t xa = pack4(x, s);
#pragma unroll
            for (int t = 0; t < 2; ++t) O[t] = MFMA8(ld4(wl + WL_VT + (32 * t + m32) * 80 + (8 * s + 4 * hh) * 2), xa, O[t]);
        }
#pragma unroll
        for (int rt = 0; rt < NRT; ++rt)
#pragma unroll
            for (int s = 0; s < 4; ++s) {
                const bf16x4_t qa = ld4(wl + WL_QC + m32 * 144 + (32 * rt + 8 * s + 4 * hh) * 2);
#pragma unroll
                for (int t = 0; t < 2; ++t) O[t] = MFMA8(pack4(ST[rt][t], s), qa, O[t]);
            }
    }
    {
        v4u kk4[NRT][2], vv4[2][2];
#pragma unroll
        for (int p2 = 0; p2 < 2; ++p2) {
#pragma unroll
            for (int rt = 0; rt < NRT; ++rt) kk4[rt][p2] = *(const LAS v4u*)(wl + WL_KT + (32 * rt + m32) * 80 + (16 * p2 + 8 * hh) * 2);
#pragma unroll
            for (int t = 0; t < 2; ++t) vv4[t][p2] = *(const LAS v4u*)(wl + WL_VT + (32 * t + m32) * 80 + (16 * p2 + 8 * hh) * 2);
        }
#pragma unroll
        for (int p2 = 0; p2 < 2; ++p2)
#pragma unroll
            for (int e = 0; e < 2; ++e)
#pragma unroll
                for (int rt = 0; rt < NRT; ++rt) { v2u ku; ku.x = e ? kk4[rt][p2].z : kk4[rt][p2].x; ku.y = e ? kk4[rt][p2].w : kk4[rt][p2].y; const bf16x4_t ka = __builtin_bit_cast(bf16x4_t, ku);
#pragma unroll
                    for (int t = 0; t < 2; ++t) { v2u vu; vu.x = e ? vv4[t][p2].z : vv4[t][p2].x; vu.y = e ? vv4[t][p2].w : vv4[t][p2].y; ST[rt][t] = MFMA8(ka, __builtin_bit_cast(bf16x4_t, vu), ST[rt][t]); } }
    }
#pragma unroll
    for (int rt = 0; rt < NRT; ++rt)
#pragma unroll
        for (int g = 0; g < 4; ++g) {
            const f32x4 pl4 = *(const LAS f32x4*)(wl + WL_PL + (32 * rt + 8 * g + 4 * hh) * 4);
#pragma unroll
            for (int e = 0; e < 4; ++e) { ST[rt][0][4 * g + e] *= pl4[e]; ST[rt][1][4 * g + e] *= pl4[e]; }
        }
}
__device__ __forceinline__ float half_sum(float v) {
#pragma unroll
    for (int o = 1; o < 32; o <<= 1) v += __shfl_xor(v, o);
    return v;
}
template <int MIX, int DIR>
__device__ __forceinline__ void mixA_stream(const MixP& mp, const MxC& c, int row0, int tpos0, int lane, LAS unsigned char* wl, f32x16 (&ST)[(MIX == 2) ? 1 : 2][2], float& Gam) {
    f32x16 O[2];
    MxRaw r[8];
#pragma unroll
    for (int i = 0; i < 8; ++i) mx_load<MIX, false, DIR>(r[i], mp, c, row0, i);
    float rc = 1.0f, rs = 0.0f;
    if (MIX == 0 && tpos0 >= 0) { const int tpos = tpos0 + (DIR ? 63 : 0); const int pos = (lane & 32) ? (tpos & 63) : (tpos >> 6);
        const unsigned ro = 4u * (unsigned)(pos * 16 + (lane & 15)); rc = GLD(float, mp.rcos, ro); rs = GLD(float, mp.rsin, ro); }
    float P = 1.0f;
#pragma unroll 1
    for (int cki = 0; cki < 2; ++cki) {
        int ck = cki; asm volatile("" : "+s"(ck));
        int ln = lane; asm volatile("" : "+v"(ln));
#pragma unroll
        for (int j = 0; j < 8; ++j) {
            mx_batch<MIX, false, DIR>(r[j], mp, c, tpos0, ln, wl, j, P, rc, rs);
            if (ck == 0) mx_load<MIX, false, DIR>(r[j], mp, c, row0, 8 + j);
        }
        Gam *= P; mx_chunk<MIX, 0, false>(wl, ln, P, ST, O); P = 1.0f;
    }
}
template <int MIX>
__device__ __forceinline__ void mixA_unit(const MixP& mp, float* STG, int idx, int lane_in, LAS unsigned char* wl) {
    int lane = lane_in;
    constexpr int DK = (MIX == 2) ? 32 : 64, NRT = DK / 32;
    const int dir = idx / 2112, rem = idx - dir * 2112, bh = rem / NSEG, sg = rem - bh * NSEG, b = bh >> 2, h = bh & 3;
    asm volatile("" : "+v"(lane));
    MxC c; mx_consts<MIX>(c, mp, h, dir, lane);
    f32x16 ST[NRT][2];
#pragma unroll
    for (int rt = 0; rt < NRT; ++rt)
#pragma unroll
        for (int t = 0; t < 2; ++t)
#pragma unroll
            for (int r = 0; r < 16; ++r) ST[rt][t][r] = 0.f;
    const int row0 = seg_row0(b, sg), tpos0 = seg_tpos0(sg);
    float Gam = 1.0f;
    if (dir) mixA_stream<MIX, 1>(mp, c, row0, tpos0, lane, wl, ST, Gam); else mixA_stream<MIX, 0>(mp, c, row0, tpos0, lane, wl, ST, Gam);
    const size_t slot = (size_t)((dir * 16 + bh) * NSEG + sg);
    bf16* ds = (bf16*)(STG + (MIX == 0 ? ST_DS0 : (MIX == 1 ? ST_DS1 : ST_DS2))) + slot * (DK * 64);
    const int m32 = lane & 31, hh = lane >> 5;
#pragma unroll
    for (int rt = 0; rt < NRT; ++rt)
#pragma unroll
        for (int t = 0; t < 2; ++t)
#pragma unroll
            for (int r4 = 0; r4 < 4; ++r4) { v2u v; v.x = pkbf(ST[rt][t][4 * r4], ST[rt][t][4 * r4 + 1]); v.y = pkbf(ST[rt][t][4 * r4 + 2], ST[rt][t][4 * r4 + 3]);
                GST(v2u, ds + ((rt * 2 + t) * 4 + r4) * 256, 8u * (unsigned)lane) = v; }
    float* gs = STG + (MIX == 0 ? ST_G0 : (MIX == 1 ? ST_G1 : ST_G2)) + slot * 64;
    GST(float, gs, 4u * (unsigned)lane) = Gam;
}
__device__ __forceinline__ void mx_epi_gates(const MixP& mp, int lane, int rowc, int gcol, v2u (&g)[2][4]) {
    const int m32 = lane & 31, hh = lane >> 5;
    const bf16* gb = mp.P + (size_t)(rowc >> 2) * P4G + gcol;
    const unsigned gvo = 2u * (unsigned)((m32 >> 2) * P4G + (m32 & 3) * 256 + 4 * hh);
#pragma unroll
    for (int t = 0; t < 2; ++t)
#pragma unroll
        for (int s = 0; s < 4; ++s) g[t][s] = GLD(v2u, gb + 32 * t + 8 * s, gvo);
}
__device__ __forceinline__ void mx_epi_of(int lane, const float* OFc, v2u (&of)[2][4]) {
#pragma unroll
    for (int t = 0; t < 2; ++t)
#pragma unroll
        for (int s = 0; s < 4; ++s) of[t][s] = GLD(v2u, (const bf16*)OFc + (t * 4 + s) * 256, 8u * (unsigned)lane);
}
template <int MIX, int MODE>
__device__ __forceinline__ void mx_epilogue(const MixP& mp, LAS unsigned char* wl, int lane, f32x16 (&O)[2], int rowc, float* OFc, bf16* Y, int ycol, const v2u (&g)[2][4], const v2u (&of)[2][4]) {
    const int m32 = lane & 31, hh = lane >> 5;
    if (MODE == 1) {
#pragma unroll
        for (int t = 0; t < 2; ++t)
#pragma unroll
            for (int s = 0; s < 4; ++s) { v2u v; v.x = pkbf(O[t][4 * s], O[t][4 * s + 1]); v.y = pkbf(O[t][4 * s + 2], O[t][4 * s + 3]); GST(v2u, (bf16*)OFc + (t * 4 + s) * 256, 8u * (unsigned)lane) = v; }
    } else {
#pragma unroll
        for (int t = 0; t < 2; ++t)
#pragma unroll
            for (int s = 0; s < 4; ++s)
#pragma unroll
                for (int j = 0; j < 4; ++j) O[t][4 * s + j] += bfx(of[t][s], j);
        float mean = 0.f;
        if (MIX == 0) { float sm = 0.f;
#pragma unroll
            for (int t = 0; t < 2; ++t)
#pragma unroll
                for (int r = 0; r < 16; ++r) sm += O[t][r];
            sm += __shfl_xor(sm, 32); mean = sm * (1.0f / 64.0f); }
        float ss = 0.f;
#pragma unroll
        for (int t = 0; t < 2; ++t)
#pragma unroll
            for (int r = 0; r < 16; ++r) { const float d = O[t][r] - mean; ss = fmaf(d, d, ss); }
        ss += __shfl_xor(ss, 32);
        const float rs = __builtin_amdgcn_rsqf(ss * (1.0f / 64.0f) + NEPS), mo = -mean * rs;
        asm volatile("" ::: "memory");
#pragma unroll
        for (int t = 0; t < 2; ++t)
#pragma unroll
            for (int s = 0; s < 4; ++s) { float y[4];
#pragma unroll
                for (int j = 0; j < 4; ++j) y[j] = fmaf(O[t][4 * s + j], rs, mo) * silu_f(bfx(g[t][s], j));
                v2u w; w.x = pkbf(y[0], y[1]); w.y = pkbf(y[2], y[3]);
                *(LAS v2u*)(wl + WL_QC + m32 * 144 + (32 * t + 8 * s + 4 * hh) * 2) = w; }
        asm volatile("" ::: "memory");
#pragma unroll
        for (int k = 0; k < 4; ++k) { const v4u w = *(const LAS v4u*)(wl + WL_QC + ((lane >> 3) + 8 * k) * 144 + (lane & 7) * 16);
            GST(v4u, Y + (size_t)(rowc + 8 * k) * 1024 + ycol, 2u * (unsigned)((lane >> 3) * 1024 + (lane & 7) * 8)) = w; }
        asm volatile("" ::: "memory");
    }
}
template <int MIX, int DIR>
__device__ __forceinline__ void mixC_stream(const MixP& mp, const MxC& c, int row0, int tpos0, int lane, LAS unsigned char* wl, f32x16 (&ST)[(MIX == 2) ? 1 : 2][2],
                                            const bf16* ds, float* OFu, bf16* Y, int ycol, int gcol) {
    f32x16 O[2];
    MxRaw r[4];
#pragma unroll
    for (int i = 0; i < 3; ++i) mx_load<MIX, true, DIR>(r[i], mp, c, row0, i);
    {
#pragma unroll
        for (int rt = 0; rt < ((MIX == 2) ? 1 : 2); ++rt)
#pragma unroll
            for (int t = 0; t < 2; ++t)
#pragma unroll
                for (int r4 = 0; r4 < 4; ++r4) { const v2u v = GLD(v2u, ds + ((rt * 2 + t) * 4 + r4) * 256, 8u * (unsigned)lane);
                    ST[rt][t][4 * r4] = bfx(v, 0); ST[rt][t][4 * r4 + 1] = bfx(v, 1); ST[rt][t][4 * r4 + 2] = bfx(v, 2); ST[rt][t][4 * r4 + 3] = bfx(v, 3); }
    }
    float rc = 1.0f, rs = 0.0f;
    if (MIX == 0 && tpos0 >= 0) { const int tpos = tpos0 + (DIR ? 63 : 0); const int pos = (lane & 32) ? (tpos & 63) : (tpos >> 6);
        const unsigned ro = 4u * (unsigned)(pos * 16 + (lane & 15)); rc = GLD(float, mp.rcos, ro); rs = GLD(float, mp.rsin, ro); }
    float P = 1.0f;
#pragma unroll 1
    for (int b4i = 0; b4i < 16; b4i += 4) {
        int b4 = b4i; asm volatile("" : "+s"(b4));
        int ln = lane; asm volatile("" : "+v"(ln));
#pragma unroll
        for (int j = 0; j < 4; ++j) {
            if (b4 < 12 || j == 0) mx_load<MIX, true, DIR>(r[(j + 3) & 3], mp, c, row0, b4 + j + 3);
            mx_batch<MIX, true, DIR>(r[j], mp, c, tpos0, ln, wl, (b4 & 4) + j, P, rc, rs);
        }
        if (b4 & 4) {
            const int ck = b4 >> 3, ch = DIR ? 1 - ck : ck; float* OFc = OFu + (size_t)ch * (12 * 2048);
            v2u g[2][4], of[2][4];
            mx_chunk<MIX, DIR, true>(wl, ln, P, ST, O); P = 1.0f;
            if (DIR) { mx_epi_gates(mp, ln, row0 + 32 * ch, gcol, g); mx_epi_of(ln, OFc, of); }
            mx_epilogue<MIX, DIR ? 2 : 1>(mp, wl, ln, O, row0 + 32 * ch, OFc, Y, ycol, g, of);
        }
    }
}
template <int MIX>
__device__ __forceinline__ void mixC_unit(const MixP& mp, const float* STG, int idx, int lane_in, float* OF, LAS unsigned char* wl, bf16* Y) {
    int lane = lane_in; asm volatile("" : "+v"(lane));
    constexpr int DK = (MIX == 2) ? 32 : 64, NRT = DK / 32;
    const int bh = idx / NSEG, sg = idx - bh * NSEG, b = bh >> 2, h = bh & 3;
    const int row0 = seg_row0(b, sg), tpos0 = seg_tpos0(sg);
    const int ycol = ((MIX == 0) ? 0 : (MIX == 1 ? 512 : 768)) + h * 64;
    const int gcol = 4 * ((MIX == 0) ? C_RG : (MIX == 1 ? C_HG : C_GG)) + h * 64;
    float* OFu = OF + ((size_t)(row0 >> 5) * 12 + MIX * 4 + h) * 2048;
    const bf16* dsb = (const bf16*)(STG + (MIX == 0 ? ST_DS0 : (MIX == 1 ? ST_DS1 : ST_DS2)));
    f32x16 ST[NRT][2];
#pragma unroll 1
    for (int dir = 0; dir < 2; ++dir) {
        asm volatile("" : "+v"(lane));
        const int m32 = lane & 31, hh = lane >> 5;
        MxC c; mx_consts<MIX>(c, mp, h, dir, lane);
        const bf16* ds = dsb + (size_t)((dir * 16 + bh) * NSEG + sg) * (DK * 64);
        if (dir == 0) mixC_stream<MIX, 0>(mp, c, row0, tpos0, lane, wl, ST, ds, OFu, Y, ycol, gcol);
        else mixC_stream<MIX, 1>(mp, c, row0, tpos0, lane, wl, ST, ds, OFu, Y, ycol, gcol);
        asm volatile("s_waitcnt vmcnt(0)" ::: "memory");
    }
}
template <int MSEL>
__device__ __forceinline__ void mix_passA(const Frame& F, const Args& a, int l) {
    const MixP mp = make_mixp(F, a, l); const S5P sp = make_s5p(F, a, l);
    float* ST = (float*)(F.ws + WS_X2);
    LAS unsigned char* wl = F.lds + F.wave * WL_BYTES; LAS float* stg = (LAS float*)wl;
    if (MSEL == 15) {
        constexpr int NMX = 3 * 4224, NS5 = 2 * 64 * NSEG;
        const int heavy = NMX - (NMX / F.NGW) * F.NGW, nlight = F.NGW - heavy;
        const int n_all = (NS5 - 4 * nlight) / F.NGW;
        for (int it = 0; ; ++it) {
            int u;
            const int nmine = NMX / F.NGW + (F.gw < heavy ? 1 : 0);
            if (it < nmine) u = F.gw + it * F.NGW;
            else if (it < nmine + n_all) u = NMX + F.gw + (it - nmine) * F.NGW;
            else { const int k2 = it - nmine - n_all; if (F.gw < heavy || k2 >= 4) {
                    const int rest0 = NMX + n_all * F.NGW + 4 * nlight; const int uu = rest0 + F.gw + (k2 - (F.gw < heavy ? 0 : 4)) * F.NGW; if (uu >= NMX + NS5) break; u = uu; }
                else u = NMX + n_all * F.NGW + (F.gw - heavy) + k2 * nlight; }
            if (u >= NMX + NS5) break;
            if (u < 4224) mixA_unit<0>(mp, ST, u, fresh_lane(), wl);
            else if (u < 2 * 4224) mixA_unit<1>(mp, ST, u - 4224, fresh_lane(), wl);
            else if (u < 3 * 4224) mixA_unit<2>(mp, ST, u - 2 * 4224, fresh_lane(), wl);
            else { const int idx = u - 3 * 4224; const int dir = idx / (64 * NSEG), rem = idx - dir * 64 * NSEG, bg = rem / NSEG, sg = rem - bg * NSEG;
                float hre = 0.f, him = 0.f;
                S5U U; s5_load_u(U, mp.P, bg >> 4, bg & 15, sg, fresh_lane()); s5_mm<0>(sp, U, bg >> 4, bg & 15, dir, sg, fresh_lane(), hre, him, nullptr, wl, nullptr);
                float* hs = ST + ST_HS + ((size_t)((dir * 64 + bg) * NSEG + sg) * 64 + fresh_lane()) * 2;
                hs[0] = hre; hs[1] = him; }
        }
        return;
    }
    if (MSEL & 1) for (int u = F.gw; u < 4224; u += F.NGW) mixA_unit<0>(mp, ST, u, fresh_lane(), wl);
    if (MSEL & 2) for (int u = F.gw; u < 4224; u += F.NGW) mixA_unit<1>(mp, ST, u, fresh_lane(), wl);
    if (MSEL & 4) for (int u = F.gw; u < 4224; u += F.NGW) mixA_unit<2>(mp, ST, u, fresh_lane(), wl);
    if (MSEL & 8) for (int idx = F.gw; idx < 2 * 64 * NSEG; idx += F.NGW) {
        const int dir = idx / (64 * NSEG), rem = idx - dir * 64 * NSEG, bg = rem / NSEG, sg = rem - bg * NSEG;
        float hre = 0.f, him = 0.f;
        S5U U; s5_load_u(U, mp.P, bg >> 4, bg & 15, sg, fresh_lane()); s5_mm<0>(sp, U, bg >> 4, bg & 15, dir, sg, fresh_lane(), hre, him, nullptr, wl, nullptr);
        float* hs = ST + ST_HS + ((size_t)((dir * 64 + bg) * NSEG + sg) * 64 + fresh_lane()) * 2;
        hs[0] = hre; hs[1] = him;
    }
}
__device__ __forceinline__ int chain_seg(int dir, int p) { return dir ? (p < 4 ? 3 - p : 135 - p) : p; }
__device__ __forceinline__ void mix_passB(const Frame& F, const Args& a, int l) {
    float* ST = (float*)(F.ws + WS_X2);
    constexpr int N0 = 32768, N1 = 32768, N2 = 16384, N3 = 8192;
    for (int e = blockIdx.x * 512 + F.tid; e < N0 + N1 + N2 + N3; e += F.G * 512) {
        if (e < N0 + N1 + N2) {
            bf16* base; const float* gb; int dir, esz;
            if (e < N0 + N1) { const int mix = e >= N0, e2 = e - mix * N0, c = e2 >> 10, el = (e2 & 1023) * 4; dir = c >> 4; esz = 4096;
                base = (bf16*)(ST + (mix ? ST_DS1 : ST_DS0)) + (size_t)c * NSEG * 4096 + el; gb = ST + (mix ? ST_G1 : ST_G0) + (size_t)c * NSEG * 64 + 32 * (el >> 11) + 8 * ((el >> 8) & 3) + 4 * ((el >> 7) & 1); }
            else { const int e2 = e - N0 - N1, c = e2 >> 9, el = (e2 & 511) * 4; dir = c >> 4; esz = 2048;
                base = (bf16*)(ST + ST_DS2) + (size_t)c * NSEG * 2048 + el; gb = ST + ST_G2 + (size_t)c * NSEG * 64 + 8 * ((el >> 8) & 3) + 4 * ((el >> 7) & 1); }
            f32x4 run = {0.f, 0.f, 0.f, 0.f};
#pragma unroll 1
            for (int p0 = 0; p0 < NSEG; p0 += 12) {
                f32x4 d[12], gm[12];
#pragma unroll
                for (int q = 0; q < 12; ++q) { const int sg = chain_seg(dir, p0 + q); const v2u w = *(const v2u*)(base + (size_t)sg * esz); d[q] = (f32x4){bfx(w, 0), bfx(w, 1), bfx(w, 2), bfx(w, 3)}; gm[q] = *(const f32x4*)(gb + sg * 64); }
#pragma unroll
                for (int q = 0; q < 12; ++q) { const int sg = chain_seg(dir, p0 + q); v2u w; w.x = pkbf(run[0], run[1]); w.y = pkbf(run[2], run[3]); *(v2u*)(base + (size_t)sg * esz) = w; run = run * gm[q] + d[q]; }
            }
        } else {
            const int e2 = e - N0 - N1 - N2, c = e2 >> 6, p = e2 & 63, dir = c >> 6, g = c & 15;
            const int dg = dir * 16 + g;
            const float lre = a.in[F.zz + I_LAMRE][(size_t)l * 2048 + dg * 64 + p], lim = a.in[F.zz + I_LAMIM][(size_t)l * 2048 + dg * 64 + p], dt = expf(a.in[F.zz + I_LOGDT][l * 32 + dg]);
            const float er = expf(lre * dt * 64.0f); const float sn = sinf(lim * dt * 64.0f), cs = cosf(lim * dt * 64.0f);
            const float ar = er * cs, ai = er * sn;
            float* base = ST + ST_HS + ((size_t)c * NSEG * 64 + p) * 2;
            float rr = 0.f, ri = 0.f;
#pragma unroll 1
            for (int q0 = 0; q0 < NSEG; q0 += 12) {
                float dr[12], di[12];
#pragma unroll
                for (int q = 0; q < 12; ++q) { const int sg = chain_seg(dir, q0 + q); dr[q] = base[(size_t)sg * 128]; di[q] = base[(size_t)sg * 128 + 1]; }
#pragma unroll
                for (int q = 0; q < 12; ++q) { const int sg = chain_seg(dir, q0 + q); base[(size_t)sg * 128] = rr; base[(size_t)sg * 128 + 1] = ri;
                    const float nr = ar * rr - ai * ri + dr[q], ni = ar * ri + ai * rr + di[q]; rr = nr; ri = ni; }
            }
        }
    }
}
template <int MSEL>
__device__ __forceinline__ void mix_passC(const Frame& F, const Args& a, int l) {
    const MixP mp = make_mixp(F, a, l); const S5P sp = make_s5p(F, a, l);
    const float* ST = (const float*)(F.ws + WS_X2);
    LAS unsigned char* wl = F.lds + F.wave * WL_BYTES;
    LAS float* stg = (LAS float*)wl; LAS float* of = (LAS float*)(wl + 9216);
    float* OF = (float*)(F.ws + WS_OF);
    bf16* Y = (bf16*)(F.ws + WS_ACT); bf16* Z = (bf16*)(F.ws + WS_Z);
    const bool keep = l < DEPTH - 1;
    constexpr int NM = 16 * NSEG;
    if (MSEL == 15) {
        constexpr int NMX = 3 * NM, NS5 = 64 * NSEG;
        const int heavy = NMX - (NMX / F.NGW) * F.NGW, nlight = F.NGW - heavy;
        for (int it = 0; ; ++it) {
            int u;
            const int nmine = NMX / F.NGW + (F.gw < heavy ? 1 : 0);
            if (it < nmine) u = F.gw + it * F.NGW;
            else { if (F.gw < heavy) break; u = NMX + (F.gw - heavy) + (it - nmine) * nlight; }
            if (u >= NMX + NS5) break;
            const int sgu = (u < 3 * NM) ? (u % NSEG) : ((u - 3 * NM) % NSEG);
            if (!keep && sgu < 4) continue;
            if (u < NM) mixC_unit<0>(mp, ST, u, fresh_lane(), OF, wl, Y);
            else if (u < 2 * NM) mixC_unit<1>(mp, ST, u - NM, fresh_lane(), OF, wl, Y);
            else if (u < 3 * NM) mixC_unit<2>(mp, ST, u - 2 * NM, fresh_lane(), OF, wl, Y);
            else { const int idx = u - 3 * NM, bg = idx / NSEG, sg = idx - bg * NSEG;
                S5U U; s5_load_u(U, mp.P, bg >> 4, bg & 15, sg, fresh_lane());
                const float* h0 = ST + ST_HS + ((size_t)((0 * 64 + bg) * NSEG + sg) * 64 + fresh_lane()) * 2;
                float hre = h0[0], him = h0[1];
                s5_mm<1>(sp, U, bg >> 4, bg & 15, 0, sg, fresh_lane(), hre, him, of, wl, Z);
                const float* h1 = ST + ST_HS + ((size_t)((1 * 64 + bg) * NSEG + sg) * 64 + fresh_lane()) * 2;
                hre = h1[0]; him = h1[1];
                s5_mm<2>(sp, U, bg >> 4, bg & 15, 1, sg, fresh_lane(), hre, him, of, wl, Z); }
        }
        return;
    }
    if (MSEL & 1) for (int u = F.gw; u < NM; u += F.NGW) { if (!keep && (u % NSEG) < 4) continue; mixC_unit<0>(mp, ST, u, fresh_lane(), OF, wl, Y); }
    if (MSEL & 2) for (int u = F.gw; u < NM; u += F.NGW) { if (!keep && (u % NSEG) < 4) continue; mixC_unit<1>(mp, ST, u, fresh_lane(), OF, wl, Y); }
    if (MSEL & 4) for (int u = F.gw; u < NM; u += F.NGW) { if (!keep && (u % NSEG) < 4) continue; mixC_unit<2>(mp, ST, u, fresh_lane(), OF, wl, Y); }
    if (MSEL & 8) for (int idx = F.gw; idx < 64 * NSEG; idx += F.NGW) {
        const int bg = idx / NSEG, sg = idx - bg * NSEG;
        if (!keep && sg < 4) continue;
        S5U U; s5_load_u(U, mp.P, bg >> 4, bg & 15, sg, fresh_lane());
        const float* h0 = ST + ST_HS + ((size_t)((0 * 64 + bg) * NSEG + sg) * 64 + fresh_lane()) * 2;
        float hre = h0[0], him = h0[1];
        s5_mm<1>(sp, U, bg >> 4, bg & 15, 0, sg, fresh_lane(), hre, him, of, wl, Z);
        const float* h1 = ST + ST_HS + ((size_t)((1 * 64 + bg) * NSEG + sg) * 64 + fresh_lane()) * 2;
        hre = h1[0]; him = h1[1];
        s5_mm<2>(sp, U, bg >> 4, bg & 15, 1, sg, fresh_lane(), hre, him, of, wl, Z);
    }
}

constexpr int NPH = 11;
template <int PH_MASK, int MSEL>
__global__ void __launch_bounds__(512, 2) mk_fwd(Args a) {
    extern __shared__ __attribute__((aligned(16))) unsigned char lds_raw[];
    Frame F;
    F.lds = (LAS unsigned char*)lds_raw;
    const int wave0 = __builtin_amdgcn_readfirstlane((int)threadIdx.x >> 6);
    F.lane = fresh_lane(); F.tid = wave0 * 64 + F.lane; F.wave = wave0;
    F.G = gridDim.x; F.gw = blockIdx.x * 8 + F.wave; F.NGW = F.G * 8; F.zz = 0; F.ws = (unsigned char*)a.in[I_WS]; F.out = (float*)a.in[I_OUT];
    volatile LAS unsigned* MISC = (volatile LAS unsigned*)(F.lds + MISC_OFF);
    for (int u = F.tid; u < 64; u += 512) ((LAS unsigned*)(F.lds + MISC_OFF))[u] = 0u;
    __syncthreads();
    XcdBarrier bar; bar.bar = (unsigned*)F.ws + CW_BAR; bar.x = 0; bar.st = nullptr;
    if (a.fused) bar = xcd_barrier_post((unsigned*)F.ws + CW_BAR, MISC + 8, F.tid);
#define SEAM() do { if (a.fused) { XcdBarrier bb = bar; asm volatile("" : "+s"(bb.bar), "+s"(bb.x)); xcd_barrier(bb, wave0 * 64 + fresh_lane()); } } while (0)
#define PHASE_BEGIN() do { int zz_ = 0; asm volatile("" : "+s"(zz_)); F.zz = zz_; F.ws = (unsigned char*)a.in[I_WS + zz_]; F.out = (float*)a.in[I_OUT + zz_]; \
        const int ln_ = fresh_lane(); const int t_ = wave0 * 64 + ln_ + zz_; F.tid = t_; F.lane = t_ & 63; F.wave = wave0 + zz_; F.G = (int)gridDim.x + zz_; F.gw = ((int)blockIdx.x + zz_) * 8 + F.wave; F.NGW = F.G * 8; \
        F.lds = (LAS unsigned char*)lds_raw + zz_; } while (0)
#define IN(k) (((PH_MASK >> (k)) & 1) && a.ph_lo <= (k) && (k) < a.ph_hi)
#ifndef DUP_PH
#define DUP_PH 0
#endif
constexpr int TAILB = 16;
#define REP(k) for (int rep_ = 0; rep_ < (((DUP_PH >> (k)) & 1) ? 2 : 1); ++rep_)
#define hb ((float*)(F.ws + WS_HB))
#define MOD ((const float*)(F.ws + WS_MOD))
#define ACT ((bf16*)(F.ws + WS_ACT))
#define PH ((bf16*)(F.ws + WS_PH))

    if (((PH_MASK >> 12) & 1) && a.do_pro) REP(12) { PHASE_BEGIN(); s5_build(F, a); prologue(F, a); SEAM(); }

#pragma unroll
    for (int l = 0; l < DEPTH; ++l) {
        if (l < a.l_lo || l >= a.l_hi) continue;
        const bool keep = l < DEPTH - 1, moe = l & 1; const int j = l >> 1;
        const int Mrows = keep ? MT : NLAT;
        if (IN(0)) { PHASE_BEGIN();
            if ((l & 1) && F.G > TAILB) {
                if ((int)blockIdx.x < TAILB) {
                    const int lp = l - 1, jp = lp >> 1;
                    int k8 = DFF / 2; asm volatile("" : "+s"(k8)); pg8::Gemm g{(const bf16*)((const unsigned char*)PH + (size_t)NLAT * DFF), (const bf16*)(F.ws + WS_W2D + (size_t)jp * 1024 * DFF), MT - NLAT, 1024, k8}; pg8::StaticOrder S; S.init(MT - NLAT, 1024, TAILB, (int)blockIdx.x);
                    EpiResid E{F.out, hb, F.out, hb, MOD + (size_t)lp * 5 * 6144 + 5 * 1024, 1.0f / WSC8, NLAT / 256};
                    pg8::gemm_phase_f8<EpiResid, pg8::StaticOrder, true, true>(F.lds, g, S, E, F.tid);
                    group_arrive((unsigned*)F.ws + CW_TAIL + (2 * l + 1) * 64, F.tid);
                } else {
                    moe_cvt_range(F, a, j, TAILB, 0, 8 * 3 * 1408);
                    norm_phase<0>(F, a, l, 0, NLAT, -1, 0, ((int)blockIdx.x - TAILB) * 8 + F.wave, (F.G - TAILB) * 8);
                }
                group_wait((unsigned*)F.ws + CW_BAR, (unsigned*)F.ws + CW_TAIL + (2 * l + 1) * 64, TAILB, F.tid);
                norm_phase<0>(F, a, l, 0, MT, -1, NLAT, F.gw, F.NGW);
            } else {
                if (l & 1) moe_cvt(F, a, j);
                norm_phase<0>(F, a, l, 0, MT, (l == 2) ? 1 : -1);
            }
            SEAM();
        }
        if (IN(1)) REP(1) { PHASE_BEGIN();
            pg8::Gemm g{ACT, (const bf16*)(F.ws + WS_WIN) + (size_t)l * DINP * 1024, MT, DINP, 1024}; pg8::StaticOrder S; S.init(MT, DINP, F.G, (int)blockIdx.x);
            EpiStoreP4 E{PH};
            pg8::gemm_phase<EpiStoreP4, pg8::StaticOrder, true, true>(F.lds, g, S, E, F.tid);
            SEAM();
        }
        if (IN(2)) { PHASE_BEGIN(); mix_passA<MSEL>(F, a, l); SEAM(); }
#ifdef DUP_MIX
        if (IN(2)) { PHASE_BEGIN(); mix_passA<DUP_MIX>(F, a, l); SEAM(); }
#endif
#ifdef DUP_A
        if (IN(2)) { PHASE_BEGIN(); mix_passA<DUP_A>(F, a, l); SEAM(); }
#endif
        if (IN(3)) { PHASE_BEGIN(); mix_passB(F, a, l); SEAM(); }
        if (IN(4)) { PHASE_BEGIN(); mix_passC<MSEL>(F, a, l); SEAM(); }
#ifdef DUP_MIX
        if (IN(4)) { PHASE_BEGIN(); mix_passC<DUP_MIX>(F, a, l); SEAM(); }
#endif
#ifdef DUP_C
        if (IN(4)) { PHASE_BEGIN(); mix_passC<DUP_C>(F, a, l); SEAM(); }
#endif
        if (IN(5)) REP(5) { PHASE_BEGIN();
            int k256 = 256; asm volatile("" : "+s"(k256)); pg8::Gemm g{(const bf16*)(F.ws + WS_Z), (const bf16*)(F.ws + WS_GLUW) + (size_t)l * 65536, Mrows, 256, k256}; pg8::StaticOrder S; S.init(Mrows, 256, F.G, (int)blockIdx.x);
            EpiGlu E{(const bf16*)(F.ws + WS_Z), ACT, a.in[F.zz + I_GLUB] + l * 256};
            pg8::gemm_phase<EpiGlu, pg8::StaticOrder, true, true>(F.lds, g, S, E, F.tid);
            SEAM();
        }
        const bool f1f8 = !moe && j == FP8_F1_J;
        const bool tail = keep && F.G > TAILB;
        if (IN(6)) { PHASE_BEGIN();
            const int Mg = tail ? NLAT : Mrows;
            pg8::Gemm g{ACT, (const bf16*)(F.ws + WS_WOUT) + (size_t)l * 1024 * 1024, Mg, 1024, 1024}; pg8::StaticOrder S; S.init(Mg, 1024, F.G, (int)blockIdx.x);
            EpiResid E{(l == 0) ? a.in[F.zz + I_X] : F.out, (l == 0) ? a.in[F.zz + I_CTX] : hb, F.out, hb, MOD + (size_t)l * 5 * 6144 + 2 * 1024, 1.0f};
            pg8::gemm_phase<EpiResid, pg8::StaticOrder, true, true>(F.lds, g, S, E, F.tid);
            SEAM();
        }
        if (IN(7)) { PHASE_BEGIN();
            if (tail) {
                if ((int)blockIdx.x < TAILB) {
                    pg8::Gemm g{ACT + (size_t)NLAT * 1024, (const bf16*)(F.ws + WS_WOUT) + (size_t)l * 1024 * 1024, MT - NLAT, 1024, 1024}; pg8::StaticOrder S; S.init(MT - NLAT, 1024, TAILB, (int)blockIdx.x);
                    EpiResid E{(l == 0) ? a.in[F.zz + I_X] : F.out, (l == 0) ? a.in[F.zz + I_CTX] : hb, F.out, hb, MOD + (size_t)l * 5 * 6144 + 2 * 1024, 1.0f, NLAT / 256};
                    pg8::gemm_phase<EpiResid, pg8::StaticOrder, true, true>(F.lds, g, S, E, F.tid);
                    group_arrive((unsigned*)F.ws + CW_TAIL + (2 * l) * 64, F.tid);
                } else {
                    if (moe) norm_phase<1>(F, a, l, 1, NLAT, -1, 0, ((int)blockIdx.x - TAILB) * 8 + F.wave, (F.G - TAILB) * 8); else if (f1f8) norm_phase<3>(F, a, l, 1, NLAT, -1, 0, ((int)blockIdx.x - TAILB) * 8 + F.wave, (F.G - TAILB) * 8); else norm_phase<0>(F, a, l, 1, NLAT, -1, 0, ((int)blockIdx.x - TAILB) * 8 + F.wave, (F.G - TAILB) * 8);
                }
                group_wait((unsigned*)F.ws + CW_BAR, (unsigned*)F.ws + CW_TAIL + (2 * l) * 64, TAILB, F.tid);
                if (moe) norm_phase<1>(F, a, l, 1, MT, -1, NLAT, F.gw, F.NGW); else if (f1f8) norm_phase<3>(F, a, l, 1, MT, -1, NLAT, F.gw, F.NGW); else norm_phase<0>(F, a, l, 1, MT, -1, NLAT, F.gw, F.NGW);
            } else { if (moe) norm_phase<1>(F, a, l, 1, Mrows, -1); else if (f1f8) norm_phase<3>(F, a, l, 1, Mrows, -1); else norm_phase<0>(F, a, l, 1, Mrows, -1); }
            SEAM();
        }
        if (!moe) {
            if (IN(8)) REP(8) { PHASE_BEGIN();
                if (f1f8) {
                    int k8 = 512; asm volatile("" : "+s"(k8)); pg8::Gemm g{ACT, (const bf16*)(F.ws + WS_W13D) + (size_t)j * 5632 * 1024, Mrows, 5632, k8}; pg8::StaticOrder S; S.init(Mrows, 5632, F.G, (int)blockIdx.x);
                    EpiSwiglu8 E{(unsigned char*)PH, 1.0f / WSC8};
                    pg8::gemm_phase_f8<EpiSwiglu8, pg8::StaticOrder, true, true>(F.lds, g, S, E, F.tid);
                } else {
                pg8::Gemm g{ACT, (const bf16*)(F.ws + WS_W13D) + (size_t)j * 5632 * 1024, Mrows, 5632, 1024}; pg8::StaticOrder S; S.init(Mrows, 5632, F.G, (int)blockIdx.x);
                EpiSwiglu8 E{(unsigned char*)PH, 1.0f};
                pg8::gemm_phase<EpiSwiglu8, pg8::StaticOrder, true, true>(F.lds, g, S, E, F.tid);
                }
                SEAM();
            }
            if (IN(9)) { PHASE_BEGIN();
                const int Mg = tail ? NLAT : Mrows;
                int k8 = DFF / 2; asm volatile("" : "+s"(k8)); pg8::Gemm g{PH, (const bf16*)(F.ws + WS_W2D + (size_t)j * 1024 * DFF), Mg, 1024, k8}; pg8::StaticOrder S; S.init(Mg, 1024, F.G, (int)blockIdx.x);
                EpiResid E{F.out, hb, F.out, hb, MOD + (size_t)l * 5 * 6144 + 5 * 1024, 1.0f / WSC8};
                pg8::gemm_phase_f8<EpiResid, pg8::StaticOrder, true, true>(F.lds, g, S, E, F.tid);
                if (!tail) { const int rem = ((Mrows / 256) * 4) % F.G; if (rem > 0 && (int)blockIdx.x >= rem) moe_cvt_idle(F, a, j, rem); else if (rem == 0) moe_cvt(F, a, j); }
                SEAM();
            }
        } else {
                        if (IN(8)) REP(8) { PHASE_BEGIN(); moe_gather(F, j); SEAM(); }
            if (IN(9)) REP(9) { PHASE_BEGIN();
                int k8 = 512; asm volatile("" : "+s"(k8)); pg8::Gemm g{(const bf16*)(F.ws + WS_X2), (const bf16*)(F.ws + WS_W13M), 0, 5632, k8}; MoeOrder S; S.init((const unsigned*)F.ws + CW_CNT + j * 8 * 64, 22, F.G, (int)blockIdx.x);
                EpiSwiglu8 E{(unsigned char*)PH, 1.0f / WSC8};
                pg8::gemm_phase_f8<EpiSwiglu8, MoeOrder, true, true>(F.lds, g, S, E, F.tid);
                SEAM();
            }
            if (IN(10)) REP(10) { PHASE_BEGIN();
                int k8 = DFF / 2; asm volatile("" : "+s"(k8)); pg8::Gemm g{PH, (const bf16*)(F.ws + WS_W2M), 0, 1024, k8}; MoeOrder S; S.init((const unsigned*)F.ws + CW_CNT + j * 8 * 64, 4, F.G, (int)blockIdx.x);
                EpiStoreBf16 E{(bf16*)(F.ws + WS_X2), 1024, 1.0f / WSC8};
                pg8::gemm_phase_f8<EpiStoreBf16, MoeOrder, true, true>(F.lds, g, S, E, F.tid);
                SEAM();
            }
        }
    }
    if (((PH_MASK >> 13) & 1) && a.do_fin) { PHASE_BEGIN(); norm_phase<2>(F, a, DEPTH - 1, 0, NLAT, DEPTH - 1); }
#undef SEAM
#undef IN
#undef hb
#undef MOD
#undef ACT
#undef PH
}

#ifndef MK_FUSED
#define MK_FUSED 1
#endif
template <int PM, int MS> static void launch_one(const Args& a, int grid, hipStream_t stream) {
    static bool attr_done = false;
    if (!attr_done) { (void)hipFuncSetAttribute((const void*)mk_fwd<PM, MS>, hipFuncAttributeMaxDynamicSharedMemorySize, LDS_BYTES); attr_done = true; }
    hipLaunchKernelGGL((mk_fwd<PM, MS>), dim3(grid), dim3(512), LDS_BYTES, stream, a);
}
extern "C" void kernel_launch(void* const* d_in, const int* in_sizes, int n_in, void* d_out, int out_size, void* d_ws, size_t ws_size, hipStream_t stream) {
    static int grid = 0;
    if (grid == 0) {
        if (n_in != 35 || in_sizes[0] != NLAT * DM || out_size != NLAT * DM || ws_size < WS_END) {
            fprintf(stderr, "kernel_launch: unexpected shapes / workspace (n_in %d, ws %zu, need %zu); nothing launched\n", n_in, ws_size, (size_t)WS_END); grid = -1; return; }
        int dev = 0, cus = 0;
        if (hipGetDevice(&dev) != hipSuccess || hipDeviceGetAttribute(&cus, hipDeviceAttributeMultiprocessorCount, dev) != hipSuccess) { grid = -1; return; }
        grid = cus;
    }
    if (grid < 0) return;
    (void)hipMemsetAsync((char*)d_ws + WS_CTL, 0, CTL_ZERO_BYTES, stream);
    Args a{};
    for (int i = 0; i < 35; ++i) a.in[i] = (const float*)d_in[i];
    a.in[I_OUT] = (const float*)d_out; a.in[I_WS] = (const float*)d_ws; a.pad = 0;
#if MK_FUSED
    a.l_lo = 0; a.l_hi = DEPTH; a.ph_lo = 0; a.ph_hi = NPH; a.do_pro = 1; a.do_fin = 1; a.fused = 1;
#ifndef TEST_PM
#define TEST_PM 0xFFFF
#endif
#ifndef TEST_MS
#define TEST_MS 15
#endif
    launch_one<TEST_PM, TEST_MS>(a, grid, stream);
#else
    a.fused = 0;
    a.l_lo = 0; a.l_hi = 0; a.ph_lo = 0; a.ph_hi = 0; a.do_pro = 1; a.do_fin = 0;
    launch_one<0x1000, 15>(a, grid, stream);
    a.do_pro = 0;
    for (int l = 0; l < DEPTH; ++l) {
        a.l_lo = l; a.l_hi = l + 1; a.ph_lo = 0; a.ph_hi = NPH;
        launch_one<0x1, 15>(a, grid, stream); launch_one<0x2, 15>(a, grid, stream); launch_one<0x4, 15>(a, grid, stream); launch_one<0x8, 15>(a, grid, stream);
        launch_one<0x10, 1>(a, grid, stream); launch_one<0x10, 2>(a, grid, stream); launch_one<0x10, 4>(a, grid, stream); launch_one<0x10, 8>(a, grid, stream);
        launch_one<0x20, 15>(a, grid, stream); launch_one<0x40, 15>(a, grid, stream); launch_one<0x80, 15>(a, grid, stream);
        launch_one<0x100, 15>(a, grid, stream); launch_one<0x200, 15>(a, grid, stream);
        if (l & 1) launch_one<0x400, 15>(a, grid, stream);
    }
    a.l_lo = 0; a.l_hi = 0; a.ph_lo = 0; a.ph_hi = 0; a.do_fin = 1;
    launch_one<0x2000, 15>(a, grid, stream);
#endif
}
```

```cpp
#include <hip/hip_runtime.h>
#include <cstdio>
#include <cstdint>
#define LAS __attribute__((address_space(3)))
namespace pg8 {
#define PG8_LAS __attribute__((address_space(3)))
typedef unsigned short bf16_t;
typedef short bf16x8 __attribute__((ext_vector_type(8)));
typedef float f32x4 __attribute__((ext_vector_type(4)));
typedef unsigned u32x4 __attribute__((ext_vector_type(4)));
constexpr int BM = 256, BK = 64, HALF = 128, HTB = HALF * BK * 2  , STAGE_BYTES = 8 * HTB, NXCD = 8, WGM = 8;

__host__ __device__ __forceinline__ int lds_byte(int r, int c) { const int st = (r >> 4) * 2 + (c >> 5), rr = r & 15, cc = c & 31, ob = rr * 64 + cc * 2; return st * 1024 + (ob ^ (((ob >> 9) & 1) << 5)); }
__host__ __device__ __forceinline__ void stage_rc(int b, int& R, int& C) { const int st = b / 1024, sb = b % 1024, swz = sb ^ (((sb >> 9) & 1) << 5); R = (st >> 1) * 16 + swz / 64; C = (st & 1) * 32 + (swz % 64) / 2; }
__host__ __device__ __forceinline__ int perm32(int rho) { const int n = rho >> 4, i = rho & 15; return 8 * (i >> 2) + 4 * n + (i & 3); }

__host__ __device__ __forceinline__ int perm32f(int rho) { return 2 * (rho & 15) + (rho >> 4); }
template <class E, class = void> struct epi_flip { static constexpr bool v = false; };
template <class E> struct epi_flip<E, decltype((void)E::FLIP)> { static constexpr bool v = E::FLIP; };
struct Unit { int pm, pn, pc; };
struct Gemm { const bf16_t* A; const bf16_t* Bt; int M, N, K; };

struct StaticOrder {
    int nM, nN, nwg, G, c;
    __host__ __device__ void init(int M, int N, int G_, int c_) { nM = M / BM; nN = N / BM; nwg = nM * nN; G = G_; c = c_; }
    __host__ __device__ bool next(int i, Unit& u) const {
        const long L = (long)i * G + c; if (L >= nwg) return false;
        int wgid = (int)L; { const int q = nwg / NXCD, r = nwg % NXCD, xcd = wgid % NXCD, off = wgid / NXCD; wgid = (xcd < r ? xcd * (q + 1) : r * (q + 1) + (xcd - r) * q) + off; }
        const int nig = WGM * nN, gid = wgid / nig, fm = gid * WGM, gsz = (nM - fm) < WGM ? (nM - fm) : WGM;
        u.pm = fm + ((wgid % nig) % gsz); u.pn = (wgid % nig) / gsz; u.pc = u.pn; return true;
    }
    __device__ __forceinline__ void a_ready(const Unit&) const {}
    __device__ __forceinline__ void done(const Unit&) const {}
};

__device__ __forceinline__ unsigned cvt_pk_bf16(float lo, float hi) { unsigned r; asm volatile("v_cvt_pk_bf16_f32 %0, %1, %2" : "=v"(r) : "v"(lo), "v"(hi)); return r; }
typedef float f32x2 __attribute__((ext_vector_type(2)));

template <class Epi, class Sched, bool ALIGN_EPI = false, bool SP2 = false>
__device__ __forceinline__ void gemm_phase(PG8_LAS unsigned char* lds, const Gemm g, const Sched& S, const Epi& E, const int tid) {
    const int wid = __builtin_amdgcn_readfirstlane(tid >> 6), lane = tid & 63, wr = wid >> 2, wc = wid & 3, fr = lane & 15, fq = lane >> 4;
    const int K = g.K, nt = K / BK;
    unsigned voffA[2], voffB[2];
#pragma unroll
    for (int i = 0; i < 2; ++i) { int R, C; stage_rc(tid * 16 + i * 8192, R, C); const int Rb = epi_flip<Epi>::v ? ((R & ~31) + perm32f(R & 31)) : (Epi::PERM ? ((R & ~31) + perm32(R & 31)) : R);
        voffA[i] = (unsigned)(R * K + C) * 2u; voffB[i] = (unsigned)(Rb * K + C) * 2u; }
    const size_t kstep = (size_t)(BK * 2);
    const size_t hstep = (size_t)HALF * K * 2;
    const size_t tstep = 2 * hstep;
    const unsigned ldsw = (unsigned)wid * 1024u;
    const int aoff = lds_byte(wr * 64 + fr, fq * 8), boff = lds_byte(wc * 32 + fr, fq * 8);
#define PG8_SA(b, h) (((b) * 2 + (h)) * HTB)
#define PG8_SB(b, h) ((4 + (b) * 2 + (h)) * HTB)
#define PG8_STAGE(bufoff, gbase, voff) do { _Pragma("unroll") for (int _i = 0; _i < 2; ++_i) \
        __builtin_amdgcn_global_load_lds((const unsigned*)((const char*)(gbase) + (voff)[_i]), (PG8_LAS unsigned*)(lds + (bufoff) + ldsw + _i * 8192), 16, 0, 0); } while (0)
#define PG8_LDA(dst, b, h) do { _Pragma("unroll") for (int m = 0; m < 4; ++m) _Pragma("unroll") for (int k = 0; k < 2; ++k) dst[m][k] = *(const PG8_LAS bf16x8*)(lds + PG8_SA(b, h) + aoff + m * 2048 + k * 1024); } while (0)
#define PG8_LDB(dst, b, h) do { _Pragma("unroll") for (int n = 0; n < 2; ++n) _Pragma("unroll") for (int k = 0; k < 2; ++k) dst[n][k] = *(const PG8_LAS bf16x8*)(lds + PG8_SB(b, h) + boff + n * 2048 + k * 1024); } while (0)
#define PG8_MMA(ai, bj, At, Bt) do { __builtin_amdgcn_s_setprio(1); _Pragma("unroll") for (int m = 0; m < 4; ++m) _Pragma("unroll") for (int n = 0; n < 2; ++n) _Pragma("unroll") for (int k = 0; k < 2; ++k) \
        { if constexpr (epi_flip<Epi>::v) acc[ai][bj][m][n] = __builtin_amdgcn_mfma_f32_16x16x32_bf16(At[m][k], Bt[n][k], acc[ai][bj][m][n], 0, 0, 0); \
          else acc[ai][bj][m][n] = __builtin_amdgcn_mfma_f32_16x16x32_bf16(Bt[n][k], At[m][k], acc[ai][bj][m][n], 0, 0, 0); } __builtin_amdgcn_s_setprio(0); } while (0)
#define PG8_WAIT_V(n) asm volatile("s_waitcnt vmcnt(" #n ")" ::: "memory")
#define PG8_WAIT_L(n) asm volatile("s_waitcnt lgkmcnt(" #n ")" ::: "memory")
#define PG8_BAR __builtin_amdgcn_s_barrier()
#define PG8_SCHED __builtin_amdgcn_sched_barrier(0)
    Unit cur, nxt; int ui = 0;
    if (!S.next(0, cur)) return;
    f32x4 acc[2][2][4][2];
#pragma unroll
    for (int a = 0; a < 2; ++a)
#pragma unroll
        for (int b = 0; b < 2; ++b)
#pragma unroll
            for (int m = 0; m < 4; ++m)
#pragma unroll
                for (int n = 0; n < 2; ++n) acc[a][b][m][n] = (f32x4){0.f, 0.f, 0.f, 0.f};
    bf16x8 At[4][2], B0[2][2], B1[2][2];
    const char* cA = (const char*)g.A + (size_t)cur.pm * tstep; const char* cB = (const char*)g.Bt + (size_t)cur.pn * tstep;
    S.a_ready(cur);
    if constexpr (SP2) {
        PG8_STAGE(PG8_SB(0, 0), cB, voffB); PG8_STAGE(PG8_SB(0, 1), cB + hstep, voffB); PG8_STAGE(PG8_SA(0, 0), cA, voffA); PG8_STAGE(PG8_SA(0, 1), cA + hstep, voffA);
        if (wr == 1) PG8_BAR;
        PG8_WAIT_V(2); PG8_BAR;
        PG8_STAGE(PG8_SB(1, 0), cB + kstep, voffB); PG8_STAGE(PG8_SA(1, 0), cA + kstep, voffA); PG8_STAGE(PG8_SB(1, 1), cB + hstep + kstep, voffB);
        PG8_WAIT_V(6); PG8_BAR;
    } else {
        PG8_STAGE(PG8_SB(0, 0), cB, voffB); PG8_STAGE(PG8_SA(0, 0), cA, voffA); PG8_STAGE(PG8_SB(0, 1), cB + hstep, voffB); PG8_STAGE(PG8_SA(0, 1), cA + hstep, voffA);
        if (wr == 1) PG8_BAR;
        PG8_WAIT_V(4); PG8_BAR;
        PG8_STAGE(PG8_SB(1, 0), cB + kstep, voffB); PG8_STAGE(PG8_SA(1, 0), cA + kstep, voffA); PG8_STAGE(PG8_SB(1, 1), cB + hstep + kstep, voffB);
        PG8_WAIT_V(6); PG8_BAR;
    }
    for (;;) {
        const bool has_next = S.next(ui + 1, nxt);
        const char* nA = has_next ? (const char*)g.A + (size_t)nxt.pm * tstep : cA; const char* nB = has_next ? (const char*)g.Bt + (size_t)nxt.pn * tstep : cB;
        for (int t = 0; t < nt; t += 2) {
            const bool last = (t == nt - 2);
            const char* a1 = cA + (size_t)(t + 1) * kstep;
            const char* a2 = last ? nA : cA + (size_t)(t + 2) * kstep; const char* b2 = last ? nB : cB + (size_t)(t + 2) * kstep;
            const char* a3 = a2 + kstep; const char* b3 = b2 + kstep;
            if (last && has_next) S.a_ready(nxt);
            if constexpr (SP2) {
            PG8_LDB(B0, 0, 0); PG8_LDB(B1, 0, 1); PG8_SCHED; PG8_LDA(At, 0, 0); PG8_STAGE(PG8_SA(1, 1), a1 + hstep, voffA);
            PG8_WAIT_V(8); PG8_WAIT_L(0); PG8_BAR; PG8_MMA(0, 0, At, B0); PG8_MMA(0, 1, At, B1); PG8_BAR; PG8_SCHED;
            PG8_LDA(At, 0, 1); PG8_STAGE(PG8_SB(0, 0), b2, voffB); PG8_STAGE(PG8_SB(0, 1), b2 + hstep, voffB); PG8_STAGE(PG8_SA(0, 0), a2, voffA);
            PG8_WAIT_V(8); PG8_WAIT_L(0); PG8_BAR; PG8_MMA(1, 0, At, B0); PG8_MMA(1, 1, At, B1); PG8_BAR; PG8_SCHED;
            PG8_LDB(B0, 1, 0); PG8_LDB(B1, 1, 1); PG8_SCHED; PG8_LDA(At, 1, 0); PG8_STAGE(PG8_SA(0, 1), a2 + hstep, voffA);
            PG8_WAIT_V(8); PG8_WAIT_L(0); PG8_BAR; PG8_MMA(0, 0, At, B0); PG8_MMA(0, 1, At, B1); PG8_BAR; PG8_SCHED;
            PG8_LDA(At, 1, 1); PG8_STAGE(PG8_SB(1, 0), b3, voffB); PG8_STAGE(PG8_SB(1, 1), b3 + hstep, voffB); PG8_STAGE(PG8_SA(1, 0), a3, voffA);
            PG8_WAIT_V(8); PG8_WAIT_L(0); PG8_BAR; PG8_MMA(1, 0, At, B0); PG8_MMA(1, 1, At, B1); PG8_BAR; PG8_SCHED;
            } else {
            PG8_LDB(B0, 0, 0); PG8_SCHED; PG8_LDA(At, 0, 0); PG8_STAGE(PG8_SA(1, 1), a1 + hstep, voffA);
            PG8_WAIT_L(8); PG8_BAR; PG8_WAIT_L(0); PG8_MMA(0, 0, At, B0); PG8_BAR; PG8_SCHED;
            PG8_LDB(B1, 0, 1); PG8_STAGE(PG8_SB(0, 0), b2, voffB);
            PG8_BAR; PG8_WAIT_L(0); PG8_MMA(0, 1, At, B1); PG8_BAR;
            PG8_LDA(At, 0, 1); PG8_STAGE(PG8_SA(0, 0), a2, voffA);
            PG8_BAR; PG8_WAIT_L(0); PG8_MMA(1, 0, At, B0); PG8_BAR; PG8_SCHED;
            PG8_STAGE(PG8_SB(0, 1), b2 + hstep, voffB);
            PG8_WAIT_V(6); PG8_BAR; PG8_MMA(1, 1, At, B1); PG8_BAR;
            PG8_LDB(B0, 1, 0); PG8_SCHED; PG8_LDA(At, 1, 0); PG8_STAGE(PG8_SA(0, 1), a2 + hstep, voffA);
            PG8_WAIT_L(8); PG8_BAR; PG8_WAIT_L(0); PG8_MMA(0, 0, At, B0); PG8_BAR; PG8_SCHED;
            PG8_LDB(B1, 1, 1); PG8_STAGE(PG8_SB(1, 0), b3, voffB);
            PG8_BAR; PG8_WAIT_L(0); PG8_MMA(0, 1, At, B1); PG8_BAR;
            PG8_LDA(At, 1, 1); PG8_STAGE(PG8_SA(1, 0), a3, voffA);
            PG8_BAR; PG8_WAIT_L(0); PG8_MMA(1, 0, At, B0); PG8_BAR; PG8_SCHED;
            PG8_STAGE(PG8_SB(1, 1), b3 + hstep, voffB);
            PG8_WAIT_V(6); PG8_BAR; PG8_MMA(1, 1, At, B1); PG8_BAR;
            }
        }
        if constexpr (ALIGN_EPI) { if (wr == 0) PG8_BAR; }
        if constexpr (!Epi::AFTER_DRAIN) { E(acc, cur, wr, wc, fr, fq); S.done(cur); }
        if (!has_next) break;
#pragma unroll
        for (int a = 0; a < 2; ++a)
#pragma unroll
            for (int b = 0; b < 2; ++b)
#pragma unroll
                for (int m = 0; m < 4; ++m)
#pragma unroll
                    for (int n = 0; n < 2; ++n) acc[a][b][m][n] = (f32x4){0.f, 0.f, 0.f, 0.f};
        cur = nxt; cA = nA; cB = nB; ++ui;
        if constexpr (ALIGN_EPI) { if (wr == 1) PG8_BAR; }
    }
    PG8_WAIT_V(0);
    if constexpr (!ALIGN_EPI) { if (wr == 0) PG8_BAR; }
    PG8_BAR;
    if constexpr (Epi::AFTER_DRAIN) { E.fused(acc, cur, wr, wc, fr, fq, lds, wid, lane); S.done(cur); }
#undef PG8_SA
#undef PG8_SB
#undef PG8_STAGE
#undef PG8_LDA
#undef PG8_LDB
#undef PG8_MMA
#undef PG8_WAIT_V
#undef PG8_WAIT_L
#undef PG8_BAR
#undef PG8_SCHED
}
typedef int v8i_t __attribute__((ext_vector_type(8)));
typedef int v4i_t __attribute__((ext_vector_type(4)));
template <class Epi, class Sched, bool ALIGN_EPI = false, bool SP2 = false>
__device__ __forceinline__ void gemm_phase_f8(PG8_LAS unsigned char* lds, const Gemm g, const Sched& S, const Epi& E, const int tid) {
    const int wid = __builtin_amdgcn_readfirstlane(tid >> 6), lane = tid & 63, wr = wid >> 2, wc = wid & 3, fr = lane & 15, fq = lane >> 4;
    const int K = g.K, nt = K / BK;
    unsigned voffA[2], voffB[2];
#pragma unroll
    for (int i = 0; i < 2; ++i) { int R, C; stage_rc(tid * 16 + i * 8192, R, C); const int Rb = Epi::PERM ? ((R & ~31) + perm32(R & 31)) : R;
        voffA[i] = (unsigned)(R * K + C) * 2u; voffB[i] = (unsigned)(Rb * K + C) * 2u; }
    const size_t kstep = (size_t)(BK * 2);
    const size_t hstep = (size_t)HALF * K * 2;
    const size_t tstep = 2 * hstep;
    const unsigned ldsw = (unsigned)wid * 1024u;
    const int aoff0 = lds_byte(wr * 64 + fr, fq * 16), aoff1 = lds_byte(wr * 64 + fr, fq * 16 + 8), boff0 = lds_byte(wc * 32 + fr, fq * 16), boff1 = lds_byte(wc * 32 + fr, fq * 16 + 8);
#define PG8_SA(b, h) (((b) * 2 + (h)) * HTB)
#define PG8_SB(b, h) ((4 + (b) * 2 + (h)) * HTB)
#define PG8_STAGE(bufoff, gbase, voff) do { _Pragma("unroll") for (int _i = 0; _i < 2; ++_i) \
        __builtin_amdgcn_global_load_lds((const unsigned*)((const char*)(gbase) + (voff)[_i]), (PG8_LAS unsigned*)(lds + (bufoff) + ldsw + _i * 8192), 16, 0, 0); } while (0)
#define PG8_LDA(dst, b, h) do { _Pragma("unroll") for (int m = 0; m < 4; ++m) { const u32x4 lo_ = *(const PG8_LAS u32x4*)(lds + PG8_SA(b, h) + aoff0 + m * 2048), hi_ = *(const PG8_LAS u32x4*)(lds + PG8_SA(b, h) + aoff1 + m * 2048); \
        dst[m] = __builtin_shufflevector((v4i_t)lo_, (v4i_t)hi_, 0, 1, 2, 3, 4, 5, 6, 7); } } while (0)
#define PG8_LDB(dst, b, h) do { _Pragma("unroll") for (int n = 0; n < 2; ++n) { const u32x4 lo_ = *(const PG8_LAS u32x4*)(lds + PG8_SB(b, h) + boff0 + n * 2048), hi_ = *(const PG8_LAS u32x4*)(lds + PG8_SB(b, h) + boff1 + n * 2048); \
        dst[n] = __builtin_shufflevector((v4i_t)lo_, (v4i_t)hi_, 0, 1, 2, 3, 4, 5, 6, 7); } } while (0)
#define PG8_MMA(ai, bj, At, Bt) do { __builtin_amdgcn_s_setprio(1); _Pragma("unroll") for (int m = 0; m < 4; ++m) _Pragma("unroll") for (int n = 0; n < 2; ++n) \
        asm volatile("v_mfma_scale_f32_16x16x128_f8f6f4 %0, %1, %2, %0, %3, %3 op_sel_hi:[0,0,0]" : "+v"(acc[ai][bj][m][n]) : "v"(Bt[n]), "v"(At[m]), "v"(one_scale)); __builtin_amdgcn_s_setprio(0); } while (0)
#define PG8_WAIT_V(n) asm volatile("s_waitcnt vmcnt(" #n ")" ::: "memory")
#define PG8_WAIT_L(n) asm volatile("s_waitcnt lgkmcnt(" #n ")" ::: "memory")
#define PG8_BAR __builtin_amdgcn_s_barrier()
#define PG8_SCHED __builtin_amdgcn_sched_barrier(0)
    Unit cur, nxt; int ui = 0;
    if (!S.next(0, cur)) return;
    f32x4 acc[2][2][4][2];
#pragma unroll
    for (int a = 0; a < 2; ++a)
#pragma unroll
        for (int b = 0; b < 2; ++b)
#pragma unroll
            for (int m = 0; m < 4; ++m)
#pragma unroll
                for (int n = 0; n < 2; ++n) acc[a][b][m][n] = (f32x4){0.f, 0.f, 0.f, 0.f};
    v8i_t At[4], B0[2], B1[2]; const int one_scale = 0x7f7f7f7f;
    const char* cA = (const char*)g.A + (size_t)cur.pm * tstep; const char* cB = (const char*)g.Bt + (size_t)cur.pn * tstep;
    S.a_ready(cur);
    if constexpr (SP2) {
        PG8_STAGE(PG8_SB(0, 0), cB, voffB); PG8_STAGE(PG8_SB(0, 1), cB + hstep, voffB); PG8_STAGE(PG8_SA(0, 0), cA, voffA); PG8_STAGE(PG8_SA(0, 1), cA + hstep, voffA);
        if (wr == 1) PG8_BAR;
        PG8_WAIT_V(2); PG8_BAR;
        PG8_STAGE(PG8_SB(1, 0), cB + kstep, voffB); PG8_STAGE(PG8_SA(1, 0), cA + kstep, voffA); PG8_STAGE(PG8_SB(1, 1), cB + hstep + kstep, voffB);
        PG8_WAIT_V(6); PG8_BAR;
    } else {
        PG8_STAGE(PG8_SB(0, 0), cB, voffB); PG8_STAGE(PG8_SA(0, 0), cA, voffA); PG8_STAGE(PG8_SB(0, 1), cB + hstep, voffB); PG8_STAGE(PG8_SA(0, 1), cA + hstep, voffA);
        if (wr == 1) PG8_BAR;
        PG8_WAIT_V(4); PG8_BAR;
        PG8_STAGE(PG8_SB(1, 0), cB + kstep, voffB); PG8_STAGE(PG8_SA(1, 0), cA + kstep, voffA); PG8_STAGE(PG8_SB(1, 1), cB + hstep + kstep, voffB);
        PG8_WAIT_V(6); PG8_BAR;
    }
    for (;;) {
        const bool has_next = S.next(ui + 1, nxt);
        const char* nA = has_next ? (const char*)g.A + (size_t)nxt.pm * tstep : cA; const char* nB = has_next ? (const char*)g.Bt + (size_t)nxt.pn * tstep : cB;
        for (int t = 0; t < nt; t += 2) {
            const bool last = (t == nt - 2);
            const char* a1 = cA + (size_t)(t + 1) * kstep;
            const char* a2 = last ? nA : cA + (size_t)(t + 2) * kstep; const char* b2 = last ? nB : cB + (size_t)(t + 2) * kstep;
            const char* a3 = a2 + kstep; const char* b3 = b2 + kstep;
            if (last && has_next) S.a_ready(nxt);
            if constexpr (SP2) {
            PG8_LDB(B0, 0, 0); PG8_LDB(B1, 0, 1); PG8_SCHED; PG8_LDA(At, 0, 0); PG8_STAGE(PG8_SA(1, 1), a1 + hstep, voffA);
            PG8_WAIT_V(8); PG8_WAIT_L(0); PG8_BAR; PG8_MMA(0, 0, At, B0); PG8_MMA(0, 1, At, B1); PG8_BAR; PG8_SCHED;
            PG8_LDA(At, 0, 1); PG8_STAGE(PG8_SB(0, 0), b2, voffB); PG8_STAGE(PG8_SB(0, 1), b2 + hstep, voffB); PG8_STAGE(PG8_SA(0, 0), a2, voffA);
            PG8_WAIT_V(8); PG8_WAIT_L(0); PG8_BAR; PG8_MMA(1, 0, At, B0); PG8_MMA(1, 1, At, B1); PG8_BAR; PG8_SCHED;
            PG8_LDB(B0, 1, 0); PG8_LDB(B1, 1, 1); PG8_SCHED; PG8_LDA(At, 1, 0); PG8_STAGE(PG8_SA(0, 1), a2 + hstep, voffA);
            PG8_WAIT_V(8); PG8_WAIT_L(0); PG8_BAR; PG8_MMA(0, 0, At, B0); PG8_MMA(0, 1, At, B1); PG8_BAR; PG8_SCHED;
            PG8_LDA(At, 1, 1); PG8_STAGE(PG8_SB(1, 0), b3, voffB); PG8_STAGE(PG8_SB(1, 1), b3 + hstep, voffB); PG8_STAGE(PG8_SA(1, 0), a3, voffA);
            PG8_WAIT_V(8); PG8_WAIT_L(0); PG8_BAR; PG8_MMA(1, 0, At, B0); PG8_MMA(1, 1, At, B1); PG8_BAR; PG8_SCHED;
            } else {
            PG8_LDB(B0, 0, 0); PG8_SCHED; PG8_LDA(At, 0, 0); PG8_STAGE(PG8_SA(1, 1), a1 + hstep, voffA);
            PG8_WAIT_L(8); PG8_BAR; PG8_WAIT_L(0); PG8_MMA(0, 0, At, B0); PG8_BAR; PG8_SCHED;
            PG8_LDB(B1, 0, 1); PG8_STAGE(PG8_SB(0, 0), b2, voffB);
            PG8_BAR; PG8_WAIT_L(0); PG8_MMA(0, 1, At, B1); PG8_BAR;
            PG8_LDA(At, 0, 1); PG8_STAGE(PG8_SA(0, 0), a2, voffA);
            PG8_BAR; PG8_WAIT_L(0); PG8_MMA(1, 0, At, B0); PG8_BAR; PG8_SCHED;
            PG8_STAGE(PG8_SB(0, 1), b2 + hstep, voffB);
            PG8_WAIT_V(6); PG8_BAR; PG8_MMA(1, 1, At, B1); PG8_BAR;
            PG8_LDB(B0, 1, 0); PG8_SCHED; PG8_LDA(At, 1, 0); PG8_STAGE(PG8_SA(0, 1), a2 + hstep, voffA);
            PG8_WAIT_L(8); PG8_BAR; PG8_WAIT_L(0); PG8_MMA(0, 0, At, B0); PG8_BAR; PG8_SCHED;
            PG8_LDB(B1, 1, 1); PG8_STAGE(PG8_SB(1, 0), b3, voffB);
            PG8_BAR; PG8_WAIT_L(0); PG8_MMA(0, 1, At, B1); PG8_BAR;
            PG8_LDA(At, 1, 1); PG8_STAGE(PG8_SA(1, 0), a3, voffA);
            PG8_BAR; PG8_WAIT_L(0); PG8_MMA(1, 0, At, B0); PG8_BAR; PG8_SCHED;
            PG8_STAGE(PG8_SB(1, 1), b3 + hstep, voffB);
            PG8_WAIT_V(6); PG8_BAR; PG8_MMA(1, 1, At, B1); PG8_BAR;
            }
        }
        if constexpr (ALIGN_EPI) { if (wr == 0) PG8_BAR; }
        asm volatile("s_nop 15\n\ts_nop 15" ::: "memory");
        if constexpr (!Epi::AFTER_DRAIN) { E(acc, cur, wr, wc, fr, fq); S.done(cur); }
        if (!has_next) break;
#pragma unroll
        for (int a = 0; a < 2; ++a)
#pragma unroll
            for (int b = 0; b < 2; ++b)
#pragma unroll
                for (int m = 0; m < 4; ++m)
#pragma unroll
                    for (int n = 0; n < 2; ++n) acc[a][b][m][n] = (f32x4){0.f, 0.f, 0.f, 0.f};
        cur = nxt; cA = nA; cB = nB; ++ui;
        if constexpr (ALIGN_EPI) { if (wr == 1) PG8_BAR; }
    }
    PG8_WAIT_V(0);
    if constexpr (!ALIGN_EPI) { if (wr == 0) PG8_BAR; }
    PG8_BAR;
    if constexpr (Epi::AFTER_DRAIN) { E.fused(acc, cur, wr, wc, fr, fq, lds, wid, lane); S.done(cur); }
#undef PG8_SA
#undef PG8_SB
#undef PG8_STAGE
#undef PG8_LDA
#undef PG8_LDB
#undef PG8_MMA
#undef PG8_WAIT_V
#undef PG8_WAIT_L
#undef PG8_BAR
#undef PG8_SCHED
}
}

#define XB_TMO      128
#define XB_XCNT(j)  (256  + 64 * (j))
#define XB_XSUB(j)  (1280 + 64 * (j))
#define XB_XGEN(j)  (2304 + 64 * (j))
#define XB_TOP      3328
#define XB_TOPGEN   3392
#define XCD_BAR_WORDS 3456
#define XB_SPIN_CAP (1u << 18)

__device__ __forceinline__ unsigned xb_ld(unsigned* p)              { return __hip_atomic_load(p, __ATOMIC_RELAXED, __HIP_MEMORY_SCOPE_AGENT); }
__device__ __forceinline__ unsigned xb_add(unsigned* p, unsigned v) { return __hip_atomic_fetch_add(p, v, __ATOMIC_RELAXED, __HIP_MEMORY_SCOPE_AGENT); }
__device__ __forceinline__ unsigned xb_xcc_id() { return (unsigned)__builtin_amdgcn_s_getreg((3 << 11) | 20) & 0xFu; }
#define XB_SPIN(cond, bar) do { unsigned _sp = 0; while (cond) { __builtin_amdgcn_s_sleep(1); \
    if ((++_sp & 255u) == 0u) { if (xb_ld(&(bar)[XB_TMO])) break; if (_sp > XB_SPIN_CAP) { atomicAdd(&(bar)[XB_TMO], 1u); break; } } } } while (0)

struct XcdBarrier {
    unsigned* bar; unsigned x;
    volatile LAS unsigned* st;
};

__device__ __forceinline__ XcdBarrier xcd_barrier_post(unsigned* bar, volatile LAS unsigned* st, const int xb_tid) {
    XcdBarrier b; b.bar = bar; b.x = xb_xcc_id(); b.st = st;
    if (xb_tid == 0) (void)xb_add(&bar[XB_XCNT(b.x)], 1u);
    return b;
}
__device__ __forceinline__ void xcd_barrier_complete(unsigned* bar, unsigned x, unsigned& nloc, unsigned& nx) {
    const unsigned G = gridDim.x * gridDim.y * gridDim.z;
    unsigned sum, cnt, mine, sp = 0u;
    for (;;) {
        sum = 0u; cnt = 0u; mine = 0u;
#pragma unroll
        for (unsigned j = 0; j < 16; ++j) { const unsigned c = xb_ld(&bar[XB_XCNT(j)]); sum += c; cnt += (c > 0u) ? 1u : 0u; mine = (j == x) ? c : mine; }
        if (sum == G) break;
        __builtin_amdgcn_s_sleep(1);
        if ((++sp & 255u) == 0u) { if (xb_ld(&bar[XB_TMO])) break; if (sp > XB_SPIN_CAP) { atomicAdd(&bar[XB_TMO], 1u); break; } }
    }
    nloc = mine > 0u ? mine : 1u; nx = cnt > 0u ? cnt : 1u;
}

__device__ __forceinline__ void xcd_barrier(const XcdBarrier& b, const int xb_tid) {
    asm volatile("s_waitcnt vmcnt(0)" ::: "memory");
    __syncthreads();
    if (xb_tid == 0) {
        unsigned* bar = b.bar;
        __builtin_amdgcn_s_waitcnt(0);
        unsigned nloc = b.st[0], nx = b.st[1];
        if (nloc == 0u) { xcd_barrier_complete(bar, b.x, nloc, nx); b.st[0] = nloc; b.st[1] = nx; }
        const unsigned old = xb_add(&bar[XB_XSUB(b.x)], 1u);
        const unsigned gen = old / nloc;
        if (old + 1u == (gen + 1u) * nloc) {
            __builtin_amdgcn_fence(__ATOMIC_RELEASE, "agent");
            asm volatile("s_waitcnt vmcnt(0)" ::: "memory");
            const unsigned og = xb_add(&bar[XB_TOP], 1u);
            const unsigned tg = og / nx;
            if (og + 1u == (tg + 1u) * nx) xb_add(&bar[XB_TOPGEN], 1u);
            else XB_SPIN(xb_ld(&bar[XB_TOPGEN]) == tg, bar);
            __builtin_amdgcn_fence(__ATOMIC_ACQUIRE, "agent");
            xb_add(&bar[XB_XGEN(b.x)], 1u);
            asm volatile("s_waitcnt vmcnt(0)" ::: "memory");
        } else {
            XB_SPIN(xb_ld(&bar[XB_XGEN(b.x)]) == gen, bar);
            __builtin_amdgcn_fence(__ATOMIC_ACQUIRE, "agent");
            asm volatile("s_waitcnt vmcnt(0)" ::: "memory");
        }
    }
    __syncthreads();
}

__device__ __forceinline__ void group_arrive(unsigned* cnt, const int xb_tid) {
    asm volatile("s_waitcnt vmcnt(0)" ::: "memory");
    __syncthreads();
    if (xb_tid == 0) {
        __builtin_amdgcn_s_waitcnt(0);
        __builtin_amdgcn_fence(__ATOMIC_RELEASE, "agent");
        asm volatile("s_waitcnt vmcnt(0)" ::: "memory");
        (void)xb_add(cnt, 1u);
    }
}
__device__ __forceinline__ void group_wait(unsigned* bar, unsigned* cnt, unsigned n, const int xb_tid) {
    __syncthreads();
    if (xb_tid == 0) {
        XB_SPIN(xb_ld(cnt) < n, bar);
        __builtin_amdgcn_fence(__ATOMIC_ACQUIRE, "agent");
        asm volatile("s_waitcnt vmcnt(0)" ::: "memory");
    }
    __syncthreads();
}

#define GAS __attribute__((address_space(1)))
typedef unsigned short bf16;
typedef unsigned v4u __attribute__((ext_vector_type(4)));
typedef unsigned v2u __attribute__((ext_vector_type(2)));
typedef float f32x4 __attribute__((ext_vector_type(4)));

constexpr int NB = 4, SEQ = 8192, DM = 1024, DEPTH = 4, CTXL = 256;
constexpr int NLAT = NB * SEQ, NCTX = NB * CTXL, MT = NLAT + NCTX;
constexpr int DIN = 3360, DINP = 3584, DFF = 2816, NEXP = 8;
constexpr int C_RQ = 0, C_RK = 256, C_RV = 512, C_RG = 768, C_S5 = 1024, C_HQ = 1280, C_HFF = 1536, C_HFB = 1792, C_HI = 2048, C_HG = 2304,
              C_GQ = 2560, C_GK = 2688, C_GV = 2816, C_GG = 3072, C_GAF = 3328, C_GAB = 3344,
              C_GZF = 3328, C_GZB = 3456;
constexpr int NSEG = 132;
constexpr int MOE_CAP_TILES = 272;
constexpr float NEPS = 1e-6f;
constexpr float WSC8 = 64.0f;

constexpr size_t MiB = 1u << 20;
constexpr size_t WS_CTL = 0, CTL_ZERO_BYTES = 2 * MiB;
constexpr size_t WS_MOD = 2 * MiB;
constexpr size_t WS_LB = 3 * MiB;
constexpr size_t WS_ROPE = 3 * MiB + 65536;
constexpr size_t WS_GLUW = 3 * MiB + 131072;
constexpr size_t WS_WIN = 4 * MiB;
constexpr size_t WS_WOUT = 32 * MiB;
constexpr size_t WS_W13D = 40 * MiB;
constexpr size_t WS_W2D = 62 * MiB;
constexpr size_t WS_W13M = 73 * MiB;
constexpr size_t WS_W2M = 161 * MiB;
constexpr size_t WS_HB = 205 * MiB;
constexpr size_t WS_ACT = 209 * MiB;
constexpr size_t WS_Z = 275 * MiB;
constexpr size_t WS_PH = 292 * MiB;
constexpr size_t WS_OF = (292 + 232) * MiB;
constexpr size_t WS_X2 = 666 * MiB;
constexpr size_t WS_LIST = 843 * MiB;
constexpr size_t WS_S5PAR = 70 * MiB;
constexpr size_t WS_END = 846 * MiB;
constexpr size_t ST_DS0 = 0;
constexpr size_t ST_DS1 = ST_DS0 + (size_t)2 * 16 * NSEG * 4096;
constexpr size_t ST_DS2 = ST_DS1 + (size_t)2 * 16 * NSEG * 4096;
constexpr size_t ST_G0 = ST_DS2 + (size_t)2 * 16 * NSEG * 2048;
constexpr size_t ST_G1 = ST_G0 + (size_t)2 * 16 * NSEG * 64;
constexpr size_t ST_G2 = ST_G1 + (size_t)2 * 16 * NSEG * 64;
constexpr size_t ST_HS = ST_G2 + (size_t)2 * 16 * NSEG * 64;
constexpr size_t ST_END = ST_HS + (size_t)2 * 64 * NSEG * 128;
static_assert(ST_END * 4 <= (WS_LIST - WS_X2), "state region");
static_assert(WS_PH + (size_t)MT * DINP * 2 <= WS_OF && WS_OF + (size_t)MT * 768 * 4 <= WS_X2, "OF region");
static_assert((size_t)MOE_CAP_TILES * 256 * 1024 * 2 <= (WS_LIST - WS_X2), "XB region");
static_assert((size_t)MOE_CAP_TILES * 256 * DFF * 2 <= (WS_X2 - WS_PH) && (size_t)MT * DINP * 2 <= (WS_X2 - WS_PH), "P/H region");
constexpr int CW_BAR = 4096;
constexpr int FP8_F1_J = 1;
constexpr int CW_TAIL = 32768;
constexpr int CW_CNT = 16384;

constexpr int LDS_BYTES = 163840;
constexpr int MISC_OFF = 163840 - 512;

__device__ __forceinline__ float bf2f(unsigned short h) { return __uint_as_float(((unsigned)h) << 16); }
__device__ __forceinline__ unsigned f2bf(float f) { unsigned u = __float_as_uint(f); return (u + 0x7fffu + ((u >> 16) & 1u)) >> 16; }
__device__ __forceinline__ unsigned pk2(float lo, float hi) { return f2bf(lo) | (f2bf(hi) << 16); }
__device__ __forceinline__ float wave_sum(float v) {
#define WS_DPP(ctrl, rmask) v += __int_as_float(__builtin_amdgcn_update_dpp(0, __float_as_int(v), (ctrl), (rmask), 0xf, false))
    WS_DPP(0x111, 0xf); WS_DPP(0x112, 0xf); WS_DPP(0x114, 0xf); WS_DPP(0x118, 0xf); WS_DPP(0x142, 0xa); WS_DPP(0x143, 0xc);
#undef WS_DPP
    return __int_as_float(__builtin_amdgcn_readlane(__float_as_int(v), 63));
}
__device__ __forceinline__ float rdl(float v, int k) { return __uint_as_float((unsigned)__builtin_amdgcn_readlane((int)__float_as_uint(v), k)); }
__device__ __forceinline__ float sigm(float x) { return __builtin_amdgcn_rcpf(1.0f + __expf(-x)); }
__device__ __forceinline__ float silu_f(float x) { return x * __builtin_amdgcn_rcpf(1.0f + __expf(-x)); }
#define LDS_WAIT() asm volatile("s_waitcnt lgkmcnt(0)" ::: "memory")

struct Args {
    const float* in[37];
    int l_lo, l_hi, ph_lo, ph_hi, do_pro, do_fin, fused, pad;
};
constexpr int I_OUT = 35, I_WS = 36;
enum { I_X = 0, I_C, I_CTX, I_CCTX, I_ADAW, I_ADAB, I_N1W, I_N2W, I_WIN, I_WOUT, I_RETGN, I_LAMRE, I_LAMIM, I_LOGDT, I_BRE, I_BIM, I_CRE, I_CIM, I_S5D,
       I_GLUW, I_GLUB, I_LBL, I_HGNW, I_WA2, I_BA, I_GLANW, I_FW1, I_FW3, I_FW2, I_RW, I_RB, I_MW1, I_MW3, I_MW2, I_FINW };

struct Frame {
    LAS unsigned char* lds;
    int tid, lane, wave, gw, NGW, G, zz;
    unsigned char* ws; float* out;
};

struct EpiStoreBf16 {
    static constexpr bool PERM = true, AFTER_DRAIN = false;
    bf16* O; int ldc; float sc;
    __device__ __forceinline__ void operator()(const pg8::f32x4 (&acc)[2][2][4][2], const pg8::Unit& u, int wr, int wc, int fr, int fq) const {
        const int row0 = u.pm * 256 + wr * 64 + fr, col0 = u.pc * 256 + wc * 32 + 8 * fq;
#pragma unroll
        for (int ai = 0; ai < 2; ++ai)
#pragma unroll
            for (int m = 0; m < 4; ++m) { bf16* rowp = O + (size_t)(row0 + ai * 128 + m * 16) * ldc + col0;
#pragma unroll
                for (int bj = 0; bj < 2; ++bj) { const pg8::f32x4 v0 = acc[ai][bj][m][0] * sc, v1 = acc[ai][bj][m][1] * sc;
                    pg8::u32x4 w; w.x = pg8::cvt_pk_bf16(v0[0], v0[1]); w.y = pg8::cvt_pk_bf16(v0[2], v0[3]); w.z = pg8::cvt_pk_bf16(v1[0], v1[1]); w.w = pg8::cvt_pk_bf16(v1[2], v1[3]);
                    *(pg8::u32x4*)(rowp + bj * 128) = w; } }
    }
};
constexpr int P4G = 4 * DINP, P4S5 = 4096;
struct EpiStoreP4 {
    static constexpr bool PERM = true, FLIP = true, AFTER_DRAIN = false;
    bf16* O;
    __device__ __forceinline__ void operator()(const pg8::f32x4 (&acc)[2][2][4][2], const pg8::Unit& u, int wr, int wc, int fr, int fq) const {
        const int grp0 = u.pm * 64 + wr * 16 + fq;
        if (!(u.pc == 3 || u.pc == 4 || u.pc == 9 || u.pc == 12)) {
            bf16* base = O + (size_t)grp0 * P4G + (size_t)(u.pc * 256 + wc * 32 + 2 * fr) * 4;
#pragma unroll
            for (int ai = 0; ai < 2; ++ai)
#pragma unroll
                for (int m = 0; m < 4; ++m) { bf16* gp = base + (size_t)(ai * 32 + m * 4) * P4G;
#pragma unroll
                    for (int bj = 0; bj < 2; ++bj) { const pg8::f32x4 v0 = acc[ai][bj][m][0], v1 = acc[ai][bj][m][1];
                        pg8::u32x4 w; w.x = pg8::cvt_pk_bf16(v0[0], v0[1]); w.y = pg8::cvt_pk_bf16(v0[2], v0[3]); w.z = pg8::cvt_pk_bf16(v1[0], v1[1]); w.w = pg8::cvt_pk_bf16(v1[2], v1[3]);
                        *(pg8::u32x4*)(gp + bj * 512) = w; } }
        } else {
            bf16* base = O + (size_t)grp0 * P4G + u.pc * 1024 + wc * 32 + 2 * fr;
#pragma unroll
            for (int ai = 0; ai < 2; ++ai)
#pragma unroll
                for (int m = 0; m < 4; ++m) { bf16* gp = base + (size_t)(ai * 32 + m * 4) * P4G;
#pragma unroll
                    for (int bj = 0; bj < 2; ++bj)
#pragma unroll
                        for (int r = 0; r < 4; ++r) *(unsigned*)(gp + r * 256 + bj * 128) = pg8::cvt_pk_bf16(acc[ai][bj][m][0][r], acc[ai][bj][m][1][r]); }
        }
    }
};
struct EpiSwiglu {
    static constexpr bool PERM = true, AFTER_DRAIN = false;
    bf16* H;
    __device__ __forceinline__ void operator()(const pg8::f32x4 (&acc)[2][2][4][2], const pg8::Unit& u, int wr, int wc, int fr, int fq) const {
        const int row0 = u.pm * 256 + wr * 64 + fr, col0 = u.pc * 128 + wc * 32 + 8 * fq;
#pragma unroll
        for (int ai = 0; ai < 2; ++ai)
#pragma unroll
            for (int m = 0; m < 4; ++m) { bf16* rowp = H + (size_t)(row0 + ai * 128 + m * 16) * DFF + col0;
                float h[8];
#pragma unroll
                for (int n = 0; n < 2; ++n)
#pragma unroll
                    for (int j = 0; j < 4; ++j) { const float a = acc[ai][0][m][n][j], b = acc[ai][1][m][n][j];
                        h[n * 4 + j] = a * __builtin_amdgcn_rcpf(1.0f + __builtin_amdgcn_exp2f(-1.4426950408889634f * a)) * b; }
                pg8::u32x4 w; w.x = pg8::cvt_pk_bf16(h[0], h[1]); w.y = pg8::cvt_pk_bf16(h[2], h[3]); w.z = pg8::cvt_pk_bf16(h[4], h[5]); w.w = pg8::cvt_pk_bf16(h[6], h[7]);
                *(pg8::u32x4*)rowp = w; }
    }
};
struct EpiSwiglu8 {
    static constexpr bool PERM = true, AFTER_DRAIN = false;
    unsigned char* H; float sc;
    __device__ __forceinline__ void operator()(const pg8::f32x4 (&acc)[2][2][4][2], const pg8::Unit& u, int wr, int wc, int fr, int fq) const {
        const int row0 = u.pm * 256 + wr * 64 + fr, col0 = u.pc * 128 + wc * 32 + 8 * fq;
        const float c1 = -1.4426950408889634f * sc, s2 = sc * sc;
#pragma unroll
        for (int ai = 0; ai < 2; ++ai)
#pragma unroll
            for (int m = 0; m < 4; ++m) { unsigned char* rowp = H + (size_t)(row0 + ai * 128 + m * 16) * DFF + col0;
                float h[8];
#pragma unroll
                for (int n = 0; n < 2; ++n)
#pragma unroll
                    for (int j = 0; j < 4; ++j) { const float a = acc[ai][0][m][n][j], b = acc[ai][1][m][n][j];
                        const float hv = (a * b) * __builtin_amdgcn_rcpf(1.0f + __builtin_amdgcn_exp2f(c1 * a)) * s2;
                        h[n * 4 + j] = __builtin_amdgcn_fmed3f(hv, -448.0f, 448.0f); }
                unsigned w0 = 0u, w1 = 0u;
                w0 = __builtin_amdgcn_cvt_pk_fp8_f32(h[0], h[1], w0, false); w0 = __builtin_amdgcn_cvt_pk_fp8_f32(h[2], h[3], w0, true);
                w1 = __builtin_amdgcn_cvt_pk_fp8_f32(h[4], h[5], w1, false); w1 = __builtin_amdgcn_cvt_pk_fp8_f32(h[6], h[7], w1, true);
                v2u w; w.x = w0; w.y = w1; *(v2u*)rowp = w; }
    }
};
struct EpiResid {
    static constexpr bool PERM = false, AFTER_DRAIN = false;
    const float* xin_lat; const float* xin_ctx; float* xout_lat; float* xout_ctx; const float* gate; float sc; int pm_off;
    __device__ __forceinline__ void operator()(const pg8::f32x4 (&acc)[2][2][4][2], const pg8::Unit& u, int wr, int wc, int fr, int fq) const {
        const int pmg = u.pm + pm_off; const bool isctx = pmg >= 128; const int bidx = isctx ? 4 : (pmg >> 5);
        const size_t rbase = (size_t)(isctx ? (pmg - 128) : pmg) * 256 + wr * 64 + fr;
        const float* xi = (isctx ? xin_ctx : xin_lat); float* xo = (isctx ? xout_ctx : xout_lat);
        const int col0 = u.pc * 256 + wc * 32 + 4 * fq; const float* g = gate + (size_t)bidx * 6144 + col0;
        pg8::f32x4 gv[2][2];
#pragma unroll
        for (int bj = 0; bj < 2; ++bj)
#pragma unroll
            for (int n = 0; n < 2; ++n) gv[bj][n] = *(const pg8::f32x4*)(g + bj * 128 + n * 16) * sc;
#pragma unroll
        for (int ai = 0; ai < 2; ++ai)
#pragma unroll
            for (int m = 0; m < 4; ++m) { const size_t off = (rbase + ai * 128 + m * 16) * 1024 + col0;
#pragma unroll
                for (int bj = 0; bj < 2; ++bj)
#pragma unroll
                    for (int n = 0; n < 2; ++n) { const pg8::f32x4 xv = *(const pg8::f32x4*)(xi + off + bj * 128 + n * 16);
                        *(pg8::f32x4*)(xo + off + bj * 128 + n * 16) = xv + gv[bj][n] * acc[ai][bj][m][n]; }
                asm volatile("" ::: "memory"); }
    }
};
struct EpiGlu {
    static constexpr bool PERM = true, AFTER_DRAIN = false;
    const bf16* Z; bf16* Y; const float* bias;
    __device__ __forceinline__ void operator()(const pg8::f32x4 (&acc)[2][2][4][2], const pg8::Unit& u, int wr, int wc, int fr, int fq) const {
        const int row0 = u.pm * 256 + wr * 64 + fr, col0 = wc * 32 + 8 * fq;
#pragma unroll
        for (int ai = 0; ai < 2; ++ai)
#pragma unroll
            for (int m = 0; m < 4; ++m) { const size_t row = (size_t)(row0 + ai * 128 + m * 16);
#pragma unroll
                for (int bj = 0; bj < 2; ++bj) { const int col = col0 + bj * 128;
                    const pg8::u32x4 zz = *(const pg8::u32x4*)(Z + row * 256 + col);
                    const pg8::f32x4 b0 = *(const pg8::f32x4*)(bias + col), b1 = *(const pg8::f32x4*)(bias + col + 4);
                    const pg8::f32x4 v0 = acc[ai][bj][m][0] + b0, v1 = acc[ai][bj][m][1] + b1;
                    float o[8]; const unsigned zw[4] = {zz.x, zz.y, zz.z, zz.w};
#pragma unroll
                    for (int j = 0; j < 4; ++j) { const float zl = __uint_as_float(zw[j] << 16), zh = __uint_as_float(zw[j] & 0xffff0000u);
                        const float a0 = (j < 2) ? v0[2 * j] : v1[2 * j - 4], a1 = (j < 2) ? v0[2 * j + 1] : v1[2 * j - 3];
                        o[2 * j] = zl * sigm(a0); o[2 * j + 1] = zh * sigm(a1); }
                    pg8::u32x4 w; w.x = pg8::cvt_pk_bf16(o[0], o[1]); w.y = pg8::cvt_pk_bf16(o[2], o[3]); w.z = pg8::cvt_pk_bf16(o[4], o[5]); w.w = pg8::cvt_pk_bf16(o[6], o[7]);
                    *(pg8::u32x4*)(Y + row * 1024 + 256 + col) = w; }
                asm volatile("" ::: "memory"); }
    }
};
struct MoeOrder {
    int tp[9]; int nN, G, c, total;
    __device__ __forceinline__ void init(const unsigned* cnt, int nN_, int G_, int c_) {
        tp[0] = 0;
#pragma unroll
        for (int e = 0; e < 8; ++e) tp[e + 1] = tp[e] + (int)(((unsigned)__builtin_amdgcn_readfirstlane((int)__hip_atomic_load(cnt + e * 64, __ATOMIC_RELAXED, __HIP_MEMORY_SCOPE_AGENT)) + 255u) >> 8);
        nN = nN_; G = G_; c = c_; total = tp[8] * nN;
    }
    __device__ __forceinline__ bool next(int i, pg8::Unit& u) const {
        const int L = i * G + c; if (L >= total) return false;
        int wgid = L; { const int q = total / pg8::NXCD, r = total % pg8::NXCD, xcd = wgid % pg8::NXCD, off = wgid / pg8::NXCD; wgid = (xcd < r ? xcd * (q + 1) : r * (q + 1) + (xcd - r) * q) + off; }
        const int nM = tp[8], nig = pg8::WGM * nN, gid = wgid / nig, fm = gid * pg8::WGM, gsz = (nM - fm) < pg8::WGM ? (nM - fm) : pg8::WGM;
        const int rem = wgid - gid * nig, t = fm + rem % gsz, pn = rem / gsz; int e = 0;
#pragma unroll
        for (int k = 1; k < 8; ++k) e += (t >= tp[k]) ? 1 : 0;
        u.pm = t; u.pn = e * nN + pn; u.pc = pn; return true;
    }
    __device__ __forceinline__ void a_ready(const pg8::Unit&) const {}
    __device__ __forceinline__ void done(const pg8::Unit&) const {}
};

__device__ __forceinline__ void cvt_item(const float* W, int K, int N, bf16* WT, int mode, int add, LAS float* scr, int item, int lane, int nblk_override = 0, const float* ks = nullptr  ) {
    const int nblk = nblk_override ? nblk_override : (N >> 5), kb = item / nblk, nb = item - kb * nblk, k0 = 64 * kb, n0 = 32 * nb;
    const int r = lane >> 3, c4 = lane & 7;
    f32x4 v[8];
#pragma unroll
    for (int i = 0; i < 8; ++i) v[i] = *(const f32x4*)(W + (size_t)(k0 + 8 * i + r) * N + n0 + 4 * c4);
    if (ks) {
#pragma unroll
        for (int i = 0; i < 8; ++i) v[i] *= ks[8 * i + r]; }
#pragma unroll
    for (int i = 0; i < 8; ++i) {
#pragma unroll
        for (int j = 0; j < 4; ++j) scr[(8 * i + r) * 33 + 4 * c4 + j] = v[i][j]; }
    LDS_WAIT();
    const int c = lane & 7;
#pragma unroll
    for (int j = 0; j < 4; ++j) { const int n = (lane >> 3) + 8 * j; const LAS float* s = scr + (8 * c) * 33 + n;
        v4u o; o.x = pk2(s[0 * 33], s[1 * 33]); o.y = pk2(s[2 * 33], s[3 * 33]); o.z = pk2(s[4 * 33], s[5 * 33]); o.w = pk2(s[6 * 33], s[7 * 33]);
        const int nn = n0 + n; const int drow = (mode == 0) ? (nn + add) : (((nn >> 7) << 8) + (nn & 127) + add);
        *(v4u*)(WT + (size_t)drow * K + k0 + 8 * c) = o; }
    LDS_WAIT();
}
__device__ __forceinline__ void cvt_item_f8(const float* W, int K, int N, unsigned char* WT, int mode, int add, LAS float* scr, int item, int lane) {
    const int nblk = N >> 5, kb = item / nblk, nb = item - kb * nblk, k0 = 64 * kb, n0 = 32 * nb;
    const int r = lane >> 3, c4 = lane & 7;
    f32x4 v[8];
#pragma unroll
    for (int i = 0; i < 8; ++i) v[i] = *(const f32x4*)(W + (size_t)(k0 + 8 * i + r) * N + n0 + 4 * c4);
#pragma unroll
    for (int i = 0; i < 8; ++i) {
#pragma unroll
        for (int j = 0; j < 4; ++j) scr[(8 * i + r) * 33 + 4 * c4 + j] = v[i][j]; }
    LDS_WAIT();
    const int c = lane & 3;
#pragma unroll
    for (int j = 0; j < 2; ++j) { const int n = (lane >> 2) + 16 * j; const LAS float* s = scr + (16 * c) * 33 + n;
        unsigned w[4];
#pragma unroll
        for (int q = 0; q < 4; ++q) { unsigned x = 0u;
            x = __builtin_amdgcn_cvt_pk_fp8_f32(s[(4 * q) * 33] * WSC8, s[(4 * q + 1) * 33] * WSC8, x, false);
            x = __builtin_amdgcn_cvt_pk_fp8_f32(s[(4 * q + 2) * 33] * WSC8, s[(4 * q + 3) * 33] * WSC8, x, true); w[q] = x; }
        v4u o; o.x = w[0]; o.y = w[1]; o.z = w[2]; o.w = w[3];
        const int nn = n0 + n; const int drow = (mode == 0) ? (nn + add) : (((nn >> 7) << 8) + (nn & 127) + add);
        *(v4u*)(WT + (size_t)drow * K + k0 + 16 * c) = o; }
    LDS_WAIT();
}
__device__ __forceinline__ void moe_cvt_idle(const Frame& F, const Args& a, int j, int b_lo) {
    LAS float* scr = (LAS float*)(F.lds + F.wave * 16384);
    constexpr int IT = 1408;
    const int nw = (F.G - b_lo) * 8, w = ((int)blockIdx.x - b_lo) * 8 + F.wave;
    for (int it = w; it < 8 * 3 * IT; it += nw) {
        const int e = it / (3 * IT), r = it - e * 3 * IT, which = r / IT, item = r - which * IT;
        const size_t eo = ((size_t)j * 8 + e) * (size_t)(1024 * DFF);
        if (which == 0) cvt_item_f8(a.in[F.zz + I_MW1] + eo, 1024, DFF, F.ws + WS_W13M + (size_t)e * 5632 * 1024, 1, 0, scr, item, F.lane);
        else if (which == 1) cvt_item_f8(a.in[F.zz + I_MW3] + eo, 1024, DFF, F.ws + WS_W13M + (size_t)e * 5632 * 1024, 1, 128, scr, item, F.lane);
        else cvt_item_f8(a.in[F.zz + I_MW2] + eo, DFF, 1024, F.ws + WS_W2M + (size_t)e * 1024 * DFF, 0, 0, scr, item, F.lane);
    }
}
__device__ __forceinline__ void moe_cvt(const Frame& F, const Args& a, int j) {
    LAS float* scr = (LAS float*)(F.lds + F.wave * 16384);
    constexpr int IT = 1408;
    for (int it = F.gw; it < 8 * 3 * IT; it += F.NGW) {
        const int e = it / (3 * IT), r = it - e * 3 * IT, which = r / IT, item = r - which * IT;
        const size_t eo = ((size_t)j * 8 + e) * (size_t)(1024 * DFF);
        if (which == 0) cvt_item_f8(a.in[F.zz + I_MW1] + eo, 1024, DFF, F.ws + WS_W13M + (size_t)e * 5632 * 1024, 1, 0, scr, item, F.lane);
        else if (which == 1) cvt_item_f8(a.in[F.zz + I_MW3] + eo, 1024, DFF, F.ws + WS_W13M + (size_t)e * 5632 * 1024, 1, 128, scr, item, F.lane);
        else cvt_item_f8(a.in[F.zz + I_MW2] + eo, DFF, 1024, F.ws + WS_W2M + (size_t)e * 1024 * DFF, 0, 0, scr, item, F.lane);
    }
}
__device__ __forceinline__ void prologue(const Frame& F, const Args& a) {
    {
        LAS float* sc = (LAS float*)F.lds; LAS float* red = sc + 5120;
        for (int idx = F.tid; idx < 5120; idx += 512) { const int r = idx >> 10, k = idx & 1023; const float cv = (r < 4) ? a.in[F.zz + I_C][r * 1024 + k] : a.in[F.zz + I_CCTX][k]; sc[idx] = silu_f(cv); }
        __syncthreads();
        float* MOD = (float*)(F.ws + WS_MOD);
        for (int item = blockIdx.x; item < 384; item += F.G) {
            const int l = item / 96, nb = item - l * 96, cl = F.tid & 63, ks = F.tid >> 6, n = nb * 64 + cl;
            float acc[5] = {0.f, 0.f, 0.f, 0.f, 0.f};
            const float* wp = a.in[F.zz + I_ADAW] + ((size_t)l * 1024 + ks * 128) * 6144 + n;
#pragma unroll 16
            for (int kk = 0; kk < 128; ++kk) { const float w = wp[(size_t)kk * 6144];
#pragma unroll
                for (int r = 0; r < 5; ++r) acc[r] = fmaf(sc[r * 1024 + ks * 128 + kk], w, acc[r]); }
#pragma unroll
            for (int r = 0; r < 5; ++r) red[(ks * 5 + r) * 64 + cl] = acc[r];
            __syncthreads();
            if (F.tid < 320) { const int r = F.tid >> 6; float s = 0.f;
#pragma unroll
                for (int k2 = 0; k2 < 8; ++k2) s += red[(k2 * 5 + r) * 64 + cl];
                MOD[((size_t)l * 5 + r) * 6144 + n] = s + a.in[F.zz + I_ADAB][l * 6144 + n]; }
            __syncthreads();
        }
        if (blockIdx.x == 0 && F.tid < 256) {
            const float* lg = a.in[F.zz + I_LBL]; float x[4], mx = -3.0e38f;
#pragma unroll
            for (int l = 0; l < 4; ++l) { x[l] = lg[l * 256 + F.tid]; mx = fmaxf(mx, x[l]); }
            float s = 0.f;
#pragma unroll
            for (int l = 0; l < 4; ++l) { x[l] = expf(x[l] - mx); s += x[l]; }
            float cs = 0.f; const float sm0 = x[0] / s; float* LB = (float*)(F.ws + WS_LB);
#pragma unroll
            for (int l = 0; l < 4; ++l) { cs += x[l] / s; LB[l * 256 + F.tid] = fminf(fmaxf(cs - sm0, 0.f), 1.0f - 1e-6f); }
        }
        if (blockIdx.x == (1 % F.G)) {
            float* RC = (float*)(F.ws + WS_ROPE); float* RS = RC + 2048;
            for (int idx = F.tid; idx < 2048; idx += 512) { const int pos = idx >> 4, i = idx & 15;
                const float fr = powf(10000.0f, -(float)i / 16.0f); const float ang = (float)pos * fr; RC[idx] = cosf(ang); RS[idx] = sinf(ang); }
        }
        __syncthreads();
    }
    LAS float* scr = (LAS float*)(F.lds + F.wave * 16384);
    constexpr int I_IN = 16 * 104, I_OUT = 16 * 32, I_F = 1408, I_GL = 4 * 8;
    constexpr int NIT = 4 * I_IN + 4 * I_OUT + 6 * I_F + 4 * I_GL;
    for (int it = F.gw; it < NIT; it += F.NGW) {
        int r = it;
        if (r < 4 * I_IN) { const int l = r / I_IN; cvt_item(a.in[F.zz + I_WIN] + (size_t)l * 1024 * DIN, 1024, DIN, (bf16*)(F.ws + WS_WIN) + (size_t)l * DINP * 1024, 0, 0, scr, r - l * I_IN, F.lane, 104); continue; } r -= 4 * I_IN;
        if (r < 4 * I_OUT) { const int l = r / I_OUT, it = r - l * I_OUT, k0 = 64 * (it >> 5);
            const float* ks = k0 < 256 ? a.in[F.zz + I_RETGN] + l * 256 + k0 : (k0 < 512 ? nullptr : (k0 < 768 ? a.in[F.zz + I_HGNW] + l * 256 + (k0 - 512) : a.in[F.zz + I_GLANW] + l * 256 + (k0 - 768)));
            cvt_item(a.in[F.zz + I_WOUT] + (size_t)l * 1024 * 1024, 1024, 1024, (bf16*)(F.ws + WS_WOUT) + (size_t)l * 1024 * 1024, 0, 0, scr, it, F.lane, 0, ks); continue; } r -= 4 * I_OUT;
        if (r < 6 * I_F) { const int j = r / (3 * I_F), r2 = r - j * 3 * I_F, which = r2 / I_F, item = r2 - which * I_F; const size_t wo = (size_t)j * 1024 * DFF;
            if (j == FP8_F1_J && which < 2) {
                if (which == 0) cvt_item_f8(a.in[F.zz + I_FW1] + wo, 1024, DFF, F.ws + WS_W13D + (size_t)j * 5632 * 1024 * 2, 1, 0, scr, item, F.lane);
                else if (which == 1) cvt_item_f8(a.in[F.zz + I_FW3] + wo, 1024, DFF, F.ws + WS_W13D + (size_t)j * 5632 * 1024 * 2, 1, 128, scr, item, F.lane);
            } else
            if (which == 0) cvt_item(a.in[F.zz + I_FW1] + wo, 1024, DFF, (bf16*)(F.ws + WS_W13D) + (size_t)j * 5632 * 1024, 1, 0, scr, item, F.lane);
            else if (which == 1) cvt_item(a.in[F.zz + I_FW3] + wo, 1024, DFF, (bf16*)(F.ws + WS_W13D) + (size_t)j * 5632 * 1024, 1, 128, scr, item, F.lane);
            else cvt_item_f8(a.in[F.zz + I_FW2] + wo, DFF, 1024, F.ws + WS_W2D + (size_t)j * 1024 * DFF, 0, 0, scr, item, F.lane);
            continue; } r -= 6 * I_F;
        { const int l = r / I_GL; cvt_item(a.in[F.zz + I_GLUW] + (size_t)l * 65536, 256, 256, (bf16*)(F.ws + WS_GLUW) + (size_t)l * 65536, 0, 0, scr, r - l * I_GL, F.lane); }
    }
    for (int i = blockIdx.x * 512 + F.tid; i < 4 * 256 * 128; i += F.G * 512) {
        const int l = i >> 15, rem = i & 32767, n = rem >> 7, k0 = (rem & 127) * 8, d = n >> 7, cidx = n & 127;
        const float* wa = a.in[F.zz + I_WA2] + ((size_t)(l * 2 + d) * 16) * 128 + cidx;
        float acc[8] = {0.f, 0.f, 0.f, 0.f, 0.f, 0.f, 0.f, 0.f};
#pragma unroll
        for (int r = 0; r < 16; ++r) { const float w2 = wa[r * 128];
#pragma unroll
            for (int kk = 0; kk < 8; ++kk) acc[kk] = fmaf(a.in[F.zz + I_WIN][((size_t)l * 1024 + k0 + kk) * DIN + 3328 + 16 * d + r], w2, acc[kk]); }
        v4u o; o.x = pk2(acc[0], acc[1]); o.y = pk2(acc[2], acc[3]); o.z = pk2(acc[4], acc[5]); o.w = pk2(acc[6], acc[7]);
        *(v4u*)((bf16*)(F.ws + WS_WIN) + ((size_t)l * DINP + 3328 + n) * 1024 + k0) = o;
    }
}

struct MoeTp { int tp[9]; };
__device__ __forceinline__ void load_tp(MoeTp& t, const unsigned* cnt) {
    t.tp[0] = 0;
#pragma unroll
    for (int e = 0; e < 8; ++e) t.tp[e + 1] = t.tp[e] + (int)(((unsigned)__builtin_amdgcn_readfirstlane((int)__hip_atomic_load(cnt + e * 64, __ATOMIC_RELAXED, __HIP_MEMORY_SCOPE_AGENT)) + 255u) >> 8);
}
__device__ __forceinline__ void moe_route_flush(const Frame& F, int jm, int nk, int rt_e, int rt_m, float g0, float g1) {
    unsigned* cnt = (unsigned*)F.ws + CW_CNT + jm * 8 * 64; int* LIST = (int*)(F.ws + WS_LIST);
    int* EPw = (int*)(F.ws + WS_LIST) + 8 * MT; float* GW = (float*)(F.ws + WS_LIST) + 10 * MT;
    const bool has = F.lane < nk; const int e0 = rt_e & 15, e1 = rt_e >> 4;
    unsigned p0 = 0u, p1 = 0u;
#pragma unroll
    for (int e = 0; e < 8; ++e) {
        const unsigned long long b0 = __ballot(has && e0 == e), b1 = __ballot(has && e1 == e);
        const unsigned c0 = (unsigned)__popcll(b0), c = c0 + (unsigned)__popcll(b1);
        if (c == 0u) continue;
        unsigned base = 0u;
        if (F.lane == 0) base = __hip_atomic_fetch_add(cnt + e * 64, c, __ATOMIC_RELAXED, __HIP_MEMORY_SCOPE_AGENT);
        base = (unsigned)__builtin_amdgcn_readfirstlane((int)base);
        const unsigned long long below = (1ull << F.lane) - 1ull;
        if (has && e0 == e) p0 = base + (unsigned)__popcll(b0 & below);
        if (has && e1 == e) p1 = base + c0 + (unsigned)__popcll(b1 & below);
    }
    if (has) {
        LIST[e0 * MT + p0] = rt_m; LIST[e1 * MT + p1] = rt_m;
        EPw[2 * rt_m] = e0 | (int)(p0 << 3); EPw[2 * rt_m + 1] = e1 | (int)(p1 << 3);
        GW[2 * rt_m] = g0; GW[2 * rt_m + 1] = g1;
    }
}
template <int MODE>
__device__ __forceinline__ void norm_phase(const Frame& F, const Args& a, int l, int which  , int nrows, int comb_l  ,
                                           int row_lo = 0, int w0 = -1  , int nwav = 0) {
    const int wv_ = (w0 < 0) ? F.gw : w0, nwv_ = (w0 < 0) ? F.NGW : nwav;
    const float* MOD = (const float*)(F.ws + WS_MOD);
    const float* nw = (MODE == 2) ? a.in[F.zz + I_FINW] : ((which ? a.in[F.zz + I_N2W] : a.in[F.zz + I_N1W]) + l * 1024);
    bf16* XN = (bf16*)(F.ws + WS_ACT);
    float* hb = (float*)(F.ws + WS_HB);
    const int* EP = (const int*)(F.ws + WS_LIST) + 8 * MT; const float* GATE = (const float*)(F.ws + WS_LIST) + 10 * MT;
    const bf16* YM = (const bf16*)(F.ws + WS_X2);
    const bool from_input = (l == 0 && which == 0 && MODE != 2);
    MoeTp ctp; if (comb_l >= 0) load_tp(ctp, (const unsigned*)F.ws + CW_CNT + (comb_l >> 1) * 8 * 64);
    const int jm = l >> 1;
    LAS float* rwl = (LAS float*)F.lds;
    if (MODE == 1) {
        const float* rw = a.in[F.zz + I_RW] + (size_t)jm * 8192;
        for (int idx = F.tid; idx < 8192; idx += 512) { const int k = idx >> 3, e = idx & 7; rwl[e * 1024 + k] = rw[idx]; }
        __syncthreads();
    }
    f32x4 wv[4];
#pragma unroll
    for (int j = 0; j < 4; ++j) wv[j] = *((const f32x4*)nw + F.lane + 64 * j);
    f32x4 vn[4]; int epn0 = 0, epn1 = 0; float gn0 = 0.f, gn1 = 0.f, gq0 = 0.f, gq1 = 0.f; v2u ymn0[4], ymn1[4];
#pragma unroll
    for (int j = 0; j < 4; ++j) { ymn0[j] = (v2u){0u, 0u}; ymn1[j] = (v2u){0u, 0u}; }
    { const int m = (row_lo + wv_ < nrows) ? row_lo + wv_ : row_lo; const bool isctx = m >= NLAT;
      const float* xr = from_input ? (isctx ? a.in[F.zz + I_CTX] + (size_t)(m - NLAT) * 1024 : a.in[F.zz + I_X] + (size_t)m * 1024) : (isctx ? hb + (size_t)(m - NLAT) * 1024 : F.out + (size_t)m * 1024);
#pragma unroll
      for (int j = 0; j < 4; ++j) vn[j] = *((const f32x4*)xr + F.lane + 64 * j);
      if (comb_l >= 0) { const int e0 = EP[2 * m], e1 = EP[2 * m + 1]; gn0 = GATE[2 * m]; gn1 = GATE[2 * m + 1];
          int t0 = 0, t1 = 0;
#pragma unroll
          for (int e = 0; e < 8; ++e) { t0 = ((e0 & 7) == e) ? ctp.tp[e] : t0; t1 = ((e1 & 7) == e) ? ctp.tp[e] : t1; }
          const size_t d0 = (size_t)t0 * 256 + (e0 >> 3), d1 = (size_t)t1 * 256 + (e1 >> 3);
#pragma unroll
          for (int j = 0; j < 4; ++j) { ymn0[j] = *((const v2u*)(YM + d0 * 1024) + F.lane + 64 * j); ymn1[j] = *((const v2u*)(YM + d1 * 1024) + F.lane + 64 * j); }
          const int m1 = (m + nwv_ < nrows) ? m + nwv_ : m;
          epn0 = EP[2 * m1]; epn1 = EP[2 * m1 + 1]; gq0 = GATE[2 * m1]; gq1 = GATE[2 * m1 + 1]; } }
    int mod_b = -1; f32x4 ms0[4], ms1[4];
#pragma unroll
    for (int j = 0; j < 4; ++j) { ms0[j] = (f32x4){0.f, 0.f, 0.f, 0.f}; ms1[j] = ms0[j]; }
    int rt_k = 0, rt_e = 0, rt_m = 0; float rt_g0 = 0.f, rt_g1 = 0.f;
    for (int m = row_lo + wv_; m < nrows; m += nwv_) {
        const bool isctx = m >= NLAT; const int bidx = isctx ? 4 : (m >> 13);
        f32x4 v[4];
#pragma unroll
        for (int j = 0; j < 4; ++j) v[j] = vn[j];
        const float g0 = gn0, g1 = gn1; v2u ym0[4], ym1[4];
#pragma unroll
        for (int j = 0; j < 4; ++j) { ym0[j] = ymn0[j]; ym1[j] = ymn1[j]; }
        { const int mn = (m + nwv_ < nrows) ? m + nwv_ : m; const bool cn = mn >= NLAT;
          const float* xr = from_input ? (cn ? a.in[F.zz + I_CTX] + (size_t)(mn - NLAT) * 1024 : a.in[F.zz + I_X] + (size_t)mn * 1024) : (cn ? hb + (size_t)(mn - NLAT) * 1024 : F.out + (size_t)mn * 1024);
#pragma unroll
          for (int j = 0; j < 4; ++j) vn[j] = *((const f32x4*)xr + F.lane + 64 * j);
          if (comb_l >= 0) {
              int t0 = 0, t1 = 0;
#pragma unroll
              for (int e = 0; e < 8; ++e) { t0 = ((epn0 & 7) == e) ? ctp.tp[e] : t0; t1 = ((epn1 & 7) == e) ? ctp.tp[e] : t1; }
              const size_t d0 = (size_t)t0 * 256 + (epn0 >> 3), d1 = (size_t)t1 * 256 + (epn1 >> 3);
#pragma unroll
              for (int j = 0; j < 4; ++j) { ymn0[j] = *((const v2u*)(YM + d0 * 1024) + F.lane + 64 * j); ymn1[j] = *((const v2u*)(YM + d1 * 1024) + F.lane + 64 * j); }
              gn0 = gq0; gn1 = gq1;
              const int mn2 = (mn + nwv_ < nrows) ? mn + nwv_ : mn;
              epn0 = EP[2 * mn2]; epn1 = EP[2 * mn2 + 1]; gq0 = GATE[2 * mn2]; gq1 = GATE[2 * mn2 + 1]; } }
        if (comb_l >= 0) {
            const float* m5 = MOD + ((size_t)comb_l * 5 + bidx) * 6144 + 5 * 1024;
            float* xw = isctx ? hb + (size_t)(m - NLAT) * 1024 : F.out + (size_t)m * 1024;
#pragma unroll
            for (int j = 0; j < 4; ++j) {
                const v2u y0 = ym0[j], y1 = ym1[j];
                const f32x4 mm = *((const f32x4*)m5 + F.lane + 64 * j);
                f32x4 f0, f1;
                f0[0] = __uint_as_float(y0.x << 16); f0[1] = __uint_as_float(y0.x & 0xffff0000u); f0[2] = __uint_as_float(y0.y << 16); f0[3] = __uint_as_float(y0.y & 0xffff0000u);
                f1[0] = __uint_as_float(y1.x << 16); f1[1] = __uint_as_float(y1.x & 0xffff0000u); f1[2] = __uint_as_float(y1.y << 16); f1[3] = __uint_as_float(y1.y & 0xffff0000u);
                v[j] = v[j] + mm * (f0 * g0 + f1 * g1);
                if (MODE != 2) *((f32x4*)xw + F.lane + 64 * j) = v[j];
            }
        }
        float ss = 0.f;
#pragma unroll
        for (int j = 0; j < 4; ++j) ss += (v[j][0] * v[j][0] + v[j][1] * v[j][1]) + (v[j][2] * v[j][2] + v[j][3] * v[j][3]);
        ss = wave_sum(ss);
        const float rstd = __builtin_amdgcn_rsqf(ss * (1.0f / 1024.0f) + NEPS);
        if (MODE == 2) {
#pragma unroll
            for (int j = 0; j < 4; ++j) *((f32x4*)(F.out + (size_t)m * 1024) + F.lane + 64 * j) = v[j] * rstd * wv[j];
        } else {
            if (bidx != mod_b) {
                const float* sh = MOD + ((size_t)l * 5 + bidx) * 6144 + (which ? 3 : 0) * 1024; const float* scl = sh + 1024;
#pragma unroll
                for (int j = 0; j < 4; ++j) { ms1[j] = *((const f32x4*)scl + F.lane + 64 * j) + 1.0f; ms0[j] = *((const f32x4*)sh + F.lane + 64 * j); }
                mod_b = bidx;
            }
            f32x4 o[4];
#pragma unroll
            for (int j = 0; j < 4; ++j) {
                o[j] = (v[j] * rstd * wv[j]) * ms1[j] + ms0[j];
                if (MODE == 1 || MODE == 3) {
                    unsigned w8 = 0u; w8 = __builtin_amdgcn_cvt_pk_fp8_f32(fminf(fmaxf(o[j][0], -448.f), 448.f), fminf(fmaxf(o[j][1], -448.f), 448.f), w8, false);
                    w8 = __builtin_amdgcn_cvt_pk_fp8_f32(fminf(fmaxf(o[j][2], -448.f), 448.f), fminf(fmaxf(o[j][3], -448.f), 448.f), w8, true);
                    *((unsigned*)((unsigned char*)XN + (size_t)m * 1024) + F.lane + 64 * j) = w8;
                } else { v2u w; w.x = pk2(o[j][0], o[j][1]); w.y = pk2(o[j][2], o[j][3]);
                    *((v2u*)(XN + (size_t)m * 1024) + F.lane + 64 * j) = w; } }
            if (MODE == 1) {
                float p[8];
#pragma unroll
                for (int e = 0; e < 8; ++e) { float s = 0.f;
#pragma unroll
                    for (int j = 0; j < 4; ++j) { const f32x4 w4 = *((const LAS f32x4*)(rwl + e * 1024) + F.lane + 64 * j);
                        s += (o[j][0] * w4[0] + o[j][1] * w4[1]) + (o[j][2] * w4[2] + o[j][3] * w4[3]); }
                    p[e] = wave_sum(s) + a.in[F.zz + I_RB][jm * 8 + e]; }
                int e0 = 0; float v0 = p[0];
#pragma unroll
                for (int e = 1; e < 8; ++e) if (p[e] > v0) { v0 = p[e]; e0 = e; }
                int e1 = -1; float v1 = -3.0e38f;
#pragma unroll
                for (int e = 0; e < 8; ++e) if (e != e0 && p[e] > v1) { v1 = p[e]; e1 = e; }
                const float ex = expf(v1 - v0), g0 = 1.0f / (1.0f + ex), g1 = ex / (1.0f + ex);
                if (F.lane == rt_k) { rt_e = e0 | (e1 << 4); rt_m = m; rt_g0 = g0; rt_g1 = g1; }
                ++rt_k;
                if (rt_k == 64) { moe_route_flush(F, jm, rt_k, rt_e, rt_m, rt_g0, rt_g1); rt_k = 0; }
            }
        }
    }
    if (MODE == 1) { if (rt_k > 0) moe_route_flush(F, jm, rt_k, rt_e, rt_m, rt_g0, rt_g1); __syncthreads(); }
}
__device__ __forceinline__ void moe_gather(const Frame& F, int jm) {
    const unsigned* cnt = (const unsigned*)F.ws + CW_CNT + jm * 8 * 64;
    MoeTp t; load_tp(t, cnt);
    int cn[8];
#pragma unroll
    for (int e = 0; e < 8; ++e) cn[e] = __builtin_amdgcn_readfirstlane((int)__hip_atomic_load(cnt + e * 64, __ATOMIC_RELAXED, __HIP_MEMORY_SCOPE_AGENT));
    const int rows = t.tp[8] * 256;
    const int* LIST = (const int*)(F.ws + WS_LIST); const v4u* XN = (const v4u*)(F.ws + WS_ACT); v4u* XB = (v4u*)(F.ws + WS_X2);
    for (int r0 = F.gw; r0 < rows; r0 += 8 * F.NGW) {
        int src[8];
#pragma unroll
        for (int q = 0; q < 8; ++q) { const int r = r0 + q * F.NGW; src[q] = -1;
            if (r < rows) { const int tile = r >> 8; int e = 0, tpe = 0, ce = cn[0];
#pragma unroll
                for (int k = 1; k < 8; ++k) { const bool ge = tile >= t.tp[k]; e += ge ? 1 : 0; tpe = ge ? t.tp[k] : tpe; ce = ge ? cn[k] : ce; }
                const int pos = r - tpe * 256;
                if (pos < ce) src[q] = LIST[e * MT + pos]; } }
        v4u x[8];
#pragma unroll
        for (int q = 0; q < 8; ++q) { x[q] = (v4u){0u, 0u, 0u, 0u}; if (src[q] >= 0) x[q] = XN[(size_t)src[q] * 64 + F.lane]; }
#pragma unroll
        for (int q = 0; q < 8; ++q) { const int r = r0 + q * F.NGW; if (r < rows) XB[(size_t)r * 64 + F.lane] = x[q]; }
    }
}
#define GLD(T, ubase, voff) (*(const T*)((const char*)(ubase) + (unsigned)(voff)))
#define GST(T, ubase, voff) (*(T*)((char*)(ubase) + (unsigned)(voff)))
__device__ __forceinline__ int fresh_lane() { int l; asm volatile("v_mbcnt_lo_u32_b32 %0, -1, 0\n\tv_mbcnt_hi_u32_b32 %0, -1, %0" : "=v"(l)); return l; }

struct MixP { const bf16* P; const float* lb; const float* rcos; const float* rsin; const float* ba; };
__device__ __forceinline__ int seg_row0(int b, int sg) { return sg < 4 ? NLAT + b * CTXL + sg * 64 : b * SEQ + (sg - 4) * 64; }
__device__ __forceinline__ int seg_tpos0(int sg) { return sg < 4 ? -1 : (sg - 4) * 64; }

struct S5P { const float *lam_re, *lam_im, *log_dt, *b_re, *b_im, *c_re, *c_im, *dd; const unsigned* par; };
__device__ __forceinline__ float gelu_tanh(float y) { const float t = 0.7978845608028654f * (y + 0.044715f * y * y * y); const float th = 1.0f - 2.0f * __builtin_amdgcn_rcpf(1.0f + __expf(2.0f * t)); return 0.5f * y * (1.0f + th); }
template <int MODE>
__device__ __forceinline__ void s5_scan(const S5P& sp, const bf16* P, int b, int g, int dir, int sg, int lane, float& hre, float& him, LAS float* yf, LAS float* stg, bf16* Z) {
    const int row0 = seg_row0(b, sg); const int dg = dir * 16 + g;
    const float lre = sp.lam_re[dg * 64 + lane], lim = sp.lam_im[dg * 64 + lane], dt = expf(sp.log_dt[dg]);
    const float er = expf(lre * dt); const float sn = sinf(lim * dt), cs = cosf(lim * dt);
    const float ar = er * cs, ai = er * sn;
    const float nr = ar - 1.0f, ni = ai, den = lre * lre + lim * lim;
    const float cr = (nr * lre + ni * lim) / den, ci = (ni * lre - nr * lim) / den;
    float bbr[16], bbi[16], Cr[16], Ci[16];
#pragma unroll
    for (int c = 0; c < 16; ++c) { const float Br = sp.b_re[((size_t)dg * 64 + lane) * 16 + c], Bi = sp.b_im[((size_t)dg * 64 + lane) * 16 + c];
        bbr[c] = cr * Br - ci * Bi; bbi[c] = cr * Bi + ci * Br;
        Cr[c] = (MODE != 0) ? sp.c_re[((size_t)dg * 16 + c) * 64 + lane] : 0.f; Ci[c] = (MODE != 0) ? sp.c_im[((size_t)dg * 16 + c) * 64 + lane] : 0.f; }
    const int ch = ((lane >> 5) & 1) * 8 + ((lane >> 4) & 1) * 4 + ((lane >> 3) & 1) * 2 + ((lane >> 2) & 1);
    const float dv = (MODE == 2) ? sp.dd[g * 16 + ch] : 0.f;
    const bool b5 = lane & 32, b4 = lane & 16, b3 = lane & 8, b2 = lane & 4;
    const unsigned ucol = 2u * (unsigned)(C_S5 + g * 16 + (lane & 15));
    unsigned short rn0[4], rn1[4], rn2[4];
#pragma unroll
    for (int u = 0; u < 4; ++u) { rn0[u] = GLD(unsigned short, P + (size_t)(row0 + (dir ? 63 - u : u)) * DINP, ucol); rn1[u] = GLD(unsigned short, P + (size_t)(row0 + (dir ? 59 - u : 4 + u)) * DINP, ucol);
        rn2[u] = GLD(unsigned short, P + (size_t)(row0 + (dir ? 55 - u : 8 + u)) * DINP, ucol); }
#pragma unroll 1
    for (int i0 = 0; i0 < 64; i0 += 4) {
        unsigned short ru[4], rn3[4];
        const int ip = (i0 + 12 < 64) ? i0 + 12 : 60;
#pragma unroll
        for (int u = 0; u < 4; ++u) { ru[u] = rn0[u]; rn3[u] = GLD(unsigned short, P + (size_t)(row0 + (dir ? 63 - (ip + u) : (ip + u))) * DINP, ucol); }
#pragma unroll
        for (int u = 0; u < 4; ++u) stg[u * 64 + lane] = bf2f(ru[u]);
#pragma unroll
        for (int u = 0; u < 4; ++u) {
            const int ti = dir ? 63 - (i0 + u) : (i0 + u);
            const float uf = bf2f(ru[u]);
            float bur = 0.f, bui = 0.f;
#pragma unroll
            for (int c4 = 0; c4 < 4; ++c4) { const f32x4 ux = *(const LAS f32x4*)(stg + u * 64 + 4 * c4);
#pragma unroll
                for (int jj = 0; jj < 4; ++jj) { bur = fmaf(bbr[4 * c4 + jj], ux[jj], bur); bui = fmaf(bbi[4 * c4 + jj], ux[jj], bui); } }
            const float nre = ar * hre - ai * him + bur, nim = ar * him + ai * hre + bui;
            hre = nre; him = nim;
            if (MODE != 0) {
                float v[16];
#pragma unroll
                for (int c = 0; c < 16; ++c) v[c] = Cr[c] * hre - Ci[c] * him;
                float w8[8], w4[4], w2[2], w1;
#pragma unroll
                for (int i = 0; i < 8; ++i) { const float mine = b5 ? v[8 + i] : v[i], oth = b5 ? v[i] : v[8 + i]; w8[i] = mine + __shfl_xor(oth, 32); }
#pragma unroll
                for (int i = 0; i < 4; ++i) { const float mine = b4 ? w8[4 + i] : w8[i], oth = b4 ? w8[i] : w8[4 + i]; w4[i] = mine + __shfl_xor(oth, 16); }
#pragma unroll
                for (int i = 0; i < 2; ++i) { const float mine = b3 ? w4[2 + i] : w4[i], oth = b3 ? w4[i] : w4[2 + i]; w2[i] = mine + __shfl_xor(oth, 8); }
                { const float mine = b2 ? w2[1] : w2[0], oth = b2 ? w2[0] : w2[1]; w1 = mine + __shfl_xor(oth, 4); }
                w1 += __shfl_xor(w1, 2); w1 += __shfl_xor(w1, 1);
                if (MODE == 1) { if ((lane & 3) == 0) yf[ti * 16 + ch] = w1; }
                if (MODE == 2) {
                    const float uch = __shfl(uf, ch);
                    if ((lane & 3) == 0) { const float y = w1 + yf[ti * 16 + ch] + dv * uch; Z[(size_t)(row0 + ti) * 256 + g * 16 + ch] = (bf16)f2bf(gelu_tanh(y)); }
                }
            }
        }
#pragma unroll
        for (int u = 0; u < 4; ++u) { rn0[u] = rn1[u]; rn1[u] = rn2[u]; rn2[u] = rn3[u]; }
    }
}

__device__ __forceinline__ MixP make_mixp(const Frame& F, const Args& a, int l) {
    MixP mp; mp.P = (const bf16*)(F.ws + WS_PH); mp.lb = (const float*)(F.ws + WS_LB) + l * 256; mp.rcos = (const float*)(F.ws + WS_ROPE); mp.rsin = mp.rcos + 2048;
    mp.ba = a.in[F.zz + I_BA] + (size_t)l * 2 * 128; return mp;
}
__device__ __forceinline__ S5P make_s5p(const Frame& F, const Args& a, int l) {
    S5P sp; sp.lam_re = a.in[F.zz + I_LAMRE] + (size_t)l * 2048; sp.lam_im = a.in[F.zz + I_LAMIM] + (size_t)l * 2048; sp.log_dt = a.in[F.zz + I_LOGDT] + l * 32;
    sp.b_re = a.in[F.zz + I_BRE] + (size_t)l * 32768; sp.b_im = a.in[F.zz + I_BIM] + (size_t)l * 32768; sp.c_re = a.in[F.zz + I_CRE] + (size_t)l * 32768; sp.c_im = a.in[F.zz + I_CIM] + (size_t)l * 32768;
    sp.dd = a.in[F.zz + I_S5D] + l * 256; sp.par = (const unsigned*)(F.ws + WS_S5PAR) + (size_t)l * 32 * 4096; return sp;
}


typedef short bf16x8_t __attribute__((ext_vector_type(8)));
typedef float f32x16 __attribute__((ext_vector_type(16)));
typedef float f32x2_t __attribute__((ext_vector_type(2)));
typedef __bf16 bf16x2_n __attribute__((ext_vector_type(2)));
__device__ __forceinline__ unsigned pkbf(float lo, float hi) { const f32x2_t v = {lo, hi}; const bf16x2_n r = __builtin_convertvector(v, bf16x2_n); return __builtin_bit_cast(unsigned, r); }
constexpr int WL_QC = 0, WL_KC = 4608, WL_KT = 9216, WL_VT = 14336, WL_PL = 19456, WL_BYTES = 19712;

struct MxC { float gamma, lbv, oml, bav, rc1, rs1; unsigned cq, ck, cv, cz; };
template <int MIX>
__device__ __forceinline__ void mx_consts(MxC& c, const MixP& mp, int h, int dir, int lane) {
    c.gamma = 1.f; c.lbv = 0.f; c.oml = 1.f; c.bav = 0.f; c.cz = 0; c.rc1 = 1.f; c.rs1 = 0.f;
    if (MIX == 0) { c.cq = 8u * (unsigned)(C_RQ + h * 64 + lane); c.ck = 8u * (unsigned)(C_RK + h * 64 + lane); c.cv = 8u * (unsigned)(C_RV + h * 64 + lane); c.gamma = 1.0f - exp2f(-5.0f - (float)(dir ? 3 - h : h));
        if (lane & 32) { const unsigned r1 = 4u * (unsigned)(16 + (lane & 15)); c.rc1 = GLD(float, mp.rcos, r1); const float s1 = GLD(float, mp.rsin, r1); c.rs1 = dir ? -s1 : s1; } }
    else if (MIX == 1) { c.cq = 8u * (unsigned)(C_HQ + h * 64 + lane); c.ck = 8u * (unsigned)((dir ? C_HFB : C_HFF) + h * 64 + lane); c.cv = 8u * (unsigned)(C_HI + h * 64 + lane); c.lbv = mp.lb[h * 64 + lane]; c.oml = 1.0f - c.lbv; }
    else { c.cq = 8u * (unsigned)(C_GQ + h * 32 + (lane & 31)); c.ck = 8u * (unsigned)(C_GK + h * 32 + (lane & 31)); c.cv = 8u * (unsigned)(C_GV + h * 64 + lane); c.cz = 8u * (unsigned)((dir ? C_GZB : C_GZF) + h * 32 + (lane & 31));
        c.bav = mp.ba[dir * 128 + h * 32 + (lane & 31)]; }
}
struct MxRaw { v2u q, k, v, z; };
template <int MIX, bool NEEDQ, int DIR>
__device__ __forceinline__ void mx_load(MxRaw& w, const MixP& mp, const MxC& c, int rows, int b) {
    const bf16* pr = mp.P + (size_t)((rows >> 2) + (DIR ? 15 - b : b)) * P4G;
    const v2u zero = {0u, 0u};
    w.q = NEEDQ ? GLD(v2u, pr, c.cq) : zero; w.k = GLD(v2u, pr, c.ck); w.v = GLD(v2u, pr, c.cv); w.z = (MIX == 2) ? GLD(v2u, pr, c.cz) : zero;
}
__device__ __forceinline__ float bfx(const v2u& w, int i) { const unsigned d = (i >> 1) ? w.y : w.x; return __builtin_bit_cast(float, (i & 1) ? (d & 0xffff0000u) : (d << 16)); }
template <int MIX, bool NEEDQ, int DIR>
__device__ __forceinline__ void mx_batch(const MxRaw& cur, const MixP& mp, const MxC& c, int tposs  , int lane, LAS unsigned char* wl, int b, float& P, float& rc, float& rs) {
    constexpr int DK = (MIX == 2) ? 32 : 64;
    float kt[4];
#pragma unroll
    for (int u = 0; u < 4; ++u) {
        const int cc = b * 4 + u, ts = DIR ? 63 - cc : cc, t = ts & 31;
        const int pu = DIR ? 3 - u : u; float q = bfx(cur.q, pu), k, f;
        if (MIX == 0) {
            k = bfx(cur.k, pu) * 0.125f; f = c.gamma;
            if (tposs >= 0) { const float cs = rc, sn = rs;
                rc = cs * c.rc1 - sn * c.rs1; rs = sn * c.rc1 + cs * c.rs1;
                const float ss = (lane & 16) ? sn : -sn;
                const float kp = __shfl_xor(k, 16); k = fmaf(kp, ss, k * cs);
                if (NEEDQ) { const float qp = __shfl_xor(q, 16); q = fmaf(qp, ss, q * cs); } }
        } else if (MIX == 1) {
            const float z = bfx(cur.k, pu); const float e = __expf(-z); const float sp = __builtin_amdgcn_rcpf(1.0f + e), sn = e * sp;
            f = fmaf(c.oml, sp, c.lbv); k = c.oml * sn;
        } else {
            k = bfx(cur.k, pu) * 0.17677669529663687f; const float z = bfx(cur.z, pu) + c.bav;
            const float ls = fminf(z, 0.f) - __logf(1.0f + __expf(-fabsf(z)));
            f = __expf(ls * 0.0625f);
        }
        P = fmaxf(P * f, 1e-30f);
        const float kk = k * __builtin_amdgcn_rcpf(P); kt[DIR ? 3 - u : u] = kk;
        if (lane < DK) {
            const unsigned qk = pkbf(q * P, kk);
            if (NEEDQ) *(LAS unsigned short*)(wl + WL_QC + t * 144 + lane * 2) = (unsigned short)qk;
            *(LAS unsigned short*)(wl + WL_KC + t * 144 + lane * 2) = (unsigned short)(qk >> 16);
        }
    }
    const int g4 = ((DIR ? 63 - b * 4 : b * 4) & 31) >> 2;
    v2u kp; kp.x = pkbf(kt[0], kt[1]); kp.y = pkbf(kt[2], kt[3]);
    if (lane < DK) *(LAS v2u*)(wl + WL_KT + lane * 80 + g4 * 8) = kp;
    *(LAS v2u*)(wl + WL_VT + lane * 80 + g4 * 8) = cur.v;
}
typedef short bf16x4_t __attribute__((ext_vector_type(4)));
#define MFMA8(a, b, c) __builtin_amdgcn_mfma_f32_32x32x8bf16_1k((a), (b), (c), 0, 0, 0)
__device__ __forceinline__ bf16x4_t pack4(const f32x16& x, int s) {
    v2u p; p.x = pkbf(x[4 * s], x[4 * s + 1]); p.y = pkbf(x[4 * s + 2], x[4 * s + 3]);
    return __builtin_bit_cast(bf16x4_t, p);
}
__device__ __forceinline__ bf16x4_t ld4(const LAS unsigned char* p) { const v2u a = *(const LAS v2u*)p; return __builtin_bit_cast(bf16x4_t, a); }

__device__ __forceinline__ float u2f_(unsigned u) { return __builtin_bit_cast(float, u); }
__device__ __forceinline__ unsigned f2u_(float f) { return __builtin_bit_cast(unsigned, f); }
__device__ __forceinline__ void s5_build(const Frame& F, const Args& a) {
    for (int it = F.gw; it < 128; it += F.NGW) {
        const int l = it >> 5, dg = it & 31, lane = F.lane, m32 = lane & 31, hh = lane >> 5;
        const S5P sp = make_s5p(F, a, l);
        unsigned* par = (unsigned*)(F.ws + WS_S5PAR) + (size_t)it * 4096;
    float ar[2], ai[2], a2r[2], a2i[2], a3r[2], a3i[2], a4r[2], a4i[2];
    bf16x4_t bfr[4][2];
    const float dt = __expf(sp.log_dt[dg]);
#pragma unroll
    for (int sh = 0; sh < 2; ++sh) {
        const int p = 32 * sh + m32;
        const float lre = sp.lam_re[dg * 64 + p], lim = sp.lam_im[dg * 64 + p];
        const float er = __expf(lre * dt), sn = sinf(lim * dt), cs = cosf(lim * dt);
        ar[sh] = er * cs; ai[sh] = er * sn;
        a2r[sh] = ar[sh] * ar[sh] - ai[sh] * ai[sh]; a2i[sh] = ar[sh] * ai[sh] + ar[sh] * ai[sh];
        a3r[sh] = a2r[sh] * ar[sh] - a2i[sh] * ai[sh]; a3i[sh] = a2r[sh] * ai[sh] + a2i[sh] * ar[sh];
        a4r[sh] = a2r[sh] * a2r[sh] - a2i[sh] * a2i[sh]; a4i[sh] = a2r[sh] * a2i[sh] + a2r[sh] * a2i[sh];
        const float nr = ar[sh] - 1.0f, ni = ai[sh], den = 1.0f / (lre * lre + lim * lim);
        const float cr = (nr * lre + ni * lim) * den, ci = (ni * lre - nr * lim) * den;
#pragma unroll
        for (int s2 = 0; s2 < 2; ++s2) {
            const f32x4 Br = *(const f32x4*)(sp.b_re + ((size_t)dg * 64 + p) * 16 + 8 * s2 + 4 * hh), Bi = *(const f32x4*)(sp.b_im + ((size_t)dg * 64 + p) * 16 + 8 * s2 + 4 * hh);
            const f32x4 re = Br * cr - Bi * ci, im = Bi * cr + Br * ci;
            v2u pr, pi; pr.x = pkbf(re[0], re[1]); pr.y = pkbf(re[2], re[3]); pi.x = pkbf(im[0], im[1]); pi.y = pkbf(im[2], im[3]);
            bfr[sh][s2] = __builtin_bit_cast(bf16x4_t, pr); bfr[2 + sh][s2] = __builtin_bit_cast(bf16x4_t, pi);
        }
    }
    bf16x4_t cfr[16];
    {
#pragma unroll
        for (int s = 0; s < 16; ++s) {
            const int mp_ = 2 * s + hh; f32x4 cv = {0.f, 0.f, 0.f, 0.f};
            if (m32 < 16) { const float* cre = sp.c_re + ((size_t)dg * 16 + m32) * 64 + mp_; const float* cim = sp.c_im + ((size_t)dg * 16 + m32) * 64 + mp_;
                cv[0] = cre[0]; cv[1] = cre[32]; cv[2] = -cim[0]; cv[3] = -cim[32]; }
            v2u pc; pc.x = pkbf(cv[0], cv[1]); pc.y = pkbf(cv[2], cv[3]); cfr[s] = __builtin_bit_cast(bf16x4_t, pc);
        }
    }
#define S5U(x) __builtin_bit_cast(unsigned, (x))
        v4u q;
        q.x = S5U(ar[0]); q.y = S5U(ar[1]); q.z = S5U(ai[0]); q.w = S5U(ai[1]); *(v4u*)(par + (0 * 64 + lane) * 4) = q;
        q.x = S5U(a2r[0]); q.y = S5U(a2r[1]); q.z = S5U(a2i[0]); q.w = S5U(a2i[1]); *(v4u*)(par + (1 * 64 + lane) * 4) = q;
        q.x = S5U(a3r[0]); q.y = S5U(a3r[1]); q.z = S5U(a3i[0]); q.w = S5U(a3i[1]); *(v4u*)(par + (2 * 64 + lane) * 4) = q;
        q.x = S5U(a4r[0]); q.y = S5U(a4r[1]); q.z = S5U(a4i[0]); q.w = S5U(a4i[1]); *(v4u*)(par + (3 * 64 + lane) * 4) = q;
#undef S5U
#pragma unroll
        for (int i = 0; i < 4; ++i) { const v2u lo = __builtin_bit_cast(v2u, bfr[i][0]), hi = __builtin_bit_cast(v2u, bfr[i][1]); q.x = lo.x; q.y = lo.y; q.z = hi.x; q.w = hi.y; *(v4u*)(par + ((4 + i) * 64 + lane) * 4) = q; }
#pragma unroll
        for (int k = 0; k < 8; ++k) { const v2u lo = __builtin_bit_cast(v2u, cfr[2 * k]), hi = __builtin_bit_cast(v2u, cfr[2 * k + 1]); q.x = lo.x; q.y = lo.y; q.z = hi.x; q.w = hi.y; *(v4u*)(par + ((8 + k) * 64 + lane) * 4) = q; }
    }
}
struct S5U { v2u u[2][2]; };
__device__ __forceinline__ void s5_load_u(S5U& U, const bf16* P, int b, int g, int sg, int lane) {
    const int m32 = lane & 31, hh = lane >> 5, row0 = seg_row0(b, sg);
#pragma unroll
    for (int ch = 0; ch < 2; ++ch) { const bf16* urow = P + (size_t)((row0 + 32 * ch + m32) >> 2) * P4G + P4S5 + (m32 & 3) * 256 + g * 16 + 4 * hh;
        U.u[ch][0] = *(const v2u*)urow; U.u[ch][1] = *(const v2u*)(urow + 8); }
}
template <int MODE, int DIR>
__device__ __forceinline__ void s5_mm_dir(const S5P& sp, const S5U& U, int b, int g, int sg, int lane, float& hre, float& him, LAS float* yf, LAS unsigned char* hs, bf16* Z) {
    const int m32 = lane & 31, hh = lane >> 5, dg = DIR * 16 + g, row0 = seg_row0(b, sg);
    float ar[2], ai[2], a2r[2], a2i[2], a3r[2], a3i[2], a4r[2], a4i[2];
    bf16x4_t bfr[4][2];
    bf16x4_t cfr[16];
    {
        const unsigned* par = sp.par + (size_t)dg * 4096;
        v4u pq[16];
#pragma unroll
        for (int q = 0; q < ((MODE != 0) ? 16 : 8); ++q) pq[q] = GLD(v4u, par + q * 256, 16u * (unsigned)lane);
#define S5F(x) u2f_(x)
        ar[0] = S5F(pq[0].x); ar[1] = S5F(pq[0].y); ai[0] = S5F(pq[0].z); ai[1] = S5F(pq[0].w);
        a2r[0] = S5F(pq[1].x); a2r[1] = S5F(pq[1].y); a2i[0] = S5F(pq[1].z); a2i[1] = S5F(pq[1].w);
        a3r[0] = S5F(pq[2].x); a3r[1] = S5F(pq[2].y); a3i[0] = S5F(pq[2].z); a3i[1] = S5F(pq[2].w);
        a4r[0] = S5F(pq[3].x); a4r[1] = S5F(pq[3].y); a4i[0] = S5F(pq[3].z); a4i[1] = S5F(pq[3].w);
#undef S5F
#pragma unroll
        for (int i = 0; i < 4; ++i) { v2u lo, hi; lo.x = pq[4 + i].x; lo.y = pq[4 + i].y; hi.x = pq[4 + i].z; hi.y = pq[4 + i].w; bfr[i][0] = __builtin_bit_cast(bf16x4_t, lo); bfr[i][1] = __builtin_bit_cast(bf16x4_t, hi); }
        if (MODE != 0) {
#pragma unroll
            for (int k = 0; k < 8; ++k) { v2u lo, hi; lo.x = pq[8 + k].x; lo.y = pq[8 + k].y; hi.x = pq[8 + k].z; hi.y = pq[8 + k].w; cfr[2 * k] = __builtin_bit_cast(bf16x4_t, lo); cfr[2 * k + 1] = __builtin_bit_cast(bf16x4_t, hi); }
        }
    }
    const float ddv = (MODE == 2 && m32 < 16) ? sp.dd[g * 16 + m32] : 0.f;
    float hr[2], hi[2];
    hr[0] = __shfl(hre, m32); hi[0] = __shfl(him, m32); hr[1] = __shfl(hre, m32 + 32); hi[1] = __shfl(him, m32 + 32);
#pragma unroll 1
    for (int ci2 = 0; ci2 < 2; ++ci2) {
        const int ch = DIR ? 1 - ci2 : ci2, rowc = row0 + 32 * ch;
        const v2u x0 = ch ? U.u[1][0] : U.u[0][0], x1 = ch ? U.u[1][1] : U.u[0][1];
        const bf16x4_t ua0 = __builtin_bit_cast(bf16x4_t, x0), ua1 = __builtin_bit_cast(bf16x4_t, x1);
        if (MODE == 2) { *(LAS v2u*)(hs + 13312 + m32 * 32 + 8 * hh) = x0; *(LAS v2u*)(hs + 13312 + m32 * 32 + 16 + 8 * hh) = x1; }
        f32x16 BU[4];
#pragma unroll
        for (int nt = 0; nt < 4; ++nt) {
#pragma unroll
            for (int r = 0; r < 16; ++r) BU[nt][r] = 0.f;
            BU[nt] = MFMA8(ua0, bfr[nt][0], BU[nt]); BU[nt] = MFMA8(ua1, bfr[nt][1], BU[nt]);
        }
#pragma unroll
        for (int sh = 0; sh < 2; ++sh)
#pragma unroll
            for (int gg = 0; gg < 4; ++gg)
#pragma unroll
                for (int jj = 1; jj < 4; ++jj) {
                    const int r = DIR ? 4 * gg + 3 - jj : 4 * gg + jj, rp = DIR ? r + 1 : r - 1;
                    const float pr = BU[sh][rp], pi = BU[2 + sh][rp];
                    BU[sh][r] += ar[sh] * pr - ai[sh] * pi; BU[2 + sh][r] += ar[sh] * pi + ai[sh] * pr;
                }
        float hnr[2][4], hni[2][4];
        {
            float elr[2][4], eli[2][4], ehr[2][4], ehi[2][4];
#pragma unroll
            for (int sh = 0; sh < 2; ++sh)
#pragma unroll
                for (int gg = 0; gg < 4; ++gg) { const int rl = DIR ? 4 * gg : 4 * gg + 3;
                    const unsigned vr = f2u_(BU[sh][rl]), vi = f2u_(BU[2 + sh][rl]);
                    const auto sr = __builtin_amdgcn_permlane32_swap(vr, vr, false, false), si = __builtin_amdgcn_permlane32_swap(vi, vi, false, false);
                    elr[sh][gg] = u2f_((unsigned)sr[0]); ehr[sh][gg] = u2f_((unsigned)sr[1]); eli[sh][gg] = u2f_((unsigned)si[0]); ehi[sh][gg] = u2f_((unsigned)si[1]); }
            float tr[2], ti[2];
#pragma unroll
            for (int st = 0; st < 8; ++st) {
                const int grp = DIR ? 7 - st : st, gg = grp >> 1, half = grp & 1;
#pragma unroll
                for (int sh = 0; sh < 2; ++sh) {
                    if (half == (DIR ? 1 : 0)) { tr[sh] = hr[sh]; ti[sh] = hi[sh]; }
                    else { hnr[sh][gg] = (hh == half) ? hr[sh] : tr[sh]; hni[sh][gg] = (hh == half) ? hi[sh] : ti[sh]; }
                    const float er = half ? ehr[sh][gg] : elr[sh][gg], ei = half ? ehi[sh][gg] : eli[sh][gg];
                    const float nr = er + a4r[sh] * hr[sh] - a4i[sh] * hi[sh], ni = ei + a4r[sh] * hi[sh] + a4i[sh] * hr[sh];
                    hr[sh] = nr; hi[sh] = ni;
                }
            }
        }
        if (MODE != 0) {
#pragma unroll
            for (int sh = 0; sh < 2; ++sh)
#pragma unroll
                for (int gg = 0; gg < 4; ++gg)
#pragma unroll
                    for (int jj = 0; jj < 4; ++jj) {
                        const int pw = DIR ? 4 - jj : jj + 1;
                        const float pr = (pw == 1) ? ar[sh] : (pw == 2) ? a2r[sh] : (pw == 3) ? a3r[sh] : a4r[sh], pi = (pw == 1) ? ai[sh] : (pw == 2) ? a2i[sh] : (pw == 3) ? a3i[sh] : a4i[sh];
                        BU[sh][4 * gg + jj] += pr * hnr[sh][gg] - pi * hni[sh][gg]; BU[2 + sh][4 * gg + jj] += pr * hni[sh][gg] + pi * hnr[sh][gg];
                    }
#pragma unroll
            for (int r = 0; r < 16; ++r) { v2u w; w.x = pkbf(BU[0][r], BU[1][r]); w.y = pkbf(BU[2][r], BU[3][r]);
                *(LAS v2u*)(hs + ((r & 3) + 8 * (r >> 2) + 4 * hh) * 272 + m32 * 8) = w; }
            f32x16 Yv, Yw;
#pragma unroll
            for (int r = 0; r < 16; ++r) { Yv[r] = 0.f; Yw[r] = 0.f; }
#pragma unroll
            for (int s = 0; s < 16; s += 2) { Yv = MFMA8(ld4(hs + m32 * 272 + (8 * s + 4 * hh) * 2), cfr[s], Yv); Yw = MFMA8(ld4(hs + m32 * 272 + (8 * s + 8 + 4 * hh) * 2), cfr[s + 1], Yw); }
#pragma unroll
            for (int r = 0; r < 16; ++r) Yv[r] += Yw[r];
            if (m32 < 16) {
#pragma unroll
                for (int r = 0; r < 16; ++r) {
                    const int tl = (r & 3) + 8 * (r >> 2) + 4 * hh;
                    if (MODE == 1) yf[(32 * ch + tl) * 16 + m32] = Yv[r];
                    else { const float u = bf2f(*(const LAS unsigned short*)(hs + 13312 + tl * 32 + m32 * 2));
                        const float y = Yv[r] + yf[(32 * ch + tl) * 16 + m32] + ddv * u;
                        const float zz = gelu_tanh(y); Z[(size_t)(rowc + tl) * 256 + g * 16 + m32] = (bf16)pkbf(zz, zz); }
                }
            }
        }
    }
    hre = hh ? hr[1] : hr[0]; him = hh ? hi[1] : hi[0];
}
template <int MODE>
__device__ __forceinline__ void s5_mm(const S5P& sp, const S5U& U, int b, int g, int dir, int sg, int lane, float& hre, float& him, LAS float* yf, LAS unsigned char* hs, bf16* Z) {
    if (dir) s5_mm_dir<MODE, 1>(sp, U, b, g, sg, lane, hre, him, yf, hs, Z); else s5_mm_dir<MODE, 0>(sp, U, b, g, sg, lane, hre, him, yf, hs, Z);
}
template <int MIX, int DIR, bool WITH_O>
__device__ __forceinline__ void mx_chunk(LAS unsigned char* wl, int lane, float Pl, f32x16 (&ST)[(MIX == 2) ? 1 : 2][2], f32x16 (&O)[2]) {
    constexpr int DK = (MIX == 2) ? 32 : 64, NRT = DK / 32;
    const int m32 = lane & 31, hh = lane >> 5;
    asm volatile("" ::: "memory");
    if (lane < DK) *(LAS float*)(wl + WL_PL + lane * 4) = Pl;
    asm volatile("" ::: "memory");
    if (WITH_O) {
        f32x16 x;
#pragma unroll
        for (int r = 0; r < 16; ++r) x[r] = 0.f;
#pragma unroll
        for (int s = 0; s < DK / 8; ++s) {
            const bf16x4_t ka = ld4(wl + WL_KC + m32 * 144 + (8 * s + 4 * hh) * 2);
            const bf16x4_t qb = ld4(wl + WL_QC + m32 * 144 + (8 * s + 4 * hh) * 2);
            x = MFMA8(ka, qb, x);
        }
#pragma unroll
        for (int r = 0; r < 16; ++r) { const int j = (r & 3) + 8 * (r >> 2) + 4 * hh; const bool keep = DIR ? (j >= m32) : (j <= m32); x[r] = keep ? x[r] : 0.f; }
#pragma unroll
        for (int t = 0; t < 2; ++t)
#pragma unroll
            for (int r = 0; r < 16; ++r) O[t][r] = 0.f;
#pragma unroll
        for (int s = 0; s < 4; ++s) {
            const bf16x4_t xa = pack4(x, s);
#pragma unroll
            for (int t = 0; t < 2; ++t) O[t] = MFMA8(ld4(wl + WL_VT + (32 * t + m32) * 80 + (8 * s + 4 * hh) * 2), xa, O[t]);
        }
#pragma unroll
        for (int rt = 0; rt < NRT; ++rt)
#pragma unroll
            for (int s = 0; s < 4; ++s) {
                const bf16x4_t qa = ld4(wl + WL_QC + m32 * 144 + (32 * rt + 8 * s + 4 * hh) * 2);
#pragma unroll
                for (int t = 0; t < 2; ++t) O[t] = MFMA8(pack4(ST[rt][t], s), qa, O[t]);
            }
    }
    {
        v4u kk4[NRT][2], vv4[2][2];
#pragma unroll
        for (int p2 = 0; p2 < 2; ++p2) {
#pragma unroll
            for (int rt = 0; rt < NRT; ++rt) kk4[rt][p2] = *(const LAS v4u*)(wl + WL_KT + (32 * rt + m32) * 80 + (16 * p2 + 8 * hh) * 2);
#pragma unroll
            for (int t = 0; t < 2; ++t) vv4[t][p2] = *(const LAS v4u*)(wl + WL_VT + (32 * t + m32) * 80 + (16 * p2 + 8 * hh) * 2);
        }
#pragma unroll
        for (int p2 = 0; p2 < 2; ++p2)
#pragma unroll
            for (int e = 0; e < 2; ++e)
#pragma unroll
                for (int rt = 0; rt < NRT; ++rt) { v2u ku; ku.x = e ? kk4[rt][p2].z : kk4[rt][p2].x; ku.y = e ? kk4[rt][p2].w : kk4[rt][p2].y; const bf16x4_t ka = __builtin_bit_cast(bf16x4_t, ku);
#pragma unroll
                    for (int t = 0; t < 2; ++t) { v2u vu; vu.x = e ? vv4[t][p2].z : vv4[t][p2].x; vu.y = e ? vv4[t][p2].w : vv4[t][p2].y; ST[rt][t] = MFMA8(ka, __builtin_bit_cast(bf16x4_t, vu), ST[rt][t]); } }
    }
#pragma unroll
    for (int rt = 0; rt < NRT; ++rt)
#pragma unroll
        for (int g = 0; g < 4; ++g) {
            const f32x4 pl4 = *(const LAS f32x4*)(wl + WL_PL + (32 * rt + 8 * g + 4 * hh) * 4);
#pragma unroll
            for (int e = 0; e < 4; ++e) { ST[rt][0][4 * g + e] *= pl4[e]; ST[rt][1][4 * g + e] *= pl4[e]; }
        }
}
__device__ __forceinline__ float half_sum(float v) {
#pragma unroll
    for (int o = 1; o < 32; o <<= 1) v += __shfl_xor(v, o);
    return v;
}
template <int MIX, int DIR>
__device__ __forceinline__ void mixA_stream(const MixP& mp, const MxC& c, int row0, int tpos0, int lane, LAS unsigned char* wl, f32x16 (&ST)[(MIX == 2) ? 1 : 2][2], float& Gam) {
    f32x16 O[2];
    MxRaw r[8];
#pragma unroll
    for (int i = 0; i < 8; ++i) mx_load<MIX, false, DIR>(r[i], mp, c, row0, i);
    float rc = 1.0f, rs = 0.0f;
    if (MIX == 0 && tpos0 >= 0) { const int tpos = tpos0 + (DIR ? 63 : 0); const int pos = (lane & 32) ? (tpos & 63) : (tpos >> 6);
        const unsigned ro = 4u * (unsigned)(pos * 16 + (lane & 15)); rc = GLD(float, mp.rcos, ro); rs = GLD(float, mp.rsin, ro); }
    float P = 1.0f;
#pragma unroll 1
    for (int cki = 0; cki < 2; ++cki) {
        int ck = cki; asm volatile("" : "+s"(ck));
        int ln = lane; asm volatile("" : "+v"(ln));
#pragma unroll
        for (int j = 0; j < 8; ++j) {
            mx_batch<MIX, false, DIR>(r[j], mp, c, tpos0, ln, wl, j, P, rc, rs);
            if (ck == 0) mx_load<MIX, false, DIR>(r[j], mp, c, row0, 8 + j);
        }
        Gam *= P; mx_chunk<MIX, 0, false>(wl, ln, P, ST, O); P = 1.0f;
    }
}
template <int MIX>
__device__ __forceinline__ void mixA_unit(const MixP& mp, float* STG, int idx, int lane_in, LAS unsigned char* wl) {
    int lane = lane_in;
    constexpr int DK = (MIX == 2) ? 32 : 64, NRT = DK / 32;
    const int dir = idx / 2112, rem = idx - dir * 2112, bh = rem / NSEG, sg = rem - bh * NSEG, b = bh >> 2, h = bh & 3;
    asm volatile("" : "+v"(lane));
    MxC c; mx_consts<MIX>(c, mp, h, dir, lane);
    f32x16 ST[NRT][2];
#pragma unroll
    for (int rt = 0; rt < NRT; ++rt)
#pragma unroll
        for (int t = 0; t < 2; ++t)
#pragma unroll
            for (int r = 0; r < 16; ++r) ST[rt][t][r] = 0.f;
    const int row0 = seg_row0(b, sg), tpos0 = seg_tpos0(sg);
    float Gam = 1.0f;
    if (dir) mixA_stream<MIX, 1>(mp, c, row0, tpos0, lane, wl, ST, Gam); else mixA_stream<MIX, 0>(mp, c, row0, tpos0, lane, wl, ST, Gam);
    const size_t slot = (size_t)((dir * 16 + bh) * NSEG + sg);
    bf16* ds = (bf16*)(STG + (MIX == 0 ? ST_DS0 : (MIX == 1 ? ST_DS1 : ST_DS2))) + slot * (DK * 64);
    const int m32 = lane & 31, hh = lane >> 5;
#pragma unroll
    for (int rt = 0; rt < NRT; ++rt)
#pragma unroll
        for (int t = 0; t < 2; ++t)
#pragma unroll
            for (int r4 = 0; r4 < 4; ++r4) { v2u v; v.x = pkbf(ST[rt][t][4 * r4], ST[rt][t][4 * r4 + 1]); v.y = pkbf(ST[rt][t][4 * r4 + 2], ST[rt][t][4 * r4 + 3]);
                GST(v2u, ds + ((rt * 2 + t) * 4 + r4) * 256, 8u * (unsigned)lane) = v; }
    float* gs = STG + (MIX == 0 ? ST_G0 : (MIX == 1 ? ST_G1 : ST_G2)) + slot * 64;
    GST(float, gs, 4u * (unsigned)lane) = Gam;
}
__device__ __forceinline__ void mx_epi_gates(const MixP& mp, int lane, int rowc, int gcol, v2u (&g)[2][4]) {
    const int m32 = lane & 31, hh = lane >> 5;
    const bf16* gb = mp.P + (size_t)(rowc >> 2) * P4G + gcol;
    const unsigned gvo = 2u * (unsigned)((m32 >> 2) * P4G + (m32 & 3) * 256 + 4 * hh);
#pragma unroll
    for (int t = 0; t < 2; ++t)
#pragma unroll
        for (int s = 0; s < 4; ++s) g[t][s] = GLD(v2u, gb + 32 * t + 8 * s, gvo);
}
__device__ __forceinline__ void mx_epi_of(int lane, const float* OFc, v2u (&of)[2][4]) {
#pragma unroll
    for (int t = 0; t < 2; ++t)
#pragma unroll
        for (int s = 0; s < 4; ++s) of[t][s] = GLD(v2u, (const bf16*)OFc + (t * 4 + s) * 256, 8u * (unsigned)lane);
}
template <int MIX, int MODE>
__device__ __forceinline__ void mx_epilogue(const MixP& mp, LAS unsigned char* wl, int lane, f32x16 (&O)[2], int rowc, float* OFc, bf16* Y, int ycol, const v2u (&g)[2][4], const v2u (&of)[2][4]) {
    const int m32 = lane & 31, hh = lane >> 5;
    if (MODE == 1) {
#pragma unroll
        for (int t = 0; t < 2; ++t)
#pragma unroll
            for (int s = 0; s < 4; ++s) { v2u v; v.x = pkbf(O[t][4 * s], O[t][4 * s + 1]); v.y = pkbf(O[t][4 * s + 2], O[t][4 * s + 3]); GST(v2u, (bf16*)OFc + (t * 4 + s) * 256, 8u * (unsigned)lane) = v; }
    } else {
#pragma unroll
        for (int t = 0; t < 2; ++t)
#pragma unroll
            for (int s = 0; s < 4; ++s)
#pragma unroll
                for (int j = 0; j < 4; ++j) O[t][4 * s + j] += bfx(of[t][s], j);
        float mean = 0.f;
        if (MIX == 0) { float sm = 0.f;
#pragma unroll
            for (int t = 0; t < 2; ++t)
#pragma unroll
                for (int r = 0; r < 16; ++r) sm += O[t][r];
            sm += __shfl_xor(sm, 32); mean = sm * (1.0f / 64.0f); }
        float ss = 0.f;
#pragma unroll
        for (int t = 0; t < 2; ++t)
#pragma unroll
            for (int r = 0; r < 16; ++r) { const float d = O[t][r] - mean; ss = fmaf(d, d, ss); }
        ss += __shfl_xor(ss, 32);
        const float rs = __builtin_amdgcn_rsqf(ss * (1.0f / 64.0f) + NEPS), mo = -mean * rs;
        asm volatile("" ::: "memory");
#pragma unroll
        for (int t = 0; t < 2; ++t)
#pragma unroll
            for (int s = 0; s < 4; ++s) { float y[4];
#pragma unroll
                for (int j = 0; j < 4; ++j) y[j] = fmaf(O[t][4 * s + j], rs, mo) * silu_f(bfx(g[t][s], j));
                v2u w; w.x = pkbf(y[0], y[1]); w.y = pkbf(y[2], y[3]);
                *(LAS v2u*)(wl + WL_QC + m32 * 144 + (32 * t + 8 * s + 4 * hh) * 2) = w; }
        asm volatile("" ::: "memory");
#pragma unroll
        for (int k = 0; k < 4; ++k) { const v4u w = *(const LAS v4u*)(wl + WL_QC + ((lane >> 3) + 8 * k) * 144 + (lane & 7) * 16);
            GST(v4u, Y + (size_t)(rowc + 8 * k) * 1024 + ycol, 2u * (unsigned)((lane >> 3) * 1024 + (lane & 7) * 8)) = w; }
        asm volatile("" ::: "memory");
    }
}
template <int MIX, int DIR>
__device__ __forceinline__ void mixC_stream(const MixP& mp, const MxC& c, int row0, int tpos0, int lane, LAS unsigned char* wl, f32x16 (&ST)[(MIX == 2) ? 1 : 2][2],
                                            const bf16* ds, float* OFu, bf16* Y, int ycol, int gcol) {
    f32x16 O[2];
    MxRaw r[4];
#pragma unroll
    for (int i = 0; i < 3; ++i) mx_load<MIX, true, DIR>(r[i], mp, c, row0, i);
    {
#pragma unroll
        for (int rt = 0; rt < ((MIX == 2) ? 1 : 2); ++rt)
#pragma unroll
            for (int t = 0; t < 2; ++t)
#pragma unroll
                for (int r4 = 0; r4 < 4; ++r4) { const v2u v = GLD(v2u, ds + ((rt * 2 + t) * 4 + r4) * 256, 8u * (unsigned)lane);
                    ST[rt][t][4 * r4] = bfx(v, 0); ST[rt][t][4 * r4 + 1] = bfx(v, 1); ST[rt][t][4 * r4 + 2] = bfx(v, 2); ST[rt][t][4 * r4 + 3] = bfx(v, 3); }
    }
    float rc = 1.0f, rs = 0.0f;
    if (MIX == 0 && tpos0 >= 0) { const int tpos = tpos0 + (DIR ? 63 : 0); const int pos = (lane & 32) ? (tpos & 63) : (tpos >> 6);
        const unsigned ro = 4u * (unsigned)(pos * 16 + (lane & 15)); rc = GLD(float, mp.rcos, ro); rs = GLD(float, mp.rsin, ro); }
    float P = 1.0f;
#pragma unroll 1
    for (int b4i = 0; b4i < 16; b4i += 4) {
        int b4 = b4i; asm volatile("" : "+s"(b4));
        int ln = lane; asm volatile("" : "+v"(ln));
#pragma unroll
        for (int j = 0; j < 4; ++j) {
            if (b4 < 12 || j == 0) mx_load<MIX, true, DIR>(r[(j + 3) & 3], mp, c, row0, b4 + j + 3);
            mx_batch<MIX, true, DIR>(r[j], mp, c, tpos0, ln, wl, (b4 & 4) + j, P, rc, rs);
        }
        if (b4 & 4) {
            const int ck = b4 >> 3, ch = DIR ? 1 - ck : ck; float* OFc = OFu + (size_t)ch * (12 * 2048);
            v2u g[2][4], of[2][4];
            mx_chunk<MIX, DIR, true>(wl, ln, P, ST, O); P = 1.0f;
            if (DIR) { mx_epi_gates(mp, ln, row0 + 32 * ch, gcol, g); mx_epi_of(ln, OFc, of); }
            mx_epilogue<MIX, DIR ? 2 : 1>(mp, wl, ln, O, row0 + 32 * ch, OFc, Y, ycol, g, of);
        }
    }
}
template <int MIX>
__device__ __forceinline__ void mixC_unit(const MixP& mp, const float* STG, int idx, int lane_in, float* OF, LAS unsigned char* wl, bf16* Y) {
    int lane = lane_in; asm volatile("" : "+v"(lane));
    constexpr int DK = (MIX == 2) ? 32 : 64, NRT = DK / 32;
    const int bh = idx / NSEG, sg = idx - bh * NSEG, b = bh >> 2, h = bh & 3;
    const int row0 = seg_row0(b, sg), tpos0 = seg_tpos0(sg);
    const int ycol = ((MIX == 0) ? 0 : (MIX == 1 ? 512 : 768)) + h * 64;
    const int gcol = 4 * ((MIX == 0) ? C_RG : (MIX == 1 ? C_HG : C_GG)) + h * 64;
    float* OFu = OF + ((size_t)(row0 >> 5) * 12 + MIX * 4 + h) * 2048;
    const bf16* dsb = (const bf16*)(STG + (MIX == 0 ? ST_DS0 : (MIX == 1 ? ST_DS1 : ST_DS2)));
    f32x16 ST[NRT][2];
#pragma unroll 1
    for (int dir = 0; dir < 2; ++dir) {
        asm volatile("" : "+v"(lane));
        const int m32 = lane & 31, hh = lane >> 5;
        MxC c; mx_consts<MIX>(c, mp, h, dir, lane);
        const bf16* ds = dsb + (size_t)((dir * 16 + bh) * NSEG + sg) * (DK * 64);
        if (dir == 0) mixC_stream<MIX, 0>(mp, c, row0, tpos0, lane, wl, ST, ds, OFu, Y, ycol, gcol);
        else mixC_stream<MIX, 1>(mp, c, row0, tpos0, lane, wl, ST, ds, OFu, Y, ycol, gcol);
        asm volatile("s_waitcnt vmcnt(0)" ::: "memory");
    }
}
template <int MSEL>
__device__ __forceinline__ void mix_passA(const Frame& F, const Args& a, int l) {
    const MixP mp = make_mixp(F, a, l); const S5P sp = make_s5p(F, a, l);
    float* ST = (float*)(F.ws + WS_X2);
    LAS unsigned char* wl = F.lds + F.wave * WL_BYTES; LAS float* stg = (LAS float*)wl;
    if (MSEL == 15) {
        constexpr int NMX = 3 * 4224, NS5 = 2 * 64 * NSEG;
        const int heavy = NMX - (NMX / F.NGW) * F.NGW, nlight = F.NGW - heavy;
        const int n_all = (NS5 - 4 * nlight) / F.NGW;
        for (int it = 0; ; ++it) {
            int u;
            const int nmine = NMX / F.NGW + (F.gw < heavy ? 1 : 0);
            if (it < nmine) u = F.gw + it * F.NGW;
            else if (it < nmine + n_all) u = NMX + F.gw + (it - nmine) * F.NGW;
            else { const int k2 = it - nmine - n_all; if (F.gw < heavy || k2 >= 4) {
                    const int rest0 = NMX + n_all * F.NGW + 4 * nlight; const int uu = rest0 + F.gw + (k2 - (F.gw < heavy ? 0 : 4)) * F.NGW; if (uu >= NMX + NS5) break; u = uu; }
                else u = NMX + n_all * F.NGW + (F.gw - heavy) + k2 * nlight; }
            if (u >= NMX + NS5) break;
            if (u < 4224) mixA_unit<0>(mp, ST, u, fresh_lane(), wl);
            else if (u < 2 * 4224) mixA_unit<1>(mp, ST, u - 4224, fresh_lane(), wl);
            else if (u < 3 * 4224) mixA_unit<2>(mp, ST, u - 2 * 4224, fresh_lane(), wl);
            else { const int idx = u - 3 * 4224; const int dir = idx / (64 * NSEG), rem = idx - dir * 64 * NSEG, bg = rem / NSEG, sg = rem - bg * NSEG;
                float hre = 0.f, him = 0.f;
                S5U U; s5_load_u(U, mp.P, bg >> 4, bg & 15, sg, fresh_lane()); s5_mm<0>(sp, U, bg >> 4, bg & 15, dir, sg, fresh_lane(), hre, him, nullptr, wl, nullptr);
                float* hs = ST + ST_HS + ((size_t)((dir * 64 + bg) * NSEG + sg) * 64 + fresh_lane()) * 2;
                hs[0] = hre; hs[1] = him; }
        }
        return;
    }
    if (MSEL & 1) for (int u = F.gw; u < 4224; u += F.NGW) mixA_unit<0>(mp, ST, u, fresh_lane(), wl);
    if (MSEL & 2) for (int u = F.gw; u < 4224; u += F.NGW) mixA_unit<1>(mp, ST, u, fresh_lane(), wl);
    if (MSEL & 4) for (int u = F.gw; u < 4224; u += F.NGW) mixA_unit<2>(mp, ST, u, fresh_lane(), wl);
    if (MSEL & 8) for (int idx = F.gw; idx < 2 * 64 * NSEG; idx += F.NGW) {
        const int dir = idx / (64 * NSEG), rem = idx - dir * 64 * NSEG, bg = rem / NSEG, sg = rem - bg * NSEG;
        float hre = 0.f, him = 0.f;
        S5U U; s5_load_u(U, mp.P, bg >> 4, bg & 15, sg, fresh_lane()); s5_mm<0>(sp, U, bg >> 4, bg & 15, dir, sg, fresh_lane(), hre, him, nullptr, wl, nullptr);
        float* hs = ST + ST_HS + ((size_t)((dir * 64 + bg) * NSEG + sg) * 64 + fresh_lane()) * 2;
        hs[0] = hre; hs[1] = him;
    }
}
__device__ __forceinline__ int chain_seg(int dir, int p) { return dir ? (p < 4 ? 3 - p : 135 - p) : p; }
__device__ __forceinline__ void mix_passB(const Frame& F, const Args& a, int l) {
    float* ST = (float*)(F.ws + WS_X2);
    constexpr int N0 = 32768, N1 = 32768, N2 = 16384, N3 = 8192;
    for (int e = blockIdx.x * 512 + F.tid; e < N0 + N1 + N2 + N3; e += F.G * 512) {
        if (e < N0 + N1 + N2) {
            bf16* base; const float* gb; int dir, esz;
            if (e < N0 + N1) { const int mix = e >= N0, e2 = e - mix * N0, c = e2 >> 10, el = (e2 & 1023) * 4; dir = c >> 4; esz = 4096;
                base = (bf16*)(ST + (mix ? ST_DS1 : ST_DS0)) + (size_t)c * NSEG * 4096 + el; gb = ST + (mix ? ST_G1 : ST_G0) + (size_t)c * NSEG * 64 + 32 * (el >> 11) + 8 * ((el >> 8) & 3) + 4 * ((el >> 7) & 1); }
            else { const int e2 = e - N0 - N1, c = e2 >> 9, el = (e2 & 511) * 4; dir = c >> 4; esz = 2048;
                base = (bf16*)(ST + ST_DS2) + (size_t)c * NSEG * 2048 + el; gb = ST + ST_G2 + (size_t)c * NSEG * 64 + 8 * ((el >> 8) & 3) + 4 * ((el >> 7) & 1); }
            f32x4 run = {0.f, 0.f, 0.f, 0.f};
#pragma unroll 1
            for (int p0 = 0; p0 < NSEG; p0 += 12) {
                f32x4 d[12], gm[12];
#pragma unroll
                for (int q = 0; q < 12; ++q) { const int sg = chain_seg(dir, p0 + q); const v2u w = *(const v2u*)(base + (size_t)sg * esz); d[q] = (f32x4){bfx(w, 0), bfx(w, 1), bfx(w, 2), bfx(w, 3)}; gm[q] = *(const f32x4*)(gb + sg * 64); }
#pragma unroll
                for (int q = 0; q < 12; ++q) { const int sg = chain_seg(dir, p0 + q); v2u w; w.x = pkbf(run[0], run[1]); w.y = pkbf(run[2], run[3]); *(v2u*)(base + (size_t)sg * esz) = w; run = run * gm[q] + d[q]; }
            }
        } else {
            const int e2 = e - N0 - N1 - N2, c = e2 >> 6, p = e2 & 63, dir = c >> 6, g = c & 15;
            const int dg = dir * 16 + g;
            const float lre = a.in[F.zz + I_LAMRE][(size_t)l * 2048 + dg * 64 + p], lim = a.in[F.zz + I_LAMIM][(size_t)l * 2048 + dg * 64 + p], dt = expf(a.in[F.zz + I_LOGDT][l * 32 + dg]);
            const float er = expf(lre * dt * 64.0f); const float sn = sinf(lim * dt * 64.0f), cs = cosf(lim * dt * 64.0f);
            const float ar = er * cs, ai = er * sn;
            float* base = ST + ST_HS + ((size_t)c * NSEG * 64 + p) * 2;
            float rr = 0.f, ri = 0.f;
#pragma unroll 1
            for (int q0 = 0; q0 < NSEG; q0 += 12) {
                float dr[12], di[12];
#pragma unroll
                for (int q = 0; q < 12; ++q) { const int sg = chain_seg(dir, q0 + q); dr[q] = base[(size_t)sg * 128]; di[q] = base[(size_t)sg * 128 + 1]; }
#pragma unroll
                for (int q = 0; q < 12; ++q) { const int sg = chain_seg(dir, q0 + q); base[(size_t)sg * 128] = rr; base[(size_t)sg * 128 + 1] = ri;
                    const float nr = ar * rr - ai * ri + dr[q], ni = ar * ri + ai * rr + di[q]; rr = nr; ri = ni; }
            }
        }
    }
}
template <int MSEL>
__device__ __forceinline__ void mix_passC(const Frame& F, const Args& a, int l) {
    const MixP mp = make_mixp(F, a, l); const S5P sp = make_s5p(F, a, l);
    const float* ST = (const float*)(F.ws + WS_X2);
    LAS unsigned char* wl = F.lds + F.wave * WL_BYTES;
    LAS float* stg = (LAS float*)wl; LAS float* of = (LAS float*)(wl + 9216);
    float* OF = (float*)(F.ws + WS_OF);
    bf16* Y = (bf16*)(F.ws + WS_ACT); bf16* Z = (bf16*)(F.ws + WS_Z);
    const bool keep = l < DEPTH - 1;
    constexpr int NM = 16 * NSEG;
    if (MSEL == 15) {
        constexpr int NMX = 3 * NM, NS5 = 64 * NSEG;
        const int heavy = NMX - (NMX / F.NGW) * F.NGW, nlight = F.NGW - heavy;
        for (int it = 0; ; ++it) {
            int u;
            const int nmine = NMX / F.NGW + (F.gw < heavy ? 1 : 0);
            if (it < nmine) u = F.gw + it * F.NGW;
            else { if (F.gw < heavy) break; u = NMX + (F.gw - heavy) + (it - nmine) * nlight; }
            if (u >= NMX + NS5) break;
            const int sgu = (u < 3 * NM) ? (u % NSEG) : ((u - 3 * NM) % NSEG);
            if (!keep && sgu < 4) continue;
            if (u < NM) mixC_unit<0>(mp, ST, u, fresh_lane(), OF, wl, Y);
            else if (u < 2 * NM) mixC_unit<1>(mp, ST, u - NM, fresh_lane(), OF, wl, Y);
            else if (u < 3 * NM) mixC_unit<2>(mp, ST, u - 2 * NM, fresh_lane(), OF, wl, Y);
            else { const int idx = u - 3 * NM, bg = idx / NSEG, sg = idx - bg * NSEG;
                S5U U; s5_load_u(U, mp.P, bg >> 4, bg & 15, sg, fresh_lane());
                const float* h0 = ST + ST_HS + ((size_t)((0 * 64 + bg) * NSEG + sg) * 64 + fresh_lane()) * 2;
                float hre = h0[0], him = h0[1];
                s5_mm<1>(sp, U, bg >> 4, bg & 15, 0, sg, fresh_lane(), hre, him, of, wl, Z);
                const float* h1 = ST + ST_HS + ((size_t)((1 * 64 + bg) * NSEG + sg) * 64 + fresh_lane()) * 2;
                hre = h1[0]; him = h1[1];
                s5_mm<2>(sp, U, bg >> 4, bg & 15, 1, sg, fresh_lane(), hre, him, of, wl, Z); }
        }
        return;
    }
    if (MSEL & 1) for (int u = F.gw; u < NM; u += F.NGW) { if (!keep && (u % NSEG) < 4) continue; mixC_unit<0>(mp, ST, u, fresh_lane(), OF, wl, Y); }
    if (MSEL & 2) for (int u = F.gw; u < NM; u += F.NGW) { if (!keep && (u % NSEG) < 4) continue; mixC_unit<1>(mp, ST, u, fresh_lane(), OF, wl, Y); }
    if (MSEL & 4) for (int u = F.gw; u < NM; u += F.NGW) { if (!keep && (u % NSEG) < 4) continue; mixC_unit<2>(mp, ST, u, fresh_lane(), OF, wl, Y); }
    if (MSEL & 8) for (int idx = F.gw; idx < 64 * NSEG; idx += F.NGW) {
        const int bg = idx / NSEG, sg = idx - bg * NSEG;
        if (!keep && sg < 4) continue;
        S5U U; s5_load_u(U, mp.P, bg >> 4, bg & 15, sg, fresh_lane());
        const float* h0 = ST + ST_HS + ((size_t)((0 * 64 + bg) * NSEG + sg) * 64 + fresh_lane()) * 2;
        float hre = h0[0], him = h0[1];
        s5_mm<1>(sp, U, bg >> 4, bg & 15, 0, sg, fresh_lane(), hre, him, of, wl, Z);
        const float* h1 = ST + ST_HS + ((size_t)((1 * 64 + bg) * NSEG + sg) * 64 + fresh_lane()) * 2;
        hre = h1[0]; him = h1[1];
        s5_mm<2>(sp, U, bg >> 4, bg & 15, 1, sg, fresh_lane(), hre, him, of, wl, Z);
    }
}

constexpr int NPH = 11;
template <int PH_MASK, int MSEL>
__global__ void __launch_bounds__(512, 2) mk_fwd(Args a) {
    extern __shared__ __attribute__((aligned(16))) unsigned char lds_raw[];
    Frame F;
    F.lds = (LAS unsigned char*)lds_raw;
    const int wave0 = __builtin_amdgcn_readfirstlane((int)threadIdx.x >> 6);
    F.lane = fresh_lane(); F.tid = wave0 * 64 + F.lane; F.wave = wave0;
    F.G = gridDim.x; F.gw = blockIdx.x * 8 + F.wave; F.NGW = F.G * 8; F.zz = 0; F.ws = (unsigned char*)a.in[I_WS]; F.out = (float*)a.in[I_OUT];
    volatile LAS unsigned* MISC = (volatile LAS unsigned*)(F.lds + MISC_OFF);
    for (int u = F.tid; u < 64; u += 512) ((LAS unsigned*)(F.lds + MISC_OFF))[u] = 0u;
    __syncthreads();
    XcdBarrier bar; bar.bar = (unsigned*)F.ws + CW_BAR; bar.x = 0; bar.st = nullptr;
    if (a.fused) bar = xcd_barrier_post((unsigned*)F.ws + CW_BAR, MISC + 8, F.tid);
#define SEAM() do { if (a.fused) { XcdBarrier bb = bar; asm volatile("" : "+s"(bb.bar), "+s"(bb.x)); xcd_barrier(bb, wave0 * 64 + fresh_lane()); } } while (0)
#define PHASE_BEGIN() do { int zz_ = 0; asm volatile("" : "+s"(zz_)); F.zz = zz_; F.ws = (unsigned char*)a.in[I_WS + zz_]; F.out = (float*)a.in[I_OUT + zz_]; \
        const int ln_ = fresh_lane(); const int t_ = wave0 * 64 + ln_ + zz_; F.tid = t_; F.lane = t_ & 63; F.wave = wave0 + zz_; F.G = (int)gridDim.x + zz_; F.gw = ((int)blockIdx.x + zz_) * 8 + F.wave; F.NGW = F.G * 8; \
        F.lds = (LAS unsigned char*)lds_raw + zz_; } while (0)
#define IN(k) (((PH_MASK >> (k)) & 1) && a.ph_lo <= (k) && (k) < a.ph_hi)
#ifndef DUP_PH
#define DUP_PH 0
#endif
constexpr int TAILB = 16;
#define REP(k) for (int rep_ = 0; rep_ < (((DUP_PH >> (k)) & 1) ? 2 : 1); ++rep_)
#define hb ((float*)(F.ws + WS_HB))
#define MOD ((const float*)(F.ws + WS_MOD))
#define ACT ((bf16*)(F.ws + WS_ACT))
#define PH ((bf16*)(F.ws + WS_PH))

    if (((PH_MASK >> 12) & 1) && a.do_pro) REP(12) { PHASE_BEGIN(); s5_build(F, a); prologue(F, a); SEAM(); }

#pragma unroll
    for (int l = 0; l < DEPTH; ++l) {
        if (l < a.l_lo || l >= a.l_hi) continue;
        const bool keep = l < DEPTH - 1, moe = l & 1; const int j = l >> 1;
        const int Mrows = keep ? MT : NLAT;
        if (IN(0)) { PHASE_BEGIN();
            if ((l & 1) && F.G > TAILB) {
                if ((int)blockIdx.x < TAILB) {
                    const int lp = l - 1, jp = lp >> 1;
                    int k8 = DFF / 2; asm volatile("" : "+s"(k8)); pg8::Gemm g{(const bf16*)((const unsigned char*)PH + (size_t)NLAT * DFF), (const bf16*)(F.ws + WS_W2D + (size_t)jp * 1024 * DFF), MT - NLAT, 1024, k8}; pg8::StaticOrder S; S.init(MT - NLAT, 1024, TAILB, (int)blockIdx.x);
                    EpiResid E{F.out, hb, F.out, hb, MOD + (size_t)lp * 5 * 6144 + 5 * 1024, 1.0f / WSC8, NLAT / 256};
                    pg8::gemm_phase_f8<EpiResid, pg8::StaticOrder, true, true>(F.lds, g, S, E, F.tid);
                    group_arrive((unsigned*)F.ws + CW_TAIL + (2 * l + 1) * 64, F.tid);
                } else {
                    moe_cvt_idle(F, a, j, TAILB);
                    norm_phase<0>(F, a, l, 0, NLAT, -1, 0, ((int)blockIdx.x - TAILB) * 8 + F.wave, (F.G - TAILB) * 8);
                }
                group_wait((unsigned*)F.ws + CW_BAR, (unsigned*)F.ws + CW_TAIL + (2 * l + 1) * 64, TAILB, F.tid);
                norm_phase<0>(F, a, l, 0, MT, -1, NLAT, F.gw, F.NGW);
            } else {
                if (l & 1) moe_cvt(F, a, j);
                norm_phase<0>(F, a, l, 0, MT, (l == 2) ? 1 : -1);
            }
            SEAM();
        }
        if (IN(1)) REP(1) { PHASE_BEGIN();
            pg8::Gemm g{ACT, (const bf16*)(F.ws + WS_WIN) + (size_t)l * DINP * 1024, MT, DINP, 1024}; pg8::StaticOrder S; S.init(MT, DINP, F.G, (int)blockIdx.x);
            EpiStoreP4 E{PH};
            pg8::gemm_phase<EpiStoreP4, pg8::StaticOrder, true, true>(F.lds, g, S, E, F.tid);
            SEAM();
        }
        if (IN(2)) { PHASE_BEGIN(); mix_passA<MSEL>(F, a, l); SEAM(); }
#ifdef DUP_MIX
        if (IN(2)) { PHASE_BEGIN(); mix_passA<DUP_MIX>(F, a, l); SEAM(); }
#endif
#ifdef DUP_A
        if (IN(2)) { PHASE_BEGIN(); mix_passA<DUP_A>(F, a, l); SEAM(); }
#endif
        if (IN(3)) { PHASE_BEGIN(); mix_passB(F, a, l); SEAM(); }
        if (IN(4)) { PHASE_BEGIN(); mix_passC<MSEL>(F, a, l); SEAM(); }
#ifdef DUP_MIX
        if (IN(4)) { PHASE_BEGIN(); mix_passC<DUP_MIX>(F, a, l); SEAM(); }
#endif
#ifdef DUP_C
        if (IN(4)) { PHASE_BEGIN(); mix_passC<DUP_C>(F, a, l); SEAM(); }
#endif
        if (IN(5)) REP(5) { PHASE_BEGIN();
            int k256 = 256; asm volatile("" : "+s"(k256)); pg8::Gemm g{(const bf16*)(F.ws + WS_Z), (const bf16*)(F.ws + WS_GLUW) + (size_t)l * 65536, Mrows, 256, k256}; pg8::StaticOrder S; S.init(Mrows, 256, F.G, (int)blockIdx.x);
            EpiGlu E{(const bf16*)(F.ws + WS_Z), ACT, a.in[F.zz + I_GLUB] + l * 256};
            pg8::gemm_phase<EpiGlu, pg8::StaticOrder, true, true>(F.lds, g, S, E, F.tid);
            SEAM();
        }
        const bool f1f8 = !moe && j == FP8_F1_J;
        const bool tail = keep && F.G > TAILB;
        if (IN(6)) { PHASE_BEGIN();
            const int Mg = tail ? NLAT : Mrows;
            pg8::Gemm g{ACT, (const bf16*)(F.ws + WS_WOUT) + (size_t)l * 1024 * 1024, Mg, 1024, 1024}; pg8::StaticOrder S; S.init(Mg, 1024, F.G, (int)blockIdx.x);
            EpiResid E{(l == 0) ? a.in[F.zz + I_X] : F.out, (l == 0) ? a.in[F.zz + I_CTX] : hb, F.out, hb, MOD + (size_t)l * 5 * 6144 + 2 * 1024, 1.0f};
            pg8::gemm_phase<EpiResid, pg8::StaticOrder, true, true>(F.lds, g, S, E, F.tid);
            SEAM();
        }
        if (IN(7)) { PHASE_BEGIN();
            if (tail) {
                if ((int)blockIdx.x < TAILB) {
                    pg8::Gemm g{ACT + (size_t)NLAT * 1024, (const bf16*)(F.ws + WS_WOUT) + (size_t)l * 1024 * 1024, MT - NLAT, 1024, 1024}; pg8::StaticOrder S; S.init(MT - NLAT, 1024, TAILB, (int)blockIdx.x);
                    EpiResid E{(l == 0) ? a.in[F.zz + I_X] : F.out, (l == 0) ? a.in[F.zz + I_CTX] : hb, F.out, hb, MOD + (size_t)l * 5 * 6144 + 2 * 1024, 1.0f, NLAT / 256};
                    pg8::gemm_phase<EpiResid, pg8::StaticOrder, true, true>(F.lds, g, S, E, F.tid);
                    group_arrive((unsigned*)F.ws + CW_TAIL + (2 * l) * 64, F.tid);
                } else {
                    if (moe) norm_phase<1>(F, a, l, 1, NLAT, -1, 0, ((int)blockIdx.x - TAILB) * 8 + F.wave, (F.G - TAILB) * 8); else if (f1f8) norm_phase<3>(F, a, l, 1, NLAT, -1, 0, ((int)blockIdx.x - TAILB) * 8 + F.wave, (F.G - TAILB) * 8); else norm_phase<0>(F, a, l, 1, NLAT, -1, 0, ((int)blockIdx.x - TAILB) * 8 + F.wave, (F.G - TAILB) * 8);
                }
                group_wait((unsigned*)F.ws + CW_BAR, (unsigned*)F.ws + CW_TAIL + (2 * l) * 64, TAILB, F.tid);
                if (moe) norm_phase<1>(F, a, l, 1, MT, -1, NLAT, F.gw, F.NGW); else if (f1f8) norm_phase<3>(F, a, l, 1, MT, -1, NLAT, F.gw, F.NGW); else norm_phase<0>(F, a, l, 1, MT, -1, NLAT, F.gw, F.NGW);
            } else { if (moe) norm_phase<1>(F, a, l, 1, Mrows, -1); else if (f1f8) norm_phase<3>(F, a, l, 1, Mrows, -1); else norm_phase<0>(F, a, l, 1, Mrows, -1); }
            SEAM();
        }
        if (!moe) {
            if (IN(8)) REP(8) { PHASE_BEGIN();
                if (f1f8) {
                    int k8 = 512; asm volatile("" : "+s"(k8)); pg8::Gemm g{ACT, (const bf16*)(F.ws + WS_W13D) + (size_t)j * 5632 * 1024, Mrows, 5632, k8}; pg8::StaticOrder S; S.init(Mrows, 5632, F.G, (int)blockIdx.x);
                    EpiSwiglu8 E{(unsigned char*)PH, 1.0f / WSC8};
                    pg8::gemm_phase_f8<EpiSwiglu8, pg8::StaticOrder, true, true>(F.lds, g, S, E, F.tid);
                } else {
                pg8::Gemm g{ACT, (const bf16*)(F.ws + WS_W13D) + (size_t)j * 5632 * 1024, Mrows, 5632, 1024}; pg8::StaticOrder S; S.init(Mrows, 5632, F.G, (int)blockIdx.x);
                EpiSwiglu8 E{(unsigned char*)PH, 1.0f};
                pg8::gemm_phase<EpiSwiglu8, pg8::StaticOrder, true, true>(F.lds, g, S, E, F.tid);
                }
                SEAM();
            }
            if (IN(9)) { PHASE_BEGIN();
                const int Mg = tail ? NLAT : Mrows;
                int k8 = DFF / 2; asm volatile("" : "+s"(k8)); pg8::Gemm g{PH, (const bf16*)(F.ws + WS_W2D + (size_t)j * 1024 * DFF), Mg, 1024, k8}; pg8::StaticOrder S; S.init(Mg, 1024, F.G, (int)blockIdx.x);
                EpiResid E{F.out, hb, F.out, hb, MOD + (size_t)l * 5 * 6144 + 5 * 1024, 1.0f / WSC8};
                pg8::gemm_phase_f8<EpiResid, pg8::StaticOrder, true, true>(F.lds, g, S, E, F.tid);
                if (!tail) { const int rem = ((Mrows / 256) * 4) % F.G; if (rem > 0 && (int)blockIdx.x >= rem) moe_cvt_idle(F, a, j, rem); else if (rem == 0) moe_cvt(F, a, j); }
                SEAM();
            }
        } else {
                        if (IN(8)) REP(8) { PHASE_BEGIN(); moe_gather(F, j); SEAM(); }
            if (IN(9)) REP(9) { PHASE_BEGIN();
                int k8 = 512; asm volatile("" : "+s"(k8)); pg8::Gemm g{(const bf16*)(F.ws + WS_X2), (const bf16*)(F.ws + WS_W13M), 0, 5632, k8}; MoeOrder S; S.init((const unsigned*)F.ws + CW_CNT + j * 8 * 64, 22, F.G, (int)blockIdx.x);
                EpiSwiglu8 E{(unsigned char*)PH, 1.0f / WSC8};
                pg8::gemm_phase_f8<EpiSwiglu8, MoeOrder, true, true>(F.lds, g, S, E, F.tid);
                SEAM();
            }
            if (IN(10)) REP(10) { PHASE_BEGIN();
                int k8 = DFF / 2; asm volatile("" : "+s"(k8)); pg8::Gemm g{PH, (const bf16*)(F.ws + WS_W2M), 0, 1024, k8}; MoeOrder S; S.init((const unsigned*)F.ws + CW_CNT + j * 8 * 64, 4, F.G, (int)blockIdx.x);
                EpiStoreBf16 E{(bf16*)(F.ws + WS_X2), 1024, 1.0f / WSC8};
                pg8::gemm_phase_f8<EpiStoreBf16, MoeOrder, true, true>(F.lds, g, S, E, F.tid);
                SEAM();
            }
        }
    }
    if (((PH_MASK >> 13) & 1) && a.do_fin) { PHASE_BEGIN(); norm_phase<2>(F, a, DEPTH - 1, 0, NLAT, DEPTH - 1); }
#undef SEAM
#undef IN
#undef hb
#undef MOD
#undef ACT
#undef PH
}

#ifndef MK_FUSED
#define MK_FUSED 1
#endif
template <int PM, int MS> static void launch_one(const Args& a, int grid, hipStream_t stream) {
    static bool attr_done = false;
    if (!attr_done) { (void)hipFuncSetAttribute((const void*)mk_fwd<PM, MS>, hipFuncAttributeMaxDynamicSharedMemorySize, LDS_BYTES); attr_done = true; }
    hipLaunchKernelGGL((mk_fwd<PM, MS>), dim3(grid), dim3(512), LDS_BYTES, stream, a);
}
extern "C" void kernel_launch(void* const* d_in, const int* in_sizes, int n_in, void* d_out, int out_size, void* d_ws, size_t ws_size, hipStream_t stream) {
    static int grid = 0;
    if (grid == 0) {
        if (n_in != 35 || in_sizes[0] != NLAT * DM || out_size != NLAT * DM || ws_size < WS_END) {
            fprintf(stderr, "kernel_launch: unexpected shapes / workspace (n_in %d, ws %zu, need %zu); nothing launched\n", n_in, ws_size, (size_t)WS_END); grid = -1; return; }
        int dev = 0, cus = 0;
        if (hipGetDevice(&dev) != hipSuccess || hipDeviceGetAttribute(&cus, hipDeviceAttributeMultiprocessorCount, dev) != hipSuccess) { grid = -1; return; }
        grid = cus;
    }
    if (grid < 0) return;
    (void)hipMemsetAsync((char*)d_ws + WS_CTL, 0, CTL_ZERO_BYTES, stream);
    Args a{};
    for (int i = 0; i < 35; ++i) a.in[i] = (const float*)d_in[i];
    a.in[I_OUT] = (const float*)d_out; a.in[I_WS] = (const float*)d_ws; a.pad = 0;
#if MK_FUSED
    a.l_lo = 0; a.l_hi = DEPTH; a.ph_lo = 0; a.ph_hi = NPH; a.do_pro = 1; a.do_fin = 1; a.fused = 1;
#ifndef TEST_PM
#define TEST_PM 0xFFFF
#endif
#ifndef TEST_MS
#define TEST_MS 15
#endif
    launch_one<TEST_PM, TEST_MS>(a, grid, stream);
#else
    a.fused = 0;
    a.l_lo = 0; a.l_hi = 0; a.ph_lo = 0; a.ph_hi = 0; a.do_pro = 1; a.do_fin = 0;
    launch_one<0x1000, 15>(a, grid, stream);
    a.do_pro = 0;
    for (int l = 0; l < DEPTH; ++l) {
        a.l_lo = l; a.l_hi = l + 1; a.ph_lo = 0; a.ph_hi = NPH;
        launch_one<0x1, 15>(a, grid, stream); launch_one<0x2, 15>(a, grid, stream); launch_one<0x4, 15>(a, grid, stream); launch_one<0x8, 15>(a, grid, stream);
        launch_one<0x10, 1>(a, grid, stream); launch_one<0x10, 2>(a, grid, stream); launch_one<0x10, 4>(a, grid, stream); launch_one<0x10, 8>(a, grid, stream);
        launch_one<0x20, 15>(a, grid, stream); launch_one<0x40, 15>(a, grid, stream); launch_one<0x80, 15>(a, grid, stream);
        launch_one<0x100, 15>(a, grid, stream); launch_one<0x200, 15>(a, grid, stream);
        if (l & 1) launch_one<0x400, 15>(a, grid, stream);
    }
    a.l_lo = 0; a.l_hi = 0; a.ph_lo = 0; a.ph_hi = 0; a.do_fin = 1;
    launch_one<0x2000, 15>(a, grid, stream);
#endif
}
```

```cpp
#include <hip/hip_runtime.h>
#include <cstdio>
#include <cstdint>
#define LAS __attribute__((address_space(3)))
namespace pg8 {
#define PG8_LAS __attribute__((address_space(3)))
typedef unsigned short bf16_t;
typedef short bf16x8 __attribute__((ext_vector_type(8)));
typedef float f32x4 __attribute__((ext_vector_type(4)));
typedef unsigned u32x4 __attribute__((ext_vector_type(4)));
constexpr int BM = 256, BK = 64, HALF = 128, HTB = HALF * BK * 2  , STAGE_BYTES = 8 * HTB, NXCD = 8, WGM = 8;

__host__ __device__ __forceinline__ int lds_byte(int r, int c) { const int st = (r >> 4) * 2 + (c >> 5), rr = r & 15, cc = c & 31, ob = rr * 64 + cc * 2; return st * 1024 + (ob ^ (((ob >> 9) & 1) << 5)); }
__host__ __device__ __forceinline__ void stage_rc(int b, int& R, int& C) { const int st = b / 1024, sb = b % 1024, swz = sb ^ (((sb >> 9) & 1) << 5); R = (st >> 1) * 16 + swz / 64; C = (st & 1) * 32 + (swz % 64) / 2; }
__host__ __device__ __forceinline__ int perm32(int rho) { const int n = rho >> 4, i = rho & 15; return 8 * (i >> 2) + 4 * n + (i & 3); }

__host__ __device__ __forceinline__ int perm32f(int rho) { return 2 * (rho & 15) + (rho >> 4); }
template <class E, class = void> struct epi_flip { static constexpr bool v = false; };
template <class E> struct epi_flip<E, decltype((void)E::FLIP)> { static constexpr bool v = E::FLIP; };
struct Unit { int pm, pn, pc; };
struct Gemm { const bf16_t* A; const bf16_t* Bt; int M, N, K; };

struct StaticOrder {
    int nM, nN, nwg, G, c;
    __host__ __device__ void init(int M, int N, int G_, int c_) { nM = M / BM; nN = N / BM; nwg = nM * nN; G = G_; c = c_; }
    __host__ __device__ bool next(int i, Unit& u) const {
        const long L = (long)i * G + c; if (L >= nwg) return false;
        int wgid = (int)L; { const int q = nwg / NXCD, r = nwg % NXCD, xcd = wgid % NXCD, off = wgid / NXCD; wgid = (xcd < r ? xcd * (q + 1) : r * (q + 1) + (xcd - r) * q) + off; }
        const int nig = WGM * nN, gid = wgid / nig, fm = gid * WGM, gsz = (nM - fm) < WGM ? (nM - fm) : WGM;
        u.pm = fm + ((wgid % nig) % gsz); u.pn = (wgid % nig) / gsz; u.pc = u.pn; return true;
    }
    __device__ __forceinline__ void a_ready(const Unit&) const {}
    __device__ __forceinline__ void done(const Unit&) const {}
};

__device__ __forceinline__ unsigned cvt_pk_bf16(float lo, float hi) { unsigned r; asm volatile("v_cvt_pk_bf16_f32 %0, %1, %2" : "=v"(r) : "v"(lo), "v"(hi)); return r; }
typedef float f32x2 __attribute__((ext_vector_type(2)));

template <class Epi, class Sched, bool ALIGN_EPI = false, bool SP2 = false>
__device__ __forceinline__ void gemm_phase(PG8_LAS unsigned char* lds, const Gemm g, const Sched& S, const Epi& E, const int tid) {
    const int wid = __builtin_amdgcn_readfirstlane(tid >> 6), lane = tid & 63, wr = wid >> 2, wc = wid & 3, fr = lane & 15, fq = lane >> 4;
    const int K = g.K, nt = K / BK;
    unsigned voffA[2], voffB[2];
#pragma unroll
    for (int i = 0; i < 2; ++i) { int R, C; stage_rc(tid * 16 + i * 8192, R, C); const int Rb = epi_flip<Epi>::v ? ((R & ~31) + perm32f(R & 31)) : (Epi::PERM ? ((R & ~31) + perm32(R & 31)) : R);
        voffA[i] = (unsigned)(R * K + C) * 2u; voffB[i] = (unsigned)(Rb * K + C) * 2u; }
    const size_t kstep = (size_t)(BK * 2);
    const size_t hstep = (size_t)HALF * K * 2;
    const size_t tstep = 2 * hstep;
    const unsigned ldsw = (unsigned)wid * 1024u;
    const int aoff = lds_byte(wr * 64 + fr, fq * 8), boff = lds_byte(wc * 32 + fr, fq * 8);
#define PG8_SA(b, h) (((b) * 2 + (h)) * HTB)
#define PG8_SB(b, h) ((4 + (b) * 2 + (h)) * HTB)
#define PG8_STAGE(bufoff, gbase, voff) do { _Pragma("unroll") for (int _i = 0; _i < 2; ++_i) \
        __builtin_amdgcn_global_load_lds((const unsigned*)((const char*)(gbase) + (voff)[_i]), (PG8_LAS unsigned*)(lds + (bufoff) + ldsw + _i * 8192), 16, 0, 0); } while (0)
#define PG8_LDA(dst, b, h) do { _Pragma("unroll") for (int m = 0; m < 4; ++m) _Pragma("unroll") for (int k = 0; k < 2; ++k) dst[m][k] = *(const PG8_LAS bf16x8*)(lds + PG8_SA(b, h) + aoff + m * 2048 + k * 1024); } while (0)
#define PG8_LDB(dst, b, h) do { _Pragma("unroll") for (int n = 0; n < 2; ++n) _Pragma("unroll") for (int k = 0; k < 2; ++k) dst[n][k] = *(const PG8_LAS bf16x8*)(lds + PG8_SB(b, h) + boff + n * 2048 + k * 1024); } while (0)
#define PG8_MMA(ai, bj, At, Bt) do { __builtin_amdgcn_s_setprio(1); _Pragma("unroll") for (int m = 0; m < 4; ++m) _Pragma("unroll") for (int n = 0; n < 2; ++n) _Pragma("unroll") for (int k = 0; k < 2; ++k) \
        { if constexpr (epi_flip<Epi>::v) acc[ai][bj][m][n] = __builtin_amdgcn_mfma_f32_16x16x32_bf16(At[m][k], Bt[n][k], acc[ai][bj][m][n], 0, 0, 0); \
          else acc[ai][bj][m][n] = __builtin_amdgcn_mfma_f32_16x16x32_bf16(Bt[n][k], At[m][k], acc[ai][bj][m][n], 0, 0, 0); } __builtin_amdgcn_s_setprio(0); } while (0)
#define PG8_WAIT_V(n) asm volatile("s_waitcnt vmcnt(" #n ")" ::: "memory")
#define PG8_WAIT_L(n) asm volatile("s_waitcnt lgkmcnt(" #n ")" ::: "memory")
#define PG8_BAR __builtin_amdgcn_s_barrier()
#define PG8_SCHED __builtin_amdgcn_sched_barrier(0)
    Unit cur, nxt; int ui = 0;
    if (!S.next(0, cur)) return;
    f32x4 acc[2][2][4][2];
#pragma unroll
    for (int a = 0; a < 2; ++a)
#pragma unroll
        for (int b = 0; b < 2; ++b)
#pragma unroll
            for (int m = 0; m < 4; ++m)
#pragma unroll
                for (int n = 0; n < 2; ++n) acc[a][b][m][n] = (f32x4){0.f, 0.f, 0.f, 0.f};
    bf16x8 At[4][2], B0[2][2], B1[2][2];
    const char* cA = (const char*)g.A + (size_t)cur.pm * tstep; const char* cB = (const char*)g.Bt + (size_t)cur.pn * tstep;
    S.a_ready(cur);
    if constexpr (SP2) {
        PG8_STAGE(PG8_SB(0, 0), cB, voffB); PG8_STAGE(PG8_SB(0, 1), cB + hstep, voffB); PG8_STAGE(PG8_SA(0, 0), cA, voffA); PG8_STAGE(PG8_SA(0, 1), cA + hstep, voffA);
        if (wr == 1) PG8_BAR;
        PG8_WAIT_V(2); PG8_BAR;
        PG8_STAGE(PG8_SB(1, 0), cB + kstep, voffB); PG8_STAGE(PG8_SA(1, 0), cA + kstep, voffA); PG8_STAGE(PG8_SB(1, 1), cB + hstep + kstep, voffB);
        PG8_WAIT_V(6); PG8_BAR;
    } else {
        PG8_STAGE(PG8_SB(0, 0), cB, voffB); PG8_STAGE(PG8_SA(0, 0), cA, voffA); PG8_STAGE(PG8_SB(0, 1), cB + hstep, voffB); PG8_STAGE(PG8_SA(0, 1), cA + hstep, voffA);
        if (wr == 1) PG8_BAR;
        PG8_WAIT_V(4); PG8_BAR;
        PG8_STAGE(PG8_SB(1, 0), cB + kstep, voffB); PG8_STAGE(PG8_SA(1, 0), cA + kstep, voffA); PG8_STAGE(PG8_SB(1, 1), cB + hstep + kstep, voffB);
        PG8_WAIT_V(6); PG8_BAR;
    }
    for (;;) {
        const bool has_next = S.next(ui + 1, nxt);
        const char* nA = has_next ? (const char*)g.A + (size_t)nxt.pm * tstep : cA; const char* nB = has_next ? (const char*)g.Bt + (size_t)nxt.pn * tstep : cB;
        for (int t = 0; t < nt; t += 2) {
            const bool last = (t == nt - 2);
            const char* a1 = cA + (size_t)(t + 1) * kstep;
            const char* a2 = last ? nA : cA + (size_t)(t + 2) * kstep; const char* b2 = last ? nB : cB + (size_t)(t + 2) * kstep;
            const char* a3 = a2 + kstep; const char* b3 = b2 + kstep;
            if (last && has_next) S.a_ready(nxt);
            if constexpr (SP2) {
            PG8_LDB(B0, 0, 0); PG8_LDB(B1, 0, 1); PG8_SCHED; PG8_LDA(At, 0, 0); PG8_STAGE(PG8_SA(1, 1), a1 + hstep, voffA);
            PG8_WAIT_V(8); PG8_WAIT_L(0); PG8_BAR; PG8_MMA(0, 0, At, B0); PG8_MMA(0, 1, At, B1); PG8_BAR; PG8_SCHED;
            PG8_LDA(At, 0, 1); PG8_STAGE(PG8_SB(0, 0), b2, voffB); PG8_STAGE(PG8_SB(0, 1), b2 + hstep, voffB); PG8_STAGE(PG8_SA(0, 0), a2, voffA);
            PG8_WAIT_V(8); PG8_WAIT_L(0); PG8_BAR; PG8_MMA(1, 0, At, B0); PG8_MMA(1, 1, At, B1); PG8_BAR; PG8_SCHED;
            PG8_LDB(B0, 1, 0); PG8_LDB(B1, 1, 1); PG8_SCHED; PG8_LDA(At, 1, 0); PG8_STAGE(PG8_SA(0, 1), a2 + hstep, voffA);
            PG8_WAIT_V(8); PG8_WAIT_L(0); PG8_BAR; PG8_MMA(0, 0, At, B0); PG8_MMA(0, 1, At, B1); PG8_BAR; PG8_SCHED;
            PG8_LDA(At, 1, 1); PG8_STAGE(PG8_SB(1, 0), b3, voffB); PG8_STAGE(PG8_SB(1, 1), b3 + hstep, voffB); PG8_STAGE(PG8_SA(1, 0), a3, voffA);
            PG8_WAIT_V(8); PG8_WAIT_L(0); PG8_BAR; PG8_MMA(1, 0, At, B0); PG8_MMA(1, 1, At, B1); PG8_BAR; PG8_SCHED;
            } else {
            PG8_LDB(B0, 0, 0); PG8_SCHED; PG8_LDA(At, 0, 0); PG8_STAGE(PG8_SA(1, 1), a1 + hstep, voffA);
            PG8_WAIT_L(8); PG8_BAR; PG8_WAIT_L(0); PG8_MMA(0, 0, At, B0); PG8_BAR; PG8_SCHED;
            PG8_LDB(B1, 0, 1); PG8_STAGE(PG8_SB(0, 0), b2, voffB);
            PG8_BAR; PG8_WAIT_L(0); PG8_MMA(0, 1, At, B1); PG8_BAR;
            PG8_LDA(At, 0, 1); PG8_STAGE(PG8_SA(0, 0), a2, voffA);
            PG8_BAR; PG8_WAIT_L(0); PG8_MMA(1, 0, At, B0); PG8_BAR; PG8_SCHED;
            PG8_STAGE(PG8_SB(0, 1), b2 + hstep, voffB);
            PG8_WAIT_V(6); PG8_BAR; PG8_MMA(1, 1, At, B1); PG8_BAR;
            PG8_LDB(B0, 1, 0); PG8_SCHED; PG8_LDA(At, 1, 0); PG8_STAGE(PG8_SA(0, 1), a2 + hstep, voffA);
            PG8_WAIT_L(8); PG8_BAR; PG8_WAIT_L(0); PG8_MMA(0, 0, At, B0); PG8_BAR; PG8_SCHED;
            PG8_LDB(B1, 1, 1); PG8_STAGE(PG8_SB(1, 0), b3, voffB);
            PG8_BAR; PG8_WAIT_L(0); PG8_MMA(0, 1, At, B1); PG8_BAR;
            PG8_LDA(At, 1, 1); PG8_STAGE(PG8_SA(1, 0), a3, voffA);
            PG8_BAR; PG8_WAIT_L(0); PG8_MMA(1, 0, At, B0); PG8_BAR; PG8_SCHED;
            PG8_STAGE(PG8_SB(1, 1), b3 + hstep, voffB);
            PG8_WAIT_V(6); PG8_BAR; PG8_MMA(1, 1, At, B1); PG8_BAR;
            }
        }
        if constexpr (ALIGN_EPI) { if (wr == 0) PG8_BAR; }
        if constexpr (!Epi::AFTER_DRAIN) { E(acc, cur, wr, wc, fr, fq); S.done(cur); }
        if (!has_next) break;
#pragma unroll
        for (int a = 0; a < 2; ++a)
#pragma unroll
            for (int b = 0; b < 2; ++b)
#pragma unroll
                for (int m = 0; m < 4; ++m)
#pragma unroll
                    for (int n = 0; n < 2; ++n) acc[a][b][m][n] = (f32x4){0.f, 0.f, 0.f, 0.f};
        cur = nxt; cA = nA; cB = nB; ++ui;
        if constexpr (ALIGN_EPI) { if (wr == 1) PG8_BAR; }
    }
    PG8_WAIT_V(0);
    if constexpr (!ALIGN_EPI) { if (wr == 0) PG8_BAR; }
    PG8_BAR;
    if constexpr (Epi::AFTER_DRAIN) { E.fused(acc, cur, wr, wc, fr, fq, lds, wid, lane); S.done(cur); }
#undef PG8_SA
#undef PG8_SB
#undef PG8_STAGE
#undef PG8_LDA
#undef PG8_LDB
#undef PG8_MMA
#undef PG8_WAIT_V
#undef PG8_WAIT_L
#undef PG8_BAR
#undef PG8_SCHED
}
typedef int v8i_t __attribute__((ext_vector_type(8)));
typedef int v4i_t __attribute__((ext_vector_type(4)));
template <class Epi, class Sched, bool ALIGN_EPI = false, bool SP2 = false>
__device__ __forceinline__ void gemm_phase_f8(PG8_LAS unsigned char* lds, const Gemm g, const Sched& S, const Epi& E, const int tid) {
    const int wid = __builtin_amdgcn_readfirstlane(tid >> 6), lane = tid & 63, wr = wid >> 2, wc = wid & 3, fr = lane & 15, fq = lane >> 4;
    const int K = g.K, nt = K / BK;
    unsigned voffA[2], voffB[2];
#pragma unroll
    for (int i = 0; i < 2; ++i) { int R, C; stage_rc(tid * 16 + i * 8192, R, C); const int Rb = Epi::PERM ? ((R & ~31) + perm32(R & 31)) : R;
        voffA[i] = (unsigned)(R * K + C) * 2u; voffB[i] = (unsigned)(Rb * K + C) * 2u; }
    const size_t kstep = (size_t)(BK * 2);
    const size_t hstep = (size_t)HALF * K * 2;
    const size_t tstep = 2 * hstep;
    const unsigned ldsw = (unsigned)wid * 1024u;
    const int aoff0 = lds_byte(wr * 64 + fr, fq * 16), aoff1 = lds_byte(wr * 64 + fr, fq * 16 + 8), boff0 = lds_byte(wc * 32 + fr, fq * 16), boff1 = lds_byte(wc * 32 + fr, fq * 16 + 8);
#define PG8_SA(b, h) (((b) * 2 + (h)) * HTB)
#define PG8_SB(b, h) ((4 + (b) * 2 + (h)) * HTB)
#define PG8_STAGE(bufoff, gbase, voff) do { _Pragma("unroll") for (int _i = 0; _i < 2; ++_i) \
        __builtin_amdgcn_global_load_lds((const unsigned*)((const char*)(gbase) + (voff)[_i]), (PG8_LAS unsigned*)(lds + (bufoff) + ldsw + _i * 8192), 16, 0, 0); } while (0)
#define PG8_LDA(dst, b, h) do { _Pragma("unroll") for (int m = 0; m < 4; ++m) { const u32x4 lo_ = *(const PG8_LAS u32x4*)(lds + PG8_SA(b, h) + aoff0 + m * 2048), hi_ = *(const PG8_LAS u32x4*)(lds + PG8_SA(b, h) + aoff1 + m * 2048); \
        dst[m] = __builtin_shufflevector((v4i_t)lo_, (v4i_t)hi_, 0, 1, 2, 3, 4, 5, 6, 7); } } while (0)
#define PG8_LDB(dst, b, h) do { _Pragma("unroll") for (int n = 0; n < 2; ++n) { const u32x4 lo_ = *(const PG8_LAS u32x4*)(lds + PG8_SB(b, h) + boff0 + n * 2048), hi_ = *(const PG8_LAS u32x4*)(lds + PG8_SB(b, h) + boff1 + n * 2048); \
        dst[n] = __builtin_shufflevector((v4i_t)lo_, (v4i_t)hi_, 0, 1, 2, 3, 4, 5, 6, 7); } } while (0)
#define PG8_MMA(ai, bj, At, Bt) do { __builtin_amdgcn_s_setprio(1); _Pragma("unroll") for (int m = 0; m < 4; ++m) _Pragma("unroll") for (int n = 0; n < 2; ++n) \
        asm volatile("v_mfma_scale_f32_16x16x128_f8f6f4 %0, %1, %2, %0, %3, %3 op_sel_hi:[0,0,0]" : "+v"(acc[ai][bj][m][n]) : "v"(Bt[n]), "v"(At[m]), "v"(one_scale)); __builtin_amdgcn_s_setprio(0); } while (0)
#define PG8_WAIT_V(n) asm volatile("s_waitcnt vmcnt(" #n ")" ::: "memory")
#define PG8_WAIT_L(n) asm volatile("s_waitcnt lgkmcnt(" #n ")" ::: "memory")
#define PG8_BAR __builtin_amdgcn_s_barrier()
#define PG8_SCHED __builtin_amdgcn_sched_barrier(0)
    Unit cur, nxt; int ui = 0;
    if (!S.next(0, cur)) return;
    f32x4 acc[2][2][4][2];
#pragma unroll
    for (int a = 0; a < 2; ++a)
#pragma unroll
        for (int b = 0; b < 2; ++b)
#pragma unroll
            for (int m = 0; m < 4; ++m)
#pragma unroll
                for (int n = 0; n < 2; ++n) acc[a][b][m][n] = (f32x4){0.f, 0.f, 0.f, 0.f};
    v8i_t At[4], B0[2], B1[2]; const int one_scale = 0x7f7f7f7f;
    const char* cA = (const char*)g.A + (size_t)cur.pm * tstep; const char* cB = (const char*)g.Bt + (size_t)cur.pn * tstep;
    S.a_ready(cur);
    if constexpr (SP2) {
        PG8_STAGE(PG8_SB(0, 0), cB, voffB); PG8_STAGE(PG8_SB(0, 1), cB + hstep, voffB); PG8_STAGE(PG8_SA(0, 0), cA, voffA); PG8_STAGE(PG8_SA(0, 1), cA + hstep, voffA);
        if (wr == 1) PG8_BAR;
        PG8_WAIT_V(2); PG8_BAR;
        PG8_STAGE(PG8_SB(1, 0), cB + kstep, voffB); PG8_STAGE(PG8_SA(1, 0), cA + kstep, voffA); PG8_STAGE(PG8_SB(1, 1), cB + hstep + kstep, voffB);
        PG8_WAIT_V(6); PG8_BAR;
    } else {
        PG8_STAGE(PG8_SB(0, 0), cB, voffB); PG8_STAGE(PG8_SA(0, 0), cA, voffA); PG8_STAGE(PG8_SB(0, 1), cB + hstep, voffB); PG8_STAGE(PG8_SA(0, 1), cA + hstep, voffA);
        if (wr == 1) PG8_BAR;
        PG8_WAIT_V(4); PG8_BAR;
        PG8_STAGE(PG8_SB(1, 0), cB + kstep, voffB); PG8_STAGE(PG8_SA(1, 0), cA + kstep, voffA); PG8_STAGE(PG8_SB(1, 1), cB + hstep + kstep, voffB);
        PG8_WAIT_V(6); PG8_BAR;
    }
    for (;;) {
        const bool has_next = S.next(ui + 1, nxt);
        const char* nA = has_next ? (const char*)g.A + (size_t)nxt.pm * tstep : cA; const char* nB = has_next ? (const char*)g.Bt + (size_t)nxt.pn * tstep : cB;
        for (int t = 0; t < nt; t += 2) {
            const bool last = (t == nt - 2);
            const char* a1 = cA + (size_t)(t + 1) * kstep;
            const char* a2 = last ? nA : cA + (size_t)(t + 2) * kstep; const char* b2 = last ? nB : cB + (size_t)(t + 2) * kstep;
            const char* a3 = a2 + kstep; const char* b3 = b2 + kstep;
            if (last && has_next) S.a_ready(nxt);
            if constexpr (SP2) {
            PG8_LDB(B0, 0, 0); PG8_LDB(B1, 0, 1); PG8_SCHED; PG8_LDA(At, 0, 0); PG8_STAGE(PG8_SA(1, 1), a1 + hstep, voffA);
            PG8_WAIT_V(8); PG8_WAIT_L(0); PG8_BAR; PG8_MMA(0, 0, At, B0); PG8_MMA(0, 1, At, B1); PG8_BAR; PG8_SCHED;
            PG8_LDA(At, 0, 1); PG8_STAGE(PG8_SB(0, 0), b2, voffB); PG8_STAGE(PG8_SB(0, 1), b2 + hstep, voffB); PG8_STAGE(PG8_SA(0, 0), a2, voffA);
            PG8_WAIT_V(8); PG8_WAIT_L(0); PG8_BAR; PG8_MMA(1, 0, At, B0); PG8_MMA(1, 1, At, B1); PG8_BAR; PG8_SCHED;
            PG8_LDB(B0, 1, 0); PG8_LDB(B1, 1, 1); PG8_SCHED; PG8_LDA(At, 1, 0); PG8_STAGE(PG8_SA(0, 1), a2 + hstep, voffA);
            PG8_WAIT_V(8); PG8_WAIT_L(0); PG8_BAR; PG8_MMA(0, 0, At, B0); PG8_MMA(0, 1, At, B1); PG8_BAR; PG8_SCHED;
            PG8_LDA(At, 1, 1); PG8_STAGE(PG8_SB(1, 0), b3, voffB); PG8_STAGE(PG8_SB(1, 1), b3 + hstep, voffB); PG8_STAGE(PG8_SA(1, 0), a3, voffA);
            PG8_WAIT_V(8); PG8_WAIT_L(0); PG8_BAR; PG8_MMA(1, 0, At, B0); PG8_MMA(1, 1, At, B1); PG8_BAR; PG8_SCHED;
            } else {
            PG8_LDB(B0, 0, 0); PG8_SCHED; PG8_LDA(At, 0, 0); PG8_STAGE(PG8_SA(1, 1), a1 + hstep, voffA);
            PG8_WAIT_L(8); PG8_BAR; PG8_WAIT_L(0); PG8_MMA(0, 0, At, B0); PG8_BAR; PG8_SCHED;
            PG8_LDB(B1, 0, 1); PG8_STAGE(PG8_SB(0, 0), b2, voffB);
            PG8_BAR; PG8_WAIT_L(0); PG8_MMA(0, 1, At, B1); PG8_BAR;
            PG8_LDA(At, 0, 1); PG8_STAGE(PG8_SA(0, 0), a2, voffA);
            PG8_BAR; PG8_WAIT_L(0); PG8_MMA(1, 0, At, B0); PG8_BAR; PG8_SCHED;
            PG8_STAGE(PG8_SB(0, 1), b2 + hstep, voffB);
            PG8_WAIT_V(6); PG8_BAR; PG8_MMA(1, 1, At, B1); PG8_BAR;
            PG8_LDB(B0, 1, 0); PG8_SCHED; PG8_LDA(At, 1, 0); PG8_STAGE(PG8_SA(0, 1), a2 + hstep, voffA);
            PG8_WAIT_L(8); PG8_BAR; PG8_WAIT_L(0); PG8_MMA(0, 0, At, B0); PG8_BAR; PG8_SCHED;
            PG8_LDB(B1, 1, 1); PG8_STAGE(PG8_SB(1, 0), b3, voffB);
            PG8_BAR; PG8_WAIT_L(0); PG8_MMA(0, 1, At, B1); PG8_BAR;
            PG8_LDA(At, 1, 1); PG8_STAGE(PG8_SA(1, 0), a3, voffA);
            PG8_BAR; PG8_WAIT_L(0); PG8_MMA(1, 0, At, B0); PG8_BAR; PG8_SCHED;
            PG8_STAGE(PG8_SB(1, 1), b3 + hstep, voffB);
            PG8_WAIT_V(6); PG8_BAR; PG8_MMA(1, 1, At, B1); PG8_BAR;
            }
        }
        if constexpr (ALIGN_EPI) { if (wr == 0) PG8_BAR; }
        asm volatile("s_nop 15\n\ts_nop 15" ::: "memory");
        if constexpr (!Epi::AFTER_DRAIN) { E(acc, cur, wr, wc, fr, fq); S.done(cur); }
        if (!has_next) break;
#pragma unroll
        for (int a = 0; a < 2; ++a)
#pragma unroll
            for (int b = 0; b < 2; ++b)
#pragma unroll
                for (int m = 0; m < 4; ++m)
#pragma unroll
                    for (int n = 0; n < 2; ++n) acc[a][b][m][n] = (f32x4){0.f, 0.f, 0.f, 0.f};
        cur = nxt; cA = nA; cB = nB; ++ui;
        if constexpr (ALIGN_EPI) { if (wr == 1) PG8_BAR; }
    }
    PG8_WAIT_V(0);
    if constexpr (!ALIGN_EPI) { if (wr == 0) PG8_BAR; }
    PG8_BAR;
    if constexpr (Epi::AFTER_DRAIN) { E.fused(acc, cur, wr, wc, fr, fq, lds, wid, lane); S.done(cur); }
#undef PG8_SA
#undef PG8_SB
#undef PG8_STAGE
#undef PG8_LDA
#undef PG8_LDB
#undef PG8_MMA
#undef PG8_WAIT_V
#undef PG8_WAIT_L
#undef PG8_BAR
#undef PG8_SCHED
}
}

#define XB_TMO      128
#define XB_XCNT(j)  (256  + 64 * (j))
#define XB_XSUB(j)  (1280 + 64 * (j))
#define XB_XGEN(j)  (2304 + 64 * (j))
#define XB_TOP      3328
#define XB_TOPGEN   3392
#define XCD_BAR_WORDS 3456
#define XB_SPIN_CAP (1u << 18)

__device__ __forceinline__ unsigned xb_ld(unsigned* p)              { return __hip_atomic_load(p, __ATOMIC_RELAXED, __HIP_MEMORY_SCOPE_AGENT); }
__device__ __forceinline__ unsigned xb_add(unsigned* p, unsigned v) { return __hip_atomic_fetch_add(p, v, __ATOMIC_RELAXED, __HIP_MEMORY_SCOPE_AGENT); }
__device__ __forceinline__ unsigned xb_xcc_id() { return (unsigned)__builtin_amdgcn_s_getreg((3 << 11) | 20) & 0xFu; }
#define XB_SPIN(cond, bar) do { unsigned _sp = 0; while (cond) { __builtin_amdgcn_s_sleep(1); \
    if ((++_sp & 255u) == 0u) { if (xb_ld(&(bar)[XB_TMO])) break; if (_sp > XB_SPIN_CAP) { atomicAdd(&(bar)[XB_TMO], 1u); break; } } } } while (0)

struct XcdBarrier {
    unsigned* bar; unsigned x;
    volatile LAS unsigned* st;
};

__device__ __forceinline__ XcdBarrier xcd_barrier_post(unsigned* bar, volatile LAS unsigned* st, const int xb_tid) {
    XcdBarrier b; b.bar = bar; b.x = xb_xcc_id(); b.st = st;
    if (xb_tid == 0) (void)xb_add(&bar[XB_XCNT(b.x)], 1u);
    return b;
}
__device__ __forceinline__ void xcd_barrier_complete(unsigned* bar, unsigned x, unsigned& nloc, unsigned& nx) {
    const unsigned G = gridDim.x * gridDim.y * gridDim.z;
    unsigned sum, cnt, mine, sp = 0u;
    for (;;) {
        sum = 0u; cnt = 0u; mine = 0u;
#pragma unroll
        for (unsigned j = 0; j < 16; ++j) { const unsigned c = xb_ld(&bar[XB_XCNT(j)]); sum += c; cnt += (c > 0u) ? 1u : 0u; mine = (j == x) ? c : mine; }
        if (sum == G) break;
        __builtin_amdgcn_s_sleep(1);
        if ((++sp & 255u) == 0u) { if (xb_ld(&bar[XB_TMO])) break; if (sp > XB_SPIN_CAP) { atomicAdd(&bar[XB_TMO], 1u); break; } }
    }
    nloc = mine > 0u ? mine : 1u; nx = cnt > 0u ? cnt : 1u;
}

__device__ __forceinline__ void xcd_barrier(const XcdBarrier& b, const int xb_tid) {
    asm volatile("s_waitcnt vmcnt(0)" ::: "memory");
    __syncthreads();
    if (xb_tid == 0) {
        unsigned* bar = b.bar;
        __builtin_amdgcn_s_waitcnt(0);
        unsigned nloc = b.st[0], nx = b.st[1];
        if (nloc == 0u) { xcd_barrier_complete(bar, b.x, nloc, nx); b.st[0] = nloc; b.st[1] = nx; }
        const unsigned old = xb_add(&bar[XB_XSUB(b.x)], 1u);
        const unsigned gen = old / nloc;
        if (old + 1u == (gen + 1u) * nloc) {
            __builtin_amdgcn_fence(__ATOMIC_RELEASE, "agent");
            asm volatile("s_waitcnt vmcnt(0)" ::: "memory");
            const unsigned og = xb_add(&bar[XB_TOP], 1u);
            const unsigned tg = og / nx;
            if (og + 1u == (tg + 1u) * nx) xb_add(&bar[XB_TOPGEN], 1u);
            else XB_SPIN(xb_ld(&bar[XB_TOPGEN]) == tg, bar);
            __builtin_amdgcn_fence(__ATOMIC_ACQUIRE, "agent");
            xb_add(&bar[XB_XGEN(b.x)], 1u);
            asm volatile("s_waitcnt vmcnt(0)" ::: "memory");
        } else {
            XB_SPIN(xb_ld(&bar[XB_XGEN(b.x)]) == gen, bar);
            __builtin_amdgcn_fence(__ATOMIC_ACQUIRE, "agent");
            asm volatile("s_waitcnt vmcnt(0)" ::: "memory");
        }
    }
    __syncthreads();
}

__device__ __forceinline__ void group_arrive(unsigned* cnt, const int xb_tid) {
    asm volatile("s_waitcnt vmcnt(0)" ::: "memory");
    __syncthreads();
    if (xb_tid == 0) {
        __builtin_amdgcn_s_waitcnt(0);
        __builtin_amdgcn_fence(__ATOMIC_RELEASE, "agent");
        asm volatile("s_waitcnt vmcnt(0)" ::: "memory");
        (void)xb_add(cnt, 1u);
    }
}
__device__ __forceinline__ void group_wait(unsigned* bar, unsigned* cnt, unsigned n, const int xb_tid) {
    __syncthreads();
    if (xb_tid == 0) {
        XB_SPIN(xb_ld(cnt) < n, bar);
        __builtin_amdgcn_fence(__ATOMIC_ACQUIRE, "agent");
        asm volatile("s_waitcnt vmcnt(0)" ::: "memory");
    }
    __syncthreads();
}

#define GAS __attribute__((address_space(1)))
typedef unsigned short bf16;
typedef unsigned v4u __attribute__((ext_vector_type(4)));
typedef unsigned v2u __attribute__((ext_vector_type(2)));
typedef float f32x4 __attribute__((ext_vector_type(4)));

constexpr int NB = 4, SEQ = 8192, DM = 1024, DEPTH = 4, CTXL = 256;
constexpr int NLAT = NB * SEQ, NCTX = NB * CTXL, MT = NLAT + NCTX;
constexpr int DIN = 3360, DINP = 3584, DFF = 2816, NEXP = 8;
constexpr int C_RQ = 0, C_RK = 256, C_RV = 512, C_RG = 768, C_S5 = 1024, C_HQ = 1280, C_HFF = 1536, C_HFB = 1792, C_HI = 2048, C_HG = 2304,
              C_GQ = 2560, C_GK = 2688, C_GV = 2816, C_GG = 3072, C_GAF = 3328, C_GAB = 3344,
              C_GZF = 3328, C_GZB = 3456;
constexpr int NSEG = 132;
constexpr int MOE_CAP_TILES = 272;
constexpr float NEPS = 1e-6f;
constexpr float WSC8 = 64.0f;

constexpr size_t MiB = 1u << 20;
constexpr size_t WS_CTL = 0, CTL_ZERO_BYTES = 2 * MiB;
constexpr size_t WS_MOD = 2 * MiB;
constexpr size_t WS_LB = 3 * MiB;
constexpr size_t WS_ROPE = 3 * MiB + 65536;
constexpr size_t WS_GLUW = 3 * MiB + 131072;
constexpr size_t WS_WIN = 4 * MiB;
constexpr size_t WS_WOUT = 32 * MiB;
constexpr size_t WS_W13D = 40 * MiB;
constexpr size_t WS_W2D = 62 * MiB;
constexpr size_t WS_W13M = 73 * MiB;
constexpr size_t WS_W2M = 161 * MiB;
constexpr size_t WS_HB = 205 * MiB;
constexpr size_t WS_ACT = 209 * MiB;
constexpr size_t WS_Z = 275 * MiB;
constexpr size_t WS_PH = 292 * MiB;
constexpr size_t WS_OF = (292 + 232) * MiB;
constexpr size_t WS_XR = 580 * MiB;
constexpr size_t WS_X2 = 666 * MiB;
constexpr size_t WS_LIST = 843 * MiB;
constexpr size_t WS_S5PAR = 70 * MiB;
constexpr size_t WS_END = 846 * MiB;
constexpr size_t ST_DS0 = 0;
constexpr size_t ST_DS1 = ST_DS0 + (size_t)2 * 16 * NSEG * 4096;
constexpr size_t ST_DS2 = ST_DS1 + (size_t)2 * 16 * NSEG * 4096;
constexpr size_t ST_G0 = ST_DS2 + (size_t)2 * 16 * NSEG * 2048;
constexpr size_t ST_G1 = ST_G0 + (size_t)2 * 16 * NSEG * 64;
constexpr size_t ST_G2 = ST_G1 + (size_t)2 * 16 * NSEG * 64;
constexpr size_t ST_HS = ST_G2 + (size_t)2 * 16 * NSEG * 64;
constexpr size_t ST_END = ST_HS + (size_t)2 * 64 * NSEG * 128;
static_assert(ST_END * 4 <= (WS_LIST - WS_X2), "state region");
static_assert(WS_PH + (size_t)MT * DINP * 2 <= WS_OF && WS_OF + (size_t)MT * 768 * 2 <= WS_XR && WS_XR + (size_t)MT * 1024 * 2 <= WS_X2, "OF / residual regions");
static_assert((size_t)MOE_CAP_TILES * 256 * 1024 * 2 <= (WS_LIST - WS_X2), "XB region");
static_assert((size_t)MOE_CAP_TILES * 256 * DFF * 2 <= (WS_X2 - WS_PH) && (size_t)MT * DINP * 2 <= (WS_X2 - WS_PH), "P/H region");
constexpr int CW_BAR = 4096;
constexpr int FP8_F1_J = 1;
constexpr int CW_TAIL = 32768;
constexpr int CW_CNT = 16384;

constexpr int LDS_BYTES = 163840;
constexpr int MISC_OFF = 163840 - 512;

__device__ __forceinline__ float bf2f(unsigned short h) { return __uint_as_float(((unsigned)h) << 16); }
__device__ __forceinline__ unsigned f2bf(float f) { unsigned u = __float_as_uint(f); return (u + 0x7fffu + ((u >> 16) & 1u)) >> 16; }
__device__ __forceinline__ unsigned pk2(float lo, float hi) { return f2bf(lo) | (f2bf(hi) << 16); }
__device__ __forceinline__ float wave_sum(float v) {
#define WS_DPP(ctrl, rmask) v += __int_as_float(__builtin_amdgcn_update_dpp(0, __float_as_int(v), (ctrl), (rmask), 0xf, false))
    WS_DPP(0x111, 0xf); WS_DPP(0x112, 0xf); WS_DPP(0x114, 0xf); WS_DPP(0x118, 0xf); WS_DPP(0x142, 0xa); WS_DPP(0x143, 0xc);
#undef WS_DPP
    return __int_as_float(__builtin_amdgcn_readlane(__float_as_int(v), 63));
}
__device__ __forceinline__ float rdl(float v, int k) { return __uint_as_float((unsigned)__builtin_amdgcn_readlane((int)__float_as_uint(v), k)); }
__device__ __forceinline__ float sigm(float x) { return __builtin_amdgcn_rcpf(1.0f + __expf(-x)); }
__device__ __forceinline__ float silu_f(float x) { return x * __builtin_amdgcn_rcpf(1.0f + __expf(-x)); }
#define LDS_WAIT() asm volatile("s_waitcnt lgkmcnt(0)" ::: "memory")

struct Args {
    const float* in[37];
    int l_lo, l_hi, ph_lo, ph_hi, do_pro, do_fin, fused, pad;
};
constexpr int I_OUT = 35, I_WS = 36;
enum { I_X = 0, I_C, I_CTX, I_CCTX, I_ADAW, I_ADAB, I_N1W, I_N2W, I_WIN, I_WOUT, I_RETGN, I_LAMRE, I_LAMIM, I_LOGDT, I_BRE, I_BIM, I_CRE, I_CIM, I_S5D,
       I_GLUW, I_GLUB, I_LBL, I_HGNW, I_WA2, I_BA, I_GLANW, I_FW1, I_FW3, I_FW2, I_RW, I_RB, I_MW1, I_MW3, I_MW2, I_FINW };

struct Frame {
    LAS unsigned char* lds;
    int tid, lane, wave, gw, NGW, G, zz;
    unsigned char* ws; float* out;
};

struct EpiStoreBf16 {
    static constexpr bool PERM = true, AFTER_DRAIN = false;
    bf16* O; int ldc; float sc;
    __device__ __forceinline__ void operator()(const pg8::f32x4 (&acc)[2][2][4][2], const pg8::Unit& u, int wr, int wc, int fr, int fq) const {
        const int row0 = u.pm * 256 + wr * 64 + fr, col0 = u.pc * 256 + wc * 32 + 8 * fq;
#pragma unroll
        for (int ai = 0; ai < 2; ++ai)
#pragma unroll
            for (int m = 0; m < 4; ++m) { bf16* rowp = O + (size_t)(row0 + ai * 128 + m * 16) * ldc + col0;
#pragma unroll
                for (int bj = 0; bj < 2; ++bj) { const pg8::f32x4 v0 = acc[ai][bj][m][0] * sc, v1 = acc[ai][bj][m][1] * sc;
                    pg8::u32x4 w; w.x = pg8::cvt_pk_bf16(v0[0], v0[1]); w.y = pg8::cvt_pk_bf16(v0[2], v0[3]); w.z = pg8::cvt_pk_bf16(v1[0], v1[1]); w.w = pg8::cvt_pk_bf16(v1[2], v1[3]);
                    *(pg8::u32x4*)(rowp + bj * 128) = w; } }
    }
};
constexpr int P4G = 4 * DINP, P4S5 = 4096;
struct EpiStoreP4 {
    static constexpr bool PERM = true, FLIP = true, AFTER_DRAIN = false;
    bf16* O;
    __device__ __forceinline__ void operator()(const pg8::f32x4 (&acc)[2][2][4][2], const pg8::Unit& u, int wr, int wc, int fr, int fq) const {
        const int grp0 = u.pm * 64 + wr * 16 + fq;
        if (!(u.pc == 3 || u.pc == 4 || u.pc == 9 || u.pc == 12)) {
            bf16* base = O + (size_t)grp0 * P4G + (size_t)(u.pc * 256 + wc * 32 + 2 * fr) * 4;
#pragma unroll
            for (int ai = 0; ai < 2; ++ai)
#pragma unroll
                for (int m = 0; m < 4; ++m) { bf16* gp = base + (size_t)(ai * 32 + m * 4) * P4G;
#pragma unroll
                    for (int bj = 0; bj < 2; ++bj) { const pg8::f32x4 v0 = acc[ai][bj][m][0], v1 = acc[ai][bj][m][1];
                        pg8::u32x4 w; w.x = pg8::cvt_pk_bf16(v0[0], v0[1]); w.y = pg8::cvt_pk_bf16(v0[2], v0[3]); w.z = pg8::cvt_pk_bf16(v1[0], v1[1]); w.w = pg8::cvt_pk_bf16(v1[2], v1[3]);
                        *(pg8::u32x4*)(gp + bj * 512) = w; } }
        } else {
            bf16* base = O + (size_t)grp0 * P4G + u.pc * 1024 + wc * 32 + 2 * fr;
#pragma unroll
            for (int ai = 0; ai < 2; ++ai)
#pragma unroll
                for (int m = 0; m < 4; ++m) { bf16* gp = base + (size_t)(ai * 32 + m * 4) * P4G;
#pragma unroll
                    for (int bj = 0; bj < 2; ++bj)
#pragma unroll
                        for (int r = 0; r < 4; ++r) *(unsigned*)(gp + r * 256 + bj * 128) = pg8::cvt_pk_bf16(acc[ai][bj][m][0][r], acc[ai][bj][m][1][r]); }
        }
    }
};
struct EpiSwiglu {
    static constexpr bool PERM = true, AFTER_DRAIN = false;
    bf16* H;
    __device__ __forceinline__ void operator()(const pg8::f32x4 (&acc)[2][2][4][2], const pg8::Unit& u, int wr, int wc, int fr, int fq) const {
        const int row0 = u.pm * 256 + wr * 64 + fr, col0 = u.pc * 128 + wc * 32 + 8 * fq;
#pragma unroll
        for (int ai = 0; ai < 2; ++ai)
#pragma unroll
            for (int m = 0; m < 4; ++m) { bf16* rowp = H + (size_t)(row0 + ai * 128 + m * 16) * DFF + col0;
                float h[8];
#pragma unroll
                for (int n = 0; n < 2; ++n)
#pragma unroll
                    for (int j = 0; j < 4; ++j) { const float a = acc[ai][0][m][n][j], b = acc[ai][1][m][n][j];
                        h[n * 4 + j] = a * __builtin_amdgcn_rcpf(1.0f + __builtin_amdgcn_exp2f(-1.4426950408889634f * a)) * b; }
                pg8::u32x4 w; w.x = pg8::cvt_pk_bf16(h[0], h[1]); w.y = pg8::cvt_pk_bf16(h[2], h[3]); w.z = pg8::cvt_pk_bf16(h[4], h[5]); w.w = pg8::cvt_pk_bf16(h[6], h[7]);
                *(pg8::u32x4*)rowp = w; }
    }
};
struct EpiSwiglu8 {
    static constexpr bool PERM = true, AFTER_DRAIN = false;
    unsigned char* H; float sc;
    __device__ __forceinline__ void operator()(const pg8::f32x4 (&acc)[2][2][4][2], const pg8::Unit& u, int wr, int wc, int fr, int fq) const {
        const int row0 = u.pm * 256 + wr * 64 + fr, col0 = u.pc * 128 + wc * 32 + 8 * fq;
        const float c1 = -1.4426950408889634f * sc, s2 = sc * sc;
#pragma unroll
        for (int ai = 0; ai < 2; ++ai)
#pragma unroll
            for (int m = 0; m < 4; ++m) { unsigned char* rowp = H + (size_t)(row0 + ai * 128 + m * 16) * DFF + col0;
                float h[8];
#pragma unroll
                for (int n = 0; n < 2; ++n)
#pragma unroll
                    for (int j = 0; j < 4; ++j) { const float a = acc[ai][0][m][n][j], b = acc[ai][1][m][n][j];
                        const float hv = (a * b) * __builtin_amdgcn_rcpf(1.0f + __builtin_amdgcn_exp2f(c1 * a)) * s2;
                        h[n * 4 + j] = __builtin_amdgcn_fmed3f(hv, -448.0f, 448.0f); }
                unsigned w0 = 0u, w1 = 0u;
                w0 = __builtin_amdgcn_cvt_pk_fp8_f32(h[0], h[1], w0, false); w0 = __builtin_amdgcn_cvt_pk_fp8_f32(h[2], h[3], w0, true);
                w1 = __builtin_amdgcn_cvt_pk_fp8_f32(h[4], h[5], w1, false); w1 = __builtin_amdgcn_cvt_pk_fp8_f32(h[6], h[7], w1, true);
                v2u w; w.x = w0; w.y = w1; *(v2u*)rowp = w; }
    }
};
struct EpiResid {
    static constexpr bool PERM = true, AFTER_DRAIN = false;
    const float* xin_lat; const float* xin_ctx;
    bf16* xr; const float* gate; float sc; int pm_off;
    __device__ __forceinline__ void operator()(const pg8::f32x4 (&acc)[2][2][4][2], const pg8::Unit& u, int wr, int wc, int fr, int fq) const {
        const int pmg = u.pm + pm_off; const bool isctx = pmg >= 128; const int bidx = isctx ? 4 : (pmg >> 5);
        const size_t grow = (size_t)pmg * 256 + wr * 64 + fr;
        const int col0 = u.pc * 256 + wc * 32 + 8 * fq; const float* g = gate + (size_t)bidx * 6144 + col0;
        const float* xi = xin_lat ? (isctx ? xin_ctx + ((size_t)(pmg - 128) * 256 + wr * 64 + fr) * 1024 : xin_lat + grow * 1024) : (const float*)nullptr;
        pg8::f32x4 gv[2][2];
#pragma unroll
        for (int bj = 0; bj < 2; ++bj)
#pragma unroll
            for (int n = 0; n < 2; ++n) gv[bj][n] = *(const pg8::f32x4*)(g + bj * 128 + n * 4) * sc;
#pragma unroll
        for (int ai = 0; ai < 2; ++ai)
#pragma unroll
            for (int m = 0; m < 4; ++m) { const size_t roff = (size_t)(ai * 128 + m * 16) * 1024 + col0;
#pragma unroll
                for (int bj = 0; bj < 2; ++bj) {
                    pg8::f32x4 x0, x1;
                    if (xi) { x0 = *(const pg8::f32x4*)(xi + roff + bj * 128); x1 = *(const pg8::f32x4*)(xi + roff + bj * 128 + 4); }
                    else { const pg8::u32x4 w = *(const pg8::u32x4*)(xr + grow * 1024 + roff + bj * 128);
                        x0[0] = __uint_as_float(w.x << 16); x0[1] = __uint_as_float(w.x & 0xffff0000u); x0[2] = __uint_as_float(w.y << 16); x0[3] = __uint_as_float(w.y & 0xffff0000u);
                        x1[0] = __uint_as_float(w.z << 16); x1[1] = __uint_as_float(w.z & 0xffff0000u); x1[2] = __uint_as_float(w.w << 16); x1[3] = __uint_as_float(w.w & 0xffff0000u); }
                    const pg8::f32x4 y0 = x0 + gv[bj][0] * acc[ai][bj][m][0], y1 = x1 + gv[bj][1] * acc[ai][bj][m][1];
                    pg8::u32x4 o; o.x = pg8::cvt_pk_bf16(y0[0], y0[1]); o.y = pg8::cvt_pk_bf16(y0[2], y0[3]); o.z = pg8::cvt_pk_bf16(y1[0], y1[1]); o.w = pg8::cvt_pk_bf16(y1[2], y1[3]);
                    *(pg8::u32x4*)(xr + grow * 1024 + roff + bj * 128) = o; }
                asm volatile("" ::: "memory"); }
    }
};
struct EpiGlu {
    static constexpr bool PERM = true, AFTER_DRAIN = false;
    const bf16* Z; bf16* Y; const float* bias;
    __device__ __forceinline__ void operator()(const pg8::f32x4 (&acc)[2][2][4][2], const pg8::Unit& u, int wr, int wc, int fr, int fq) const {
        const int row0 = u.pm * 256 + wr * 64 + fr, col0 = wc * 32 + 8 * fq;
#pragma unroll
        for (int ai = 0; ai < 2; ++ai)
#pragma unroll
            for (int m = 0; m < 4; ++m) { const size_t row = (size_t)(row0 + ai * 128 + m * 16);
#pragma unroll
                for (int bj = 0; bj < 2; ++bj) { const int col = col0 + bj * 128;
                    const pg8::u32x4 zz = *(const pg8::u32x4*)(Z + row * 256 + col);
                    const pg8::f32x4 b0 = *(const pg8::f32x4*)(bias + col), b1 = *(const pg8::f32x4*)(bias + col + 4);
                    const pg8::f32x4 v0 = acc[ai][bj][m][0] + b0, v1 = acc[ai][bj][m][1] + b1;
                    float o[8]; const unsigned zw[4] = {zz.x, zz.y, zz.z, zz.w};
#pragma unroll
                    for (int j = 0; j < 4; ++j) { const float zl = __uint_as_float(zw[j] << 16), zh = __uint_as_float(zw[j] & 0xffff0000u);
                        const float a0 = (j < 2) ? v0[2 * j] : v1[2 * j - 4], a1 = (j < 2) ? v0[2 * j + 1] : v1[2 * j - 3];
                        o[2 * j] = zl * sigm(a0); o[2 * j + 1] = zh * sigm(a1); }
                    pg8::u32x4 w; w.x = pg8::cvt_pk_bf16(o[0], o[1]); w.y = pg8::cvt_pk_bf16(o[2], o[3]); w.z = pg8::cvt_pk_bf16(o[4], o[5]); w.w = pg8::cvt_pk_bf16(o[6], o[7]);
                    *(pg8::u32x4*)(Y + row * 1024 + 256 + col) = w; }
                asm volatile("" ::: "memory"); }
    }
};
struct MoeOrder {
    int tp[9]; int nN, G, c, total;
    __device__ __forceinline__ void init(const unsigned* cnt, int nN_, int G_, int c_) {
        tp[0] = 0;
#pragma unroll
        for (int e = 0; e < 8; ++e) tp[e + 1] = tp[e] + (int)(((unsigned)__builtin_amdgcn_readfirstlane((int)__hip_atomic_load(cnt + e * 64, __ATOMIC_RELAXED, __HIP_MEMORY_SCOPE_AGENT)) + 255u) >> 8);
        nN = nN_; G = G_; c = c_; total = tp[8] * nN;
    }
    __device__ __forceinline__ bool next(int i, pg8::Unit& u) const {
        const int L = i * G + c; if (L >= total) return false;
        int wgid = L; { const int q = total / pg8::NXCD, r = total % pg8::NXCD, xcd = wgid % pg8::NXCD, off = wgid / pg8::NXCD; wgid = (xcd < r ? xcd * (q + 1) : r * (q + 1) + (xcd - r) * q) + off; }
        const int nM = tp[8], nig = pg8::WGM * nN, gid = wgid / nig, fm = gid * pg8::WGM, gsz = (nM - fm) < pg8::WGM ? (nM - fm) : pg8::WGM;
        const int rem = wgid - gid * nig, t = fm + rem % gsz, pn = rem / gsz; int e = 0;
#pragma unroll
        for (int k = 1; k < 8; ++k) e += (t >= tp[k]) ? 1 : 0;
        u.pm = t; u.pn = e * nN + pn; u.pc = pn; return true;
    }
    __device__ __forceinline__ void a_ready(const pg8::Unit&) const {}
    __device__ __forceinline__ void done(const pg8::Unit&) const {}
};

__device__ __forceinline__ void cvt_item(const float* W, int K, int N, bf16* WT, int mode, int add, LAS float* scr, int item, int lane, int nblk_override = 0, const float* ks = nullptr  ) {
    const int nblk = nblk_override ? nblk_override : (N >> 5), kb = item / nblk, nb = item - kb * nblk, k0 = 64 * kb, n0 = 32 * nb;
    const int r = lane >> 3, c4 = lane & 7;
    f32x4 v[8];
#pragma unroll
    for (int i = 0; i < 8; ++i) v[i] = *(const f32x4*)(W + (size_t)(k0 + 8 * i + r) * N + n0 + 4 * c4);
    if (ks) {
#pragma unroll
        for (int i = 0; i < 8; ++i) v[i] *= ks[8 * i + r]; }
#pragma unroll
    for (int i = 0; i < 8; ++i) {
#pragma unroll
        for (int j = 0; j < 4; ++j) scr[(8 * i + r) * 33 + 4 * c4 + j] = v[i][j]; }
    LDS_WAIT();
    const int c = lane & 7;
#pragma unroll
    for (int j = 0; j < 4; ++j) { const int n = (lane >> 3) + 8 * j; const LAS float* s = scr + (8 * c) * 33 + n;
        v4u o; o.x = pk2(s[0 * 33], s[1 * 33]); o.y = pk2(s[2 * 33], s[3 * 33]); o.z = pk2(s[4 * 33], s[5 * 33]); o.w = pk2(s[6 * 33], s[7 * 33]);
        const int nn = n0 + n; const int drow = (mode == 0) ? (nn + add) : (((nn >> 7) << 8) + (nn & 127) + add);
        *(v4u*)(WT + (size_t)drow * K + k0 + 8 * c) = o; }
    LDS_WAIT();
}
__device__ __forceinline__ void cvt_item_f8(const float* W, int K, int N, unsigned char* WT, int mode, int add, LAS float* scr, int item, int lane) {
    const int nblk = N >> 5, kb = item / nblk, nb = item - kb * nblk, k0 = 64 * kb, n0 = 32 * nb;
    const int r = lane >> 3, c4 = lane & 7;
    f32x4 v[8];
#pragma unroll
    for (int i = 0; i < 8; ++i) v[i] = *(const f32x4*)(W + (size_t)(k0 + 8 * i + r) * N + n0 + 4 * c4);
#pragma unroll
    for (int i = 0; i < 8; ++i) {
#pragma unroll
        for (int j = 0; j < 4; ++j) scr[(8 * i + r) * 33 + 4 * c4 + j] = v[i][j]; }
    LDS_WAIT();
    const int c = lane & 3;
#pragma unroll
    for (int j = 0; j < 2; ++j) { const int n = (lane >> 2) + 16 * j; const LAS float* s = scr + (16 * c) * 33 + n;
        unsigned w[4];
#pragma unroll
        for (int q = 0; q < 4; ++q) { unsigned x = 0u;
            x = __builtin_amdgcn_cvt_pk_fp8_f32(s[(4 * q) * 33] * WSC8, s[(4 * q + 1) * 33] * WSC8, x, false);
            x = __builtin_amdgcn_cvt_pk_fp8_f32(s[(4 * q + 2) * 33] * WSC8, s[(4 * q + 3) * 33] * WSC8, x, true); w[q] = x; }
        v4u o; o.x = w[0]; o.y = w[1]; o.z = w[2]; o.w = w[3];
        const int nn = n0 + n; const int drow = (mode == 0) ? (nn + add) : (((nn >> 7) << 8) + (nn & 127) + add);
        *(v4u*)(WT + (size_t)drow * K + k0 + 16 * c) = o; }
    LDS_WAIT();
}
__device__ __forceinline__ void moe_cvt_idle(const Frame& F, const Args& a, int j, int b_lo) {
    LAS float* scr = (LAS float*)(F.lds + F.wave * 16384);
    constexpr int IT = 1408;
    const int nw = (F.G - b_lo) * 8, w = ((int)blockIdx.x - b_lo) * 8 + F.wave;
    for (int it = w; it < 8 * 3 * IT; it += nw) {
        const int e = it / (3 * IT), r = it - e * 3 * IT, which = r / IT, item = r - which * IT;
        const size_t eo = ((size_t)j * 8 + e) * (size_t)(1024 * DFF);
        if (which == 0) cvt_item_f8(a.in[F.zz + I_MW1] + eo, 1024, DFF, F.ws + WS_W13M + (size_t)e * 5632 * 1024, 1, 0, scr, item, F.lane);
        else if (which == 1) cvt_item_f8(a.in[F.zz + I_MW3] + eo, 1024, DFF, F.ws + WS_W13M + (size_t)e * 5632 * 1024, 1, 128, scr, item, F.lane);
        else cvt_item_f8(a.in[F.zz + I_MW2] + eo, DFF, 1024, F.ws + WS_W2M + (size_t)e * 1024 * DFF, 0, 0, scr, item, F.lane);
    }
}
__device__ __forceinline__ void moe_cvt(const Frame& F, const Args& a, int j) {
    LAS float* scr = (LAS float*)(F.lds + F.wave * 16384);
    constexpr int IT = 1408;
    for (int it = F.gw; it < 8 * 3 * IT; it += F.NGW) {
        const int e = it / (3 * IT), r = it - e * 3 * IT, which = r / IT, item = r - which * IT;
        const size_t eo = ((size_t)j * 8 + e) * (size_t)(1024 * DFF);
        if (which == 0) cvt_item_f8(a.in[F.zz + I_MW1] + eo, 1024, DFF, F.ws + WS_W13M + (size_t)e * 5632 * 1024, 1, 0, scr, item, F.lane);
        else if (which == 1) cvt_item_f8(a.in[F.zz + I_MW3] + eo, 1024, DFF, F.ws + WS_W13M + (size_t)e * 5632 * 1024, 1, 128, scr, item, F.lane);
        else cvt_item_f8(a.in[F.zz + I_MW2] + eo, DFF, 1024, F.ws + WS_W2M + (size_t)e * 1024 * DFF, 0, 0, scr, item, F.lane);
    }
}
__device__ __forceinline__ void prologue(const Frame& F, const Args& a) {
    {
        LAS float* sc = (LAS float*)F.lds; LAS float* red = sc + 5120;
        for (int idx = F.tid; idx < 5120; idx += 512) { const int r = idx >> 10, k = idx & 1023; const float cv = (r < 4) ? a.in[F.zz + I_C][r * 1024 + k] : a.in[F.zz + I_CCTX][k]; sc[idx] = silu_f(cv); }
        __syncthreads();
        float* MOD = (float*)(F.ws + WS_MOD);
        for (int item = blockIdx.x; item < 384; item += F.G) {
            const int l = item / 96, nb = item - l * 96, cl = F.tid & 63, ks = F.tid >> 6, n = nb * 64 + cl;
            float acc[5] = {0.f, 0.f, 0.f, 0.f, 0.f};
            const float* wp = a.in[F.zz + I_ADAW] + ((size_t)l * 1024 + ks * 128) * 6144 + n;
#pragma unroll 16
            for (int kk = 0; kk < 128; ++kk) { const float w = wp[(size_t)kk * 6144];
#pragma unroll
                for (int r = 0; r < 5; ++r) acc[r] = fmaf(sc[r * 1024 + ks * 128 + kk], w, acc[r]); }
#pragma unroll
            for (int r = 0; r < 5; ++r) red[(ks * 5 + r) * 64 + cl] = acc[r];
            __syncthreads();
            if (F.tid < 320) { const int r = F.tid >> 6; float s = 0.f;
#pragma unroll
                for (int k2 = 0; k2 < 8; ++k2) s += red[(k2 * 5 + r) * 64 + cl];
                MOD[((size_t)l * 5 + r) * 6144 + n] = s + a.in[F.zz + I_ADAB][l * 6144 + n]; }
            __syncthreads();
        }
        if (blockIdx.x == 0 && F.tid < 256) {
            const float* lg = a.in[F.zz + I_LBL]; float x[4], mx = -3.0e38f;
#pragma unroll
            for (int l = 0; l < 4; ++l) { x[l] = lg[l * 256 + F.tid]; mx = fmaxf(mx, x[l]); }
            float s = 0.f;
#pragma unroll
            for (int l = 0; l < 4; ++l) { x[l] = expf(x[l] - mx); s += x[l]; }
            float cs = 0.f; const float sm0 = x[0] / s; float* LB = (float*)(F.ws + WS_LB);
#pragma unroll
            for (int l = 0; l < 4; ++l) { cs += x[l] / s; LB[l * 256 + F.tid] = fminf(fmaxf(cs - sm0, 0.f), 1.0f - 1e-6f); }
        }
        if (blockIdx.x == (1 % F.G)) {
            float* RC = (float*)(F.ws + WS_ROPE); float* RS = RC + 2048;
            for (int idx = F.tid; idx < 2048; idx += 512) { const int pos = idx >> 4, i = idx & 15;
                const float fr = powf(10000.0f, -(float)i / 16.0f); const float ang = (float)pos * fr; RC[idx] = cosf(ang); RS[idx] = sinf(ang); }
        }
        __syncthreads();
    }
    LAS float* scr = (LAS float*)(F.lds + F.wave * 16384);
    constexpr int I_IN = 16 * 104, I_OUT = 16 * 32, I_F = 1408, I_GL = 4 * 8;
    constexpr int NIT = 4 * I_IN + 4 * I_OUT + 6 * I_F + 4 * I_GL;
    for (int it = F.gw; it < NIT; it += F.NGW) {
        int r = it;
        if (r < 4 * I_IN) { const int l = r / I_IN; cvt_item(a.in[F.zz + I_WIN] + (size_t)l * 1024 * DIN, 1024, DIN, (bf16*)(F.ws + WS_WIN) + (size_t)l * DINP * 1024, 0, 0, scr, r - l * I_IN, F.lane, 104); continue; } r -= 4 * I_IN;
        if (r < 4 * I_OUT) { const int l = r / I_OUT, it = r - l * I_OUT, k0 = 64 * (it >> 5);
            const float* ks = k0 < 256 ? a.in[F.zz + I_RETGN] + l * 256 + k0 : (k0 < 512 ? nullptr : (k0 < 768 ? a.in[F.zz + I_HGNW] + l * 256 + (k0 - 512) : a.in[F.zz + I_GLANW] + l * 256 + (k0 - 768)));
            cvt_item(a.in[F.zz + I_WOUT] + (size_t)l * 1024 * 1024, 1024, 1024, (bf16*)(F.ws + WS_WOUT) + (size_t)l * 1024 * 1024, 0, 0, scr, it, F.lane, 0, ks); continue; } r -= 4 * I_OUT;
        if (r < 6 * I_F) { const int j = r / (3 * I_F), r2 = r - j * 3 * I_F, which = r2 / I_F, item = r2 - which * I_F; const size_t wo = (size_t)j * 1024 * DFF;
            if (j == FP8_F1_J && which < 2) {
                if (which == 0) cvt_item_f8(a.in[F.zz + I_FW1] + wo, 1024, DFF, F.ws + WS_W13D + (size_t)j * 5632 * 1024 * 2, 1, 0, scr, item, F.lane);
                else if (which == 1) cvt_item_f8(a.in[F.zz + I_FW3] + wo, 1024, DFF, F.ws + WS_W13D + (size_t)j * 5632 * 1024 * 2, 1, 128, scr, item, F.lane);
            } else
            if (which == 0) cvt_item(a.in[F.zz + I_FW1] + wo, 1024, DFF, (bf16*)(F.ws + WS_W13D) + (size_t)j * 5632 * 1024, 1, 0, scr, item, F.lane);
            else if (which == 1) cvt_item(a.in[F.zz + I_FW3] + wo, 1024, DFF, (bf16*)(F.ws + WS_W13D) + (size_t)j * 5632 * 1024, 1, 128, scr, item, F.lane);
            else cvt_item_f8(a.in[F.zz + I_FW2] + wo, DFF, 1024, F.ws + WS_W2D + (size_t)j * 1024 * DFF, 0, 0, scr, item, F.lane);
            continue; } r -= 6 * I_F;
        { const int l = r / I_GL; cvt_item(a.in[F.zz + I_GLUW] + (size_t)l * 65536, 256, 256, (bf16*)(F.ws + WS_GLUW) + (size_t)l * 65536, 0, 0, scr, r - l * I_GL, F.lane); }
    }
    for (int i = blockIdx.x * 512 + F.tid; i < 4 * 256 * 128; i += F.G * 512) {
        const int l = i >> 15, rem = i & 32767, n = rem >> 7, k0 = (rem & 127) * 8, d = n >> 7, cidx = n & 127;
        const float* wa = a.in[F.zz + I_WA2] + ((size_t)(l * 2 + d) * 16) * 128 + cidx;
        float acc[8] = {0.f, 0.f, 0.f, 0.f, 0.f, 0.f, 0.f, 0.f};
#pragma unroll
        for (int r = 0; r < 16; ++r) { const float w2 = wa[r * 128];
#pragma unroll
            for (int kk = 0; kk < 8; ++kk) acc[kk] = fmaf(a.in[F.zz + I_WIN][((size_t)l * 1024 + k0 + kk) * DIN + 3328 + 16 * d + r], w2, acc[kk]); }
        v4u o; o.x = pk2(acc[0], acc[1]); o.y = pk2(acc[2], acc[3]); o.z = pk2(acc[4], acc[5]); o.w = pk2(acc[6], acc[7]);
        *(v4u*)((bf16*)(F.ws + WS_WIN) + ((size_t)l * DINP + 3328 + n) * 1024 + k0) = o;
    }
}

struct MoeTp { int tp[9]; };
__device__ __forceinline__ void load_tp(MoeTp& t, const unsigned* cnt) {
    t.tp[0] = 0;
#pragma unroll
    for (int e = 0; e < 8; ++e) t.tp[e + 1] = t.tp[e] + (int)(((unsigned)__builtin_amdgcn_readfirstlane((int)__hip_atomic_load(cnt + e * 64, __ATOMIC_RELAXED, __HIP_MEMORY_SCOPE_AGENT)) + 255u) >> 8);
}
__device__ __forceinline__ void moe_route_flush(const Frame& F, int jm, int nk, int rt_e, int rt_m, float g0, float g1) {
    unsigned* cnt = (unsigned*)F.ws + CW_CNT + jm * 8 * 64; int* LIST = (int*)(F.ws + WS_LIST);
    int* EPw = (int*)(F.ws + WS_LIST) + 8 * MT; float* GW = (float*)(F.ws + WS_LIST) + 10 * MT;
    const bool has = F.lane < nk; const int e0 = rt_e & 15, e1 = rt_e >> 4;
    unsigned p0 = 0u, p1 = 0u;
#pragma unroll
    for (int e = 0; e < 8; ++e) {
        const unsigned long long b0 = __ballot(has && e0 == e), b1 = __ballot(has && e1 == e);
        const unsigned c0 = (unsigned)__popcll(b0), c = c0 + (unsigned)__popcll(b1);
        if (c == 0u) continue;
        unsigned base = 0u;
        if (F.lane == 0) base = __hip_atomic_fetch_add(cnt + e * 64, c, __ATOMIC_RELAXED, __HIP_MEMORY_SCOPE_AGENT);
        base = (unsigned)__builtin_amdgcn_readfirstlane((int)base);
        const unsigned long long below = (1ull << F.lane) - 1ull;
        if (has && e0 == e) p0 = base + (unsigned)__popcll(b0 & below);
        if (has && e1 == e) p1 = base + c0 + (unsigned)__popcll(b1 & below);
    }
    if (has) {
        LIST[e0 * MT + p0] = rt_m; LIST[e1 * MT + p1] = rt_m;
        EPw[2 * rt_m] = e0 | (int)(p0 << 3); EPw[2 * rt_m + 1] = e1 | (int)(p1 << 3);
        GW[2 * rt_m] = g0; GW[2 * rt_m + 1] = g1;
    }
}
template <int MODE, bool XC = true  >
__device__ __forceinline__ void norm_phase(const Frame& F, const Args& a, int l, int which  , int nrows, int comb_l  ,
                                           int row_lo = 0, int w0 = -1  , int nwav = 0) {
    const int wv_ = (w0 < 0) ? F.gw : w0, nwv_ = (w0 < 0) ? F.NGW : nwav;
    const float* MOD = (const float*)(F.ws + WS_MOD);
    const float* nw = (MODE == 2) ? a.in[F.zz + I_FINW] : ((which ? a.in[F.zz + I_N2W] : a.in[F.zz + I_N1W]) + l * 1024);
    bf16* XN = (bf16*)(F.ws + WS_ACT);
    bf16* XR = (bf16*)(F.ws + WS_XR);
    const int* EP = (const int*)(F.ws + WS_LIST) + 8 * MT; const float* GATE = (const float*)(F.ws + WS_LIST) + 10 * MT;
    const bf16* YM = (const bf16*)(F.ws + WS_X2);
    MoeTp ctp; if (comb_l >= 0) load_tp(ctp, (const unsigned*)F.ws + CW_CNT + (comb_l >> 1) * 8 * 64);
    const int jm = l >> 1;
    LAS float* rwl = (LAS float*)F.lds;
    if (MODE == 1) {
        const float* rw = a.in[F.zz + I_RW] + (size_t)jm * 8192;
        for (int idx = F.tid; idx < 8192; idx += 512) { const int k = idx >> 3, e = idx & 7; rwl[e * 1024 + k] = rw[idx]; }
        __syncthreads();
    }
    f32x4 wv[4];
#pragma unroll
    for (int j = 0; j < 4; ++j) wv[j] = *((const f32x4*)nw + F.lane + 64 * j);
    f32x4 vn[4]; v2u vnr[4]; int epn0 = 0, epn1 = 0; float gn0 = 0.f, gn1 = 0.f, gq0 = 0.f, gq1 = 0.f; v2u ymn0[4], ymn1[4];
#pragma unroll
    for (int j = 0; j < 4; ++j) { ymn0[j] = (v2u){0u, 0u}; ymn1[j] = (v2u){0u, 0u}; }
    { const int m = (row_lo + wv_ < nrows) ? row_lo + wv_ : row_lo; const bool isctx = m >= NLAT;
      const float* xr = isctx ? a.in[F.zz + I_CTX] + (size_t)(m - NLAT) * 1024 : a.in[F.zz + I_X] + (size_t)m * 1024;
#pragma unroll
      for (int j = 0; j < 4; ++j) { if (XC) vnr[j] = *((const v2u*)(XR + (size_t)m * 1024) + F.lane + 64 * j); else vn[j] = *((const f32x4*)xr + F.lane + 64 * j); }
      if (comb_l >= 0) { const int e0 = EP[2 * m], e1 = EP[2 * m + 1]; gn0 = GATE[2 * m]; gn1 = GATE[2 * m + 1];
          int t0 = 0, t1 = 0;
#pragma unroll
          for (int e = 0; e < 8; ++e) { t0 = ((e0 & 7) == e) ? ctp.tp[e] : t0; t1 = ((e1 & 7) == e) ? ctp.tp[e] : t1; }
          const size_t d0 = (size_t)t0 * 256 + (e0 >> 3), d1 = (size_t)t1 * 256 + (e1 >> 3);
#pragma unroll
          for (int j = 0; j < 4; ++j) { ymn0[j] = *((const v2u*)(YM + d0 * 1024) + F.lane + 64 * j); ymn1[j] = *((const v2u*)(YM + d1 * 1024) + F.lane + 64 * j); }
          const int m1 = (m + nwv_ < nrows) ? m + nwv_ : m;
          epn0 = EP[2 * m1]; epn1 = EP[2 * m1 + 1]; gq0 = GATE[2 * m1]; gq1 = GATE[2 * m1 + 1]; } }
    int mod_b = -1; f32x4 ms0[4], ms1[4];
#pragma unroll
    for (int j = 0; j < 4; ++j) { ms0[j] = (f32x4){0.f, 0.f, 0.f, 0.f}; ms1[j] = ms0[j]; }
    int rt_k = 0, rt_e = 0, rt_m = 0; float rt_g0 = 0.f, rt_g1 = 0.f;
    for (int m = row_lo + wv_; m < nrows; m += nwv_) {
        const bool isctx = m >= NLAT; const int bidx = isctx ? 4 : (m >> 13);
        f32x4 v[4];
#pragma unroll
        for (int j = 0; j < 4; ++j) { if (XC) { v[j][0] = __uint_as_float(vnr[j].x << 16); v[j][1] = __uint_as_float(vnr[j].x & 0xffff0000u); v[j][2] = __uint_as_float(vnr[j].y << 16); v[j][3] = __uint_as_float(vnr[j].y & 0xffff0000u); } else v[j] = vn[j]; }
        const float g0 = gn0, g1 = gn1; v2u ym0[4], ym1[4];
#pragma unroll
        for (int j = 0; j < 4; ++j) { ym0[j] = ymn0[j]; ym1[j] = ymn1[j]; }
        { const int mn = (m + nwv_ < nrows) ? m + nwv_ : m; const bool cn = mn >= NLAT;
          const float* xr = cn ? a.in[F.zz + I_CTX] + (size_t)(mn - NLAT) * 1024 : a.in[F.zz + I_X] + (size_t)mn * 1024;
#pragma unroll
          for (int j = 0; j < 4; ++j) { if (XC) vnr[j] = *((const v2u*)(XR + (size_t)mn * 1024) + F.lane + 64 * j); else vn[j] = *((const f32x4*)xr + F.lane + 64 * j); }
          if (comb_l >= 0) {
              int t0 = 0, t1 = 0;
#pragma unroll
              for (int e = 0; e < 8; ++e) { t0 = ((epn0 & 7) == e) ? ctp.tp[e] : t0; t1 = ((epn1 & 7) == e) ? ctp.tp[e] : t1; }
              const size_t d0 = (size_t)t0 * 256 + (epn0 >> 3), d1 = (size_t)t1 * 256 + (epn1 >> 3);
#pragma unroll
              for (int j = 0; j < 4; ++j) { ymn0[j] = *((const v2u*)(YM + d0 * 1024) + F.lane + 64 * j); ymn1[j] = *((const v2u*)(YM + d1 * 1024) + F.lane + 64 * j); }
              gn0 = gq0; gn1 = gq1;
              const int mn2 = (mn + nwv_ < nrows) ? mn + nwv_ : mn;
              epn0 = EP[2 * mn2]; epn1 = EP[2 * mn2 + 1]; gq0 = GATE[2 * mn2]; gq1 = GATE[2 * mn2 + 1]; } }
        if (comb_l >= 0) {
            const float* m5 = MOD + ((size_t)comb_l * 5 + bidx) * 6144 + 5 * 1024;
#pragma unroll
            for (int j = 0; j < 4; ++j) {
                const v2u y0 = ym0[j], y1 = ym1[j];
                const f32x4 mm = *((const f32x4*)m5 + F.lane + 64 * j);
                f32x4 f0, f1;
                f0[0] = __uint_as_float(y0.x << 16); f0[1] = __uint_as_float(y0.x & 0xffff0000u); f0[2] = __uint_as_float(y0.y << 16); f0[3] = __uint_as_float(y0.y & 0xffff0000u);
                f1[0] = __uint_as_float(y1.x << 16); f1[1] = __uint_as_float(y1.x & 0xffff0000u); f1[2] = __uint_as_float(y1.y << 16); f1[3] = __uint_as_float(y1.y & 0xffff0000u);
                v[j] = v[j] + mm * (f0 * g0 + f1 * g1);
                if (MODE != 2) { v2u w; w.x = pk2(v[j][0], v[j][1]); w.y = pk2(v[j][2], v[j][3]); *((v2u*)(XR + (size_t)m * 1024) + F.lane + 64 * j) = w; }
            }
        }
        float ss = 0.f;
#pragma unroll
        for (int j = 0; j < 4; ++j) ss += (v[j][0] * v[j][0] + v[j][1] * v[j][1]) + (v[j][2] * v[j][2] + v[j][3] * v[j][3]);
        ss = wave_sum(ss);
        const float rstd = __builtin_amdgcn_rsqf(ss * (1.0f / 1024.0f) + NEPS);
        if (MODE == 2) {
#pragma unroll
            for (int j = 0; j < 4; ++j) *((f32x4*)(F.out + (size_t)m * 1024) + F.lane + 64 * j) = v[j] * rstd * wv[j];
        } else {
            if (bidx != mod_b) {
                const float* sh = MOD + ((size_t)l * 5 + bidx) * 6144 + (which ? 3 : 0) * 1024; const float* scl = sh + 1024;
#pragma unroll
                for (int j = 0; j < 4; ++j) { ms1[j] = *((const f32x4*)scl + F.lane + 64 * j) + 1.0f; ms0[j] = *((const f32x4*)sh + F.lane + 64 * j); }
                mod_b = bidx;
            }
            f32x4 o[4];
#pragma unroll
            for (int j = 0; j < 4; ++j) {
                o[j] = (v[j] * rstd * wv[j]) * ms1[j] + ms0[j];
                if (MODE == 1 || MODE == 3) {
                    unsigned w8 = 0u; w8 = __builtin_amdgcn_cvt_pk_fp8_f32(fminf(fmaxf(o[j][0], -448.f), 448.f), fminf(fmaxf(o[j][1], -448.f), 448.f), w8, false);
                    w8 = __builtin_amdgcn_cvt_pk_fp8_f32(fminf(fmaxf(o[j][2], -448.f), 448.f), fminf(fmaxf(o[j][3], -448.f), 448.f), w8, true);
                    *((unsigned*)((unsigned char*)XN + (size_t)m * 1024) + F.lane + 64 * j) = w8;
                } else { v2u w; w.x = pk2(o[j][0], o[j][1]); w.y = pk2(o[j][2], o[j][3]);
                    *((v2u*)(XN + (size_t)m * 1024) + F.lane + 64 * j) = w; } }
            if (MODE == 1) {
                float p[8];
#pragma unroll
                for (int e = 0; e < 8; ++e) { float s = 0.f;
#pragma unroll
                    for (int j = 0; j < 4; ++j) { const f32x4 w4 = *((const LAS f32x4*)(rwl + e * 1024) + F.lane + 64 * j);
                        s += (o[j][0] * w4[0] + o[j][1] * w4[1]) + (o[j][2] * w4[2] + o[j][3] * w4[3]); }
                    p[e] = wave_sum(s) + a.in[F.zz + I_RB][jm * 8 + e]; }
                int e0 = 0; float v0 = p[0];
#pragma unroll
                for (int e = 1; e < 8; ++e) if (p[e] > v0) { v0 = p[e]; e0 = e; }
                int e1 = -1; float v1 = -3.0e38f;
#pragma unroll
                for (int e = 0; e < 8; ++e) if (e != e0 && p[e] > v1) { v1 = p[e]; e1 = e; }
                const float ex = expf(v1 - v0), g0 = 1.0f / (1.0f + ex), g1 = ex / (1.0f + ex);
                if (F.lane == rt_k) { rt_e = e0 | (e1 << 4); rt_m = m; rt_g0 = g0; rt_g1 = g1; }
                ++rt_k;
                if (rt_k == 64) { moe_route_flush(F, jm, rt_k, rt_e, rt_m, rt_g0, rt_g1); rt_k = 0; }
            }
        }
    }
    if (MODE == 1) { if (rt_k > 0) moe_route_flush(F, jm, rt_k, rt_e, rt_m, rt_g0, rt_g1); __syncthreads(); }
}
__device__ __forceinline__ void moe_gather(const Frame& F, int jm) {
    const unsigned* cnt = (const unsigned*)F.ws + CW_CNT + jm * 8 * 64;
    MoeTp t; load_tp(t, cnt);
    int cn[8];
#pragma unroll
    for (int e = 0; e < 8; ++e) cn[e] = __builtin_amdgcn_readfirstlane((int)__hip_atomic_load(cnt + e * 64, __ATOMIC_RELAXED, __HIP_MEMORY_SCOPE_AGENT));
    const int rows = t.tp[8] * 256;
    const int* LIST = (const int*)(F.ws + WS_LIST); const v4u* XN = (const v4u*)(F.ws + WS_ACT); v4u* XB = (v4u*)(F.ws + WS_X2);
    for (int r0 = F.gw; r0 < rows; r0 += 8 * F.NGW) {
        int src[8];
#pragma unroll
        for (int q = 0; q < 8; ++q) { const int r = r0 + q * F.NGW; src[q] = -1;
            if (r < rows) { const int tile = r >> 8; int e = 0, tpe = 0, ce = cn[0];
#pragma unroll
                for (int k = 1; k < 8; ++k) { const bool ge = tile >= t.tp[k]; e += ge ? 1 : 0; tpe = ge ? t.tp[k] : tpe; ce = ge ? cn[k] : ce; }
                const int pos = r - tpe * 256;
                if (pos < ce) src[q] = LIST[e * MT + pos]; } }
        v4u x[8];
#pragma unroll
        for (int q = 0; q < 8; ++q) { x[q] = (v4u){0u, 0u, 0u, 0u}; if (src[q] >= 0) x[q] = XN[(size_t)src[q] * 64 + F.lane]; }
#pragma unroll
        for (int q = 0; q < 8; ++q) { const int r = r0 + q * F.NGW; if (r < rows) XB[(size_t)r * 64 + F.lane] = x[q]; }
    }
}
#define GLD(T, ubase, voff) (*(const T*)((const char*)(ubase) + (unsigned)(voff)))
#define GST(T, ubase, voff) (*(T*)((char*)(ubase) + (unsigned)(voff)))
__device__ __forceinline__ int fresh_lane() { int l; asm volatile("v_mbcnt_lo_u32_b32 %0, -1, 0\n\tv_mbcnt_hi_u32_b32 %0, -1, %0" : "=v"(l)); return l; }

struct MixP { const bf16* P; const float* lb; const float* rcos; const float* rsin; const float* ba; };
__device__ __forceinline__ int seg_row0(int b, int sg) { return sg < 4 ? NLAT + b * CTXL + sg * 64 : b * SEQ + (sg - 4) * 64; }
__device__ __forceinline__ int seg_tpos0(int sg) { return sg < 4 ? -1 : (sg - 4) * 64; }

struct S5P { const float *lam_re, *lam_im, *log_dt, *b_re, *b_im, *c_re, *c_im, *dd; const unsigned* par; };
__device__ __forceinline__ float gelu_tanh(float y) { const float t = 0.7978845608028654f * (y + 0.044715f * y * y * y); const float th = 1.0f - 2.0f * __builtin_amdgcn_rcpf(1.0f + __expf(2.0f * t)); return 0.5f * y * (1.0f + th); }
template <int MODE>
__device__ __forceinline__ void s5_scan(const S5P& sp, const bf16* P, int b, int g, int dir, int sg, int lane, float& hre, float& him, LAS float* yf, LAS float* stg, bf16* Z) {
    const int row0 = seg_row0(b, sg); const int dg = dir * 16 + g;
    const float lre = sp.lam_re[dg * 64 + lane], lim = sp.lam_im[dg * 64 + lane], dt = expf(sp.log_dt[dg]);
    const float er = expf(lre * dt); const float sn = sinf(lim * dt), cs = cosf(lim * dt);
    const float ar = er * cs, ai = er * sn;
    const float nr = ar - 1.0f, ni = ai, den = lre * lre + lim * lim;
    const float cr = (nr * lre + ni * lim) / den, ci = (ni * lre - nr * lim) / den;
    float bbr[16], bbi[16], Cr[16], Ci[16];
#pragma unroll
    for (int c = 0; c < 16; ++c) { const float Br = sp.b_re[((size_t)dg * 64 + lane) * 16 + c], Bi = sp.b_im[((size_t)dg * 64 + lane) * 16 + c];
        bbr[c] = cr * Br - ci * Bi; bbi[c] = cr * Bi + ci * Br;
        Cr[c] = (MODE != 0) ? sp.c_re[((size_t)dg * 16 + c) * 64 + lane] : 0.f; Ci[c] = (MODE != 0) ? sp.c_im[((size_t)dg * 16 + c) * 64 + lane] : 0.f; }
    const int ch = ((lane >> 5) & 1) * 8 + ((lane >> 4) & 1) * 4 + ((lane >> 3) & 1) * 2 + ((lane >> 2) & 1);
    const float dv = (MODE == 2) ? sp.dd[g * 16 + ch] : 0.f;
    const bool b5 = lane & 32, b4 = lane & 16, b3 = lane & 8, b2 = lane & 4;
    const unsigned ucol = 2u * (unsigned)(C_S5 + g * 16 + (lane & 15));
    unsigned short rn0[4], rn1[4], rn2[4];
#pragma unroll
    for (int u = 0; u < 4; ++u) { rn0[u] = GLD(unsigned short, P + (size_t)(row0 + (dir ? 63 - u : u)) * DINP, ucol); rn1[u] = GLD(unsigned short, P + (size_t)(row0 + (dir ? 59 - u : 4 + u)) * DINP, ucol);
        rn2[u] = GLD(unsigned short, P + (size_t)(row0 + (dir ? 55 - u : 8 + u)) * DINP, ucol); }
#pragma unroll 1
    for (int i0 = 0; i0 < 64; i0 += 4) {
        unsigned short ru[4], rn3[4];
        const int ip = (i0 + 12 < 64) ? i0 + 12 : 60;
#pragma unroll
        for (int u = 0; u < 4; ++u) { ru[u] = rn0[u]; rn3[u] = GLD(unsigned short, P + (size_t)(row0 + (dir ? 63 - (ip + u) : (ip + u))) * DINP, ucol); }
#pragma unroll
        for (int u = 0; u < 4; ++u) stg[u * 64 + lane] = bf2f(ru[u]);
#pragma unroll
        for (int u = 0; u < 4; ++u) {
            const int ti = dir ? 63 - (i0 + u) : (i0 + u);
            const float uf = bf2f(ru[u]);
            float bur = 0.f, bui = 0.f;
#pragma unroll
            for (int c4 = 0; c4 < 4; ++c4) { const f32x4 ux = *(const LAS f32x4*)(stg + u * 64 + 4 * c4);
#pragma unroll
                for (int jj = 0; jj < 4; ++jj) { bur = fmaf(bbr[4 * c4 + jj], ux[jj], bur); bui = fmaf(bbi[4 * c4 + jj], ux[jj], bui); } }
            const float nre = ar * hre - ai * him + bur, nim = ar * him + ai * hre + bui;
            hre = nre; him = nim;
            if (MODE != 0) {
                float v[16];
#pragma unroll
                for (int c = 0; c < 16; ++c) v[c] = Cr[c] * hre - Ci[c] * him;
                float w8[8], w4[4], w2[2], w1;
#pragma unroll
                for (int i = 0; i < 8; ++i) { const float mine = b5 ? v[8 + i] : v[i], oth = b5 ? v[i] : v[8 + i]; w8[i] = mine + __shfl_xor(oth, 32); }
#pragma unroll
                for (int i = 0; i < 4; ++i) { const float mine = b4 ? w8[4 + i] : w8[i], oth = b4 ? w8[i] : w8[4 + i]; w4[i] = mine + __shfl_xor(oth, 16); }
#pragma unroll
                for (int i = 0; i < 2; ++i) { const float mine = b3 ? w4[2 + i] : w4[i], oth = b3 ? w4[i] : w4[2 + i]; w2[i] = mine + __shfl_xor(oth, 8); }
                { const float mine = b2 ? w2[1] : w2[0], oth = b2 ? w2[0] : w2[1]; w1 = mine + __shfl_xor(oth, 4); }
                w1 += __shfl_xor(w1, 2); w1 += __shfl_xor(w1, 1);
                if (MODE == 1) { if ((lane & 3) == 0) yf[ti * 16 + ch] = w1; }
                if (MODE == 2) {
                    const float uch = __shfl(uf, ch);
                    if ((lane & 3) == 0) { const float y = w1 + yf[ti * 16 + ch] + dv * uch; Z[(size_t)(row0 + ti) * 256 + g * 16 + ch] = (bf16)f2bf(gelu_tanh(y)); }
                }
            }
        }
#pragma unroll
        for (int u = 0; u < 4; ++u) { rn0[u] = rn1[u]; rn1[u] = rn2[u]; rn2[u] = rn3[u]; }
    }
}

__device__ __forceinline__ MixP make_mixp(const Frame& F, const Args& a, int l) {
    MixP mp; mp.P = (const bf16*)(F.ws + WS_PH); mp.lb = (const float*)(F.ws + WS_LB) + l * 256; mp.rcos = (const float*)(F.ws + WS_ROPE); mp.rsin = mp.rcos + 2048;
    mp.ba = a.in[F.zz + I_BA] + (size_t)l * 2 * 128; return mp;
}
__device__ __forceinline__ S5P make_s5p(const Frame& F, const Args& a, int l) {
    S5P sp; sp.lam_re = a.in[F.zz + I_LAMRE] + (size_t)l * 2048; sp.lam_im = a.in[F.zz + I_LAMIM] + (size_t)l * 2048; sp.log_dt = a.in[F.zz + I_LOGDT] + l * 32;
    sp.b_re = a.in[F.zz + I_BRE] + (size_t)l * 32768; sp.b_im = a.in[F.zz + I_BIM] + (size_t)l * 32768; sp.c_re = a.in[F.zz + I_CRE] + (size_t)l * 32768; sp.c_im = a.in[F.zz + I_CIM] + (size_t)l * 32768;
    sp.dd = a.in[F.zz + I_S5D] + l * 256; sp.par = (const unsigned*)(F.ws + WS_S5PAR) + (size_t)l * 32 * 4096; return sp;
}


typedef short bf16x8_t __attribute__((ext_vector_type(8)));
typedef float f32x16 __attribute__((ext_vector_type(16)));
typedef float f32x2_t __attribute__((ext_vector_type(2)));
typedef __bf16 bf16x2_n __attribute__((ext_vector_type(2)));
__device__ __forceinline__ unsigned pkbf(float lo, float hi) { const f32x2_t v = {lo, hi}; const bf16x2_n r = __builtin_convertvector(v, bf16x2_n); return __builtin_bit_cast(unsigned, r); }
constexpr int WL_QC = 0, WL_KC = 4608, WL_KT = 9216, WL_VT = 14336, WL_PL = 19456, WL_BYTES = 19712;

struct MxC { float gamma, lbv, oml, bav, rc1, rs1; unsigned cq, ck, cv, cz; };
template <int MIX>
__device__ __forceinline__ void mx_consts(MxC& c, const MixP& mp, int h, int dir, int lane) {
    c.gamma = 1.f; c.lbv = 0.f; c.oml = 1.f; c.bav = 0.f; c.cz = 0; c.rc1 = 1.f; c.rs1 = 0.f;
    if (MIX == 0) { c.cq = 8u * (unsigned)(C_RQ + h * 64 + lane); c.ck = 8u * (unsigned)(C_RK + h * 64 + lane); c.cv = 8u * (unsigned)(C_RV + h * 64 + lane); c.gamma = 1.0f - exp2f(-5.0f - (float)(dir ? 3 - h : h));
        if (lane & 32) { const unsigned r1 = 4u * (unsigned)(16 + (lane & 15)); c.rc1 = GLD(float, mp.rcos, r1); const float s1 = GLD(float, mp.rsin, r1); c.rs1 = dir ? -s1 : s1; } }
    else if (MIX == 1) { c.cq = 8u * (unsigned)(C_HQ + h * 64 + lane); c.ck = 8u * (unsigned)((dir ? C_HFB : C_HFF) + h * 64 + lane); c.cv = 8u * (unsigned)(C_HI + h * 64 + lane); c.lbv = mp.lb[h * 64 + lane]; c.oml = 1.0f - c.lbv; }
    else { c.cq = 8u * (unsigned)(C_GQ + h * 32 + (lane & 31)); c.ck = 8u * (unsigned)(C_GK + h * 32 + (lane & 31)); c.cv = 8u * (unsigned)(C_GV + h * 64 + lane); c.cz = 8u * (unsigned)((dir ? C_GZB : C_GZF) + h * 32 + (lane & 31));
        c.bav = mp.ba[dir * 128 + h * 32 + (lane & 31)]; }
}
struct MxRaw { v2u q, k, v, z; };
template <int MIX, bool NEEDQ, int DIR>
__device__ __forceinline__ void mx_load(MxRaw& w, const MixP& mp, const MxC& c, int rows, int b) {
    const bf16* pr = mp.P + (size_t)((rows >> 2) + (DIR ? 15 - b : b)) * P4G;
    const v2u zero = {0u, 0u};
    w.q = NEEDQ ? GLD(v2u, pr, c.cq) : zero; w.k = GLD(v2u, pr, c.ck); w.v = GLD(v2u, pr, c.cv); w.z = (MIX == 2) ? GLD(v2u, pr, c.cz) : zero;
}
__device__ __forceinline__ float bfx(const v2u& w, int i) { const unsigned d = (i >> 1) ? w.y : w.x; return __builtin_bit_cast(float, (i & 1) ? (d & 0xffff0000u) : (d << 16)); }
template <int MIX, bool NEEDQ, int DIR>
__device__ __forceinline__ void mx_batch(const MxRaw& cur, const MixP& mp, const MxC& c, int tposs  , int lane, LAS unsigned char* wl, int b, float& P, float& rc, float& rs) {
    constexpr int DK = (MIX == 2) ? 32 : 64;
    float kt[4];
#pragma unroll
    for (int u = 0; u < 4; ++u) {
        const int cc = b * 4 + u, ts = DIR ? 63 - cc : cc, t = ts & 31;
        const int pu = DIR ? 3 - u : u; float q = bfx(cur.q, pu), k, f;
        if (MIX == 0) {
            k = bfx(cur.k, pu) * 0.125f; f = c.gamma;
            if (tposs >= 0) { const float cs = rc, sn = rs;
                rc = cs * c.rc1 - sn * c.rs1; rs = sn * c.rc1 + cs * c.rs1;
                const float ss = (lane & 16) ? sn : -sn;
                const float kp = __shfl_xor(k, 16); k = fmaf(kp, ss, k * cs);
                if (NEEDQ) { const float qp = __shfl_xor(q, 16); q = fmaf(qp, ss, q * cs); } }
        } else if (MIX == 1) {
            const float z = bfx(cur.k, pu); const float e = __expf(-z); const float sp = __builtin_amdgcn_rcpf(1.0f + e), sn = e * sp;
            f = fmaf(c.oml, sp, c.lbv); k = c.oml * sn;
        } else {
            k = bfx(cur.k, pu) * 0.17677669529663687f; const float z = bfx(cur.z, pu) + c.bav;
            const float ls = fminf(z, 0.f) - __logf(1.0f + __expf(-fabsf(z)));
            f = __expf(ls * 0.0625f);
        }
        P = fmaxf(P * f, 1e-30f);
        const float kk = k * __builtin_amdgcn_rcpf(P); kt[DIR ? 3 - u : u] = kk;
        if (lane < DK) {
            const unsigned qk = pkbf(q * P, kk);
            if (NEEDQ) *(LAS unsigned short*)(wl + WL_QC + t * 144 + lane * 2) = (unsigned short)qk;
            *(LAS unsigned short*)(wl + WL_KC + t * 144 + lane * 2) = (unsigned short)(qk >> 16);
        }
    }
    const int g4 = ((DIR ? 63 - b * 4 : b * 4) & 31) >> 2;
    v2u kp; kp.x = pkbf(kt[0], kt[1]); kp.y = pkbf(kt[2], kt[3]);
    if (lane < DK) *(LAS v2u*)(wl + WL_KT + lane * 80 + g4 * 8) = kp;
    *(LAS v2u*)(wl + WL_VT + lane * 80 + g4 * 8) = cur.v;
}
typedef short bf16x4_t __attribute__((ext_vector_type(4)));
#define MFMA8(a, b, c) __builtin_amdgcn_mfma_f32_32x32x8bf16_1k((a), (b), (c), 0, 0, 0)
__device__ __forceinline__ bf16x4_t pack4(const f32x16& x, int s) {
    v2u p; p.x = pkbf(x[4 * s], x[4 * s + 1]); p.y = pkbf(x[4 * s + 2], x[4 * s + 3]);
    return __builtin_bit_cast(bf16x4_t, p);
}
__device__ __forceinline__ bf16x4_t ld4(const LAS unsigned char* p) { const v2u a = *(const LAS v2u*)p; return __builtin_bit_cast(bf16x4_t, a); }

__device__ __forceinline__ float u2f_(unsigned u) { return __builtin_bit_cast(float, u); }
__device__ __forceinline__ unsigned f2u_(float f) { return __builtin_bit_cast(unsigned, f); }
__device__ __forceinline__ void s5_build(const Frame& F, const Args& a) {
    for (int it = F.gw; it < 128; it += F.NGW) {
        const int l = it >> 5, dg = it & 31, lane = F.lane, m32 = lane & 31, hh = lane >> 5;
        const S5P sp = make_s5p(F, a, l);
        unsigned* par = (unsigned*)(F.ws + WS_S5PAR) + (size_t)it * 4096;
    float ar[2], ai[2], a2r[2], a2i[2], a3r[2], a3i[2], a4r[2], a4i[2];
    bf16x4_t bfr[4][2];
    const float dt = __expf(sp.log_dt[dg]);
#pragma unroll
    for (int sh = 0; sh < 2; ++sh) {
        const int p = 32 * sh + m32;
        const float lre = sp.lam_re[dg * 64 + p], lim = sp.lam_im[dg * 64 + p];
        const float er = __expf(lre * dt), sn = sinf(lim * dt), cs = cosf(lim * dt);
        ar[sh] = er * cs; ai[sh] = er * sn;
        a2r[sh] = ar[sh] * ar[sh] - ai[sh] * ai[sh]; a2i[sh] = ar[sh] * ai[sh] + ar[sh] * ai[sh];
        a3r[sh] = a2r[sh] * ar[sh] - a2i[sh] * ai[sh]; a3i[sh] = a2r[sh] * ai[sh] + a2i[sh] * ar[sh];
        a4r[sh] = a2r[sh] * a2r[sh] - a2i[sh] * a2i[sh]; a4i[sh] = a2r[sh] * a2i[sh] + a2r[sh] * a2i[sh];
        const float nr = ar[sh] - 1.0f, ni = ai[sh], den = 1.0f / (lre * lre + lim * lim);
        const float cr = (nr * lre + ni * lim) * den, ci = (ni * lre - nr * lim) * den;
#pragma unroll
        for (int s2 = 0; s2 < 2; ++s2) {
            const f32x4 Br = *(const f32x4*)(sp.b_re + ((size_t)dg * 64 + p) * 16 + 8 * s2 + 4 * hh), Bi = *(const f32x4*)(sp.b_im + ((size_t)dg * 64 + p) * 16 + 8 * s2 + 4 * hh);
            const f32x4 re = Br * cr - Bi * ci, im = Bi * cr + Br * ci;
            v2u pr, pi; pr.x = pkbf(re[0], re[1]); pr.y = pkbf(re[2], re[3]); pi.x = pkbf(im[0], im[1]); pi.y = pkbf(im[2], im[3]);
            bfr[sh][s2] = __builtin_bit_cast(bf16x4_t, pr); bfr[2 + sh][s2] = __builtin_bit_cast(bf16x4_t, pi);
        }
    }
    bf16x4_t cfr[16];
    {
#pragma unroll
        for (int s = 0; s < 16; ++s) {
            const int mp_ = 2 * s + hh; f32x4 cv = {0.f, 0.f, 0.f, 0.f};
            if (m32 < 16) { const float* cre = sp.c_re + ((size_t)dg * 16 + m32) * 64 + mp_; const float* cim = sp.c_im + ((size_t)dg * 16 + m32) * 64 + mp_;
                cv[0] = cre[0]; cv[1] = cre[32]; cv[2] = -cim[0]; cv[3] = -cim[32]; }
            v2u pc; pc.x = pkbf(cv[0], cv[1]); pc.y = pkbf(cv[2], cv[3]); cfr[s] = __builtin_bit_cast(bf16x4_t, pc);
        }
    }
#define S5U(x) __builtin_bit_cast(unsigned, (x))
        v4u q;
        q.x = S5U(ar[0]); q.y = S5U(ar[1]); q.z = S5U(ai[0]); q.w = S5U(ai[1]); *(v4u*)(par + (0 * 64 + lane) * 4) = q;
        q.x = S5U(a2r[0]); q.y = S5U(a2r[1]); q.z = S5U(a2i[0]); q.w = S5U(a2i[1]); *(v4u*)(par + (1 * 64 + lane) * 4) = q;
        q.x = S5U(a3r[0]); q.y = S5U(a3r[1]); q.z = S5U(a3i[0]); q.w = S5U(a3i[1]); *(v4u*)(par + (2 * 64 + lane) * 4) = q;
        q.x = S5U(a4r[0]); q.y = S5U(a4r[1]); q.z = S5U(a4i[0]); q.w = S5U(a4i[1]); *(v4u*)(par + (3 * 64 + lane) * 4) = q;
#undef S5U
#pragma unroll
        for (int i = 0; i < 4; ++i) { const v2u lo = __builtin_bit_cast(v2u, bfr[i][0]), hi = __builtin_bit_cast(v2u, bfr[i][1]); q.x = lo.x; q.y = lo.y; q.z = hi.x; q.w = hi.y; *(v4u*)(par + ((4 + i) * 64 + lane) * 4) = q; }
#pragma unroll
        for (int k = 0; k < 8; ++k) { const v2u lo = __builtin_bit_cast(v2u, cfr[2 * k]), hi = __builtin_bit_cast(v2u, cfr[2 * k + 1]); q.x = lo.x; q.y = lo.y; q.z = hi.x; q.w = hi.y; *(v4u*)(par + ((8 + k) * 64 + lane) * 4) = q; }
    }
}
struct S5U { v2u u[2][2]; };
__device__ __forceinline__ void s5_load_u(S5U& U, const bf16* P, int b, int g, int sg, int lane) {
    const int m32 = lane & 31, hh = lane >> 5, row0 = seg_row0(b, sg);
#pragma unroll
    for (int ch = 0; ch < 2; ++ch) { const bf16* urow = P + (size_t)((row0 + 32 * ch + m32) >> 2) * P4G + P4S5 + (m32 & 3) * 256 + g * 16 + 4 * hh;
        U.u[ch][0] = *(const v2u*)urow; U.u[ch][1] = *(const v2u*)(urow + 8); }
}
template <int MODE, int DIR>
__device__ __forceinline__ void s5_mm_dir(const S5P& sp, const S5U& U, int b, int g, int sg, int lane, float& hre, float& him, LAS float* yf, LAS unsigned char* hs, bf16* Z) {
    const int m32 = lane & 31, hh = lane >> 5, dg = DIR * 16 + g, row0 = seg_row0(b, sg);
    float ar[2], ai[2], a2r[2], a2i[2], a3r[2], a3i[2], a4r[2], a4i[2];
    bf16x4_t bfr[4][2];
    bf16x4_t cfr[16];
    {
        const unsigned* par = sp.par + (size_t)dg * 4096;
        v4u pq[16];
#pragma unroll
        for (int q = 0; q < ((MODE != 0) ? 16 : 8); ++q) pq[q] = GLD(v4u, par + q * 256, 16u * (unsigned)lane);
#define S5F(x) u2f_(x)
        ar[0] = S5F(pq[0].x); ar[1] = S5F(pq[0].y); ai[0] = S5F(pq[0].z); ai[1] = S5F(pq[0].w);
        a2r[0] = S5F(pq[1].x); a2r[1] = S5F(pq[1].y); a2i[0] = S5F(pq[1].z); a2i[1] = S5F(pq[1].w);
        a3r[0] = S5F(pq[2].x); a3r[1] = S5F(pq[2].y); a3i[0] = S5F(pq[2].z); a3i[1] = S5F(pq[2].w);
        a4r[0] = S5F(pq[3].x); a4r[1] = S5F(pq[3].y); a4i[0] = S5F(pq[3].z); a4i[1] = S5F(pq[3].w);
#undef S5F
#pragma unroll
        for (int i = 0; i < 4; ++i) { v2u lo, hi; lo.x = pq[4 + i].x; lo.y = pq[4 + i].y; hi.x = pq[4 + i].z; hi.y = pq[4 + i].w; bfr[i][0] = __builtin_bit_cast(bf16x4_t, lo); bfr[i][1] = __builtin_bit_cast(bf16x4_t, hi); }
        if (MODE != 0) {
#pragma unroll
            for (int k = 0; k < 8; ++k) { v2u lo, hi; lo.x = pq[8 + k].x; lo.y = pq[8 + k].y; hi.x = pq[8 + k].z; hi.y = pq[8 + k].w; cfr[2 * k] = __builtin_bit_cast(bf16x4_t, lo); cfr[2 * k + 1] = __builtin_bit_cast(bf16x4_t, hi); }
        }
    }
    const float ddv = (MODE == 2 && m32 < 16) ? sp.dd[g * 16 + m32] : 0.f;
    float hr[2], hi[2];
    hr[0] = __shfl(hre, m32); hi[0] = __shfl(him, m32); hr[1] = __shfl(hre, m32 + 32); hi[1] = __shfl(him, m32 + 32);
#pragma unroll 1
    for (int ci2 = 0; ci2 < 2; ++ci2) {
        const int ch = DIR ? 1 - ci2 : ci2, rowc = row0 + 32 * ch;
        const v2u x0 = ch ? U.u[1][0] : U.u[0][0], x1 = ch ? U.u[1][1] : U.u[0][1];
        const bf16x4_t ua0 = __builtin_bit_cast(bf16x4_t, x0), ua1 = __builtin_bit_cast(bf16x4_t, x1);
        if (MODE == 2) { *(LAS v2u*)(hs + 13312 + m32 * 32 + 8 * hh) = x0; *(LAS v2u*)(hs + 13312 + m32 * 32 + 16 + 8 * hh) = x1; }
        f32x16 BU[4];
#pragma unroll
        for (int nt = 0; nt < 4; ++nt) {
#pragma unroll
            for (int r = 0; r < 16; ++r) BU[nt][r] = 0.f;
            BU[nt] = MFMA8(ua0, bfr[nt][0], BU[nt]); BU[nt] = MFMA8(ua1, bfr[nt][1], BU[nt]);
        }
#pragma unroll
        for (int sh = 0; sh < 2; ++sh)
#pragma unroll
            for (int gg = 0; gg < 4; ++gg)
#pragma unroll
                for (int jj = 1; jj < 4; ++jj) {
                    const int r = DIR ? 4 * gg + 3 - jj : 4 * gg + jj, rp = DIR ? r + 1 : r - 1;
                    const float pr = BU[sh][rp], pi = BU[2 + sh][rp];
                    BU[sh][r] += ar[sh] * pr - ai[sh] * pi; BU[2 + sh][r] += ar[sh] * pi + ai[sh] * pr;
                }
        float hnr[2][4], hni[2][4];
        {
            float elr[2][4], eli[2][4], ehr[2][4], ehi[2][4];
#pragma unroll
            for (int sh = 0; sh < 2; ++sh)
#pragma unroll
                for (int gg = 0; gg < 4; ++gg) { const int rl = DIR ? 4 * gg : 4 * gg + 3;
                    const unsigned vr = f2u_(BU[sh][rl]), vi = f2u_(BU[2 + sh][rl]);
                    const auto sr = __builtin_amdgcn_permlane32_swap(vr, vr, false, false), si = __builtin_amdgcn_permlane32_swap(vi, vi, false, false);
                    elr[sh][gg] = u2f_((unsigned)sr[0]); ehr[sh][gg] = u2f_((unsigned)sr[1]); eli[sh][gg] = u2f_((unsigned)si[0]); ehi[sh][gg] = u2f_((unsigned)si[1]); }
            float tr[2], ti[2];
#pragma unroll
            for (int st = 0; st < 8; ++st) {
                const int grp = DIR ? 7 - st : st, gg = grp >> 1, half = grp & 1;
#pragma unroll
                for (int sh = 0; sh < 2; ++sh) {
                    if (half == (DIR ? 1 : 0)) { tr[sh] = hr[sh]; ti[sh] = hi[sh]; }
                    else { hnr[sh][gg] = (hh == half) ? hr[sh] : tr[sh]; hni[sh][gg] = (hh == half) ? hi[sh] : ti[sh]; }
                    const float er = half ? ehr[sh][gg] : elr[sh][gg], ei = half ? ehi[sh][gg] : eli[sh][gg];
                    const float nr = er + a4r[sh] * hr[sh] - a4i[sh] * hi[sh], ni = ei + a4r[sh] * hi[sh] + a4i[sh] * hr[sh];
                    hr[sh] = nr; hi[sh] = ni;
                }
            }
        }
        if (MODE != 0) {
#pragma unroll
            for (int sh = 0; sh < 2; ++sh)
#pragma unroll
                for (int gg = 0; gg < 4; ++gg)
#pragma unroll
                    for (int jj = 0; jj < 4; ++jj) {
                        const int pw = DIR ? 4 - jj : jj + 1;
                        const float pr = (pw == 1) ? ar[sh] : (pw == 2) ? a2r[sh] : (pw == 3) ? a3r[sh] : a4r[sh], pi = (pw == 1) ? ai[sh] : (pw == 2) ? a2i[sh] : (pw == 3) ? a3i[sh] : a4i[sh];
                        BU[sh][4 * gg + jj] += pr * hnr[sh][gg] - pi * hni[sh][gg]; BU[2 + sh][4 * gg + jj] += pr * hni[sh][gg] + pi * hnr[sh][gg];
                    }
#pragma unroll
            for (int r = 0; r < 16; ++r) { v2u w; w.x = pkbf(BU[0][r], BU[1][r]); w.y = pkbf(BU[2][r], BU[3][r]);
                *(LAS v2u*)(hs + ((r & 3) + 8 * (r >> 2) + 4 * hh) * 272 + m32 * 8) = w; }
            f32x16 Yv, Yw;
#pragma unroll
            for (int r = 0; r < 16; ++r) { Yv[r] = 0.f; Yw[r] = 0.f; }
#pragma unroll
            for (int s = 0; s < 16; s += 2) { Yv = MFMA8(ld4(hs + m32 * 272 + (8 * s + 4 * hh) * 2), cfr[s], Yv); Yw = MFMA8(ld4(hs + m32 * 272 + (8 * s + 8 + 4 * hh) * 2), cfr[s + 1], Yw); }
#pragma unroll
            for (int r = 0; r < 16; ++r) Yv[r] += Yw[r];
            if (m32 < 16) {
#pragma unroll
                for (int r = 0; r < 16; ++r) {
                    const int tl = (r & 3) + 8 * (r >> 2) + 4 * hh;
                    if (MODE == 1) yf[(32 * ch + tl) * 16 + m32] = Yv[r];
                    else { const float u = bf2f(*(const LAS unsigned short*)(hs + 13312 + tl * 32 + m32 * 2));
                        const float y = Yv[r] + yf[(32 * ch + tl) * 16 + m32] + ddv * u;
                        const float zz = gelu_tanh(y); Z[(size_t)(rowc + tl) * 256 + g * 16 + m32] = (bf16)pkbf(zz, zz); }
                }
            }
        }
    }
    hre = hh ? hr[1] : hr[0]; him = hh ? hi[1] : hi[0];
}
template <int MODE>
__device__ __forceinline__ void s5_mm(const S5P& sp, const S5U& U, int b, int g, int dir, int sg, int lane, float& hre, float& him, LAS float* yf, LAS unsigned char* hs, bf16* Z) {
    if (dir) s5_mm_dir<MODE, 1>(sp, U, b, g, sg, lane, hre, him, yf, hs, Z); else s5_mm_dir<MODE, 0>(sp, U, b, g, sg, lane, hre, him, yf, hs, Z);
}
template <int MIX, int DIR, bool WITH_O>
__device__ __forceinline__ void mx_chunk(LAS unsigned char* wl, int lane, float Pl, f32x16 (&ST)[(MIX == 2) ? 1 : 2][2], f32x16 (&O)[2]) {
    constexpr int DK = (MIX == 2) ? 32 : 64, NRT = DK / 32;
    const int m32 = lane & 31, hh = lane >> 5;
    asm volatile("" ::: "memory");
    if (lane < DK) *(LAS float*)(wl + WL_PL + lane * 4) = Pl;
    asm volatile("" ::: "memory");
    if (WITH_O) {
        f32x16 x;
#pragma unroll
        for (int r = 0; r < 16; ++r) x[r] = 0.f;
#pragma unroll
        for (int s = 0; s < DK / 8; ++s) {
            const bf16x4_t ka = ld4(wl + WL_KC + m32 * 144 + (8 * s + 4 * hh) * 2);
            const bf16x4_t qb = ld4(wl + WL_QC + m32 * 144 + (8 * s + 4 * hh) * 2);
            x = MFMA8(ka, qb, x);
        }
#pragma unroll
        for (int r = 0; r < 16; ++r) { const int j = (r & 3) + 8 * (r >> 2) + 4 * hh; const bool keep = DIR ? (j >= m32) : (j <= m32); x[r] = keep ? x[r] : 0.f; }
#pragma unroll
        for (int t = 0; t < 2; ++t)
#pragma unroll
            for (int r = 0; r < 16; ++r) O[t][r] = 0.f;
#pragma unroll
        for (int s = 0; s < 4; ++s) {
            const bf16x4_t xa = pack4(x, s);
#pragma unroll
            for (int t = 0; t < 2; ++t) O[t] = MFMA8(ld4(wl + WL_VT + (32 * t + m32) * 80 + (8 * s + 4 * hh) * 2), xa, O[t]);
        }
#pragma unroll
        for (int rt = 0; rt < NRT; ++rt)
#pragma unroll
            for (int s = 0; s < 4; ++s) {
                const bf16x4_t qa = ld4(wl + WL_QC + m32 * 144 + (32 * rt + 8 * s + 4 * hh) * 2);
#pragma unroll
                for (int t = 0; t < 2; ++t) O[t] = MFMA8(pack4(ST[rt][t], s), qa, O[t]);
            }
    }
    {
        v4u kk4[NRT][2], vv4[2][2];
#pragma unroll
        for (int p2 = 0; p2 < 2; ++p2) {
#pragma unroll
            for (int rt = 0; rt < NRT; ++rt) kk4[rt][p2] = *(const LAS v4u*)(wl + WL_KT + (32 * rt + m32) * 80 + (16 * p2 + 8 * hh) * 2);
#pragma unroll
            for (int t = 0; t < 2; ++t) vv4[t][p2] = *(const LAS v4u*)(wl + WL_VT + (32 * t + m32) * 80 + (16 * p2 + 8 * hh) * 2);
        }
#pragma unroll
        for (int p2 = 0; p2 < 2; ++p2)
#pragma unroll
            for (int e = 0; e < 2; ++e)
#pragma unroll
                for (int rt = 0; rt < NRT; ++rt) { v2u ku; ku.x = e ? kk4[rt][p2].z : kk4[rt][p2].x; ku.y = e ? kk4[rt][p2].w : kk4[rt][p2].y; const bf16x4_t ka = __builtin_bit_cast(bf16x4_t, ku);
#pragma unroll
                    for (int t = 0; t < 2; ++t) { v2u vu; vu.x = e ? vv4[t][p2].z : vv4[t][p2].x; vu.y = e ? vv4[t][p2].w : vv4[t][p2].y; ST[rt][t] = MFMA8(ka, __builtin_bit_cast(bf16x4_t, vu), ST[rt][t]); } }
    }
#pragma unroll
    for (int rt = 0; rt < NRT; ++rt)
#pragma unroll
        for (int g = 0; g < 4; ++g) {
            const f32x4 pl4 = *(const LAS f32x4*)(wl + WL_PL + (32 * rt + 8 * g + 4 * hh) * 4);
#pragma unroll
            for (int e = 0; e < 4; ++e) { ST[rt][0][4 * g + e] *= pl4[e]; ST[rt][1][4 * g + e] *= pl4[e]; }
        }
}
__device__ __forceinline__ float half_sum(float v) {
#pragma unroll
    for (int o = 1; o < 32; o <<= 1) v += __shfl_xor(v, o);
    return v;
}
template <int MIX, int DIR>
__device__ __forceinline__ void mixA_stream(const MixP& mp, const MxC& c, int row0, int tpos0, int lane, LAS unsigned char* wl, f32x16 (&ST)[(MIX == 2) ? 1 : 2][2], float& Gam) {
    f32x16 O[2];
    MxRaw r[8];
#pragma unroll
    for (int i = 0; i < 8; ++i) mx_load<MIX, false, DIR>(r[i], mp, c, row0, i);
    float rc = 1.0f, rs = 0.0f;
    if (MIX == 0 && tpos0 >= 0) { const int tpos = tpos0 + (DIR ? 63 : 0); const int pos = (lane & 32) ? (tpos & 63) : (tpos >> 6);
        const unsigned ro = 4u * (unsigned)(pos * 16 + (lane & 15)); rc = GLD(float, mp.rcos, ro); rs = GLD(float, mp.rsin, ro); }
    float P = 1.0f;
#pragma unroll 1
    for (int cki = 0; cki < 2; ++cki) {
        int ck = cki; asm volatile("" : "+s"(ck));
        int ln = lane; asm volatile("" : "+v"(ln));
#pragma unroll
        for (int j = 0; j < 8; ++j) {
            mx_batch<MIX, false, DIR>(r[j], mp, c, tpos0, ln, wl, j, P, rc, rs);
            if (ck == 0) mx_load<MIX, false, DIR>(r[j], mp, c, row0, 8 + j);
        }
        Gam *= P; mx_chunk<MIX, 0, false>(wl, ln, P, ST, O); P = 1.0f;
    }
}
template <int MIX>
__device__ __forceinline__ void mixA_unit(const MixP& mp, float* STG, int idx, int lane_in, LAS unsigned char* wl) {
    int lane = lane_in;
    constexpr int DK = (MIX == 2) ? 32 : 64, NRT = DK / 32;
    const int dir = idx / 2112, rem = idx - dir * 2112, bh = rem / NSEG, sg = rem - bh * NSEG, b = bh >> 2, h = bh & 3;
    asm volatile("" : "+v"(lane));
    MxC c; mx_consts<MIX>(c, mp, h, dir, lane);
    f32x16 ST[NRT][2];
#pragma unroll
    for (int rt = 0; rt < NRT; ++rt)
#pragma unroll
        for (int t = 0; t < 2; ++t)
#pragma unroll
            for (int r = 0; r < 16; ++r) ST[rt][t][r] = 0.f;
    const int row0 = seg_row0(b, sg), tpos0 = seg_tpos0(sg);
    float Gam = 1.0f;
    if (dir) mixA_stream<MIX, 1>(mp, c, row0, tpos0, lane, wl, ST, Gam); else mixA_stream<MIX, 0>(mp, c, row0, tpos0, lane, wl, ST, Gam);
    const size_t slot = (size_t)((dir * 16 + bh) * NSEG + sg);
    bf16* ds = (bf16*)(STG + (MIX == 0 ? ST_DS0 : (MIX == 1 ? ST_DS1 : ST_DS2))) + slot * (DK * 64);
    const int m32 = lane & 31, hh = lane >> 5;
#pragma unroll
    for (int rt = 0; rt < NRT; ++rt)
#pragma unroll
        for (int t = 0; t < 2; ++t)
#pragma unroll
            for (int r4 = 0; r4 < 4; ++r4) { v2u v; v.x = pkbf(ST[rt][t][4 * r4], ST[rt][t][4 * r4 + 1]); v.y = pkbf(ST[rt][t][4 * r4 + 2], ST[rt][t][4 * r4 + 3]);
                GST(v2u, ds + ((rt * 2 + t) * 4 + r4) * 256, 8u * (unsigned)lane) = v; }
    float* gs = STG + (MIX == 0 ? ST_G0 : (MIX == 1 ? ST_G1 : ST_G2)) + slot * 64;
    GST(float, gs, 4u * (unsigned)lane) = Gam;
}
__device__ __forceinline__ void mx_epi_gates(const MixP& mp, int lane, int rowc, int gcol, v2u (&g)[2][4]) {
    const int m32 = lane & 31, hh = lane >> 5;
    const bf16* gb = mp.P + (size_t)(rowc >> 2) * P4G + gcol;
    const unsigned gvo = 2u * (unsigned)((m32 >> 2) * P4G + (m32 & 3) * 256 + 4 * hh);
#pragma unroll
    for (int t = 0; t < 2; ++t)
#pragma unroll
        for (int s = 0; s < 4; ++s) g[t][s] = GLD(v2u, gb + 32 * t + 8 * s, gvo);
}
__device__ __forceinline__ void mx_epi_of(int lane, const float* OFc, v2u (&of)[2][4]) {
#pragma unroll
    for (int t = 0; t < 2; ++t)
#pragma unroll
        for (int s = 0; s < 4; ++s) of[t][s] = GLD(v2u, (const bf16*)OFc + (t * 4 + s) * 256, 8u * (unsigned)lane);
}
template <int MIX, int MODE>
__device__ __forceinline__ void mx_epilogue(const MixP& mp, LAS unsigned char* wl, int lane, f32x16 (&O)[2], int rowc, float* OFc, bf16* Y, int ycol, const v2u (&g)[2][4], const v2u (&of)[2][4]) {
    const int m32 = lane & 31, hh = lane >> 5;
    if (MODE == 1) {
#pragma unroll
        for (int t = 0; t < 2; ++t)
#pragma unroll
            for (int s = 0; s < 4; ++s) { v2u v; v.x = pkbf(O[t][4 * s], O[t][4 * s + 1]); v.y = pkbf(O[t][4 * s + 2], O[t][4 * s + 3]); GST(v2u, (bf16*)OFc + (t * 4 + s) * 256, 8u * (unsigned)lane) = v; }
    } else {
#pragma unroll
        for (int t = 0; t < 2; ++t)
#pragma unroll
            for (int s = 0; s < 4; ++s)
#pragma unroll
                for (int j = 0; j < 4; ++j) O[t][4 * s + j] += bfx(of[t][s], j);
        float mean = 0.f;
        if (MIX == 0) { float sm = 0.f;
#pragma unroll
            for (int t = 0; t < 2; ++t)
#pragma unroll
                for (int r = 0; r < 16; ++r) sm += O[t][r];
            sm += __shfl_xor(sm, 32); mean = sm * (1.0f / 64.0f); }
        float ss = 0.f;
#pragma unroll
        for (int t = 0; t < 2; ++t)
#pragma unroll
            for (int r = 0; r < 16; ++r) { const float d = O[t][r] - mean; ss = fmaf(d, d, ss); }
        ss += __shfl_xor(ss, 32);
        const float rs = __builtin_amdgcn_rsqf(ss * (1.0f / 64.0f) + NEPS), mo = -mean * rs;
        asm volatile("" ::: "memory");
#pragma unroll
        for (int t = 0; t < 2; ++t)
#pragma unroll
            for (int s = 0; s < 4; ++s) { float y[4];
#pragma unroll
                for (int j = 0; j < 4; ++j) y[j] = fmaf(O[t][4 * s + j], rs, mo) * silu_f(bfx(g[t][s], j));
                v2u w; w.x = pkbf(y[0], y[1]); w.y = pkbf(y[2], y[3]);
                *(LAS v2u*)(wl + WL_QC + m32 * 144 + (32 * t + 8 * s + 4 * hh) * 2) = w; }
        asm volatile("" ::: "memory");
#pragma unroll
        for (int k = 0; k < 4; ++k) { const v4u w = *(const LAS v4u*)(wl + WL_QC + ((lane >> 3) + 8 * k) * 144 + (lane & 7) * 16);
            GST(v4u, Y + (size_t)(rowc + 8 * k) * 1024 + ycol, 2u * (unsigned)((lane >> 3) * 1024 + (lane & 7) * 8)) = w; }
        asm volatile("" ::: "memory");
    }
}
template <int MIX, int DIR>
__device__ __forceinline__ void mixC_stream(const MixP& mp, const MxC& c, int row0, int tpos0, int lane, LAS unsigned char* wl, f32x16 (&ST)[(MIX == 2) ? 1 : 2][2],
                                            const bf16* ds, float* OFu, bf16* Y, int ycol, int gcol) {
    f32x16 O[2];
    MxRaw r[4];
#pragma unroll
    for (int i = 0; i < 3; ++i) mx_load<MIX, true, DIR>(r[i], mp, c, row0, i);
    {
#pragma unroll
        for (int rt = 0; rt < ((MIX == 2) ? 1 : 2); ++rt)
#pragma unroll
            for (int t = 0; t < 2; ++t)
#pragma unroll
                for (int r4 = 0; r4 < 4; ++r4) { const v2u v = GLD(v2u, ds + ((rt * 2 + t) * 4 + r4) * 256, 8u * (unsigned)lane);
                    ST[rt][t][4 * r4] = bfx(v, 0); ST[rt][t][4 * r4 + 1] = bfx(v, 1); ST[rt][t][4 * r4 + 2] = bfx(v, 2); ST[rt][t][4 * r4 + 3] = bfx(v, 3); }
    }
    float rc = 1.0f, rs = 0.0f;
    if (MIX == 0 && tpos0 >= 0) { const int tpos = tpos0 + (DIR ? 63 : 0); const int pos = (lane & 32) ? (tpos & 63) : (tpos >> 6);
        const unsigned ro = 4u * (unsigned)(pos * 16 + (lane & 15)); rc = GLD(float, mp.rcos, ro); rs = GLD(float, mp.rsin, ro); }
    float P = 1.0f;
#pragma unroll 1
    for (int b4i = 0; b4i < 16; b4i += 4) {
        int b4 = b4i; asm volatile("" : "+s"(b4));
        int ln = lane; asm volatile("" : "+v"(ln));
#pragma unroll
        for (int j = 0; j < 4; ++j) {
            if (b4 < 12 || j == 0) mx_load<MIX, true, DIR>(r[(j + 3) & 3], mp, c, row0, b4 + j + 3);
            mx_batch<MIX, true, DIR>(r[j], mp, c, tpos0, ln, wl, (b4 & 4) + j, P, rc, rs);
        }
        if (b4 & 4) {
            const int ck = b4 >> 3, ch = DIR ? 1 - ck : ck; float* OFc = OFu + (size_t)ch * (12 * 1024);
            v2u g[2][4], of[2][4];
            mx_chunk<MIX, DIR, true>(wl, ln, P, ST, O); P = 1.0f;
            if (DIR) { mx_epi_gates(mp, ln, row0 + 32 * ch, gcol, g); mx_epi_of(ln, OFc, of); }
            mx_epilogue<MIX, DIR ? 2 : 1>(mp, wl, ln, O, row0 + 32 * ch, OFc, Y, ycol, g, of);
        }
    }
}
template <int MIX>
__device__ __forceinline__ void mixC_unit(const MixP& mp, const float* STG, int idx, int lane_in, float* OF, LAS unsigned char* wl, bf16* Y) {
    int lane = lane_in; asm volatile("" : "+v"(lane));
    constexpr int DK = (MIX == 2) ? 32 : 64, NRT = DK / 32;
    const int bh = idx / NSEG, sg = idx - bh * NSEG, b = bh >> 2, h = bh & 3;
    const int row0 = seg_row0(b, sg), tpos0 = seg_tpos0(sg);
    const int ycol = ((MIX == 0) ? 0 : (MIX == 1 ? 512 : 768)) + h * 64;
    const int gcol = 4 * ((MIX == 0) ? C_RG : (MIX == 1 ? C_HG : C_GG)) + h * 64;
    float* OFu = OF + ((size_t)(row0 >> 5) * 12 + MIX * 4 + h) * 1024;
    const bf16* dsb = (const bf16*)(STG + (MIX == 0 ? ST_DS0 : (MIX == 1 ? ST_DS1 : ST_DS2)));
    f32x16 ST[NRT][2];
#pragma unroll 1
    for (int dir = 0; dir < 2; ++dir) {
        asm volatile("" : "+v"(lane));
        const int m32 = lane & 31, hh = lane >> 5;
        MxC c; mx_consts<MIX>(c, mp, h, dir, lane);
        const bf16* ds = dsb + (size_t)((dir * 16 + bh) * NSEG + sg) * (DK * 64);
        if (dir == 0) mixC_stream<MIX, 0>(mp, c, row0, tpos0, lane, wl, ST, ds, OFu, Y, ycol, gcol);
        else mixC_stream<MIX, 1>(mp, c, row0, tpos0, lane, wl, ST, ds, OFu, Y, ycol, gcol);
        asm volatile("s_waitcnt vmcnt(0)" ::: "memory");
    }
}
template <int MSEL>
__device__ __forceinline__ void mix_passA(const Frame& F, const Args& a, int l) {
    const MixP mp = make_mixp(F, a, l); const S5P sp = make_s5p(F, a, l);
    float* ST = (float*)(F.ws + WS_X2);
    LAS unsigned char* wl = F.lds + F.wave * WL_BYTES; LAS float* stg = (LAS float*)wl;
    if (MSEL == 15) {
        constexpr int NMX = 3 * 4224, NS5 = 2 * 64 * NSEG;
        const int heavy = NMX - (NMX / F.NGW) * F.NGW, nlight = F.NGW - heavy;
        const int n_all = (NS5 - 4 * nlight) / F.NGW;
        for (int it = 0; ; ++it) {
            int u;
            const int nmine = NMX / F.NGW + (F.gw < heavy ? 1 : 0);
            if (it < nmine) u = F.gw + it * F.NGW;
            else if (it < nmine + n_all) u = NMX + F.gw + (it - nmine) * F.NGW;
            else { const int k2 = it - nmine - n_all; if (F.gw < heavy || k2 >= 4) {
                    const int rest0 = NMX + n_all * F.NGW + 4 * nlight; const int uu = rest0 + F.gw + (k2 - (F.gw < heavy ? 0 : 4)) * F.NGW; if (uu >= NMX + NS5) break; u = uu; }
                else u = NMX + n_all * F.NGW + (F.gw - heavy) + k2 * nlight; }
            if (u >= NMX + NS5) break;
            if (u < 4224) mixA_unit<0>(mp, ST, u, fresh_lane(), wl);
            else if (u < 2 * 4224) mixA_unit<1>(mp, ST, u - 4224, fresh_lane(), wl);
            else if (u < 3 * 4224) mixA_unit<2>(mp, ST, u - 2 * 4224, fresh_lane(), wl);
            else { const int idx = u - 3 * 4224; const int dir = idx / (64 * NSEG), rem = idx - dir * 64 * NSEG, bg = rem / NSEG, sg = rem - bg * NSEG;
                float hre = 0.f, him = 0.f;
                S5U U; s5_load_u(U, mp.P, bg >> 4, bg & 15, sg, fresh_lane()); s5_mm<0>(sp, U, bg >> 4, bg & 15, dir, sg, fresh_lane(), hre, him, nullptr, wl, nullptr);
                float* hs = ST + ST_HS + ((size_t)((dir * 64 + bg) * NSEG + sg) * 64 + fresh_lane()) * 2;
                hs[0] = hre; hs[1] = him; }
        }
        return;
    }
    if (MSEL & 1) for (int u = F.gw; u < 4224; u += F.NGW) mixA_unit<0>(mp, ST, u, fresh_lane(), wl);
    if (MSEL & 2) for (int u = F.gw; u < 4224; u += F.NGW) mixA_unit<1>(mp, ST, u, fresh_lane(), wl);
    if (MSEL & 4) for (int u = F.gw; u < 4224; u += F.NGW) mixA_unit<2>(mp, ST, u, fresh_lane(), wl);
    if (MSEL & 8) for (int idx = F.gw; idx < 2 * 64 * NSEG; idx += F.NGW) {
        const int dir = idx / (64 * NSEG), rem = idx - dir * 64 * NSEG, bg = rem / NSEG, sg = rem - bg * NSEG;
        float hre = 0.f, him = 0.f;
        S5U U; s5_load_u(U, mp.P, bg >> 4, bg & 15, sg, fresh_lane()); s5_mm<0>(sp, U, bg >> 4, bg & 15, dir, sg, fresh_lane(), hre, him, nullptr, wl, nullptr);
        float* hs = ST + ST_HS + ((size_t)((dir * 64 + bg) * NSEG + sg) * 64 + fresh_lane()) * 2;
        hs[0] = hre; hs[1] = him;
    }
}
__device__ __forceinline__ int chain_seg(int dir, int p) { return dir ? (p < 4 ? 3 - p : 135 - p) : p; }
__device__ __forceinline__ void mix_passB(const Frame& F, const Args& a, int l) {
    float* ST = (float*)(F.ws + WS_X2);
    constexpr int N0 = 32768, N1 = 32768, N2 = 16384, N3 = 8192;
    for (int e = blockIdx.x * 512 + F.tid; e < N0 + N1 + N2 + N3; e += F.G * 512) {
        if (e < N0 + N1 + N2) {
            bf16* base; const float* gb; int dir, esz;
            if (e < N0 + N1) { const int mix = e >= N0, e2 = e - mix * N0, c = e2 >> 10, el = (e2 & 1023) * 4; dir = c >> 4; esz = 4096;
                base = (bf16*)(ST + (mix ? ST_DS1 : ST_DS0)) + (size_t)c * NSEG * 4096 + el; gb = ST + (mix ? ST_G1 : ST_G0) + (size_t)c * NSEG * 64 + 32 * (el >> 11) + 8 * ((el >> 8) & 3) + 4 * ((el >> 7) & 1); }
            else { const int e2 = e - N0 - N1, c = e2 >> 9, el = (e2 & 511) * 4; dir = c >> 4; esz = 2048;
                base = (bf16*)(ST + ST_DS2) + (size_t)c * NSEG * 2048 + el; gb = ST + ST_G2 + (size_t)c * NSEG * 64 + 8 * ((el >> 8) & 3) + 4 * ((el >> 7) & 1); }
            f32x4 run = {0.f, 0.f, 0.f, 0.f};
#pragma unroll 1
            for (int p0 = 0; p0 < NSEG; p0 += 12) {
                f32x4 d[12], gm[12];
#pragma unroll
                for (int q = 0; q < 12; ++q) { const int sg = chain_seg(dir, p0 + q); const v2u w = *(const v2u*)(base + (size_t)sg * esz); d[q] = (f32x4){bfx(w, 0), bfx(w, 1), bfx(w, 2), bfx(w, 3)}; gm[q] = *(const f32x4*)(gb + sg * 64); }
#pragma unroll
                for (int q = 0; q < 12; ++q) { const int sg = chain_seg(dir, p0 + q); v2u w; w.x = pkbf(run[0], run[1]); w.y = pkbf(run[2], run[3]); *(v2u*)(base + (size_t)sg * esz) = w; run = run * gm[q] + d[q]; }
            }
        } else {
            const int e2 = e - N0 - N1 - N2, c = e2 >> 6, p = e2 & 63, dir = c >> 6, g = c & 15;
            const int dg = dir * 16 + g;
            const float lre = a.in[F.zz + I_LAMRE][(size_t)l * 2048 + dg * 64 + p], lim = a.in[F.zz + I_LAMIM][(size_t)l * 2048 + dg * 64 + p], dt = expf(a.in[F.zz + I_LOGDT][l * 32 + dg]);
            const float er = expf(lre * dt * 64.0f); const float sn = sinf(lim * dt * 64.0f), cs = cosf(lim * dt * 64.0f);
            const float ar = er * cs, ai = er * sn;
            float* base = ST + ST_HS + ((size_t)c * NSEG * 64 + p) * 2;
            float rr = 0.f, ri = 0.f;
#pragma unroll 1
            for (int q0 = 0; q0 < NSEG; q0 += 12) {
                float dr[12], di[12];
#pragma unroll
                for (int q = 0; q < 12; ++q) { const int sg = chain_seg(dir, q0 + q); dr[q] = base[(size_t)sg * 128]; di[q] = base[(size_t)sg * 128 + 1]; }
#pragma unroll
                for (int q = 0; q < 12; ++q) { const int sg = chain_seg(dir, q0 + q); base[(size_t)sg * 128] = rr; base[(size_t)sg * 128 + 1] = ri;
                    const float nr = ar * rr - ai * ri + dr[q], ni = ar * ri + ai * rr + di[q]; rr = nr; ri = ni; }
            }
        }
    }
}
template <int MSEL>
__device__ __forceinline__ void mix_passC(const Frame& F, const Args& a, int l) {
    const MixP mp = make_mixp(F, a, l); const S5P sp = make_s5p(F, a, l);
    const float* ST = (const float*)(F.ws + WS_X2);
    LAS unsigned char* wl = F.lds + F.wave * WL_BYTES;
    LAS float* stg = (LAS float*)wl; LAS float* of = (LAS float*)(wl + 9216);
    float* OF = (float*)(F.ws + WS_OF);
    bf16* Y = (bf16*)(F.ws + WS_ACT); bf16* Z = (bf16*)(F.ws + WS_Z);
    const bool keep = l < DEPTH - 1;
    constexpr int NM = 16 * NSEG;
    if (MSEL == 15) {
        constexpr int NMX = 3 * NM, NS5 = 64 * NSEG;
        const int heavy = NMX - (NMX / F.NGW) * F.NGW, nlight = F.NGW - heavy;
        for (int it = 0; ; ++it) {
            int u;
            const int nmine = NMX / F.NGW + (F.gw < heavy ? 1 : 0);
            if (it < nmine) u = F.gw + it * F.NGW;
            else { if (F.gw < heavy) break; u = NMX + (F.gw - heavy) + (it - nmine) * nlight; }
            if (u >= NMX + NS5) break;
            const int sgu = (u < 3 * NM) ? (u % NSEG) : ((u - 3 * NM) % NSEG);
            if (!keep && sgu < 4) continue;
            if (u < NM) mixC_unit<0>(mp, ST, u, fresh_lane(), OF, wl, Y);
            else if (u < 2 * NM) mixC_unit<1>(mp, ST, u - NM, fresh_lane(), OF, wl, Y);
            else if (u < 3 * NM) mixC_unit<2>(mp, ST, u - 2 * NM, fresh_lane(), OF, wl, Y);
            else { const int idx = u - 3 * NM, bg = idx / NSEG, sg = idx - bg * NSEG;
                S5U U; s5_load_u(U, mp.P, bg >> 4, bg & 15, sg, fresh_lane());
                const float* h0 = ST + ST_HS + ((size_t)((0 * 64 + bg) * NSEG + sg) * 64 + fresh_lane()) * 2;
                float hre = h0[0], him = h0[1];
                s5_mm<1>(sp, U, bg >> 4, bg & 15, 0, sg, fresh_lane(), hre, him, of, wl, Z);
                const float* h1 = ST + ST_HS + ((size_t)((1 * 64 + bg) * NSEG + sg) * 64 + fresh_lane()) * 2;
                hre = h1[0]; him = h1[1];
                s5_mm<2>(sp, U, bg >> 4, bg & 15, 1, sg, fresh_lane(), hre, him, of, wl, Z); }
        }
        return;
    }
    if (MSEL & 1) for (int u = F.gw; u < NM; u += F.NGW) { if (!keep && (u % NSEG) < 4) continue; mixC_unit<0>(mp, ST, u, fresh_lane(), OF, wl, Y); }
    if (MSEL & 2) for (int u = F.gw; u < NM; u += F.NGW) { if (!keep && (u % NSEG) < 4) continue; mixC_unit<1>(mp, ST, u, fresh_lane(), OF, wl, Y); }
    if (MSEL & 4) for (int u = F.gw; u < NM; u += F.NGW) { if (!keep && (u % NSEG) < 4) continue; mixC_unit<2>(mp, ST, u, fresh_lane(), OF, wl, Y); }
    if (MSEL & 8) for (int idx = F.gw; idx < 64 * NSEG; idx += F.NGW) {
        const int bg = idx / NSEG, sg = idx - bg * NSEG;
        if (!keep && sg < 4) continue;
        S5U U; s5_load_u(U, mp.P, bg >> 4, bg & 15, sg, fresh_lane());
        const float* h0 = ST + ST_HS + ((size_t)((0 * 64 + bg) * NSEG + sg) * 64 + fresh_lane()) * 2;
        float hre = h0[0], him = h0[1];
        s5_mm<1>(sp, U, bg >> 4, bg & 15, 0, sg, fresh_lane(), hre, him, of, wl, Z);
        const float* h1 = ST + ST_HS + ((size_t)((1 * 64 + bg) * NSEG + sg) * 64 + fresh_lane()) * 2;
        hre = h1[0]; him = h1[1];
        s5_mm<2>(sp, U, bg >> 4, bg & 15, 1, sg, fresh_lane(), hre, him, of, wl, Z);
    }
}

constexpr int NPH = 11;
template <int PH_MASK, int MSEL>
__global__ void __launch_bounds__(512, 2) mk_fwd(Args a) {
    extern __shared__ __attribute__((aligned(16))) unsigned char lds_raw[];
    Frame F;
    F.lds = (LAS unsigned char*)lds_raw;
    const int wave0 = __builtin_amdgcn_readfirstlane((int)threadIdx.x >> 6);
    F.lane = fresh_lane(); F.tid = wave0 * 64 + F.lane; F.wave = wave0;
    F.G = gridDim.x; F.gw = blockIdx.x * 8 + F.wave; F.NGW = F.G * 8; F.zz = 0; F.ws = (unsigned char*)a.in[I_WS]; F.out = (float*)a.in[I_OUT];
    volatile LAS unsigned* MISC = (volatile LAS unsigned*)(F.lds + MISC_OFF);
    for (int u = F.tid; u < 64; u += 512) ((LAS unsigned*)(F.lds + MISC_OFF))[u] = 0u;
    __syncthreads();
    XcdBarrier bar; bar.bar = (unsigned*)F.ws + CW_BAR; bar.x = 0; bar.st = nullptr;
    if (a.fused) bar = xcd_barrier_post((unsigned*)F.ws + CW_BAR, MISC + 8, F.tid);
#define SEAM() do { if (a.fused) { XcdBarrier bb = bar; asm volatile("" : "+s"(bb.bar), "+s"(bb.x)); xcd_barrier(bb, wave0 * 64 + fresh_lane()); } } while (0)
#define PHASE_BEGIN() do { int zz_ = 0; asm volatile("" : "+s"(zz_)); F.zz = zz_; F.ws = (unsigned char*)a.in[I_WS + zz_]; F.out = (float*)a.in[I_OUT + zz_]; \
        const int ln_ = fresh_lane(); const int t_ = wave0 * 64 + ln_ + zz_; F.tid = t_; F.lane = t_ & 63; F.wave = wave0 + zz_; F.G = (int)gridDim.x + zz_; F.gw = ((int)blockIdx.x + zz_) * 8 + F.wave; F.NGW = F.G * 8; \
        F.lds = (LAS unsigned char*)lds_raw + zz_; } while (0)
#define IN(k) (((PH_MASK >> (k)) & 1) && a.ph_lo <= (k) && (k) < a.ph_hi)
#ifndef DUP_PH
#define DUP_PH 0
#endif
constexpr int TAILB = 16;
#define REP(k) for (int rep_ = 0; rep_ < (((DUP_PH >> (k)) & 1) ? 2 : 1); ++rep_)
#define XRB ((bf16*)(F.ws + WS_XR))
#define MOD ((const float*)(F.ws + WS_MOD))
#define ACT ((bf16*)(F.ws + WS_ACT))
#define PH ((bf16*)(F.ws + WS_PH))

    if (((PH_MASK >> 12) & 1) && a.do_pro) REP(12) { PHASE_BEGIN(); s5_build(F, a); prologue(F, a); SEAM(); }

#pragma unroll
    for (int l = 0; l < DEPTH; ++l) {
        if (l < a.l_lo || l >= a.l_hi) continue;
        const bool keep = l < DEPTH - 1, moe = l & 1; const int j = l >> 1;
        const int Mrows = keep ? MT : NLAT;
        if (IN(0)) { PHASE_BEGIN();
            if ((l & 1) && F.G > TAILB) {
                if ((int)blockIdx.x < TAILB) {
                    const int lp = l - 1, jp = lp >> 1;
                    int k8 = DFF / 2; asm volatile("" : "+s"(k8)); pg8::Gemm g{(const bf16*)((const unsigned char*)PH + (size_t)NLAT * DFF), (const bf16*)(F.ws + WS_W2D + (size_t)jp * 1024 * DFF), MT - NLAT, 1024, k8}; pg8::StaticOrder S; S.init(MT - NLAT, 1024, TAILB, (int)blockIdx.x);
                    EpiResid E{nullptr, nullptr, XRB, MOD + (size_t)lp * 5 * 6144 + 5 * 1024, 1.0f / WSC8, NLAT / 256};
                    pg8::gemm_phase_f8<EpiResid, pg8::StaticOrder, true, true>(F.lds, g, S, E, F.tid);
                    group_arrive((unsigned*)F.ws + CW_TAIL + (2 * l + 1) * 64, F.tid);
                } else {
                    moe_cvt_idle(F, a, j, TAILB);
                    norm_phase<0>(F, a, l, 0, NLAT, -1, 0, ((int)blockIdx.x - TAILB) * 8 + F.wave, (F.G - TAILB) * 8);
                }
                group_wait((unsigned*)F.ws + CW_BAR, (unsigned*)F.ws + CW_TAIL + (2 * l + 1) * 64, TAILB, F.tid);
                norm_phase<0>(F, a, l, 0, MT, -1, NLAT, F.gw, F.NGW);
            } else {
                if (l & 1) moe_cvt(F, a, j);
                if (l == 0) norm_phase<0, false>(F, a, l, 0, MT, -1); else norm_phase<0>(F, a, l, 0, MT, (l == 2) ? 1 : -1);
            }
            SEAM();
        }
        if (IN(1)) REP(1) { PHASE_BEGIN();
            pg8::Gemm g{ACT, (const bf16*)(F.ws + WS_WIN) + (size_t)l * DINP * 1024, MT, DINP, 1024}; pg8::StaticOrder S; S.init(MT, DINP, F.G, (int)blockIdx.x);
            EpiStoreP4 E{PH};
            pg8::gemm_phase<EpiStoreP4, pg8::StaticOrder, true, true>(F.lds, g, S, E, F.tid);
            SEAM();
        }
        if (IN(2)) { PHASE_BEGIN(); mix_passA<MSEL>(F, a, l); SEAM(); }
#ifdef DUP_MIX
        if (IN(2)) { PHASE_BEGIN(); mix_passA<DUP_MIX>(F, a, l); SEAM(); }
#endif
#ifdef DUP_A
        if (IN(2)) { PHASE_BEGIN(); mix_passA<DUP_A>(F, a, l); SEAM(); }
#endif
        if (IN(3)) { PHASE_BEGIN(); mix_passB(F, a, l); SEAM(); }
        if (IN(4)) { PHASE_BEGIN(); mix_passC<MSEL>(F, a, l); SEAM(); }
#ifdef DUP_MIX
        if (IN(4)) { PHASE_BEGIN(); mix_passC<DUP_MIX>(F, a, l); SEAM(); }
#endif
#ifdef DUP_C
        if (IN(4)) { PHASE_BEGIN(); mix_passC<DUP_C>(F, a, l); SEAM(); }
#endif
        if (IN(5)) REP(5) { PHASE_BEGIN();
            int k256 = 256; asm volatile("" : "+s"(k256)); pg8::Gemm g{(const bf16*)(F.ws + WS_Z), (const bf16*)(F.ws + WS_GLUW) + (size_t)l * 65536, Mrows, 256, k256}; pg8::StaticOrder S; S.init(Mrows, 256, F.G, (int)blockIdx.x);
            EpiGlu E{(const bf16*)(F.ws + WS_Z), ACT, a.in[F.zz + I_GLUB] + l * 256};
            pg8::gemm_phase<EpiGlu, pg8::StaticOrder, true, true>(F.lds, g, S, E, F.tid);
            SEAM();
        }
        const bool f1f8 = !moe && j == FP8_F1_J;
        const bool tail = keep && F.G > TAILB;
        if (IN(6)) { PHASE_BEGIN();
            const int Mg = tail ? NLAT : Mrows;
            pg8::Gemm g{ACT, (const bf16*)(F.ws + WS_WOUT) + (size_t)l * 1024 * 1024, Mg, 1024, 1024}; pg8::StaticOrder S; S.init(Mg, 1024, F.G, (int)blockIdx.x);
            EpiResid E{(l == 0) ? a.in[F.zz + I_X] : (const float*)nullptr, (l == 0) ? a.in[F.zz + I_CTX] : (const float*)nullptr, XRB, MOD + (size_t)l * 5 * 6144 + 2 * 1024, 1.0f, 0};
            pg8::gemm_phase<EpiResid, pg8::StaticOrder, true, true>(F.lds, g, S, E, F.tid);
            SEAM();
        }
        if (IN(7)) { PHASE_BEGIN();
            if (tail) {
                if ((int)blockIdx.x < TAILB) {
                    pg8::Gemm g{ACT + (size_t)NLAT * 1024, (const bf16*)(F.ws + WS_WOUT) + (size_t)l * 1024 * 1024, MT - NLAT, 1024, 1024}; pg8::StaticOrder S; S.init(MT - NLAT, 1024, TAILB, (int)blockIdx.x);
                    EpiResid E{(l == 0) ? a.in[F.zz + I_X] : (const float*)nullptr, (l == 0) ? a.in[F.zz + I_CTX] : (const float*)nullptr, XRB, MOD + (size_t)l * 5 * 6144 + 2 * 1024, 1.0f, NLAT / 256};
                    pg8::gemm_phase<EpiResid, pg8::StaticOrder, true, true>(F.lds, g, S, E, F.tid);
                    group_arrive((unsigned*)F.ws + CW_TAIL + (2 * l) * 64, F.tid);
                } else {
                    if (moe) norm_phase<1>(F, a, l, 1, NLAT, -1, 0, ((int)blockIdx.x - TAILB) * 8 + F.wave, (F.G - TAILB) * 8); else if (f1f8) norm_phase<3>(F, a, l, 1, NLAT, -1, 0, ((int)blockIdx.x - TAILB) * 8 + F.wave, (F.G - TAILB) * 8); else norm_phase<0>(F, a, l, 1, NLAT, -1, 0, ((int)blockIdx.x - TAILB) * 8 + F.wave, (F.G - TAILB) * 8);
                }
                group_wait((unsigned*)F.ws + CW_BAR, (unsigned*)F.ws + CW_TAIL + (2 * l) * 64, TAILB, F.tid);
                if (moe) norm_phase<1>(F, a, l, 1, MT, -1, NLAT, F.gw, F.NGW); else if (f1f8) norm_phase<3>(F, a, l, 1, MT, -1, NLAT, F.gw, F.NGW); else norm_phase<0>(F, a, l, 1, MT, -1, NLAT, F.gw, F.NGW);
            } else { if (moe) norm_phase<1>(F, a, l, 1, Mrows, -1); else if (f1f8) norm_phase<3>(F, a, l, 1, Mrows, -1); else norm_phase<0>(F, a, l, 1, Mrows, -1); }
            SEAM();
        }
        if (!moe) {
            if (IN(8)) REP(8) { PHASE_BEGIN();
                if (f1f8) {
                    int k8 = 512; asm volatile("" : "+s"(k8)); pg8::Gemm g{ACT, (const bf16*)(F.ws + WS_W13D) + (size_t)j * 5632 * 1024, Mrows, 5632, k8}; pg8::StaticOrder S; S.init(Mrows, 5632, F.G, (int)blockIdx.x);
                    EpiSwiglu8 E{(unsigned char*)PH, 1.0f / WSC8};
                    pg8::gemm_phase_f8<EpiSwiglu8, pg8::StaticOrder, true, true>(F.lds, g, S, E, F.tid);
                } else {
                pg8::Gemm g{ACT, (const bf16*)(F.ws + WS_W13D) + (size_t)j * 5632 * 1024, Mrows, 5632, 1024}; pg8::StaticOrder S; S.init(Mrows, 5632, F.G, (int)blockIdx.x);
                EpiSwiglu8 E{(unsigned char*)PH, 1.0f};
                pg8::gemm_phase<EpiSwiglu8, pg8::StaticOrder, true, true>(F.lds, g, S, E, F.tid);
                }
                SEAM();
            }
            if (IN(9)) { PHASE_BEGIN();
                const int Mg = tail ? NLAT : Mrows;
                int k8 = DFF / 2; asm volatile("" : "+s"(k8)); pg8::Gemm g{PH, (const bf16*)(F.ws + WS_W2D + (size_t)j * 1024 * DFF), Mg, 1024, k8}; pg8::StaticOrder S; S.init(Mg, 1024, F.G, (int)blockIdx.x);
                EpiResid E{nullptr, nullptr, XRB, MOD + (size_t)l * 5 * 6144 + 5 * 1024, 1.0f / WSC8, 0};
                pg8::gemm_phase_f8<EpiResid, pg8::StaticOrder, true, true>(F.lds, g, S, E, F.tid);
                if (!tail) { const int rem = ((Mrows / 256) * 4) % F.G; if (rem > 0 && (int)blockIdx.x >= rem) moe_cvt_idle(F, a, j, rem); else if (rem == 0) moe_cvt(F, a, j); }
                SEAM();
            }
        } else {
                        if (IN(8)) REP(8) { PHASE_BEGIN(); moe_gather(F, j); SEAM(); }
            if (IN(9)) REP(9) { PHASE_BEGIN();
                int k8 = 512; asm volatile("" : "+s"(k8)); pg8::Gemm g{(const bf16*)(F.ws + WS_X2), (const bf16*)(F.ws + WS_W13M), 0, 5632, k8}; MoeOrder S; S.init((const unsigned*)F.ws + CW_CNT + j * 8 * 64, 22, F.G, (int)blockIdx.x);
                EpiSwiglu8 E{(unsigned char*)PH, 1.0f / WSC8};
                pg8::gemm_phase_f8<EpiSwiglu8, MoeOrder, true, true>(F.lds, g, S, E, F.tid);
                SEAM();
            }
            if (IN(10)) REP(10) { PHASE_BEGIN();
                int k8 = DFF / 2; asm volatile("" : "+s"(k8)); pg8::Gemm g{PH, (const bf16*)(F.ws + WS_W2M), 0, 1024, k8}; MoeOrder S; S.init((const unsigned*)F.ws + CW_CNT + j * 8 * 64, 4, F.G, (int)blockIdx.x);
                EpiStoreBf16 E{(bf16*)(F.ws + WS_X2), 1024, 1.0f / WSC8};
                pg8::gemm_phase_f8<EpiStoreBf16, MoeOrder, true, true>(F.lds, g, S, E, F.tid);
                SEAM();
            }
        }
    }
    if (((PH_MASK >> 13) & 1) && a.do_fin) { PHASE_BEGIN(); norm_phase<2>(F, a, DEPTH - 1, 0, NLAT, DEPTH - 1); }
#undef SEAM
#undef IN
#undef XRB
#undef MOD
#undef ACT
#undef PH
}

#ifndef MK_FUSED
#define MK_FUSED 1
#endif
template <int PM, int MS> static void launch_one(const Args& a, int grid, hipStream_t stream) {
    static bool attr_done = false;
    if (!attr_done) { (void)hipFuncSetAttribute((const void*)mk_fwd<PM, MS>, hipFuncAttributeMaxDynamicSharedMemorySize, LDS_BYTES); attr_done = true; }
    hipLaunchKernelGGL((mk_fwd<PM, MS>), dim3(grid), dim3(512), LDS_BYTES, stream, a);
}
extern "C" void kernel_launch(void* const* d_in, const int* in_sizes, int n_in, void* d_out, int out_size, void* d_ws, size_t ws_size, hipStream_t stream) {
    static int grid = 0;
    if (grid == 0) {
        if (n_in != 35 || in_sizes[0] != NLAT * DM || out_size != NLAT * DM || ws_size < WS_END) {
            fprintf(stderr, "kernel_launch: unexpected shapes / workspace (n_in %d, ws %zu, need %zu); nothing launched\n", n_in, ws_size, (size_t)WS_END); grid = -1; return; }
        int dev = 0, cus = 0;
        if (hipGetDevice(&dev) != hipSuccess || hipDeviceGetAttribute(&cus, hipDeviceAttributeMultiprocessorCount, dev) != hipSuccess) { grid = -1; return; }
        grid = cus;
    }
    if (grid < 0) return;
    (void)hipMemsetAsync((char*)d_ws + WS_CTL, 0, CTL_ZERO_BYTES, stream);
    Args a{};
    for (int i = 0; i < 35; ++i) a.in[i] = (const float*)d_in[i];
    a.in[I_OUT] = (const float*)d_out; a.in[I_WS] = (const float*)d_ws; a.pad = 0;
#if MK_FUSED
    a.l_lo = 0; a.l_hi = DEPTH; a.ph_lo = 0; a.ph_hi = NPH; a.do_pro = 1; a.do_fin = 1; a.fused = 1;
#ifndef TEST_PM
#define TEST_PM 0xFFFF
#endif
#ifndef TEST_MS
#define TEST_MS 15
#endif
    launch_one<TEST_PM, TEST_MS>(a, grid, stream);
#else
    a.fused = 0;
    a.l_lo = 0; a.l_hi = 0; a.ph_lo = 0; a.ph_hi = 0; a.do_pro = 1; a.do_fin = 0;
    launch_one<0x1000, 15>(a, grid, stream);
    a.do_pro = 0;
    for (int l = 0; l < DEPTH; ++l) {
        a.l_lo = l; a.l_hi = l + 1; a.ph_lo = 0; a.ph_hi = NPH;
        launch_one<0x1, 15>(a, grid, stream); launch_one<0x2, 15>(a, grid, stream); launch_one<0x4, 15>(a, grid, stream); launch_one<0x8, 15>(a, grid, stream);
        launch_one<0x10, 1>(a, grid, stream); launch_one<0x10, 2>(a, grid, stream); launch_one<0x10, 4>(a, grid, stream); launch_one<0x10, 8>(a, grid, stream);
        launch_one<0x20, 15>(a, grid, stream); launch_one<0x40, 15>(a, grid, stream); launch_one<0x80, 15>(a, grid, stream);
        launch_one<0x100, 15>(a, grid, stream); launch_one<0x200, 15>(a, grid, stream);
        if (l & 1) launch_one<0x400, 15>(a, grid, stream);
    }
    a.l_lo = 0; a.l_hi = 0; a.ph_lo = 0; a.ph_hi = 0; a.do_fin = 1;
    launch_one<0x2000, 15>(a, grid, stream);
#endif
}
```

```cpp
#include <hip/hip_runtime.h>
#include <cstdio>
#include <cstdint>
#define LAS __attribute__((address_space(3)))
namespace pg8 {
#define PG8_LAS __attribute__((address_space(3)))
typedef unsigned short bf16_t;
typedef short bf16x8 __attribute__((ext_vector_type(8)));
typedef float f32x4 __attribute__((ext_vector_type(4)));
typedef unsigned u32x4 __attribute__((ext_vector_type(4)));
constexpr int BM = 256, BK = 64, HALF = 128, HTB = HALF * BK * 2  , STAGE_BYTES = 8 * HTB, NXCD = 8, WGM = 8;

__host__ __device__ __forceinline__ int lds_byte(int r, int c) { const int st = (r >> 4) * 2 + (c >> 5), rr = r & 15, cc = c & 31, ob = rr * 64 + cc * 2; return st * 1024 + (ob ^ (((ob >> 9) & 1) << 5)); }
__host__ __device__ __forceinline__ void stage_rc(int b, int& R, int& C) { const int st = b / 1024, sb = b % 1024, swz = sb ^ (((sb >> 9) & 1) << 5); R = (st >> 1) * 16 + swz / 64; C = (st & 1) * 32 + (swz % 64) / 2; }
__host__ __device__ __forceinline__ int perm32(int rho) { const int n = rho >> 4, i = rho & 15; return 8 * (i >> 2) + 4 * n + (i & 3); }

__host__ __device__ __forceinline__ int perm32f(int rho) { return 2 * (rho & 15) + (rho >> 4); }
template <class E, class = void> struct epi_flip { static constexpr bool v = false; };
template <class E> struct epi_flip<E, decltype((void)E::FLIP)> { static constexpr bool v = E::FLIP; };
struct Unit { int pm, pn, pc; };
struct Gemm { const bf16_t* A; const bf16_t* Bt; int M, N, K; };

struct StaticOrder {
    int nM, nN, nwg, G, c;
    __host__ __device__ void init(int M, int N, int G_, int c_) { nM = M / BM; nN = N / BM; nwg = nM * nN; G = G_; c = c_; }
    __host__ __device__ bool next(int i, Unit& u) const {
        const long L = (long)i * G + c; if (L >= nwg) return false;
        int wgid = (int)L; { const int q = nwg / NXCD, r = nwg % NXCD, xcd = wgid % NXCD, off = wgid / NXCD; wgid = (xcd < r ? xcd * (q + 1) : r * (q + 1) + (xcd - r) * q) + off; }
        const int nig = WGM * nN, gid = wgid / nig, fm = gid * WGM, gsz = (nM - fm) < WGM ? (nM - fm) : WGM;
        u.pm = fm + ((wgid % nig) % gsz); u.pn = (wgid % nig) / gsz; u.pc = u.pn; return true;
    }
    __device__ __forceinline__ void a_ready(const Unit&) const {}
    __device__ __forceinline__ void done(const Unit&) const {}
};

__device__ __forceinline__ unsigned cvt_pk_bf16(float lo, float hi) { unsigned r; asm volatile("v_cvt_pk_bf16_f32 %0, %1, %2" : "=v"(r) : "v"(lo), "v"(hi)); return r; }
typedef float f32x2 __attribute__((ext_vector_type(2)));

template <class Epi, class Sched, bool ALIGN_EPI = false, bool SP2 = false>
__device__ __forceinline__ void gemm_phase(PG8_LAS unsigned char* lds, const Gemm g, const Sched& S, const Epi& E, const int tid) {
    const int wid = __builtin_amdgcn_readfirstlane(tid >> 6), lane = tid & 63, wr = wid >> 2, wc = wid & 3, fr = lane & 15, fq = lane >> 4;
    const int K = g.K, nt = K / BK;
    unsigned voffA[2], voffB[2];
#pragma unroll
    for (int i = 0; i < 2; ++i) { int R, C; stage_rc(tid * 16 + i * 8192, R, C); const int Rb = epi_flip<Epi>::v ? ((R & ~31) + perm32f(R & 31)) : (Epi::PERM ? ((R & ~31) + perm32(R & 31)) : R);
        voffA[i] = (unsigned)(R * K + C) * 2u; voffB[i] = (unsigned)(Rb * K + C) * 2u; }
    const size_t kstep = (size_t)(BK * 2);
    const size_t hstep = (size_t)HALF * K * 2;
    const size_t tstep = 2 * hstep;
    const unsigned ldsw = (unsigned)wid * 1024u;
    const int aoff = lds_byte(wr * 64 + fr, fq * 8), boff = lds_byte(wc * 32 + fr, fq * 8);
#define PG8_SA(b, h) (((b) * 2 + (h)) * HTB)
#define PG8_SB(b, h) ((4 + (b) * 2 + (h)) * HTB)
#define PG8_STAGE(bufoff, gbase, voff) do { _Pragma("unroll") for (int _i = 0; _i < 2; ++_i) \
        __builtin_amdgcn_global_load_lds((const unsigned*)((const char*)(gbase) + (voff)[_i]), (PG8_LAS unsigned*)(lds + (bufoff) + ldsw + _i * 8192), 16, 0, 0); } while (0)
#define PG8_LDA(dst, b, h) do { _Pragma("unroll") for (int m = 0; m < 4; ++m) _Pragma("unroll") for (int k = 0; k < 2; ++k) dst[m][k] = *(const PG8_LAS bf16x8*)(lds + PG8_SA(b, h) + aoff + m * 2048 + k * 1024); } while (0)
#define PG8_LDB(dst, b, h) do { _Pragma("unroll") for (int n = 0; n < 2; ++n) _Pragma("unroll") for (int k = 0; k < 2; ++k) dst[n][k] = *(const PG8_LAS bf16x8*)(lds + PG8_SB(b, h) + boff + n * 2048 + k * 1024); } while (0)
#define PG8_MMA(ai, bj, At, Bt) do { __builtin_amdgcn_s_setprio(1); _Pragma("unroll") for (int m = 0; m < 4; ++m) _Pragma("unroll") for (int n = 0; n < 2; ++n) _Pragma("unroll") for (int k = 0; k < 2; ++k) \
        { if constexpr (epi_flip<Epi>::v) acc[ai][bj][m][n] = __builtin_amdgcn_mfma_f32_16x16x32_bf16(At[m][k], Bt[n][k], acc[ai][bj][m][n], 0, 0, 0); \
          else acc[ai][bj][m][n] = __builtin_amdgcn_mfma_f32_16x16x32_bf16(Bt[n][k], At[m][k], acc[ai][bj][m][n], 0, 0, 0); } __builtin_amdgcn_s_setprio(0); } while (0)
#define PG8_WAIT_V(n) asm volatile("s_waitcnt vmcnt(" #n ")" ::: "memory")
#define PG8_WAIT_L(n) asm volatile("s_waitcnt lgkmcnt(" #n ")" ::: "memory")
#define PG8_BAR __builtin_amdgcn_s_barrier()
#define PG8_SCHED __builtin_amdgcn_sched_barrier(0)
    Unit cur, nxt; int ui = 0;
    if (!S.next(0, cur)) return;
    f32x4 acc[2][2][4][2];
#pragma unroll
    for (int a = 0; a < 2; ++a)
#pragma unroll
        for (int b = 0; b < 2; ++b)
#pragma unroll
            for (int m = 0; m < 4; ++m)
#pragma unroll
                for (int n = 0; n < 2; ++n) acc[a][b][m][n] = (f32x4){0.f, 0.f, 0.f, 0.f};
    bf16x8 At[4][2], B0[2][2], B1[2][2];
    const char* cA = (const char*)g.A + (size_t)cur.pm * tstep; const char* cB = (const char*)g.Bt + (size_t)cur.pn * tstep;
    S.a_ready(cur);
    if constexpr (SP2) {
        PG8_STAGE(PG8_SB(0, 0), cB, voffB); PG8_STAGE(PG8_SB(0, 1), cB + hstep, voffB); PG8_STAGE(PG8_SA(0, 0), cA, voffA); PG8_STAGE(PG8_SA(0, 1), cA + hstep, voffA);
        if (wr == 1) PG8_BAR;
        PG8_WAIT_V(2); PG8_BAR;
        PG8_STAGE(PG8_SB(1, 0), cB + kstep, voffB); PG8_STAGE(PG8_SA(1, 0), cA + kstep, voffA); PG8_STAGE(PG8_SB(1, 1), cB + hstep + kstep, voffB);
        PG8_WAIT_V(6); PG8_BAR;
    } else {
        PG8_STAGE(PG8_SB(0, 0), cB, voffB); PG8_STAGE(PG8_SA(0, 0), cA, voffA); PG8_STAGE(PG8_SB(0, 1), cB + hstep, voffB); PG8_STAGE(PG8_SA(0, 1), cA + hstep, voffA);
        if (wr == 1) PG8_BAR;
        PG8_WAIT_V(4); PG8_BAR;
        PG8_STAGE(PG8_SB(1, 0), cB + kstep, voffB); PG8_STAGE(PG8_SA(1, 0), cA + kstep, voffA); PG8_STAGE(PG8_SB(1, 1), cB + hstep + kstep, voffB);
        PG8_WAIT_V(6); PG8_BAR;
    }
    for (;;) {
        const bool has_next = S.next(ui + 1, nxt);
        const char* nA = has_next ? (const char*)g.A + (size_t)nxt.pm * tstep : cA; const char* nB = has_next ? (const char*)g.Bt + (size_t)nxt.pn * tstep : cB;
        for (int t = 0; t < nt; t += 2) {
            const bool last = (t == nt - 2);
            const char* a1 = cA + (size_t)(t + 1) * kstep;
            const char* a2 = last ? nA : cA + (size_t)(t + 2) * kstep; const char* b2 = last ? nB : cB + (size_t)(t + 2) * kstep;
            const char* a3 = a2 + kstep; const char* b3 = b2 + kstep;
            if (last && has_next) S.a_ready(nxt);
            if constexpr (SP2) {
            PG8_LDB(B0, 0, 0); PG8_LDB(B1, 0, 1); PG8_SCHED; PG8_LDA(At, 0, 0); PG8_STAGE(PG8_SA(1, 1), a1 + hstep, voffA);
            PG8_WAIT_V(8); PG8_WAIT_L(0); PG8_BAR; PG8_MMA(0, 0, At, B0); PG8_MMA(0, 1, At, B1); PG8_BAR; PG8_SCHED;
            PG8_LDA(At, 0, 1); PG8_STAGE(PG8_SB(0, 0), b2, voffB); PG8_STAGE(PG8_SB(0, 1), b2 + hstep, voffB); PG8_STAGE(PG8_SA(0, 0), a2, voffA);
            PG8_WAIT_V(8); PG8_WAIT_L(0); PG8_BAR; PG8_MMA(1, 0, At, B0); PG8_MMA(1, 1, At, B1); PG8_BAR; PG8_SCHED;
            PG8_LDB(B0, 1, 0); PG8_LDB(B1, 1, 1); PG8_SCHED; PG8_LDA(At, 1, 0); PG8_STAGE(PG8_SA(0, 1), a2 + hstep, voffA);
            PG8_WAIT_V(8); PG8_WAIT_L(0); PG8_BAR; PG8_MMA(0, 0, At, B0); PG8_MMA(0, 1, At, B1); PG8_BAR; PG8_SCHED;
            PG8_LDA(At, 1, 1); PG8_STAGE(PG8_SB(1, 0), b3, voffB); PG8_STAGE(PG8_SB(1, 1), b3 + hstep, voffB); PG8_STAGE(PG8_SA(1, 0), a3, voffA);
            PG8_WAIT_V(8); PG8_WAIT_L(0); PG8_BAR; PG8_MMA(1, 0, At, B0); PG8_MMA(1, 1, At, B1); PG8_BAR; PG8_SCHED;
            } else {
            PG8_LDB(B0, 0, 0); PG8_SCHED; PG8_LDA(At, 0, 0); PG8_STAGE(PG8_SA(1, 1), a1 + hstep, voffA);
            PG8_WAIT_L(8); PG8_BAR; PG8_WAIT_L(0); PG8_MMA(0, 0, At, B0); PG8_BAR; PG8_SCHED;
            PG8_LDB(B1, 0, 1); PG8_STAGE(PG8_SB(0, 0), b2, voffB);
            PG8_BAR; PG8_WAIT_L(0); PG8_MMA(0, 1, At, B1); PG8_BAR;
            PG8_LDA(At, 0, 1); PG8_STAGE(PG8_SA(0, 0), a2, voffA);
            PG8_BAR; PG8_WAIT_L(0); PG8_MMA(1, 0, At, B0); PG8_BAR; PG8_SCHED;
            PG8_STAGE(PG8_SB(0, 1), b2 + hstep, voffB);
            PG8_WAIT_V(6); PG8_BAR; PG8_MMA(1, 1, At, B1); PG8_BAR;
            PG8_LDB(B0, 1, 0); PG8_SCHED; PG8_LDA(At, 1, 0); PG8_STAGE(PG8_SA(0, 1), a2 + hstep, voffA);
            PG8_WAIT_L(8); PG8_BAR; PG8_WAIT_L(0); PG8_MMA(0, 0, At, B0); PG8_BAR; PG8_SCHED;
            PG8_LDB(B1, 1, 1); PG8_STAGE(PG8_SB(1, 0), b3, voffB);
            PG8_BAR; PG8_WAIT_L(0); PG8_MMA(0, 1, At, B1); PG8_BAR;
            PG8_LDA(At, 1, 1); PG8_STAGE(PG8_SA(1, 0), a3, voffA);
            PG8_BAR; PG8_WAIT_L(0); PG8_MMA(1, 0, At, B0); PG8_BAR; PG8_SCHED;
            PG8_STAGE(PG8_SB(1, 1), b3 + hstep, voffB);
            PG8_WAIT_V(6); PG8_BAR; PG8_MMA(1, 1, At, B1); PG8_BAR;
            }
        }
        if constexpr (ALIGN_EPI) { if (wr == 0) PG8_BAR; }
        if constexpr (!Epi::AFTER_DRAIN) { E(acc, cur, wr, wc, fr, fq); S.done(cur); }
        if (!has_next) break;
#pragma unroll
        for (int a = 0; a < 2; ++a)
#pragma unroll
            for (int b = 0; b < 2; ++b)
#pragma unroll
                for (int m = 0; m < 4; ++m)
#pragma unroll
                    for (int n = 0; n < 2; ++n) acc[a][b][m][n] = (f32x4){0.f, 0.f, 0.f, 0.f};
        cur = nxt; cA = nA; cB = nB; ++ui;
        if constexpr (ALIGN_EPI) { if (wr == 1) PG8_BAR; }
    }
    PG8_WAIT_V(0);
    if constexpr (!ALIGN_EPI) { if (wr == 0) PG8_BAR; }
    PG8_BAR;
    if constexpr (Epi::AFTER_DRAIN) { E.fused(acc, cur, wr, wc, fr, fq, lds, wid, lane); S.done(cur); }
#undef PG8_SA
#undef PG8_SB
#undef PG8_STAGE
#undef PG8_LDA
#undef PG8_LDB
#undef PG8_MMA
#undef PG8_WAIT_V
#undef PG8_WAIT_L
#undef PG8_BAR
#undef PG8_SCHED
}
typedef int v8i_t __attribute__((ext_vector_type(8)));
typedef int v4i_t __attribute__((ext_vector_type(4)));
template <class Epi, class Sched, bool ALIGN_EPI = false, bool SP2 = false, bool GATHER = false  >
__device__ __forceinline__ void gemm_phase_f8(PG8_LAS unsigned char* lds, const Gemm g, const Sched& S, const Epi& E, const int tid) {
    const int wid = __builtin_amdgcn_readfirstlane(tid >> 6), lane = tid & 63, wr = wid >> 2, wc = wid & 3, fr = lane & 15, fq = lane >> 4;
    const int K = g.K, nt = K / BK;
    unsigned voffA[2], voffB[2];
    int sRi[2]; unsigned sCi[2]; unsigned vAc[2][2] = {{0u, 0u}, {0u, 0u}}, vAn[2][2] = {{0u, 0u}, {0u, 0u}};
#pragma unroll
    for (int i = 0; i < 2; ++i) { int R, C; stage_rc(tid * 16 + i * 8192, R, C); const int Rb = Epi::PERM ? ((R & ~31) + perm32(R & 31)) : R; sRi[i] = R; sCi[i] = (unsigned)C * 2u;
        voffA[i] = (unsigned)(R * K + C) * 2u; voffB[i] = (unsigned)(Rb * K + C) * 2u; }
#define PG8_FILL(V, U) do { _Pragma("unroll") for (int h_ = 0; h_ < 2; ++h_) _Pragma("unroll") for (int i_ = 0; i_ < 2; ++i_) V[h_][i_] = S.arow_off(U, h_ * HALF + sRi[i_]) + sCi[i_]; } while (0)
#define PG8_STAGEA(b, h, gbase, nx) do { _Pragma("unroll") for (int _i = 0; _i < 2; ++_i) { const unsigned vo_ = GATHER ? ((nx) ? vAn[h][_i] : vAc[h][_i]) : voffA[_i]; \
        __builtin_amdgcn_global_load_lds((const unsigned*)((const char*)(gbase) + (GATHER ? (size_t)0 : (size_t)(h) * hstep) + vo_), (PG8_LAS unsigned*)(lds + PG8_SA(b, h) + ldsw + _i * 8192), 16, 0, 0); } } while (0)
    const size_t kstep = (size_t)(BK * 2);
    const size_t hstep = (size_t)HALF * K * 2;
    const size_t tstep = 2 * hstep;
    const unsigned ldsw = (unsigned)wid * 1024u;
    const int aoff0 = lds_byte(wr * 64 + fr, fq * 16), aoff1 = lds_byte(wr * 64 + fr, fq * 16 + 8), boff0 = lds_byte(wc * 32 + fr, fq * 16), boff1 = lds_byte(wc * 32 + fr, fq * 16 + 8);
#define PG8_SA(b, h) (((b) * 2 + (h)) * HTB)
#define PG8_SB(b, h) ((4 + (b) * 2 + (h)) * HTB)
#define PG8_STAGE(bufoff, gbase, voff) do { _Pragma("unroll") for (int _i = 0; _i < 2; ++_i) \
        __builtin_amdgcn_global_load_lds((const unsigned*)((const char*)(gbase) + (voff)[_i]), (PG8_LAS unsigned*)(lds + (bufoff) + ldsw + _i * 8192), 16, 0, 0); } while (0)
#define PG8_LDA(dst, b, h) do { _Pragma("unroll") for (int m = 0; m < 4; ++m) { const u32x4 lo_ = *(const PG8_LAS u32x4*)(lds + PG8_SA(b, h) + aoff0 + m * 2048), hi_ = *(const PG8_LAS u32x4*)(lds + PG8_SA(b, h) + aoff1 + m * 2048); \
        dst[m] = __builtin_shufflevector((v4i_t)lo_, (v4i_t)hi_, 0, 1, 2, 3, 4, 5, 6, 7); } } while (0)
#define PG8_LDB(dst, b, h) do { _Pragma("unroll") for (int n = 0; n < 2; ++n) { const u32x4 lo_ = *(const PG8_LAS u32x4*)(lds + PG8_SB(b, h) + boff0 + n * 2048), hi_ = *(const PG8_LAS u32x4*)(lds + PG8_SB(b, h) + boff1 + n * 2048); \
        dst[n] = __builtin_shufflevector((v4i_t)lo_, (v4i_t)hi_, 0, 1, 2, 3, 4, 5, 6, 7); } } while (0)
#define PG8_MMA(ai, bj, At, Bt) do { __builtin_amdgcn_s_setprio(1); _Pragma("unroll") for (int m = 0; m < 4; ++m) _Pragma("unroll") for (int n = 0; n < 2; ++n) \
        asm volatile("v_mfma_scale_f32_16x16x128_f8f6f4 %0, %1, %2, %0, %3, %3 op_sel_hi:[0,0,0]" : "+v"(acc[ai][bj][m][n]) : "v"(Bt[n]), "v"(At[m]), "v"(one_scale)); __builtin_amdgcn_s_setprio(0); } while (0)
#define PG8_WAIT_V(n) asm volatile("s_waitcnt vmcnt(" #n ")" ::: "memory")
#define PG8_WAIT_L(n) asm volatile("s_waitcnt lgkmcnt(" #n ")" ::: "memory")
#define PG8_BAR __builtin_amdgcn_s_barrier()
#define PG8_SCHED __builtin_amdgcn_sched_barrier(0)
    Unit cur, nxt; int ui = 0;
    if (!S.next(0, cur)) return;
    f32x4 acc[2][2][4][2];
#pragma unroll
    for (int a = 0; a < 2; ++a)
#pragma unroll
        for (int b = 0; b < 2; ++b)
#pragma unroll
            for (int m = 0; m < 4; ++m)
#pragma unroll
                for (int n = 0; n < 2; ++n) acc[a][b][m][n] = (f32x4){0.f, 0.f, 0.f, 0.f};
    v8i_t At[4], B0[2], B1[2]; const int one_scale = 0x7f7f7f7f;
    const char* cA = GATHER ? (const char*)g.A : (const char*)g.A + (size_t)cur.pm * tstep; const char* cB = (const char*)g.Bt + (size_t)cur.pn * tstep;
    S.a_ready(cur);
    if constexpr (GATHER) PG8_FILL(vAc, cur);
    if constexpr (SP2) {
        PG8_STAGE(PG8_SB(0, 0), cB, voffB); PG8_STAGE(PG8_SB(0, 1), cB + hstep, voffB); PG8_STAGEA(0, 0, cA, false); PG8_STAGEA(0, 1, cA, false);
        if (wr == 1) PG8_BAR;
        PG8_WAIT_V(2); PG8_BAR;
        PG8_STAGE(PG8_SB(1, 0), cB + kstep, voffB); PG8_STAGEA(1, 0, cA + kstep, false); PG8_STAGE(PG8_SB(1, 1), cB + hstep + kstep, voffB);
        PG8_WAIT_V(6); PG8_BAR;
    } else {
        PG8_STAGE(PG8_SB(0, 0), cB, voffB); PG8_STAGEA(0, 0, cA, false); PG8_STAGE(PG8_SB(0, 1), cB + hstep, voffB); PG8_STAGEA(0, 1, cA, false);
        if (wr == 1) PG8_BAR;
        PG8_WAIT_V(4); PG8_BAR;
        PG8_STAGE(PG8_SB(1, 0), cB + kstep, voffB); PG8_STAGEA(1, 0, cA + kstep, false); PG8_STAGE(PG8_SB(1, 1), cB + hstep + kstep, voffB);
        PG8_WAIT_V(6); PG8_BAR;
    }
    for (;;) {
        const bool has_next = S.next(ui + 1, nxt);
        if constexpr (GATHER) { if (has_next) PG8_FILL(vAn, nxt); }
        const bool nxu = GATHER && has_next;
        const char* nA = GATHER ? (const char*)g.A : (has_next ? (const char*)g.A + (size_t)nxt.pm * tstep : cA); const char* nB = has_next ? (const char*)g.Bt + (size_t)nxt.pn * tstep : cB;
        for (int t = 0; t < nt; t += 2) {
            const bool last = (t == nt - 2);
            const char* a1 = cA + (size_t)(t + 1) * kstep;
            const char* a2 = last ? nA : cA + (size_t)(t + 2) * kstep; const char* b2 = last ? nB : cB + (size_t)(t + 2) * kstep;
            const char* a3 = a2 + kstep; const char* b3 = b2 + kstep;
            if (last && has_next) S.a_ready(nxt);
            if constexpr (SP2) {
            PG8_LDB(B0, 0, 0); PG8_LDB(B1, 0, 1); PG8_SCHED; PG8_LDA(At, 0, 0); PG8_STAGEA(1, 1, a1, false);
            PG8_WAIT_V(8); PG8_WAIT_L(0); PG8_BAR; PG8_MMA(0, 0, At, B0); PG8_MMA(0, 1, At, B1); PG8_BAR; PG8_SCHED;
            PG8_LDA(At, 0, 1); PG8_STAGE(PG8_SB(0, 0), b2, voffB); PG8_STAGE(PG8_SB(0, 1), b2 + hstep, voffB); PG8_STAGEA(0, 0, a2, last && nxu);
            PG8_WAIT_V(8); PG8_WAIT_L(0); PG8_BAR; PG8_MMA(1, 0, At, B0); PG8_MMA(1, 1, At, B1); PG8_BAR; PG8_SCHED;
            PG8_LDB(B0, 1, 0); PG8_LDB(B1, 1, 1); PG8_SCHED; PG8_LDA(At, 1, 0); PG8_STAGEA(0, 1, a2, last && nxu);
            PG8_WAIT_V(8); PG8_WAIT_L(0); PG8_BAR; PG8_MMA(0, 0, At, B0); PG8_MMA(0, 1, At, B1); PG8_BAR; PG8_SCHED;
            PG8_LDA(At, 1, 1); PG8_STAGE(PG8_SB(1, 0), b3, voffB); PG8_STAGE(PG8_SB(1, 1), b3 + hstep, voffB); PG8_STAGEA(1, 0, a3, last && nxu);
            PG8_WAIT_V(8); PG8_WAIT_L(0); PG8_BAR; PG8_MMA(1, 0, At, B0); PG8_MMA(1, 1, At, B1); PG8_BAR; PG8_SCHED;
            } else {
            PG8_LDB(B0, 0, 0); PG8_SCHED; PG8_LDA(At, 0, 0); PG8_STAGEA(1, 1, a1, false);
            PG8_WAIT_L(8); PG8_BAR; PG8_WAIT_L(0); PG8_MMA(0, 0, At, B0); PG8_BAR; PG8_SCHED;
            PG8_LDB(B1, 0, 1); PG8_STAGE(PG8_SB(0, 0), b2, voffB);
            PG8_BAR; PG8_WAIT_L(0); PG8_MMA(0, 1, At, B1); PG8_BAR;
            PG8_LDA(At, 0, 1); PG8_STAGEA(0, 0, a2, last && nxu);
            PG8_BAR; PG8_WAIT_L(0); PG8_MMA(1, 0, At, B0); PG8_BAR; PG8_SCHED;
            PG8_STAGE(PG8_SB(0, 1), b2 + hstep, voffB);
            PG8_WAIT_V(6); PG8_BAR; PG8_MMA(1, 1, At, B1); PG8_BAR;
            PG8_LDB(B0, 1, 0); PG8_SCHED; PG8_LDA(At, 1, 0); PG8_STAGEA(0, 1, a2, last && nxu);
            PG8_WAIT_L(8); PG8_BAR; PG8_WAIT_L(0); PG8_MMA(0, 0, At, B0); PG8_BAR; PG8_SCHED;
            PG8_LDB(B1, 1, 1); PG8_STAGE(PG8_SB(1, 0), b3, voffB);
            PG8_BAR; PG8_WAIT_L(0); PG8_MMA(0, 1, At, B1); PG8_BAR;
            PG8_LDA(At, 1, 1); PG8_STAGEA(1, 0, a3, last && nxu);
            PG8_BAR; PG8_WAIT_L(0); PG8_MMA(1, 0, At, B0); PG8_BAR; PG8_SCHED;
            PG8_STAGE(PG8_SB(1, 1), b3 + hstep, voffB);
            PG8_WAIT_V(6); PG8_BAR; PG8_MMA(1, 1, At, B1); PG8_BAR;
            }
        }
        if constexpr (ALIGN_EPI) { if (wr == 0) PG8_BAR; }
        asm volatile("s_nop 15\n\ts_nop 15" ::: "memory");
        if constexpr (!Epi::AFTER_DRAIN) { E(acc, cur, wr, wc, fr, fq); S.done(cur); }
        if (!has_next) break;
#pragma unroll
        for (int a = 0; a < 2; ++a)
#pragma unroll
            for (int b = 0; b < 2; ++b)
#pragma unroll
                for (int m = 0; m < 4; ++m)
#pragma unroll
                    for (int n = 0; n < 2; ++n) acc[a][b][m][n] = (f32x4){0.f, 0.f, 0.f, 0.f};
        cur = nxt; cA = nA; cB = nB; ++ui;
        if constexpr (GATHER) { _Pragma("unroll") for (int h_ = 0; h_ < 2; ++h_) _Pragma("unroll") for (int i_ = 0; i_ < 2; ++i_) vAc[h_][i_] = vAn[h_][i_]; }
        if constexpr (ALIGN_EPI) { if (wr == 1) PG8_BAR; }
    }
    PG8_WAIT_V(0);
    if constexpr (!ALIGN_EPI) { if (wr == 0) PG8_BAR; }
    PG8_BAR;
    if constexpr (Epi::AFTER_DRAIN) { E.fused(acc, cur, wr, wc, fr, fq, lds, wid, lane); S.done(cur); }
#undef PG8_SA
#undef PG8_SB
#undef PG8_STAGE
#undef PG8_STAGEA
#undef PG8_FILL
#undef PG8_LDA
#undef PG8_LDB
#undef PG8_MMA
#undef PG8_WAIT_V
#undef PG8_WAIT_L
#undef PG8_BAR
#undef PG8_SCHED
}
}

#define XB_TMO      128
#define XB_XCNT(j)  (256  + 64 * (j))
#define XB_XSUB(j)  (1280 + 64 * (j))
#define XB_XGEN(j)  (2304 + 64 * (j))
#define XB_TOP      3328
#define XB_TOPGEN   3392
#define XCD_BAR_WORDS 3456
#define XB_SPIN_CAP (1u << 18)

__device__ __forceinline__ unsigned xb_ld(unsigned* p)              { return __hip_atomic_load(p, __ATOMIC_RELAXED, __HIP_MEMORY_SCOPE_AGENT); }
__device__ __forceinline__ unsigned xb_add(unsigned* p, unsigned v) { return __hip_atomic_fetch_add(p, v, __ATOMIC_RELAXED, __HIP_MEMORY_SCOPE_AGENT); }
__device__ __forceinline__ unsigned xb_xcc_id() { return (unsigned)__builtin_amdgcn_s_getreg((3 << 11) | 20) & 0xFu; }
#define XB_SPIN(cond, bar) do { unsigned _sp = 0; while (cond) { __builtin_amdgcn_s_sleep(1); \
    if ((++_sp & 255u) == 0u) { if (xb_ld(&(bar)[XB_TMO])) break; if (_sp > XB_SPIN_CAP) { atomicAdd(&(bar)[XB_TMO], 1u); break; } } } } while (0)

struct XcdBarrier {
    unsigned* bar; unsigned x;
    volatile LAS unsigned* st;
};

__device__ __forceinline__ XcdBarrier xcd_barrier_post(unsigned* bar, volatile LAS unsigned* st, const int xb_tid) {
    XcdBarrier b; b.bar = bar; b.x = xb_xcc_id(); b.st = st;
    if (xb_tid == 0) (void)xb_add(&bar[XB_XCNT(b.x)], 1u);
    return b;
}
__device__ __forceinline__ void xcd_barrier_complete(unsigned* bar, unsigned x, unsigned& nloc, unsigned& nx) {
    const unsigned G = gridDim.x * gridDim.y * gridDim.z;
    unsigned sum, cnt, mine, sp = 0u;
    for (;;) {
        sum = 0u; cnt = 0u; mine = 0u;
#pragma unroll
        for (unsigned j = 0; j < 16; ++j) { const unsigned c = xb_ld(&bar[XB_XCNT(j)]); sum += c; cnt += (c > 0u) ? 1u : 0u; mine = (j == x) ? c : mine; }
        if (sum == G) break;
        __builtin_amdgcn_s_sleep(1);
        if ((++sp & 255u) == 0u) { if (xb_ld(&bar[XB_TMO])) break; if (sp > XB_SPIN_CAP) { atomicAdd(&bar[XB_TMO], 1u); break; } }
    }
    nloc = mine > 0u ? mine : 1u; nx = cnt > 0u ? cnt : 1u;
}

__device__ __forceinline__ void xcd_barrier(const XcdBarrier& b, const int xb_tid) {
    asm volatile("s_waitcnt vmcnt(0)" ::: "memory");
    __syncthreads();
    if (xb_tid == 0) {
        unsigned* bar = b.bar;
        __builtin_amdgcn_s_waitcnt(0);
        unsigned nloc = b.st[0], nx = b.st[1];
        if (nloc == 0u) { xcd_barrier_complete(bar, b.x, nloc, nx); b.st[0] = nloc; b.st[1] = nx; }
        const unsigned old = xb_add(&bar[XB_XSUB(b.x)], 1u);
        const unsigned gen = old / nloc;
        if (old + 1u == (gen + 1u) * nloc) {
            __builtin_amdgcn_fence(__ATOMIC_RELEASE, "agent");
            asm volatile("s_waitcnt vmcnt(0)" ::: "memory");
            const unsigned og = xb_add(&bar[XB_TOP], 1u);
            const unsigned tg = og / nx;
            if (og + 1u == (tg + 1u) * nx) xb_add(&bar[XB_TOPGEN], 1u);
            else XB_SPIN(xb_ld(&bar[XB_TOPGEN]) == tg, bar);
            __builtin_amdgcn_fence(__ATOMIC_ACQUIRE, "agent");
            xb_add(&bar[XB_XGEN(b.x)], 1u);
            asm volatile("s_waitcnt vmcnt(0)" ::: "memory");
        } else {
            XB_SPIN(xb_ld(&bar[XB_XGEN(b.x)]) == gen, bar);
            __builtin_amdgcn_fence(__ATOMIC_ACQUIRE, "agent");
            asm volatile("s_waitcnt vmcnt(0)" ::: "memory");
        }
    }
    __syncthreads();
}

__device__ __forceinline__ void group_arrive(unsigned* cnt, const int xb_tid) {
    asm volatile("s_waitcnt vmcnt(0)" ::: "memory");
    __syncthreads();
    if (xb_tid == 0) {
        __builtin_amdgcn_s_waitcnt(0);
        __builtin_amdgcn_fence(__ATOMIC_RELEASE, "agent");
        asm volatile("s_waitcnt vmcnt(0)" ::: "memory");
        (void)xb_add(cnt, 1u);
    }
}
__device__ __forceinline__ void group_wait(unsigned* bar, unsigned* cnt, unsigned n, const int xb_tid) {
    __syncthreads();
    if (xb_tid == 0) {
        XB_SPIN(xb_ld(cnt) < n, bar);
        __builtin_amdgcn_fence(__ATOMIC_ACQUIRE, "agent");
        asm volatile("s_waitcnt vmcnt(0)" ::: "memory");
    }
    __syncthreads();
}

#define GAS __attribute__((address_space(1)))
typedef unsigned short bf16;
typedef unsigned v4u __attribute__((ext_vector_type(4)));
typedef unsigned v2u __attribute__((ext_vector_type(2)));
typedef float f32x4 __attribute__((ext_vector_type(4)));

constexpr int NB = 4, SEQ = 8192, DM = 1024, DEPTH = 4, CTXL = 256;
constexpr int NLAT = NB * SEQ, NCTX = NB * CTXL, MT = NLAT + NCTX;
constexpr int DIN = 3360, DINP = 3584, DFF = 2816, NEXP = 8;
constexpr int C_RQ = 0, C_RK = 256, C_RV = 512, C_RG = 768, C_S5 = 1024, C_HQ = 1280, C_HFF = 1536, C_HFB = 1792, C_HI = 2048, C_HG = 2304,
              C_GQ = 2560, C_GK = 2688, C_GV = 2816, C_GG = 3072, C_GAF = 3328, C_GAB = 3344,
              C_GZF = 3328, C_GZB = 3456;
constexpr int NSEG = 132;
constexpr int MOE_CAP_TILES = 272;
constexpr float NEPS = 1e-6f;
constexpr float WSC8 = 64.0f;

constexpr size_t MiB = 1u << 20;
constexpr size_t WS_CTL = 0, CTL_ZERO_BYTES = 2 * MiB;
constexpr size_t WS_MOD = 2 * MiB;
constexpr size_t WS_LB = 3 * MiB;
constexpr size_t WS_ROPE = 3 * MiB + 65536;
constexpr size_t WS_GLUW = 3 * MiB + 131072;
constexpr size_t WS_WIN = 4 * MiB;
constexpr size_t WS_WOUT = 32 * MiB;
constexpr size_t WS_W13D = 40 * MiB;
constexpr size_t WS_W2D = 62 * MiB;
constexpr size_t WS_W13M = 73 * MiB;
constexpr size_t WS_W2M = 161 * MiB;
constexpr size_t WS_HB = 205 * MiB;
constexpr size_t WS_ACT = 209 * MiB;
constexpr size_t WS_Z = 275 * MiB;
constexpr size_t WS_PH = 292 * MiB;
constexpr size_t WS_OF = (292 + 232) * MiB;
constexpr size_t WS_XR = 580 * MiB;
constexpr size_t WS_X2 = 666 * MiB;
constexpr size_t WS_LIST = 843 * MiB;
constexpr size_t WS_S5PAR = 70 * MiB;
constexpr size_t WS_END = 846 * MiB;
constexpr size_t ST_DS0 = 0;
constexpr size_t ST_DS1 = ST_DS0 + (size_t)2 * 16 * NSEG * 4096;
constexpr size_t ST_DS2 = ST_DS1 + (size_t)2 * 16 * NSEG * 4096;
constexpr size_t ST_G0 = ST_DS2 + (size_t)2 * 16 * NSEG * 2048;
constexpr size_t ST_G1 = ST_G0 + (size_t)2 * 16 * NSEG * 64;
constexpr size_t ST_G2 = ST_G1 + (size_t)2 * 16 * NSEG * 64;
constexpr size_t ST_HS = ST_G2 + (size_t)2 * 16 * NSEG * 64;
constexpr size_t ST_END = ST_HS + (size_t)2 * 64 * NSEG * 128;
static_assert(ST_END * 4 <= (WS_LIST - WS_X2), "state region");
static_assert(WS_PH + (size_t)MT * DINP * 2 <= WS_OF && WS_OF + (size_t)MT * 768 * 2 <= WS_XR && WS_XR + (size_t)MT * 1024 * 2 <= WS_X2, "OF / residual regions");
static_assert((size_t)MOE_CAP_TILES * 256 * 1024 * 2 <= (WS_LIST - WS_X2), "XB region");
static_assert((size_t)MOE_CAP_TILES * 256 * DFF * 2 <= (WS_X2 - WS_PH) && (size_t)MT * DINP * 2 <= (WS_X2 - WS_PH), "P/H region");
constexpr int CW_BAR = 4096;
constexpr int FP8_F1_J = 1;
constexpr int CW_TAIL = 32768;
constexpr unsigned ZROW_OFF = 1024u * 1024u;
constexpr int CW_CNT = 16384;

constexpr int LDS_BYTES = 163840;
constexpr int MISC_OFF = 163840 - 512;

__device__ __forceinline__ float bf2f(unsigned short h) { return __uint_as_float(((unsigned)h) << 16); }
__device__ __forceinline__ unsigned f2bf(float f) { unsigned u = __float_as_uint(f); return (u + 0x7fffu + ((u >> 16) & 1u)) >> 16; }
__device__ __forceinline__ unsigned pk2(float lo, float hi) { return f2bf(lo) | (f2bf(hi) << 16); }
__device__ __forceinline__ float wave_sum(float v) {
#define WS_DPP(ctrl, rmask) v += __int_as_float(__builtin_amdgcn_update_dpp(0, __float_as_int(v), (ctrl), (rmask), 0xf, false))
    WS_DPP(0x111, 0xf); WS_DPP(0x112, 0xf); WS_DPP(0x114, 0xf); WS_DPP(0x118, 0xf); WS_DPP(0x142, 0xa); WS_DPP(0x143, 0xc);
#undef WS_DPP
    return __int_as_float(__builtin_amdgcn_readlane(__float_as_int(v), 63));
}
__device__ __forceinline__ float rdl(float v, int k) { return __uint_as_float((unsigned)__builtin_amdgcn_readlane((int)__float_as_uint(v), k)); }
__device__ __forceinline__ float sigm(float x) { return __builtin_amdgcn_rcpf(1.0f + __expf(-x)); }
__device__ __forceinline__ float silu_f(float x) { return x * __builtin_amdgcn_rcpf(1.0f + __expf(-x)); }
#define LDS_WAIT() asm volatile("s_waitcnt lgkmcnt(0)" ::: "memory")

struct Args {
    const float* in[37];
    int l_lo, l_hi, ph_lo, ph_hi, do_pro, do_fin, fused, pad;
};
constexpr int I_OUT = 35, I_WS = 36;
enum { I_X = 0, I_C, I_CTX, I_CCTX, I_ADAW, I_ADAB, I_N1W, I_N2W, I_WIN, I_WOUT, I_RETGN, I_LAMRE, I_LAMIM, I_LOGDT, I_BRE, I_BIM, I_CRE, I_CIM, I_S5D,
       I_GLUW, I_GLUB, I_LBL, I_HGNW, I_WA2, I_BA, I_GLANW, I_FW1, I_FW3, I_FW2, I_RW, I_RB, I_MW1, I_MW3, I_MW2, I_FINW };

struct Frame {
    LAS unsigned char* lds;
    int tid, lane, wave, gw, NGW, G, zz;
    unsigned char* ws; float* out;
};

struct EpiStoreBf16 {
    static constexpr bool PERM = true, AFTER_DRAIN = false;
    bf16* O; int ldc; float sc;
    __device__ __forceinline__ void operator()(const pg8::f32x4 (&acc)[2][2][4][2], const pg8::Unit& u, int wr, int wc, int fr, int fq) const {
        const int row0 = u.pm * 256 + wr * 64 + fr, col0 = u.pc * 256 + wc * 32 + 8 * fq;
#pragma unroll
        for (int ai = 0; ai < 2; ++ai)
#pragma unroll
            for (int m = 0; m < 4; ++m) { bf16* rowp = O + (size_t)(row0 + ai * 128 + m * 16) * ldc + col0;
#pragma unroll
                for (int bj = 0; bj < 2; ++bj) { const pg8::f32x4 v0 = acc[ai][bj][m][0] * sc, v1 = acc[ai][bj][m][1] * sc;
                    pg8::u32x4 w; w.x = pg8::cvt_pk_bf16(v0[0], v0[1]); w.y = pg8::cvt_pk_bf16(v0[2], v0[3]); w.z = pg8::cvt_pk_bf16(v1[0], v1[1]); w.w = pg8::cvt_pk_bf16(v1[2], v1[3]);
                    *(pg8::u32x4*)(rowp + bj * 128) = w; } }
    }
};
constexpr int P4G = 4 * DINP, P4S5 = 4096;
struct EpiStoreP4 {
    static constexpr bool PERM = true, FLIP = true, AFTER_DRAIN = false;
    bf16* O;
    __device__ __forceinline__ void operator()(const pg8::f32x4 (&acc)[2][2][4][2], const pg8::Unit& u, int wr, int wc, int fr, int fq) const {
        const int grp0 = u.pm * 64 + wr * 16 + fq;
        if (!(u.pc == 3 || u.pc == 4 || u.pc == 9 || u.pc == 12)) {
            bf16* base = O + (size_t)grp0 * P4G + (size_t)(u.pc * 256 + wc * 32 + 2 * fr) * 4;
#pragma unroll
            for (int ai = 0; ai < 2; ++ai)
#pragma unroll
                for (int m = 0; m < 4; ++m) { bf16* gp = base + (size_t)(ai * 32 + m * 4) * P4G;
#pragma unroll
                    for (int bj = 0; bj < 2; ++bj) { const pg8::f32x4 v0 = acc[ai][bj][m][0], v1 = acc[ai][bj][m][1];
                        pg8::u32x4 w; w.x = pg8::cvt_pk_bf16(v0[0], v0[1]); w.y = pg8::cvt_pk_bf16(v0[2], v0[3]); w.z = pg8::cvt_pk_bf16(v1[0], v1[1]); w.w = pg8::cvt_pk_bf16(v1[2], v1[3]);
                        *(pg8::u32x4*)(gp + bj * 512) = w; } }
        } else {
            bf16* base = O + (size_t)grp0 * P4G + u.pc * 1024 + wc * 32 + 2 * fr;
#pragma unroll
            for (int ai = 0; ai < 2; ++ai)
#pragma unroll
                for (int m = 0; m < 4; ++m) { bf16* gp = base + (size_t)(ai * 32 + m * 4) * P4G;
#pragma unroll
                    for (int bj = 0; bj < 2; ++bj)
#pragma unroll
                        for (int r = 0; r < 4; ++r) *(unsigned*)(gp + r * 256 + bj * 128) = pg8::cvt_pk_bf16(acc[ai][bj][m][0][r], acc[ai][bj][m][1][r]); }
        }
    }
};
struct EpiSwiglu {
    static constexpr bool PERM = true, AFTER_DRAIN = false;
    bf16* H;
    __device__ __forceinline__ void operator()(const pg8::f32x4 (&acc)[2][2][4][2], const pg8::Unit& u, int wr, int wc, int fr, int fq) const {
        const int row0 = u.pm * 256 + wr * 64 + fr, col0 = u.pc * 128 + wc * 32 + 8 * fq;
#pragma unroll
        for (int ai = 0; ai < 2; ++ai)
#pragma unroll
            for (int m = 0; m < 4; ++m) { bf16* rowp = H + (size_t)(row0 + ai * 128 + m * 16) * DFF + col0;
                float h[8];
#pragma unroll
                for (int n = 0; n < 2; ++n)
#pragma unroll
                    for (int j = 0; j < 4; ++j) { const float a = acc[ai][0][m][n][j], b = acc[ai][1][m][n][j];
                        h[n * 4 + j] = a * __builtin_amdgcn_rcpf(1.0f + __builtin_amdgcn_exp2f(-1.4426950408889634f * a)) * b; }
                pg8::u32x4 w; w.x = pg8::cvt_pk_bf16(h[0], h[1]); w.y = pg8::cvt_pk_bf16(h[2], h[3]); w.z = pg8::cvt_pk_bf16(h[4], h[5]); w.w = pg8::cvt_pk_bf16(h[6], h[7]);
                *(pg8::u32x4*)rowp = w; }
    }
};
struct EpiSwiglu8 {
    static constexpr bool PERM = true, AFTER_DRAIN = false;
    unsigned char* H; float sc;
    __device__ __forceinline__ void operator()(const pg8::f32x4 (&acc)[2][2][4][2], const pg8::Unit& u, int wr, int wc, int fr, int fq) const {
        const int row0 = u.pm * 256 + wr * 64 + fr, col0 = u.pc * 128 + wc * 32 + 8 * fq;
        const float c1 = -1.4426950408889634f * sc, s2 = sc * sc;
#pragma unroll
        for (int ai = 0; ai < 2; ++ai)
#pragma unroll
            for (int m = 0; m < 4; ++m) { unsigned char* rowp = H + (size_t)(row0 + ai * 128 + m * 16) * DFF + col0;
                float h[8];
#pragma unroll
                for (int n = 0; n < 2; ++n)
#pragma unroll
                    for (int j = 0; j < 4; ++j) { const float a = acc[ai][0][m][n][j], b = acc[ai][1][m][n][j];
                        const float hv = (a * b) * __builtin_amdgcn_rcpf(1.0f + __builtin_amdgcn_exp2f(c1 * a)) * s2;
                        h[n * 4 + j] = __builtin_amdgcn_fmed3f(hv, -448.0f, 448.0f); }
                unsigned w0 = 0u, w1 = 0u;
                w0 = __builtin_amdgcn_cvt_pk_fp8_f32(h[0], h[1], w0, false); w0 = __builtin_amdgcn_cvt_pk_fp8_f32(h[2], h[3], w0, true);
                w1 = __builtin_amdgcn_cvt_pk_fp8_f32(h[4], h[5], w1, false); w1 = __builtin_amdgcn_cvt_pk_fp8_f32(h[6], h[7], w1, true);
                v2u w; w.x = w0; w.y = w1; *(v2u*)rowp = w; }
    }
};
struct EpiResid {
    static constexpr bool PERM = true, AFTER_DRAIN = false;
    const float* xin_lat; const float* xin_ctx;
    bf16* xr; const float* gate; float sc; int pm_off;
    __device__ __forceinline__ void operator()(const pg8::f32x4 (&acc)[2][2][4][2], const pg8::Unit& u, int wr, int wc, int fr, int fq) const {
        const int pmg = u.pm + pm_off; const bool isctx = pmg >= 128; const int bidx = isctx ? 4 : (pmg >> 5);
        const size_t grow = (size_t)pmg * 256 + wr * 64 + fr;
        const int col0 = u.pc * 256 + wc * 32 + 8 * fq; const float* g = gate + (size_t)bidx * 6144 + col0;
        const float* xi = xin_lat ? (isctx ? xin_ctx + ((size_t)(pmg - 128) * 256 + wr * 64 + fr) * 1024 : xin_lat + grow * 1024) : (const float*)nullptr;
        pg8::f32x4 gv[2][2];
#pragma unroll
        for (int bj = 0; bj < 2; ++bj)
#pragma unroll
            for (int n = 0; n < 2; ++n) gv[bj][n] = *(const pg8::f32x4*)(g + bj * 128 + n * 4) * sc;
#pragma unroll
        for (int ai = 0; ai < 2; ++ai)
#pragma unroll
            for (int m = 0; m < 4; ++m) { const size_t roff = (size_t)(ai * 128 + m * 16) * 1024 + col0;
#pragma unroll
                for (int bj = 0; bj < 2; ++bj) {
                    pg8::f32x4 x0, x1;
                    if (xi) { x0 = *(const pg8::f32x4*)(xi + roff + bj * 128); x1 = *(const pg8::f32x4*)(xi + roff + bj * 128 + 4); }
                    else { const pg8::u32x4 w = *(const pg8::u32x4*)(xr + grow * 1024 + roff + bj * 128);
                        x0[0] = __uint_as_float(w.x << 16); x0[1] = __uint_as_float(w.x & 0xffff0000u); x0[2] = __uint_as_float(w.y << 16); x0[3] = __uint_as_float(w.y & 0xffff0000u);
                        x1[0] = __uint_as_float(w.z << 16); x1[1] = __uint_as_float(w.z & 0xffff0000u); x1[2] = __uint_as_float(w.w << 16); x1[3] = __uint_as_float(w.w & 0xffff0000u); }
                    const pg8::f32x4 y0 = x0 + gv[bj][0] * acc[ai][bj][m][0], y1 = x1 + gv[bj][1] * acc[ai][bj][m][1];
                    pg8::u32x4 o; o.x = pg8::cvt_pk_bf16(y0[0], y0[1]); o.y = pg8::cvt_pk_bf16(y0[2], y0[3]); o.z = pg8::cvt_pk_bf16(y1[0], y1[1]); o.w = pg8::cvt_pk_bf16(y1[2], y1[3]);
                    *(pg8::u32x4*)(xr + grow * 1024 + roff + bj * 128) = o; }
                asm volatile("" ::: "memory"); }
    }
};
struct EpiGlu {
    static constexpr bool PERM = true, AFTER_DRAIN = false;
    const bf16* Z; bf16* Y; const float* bias;
    __device__ __forceinline__ void operator()(const pg8::f32x4 (&acc)[2][2][4][2], const pg8::Unit& u, int wr, int wc, int fr, int fq) const {
        const int row0 = u.pm * 256 + wr * 64 + fr, col0 = wc * 32 + 8 * fq;
#pragma unroll
        for (int ai = 0; ai < 2; ++ai)
#pragma unroll
            for (int m = 0; m < 4; ++m) { const size_t row = (size_t)(row0 + ai * 128 + m * 16);
#pragma unroll
                for (int bj = 0; bj < 2; ++bj) { const int col = col0 + bj * 128;
                    const pg8::u32x4 zz = *(const pg8::u32x4*)(Z + row * 256 + col);
                    const pg8::f32x4 b0 = *(const pg8::f32x4*)(bias + col), b1 = *(const pg8::f32x4*)(bias + col + 4);
                    const pg8::f32x4 v0 = acc[ai][bj][m][0] + b0, v1 = acc[ai][bj][m][1] + b1;
                    float o[8]; const unsigned zw[4] = {zz.x, zz.y, zz.z, zz.w};
#pragma unroll
                    for (int j = 0; j < 4; ++j) { const float zl = __uint_as_float(zw[j] << 16), zh = __uint_as_float(zw[j] & 0xffff0000u);
                        const float a0 = (j < 2) ? v0[2 * j] : v1[2 * j - 4], a1 = (j < 2) ? v0[2 * j + 1] : v1[2 * j - 3];
                        o[2 * j] = zl * sigm(a0); o[2 * j + 1] = zh * sigm(a1); }
                    pg8::u32x4 w; w.x = pg8::cvt_pk_bf16(o[0], o[1]); w.y = pg8::cvt_pk_bf16(o[2], o[3]); w.z = pg8::cvt_pk_bf16(o[4], o[5]); w.w = pg8::cvt_pk_bf16(o[6], o[7]);
                    *(pg8::u32x4*)(Y + row * 1024 + 256 + col) = w; }
                asm volatile("" ::: "memory"); }
    }
};
struct MoeOrder {
    int tp[9]; int nN, G, c, total;
    __device__ __forceinline__ void init(const unsigned* cnt, int nN_, int G_, int c_) {
        tp[0] = 0;
#pragma unroll
        for (int e = 0; e < 8; ++e) tp[e + 1] = tp[e] + (int)(((unsigned)__builtin_amdgcn_readfirstlane((int)__hip_atomic_load(cnt + e * 64, __ATOMIC_RELAXED, __HIP_MEMORY_SCOPE_AGENT)) + 255u) >> 8);
        nN = nN_; G = G_; c = c_; total = tp[8] * nN;
    }
    __device__ __forceinline__ bool next(int i, pg8::Unit& u) const {
        const int L = i * G + c; if (L >= total) return false;
        int wgid = L; { const int q = total / pg8::NXCD, r = total % pg8::NXCD, xcd = wgid % pg8::NXCD, off = wgid / pg8::NXCD; wgid = (xcd < r ? xcd * (q + 1) : r * (q + 1) + (xcd - r) * q) + off; }
        const int nM = tp[8], nig = pg8::WGM * nN, gid = wgid / nig, fm = gid * pg8::WGM, gsz = (nM - fm) < pg8::WGM ? (nM - fm) : pg8::WGM;
        const int rem = wgid - gid * nig, t = fm + rem % gsz, pn = rem / gsz; int e = 0;
#pragma unroll
        for (int k = 1; k < 8; ++k) e += (t >= tp[k]) ? 1 : 0;
        u.pm = t; u.pn = e * nN + pn; u.pc = pn; return true;
    }
    const unsigned* cntp; const int* LISTp;
    __device__ __forceinline__ unsigned arow_off(const pg8::Unit& u, int r) const {
        int e = 0, tpe = 0;
#pragma unroll
        for (int k = 1; k < 8; ++k) { const bool ge = u.pm >= tp[k]; e += ge ? 1 : 0; tpe = ge ? tp[k] : tpe; }
        const int ce = __builtin_amdgcn_readfirstlane((int)__hip_atomic_load(cntp + e * 64, __ATOMIC_RELAXED, __HIP_MEMORY_SCOPE_AGENT));
        const int pos = (u.pm - tpe) * 256 + r;
        return pos < ce ? (unsigned)WS_ACT + (unsigned)LISTp[e * MT + pos] * 1024u : (unsigned)ZROW_OFF;
    }
    __device__ __forceinline__ void a_ready(const pg8::Unit&) const {}
    __device__ __forceinline__ void done(const pg8::Unit&) const {}
};

__device__ __forceinline__ void cvt_item(const float* W, int K, int N, bf16* WT, int mode, int add, LAS float* scr, int item, int lane, int nblk_override = 0, const float* ks = nullptr  ) {
    const int nblk = nblk_override ? nblk_override : (N >> 5), kb = item / nblk, nb = item - kb * nblk, k0 = 64 * kb, n0 = 32 * nb;
    const int r = lane >> 3, c4 = lane & 7;
    f32x4 v[8];
#pragma unroll
    for (int i = 0; i < 8; ++i) v[i] = *(const f32x4*)(W + (size_t)(k0 + 8 * i + r) * N + n0 + 4 * c4);
    if (ks) {
#pragma unroll
        for (int i = 0; i < 8; ++i) v[i] *= ks[8 * i + r]; }
#pragma unroll
    for (int i = 0; i < 8; ++i) {
#pragma unroll
        for (int j = 0; j < 4; ++j) scr[(8 * i + r) * 33 + 4 * c4 + j] = v[i][j]; }
    LDS_WAIT();
    const int c = lane & 7;
#pragma unroll
    for (int j = 0; j < 4; ++j) { const int n = (lane >> 3) + 8 * j; const LAS float* s = scr + (8 * c) * 33 + n;
        v4u o; o.x = pk2(s[0 * 33], s[1 * 33]); o.y = pk2(s[2 * 33], s[3 * 33]); o.z = pk2(s[4 * 33], s[5 * 33]); o.w = pk2(s[6 * 33], s[7 * 33]);
        const int nn = n0 + n; const int drow = (mode == 0) ? (nn + add) : (((nn >> 7) << 8) + (nn & 127) + add);
        *(v4u*)(WT + (size_t)drow * K + k0 + 8 * c) = o; }
    LDS_WAIT();
}
__device__ __forceinline__ void cvt_item_f8(const float* W, int K, int N, unsigned char* WT, int mode, int add, LAS float* scr, int item, int lane) {
    const int nblk = N >> 5, kb = item / nblk, nb = item - kb * nblk, k0 = 64 * kb, n0 = 32 * nb;
    const int r = lane >> 3, c4 = lane & 7;
    f32x4 v[8];
#pragma unroll
    for (int i = 0; i < 8; ++i) v[i] = *(const f32x4*)(W + (size_t)(k0 + 8 * i + r) * N + n0 + 4 * c4);
#pragma unroll
    for (int i = 0; i < 8; ++i) {
#pragma unroll
        for (int j = 0; j < 4; ++j) scr[(8 * i + r) * 33 + 4 * c4 + j] = v[i][j]; }
    LDS_WAIT();
    const int c = lane & 3;
#pragma unroll
    for (int j = 0; j < 2; ++j) { const int n = (lane >> 2) + 16 * j; const LAS float* s = scr + (16 * c) * 33 + n;
        unsigned w[4];
#pragma unroll
        for (int q = 0; q < 4; ++q) { unsigned x = 0u;
            x = __builtin_amdgcn_cvt_pk_fp8_f32(s[(4 * q) * 33] * WSC8, s[(4 * q + 1) * 33] * WSC8, x, false);
            x = __builtin_amdgcn_cvt_pk_fp8_f32(s[(4 * q + 2) * 33] * WSC8, s[(4 * q + 3) * 33] * WSC8, x, true); w[q] = x; }
        v4u o; o.x = w[0]; o.y = w[1]; o.z = w[2]; o.w = w[3];
        const int nn = n0 + n; const int drow = (mode == 0) ? (nn + add) : (((nn >> 7) << 8) + (nn & 127) + add);
        *(v4u*)(WT + (size_t)drow * K + k0 + 16 * c) = o; }
    LDS_WAIT();
}
__device__ __forceinline__ void moe_cvt_idle(const Frame& F, const Args& a, int j, int b_lo) {
    LAS float* scr = (LAS float*)(F.lds + F.wave * 16384);
    constexpr int IT = 1408;
    const int nw = (F.G - b_lo) * 8, w = ((int)blockIdx.x - b_lo) * 8 + F.wave;
    for (int it = w; it < 8 * 3 * IT; it += nw) {
        const int e = it / (3 * IT), r = it - e * 3 * IT, which = r / IT, item = r - which * IT;
        const size_t eo = ((size_t)j * 8 + e) * (size_t)(1024 * DFF);
        if (which == 0) cvt_item_f8(a.in[F.zz + I_MW1] + eo, 1024, DFF, F.ws + WS_W13M + (size_t)e * 5632 * 1024, 1, 0, scr, item, F.lane);
        else if (which == 1) cvt_item_f8(a.in[F.zz + I_MW3] + eo, 1024, DFF, F.ws + WS_W13M + (size_t)e * 5632 * 1024, 1, 128, scr, item, F.lane);
        else cvt_item_f8(a.in[F.zz + I_MW2] + eo, DFF, 1024, F.ws + WS_W2M + (size_t)e * 1024 * DFF, 0, 0, scr, item, F.lane);
    }
}
__device__ __forceinline__ void moe_cvt(const Frame& F, const Args& a, int j) {
    LAS float* scr = (LAS float*)(F.lds + F.wave * 16384);
    constexpr int IT = 1408;
    for (int it = F.gw; it < 8 * 3 * IT; it += F.NGW) {
        const int e = it / (3 * IT), r = it - e * 3 * IT, which = r / IT, item = r - which * IT;
        const size_t eo = ((size_t)j * 8 + e) * (size_t)(1024 * DFF);
        if (which == 0) cvt_item_f8(a.in[F.zz + I_MW1] + eo, 1024, DFF, F.ws + WS_W13M + (size_t)e * 5632 * 1024, 1, 0, scr, item, F.lane);
        else if (which == 1) cvt_item_f8(a.in[F.zz + I_MW3] + eo, 1024, DFF, F.ws + WS_W13M + (size_t)e * 5632 * 1024, 1, 128, scr, item, F.lane);
        else cvt_item_f8(a.in[F.zz + I_MW2] + eo, DFF, 1024, F.ws + WS_W2M + (size_t)e * 1024 * DFF, 0, 0, scr, item, F.lane);
    }
}
__device__ __forceinline__ void prologue(const Frame& F, const Args& a) {
    {
        LAS float* sc = (LAS float*)F.lds; LAS float* red = sc + 5120;
        for (int idx = F.tid; idx < 5120; idx += 512) { const int r = idx >> 10, k = idx & 1023; const float cv = (r < 4) ? a.in[F.zz + I_C][r * 1024 + k] : a.in[F.zz + I_CCTX][k]; sc[idx] = silu_f(cv); }
        __syncthreads();
        float* MOD = (float*)(F.ws + WS_MOD);
        for (int item = blockIdx.x; item < 384; item += F.G) {
            const int l = item / 96, nb = item - l * 96, cl = F.tid & 63, ks = F.tid >> 6, n = nb * 64 + cl;
            float acc[5] = {0.f, 0.f, 0.f, 0.f, 0.f};
            const float* wp = a.in[F.zz + I_ADAW] + ((size_t)l * 1024 + ks * 128) * 6144 + n;
#pragma unroll 16
            for (int kk = 0; kk < 128; ++kk) { const float w = wp[(size_t)kk * 6144];
#pragma unroll
                for (int r = 0; r < 5; ++r) acc[r] = fmaf(sc[r * 1024 + ks * 128 + kk], w, acc[r]); }
#pragma unroll
            for (int r = 0; r < 5; ++r) red[(ks * 5 + r) * 64 + cl] = acc[r];
            __syncthreads();
            if (F.tid < 320) { const int r = F.tid >> 6; float s = 0.f;
#pragma unroll
                for (int k2 = 0; k2 < 8; ++k2) s += red[(k2 * 5 + r) * 64 + cl];
                MOD[((size_t)l * 5 + r) * 6144 + n] = s + a.in[F.zz + I_ADAB][l * 6144 + n]; }
            __syncthreads();
        }
        if (blockIdx.x == 0 && F.tid < 256) {
            const float* lg = a.in[F.zz + I_LBL]; float x[4], mx = -3.0e38f;
#pragma unroll
            for (int l = 0; l < 4; ++l) { x[l] = lg[l * 256 + F.tid]; mx = fmaxf(mx, x[l]); }
            float s = 0.f;
#pragma unroll
            for (int l = 0; l < 4; ++l) { x[l] = expf(x[l] - mx); s += x[l]; }
            float cs = 0.f; const float sm0 = x[0] / s; float* LB = (float*)(F.ws + WS_LB);
#pragma unroll
            for (int l = 0; l < 4; ++l) { cs += x[l] / s; LB[l * 256 + F.tid] = fminf(fmaxf(cs - sm0, 0.f), 1.0f - 1e-6f); }
        }
        if (blockIdx.x == (1 % F.G)) {
            float* RC = (float*)(F.ws + WS_ROPE); float* RS = RC + 2048;
            for (int idx = F.tid; idx < 2048; idx += 512) { const int pos = idx >> 4, i = idx & 15;
                const float fr = powf(10000.0f, -(float)i / 16.0f); const float ang = (float)pos * fr; RC[idx] = cosf(ang); RS[idx] = sinf(ang); }
        }
        __syncthreads();
    }
    LAS float* scr = (LAS float*)(F.lds + F.wave * 16384);
    constexpr int I_IN = 16 * 104, I_OUT = 16 * 32, I_F = 1408, I_GL = 4 * 8;
    constexpr int NIT = 4 * I_IN + 4 * I_OUT + 6 * I_F + 4 * I_GL;
    for (int it = F.gw; it < NIT; it += F.NGW) {
        int r = it;
        if (r < 4 * I_IN) { const int l = r / I_IN; cvt_item(a.in[F.zz + I_WIN] + (size_t)l * 1024 * DIN, 1024, DIN, (bf16*)(F.ws + WS_WIN) + (size_t)l * DINP * 1024, 0, 0, scr, r - l * I_IN, F.lane, 104); continue; } r -= 4 * I_IN;
        if (r < 4 * I_OUT) { const int l = r / I_OUT, it = r - l * I_OUT, k0 = 64 * (it >> 5);
            const float* ks = k0 < 256 ? a.in[F.zz + I_RETGN] + l * 256 + k0 : (k0 < 512 ? nullptr : (k0 < 768 ? a.in[F.zz + I_HGNW] + l * 256 + (k0 - 512) : a.in[F.zz + I_GLANW] + l * 256 + (k0 - 768)));
            cvt_item(a.in[F.zz + I_WOUT] + (size_t)l * 1024 * 1024, 1024, 1024, (bf16*)(F.ws + WS_WOUT) + (size_t)l * 1024 * 1024, 0, 0, scr, it, F.lane, 0, ks); continue; } r -= 4 * I_OUT;
        if (r < 6 * I_F) { const int j = r / (3 * I_F), r2 = r - j * 3 * I_F, which = r2 / I_F, item = r2 - which * I_F; const size_t wo = (size_t)j * 1024 * DFF;
            if (j == FP8_F1_J && which < 2) {
                if (which == 0) cvt_item_f8(a.in[F.zz + I_FW1] + wo, 1024, DFF, F.ws + WS_W13D + (size_t)j * 5632 * 1024 * 2, 1, 0, scr, item, F.lane);
                else if (which == 1) cvt_item_f8(a.in[F.zz + I_FW3] + wo, 1024, DFF, F.ws + WS_W13D + (size_t)j * 5632 * 1024 * 2, 1, 128, scr, item, F.lane);
            } else
            if (which == 0) cvt_item(a.in[F.zz + I_FW1] + wo, 1024, DFF, (bf16*)(F.ws + WS_W13D) + (size_t)j * 5632 * 1024, 1, 0, scr, item, F.lane);
            else if (which == 1) cvt_item(a.in[F.zz + I_FW3] + wo, 1024, DFF, (bf16*)(F.ws + WS_W13D) + (size_t)j * 5632 * 1024, 1, 128, scr, item, F.lane);
            else cvt_item_f8(a.in[F.zz + I_FW2] + wo, DFF, 1024, F.ws + WS_W2D + (size_t)j * 1024 * DFF, 0, 0, scr, item, F.lane);
            continue; } r -= 6 * I_F;
        { const int l = r / I_GL; cvt_item(a.in[F.zz + I_GLUW] + (size_t)l * 65536, 256, 256, (bf16*)(F.ws + WS_GLUW) + (size_t)l * 65536, 0, 0, scr, r - l * I_GL, F.lane); }
    }
    for (int i = blockIdx.x * 512 + F.tid; i < 4 * 256 * 128; i += F.G * 512) {
        const int l = i >> 15, rem = i & 32767, n = rem >> 7, k0 = (rem & 127) * 8, d = n >> 7, cidx = n & 127;
        const float* wa = a.in[F.zz + I_WA2] + ((size_t)(l * 2 + d) * 16) * 128 + cidx;
        float acc[8] = {0.f, 0.f, 0.f, 0.f, 0.f, 0.f, 0.f, 0.f};
#pragma unroll
        for (int r = 0; r < 16; ++r) { const float w2 = wa[r * 128];
#pragma unroll
            for (int kk = 0; kk < 8; ++kk) acc[kk] = fmaf(a.in[F.zz + I_WIN][((size_t)l * 1024 + k0 + kk) * DIN + 3328 + 16 * d + r], w2, acc[kk]); }
        v4u o; o.x = pk2(acc[0], acc[1]); o.y = pk2(acc[2], acc[3]); o.z = pk2(acc[4], acc[5]); o.w = pk2(acc[6], acc[7]);
        *(v4u*)((bf16*)(F.ws + WS_WIN) + ((size_t)l * DINP + 3328 + n) * 1024 + k0) = o;
    }
}

struct MoeTp { int tp[9]; };
__device__ __forceinline__ void load_tp(MoeTp& t, const unsigned* cnt) {
    t.tp[0] = 0;
#pragma unroll
    for (int e = 0; e < 8; ++e) t.tp[e + 1] = t.tp[e] + (int)(((unsigned)__builtin_amdgcn_readfirstlane((int)__hip_atomic_load(cnt + e * 64, __ATOMIC_RELAXED, __HIP_MEMORY_SCOPE_AGENT)) + 255u) >> 8);
}
__device__ __forceinline__ void moe_route_flush(const Frame& F, int jm, int nk, int rt_e, int rt_m, float g0, float g1) {
    unsigned* cnt = (unsigned*)F.ws + CW_CNT + jm * 8 * 64; int* LIST = (int*)(F.ws + WS_LIST);
    int* EPw = (int*)(F.ws + WS_LIST) + 8 * MT; float* GW = (float*)(F.ws + WS_LIST) + 10 * MT;
    const bool has = F.lane < nk; const int e0 = rt_e & 15, e1 = rt_e >> 4;
    unsigned p0 = 0u, p1 = 0u;
#pragma unroll
    for (int e = 0; e < 8; ++e) {
        const unsigned long long b0 = __ballot(has && e0 == e), b1 = __ballot(has && e1 == e);
        const unsigned c0 = (unsigned)__popcll(b0), c = c0 + (unsigned)__popcll(b1);
        if (c == 0u) continue;
        unsigned base = 0u;
        if (F.lane == 0) base = __hip_atomic_fetch_add(cnt + e * 64, c, __ATOMIC_RELAXED, __HIP_MEMORY_SCOPE_AGENT);
        base = (unsigned)__builtin_amdgcn_readfirstlane((int)base);
        const unsigned long long below = (1ull << F.lane) - 1ull;
        if (has && e0 == e) p0 = base + (unsigned)__popcll(b0 & below);
        if (has && e1 == e) p1 = base + c0 + (unsigned)__popcll(b1 & below);
    }
    if (has) {
        LIST[e0 * MT + p0] = rt_m; LIST[e1 * MT + p1] = rt_m;
        EPw[2 * rt_m] = e0 | (int)(p0 << 3); EPw[2 * rt_m + 1] = e1 | (int)(p1 << 3);
        GW[2 * rt_m] = g0; GW[2 * rt_m + 1] = g1;
    }
}
template <int MODE, bool XC = true  >
__device__ __forceinline__ void norm_phase(const Frame& F, const Args& a, int l, int which  , int nrows, int comb_l  ,
                                           int row_lo = 0, int w0 = -1  , int nwav = 0) {
    const int wv_ = (w0 < 0) ? F.gw : w0, nwv_ = (w0 < 0) ? F.NGW : nwav;
    const float* MOD = (const float*)(F.ws + WS_MOD);
    const float* nw = (MODE == 2) ? a.in[F.zz + I_FINW] : ((which ? a.in[F.zz + I_N2W] : a.in[F.zz + I_N1W]) + l * 1024);
    bf16* XN = (bf16*)(F.ws + WS_ACT);
    bf16* XR = (bf16*)(F.ws + WS_XR);
    const int* EP = (const int*)(F.ws + WS_LIST) + 8 * MT; const float* GATE = (const float*)(F.ws + WS_LIST) + 10 * MT;
    const bf16* YM = (const bf16*)(F.ws + WS_X2);
    MoeTp ctp; if (comb_l >= 0) load_tp(ctp, (const unsigned*)F.ws + CW_CNT + (comb_l >> 1) * 8 * 64);
    const int jm = l >> 1;
    LAS float* rwl = (LAS float*)F.lds;
    if (MODE == 1) {
        const float* rw = a.in[F.zz + I_RW] + (size_t)jm * 8192;
        for (int idx = F.tid; idx < 8192; idx += 512) { const int k = idx >> 3, e = idx & 7; rwl[e * 1024 + k] = rw[idx]; }
        __syncthreads();
    }
    f32x4 wv[4];
#pragma unroll
    for (int j = 0; j < 4; ++j) wv[j] = *((const f32x4*)nw + F.lane + 64 * j);
    f32x4 vn[4]; v2u vnr[4]; int epn0 = 0, epn1 = 0; float gn0 = 0.f, gn1 = 0.f, gq0 = 0.f, gq1 = 0.f; v2u ymn0[4], ymn1[4];
#pragma unroll
    for (int j = 0; j < 4; ++j) { ymn0[j] = (v2u){0u, 0u}; ymn1[j] = (v2u){0u, 0u}; }
    { const int m = (row_lo + wv_ < nrows) ? row_lo + wv_ : row_lo; const bool isctx = m >= NLAT;
      const float* xr = isctx ? a.in[F.zz + I_CTX] + (size_t)(m - NLAT) * 1024 : a.in[F.zz + I_X] + (size_t)m * 1024;
#pragma unroll
      for (int j = 0; j < 4; ++j) { if (XC) vnr[j] = *((const v2u*)(XR + (size_t)m * 1024) + F.lane + 64 * j); else vn[j] = *((const f32x4*)xr + F.lane + 64 * j); }
      if (comb_l >= 0) { const int e0 = EP[2 * m], e1 = EP[2 * m + 1]; gn0 = GATE[2 * m]; gn1 = GATE[2 * m + 1];
          int t0 = 0, t1 = 0;
#pragma unroll
          for (int e = 0; e < 8; ++e) { t0 = ((e0 & 7) == e) ? ctp.tp[e] : t0; t1 = ((e1 & 7) == e) ? ctp.tp[e] : t1; }
          const size_t d0 = (size_t)t0 * 256 + (e0 >> 3), d1 = (size_t)t1 * 256 + (e1 >> 3);
#pragma unroll
          for (int j = 0; j < 4; ++j) { ymn0[j] = *((const v2u*)(YM + d0 * 1024) + F.lane + 64 * j); ymn1[j] = *((const v2u*)(YM + d1 * 1024) + F.lane + 64 * j); }
          const int m1 = (m + nwv_ < nrows) ? m + nwv_ : m;
          epn0 = EP[2 * m1]; epn1 = EP[2 * m1 + 1]; gq0 = GATE[2 * m1]; gq1 = GATE[2 * m1 + 1]; } }
    int mod_b = -1; f32x4 ms0[4], ms1[4];
#pragma unroll
    for (int j = 0; j < 4; ++j) { ms0[j] = (f32x4){0.f, 0.f, 0.f, 0.f}; ms1[j] = ms0[j]; }
    int rt_k = 0, rt_e = 0, rt_m = 0; float rt_g0 = 0.f, rt_g1 = 0.f;
    for (int m = row_lo + wv_; m < nrows; m += nwv_) {
        const bool isctx = m >= NLAT; const int bidx = isctx ? 4 : (m >> 13);
        f32x4 v[4];
#pragma unroll
        for (int j = 0; j < 4; ++j) { if (XC) { v[j][0] = __uint_as_float(vnr[j].x << 16); v[j][1] = __uint_as_float(vnr[j].x & 0xffff0000u); v[j][2] = __uint_as_float(vnr[j].y << 16); v[j][3] = __uint_as_float(vnr[j].y & 0xffff0000u); } else v[j] = vn[j]; }
        const float g0 = gn0, g1 = gn1; v2u ym0[4], ym1[4];
#pragma unroll
        for (int j = 0; j < 4; ++j) { ym0[j] = ymn0[j]; ym1[j] = ymn1[j]; }
        { const int mn = (m + nwv_ < nrows) ? m + nwv_ : m; const bool cn = mn >= NLAT;
          const float* xr = cn ? a.in[F.zz + I_CTX] + (size_t)(mn - NLAT) * 1024 : a.in[F.zz + I_X] + (size_t)mn * 1024;
#pragma unroll
          for (int j = 0; j < 4; ++j) { if (XC) vnr[j] = *((const v2u*)(XR + (size_t)mn * 1024) + F.lane + 64 * j); else vn[j] = *((const f32x4*)xr + F.lane + 64 * j); }
          if (comb_l >= 0) {
              int t0 = 0, t1 = 0;
#pragma unroll
              for (int e = 0; e < 8; ++e) { t0 = ((epn0 & 7) == e) ? ctp.tp[e] : t0; t1 = ((epn1 & 7) == e) ? ctp.tp[e] : t1; }
              const size_t d0 = (size_t)t0 * 256 + (epn0 >> 3), d1 = (size_t)t1 * 256 + (epn1 >> 3);
#pragma unroll
              for (int j = 0; j < 4; ++j) { ymn0[j] = *((const v2u*)(YM + d0 * 1024) + F.lane + 64 * j); ymn1[j] = *((const v2u*)(YM + d1 * 1024) + F.lane + 64 * j); }
              gn0 = gq0; gn1 = gq1;
              const int mn2 = (mn + nwv_ < nrows) ? mn + nwv_ : mn;
              epn0 = EP[2 * mn2]; epn1 = EP[2 * mn2 + 1]; gq0 = GATE[2 * mn2]; gq1 = GATE[2 * mn2 + 1]; } }
        if (comb_l >= 0) {
            const float* m5 = MOD + ((size_t)comb_l * 5 + bidx) * 6144 + 5 * 1024;
#pragma unroll
            for (int j = 0; j < 4; ++j) {
                const v2u y0 = ym0[j], y1 = ym1[j];
                const f32x4 mm = *((const f32x4*)m5 + F.lane + 64 * j);
                f32x4 f0, f1;
                f0[0] = __uint_as_float(y0.x << 16); f0[1] = __uint_as_float(y0.x & 0xffff0000u); f0[2] = __uint_as_float(y0.y << 16); f0[3] = __uint_as_float(y0.y & 0xffff0000u);
                f1[0] = __uint_as_float(y1.x << 16); f1[1] = __uint_as_float(y1.x & 0xffff0000u); f1[2] = __uint_as_float(y1.y << 16); f1[3] = __uint_as_float(y1.y & 0xffff0000u);
                v[j] = v[j] + mm * (f0 * g0 + f1 * g1);
                if (MODE != 2) { v2u w; w.x = pk2(v[j][0], v[j][1]); w.y = pk2(v[j][2], v[j][3]); *((v2u*)(XR + (size_t)m * 1024) + F.lane + 64 * j) = w; }
            }
        }
        float ss = 0.f;
#pragma unroll
        for (int j = 0; j < 4; ++j) ss += (v[j][0] * v[j][0] + v[j][1] * v[j][1]) + (v[j][2] * v[j][2] + v[j][3] * v[j][3]);
        ss = wave_sum(ss);
        const float rstd = __builtin_amdgcn_rsqf(ss * (1.0f / 1024.0f) + NEPS);
        if (MODE == 2) {
#pragma unroll
            for (int j = 0; j < 4; ++j) *((f32x4*)(F.out + (size_t)m * 1024) + F.lane + 64 * j) = v[j] * rstd * wv[j];
        } else {
            if (bidx != mod_b) {
                const float* sh = MOD + ((size_t)l * 5 + bidx) * 6144 + (which ? 3 : 0) * 1024; const float* scl = sh + 1024;
#pragma unroll
                for (int j = 0; j < 4; ++j) { ms1[j] = *((const f32x4*)scl + F.lane + 64 * j) + 1.0f; ms0[j] = *((const f32x4*)sh + F.lane + 64 * j); }
                mod_b = bidx;
            }
            f32x4 o[4];
#pragma unroll
            for (int j = 0; j < 4; ++j) {
                o[j] = (v[j] * rstd * wv[j]) * ms1[j] + ms0[j];
                if (MODE == 1 || MODE == 3) {
                    unsigned w8 = 0u; w8 = __builtin_amdgcn_cvt_pk_fp8_f32(fminf(fmaxf(o[j][0], -448.f), 448.f), fminf(fmaxf(o[j][1], -448.f), 448.f), w8, false);
                    w8 = __builtin_amdgcn_cvt_pk_fp8_f32(fminf(fmaxf(o[j][2], -448.f), 448.f), fminf(fmaxf(o[j][3], -448.f), 448.f), w8, true);
                    *((unsigned*)((unsigned char*)XN + (size_t)m * 1024) + F.lane + 64 * j) = w8;
                } else { v2u w; w.x = pk2(o[j][0], o[j][1]); w.y = pk2(o[j][2], o[j][3]);
                    *((v2u*)(XN + (size_t)m * 1024) + F.lane + 64 * j) = w; } }
            if (MODE == 1) {
                float p[8];
#pragma unroll
                for (int e = 0; e < 8; ++e) { float s = 0.f;
#pragma unroll
                    for (int j = 0; j < 4; ++j) { const f32x4 w4 = *((const LAS f32x4*)(rwl + e * 1024) + F.lane + 64 * j);
                        s += (o[j][0] * w4[0] + o[j][1] * w4[1]) + (o[j][2] * w4[2] + o[j][3] * w4[3]); }
                    p[e] = wave_sum(s) + a.in[F.zz + I_RB][jm * 8 + e]; }
                int e0 = 0; float v0 = p[0];
#pragma unroll
                for (int e = 1; e < 8; ++e) if (p[e] > v0) { v0 = p[e]; e0 = e; }
                int e1 = -1; float v1 = -3.0e38f;
#pragma unroll
                for (int e = 0; e < 8; ++e) if (e != e0 && p[e] > v1) { v1 = p[e]; e1 = e; }
                const float ex = expf(v1 - v0), g0 = 1.0f / (1.0f + ex), g1 = ex / (1.0f + ex);
                if (F.lane == rt_k) { rt_e = e0 | (e1 << 4); rt_m = m; rt_g0 = g0; rt_g1 = g1; }
                ++rt_k;
                if (rt_k == 64) { moe_route_flush(F, jm, rt_k, rt_e, rt_m, rt_g0, rt_g1); rt_k = 0; }
            }
        }
    }
    if (MODE == 1) { if (rt_k > 0) moe_route_flush(F, jm, rt_k, rt_e, rt_m, rt_g0, rt_g1); __syncthreads(); }
}
__device__ __forceinline__ void moe_gather(const Frame& F, int jm) {
    const unsigned* cnt = (const unsigned*)F.ws + CW_CNT + jm * 8 * 64;
    MoeTp t; load_tp(t, cnt);
    int cn[8];
#pragma unroll
    for (int e = 0; e < 8; ++e) cn[e] = __builtin_amdgcn_readfirstlane((int)__hip_atomic_load(cnt + e * 64, __ATOMIC_RELAXED, __HIP_MEMORY_SCOPE_AGENT));
    const int rows = t.tp[8] * 256;
    const int* LIST = (const int*)(F.ws + WS_LIST); const v4u* XN = (const v4u*)(F.ws + WS_ACT); v4u* XB = (v4u*)(F.ws + WS_X2);
    for (int r0 = F.gw; r0 < rows; r0 += 8 * F.NGW) {
        int src[8];
#pragma unroll
        for (int q = 0; q < 8; ++q) { const int r = r0 + q * F.NGW; src[q] = -1;
            if (r < rows) { const int tile = r >> 8; int e = 0, tpe = 0, ce = cn[0];
#pragma unroll
                for (int k = 1; k < 8; ++k) { const bool ge = tile >= t.tp[k]; e += ge ? 1 : 0; tpe = ge ? t.tp[k] : tpe; ce = ge ? cn[k] : ce; }
                const int pos = r - tpe * 256;
                if (pos < ce) src[q] = LIST[e * MT + pos]; } }
        v4u x[8];
#pragma unroll
        for (int q = 0; q < 8; ++q) { x[q] = (v4u){0u, 0u, 0u, 0u}; if (src[q] >= 0) x[q] = XN[(size_t)src[q] * 64 + F.lane]; }
#pragma unroll
        for (int q = 0; q < 8; ++q) { const int r = r0 + q * F.NGW; if (r < rows) XB[(size_t)r * 64 + F.lane] = x[q]; }
    }
}
#define GLD(T, ubase, voff) (*(const T*)((const char*)(ubase) + (unsigned)(voff)))
#define GST(T, ubase, voff) (*(T*)((char*)(ubase) + (unsigned)(voff)))
__device__ __forceinline__ int fresh_lane() { int l; asm volatile("v_mbcnt_lo_u32_b32 %0, -1, 0\n\tv_mbcnt_hi_u32_b32 %0, -1, %0" : "=v"(l)); return l; }

struct MixP { const bf16* P; const float* lb; const float* rcos; const float* rsin; const float* ba; };
__device__ __forceinline__ int seg_row0(int b, int sg) { return sg < 4 ? NLAT + b * CTXL + sg * 64 : b * SEQ + (sg - 4) * 64; }
__device__ __forceinline__ int seg_tpos0(int sg) { return sg < 4 ? -1 : (sg - 4) * 64; }

struct S5P { const float *lam_re, *lam_im, *log_dt, *b_re, *b_im, *c_re, *c_im, *dd; const unsigned* par; };
__device__ __forceinline__ float gelu_tanh(float y) { const float t = 0.7978845608028654f * (y + 0.044715f * y * y * y); const float th = 1.0f - 2.0f * __builtin_amdgcn_rcpf(1.0f + __expf(2.0f * t)); return 0.5f * y * (1.0f + th); }
template <int MODE>
__device__ __forceinline__ void s5_scan(const S5P& sp, const bf16* P, int b, int g, int dir, int sg, int lane, float& hre, float& him, LAS float* yf, LAS float* stg, bf16* Z) {
    const int row0 = seg_row0(b, sg); const int dg = dir * 16 + g;
    const float lre = sp.lam_re[dg * 64 + lane], lim = sp.lam_im[dg * 64 + lane], dt = expf(sp.log_dt[dg]);
    const float er = expf(lre * dt); const float sn = sinf(lim * dt), cs = cosf(lim * dt);
    const float ar = er * cs, ai = er * sn;
    const float nr = ar - 1.0f, ni = ai, den = lre * lre + lim * lim;
    const float cr = (nr * lre + ni * lim) / den, ci = (ni * lre - nr * lim) / den;
    float bbr[16], bbi[16], Cr[16], Ci[16];
#pragma unroll
    for (int c = 0; c < 16; ++c) { const float Br = sp.b_re[((size_t)dg * 64 + lane) * 16 + c], Bi = sp.b_im[((size_t)dg * 64 + lane) * 16 + c];
        bbr[c] = cr * Br - ci * Bi; bbi[c] = cr * Bi + ci * Br;
        Cr[c] = (MODE != 0) ? sp.c_re[((size_t)dg * 16 + c) * 64 + lane] : 0.f; Ci[c] = (MODE != 0) ? sp.c_im[((size_t)dg * 16 + c) * 64 + lane] : 0.f; }
    const int ch = ((lane >> 5) & 1) * 8 + ((lane >> 4) & 1) * 4 + ((lane >> 3) & 1) * 2 + ((lane >> 2) & 1);
    const float dv = (MODE == 2) ? sp.dd[g * 16 + ch] : 0.f;
    const bool b5 = lane & 32, b4 = lane & 16, b3 = lane & 8, b2 = lane & 4;
    const unsigned ucol = 2u * (unsigned)(C_S5 + g * 16 + (lane & 15));
    unsigned short rn0[4], rn1[4], rn2[4];
#pragma unroll
    for (int u = 0; u < 4; ++u) { rn0[u] = GLD(unsigned short, P + (size_t)(row0 + (dir ? 63 - u : u)) * DINP, ucol); rn1[u] = GLD(unsigned short, P + (size_t)(row0 + (dir ? 59 - u : 4 + u)) * DINP, ucol);
        rn2[u] = GLD(unsigned short, P + (size_t)(row0 + (dir ? 55 - u : 8 + u)) * DINP, ucol); }
#pragma unroll 1
    for (int i0 = 0; i0 < 64; i0 += 4) {
        unsigned short ru[4], rn3[4];
        const int ip = (i0 + 12 < 64) ? i0 + 12 : 60;
#pragma unroll
        for (int u = 0; u < 4; ++u) { ru[u] = rn0[u]; rn3[u] = GLD(unsigned short, P + (size_t)(row0 + (dir ? 63 - (ip + u) : (ip + u))) * DINP, ucol); }
#pragma unroll
        for (int u = 0; u < 4; ++u) stg[u * 64 + lane] = bf2f(ru[u]);
#pragma unroll
        for (int u = 0; u < 4; ++u) {
            const int ti = dir ? 63 - (i0 + u) : (i0 + u);
            const float uf = bf2f(ru[u]);
            float bur = 0.f, bui = 0.f;
#pragma unroll
            for (int c4 = 0; c4 < 4; ++c4) { const f32x4 ux = *(const LAS f32x4*)(stg + u * 64 + 4 * c4);
#pragma unroll
                for (int jj = 0; jj < 4; ++jj) { bur = fmaf(bbr[4 * c4 + jj], ux[jj], bur); bui = fmaf(bbi[4 * c4 + jj], ux[jj], bui); } }
            const float nre = ar * hre - ai * him + bur, nim = ar * him + ai * hre + bui;
            hre = nre; him = nim;
            if (MODE != 0) {
                float v[16];
#pragma unroll
                for (int c = 0; c < 16; ++c) v[c] = Cr[c] * hre - Ci[c] * him;
                float w8[8], w4[4], w2[2], w1;
#pragma unroll
                for (int i = 0; i < 8; ++i) { const float mine = b5 ? v[8 + i] : v[i], oth = b5 ? v[i] : v[8 + i]; w8[i] = mine + __shfl_xor(oth, 32); }
#pragma unroll
                for (int i = 0; i < 4; ++i) { const float mine = b4 ? w8[4 + i] : w8[i], oth = b4 ? w8[i] : w8[4 + i]; w4[i] = mine + __shfl_xor(oth, 16); }
#pragma unroll
                for (int i = 0; i < 2; ++i) { const float mine = b3 ? w4[2 + i] : w4[i], oth = b3 ? w4[i] : w4[2 + i]; w2[i] = mine + __shfl_xor(oth, 8); }
                { const float mine = b2 ? w2[1] : w2[0], oth = b2 ? w2[0] : w2[1]; w1 = mine + __shfl_xor(oth, 4); }
                w1 += __shfl_xor(w1, 2); w1 += __shfl_xor(w1, 1);
                if (MODE == 1) { if ((lane & 3) == 0) yf[ti * 16 + ch] = w1; }
                if (MODE == 2) {
                    const float uch = __shfl(uf, ch);
                    if ((lane & 3) == 0) { const float y = w1 + yf[ti * 16 + ch] + dv * uch; Z[(size_t)(row0 + ti) * 256 + g * 16 + ch] = (bf16)f2bf(gelu_tanh(y)); }
                }
            }
        }
#pragma unroll
        for (int u = 0; u < 4; ++u) { rn0[u] = rn1[u]; rn1[u] = rn2[u]; rn2[u] = rn3[u]; }
    }
}

__device__ __forceinline__ MixP make_mixp(const Frame& F, const Args& a, int l) {
    MixP mp; mp.P = (const bf16*)(F.ws + WS_PH); mp.lb = (const float*)(F.ws + WS_LB) + l * 256; mp.rcos = (const float*)(F.ws + WS_ROPE); mp.rsin = mp.rcos + 2048;
    mp.ba = a.in[F.zz + I_BA] + (size_t)l * 2 * 128; return mp;
}
__device__ __forceinline__ S5P make_s5p(const Frame& F, const Args& a, int l) {
    S5P sp; sp.lam_re = a.in[F.zz + I_LAMRE] + (size_t)l * 2048; sp.lam_im = a.in[F.zz + I_LAMIM] + (size_t)l * 2048; sp.log_dt = a.in[F.zz + I_LOGDT] + l * 32;
    sp.b_re = a.in[F.zz + I_BRE] + (size_t)l * 32768; sp.b_im = a.in[F.zz + I_BIM] + (size_t)l * 32768; sp.c_re = a.in[F.zz + I_CRE] + (size_t)l * 32768; sp.c_im = a.in[F.zz + I_CIM] + (size_t)l * 32768;
    sp.dd = a.in[F.zz + I_S5D] + l * 256; sp.par = (const unsigned*)(F.ws + WS_S5PAR) + (size_t)l * 32 * 4096; return sp;
}


typedef short bf16x8_t __attribute__((ext_vector_type(8)));
typedef float f32x16 __attribute__((ext_vector_type(16)));
typedef float f32x2_t __attribute__((ext_vector_type(2)));
typedef __bf16 bf16x2_n __attribute__((ext_vector_type(2)));
__device__ __forceinline__ unsigned pkbf(float lo, float hi) { const f32x2_t v = {lo, hi}; const bf16x2_n r = __builtin_convertvector(v, bf16x2_n); return __builtin_bit_cast(unsigned, r); }
constexpr int WL_QC = 0, WL_KC = 4608, WL_KT = 9216, WL_VT = 14336, WL_PL = 19456, WL_BYTES = 19712;

struct MxC { float gamma, lbv, oml, bav, rc1, rs1; unsigned cq, ck, cv, cz; };
template <int MIX>
__device__ __forceinline__ void mx_consts(MxC& c, const MixP& mp, int h, int dir, int lane) {
    c.gamma = 1.f; c.lbv = 0.f; c.oml = 1.f; c.bav = 0.f; c.cz = 0; c.rc1 = 1.f; c.rs1 = 0.f;
    if (MIX == 0) { c.cq = 8u * (unsigned)(C_RQ + h * 64 + lane); c.ck = 8u * (unsigned)(C_RK + h * 64 + lane); c.cv = 8u * (unsigned)(C_RV + h * 64 + lane); c.gamma = 1.0f - exp2f(-5.0f - (float)(dir ? 3 - h : h));
        if (lane & 32) { const unsigned r1 = 4u * (unsigned)(16 + (lane & 15)); c.rc1 = GLD(float, mp.rcos, r1); const float s1 = GLD(float, mp.rsin, r1); c.rs1 = dir ? -s1 : s1; } }
    else if (MIX == 1) { c.cq = 8u * (unsigned)(C_HQ + h * 64 + lane); c.ck = 8u * (unsigned)((dir ? C_HFB : C_HFF) + h * 64 + lane); c.cv = 8u * (unsigned)(C_HI + h * 64 + lane); c.lbv = mp.lb[h * 64 + lane]; c.oml = 1.0f - c.lbv; }
    else { c.cq = 8u * (unsigned)(C_GQ + h * 32 + (lane & 31)); c.ck = 8u * (unsigned)(C_GK + h * 32 + (lane & 31)); c.cv = 8u * (unsigned)(C_GV + h * 64 + lane); c.cz = 8u * (unsigned)((dir ? C_GZB : C_GZF) + h * 32 + (lane & 31));
        c.bav = mp.ba[dir * 128 + h * 32 + (lane & 31)]; }
}
struct MxRaw { v2u q, k, v, z; };
template <int MIX, bool NEEDQ, int DIR>
__device__ __forceinline__ void mx_load(MxRaw& w, const MixP& mp, const MxC& c, int rows, int b) {
    const bf16* pr = mp.P + (size_t)((rows >> 2) + (DIR ? 15 - b : b)) * P4G;
    const v2u zero = {0u, 0u};
    w.q = NEEDQ ? GLD(v2u, pr, c.cq) : zero; w.k = GLD(v2u, pr, c.ck); w.v = GLD(v2u, pr, c.cv); w.z = (MIX == 2) ? GLD(v2u, pr, c.cz) : zero;
}
__device__ __forceinline__ float bfx(const v2u& w, int i) { const unsigned d = (i >> 1) ? w.y : w.x; return __builtin_bit_cast(float, (i & 1) ? (d & 0xffff0000u) : (d << 16)); }
template <int MIX, bool NEEDQ, int DIR>
__device__ __forceinline__ void mx_batch(const MxRaw& cur, const MixP& mp, const MxC& c, int tposs  , int lane, LAS unsigned char* wl, int b, float& P, float& rc, float& rs) {
    constexpr int DK = (MIX == 2) ? 32 : 64;
    float kt[4];
#pragma unroll
    for (int u = 0; u < 4; ++u) {
        const int cc = b * 4 + u, ts = DIR ? 63 - cc : cc, t = ts & 31;
        const int pu = DIR ? 3 - u : u; float q = bfx(cur.q, pu), k, f;
        if (MIX == 0) {
            k = bfx(cur.k, pu) * 0.125f; f = c.gamma;
            if (tposs >= 0) { const float cs = rc, sn = rs;
                rc = cs * c.rc1 - sn * c.rs1; rs = sn * c.rc1 + cs * c.rs1;
                const float ss = (lane & 16) ? sn : -sn;
                const float kp = __shfl_xor(k, 16); k = fmaf(kp, ss, k * cs);
                if (NEEDQ) { const float qp = __shfl_xor(q, 16); q = fmaf(qp, ss, q * cs); } }
        } else if (MIX == 1) {
            const float z = bfx(cur.k, pu); const float e = __expf(-z); const float sp = __builtin_amdgcn_rcpf(1.0f + e), sn = e * sp;
            f = fmaf(c.oml, sp, c.lbv); k = c.oml * sn;
        } else {
            k = bfx(cur.k, pu) * 0.17677669529663687f; const float z = bfx(cur.z, pu) + c.bav;
            const float ls = fminf(z, 0.f) - __logf(1.0f + __expf(-fabsf(z)));
            f = __expf(ls * 0.0625f);
        }
        P = fmaxf(P * f, 1e-30f);
        const float kk = k * __builtin_amdgcn_rcpf(P); kt[DIR ? 3 - u : u] = kk;
        if (lane < DK) {
            const unsigned qk = pkbf(q * P, kk);
            if (NEEDQ) *(LAS unsigned short*)(wl + WL_QC + t * 144 + lane * 2) = (unsigned short)qk;
            *(LAS unsigned short*)(wl + WL_KC + t * 144 + lane * 2) = (unsigned short)(qk >> 16);
        }
    }
    const int g4 = ((DIR ? 63 - b * 4 : b * 4) & 31) >> 2;
    v2u kp; kp.x = pkbf(kt[0], kt[1]); kp.y = pkbf(kt[2], kt[3]);
    if (lane < DK) *(LAS v2u*)(wl + WL_KT + lane * 80 + g4 * 8) = kp;
    *(LAS v2u*)(wl + WL_VT + lane * 80 + g4 * 8) = cur.v;
}
typedef short bf16x4_t __attribute__((ext_vector_type(4)));
#define MFMA8(a, b, c) __builtin_amdgcn_mfma_f32_32x32x8bf16_1k((a), (b), (c), 0, 0, 0)
__device__ __forceinline__ bf16x4_t pack4(const f32x16& x, int s) {
    v2u p; p.x = pkbf(x[4 * s], x[4 * s + 1]); p.y = pkbf(x[4 * s + 2], x[4 * s + 3]);
    return __builtin_bit_cast(bf16x4_t, p);
}
__device__ __forceinline__ bf16x4_t ld4(const LAS unsigned char* p) { const v2u a = *(const LAS v2u*)p; return __builtin_bit_cast(bf16x4_t, a); }

__device__ __forceinline__ float u2f_(unsigned u) { return __builtin_bit_cast(float, u); }
__device__ __forceinline__ unsigned f2u_(float f) { return __builtin_bit_cast(unsigned, f); }
__device__ __forceinline__ void s5_build(const Frame& F, const Args& a) {
    for (int it = F.gw; it < 128; it += F.NGW) {
        const int l = it >> 5, dg = it & 31, lane = F.lane, m32 = lane & 31, hh = lane >> 5;
        const S5P sp = make_s5p(F, a, l);
        unsigned* par = (unsigned*)(F.ws + WS_S5PAR) + (size_t)it * 4096;
    float ar[2], ai[2], a2r[2], a2i[2], a3r[2], a3i[2], a4r[2], a4i[2];
    bf16x4_t bfr[4][2];
    const float dt = __expf(sp.log_dt[dg]);
#pragma unroll
    for (int sh = 0; sh < 2; ++sh) {
        const int p = 32 * sh + m32;
        const float lre = sp.lam_re[dg * 64 + p], lim = sp.lam_im[dg * 64 + p];
        const float er = __expf(lre * dt), sn = sinf(lim * dt), cs = cosf(lim * dt);
        ar[sh] = er * cs; ai[sh] = er * sn;
        a2r[sh] = ar[sh] * ar[sh] - ai[sh] * ai[sh]; a2i[sh] = ar[sh] * ai[sh] + ar[sh] * ai[sh];
        a3r[sh] = a2r[sh] * ar[sh] - a2i[sh] * ai[sh]; a3i[sh] = a2r[sh] * ai[sh] + a2i[sh] * ar[sh];
        a4r[sh] = a2r[sh] * a2r[sh] - a2i[sh] * a2i[sh]; a4i[sh] = a2r[sh] * a2i[sh] + a2r[sh] * a2i[sh];
        const float nr = ar[sh] - 1.0f, ni = ai[sh], den = 1.0f / (lre * lre + lim * lim);
        const float cr = (nr * lre + ni * lim) * den, ci = (ni * lre - nr * lim) * den;
#pragma unroll
        for (int s2 = 0; s2 < 2; ++s2) {
            const f32x4 Br = *(const f32x4*)(sp.b_re + ((size_t)dg * 64 + p) * 16 + 8 * s2 + 4 * hh), Bi = *(const f32x4*)(sp.b_im + ((size_t)dg * 64 + p) * 16 + 8 * s2 + 4 * hh);
            const f32x4 re = Br * cr - Bi * ci, im = Bi * cr + Br * ci;
            v2u pr, pi; pr.x = pkbf(re[0], re[1]); pr.y = pkbf(re[2], re[3]); pi.x = pkbf(im[0], im[1]); pi.y = pkbf(im[2], im[3]);
            bfr[sh][s2] = __builtin_bit_cast(bf16x4_t, pr); bfr[2 + sh][s2] = __builtin_bit_cast(bf16x4_t, pi);
        }
    }
    bf16x4_t cfr[16];
    {
#pragma unroll
        for (int s = 0; s < 16; ++s) {
            const int mp_ = 2 * s + hh; f32x4 cv = {0.f, 0.f, 0.f, 0.f};
            if (m32 < 16) { const float* cre = sp.c_re + ((size_t)dg * 16 + m32) * 64 + mp_; const float* cim = sp.c_im + ((size_t)dg * 16 + m32) * 64 + mp_;
                cv[0] = cre[0]; cv[1] = cre[32]; cv[2] = -cim[0]; cv[3] = -cim[32]; }
            v2u pc; pc.x = pkbf(cv[0], cv[1]); pc.y = pkbf(cv[2], cv[3]); cfr[s] = __builtin_bit_cast(bf16x4_t, pc);
        }
    }
#define S5U(x) __builtin_bit_cast(unsigned, (x))
        v4u q;
        q.x = S5U(ar[0]); q.y = S5U(ar[1]); q.z = S5U(ai[0]); q.w = S5U(ai[1]); *(v4u*)(par + (0 * 64 + lane) * 4) = q;
        q.x = S5U(a2r[0]); q.y = S5U(a2r[1]); q.z = S5U(a2i[0]); q.w = S5U(a2i[1]); *(v4u*)(par + (1 * 64 + lane) * 4) = q;
        q.x = S5U(a3r[0]); q.y = S5U(a3r[1]); q.z = S5U(a3i[0]); q.w = S5U(a3i[1]); *(v4u*)(par + (2 * 64 + lane) * 4) = q;
        q.x = S5U(a4r[0]); q.y = S5U(a4r[1]); q.z = S5U(a4i[0]); q.w = S5U(a4i[1]); *(v4u*)(par + (3 * 64 + lane) * 4) = q;
#undef S5U
#pragma unroll
        for (int i = 0; i < 4; ++i) { const v2u lo = __builtin_bit_cast(v2u, bfr[i][0]), hi = __builtin_bit_cast(v2u, bfr[i][1]); q.x = lo.x; q.y = lo.y; q.z = hi.x; q.w = hi.y; *(v4u*)(par + ((4 + i) * 64 + lane) * 4) = q; }
#pragma unroll
        for (int k = 0; k < 8; ++k) { const v2u lo = __builtin_bit_cast(v2u, cfr[2 * k]), hi = __builtin_bit_cast(v2u, cfr[2 * k + 1]); q.x = lo.x; q.y = lo.y; q.z = hi.x; q.w = hi.y; *(v4u*)(par + ((8 + k) * 64 + lane) * 4) = q; }
    }
}
struct S5U { v2u u[2][2]; };
__device__ __forceinline__ void s5_load_u(S5U& U, const bf16* P, int b, int g, int sg, int lane) {
    const int m32 = lane & 31, hh = lane >> 5, row0 = seg_row0(b, sg);
#pragma unroll
    for (int ch = 0; ch < 2; ++ch) { const bf16* urow = P + (size_t)((row0 + 32 * ch + m32) >> 2) * P4G + P4S5 + (m32 & 3) * 256 + g * 16 + 4 * hh;
        U.u[ch][0] = *(const v2u*)urow; U.u[ch][1] = *(const v2u*)(urow + 8); }
}
template <int MODE, int DIR>
__device__ __forceinline__ void s5_mm_dir(const S5P& sp, const S5U& U, int b, int g, int sg, int lane, float& hre, float& him, LAS float* yf, LAS unsigned char* hs, bf16* Z) {
    const int m32 = lane & 31, hh = lane >> 5, dg = DIR * 16 + g, row0 = seg_row0(b, sg);
    float ar[2], ai[2], a2r[2], a2i[2], a3r[2], a3i[2], a4r[2], a4i[2];
    bf16x4_t bfr[4][2];
    bf16x4_t cfr[16];
    {
        const unsigned* par = sp.par + (size_t)dg * 4096;
        v4u pq[16];
#pragma unroll
        for (int q = 0; q < ((MODE != 0) ? 16 : 8); ++q) pq[q] = GLD(v4u, par + q * 256, 16u * (unsigned)lane);
#define S5F(x) u2f_(x)
        ar[0] = S5F(pq[0].x); ar[1] = S5F(pq[0].y); ai[0] = S5F(pq[0].z); ai[1] = S5F(pq[0].w);
        a2r[0] = S5F(pq[1].x); a2r[1] = S5F(pq[1].y); a2i[0] = S5F(pq[1].z); a2i[1] = S5F(pq[1].w);
        a3r[0] = S5F(pq[2].x); a3r[1] = S5F(pq[2].y); a3i[0] = S5F(pq[2].z); a3i[1] = S5F(pq[2].w);
        a4r[0] = S5F(pq[3].x); a4r[1] = S5F(pq[3].y); a4i[0] = S5F(pq[3].z); a4i[1] = S5F(pq[3].w);
#undef S5F
#pragma unroll
        for (int i = 0; i < 4; ++i) { v2u lo, hi; lo.x = pq[4 + i].x; lo.y = pq[4 + i].y; hi.x = pq[4 + i].z; hi.y = pq[4 + i].w; bfr[i][0] = __builtin_bit_cast(bf16x4_t, lo); bfr[i][1] = __builtin_bit_cast(bf16x4_t, hi); }
        if (MODE != 0) {
#pragma unroll
            for (int k = 0; k < 8; ++k) { v2u lo, hi; lo.x = pq[8 + k].x; lo.y = pq[8 + k].y; hi.x = pq[8 + k].z; hi.y = pq[8 + k].w; cfr[2 * k] = __builtin_bit_cast(bf16x4_t, lo); cfr[2 * k + 1] = __builtin_bit_cast(bf16x4_t, hi); }
        }
    }
    const float ddv = (MODE == 2 && m32 < 16) ? sp.dd[g * 16 + m32] : 0.f;
    float hr[2], hi[2];
    hr[0] = __shfl(hre, m32); hi[0] = __shfl(him, m32); hr[1] = __shfl(hre, m32 + 32); hi[1] = __shfl(him, m32 + 32);
#pragma unroll 1
    for (int ci2 = 0; ci2 < 2; ++ci2) {
        const int ch = DIR ? 1 - ci2 : ci2, rowc = row0 + 32 * ch;
        const v2u x0 = ch ? U.u[1][0] : U.u[0][0], x1 = ch ? U.u[1][1] : U.u[0][1];
        const bf16x4_t ua0 = __builtin_bit_cast(bf16x4_t, x0), ua1 = __builtin_bit_cast(bf16x4_t, x1);
        if (MODE == 2) { *(LAS v2u*)(hs + 13312 + m32 * 32 + 8 * hh) = x0; *(LAS v2u*)(hs + 13312 + m32 * 32 + 16 + 8 * hh) = x1; }
        f32x16 BU[4];
#pragma unroll
        for (int nt = 0; nt < 4; ++nt) {
#pragma unroll
            for (int r = 0; r < 16; ++r) BU[nt][r] = 0.f;
            BU[nt] = MFMA8(ua0, bfr[nt][0], BU[nt]); BU[nt] = MFMA8(ua1, bfr[nt][1], BU[nt]);
        }
#pragma unroll
        for (int sh = 0; sh < 2; ++sh)
#pragma unroll
            for (int gg = 0; gg < 4; ++gg)
#pragma unroll
                for (int jj = 1; jj < 4; ++jj) {
                    const int r = DIR ? 4 * gg + 3 - jj : 4 * gg + jj, rp = DIR ? r + 1 : r - 1;
                    const float pr = BU[sh][rp], pi = BU[2 + sh][rp];
                    BU[sh][r] += ar[sh] * pr - ai[sh] * pi; BU[2 + sh][r] += ar[sh] * pi + ai[sh] * pr;
                }
        float hnr[2][4], hni[2][4];
        {
            float elr[2][4], eli[2][4], ehr[2][4], ehi[2][4];
#pragma unroll
            for (int sh = 0; sh < 2; ++sh)
#pragma unroll
                for (int gg = 0; gg < 4; ++gg) { const int rl = DIR ? 4 * gg : 4 * gg + 3;
                    const unsigned vr = f2u_(BU[sh][rl]), vi = f2u_(BU[2 + sh][rl]);
                    const auto sr = __builtin_amdgcn_permlane32_swap(vr, vr, false, false), si = __builtin_amdgcn_permlane32_swap(vi, vi, false, false);
                    elr[sh][gg] = u2f_((unsigned)sr[0]); ehr[sh][gg] = u2f_((unsigned)sr[1]); eli[sh][gg] = u2f_((unsigned)si[0]); ehi[sh][gg] = u2f_((unsigned)si[1]); }
            float tr[2], ti[2];
#pragma unroll
            for (int st = 0; st < 8; ++st) {
                const int grp = DIR ? 7 - st : st, gg = grp >> 1, half = grp & 1;
#pragma unroll
                for (int sh = 0; sh < 2; ++sh) {
                    if (half == (DIR ? 1 : 0)) { tr[sh] = hr[sh]; ti[sh] = hi[sh]; }
                    else { hnr[sh][gg] = (hh == half) ? hr[sh] : tr[sh]; hni[sh][gg] = (hh == half) ? hi[sh] : ti[sh]; }
                    const float er = half ? ehr[sh][gg] : elr[sh][gg], ei = half ? ehi[sh][gg] : eli[sh][gg];
                    const float nr = er + a4r[sh] * hr[sh] - a4i[sh] * hi[sh], ni = ei + a4r[sh] * hi[sh] + a4i[sh] * hr[sh];
                    hr[sh] = nr; hi[sh] = ni;
                }
            }
        }
        if (MODE != 0) {
#pragma unroll
            for (int sh = 0; sh < 2; ++sh)
#pragma unroll
                for (int gg = 0; gg < 4; ++gg)
#pragma unroll
                    for (int jj = 0; jj < 4; ++jj) {
                        const int pw = DIR ? 4 - jj : jj + 1;
                        const float pr = (pw == 1) ? ar[sh] : (pw == 2) ? a2r[sh] : (pw == 3) ? a3r[sh] : a4r[sh], pi = (pw == 1) ? ai[sh] : (pw == 2) ? a2i[sh] : (pw == 3) ? a3i[sh] : a4i[sh];
                        BU[sh][4 * gg + jj] += pr * hnr[sh][gg] - pi * hni[sh][gg]; BU[2 + sh][4 * gg + jj] += pr * hni[sh][gg] + pi * hnr[sh][gg];
                    }
#pragma unroll
            for (int r = 0; r < 16; ++r) { v2u w; w.x = pkbf(BU[0][r], BU[1][r]); w.y = pkbf(BU[2][r], BU[3][r]);
                *(LAS v2u*)(hs + ((r & 3) + 8 * (r >> 2) + 4 * hh) * 272 + m32 * 8) = w; }
            f32x16 Yv, Yw;
#pragma unroll
            for (int r = 0; r < 16; ++r) { Yv[r] = 0.f; Yw[r] = 0.f; }
#pragma unroll
            for (int s = 0; s < 16; s += 2) { Yv = MFMA8(ld4(hs + m32 * 272 + (8 * s + 4 * hh) * 2), cfr[s], Yv); Yw = MFMA8(ld4(hs + m32 * 272 + (8 * s + 8 + 4 * hh) * 2), cfr[s + 1], Yw); }
#pragma unroll
            for (int r = 0; r < 16; ++r) Yv[r] += Yw[r];
            if (m32 < 16) {
#pragma unroll
                for (int r = 0; r < 16; ++r) {
                    const int tl = (r & 3) + 8 * (r >> 2) + 4 * hh;
                    if (MODE == 1) yf[(32 * ch + tl) * 16 + m32] = Yv[r];
                    else { const float u = bf2f(*(const LAS unsigned short*)(hs + 13312 + tl * 32 + m32 * 2));
                        const float y = Yv[r] + yf[(32 * ch + tl) * 16 + m32] + ddv * u;
                        const float zz = gelu_tanh(y); Z[(size_t)(rowc + tl) * 256 + g * 16 + m32] = (bf16)pkbf(zz, zz); }
                }
            }
        }
    }
    hre = hh ? hr[1] : hr[0]; him = hh ? hi[1] : hi[0];
}
template <int MODE>
__device__ __forceinline__ void s5_mm(const S5P& sp, const S5U& U, int b, int g, int dir, int sg, int lane, float& hre, float& him, LAS float* yf, LAS unsigned char* hs, bf16* Z) {
    if (dir) s5_mm_dir<MODE, 1>(sp, U, b, g, sg, lane, hre, him, yf, hs, Z); else s5_mm_dir<MODE, 0>(sp, U, b, g, sg, lane, hre, him, yf, hs, Z);
}
template <int MIX, int DIR, bool WITH_O>
__device__ __forceinline__ void mx_chunk(LAS unsigned char* wl, int lane, float Pl, f32x16 (&ST)[(MIX == 2) ? 1 : 2][2], f32x16 (&O)[2]) {
    constexpr int DK = (MIX == 2) ? 32 : 64, NRT = DK / 32;
    const int m32 = lane & 31, hh = lane >> 5;
    asm volatile("" ::: "memory");
    if (lane < DK) *(LAS float*)(wl + WL_PL + lane * 4) = Pl;
    asm volatile("" ::: "memory");
    if (WITH_O) {
        f32x16 x;
#pragma unroll
        for (int r = 0; r < 16; ++r) x[r] = 0.f;
#pragma unroll
        for (int s = 0; s < DK / 8; ++s) {
            const bf16x4_t ka = ld4(wl + WL_KC + m32 * 144 + (8 * s + 4 * hh) * 2);
            const bf16x4_t qb = ld4(wl + WL_QC + m32 * 144 + (8 * s + 4 * hh) * 2);
            x = MFMA8(ka, qb, x);
        }
#pragma unroll
        for (int r = 0; r < 16; ++r) { const int j = (r & 3) + 8 * (r >> 2) + 4 * hh; const bool keep = DIR ? (j >= m32) : (j <= m32); x[r] = keep ? x[r] : 0.f; }
#pragma unroll
        for (int t = 0; t < 2; ++t)
#pragma unroll
            for (int r = 0; r < 16; ++r) O[t][r] = 0.f;
#pragma unroll
        for (int s = 0; s < 4; ++s) {
            const bf16x4_t xa = pack4(x, s);
#pragma unroll
            for (int t = 0; t < 2; ++t) O[t] = MFMA8(ld4(wl + WL_VT + (32 * t + m32) * 80 + (8 * s + 4 * hh) * 2), xa, O[t]);
        }
#pragma unroll
        for (int rt = 0; rt < NRT; ++rt)
#pragma unroll
            for (int s = 0; s < 4; ++s) {
                const bf16x4_t qa = ld4(wl + WL_QC + m32 * 144 + (32 * rt + 8 * s + 4 * hh) * 2);
#pragma unroll
                for (int t = 0; t < 2; ++t) O[t] = MFMA8(pack4(ST[rt][t], s), qa, O[t]);
            }
    }
    {
        v4u kk4[NRT][2], vv4[2][2];
#pragma unroll
        for (int p2 = 0; p2 < 2; ++p2) {
#pragma unroll
            for (int rt = 0; rt < NRT; ++rt) kk4[rt][p2] = *(const LAS v4u*)(wl + WL_KT + (32 * rt + m32) * 80 + (16 * p2 + 8 * hh) * 2);
#pragma unroll
            for (int t = 0; t < 2; ++t) vv4[t][p2] = *(const LAS v4u*)(wl + WL_VT + (32 * t + m32) * 80 + (16 * p2 + 8 * hh) * 2);
        }
#pragma unroll
        for (int p2 = 0; p2 < 2; ++p2)
#pragma unroll
            for (int e = 0; e < 2; ++e)
#pragma unroll
                for (int rt = 0; rt < NRT; ++rt) { v2u ku; ku.x = e ? kk4[rt][p2].z : kk4[rt][p2].x; ku.y = e ? kk4[rt][p2].w : kk4[rt][p2].y; const bf16x4_t ka = __builtin_bit_cast(bf16x4_t, ku);
#pragma unroll
                    for (int t = 0; t < 2; ++t) { v2u vu; vu.x = e ? vv4[t][p2].z : vv4[t][p2].x; vu.y = e ? vv4[t][p2].w : vv4[t][p2].y; ST[rt][t] = MFMA8(ka, __builtin_bit_cast(bf16x4_t, vu), ST[rt][t]); } }
    }
#pragma unroll
    for (int rt = 0; rt < NRT; ++rt)
#pragma unroll
        for (int g = 0; g < 4; ++g) {
            const f32x4 pl4 = *(const LAS f32x4*)(wl + WL_PL + (32 * rt + 8 * g + 4 * hh) * 4);
#pragma unroll
            for (int e = 0; e < 4; ++e) { ST[rt][0][4 * g + e] *= pl4[e]; ST[rt][1][4 * g + e] *= pl4[e]; }
        }
}
__device__ __forceinline__ float half_sum(float v) {
#pragma unroll
    for (int o = 1; o < 32; o <<= 1) v += __shfl_xor(v, o);
    return v;
}
template <int MIX, int DIR>
__device__ __forceinline__ void mixA_stream(const MixP& mp, const MxC& c, int row0, int tpos0, int lane, LAS unsigned char* wl, f32x16 (&ST)[(MIX == 2) ? 1 : 2][2], float& Gam) {
    f32x16 O[2];
    MxRaw r[8];
#pragma unroll
    for (int i = 0; i < 8; ++i) mx_load<MIX, false, DIR>(r[i], mp, c, row0, i);
    float rc = 1.0f, rs = 0.0f;
    if (MIX == 0 && tpos0 >= 0) { const int tpos = tpos0 + (DIR ? 63 : 0); const int pos = (lane & 32) ? (tpos & 63) : (tpos >> 6);
        const unsigned ro = 4u * (unsigned)(pos * 16 + (lane & 15)); rc = GLD(float, mp.rcos, ro); rs = GLD(float, mp.rsin, ro); }
    float P = 1.0f;
#pragma unroll 1
    for (int cki = 0; cki < 2; ++cki) {
        int ck = cki; asm volatile("" : "+s"(ck));
        int ln = lane; asm volatile("" : "+v"(ln));
#pragma unroll
        for (int j = 0; j < 8; ++j) {
            mx_batch<MIX, false, DIR>(r[j], mp, c, tpos0, ln, wl, j, P, rc, rs);
            if (ck == 0) mx_load<MIX, false, DIR>(r[j], mp, c, row0, 8 + j);
        }
        Gam *= P; mx_chunk<MIX, 0, false>(wl, ln, P, ST, O); P = 1.0f;
    }
}
template <int MIX>
__device__ __forceinline__ void mixA_unit(const MixP& mp, float* STG, int idx, int lane_in, LAS unsigned char* wl) {
    int lane = lane_in;
    constexpr int DK = (MIX == 2) ? 32 : 64, NRT = DK / 32;
    const int dir = idx / 2112, rem = idx - dir * 2112, bh = rem / NSEG, sg = rem - bh * NSEG, b = bh >> 2, h = bh & 3;
    asm volatile("" : "+v"(lane));
    MxC c; mx_consts<MIX>(c, mp, h, dir, lane);
    f32x16 ST[NRT][2];
#pragma unroll
    for (int rt = 0; rt < NRT; ++rt)
#pragma unroll
        for (int t = 0; t < 2; ++t)
#pragma unroll
            for (int r = 0; r < 16; ++r) ST[rt][t][r] = 0.f;
    const int row0 = seg_row0(b, sg), tpos0 = seg_tpos0(sg);
    float Gam = 1.0f;
    if (dir) mixA_stream<MIX, 1>(mp, c, row0, tpos0, lane, wl, ST, Gam); else mixA_stream<MIX, 0>(mp, c, row0, tpos0, lane, wl, ST, Gam);
    const size_t slot = (size_t)((dir * 16 + bh) * NSEG + sg);
    bf16* ds = (bf16*)(STG + (MIX == 0 ? ST_DS0 : (MIX == 1 ? ST_DS1 : ST_DS2))) + slot * (DK * 64);
    const int m32 = lane & 31, hh = lane >> 5;
#pragma unroll
    for (int rt = 0; rt < NRT; ++rt)
#pragma unroll
        for (int t = 0; t < 2; ++t)
#pragma unroll
            for (int r4 = 0; r4 < 4; ++r4) { v2u v; v.x = pkbf(ST[rt][t][4 * r4], ST[rt][t][4 * r4 + 1]); v.y = pkbf(ST[rt][t][4 * r4 + 2], ST[rt][t][4 * r4 + 3]);
                GST(v2u, ds + ((rt * 2 + t) * 4 + r4) * 256, 8u * (unsigned)lane) = v; }
    float* gs = STG + (MIX == 0 ? ST_G0 : (MIX == 1 ? ST_G1 : ST_G2)) + slot * 64;
    GST(float, gs, 4u * (unsigned)lane) = Gam;
}
__device__ __forceinline__ void mx_epi_gates(const MixP& mp, int lane, int rowc, int gcol, v2u (&g)[2][4]) {
    const int m32 = lane & 31, hh = lane >> 5;
    const bf16* gb = mp.P + (size_t)(rowc >> 2) * P4G + gcol;
    const unsigned gvo = 2u * (unsigned)((m32 >> 2) * P4G + (m32 & 3) * 256 + 4 * hh);
#pragma unroll
    for (int t = 0; t < 2; ++t)
#pragma unroll
        for (int s = 0; s < 4; ++s) g[t][s] = GLD(v2u, gb + 32 * t + 8 * s, gvo);
}
__device__ __forceinline__ void mx_epi_of(int lane, const float* OFc, v2u (&of)[2][4]) {
#pragma unroll
    for (int t = 0; t < 2; ++t)
#pragma unroll
        for (int s = 0; s < 4; ++s) of[t][s] = GLD(v2u, (const bf16*)OFc + (t * 4 + s) * 256, 8u * (unsigned)lane);
}
template <int MIX, int MODE>
__device__ __forceinline__ void mx_epilogue(const MixP& mp, LAS unsigned char* wl, int lane, f32x16 (&O)[2], int rowc, float* OFc, bf16* Y, int ycol, const v2u (&g)[2][4], const v2u (&of)[2][4]) {
    const int m32 = lane & 31, hh = lane >> 5;
    if (MODE == 1) {
#pragma unroll
        for (int t = 0; t < 2; ++t)
#pragma unroll
            for (int s = 0; s < 4; ++s) { v2u v; v.x = pkbf(O[t][4 * s], O[t][4 * s + 1]); v.y = pkbf(O[t][4 * s + 2], O[t][4 * s + 3]); GST(v2u, (bf16*)OFc + (t * 4 + s) * 256, 8u * (unsigned)lane) = v; }
    } else {
#pragma unroll
        for (int t = 0; t < 2; ++t)
#pragma unroll
            for (int s = 0; s < 4; ++s)
#pragma unroll
                for (int j = 0; j < 4; ++j) O[t][4 * s + j] += bfx(of[t][s], j);
        float mean = 0.f;
        if (MIX == 0) { float sm = 0.f;
#pragma unroll
            for (int t = 0; t < 2; ++t)
#pragma unroll
                for (int r = 0; r < 16; ++r) sm += O[t][r];
            sm += __shfl_xor(sm, 32); mean = sm * (1.0f / 64.0f); }
        float ss = 0.f;
#pragma unroll
        for (int t = 0; t < 2; ++t)
#pragma unroll
            for (int r = 0; r < 16; ++r) { const float d = O[t][r] - mean; ss = fmaf(d, d, ss); }
        ss += __shfl_xor(ss, 32);
        const float rs = __builtin_amdgcn_rsqf(ss * (1.0f / 64.0f) + NEPS), mo = -mean * rs;
        asm volatile("" ::: "memory");
#pragma unroll
        for (int t = 0; t < 2; ++t)
#pragma unroll
            for (int s = 0; s < 4; ++s) { float y[4];
#pragma unroll
                for (int j = 0; j < 4; ++j) y[j] = fmaf(O[t][4 * s + j], rs, mo) * silu_f(bfx(g[t][s], j));
                v2u w; w.x = pkbf(y[0], y[1]); w.y = pkbf(y[2], y[3]);
                *(LAS v2u*)(wl + WL_QC + m32 * 144 + (32 * t + 8 * s + 4 * hh) * 2) = w; }
        asm volatile("" ::: "memory");
#pragma unroll
        for (int k = 0; k < 4; ++k) { const v4u w = *(const LAS v4u*)(wl + WL_QC + ((lane >> 3) + 8 * k) * 144 + (lane & 7) * 16);
            GST(v4u, Y + (size_t)(rowc + 8 * k) * 1024 + ycol, 2u * (unsigned)((lane >> 3) * 1024 + (lane & 7) * 8)) = w; }
        asm volatile("" ::: "memory");
    }
}
template <int MIX, int DIR>
__device__ __forceinline__ void mixC_stream(const MixP& mp, const MxC& c, int row0, int tpos0, int lane, LAS unsigned char* wl, f32x16 (&ST)[(MIX == 2) ? 1 : 2][2],
                                            const bf16* ds, float* OFu, bf16* Y, int ycol, int gcol) {
    f32x16 O[2];
    MxRaw r[4];
#pragma unroll
    for (int i = 0; i < 3; ++i) mx_load<MIX, true, DIR>(r[i], mp, c, row0, i);
    {
#pragma unroll
        for (int rt = 0; rt < ((MIX == 2) ? 1 : 2); ++rt)
#pragma unroll
            for (int t = 0; t < 2; ++t)
#pragma unroll
                for (int r4 = 0; r4 < 4; ++r4) { const v2u v = GLD(v2u, ds + ((rt * 2 + t) * 4 + r4) * 256, 8u * (unsigned)lane);
                    ST[rt][t][4 * r4] = bfx(v, 0); ST[rt][t][4 * r4 + 1] = bfx(v, 1); ST[rt][t][4 * r4 + 2] = bfx(v, 2); ST[rt][t][4 * r4 + 3] = bfx(v, 3); }
    }
    float rc = 1.0f, rs = 0.0f;
    if (MIX == 0 && tpos0 >= 0) { const int tpos = tpos0 + (DIR ? 63 : 0); const int pos = (lane & 32) ? (tpos & 63) : (tpos >> 6);
        const unsigned ro = 4u * (unsigned)(pos * 16 + (lane & 15)); rc = GLD(float, mp.rcos, ro); rs = GLD(float, mp.rsin, ro); }
    float P = 1.0f;
#pragma unroll 1
    for (int b4i = 0; b4i < 16; b4i += 4) {
        int b4 = b4i; asm volatile("" : "+s"(b4));
        int ln = lane; asm volatile("" : "+v"(ln));
#pragma unroll
        for (int j = 0; j < 4; ++j) {
            if (b4 < 12 || j == 0) mx_load<MIX, true, DIR>(r[(j + 3) & 3], mp, c, row0, b4 + j + 3);
            mx_batch<MIX, true, DIR>(r[j], mp, c, tpos0, ln, wl, (b4 & 4) + j, P, rc, rs);
        }
        if (b4 & 4) {
            const int ck = b4 >> 3, ch = DIR ? 1 - ck : ck; float* OFc = OFu + (size_t)ch * (12 * 1024);
            v2u g[2][4], of[2][4];
            mx_chunk<MIX, DIR, true>(wl, ln, P, ST, O); P = 1.0f;
            if (DIR) { mx_epi_gates(mp, ln, row0 + 32 * ch, gcol, g); mx_epi_of(ln, OFc, of); }
            mx_epilogue<MIX, DIR ? 2 : 1>(mp, wl, ln, O, row0 + 32 * ch, OFc, Y, ycol, g, of);
        }
    }
}
template <int MIX>
__device__ __forceinline__ void mixC_unit(const MixP& mp, const float* STG, int idx, int lane_in, float* OF, LAS unsigned char* wl, bf16* Y) {
    int lane = lane_in; asm volatile("" : "+v"(lane));
    constexpr int DK = (MIX == 2) ? 32 : 64, NRT = DK / 32;
    const int bh = idx / NSEG, sg = idx - bh * NSEG, b = bh >> 2, h = bh & 3;
    const int row0 = seg_row0(b, sg), tpos0 = seg_tpos0(sg);
    const int ycol = ((MIX == 0) ? 0 : (MIX == 1 ? 512 : 768)) + h * 64;
    const int gcol = 4 * ((MIX == 0) ? C_RG : (MIX == 1 ? C_HG : C_GG)) + h * 64;
    float* OFu = OF + ((size_t)(row0 >> 5) * 12 + MIX * 4 + h) * 1024;
    const bf16* dsb = (const bf16*)(STG + (MIX == 0 ? ST_DS0 : (MIX == 1 ? ST_DS1 : ST_DS2)));
    f32x16 ST[NRT][2];
#pragma unroll 1
    for (int dir = 0; dir < 2; ++dir) {
        asm volatile("" : "+v"(lane));
        const int m32 = lane & 31, hh = lane >> 5;
        MxC c; mx_consts<MIX>(c, mp, h, dir, lane);
        const bf16* ds = dsb + (size_t)((dir * 16 + bh) * NSEG + sg) * (DK * 64);
        if (dir == 0) mixC_stream<MIX, 0>(mp, c, row0, tpos0, lane, wl, ST, ds, OFu, Y, ycol, gcol);
        else mixC_stream<MIX, 1>(mp, c, row0, tpos0, lane, wl, ST, ds, OFu, Y, ycol, gcol);
        asm volatile("s_waitcnt vmcnt(0)" ::: "memory");
    }
}
template <int MSEL>
__device__ __forceinline__ void mix_passA(const Frame& F, const Args& a, int l) {
    const MixP mp = make_mixp(F, a, l); const S5P sp = make_s5p(F, a, l);
    float* ST = (float*)(F.ws + WS_X2);
    LAS unsigned char* wl = F.lds + F.wave * WL_BYTES; LAS float* stg = (LAS float*)wl;
    if (MSEL == 15) {
        constexpr int NMX = 3 * 4224, NS5 = 2 * 64 * NSEG;
        const int heavy = NMX - (NMX / F.NGW) * F.NGW, nlight = F.NGW - heavy;
        const int n_all = (NS5 - 4 * nlight) / F.NGW;
        for (int it = 0; ; ++it) {
            int u;
            const int nmine = NMX / F.NGW + (F.gw < heavy ? 1 : 0);
            if (it < nmine) u = F.gw + it * F.NGW;
            else if (it < nmine + n_all) u = NMX + F.gw + (it - nmine) * F.NGW;
            else { const int k2 = it - nmine - n_all; if (F.gw < heavy || k2 >= 4) {
                    const int rest0 = NMX + n_all * F.NGW + 4 * nlight; const int uu = rest0 + F.gw + (k2 - (F.gw < heavy ? 0 : 4)) * F.NGW; if (uu >= NMX + NS5) break; u = uu; }
                else u = NMX + n_all * F.NGW + (F.gw - heavy) + k2 * nlight; }
            if (u >= NMX + NS5) break;
            if (u < 4224) mixA_unit<0>(mp, ST, u, fresh_lane(), wl);
            else if (u < 2 * 4224) mixA_unit<1>(mp, ST, u - 4224, fresh_lane(), wl);
            else if (u < 3 * 4224) mixA_unit<2>(mp, ST, u - 2 * 4224, fresh_lane(), wl);
            else { const int idx = u - 3 * 4224; const int dir = idx / (64 * NSEG), rem = idx - dir * 64 * NSEG, bg = rem / NSEG, sg = rem - bg * NSEG;
                float hre = 0.f, him = 0.f;
                S5U U; s5_load_u(U, mp.P, bg >> 4, bg & 15, sg, fresh_lane()); s5_mm<0>(sp, U, bg >> 4, bg & 15, dir, sg, fresh_lane(), hre, him, nullptr, wl, nullptr);
                float* hs = ST + ST_HS + ((size_t)((dir * 64 + bg) * NSEG + sg) * 64 + fresh_lane()) * 2;
                hs[0] = hre; hs[1] = him; }
        }
        return;
    }
    if (MSEL & 1) for (int u = F.gw; u < 4224; u += F.NGW) mixA_unit<0>(mp, ST, u, fresh_lane(), wl);
    if (MSEL & 2) for (int u = F.gw; u < 4224; u += F.NGW) mixA_unit<1>(mp, ST, u, fresh_lane(), wl);
    if (MSEL & 4) for (int u = F.gw; u < 4224; u += F.NGW) mixA_unit<2>(mp, ST, u, fresh_lane(), wl);
    if (MSEL & 8) for (int idx = F.gw; idx < 2 * 64 * NSEG; idx += F.NGW) {
        const int dir = idx / (64 * NSEG), rem = idx - dir * 64 * NSEG, bg = rem / NSEG, sg = rem - bg * NSEG;
        float hre = 0.f, him = 0.f;
        S5U U; s5_load_u(U, mp.P, bg >> 4, bg & 15, sg, fresh_lane()); s5_mm<0>(sp, U, bg >> 4, bg & 15, dir, sg, fresh_lane(), hre, him, nullptr, wl, nullptr);
        float* hs = ST + ST_HS + ((size_t)((dir * 64 + bg) * NSEG + sg) * 64 + fresh_lane()) * 2;
        hs[0] = hre; hs[1] = him;
    }
}
__device__ __forceinline__ int chain_seg(int dir, int p) { return dir ? (p < 4 ? 3 - p : 135 - p) : p; }
__device__ __forceinline__ void mix_passB(const Frame& F, const Args& a, int l) {
    float* ST = (float*)(F.ws + WS_X2);
    constexpr int N0 = 32768, N1 = 32768, N2 = 16384, N3 = 8192;
    for (int e = blockIdx.x * 512 + F.tid; e < N0 + N1 + N2 + N3; e += F.G * 512) {
        if (e < N0 + N1 + N2) {
            bf16* base; const float* gb; int dir, esz;
            if (e < N0 + N1) { const int mix = e >= N0, e2 = e - mix * N0, c = e2 >> 10, el = (e2 & 1023) * 4; dir = c >> 4; esz = 4096;
                base = (bf16*)(ST + (mix ? ST_DS1 : ST_DS0)) + (size_t)c * NSEG * 4096 + el; gb = ST + (mix ? ST_G1 : ST_G0) + (size_t)c * NSEG * 64 + 32 * (el >> 11) + 8 * ((el >> 8) & 3) + 4 * ((el >> 7) & 1); }
            else { const int e2 = e - N0 - N1, c = e2 >> 9, el = (e2 & 511) * 4; dir = c >> 4; esz = 2048;
                base = (bf16*)(ST + ST_DS2) + (size_t)c * NSEG * 2048 + el; gb = ST + ST_G2 + (size_t)c * NSEG * 64 + 8 * ((el >> 8) & 3) + 4 * ((el >> 7) & 1); }
            f32x4 run = {0.f, 0.f, 0.f, 0.f};
#pragma unroll 1
            for (int p0 = 0; p0 < NSEG; p0 += 12) {
                f32x4 d[12], gm[12];
#pragma unroll
                for (int q = 0; q < 12; ++q) { const int sg = chain_seg(dir, p0 + q); const v2u w = *(const v2u*)(base + (size_t)sg * esz); d[q] = (f32x4){bfx(w, 0), bfx(w, 1), bfx(w, 2), bfx(w, 3)}; gm[q] = *(const f32x4*)(gb + sg * 64); }
#pragma unroll
                for (int q = 0; q < 12; ++q) { const int sg = chain_seg(dir, p0 + q); v2u w; w.x = pkbf(run[0], run[1]); w.y = pkbf(run[2], run[3]); *(v2u*)(base + (size_t)sg * esz) = w; run = run * gm[q] + d[q]; }
            }
        } else {
            const int e2 = e - N0 - N1 - N2, c = e2 >> 6, p = e2 & 63, dir = c >> 6, g = c & 15;
            const int dg = dir * 16 + g;
            const float lre = a.in[F.zz + I_LAMRE][(size_t)l * 2048 + dg * 64 + p], lim = a.in[F.zz + I_LAMIM][(size_t)l * 2048 + dg * 64 + p], dt = expf(a.in[F.zz + I_LOGDT][l * 32 + dg]);
            const float er = expf(lre * dt * 64.0f); const float sn = sinf(lim * dt * 64.0f), cs = cosf(lim * dt * 64.0f);
            const float ar = er * cs, ai = er * sn;
            float* base = ST + ST_HS + ((size_t)c * NSEG * 64 + p) * 2;
            float rr = 0.f, ri = 0.f;
#pragma unroll 1
            for (int q0 = 0; q0 < NSEG; q0 += 12) {
                float dr[12], di[12];
#pragma unroll
                for (int q = 0; q < 12; ++q) { const int sg = chain_seg(dir, q0 + q); dr[q] = base[(size_t)sg * 128]; di[q] = base[(size_t)sg * 128 + 1]; }
#pragma unroll
                for (int q = 0; q < 12; ++q) { const int sg = chain_seg(dir, q0 + q); base[(size_t)sg * 128] = rr; base[(size_t)sg * 128 + 1] = ri;
                    const float nr = ar * rr - ai * ri + dr[q], ni = ar * ri + ai * rr + di[q]; rr = nr; ri = ni; }
            }
        }
    }
}
template <int MSEL>
__device__ __forceinline__ void mix_passC(const Frame& F, const Args& a, int l) {
    const MixP mp = make_mixp(F, a, l); const S5P sp = make_s5p(F, a, l);
    const float* ST = (const float*)(F.ws + WS_X2);
    LAS unsigned char* wl = F.lds + F.wave * WL_BYTES;
    LAS float* stg = (LAS float*)wl; LAS float* of = (LAS float*)(wl + 9216);
    float* OF = (float*)(F.ws + WS_OF);
    bf16* Y = (bf16*)(F.ws + WS_ACT); bf16* Z = (bf16*)(F.ws + WS_Z);
    const bool keep = l < DEPTH - 1;
    constexpr int NM = 16 * NSEG;
    if (MSEL == 15) {
        constexpr int NMX = 3 * NM, NS5 = 64 * NSEG;
        const int heavy = NMX - (NMX / F.NGW) * F.NGW, nlight = F.NGW - heavy;
        for (int it = 0; ; ++it) {
            int u;
            const int nmine = NMX / F.NGW + (F.gw < heavy ? 1 : 0);
            if (it < nmine) u = F.gw + it * F.NGW;
            else { if (F.gw < heavy) break; u = NMX + (F.gw - heavy) + (it - nmine) * nlight; }
            if (u >= NMX + NS5) break;
            const int sgu = (u < 3 * NM) ? (u % NSEG) : ((u - 3 * NM) % NSEG);
            if (!keep && sgu < 4) continue;
            if (u < NM) mixC_unit<0>(mp, ST, u, fresh_lane(), OF, wl, Y);
            else if (u < 2 * NM) mixC_unit<1>(mp, ST, u - NM, fresh_lane(), OF, wl, Y);
            else if (u < 3 * NM) mixC_unit<2>(mp, ST, u - 2 * NM, fresh_lane(), OF, wl, Y);
            else { const int idx = u - 3 * NM, bg = idx / NSEG, sg = idx - bg * NSEG;
                S5U U; s5_load_u(U, mp.P, bg >> 4, bg & 15, sg, fresh_lane());
                const float* h0 = ST + ST_HS + ((size_t)((0 * 64 + bg) * NSEG + sg) * 64 + fresh_lane()) * 2;
                float hre = h0[0], him = h0[1];
                s5_mm<1>(sp, U, bg >> 4, bg & 15, 0, sg, fresh_lane(), hre, him, of, wl, Z);
                const float* h1 = ST + ST_HS + ((size_t)((1 * 64 + bg) * NSEG + sg) * 64 + fresh_lane()) * 2;
                hre = h1[0]; him = h1[1];
                s5_mm<2>(sp, U, bg >> 4, bg & 15, 1, sg, fresh_lane(), hre, him, of, wl, Z); }
        }
        return;
    }
    if (MSEL & 1) for (int u = F.gw; u < NM; u += F.NGW) { if (!keep && (u % NSEG) < 4) continue; mixC_unit<0>(mp, ST, u, fresh_lane(), OF, wl, Y); }
    if (MSEL & 2) for (int u = F.gw; u < NM; u += F.NGW) { if (!keep && (u % NSEG) < 4) continue; mixC_unit<1>(mp, ST, u, fresh_lane(), OF, wl, Y); }
    if (MSEL & 4) for (int u = F.gw; u < NM; u += F.NGW) { if (!keep && (u % NSEG) < 4) continue; mixC_unit<2>(mp, ST, u, fresh_lane(), OF, wl, Y); }
    if (MSEL & 8) for (int idx = F.gw; idx < 64 * NSEG; idx += F.NGW) {
        const int bg = idx / NSEG, sg = idx - bg * NSEG;
        if (!keep && sg < 4) continue;
        S5U U; s5_load_u(U, mp.P, bg >> 4, bg & 15, sg, fresh_lane());
        const float* h0 = ST + ST_HS + ((size_t)((0 * 64 + bg) * NSEG + sg) * 64 + fresh_lane()) * 2;
        float hre = h0[0], him = h0[1];
        s5_mm<1>(sp, U, bg >> 4, bg & 15, 0, sg, fresh_lane(), hre, him, of, wl, Z);
        const float* h1 = ST + ST_HS + ((size_t)((1 * 64 + bg) * NSEG + sg) * 64 + fresh_lane()) * 2;
        hre = h1[0]; him = h1[1];
        s5_mm<2>(sp, U, bg >> 4, bg & 15, 1, sg, fresh_lane(), hre, him, of, wl, Z);
    }
}

constexpr int NPH = 11;
template <int PH_MASK, int MSEL>
__global__ void __launch_bounds__(512, 2) mk_fwd(Args a) {
    extern __shared__ __attribute__((aligned(16))) unsigned char lds_raw[];
    Frame F;
    F.lds = (LAS unsigned char*)lds_raw;
    const int wave0 = __builtin_amdgcn_readfirstlane((int)threadIdx.x >> 6);
    F.lane = fresh_lane(); F.tid = wave0 * 64 + F.lane; F.wave = wave0;
    F.G = gridDim.x; F.gw = blockIdx.x * 8 + F.wave; F.NGW = F.G * 8; F.zz = 0; F.ws = (unsigned char*)a.in[I_WS]; F.out = (float*)a.in[I_OUT];
    volatile LAS unsigned* MISC = (volatile LAS unsigned*)(F.lds + MISC_OFF);
    for (int u = F.tid; u < 64; u += 512) ((LAS unsigned*)(F.lds + MISC_OFF))[u] = 0u;
    __syncthreads();
    XcdBarrier bar; bar.bar = (unsigned*)F.ws + CW_BAR; bar.x = 0; bar.st = nullptr;
    if (a.fused) bar = xcd_barrier_post((unsigned*)F.ws + CW_BAR, MISC + 8, F.tid);
#define SEAM() do { if (a.fused) { XcdBarrier bb = bar; asm volatile("" : "+s"(bb.bar), "+s"(bb.x)); xcd_barrier(bb, wave0 * 64 + fresh_lane()); } } while (0)
#define PHASE_BEGIN() do { int zz_ = 0; asm volatile("" : "+s"(zz_)); F.zz = zz_; F.ws = (unsigned char*)a.in[I_WS + zz_]; F.out = (float*)a.in[I_OUT + zz_]; \
        const int ln_ = fresh_lane(); const int t_ = wave0 * 64 + ln_ + zz_; F.tid = t_; F.lane = t_ & 63; F.wave = wave0 + zz_; F.G = (int)gridDim.x + zz_; F.gw = ((int)blockIdx.x + zz_) * 8 + F.wave; F.NGW = F.G * 8; \
        F.lds = (LAS unsigned char*)lds_raw + zz_; } while (0)
#define IN(k) (((PH_MASK >> (k)) & 1) && a.ph_lo <= (k) && (k) < a.ph_hi)
#ifndef DUP_PH
#define DUP_PH 0
#endif
constexpr int TAILB = 16;
#define REP(k) for (int rep_ = 0; rep_ < (((DUP_PH >> (k)) & 1) ? 2 : 1); ++rep_)
#define XRB ((bf16*)(F.ws + WS_XR))
#define MOD ((const float*)(F.ws + WS_MOD))
#define ACT ((bf16*)(F.ws + WS_ACT))
#define PH ((bf16*)(F.ws + WS_PH))

    if (((PH_MASK >> 12) & 1) && a.do_pro) REP(12) { PHASE_BEGIN(); s5_build(F, a); prologue(F, a); SEAM(); }

#pragma unroll
    for (int l = 0; l < DEPTH; ++l) {
        if (l < a.l_lo || l >= a.l_hi) continue;
        const bool keep = l < DEPTH - 1, moe = l & 1; const int j = l >> 1;
        const int Mrows = keep ? MT : NLAT;
        if (IN(0)) { PHASE_BEGIN();
            if ((l & 1) && F.G > TAILB) {
                if ((int)blockIdx.x < TAILB) {
                    const int lp = l - 1, jp = lp >> 1;
                    int k8 = DFF / 2; asm volatile("" : "+s"(k8)); pg8::Gemm g{(const bf16*)((const unsigned char*)PH + (size_t)NLAT * DFF), (const bf16*)(F.ws + WS_W2D + (size_t)jp * 1024 * DFF), MT - NLAT, 1024, k8}; pg8::StaticOrder S; S.init(MT - NLAT, 1024, TAILB, (int)blockIdx.x);
                    EpiResid E{nullptr, nullptr, XRB, MOD + (size_t)lp * 5 * 6144 + 5 * 1024, 1.0f / WSC8, NLAT / 256};
                    pg8::gemm_phase_f8<EpiResid, pg8::StaticOrder, true, true>(F.lds, g, S, E, F.tid);
                    group_arrive((unsigned*)F.ws + CW_TAIL + (2 * l + 1) * 64, F.tid);
                } else {
                    moe_cvt_idle(F, a, j, TAILB);
                    norm_phase<0>(F, a, l, 0, NLAT, -1, 0, ((int)blockIdx.x - TAILB) * 8 + F.wave, (F.G - TAILB) * 8);
                }
                group_wait((unsigned*)F.ws + CW_BAR, (unsigned*)F.ws + CW_TAIL + (2 * l + 1) * 64, TAILB, F.tid);
                norm_phase<0>(F, a, l, 0, MT, -1, NLAT, F.gw, F.NGW);
            } else {
                if (l & 1) moe_cvt(F, a, j);
                if (l == 0) norm_phase<0, false>(F, a, l, 0, MT, -1); else norm_phase<0>(F, a, l, 0, MT, (l == 2) ? 1 : -1);
            }
            SEAM();
        }
        if (IN(1)) REP(1) { PHASE_BEGIN();
            pg8::Gemm g{ACT, (const bf16*)(F.ws + WS_WIN) + (size_t)l * DINP * 1024, MT, DINP, 1024}; pg8::StaticOrder S; S.init(MT, DINP, F.G, (int)blockIdx.x);
            EpiStoreP4 E{PH};
            pg8::gemm_phase<EpiStoreP4, pg8::StaticOrder, true, true>(F.lds, g, S, E, F.tid);
            SEAM();
        }
        if (IN(2)) { PHASE_BEGIN(); mix_passA<MSEL>(F, a, l); SEAM(); }
#ifdef DUP_MIX
        if (IN(2)) { PHASE_BEGIN(); mix_passA<DUP_MIX>(F, a, l); SEAM(); }
#endif
#ifdef DUP_A
        if (IN(2)) { PHASE_BEGIN(); mix_passA<DUP_A>(F, a, l); SEAM(); }
#endif
        if (IN(3)) { PHASE_BEGIN(); mix_passB(F, a, l); SEAM(); }
        if (IN(4)) { PHASE_BEGIN(); mix_passC<MSEL>(F, a, l); SEAM(); }
#ifdef DUP_MIX
        if (IN(4)) { PHASE_BEGIN(); mix_passC<DUP_MIX>(F, a, l); SEAM(); }
#endif
#ifdef DUP_C
        if (IN(4)) { PHASE_BEGIN(); mix_passC<DUP_C>(F, a, l); SEAM(); }
#endif
        if (IN(5)) REP(5) { PHASE_BEGIN();
            int k256 = 256; asm volatile("" : "+s"(k256)); pg8::Gemm g{(const bf16*)(F.ws + WS_Z), (const bf16*)(F.ws + WS_GLUW) + (size_t)l * 65536, Mrows, 256, k256}; pg8::StaticOrder S; S.init(Mrows, 256, F.G, (int)blockIdx.x);
            EpiGlu E{(const bf16*)(F.ws + WS_Z), ACT, a.in[F.zz + I_GLUB] + l * 256};
            pg8::gemm_phase<EpiGlu, pg8::StaticOrder, true, true>(F.lds, g, S, E, F.tid);
            SEAM();
        }
        const bool f1f8 = !moe && j == FP8_F1_J;
        const bool tail = keep && F.G > TAILB;
        if (IN(6)) { PHASE_BEGIN();
            const int Mg = tail ? NLAT : Mrows;
            pg8::Gemm g{ACT, (const bf16*)(F.ws + WS_WOUT) + (size_t)l * 1024 * 1024, Mg, 1024, 1024}; pg8::StaticOrder S; S.init(Mg, 1024, F.G, (int)blockIdx.x);
            EpiResid E{(l == 0) ? a.in[F.zz + I_X] : (const float*)nullptr, (l == 0) ? a.in[F.zz + I_CTX] : (const float*)nullptr, XRB, MOD + (size_t)l * 5 * 6144 + 2 * 1024, 1.0f, 0};
            pg8::gemm_phase<EpiResid, pg8::StaticOrder, true, true>(F.lds, g, S, E, F.tid);
            SEAM();
        }
        if (IN(7)) { PHASE_BEGIN();
            if (tail) {
                if ((int)blockIdx.x < TAILB) {
                    pg8::Gemm g{ACT + (size_t)NLAT * 1024, (const bf16*)(F.ws + WS_WOUT) + (size_t)l * 1024 * 1024, MT - NLAT, 1024, 1024}; pg8::StaticOrder S; S.init(MT - NLAT, 1024, TAILB, (int)blockIdx.x);
                    EpiResid E{(l == 0) ? a.in[F.zz + I_X] : (const float*)nullptr, (l == 0) ? a.in[F.zz + I_CTX] : (const float*)nullptr, XRB, MOD + (size_t)l * 5 * 6144 + 2 * 1024, 1.0f, NLAT / 256};
                    pg8::gemm_phase<EpiResid, pg8::StaticOrder, true, true>(F.lds, g, S, E, F.tid);
                    group_arrive((unsigned*)F.ws + CW_TAIL + (2 * l) * 64, F.tid);
                } else {
                    if (moe) norm_phase<1>(F, a, l, 1, NLAT, -1, 0, ((int)blockIdx.x - TAILB) * 8 + F.wave, (F.G - TAILB) * 8); else if (f1f8) norm_phase<3>(F, a, l, 1, NLAT, -1, 0, ((int)blockIdx.x - TAILB) * 8 + F.wave, (F.G - TAILB) * 8); else norm_phase<0>(F, a, l, 1, NLAT, -1, 0, ((int)blockIdx.x - TAILB) * 8 + F.wave, (F.G - TAILB) * 8);
                }
                group_wait((unsigned*)F.ws + CW_BAR, (unsigned*)F.ws + CW_TAIL + (2 * l) * 64, TAILB, F.tid);
                if (moe) norm_phase<1>(F, a, l, 1, MT, -1, NLAT, F.gw, F.NGW); else if (f1f8) norm_phase<3>(F, a, l, 1, MT, -1, NLAT, F.gw, F.NGW); else norm_phase<0>(F, a, l, 1, MT, -1, NLAT, F.gw, F.NGW);
            } else { if (moe) norm_phase<1>(F, a, l, 1, Mrows, -1); else if (f1f8) norm_phase<3>(F, a, l, 1, Mrows, -1); else norm_phase<0>(F, a, l, 1, Mrows, -1); }
            SEAM();
        }
        if (!moe) {
            if (IN(8)) REP(8) { PHASE_BEGIN();
                if (f1f8) {
                    int k8 = 512; asm volatile("" : "+s"(k8)); pg8::Gemm g{ACT, (const bf16*)(F.ws + WS_W13D) + (size_t)j * 5632 * 1024, Mrows, 5632, k8}; pg8::StaticOrder S; S.init(Mrows, 5632, F.G, (int)blockIdx.x);
                    EpiSwiglu8 E{(unsigned char*)PH, 1.0f / WSC8};
                    pg8::gemm_phase_f8<EpiSwiglu8, pg8::StaticOrder, true, true>(F.lds, g, S, E, F.tid);
                } else {
                pg8::Gemm g{ACT, (const bf16*)(F.ws + WS_W13D) + (size_t)j * 5632 * 1024, Mrows, 5632, 1024}; pg8::StaticOrder S; S.init(Mrows, 5632, F.G, (int)blockIdx.x);
                EpiSwiglu8 E{(unsigned char*)PH, 1.0f};
                pg8::gemm_phase<EpiSwiglu8, pg8::StaticOrder, true, true>(F.lds, g, S, E, F.tid);
                }
                SEAM();
            }
            if (IN(9)) { PHASE_BEGIN();
                const int Mg = tail ? NLAT : Mrows;
                int k8 = DFF / 2; asm volatile("" : "+s"(k8)); pg8::Gemm g{PH, (const bf16*)(F.ws + WS_W2D + (size_t)j * 1024 * DFF), Mg, 1024, k8}; pg8::StaticOrder S; S.init(Mg, 1024, F.G, (int)blockIdx.x);
                EpiResid E{nullptr, nullptr, XRB, MOD + (size_t)l * 5 * 6144 + 5 * 1024, 1.0f / WSC8, 0};
                pg8::gemm_phase_f8<EpiResid, pg8::StaticOrder, true, true>(F.lds, g, S, E, F.tid);
                if (!tail) { const int rem = ((Mrows / 256) * 4) % F.G; if (rem > 0 && (int)blockIdx.x >= rem) moe_cvt_idle(F, a, j, rem); else if (rem == 0) moe_cvt(F, a, j); }
                SEAM();
            }
        } else {
            if (IN(9)) REP(9) { PHASE_BEGIN();
                int k8 = 512; asm volatile("" : "+s"(k8)); pg8::Gemm g{(const bf16*)F.ws, (const bf16*)(F.ws + WS_W13M), 0, 5632, k8}; MoeOrder S; S.init((const unsigned*)F.ws + CW_CNT + j * 8 * 64, 22, F.G, (int)blockIdx.x);
                S.cntp = (const unsigned*)F.ws + CW_CNT + j * 8 * 64; S.LISTp = (const int*)(F.ws + WS_LIST);
                EpiSwiglu8 E{(unsigned char*)PH, 1.0f / WSC8};
                pg8::gemm_phase_f8<EpiSwiglu8, MoeOrder, true, true, true>(F.lds, g, S, E, F.tid);
                SEAM();
            }
            if (IN(10)) REP(10) { PHASE_BEGIN();
                int k8 = DFF / 2; asm volatile("" : "+s"(k8)); pg8::Gemm g{PH, (const bf16*)(F.ws + WS_W2M), 0, 1024, k8}; MoeOrder S; S.init((const unsigned*)F.ws + CW_CNT + j * 8 * 64, 4, F.G, (int)blockIdx.x); S.cntp = nullptr; S.LISTp = nullptr;
                EpiStoreBf16 E{(bf16*)(F.ws + WS_X2), 1024, 1.0f / WSC8};
                pg8::gemm_phase_f8<EpiStoreBf16, MoeOrder, true, true>(F.lds, g, S, E, F.tid);
                SEAM();
            }
        }
    }
    if (((PH_MASK >> 13) & 1) && a.do_fin) { PHASE_BEGIN(); norm_phase<2>(F, a, DEPTH - 1, 0, NLAT, DEPTH - 1); }
#undef SEAM
#undef IN
#undef XRB
#undef MOD
#undef ACT
#undef PH
}

#ifndef MK_FUSED
#define MK_FUSED 1
#endif
template <int PM, int MS> static void launch_one(const Args& a, int grid, hipStream_t stream) {
    static bool attr_done = false;
    if (!attr_done) { (void)hipFuncSetAttribute((const void*)mk_fwd<PM, MS>, hipFuncAttributeMaxDynamicSharedMemorySize, LDS_BYTES); attr_done = true; }
    hipLaunchKernelGGL((mk_fwd<PM, MS>), dim3(grid), dim3(512), LDS_BYTES, stream, a);
}
extern "C" void kernel_launch(void* const* d_in, const int* in_sizes, int n_in, void* d_out, int out_size, void* d_ws, size_t ws_size, hipStream_t stream) {
    static int grid = 0;
    if (grid == 0) {
        if (n_in != 35 || in_sizes[0] != NLAT * DM || out_size != NLAT * DM || ws_size < WS_END) {
            fprintf(stderr, "kernel_launch: unexpected shapes / workspace (n_in %d, ws %zu, need %zu); nothing launched\n", n_in, ws_size, (size_t)WS_END); grid = -1; return; }
        int dev = 0, cus = 0;
        if (hipGetDevice(&dev) != hipSuccess || hipDeviceGetAttribute(&cus, hipDeviceAttributeMultiprocessorCount, dev) != hipSuccess) { grid = -1; return; }
        grid = cus;
    }
    if (grid < 0) return;
    (void)hipMemsetAsync((char*)d_ws + WS_CTL, 0, CTL_ZERO_BYTES, stream);
    Args a{};
    for (int i = 0; i < 35; ++i) a.in[i] = (const float*)d_in[i];
    a.in[I_OUT] = (const float*)d_out; a.in[I_WS] = (const float*)d_ws; a.pad = 0;
#if MK_FUSED
    a.l_lo = 0; a.l_hi = DEPTH; a.ph_lo = 0; a.ph_hi = NPH; a.do_pro = 1; a.do_fin = 1; a.fused = 1;
#ifndef TEST_PM
#define TEST_PM 0xFFFF
#endif
#ifndef TEST_MS
#define TEST_MS 15
#endif
    launch_one<TEST_PM, TEST_MS>(a, grid, stream);
#else
    a.fused = 0;
    a.l_lo = 0; a.l_hi = 0; a.ph_lo = 0; a.ph_hi = 0; a.do_pro = 1; a.do_fin = 0;
    launch_one<0x1000, 15>(a, grid, stream);
    a.do_pro = 0;
    for (int l = 0; l < DEPTH; ++l) {
        a.l_lo = l; a.l_hi = l + 1; a.ph_lo = 0; a.ph_hi = NPH;
        launch_one<0x1, 15>(a, grid, stream); launch_one<0x2, 15>(a, grid, stream); launch_one<0x4, 15>(a, grid, stream); launch_one<0x8, 15>(a, grid, stream);
        launch_one<0x10, 1>(a, grid, stream); launch_one<0x10, 2>(a, grid, stream); launch_one<0x10, 4>(a, grid, stream); launch_one<0x10, 8>(a, grid, stream);
        launch_one<0x20, 15>(a, grid, stream); launch_one<0x40, 15>(a, grid, stream); launch_one<0x80, 15>(a, grid, stream);
        launch_one<0x100, 15>(a, grid, stream); launch_one<0x200, 15>(a, grid, stream);
        if (l & 1) launch_one<0x400, 15>(a, grid, stream);
    }
    a.l_lo = 0; a.l_hi = 0; a.ph_lo = 0; a.ph_hi = 0; a.do_fin = 1;
    launch_one<0x2000, 15>(a, grid, stream);
#endif
}
```
